# Optimizing an MI355X kernel written in HIP

```python
import math
import jax
import jax.numpy as jnp
from jax import lax
import numpy as np

D_MODEL = 1024
BATCH = 8
SEQ = 2048
DEPTH = 2

N_META = 16
MIX_WIDTH = 512
N_BRANCH = 3
N_Q_HEADS = 8
N_KV_HEADS = 2
HEAD_DIM = 64
Q_GROUP = N_Q_HEADS // N_KV_HEADS
WINDOW = 128
BLOCK = 128
ROPE_THETA = 10000.0
SSM_GROUP_SIZE = 16
SSM_GROUPS = MIX_WIDTH // SSM_GROUP_SIZE
SSM_STATE = 64
DT_MIN = 1e-3
DT_MAX = 1e-1
POOL_WINDOWS = (2, 4, 8, 16)
POOL_GROUP = MIX_WIDTH // len(POOL_WINDOWS)
D_FF = 4 * D_MODEL
EPS = 1e-6
NEG_INF = -1e30

Q_W = N_Q_HEADS * HEAD_DIM
KV_W = N_KV_HEADS * HEAD_DIM
OFF_Q = 0
OFF_K = OFF_Q + Q_W
OFF_V = OFF_K + KV_W
OFF_SSM = OFF_V + KV_W
OFF_POOL = OFF_SSM + MIX_WIDTH
OFF_GATE = OFF_POOL + MIX_WIDTH
D_IN = OFF_GATE + N_BRANCH * D_MODEL

kernel_name = "hybrid_gated_swa_s5_pool_encoder"


def rms_norm(x, gain):
    xf = x.astype(jnp.float32)
    y = xf * lax.rsqrt(jnp.mean(xf * xf, axis=-1, keepdims=True) + EPS)
    return (y * gain.astype(jnp.float32)).astype(x.dtype)


def apply_rope(x, pos):
    half = HEAD_DIM // 2
    inv_freq = ROPE_THETA ** (-jnp.arange(half, dtype=jnp.float32) * 2.0 / HEAD_DIM)
    ang = pos[:, None] * inv_freq[None, :]
    cos = jnp.cos(ang)[None, :, None, :]
    sin = jnp.sin(ang)[None, :, None, :]
    xf = x.astype(jnp.float32)
    x1, x2 = xf[..., :half], xf[..., half:]
    out = jnp.concatenate([x1 * cos - x2 * sin, x2 * cos + x1 * sin], axis=-1)
    return out.astype(x.dtype)


def windowed_gqa_attention(q, k, v, sink):
    b, L = q.shape[0], q.shape[1]
    front = BLOCK - N_META
    Lp = L + front
    nb = Lp // BLOCK
    qb = jnp.pad(q, ((0, 0), (front, 0), (0, 0), (0, 0)))
    qb = qb.reshape(b, nb, BLOCK, N_KV_HEADS, Q_GROUP, HEAD_DIM)

    def band(t):
        tp = jnp.pad(t, ((0, 0), (front + BLOCK, BLOCK), (0, 0), (0, 0)))
        tp = tp.reshape(b, nb + 2, BLOCK, N_KV_HEADS, HEAD_DIM)
        return jnp.concatenate([tp[:, :-2], tp[:, 1:-1], tp[:, 2:]], axis=2)

    k_band, v_band = band(k), band(v)
    k_meta, v_meta = k[:, :N_META], v[:, :N_META]
    q_pos = jnp.arange(nb)[:, None] * BLOCK + jnp.arange(BLOCK)[None, :]
    k_pos = (jnp.arange(nb)[:, None] - 1) * BLOCK + jnp.arange(3 * BLOCK)[None, :]
    valid = ((k_pos[:, None, :] >= BLOCK) & (k_pos[:, None, :] < Lp)
             & (jnp.abs(q_pos[:, :, None] - k_pos[:, None, :]) <= WINDOW))
    scale = HEAD_DIM ** -0.5
    s_band = jnp.einsum("bnqhgd,bnkhd->bnhgqk", qb, k_band).astype(jnp.float32) * scale
    s_band = jnp.where(valid[None, :, None, None], s_band, NEG_INF)
    s_meta = jnp.einsum("bnqhgd,bmhd->bnhgqm", qb, k_meta).astype(jnp.float32) * scale
    s_sink = jnp.broadcast_to(
        sink.astype(jnp.float32).reshape(1, 1, N_KV_HEADS, Q_GROUP, 1, 1),
        s_meta.shape[:-1] + (1,))
    p = jax.nn.softmax(jnp.concatenate([s_band, s_meta, s_sink], axis=-1), axis=-1)
    nk = 3 * BLOCK
    p_band = p[..., :nk].astype(v.dtype)
    p_meta = p[..., nk:nk + N_META].astype(v.dtype)
    out = (jnp.einsum("bnhgqk,bnkhd->bnqhgd", p_band, v_band)
           + jnp.einsum("bnhgqm,bmhd->bnqhgd", p_meta, v_meta))
    return out.reshape(b, Lp, Q_W)[:, front:]


def _ssm_combine(left, right):
    a1r, a1i, b1r, b1i = left
    a2r, a2i, b2r, b2i = right
    ar = a2r * a1r - a2i * a1i
    ai = a2r * a1i + a2i * a1r
    br = a2r * b1r - a2i * b1i + b2r
    bi = a2r * b1i + a2i * b1r + b2i
    return ar, ai, br, bi


def bidirectional_s5(u, lam_re, lam_im, log_dt, b_re, b_im, c_re, c_im, d_skip, glu_w, glu_b):
    f32 = jnp.float32
    b, L = u.shape[0], u.shape[1]
    uf = u.astype(f32).reshape(b, L, SSM_GROUPS, SSM_GROUP_SIZE)
    y = d_skip.astype(f32).reshape(SSM_GROUPS, SSM_GROUP_SIZE) * uf
    for direction, reverse in ((0, False), (1, True)):
        lr = lam_re[direction].astype(f32)
        li = lam_im[direction].astype(f32)
        dt = jnp.exp(log_dt[direction].astype(f32))[:, None]
        mag = jnp.exp(lr * dt)
        abar_re = mag * jnp.cos(li * dt)
        abar_im = mag * jnp.sin(li * dt)
        den = lr * lr + li * li
        num_re = abar_re - 1.0
        f_re = (num_re * lr + abar_im * li) / den
        f_im = (abar_im * lr - num_re * li) / den
        br = b_re[direction].astype(f32)
        bi = b_im[direction].astype(f32)
        bbar_re = f_re[..., None] * br - f_im[..., None] * bi
        bbar_im = f_re[..., None] * bi + f_im[..., None] * br
        bu_re = jnp.einsum("blgp,gnp->blgn", uf, bbar_re)
        bu_im = jnp.einsum("blgp,gnp->blgn", uf, bbar_im)
        a_re = jnp.broadcast_to(abar_re, bu_re.shape)
        a_im = jnp.broadcast_to(abar_im, bu_im.shape)
        _, _, x_re, x_im = lax.associative_scan(
            _ssm_combine, (a_re, a_im, bu_re, bu_im), reverse=reverse, axis=1)
        y = (y + jnp.einsum("blgn,gpn->blgp", x_re, c_re[direction].astype(f32))
             - jnp.einsum("blgn,gpn->blgp", x_im, c_im[direction].astype(f32)))
    z = jax.nn.gelu(y.reshape(b, L, MIX_WIDTH), approximate=False)
    gate = jax.nn.sigmoid(z @ glu_w.astype(f32) + glu_b.astype(f32))
    return (z * gate).astype(u.dtype)


def multiscale_pool(u, pool_w, pool_scale):
    f32 = jnp.float32
    b, L = u.shape[0], u.shape[1]
    uf = u.astype(f32)
    cs = jnp.concatenate([jnp.zeros((b, 1, MIX_WIDTH), f32), jnp.cumsum(uf, axis=1)], axis=1)
    idx = jnp.arange(L)
    outs = []
    for gi, w in enumerate(POOL_WINDOWS):
        sl = slice(gi * POOL_GROUP, (gi + 1) * POOL_GROUP)
        lo = jnp.clip(idx - w // 2, 0, L)
        hi = jnp.clip(idx + w // 2, 0, L)
        cnt = (hi - lo).astype(f32)[None, :, None]
        csg = cs[..., sl]
        mean = (jnp.take(csg, hi, axis=1) - jnp.take(csg, lo, axis=1)) / cnt
        outs.append((mean - uf[..., sl]) @ pool_w[gi].astype(f32))
    return (jnp.concatenate(outs, axis=-1) * pool_scale.astype(f32)).astype(u.dtype)


def setup_inputs(seed: int = 0) -> dict:
    key = jax.random.key(seed)
    ks = jax.random.split(key, 32)
    f32 = jnp.float32

    def nrm(k, shape, scale):
        return jax.random.normal(k, shape, f32) * scale

    G, N, P = SSM_GROUPS, SSM_STATE, SSM_GROUP_SIZE
    n_idx = jnp.arange(N, dtype=f32)
    return {
        "x": nrm(ks[0], (BATCH, SEQ, D_MODEL), 1.0),
        "meta_tokens": nrm(ks[1], (N_META, D_MODEL), 1.0),
        "norm_mix": 1.0 + nrm(ks[2], (DEPTH, D_MODEL), 0.02),
        "w_in": nrm(ks[3], (DEPTH, D_MODEL, D_IN), D_MODEL ** -0.5),
        "attn_sink": nrm(ks[4], (DEPTH, N_Q_HEADS), 0.5),
        "ssm_lam_re": -0.5 + nrm(ks[5], (DEPTH, 2, G, N), 0.01),
        "ssm_lam_im": jnp.pi * n_idx + nrm(ks[6], (DEPTH, 2, G, N), 0.01),
        "ssm_log_dt": jax.random.uniform(ks[7], (DEPTH, 2, G), f32, math.log(DT_MIN), math.log(DT_MAX)),
        "ssm_b_re": nrm(ks[8], (DEPTH, 2, G, N, P), (2 * P) ** -0.5),
        "ssm_b_im": nrm(ks[9], (DEPTH, 2, G, N, P), (2 * P) ** -0.5),
        "ssm_c_re": nrm(ks[10], (DEPTH, 2, G, P, N), N ** -0.5),
        "ssm_c_im": nrm(ks[11], (DEPTH, 2, G, P, N), N ** -0.5),
        "ssm_d": nrm(ks[12], (DEPTH, MIX_WIDTH), 0.5),
        "ssm_glu_w": nrm(ks[13], (DEPTH, MIX_WIDTH, MIX_WIDTH), MIX_WIDTH ** -0.5),
        "ssm_glu_b": nrm(ks[14], (DEPTH, MIX_WIDTH), 0.02),
        "pool_w": nrm(ks[15], (DEPTH, len(POOL_WINDOWS), POOL_GROUP, POOL_GROUP), POOL_GROUP ** -0.5),
        "pool_scale": 1.0 + nrm(ks[16], (DEPTH, MIX_WIDTH), 0.02),
        "w_branch": nrm(ks[17], (DEPTH, N_BRANCH, MIX_WIDTH, D_MODEL), MIX_WIDTH ** -0.5),
        "w_out": nrm(ks[18], (DEPTH, D_MODEL, D_MODEL), 0.5 * D_MODEL ** -0.5),
        "norm_mlp": 1.0 + nrm(ks[19], (DEPTH, D_MODEL), 0.02),
        "w_up": nrm(ks[20], (DEPTH, D_MODEL, D_FF), D_MODEL ** -0.5),
        "w_down": nrm(ks[21], (DEPTH, D_FF, D_MODEL), 0.5 * D_FF ** -0.5),
        "norm_final": 1.0 + nrm(ks[22], (D_MODEL,), 0.02),
    }


def reference(x, meta_tokens, norm_mix, w_in, attn_sink, ssm_lam_re, ssm_lam_im, ssm_log_dt,
              ssm_b_re, ssm_b_im, ssm_c_re, ssm_c_im, ssm_d, ssm_glu_w, ssm_glu_b,
              pool_w, pool_scale, w_branch, w_out, norm_mlp, w_up, w_down, norm_final):
    b = x.shape[0]
    meta = jnp.broadcast_to(meta_tokens[None].astype(x.dtype), (b, N_META, D_MODEL))
    h = jnp.concatenate([meta, x], axis=1)
    L = h.shape[1]
    pos = jnp.arange(L, dtype=jnp.float32)
    for layer in range(DEPTH):
        hn = rms_norm(h, norm_mix[layer])
        proj = hn @ w_in[layer]
        q = apply_rope(proj[..., OFF_Q:OFF_K].reshape(b, L, N_Q_HEADS, HEAD_DIM), pos)
        k = apply_rope(proj[..., OFF_K:OFF_V].reshape(b, L, N_KV_HEADS, HEAD_DIM), pos)
        v = proj[..., OFF_V:OFF_SSM].reshape(b, L, N_KV_HEADS, HEAD_DIM)
        y_attn = windowed_gqa_attention(q, k, v, attn_sink[layer])
        y_ssm = bidirectional_s5(proj[..., OFF_SSM:OFF_POOL], ssm_lam_re[layer], ssm_lam_im[layer],
                                 ssm_log_dt[layer], ssm_b_re[layer], ssm_b_im[layer],
                                 ssm_c_re[layer], ssm_c_im[layer], ssm_d[layer],
                                 ssm_glu_w[layer], ssm_glu_b[layer])
        y_pool = multiscale_pool(proj[..., OFF_POOL:OFF_GATE], pool_w[layer], pool_scale[layer])
        ys = jnp.stack([y_attn, y_ssm, y_pool], axis=2)
        branch = jnp.einsum("blcm,cmd->blcd", ys, w_branch[layer])
        gates = jax.nn.sigmoid(proj[..., OFF_GATE:].reshape(b, L, N_BRANCH, D_MODEL))
        merged = jnp.sum(gates * branch, axis=2)
        h = h + merged @ w_out[layer]
        hn = rms_norm(h, norm_mlp[layer])
        h = h + jnp.square(jax.nn.relu(hn @ w_up[layer])) @ w_down[layer]
    return rms_norm(h, norm_final)[:, N_META:]
```

```cpp
#include <hip/hip_runtime.h>
#include <hip/hip_cooperative_groups.h>
#include <cstdio>
#include <cstdint>
namespace cg = cooperative_groups;
namespace pg8 {
#define PG8_LAS __attribute__((address_space(3)))
typedef unsigned short bf16_t;
typedef short bf16x8 __attribute__((ext_vector_type(8)));
typedef float f32x4 __attribute__((ext_vector_type(4)));
typedef unsigned u32x4 __attribute__((ext_vector_type(4)));
constexpr int BM = 256, BK = 64, HALF = 128, HTB = HALF * BK * 2  , STAGE_BYTES = 8 * HTB, NXCD = 8, WGM = 8;

__host__ __device__ __forceinline__ int lds_byte(int r, int c) { const int st = (r >> 4) * 2 + (c >> 5), rr = r & 15, cc = c & 31, ob = rr * 64 + cc * 2; return st * 1024 + (ob ^ (((ob >> 9) & 1) << 5)); }
__host__ __device__ __forceinline__ void stage_rc(int b, int& R, int& C) { const int st = b / 1024, sb = b % 1024, swz = sb ^ (((sb >> 9) & 1) << 5); R = (st >> 1) * 16 + swz / 64; C = (st & 1) * 32 + (swz % 64) / 2; }
__host__ __device__ __forceinline__ int perm32(int rho) { const int n = rho >> 4, i = rho & 15; return 8 * (i >> 2) + 4 * n + (i & 3); }

struct Unit { int pm, pn; };
struct Gemm { const bf16_t* A; const bf16_t* Bt; int M, N, K; };

struct StaticOrder {
    int nM, nN, nwg, G, c;
    __host__ __device__ void init(int M, int N, int G_, int c_) { nM = M / BM; nN = N / BM; nwg = nM * nN; G = G_; c = c_; }
    __host__ __device__ bool next(int i, Unit& u) const {
        const long L = (long)i * G + c; if (L >= nwg) return false;
        int wgid = (int)L; { const int q = nwg / NXCD, r = nwg % NXCD, xcd = wgid % NXCD, off = wgid / NXCD; wgid = (xcd < r ? xcd * (q + 1) : r * (q + 1) + (xcd - r) * q) + off; }
        const int nig = WGM * nN, gid = wgid / nig, fm = gid * WGM, gsz = (nM - fm) < WGM ? (nM - fm) : WGM;
        u.pm = fm + ((wgid % nig) % gsz); u.pn = (wgid % nig) / gsz; return true;
    }
    __device__ __forceinline__ void a_ready(const Unit&) const {}
    __device__ __forceinline__ void done(const Unit&) const {}
};

__device__ __forceinline__ unsigned cvt_pk_bf16(float lo, float hi) { unsigned r; asm volatile("v_cvt_pk_bf16_f32 %0, %1, %2" : "=v"(r) : "v"(lo), "v"(hi)); return r; }
template <class Epi, class Sched, bool ALIGN_EPI = false, bool SP2 = false>
__device__ __forceinline__ void gemm_phase(PG8_LAS unsigned char* lds, const Gemm g, const Sched& S, const Epi& E) {
    int tid_l = threadIdx.x; asm volatile("" : "+v"(tid_l));
    const int tid = tid_l, wid = __builtin_amdgcn_readfirstlane(tid >> 6), lane = tid & 63, wr = wid >> 2, wc = wid & 3, fr = lane & 15, fq = lane >> 4;
    const int K = g.K, nt = K / BK;
    unsigned voffA[2], voffB[2];
#pragma unroll
    for (int i = 0; i < 2; ++i) { int R, C; stage_rc(tid * 16 + i * 8192, R, C); const int Rb = Epi::PERM ? ((R & ~31) + perm32(R & 31)) : R;
        voffA[i] = (unsigned)(R * K + C) * 2u; voffB[i] = (unsigned)(Rb * K + C) * 2u; }
    const size_t kstep = (size_t)(BK * 2);
    const size_t hstep = (size_t)HALF * K * 2;
    const size_t tstep = 2 * hstep;
    const unsigned ldsw = (unsigned)wid * 1024u;
    const int aoff = lds_byte(wr * 64 + fr, fq * 8), boff = lds_byte(wc * 32 + fr, fq * 8);
#define PG8_SA(b, h) (((b) * 2 + (h)) * HTB)
#define PG8_SB(b, h) ((4 + (b) * 2 + (h)) * HTB)
#define PG8_STAGE(bufoff, gbase, voff) do { _Pragma("unroll") for (int _i = 0; _i < 2; ++_i) \
        __builtin_amdgcn_global_load_lds((const unsigned*)((const char*)(gbase) + (voff)[_i]), (PG8_LAS unsigned*)(lds + (bufoff) + ldsw + _i * 8192), 16, 0, 0); } while (0)
#define PG8_LDA(dst, b, h) do { _Pragma("unroll") for (int m = 0; m < 4; ++m) _Pragma("unroll") for (int k = 0; k < 2; ++k) dst[m][k] = *(const PG8_LAS bf16x8*)(lds + PG8_SA(b, h) + aoff + m * 2048 + k * 1024); } while (0)
#define PG8_LDB(dst, b, h) do { _Pragma("unroll") for (int n = 0; n < 2; ++n) _Pragma("unroll") for (int k = 0; k < 2; ++k) dst[n][k] = *(const PG8_LAS bf16x8*)(lds + PG8_SB(b, h) + boff + n * 2048 + k * 1024); } while (0)
#define PG8_MMA(ai, bj, At, Bt) do { __builtin_amdgcn_s_setprio(1); _Pragma("unroll") for (int m = 0; m < 4; ++m) _Pragma("unroll") for (int n = 0; n < 2; ++n) _Pragma("unroll") for (int k = 0; k < 2; ++k) \
        acc[ai][bj][m][n] = __builtin_amdgcn_mfma_f32_16x16x32_bf16(Bt[n][k], At[m][k], acc[ai][bj][m][n], 0, 0, 0); __builtin_amdgcn_s_setprio(0); } while (0)
#define PG8_WAIT_V(n) asm volatile("s_waitcnt vmcnt(" #n ")" ::: "memory")
#define PG8_WAIT_L(n) asm volatile("s_waitcnt lgkmcnt(" #n ")" ::: "memory")
#define PG8_BAR __builtin_amdgcn_s_barrier()
#define PG8_SCHED __builtin_amdgcn_sched_barrier(0)
    Unit cur, nxt; int ui = 0;
    if (!S.next(0, cur)) return;
    f32x4 acc[2][2][4][2];
#pragma unroll
    for (int a = 0; a < 2; ++a)
#pragma unroll
        for (int b = 0; b < 2; ++b)
#pragma unroll
            for (int m = 0; m < 4; ++m)
#pragma unroll
                for (int n = 0; n < 2; ++n) acc[a][b][m][n] = (f32x4){0.f, 0.f, 0.f, 0.f};
    bf16x8 At[4][2], B0[2][2], B1[2][2];
    const char* cA = (const char*)g.A + (size_t)cur.pm * tstep; const char* cB = (const char*)g.Bt + (size_t)cur.pn * tstep;
    S.a_ready(cur);
    if constexpr (SP2) {
        PG8_STAGE(PG8_SB(0, 0), cB, voffB); PG8_STAGE(PG8_SB(0, 1), cB + hstep, voffB); PG8_STAGE(PG8_SA(0, 0), cA, voffA); PG8_STAGE(PG8_SA(0, 1), cA + hstep, voffA);
        if (wr == 1) PG8_BAR;
        PG8_WAIT_V(2); PG8_BAR;
        PG8_STAGE(PG8_SB(1, 0), cB + kstep, voffB); PG8_STAGE(PG8_SA(1, 0), cA + kstep, voffA); PG8_STAGE(PG8_SB(1, 1), cB + hstep + kstep, voffB);
        PG8_WAIT_V(6); PG8_BAR;
    } else {
        PG8_STAGE(PG8_SB(0, 0), cB, voffB); PG8_STAGE(PG8_SA(0, 0), cA, voffA); PG8_STAGE(PG8_SB(0, 1), cB + hstep, voffB); PG8_STAGE(PG8_SA(0, 1), cA + hstep, voffA);
        if (wr == 1) PG8_BAR;
        PG8_WAIT_V(4); PG8_BAR;
        PG8_STAGE(PG8_SB(1, 0), cB + kstep, voffB); PG8_STAGE(PG8_SA(1, 0), cA + kstep, voffA); PG8_STAGE(PG8_SB(1, 1), cB + hstep + kstep, voffB);
        PG8_WAIT_V(6); PG8_BAR;
    }
    for (;;) {
        const bool has_next = S.next(ui + 1, nxt);
        const char* nA = has_next ? (const char*)g.A + (size_t)nxt.pm * tstep : cA; const char* nB = has_next ? (const char*)g.Bt + (size_t)nxt.pn * tstep : cB;
        for (int t = 0; t < nt; t += 2) {
            const bool last = (t == nt - 2);
            const char* a1 = cA + (size_t)(t + 1) * kstep;
            const char* a2 = last ? nA : cA + (size_t)(t + 2) * kstep; const char* b2 = last ? nB : cB + (size_t)(t + 2) * kstep;
            const char* a3 = a2 + kstep; const char* b3 = b2 + kstep;
            if (last && has_next) S.a_ready(nxt);
            if constexpr (SP2) {
            PG8_LDB(B0, 0, 0); PG8_LDB(B1, 0, 1); PG8_SCHED; PG8_LDA(At, 0, 0); PG8_STAGE(PG8_SA(1, 1), a1 + hstep, voffA);
            PG8_WAIT_V(8); PG8_WAIT_L(0); PG8_BAR; PG8_MMA(0, 0, At, B0); PG8_MMA(0, 1, At, B1); PG8_BAR; PG8_SCHED;
            PG8_LDA(At, 0, 1); PG8_STAGE(PG8_SB(0, 0), b2, voffB); PG8_STAGE(PG8_SB(0, 1), b2 + hstep, voffB); PG8_STAGE(PG8_SA(0, 0), a2, voffA);
            PG8_WAIT_V(8); PG8_WAIT_L(0); PG8_BAR; PG8_MMA(1, 0, At, B0); PG8_MMA(1, 1, At, B1); PG8_BAR; PG8_SCHED;
            PG8_LDB(B0, 1, 0); PG8_LDB(B1, 1, 1); PG8_SCHED; PG8_LDA(At, 1, 0); PG8_STAGE(PG8_SA(0, 1), a2 + hstep, voffA);
            PG8_WAIT_V(8); PG8_WAIT_L(0); PG8_BAR; PG8_MMA(0, 0, At, B0); PG8_MMA(0, 1, At, B1); PG8_BAR; PG8_SCHED;
            PG8_LDA(At, 1, 1); PG8_STAGE(PG8_SB(1, 0), b3, voffB); PG8_STAGE(PG8_SB(1, 1), b3 + hstep, voffB); PG8_STAGE(PG8_SA(1, 0), a3, voffA);
            PG8_WAIT_V(8); PG8_WAIT_L(0); PG8_BAR; PG8_MMA(1, 0, At, B0); PG8_MMA(1, 1, At, B1); PG8_BAR; PG8_SCHED;
            } else {
            PG8_LDB(B0, 0, 0); PG8_SCHED; PG8_LDA(At, 0, 0); PG8_STAGE(PG8_SA(1, 1), a1 + hstep, voffA);
            PG8_WAIT_L(8); PG8_BAR; PG8_WAIT_L(0); PG8_MMA(0, 0, At, B0); PG8_BAR; PG8_SCHED;
            PG8_LDB(B1, 0, 1); PG8_STAGE(PG8_SB(0, 0), b2, voffB);
            PG8_BAR; PG8_WAIT_L(0); PG8_MMA(0, 1, At, B1); PG8_BAR;
            PG8_LDA(At, 0, 1); PG8_STAGE(PG8_SA(0, 0), a2, voffA);
            PG8_BAR; PG8_WAIT_L(0); PG8_MMA(1, 0, At, B0); PG8_BAR; PG8_SCHED;
            PG8_STAGE(PG8_SB(0, 1), b2 + hstep, voffB);
            PG8_WAIT_V(6); PG8_BAR; PG8_MMA(1, 1, At, B1); PG8_BAR;
            PG8_LDB(B0, 1, 0); PG8_SCHED; PG8_LDA(At, 1, 0); PG8_STAGE(PG8_SA(0, 1), a2 + hstep, voffA);
            PG8_WAIT_L(8); PG8_BAR; PG8_WAIT_L(0); PG8_MMA(0, 0, At, B0); PG8_BAR; PG8_SCHED;
            PG8_LDB(B1, 1, 1); PG8_STAGE(PG8_SB(1, 0), b3, voffB);
            PG8_BAR; PG8_WAIT_L(0); PG8_MMA(0, 1, At, B1); PG8_BAR;
            PG8_LDA(At, 1, 1); PG8_STAGE(PG8_SA(1, 0), a3, voffA);
            PG8_BAR; PG8_WAIT_L(0); PG8_MMA(1, 0, At, B0); PG8_BAR; PG8_SCHED;
            PG8_STAGE(PG8_SB(1, 1), b3 + hstep, voffB);
            PG8_WAIT_V(6); PG8_BAR; PG8_MMA(1, 1, At, B1); PG8_BAR;
            }
        }
        if constexpr (ALIGN_EPI) { if (wr == 0) PG8_BAR; }
        if constexpr (!Epi::AFTER_DRAIN) { E(acc, cur, wr, wc, fr, fq); S.done(cur); }
        if (!has_next) break;
#pragma unroll
        for (int a = 0; a < 2; ++a)
#pragma unroll
            for (int b = 0; b < 2; ++b)
#pragma unroll
                for (int m = 0; m < 4; ++m)
#pragma unroll
                    for (int n = 0; n < 2; ++n) acc[a][b][m][n] = (f32x4){0.f, 0.f, 0.f, 0.f};
        cur = nxt; cA = nA; cB = nB; ++ui;
        if constexpr (ALIGN_EPI) { if (wr == 1) PG8_BAR; }
    }
    PG8_WAIT_V(0);
    if constexpr (!ALIGN_EPI) { if (wr == 0) PG8_BAR; }
    PG8_BAR;
    if constexpr (Epi::AFTER_DRAIN) { E.fused(acc, cur, wr, wc, fr, fq, lds, wid, lane); S.done(cur); }
#undef PG8_SA
#undef PG8_SB
#undef PG8_STAGE
#undef PG8_LDA
#undef PG8_LDB
#undef PG8_MMA
#undef PG8_WAIT_V
#undef PG8_WAIT_L
#undef PG8_BAR
#undef PG8_SCHED
}
}

#define LAS __attribute__((address_space(3)))
typedef unsigned short bf16;
typedef short bf16x8 __attribute__((ext_vector_type(8)));
typedef float f32x4 __attribute__((ext_vector_type(4)));
typedef float f32x16 __attribute__((ext_vector_type(16)));
typedef unsigned u32x2 __attribute__((ext_vector_type(2)));
typedef unsigned u32x4 __attribute__((ext_vector_type(4)));

constexpr int NB = 8, SEQ = 2048, NMETA = 16, LL = 2064, DM = 1024, FF = 4096, DIN = 4864, NPROJ = 1792;
constexpr int NREAL = NB * SEQ;
constexpr int TPR = NREAL + 256;
constexpr int LDS_BYTES = 147456;

constexpr size_t MiB = 1u << 20;
constexpr size_t WS_CTL = 0;
constexpr size_t WS_ROPE = 1 * MiB;
constexpr size_t WS_ABAR = 2 * MiB;
constexpr size_t WS_BMAT = 2 * MiB + 65536;
constexpr size_t WS_CMAT = WS_BMAT + 524288;
constexpr size_t WS_HM = 4 * MiB;
constexpr size_t WS_W = 5 * MiB;
constexpr size_t OW_IN = 0, OW_GLU = (size_t)DIN * DM * 2, OW_POOL = OW_GLU + 512 * 512 * 2, OW_BR = OW_POOL + 512 * 512 * 2,
                 OW_OUT = OW_BR + 3 * 1024 * 512 * 2, OW_UP = OW_OUT + 1024 * 1024 * 2, OW_DN = OW_UP + (size_t)FF * DM * 2, LW_BYTES = OW_DN + (size_t)FF * DM * 2;
constexpr size_t WS_HB = 68 * MiB;
constexpr size_t WS_X = 101 * MiB;
constexpr size_t UU = (size_t)TPR * 512 * 2;
constexpr size_t WS_YF = WS_X, WS_YP = WS_X, WS_Q = WS_X + 2 * UU, WS_K = WS_Q + UU, WS_V = WS_K + UU / 4, WS_MG = WS_X + 2 * UU,
                 WS_SU = WS_X + 4 * UU, WS_YA = WS_X + 8 * UU  , WS_PU = WS_X + 5 * UU, WS_YS = WS_PU, WS_Z = WS_X + 6 * UU, WS_PD = WS_X + 7 * UU, WS_BR = WS_Z, WS_ACT = WS_X;
constexpr size_t WS_RS = WS_X + 9 * UU;
constexpr size_t WS_END = WS_RS + (size_t)5 * TPR * 16 * 4;
static_assert(WS_W + 2 * LW_BYTES <= WS_HB && WS_HB + (size_t)TPR * 1024 * 2 <= WS_X && WS_END <= 256 * MiB, "ws map");
static_assert((size_t)256 * 2064 * 16 * 4 <= 2 * UU, "YF fits");

__device__ __forceinline__ unsigned f2bf(float f) { unsigned u = __float_as_uint(f); return (u + 0x7fffu + ((u >> 16) & 1u)) >> 16; }
__device__ __forceinline__ unsigned pk2(float lo, float hi) { return f2bf(lo) | (f2bf(hi) << 16); }
__device__ __forceinline__ float bf2f(unsigned b) { return __uint_as_float(b << 16); }
__device__ __forceinline__ int tok_row(int b, int l) { return l >= NMETA ? b * SEQ + l - NMETA : NREAL + b * NMETA + l; }
#define LDS_FENCE() asm volatile("s_waitcnt lgkmcnt(0)" ::: "memory")
#define SSM_SYNC() do { asm volatile("s_waitcnt vmcnt(0) lgkmcnt(0)" ::: "memory"); __syncthreads(); } while (0)
__device__ __forceinline__ float row_rstd(const float* rs, int R) {
    const f32x4 a = *(const f32x4*)(rs + (size_t)R * 4), b = *(const f32x4*)(rs + ((size_t)TPR + R) * 4), c = *(const f32x4*)(rs + ((size_t)2 * TPR + R) * 4), d = *(const f32x4*)(rs + ((size_t)3 * TPR + R) * 4);
    const float s = (((a[0] + a[1]) + (a[2] + a[3])) + ((b[0] + b[1]) + (b[2] + b[3]))) + (((c[0] + c[1]) + (c[2] + c[3])) + ((d[0] + d[1]) + (d[2] + d[3])));
    return rsqrtf(s * (1.0f / 1024.0f) + 1e-6f);
}

__device__ __forceinline__ void dsincos(double a, double& s, double& c) {
    const double q = rint(a * 0.63661977236758134308);
    double r = fma(-q, 1.57079632679489655800e+00, a); r = fma(-q, 6.12323399573676603587e-17, r);
    const double r2 = r * r;
    double sp = -7.6471637318198164759e-13; sp = fma(sp, r2, 1.6059043836821614599e-10); sp = fma(sp, r2, -2.5052108385441718775e-08); sp = fma(sp, r2, 2.7557319223985890653e-06);
    sp = fma(sp, r2, -1.9841269841269841270e-04); sp = fma(sp, r2, 8.3333333333333333333e-03); sp = fma(sp, r2, -1.6666666666666666667e-01); sp = fma(sp * r2, r, r);
    double cp = 4.7794773323873852974e-14; cp = fma(cp, r2, -1.1470745597729724714e-11); cp = fma(cp, r2, 2.0876756987868098979e-09); cp = fma(cp, r2, -2.7557319223985890653e-07);
    cp = fma(cp, r2, 2.4801587301587301587e-05); cp = fma(cp, r2, -1.3888888888888888889e-03); cp = fma(cp, r2, 4.1666666666666666667e-02); cp = fma(cp, r2, -0.5); cp = fma(cp, r2, 1.0);
    const int qi = ((int)q) & 3;
    s = (qi == 0) ? sp : (qi == 1) ? cp : (qi == 2) ? -sp : -cp;
    c = (qi == 0) ? cp : (qi == 1) ? -sp : (qi == 2) ? -cp : sp;
}
__device__ __forceinline__ double dexp(double x) {
    const double k = rint(x * 1.44269504088896340736);
    double r = fma(-k, 6.93147180369123816490e-01, x); r = fma(-k, 1.90821492927058770002e-10, r);
    double p = 1.0 / 6227020800.0; p = fma(p, r, 1.0 / 479001600.0); p = fma(p, r, 1.0 / 39916800.0); p = fma(p, r, 1.0 / 3628800.0); p = fma(p, r, 1.0 / 362880.0); p = fma(p, r, 1.0 / 40320.0);
    p = fma(p, r, 1.0 / 5040.0); p = fma(p, r, 1.0 / 720.0); p = fma(p, r, 1.0 / 120.0); p = fma(p, r, 1.0 / 24.0); p = fma(p, r, 1.0 / 6.0); p = fma(p, r, 0.5); p = fma(p, r, 1.0); p = fma(p, r, 1.0);
    const long long bits = ((long long)(1023 + (int)k)) << 52;
    return p * __longlong_as_double(bits);
}

struct EpiInProj {
    static constexpr bool PERM = false, AFTER_DRAIN = false;
    const float* rowss; const float* rope; bf16 *Q, *K, *V, *SU, *PU;
    __device__ __forceinline__ void operator()(const f32x4 (&acc)[2][2][4][2], const pg8::Unit& u, int wr, int wc, int fr, int fq) const {
#pragma unroll
        for (int ai = 0; ai < 2; ++ai)
#pragma unroll
            for (int m = 0; m < 4; ++m) {
                const int R = u.pm * 256 + ai * 128 + wr * 64 + m * 16 + fr;
                const float rs = row_rstd(rowss, R);
                const int l = R < NREAL ? (R & 2047) + NMETA : (R & 15);
#pragma unroll
                for (int bj = 0; bj < 2; ++bj)
#pragma unroll
                    for (int n = 0; n < 2; ++n) {
                        const int c = u.pn * 256 + bj * 128 + wc * 32 + n * 16 + 4 * fq;
                        const f32x4 v = acc[ai][bj][m][n] * rs;
                        u32x2 w;
                        if (c < 640) {
                            const int i0 = (c & 63) >> 1;
                            const f32x4 cs = *(const f32x4*)(rope + ((size_t)l * 32 + i0) * 2);
                            float o0 = v[0] * cs[0] - v[1] * cs[1], o1 = v[1] * cs[0] + v[0] * cs[1], o2 = v[2] * cs[2] - v[3] * cs[3], o3 = v[3] * cs[2] + v[2] * cs[3];
                            if (c < 512) { w.x = pk2(o0 * 0.125f, o1 * 0.125f); w.y = pk2(o2 * 0.125f, o3 * 0.125f); *(u32x2*)(Q + (size_t)R * 512 + c) = w; }
                            else { w.x = pk2(o0, o1); w.y = pk2(o2, o3); *(u32x2*)(K + (size_t)R * 128 + (c - 512)) = w; }
                        } else {
                            w.x = pk2(v[0], v[1]); w.y = pk2(v[2], v[3]);
                            if (c < 768) *(u32x2*)(V + (size_t)R * 128 + (c - 640)) = w;
                            else if (c < 1280) *(u32x2*)(SU + (size_t)R * 512 + (c - 768)) = w;
                            else *(u32x2*)(PU + (size_t)R * 512 + (c - 1280)) = w;
                        }
                    }
            }
    }
};
struct EpiGlu {
    static constexpr bool PERM = false, AFTER_DRAIN = false;
    const bf16* Z; const float* bias; bf16* YS;
    __device__ __forceinline__ void operator()(const f32x4 (&acc)[2][2][4][2], const pg8::Unit& u, int wr, int wc, int fr, int fq) const {
#pragma unroll
        for (int ai = 0; ai < 2; ++ai)
#pragma unroll
            for (int m = 0; m < 4; ++m) {
                const int R = u.pm * 256 + ai * 128 + wr * 64 + m * 16 + fr;
#pragma unroll
                for (int bj = 0; bj < 2; ++bj)
#pragma unroll
                    for (int n = 0; n < 2; ++n) {
                        const int c = u.pn * 256 + bj * 128 + wc * 32 + n * 16 + 4 * fq;
                        const f32x4 v = acc[ai][bj][m][n] + *(const f32x4*)(bias + c);
                        const u32x2 zz = *(const u32x2*)(Z + (size_t)R * 512 + c);
                        const float z0 = bf2f(zz.x & 0xffffu), z1 = bf2f(zz.x >> 16), z2 = bf2f(zz.y & 0xffffu), z3 = bf2f(zz.y >> 16);
                        u32x2 w; w.x = pk2(z0 / (1.0f + __expf(-v[0])), z1 / (1.0f + __expf(-v[1]))); w.y = pk2(z2 / (1.0f + __expf(-v[2])), z3 / (1.0f + __expf(-v[3])));
                        *(u32x2*)(YS + (size_t)R * 512 + c) = w;
                    }
            }
    }
};
struct EpiScale {
    static constexpr bool PERM = false, AFTER_DRAIN = false;
    bf16* O; int ldc; const float* scale;
    __device__ __forceinline__ void operator()(const f32x4 (&acc)[2][2][4][2], const pg8::Unit& u, int wr, int wc, int fr, int fq) const {
#pragma unroll
        for (int ai = 0; ai < 2; ++ai)
#pragma unroll
            for (int m = 0; m < 4; ++m) {
                const int R = u.pm * 256 + ai * 128 + wr * 64 + m * 16 + fr;
#pragma unroll
                for (int bj = 0; bj < 2; ++bj)
#pragma unroll
                    for (int n = 0; n < 2; ++n) {
                        const int c = u.pn * 256 + bj * 128 + wc * 32 + n * 16 + 4 * fq;
                        f32x4 v = acc[ai][bj][m][n];
                        if (scale) v = v * *(const f32x4*)(scale + c);
                        u32x2 w; w.x = pk2(v[0], v[1]); w.y = pk2(v[2], v[3]);
                        *(u32x2*)(O + (size_t)R * ldc + c) = w;
                    }
            }
    }
};
template <bool FIRST> struct EpiGate {
    static constexpr bool PERM = false, AFTER_DRAIN = false;
    const float* rowss; const bf16* BR; bf16* MG;
    __device__ __forceinline__ void operator()(const f32x4 (&acc)[2][2][4][2], const pg8::Unit& u, int wr, int wc, int fr, int fq) const {
#pragma unroll
        for (int ai = 0; ai < 2; ++ai)
#pragma unroll
            for (int m = 0; m < 4; ++m) {
                const int R = u.pm * 256 + ai * 128 + wr * 64 + m * 16 + fr;
                const float rs = row_rstd(rowss, R);
#pragma unroll
                for (int bj = 0; bj < 2; ++bj)
#pragma unroll
                    for (int n = 0; n < 2; ++n) {
                        const int c = u.pn * 256 + bj * 128 + wc * 32 + n * 16 + 4 * fq;
                        const f32x4 v = acc[ai][bj][m][n] * rs;
                        const u32x2 bb = *(const u32x2*)(BR + (size_t)R * 1024 + c);
                        float o0 = bf2f(bb.x & 0xffffu) / (1.0f + __expf(-v[0])), o1 = bf2f(bb.x >> 16) / (1.0f + __expf(-v[1]));
                        float o2 = bf2f(bb.y & 0xffffu) / (1.0f + __expf(-v[2])), o3 = bf2f(bb.y >> 16) / (1.0f + __expf(-v[3]));
                        if (!FIRST) { const u32x2 mm = *(const u32x2*)(MG + (size_t)R * 1024 + c);
                            o0 += bf2f(mm.x & 0xffffu); o1 += bf2f(mm.x >> 16); o2 += bf2f(mm.y & 0xffffu); o3 += bf2f(mm.y >> 16); }
                        u32x2 w; w.x = pk2(o0, o1); w.y = pk2(o2, o3);
                        *(u32x2*)(MG + (size_t)R * 1024 + c) = w;
                    }
            }
    }
};
struct EpiRes {
    static constexpr bool PERM = false, AFTER_DRAIN = false;
    float* Hreal; float* Hmeta; bf16* HB; float* rowss_out;
    __device__ __forceinline__ void operator()(const f32x4 (&acc)[2][2][4][2], const pg8::Unit& u, int wr, int wc, int fr, int fq) const {
#pragma unroll
        for (int ai = 0; ai < 2; ++ai)
#pragma unroll
            for (int m = 0; m < 4; ++m) {
                const int R = u.pm * 256 + ai * 128 + wr * 64 + m * 16 + fr;
                float* hrow = R < NREAL ? Hreal + (size_t)R * 1024 : Hmeta + (size_t)(R - NREAL) * 1024;
                float ss = 0.f;
#pragma unroll
                for (int bj = 0; bj < 2; ++bj)
#pragma unroll
                    for (int n = 0; n < 2; ++n) {
                        const int c = u.pn * 256 + bj * 128 + wc * 32 + n * 16 + 4 * fq;
                        const f32x4 h = *(const f32x4*)(hrow + c) + acc[ai][bj][m][n];
                        *(f32x4*)(hrow + c) = h;
                        ss += (h[0] * h[0] + h[1] * h[1]) + (h[2] * h[2] + h[3] * h[3]);
                        u32x2 w; w.x = pk2(h[0], h[1]); w.y = pk2(h[2], h[3]);
                        *(u32x2*)(HB + (size_t)R * 1024 + c) = w;
                    }
                ss += __shfl_xor(ss, 16); ss += __shfl_xor(ss, 32);
                if (fq == 0) rowss_out[((size_t)u.pn * TPR + R) * 4 + wc] = ss;
            }
    }
};
struct EpiUp {
    static constexpr bool PERM = false, AFTER_DRAIN = false;
    const float* rowss; bf16* ACT;
    __device__ __forceinline__ void operator()(const f32x4 (&acc)[2][2][4][2], const pg8::Unit& u, int wr, int wc, int fr, int fq) const {
#pragma unroll
        for (int ai = 0; ai < 2; ++ai)
#pragma unroll
            for (int m = 0; m < 4; ++m) {
                const int R = u.pm * 256 + ai * 128 + wr * 64 + m * 16 + fr;
                const float rs = row_rstd(rowss, R);
#pragma unroll
                for (int bj = 0; bj < 2; ++bj)
#pragma unroll
                    for (int n = 0; n < 2; ++n) {
                        const int c = u.pn * 256 + bj * 128 + wc * 32 + n * 16 + 4 * fq;
                        f32x4 v = acc[ai][bj][m][n] * rs;
#pragma unroll
                        for (int j = 0; j < 4; ++j) { const float r = fmaxf(v[j], 0.f); v[j] = r * r; }
                        u32x2 w; w.x = pk2(v[0], v[1]); w.y = pk2(v[2], v[3]);
                        *(u32x2*)(ACT + (size_t)R * FF + c) = w;
                    }
            }
    }
};

struct Args { const float* in[23]; float* out; unsigned char* ws; };

__device__ __forceinline__ void p0_item(const float* W, int ldw, int K, const float* scale, bf16* WT, int permrows, LAS float* scr, int item, int nblk, int lane) {
    const int kb = item / nblk, nb = item % nblk, k0 = 64 * kb, n0 = 32 * nb;
    const int dn = n0 + (lane & 31); int sc = dn;
    if (dn < permrows) { const int j = dn & 63; sc = (dn & ~63) + ((j & 1) ? 32 + (j >> 1) : (j >> 1)); }
#pragma unroll 8
    for (int i = 0; i < 32; ++i) { const int kk = 2 * i + (lane >> 5); float w = W[(size_t)(k0 + kk) * ldw + sc]; if (scale) w *= scale[k0 + kk]; scr[kk * 33 + (lane & 31)] = w; }
    LDS_FENCE();
    const int c = lane & 7;
#pragma unroll
    for (int j = 0; j < 4; ++j) { const int n = (lane >> 3) + 8 * j; const LAS float* s = scr + (8 * c) * 33 + n;
        u32x4 o; o.x = pk2(s[0 * 33], s[1 * 33]); o.y = pk2(s[2 * 33], s[3 * 33]); o.z = pk2(s[4 * 33], s[5 * 33]); o.w = pk2(s[6 * 33], s[7 * 33]);
        *(u32x4*)(WT + (size_t)(n0 + n) * K + k0 + 8 * c) = o; }
    LDS_FENCE();
}

__device__ __forceinline__ void p0_prologue(const Args& a, LAS unsigned char* lds) {
    const int tid = threadIdx.x, lane = tid & 63, wave = __builtin_amdgcn_readfirstlane(tid >> 6);
    const int gw = blockIdx.x * 8 + wave, NGW = gridDim.x * 8;
    const int gt = blockIdx.x * 512 + tid, NGT = gridDim.x * 512;
    unsigned char* ws = a.ws;
    LAS float* scr = (LAS float*)(lds + wave * 16384);
    constexpr int I_IN = 16 * 152, I_GLU = 8 * 16, I_BR = 8 * 32, I_OUT = 16 * 32, I_UP = 16 * 128, I_DN = 64 * 32, I_L = I_IN + I_GLU + 3 * I_BR + I_OUT + I_UP + I_DN;
    for (int it = gw; it < 2 * I_L; it += NGW) {
        const int layer = it / I_L; int r = it % I_L;
        unsigned char* wl = ws + WS_W + (size_t)layer * LW_BYTES;
        if (r < I_IN) { p0_item(a.in[3] + (size_t)layer * DM * DIN, DIN, DM, a.in[2] + layer * DM, (bf16*)(wl + OW_IN), 640, scr, r, 152, lane); continue; } r -= I_IN;
        if (r < I_GLU) { p0_item(a.in[13] + (size_t)layer * 512 * 512, 512, 512, nullptr, (bf16*)(wl + OW_GLU), 0, scr, r, 16, lane); continue; } r -= I_GLU;
        if (r < 3 * I_BR) { const int c = r / I_BR; p0_item(a.in[17] + ((size_t)layer * 3 + c) * 512 * 1024, 1024, 512, nullptr, (bf16*)(wl + OW_BR) + (size_t)c * 1024 * 512, 0, scr, r % I_BR, 32, lane); continue; } r -= 3 * I_BR;
        if (r < I_OUT) { p0_item(a.in[18] + (size_t)layer * DM * DM, DM, DM, nullptr, (bf16*)(wl + OW_OUT), 0, scr, r, 32, lane); continue; } r -= I_OUT;
        if (r < I_UP) { p0_item(a.in[20] + (size_t)layer * DM * FF, FF, DM, a.in[19] + layer * DM, (bf16*)(wl + OW_UP), 0, scr, r, 128, lane); continue; } r -= I_UP;
        p0_item(a.in[21] + (size_t)layer * FF * DM, DM, FF, nullptr, (bf16*)(wl + OW_DN), 0, scr, r, 32, lane);
    }
    for (int i = gt; i < 2 * 512 * 512; i += NGT) {
        const int layer = i >> 18, n = (i >> 9) & 511, k = i & 511;
        float w = 0.f;
        if ((n >> 7) == (k >> 7)) w = a.in[15][(((size_t)layer * 4 + (n >> 7)) * 128 + (k & 127)) * 128 + (n & 127)];
        ((bf16*)(ws + WS_W + (size_t)layer * LW_BYTES + OW_POOL))[(size_t)n * 512 + k] = (bf16)f2bf(w);
    }
    for (int i = gt; i < LL * 32; i += NGT) {
        const int l = i >> 5, f = i & 31;
        const float invf = (float)dexp(-(double)f * (9.21034037197618273607 / 32.0));
        const float ang = (float)l * invf;
        double s, c; dsincos((double)ang, s, c);
        float* rp = (float*)(ws + WS_ROPE) + (size_t)i * 2; rp[0] = (float)c; rp[1] = (float)s;
    }
    for (int i = gt; i < 2 * 2 * 32 * 64; i += NGT) {
        const int n = i & 63, pidx = i >> 6;
        const double lr = (double)a.in[5][i], li = (double)a.in[6][i];
        const double dt = (double)(float)dexp((double)a.in[7][pidx]);
        const double mag = dexp(lr * dt); double sn, cn; dsincos(li * dt, sn, cn);
        const double are = mag * cn, aim = mag * sn, den = lr * lr + li * li, nre = are - 1.0;
        const double fre = (nre * lr + aim * li) / den, fim = (aim * lr - nre * li) / den;
        float* ab = (float*)(ws + WS_ABAR) + (size_t)i * 2; ab[0] = (float)are; ab[1] = (float)aim;
        bf16* bm = (bf16*)(ws + WS_BMAT) + (size_t)pidx * 128 * 16;
        bf16* cm = (bf16*)(ws + WS_CMAT) + (size_t)pidx * 16 * 128;
        for (int q = 0; q < 16; ++q) {
            const double br = (double)a.in[8][(size_t)i * 16 + q], bi = (double)a.in[9][(size_t)i * 16 + q];
            bm[n * 16 + q] = (bf16)f2bf((float)(fre * br - fim * bi));
            bm[(64 + n) * 16 + q] = (bf16)f2bf((float)(fre * bi + fim * br));
            cm[q * 128 + n] = (bf16)f2bf(a.in[10][((size_t)pidx * 16 + q) * 64 + n]);
            cm[q * 128 + 64 + n] = (bf16)f2bf(-a.in[11][((size_t)pidx * 16 + q) * 64 + n]);
        }
    }
    for (int R = gw; R < TPR; R += NGW) {
        const int mrow = R - NREAL;
        const float* src = R < NREAL ? a.in[0] + (size_t)R * DM : a.in[1] + (size_t)(mrow & 15) * DM;
        float* dst = R < NREAL ? a.out + (size_t)R * DM : (float*)(ws + WS_HM) + (size_t)mrow * DM;
        bf16* hb = (bf16*)(ws + WS_HB) + (size_t)R * DM;
        const bool pad = mrow >= NB * NMETA;
        float ss = 0.f;
#pragma unroll
        for (int j = 0; j < 4; ++j) {
            f32x4 v = *(const f32x4*)(src + 4 * lane + 256 * j);
            if (pad) v = (f32x4){0.f, 0.f, 0.f, 0.f};
            *(f32x4*)(dst + 4 * lane + 256 * j) = v;
            ss += (v[0] * v[0] + v[1] * v[1]) + (v[2] * v[2] + v[3] * v[3]);
            u32x2 w; w.x = pk2(v[0], v[1]); w.y = pk2(v[2], v[3]);
            *(u32x2*)(hb + 4 * lane + 256 * j) = w;
        }
#pragma unroll
        for (int o = 1; o < 64; o <<= 1) ss += __shfl_xor(ss, o);
        if (lane < 16) ((float*)(ws + WS_RS))[((size_t)(lane >> 2) * TPR + R) * 4 + (lane & 3)] = lane == 0 ? ss : 0.f;
    }
}

__device__ __forceinline__ void ssm_task(LAS unsigned char* lds, int task, int layer, const bf16* SU, float* YF,
                                         const float* abar_all, const bf16* bmat_all, const bf16* cmat_all) {
    int tid_l = threadIdx.x; asm volatile("" : "+v"(tid_l));
    const int tid = tid_l, lane = tid & 63, wave = __builtin_amdgcn_readfirstlane(tid >> 6);
    const int b = task >> 5, g = task & 31;
    __syncthreads();
    LAS float* BU = (LAS float*)(lds + wave * 12800);
    LAS unsigned short* X = (LAS unsigned short*)(lds + wave * 12800 + 8448);
    LAS float* SX = (LAS float*)(lds + 8 * 12800);
    const int blk0 = wave == 0 ? 0 : 16 * wave + 1, nblk = wave == 0 ? 17 : 16;
    bf16* yfb = (bf16*)YF + (size_t)task * LL * 16;
    const int fr = lane & 15, fq = lane >> 4;
    const bf16x8 zero8 = {0, 0, 0, 0, 0, 0, 0, 0};
    for (int dir = 0; dir < 2; ++dir) {
        const int pidx = (layer * 2 + dir) * 32 + g;
        const float are = abar_all[((size_t)pidx * 64 + lane) * 2], aim = abar_all[((size_t)pidx * 64 + lane) * 2 + 1];
        bf16x8 bfr[8], cfr[4];
        const bf16* bm = bmat_all + (size_t)pidx * 128 * 16;
#pragma unroll
        for (int nt = 0; nt < 8; ++nt) bfr[nt] = fq < 2 ? *(const bf16x8*)(bm + (nt * 16 + fr) * 16 + 8 * fq) : zero8;
        const bf16* cm = cmat_all + (size_t)pidx * 16 * 128;
#pragma unroll
        for (int ks = 0; ks < 4; ++ks) cfr[ks] = *(const bf16x8*)(cm + fr * 128 + ks * 32 + 8 * fq);
        float p16r = are, p16i = aim;
#pragma unroll
        for (int i = 0; i < 4; ++i) { const float tr = p16r * p16r - p16i * p16i, ti = 2.f * p16r * p16i; p16r = tr; p16i = ti; }
        float p256r = p16r, p256i = p16i;
#pragma unroll
        for (int i = 0; i < 4; ++i) { const float tr = p256r * p256r - p256i * p256i, ti = 2.f * p256r * p256i; p256r = tr; p256i = ti; }
        const float p272r = p256r * p16r - p256i * p16i, p272i = p256r * p16i + p256i * p16r;

        float xre = 0.f, xim = 0.f;
        for (int pass = 0; pass < 2; ++pass) {
            for (int ib = 0; ib < nblk; ++ib) {
                const int blk = dir == 0 ? blk0 + ib : blk0 + nblk - 1 - ib;
                const int Rb = blk == 0 ? NREAL + b * NMETA : b * SEQ + blk * 16 - NMETA;
                const bf16x8 ufr = fq < 2 ? *(const bf16x8*)(SU + (size_t)(Rb + fr) * 512 + g * 16 + 8 * fq) : zero8;
                f32x4 dd[8];
#pragma unroll
                for (int nt = 0; nt < 8; ++nt) { dd[nt] = (f32x4){0.f, 0.f, 0.f, 0.f}; dd[nt] = __builtin_amdgcn_mfma_f32_16x16x32_bf16(ufr, bfr[nt], dd[nt], 0, 0, 0); }
                asm volatile("s_nop 15\n\ts_nop 15" : "+v"(dd[0]), "+v"(dd[1]), "+v"(dd[2]), "+v"(dd[3]), "+v"(dd[4]), "+v"(dd[5]), "+v"(dd[6]), "+v"(dd[7]));
#pragma unroll
                for (int nt = 0; nt < 8; ++nt)
#pragma unroll
                    for (int r = 0; r < 4; ++r) BU[(4 * fq + r) * 132 + nt * 16 + fr] = dd[nt][r];
                LDS_FENCE();
                if (pass == 0) {
#pragma unroll
                    for (int i = 0; i < 16; ++i) {
                        const int tt = dir == 0 ? i : 15 - i;
                        const float bre = BU[tt * 132 + lane], bim = BU[tt * 132 + 64 + lane];
                        const float nr = are * xre - aim * xim + bre, ni = are * xim + aim * xre + bim; xre = nr; xim = ni;
                    }
                    LDS_FENCE();
                } else {
#pragma unroll
                    for (int i = 0; i < 16; ++i) {
                        const int tt = dir == 0 ? i : 15 - i;
                        const float bre = BU[tt * 132 + lane], bim = BU[tt * 132 + 64 + lane];
                        const float nr = are * xre - aim * xim + bre, ni = are * xim + aim * xre + bim; xre = nr; xim = ni;
                        X[tt * 136 + lane] = (unsigned short)f2bf(xre); X[tt * 136 + 64 + lane] = (unsigned short)f2bf(xim);
                    }
                    LDS_FENCE();
                    f32x4 y = {0.f, 0.f, 0.f, 0.f};
#pragma unroll
                    for (int ks = 0; ks < 4; ++ks) {
                        const bf16x8 afr = *(const LAS bf16x8*)(X + fr * 136 + ks * 32 + 8 * fq);
                        y = __builtin_amdgcn_mfma_f32_16x16x32_bf16(afr, cfr[ks], y, 0, 0, 0);
                    }
                    asm volatile("s_nop 15\n\ts_nop 15" : "+v"(y));
                    LDS_FENCE();
                    {
                        bf16* yd = yfb + (size_t)dir * 256 * LL * 16;
#pragma unroll
                        for (int r = 0; r < 4; ++r) yd[(size_t)(blk * 16 + 4 * fq + r) * 16 + fr] = (bf16)f2bf(y[r]);
                    }
                }
            }
            if (pass == 0) {
                SX[(wave * 64 + lane) * 2] = xre; SX[(wave * 64 + lane) * 2 + 1] = xim;
                LDS_FENCE(); __syncthreads();
                float cre = 0.f, cim = 0.f;
                if (dir == 0) {
                    for (int w = 0; w < wave; ++w) { const float pr = w == 0 ? p272r : p256r, pi = w == 0 ? p272i : p256i;
                        const float sr = SX[(w * 64 + lane) * 2], si = SX[(w * 64 + lane) * 2 + 1];
                        const float nr = pr * cre - pi * cim + sr, ni = pr * cim + pi * cre + si; cre = nr; cim = ni; }
                } else {
                    for (int w = 7; w > wave; --w) {
                        const float sr = SX[(w * 64 + lane) * 2], si = SX[(w * 64 + lane) * 2 + 1];
                        const float nr = p256r * cre - p256i * cim + sr, ni = p256r * cim + p256i * cre + si; cre = nr; cim = ni; }
                }
                xre = cre; xim = cim;
            }
        }
        LDS_FENCE(); __syncthreads();
    }
}

constexpr int ATT_KROW = 72, ATT_VROW = 40, ATT_KT = 32 * ATT_KROW * 2  , ATT_VT = 64 * ATT_VROW * 2  , ATT_MAXT = 11, ATT_VOFF = ATT_MAXT * ATT_KT;
static_assert(ATT_VOFF + ATT_MAXT * ATT_VT <= 131072, "attention LDS");
__device__ __forceinline__ void attn_task(LAS unsigned char* lds, int task, const bf16* Q, const bf16* K, const bf16* V, bf16* YA, const float* sink) {
    int tid_l = threadIdx.x; asm volatile("" : "+v"(tid_l));
    const int tid = tid_l, lane = tid & 63, wave = __builtin_amdgcn_readfirstlane(tid >> 6);
    const int qb = task % 33, bh = task / 33, h = bh & 1, b = bh >> 1;
    const int l0 = qb * 64;
    __syncthreads();
    int jlo = (l0 - 128) >> 5; if (jlo < 1) jlo = 1;
    int jhi = (l0 + 191) >> 5; if (jhi > 64) jhi = 64;
    const int ntiles = 1 + (jhi - jlo + 1);
    LAS unsigned short* Ks = (LAS unsigned short*)lds;
    LAS unsigned short* Vs = (LAS unsigned short*)(lds + ATT_VOFF);
    for (int idx = tid; idx < ntiles * 32 * 8; idx += 512) {
        const int ch = idx & 7, key = idx >> 3, slot = key >> 5, kk = key & 31;
        const int lk = (slot == 0 ? 0 : (jlo + slot - 1) * 32) + kk;
        u32x4 kv = {0u, 0u, 0u, 0u}, vv = {0u, 0u, 0u, 0u};
        if (lk < LL) { const size_t R = (size_t)tok_row(b, lk);
            kv = *(const u32x4*)(K + R * 128 + h * 64 + ch * 8); vv = *(const u32x4*)(V + R * 128 + h * 64 + ch * 8); }
        *(LAS u32x4*)(Ks + slot * (ATT_KT / 2) + kk * ATT_KROW + ch * 8) = kv;
        LAS unsigned short* vd = Vs + slot * (ATT_VT / 2) + (ch * 8) * ATT_VROW + kk;
        vd[0 * ATT_VROW] = (unsigned short)(vv.x & 0xffffu); vd[1 * ATT_VROW] = (unsigned short)(vv.x >> 16);
        vd[2 * ATT_VROW] = (unsigned short)(vv.y & 0xffffu); vd[3 * ATT_VROW] = (unsigned short)(vv.y >> 16);
        vd[4 * ATT_VROW] = (unsigned short)(vv.z & 0xffffu); vd[5 * ATT_VROW] = (unsigned short)(vv.z >> 16);
        vd[6 * ATT_VROW] = (unsigned short)(vv.w & 0xffffu); vd[7 * ATT_VROW] = (unsigned short)(vv.w >> 16);
    }
    LDS_FENCE(); __syncthreads();
    const int head = h * 4 + (wave >> 1), r32 = lane & 31, hi = lane >> 5;
    const int lq = l0 + 32 * (wave & 1) + r32;
    const bool qvalid = lq < LL;
    const size_t Rq = (size_t)tok_row(b, qvalid ? lq : LL - 1);
    bf16x8 qf[4];
#pragma unroll
    for (int ks = 0; ks < 4; ++ks) qf[ks] = *(const bf16x8*)(Q + Rq * 512 + head * 64 + ks * 16 + 8 * hi);
    float mrun = sink[head], lsum = hi == 0 ? 1.0f : 0.0f;
    f32x16 o0, o1;
#pragma unroll
    for (int i = 0; i < 16; ++i) { o0[i] = 0.f; o1[i] = 0.f; }
    for (int slot = 0; slot < ntiles; ++slot) {
        const int kbase = slot == 0 ? 0 : (jlo + slot - 1) * 32;
        const LAS unsigned short* kt = Ks + slot * (ATT_KT / 2);
        f32x16 s;
#pragma unroll
        for (int i = 0; i < 16; ++i) s[i] = 0.f;
#pragma unroll
        for (int ks = 0; ks < 4; ++ks) {
            const bf16x8 kf = *(const LAS bf16x8*)(kt + r32 * ATT_KROW + ks * 16 + 8 * hi);
            s = __builtin_amdgcn_mfma_f32_32x32x16_bf16(kf, qf[ks], s, 0, 0, 0);
        }
        float mt = -1e30f;
#pragma unroll
        for (int i = 0; i < 16; ++i) {
            const int lk = kbase + (i & 3) + 8 * (i >> 2) + 4 * hi;
            int d = lq - lk; d = d < 0 ? -d : d;
            const bool valid = (lk < NMETA) || (d <= 128 && lk < LL);
            s[i] = valid ? s[i] : -1e30f;
            mt = fmaxf(mt, s[i]);
        }
        mt = fmaxf(mt, __shfl_xor(mt, 32));
        const float mnew = fmaxf(mrun, mt);
        const float alpha = __expf(mrun - mnew);
        mrun = mnew;
        float ps = 0.f;
#pragma unroll
        for (int i = 0; i < 16; ++i) { s[i] = __expf(s[i] - mnew); ps += s[i]; }
        lsum = lsum * alpha + ps;
#pragma unroll
        for (int i = 0; i < 16; ++i) { o0[i] *= alpha; o1[i] *= alpha; }
        const LAS unsigned short* vt = Vs + slot * (ATT_VT / 2);
#pragma unroll
        for (int s2 = 0; s2 < 2; ++s2) {
            union { bf16x8 v; unsigned u[4]; } pf;
            pf.u[0] = pk2(s[8 * s2 + 0], s[8 * s2 + 1]); pf.u[1] = pk2(s[8 * s2 + 2], s[8 * s2 + 3]);
            pf.u[2] = pk2(s[8 * s2 + 4], s[8 * s2 + 5]); pf.u[3] = pk2(s[8 * s2 + 6], s[8 * s2 + 7]);
#pragma unroll
            for (int dt = 0; dt < 2; ++dt) {
                union { bf16x8 v; u32x2 u[2]; } vf;
                const LAS unsigned short* vp = vt + (dt * 32 + r32) * ATT_VROW + 16 * s2 + 4 * hi;
                vf.u[0] = *(const LAS u32x2*)(vp); vf.u[1] = *(const LAS u32x2*)(vp + 8);
                if (dt == 0) o0 = __builtin_amdgcn_mfma_f32_32x32x16_bf16(vf.v, pf.v, o0, 0, 0, 0);
                else o1 = __builtin_amdgcn_mfma_f32_32x32x16_bf16(vf.v, pf.v, o1, 0, 0, 0);
            }
        }
    }
    lsum += __shfl_xor(lsum, 32);
    const float inv = 1.0f / lsum;
    if (qvalid) {
#pragma unroll
        for (int g4 = 0; g4 < 4; ++g4) {
            u32x2 w0, w1;
            w0.x = pk2(o0[4 * g4] * inv, o0[4 * g4 + 1] * inv); w0.y = pk2(o0[4 * g4 + 2] * inv, o0[4 * g4 + 3] * inv);
            w1.x = pk2(o1[4 * g4] * inv, o1[4 * g4 + 1] * inv); w1.y = pk2(o1[4 * g4 + 2] * inv, o1[4 * g4 + 3] * inv);
            *(u32x2*)(YA + Rq * 512 + head * 64 + 8 * g4 + 4 * hi) = w0;
            *(u32x2*)(YA + Rq * 512 + head * 64 + 32 + 8 * g4 + 4 * hi) = w1;
        }
    }
    __syncthreads();
}

__device__ __forceinline__ void pool_diff(const bf16* PU, bf16* PD) {
    const int gt = blockIdx.x * 512 + threadIdx.x, NGT = gridDim.x * 512;
    for (int i = gt; i < NB * LL * 64; i += NGT) {
        const int ch = i & 63, tk = i >> 6, b = tk / LL, l = tk % LL;
        const int half = 1 << (ch >> 4);
        const int lo = l - half < 0 ? 0 : l - half, hh = l + half > LL ? LL : l + half;
        float s[8];
#pragma unroll
        for (int j = 0; j < 8; ++j) s[j] = 0.f;
        for (int lp = lo; lp < hh; ++lp) {
            const u32x4 v = *(const u32x4*)(PU + (size_t)tok_row(b, lp) * 512 + ch * 8);
            s[0] += bf2f(v.x & 0xffffu); s[1] += bf2f(v.x >> 16); s[2] += bf2f(v.y & 0xffffu); s[3] += bf2f(v.y >> 16);
            s[4] += bf2f(v.z & 0xffffu); s[5] += bf2f(v.z >> 16); s[6] += bf2f(v.w & 0xffffu); s[7] += bf2f(v.w >> 16);
        }
        const float ic = 1.0f / (float)(hh - lo);
        const size_t R = (size_t)tok_row(b, l);
        const u32x4 v = *(const u32x4*)(PU + R * 512 + ch * 8);
        u32x4 o;
        o.x = pk2(s[0] * ic - bf2f(v.x & 0xffffu), s[1] * ic - bf2f(v.x >> 16)); o.y = pk2(s[2] * ic - bf2f(v.y & 0xffffu), s[3] * ic - bf2f(v.y >> 16));
        o.z = pk2(s[4] * ic - bf2f(v.z & 0xffffu), s[5] * ic - bf2f(v.z >> 16)); o.w = pk2(s[6] * ic - bf2f(v.w & 0xffffu), s[7] * ic - bf2f(v.w >> 16));
        *(u32x4*)(PD + R * 512 + ch * 8) = o;
    }
}

__device__ __forceinline__ void z_pass(const float* YF, const bf16* SU, const float* dskip, bf16* Z) {
    const int gt = blockIdx.x * 512 + threadIdx.x, NGT = gridDim.x * 512;
    for (int i = gt; i < NB * LL * 64; i += NGT) {
        const int ch = i & 63, tk = i >> 6, b = tk / LL, l = tk % LL, g = ch >> 1;
        const size_t R = (size_t)tok_row(b, l);
        const bf16* yp = (const bf16*)YF + ((size_t)(b * 32 + g) * LL + l) * 16 + (ch & 1) * 8;
        const u32x4 ya = *(const u32x4*)yp, yb = *(const u32x4*)(yp + (size_t)256 * LL * 16);
        f32x4 y0, y1;
        y0[0] = bf2f(ya.x & 0xffffu) + bf2f(yb.x & 0xffffu); y0[1] = bf2f(ya.x >> 16) + bf2f(yb.x >> 16); y0[2] = bf2f(ya.y & 0xffffu) + bf2f(yb.y & 0xffffu); y0[3] = bf2f(ya.y >> 16) + bf2f(yb.y >> 16);
        y1[0] = bf2f(ya.z & 0xffffu) + bf2f(yb.z & 0xffffu); y1[1] = bf2f(ya.z >> 16) + bf2f(yb.z >> 16); y1[2] = bf2f(ya.w & 0xffffu) + bf2f(yb.w & 0xffffu); y1[3] = bf2f(ya.w >> 16) + bf2f(yb.w >> 16);
        const f32x4 d0 = *(const f32x4*)(dskip + ch * 8), d1 = *(const f32x4*)(dskip + ch * 8 + 4);
        const u32x4 uu = *(const u32x4*)(SU + R * 512 + ch * 8);
        float t[8];
        t[0] = y0[0] + d0[0] * bf2f(uu.x & 0xffffu); t[1] = y0[1] + d0[1] * bf2f(uu.x >> 16); t[2] = y0[2] + d0[2] * bf2f(uu.y & 0xffffu); t[3] = y0[3] + d0[3] * bf2f(uu.y >> 16);
        t[4] = y1[0] + d1[0] * bf2f(uu.z & 0xffffu); t[5] = y1[1] + d1[1] * bf2f(uu.z >> 16); t[6] = y1[2] + d1[2] * bf2f(uu.w & 0xffffu); t[7] = y1[3] + d1[3] * bf2f(uu.w >> 16);
#pragma unroll
        for (int j = 0; j < 8; ++j) t[j] = 0.5f * t[j] * (1.0f + erff(t[j] * 0.70710678118654752f));
        u32x4 o; o.x = pk2(t[0], t[1]); o.y = pk2(t[2], t[3]); o.z = pk2(t[4], t[5]); o.w = pk2(t[6], t[7]);
        *(u32x4*)(Z + R * 512 + ch * 8) = o;
    }
}

#ifndef MK_ALIGN
#define MK_ALIGN false
#endif
#ifndef MK_SP2
#define MK_SP2 false
#endif
#ifndef MK_SPLIT
#define MK_SPLIT 0
#endif
constexpr int NPL = 8, NPHASE = 1 + 2 * NPL + 1, PH_FINAL = NPHASE - 1;

__global__ void __launch_bounds__(512, 2) fwd_kernel(Args a, int ph_lo, int ph_hi) {
    extern __shared__ __attribute__((aligned(16))) unsigned char lds_raw[];
    LAS unsigned char* lds = (LAS unsigned char*)lds_raw;
    const int G = gridDim.x, bid = blockIdx.x;
#if MK_SPLIT
#define GRID_SYNC() do {} while (0)
    (void)lds;
#else
    cg::grid_group grid = cg::this_grid();
#define GRID_SYNC() do { asm volatile("s_waitcnt vmcnt(0)" ::: "memory"); __syncthreads(); \
    if (threadIdx.x == 0) { __builtin_amdgcn_fence(__ATOMIC_RELEASE, "agent"); asm volatile("s_waitcnt vmcnt(0)" ::: "memory"); } \
    __syncthreads(); grid.sync(); \
    if (threadIdx.x == 0) { __builtin_amdgcn_fence(__ATOMIC_ACQUIRE, "agent"); asm volatile("s_waitcnt vmcnt(0)" ::: "memory"); } \
    __syncthreads(); } while (0)
#endif
#ifndef PHMASK
#define PHMASK 0xFFFFu
#endif
#define IN(k) (((PHMASK >> ((k) == 0 ? 0 : (k) == PH_FINAL ? 9 : 1 + ((k) - 1) % NPL)) & 1u) && ph_lo <= (k) && (k) < ph_hi)
#define SEAM(k) do { if (IN(k) && (k) + 1 < ph_hi) GRID_SYNC(); } while (0)
#define PHASE_BEGIN() unsigned char* ws = a.ws; asm volatile("" : "+s"(ws)); float* rowss = (float*)(ws + WS_RS); float* Hm = (float*)(ws + WS_HM); bf16* HB = (bf16*)(ws + WS_HB); unsigned char* wl = ws + WS_W + (size_t)layer * LW_BYTES; \
    const float* rs_mix = rowss + (size_t)(2 * layer) * TPR * 16; float* rs_mlp = rowss + (size_t)(2 * layer + 1) * TPR * 16; float* rs_next = rowss + (size_t)(2 * layer + 2) * TPR * 16; (void)Hm; (void)HB; (void)wl; (void)rs_mix; (void)rs_mlp; (void)rs_next;

    if (IN(0)) { p0_prologue(a, lds); }
    SEAM(0);
#ifndef MK_NLAYER
#define MK_NLAYER 2
#endif
#ifndef MK_RSIDX
#define MK_RSIDX 4
#endif
#pragma unroll 1
    for (int layer = 0; layer < MK_NLAYER; ++layer) {
        const int p = 1 + NPL * layer;
        if (IN(p)) { PHASE_BEGIN();
            pg8::Gemm g{HB, (const bf16*)(wl + OW_IN), TPR, NPROJ, DM}; pg8::StaticOrder S; S.init(TPR, NPROJ, G, bid);
            EpiInProj E{rs_mix, (const float*)(ws + WS_ROPE), (bf16*)(ws + WS_Q), (bf16*)(ws + WS_K), (bf16*)(ws + WS_V), (bf16*)(ws + WS_SU), (bf16*)(ws + WS_PU)};
            pg8::gemm_phase<EpiInProj, pg8::StaticOrder, MK_ALIGN, MK_SP2>(lds, g, S, E);
        }
        SEAM(p);
        if (IN(p + 1)) { PHASE_BEGIN();
            for (int t = bid; t < 256; t += G)
                ssm_task(lds, t, layer, (const bf16*)(ws + WS_SU), (float*)(ws + WS_YF), (const float*)(ws + WS_ABAR), (const bf16*)(ws + WS_BMAT), (const bf16*)(ws + WS_CMAT));
            for (int t = bid; t < NB * 2 * 33; t += G)
                attn_task(lds, t, (const bf16*)(ws + WS_Q), (const bf16*)(ws + WS_K), (const bf16*)(ws + WS_V), (bf16*)(ws + WS_YA), a.in[4] + layer * 8);
            pool_diff((const bf16*)(ws + WS_PU), (bf16*)(ws + WS_PD));
        }
        SEAM(p + 1);
        if (IN(p + 2)) { PHASE_BEGIN();
            z_pass((const float*)(ws + WS_YF), (const bf16*)(ws + WS_SU), a.in[12] + layer * 512, (bf16*)(ws + WS_Z));
        }
        SEAM(p + 2);
        if (IN(p + 3)) { PHASE_BEGIN();
            { pg8::Gemm g{(const bf16*)(ws + WS_Z), (const bf16*)(wl + OW_GLU), TPR, 512, 512}; pg8::StaticOrder S; S.init(TPR, 512, G, bid);
              EpiGlu E{(const bf16*)(ws + WS_Z), a.in[14] + layer * 512, (bf16*)(ws + WS_YS)};
              pg8::gemm_phase<EpiGlu, pg8::StaticOrder, MK_ALIGN, MK_SP2>(lds, g, S, E); }
            { pg8::Gemm g{(const bf16*)(ws + WS_PD), (const bf16*)(wl + OW_POOL), TPR, 512, 512}; pg8::StaticOrder S; S.init(TPR, 512, G, bid);
              EpiScale E{(bf16*)(ws + WS_YP), 512, a.in[16] + layer * 512};
              pg8::gemm_phase<EpiScale, pg8::StaticOrder, MK_ALIGN, MK_SP2>(lds, g, S, E); }
        }
        SEAM(p + 3);
        if (IN(p + 4)) { PHASE_BEGIN();
#pragma unroll 1
            for (int c = 0; c < 3; ++c) {
                const bf16* Yc = (const bf16*)(ws + (c == 0 ? WS_YA : c == 1 ? WS_YS : WS_YP));
                { pg8::Gemm g{Yc, (const bf16*)(wl + OW_BR) + (size_t)c * 1024 * 512, TPR, 1024, 512}; pg8::StaticOrder S; S.init(TPR, 1024, G, bid);
                  EpiScale E{(bf16*)(ws + WS_BR), 1024, nullptr};
                  pg8::gemm_phase<EpiScale, pg8::StaticOrder, MK_ALIGN, MK_SP2>(lds, g, S, E); }
                pg8::Gemm g{HB, (const bf16*)(wl + OW_IN) + (size_t)(NPROJ + c * 1024) * DM, TPR, 1024, DM}; pg8::StaticOrder S; S.init(TPR, 1024, G, bid);
                if (c == 0) { EpiGate<true> E{rs_mix, (const bf16*)(ws + WS_BR), (bf16*)(ws + WS_MG)}; pg8::gemm_phase<EpiGate<true>, pg8::StaticOrder, MK_ALIGN, MK_SP2>(lds, g, S, E); }
                else { EpiGate<false> E{rs_mix, (const bf16*)(ws + WS_BR), (bf16*)(ws + WS_MG)}; pg8::gemm_phase<EpiGate<false>, pg8::StaticOrder, MK_ALIGN, MK_SP2>(lds, g, S, E); }
            }
        }
        SEAM(p + 4);
        if (IN(p + 5)) { PHASE_BEGIN();
            pg8::Gemm g{(const bf16*)(ws + WS_MG), (const bf16*)(wl + OW_OUT), TPR, DM, DM}; pg8::StaticOrder S; S.init(TPR, DM, G, bid);
            EpiRes E{a.out, Hm, HB, rs_mlp};
            pg8::gemm_phase<EpiRes, pg8::StaticOrder, MK_ALIGN, MK_SP2>(lds, g, S, E);
        }
        SEAM(p + 5);
        if (IN(p + 6)) { PHASE_BEGIN();
            pg8::Gemm g{HB, (const bf16*)(wl + OW_UP), TPR, FF, DM}; pg8::StaticOrder S; S.init(TPR, FF, G, bid);
            EpiUp E{rs_mlp, (bf16*)(ws + WS_ACT)};
            pg8::gemm_phase<EpiUp, pg8::StaticOrder, MK_ALIGN, MK_SP2>(lds, g, S, E);
        }
        SEAM(p + 6);
        if (IN(p + 7)) { PHASE_BEGIN();
            pg8::Gemm g{(const bf16*)(ws + WS_ACT), (const bf16*)(wl + OW_DN), TPR, DM, FF}; pg8::StaticOrder S; S.init(TPR, DM, G, bid);
            EpiRes E{a.out, Hm, HB, rs_next};
            pg8::gemm_phase<EpiRes, pg8::StaticOrder, MK_ALIGN, MK_SP2>(lds, g, S, E);
        }
        SEAM(p + 7);
    }
#ifdef MK_DUMP_OFF
    if (IN(PH_FINAL)) {
        const bf16* src = (const bf16*)(a.ws + (MK_DUMP_OFF)); const bf16* src2 = (const bf16*)(a.ws + (MK_DUMP_OFF2));
        for (int i = bid * 512 + threadIdx.x; i < NREAL * 1024; i += G * 512) { const int R = MK_DUMP_ROW(i >> 10), c = i & 1023; a.out[i] = c < 512 ? bf2f(src[(size_t)R * (MK_DUMP_LD) + (c % (MK_DUMP_LD))]) : bf2f(src2[(size_t)R * (MK_DUMP_LD2) + (c % (MK_DUMP_LD2))]); }
    }
#else
    if (IN(PH_FINAL)) {
        const float* rs = (const float*)(a.ws + WS_RS) + (size_t)MK_RSIDX * TPR * 16; const float* gain = a.in[22];
        for (int i = bid * 512 + threadIdx.x; i < NREAL * 256; i += G * 512) {
            const int R = i >> 8, c4 = (i & 255) * 4;
            const float r = row_rstd(rs, R);
            f32x4 v = *(const f32x4*)(a.out + (size_t)R * DM + c4); const f32x4 gn = *(const f32x4*)(gain + c4);
            v = v * r * gn;
            *(f32x4*)(a.out + (size_t)R * DM + c4) = v;
        }
    }
#endif
#undef IN
#undef SEAM
}

extern "C" void kernel_launch(void* const* d_in, const int* in_sizes, int n_in, void* d_out, int out_size, void* d_ws, size_t ws_size, hipStream_t stream) {
    static int grid = 0;
    if (grid == 0) {
        if (n_in != 23 || out_size != NREAL * DM || ws_size < WS_END) { fprintf(stderr, "kernel_launch: unexpected shapes (n_in %d out %d ws %zu)\n", n_in, out_size, ws_size); grid = -1; return; }
        int dev = 0, cus = 0, per_cu = 0;
        hipGetDevice(&dev); hipDeviceGetAttribute(&cus, hipDeviceAttributeMultiprocessorCount, dev);
        if (hipFuncSetAttribute((const void*)fwd_kernel, hipFuncAttributeMaxDynamicSharedMemorySize, LDS_BYTES) != hipSuccess) { fprintf(stderr, "kernel_launch: hipFuncSetAttribute failed\n"); grid = -1; return; }
        if (hipOccupancyMaxActiveBlocksPerMultiprocessor(&per_cu, (const void*)fwd_kernel, 512, LDS_BYTES) != hipSuccess || per_cu < 1) { fprintf(stderr, "kernel_launch: occupancy query gave %d\n", per_cu); per_cu = 1; }
        (void)hipGetLastError();
        grid = cus * (per_cu > 1 ? 1 : per_cu);
        if (grid <= 0) grid = 256;
    }
    if (grid < 0) return;
    Args a{};
    for (int i = 0; i < 23; ++i) a.in[i] = (const float*)d_in[i];
    a.out = (float*)d_out; a.ws = (unsigned char*)d_ws;
#if MK_SPLIT
    for (int ph = 0; ph < NPHASE; ++ph) hipLaunchKernelGGL(fwd_kernel, dim3(grid), dim3(512), LDS_BYTES, stream, a, ph, ph + 1);
#else
    int lo = 0, hi = NPHASE;
    void* kargs[] = {(void*)&a, (void*)&lo, (void*)&hi};
    hipError_t e = hipLaunchCooperativeKernel((const void*)fwd_kernel, dim3(grid), dim3(512), kargs, LDS_BYTES, stream);
    if (e != hipSuccess) fprintf(stderr, "kernel_launch: cooperative launch failed: %s (grid %d)\n", hipGetErrorString(e), grid);
#endif
}
```

```cpp
#include <hip/hip_runtime.h>
#include <hip/hip_cooperative_groups.h>
#include <cstdio>
#include <cstdint>
namespace cg = cooperative_groups;
namespace pg8 {
#define PG8_LAS __attribute__((address_space(3)))
typedef unsigned short bf16_t;
typedef short bf16x8 __attribute__((ext_vector_type(8)));
typedef float f32x4 __attribute__((ext_vector_type(4)));
typedef unsigned u32x4 __attribute__((ext_vector_type(4)));
constexpr int BM = 256, BK = 64, HALF = 128, HTB = HALF * BK * 2  , STAGE_BYTES = 8 * HTB, NXCD = 8, WGM = 8;

__host__ __device__ __forceinline__ int lds_byte(int r, int c) { const int st = (r >> 4) * 2 + (c >> 5), rr = r & 15, cc = c & 31, ob = rr * 64 + cc * 2; return st * 1024 + (ob ^ (((ob >> 9) & 1) << 5)); }
__host__ __device__ __forceinline__ void stage_rc(int b, int& R, int& C) { const int st = b / 1024, sb = b % 1024, swz = sb ^ (((sb >> 9) & 1) << 5); R = (st >> 1) * 16 + swz / 64; C = (st & 1) * 32 + (swz % 64) / 2; }
__host__ __device__ __forceinline__ int perm32(int rho) { const int n = rho >> 4, i = rho & 15; return 8 * (i >> 2) + 4 * n + (i & 3); }

struct Unit { int pm, pn; };
struct Gemm { const bf16_t* A; const bf16_t* Bt; int M, N, K; };

struct StaticOrder {
    int nM, nN, nwg, G, c;
    __host__ __device__ void init(int M, int N, int G_, int c_) { nM = M / BM; nN = N / BM; nwg = nM * nN; G = G_; c = c_; }
    __host__ __device__ bool next(int i, Unit& u) const {
        const long L = (long)i * G + c; if (L >= nwg) return false;
        int wgid = (int)L; { const int q = nwg / NXCD, r = nwg % NXCD, xcd = wgid % NXCD, off = wgid / NXCD; wgid = (xcd < r ? xcd * (q + 1) : r * (q + 1) + (xcd - r) * q) + off; }
        const int nig = WGM * nN, gid = wgid / nig, fm = gid * WGM, gsz = (nM - fm) < WGM ? (nM - fm) : WGM;
        u.pm = fm + ((wgid % nig) % gsz); u.pn = (wgid % nig) / gsz; return true;
    }
    __device__ __forceinline__ void a_ready(const Unit&) const {}
    __device__ __forceinline__ void done(const Unit&) const {}
};

__device__ __forceinline__ unsigned cvt_pk_bf16(float lo, float hi) { unsigned r; asm volatile("v_cvt_pk_bf16_f32 %0, %1, %2" : "=v"(r) : "v"(lo), "v"(hi)); return r; }
template <class Epi, class Sched, bool ALIGN_EPI = false, bool SP2 = false>
__device__ __forceinline__ void gemm_phase(PG8_LAS unsigned char* lds, const Gemm g, const Sched& S, const Epi& E) {
    int tid_l = threadIdx.x; asm volatile("" : "+v"(tid_l));
    const int tid = tid_l, wid = __builtin_amdgcn_readfirstlane(tid >> 6), lane = tid & 63, wr = wid >> 2, wc = wid & 3, fr = lane & 15, fq = lane >> 4;
    const int K = g.K, nt = K / BK;
    unsigned voffA[2], voffB[2];
#pragma unroll
    for (int i = 0; i < 2; ++i) { int R, C; stage_rc(tid * 16 + i * 8192, R, C); const int Rb = Epi::PERM ? ((R & ~31) + perm32(R & 31)) : R;
        voffA[i] = (unsigned)(R * K + C) * 2u; voffB[i] = (unsigned)(Rb * K + C) * 2u; }
    const size_t kstep = (size_t)(BK * 2);
    const size_t hstep = (size_t)HALF * K * 2;
    const size_t tstep = 2 * hstep;
    const unsigned ldsw = (unsigned)wid * 1024u;
    const int aoff = lds_byte(wr * 64 + fr, fq * 8), boff = lds_byte(wc * 32 + fr, fq * 8);
#define PG8_SA(b, h) (((b) * 2 + (h)) * HTB)
#define PG8_SB(b, h) ((4 + (b) * 2 + (h)) * HTB)
#define PG8_STAGE(bufoff, gbase, voff) do { _Pragma("unroll") for (int _i = 0; _i < 2; ++_i) \
        __builtin_amdgcn_global_load_lds((const unsigned*)((const char*)(gbase) + (voff)[_i]), (PG8_LAS unsigned*)(lds + (bufoff) + ldsw + _i * 8192), 16, 0, 0); } while (0)
#define PG8_LDA(dst, b, h) do { _Pragma("unroll") for (int m = 0; m < 4; ++m) _Pragma("unroll") for (int k = 0; k < 2; ++k) dst[m][k] = *(const PG8_LAS bf16x8*)(lds + PG8_SA(b, h) + aoff + m * 2048 + k * 1024); } while (0)
#define PG8_LDB(dst, b, h) do { _Pragma("unroll") for (int n = 0; n < 2; ++n) _Pragma("unroll") for (int k = 0; k < 2; ++k) dst[n][k] = *(const PG8_LAS bf16x8*)(lds + PG8_SB(b, h) + boff + n * 2048 + k * 1024); } while (0)
#define PG8_MMA(ai, bj, At, Bt) do { __builtin_amdgcn_s_setprio(1); _Pragma("unroll") for (int m = 0; m < 4; ++m) _Pragma("unroll") for (int n = 0; n < 2; ++n) _Pragma("unroll") for (int k = 0; k < 2; ++k) \
        acc[ai][bj][m][n] = __builtin_amdgcn_mfma_f32_16x16x32_bf16(Bt[n][k], At[m][k], acc[ai][bj][m][n], 0, 0, 0); __builtin_amdgcn_s_setprio(0); } while (0)
#define PG8_WAIT_V(n) asm volatile("s_waitcnt vmcnt(" #n ")" ::: "memory")
#define PG8_WAIT_L(n) asm volatile("s_waitcnt lgkmcnt(" #n ")" ::: "memory")
#define PG8_BAR __builtin_amdgcn_s_barrier()
#define PG8_SCHED __builtin_amdgcn_sched_barrier(0)
    Unit cur, nxt; int ui = 0;
    if (!S.next(0, cur)) return;
    f32x4 acc[2][2][4][2];
#pragma unroll
    for (int a = 0; a < 2; ++a)
#pragma unroll
        for (int b = 0; b < 2; ++b)
#pragma unroll
            for (int m = 0; m < 4; ++m)
#pragma unroll
                for (int n = 0; n < 2; ++n) acc[a][b][m][n] = (f32x4){0.f, 0.f, 0.f, 0.f};
    bf16x8 At[4][2], B0[2][2], B1[2][2];
    const char* cA = (const char*)g.A + (size_t)cur.pm * tstep; const char* cB = (const char*)g.Bt + (size_t)cur.pn * tstep;
    S.a_ready(cur);
    if constexpr (SP2) {
        PG8_STAGE(PG8_SB(0, 0), cB, voffB); PG8_STAGE(PG8_SB(0, 1), cB + hstep, voffB); PG8_STAGE(PG8_SA(0, 0), cA, voffA); PG8_STAGE(PG8_SA(0, 1), cA + hstep, voffA);
        if (wr == 1) PG8_BAR;
        PG8_WAIT_V(2); PG8_BAR;
        PG8_STAGE(PG8_SB(1, 0), cB + kstep, voffB); PG8_STAGE(PG8_SA(1, 0), cA + kstep, voffA); PG8_STAGE(PG8_SB(1, 1), cB + hstep + kstep, voffB);
        PG8_WAIT_V(6); PG8_BAR;
    } else {
        PG8_STAGE(PG8_SB(0, 0), cB, voffB); PG8_STAGE(PG8_SA(0, 0), cA, voffA); PG8_STAGE(PG8_SB(0, 1), cB + hstep, voffB); PG8_STAGE(PG8_SA(0, 1), cA + hstep, voffA);
        if (wr == 1) PG8_BAR;
        PG8_WAIT_V(4); PG8_BAR;
        PG8_STAGE(PG8_SB(1, 0), cB + kstep, voffB); PG8_STAGE(PG8_SA(1, 0), cA + kstep, voffA); PG8_STAGE(PG8_SB(1, 1), cB + hstep + kstep, voffB);
        PG8_WAIT_V(6); PG8_BAR;
    }
    for (;;) {
        const bool has_next = S.next(ui + 1, nxt);
        const char* nA = has_next ? (const char*)g.A + (size_t)nxt.pm * tstep : cA; const char* nB = has_next ? (const char*)g.Bt + (size_t)nxt.pn * tstep : cB;
        for (int t = 0; t < nt; t += 2) {
            const bool last = (t == nt - 2);
            const char* a1 = cA + (size_t)(t + 1) * kstep;
            const char* a2 = last ? nA : cA + (size_t)(t + 2) * kstep; const char* b2 = last ? nB : cB + (size_t)(t + 2) * kstep;
            const char* a3 = a2 + kstep; const char* b3 = b2 + kstep;
            if (last && has_next) S.a_ready(nxt);
            if constexpr (SP2) {
            PG8_LDB(B0, 0, 0); PG8_LDB(B1, 0, 1); PG8_SCHED; PG8_LDA(At, 0, 0); PG8_STAGE(PG8_SA(1, 1), a1 + hstep, voffA);
            PG8_WAIT_V(8); PG8_WAIT_L(0); PG8_BAR; PG8_MMA(0, 0, At, B0); PG8_MMA(0, 1, At, B1); PG8_BAR; PG8_SCHED;
            PG8_LDA(At, 0, 1); PG8_STAGE(PG8_SB(0, 0), b2, voffB); PG8_STAGE(PG8_SB(0, 1), b2 + hstep, voffB); PG8_STAGE(PG8_SA(0, 0), a2, voffA);
            PG8_WAIT_V(8); PG8_WAIT_L(0); PG8_BAR; PG8_MMA(1, 0, At, B0); PG8_MMA(1, 1, At, B1); PG8_BAR; PG8_SCHED;
            PG8_LDB(B0, 1, 0); PG8_LDB(B1, 1, 1); PG8_SCHED; PG8_LDA(At, 1, 0); PG8_STAGE(PG8_SA(0, 1), a2 + hstep, voffA);
            PG8_WAIT_V(8); PG8_WAIT_L(0); PG8_BAR; PG8_MMA(0, 0, At, B0); PG8_MMA(0, 1, At, B1); PG8_BAR; PG8_SCHED;
            PG8_LDA(At, 1, 1); PG8_STAGE(PG8_SB(1, 0), b3, voffB); PG8_STAGE(PG8_SB(1, 1), b3 + hstep, voffB); PG8_STAGE(PG8_SA(1, 0), a3, voffA);
            PG8_WAIT_V(8); PG8_WAIT_L(0); PG8_BAR; PG8_MMA(1, 0, At, B0); PG8_MMA(1, 1, At, B1); PG8_BAR; PG8_SCHED;
            } else {
            PG8_LDB(B0, 0, 0); PG8_SCHED; PG8_LDA(At, 0, 0); PG8_STAGE(PG8_SA(1, 1), a1 + hstep, voffA);
            PG8_WAIT_L(8); PG8_BAR; PG8_WAIT_L(0); PG8_MMA(0, 0, At, B0); PG8_BAR; PG8_SCHED;
            PG8_LDB(B1, 0, 1); PG8_STAGE(PG8_SB(0, 0), b2, voffB);
            PG8_BAR; PG8_WAIT_L(0); PG8_MMA(0, 1, At, B1); PG8_BAR;
            PG8_LDA(At, 0, 1); PG8_STAGE(PG8_SA(0, 0), a2, voffA);
            PG8_BAR; PG8_WAIT_L(0); PG8_MMA(1, 0, At, B0); PG8_BAR; PG8_SCHED;
            PG8_STAGE(PG8_SB(0, 1), b2 + hstep, voffB);
            PG8_WAIT_V(6); PG8_BAR; PG8_MMA(1, 1, At, B1); PG8_BAR;
            PG8_LDB(B0, 1, 0); PG8_SCHED; PG8_LDA(At, 1, 0); PG8_STAGE(PG8_SA(0, 1), a2 + hstep, voffA);
            PG8_WAIT_L(8); PG8_BAR; PG8_WAIT_L(0); PG8_MMA(0, 0, At, B0); PG8_BAR; PG8_SCHED;
            PG8_LDB(B1, 1, 1); PG8_STAGE(PG8_SB(1, 0), b3, voffB);
            PG8_BAR; PG8_WAIT_L(0); PG8_MMA(0, 1, At, B1); PG8_BAR;
            PG8_LDA(At, 1, 1); PG8_STAGE(PG8_SA(1, 0), a3, voffA);
            PG8_BAR; PG8_WAIT_L(0); PG8_MMA(1, 0, At, B0); PG8_BAR; PG8_SCHED;
            PG8_STAGE(PG8_SB(1, 1), b3 + hstep, voffB);
            PG8_WAIT_V(6); PG8_BAR; PG8_MMA(1, 1, At, B1); PG8_BAR;
            }
        }
        if constexpr (ALIGN_EPI) { if (wr == 0) PG8_BAR; }
        asm volatile("s_nop 15\n\ts_nop 15" ::: "memory");
        if constexpr (!Epi::AFTER_DRAIN) { E(acc, cur, wr, wc, fr, fq); S.done(cur); }
        if (!has_next) break;
#pragma unroll
        for (int a = 0; a < 2; ++a)
#pragma unroll
            for (int b = 0; b < 2; ++b)
#pragma unroll
                for (int m = 0; m < 4; ++m)
#pragma unroll
                    for (int n = 0; n < 2; ++n) acc[a][b][m][n] = (f32x4){0.f, 0.f, 0.f, 0.f};
        cur = nxt; cA = nA; cB = nB; ++ui;
        if constexpr (ALIGN_EPI) { if (wr == 1) PG8_BAR; }
    }
    PG8_WAIT_V(0);
    if constexpr (!ALIGN_EPI) { if (wr == 0) PG8_BAR; }
    PG8_BAR;
    if constexpr (Epi::AFTER_DRAIN) { E.fused(acc, cur, wr, wc, fr, fq, lds, wid, lane); S.done(cur); }
#undef PG8_SA
#undef PG8_SB
#undef PG8_STAGE
#undef PG8_LDA
#undef PG8_LDB
#undef PG8_MMA
#undef PG8_WAIT_V
#undef PG8_WAIT_L
#undef PG8_BAR
#undef PG8_SCHED
}
}

#define LAS __attribute__((address_space(3)))
typedef unsigned short bf16;
typedef short bf16x8 __attribute__((ext_vector_type(8)));
typedef float f32x4 __attribute__((ext_vector_type(4)));
typedef float f32x16 __attribute__((ext_vector_type(16)));
typedef unsigned u32x2 __attribute__((ext_vector_type(2)));
typedef unsigned u32x4 __attribute__((ext_vector_type(4)));

constexpr int NB = 8, SEQ = 2048, NMETA = 16, LL = 2064, DM = 1024, FF = 4096, DIN = 4864, NPROJ = 1792;
constexpr int NREAL = NB * SEQ;
constexpr int TPR = NREAL + 256;
constexpr int LDS_BYTES = 147456;

constexpr size_t MiB = 1u << 20;
constexpr size_t WS_CTL = 0;
constexpr size_t WS_ROPE = 1 * MiB;
constexpr size_t WS_ABAR = 2 * MiB;
constexpr size_t WS_BMAT = 2 * MiB + 65536;
constexpr size_t WS_CMAT = WS_BMAT + 524288;
constexpr size_t WS_HM = 4 * MiB;
constexpr size_t WS_W = 5 * MiB;
constexpr size_t OW_IN = 0, OW_GLU = (size_t)DIN * DM * 2, OW_POOL = OW_GLU + 512 * 512 * 2, OW_BR = OW_POOL + 512 * 512 * 2,
                 OW_OUT = OW_BR + 3 * 1024 * 512 * 2, OW_UP = OW_OUT + 1024 * 1024 * 2, OW_DN = OW_UP + (size_t)FF * DM * 2, LW_BYTES = OW_DN + (size_t)FF * DM * 2;
constexpr size_t WS_HB = 68 * MiB;
constexpr size_t WS_X = 101 * MiB;
constexpr size_t UU = (size_t)TPR * 512 * 2;
constexpr size_t WS_YF = WS_X, WS_YP = WS_X, WS_Q = WS_X + 2 * UU, WS_K = WS_Q + UU, WS_V = WS_K + UU / 4, WS_MG = WS_X + 2 * UU,
                 WS_SU = WS_X + 4 * UU, WS_YA = WS_X + 8 * UU  , WS_PU = WS_X + 5 * UU, WS_YS = WS_PU, WS_Z = WS_X + 6 * UU, WS_PD = WS_X + 7 * UU, WS_BR = WS_Z, WS_ACT = WS_X;
constexpr size_t WS_RS = WS_X + 9 * UU;
constexpr size_t WS_END = WS_RS + (size_t)5 * TPR * 16 * 4;
static_assert(WS_W + 2 * LW_BYTES <= WS_HB && WS_HB + (size_t)TPR * 1024 * 2 <= WS_X && WS_END <= 256 * MiB, "ws map");
static_assert((size_t)256 * 2064 * 16 * 4 <= 2 * UU, "YF fits");

__device__ __forceinline__ unsigned f2bf(float f) { unsigned u = __float_as_uint(f); return (u + 0x7fffu + ((u >> 16) & 1u)) >> 16; }
__device__ __forceinline__ unsigned pk2(float lo, float hi) { return f2bf(lo) | (f2bf(hi) << 16); }
__device__ __forceinline__ float bf2f(unsigned b) { return __uint_as_float(b << 16); }
__device__ __forceinline__ int tok_row(int b, int l) { return l >= NMETA ? b * SEQ + l - NMETA : NREAL + b * NMETA + l; }
#define LDS_FENCE() asm volatile("s_waitcnt lgkmcnt(0)" ::: "memory")
#define SSM_SYNC() do { asm volatile("s_waitcnt vmcnt(0) lgkmcnt(0)" ::: "memory"); __syncthreads(); } while (0)
__device__ __forceinline__ float row_rstd(const float* rs, int R) {
    const f32x4 a = *(const f32x4*)(rs + (size_t)R * 4), b = *(const f32x4*)(rs + ((size_t)TPR + R) * 4), c = *(const f32x4*)(rs + ((size_t)2 * TPR + R) * 4), d = *(const f32x4*)(rs + ((size_t)3 * TPR + R) * 4);
    const float s = (((a[0] + a[1]) + (a[2] + a[3])) + ((b[0] + b[1]) + (b[2] + b[3]))) + (((c[0] + c[1]) + (c[2] + c[3])) + ((d[0] + d[1]) + (d[2] + d[3])));
    return rsqrtf(s * (1.0f / 1024.0f) + 1e-6f);
}

__device__ __forceinline__ void dsincos(double a, double& s, double& c) {
    const double q = rint(a * 0.63661977236758134308);
    double r = fma(-q, 1.57079632679489655800e+00, a); r = fma(-q, 6.12323399573676603587e-17, r);
    const double r2 = r * r;
    double sp = -7.6471637318198164759e-13; sp = fma(sp, r2, 1.6059043836821614599e-10); sp = fma(sp, r2, -2.5052108385441718775e-08); sp = fma(sp, r2, 2.7557319223985890653e-06);
    sp = fma(sp, r2, -1.9841269841269841270e-04); sp = fma(sp, r2, 8.3333333333333333333e-03); sp = fma(sp, r2, -1.6666666666666666667e-01); sp = fma(sp * r2, r, r);
    double cp = 4.7794773323873852974e-14; cp = fma(cp, r2, -1.1470745597729724714e-11); cp = fma(cp, r2, 2.0876756987868098979e-09); cp = fma(cp, r2, -2.7557319223985890653e-07);
    cp = fma(cp, r2, 2.4801587301587301587e-05); cp = fma(cp, r2, -1.3888888888888888889e-03); cp = fma(cp, r2, 4.1666666666666666667e-02); cp = fma(cp, r2, -0.5); cp = fma(cp, r2, 1.0);
    const int qi = ((int)q) & 3;
    s = (qi == 0) ? sp : (qi == 1) ? cp : (qi == 2) ? -sp : -cp;
    c = (qi == 0) ? cp : (qi == 1) ? -sp : (qi == 2) ? -cp : sp;
}
__device__ __forceinline__ double dexp(double x) {
    const double k = rint(x * 1.44269504088896340736);
    double r = fma(-k, 6.93147180369123816490e-01, x); r = fma(-k, 1.90821492927058770002e-10, r);
    double p = 1.0 / 6227020800.0; p = fma(p, r, 1.0 / 479001600.0); p = fma(p, r, 1.0 / 39916800.0); p = fma(p, r, 1.0 / 3628800.0); p = fma(p, r, 1.0 / 362880.0); p = fma(p, r, 1.0 / 40320.0);
    p = fma(p, r, 1.0 / 5040.0); p = fma(p, r, 1.0 / 720.0); p = fma(p, r, 1.0 / 120.0); p = fma(p, r, 1.0 / 24.0); p = fma(p, r, 1.0 / 6.0); p = fma(p, r, 0.5); p = fma(p, r, 1.0); p = fma(p, r, 1.0);
    const long long bits = ((long long)(1023 + (int)k)) << 52;
    return p * __longlong_as_double(bits);
}

struct EpiInProj {
    static constexpr bool PERM = false, AFTER_DRAIN = false;
    const float* rowss; const float* rope; bf16 *Q, *K, *V, *SU, *PU;
    __device__ __forceinline__ void operator()(const f32x4 (&acc)[2][2][4][2], const pg8::Unit& u, int wr, int wc, int fr, int fq) const {
#pragma unroll
        for (int ai = 0; ai < 2; ++ai)
#pragma unroll
            for (int m = 0; m < 4; ++m) {
                const int R = u.pm * 256 + ai * 128 + wr * 64 + m * 16 + fr;
                const float rs = row_rstd(rowss, R);
                const int l = R < NREAL ? (R & 2047) + NMETA : (R & 15);
#pragma unroll
                for (int bj = 0; bj < 2; ++bj)
#pragma unroll
                    for (int n = 0; n < 2; ++n) {
                        const int c = u.pn * 256 + bj * 128 + wc * 32 + n * 16 + 4 * fq;
                        const f32x4 v = acc[ai][bj][m][n] * rs;
                        u32x2 w;
                        if (c < 640) {
                            const int i0 = (c & 63) >> 1;
                            const f32x4 cs = *(const f32x4*)(rope + ((size_t)l * 32 + i0) * 2);
                            float o0 = v[0] * cs[0] - v[1] * cs[1], o1 = v[1] * cs[0] + v[0] * cs[1], o2 = v[2] * cs[2] - v[3] * cs[3], o3 = v[3] * cs[2] + v[2] * cs[3];
                            if (c < 512) { w.x = pk2(o0 * 0.125f, o1 * 0.125f); w.y = pk2(o2 * 0.125f, o3 * 0.125f); *(u32x2*)(Q + (size_t)R * 512 + c) = w; }
                            else { w.x = pk2(o0, o1); w.y = pk2(o2, o3); *(u32x2*)(K + (size_t)R * 128 + (c - 512)) = w; }
                        } else {
                            w.x = pk2(v[0], v[1]); w.y = pk2(v[2], v[3]);
                            if (c < 768) *(u32x2*)(V + (size_t)R * 128 + (c - 640)) = w;
                            else if (c < 1280) *(u32x2*)(SU + (size_t)R * 512 + (c - 768)) = w;
                            else *(u32x2*)(PU + (size_t)R * 512 + (c - 1280)) = w;
                        }
                    }
            }
    }
};
struct EpiGlu {
    static constexpr bool PERM = false, AFTER_DRAIN = false;
    const bf16* Z; const float* bias; bf16* YS;
    __device__ __forceinline__ void operator()(const f32x4 (&acc)[2][2][4][2], const pg8::Unit& u, int wr, int wc, int fr, int fq) const {
#pragma unroll
        for (int ai = 0; ai < 2; ++ai)
#pragma unroll
            for (int m = 0; m < 4; ++m) {
                const int R = u.pm * 256 + ai * 128 + wr * 64 + m * 16 + fr;
#pragma unroll
                for (int bj = 0; bj < 2; ++bj)
#pragma unroll
                    for (int n = 0; n < 2; ++n) {
                        const int c = u.pn * 256 + bj * 128 + wc * 32 + n * 16 + 4 * fq;
                        const f32x4 v = acc[ai][bj][m][n] + *(const f32x4*)(bias + c);
                        const u32x2 zz = *(const u32x2*)(Z + (size_t)R * 512 + c);
                        const float z0 = bf2f(zz.x & 0xffffu), z1 = bf2f(zz.x >> 16), z2 = bf2f(zz.y & 0xffffu), z3 = bf2f(zz.y >> 16);
                        u32x2 w; w.x = pk2(z0 / (1.0f + __expf(-v[0])), z1 / (1.0f + __expf(-v[1]))); w.y = pk2(z2 / (1.0f + __expf(-v[2])), z3 / (1.0f + __expf(-v[3])));
                        *(u32x2*)(YS + (size_t)R * 512 + c) = w;
                    }
            }
    }
};
struct EpiScale {
    static constexpr bool PERM = false, AFTER_DRAIN = false;
    bf16* O; int ldc; const float* scale;
    __device__ __forceinline__ void operator()(const f32x4 (&acc)[2][2][4][2], const pg8::Unit& u, int wr, int wc, int fr, int fq) const {
#pragma unroll
        for (int ai = 0; ai < 2; ++ai)
#pragma unroll
            for (int m = 0; m < 4; ++m) {
                const int R = u.pm * 256 + ai * 128 + wr * 64 + m * 16 + fr;
#pragma unroll
                for (int bj = 0; bj < 2; ++bj)
#pragma unroll
                    for (int n = 0; n < 2; ++n) {
                        const int c = u.pn * 256 + bj * 128 + wc * 32 + n * 16 + 4 * fq;
                        f32x4 v = acc[ai][bj][m][n];
                        if (scale) v = v * *(const f32x4*)(scale + c);
                        u32x2 w; w.x = pk2(v[0], v[1]); w.y = pk2(v[2], v[3]);
                        *(u32x2*)(O + (size_t)R * ldc + c) = w;
                    }
            }
    }
};
template <bool FIRST> struct EpiGate {
    static constexpr bool PERM = false, AFTER_DRAIN = false;
    const float* rowss; const bf16* BR; bf16* MG;
    __device__ __forceinline__ void operator()(const f32x4 (&acc)[2][2][4][2], const pg8::Unit& u, int wr, int wc, int fr, int fq) const {
#pragma unroll
        for (int ai = 0; ai < 2; ++ai)
#pragma unroll
            for (int m = 0; m < 4; ++m) {
                const int R = u.pm * 256 + ai * 128 + wr * 64 + m * 16 + fr;
                const float rs = row_rstd(rowss, R);
#pragma unroll
                for (int bj = 0; bj < 2; ++bj)
#pragma unroll
                    for (int n = 0; n < 2; ++n) {
                        const int c = u.pn * 256 + bj * 128 + wc * 32 + n * 16 + 4 * fq;
                        const f32x4 v = acc[ai][bj][m][n] * rs;
                        const u32x2 bb = *(const u32x2*)(BR + (size_t)R * 1024 + c);
                        float o0 = bf2f(bb.x & 0xffffu) / (1.0f + __expf(-v[0])), o1 = bf2f(bb.x >> 16) / (1.0f + __expf(-v[1]));
                        float o2 = bf2f(bb.y & 0xffffu) / (1.0f + __expf(-v[2])), o3 = bf2f(bb.y >> 16) / (1.0f + __expf(-v[3]));
                        if (!FIRST) { const u32x2 mm = *(const u32x2*)(MG + (size_t)R * 1024 + c);
                            o0 += bf2f(mm.x & 0xffffu); o1 += bf2f(mm.x >> 16); o2 += bf2f(mm.y & 0xffffu); o3 += bf2f(mm.y >> 16); }
                        u32x2 w; w.x = pk2(o0, o1); w.y = pk2(o2, o3);
                        *(u32x2*)(MG + (size_t)R * 1024 + c) = w;
                    }
            }
    }
};
struct EpiRes {
    static constexpr bool PERM = false, AFTER_DRAIN = false;
    float* Hreal; float* Hmeta; bf16* HB; float* rowss_out;
    __device__ __forceinline__ void operator()(const f32x4 (&acc)[2][2][4][2], const pg8::Unit& u, int wr, int wc, int fr, int fq) const {
#pragma unroll
        for (int ai = 0; ai < 2; ++ai)
#pragma unroll
            for (int m = 0; m < 4; ++m) {
                const int R = u.pm * 256 + ai * 128 + wr * 64 + m * 16 + fr;
                float* hrow = R < NREAL ? Hreal + (size_t)R * 1024 : Hmeta + (size_t)(R - NREAL) * 1024;
                float ss = 0.f;
#pragma unroll
                for (int bj = 0; bj < 2; ++bj)
#pragma unroll
                    for (int n = 0; n < 2; ++n) {
                        const int c = u.pn * 256 + bj * 128 + wc * 32 + n * 16 + 4 * fq;
                        const f32x4 h = *(const f32x4*)(hrow + c) + acc[ai][bj][m][n];
                        *(f32x4*)(hrow + c) = h;
                        ss += (h[0] * h[0] + h[1] * h[1]) + (h[2] * h[2] + h[3] * h[3]);
                        u32x2 w; w.x = pk2(h[0], h[1]); w.y = pk2(h[2], h[3]);
                        *(u32x2*)(HB + (size_t)R * 1024 + c) = w;
                    }
                ss += __shfl_xor(ss, 16); ss += __shfl_xor(ss, 32);
                if (fq == 0) rowss_out[((size_t)u.pn * TPR + R) * 4 + wc] = ss;
            }
    }
};
struct EpiUp {
    static constexpr bool PERM = false, AFTER_DRAIN = false;
    const float* rowss; bf16* ACT;
    __device__ __forceinline__ void operator()(const f32x4 (&acc)[2][2][4][2], const pg8::Unit& u, int wr, int wc, int fr, int fq) const {
#pragma unroll
        for (int ai = 0; ai < 2; ++ai)
#pragma unroll
            for (int m = 0; m < 4; ++m) {
                const int R = u.pm * 256 + ai * 128 + wr * 64 + m * 16 + fr;
                const float rs = row_rstd(rowss, R);
#pragma unroll
                for (int bj = 0; bj < 2; ++bj)
#pragma unroll
                    for (int n = 0; n < 2; ++n) {
                        const int c = u.pn * 256 + bj * 128 + wc * 32 + n * 16 + 4 * fq;
                        f32x4 v = acc[ai][bj][m][n] * rs;
#pragma unroll
                        for (int j = 0; j < 4; ++j) { const float r = fmaxf(v[j], 0.f); v[j] = r * r; }
                        u32x2 w; w.x = pk2(v[0], v[1]); w.y = pk2(v[2], v[3]);
                        *(u32x2*)(ACT + (size_t)R * FF + c) = w;
                    }
            }
    }
};

struct Args { const float* in[23]; float* out; unsigned char* ws; };

__device__ __forceinline__ void p0_item(const float* W, int ldw, int K, const float* scale, bf16* WT, int permrows, LAS float* scr, int item, int nblk, int lane) {
    const int kb = item / nblk, nb = item % nblk, k0 = 64 * kb, n0 = 32 * nb;
    const int dn = n0 + (lane & 31); int sc = dn;
    if (dn < permrows) { const int j = dn & 63; sc = (dn & ~63) + ((j & 1) ? 32 + (j >> 1) : (j >> 1)); }
#pragma unroll 8
    for (int i = 0; i < 32; ++i) { const int kk = 2 * i + (lane >> 5); float w = W[(size_t)(k0 + kk) * ldw + sc]; if (scale) w *= scale[k0 + kk]; scr[kk * 33 + (lane & 31)] = w; }
    LDS_FENCE();
    const int c = lane & 7;
#pragma unroll
    for (int j = 0; j < 4; ++j) { const int n = (lane >> 3) + 8 * j; const LAS float* s = scr + (8 * c) * 33 + n;
        u32x4 o; o.x = pk2(s[0 * 33], s[1 * 33]); o.y = pk2(s[2 * 33], s[3 * 33]); o.z = pk2(s[4 * 33], s[5 * 33]); o.w = pk2(s[6 * 33], s[7 * 33]);
        *(u32x4*)(WT + (size_t)(n0 + n) * K + k0 + 8 * c) = o; }
    LDS_FENCE();
}

__device__ __forceinline__ void p0_prologue(const Args& a, LAS unsigned char* lds) {
    const int tid = threadIdx.x, lane = tid & 63, wave = __builtin_amdgcn_readfirstlane(tid >> 6);
    const int gw = blockIdx.x * 8 + wave, NGW = gridDim.x * 8;
    const int gt = blockIdx.x * 512 + tid, NGT = gridDim.x * 512;
    unsigned char* ws = a.ws;
    LAS float* scr = (LAS float*)(lds + wave * 16384);
    constexpr int I_IN = 16 * 152, I_GLU = 8 * 16, I_BR = 8 * 32, I_OUT = 16 * 32, I_UP = 16 * 128, I_DN = 64 * 32, I_L = I_IN + I_GLU + 3 * I_BR + I_OUT + I_UP + I_DN;
    for (int it = gw; it < 2 * I_L; it += NGW) {
        const int layer = it / I_L; int r = it % I_L;
        unsigned char* wl = ws + WS_W + (size_t)layer * LW_BYTES;
        if (r < I_IN) { p0_item(a.in[3] + (size_t)layer * DM * DIN, DIN, DM, a.in[2] + layer * DM, (bf16*)(wl + OW_IN), 640, scr, r, 152, lane); continue; } r -= I_IN;
        if (r < I_GLU) { p0_item(a.in[13] + (size_t)layer * 512 * 512, 512, 512, nullptr, (bf16*)(wl + OW_GLU), 0, scr, r, 16, lane); continue; } r -= I_GLU;
        if (r < 3 * I_BR) { const int c = r / I_BR; p0_item(a.in[17] + ((size_t)layer * 3 + c) * 512 * 1024, 1024, 512, nullptr, (bf16*)(wl + OW_BR) + (size_t)c * 1024 * 512, 0, scr, r % I_BR, 32, lane); continue; } r -= 3 * I_BR;
        if (r < I_OUT) { p0_item(a.in[18] + (size_t)layer * DM * DM, DM, DM, nullptr, (bf16*)(wl + OW_OUT), 0, scr, r, 32, lane); continue; } r -= I_OUT;
        if (r < I_UP) { p0_item(a.in[20] + (size_t)layer * DM * FF, FF, DM, a.in[19] + layer * DM, (bf16*)(wl + OW_UP), 0, scr, r, 128, lane); continue; } r -= I_UP;
        p0_item(a.in[21] + (size_t)layer * FF * DM, DM, FF, nullptr, (bf16*)(wl + OW_DN), 0, scr, r, 32, lane);
    }
    for (int i = gt; i < 2 * 512 * 512; i += NGT) {
        const int layer = i >> 18, n = (i >> 9) & 511, k = i & 511;
        float w = 0.f;
        if ((n >> 7) == (k >> 7)) w = a.in[15][(((size_t)layer * 4 + (n >> 7)) * 128 + (k & 127)) * 128 + (n & 127)];
        ((bf16*)(ws + WS_W + (size_t)layer * LW_BYTES + OW_POOL))[(size_t)n * 512 + k] = (bf16)f2bf(w);
    }
    for (int i = gt; i < LL * 32; i += NGT) {
        const int l = i >> 5, f = i & 31;
        const float invf = (float)dexp(-(double)f * (9.21034037197618273607 / 32.0));
        const float ang = (float)l * invf;
        double s, c; dsincos((double)ang, s, c);
        float* rp = (float*)(ws + WS_ROPE) + (size_t)i * 2; rp[0] = (float)c; rp[1] = (float)s;
    }
    for (int i = gt; i < 2 * 2 * 32 * 64; i += NGT) {
        const int n = i & 63, pidx = i >> 6;
        const double lr = (double)a.in[5][i], li = (double)a.in[6][i];
        const double dt = (double)(float)dexp((double)a.in[7][pidx]);
        const double mag = dexp(lr * dt); double sn, cn; dsincos(li * dt, sn, cn);
        const double are = mag * cn, aim = mag * sn, den = lr * lr + li * li, nre = are - 1.0;
        const double fre = (nre * lr + aim * li) / den, fim = (aim * lr - nre * li) / den;
        float* ab = (float*)(ws + WS_ABAR) + (size_t)i * 2; ab[0] = (float)are; ab[1] = (float)aim;
        bf16* bm = (bf16*)(ws + WS_BMAT) + (size_t)pidx * 128 * 16;
        bf16* cm = (bf16*)(ws + WS_CMAT) + (size_t)pidx * 16 * 128;
        for (int q = 0; q < 16; ++q) {
            const double br = (double)a.in[8][(size_t)i * 16 + q], bi = (double)a.in[9][(size_t)i * 16 + q];
            bm[n * 16 + q] = (bf16)f2bf((float)(fre * br - fim * bi));
            bm[(64 + n) * 16 + q] = (bf16)f2bf((float)(fre * bi + fim * br));
            cm[q * 128 + n] = (bf16)f2bf(a.in[10][((size_t)pidx * 16 + q) * 64 + n]);
            cm[q * 128 + 64 + n] = (bf16)f2bf(-a.in[11][((size_t)pidx * 16 + q) * 64 + n]);
        }
    }
    for (int R = gw; R < TPR; R += NGW) {
        const int mrow = R - NREAL;
        const float* src = R < NREAL ? a.in[0] + (size_t)R * DM : a.in[1] + (size_t)(mrow & 15) * DM;
        float* dst = R < NREAL ? a.out + (size_t)R * DM : (float*)(ws + WS_HM) + (size_t)mrow * DM;
        bf16* hb = (bf16*)(ws + WS_HB) + (size_t)R * DM;
        const bool pad = mrow >= NB * NMETA;
        float ss = 0.f;
#pragma unroll
        for (int j = 0; j < 4; ++j) {
            f32x4 v = *(const f32x4*)(src + 4 * lane + 256 * j);
            if (pad) v = (f32x4){0.f, 0.f, 0.f, 0.f};
            *(f32x4*)(dst + 4 * lane + 256 * j) = v;
            ss += (v[0] * v[0] + v[1] * v[1]) + (v[2] * v[2] + v[3] * v[3]);
            u32x2 w; w.x = pk2(v[0], v[1]); w.y = pk2(v[2], v[3]);
            *(u32x2*)(hb + 4 * lane + 256 * j) = w;
        }
#pragma unroll
        for (int o = 1; o < 64; o <<= 1) ss += __shfl_xor(ss, o);
        if (lane < 16) ((float*)(ws + WS_RS))[((size_t)(lane >> 2) * TPR + R) * 4 + (lane & 3)] = lane == 0 ? ss : 0.f;
    }
}

__device__ __forceinline__ void ssm_task(LAS unsigned char* lds, int task, int layer, const bf16* SU, float* YF,
                                         const float* abar_all, const bf16* bmat_all, const bf16* cmat_all) {
    int tid_l = threadIdx.x; asm volatile("" : "+v"(tid_l));
    const int tid = tid_l, lane = tid & 63, wave = __builtin_amdgcn_readfirstlane(tid >> 6);
    const int b = task >> 5, g = task & 31;
    __syncthreads();
    LAS float* BU = (LAS float*)(lds + wave * 12800);
    LAS unsigned short* X = (LAS unsigned short*)(lds + wave * 12800 + 8448);
    LAS float* SX = (LAS float*)(lds + 8 * 12800);
    const int blk0 = wave == 0 ? 0 : 16 * wave + 1, nblk = wave == 0 ? 17 : 16;
    bf16* yfb = (bf16*)YF + (size_t)task * LL * 16;
    const int fr = lane & 15, fq = lane >> 4;
    const bf16x8 zero8 = {0, 0, 0, 0, 0, 0, 0, 0};
    for (int dir = 0; dir < 2; ++dir) {
        const int pidx = (layer * 2 + dir) * 32 + g;
        const float are = abar_all[((size_t)pidx * 64 + lane) * 2], aim = abar_all[((size_t)pidx * 64 + lane) * 2 + 1];
        bf16x8 bfr[8], cfr[4];
        const bf16* bm = bmat_all + (size_t)pidx * 128 * 16;
#pragma unroll
        for (int nt = 0; nt < 8; ++nt) bfr[nt] = fq < 2 ? *(const bf16x8*)(bm + (nt * 16 + fr) * 16 + 8 * fq) : zero8;
        const bf16* cm = cmat_all + (size_t)pidx * 16 * 128;
#pragma unroll
        for (int ks = 0; ks < 4; ++ks) cfr[ks] = *(const bf16x8*)(cm + fr * 128 + ks * 32 + 8 * fq);
        float p16r = are, p16i = aim;
#pragma unroll
        for (int i = 0; i < 4; ++i) { const float tr = p16r * p16r - p16i * p16i, ti = 2.f * p16r * p16i; p16r = tr; p16i = ti; }
        float p256r = p16r, p256i = p16i;
#pragma unroll
        for (int i = 0; i < 4; ++i) { const float tr = p256r * p256r - p256i * p256i, ti = 2.f * p256r * p256i; p256r = tr; p256i = ti; }
        const float p272r = p256r * p16r - p256i * p16i, p272i = p256r * p16i + p256i * p16r;

        float xre = 0.f, xim = 0.f;
        for (int pass = 0; pass < 2; ++pass) {
            for (int ib = 0; ib < nblk; ++ib) {
                const int blk = dir == 0 ? blk0 + ib : blk0 + nblk - 1 - ib;
                const int Rb = blk == 0 ? NREAL + b * NMETA : b * SEQ + blk * 16 - NMETA;
                const bf16x8 ufr = fq < 2 ? *(const bf16x8*)(SU + (size_t)(Rb + fr) * 512 + g * 16 + 8 * fq) : zero8;
                f32x4 dd[8];
#pragma unroll
                for (int nt = 0; nt < 8; ++nt) { dd[nt] = (f32x4){0.f, 0.f, 0.f, 0.f}; dd[nt] = __builtin_amdgcn_mfma_f32_16x16x32_bf16(ufr, bfr[nt], dd[nt], 0, 0, 0); }
                asm volatile("s_nop 15\n\ts_nop 15" : "+v"(dd[0]), "+v"(dd[1]), "+v"(dd[2]), "+v"(dd[3]), "+v"(dd[4]), "+v"(dd[5]), "+v"(dd[6]), "+v"(dd[7]));
#pragma unroll
                for (int nt = 0; nt < 8; ++nt)
#pragma unroll
                    for (int r = 0; r < 4; ++r) BU[(4 * fq + r) * 132 + nt * 16 + fr] = dd[nt][r];
                LDS_FENCE();
                if (pass == 0) {
#pragma unroll
                    for (int i = 0; i < 16; ++i) {
                        const int tt = dir == 0 ? i : 15 - i;
                        const float bre = BU[tt * 132 + lane], bim = BU[tt * 132 + 64 + lane];
                        const float nr = are * xre - aim * xim + bre, ni = are * xim + aim * xre + bim; xre = nr; xim = ni;
                    }
                    LDS_FENCE();
                } else {
#pragma unroll
                    for (int i = 0; i < 16; ++i) {
                        const int tt = dir == 0 ? i : 15 - i;
                        const float bre = BU[tt * 132 + lane], bim = BU[tt * 132 + 64 + lane];
                        const float nr = are * xre - aim * xim + bre, ni = are * xim + aim * xre + bim; xre = nr; xim = ni;
                        X[tt * 136 + lane] = (unsigned short)f2bf(xre); X[tt * 136 + 64 + lane] = (unsigned short)f2bf(xim);
                    }
                    LDS_FENCE();
                    f32x4 y = {0.f, 0.f, 0.f, 0.f};
#pragma unroll
                    for (int ks = 0; ks < 4; ++ks) {
                        const bf16x8 afr = *(const LAS bf16x8*)(X + fr * 136 + ks * 32 + 8 * fq);
                        y = __builtin_amdgcn_mfma_f32_16x16x32_bf16(afr, cfr[ks], y, 0, 0, 0);
                    }
                    asm volatile("s_nop 15\n\ts_nop 15" : "+v"(y));
                    LDS_FENCE();
                    {
                        bf16* yd = yfb + (size_t)dir * 256 * LL * 16;
#pragma unroll
                        for (int r = 0; r < 4; ++r) yd[(size_t)(blk * 16 + 4 * fq + r) * 16 + fr] = (bf16)f2bf(y[r]);
                    }
                }
            }
            if (pass == 0) {
                SX[(wave * 64 + lane) * 2] = xre; SX[(wave * 64 + lane) * 2 + 1] = xim;
                LDS_FENCE(); __syncthreads();
                float cre = 0.f, cim = 0.f;
                if (dir == 0) {
                    for (int w = 0; w < wave; ++w) { const float pr = w == 0 ? p272r : p256r, pi = w == 0 ? p272i : p256i;
                        const float sr = SX[(w * 64 + lane) * 2], si = SX[(w * 64 + lane) * 2 + 1];
                        const float nr = pr * cre - pi * cim + sr, ni = pr * cim + pi * cre + si; cre = nr; cim = ni; }
                } else {
                    for (int w = 7; w > wave; --w) {
                        const float sr = SX[(w * 64 + lane) * 2], si = SX[(w * 64 + lane) * 2 + 1];
                        const float nr = p256r * cre - p256i * cim + sr, ni = p256r * cim + p256i * cre + si; cre = nr; cim = ni; }
                }
                xre = cre; xim = cim;
            }
        }
        LDS_FENCE(); __syncthreads();
    }
}

constexpr int ATT_KROW = 72, ATT_VROW = 40, ATT_KT = 32 * ATT_KROW * 2  , ATT_VT = 64 * ATT_VROW * 2  , ATT_MAXT = 11, ATT_VOFF = ATT_MAXT * ATT_KT;
static_assert(ATT_VOFF + ATT_MAXT * ATT_VT <= 131072, "attention LDS");
__device__ __forceinline__ void attn_task(LAS unsigned char* lds, int task, const bf16* Q, const bf16* K, const bf16* V, bf16* YA, const float* sink) {
    int tid_l = threadIdx.x; asm volatile("" : "+v"(tid_l));
    const int tid = tid_l, lane = tid & 63, wave = __builtin_amdgcn_readfirstlane(tid >> 6);
    const int qb = task % 33, bh = task / 33, h = bh & 1, b = bh >> 1;
    const int l0 = qb * 64;
    __syncthreads();
    int jlo = (l0 - 128) >> 5; if (jlo < 1) jlo = 1;
    int jhi = (l0 + 191) >> 5; if (jhi > 64) jhi = 64;
    const int ntiles = 1 + (jhi - jlo + 1);
    LAS unsigned short* Ks = (LAS unsigned short*)lds;
    LAS unsigned short* Vs = (LAS unsigned short*)(lds + ATT_VOFF);
    for (int idx = tid; idx < ntiles * 32 * 8; idx += 512) {
        const int ch = idx & 7, key = idx >> 3, slot = key >> 5, kk = key & 31;
        const int lk = (slot == 0 ? 0 : (jlo + slot - 1) * 32) + kk;
        u32x4 kv = {0u, 0u, 0u, 0u}, vv = {0u, 0u, 0u, 0u};
        if (lk < LL) { const size_t R = (size_t)tok_row(b, lk);
            kv = *(const u32x4*)(K + R * 128 + h * 64 + ch * 8); vv = *(const u32x4*)(V + R * 128 + h * 64 + ch * 8); }
        *(LAS u32x4*)(Ks + slot * (ATT_KT / 2) + kk * ATT_KROW + ch * 8) = kv;
        LAS unsigned short* vd = Vs + slot * (ATT_VT / 2) + (ch * 8) * ATT_VROW + kk;
        vd[0 * ATT_VROW] = (unsigned short)(vv.x & 0xffffu); vd[1 * ATT_VROW] = (unsigned short)(vv.x >> 16);
        vd[2 * ATT_VROW] = (unsigned short)(vv.y & 0xffffu); vd[3 * ATT_VROW] = (unsigned short)(vv.y >> 16);
        vd[4 * ATT_VROW] = (unsigned short)(vv.z & 0xffffu); vd[5 * ATT_VROW] = (unsigned short)(vv.z >> 16);
        vd[6 * ATT_VROW] = (unsigned short)(vv.w & 0xffffu); vd[7 * ATT_VROW] = (unsigned short)(vv.w >> 16);
    }
    LDS_FENCE(); __syncthreads();
    const int head = h * 4 + (wave >> 1), r32 = lane & 31, hi = lane >> 5;
    const int lq = l0 + 32 * (wave & 1) + r32;
    const bool qvalid = lq < LL;
    const size_t Rq = (size_t)tok_row(b, qvalid ? lq : LL - 1);
    bf16x8 qf[4];
#pragma unroll
    for (int ks = 0; ks < 4; ++ks) qf[ks] = *(const bf16x8*)(Q + Rq * 512 + head * 64 + ks * 16 + 8 * hi);
    float mrun = sink[head], lsum = hi == 0 ? 1.0f : 0.0f;
    f32x16 o0, o1;
#pragma unroll
    for (int i = 0; i < 16; ++i) { o0[i] = 0.f; o1[i] = 0.f; }
    for (int slot = 0; slot < ntiles; ++slot) {
        const int kbase = slot == 0 ? 0 : (jlo + slot - 1) * 32;
        const LAS unsigned short* kt = Ks + slot * (ATT_KT / 2);
        f32x16 s;
#pragma unroll
        for (int i = 0; i < 16; ++i) s[i] = 0.f;
#pragma unroll
        for (int ks = 0; ks < 4; ++ks) {
            const bf16x8 kf = *(const LAS bf16x8*)(kt + r32 * ATT_KROW + ks * 16 + 8 * hi);
            s = __builtin_amdgcn_mfma_f32_32x32x16_bf16(kf, qf[ks], s, 0, 0, 0);
        }
        asm volatile("s_nop 15\n\ts_nop 15" : "+v"(s));
        float mt = -1e30f;
#pragma unroll
        for (int i = 0; i < 16; ++i) {
            const int lk = kbase + (i & 3) + 8 * (i >> 2) + 4 * hi;
            int d = lq - lk; d = d < 0 ? -d : d;
            const bool valid = (lk < NMETA) || (d <= 128 && lk < LL);
            s[i] = valid ? s[i] : -1e30f;
            mt = fmaxf(mt, s[i]);
        }
        mt = fmaxf(mt, __shfl_xor(mt, 32));
        const float mnew = fmaxf(mrun, mt);
        const float alpha = __expf(mrun - mnew);
        mrun = mnew;
        float ps = 0.f;
#pragma unroll
        for (int i = 0; i < 16; ++i) { s[i] = __expf(s[i] - mnew); ps += s[i]; }
        lsum = lsum * alpha + ps;
#pragma unroll
        for (int i = 0; i < 16; ++i) { o0[i] *= alpha; o1[i] *= alpha; }
        const LAS unsigned short* vt = Vs + slot * (ATT_VT / 2);
#pragma unroll
        for (int s2 = 0; s2 < 2; ++s2) {
            union { bf16x8 v; unsigned u[4]; } pf;
            pf.u[0] = pk2(s[8 * s2 + 0], s[8 * s2 + 1]); pf.u[1] = pk2(s[8 * s2 + 2], s[8 * s2 + 3]);
            pf.u[2] = pk2(s[8 * s2 + 4], s[8 * s2 + 5]); pf.u[3] = pk2(s[8 * s2 + 6], s[8 * s2 + 7]);
#pragma unroll
            for (int dt = 0; dt < 2; ++dt) {
                union { bf16x8 v; u32x2 u[2]; } vf;
                const LAS unsigned short* vp = vt + (dt * 32 + r32) * ATT_VROW + 16 * s2 + 4 * hi;
                vf.u[0] = *(const LAS u32x2*)(vp); vf.u[1] = *(const LAS u32x2*)(vp + 8);
                if (dt == 0) o0 = __builtin_amdgcn_mfma_f32_32x32x16_bf16(vf.v, pf.v, o0, 0, 0, 0);
                else o1 = __builtin_amdgcn_mfma_f32_32x32x16_bf16(vf.v, pf.v, o1, 0, 0, 0);
            }
        }
    }
    asm volatile("s_nop 15\n\ts_nop 15" : "+v"(o0), "+v"(o1));
    lsum += __shfl_xor(lsum, 32);
    const float inv = 1.0f / lsum;
    if (qvalid) {
#pragma unroll
        for (int g4 = 0; g4 < 4; ++g4) {
            u32x2 w0, w1;
            w0.x = pk2(o0[4 * g4] * inv, o0[4 * g4 + 1] * inv); w0.y = pk2(o0[4 * g4 + 2] * inv, o0[4 * g4 + 3] * inv);
            w1.x = pk2(o1[4 * g4] * inv, o1[4 * g4 + 1] * inv); w1.y = pk2(o1[4 * g4 + 2] * inv, o1[4 * g4 + 3] * inv);
            *(u32x2*)(YA + Rq * 512 + head * 64 + 8 * g4 + 4 * hi) = w0;
            *(u32x2*)(YA + Rq * 512 + head * 64 + 32 + 8 * g4 + 4 * hi) = w1;
        }
    }
    __syncthreads();
}

__device__ __forceinline__ void pool_diff(const bf16* PU, bf16* PD) {
    const int gt = blockIdx.x * 512 + threadIdx.x, NGT = gridDim.x * 512;
    for (int i = gt; i < NB * LL * 64; i += NGT) {
        const int ch = i & 63, tk = i >> 6, b = tk / LL, l = tk % LL;
        const int half = 1 << (ch >> 4);
        const int lo = l - half < 0 ? 0 : l - half, hh = l + half > LL ? LL : l + half;
        float s[8];
#pragma unroll
        for (int j = 0; j < 8; ++j) s[j] = 0.f;
        for (int lp = lo; lp < hh; ++lp) {
            const u32x4 v = *(const u32x4*)(PU + (size_t)tok_row(b, lp) * 512 + ch * 8);
            s[0] += bf2f(v.x & 0xffffu); s[1] += bf2f(v.x >> 16); s[2] += bf2f(v.y & 0xffffu); s[3] += bf2f(v.y >> 16);
            s[4] += bf2f(v.z & 0xffffu); s[5] += bf2f(v.z >> 16); s[6] += bf2f(v.w & 0xffffu); s[7] += bf2f(v.w >> 16);
        }
        const float ic = 1.0f / (float)(hh - lo);
        const size_t R = (size_t)tok_row(b, l);
        const u32x4 v = *(const u32x4*)(PU + R * 512 + ch * 8);
        u32x4 o;
        o.x = pk2(s[0] * ic - bf2f(v.x & 0xffffu), s[1] * ic - bf2f(v.x >> 16)); o.y = pk2(s[2] * ic - bf2f(v.y & 0xffffu), s[3] * ic - bf2f(v.y >> 16));
        o.z = pk2(s[4] * ic - bf2f(v.z & 0xffffu), s[5] * ic - bf2f(v.z >> 16)); o.w = pk2(s[6] * ic - bf2f(v.w & 0xffffu), s[7] * ic - bf2f(v.w >> 16));
        *(u32x4*)(PD + R * 512 + ch * 8) = o;
    }
}

__device__ __forceinline__ void z_pass(const float* YF, const bf16* SU, const float* dskip, bf16* Z) {
    const int gt = blockIdx.x * 512 + threadIdx.x, NGT = gridDim.x * 512;
    for (int i = gt; i < NB * LL * 64; i += NGT) {
        const int ch = i & 63, tk = i >> 6, b = tk / LL, l = tk % LL, g = ch >> 1;
        const size_t R = (size_t)tok_row(b, l);
        const bf16* yp = (const bf16*)YF + ((size_t)(b * 32 + g) * LL + l) * 16 + (ch & 1) * 8;
        const u32x4 ya = *(const u32x4*)yp, yb = *(const u32x4*)(yp + (size_t)256 * LL * 16);
        f32x4 y0, y1;
        y0[0] = bf2f(ya.x & 0xffffu) + bf2f(yb.x & 0xffffu); y0[1] = bf2f(ya.x >> 16) + bf2f(yb.x >> 16); y0[2] = bf2f(ya.y & 0xffffu) + bf2f(yb.y & 0xffffu); y0[3] = bf2f(ya.y >> 16) + bf2f(yb.y >> 16);
        y1[0] = bf2f(ya.z & 0xffffu) + bf2f(yb.z & 0xffffu); y1[1] = bf2f(ya.z >> 16) + bf2f(yb.z >> 16); y1[2] = bf2f(ya.w & 0xffffu) + bf2f(yb.w & 0xffffu); y1[3] = bf2f(ya.w >> 16) + bf2f(yb.w >> 16);
        const f32x4 d0 = *(const f32x4*)(dskip + ch * 8), d1 = *(const f32x4*)(dskip + ch * 8 + 4);
        const u32x4 uu = *(const u32x4*)(SU + R * 512 + ch * 8);
        float t[8];
        t[0] = y0[0] + d0[0] * bf2f(uu.x & 0xffffu); t[1] = y0[1] + d0[1] * bf2f(uu.x >> 16); t[2] = y0[2] + d0[2] * bf2f(uu.y & 0xffffu); t[3] = y0[3] + d0[3] * bf2f(uu.y >> 16);
        t[4] = y1[0] + d1[0] * bf2f(uu.z & 0xffffu); t[5] = y1[1] + d1[1] * bf2f(uu.z >> 16); t[6] = y1[2] + d1[2] * bf2f(uu.w & 0xffffu); t[7] = y1[3] + d1[3] * bf2f(uu.w >> 16);
#pragma unroll
        for (int j = 0; j < 8; ++j) t[j] = 0.5f * t[j] * (1.0f + erff(t[j] * 0.70710678118654752f));
        u32x4 o; o.x = pk2(t[0], t[1]); o.y = pk2(t[2], t[3]); o.z = pk2(t[4], t[5]); o.w = pk2(t[6], t[7]);
        *(u32x4*)(Z + R * 512 + ch * 8) = o;
    }
}

#define XB_TMO      128
#define XB_XCNT(j)  (256  + 64 * (j))
#define XB_XSUB(j)  (1280 + 64 * (j))
#define XB_XGEN(j)  (2304 + 64 * (j))
#define XB_TOP      3328
#define XB_TOPGEN   3392
#define XCD_BAR_WORDS 3456
#define XB_SPIN_CAP (1u << 18)

__device__ __forceinline__ unsigned xb_ld(unsigned* p)              { return __hip_atomic_load(p, __ATOMIC_RELAXED, __HIP_MEMORY_SCOPE_AGENT); }
__device__ __forceinline__ unsigned xb_add(unsigned* p, unsigned v) { return __hip_atomic_fetch_add(p, v, __ATOMIC_RELAXED, __HIP_MEMORY_SCOPE_AGENT); }
__device__ __forceinline__ unsigned xb_xcc_id() { return (unsigned)__builtin_amdgcn_s_getreg((3 << 11) | 20) & 0xFu; }
#define XB_SPIN(cond, bar) do { unsigned _sp = 0; while (cond) { __builtin_amdgcn_s_sleep(1); \
    if ((++_sp & 255u) == 0u) { if (xb_ld(&(bar)[XB_TMO])) break; if (_sp > XB_SPIN_CAP) { atomicAdd(&(bar)[XB_TMO], 1u); break; } } } } while (0)

struct XcdBarrier {
    unsigned* bar; unsigned x;
    volatile LAS unsigned* st;
};

__device__ __forceinline__ XcdBarrier xcd_barrier_post(unsigned* bar, volatile LAS unsigned* st) {
    XcdBarrier b; b.bar = bar; b.x = xb_xcc_id(); b.st = st;
    if (threadIdx.x == 0) (void)xb_add(&bar[XB_XCNT(b.x)], 1u);
    return b;
}
__device__ __forceinline__ void xcd_barrier_complete(unsigned* bar, unsigned x, unsigned& nloc, unsigned& nx) {
    const unsigned G = gridDim.x * gridDim.y * gridDim.z;
    unsigned sum, cnt, mine, sp = 0u;
    for (;;) {
        sum = 0u; cnt = 0u; mine = 0u;
#pragma unroll
        for (unsigned j = 0; j < 16; ++j) { const unsigned c = xb_ld(&bar[XB_XCNT(j)]); sum += c; cnt += (c > 0u) ? 1u : 0u; mine = (j == x) ? c : mine; }
        if (sum == G) break;
        __builtin_amdgcn_s_sleep(1);
        if ((++sp & 255u) == 0u) { if (xb_ld(&bar[XB_TMO])) break; if (sp > XB_SPIN_CAP) { atomicAdd(&bar[XB_TMO], 1u); break; } }
    }
    nloc = mine > 0u ? mine : 1u; nx = cnt > 0u ? cnt : 1u;
}

__device__ __forceinline__ void xcd_barrier(const XcdBarrier& b) {
    asm volatile("s_waitcnt vmcnt(0)" ::: "memory");
    __syncthreads();
    if (threadIdx.x == 0) {
        unsigned* bar = b.bar;
        __builtin_amdgcn_s_waitcnt(0);
        unsigned nloc = b.st[0], nx = b.st[1];
        if (nloc == 0u) { xcd_barrier_complete(bar, b.x, nloc, nx); b.st[0] = nloc; b.st[1] = nx; }
        const unsigned old = xb_add(&bar[XB_XSUB(b.x)], 1u);
        const unsigned gen = old / nloc;
        if (old + 1u == (gen + 1u) * nloc) {
            __builtin_amdgcn_fence(__ATOMIC_RELEASE, "agent");
            asm volatile("s_waitcnt vmcnt(0)" ::: "memory");
            const unsigned og = xb_add(&bar[XB_TOP], 1u);
            const unsigned tg = og / nx;
            if (og + 1u == (tg + 1u) * nx) xb_add(&bar[XB_TOPGEN], 1u);
            else XB_SPIN(xb_ld(&bar[XB_TOPGEN]) == tg, bar);
            __builtin_amdgcn_fence(__ATOMIC_ACQUIRE, "agent");
            xb_add(&bar[XB_XGEN(b.x)], 1u);
            asm volatile("s_waitcnt vmcnt(0)" ::: "memory");
        } else {
            XB_SPIN(xb_ld(&bar[XB_XGEN(b.x)]) == gen, bar);
            __builtin_amdgcn_fence(__ATOMIC_ACQUIRE, "agent");
            asm volatile("s_waitcnt vmcnt(0)" ::: "memory");
        }
    }
    __syncthreads();
}

#ifndef MK_ALIGN
#define MK_ALIGN false
#endif
#ifndef MK_SP2
#define MK_SP2 false
#endif
#ifndef MK_SPLIT
#define MK_SPLIT 0
#endif
constexpr int NPL = 8, NPHASE = 1 + 2 * NPL + 1, PH_FINAL = NPHASE - 1;

__global__ void __launch_bounds__(512, 2) fwd_kernel(Args a, int ph_lo, int ph_hi) {
    extern __shared__ __attribute__((aligned(16))) unsigned char lds_raw[];
    LAS unsigned char* lds = (LAS unsigned char*)lds_raw;
    const int G = gridDim.x, bid = blockIdx.x;
#if MK_SPLIT
#define GRID_SYNC() do {} while (0)
    (void)lds;
#else
#define CG_SYNC() do { asm volatile("s_waitcnt vmcnt(0)" ::: "memory"); __syncthreads(); \
    if (threadIdx.x == 0) { __builtin_amdgcn_fence(__ATOMIC_RELEASE, "agent"); asm volatile("s_waitcnt vmcnt(0)" ::: "memory"); } \
    __syncthreads(); grid.sync(); \
    if (threadIdx.x == 0) { __builtin_amdgcn_fence(__ATOMIC_ACQUIRE, "agent"); asm volatile("s_waitcnt vmcnt(0)" ::: "memory"); } \
    __syncthreads(); } while (0)
    cg::grid_group grid = cg::this_grid();
    unsigned* barw = (unsigned*)(a.ws + WS_CTL);
    if (bid == 0) for (int i = threadIdx.x; i < XCD_BAR_WORDS; i += 512) __hip_atomic_store(barw + i, 0u, __ATOMIC_RELAXED, __HIP_MEMORY_SCOPE_AGENT);
    volatile LAS unsigned* xst = (volatile LAS unsigned*)(lds + 131072 + 64);
    if (threadIdx.x < 2) xst[threadIdx.x] = 0u;
    CG_SYNC();
    const XcdBarrier xbar = xcd_barrier_post(barw, xst);
#define GRID_SYNC() xcd_barrier(xbar)

#endif
#ifndef PHMASK
#define PHMASK 0xFFFFu
#endif
#define IN(k) (((PHMASK >> ((k) == 0 ? 0 : (k) == PH_FINAL ? 9 : 1 + ((k) - 1) % NPL)) & 1u) && ph_lo <= (k) && (k) < ph_hi)
#define SEAM(k) do { if (IN(k) && (k) + 1 < ph_hi) GRID_SYNC(); } while (0)
#define PHASE_BEGIN() unsigned char* ws = a.ws; asm volatile("" : "+s"(ws)); float* rowss = (float*)(ws + WS_RS); float* Hm = (float*)(ws + WS_HM); bf16* HB = (bf16*)(ws + WS_HB); unsigned char* wl = ws + WS_W + (size_t)layer * LW_BYTES; \
    const int MT = layer == MK_NLAYER - 1 ? NREAL : TPR;     \
    const float* rs_mix = rowss + (size_t)(2 * layer) * TPR * 16; float* rs_mlp = rowss + (size_t)(2 * layer + 1) * TPR * 16; float* rs_next = rowss + (size_t)(2 * layer + 2) * TPR * 16; (void)MT; (void)Hm; (void)HB; (void)wl; (void)rs_mix; (void)rs_mlp; (void)rs_next;

    if (IN(0)) { p0_prologue(a, lds); }
    SEAM(0);
#ifndef MK_NLAYER
#define MK_NLAYER 2
#endif
#ifndef MK_RSIDX
#define MK_RSIDX 4
#endif
#pragma unroll 1
    for (int layer = 0; layer < MK_NLAYER; ++layer) {
        const int p = 1 + NPL * layer;
        if (IN(p)) { PHASE_BEGIN();
            pg8::Gemm g{HB, (const bf16*)(wl + OW_IN), TPR, NPROJ, DM}; pg8::StaticOrder S; S.init(TPR, NPROJ, G, bid);
            EpiInProj E{rs_mix, (const float*)(ws + WS_ROPE), (bf16*)(ws + WS_Q), (bf16*)(ws + WS_K), (bf16*)(ws + WS_V), (bf16*)(ws + WS_SU), (bf16*)(ws + WS_PU)};
            pg8::gemm_phase<EpiInProj, pg8::StaticOrder, MK_ALIGN, MK_SP2>(lds, g, S, E);
        }
        SEAM(p);
        if (IN(p + 1)) { PHASE_BEGIN();
            for (int t = bid; t < 256; t += G)
                ssm_task(lds, t, layer, (const bf16*)(ws + WS_SU), (float*)(ws + WS_YF), (const float*)(ws + WS_ABAR), (const bf16*)(ws + WS_BMAT), (const bf16*)(ws + WS_CMAT));
            for (int t = bid; t < NB * 2 * 33; t += G)
                attn_task(lds, t, (const bf16*)(ws + WS_Q), (const bf16*)(ws + WS_K), (const bf16*)(ws + WS_V), (bf16*)(ws + WS_YA), a.in[4] + layer * 8);
            pool_diff((const bf16*)(ws + WS_PU), (bf16*)(ws + WS_PD));
        }
        SEAM(p + 1);
        if (IN(p + 2)) { PHASE_BEGIN();
            z_pass((const float*)(ws + WS_YF), (const bf16*)(ws + WS_SU), a.in[12] + layer * 512, (bf16*)(ws + WS_Z));
        }
        SEAM(p + 2);
        if (IN(p + 3)) { PHASE_BEGIN();
            { pg8::Gemm g{(const bf16*)(ws + WS_Z), (const bf16*)(wl + OW_GLU), MT, 512, 512}; pg8::StaticOrder S; S.init(MT, 512, G, bid);
              EpiGlu E{(const bf16*)(ws + WS_Z), a.in[14] + layer * 512, (bf16*)(ws + WS_YS)};
              pg8::gemm_phase<EpiGlu, pg8::StaticOrder, MK_ALIGN, MK_SP2>(lds, g, S, E); }
            { pg8::Gemm g{(const bf16*)(ws + WS_PD), (const bf16*)(wl + OW_POOL), MT, 512, 512}; pg8::StaticOrder S; S.init(MT, 512, G, bid);
              EpiScale E{(bf16*)(ws + WS_YP), 512, a.in[16] + layer * 512};
              pg8::gemm_phase<EpiScale, pg8::StaticOrder, MK_ALIGN, MK_SP2>(lds, g, S, E); }
        }
        SEAM(p + 3);
        if (IN(p + 4)) { PHASE_BEGIN();
#pragma unroll 1
            for (int c = 0; c < 3; ++c) {
                const bf16* Yc = (const bf16*)(ws + (c == 0 ? WS_YA : c == 1 ? WS_YS : WS_YP));
                { pg8::Gemm g{Yc, (const bf16*)(wl + OW_BR) + (size_t)c * 1024 * 512, MT, 1024, 512}; pg8::StaticOrder S; S.init(MT, 1024, G, bid);
                  EpiScale E{(bf16*)(ws + WS_BR), 1024, nullptr};
                  pg8::gemm_phase<EpiScale, pg8::StaticOrder, MK_ALIGN, MK_SP2>(lds, g, S, E); }
                pg8::Gemm g{HB, (const bf16*)(wl + OW_IN) + (size_t)(NPROJ + c * 1024) * DM, MT, 1024, DM}; pg8::StaticOrder S; S.init(MT, 1024, G, bid);
                if (c == 0) { EpiGate<true> E{rs_mix, (const bf16*)(ws + WS_BR), (bf16*)(ws + WS_MG)}; pg8::gemm_phase<EpiGate<true>, pg8::StaticOrder, MK_ALIGN, MK_SP2>(lds, g, S, E); }
                else { EpiGate<false> E{rs_mix, (const bf16*)(ws + WS_BR), (bf16*)(ws + WS_MG)}; pg8::gemm_phase<EpiGate<false>, pg8::StaticOrder, MK_ALIGN, MK_SP2>(lds, g, S, E); }
            }
        }
        SEAM(p + 4);
        if (IN(p + 5)) { PHASE_BEGIN();
            pg8::Gemm g{(const bf16*)(ws + WS_MG), (const bf16*)(wl + OW_OUT), MT, DM, DM}; pg8::StaticOrder S; S.init(MT, DM, G, bid);
            EpiRes E{a.out, Hm, HB, rs_mlp};
            pg8::gemm_phase<EpiRes, pg8::StaticOrder, MK_ALIGN, MK_SP2>(lds, g, S, E);
        }
        SEAM(p + 5);
        if (IN(p + 6)) { PHASE_BEGIN();
            pg8::Gemm g{HB, (const bf16*)(wl + OW_UP), MT, FF, DM}; pg8::StaticOrder S; S.init(MT, FF, G, bid);
            EpiUp E{rs_mlp, (bf16*)(ws + WS_ACT)};
            pg8::gemm_phase<EpiUp, pg8::StaticOrder, MK_ALIGN, MK_SP2>(lds, g, S, E);
        }
        SEAM(p + 6);
        if (IN(p + 7)) { PHASE_BEGIN();
            pg8::Gemm g{(const bf16*)(ws + WS_ACT), (const bf16*)(wl + OW_DN), MT, DM, FF}; pg8::StaticOrder S; S.init(MT, DM, G, bid);
            EpiRes E{a.out, Hm, HB, rs_next};
            pg8::gemm_phase<EpiRes, pg8::StaticOrder, MK_ALIGN, MK_SP2>(lds, g, S, E);
        }
        SEAM(p + 7);
    }
#ifdef MK_DUMP_OFF
    if (IN(PH_FINAL)) {
        const bf16* src = (const bf16*)(a.ws + (MK_DUMP_OFF)); const bf16* src2 = (const bf16*)(a.ws + (MK_DUMP_OFF2));
        for (int i = bid * 512 + threadIdx.x; i < NREAL * 1024; i += G * 512) { const int R = MK_DUMP_ROW(i >> 10), c = i & 1023; a.out[i] = c < 512 ? bf2f(src[(size_t)R * (MK_DUMP_LD) + (c % (MK_DUMP_LD))]) : bf2f(src2[(size_t)R * (MK_DUMP_LD2) + (c % (MK_DUMP_LD2))]); }
    }
#else
    if (IN(PH_FINAL)) {
        const float* rs = (const float*)(a.ws + WS_RS) + (size_t)MK_RSIDX * TPR * 16; const float* gain = a.in[22];
        for (int i = bid * 512 + threadIdx.x; i < NREAL * 256; i += G * 512) {
            const int R = i >> 8, c4 = (i & 255) * 4;
            const float r = row_rstd(rs, R);
            f32x4 v = *(const f32x4*)(a.out + (size_t)R * DM + c4); const f32x4 gn = *(const f32x4*)(gain + c4);
            v = v * r * gn;
            *(f32x4*)(a.out + (size_t)R * DM + c4) = v;
        }
    }
#endif
#undef IN
#undef SEAM
}

extern "C" void kernel_launch(void* const* d_in, const int* in_sizes, int n_in, void* d_out, int out_size, void* d_ws, size_t ws_size, hipStream_t stream) {
    static int grid = 0;
    if (grid == 0) {
        if (n_in != 23 || out_size != NREAL * DM || ws_size < WS_END) { fprintf(stderr, "kernel_launch: unexpected shapes (n_in %d out %d ws %zu)\n", n_in, out_size, ws_size); grid = -1; return; }
        int dev = 0, cus = 0, per_cu = 0;
        hipGetDevice(&dev); hipDeviceGetAttribute(&cus, hipDeviceAttributeMultiprocessorCount, dev);
        if (hipFuncSetAttribute((const void*)fwd_kernel, hipFuncAttributeMaxDynamicSharedMemorySize, LDS_BYTES) != hipSuccess) { fprintf(stderr, "kernel_launch: hipFuncSetAttribute failed\n"); grid = -1; return; }
        if (hipOccupancyMaxActiveBlocksPerMultiprocessor(&per_cu, (const void*)fwd_kernel, 512, LDS_BYTES) != hipSuccess || per_cu < 1) { fprintf(stderr, "kernel_launch: occupancy query gave %d\n", per_cu); per_cu = 1; }
        (void)hipGetLastError();
        grid = cus * (per_cu > 1 ? 1 : per_cu);
        if (grid <= 0) grid = 256;
    }
    if (grid < 0) return;
    Args a{};
    for (int i = 0; i < 23; ++i) a.in[i] = (const float*)d_in[i];
    a.out = (float*)d_out; a.ws = (unsigned char*)d_ws;
#if MK_SPLIT
    for (int ph = 0; ph < NPHASE; ++ph) hipLaunchKernelGGL(fwd_kernel, dim3(grid), dim3(512), LDS_BYTES, stream, a, ph, ph + 1);
#else
    int lo = 0, hi = NPHASE;
    void* kargs[] = {(void*)&a, (void*)&lo, (void*)&hi};
    hipError_t e = hipLaunchCooperativeKernel((const void*)fwd_kernel, dim3(grid), dim3(512), kargs, LDS_BYTES, stream);
    if (e != hipSuccess) fprintf(stderr, "kernel_launch: cooperative launch failed: %s (grid %d)\n", hipGetErrorString(e), grid);
#endif
}
```

```cpp
#include <hip/hip_runtime.h>
#include <hip/hip_cooperative_groups.h>
#include <cstdio>
#include <cstdint>
namespace cg = cooperative_groups;
namespace pg8 {
#define PG8_LAS __attribute__((address_space(3)))
typedef unsigned short bf16_t;
typedef short bf16x8 __attribute__((ext_vector_type(8)));
typedef float f32x4 __attribute__((ext_vector_type(4)));
typedef unsigned u32x4 __attribute__((ext_vector_type(4)));
constexpr int BM = 256, BK = 64, HALF = 128, HTB = HALF * BK * 2  , STAGE_BYTES = 8 * HTB, NXCD = 8, WGM = 8;

__host__ __device__ __forceinline__ int lds_byte(int r, int c) { const int st = (r >> 4) * 2 + (c >> 5), rr = r & 15, cc = c & 31, ob = rr * 64 + cc * 2; return st * 1024 + (ob ^ (((ob >> 9) & 1) << 5)); }
__host__ __device__ __forceinline__ void stage_rc(int b, int& R, int& C) { const int st = b / 1024, sb = b % 1024, swz = sb ^ (((sb >> 9) & 1) << 5); R = (st >> 1) * 16 + swz / 64; C = (st & 1) * 32 + (swz % 64) / 2; }
__host__ __device__ __forceinline__ int perm32(int rho) { const int n = rho >> 4, i = rho & 15; return 8 * (i >> 2) + 4 * n + (i & 3); }

struct Unit { int pm, pn; };
struct Gemm { const bf16_t* A; const bf16_t* Bt; int M, N, K; };

struct StaticOrder {
    int nM, nN, nwg, G, c;
    __host__ __device__ void init(int M, int N, int G_, int c_) { nM = M / BM; nN = N / BM; nwg = nM * nN; G = G_; c = c_; }
    __host__ __device__ bool next(int i, Unit& u) const {
        const long L = (long)i * G + c; if (L >= nwg) return false;
        int wgid = (int)L; { const int q = nwg / NXCD, r = nwg % NXCD, xcd = wgid % NXCD, off = wgid / NXCD; wgid = (xcd < r ? xcd * (q + 1) : r * (q + 1) + (xcd - r) * q) + off; }
        const int nig = WGM * nN, gid = wgid / nig, fm = gid * WGM, gsz = (nM - fm) < WGM ? (nM - fm) : WGM;
        u.pm = fm + ((wgid % nig) % gsz); u.pn = (wgid % nig) / gsz; return true;
    }
    __device__ __forceinline__ void a_ready(const Unit&) const {}
    __device__ __forceinline__ void done(const Unit&) const {}
};

__device__ __forceinline__ unsigned cvt_pk_bf16(float lo, float hi) { unsigned r; asm volatile("v_cvt_pk_bf16_f32 %0, %1, %2" : "=v"(r) : "v"(lo), "v"(hi)); return r; }
template <class Epi, class Sched, bool ALIGN_EPI = false, bool SP2 = false>
__device__ __forceinline__ void gemm_phase(PG8_LAS unsigned char* lds, const Gemm g, const Sched& S, const Epi& E) {
    int tid_l = threadIdx.x; asm volatile("" : "+v"(tid_l));
    const int tid = tid_l, wid = __builtin_amdgcn_readfirstlane(tid >> 6), lane = tid & 63, wr = wid >> 2, wc = wid & 3, fr = lane & 15, fq = lane >> 4;
    const int K = g.K, nt = K / BK;
    unsigned voffA[2], voffB[2];
#pragma unroll
    for (int i = 0; i < 2; ++i) { int R, C; stage_rc(tid * 16 + i * 8192, R, C); const int Rb = Epi::PERM ? ((R & ~31) + perm32(R & 31)) : R;
        voffA[i] = (unsigned)(R * K + C) * 2u; voffB[i] = (unsigned)(Rb * K + C) * 2u; }
    const size_t kstep = (size_t)(BK * 2);
    const size_t hstep = (size_t)HALF * K * 2;
    const size_t tstep = 2 * hstep;
    const unsigned ldsw = (unsigned)wid * 1024u;
    const int aoff = lds_byte(wr * 64 + fr, fq * 8), boff = lds_byte(wc * 32 + fr, fq * 8);
#define PG8_SA(b, h) (((b) * 2 + (h)) * HTB)
#define PG8_SB(b, h) ((4 + (b) * 2 + (h)) * HTB)
#define PG8_STAGE(bufoff, gbase, voff) do { _Pragma("unroll") for (int _i = 0; _i < 2; ++_i) \
        __builtin_amdgcn_global_load_lds((const unsigned*)((const char*)(gbase) + (voff)[_i]), (PG8_LAS unsigned*)(lds + (bufoff) + ldsw + _i * 8192), 16, 0, 0); } while (0)
#define PG8_LDA(dst, b, h) do { _Pragma("unroll") for (int m = 0; m < 4; ++m) _Pragma("unroll") for (int k = 0; k < 2; ++k) dst[m][k] = *(const PG8_LAS bf16x8*)(lds + PG8_SA(b, h) + aoff + m * 2048 + k * 1024); } while (0)
#define PG8_LDB(dst, b, h) do { _Pragma("unroll") for (int n = 0; n < 2; ++n) _Pragma("unroll") for (int k = 0; k < 2; ++k) dst[n][k] = *(const PG8_LAS bf16x8*)(lds + PG8_SB(b, h) + boff + n * 2048 + k * 1024); } while (0)
#define PG8_MMA(ai, bj, At, Bt) do { __builtin_amdgcn_s_setprio(1); _Pragma("unroll") for (int m = 0; m < 4; ++m) _Pragma("unroll") for (int n = 0; n < 2; ++n) _Pragma("unroll") for (int k = 0; k < 2; ++k) \
        acc[ai][bj][m][n] = __builtin_amdgcn_mfma_f32_16x16x32_bf16(Bt[n][k], At[m][k], acc[ai][bj][m][n], 0, 0, 0); __builtin_amdgcn_s_setprio(0); } while (0)
#define PG8_WAIT_V(n) asm volatile("s_waitcnt vmcnt(" #n ")" ::: "memory")
#define PG8_WAIT_L(n) asm volatile("s_waitcnt lgkmcnt(" #n ")" ::: "memory")
#define PG8_BAR __builtin_amdgcn_s_barrier()
#define PG8_SCHED __builtin_amdgcn_sched_barrier(0)
    Unit cur, nxt; int ui = 0;
    if (!S.next(0, cur)) return;
    f32x4 acc[2][2][4][2];
#pragma unroll
    for (int a = 0; a < 2; ++a)
#pragma unroll
        for (int b = 0; b < 2; ++b)
#pragma unroll
            for (int m = 0; m < 4; ++m)
#pragma unroll
                for (int n = 0; n < 2; ++n) acc[a][b][m][n] = (f32x4){0.f, 0.f, 0.f, 0.f};
    bf16x8 At[4][2], B0[2][2], B1[2][2];
    const char* cA = (const char*)g.A + (size_t)cur.pm * tstep; const char* cB = (const char*)g.Bt + (size_t)cur.pn * tstep;
    S.a_ready(cur);
    if constexpr (SP2) {
        PG8_STAGE(PG8_SB(0, 0), cB, voffB); PG8_STAGE(PG8_SB(0, 1), cB + hstep, voffB); PG8_STAGE(PG8_SA(0, 0), cA, voffA); PG8_STAGE(PG8_SA(0, 1), cA + hstep, voffA);
        if (wr == 1) PG8_BAR;
        PG8_WAIT_V(2); PG8_BAR;
        PG8_STAGE(PG8_SB(1, 0), cB + kstep, voffB); PG8_STAGE(PG8_SA(1, 0), cA + kstep, voffA); PG8_STAGE(PG8_SB(1, 1), cB + hstep + kstep, voffB);
        PG8_WAIT_V(6); PG8_BAR;
    } else {
        PG8_STAGE(PG8_SB(0, 0), cB, voffB); PG8_STAGE(PG8_SA(0, 0), cA, voffA); PG8_STAGE(PG8_SB(0, 1), cB + hstep, voffB); PG8_STAGE(PG8_SA(0, 1), cA + hstep, voffA);
        if (wr == 1) PG8_BAR;
        PG8_WAIT_V(4); PG8_BAR;
        PG8_STAGE(PG8_SB(1, 0), cB + kstep, voffB); PG8_STAGE(PG8_SA(1, 0), cA + kstep, voffA); PG8_STAGE(PG8_SB(1, 1), cB + hstep + kstep, voffB);
        PG8_WAIT_V(6); PG8_BAR;
    }
    for (;;) {
        const bool has_next = S.next(ui + 1, nxt);
        const char* nA = has_next ? (const char*)g.A + (size_t)nxt.pm * tstep : cA; const char* nB = has_next ? (const char*)g.Bt + (size_t)nxt.pn * tstep : cB;
        for (int t = 0; t < nt; t += 2) {
            const bool last = (t == nt - 2);
            const char* a1 = cA + (size_t)(t + 1) * kstep;
            const char* a2 = last ? nA : cA + (size_t)(t + 2) * kstep; const char* b2 = last ? nB : cB + (size_t)(t + 2) * kstep;
            const char* a3 = a2 + kstep; const char* b3 = b2 + kstep;
            if (last && has_next) S.a_ready(nxt);
            if constexpr (SP2) {
            PG8_LDB(B0, 0, 0); PG8_LDB(B1, 0, 1); PG8_SCHED; PG8_LDA(At, 0, 0); PG8_STAGE(PG8_SA(1, 1), a1 + hstep, voffA);
            PG8_WAIT_V(8); PG8_WAIT_L(0); PG8_BAR; PG8_MMA(0, 0, At, B0); PG8_MMA(0, 1, At, B1); PG8_BAR; PG8_SCHED;
            PG8_LDA(At, 0, 1); PG8_STAGE(PG8_SB(0, 0), b2, voffB); PG8_STAGE(PG8_SB(0, 1), b2 + hstep, voffB); PG8_STAGE(PG8_SA(0, 0), a2, voffA);
            PG8_WAIT_V(8); PG8_WAIT_L(0); PG8_BAR; PG8_MMA(1, 0, At, B0); PG8_MMA(1, 1, At, B1); PG8_BAR; PG8_SCHED;
            PG8_LDB(B0, 1, 0); PG8_LDB(B1, 1, 1); PG8_SCHED; PG8_LDA(At, 1, 0); PG8_STAGE(PG8_SA(0, 1), a2 + hstep, voffA);
            PG8_WAIT_V(8); PG8_WAIT_L(0); PG8_BAR; PG8_MMA(0, 0, At, B0); PG8_MMA(0, 1, At, B1); PG8_BAR; PG8_SCHED;
            PG8_LDA(At, 1, 1); PG8_STAGE(PG8_SB(1, 0), b3, voffB); PG8_STAGE(PG8_SB(1, 1), b3 + hstep, voffB); PG8_STAGE(PG8_SA(1, 0), a3, voffA);
            PG8_WAIT_V(8); PG8_WAIT_L(0); PG8_BAR; PG8_MMA(1, 0, At, B0); PG8_MMA(1, 1, At, B1); PG8_BAR; PG8_SCHED;
            } else {
            PG8_LDB(B0, 0, 0); PG8_SCHED; PG8_LDA(At, 0, 0); PG8_STAGE(PG8_SA(1, 1), a1 + hstep, voffA);
            PG8_WAIT_L(8); PG8_BAR; PG8_WAIT_L(0); PG8_MMA(0, 0, At, B0); PG8_BAR; PG8_SCHED;
            PG8_LDB(B1, 0, 1); PG8_STAGE(PG8_SB(0, 0), b2, voffB);
            PG8_BAR; PG8_WAIT_L(0); PG8_MMA(0, 1, At, B1); PG8_BAR;
            PG8_LDA(At, 0, 1); PG8_STAGE(PG8_SA(0, 0), a2, voffA);
            PG8_BAR; PG8_WAIT_L(0); PG8_MMA(1, 0, At, B0); PG8_BAR; PG8_SCHED;
            PG8_STAGE(PG8_SB(0, 1), b2 + hstep, voffB);
            PG8_WAIT_V(6); PG8_BAR; PG8_MMA(1, 1, At, B1); PG8_BAR;
            PG8_LDB(B0, 1, 0); PG8_SCHED; PG8_LDA(At, 1, 0); PG8_STAGE(PG8_SA(0, 1), a2 + hstep, voffA);
            PG8_WAIT_L(8); PG8_BAR; PG8_WAIT_L(0); PG8_MMA(0, 0, At, B0); PG8_BAR; PG8_SCHED;
            PG8_LDB(B1, 1, 1); PG8_STAGE(PG8_SB(1, 0), b3, voffB);
            PG8_BAR; PG8_WAIT_L(0); PG8_MMA(0, 1, At, B1); PG8_BAR;
            PG8_LDA(At, 1, 1); PG8_STAGE(PG8_SA(1, 0), a3, voffA);
            PG8_BAR; PG8_WAIT_L(0); PG8_MMA(1, 0, At, B0); PG8_BAR; PG8_SCHED;
            PG8_STAGE(PG8_SB(1, 1), b3 + hstep, voffB);
            PG8_WAIT_V(6); PG8_BAR; PG8_MMA(1, 1, At, B1); PG8_BAR;
            }
        }
        if constexpr (ALIGN_EPI) { if (wr == 0) PG8_BAR; }
        asm volatile("s_nop 15\n\ts_nop 15" ::: "memory");
        if constexpr (!Epi::AFTER_DRAIN) { E(acc, cur, wr, wc, fr, fq); S.done(cur); }
        if (!has_next) break;
#pragma unroll
        for (int a = 0; a < 2; ++a)
#pragma unroll
            for (int b = 0; b < 2; ++b)
#pragma unroll
                for (int m = 0; m < 4; ++m)
#pragma unroll
                    for (int n = 0; n < 2; ++n) acc[a][b][m][n] = (f32x4){0.f, 0.f, 0.f, 0.f};
        cur = nxt; cA = nA; cB = nB; ++ui;
        if constexpr (ALIGN_EPI) { if (wr == 1) PG8_BAR; }
    }
    PG8_WAIT_V(0);
    if constexpr (!ALIGN_EPI) { if (wr == 0) PG8_BAR; }
    PG8_BAR;
    if constexpr (Epi::AFTER_DRAIN) { E.fused(acc, cur, wr, wc, fr, fq, lds, wid, lane); S.done(cur); }
#undef PG8_SA
#undef PG8_SB
#undef PG8_STAGE
#undef PG8_LDA
#undef PG8_LDB
#undef PG8_MMA
#undef PG8_WAIT_V
#undef PG8_WAIT_L
#undef PG8_BAR
#undef PG8_SCHED
}
}

#define LAS __attribute__((address_space(3)))
typedef unsigned short bf16;
typedef short bf16x8 __attribute__((ext_vector_type(8)));
typedef float f32x4 __attribute__((ext_vector_type(4)));
typedef float f32x16 __attribute__((ext_vector_type(16)));
typedef unsigned u32x2 __attribute__((ext_vector_type(2)));
typedef unsigned u32x4 __attribute__((ext_vector_type(4)));

constexpr int NB = 8, SEQ = 2048, NMETA = 16, LL = 2064, DM = 1024, FF = 4096, DIN = 4864, NPROJ = 1792;
constexpr int NREAL = NB * SEQ;
constexpr int TPR = NREAL + 256;
constexpr int LDS_BYTES = 147456;

constexpr size_t MiB = 1u << 20;
constexpr size_t WS_CTL = 0;
constexpr size_t WS_ROPE = 1 * MiB;
constexpr size_t WS_ABAR = 2 * MiB;
constexpr size_t WS_BMAT = 2 * MiB + 65536;
constexpr size_t WS_CMAT = WS_BMAT + 524288;
constexpr size_t WS_HM = 4 * MiB;
constexpr size_t WS_W = 5 * MiB;
constexpr size_t OW_IN = 0, OW_GLU = (size_t)DIN * DM * 2, OW_POOL = OW_GLU + 512 * 512 * 2, OW_BR = OW_POOL + 512 * 512 * 2,
                 OW_OUT = OW_BR + 3 * 1024 * 512 * 2, OW_UP = OW_OUT + 1024 * 1024 * 2, OW_DN = OW_UP + (size_t)FF * DM * 2, LW_BYTES = OW_DN + (size_t)FF * DM * 2;
constexpr size_t WS_HB = 68 * MiB;
constexpr size_t WS_X = 101 * MiB;
constexpr size_t UU = (size_t)TPR * 512 * 2;
constexpr size_t WS_YF = WS_X, WS_YP = WS_X, WS_Q = WS_X + 2 * UU, WS_K = WS_Q + UU, WS_V = WS_K + UU / 4, WS_MG = WS_X + 2 * UU,
                 WS_SU = WS_X + 4 * UU, WS_YA = WS_X + 8 * UU  , WS_PU = WS_X + 5 * UU, WS_YS = WS_PU, WS_Z = WS_X + 6 * UU, WS_PD = WS_X + 7 * UU, WS_BR = WS_Z, WS_ACT = WS_X;
constexpr size_t WS_RS = WS_X + 9 * UU;
constexpr size_t WS_END = WS_RS + (size_t)5 * TPR * 16 * 4;
static_assert(WS_W + 2 * LW_BYTES <= WS_HB && WS_HB + (size_t)TPR * 1024 * 2 <= WS_X && WS_END <= 256 * MiB, "ws map");
static_assert((size_t)256 * 2064 * 16 * 4 <= 2 * UU, "YF fits");

__device__ __forceinline__ unsigned f2bf(float f) { unsigned u = __float_as_uint(f); return (u + 0x7fffu + ((u >> 16) & 1u)) >> 16; }
__device__ __forceinline__ unsigned pk2(float lo, float hi) { return f2bf(lo) | (f2bf(hi) << 16); }
__device__ __forceinline__ float bf2f(unsigned b) { return __uint_as_float(b << 16); }
__device__ __forceinline__ int tok_row(int b, int l) { return l >= NMETA ? b * SEQ + l - NMETA : NREAL + b * NMETA + l; }
#define LDS_FENCE() asm volatile("s_waitcnt lgkmcnt(0)" ::: "memory")
#define SSM_SYNC() do { asm volatile("s_waitcnt vmcnt(0) lgkmcnt(0)" ::: "memory"); __syncthreads(); } while (0)
__device__ __forceinline__ float row_rstd(const float* rs, int R) {
    const f32x4 a = *(const f32x4*)(rs + (size_t)R * 4), b = *(const f32x4*)(rs + ((size_t)TPR + R) * 4), c = *(const f32x4*)(rs + ((size_t)2 * TPR + R) * 4), d = *(const f32x4*)(rs + ((size_t)3 * TPR + R) * 4);
    const float s = (((a[0] + a[1]) + (a[2] + a[3])) + ((b[0] + b[1]) + (b[2] + b[3]))) + (((c[0] + c[1]) + (c[2] + c[3])) + ((d[0] + d[1]) + (d[2] + d[3])));
    return rsqrtf(s * (1.0f / 1024.0f) + 1e-6f);
}

__device__ __forceinline__ void dsincos(double a, double& s, double& c) {
    const double q = rint(a * 0.63661977236758134308);
    double r = fma(-q, 1.57079632679489655800e+00, a); r = fma(-q, 6.12323399573676603587e-17, r);
    const double r2 = r * r;
    double sp = -7.6471637318198164759e-13; sp = fma(sp, r2, 1.6059043836821614599e-10); sp = fma(sp, r2, -2.5052108385441718775e-08); sp = fma(sp, r2, 2.7557319223985890653e-06);
    sp = fma(sp, r2, -1.9841269841269841270e-04); sp = fma(sp, r2, 8.3333333333333333333e-03); sp = fma(sp, r2, -1.6666666666666666667e-01); sp = fma(sp * r2, r, r);
    double cp = 4.7794773323873852974e-14; cp = fma(cp, r2, -1.1470745597729724714e-11); cp = fma(cp, r2, 2.0876756987868098979e-09); cp = fma(cp, r2, -2.7557319223985890653e-07);
    cp = fma(cp, r2, 2.4801587301587301587e-05); cp = fma(cp, r2, -1.3888888888888888889e-03); cp = fma(cp, r2, 4.1666666666666666667e-02); cp = fma(cp, r2, -0.5); cp = fma(cp, r2, 1.0);
    const int qi = ((int)q) & 3;
    s = (qi == 0) ? sp : (qi == 1) ? cp : (qi == 2) ? -sp : -cp;
    c = (qi == 0) ? cp : (qi == 1) ? -sp : (qi == 2) ? -cp : sp;
}
__device__ __forceinline__ double dexp(double x) {
    const double k = rint(x * 1.44269504088896340736);
    double r = fma(-k, 6.93147180369123816490e-01, x); r = fma(-k, 1.90821492927058770002e-10, r);
    double p = 1.0 / 6227020800.0; p = fma(p, r, 1.0 / 479001600.0); p = fma(p, r, 1.0 / 39916800.0); p = fma(p, r, 1.0 / 3628800.0); p = fma(p, r, 1.0 / 362880.0); p = fma(p, r, 1.0 / 40320.0);
    p = fma(p, r, 1.0 / 5040.0); p = fma(p, r, 1.0 / 720.0); p = fma(p, r, 1.0 / 120.0); p = fma(p, r, 1.0 / 24.0); p = fma(p, r, 1.0 / 6.0); p = fma(p, r, 0.5); p = fma(p, r, 1.0); p = fma(p, r, 1.0);
    const long long bits = ((long long)(1023 + (int)k)) << 52;
    return p * __longlong_as_double(bits);
}

struct EpiInProj {
    static constexpr bool PERM = false, AFTER_DRAIN = false;
    const float* rowss; const float* rope; bf16 *Q, *K, *V, *SU, *PU;
    __device__ __forceinline__ void operator()(const f32x4 (&acc)[2][2][4][2], const pg8::Unit& u, int wr, int wc, int fr, int fq) const {
#pragma unroll
        for (int ai = 0; ai < 2; ++ai)
#pragma unroll
            for (int m = 0; m < 4; ++m) {
                const int R = u.pm * 256 + ai * 128 + wr * 64 + m * 16 + fr;
                const float rs = row_rstd(rowss, R);
                const int l = R < NREAL ? (R & 2047) + NMETA : (R & 15);
#pragma unroll
                for (int bj = 0; bj < 2; ++bj)
#pragma unroll
                    for (int n = 0; n < 2; ++n) {
                        const int c = u.pn * 256 + bj * 128 + wc * 32 + n * 16 + 4 * fq;
                        const f32x4 v = acc[ai][bj][m][n] * rs;
                        u32x2 w;
                        if (c < 640) {
                            const int i0 = (c & 63) >> 1;
                            const f32x4 cs = *(const f32x4*)(rope + ((size_t)l * 32 + i0) * 2);
                            float o0 = v[0] * cs[0] - v[1] * cs[1], o1 = v[1] * cs[0] + v[0] * cs[1], o2 = v[2] * cs[2] - v[3] * cs[3], o3 = v[3] * cs[2] + v[2] * cs[3];
                            if (c < 512) { w.x = pk2(o0 * 0.125f, o1 * 0.125f); w.y = pk2(o2 * 0.125f, o3 * 0.125f); *(u32x2*)(Q + (size_t)R * 512 + c) = w; }
                            else { w.x = pk2(o0, o1); w.y = pk2(o2, o3); *(u32x2*)(K + (size_t)R * 128 + (c - 512)) = w; }
                        } else {
                            w.x = pk2(v[0], v[1]); w.y = pk2(v[2], v[3]);
                            if (c < 768) *(u32x2*)(V + (size_t)R * 128 + (c - 640)) = w;
                            else if (c < 1280) *(u32x2*)(SU + (size_t)R * 512 + (c - 768)) = w;
                            else *(u32x2*)(PU + (size_t)R * 512 + (c - 1280)) = w;
                        }
                    }
            }
    }
};
struct EpiGlu {
    static constexpr bool PERM = false, AFTER_DRAIN = false;
    const bf16* Z; const float* bias; bf16* YS;
    __device__ __forceinline__ void operator()(const f32x4 (&acc)[2][2][4][2], const pg8::Unit& u, int wr, int wc, int fr, int fq) const {
#pragma unroll
        for (int ai = 0; ai < 2; ++ai)
#pragma unroll
            for (int m = 0; m < 4; ++m) {
                const int R = u.pm * 256 + ai * 128 + wr * 64 + m * 16 + fr;
#pragma unroll
                for (int bj = 0; bj < 2; ++bj)
#pragma unroll
                    for (int n = 0; n < 2; ++n) {
                        const int c = u.pn * 256 + bj * 128 + wc * 32 + n * 16 + 4 * fq;
                        const f32x4 v = acc[ai][bj][m][n] + *(const f32x4*)(bias + c);
                        const u32x2 zz = *(const u32x2*)(Z + (size_t)R * 512 + c);
                        const float z0 = bf2f(zz.x & 0xffffu), z1 = bf2f(zz.x >> 16), z2 = bf2f(zz.y & 0xffffu), z3 = bf2f(zz.y >> 16);
                        u32x2 w; w.x = pk2(z0 / (1.0f + __expf(-v[0])), z1 / (1.0f + __expf(-v[1]))); w.y = pk2(z2 / (1.0f + __expf(-v[2])), z3 / (1.0f + __expf(-v[3])));
                        *(u32x2*)(YS + (size_t)R * 512 + c) = w;
                    }
            }
    }
};
struct EpiScale {
    static constexpr bool PERM = false, AFTER_DRAIN = false;
    bf16* O; int ldc; const float* scale;
    __device__ __forceinline__ void operator()(const f32x4 (&acc)[2][2][4][2], const pg8::Unit& u, int wr, int wc, int fr, int fq) const {
#pragma unroll
        for (int ai = 0; ai < 2; ++ai)
#pragma unroll
            for (int m = 0; m < 4; ++m) {
                const int R = u.pm * 256 + ai * 128 + wr * 64 + m * 16 + fr;
#pragma unroll
                for (int bj = 0; bj < 2; ++bj)
#pragma unroll
                    for (int n = 0; n < 2; ++n) {
                        const int c = u.pn * 256 + bj * 128 + wc * 32 + n * 16 + 4 * fq;
                        f32x4 v = acc[ai][bj][m][n];
                        if (scale) v = v * *(const f32x4*)(scale + c);
                        u32x2 w; w.x = pk2(v[0], v[1]); w.y = pk2(v[2], v[3]);
                        *(u32x2*)(O + (size_t)R * ldc + c) = w;
                    }
            }
    }
};
template <bool FIRST> struct EpiGate {
    static constexpr bool PERM = false, AFTER_DRAIN = false;
    const float* rowss; const bf16* BR; bf16* MG;
    __device__ __forceinline__ void operator()(const f32x4 (&acc)[2][2][4][2], const pg8::Unit& u, int wr, int wc, int fr, int fq) const {
#pragma unroll
        for (int ai = 0; ai < 2; ++ai)
#pragma unroll
            for (int m = 0; m < 4; ++m) {
                const int R = u.pm * 256 + ai * 128 + wr * 64 + m * 16 + fr;
                const float rs = row_rstd(rowss, R);
#pragma unroll
                for (int bj = 0; bj < 2; ++bj)
#pragma unroll
                    for (int n = 0; n < 2; ++n) {
                        const int c = u.pn * 256 + bj * 128 + wc * 32 + n * 16 + 4 * fq;
                        const f32x4 v = acc[ai][bj][m][n] * rs;
                        const u32x2 bb = *(const u32x2*)(BR + (size_t)R * 1024 + c);
                        float o0 = bf2f(bb.x & 0xffffu) / (1.0f + __expf(-v[0])), o1 = bf2f(bb.x >> 16) / (1.0f + __expf(-v[1]));
                        float o2 = bf2f(bb.y & 0xffffu) / (1.0f + __expf(-v[2])), o3 = bf2f(bb.y >> 16) / (1.0f + __expf(-v[3]));
                        if (!FIRST) { const u32x2 mm = *(const u32x2*)(MG + (size_t)R * 1024 + c);
                            o0 += bf2f(mm.x & 0xffffu); o1 += bf2f(mm.x >> 16); o2 += bf2f(mm.y & 0xffffu); o3 += bf2f(mm.y >> 16); }
                        u32x2 w; w.x = pk2(o0, o1); w.y = pk2(o2, o3);
                        *(u32x2*)(MG + (size_t)R * 1024 + c) = w;
                    }
            }
    }
};
struct EpiRes {
    static constexpr bool PERM = false, AFTER_DRAIN = false;
    float* Hreal; float* Hmeta; bf16* HB; float* rowss_out;
    __device__ __forceinline__ void operator()(const f32x4 (&acc)[2][2][4][2], const pg8::Unit& u, int wr, int wc, int fr, int fq) const {
#pragma unroll
        for (int ai = 0; ai < 2; ++ai)
#pragma unroll
            for (int m = 0; m < 4; ++m) {
                const int R = u.pm * 256 + ai * 128 + wr * 64 + m * 16 + fr;
                float* hrow = R < NREAL ? Hreal + (size_t)R * 1024 : Hmeta + (size_t)(R - NREAL) * 1024;
                float ss = 0.f;
#pragma unroll
                for (int bj = 0; bj < 2; ++bj)
#pragma unroll
                    for (int n = 0; n < 2; ++n) {
                        const int c = u.pn * 256 + bj * 128 + wc * 32 + n * 16 + 4 * fq;
                        const f32x4 h = *(const f32x4*)(hrow + c) + acc[ai][bj][m][n];
                        *(f32x4*)(hrow + c) = h;
                        ss += (h[0] * h[0] + h[1] * h[1]) + (h[2] * h[2] + h[3] * h[3]);
                        u32x2 w; w.x = pk2(h[0], h[1]); w.y = pk2(h[2], h[3]);
                        *(u32x2*)(HB + (size_t)R * 1024 + c) = w;
                    }
                ss += __shfl_xor(ss, 16); ss += __shfl_xor(ss, 32);
                if (fq == 0) rowss_out[((size_t)u.pn * TPR + R) * 4 + wc] = ss;
            }
    }
};
struct EpiUp {
    static constexpr bool PERM = false, AFTER_DRAIN = false;
    const float* rowss; bf16* ACT;
    __device__ __forceinline__ void operator()(const f32x4 (&acc)[2][2][4][2], const pg8::Unit& u, int wr, int wc, int fr, int fq) const {
#pragma unroll
        for (int ai = 0; ai < 2; ++ai)
#pragma unroll
            for (int m = 0; m < 4; ++m) {
                const int R = u.pm * 256 + ai * 128 + wr * 64 + m * 16 + fr;
                const float rs = row_rstd(rowss, R);
#pragma unroll
                for (int bj = 0; bj < 2; ++bj)
#pragma unroll
                    for (int n = 0; n < 2; ++n) {
                        const int c = u.pn * 256 + bj * 128 + wc * 32 + n * 16 + 4 * fq;
                        f32x4 v = acc[ai][bj][m][n] * rs;
#pragma unroll
                        for (int j = 0; j < 4; ++j) { const float r = fmaxf(v[j], 0.f); v[j] = r * r; }
                        u32x2 w; w.x = pk2(v[0], v[1]); w.y = pk2(v[2], v[3]);
                        *(u32x2*)(ACT + (size_t)R * FF + c) = w;
                    }
            }
    }
};

struct Args { const float* in[23]; float* out; unsigned char* ws; };

__device__ __forceinline__ void p0_item(const float* W, int ldw, int K, const float* scale, bf16* WT, int permrows, LAS float* scr, int item, int nblk, int lane) {
    const int kb = item / nblk, nb = item % nblk, k0 = 64 * kb, n0 = 32 * nb;
    const int dn = n0 + (lane & 31); int sc = dn;
    if (dn < permrows) { const int j = dn & 63; sc = (dn & ~63) + ((j & 1) ? 32 + (j >> 1) : (j >> 1)); }
#pragma unroll 8
    for (int i = 0; i < 32; ++i) { const int kk = 2 * i + (lane >> 5); float w = W[(size_t)(k0 + kk) * ldw + sc]; if (scale) w *= scale[k0 + kk]; scr[kk * 33 + (lane & 31)] = w; }
    LDS_FENCE();
    const int c = lane & 7;
#pragma unroll
    for (int j = 0; j < 4; ++j) { const int n = (lane >> 3) + 8 * j; const LAS float* s = scr + (8 * c) * 33 + n;
        u32x4 o; o.x = pk2(s[0 * 33], s[1 * 33]); o.y = pk2(s[2 * 33], s[3 * 33]); o.z = pk2(s[4 * 33], s[5 * 33]); o.w = pk2(s[6 * 33], s[7 * 33]);
        *(u32x4*)(WT + (size_t)(n0 + n) * K + k0 + 8 * c) = o; }
    LDS_FENCE();
}

__device__ __forceinline__ void p0_prologue(const Args& a, LAS unsigned char* lds) {
    const int tid = threadIdx.x, lane = tid & 63, wave = __builtin_amdgcn_readfirstlane(tid >> 6);
    const int gw = blockIdx.x * 8 + wave, NGW = gridDim.x * 8;
    const int gt = blockIdx.x * 512 + tid, NGT = gridDim.x * 512;
    unsigned char* ws = a.ws;
    LAS float* scr = (LAS float*)(lds + wave * 16384);
    constexpr int I_IN = 16 * 152, I_GLU = 8 * 16, I_BR = 8 * 32, I_OUT = 16 * 32, I_UP = 16 * 128, I_DN = 64 * 32, I_L = I_IN + I_GLU + 3 * I_BR + I_OUT + I_UP + I_DN;
    for (int it = gw; it < 2 * I_L; it += NGW) {
        const int layer = it / I_L; int r = it % I_L;
        unsigned char* wl = ws + WS_W + (size_t)layer * LW_BYTES;
        if (r < I_IN) { p0_item(a.in[3] + (size_t)layer * DM * DIN, DIN, DM, a.in[2] + layer * DM, (bf16*)(wl + OW_IN), 640, scr, r, 152, lane); continue; } r -= I_IN;
        if (r < I_GLU) { p0_item(a.in[13] + (size_t)layer * 512 * 512, 512, 512, nullptr, (bf16*)(wl + OW_GLU), 0, scr, r, 16, lane); continue; } r -= I_GLU;
        if (r < 3 * I_BR) { const int c = r / I_BR; p0_item(a.in[17] + ((size_t)layer * 3 + c) * 512 * 1024, 1024, 512, nullptr, (bf16*)(wl + OW_BR) + (size_t)c * 1024 * 512, 0, scr, r % I_BR, 32, lane); continue; } r -= 3 * I_BR;
        if (r < I_OUT) { p0_item(a.in[18] + (size_t)layer * DM * DM, DM, DM, nullptr, (bf16*)(wl + OW_OUT), 0, scr, r, 32, lane); continue; } r -= I_OUT;
        if (r < I_UP) { p0_item(a.in[20] + (size_t)layer * DM * FF, FF, DM, a.in[19] + layer * DM, (bf16*)(wl + OW_UP), 0, scr, r, 128, lane); continue; } r -= I_UP;
        p0_item(a.in[21] + (size_t)layer * FF * DM, DM, FF, nullptr, (bf16*)(wl + OW_DN), 0, scr, r, 32, lane);
    }
    for (int i = gt; i < 2 * 512 * 512; i += NGT) {
        const int layer = i >> 18, n = (i >> 9) & 511, k = i & 511;
        float w = 0.f;
        if ((n >> 7) == (k >> 7)) w = a.in[15][(((size_t)layer * 4 + (n >> 7)) * 128 + (k & 127)) * 128 + (n & 127)];
        ((bf16*)(ws + WS_W + (size_t)layer * LW_BYTES + OW_POOL))[(size_t)n * 512 + k] = (bf16)f2bf(w);
    }
    for (int i = gt; i < LL * 32; i += NGT) {
        const int l = i >> 5, f = i & 31;
        const float invf = (float)dexp(-(double)f * (9.21034037197618273607 / 32.0));
        const float ang = (float)l * invf;
        double s, c; dsincos((double)ang, s, c);
        float* rp = (float*)(ws + WS_ROPE) + (size_t)i * 2; rp[0] = (float)c; rp[1] = (float)s;
    }
    for (int i = gt; i < 2 * 2 * 32 * 64; i += NGT) {
        const int n = i & 63, pidx = i >> 6;
        const double lr = (double)a.in[5][i], li = (double)a.in[6][i];
        const double dt = (double)(float)dexp((double)a.in[7][pidx]);
        const double mag = dexp(lr * dt); double sn, cn; dsincos(li * dt, sn, cn);
        const double are = mag * cn, aim = mag * sn, den = lr * lr + li * li, nre = are - 1.0;
        const double fre = (nre * lr + aim * li) / den, fim = (aim * lr - nre * li) / den;
        float* ab = (float*)(ws + WS_ABAR) + (size_t)i * 2; ab[0] = (float)are; ab[1] = (float)aim;
        bf16* bm = (bf16*)(ws + WS_BMAT) + (size_t)pidx * 128 * 16;
        bf16* cm = (bf16*)(ws + WS_CMAT) + (size_t)pidx * 16 * 128;
        for (int q = 0; q < 16; ++q) {
            const double br = (double)a.in[8][(size_t)i * 16 + q], bi = (double)a.in[9][(size_t)i * 16 + q];
            bm[n * 16 + q] = (bf16)f2bf((float)(fre * br - fim * bi));
            bm[(64 + n) * 16 + q] = (bf16)f2bf((float)(fre * bi + fim * br));
            cm[q * 128 + n] = (bf16)f2bf(a.in[10][((size_t)pidx * 16 + q) * 64 + n]);
            cm[q * 128 + 64 + n] = (bf16)f2bf(-a.in[11][((size_t)pidx * 16 + q) * 64 + n]);
        }
    }
    for (int R = gw; R < TPR; R += NGW) {
        const int mrow = R - NREAL;
        const float* src = R < NREAL ? a.in[0] + (size_t)R * DM : a.in[1] + (size_t)(mrow & 15) * DM;
        float* dst = R < NREAL ? a.out + (size_t)R * DM : (float*)(ws + WS_HM) + (size_t)mrow * DM;
        bf16* hb = (bf16*)(ws + WS_HB) + (size_t)R * DM;
        const bool pad = mrow >= NB * NMETA;
        float ss = 0.f;
#pragma unroll
        for (int j = 0; j < 4; ++j) {
            f32x4 v = *(const f32x4*)(src + 4 * lane + 256 * j);
            if (pad) v = (f32x4){0.f, 0.f, 0.f, 0.f};
            *(f32x4*)(dst + 4 * lane + 256 * j) = v;
            ss += (v[0] * v[0] + v[1] * v[1]) + (v[2] * v[2] + v[3] * v[3]);
            u32x2 w; w.x = pk2(v[0], v[1]); w.y = pk2(v[2], v[3]);
            *(u32x2*)(hb + 4 * lane + 256 * j) = w;
        }
#pragma unroll
        for (int o = 1; o < 64; o <<= 1) ss += __shfl_xor(ss, o);
        if (lane < 16) ((float*)(ws + WS_RS))[((size_t)(lane >> 2) * TPR + R) * 4 + (lane & 3)] = lane == 0 ? ss : 0.f;
    }
}

__device__ __forceinline__ void ssm_task(LAS unsigned char* lds, int task, int layer, const bf16* SU, float* YF,
                                         const float* abar_all, const bf16* bmat_all, const bf16* cmat_all) {
    int tid_l = threadIdx.x; asm volatile("" : "+v"(tid_l));
    const int tid = tid_l, lane = tid & 63, wave = __builtin_amdgcn_readfirstlane(tid >> 6);
    const int b = task >> 5, g = task & 31;
    __syncthreads();
    LAS float* BU = (LAS float*)(lds + wave * 12800);
    LAS unsigned short* X = (LAS unsigned short*)(lds + wave * 12800 + 8448);
    LAS float* SX = (LAS float*)(lds + 8 * 12800);
    const int blk0 = wave == 0 ? 0 : 16 * wave + 1, nblk = wave == 0 ? 17 : 16;
    bf16* yfb = (bf16*)YF + (size_t)task * LL * 16;
    const int fr = lane & 15, fq = lane >> 4;
    const bf16x8 zero8 = {0, 0, 0, 0, 0, 0, 0, 0};
    for (int dir = 0; dir < 2; ++dir) {
        const int pidx = (layer * 2 + dir) * 32 + g;
        const float are = abar_all[((size_t)pidx * 64 + lane) * 2], aim = abar_all[((size_t)pidx * 64 + lane) * 2 + 1];
        bf16x8 bfr[8], cfr[4];
        const bf16* bm = bmat_all + (size_t)pidx * 128 * 16;
#pragma unroll
        for (int nt = 0; nt < 8; ++nt) bfr[nt] = fq < 2 ? *(const bf16x8*)(bm + (nt * 16 + fr) * 16 + 8 * fq) : zero8;
        const bf16* cm = cmat_all + (size_t)pidx * 16 * 128;
#pragma unroll
        for (int ks = 0; ks < 4; ++ks) cfr[ks] = *(const bf16x8*)(cm + fr * 128 + ks * 32 + 8 * fq);
        float p16r = are, p16i = aim;
#pragma unroll
        for (int i = 0; i < 4; ++i) { const float tr = p16r * p16r - p16i * p16i, ti = 2.f * p16r * p16i; p16r = tr; p16i = ti; }
        float p256r = p16r, p256i = p16i;
#pragma unroll
        for (int i = 0; i < 4; ++i) { const float tr = p256r * p256r - p256i * p256i, ti = 2.f * p256r * p256i; p256r = tr; p256i = ti; }
        const float p272r = p256r * p16r - p256i * p16i, p272i = p256r * p16i + p256i * p16r;

        float xre = 0.f, xim = 0.f;
        for (int pass = 0; pass < 2; ++pass) {
            bf16x8 unext;
            { const int blkf = dir == 0 ? blk0 : blk0 + nblk - 1; const int Rf = blkf == 0 ? NREAL + b * NMETA : b * SEQ + blkf * 16 - NMETA;
              unext = fq < 2 ? *(const bf16x8*)(SU + (size_t)(Rf + fr) * 512 + g * 16 + 8 * fq) : zero8; }
            for (int ib = 0; ib < nblk; ++ib) {
                const int blk = dir == 0 ? blk0 + ib : blk0 + nblk - 1 - ib;
                const bf16x8 ufr = unext;
                if (ib + 1 < nblk) { const int blkn = dir == 0 ? blk + 1 : blk - 1; const int Rn = blkn == 0 ? NREAL + b * NMETA : b * SEQ + blkn * 16 - NMETA;
                    unext = fq < 2 ? *(const bf16x8*)(SU + (size_t)(Rn + fr) * 512 + g * 16 + 8 * fq) : zero8; }
                f32x4 dd[8];
#pragma unroll
                for (int nt = 0; nt < 8; ++nt) { dd[nt] = (f32x4){0.f, 0.f, 0.f, 0.f}; dd[nt] = __builtin_amdgcn_mfma_f32_16x16x32_bf16(ufr, bfr[nt], dd[nt], 0, 0, 0); }
                asm volatile("s_nop 15\n\ts_nop 15" : "+v"(dd[0]), "+v"(dd[1]), "+v"(dd[2]), "+v"(dd[3]), "+v"(dd[4]), "+v"(dd[5]), "+v"(dd[6]), "+v"(dd[7]));
#pragma unroll
                for (int nt = 0; nt < 8; ++nt)
#pragma unroll
                    for (int r = 0; r < 4; ++r) BU[(4 * fq + r) * 132 + nt * 16 + fr] = dd[nt][r];
                LDS_FENCE();
                float bur[16], bui[16];
#pragma unroll
                for (int i = 0; i < 16; ++i) { const int tt = dir == 0 ? i : 15 - i; bur[i] = BU[tt * 132 + lane]; bui[i] = BU[tt * 132 + 64 + lane]; }
                if (pass == 0) {
#pragma unroll
                    for (int i = 0; i < 16; ++i) {
                        const float bre = bur[i], bim = bui[i];
                        const float nr = are * xre - aim * xim + bre, ni = are * xim + aim * xre + bim; xre = nr; xim = ni;
                    }
                    LDS_FENCE();
                } else {
#pragma unroll
                    for (int i = 0; i < 16; ++i) {
                        const int tt = dir == 0 ? i : 15 - i;
                        const float bre = bur[i], bim = bui[i];
                        const float nr = are * xre - aim * xim + bre, ni = are * xim + aim * xre + bim; xre = nr; xim = ni;
                        X[tt * 136 + lane] = (unsigned short)f2bf(xre); X[tt * 136 + 64 + lane] = (unsigned short)f2bf(xim);
                    }
                    LDS_FENCE();
                    f32x4 y = {0.f, 0.f, 0.f, 0.f};
#pragma unroll
                    for (int ks = 0; ks < 4; ++ks) {
                        const bf16x8 afr = *(const LAS bf16x8*)(X + fr * 136 + ks * 32 + 8 * fq);
                        y = __builtin_amdgcn_mfma_f32_16x16x32_bf16(afr, cfr[ks], y, 0, 0, 0);
                    }
                    asm volatile("s_nop 15\n\ts_nop 15" : "+v"(y));
                    LDS_FENCE();
                    {
                        bf16* yd = yfb + (size_t)dir * 256 * LL * 16;
#pragma unroll
                        for (int r = 0; r < 4; ++r) yd[(size_t)(blk * 16 + 4 * fq + r) * 16 + fr] = (bf16)f2bf(y[r]);
                    }
                }
            }
            if (pass == 0) {
                SX[(wave * 64 + lane) * 2] = xre; SX[(wave * 64 + lane) * 2 + 1] = xim;
                LDS_FENCE(); __syncthreads();
                float cre = 0.f, cim = 0.f;
                if (dir == 0) {
                    for (int w = 0; w < wave; ++w) { const float pr = w == 0 ? p272r : p256r, pi = w == 0 ? p272i : p256i;
                        const float sr = SX[(w * 64 + lane) * 2], si = SX[(w * 64 + lane) * 2 + 1];
                        const float nr = pr * cre - pi * cim + sr, ni = pr * cim + pi * cre + si; cre = nr; cim = ni; }
                } else {
                    for (int w = 7; w > wave; --w) {
                        const float sr = SX[(w * 64 + lane) * 2], si = SX[(w * 64 + lane) * 2 + 1];
                        const float nr = p256r * cre - p256i * cim + sr, ni = p256r * cim + p256i * cre + si; cre = nr; cim = ni; }
                }
                xre = cre; xim = cim;
            }
        }
        LDS_FENCE(); __syncthreads();
    }
}

constexpr int ATT_KROW = 72, ATT_VROW = 40, ATT_KT = 32 * ATT_KROW * 2  , ATT_VT = 64 * ATT_VROW * 2  , ATT_MAXT = 11, ATT_VOFF = ATT_MAXT * ATT_KT;
static_assert(ATT_VOFF + ATT_MAXT * ATT_VT <= 131072, "attention LDS");
__device__ __forceinline__ void attn_task(LAS unsigned char* lds, int task, const bf16* Q, const bf16* K, const bf16* V, bf16* YA, const float* sink) {
    int tid_l = threadIdx.x; asm volatile("" : "+v"(tid_l));
    const int tid = tid_l, lane = tid & 63, wave = __builtin_amdgcn_readfirstlane(tid >> 6);
    const int qb = task % 33, bh = task / 33, h = bh & 1, b = bh >> 1;
    const int l0 = qb * 64;
    __syncthreads();
    int jlo = (l0 - 128) >> 5; if (jlo < 1) jlo = 1;
    int jhi = (l0 + 191) >> 5; if (jhi > 64) jhi = 64;
    const int ntiles = 1 + (jhi - jlo + 1);
    LAS unsigned short* Ks = (LAS unsigned short*)lds;
    LAS unsigned short* Vs = (LAS unsigned short*)(lds + ATT_VOFF);
    for (int idx = tid; idx < ntiles * 32 * 8; idx += 512) {
        const int ch = idx & 7, key = idx >> 3, slot = key >> 5, kk = key & 31;
        const int lk = (slot == 0 ? 0 : (jlo + slot - 1) * 32) + kk;
        u32x4 kv = {0u, 0u, 0u, 0u}, vv = {0u, 0u, 0u, 0u};
        if (lk < LL) { const size_t R = (size_t)tok_row(b, lk);
            kv = *(const u32x4*)(K + R * 128 + h * 64 + ch * 8); vv = *(const u32x4*)(V + R * 128 + h * 64 + ch * 8); }
        *(LAS u32x4*)(Ks + slot * (ATT_KT / 2) + kk * ATT_KROW + ch * 8) = kv;
        LAS unsigned short* vd = Vs + slot * (ATT_VT / 2) + (ch * 8) * ATT_VROW + kk;
        vd[0 * ATT_VROW] = (unsigned short)(vv.x & 0xffffu); vd[1 * ATT_VROW] = (unsigned short)(vv.x >> 16);
        vd[2 * ATT_VROW] = (unsigned short)(vv.y & 0xffffu); vd[3 * ATT_VROW] = (unsigned short)(vv.y >> 16);
        vd[4 * ATT_VROW] = (unsigned short)(vv.z & 0xffffu); vd[5 * ATT_VROW] = (unsigned short)(vv.z >> 16);
        vd[6 * ATT_VROW] = (unsigned short)(vv.w & 0xffffu); vd[7 * ATT_VROW] = (unsigned short)(vv.w >> 16);
    }
    LDS_FENCE(); __syncthreads();
    const int head = h * 4 + (wave >> 1), r32 = lane & 31, hi = lane >> 5;
    const int lq = l0 + 32 * (wave & 1) + r32;
    const bool qvalid = lq < LL;
    const size_t Rq = (size_t)tok_row(b, qvalid ? lq : LL - 1);
    bf16x8 qf[4];
#pragma unroll
    for (int ks = 0; ks < 4; ++ks) qf[ks] = *(const bf16x8*)(Q + Rq * 512 + head * 64 + ks * 16 + 8 * hi);
    float mrun = sink[head], lsum = hi == 0 ? 1.0f : 0.0f;
    f32x16 o0, o1;
#pragma unroll
    for (int i = 0; i < 16; ++i) { o0[i] = 0.f; o1[i] = 0.f; }
    for (int slot = 0; slot < ntiles; ++slot) {
        const int kbase = slot == 0 ? 0 : (jlo + slot - 1) * 32;
        const LAS unsigned short* kt = Ks + slot * (ATT_KT / 2);
        f32x16 s;
#pragma unroll
        for (int i = 0; i < 16; ++i) s[i] = 0.f;
#pragma unroll
        for (int ks = 0; ks < 4; ++ks) {
            const bf16x8 kf = *(const LAS bf16x8*)(kt + r32 * ATT_KROW + ks * 16 + 8 * hi);
            s = __builtin_amdgcn_mfma_f32_32x32x16_bf16(kf, qf[ks], s, 0, 0, 0);
        }
        asm volatile("s_nop 15\n\ts_nop 15" : "+v"(s));
        float mt = -1e30f;
#pragma unroll
        for (int i = 0; i < 16; ++i) {
            const int lk = kbase + (i & 3) + 8 * (i >> 2) + 4 * hi;
            int d = lq - lk; d = d < 0 ? -d : d;
            const bool valid = (lk < NMETA) || (d <= 128 && lk < LL);
            s[i] = valid ? s[i] : -1e30f;
            mt = fmaxf(mt, s[i]);
        }
        mt = fmaxf(mt, __shfl_xor(mt, 32));
        const float mnew = fmaxf(mrun, mt);
        const float alpha = __expf(mrun - mnew);
        mrun = mnew;
        float ps = 0.f;
#pragma unroll
        for (int i = 0; i < 16; ++i) { s[i] = __expf(s[i] - mnew); ps += s[i]; }
        lsum = lsum * alpha + ps;
#pragma unroll
        for (int i = 0; i < 16; ++i) { o0[i] *= alpha; o1[i] *= alpha; }
        const LAS unsigned short* vt = Vs + slot * (ATT_VT / 2);
#pragma unroll
        for (int s2 = 0; s2 < 2; ++s2) {
            union { bf16x8 v; unsigned u[4]; } pf;
            pf.u[0] = pk2(s[8 * s2 + 0], s[8 * s2 + 1]); pf.u[1] = pk2(s[8 * s2 + 2], s[8 * s2 + 3]);
            pf.u[2] = pk2(s[8 * s2 + 4], s[8 * s2 + 5]); pf.u[3] = pk2(s[8 * s2 + 6], s[8 * s2 + 7]);
#pragma unroll
            for (int dt = 0; dt < 2; ++dt) {
                union { bf16x8 v; u32x2 u[2]; } vf;
                const LAS unsigned short* vp = vt + (dt * 32 + r32) * ATT_VROW + 16 * s2 + 4 * hi;
                vf.u[0] = *(const LAS u32x2*)(vp); vf.u[1] = *(const LAS u32x2*)(vp + 8);
                if (dt == 0) o0 = __builtin_amdgcn_mfma_f32_32x32x16_bf16(vf.v, pf.v, o0, 0, 0, 0);
                else o1 = __builtin_amdgcn_mfma_f32_32x32x16_bf16(vf.v, pf.v, o1, 0, 0, 0);
            }
        }
    }
    asm volatile("s_nop 15\n\ts_nop 15" : "+v"(o0), "+v"(o1));
    lsum += __shfl_xor(lsum, 32);
    const float inv = 1.0f / lsum;
    if (qvalid) {
#pragma unroll
        for (int g4 = 0; g4 < 4; ++g4) {
            u32x2 w0, w1;
            w0.x = pk2(o0[4 * g4] * inv, o0[4 * g4 + 1] * inv); w0.y = pk2(o0[4 * g4 + 2] * inv, o0[4 * g4 + 3] * inv);
            w1.x = pk2(o1[4 * g4] * inv, o1[4 * g4 + 1] * inv); w1.y = pk2(o1[4 * g4 + 2] * inv, o1[4 * g4 + 3] * inv);
            *(u32x2*)(YA + Rq * 512 + head * 64 + 8 * g4 + 4 * hi) = w0;
            *(u32x2*)(YA + Rq * 512 + head * 64 + 32 + 8 * g4 + 4 * hi) = w1;
        }
    }
    __syncthreads();
}

__device__ __forceinline__ void pool_diff(const bf16* PU, bf16* PD) {
    const int gt = blockIdx.x * 512 + threadIdx.x, NGT = gridDim.x * 512;
    for (int i = gt; i < NB * LL * 64; i += NGT) {
        const int ch = i & 63, tk = i >> 6, b = tk / LL, l = tk % LL;
        const int half = 1 << (ch >> 4);
        const int lo = l - half < 0 ? 0 : l - half, hh = l + half > LL ? LL : l + half;
        float s[8];
#pragma unroll
        for (int j = 0; j < 8; ++j) s[j] = 0.f;
        for (int lp = lo; lp < hh; ++lp) {
            const u32x4 v = *(const u32x4*)(PU + (size_t)tok_row(b, lp) * 512 + ch * 8);
            s[0] += bf2f(v.x & 0xffffu); s[1] += bf2f(v.x >> 16); s[2] += bf2f(v.y & 0xffffu); s[3] += bf2f(v.y >> 16);
            s[4] += bf2f(v.z & 0xffffu); s[5] += bf2f(v.z >> 16); s[6] += bf2f(v.w & 0xffffu); s[7] += bf2f(v.w >> 16);
        }
        const float ic = 1.0f / (float)(hh - lo);
        const size_t R = (size_t)tok_row(b, l);
        const u32x4 v = *(const u32x4*)(PU + R * 512 + ch * 8);
        u32x4 o;
        o.x = pk2(s[0] * ic - bf2f(v.x & 0xffffu), s[1] * ic - bf2f(v.x >> 16)); o.y = pk2(s[2] * ic - bf2f(v.y & 0xffffu), s[3] * ic - bf2f(v.y >> 16));
        o.z = pk2(s[4] * ic - bf2f(v.z & 0xffffu), s[5] * ic - bf2f(v.z >> 16)); o.w = pk2(s[6] * ic - bf2f(v.w & 0xffffu), s[7] * ic - bf2f(v.w >> 16));
        *(u32x4*)(PD + R * 512 + ch * 8) = o;
    }
}

__device__ __forceinline__ void z_pass(const float* YF, const bf16* SU, const float* dskip, bf16* Z) {
    const int gt = blockIdx.x * 512 + threadIdx.x, NGT = gridDim.x * 512;
    for (int i = gt; i < NB * LL * 64; i += NGT) {
        const int ch = i & 63, tk = i >> 6, b = tk / LL, l = tk % LL, g = ch >> 1;
        const size_t R = (size_t)tok_row(b, l);
        const bf16* yp = (const bf16*)YF + ((size_t)(b * 32 + g) * LL + l) * 16 + (ch & 1) * 8;
        const u32x4 ya = *(const u32x4*)yp, yb = *(const u32x4*)(yp + (size_t)256 * LL * 16);
        f32x4 y0, y1;
        y0[0] = bf2f(ya.x & 0xffffu) + bf2f(yb.x & 0xffffu); y0[1] = bf2f(ya.x >> 16) + bf2f(yb.x >> 16); y0[2] = bf2f(ya.y & 0xffffu) + bf2f(yb.y & 0xffffu); y0[3] = bf2f(ya.y >> 16) + bf2f(yb.y >> 16);
        y1[0] = bf2f(ya.z & 0xffffu) + bf2f(yb.z & 0xffffu); y1[1] = bf2f(ya.z >> 16) + bf2f(yb.z >> 16); y1[2] = bf2f(ya.w & 0xffffu) + bf2f(yb.w & 0xffffu); y1[3] = bf2f(ya.w >> 16) + bf2f(yb.w >> 16);
        const f32x4 d0 = *(const f32x4*)(dskip + ch * 8), d1 = *(const f32x4*)(dskip + ch * 8 + 4);
        const u32x4 uu = *(const u32x4*)(SU + R * 512 + ch * 8);
        float t[8];
        t[0] = y0[0] + d0[0] * bf2f(uu.x & 0xffffu); t[1] = y0[1] + d0[1] * bf2f(uu.x >> 16); t[2] = y0[2] + d0[2] * bf2f(uu.y & 0xffffu); t[3] = y0[3] + d0[3] * bf2f(uu.y >> 16);
        t[4] = y1[0] + d1[0] * bf2f(uu.z & 0xffffu); t[5] = y1[1] + d1[1] * bf2f(uu.z >> 16); t[6] = y1[2] + d1[2] * bf2f(uu.w & 0xffffu); t[7] = y1[3] + d1[3] * bf2f(uu.w >> 16);
#pragma unroll
        for (int j = 0; j < 8; ++j) t[j] = 0.5f * t[j] * (1.0f + erff(t[j] * 0.70710678118654752f));
        u32x4 o; o.x = pk2(t[0], t[1]); o.y = pk2(t[2], t[3]); o.z = pk2(t[4], t[5]); o.w = pk2(t[6], t[7]);
        *(u32x4*)(Z + R * 512 + ch * 8) = o;
    }
}

#define XB_TMO      128
#define XB_XCNT(j)  (256  + 64 * (j))
#define XB_XSUB(j)  (1280 + 64 * (j))
#define XB_XGEN(j)  (2304 + 64 * (j))
#define XB_TOP      3328
#define XB_TOPGEN   3392
#define XCD_BAR_WORDS 3456
#define XB_SPIN_CAP (1u << 18)

__device__ __forceinline__ unsigned xb_ld(unsigned* p)              { return __hip_atomic_load(p, __ATOMIC_RELAXED, __HIP_MEMORY_SCOPE_AGENT); }
__device__ __forceinline__ unsigned xb_add(unsigned* p, unsigned v) { return __hip_atomic_fetch_add(p, v, __ATOMIC_RELAXED, __HIP_MEMORY_SCOPE_AGENT); }
__device__ __forceinline__ unsigned xb_xcc_id() { return (unsigned)__builtin_amdgcn_s_getreg((3 << 11) | 20) & 0xFu; }
#define XB_SPIN(cond, bar) do { unsigned _sp = 0; while (cond) { __builtin_amdgcn_s_sleep(1); \
    if ((++_sp & 255u) == 0u) { if (xb_ld(&(bar)[XB_TMO])) break; if (_sp > XB_SPIN_CAP) { atomicAdd(&(bar)[XB_TMO], 1u); break; } } } } while (0)

struct XcdBarrier {
    unsigned* bar; unsigned x;
    volatile LAS unsigned* st;
};

__device__ __forceinline__ XcdBarrier xcd_barrier_post(unsigned* bar, volatile LAS unsigned* st) {
    XcdBarrier b; b.bar = bar; b.x = xb_xcc_id(); b.st = st;
    if (threadIdx.x == 0) (void)xb_add(&bar[XB_XCNT(b.x)], 1u);
    return b;
}
__device__ __forceinline__ void xcd_barrier_complete(unsigned* bar, unsigned x, unsigned& nloc, unsigned& nx) {
    const unsigned G = gridDim.x * gridDim.y * gridDim.z;
    unsigned sum, cnt, mine, sp = 0u;
    for (;;) {
        sum = 0u; cnt = 0u; mine = 0u;
#pragma unroll
        for (unsigned j = 0; j < 16; ++j) { const unsigned c = xb_ld(&bar[XB_XCNT(j)]); sum += c; cnt += (c > 0u) ? 1u : 0u; mine = (j == x) ? c : mine; }
        if (sum == G) break;
        __builtin_amdgcn_s_sleep(1);
        if ((++sp & 255u) == 0u) { if (xb_ld(&bar[XB_TMO])) break; if (sp > XB_SPIN_CAP) { atomicAdd(&bar[XB_TMO], 1u); break; } }
    }
    nloc = mine > 0u ? mine : 1u; nx = cnt > 0u ? cnt : 1u;
}

__device__ __forceinline__ void xcd_barrier(const XcdBarrier& b) {
    asm volatile("s_waitcnt vmcnt(0)" ::: "memory");
    __syncthreads();
    if (threadIdx.x == 0) {
        unsigned* bar = b.bar;
        __builtin_amdgcn_s_waitcnt(0);
        unsigned nloc = b.st[0], nx = b.st[1];
        if (nloc == 0u) { xcd_barrier_complete(bar, b.x, nloc, nx); b.st[0] = nloc; b.st[1] = nx; }
        const unsigned old = xb_add(&bar[XB_XSUB(b.x)], 1u);
        const unsigned gen = old / nloc;
        if (old + 1u == (gen + 1u) * nloc) {
            __builtin_amdgcn_fence(__ATOMIC_RELEASE, "agent");
            asm volatile("s_waitcnt vmcnt(0)" ::: "memory");
            const unsigned og = xb_add(&bar[XB_TOP], 1u);
            const unsigned tg = og / nx;
            if (og + 1u == (tg + 1u) * nx) xb_add(&bar[XB_TOPGEN], 1u);
            else XB_SPIN(xb_ld(&bar[XB_TOPGEN]) == tg, bar);
            __builtin_amdgcn_fence(__ATOMIC_ACQUIRE, "agent");
            xb_add(&bar[XB_XGEN(b.x)], 1u);
            asm volatile("s_waitcnt vmcnt(0)" ::: "memory");
        } else {
            XB_SPIN(xb_ld(&bar[XB_XGEN(b.x)]) == gen, bar);
            __builtin_amdgcn_fence(__ATOMIC_ACQUIRE, "agent");
            asm volatile("s_waitcnt vmcnt(0)" ::: "memory");
        }
    }
    __syncthreads();
}

#ifndef MK_ALIGN
#define MK_ALIGN true
#endif
#ifndef MK_SP2
#define MK_SP2 true
#endif
#ifndef MK_SPLIT
#define MK_SPLIT 0
#endif
constexpr int NPL = 8, NPHASE = 1 + 2 * NPL + 1, PH_FINAL = NPHASE - 1;

__global__ void __launch_bounds__(512, 2) fwd_kernel(Args a, int ph_lo, int ph_hi) {
    extern __shared__ __attribute__((aligned(16))) unsigned char lds_raw[];
    LAS unsigned char* lds = (LAS unsigned char*)lds_raw;
    const int G = gridDim.x, bid = blockIdx.x;
#if MK_SPLIT
#define GRID_SYNC() do {} while (0)
    (void)lds;
#else
#define CG_SYNC() do { asm volatile("s_waitcnt vmcnt(0)" ::: "memory"); __syncthreads(); \
    if (threadIdx.x == 0) { __builtin_amdgcn_fence(__ATOMIC_RELEASE, "agent"); asm volatile("s_waitcnt vmcnt(0)" ::: "memory"); } \
    __syncthreads(); grid.sync(); \
    if (threadIdx.x == 0) { __builtin_amdgcn_fence(__ATOMIC_ACQUIRE, "agent"); asm volatile("s_waitcnt vmcnt(0)" ::: "memory"); } \
    __syncthreads(); } while (0)
    cg::grid_group grid = cg::this_grid();
    unsigned* barw = (unsigned*)(a.ws + WS_CTL);
    if (bid == 0) for (int i = threadIdx.x; i < XCD_BAR_WORDS; i += 512) __hip_atomic_store(barw + i, 0u, __ATOMIC_RELAXED, __HIP_MEMORY_SCOPE_AGENT);
    volatile LAS unsigned* xst = (volatile LAS unsigned*)(lds + 131072 + 64);
    if (threadIdx.x < 2) xst[threadIdx.x] = 0u;
    CG_SYNC();
    const XcdBarrier xbar = xcd_barrier_post(barw, xst);
#define GRID_SYNC() xcd_barrier(xbar)

#endif
#ifndef PHMASK
#define PHMASK 0xFFFFu
#endif
#define IN(k) (((PHMASK >> ((k) == 0 ? 0 : (k) == PH_FINAL ? 9 : 1 + ((k) - 1) % NPL)) & 1u) && ph_lo <= (k) && (k) < ph_hi)
#define SEAM(k) do { if (IN(k) && (k) + 1 < ph_hi) GRID_SYNC(); } while (0)
#define PHASE_BEGIN() unsigned char* ws = a.ws; asm volatile("" : "+s"(ws)); float* rowss = (float*)(ws + WS_RS); float* Hm = (float*)(ws + WS_HM); bf16* HB = (bf16*)(ws + WS_HB); unsigned char* wl = ws + WS_W + (size_t)layer * LW_BYTES; \
    const int MT = layer == MK_NLAYER - 1 ? NREAL : TPR;     \
    const float* rs_mix = rowss + (size_t)(2 * layer) * TPR * 16; float* rs_mlp = rowss + (size_t)(2 * layer + 1) * TPR * 16; float* rs_next = rowss + (size_t)(2 * layer + 2) * TPR * 16; (void)MT; (void)Hm; (void)HB; (void)wl; (void)rs_mix; (void)rs_mlp; (void)rs_next;

    if (IN(0)) { p0_prologue(a, lds); }
    SEAM(0);
#ifndef MK_NLAYER
#define MK_NLAYER 2
#endif
#ifndef MK_RSIDX
#define MK_RSIDX 4
#endif
#pragma unroll 1
    for (int layer = 0; layer < MK_NLAYER; ++layer) {
        const int p = 1 + NPL * layer;
        if (IN(p)) { PHASE_BEGIN();
            pg8::Gemm g{HB, (const bf16*)(wl + OW_IN), TPR, NPROJ, DM}; pg8::StaticOrder S; S.init(TPR, NPROJ, G, bid);
            EpiInProj E{rs_mix, (const float*)(ws + WS_ROPE), (bf16*)(ws + WS_Q), (bf16*)(ws + WS_K), (bf16*)(ws + WS_V), (bf16*)(ws + WS_SU), (bf16*)(ws + WS_PU)};
            pg8::gemm_phase<EpiInProj, pg8::StaticOrder, MK_ALIGN, MK_SP2>(lds, g, S, E);
        }
        SEAM(p);
        if (IN(p + 1)) { PHASE_BEGIN();
            for (int t = bid; t < 256; t += G)
                ssm_task(lds, t, layer, (const bf16*)(ws + WS_SU), (float*)(ws + WS_YF), (const float*)(ws + WS_ABAR), (const bf16*)(ws + WS_BMAT), (const bf16*)(ws + WS_CMAT));
            for (int t = bid; t < NB * 2 * 33; t += G)
                attn_task(lds, t, (const bf16*)(ws + WS_Q), (const bf16*)(ws + WS_K), (const bf16*)(ws + WS_V), (bf16*)(ws + WS_YA), a.in[4] + layer * 8);
            pool_diff((const bf16*)(ws + WS_PU), (bf16*)(ws + WS_PD));
        }
        SEAM(p + 1);
        if (IN(p + 2)) { PHASE_BEGIN();
            z_pass((const float*)(ws + WS_YF), (const bf16*)(ws + WS_SU), a.in[12] + layer * 512, (bf16*)(ws + WS_Z));
        }
        SEAM(p + 2);
        if (IN(p + 3)) { PHASE_BEGIN();
            { pg8::Gemm g{(const bf16*)(ws + WS_Z), (const bf16*)(wl + OW_GLU), MT, 512, 512}; pg8::StaticOrder S; S.init(MT, 512, G, bid);
              EpiGlu E{(const bf16*)(ws + WS_Z), a.in[14] + layer * 512, (bf16*)(ws + WS_YS)};
              pg8::gemm_phase<EpiGlu, pg8::StaticOrder, MK_ALIGN, MK_SP2>(lds, g, S, E); }
            { pg8::Gemm g{(const bf16*)(ws + WS_PD), (const bf16*)(wl + OW_POOL), MT, 512, 512}; pg8::StaticOrder S; S.init(MT, 512, G, bid);
              EpiScale E{(bf16*)(ws + WS_YP), 512, a.in[16] + layer * 512};
              pg8::gemm_phase<EpiScale, pg8::StaticOrder, MK_ALIGN, MK_SP2>(lds, g, S, E); }
        }
        SEAM(p + 3);
        if (IN(p + 4)) { PHASE_BEGIN();
#pragma unroll 1
            for (int c = 0; c < 3; ++c) {
                const bf16* Yc = (const bf16*)(ws + (c == 0 ? WS_YA : c == 1 ? WS_YS : WS_YP));
                { pg8::Gemm g{Yc, (const bf16*)(wl + OW_BR) + (size_t)c * 1024 * 512, MT, 1024, 512}; pg8::StaticOrder S; S.init(MT, 1024, G, bid);
                  EpiScale E{(bf16*)(ws + WS_BR), 1024, nullptr};
                  pg8::gemm_phase<EpiScale, pg8::StaticOrder, MK_ALIGN, MK_SP2>(lds, g, S, E); }
                pg8::Gemm g{HB, (const bf16*)(wl + OW_IN) + (size_t)(NPROJ + c * 1024) * DM, MT, 1024, DM}; pg8::StaticOrder S; S.init(MT, 1024, G, bid);
                if (c == 0) { EpiGate<true> E{rs_mix, (const bf16*)(ws + WS_BR), (bf16*)(ws + WS_MG)}; pg8::gemm_phase<EpiGate<true>, pg8::StaticOrder, MK_ALIGN, MK_SP2>(lds, g, S, E); }
                else { EpiGate<false> E{rs_mix, (const bf16*)(ws + WS_BR), (bf16*)(ws + WS_MG)}; pg8::gemm_phase<EpiGate<false>, pg8::StaticOrder, MK_ALIGN, MK_SP2>(lds, g, S, E); }
            }
        }
        SEAM(p + 4);
        if (IN(p + 5)) { PHASE_BEGIN();
            pg8::Gemm g{(const bf16*)(ws + WS_MG), (const bf16*)(wl + OW_OUT), MT, DM, DM}; pg8::StaticOrder S; S.init(MT, DM, G, bid);
            EpiRes E{a.out, Hm, HB, rs_mlp};
            pg8::gemm_phase<EpiRes, pg8::StaticOrder, MK_ALIGN, MK_SP2>(lds, g, S, E);
        }
        SEAM(p + 5);
        if (IN(p + 6)) { PHASE_BEGIN();
            pg8::Gemm g{HB, (const bf16*)(wl + OW_UP), MT, FF, DM}; pg8::StaticOrder S; S.init(MT, FF, G, bid);
            EpiUp E{rs_mlp, (bf16*)(ws + WS_ACT)};
            pg8::gemm_phase<EpiUp, pg8::StaticOrder, MK_ALIGN, MK_SP2>(lds, g, S, E);
        }
        SEAM(p + 6);
        if (IN(p + 7)) { PHASE_BEGIN();
            pg8::Gemm g{(const bf16*)(ws + WS_ACT), (const bf16*)(wl + OW_DN), MT, DM, FF}; pg8::StaticOrder S; S.init(MT, DM, G, bid);
            EpiRes E{a.out, Hm, HB, rs_next};
            pg8::gemm_phase<EpiRes, pg8::StaticOrder, MK_ALIGN, MK_SP2>(lds, g, S, E);
        }
        SEAM(p + 7);
    }
#ifdef MK_DUMP_OFF
    if (IN(PH_FINAL)) {
        const bf16* src = (const bf16*)(a.ws + (MK_DUMP_OFF)); const bf16* src2 = (const bf16*)(a.ws + (MK_DUMP_OFF2));
        for (int i = bid * 512 + threadIdx.x; i < NREAL * 1024; i += G * 512) { const int R = MK_DUMP_ROW(i >> 10), c = i & 1023; a.out[i] = c < 512 ? bf2f(src[(size_t)R * (MK_DUMP_LD) + (c % (MK_DUMP_LD))]) : bf2f(src2[(size_t)R * (MK_DUMP_LD2) + (c % (MK_DUMP_LD2))]); }
    }
#else
    if (IN(PH_FINAL)) {
        const float* rs = (const float*)(a.ws + WS_RS) + (size_t)MK_RSIDX * TPR * 16; const float* gain = a.in[22];
        for (int i = bid * 512 + threadIdx.x; i < NREAL * 256; i += G * 512) {
            const int R = i >> 8, c4 = (i & 255) * 4;
            const float r = row_rstd(rs, R);
            f32x4 v = *(const f32x4*)(a.out + (size_t)R * DM + c4); const f32x4 gn = *(const f32x4*)(gain + c4);
            v = v * r * gn;
            *(f32x4*)(a.out + (size_t)R * DM + c4) = v;
        }
    }
#endif
#undef IN
#undef SEAM
}

extern "C" void kernel_launch(void* const* d_in, const int* in_sizes, int n_in, void* d_out, int out_size, void* d_ws, size_t ws_size, hipStream_t stream) {
    static int grid = 0;
    if (grid == 0) {
        if (n_in != 23 || out_size != NREAL * DM || ws_size < WS_END) { fprintf(stderr, "kernel_launch: unexpected shapes (n_in %d out %d ws %zu)\n", n_in, out_size, ws_size); grid = -1; return; }
        int dev = 0, cus = 0, per_cu = 0;
        hipGetDevice(&dev); hipDeviceGetAttribute(&cus, hipDeviceAttributeMultiprocessorCount, dev);
        if (hipFuncSetAttribute((const void*)fwd_kernel, hipFuncAttributeMaxDynamicSharedMemorySize, LDS_BYTES) != hipSuccess) { fprintf(stderr, "kernel_launch: hipFuncSetAttribute failed\n"); grid = -1; return; }
        if (hipOccupancyMaxActiveBlocksPerMultiprocessor(&per_cu, (const void*)fwd_kernel, 512, LDS_BYTES) != hipSuccess || per_cu < 1) { fprintf(stderr, "kernel_launch: occupancy query gave %d\n", per_cu); per_cu = 1; }
        (void)hipGetLastError();
        grid = cus * (per_cu > 1 ? 1 : per_cu);
        if (grid <= 0) grid = 256;
    }
    if (grid < 0) return;
    Args a{};
    for (int i = 0; i < 23; ++i) a.in[i] = (const float*)d_in[i];
    a.out = (float*)d_out; a.ws = (unsigned char*)d_ws;
#if MK_SPLIT
    for (int ph = 0; ph < NPHASE; ++ph) hipLaunchKernelGGL(fwd_kernel, dim3(grid), dim3(512), LDS_BYTES, stream, a, ph, ph + 1);
#else
    int lo = 0, hi = NPHASE;
    void* kargs[] = {(void*)&a, (void*)&lo, (void*)&hi};
    hipError_t e = hipLaunchCooperativeKernel((const void*)fwd_kernel, dim3(grid), dim3(512), kargs, LDS_BYTES, stream);
    if (e != hipSuccess) fprintf(stderr, "kernel_launch: cooperative launch failed: %s (grid %d)\n", hipGetErrorString(e), grid);
#endif
}
```

```cpp
#include <hip/hip_runtime.h>
#include <hip/hip_cooperative_groups.h>
#include <cstdio>
#include <cstdint>
namespace cg = cooperative_groups;
namespace pg8 {
#define PG8_LAS __attribute__((address_space(3)))
typedef unsigned short bf16_t;
typedef short bf16x8 __attribute__((ext_vector_type(8)));
typedef float f32x4 __attribute__((ext_vector_type(4)));
typedef unsigned u32x4 __attribute__((ext_vector_type(4)));
constexpr int BM = 256, BK = 64, HALF = 128, HTB = HALF * BK * 2  , STAGE_BYTES = 8 * HTB, NXCD = 8, WGM = 8;

__host__ __device__ __forceinline__ int lds_byte(int r, int c) { const int st = (r >> 4) * 2 + (c >> 5), rr = r & 15, cc = c & 31, ob = rr * 64 + cc * 2; return st * 1024 + (ob ^ (((ob >> 9) & 1) << 5)); }
__host__ __device__ __forceinline__ void stage_rc(int b, int& R, int& C) { const int st = b / 1024, sb = b % 1024, swz = sb ^ (((sb >> 9) & 1) << 5); R = (st >> 1) * 16 + swz / 64; C = (st & 1) * 32 + (swz % 64) / 2; }
__host__ __device__ __forceinline__ int perm32(int rho) { const int n = rho >> 4, i = rho & 15; return 8 * (i >> 2) + 4 * n + (i & 3); }

struct Unit { int pm, pn; };
struct Gemm { const bf16_t* A; const bf16_t* Bt; int M, N, K; };

struct StaticOrder {
    int nM, nN, nwg, G, c;
    __host__ __device__ void init(int M, int N, int G_, int c_) { nM = M / BM; nN = N / BM; nwg = nM * nN; G = G_; c = c_; }
    __host__ __device__ bool next(int i, Unit& u) const {
        const long L = (long)i * G + c; if (L >= nwg) return false;
        int wgid = (int)L; { const int q = nwg / NXCD, r = nwg % NXCD, xcd = wgid % NXCD, off = wgid / NXCD; wgid = (xcd < r ? xcd * (q + 1) : r * (q + 1) + (xcd - r) * q) + off; }
        const int nig = WGM * nN, gid = wgid / nig, fm = gid * WGM, gsz = (nM - fm) < WGM ? (nM - fm) : WGM;
        u.pm = fm + ((wgid % nig) % gsz); u.pn = (wgid % nig) / gsz; return true;
    }
    __device__ __forceinline__ void a_ready(const Unit&) const {}
    __device__ __forceinline__ void done(const Unit&) const {}
};

__device__ __forceinline__ unsigned cvt_pk_bf16(float lo, float hi) { unsigned r; asm volatile("v_cvt_pk_bf16_f32 %0, %1, %2" : "=v"(r) : "v"(lo), "v"(hi)); return r; }
template <class Epi, class Sched, bool ALIGN_EPI = false, bool SP2 = false>
__device__ __forceinline__ void gemm_phase(PG8_LAS unsigned char* lds, const Gemm g, const Sched& S, const Epi& E) {
    int tid_l = threadIdx.x; asm volatile("" : "+v"(tid_l));
    const int tid = tid_l, wid = __builtin_amdgcn_readfirstlane(tid >> 6), lane = tid & 63, wr = wid >> 2, wc = wid & 3, fr = lane & 15, fq = lane >> 4;
    const int K = g.K, nt = K / BK;
    unsigned voffA[2], voffB[2];
#pragma unroll
    for (int i = 0; i < 2; ++i) { int R, C; stage_rc(tid * 16 + i * 8192, R, C); const int Rb = Epi::PERM ? ((R & ~31) + perm32(R & 31)) : R;
        voffA[i] = (unsigned)(R * K + C) * 2u; voffB[i] = (unsigned)(Rb * K + C) * 2u; }
    const size_t kstep = (size_t)(BK * 2);
    const size_t hstep = (size_t)HALF * K * 2;
    const size_t tstep = 2 * hstep;
    const unsigned ldsw = (unsigned)wid * 1024u;
    const int aoff = lds_byte(wr * 64 + fr, fq * 8), boff = lds_byte(wc * 32 + fr, fq * 8);
#define PG8_SA(b, h) (((b) * 2 + (h)) * HTB)
#define PG8_SB(b, h) ((4 + (b) * 2 + (h)) * HTB)
#define PG8_STAGE(bufoff, gbase, voff) do { _Pragma("unroll") for (int _i = 0; _i < 2; ++_i) \
        __builtin_amdgcn_global_load_lds((const unsigned*)((const char*)(gbase) + (voff)[_i]), (PG8_LAS unsigned*)(lds + (bufoff) + ldsw + _i * 8192), 16, 0, 0); } while (0)
#define PG8_LDA(dst, b, h) do { _Pragma("unroll") for (int m = 0; m < 4; ++m) _Pragma("unroll") for (int k = 0; k < 2; ++k) dst[m][k] = *(const PG8_LAS bf16x8*)(lds + PG8_SA(b, h) + aoff + m * 2048 + k * 1024); } while (0)
#define PG8_LDB(dst, b, h) do { _Pragma("unroll") for (int n = 0; n < 2; ++n) _Pragma("unroll") for (int k = 0; k < 2; ++k) dst[n][k] = *(const PG8_LAS bf16x8*)(lds + PG8_SB(b, h) + boff + n * 2048 + k * 1024); } while (0)
#define PG8_MMA(ai, bj, At, Bt) do { __builtin_amdgcn_s_setprio(1); _Pragma("unroll") for (int m = 0; m < 4; ++m) _Pragma("unroll") for (int n = 0; n < 2; ++n) _Pragma("unroll") for (int k = 0; k < 2; ++k) \
        acc[ai][bj][m][n] = __builtin_amdgcn_mfma_f32_16x16x32_bf16(Bt[n][k], At[m][k], acc[ai][bj][m][n], 0, 0, 0); __builtin_amdgcn_s_setprio(0); } while (0)
#define PG8_WAIT_V(n) asm volatile("s_waitcnt vmcnt(" #n ")" ::: "memory")
#define PG8_WAIT_L(n) asm volatile("s_waitcnt lgkmcnt(" #n ")" ::: "memory")
#define PG8_BAR __builtin_amdgcn_s_barrier()
#define PG8_SCHED __builtin_amdgcn_sched_barrier(0)
    Unit cur, nxt; int ui = 0;
    if (!S.next(0, cur)) return;
    f32x4 acc[2][2][4][2];
#pragma unroll
    for (int a = 0; a < 2; ++a)
#pragma unroll
        for (int b = 0; b < 2; ++b)
#pragma unroll
            for (int m = 0; m < 4; ++m)
#pragma unroll
                for (int n = 0; n < 2; ++n) acc[a][b][m][n] = (f32x4){0.f, 0.f, 0.f, 0.f};
    bf16x8 At[4][2], B0[2][2], B1[2][2];
    const char* cA = (const char*)g.A + (size_t)cur.pm * tstep; const char* cB = (const char*)g.Bt + (size_t)cur.pn * tstep;
    S.a_ready(cur);
    if constexpr (SP2) {
        PG8_STAGE(PG8_SB(0, 0), cB, voffB); PG8_STAGE(PG8_SB(0, 1), cB + hstep, voffB); PG8_STAGE(PG8_SA(0, 0), cA, voffA); PG8_STAGE(PG8_SA(0, 1), cA + hstep, voffA);
        if (wr == 1) PG8_BAR;
        PG8_WAIT_V(2); PG8_BAR;
        PG8_STAGE(PG8_SB(1, 0), cB + kstep, voffB); PG8_STAGE(PG8_SA(1, 0), cA + kstep, voffA); PG8_STAGE(PG8_SB(1, 1), cB + hstep + kstep, voffB);
        PG8_WAIT_V(6); PG8_BAR;
    } else {
        PG8_STAGE(PG8_SB(0, 0), cB, voffB); PG8_STAGE(PG8_SA(0, 0), cA, voffA); PG8_STAGE(PG8_SB(0, 1), cB + hstep, voffB); PG8_STAGE(PG8_SA(0, 1), cA + hstep, voffA);
        if (wr == 1) PG8_BAR;
        PG8_WAIT_V(4); PG8_BAR;
        PG8_STAGE(PG8_SB(1, 0), cB + kstep, voffB); PG8_STAGE(PG8_SA(1, 0), cA + kstep, voffA); PG8_STAGE(PG8_SB(1, 1), cB + hstep + kstep, voffB);
        PG8_WAIT_V(6); PG8_BAR;
    }
    for (;;) {
        const bool has_next = S.next(ui + 1, nxt);
        const char* nA = has_next ? (const char*)g.A + (size_t)nxt.pm * tstep : cA; const char* nB = has_next ? (const char*)g.Bt + (size_t)nxt.pn * tstep : cB;
        for (int t = 0; t < nt; t += 2) {
            const bool last = (t == nt - 2);
            const char* a1 = cA + (size_t)(t + 1) * kstep;
            const char* a2 = last ? nA : cA + (size_t)(t + 2) * kstep; const char* b2 = last ? nB : cB + (size_t)(t + 2) * kstep;
            const char* a3 = a2 + kstep; const char* b3 = b2 + kstep;
            if (last && has_next) S.a_ready(nxt);
            if constexpr (SP2) {
            PG8_LDB(B0, 0, 0); PG8_LDB(B1, 0, 1); PG8_SCHED; PG8_LDA(At, 0, 0); PG8_STAGE(PG8_SA(1, 1), a1 + hstep, voffA);
            PG8_WAIT_V(8); PG8_WAIT_L(0); PG8_BAR; PG8_MMA(0, 0, At, B0); PG8_MMA(0, 1, At, B1); PG8_BAR; PG8_SCHED;
            PG8_LDA(At, 0, 1); PG8_STAGE(PG8_SB(0, 0), b2, voffB); PG8_STAGE(PG8_SB(0, 1), b2 + hstep, voffB); PG8_STAGE(PG8_SA(0, 0), a2, voffA);
            PG8_WAIT_V(8); PG8_WAIT_L(0); PG8_BAR; PG8_MMA(1, 0, At, B0); PG8_MMA(1, 1, At, B1); PG8_BAR; PG8_SCHED;
            PG8_LDB(B0, 1, 0); PG8_LDB(B1, 1, 1); PG8_SCHED; PG8_LDA(At, 1, 0); PG8_STAGE(PG8_SA(0, 1), a2 + hstep, voffA);
            PG8_WAIT_V(8); PG8_WAIT_L(0); PG8_BAR; PG8_MMA(0, 0, At, B0); PG8_MMA(0, 1, At, B1); PG8_BAR; PG8_SCHED;
            PG8_LDA(At, 1, 1); PG8_STAGE(PG8_SB(1, 0), b3, voffB); PG8_STAGE(PG8_SB(1, 1), b3 + hstep, voffB); PG8_STAGE(PG8_SA(1, 0), a3, voffA);
            PG8_WAIT_V(8); PG8_WAIT_L(0); PG8_BAR; PG8_MMA(1, 0, At, B0); PG8_MMA(1, 1, At, B1); PG8_BAR; PG8_SCHED;
            } else {
            PG8_LDB(B0, 0, 0); PG8_SCHED; PG8_LDA(At, 0, 0); PG8_STAGE(PG8_SA(1, 1), a1 + hstep, voffA);
            PG8_WAIT_L(8); PG8_BAR; PG8_WAIT_L(0); PG8_MMA(0, 0, At, B0); PG8_BAR; PG8_SCHED;
            PG8_LDB(B1, 0, 1); PG8_STAGE(PG8_SB(0, 0), b2, voffB);
            PG8_BAR; PG8_WAIT_L(0); PG8_MMA(0, 1, At, B1); PG8_BAR;
            PG8_LDA(At, 0, 1); PG8_STAGE(PG8_SA(0, 0), a2, voffA);
            PG8_BAR; PG8_WAIT_L(0); PG8_MMA(1, 0, At, B0); PG8_BAR; PG8_SCHED;
            PG8_STAGE(PG8_SB(0, 1), b2 + hstep, voffB);
            PG8_WAIT_V(6); PG8_BAR; PG8_MMA(1, 1, At, B1); PG8_BAR;
            PG8_LDB(B0, 1, 0); PG8_SCHED; PG8_LDA(At, 1, 0); PG8_STAGE(PG8_SA(0, 1), a2 + hstep, voffA);
            PG8_WAIT_L(8); PG8_BAR; PG8_WAIT_L(0); PG8_MMA(0, 0, At, B0); PG8_BAR; PG8_SCHED;
            PG8_LDB(B1, 1, 1); PG8_STAGE(PG8_SB(1, 0), b3, voffB);
            PG8_BAR; PG8_WAIT_L(0); PG8_MMA(0, 1, At, B1); PG8_BAR;
            PG8_LDA(At, 1, 1); PG8_STAGE(PG8_SA(1, 0), a3, voffA);
            PG8_BAR; PG8_WAIT_L(0); PG8_MMA(1, 0, At, B0); PG8_BAR; PG8_SCHED;
            PG8_STAGE(PG8_SB(1, 1), b3 + hstep, voffB);
            PG8_WAIT_V(6); PG8_BAR; PG8_MMA(1, 1, At, B1); PG8_BAR;
            }
        }
        if constexpr (ALIGN_EPI) { if (wr == 0) PG8_BAR; }
        asm volatile("s_nop 15\n\ts_nop 15" ::: "memory");
        if constexpr (!Epi::AFTER_DRAIN) { E(acc, cur, wr, wc, fr, fq); S.done(cur); }
        if (!has_next) break;
#pragma unroll
        for (int a = 0; a < 2; ++a)
#pragma unroll
            for (int b = 0; b < 2; ++b)
#pragma unroll
                for (int m = 0; m < 4; ++m)
#pragma unroll
                    for (int n = 0; n < 2; ++n) acc[a][b][m][n] = (f32x4){0.f, 0.f, 0.f, 0.f};
        cur = nxt; cA = nA; cB = nB; ++ui;
        if constexpr (ALIGN_EPI) { if (wr == 1) PG8_BAR; }
    }
    PG8_WAIT_V(0);
    if constexpr (!ALIGN_EPI) { if (wr == 0) PG8_BAR; }
    PG8_BAR;
    if constexpr (Epi::AFTER_DRAIN) { E.fused(acc, cur, wr, wc, fr, fq, lds, wid, lane); S.done(cur); }
#undef PG8_SA
#undef PG8_SB
#undef PG8_STAGE
#undef PG8_LDA
#undef PG8_LDB
#undef PG8_MMA
#undef PG8_WAIT_V
#undef PG8_WAIT_L
#undef PG8_BAR
#undef PG8_SCHED
}
}

#define LAS __attribute__((address_space(3)))
typedef unsigned short bf16;
typedef short bf16x8 __attribute__((ext_vector_type(8)));
typedef float f32x4 __attribute__((ext_vector_type(4)));
typedef float f32x16 __attribute__((ext_vector_type(16)));
typedef unsigned u32x2 __attribute__((ext_vector_type(2)));
typedef unsigned u32x4 __attribute__((ext_vector_type(4)));

constexpr int NB = 8, SEQ = 2048, NMETA = 16, LL = 2064, DM = 1024, FF = 4096, DIN = 4864, NPROJ = 1792;
constexpr int NREAL = NB * SEQ;
constexpr int TPR = NREAL + 256;
constexpr int LDS_BYTES = 147456;

constexpr size_t MiB = 1u << 20;
constexpr size_t WS_CTL = 0;
constexpr size_t WS_ROPE = 1 * MiB;
constexpr size_t WS_ABAR = 2 * MiB;
constexpr size_t WS_BMAT = 2 * MiB + 65536;
constexpr size_t WS_CMAT = WS_BMAT + 524288;
constexpr size_t WS_HM = 4 * MiB;
constexpr size_t WS_W = 5 * MiB;
constexpr size_t OW_IN = 0, OW_GLU = (size_t)DIN * DM * 2, OW_POOL = OW_GLU + 512 * 512 * 2, OW_BR = OW_POOL + 512 * 512 * 2,
                 OW_OUT = OW_BR + 3 * 1024 * 512 * 2, OW_UP = OW_OUT + 1024 * 1024 * 2, OW_DN = OW_UP + (size_t)FF * DM * 2, LW_BYTES = OW_DN + (size_t)FF * DM * 2;
constexpr size_t WS_HB = 68 * MiB;
constexpr size_t WS_X = 101 * MiB;
constexpr size_t UU = (size_t)TPR * 512 * 2;
constexpr size_t WS_YF = WS_X, WS_YP = WS_X, WS_Q = WS_X + 2 * UU, WS_K = WS_Q + UU, WS_V = WS_K + UU / 4, WS_MG = WS_X + 2 * UU,
                 WS_SU = WS_X + 4 * UU, WS_YA = WS_X + 8 * UU  , WS_PU = WS_X + 5 * UU, WS_YS = WS_PU, WS_Z = WS_X + 6 * UU, WS_PD = WS_X + 7 * UU, WS_BR = WS_Z, WS_ACT = WS_X;
constexpr size_t WS_RS = WS_X + 9 * UU;
constexpr size_t WS_END = WS_RS + (size_t)5 * TPR * 16 * 4;
static_assert(WS_W + 2 * LW_BYTES <= WS_HB && WS_HB + (size_t)TPR * 1024 * 2 <= WS_X && WS_END <= 256 * MiB, "ws map");
static_assert((size_t)256 * 2064 * 16 * 4 <= 2 * UU, "YF fits");

__device__ __forceinline__ unsigned f2bf(float f) { unsigned u = __float_as_uint(f); return (u + 0x7fffu + ((u >> 16) & 1u)) >> 16; }
__device__ __forceinline__ unsigned pk2(float lo, float hi) { return f2bf(lo) | (f2bf(hi) << 16); }
__device__ __forceinline__ float bf2f(unsigned b) { return __uint_as_float(b << 16); }
__device__ __forceinline__ int tok_row(int b, int l) { return l >= NMETA ? b * SEQ + l - NMETA : NREAL + b * NMETA + l; }
#define LDS_FENCE() asm volatile("s_waitcnt lgkmcnt(0)" ::: "memory")
#define SSM_SYNC() do { asm volatile("s_waitcnt vmcnt(0) lgkmcnt(0)" ::: "memory"); __syncthreads(); } while (0)
__device__ __forceinline__ float row_rstd(const float* rs, int R) {
    const f32x4 a = *(const f32x4*)(rs + (size_t)R * 4), b = *(const f32x4*)(rs + ((size_t)TPR + R) * 4), c = *(const f32x4*)(rs + ((size_t)2 * TPR + R) * 4), d = *(const f32x4*)(rs + ((size_t)3 * TPR + R) * 4);
    const float s = (((a[0] + a[1]) + (a[2] + a[3])) + ((b[0] + b[1]) + (b[2] + b[3]))) + (((c[0] + c[1]) + (c[2] + c[3])) + ((d[0] + d[1]) + (d[2] + d[3])));
    return rsqrtf(s * (1.0f / 1024.0f) + 1e-6f);
}

__device__ __forceinline__ void dsincos(double a, double& s, double& c) {
    const double q = rint(a * 0.63661977236758134308);
    double r = fma(-q, 1.57079632679489655800e+00, a); r = fma(-q, 6.12323399573676603587e-17, r);
    const double r2 = r * r;
    double sp = -7.6471637318198164759e-13; sp = fma(sp, r2, 1.6059043836821614599e-10); sp = fma(sp, r2, -2.5052108385441718775e-08); sp = fma(sp, r2, 2.7557319223985890653e-06);
    sp = fma(sp, r2, -1.9841269841269841270e-04); sp = fma(sp, r2, 8.3333333333333333333e-03); sp = fma(sp, r2, -1.6666666666666666667e-01); sp = fma(sp * r2, r, r);
    double cp = 4.7794773323873852974e-14; cp = fma(cp, r2, -1.1470745597729724714e-11); cp = fma(cp, r2, 2.0876756987868098979e-09); cp = fma(cp, r2, -2.7557319223985890653e-07);
    cp = fma(cp, r2, 2.4801587301587301587e-05); cp = fma(cp, r2, -1.3888888888888888889e-03); cp = fma(cp, r2, 4.1666666666666666667e-02); cp = fma(cp, r2, -0.5); cp = fma(cp, r2, 1.0);
    const int qi = ((int)q) & 3;
    s = (qi == 0) ? sp : (qi == 1) ? cp : (qi == 2) ? -sp : -cp;
    c = (qi == 0) ? cp : (qi == 1) ? -sp : (qi == 2) ? -cp : sp;
}
__device__ __forceinline__ double dexp(double x) {
    const double k = rint(x * 1.44269504088896340736);
    double r = fma(-k, 6.93147180369123816490e-01, x); r = fma(-k, 1.90821492927058770002e-10, r);
    double p = 1.0 / 6227020800.0; p = fma(p, r, 1.0 / 479001600.0); p = fma(p, r, 1.0 / 39916800.0); p = fma(p, r, 1.0 / 3628800.0); p = fma(p, r, 1.0 / 362880.0); p = fma(p, r, 1.0 / 40320.0);
    p = fma(p, r, 1.0 / 5040.0); p = fma(p, r, 1.0 / 720.0); p = fma(p, r, 1.0 / 120.0); p = fma(p, r, 1.0 / 24.0); p = fma(p, r, 1.0 / 6.0); p = fma(p, r, 0.5); p = fma(p, r, 1.0); p = fma(p, r, 1.0);
    const long long bits = ((long long)(1023 + (int)k)) << 52;
    return p * __longlong_as_double(bits);
}

struct EpiInProj {
    static constexpr bool PERM = false, AFTER_DRAIN = false;
    const float* rowss; const float* rope; bf16 *Q, *K, *V, *SU, *PU;
    __device__ __forceinline__ void operator()(const f32x4 (&acc)[2][2][4][2], const pg8::Unit& u, int wr, int wc, int fr, int fq) const {
#pragma unroll
        for (int ai = 0; ai < 2; ++ai)
#pragma unroll
            for (int m = 0; m < 4; ++m) {
                const int R = u.pm * 256 + ai * 128 + wr * 64 + m * 16 + fr;
                const float rs = row_rstd(rowss, R);
                const int l = R < NREAL ? (R & 2047) + NMETA : (R & 15);
#pragma unroll
                for (int bj = 0; bj < 2; ++bj)
#pragma unroll
                    for (int n = 0; n < 2; ++n) {
                        const int c = u.pn * 256 + bj * 128 + wc * 32 + n * 16 + 4 * fq;
                        const f32x4 v = acc[ai][bj][m][n] * rs;
                        u32x2 w;
                        if (c < 640) {
                            const int i0 = (c & 63) >> 1;
                            const f32x4 cs = *(const f32x4*)(rope + ((size_t)l * 32 + i0) * 2);
                            float o0 = v[0] * cs[0] - v[1] * cs[1], o1 = v[1] * cs[0] + v[0] * cs[1], o2 = v[2] * cs[2] - v[3] * cs[3], o3 = v[3] * cs[2] + v[2] * cs[3];
                            if (c < 512) { w.x = pk2(o0 * 0.125f, o1 * 0.125f); w.y = pk2(o2 * 0.125f, o3 * 0.125f); *(u32x2*)(Q + (size_t)R * 512 + c) = w; }
                            else { w.x = pk2(o0, o1); w.y = pk2(o2, o3); *(u32x2*)(K + (size_t)R * 128 + (c - 512)) = w; }
                        } else {
                            w.x = pk2(v[0], v[1]); w.y = pk2(v[2], v[3]);
                            if (c < 768) *(u32x2*)(V + (size_t)R * 128 + (c - 640)) = w;
                            else if (c < 1280) *(u32x2*)(SU + (size_t)R * 512 + (c - 768)) = w;
                            else *(u32x2*)(PU + (size_t)R * 512 + (c - 1280)) = w;
                        }
                    }
            }
    }
};
#define EPI_BODY() \
    __device__ __forceinline__ void rg(int R, int pn, int wc, int fq, const f32x4 (&a4)[2][2]) const { \
        _Pragma("unroll") for (int bj = 0; bj < 2; ++bj) _Pragma("unroll") for (int n = 0; n < 2; ++n) q(R, pn * 256 + bj * 128 + wc * 32 + n * 16 + 4 * fq, a4[bj][n]); } \
    __device__ __forceinline__ void tq(int R, int c, const f32x4& v) const { q(R, c, v); } \
    EPI_OP()
#define EPI_OP() \
    __device__ __forceinline__ void operator()(const f32x4 (&acc)[2][2][4][2], const pg8::Unit& u, int wr, int wc, int fr, int fq) const { \
        _Pragma("unroll") for (int ai = 0; ai < 2; ++ai) _Pragma("unroll") for (int m = 0; m < 4; ++m) { \
            const f32x4 a4[2][2] = {{acc[ai][0][m][0], acc[ai][0][m][1]}, {acc[ai][1][m][0], acc[ai][1][m][1]}}; \
            rg(u.pm * 256 + ai * 128 + wr * 64 + m * 16 + fr, u.pn, wc, fq, a4); } }
struct EpiGlu {
    static constexpr bool PERM = false, AFTER_DRAIN = false;
    const bf16* Z; const float* bias; bf16* YS;
    __device__ __forceinline__ void q(int R, int c, const f32x4& a) const {
        const f32x4 v = a + *(const f32x4*)(bias + c);
        const u32x2 zz = *(const u32x2*)(Z + (size_t)R * 512 + c);
        const float z0 = bf2f(zz.x & 0xffffu), z1 = bf2f(zz.x >> 16), z2 = bf2f(zz.y & 0xffffu), z3 = bf2f(zz.y >> 16);
        u32x2 w; w.x = pk2(z0 / (1.0f + __expf(-v[0])), z1 / (1.0f + __expf(-v[1]))); w.y = pk2(z2 / (1.0f + __expf(-v[2])), z3 / (1.0f + __expf(-v[3])));
        *(u32x2*)(YS + (size_t)R * 512 + c) = w;
    }
    EPI_BODY()
};
struct EpiScale {
    static constexpr bool PERM = false, AFTER_DRAIN = false;
    bf16* O; int ldc; const float* scale;
    __device__ __forceinline__ void q(int R, int c, const f32x4& a) const {
        f32x4 v = a;
        if (scale) v = v * *(const f32x4*)(scale + c);
        u32x2 w; w.x = pk2(v[0], v[1]); w.y = pk2(v[2], v[3]);
        *(u32x2*)(O + (size_t)R * ldc + c) = w;
    }
    EPI_BODY()
};
template <bool FIRST> struct EpiGate {
    static constexpr bool PERM = false, AFTER_DRAIN = false;
    const float* rowss; const bf16* BR; bf16* MG;
    __device__ __forceinline__ void q(int R, int c, const f32x4& a) const {
        const f32x4 v = a * row_rstd(rowss, R);
        const u32x2 bb = *(const u32x2*)(BR + (size_t)R * 1024 + c);
        float o0 = bf2f(bb.x & 0xffffu) / (1.0f + __expf(-v[0])), o1 = bf2f(bb.x >> 16) / (1.0f + __expf(-v[1]));
        float o2 = bf2f(bb.y & 0xffffu) / (1.0f + __expf(-v[2])), o3 = bf2f(bb.y >> 16) / (1.0f + __expf(-v[3]));
        if (!FIRST) { const u32x2 mm = *(const u32x2*)(MG + (size_t)R * 1024 + c);
            o0 += bf2f(mm.x & 0xffffu); o1 += bf2f(mm.x >> 16); o2 += bf2f(mm.y & 0xffffu); o3 += bf2f(mm.y >> 16); }
        u32x2 w; w.x = pk2(o0, o1); w.y = pk2(o2, o3);
        *(u32x2*)(MG + (size_t)R * 1024 + c) = w;
    }
    EPI_BODY()
};
struct EpiRes {
    static constexpr bool PERM = false, AFTER_DRAIN = false;
    float* Hreal; float* Hmeta; bf16* HB; float* rowss_out;
    __device__ __forceinline__ float q(int R, int c, const f32x4& a) const {
        float* hrow = R < NREAL ? Hreal + (size_t)R * 1024 : Hmeta + (size_t)(R - NREAL) * 1024;
        const f32x4 h = *(const f32x4*)(hrow + c) + a;
        *(f32x4*)(hrow + c) = h;
        u32x2 w; w.x = pk2(h[0], h[1]); w.y = pk2(h[2], h[3]);
        *(u32x2*)(HB + (size_t)R * 1024 + c) = w;
        return (h[0] * h[0] + h[1] * h[1]) + (h[2] * h[2] + h[3] * h[3]);
    }
    __device__ __forceinline__ void rg(int R, int pn, int wc, int fq, const f32x4 (&a4)[2][2]) const {
        float ss = 0.f;
#pragma unroll
        for (int bj = 0; bj < 2; ++bj)
#pragma unroll
            for (int n = 0; n < 2; ++n) ss += q(R, pn * 256 + bj * 128 + wc * 32 + n * 16 + 4 * fq, a4[bj][n]);
        ss += __shfl_xor(ss, 16); ss += __shfl_xor(ss, 32);
        if (fq == 0) rowss_out[((size_t)pn * TPR + R) * 4 + wc] = ss;
    }
    __device__ __forceinline__ void tq(int R, int c, const f32x4& v) const {
        float ss = q(R, c, v);
        ss += __shfl_xor(ss, 16); ss += __shfl_xor(ss, 32);
        if ((threadIdx.x & 48) == 0) atomicAdd(rowss_out + (size_t)R * 4, ss);
    }
    EPI_OP()
};
struct EpiUp {
    static constexpr bool PERM = false, AFTER_DRAIN = false;
    const float* rowss; bf16* ACT;
    __device__ __forceinline__ void q(int R, int c, const f32x4& a) const {
        f32x4 v = a * row_rstd(rowss, R);
#pragma unroll
        for (int j = 0; j < 4; ++j) { const float r = fmaxf(v[j], 0.f); v[j] = r * r; }
        u32x2 w; w.x = pk2(v[0], v[1]); w.y = pk2(v[2], v[3]);
        *(u32x2*)(ACT + (size_t)R * FF + c) = w;
    }
    EPI_BODY()
};
template <class Epi>
__device__ __forceinline__ void thin_gemm(LAS unsigned char* lds, const bf16* A, const bf16* Bt, int K, int N, const Epi& E) {
    int tid_l = threadIdx.x; asm volatile("" : "+v"(tid_l));
    const int lane = tid_l & 63, w = __builtin_amdgcn_readfirstlane(tid_l >> 6), fr = lane & 15, fq = lane >> 4;
    LAS f32x4* red = (LAS f32x4*)lds;
    const int kw = K >> 3;
    for (int pc = blockIdx.x; pc < N / 16; pc += gridDim.x) {
        const bf16* ap = A + (size_t)(NREAL + fr) * K + w * kw + 8 * fq;
        const bf16* bp = Bt + (size_t)(16 * pc + fr) * K + w * kw + 8 * fq;
        f32x4 acc[8];
#pragma unroll
        for (int rb = 0; rb < 8; ++rb) acc[rb] = (f32x4){0.f, 0.f, 0.f, 0.f};
#pragma unroll 2
        for (int k0 = 0; k0 < kw; k0 += 32) {
            const bf16x8 bf = *(const bf16x8*)(bp + k0);
            bf16x8 af[8];
#pragma unroll
            for (int rb = 0; rb < 8; ++rb) af[rb] = *(const bf16x8*)(ap + (size_t)(16 * rb) * K + k0);
#pragma unroll
            for (int rb = 0; rb < 8; ++rb) acc[rb] = __builtin_amdgcn_mfma_f32_16x16x32_bf16(bf, af[rb], acc[rb], 0, 0, 0);
        }
        asm volatile("s_nop 15\n\ts_nop 15" : "+v"(acc[0]), "+v"(acc[1]), "+v"(acc[2]), "+v"(acc[3]), "+v"(acc[4]), "+v"(acc[5]), "+v"(acc[6]), "+v"(acc[7]));
#pragma unroll
        for (int rb = 0; rb < 8; ++rb) red[(w * 8 + rb) * 64 + lane] = acc[rb];
        LDS_FENCE(); __syncthreads();
        f32x4 v = red[(0 * 8 + w) * 64 + lane];
#pragma unroll
        for (int ww = 1; ww < 8; ++ww) v = v + red[(ww * 8 + w) * 64 + lane];
        LDS_FENCE(); __syncthreads();
        E.tq(NREAL + 16 * w + fr, 16 * pc + 4 * fq, v);
    }
}

struct Args { const float* in[23]; float* out; unsigned char* ws; };

__device__ __forceinline__ void p0_item(const float* W, int ldw, int K, const float* scale, bf16* WT, int permrows, LAS float* scr, int item, int nblk, int lane) {
    const int kb = item / nblk, nb = item % nblk, k0 = 64 * kb, n0 = 32 * nb;
    const int dn = n0 + (lane & 31); int sc = dn;
    if (dn < permrows) { const int j = dn & 63; sc = (dn & ~63) + ((j & 1) ? 32 + (j >> 1) : (j >> 1)); }
#pragma unroll 8
    for (int i = 0; i < 32; ++i) { const int kk = 2 * i + (lane >> 5); float w = W[(size_t)(k0 + kk) * ldw + sc]; if (scale) w *= scale[k0 + kk]; scr[kk * 33 + (lane & 31)] = w; }
    LDS_FENCE();
    const int c = lane & 7;
#pragma unroll
    for (int j = 0; j < 4; ++j) { const int n = (lane >> 3) + 8 * j; const LAS float* s = scr + (8 * c) * 33 + n;
        u32x4 o; o.x = pk2(s[0 * 33], s[1 * 33]); o.y = pk2(s[2 * 33], s[3 * 33]); o.z = pk2(s[4 * 33], s[5 * 33]); o.w = pk2(s[6 * 33], s[7 * 33]);
        *(u32x4*)(WT + (size_t)(n0 + n) * K + k0 + 8 * c) = o; }
    LDS_FENCE();
}

__device__ __forceinline__ void p0_prologue(const Args& a, LAS unsigned char* lds) {
    int tl_ = threadIdx.x; asm volatile("" : "+v"(tl_));
    const int tid = tl_, lane = tid & 63, wave = __builtin_amdgcn_readfirstlane(tid >> 6);
    const int gw = blockIdx.x * 8 + wave, NGW = gridDim.x * 8;
    const int gt = blockIdx.x * 512 + tid, NGT = gridDim.x * 512;
    unsigned char* ws = a.ws;
    LAS float* scr = (LAS float*)(lds + wave * 16384);
    for (int i = gt; i < 4 * 4 * 128 * 4; i += NGT) { const int idx = 1 + (i >> 11), pn = (i >> 9) & 3, r = (i >> 2) & 127, sl = i & 3;
        ((float*)(ws + WS_RS))[((size_t)idx * 4 * TPR + (size_t)pn * TPR + NREAL + r) * 4 + sl] = 0.f; }
    constexpr int I_IN = 16 * 152, I_GLU = 8 * 16, I_BR = 8 * 32, I_OUT = 16 * 32, I_UP = 16 * 128, I_DN = 64 * 32, I_L = I_IN + I_GLU + 3 * I_BR + I_OUT + I_UP + I_DN;
    for (int it = gw; it < 2 * I_L; it += NGW) {
        const int layer = it / I_L; int r = it % I_L;
        unsigned char* wl = ws + WS_W + (size_t)layer * LW_BYTES;
        if (r < I_IN) { p0_item(a.in[3] + (size_t)layer * DM * DIN, DIN, DM, a.in[2] + layer * DM, (bf16*)(wl + OW_IN), 640, scr, r, 152, lane); continue; } r -= I_IN;
        if (r < I_GLU) { p0_item(a.in[13] + (size_t)layer * 512 * 512, 512, 512, nullptr, (bf16*)(wl + OW_GLU), 0, scr, r, 16, lane); continue; } r -= I_GLU;
        if (r < 3 * I_BR) { const int c = r / I_BR; p0_item(a.in[17] + ((size_t)layer * 3 + c) * 512 * 1024, 1024, 512, nullptr, (bf16*)(wl + OW_BR) + (size_t)c * 1024 * 512, 0, scr, r % I_BR, 32, lane); continue; } r -= 3 * I_BR;
        if (r < I_OUT) { p0_item(a.in[18] + (size_t)layer * DM * DM, DM, DM, nullptr, (bf16*)(wl + OW_OUT), 0, scr, r, 32, lane); continue; } r -= I_OUT;
        if (r < I_UP) { p0_item(a.in[20] + (size_t)layer * DM * FF, FF, DM, a.in[19] + layer * DM, (bf16*)(wl + OW_UP), 0, scr, r, 128, lane); continue; } r -= I_UP;
        p0_item(a.in[21] + (size_t)layer * FF * DM, DM, FF, nullptr, (bf16*)(wl + OW_DN), 0, scr, r, 32, lane);
    }
    for (int i = gt; i < 2 * 512 * 512; i += NGT) {
        const int layer = i >> 18, n = (i >> 9) & 511, k = i & 511;
        float w = 0.f;
        if ((n >> 7) == (k >> 7)) w = a.in[15][(((size_t)layer * 4 + (n >> 7)) * 128 + (k & 127)) * 128 + (n & 127)];
        ((bf16*)(ws + WS_W + (size_t)layer * LW_BYTES + OW_POOL))[(size_t)n * 512 + k] = (bf16)f2bf(w);
    }
    for (int i = gt; i < LL * 32; i += NGT) {
        const int l = i >> 5, f = i & 31;
        const float invf = (float)dexp(-(double)f * (9.21034037197618273607 / 32.0));
        const float ang = (float)l * invf;
        double s, c; dsincos((double)ang, s, c);
        float* rp = (float*)(ws + WS_ROPE) + (size_t)i * 2; rp[0] = (float)c; rp[1] = (float)s;
    }
    for (int i = gt; i < 2 * 2 * 32 * 64; i += NGT) {
        const int n = i & 63, pidx = i >> 6;
        const double lr = (double)a.in[5][i], li = (double)a.in[6][i];
        const double dt = (double)(float)dexp((double)a.in[7][pidx]);
        const double mag = dexp(lr * dt); double sn, cn; dsincos(li * dt, sn, cn);
        const double are = mag * cn, aim = mag * sn, den = lr * lr + li * li, nre = are - 1.0;
        const double fre = (nre * lr + aim * li) / den, fim = (aim * lr - nre * li) / den;
        float* ab = (float*)(ws + WS_ABAR) + (size_t)i * 2; ab[0] = (float)are; ab[1] = (float)aim;
        bf16* bm = (bf16*)(ws + WS_BMAT) + (size_t)pidx * 128 * 16;
        bf16* cm = (bf16*)(ws + WS_CMAT) + (size_t)pidx * 16 * 128;
        for (int q = 0; q < 16; ++q) {
            const double br = (double)a.in[8][(size_t)i * 16 + q], bi = (double)a.in[9][(size_t)i * 16 + q];
            bm[n * 16 + q] = (bf16)f2bf((float)(fre * br - fim * bi));
            bm[(64 + n) * 16 + q] = (bf16)f2bf((float)(fre * bi + fim * br));
            cm[q * 128 + n] = (bf16)f2bf(a.in[10][((size_t)pidx * 16 + q) * 64 + n]);
            cm[q * 128 + 64 + n] = (bf16)f2bf(-a.in[11][((size_t)pidx * 16 + q) * 64 + n]);
        }
    }
    for (int R = gw; R < TPR; R += NGW) {
        const int mrow = R - NREAL;
        const float* src = R < NREAL ? a.in[0] + (size_t)R * DM : a.in[1] + (size_t)(mrow & 15) * DM;
        float* dst = R < NREAL ? a.out + (size_t)R * DM : (float*)(ws + WS_HM) + (size_t)mrow * DM;
        bf16* hb = (bf16*)(ws + WS_HB) + (size_t)R * DM;
        const bool pad = mrow >= NB * NMETA;
        float ss = 0.f;
#pragma unroll
        for (int j = 0; j < 4; ++j) {
            f32x4 v = *(const f32x4*)(src + 4 * lane + 256 * j);
            if (pad) v = (f32x4){0.f, 0.f, 0.f, 0.f};
            *(f32x4*)(dst + 4 * lane + 256 * j) = v;
            ss += (v[0] * v[0] + v[1] * v[1]) + (v[2] * v[2] + v[3] * v[3]);
            u32x2 w; w.x = pk2(v[0], v[1]); w.y = pk2(v[2], v[3]);
            *(u32x2*)(hb + 4 * lane + 256 * j) = w;
        }
#pragma unroll
        for (int o = 1; o < 64; o <<= 1) ss += __shfl_xor(ss, o);
        if (lane < 16) ((float*)(ws + WS_RS))[((size_t)(lane >> 2) * TPR + R) * 4 + (lane & 3)] = lane == 0 ? ss : 0.f;
    }
}

__device__ __forceinline__ void ssm_task(LAS unsigned char* lds, int task, int layer, const bf16* SU, float* YF,
                                         const float* abar_all, const bf16* bmat_all, const bf16* cmat_all) {
    int tid_l = threadIdx.x; asm volatile("" : "+v"(tid_l));
    const int tid = tid_l, lane = tid & 63, wave = __builtin_amdgcn_readfirstlane(tid >> 6);
    const int b = task >> 5, g = task & 31;
    __syncthreads();
    LAS float* BU = (LAS float*)(lds + wave * 12800);
    LAS unsigned short* X = (LAS unsigned short*)(lds + wave * 12800 + 8448);
    LAS float* SX = (LAS float*)(lds + 8 * 12800);
    const int blk0 = wave == 0 ? 0 : 16 * wave + 1, nblk = wave == 0 ? 17 : 16;
    bf16* yfb = (bf16*)YF + (size_t)task * LL * 16;
    const int fr = lane & 15, fq = lane >> 4;
    const bf16x8 zero8 = {0, 0, 0, 0, 0, 0, 0, 0};
    for (int dir = 0; dir < 2; ++dir) {
        const int pidx = (layer * 2 + dir) * 32 + g;
        const float are = abar_all[((size_t)pidx * 64 + lane) * 2], aim = abar_all[((size_t)pidx * 64 + lane) * 2 + 1];
        bf16x8 bfr[8], cfr[4];
        const bf16* bm = bmat_all + (size_t)pidx * 128 * 16;
#pragma unroll
        for (int nt = 0; nt < 8; ++nt) bfr[nt] = fq < 2 ? *(const bf16x8*)(bm + (nt * 16 + fr) * 16 + 8 * fq) : zero8;
        const bf16* cm = cmat_all + (size_t)pidx * 16 * 128;
#pragma unroll
        for (int ks = 0; ks < 4; ++ks) cfr[ks] = *(const bf16x8*)(cm + fr * 128 + ks * 32 + 8 * fq);
        float p16r = are, p16i = aim;
#pragma unroll
        for (int i = 0; i < 4; ++i) { const float tr = p16r * p16r - p16i * p16i, ti = 2.f * p16r * p16i; p16r = tr; p16i = ti; }
        float p256r = p16r, p256i = p16i;
#pragma unroll
        for (int i = 0; i < 4; ++i) { const float tr = p256r * p256r - p256i * p256i, ti = 2.f * p256r * p256i; p256r = tr; p256i = ti; }
        const float p272r = p256r * p16r - p256i * p16i, p272i = p256r * p16i + p256i * p16r;

        float xre = 0.f, xim = 0.f;
        for (int pass = 0; pass < 2; ++pass) {
            bf16x8 unext;
            { const int blkf = dir == 0 ? blk0 : blk0 + nblk - 1; const int Rf = blkf == 0 ? NREAL + b * NMETA : b * SEQ + blkf * 16 - NMETA;
              unext = fq < 2 ? *(const bf16x8*)(SU + (size_t)(Rf + fr) * 512 + g * 16 + 8 * fq) : zero8; }
            for (int ib = 0; ib < nblk; ++ib) {
                const int blk = dir == 0 ? blk0 + ib : blk0 + nblk - 1 - ib;
                const bf16x8 ufr = unext;
                if (ib + 1 < nblk) { const int blkn = dir == 0 ? blk + 1 : blk - 1; const int Rn = blkn == 0 ? NREAL + b * NMETA : b * SEQ + blkn * 16 - NMETA;
                    unext = fq < 2 ? *(const bf16x8*)(SU + (size_t)(Rn + fr) * 512 + g * 16 + 8 * fq) : zero8; }
                f32x4 dd[8];
#pragma unroll
                for (int nt = 0; nt < 8; ++nt) { dd[nt] = (f32x4){0.f, 0.f, 0.f, 0.f}; dd[nt] = __builtin_amdgcn_mfma_f32_16x16x32_bf16(ufr, bfr[nt], dd[nt], 0, 0, 0); }
                asm volatile("s_nop 15\n\ts_nop 15" : "+v"(dd[0]), "+v"(dd[1]), "+v"(dd[2]), "+v"(dd[3]), "+v"(dd[4]), "+v"(dd[5]), "+v"(dd[6]), "+v"(dd[7]));
#pragma unroll
                for (int nt = 0; nt < 8; ++nt)
#pragma unroll
                    for (int r = 0; r < 4; ++r) BU[(4 * fq + r) * 132 + nt * 16 + fr] = dd[nt][r];
                LDS_FENCE();
                float bur[16], bui[16];
#pragma unroll
                for (int i = 0; i < 16; ++i) { const int tt = dir == 0 ? i : 15 - i; bur[i] = BU[tt * 132 + lane]; bui[i] = BU[tt * 132 + 64 + lane]; }
                if (pass == 0) {
#pragma unroll
                    for (int i = 0; i < 16; ++i) {
                        const float bre = bur[i], bim = bui[i];
                        const float nr = are * xre - aim * xim + bre, ni = are * xim + aim * xre + bim; xre = nr; xim = ni;
                    }
                    LDS_FENCE();
                } else {
#pragma unroll
                    for (int i = 0; i < 16; ++i) {
                        const int tt = dir == 0 ? i : 15 - i;
                        const float bre = bur[i], bim = bui[i];
                        const float nr = are * xre - aim * xim + bre, ni = are * xim + aim * xre + bim; xre = nr; xim = ni;
                        X[tt * 136 + lane] = (unsigned short)f2bf(xre); X[tt * 136 + 64 + lane] = (unsigned short)f2bf(xim);
                    }
                    LDS_FENCE();
                    f32x4 y = {0.f, 0.f, 0.f, 0.f};
#pragma unroll
                    for (int ks = 0; ks < 4; ++ks) {
                        const bf16x8 afr = *(const LAS bf16x8*)(X + fr * 136 + ks * 32 + 8 * fq);
                        y = __builtin_amdgcn_mfma_f32_16x16x32_bf16(afr, cfr[ks], y, 0, 0, 0);
                    }
                    asm volatile("s_nop 15\n\ts_nop 15" : "+v"(y));
                    LDS_FENCE();
                    {
                        bf16* yd = yfb + (size_t)dir * 256 * LL * 16;
#pragma unroll
                        for (int r = 0; r < 4; ++r) yd[(size_t)(blk * 16 + 4 * fq + r) * 16 + fr] = (bf16)f2bf(y[r]);
                    }
                }
            }
            if (pass == 0) {
                SX[(wave * 64 + lane) * 2] = xre; SX[(wave * 64 + lane) * 2 + 1] = xim;
                LDS_FENCE(); __syncthreads();
                float cre = 0.f, cim = 0.f;
                if (dir == 0) {
                    for (int w = 0; w < wave; ++w) { const float pr = w == 0 ? p272r : p256r, pi = w == 0 ? p272i : p256i;
                        const float sr = SX[(w * 64 + lane) * 2], si = SX[(w * 64 + lane) * 2 + 1];
                        const float nr = pr * cre - pi * cim + sr, ni = pr * cim + pi * cre + si; cre = nr; cim = ni; }
                } else {
                    for (int w = 7; w > wave; --w) {
                        const float sr = SX[(w * 64 + lane) * 2], si = SX[(w * 64 + lane) * 2 + 1];
                        const float nr = p256r * cre - p256i * cim + sr, ni = p256r * cim + p256i * cre + si; cre = nr; cim = ni; }
                }
                xre = cre; xim = cim;
            }
        }
        LDS_FENCE(); __syncthreads();
    }
}

constexpr int ATT_KROW = 72, ATT_VROW = 40, ATT_KT = 32 * ATT_KROW * 2  , ATT_VT = 64 * ATT_VROW * 2  , ATT_MAXT = 11, ATT_VOFF = ATT_MAXT * ATT_KT;
static_assert(ATT_VOFF + ATT_MAXT * ATT_VT <= 131072, "attention LDS");
__device__ __forceinline__ void attn_task(LAS unsigned char* lds, int task, const bf16* Q, const bf16* K, const bf16* V, bf16* YA, const float* sink) {
    int tid_l = threadIdx.x; asm volatile("" : "+v"(tid_l));
    const int tid = tid_l, lane = tid & 63, wave = __builtin_amdgcn_readfirstlane(tid >> 6);
    const int qb = task % 33, bh = task / 33, h = bh & 1, b = bh >> 1;
    const int l0 = qb * 64;
    __syncthreads();
    int jlo = (l0 - 128) >> 5; if (jlo < 1) jlo = 1;
    int jhi = (l0 + 191) >> 5; if (jhi > 64) jhi = 64;
    const int ntiles = 1 + (jhi - jlo + 1);
    LAS unsigned short* Ks = (LAS unsigned short*)lds;
    LAS unsigned short* Vs = (LAS unsigned short*)(lds + ATT_VOFF);
    for (int idx = tid; idx < ntiles * 32 * 8; idx += 512) {
        const int ch = idx & 7, key = idx >> 3, slot = key >> 5, kk = key & 31;
        const int lk = (slot == 0 ? 0 : (jlo + slot - 1) * 32) + kk;
        u32x4 kv = {0u, 0u, 0u, 0u}, vv = {0u, 0u, 0u, 0u};
        if (lk < LL) { const size_t R = (size_t)tok_row(b, lk);
            kv = *(const u32x4*)(K + R * 128 + h * 64 + ch * 8); vv = *(const u32x4*)(V + R * 128 + h * 64 + ch * 8); }
        *(LAS u32x4*)(Ks + slot * (ATT_KT / 2) + kk * ATT_KROW + ch * 8) = kv;
        LAS unsigned short* vd = Vs + slot * (ATT_VT / 2) + (ch * 8) * ATT_VROW + kk;
        vd[0 * ATT_VROW] = (unsigned short)(vv.x & 0xffffu); vd[1 * ATT_VROW] = (unsigned short)(vv.x >> 16);
        vd[2 * ATT_VROW] = (unsigned short)(vv.y & 0xffffu); vd[3 * ATT_VROW] = (unsigned short)(vv.y >> 16);
        vd[4 * ATT_VROW] = (unsigned short)(vv.z & 0xffffu); vd[5 * ATT_VROW] = (unsigned short)(vv.z >> 16);
        vd[6 * ATT_VROW] = (unsigned short)(vv.w & 0xffffu); vd[7 * ATT_VROW] = (unsigned short)(vv.w >> 16);
    }
    LDS_FENCE(); __syncthreads();
    const int head = h * 4 + (wave >> 1), r32 = lane & 31, hi = lane >> 5;
    const int lq = l0 + 32 * (wave & 1) + r32;
    const bool qvalid = lq < LL;
    const size_t Rq = (size_t)tok_row(b, qvalid ? lq : LL - 1);
    bf16x8 qf[4];
#pragma unroll
    for (int ks = 0; ks < 4; ++ks) qf[ks] = *(const bf16x8*)(Q + Rq * 512 + head * 64 + ks * 16 + 8 * hi);
    float mrun = sink[head], lsum = hi == 0 ? 1.0f : 0.0f;
    f32x16 o0, o1;
#pragma unroll
    for (int i = 0; i < 16; ++i) { o0[i] = 0.f; o1[i] = 0.f; }
    for (int slot = 0; slot < ntiles; ++slot) {
        const int kbase = slot == 0 ? 0 : (jlo + slot - 1) * 32;
        const LAS unsigned short* kt = Ks + slot * (ATT_KT / 2);
        f32x16 s;
#pragma unroll
        for (int i = 0; i < 16; ++i) s[i] = 0.f;
#pragma unroll
        for (int ks = 0; ks < 4; ++ks) {
            const bf16x8 kf = *(const LAS bf16x8*)(kt + r32 * ATT_KROW + ks * 16 + 8 * hi);
            s = __builtin_amdgcn_mfma_f32_32x32x16_bf16(kf, qf[ks], s, 0, 0, 0);
        }
        asm volatile("s_nop 15\n\ts_nop 15" : "+v"(s));
        float mt = -1e30f;
#pragma unroll
        for (int i = 0; i < 16; ++i) {
            const int lk = kbase + (i & 3) + 8 * (i >> 2) + 4 * hi;
            int d = lq - lk; d = d < 0 ? -d : d;
            const bool valid = (lk < NMETA) || (d <= 128 && lk < LL);
            s[i] = valid ? s[i] : -1e30f;
            mt = fmaxf(mt, s[i]);
        }
        mt = fmaxf(mt, __shfl_xor(mt, 32));
        const float mnew = fmaxf(mrun, mt);
        const float alpha = __expf(mrun - mnew);
        mrun = mnew;
        float ps = 0.f;
#pragma unroll
        for (int i = 0; i < 16; ++i) { s[i] = __expf(s[i] - mnew); ps += s[i]; }
        lsum = lsum * alpha + ps;
#pragma unroll
        for (int i = 0; i < 16; ++i) { o0[i] *= alpha; o1[i] *= alpha; }
        const LAS unsigned short* vt = Vs + slot * (ATT_VT / 2);
#pragma unroll
        for (int s2 = 0; s2 < 2; ++s2) {
            union { bf16x8 v; unsigned u[4]; } pf;
            pf.u[0] = pk2(s[8 * s2 + 0], s[8 * s2 + 1]); pf.u[1] = pk2(s[8 * s2 + 2], s[8 * s2 + 3]);
            pf.u[2] = pk2(s[8 * s2 + 4], s[8 * s2 + 5]); pf.u[3] = pk2(s[8 * s2 + 6], s[8 * s2 + 7]);
#pragma unroll
            for (int dt = 0; dt < 2; ++dt) {
                union { bf16x8 v; u32x2 u[2]; } vf;
                const LAS unsigned short* vp = vt + (dt * 32 + r32) * ATT_VROW + 16 * s2 + 4 * hi;
                vf.u[0] = *(const LAS u32x2*)(vp); vf.u[1] = *(const LAS u32x2*)(vp + 8);
                if (dt == 0) o0 = __builtin_amdgcn_mfma_f32_32x32x16_bf16(vf.v, pf.v, o0, 0, 0, 0);
                else o1 = __builtin_amdgcn_mfma_f32_32x32x16_bf16(vf.v, pf.v, o1, 0, 0, 0);
            }
        }
    }
    asm volatile("s_nop 15\n\ts_nop 15" : "+v"(o0), "+v"(o1));
    lsum += __shfl_xor(lsum, 32);
    const float inv = 1.0f / lsum;
    if (qvalid) {
#pragma unroll
        for (int g4 = 0; g4 < 4; ++g4) {
            u32x2 w0, w1;
            w0.x = pk2(o0[4 * g4] * inv, o0[4 * g4 + 1] * inv); w0.y = pk2(o0[4 * g4 + 2] * inv, o0[4 * g4 + 3] * inv);
            w1.x = pk2(o1[4 * g4] * inv, o1[4 * g4 + 1] * inv); w1.y = pk2(o1[4 * g4 + 2] * inv, o1[4 * g4 + 3] * inv);
            *(u32x2*)(YA + Rq * 512 + head * 64 + 8 * g4 + 4 * hi) = w0;
            *(u32x2*)(YA + Rq * 512 + head * 64 + 32 + 8 * g4 + 4 * hi) = w1;
        }
    }
    __syncthreads();
}

__device__ __forceinline__ void pool_diff(const bf16* PU, bf16* PD) {
    int tl_ = threadIdx.x; asm volatile("" : "+v"(tl_)); const int gt = blockIdx.x * 512 + tl_, NGT = gridDim.x * 512;
    for (int i = gt; i < NB * LL * 64; i += NGT) {
        const int ch = i & 63, tk = i >> 6, b = tk / LL, l = tk % LL;
        const int half = 1 << (ch >> 4);
        const int lo = l - half < 0 ? 0 : l - half, hh = l + half > LL ? LL : l + half;
        float s[8];
#pragma unroll
        for (int j = 0; j < 8; ++j) s[j] = 0.f;
        for (int lp = lo; lp < hh; ++lp) {
            const u32x4 v = *(const u32x4*)(PU + (size_t)tok_row(b, lp) * 512 + ch * 8);
            s[0] += bf2f(v.x & 0xffffu); s[1] += bf2f(v.x >> 16); s[2] += bf2f(v.y & 0xffffu); s[3] += bf2f(v.y >> 16);
            s[4] += bf2f(v.z & 0xffffu); s[5] += bf2f(v.z >> 16); s[6] += bf2f(v.w & 0xffffu); s[7] += bf2f(v.w >> 16);
        }
        const float ic = 1.0f / (float)(hh - lo);
        const size_t R = (size_t)tok_row(b, l);
        const u32x4 v = *(const u32x4*)(PU + R * 512 + ch * 8);
        u32x4 o;
        o.x = pk2(s[0] * ic - bf2f(v.x & 0xffffu), s[1] * ic - bf2f(v.x >> 16)); o.y = pk2(s[2] * ic - bf2f(v.y & 0xffffu), s[3] * ic - bf2f(v.y >> 16));
        o.z = pk2(s[4] * ic - bf2f(v.z & 0xffffu), s[5] * ic - bf2f(v.z >> 16)); o.w = pk2(s[6] * ic - bf2f(v.w & 0xffffu), s[7] * ic - bf2f(v.w >> 16));
        *(u32x4*)(PD + R * 512 + ch * 8) = o;
    }
}

__device__ __forceinline__ void z_pass(const float* YF, const bf16* SU, const float* dskip, bf16* Z) {
    int tl_ = threadIdx.x; asm volatile("" : "+v"(tl_)); const int gt = blockIdx.x * 512 + tl_, NGT = gridDim.x * 512;
    for (int i = gt; i < NB * LL * 64; i += NGT) {
        const int ch = i & 63, tk = i >> 6, b = tk / LL, l = tk % LL, g = ch >> 1;
        const size_t R = (size_t)tok_row(b, l);
        const bf16* yp = (const bf16*)YF + ((size_t)(b * 32 + g) * LL + l) * 16 + (ch & 1) * 8;
        const u32x4 ya = *(const u32x4*)yp, yb = *(const u32x4*)(yp + (size_t)256 * LL * 16);
        f32x4 y0, y1;
        y0[0] = bf2f(ya.x & 0xffffu) + bf2f(yb.x & 0xffffu); y0[1] = bf2f(ya.x >> 16) + bf2f(yb.x >> 16); y0[2] = bf2f(ya.y & 0xffffu) + bf2f(yb.y & 0xffffu); y0[3] = bf2f(ya.y >> 16) + bf2f(yb.y >> 16);
        y1[0] = bf2f(ya.z & 0xffffu) + bf2f(yb.z & 0xffffu); y1[1] = bf2f(ya.z >> 16) + bf2f(yb.z >> 16); y1[2] = bf2f(ya.w & 0xffffu) + bf2f(yb.w & 0xffffu); y1[3] = bf2f(ya.w >> 16) + bf2f(yb.w >> 16);
        const f32x4 d0 = *(const f32x4*)(dskip + ch * 8), d1 = *(const f32x4*)(dskip + ch * 8 + 4);
        const u32x4 uu = *(const u32x4*)(SU + R * 512 + ch * 8);
        float t[8];
        t[0] = y0[0] + d0[0] * bf2f(uu.x & 0xffffu); t[1] = y0[1] + d0[1] * bf2f(uu.x >> 16); t[2] = y0[2] + d0[2] * bf2f(uu.y & 0xffffu); t[3] = y0[3] + d0[3] * bf2f(uu.y >> 16);
        t[4] = y1[0] + d1[0] * bf2f(uu.z & 0xffffu); t[5] = y1[1] + d1[1] * bf2f(uu.z >> 16); t[6] = y1[2] + d1[2] * bf2f(uu.w & 0xffffu); t[7] = y1[3] + d1[3] * bf2f(uu.w >> 16);
#pragma unroll
        for (int j = 0; j < 8; ++j) t[j] = 0.5f * t[j] * (1.0f + erff(t[j] * 0.70710678118654752f));
        u32x4 o; o.x = pk2(t[0], t[1]); o.y = pk2(t[2], t[3]); o.z = pk2(t[4], t[5]); o.w = pk2(t[6], t[7]);
        *(u32x4*)(Z + R * 512 + ch * 8) = o;
    }
}

#define XB_TMO      128
#define XB_XCNT(j)  (256  + 64 * (j))
#define XB_XSUB(j)  (1280 + 64 * (j))
#define XB_XGEN(j)  (2304 + 64 * (j))
#define XB_TOP      3328
#define XB_TOPGEN   3392
#define XCD_BAR_WORDS 3456
#define XB_SPIN_CAP (1u << 18)

__device__ __forceinline__ unsigned xb_ld(unsigned* p)              { return __hip_atomic_load(p, __ATOMIC_RELAXED, __HIP_MEMORY_SCOPE_AGENT); }
__device__ __forceinline__ unsigned xb_add(unsigned* p, unsigned v) { return __hip_atomic_fetch_add(p, v, __ATOMIC_RELAXED, __HIP_MEMORY_SCOPE_AGENT); }
__device__ __forceinline__ unsigned xb_xcc_id() { return (unsigned)__builtin_amdgcn_s_getreg((3 << 11) | 20) & 0xFu; }
#define XB_SPIN(cond, bar) do { unsigned _sp = 0; while (cond) { __builtin_amdgcn_s_sleep(1); \
    if ((++_sp & 255u) == 0u) { if (xb_ld(&(bar)[XB_TMO])) break; if (_sp > XB_SPIN_CAP) { atomicAdd(&(bar)[XB_TMO], 1u); break; } } } } while (0)

struct XcdBarrier {
    unsigned* bar; unsigned x;
    volatile LAS unsigned* st;
};

__device__ __forceinline__ XcdBarrier xcd_barrier_post(unsigned* bar, volatile LAS unsigned* st) {
    XcdBarrier b; b.bar = bar; b.x = xb_xcc_id(); b.st = st;
    if (threadIdx.x == 0) (void)xb_add(&bar[XB_XCNT(b.x)], 1u);
    return b;
}
__device__ __forceinline__ void xcd_barrier_complete(unsigned* bar, unsigned x, unsigned& nloc, unsigned& nx) {
    const unsigned G = gridDim.x * gridDim.y * gridDim.z;
    unsigned sum, cnt, mine, sp = 0u;
    for (;;) {
        sum = 0u; cnt = 0u; mine = 0u;
#pragma unroll
        for (unsigned j = 0; j < 16; ++j) { const unsigned c = xb_ld(&bar[XB_XCNT(j)]); sum += c; cnt += (c > 0u) ? 1u : 0u; mine = (j == x) ? c : mine; }
        if (sum == G) break;
        __builtin_amdgcn_s_sleep(1);
        if ((++sp & 255u) == 0u) { if (xb_ld(&bar[XB_TMO])) break; if (sp > XB_SPIN_CAP) { atomicAdd(&bar[XB_TMO], 1u); break; } }
    }
    nloc = mine > 0u ? mine : 1u; nx = cnt > 0u ? cnt : 1u;
}

__device__ __forceinline__ void xcd_barrier(const XcdBarrier& b) {
    asm volatile("s_waitcnt vmcnt(0)" ::: "memory");
    __syncthreads();
    if (threadIdx.x == 0) {
        unsigned* bar = b.bar;
        __builtin_amdgcn_s_waitcnt(0);
        unsigned nloc = b.st[0], nx = b.st[1];
        if (nloc == 0u) { xcd_barrier_complete(bar, b.x, nloc, nx); b.st[0] = nloc; b.st[1] = nx; }
        const unsigned old = xb_add(&bar[XB_XSUB(b.x)], 1u);
        const unsigned gen = old / nloc;
        if (old + 1u == (gen + 1u) * nloc) {
            __builtin_amdgcn_fence(__ATOMIC_RELEASE, "agent");
            asm volatile("s_waitcnt vmcnt(0)" ::: "memory");
            const unsigned og = xb_add(&bar[XB_TOP], 1u);
            const unsigned tg = og / nx;
            if (og + 1u == (tg + 1u) * nx) xb_add(&bar[XB_TOPGEN], 1u);
            else XB_SPIN(xb_ld(&bar[XB_TOPGEN]) == tg, bar);
            __builtin_amdgcn_fence(__ATOMIC_ACQUIRE, "agent");
            xb_add(&bar[XB_XGEN(b.x)], 1u);
            asm volatile("s_waitcnt vmcnt(0)" ::: "memory");
        } else {
            XB_SPIN(xb_ld(&bar[XB_XGEN(b.x)]) == gen, bar);
            __builtin_amdgcn_fence(__ATOMIC_ACQUIRE, "agent");
            asm volatile("s_waitcnt vmcnt(0)" ::: "memory");
        }
    }
    __syncthreads();
}

#ifndef MK_ALIGN
#define MK_ALIGN true
#endif
#ifndef MK_SP2
#define MK_SP2 true
#endif
#ifndef MK_SPLIT
#define MK_SPLIT 0
#endif
constexpr int NPL = 8, NPHASE = 1 + 2 * NPL + 1, PH_FINAL = NPHASE - 1;

typedef const __attribute__((address_space(4))) Args* KArgsP;
#define KARGS() ({ auto kp_ = __builtin_amdgcn_kernarg_segment_ptr(); asm volatile("" : "+s"(kp_)); (KArgsP)kp_; })
__global__ void __launch_bounds__(512, 2) fwd_kernel(Args a_unused, int ph_lo, int ph_hi) {
    (void)a_unused;
    extern __shared__ __attribute__((aligned(16))) unsigned char lds_raw[];
    LAS unsigned char* lds = (LAS unsigned char*)lds_raw;
    const int G = gridDim.x, bid = blockIdx.x;
#if MK_SPLIT
#define GRID_SYNC() do {} while (0)
    (void)lds;
#else
#define CG_SYNC() do { asm volatile("s_waitcnt vmcnt(0)" ::: "memory"); __syncthreads(); \
    if (threadIdx.x == 0) { __builtin_amdgcn_fence(__ATOMIC_RELEASE, "agent"); asm volatile("s_waitcnt vmcnt(0)" ::: "memory"); } \
    __syncthreads(); grid.sync(); \
    if (threadIdx.x == 0) { __builtin_amdgcn_fence(__ATOMIC_ACQUIRE, "agent"); asm volatile("s_waitcnt vmcnt(0)" ::: "memory"); } \
    __syncthreads(); } while (0)
    cg::grid_group grid = cg::this_grid();
    unsigned* barw = (unsigned*)(KARGS()->ws + WS_CTL);
    if (bid == 0) for (int i = threadIdx.x; i < XCD_BAR_WORDS; i += 512) __hip_atomic_store(barw + i, 0u, __ATOMIC_RELAXED, __HIP_MEMORY_SCOPE_AGENT);
    volatile LAS unsigned* xst = (volatile LAS unsigned*)(lds + 131072 + 64);
    if (threadIdx.x < 2) xst[threadIdx.x] = 0u;
    CG_SYNC();
    const XcdBarrier xbar = xcd_barrier_post(barw, xst);
#define GRID_SYNC() xcd_barrier(xbar)

#endif
#ifndef PHMASK
#define PHMASK 0xFFFFu
#endif
#define IN(k) (((PHMASK >> ((k) == 0 ? 0 : (k) == PH_FINAL ? 9 : 1 + ((k) - 1) % NPL)) & 1u) && ph_lo <= (k) && (k) < ph_hi)
#define SEAM(k) do { if (IN(k) && (k) + 1 < ph_hi) GRID_SYNC(); } while (0)
#define PHASE_BEGIN() KArgsP ka = KARGS(); unsigned char* ws = ka->ws; asm volatile("" : "+s"(ws)); float* rowss = (float*)(ws + WS_RS); float* Hm = (float*)(ws + WS_HM); bf16* HB = (bf16*)(ws + WS_HB); unsigned char* wl = ws + WS_W + (size_t)layer * LW_BYTES; \
    const int MT = NREAL; const bool META = layer != MK_NLAYER - 1;     \
    const float* rs_mix = rowss + (size_t)(2 * layer) * TPR * 16; float* rs_mlp = rowss + (size_t)(2 * layer + 1) * TPR * 16; float* rs_next = rowss + (size_t)(2 * layer + 2) * TPR * 16; (void)MT; (void)META; (void)Hm; (void)HB; (void)wl; (void)rs_mix; (void)rs_mlp; (void)rs_next;

    if (IN(0)) { Args al; { KArgsP kp = KARGS(); for (int i = 0; i < 23; ++i) al.in[i] = kp->in[i]; al.out = kp->out; al.ws = kp->ws; } p0_prologue(al, lds); }
    SEAM(0);
#ifndef MK_NLAYER
#define MK_NLAYER 2
#endif
#ifndef MK_RSIDX
#define MK_RSIDX 4
#endif
#pragma unroll 1
    for (int layer = 0; layer < MK_NLAYER; ++layer) {
        const int p = 1 + NPL * layer;
        if (IN(p)) { PHASE_BEGIN();
            pg8::Gemm g{HB, (const bf16*)(wl + OW_IN), TPR, NPROJ, DM}; pg8::StaticOrder S; S.init(TPR, NPROJ, G, bid);
            EpiInProj E{rs_mix, (const float*)(ws + WS_ROPE), (bf16*)(ws + WS_Q), (bf16*)(ws + WS_K), (bf16*)(ws + WS_V), (bf16*)(ws + WS_SU), (bf16*)(ws + WS_PU)};
            pg8::gemm_phase<EpiInProj, pg8::StaticOrder, MK_ALIGN, MK_SP2>(lds, g, S, E);
        }
        SEAM(p);
        if (IN(p + 1)) { PHASE_BEGIN();
            for (int t = bid; t < 256; t += G)
                ssm_task(lds, t, layer, (const bf16*)(ws + WS_SU), (float*)(ws + WS_YF), (const float*)(ws + WS_ABAR), (const bf16*)(ws + WS_BMAT), (const bf16*)(ws + WS_CMAT));
            for (int t = bid; t < NB * 2 * 33; t += G)
                attn_task(lds, t, (const bf16*)(ws + WS_Q), (const bf16*)(ws + WS_K), (const bf16*)(ws + WS_V), (bf16*)(ws + WS_YA), ka->in[4] + layer * 8);
            pool_diff((const bf16*)(ws + WS_PU), (bf16*)(ws + WS_PD));
        }
        SEAM(p + 1);
        if (IN(p + 2)) { PHASE_BEGIN();
            z_pass((const float*)(ws + WS_YF), (const bf16*)(ws + WS_SU), ka->in[12] + layer * 512, (bf16*)(ws + WS_Z));
        }
        SEAM(p + 2);
        if (IN(p + 3)) { PHASE_BEGIN();
            { pg8::Gemm g{(const bf16*)(ws + WS_Z), (const bf16*)(wl + OW_GLU), MT, 512, 512}; pg8::StaticOrder S; S.init(MT, 512, G, bid);
              EpiGlu E{(const bf16*)(ws + WS_Z), ka->in[14] + layer * 512, (bf16*)(ws + WS_YS)};
              pg8::gemm_phase<EpiGlu, pg8::StaticOrder, MK_ALIGN, MK_SP2>(lds, g, S, E); if (META) thin_gemm<EpiGlu>(lds, g.A, g.Bt, g.K, g.N, E); }
            { pg8::Gemm g{(const bf16*)(ws + WS_PD), (const bf16*)(wl + OW_POOL), MT, 512, 512}; pg8::StaticOrder S; S.init(MT, 512, G, bid);
              EpiScale E{(bf16*)(ws + WS_YP), 512, ka->in[16] + layer * 512};
              pg8::gemm_phase<EpiScale, pg8::StaticOrder, MK_ALIGN, MK_SP2>(lds, g, S, E); if (META) thin_gemm<EpiScale>(lds, g.A, g.Bt, g.K, g.N, E); }
        }
        SEAM(p + 3);
        if (IN(p + 4)) { PHASE_BEGIN();
#pragma unroll 1
            for (int c = 0; c < 3; ++c) {
                const bf16* Yc = (const bf16*)(ws + (c == 0 ? WS_YA : c == 1 ? WS_YS : WS_YP));
                { pg8::Gemm g{Yc, (const bf16*)(wl + OW_BR) + (size_t)c * 1024 * 512, MT, 1024, 512}; pg8::StaticOrder S; S.init(MT, 1024, G, bid);
                  EpiScale E{(bf16*)(ws + WS_BR), 1024, nullptr};
                  pg8::gemm_phase<EpiScale, pg8::StaticOrder, MK_ALIGN, MK_SP2>(lds, g, S, E); if (META) thin_gemm<EpiScale>(lds, g.A, g.Bt, g.K, g.N, E); }
                pg8::Gemm g{HB, (const bf16*)(wl + OW_IN) + (size_t)(NPROJ + c * 1024) * DM, MT, 1024, DM}; pg8::StaticOrder S; S.init(MT, 1024, G, bid);
                if (c == 0) { EpiGate<true> E{rs_mix, (const bf16*)(ws + WS_BR), (bf16*)(ws + WS_MG)}; pg8::gemm_phase<EpiGate<true>, pg8::StaticOrder, MK_ALIGN, MK_SP2>(lds, g, S, E); if (META) thin_gemm<EpiGate<true>>(lds, g.A, g.Bt, g.K, g.N, E); }
                else { EpiGate<false> E{rs_mix, (const bf16*)(ws + WS_BR), (bf16*)(ws + WS_MG)}; pg8::gemm_phase<EpiGate<false>, pg8::StaticOrder, MK_ALIGN, MK_SP2>(lds, g, S, E); if (META) thin_gemm<EpiGate<false>>(lds, g.A, g.Bt, g.K, g.N, E); }
            }
        }
        SEAM(p + 4);
        if (IN(p + 5)) { PHASE_BEGIN();
            pg8::Gemm g{(const bf16*)(ws + WS_MG), (const bf16*)(wl + OW_OUT), MT, DM, DM}; pg8::StaticOrder S; S.init(MT, DM, G, bid);
            EpiRes E{ka->out, Hm, HB, rs_mlp};
            pg8::gemm_phase<EpiRes, pg8::StaticOrder, MK_ALIGN, MK_SP2>(lds, g, S, E); if (META) thin_gemm<EpiRes>(lds, g.A, g.Bt, g.K, g.N, E);
        }
        SEAM(p + 5);
        if (IN(p + 6)) { PHASE_BEGIN();
            pg8::Gemm g{HB, (const bf16*)(wl + OW_UP), MT, FF, DM}; pg8::StaticOrder S; S.init(MT, FF, G, bid);
            EpiUp E{rs_mlp, (bf16*)(ws + WS_ACT)};
            pg8::gemm_phase<EpiUp, pg8::StaticOrder, MK_ALIGN, MK_SP2>(lds, g, S, E); if (META) thin_gemm<EpiUp>(lds, g.A, g.Bt, g.K, g.N, E);
        }
        SEAM(p + 6);
        if (IN(p + 7)) { PHASE_BEGIN();
            pg8::Gemm g{(const bf16*)(ws + WS_ACT), (const bf16*)(wl + OW_DN), MT, DM, FF}; pg8::StaticOrder S; S.init(MT, DM, G, bid);
            EpiRes E{ka->out, Hm, HB, rs_next};
            pg8::gemm_phase<EpiRes, pg8::StaticOrder, MK_ALIGN, MK_SP2>(lds, g, S, E); if (META) thin_gemm<EpiRes>(lds, g.A, g.Bt, g.K, g.N, E);
        }
        SEAM(p + 7);
    }
#ifdef MK_DUMP_OFF
    if (IN(PH_FINAL)) { KArgsP ka = KARGS();
        const bf16* src = (const bf16*)(ka->ws + (MK_DUMP_OFF)); const bf16* src2 = (const bf16*)(ka->ws + (MK_DUMP_OFF2));
        for (int i = bid * 512 + threadIdx.x; i < NREAL * 1024; i += G * 512) { const int R = MK_DUMP_ROW(i >> 10), c = i & 1023; ka->out[i] = c < 512 ? bf2f(src[(size_t)R * (MK_DUMP_LD) + (c % (MK_DUMP_LD))]) : bf2f(src2[(size_t)R * (MK_DUMP_LD2) + (c % (MK_DUMP_LD2))]); }
    }
#else
    if (IN(PH_FINAL)) { KArgsP ka = KARGS();
        const float* rs = (const float*)(ka->ws + WS_RS) + (size_t)MK_RSIDX * TPR * 16; const float* gain = ka->in[22];
        int tl_ = threadIdx.x; asm volatile("" : "+v"(tl_));
        for (int i = bid * 512 + tl_; i < NREAL * 256; i += G * 512) {
            const int R = i >> 8, c4 = (i & 255) * 4;
            const float r = row_rstd(rs, R);
            f32x4 v = *(const f32x4*)(ka->out + (size_t)R * DM + c4); const f32x4 gn = *(const f32x4*)(gain + c4);
            v = v * r * gn;
            *(f32x4*)(ka->out + (size_t)R * DM + c4) = v;
        }
    }
#endif
#undef IN
#undef SEAM
}

extern "C" void kernel_launch(void* const* d_in, const int* in_sizes, int n_in, void* d_out, int out_size, void* d_ws, size_t ws_size, hipStream_t stream) {
    static int grid = 0;
    if (grid == 0) {
        if (n_in != 23 || out_size != NREAL * DM || ws_size < WS_END) { fprintf(stderr, "kernel_launch: unexpected shapes (n_in %d out %d ws %zu)\n", n_in, out_size, ws_size); grid = -1; return; }
        int dev = 0, cus = 0, per_cu = 0;
        hipGetDevice(&dev); hipDeviceGetAttribute(&cus, hipDeviceAttributeMultiprocessorCount, dev);
        if (hipFuncSetAttribute((const void*)fwd_kernel, hipFuncAttributeMaxDynamicSharedMemorySize, LDS_BYTES) != hipSuccess) { fprintf(stderr, "kernel_launch: hipFuncSetAttribute failed\n"); grid = -1; return; }
        if (hipOccupancyMaxActiveBlocksPerMultiprocessor(&per_cu, (const void*)fwd_kernel, 512, LDS_BYTES) != hipSuccess || per_cu < 1) { fprintf(stderr, "kernel_launch: occupancy query gave %d\n", per_cu); per_cu = 1; }
        (void)hipGetLastError();
        grid = cus * (per_cu > 1 ? 1 : per_cu);
        if (grid <= 0) grid = 256;
    }
    if (grid < 0) return;
    Args a{};
    for (int i = 0; i < 23; ++i) a.in[i] = (const float*)d_in[i];
    a.out = (float*)d_out; a.ws = (unsigned char*)d_ws;
#if MK_SPLIT
    for (int ph = 0; ph < NPHASE; ++ph) hipLaunchKernelGGL(fwd_kernel, dim3(grid), dim3(512), LDS_BYTES, stream, a, ph, ph + 1);
#else
    int lo = 0, hi = NPHASE;
    void* kargs[] = {(void*)&a, (void*)&lo, (void*)&hi};
    hipError_t e = hipLaunchCooperativeKernel((const void*)fwd_kernel, dim3(grid), dim3(512), kargs, LDS_BYTES, stream);
    if (e != hipSuccess) fprintf(stderr, "kernel_launch: cooperative launch failed: %s (grid %d)\n", hipGetErrorString(e), grid);
#endif
}
```

```cpp
#include <hip/hip_runtime.h>
#include <hip/hip_cooperative_groups.h>
#include <cstdio>
#include <cstdint>
namespace cg = cooperative_groups;
namespace pg8 {
#define PG8_LAS __attribute__((address_space(3)))
typedef unsigned short bf16_t;
typedef short bf16x8 __attribute__((ext_vector_type(8)));
typedef float f32x4 __attribute__((ext_vector_type(4)));
typedef unsigned u32x4 __attribute__((ext_vector_type(4)));
constexpr int BM = 256, BK = 64, HALF = 128, HTB = HALF * BK * 2  , STAGE_BYTES = 8 * HTB, NXCD = 8, WGM = 8;

__host__ __device__ __forceinline__ int lds_byte(int r, int c) { const int st = (r >> 4) * 2 + (c >> 5), rr = r & 15, cc = c & 31, ob = rr * 64 + cc * 2; return st * 1024 + (ob ^ (((ob >> 9) & 1) << 5)); }
__host__ __device__ __forceinline__ void stage_rc(int b, int& R, int& C) { const int st = b / 1024, sb = b % 1024, swz = sb ^ (((sb >> 9) & 1) << 5); R = (st >> 1) * 16 + swz / 64; C = (st & 1) * 32 + (swz % 64) / 2; }
__host__ __device__ __forceinline__ int perm32(int rho) { const int n = rho >> 4, i = rho & 15; return 8 * (i >> 2) + 4 * n + (i & 3); }

struct Unit { int pm, pn; };
struct Gemm { const bf16_t* A; const bf16_t* Bt; int M, N, K; };

struct StaticOrder {
    int nM, nN, nwg, G, c;
    __host__ __device__ void init(int M, int N, int G_, int c_) { nM = M / BM; nN = N / BM; nwg = nM * nN; G = G_; c = c_; }
    __host__ __device__ bool next(int i, Unit& u) const {
        const long L = (long)i * G + c; if (L >= nwg) return false;
        int wgid = (int)L; { const int q = nwg / NXCD, r = nwg % NXCD, xcd = wgid % NXCD, off = wgid / NXCD; wgid = (xcd < r ? xcd * (q + 1) : r * (q + 1) + (xcd - r) * q) + off; }
        const int nig = WGM * nN, gid = wgid / nig, fm = gid * WGM, gsz = (nM - fm) < WGM ? (nM - fm) : WGM;
        u.pm = fm + ((wgid % nig) % gsz); u.pn = (wgid % nig) / gsz; return true;
    }
    __device__ __forceinline__ void a_ready(const Unit&) const {}
    __device__ __forceinline__ void done(const Unit&) const {}
};

__device__ __forceinline__ unsigned cvt_pk_bf16(float lo, float hi) { unsigned r; asm volatile("v_cvt_pk_bf16_f32 %0, %1, %2" : "=v"(r) : "v"(lo), "v"(hi)); return r; }
template <class Epi, class Sched, bool ALIGN_EPI = false, bool SP2 = false>
__device__ __forceinline__ void gemm_phase(PG8_LAS unsigned char* lds, const Gemm g, const Sched& S, const Epi& E) {
    int tid_l = threadIdx.x; asm volatile("" : "+v"(tid_l));
    const int tid = tid_l, wid = __builtin_amdgcn_readfirstlane(tid >> 6), lane = tid & 63, wr = wid >> 2, wc = wid & 3, fr = lane & 15, fq = lane >> 4;
    const int K = g.K, nt = K / BK;
    unsigned voffA[2], voffB[2];
#pragma unroll
    for (int i = 0; i < 2; ++i) { int R, C; stage_rc(tid * 16 + i * 8192, R, C); const int Rb = Epi::PERM ? ((R & ~31) + perm32(R & 31)) : R;
        voffA[i] = (unsigned)(R * K + C) * 2u; voffB[i] = (unsigned)(Rb * K + C) * 2u; }
    const size_t kstep = (size_t)(BK * 2);
    const size_t hstep = (size_t)HALF * K * 2;
    const size_t tstep = 2 * hstep;
    const unsigned ldsw = (unsigned)wid * 1024u;
    const int aoff = lds_byte(wr * 64 + fr, fq * 8), boff = lds_byte(wc * 32 + fr, fq * 8);
#define PG8_SA(b, h) (((b) * 2 + (h)) * HTB)
#define PG8_SB(b, h) ((4 + (b) * 2 + (h)) * HTB)
#define PG8_STAGE(bufoff, gbase, voff) do { _Pragma("unroll") for (int _i = 0; _i < 2; ++_i) \
        __builtin_amdgcn_global_load_lds((const unsigned*)((const char*)(gbase) + (voff)[_i]), (PG8_LAS unsigned*)(lds + (bufoff) + ldsw + _i * 8192), 16, 0, 0); } while (0)
#define PG8_LDA(dst, b, h) do { _Pragma("unroll") for (int m = 0; m < 4; ++m) _Pragma("unroll") for (int k = 0; k < 2; ++k) dst[m][k] = *(const PG8_LAS bf16x8*)(lds + PG8_SA(b, h) + aoff + m * 2048 + k * 1024); } while (0)
#define PG8_LDB(dst, b, h) do { _Pragma("unroll") for (int n = 0; n < 2; ++n) _Pragma("unroll") for (int k = 0; k < 2; ++k) dst[n][k] = *(const PG8_LAS bf16x8*)(lds + PG8_SB(b, h) + boff + n * 2048 + k * 1024); } while (0)
#define PG8_MMA(ai, bj, At, Bt) do { __builtin_amdgcn_s_setprio(1); _Pragma("unroll") for (int m = 0; m < 4; ++m) _Pragma("unroll") for (int n = 0; n < 2; ++n) _Pragma("unroll") for (int k = 0; k < 2; ++k) \
        acc[ai][bj][m][n] = __builtin_amdgcn_mfma_f32_16x16x32_bf16(Bt[n][k], At[m][k], acc[ai][bj][m][n], 0, 0, 0); __builtin_amdgcn_s_setprio(0); } while (0)
#define PG8_WAIT_V(n) asm volatile("s_waitcnt vmcnt(" #n ")" ::: "memory")
#define PG8_WAIT_L(n) asm volatile("s_waitcnt lgkmcnt(" #n ")" ::: "memory")
#define PG8_BAR __builtin_amdgcn_s_barrier()
#define PG8_SCHED __builtin_amdgcn_sched_barrier(0)
    Unit cur, nxt; int ui = 0;
    if (!S.next(0, cur)) return;
    f32x4 acc[2][2][4][2];
#pragma unroll
    for (int a = 0; a < 2; ++a)
#pragma unroll
        for (int b = 0; b < 2; ++b)
#pragma unroll
            for (int m = 0; m < 4; ++m)
#pragma unroll
                for (int n = 0; n < 2; ++n) acc[a][b][m][n] = (f32x4){0.f, 0.f, 0.f, 0.f};
    bf16x8 At[4][2], B0[2][2], B1[2][2];
    const char* cA = (const char*)g.A + (size_t)cur.pm * tstep; const char* cB = (const char*)g.Bt + (size_t)cur.pn * tstep;
    S.a_ready(cur);
    if constexpr (SP2) {
        PG8_STAGE(PG8_SB(0, 0), cB, voffB); PG8_STAGE(PG8_SB(0, 1), cB + hstep, voffB); PG8_STAGE(PG8_SA(0, 0), cA, voffA); PG8_STAGE(PG8_SA(0, 1), cA + hstep, voffA);
        if (wr == 1) PG8_BAR;
        PG8_WAIT_V(2); PG8_BAR;
        PG8_STAGE(PG8_SB(1, 0), cB + kstep, voffB); PG8_STAGE(PG8_SA(1, 0), cA + kstep, voffA); PG8_STAGE(PG8_SB(1, 1), cB + hstep + kstep, voffB);
        PG8_WAIT_V(6); PG8_BAR;
    } else {
        PG8_STAGE(PG8_SB(0, 0), cB, voffB); PG8_STAGE(PG8_SA(0, 0), cA, voffA); PG8_STAGE(PG8_SB(0, 1), cB + hstep, voffB); PG8_STAGE(PG8_SA(0, 1), cA + hstep, voffA);
        if (wr == 1) PG8_BAR;
        PG8_WAIT_V(4); PG8_BAR;
        PG8_STAGE(PG8_SB(1, 0), cB + kstep, voffB); PG8_STAGE(PG8_SA(1, 0), cA + kstep, voffA); PG8_STAGE(PG8_SB(1, 1), cB + hstep + kstep, voffB);
        PG8_WAIT_V(6); PG8_BAR;
    }
    for (;;) {
        const bool has_next = S.next(ui + 1, nxt);
        const char* nA = has_next ? (const char*)g.A + (size_t)nxt.pm * tstep : cA; const char* nB = has_next ? (const char*)g.Bt + (size_t)nxt.pn * tstep : cB;
        for (int t = 0; t < nt; t += 2) {
            const bool last = (t == nt - 2);
            const char* a1 = cA + (size_t)(t + 1) * kstep;
            const char* a2 = last ? nA : cA + (size_t)(t + 2) * kstep; const char* b2 = last ? nB : cB + (size_t)(t + 2) * kstep;
            const char* a3 = a2 + kstep; const char* b3 = b2 + kstep;
            if (last && has_next) S.a_ready(nxt);
            if constexpr (SP2) {
            PG8_LDB(B0, 0, 0); PG8_LDB(B1, 0, 1); PG8_SCHED; PG8_LDA(At, 0, 0); PG8_STAGE(PG8_SA(1, 1), a1 + hstep, voffA);
            PG8_WAIT_V(8); PG8_WAIT_L(0); PG8_BAR; PG8_MMA(0, 0, At, B0); PG8_MMA(0, 1, At, B1); PG8_BAR; PG8_SCHED;
            PG8_LDA(At, 0, 1); PG8_STAGE(PG8_SB(0, 0), b2, voffB); PG8_STAGE(PG8_SB(0, 1), b2 + hstep, voffB); PG8_STAGE(PG8_SA(0, 0), a2, voffA);
            PG8_WAIT_V(8); PG8_WAIT_L(0); PG8_BAR; PG8_MMA(1, 0, At, B0); PG8_MMA(1, 1, At, B1); PG8_BAR; PG8_SCHED;
            PG8_LDB(B0, 1, 0); PG8_LDB(B1, 1, 1); PG8_SCHED; PG8_LDA(At, 1, 0); PG8_STAGE(PG8_SA(0, 1), a2 + hstep, voffA);
            PG8_WAIT_V(8); PG8_WAIT_L(0); PG8_BAR; PG8_MMA(0, 0, At, B0); PG8_MMA(0, 1, At, B1); PG8_BAR; PG8_SCHED;
            PG8_LDA(At, 1, 1); PG8_STAGE(PG8_SB(1, 0), b3, voffB); PG8_STAGE(PG8_SB(1, 1), b3 + hstep, voffB); PG8_STAGE(PG8_SA(1, 0), a3, voffA);
            PG8_WAIT_V(8); PG8_WAIT_L(0); PG8_BAR; PG8_MMA(1, 0, At, B0); PG8_MMA(1, 1, At, B1); PG8_BAR; PG8_SCHED;
            } else {
            PG8_LDB(B0, 0, 0); PG8_SCHED; PG8_LDA(At, 0, 0); PG8_STAGE(PG8_SA(1, 1), a1 + hstep, voffA);
            PG8_WAIT_L(8); PG8_BAR; PG8_WAIT_L(0); PG8_MMA(0, 0, At, B0); PG8_BAR; PG8_SCHED;
            PG8_LDB(B1, 0, 1); PG8_STAGE(PG8_SB(0, 0), b2, voffB);
            PG8_BAR; PG8_WAIT_L(0); PG8_MMA(0, 1, At, B1); PG8_BAR;
            PG8_LDA(At, 0, 1); PG8_STAGE(PG8_SA(0, 0), a2, voffA);
            PG8_BAR; PG8_WAIT_L(0); PG8_MMA(1, 0, At, B0); PG8_BAR; PG8_SCHED;
            PG8_STAGE(PG8_SB(0, 1), b2 + hstep, voffB);
            PG8_WAIT_V(6); PG8_BAR; PG8_MMA(1, 1, At, B1); PG8_BAR;
            PG8_LDB(B0, 1, 0); PG8_SCHED; PG8_LDA(At, 1, 0); PG8_STAGE(PG8_SA(0, 1), a2 + hstep, voffA);
            PG8_WAIT_L(8); PG8_BAR; PG8_WAIT_L(0); PG8_MMA(0, 0, At, B0); PG8_BAR; PG8_SCHED;
            PG8_LDB(B1, 1, 1); PG8_STAGE(PG8_SB(1, 0), b3, voffB);
            PG8_BAR; PG8_WAIT_L(0); PG8_MMA(0, 1, At, B1); PG8_BAR;
            PG8_LDA(At, 1, 1); PG8_STAGE(PG8_SA(1, 0), a3, voffA);
            PG8_BAR; PG8_WAIT_L(0); PG8_MMA(1, 0, At, B0); PG8_BAR; PG8_SCHED;
            PG8_STAGE(PG8_SB(1, 1), b3 + hstep, voffB);
            PG8_WAIT_V(6); PG8_BAR; PG8_MMA(1, 1, At, B1); PG8_BAR;
            }
        }
        if constexpr (ALIGN_EPI) { if (wr == 0) PG8_BAR; }
        asm volatile("s_nop 15\n\ts_nop 15" ::: "memory");
        if constexpr (!Epi::AFTER_DRAIN) { E(acc, cur, wr, wc, fr, fq); S.done(cur); }
        if (!has_next) break;
#pragma unroll
        for (int a = 0; a < 2; ++a)
#pragma unroll
            for (int b = 0; b < 2; ++b)
#pragma unroll
                for (int m = 0; m < 4; ++m)
#pragma unroll
                    for (int n = 0; n < 2; ++n) acc[a][b][m][n] = (f32x4){0.f, 0.f, 0.f, 0.f};
        cur = nxt; cA = nA; cB = nB; ++ui;
        if constexpr (ALIGN_EPI) { if (wr == 1) PG8_BAR; }
    }
    PG8_WAIT_V(0);
    if constexpr (!ALIGN_EPI) { if (wr == 0) PG8_BAR; }
    PG8_BAR;
    if constexpr (Epi::AFTER_DRAIN) { E.fused(acc, cur, wr, wc, fr, fq, lds, wid, lane); S.done(cur); }
#undef PG8_SA
#undef PG8_SB
#undef PG8_STAGE
#undef PG8_LDA
#undef PG8_LDB
#undef PG8_MMA
#undef PG8_WAIT_V
#undef PG8_WAIT_L
#undef PG8_BAR
#undef PG8_SCHED
}
}

#define LAS __attribute__((address_space(3)))
typedef unsigned short bf16;
typedef short bf16x8 __attribute__((ext_vector_type(8)));
typedef float f32x4 __attribute__((ext_vector_type(4)));
typedef float f32x16 __attribute__((ext_vector_type(16)));
typedef unsigned u32x2 __attribute__((ext_vector_type(2)));
typedef unsigned u32x4 __attribute__((ext_vector_type(4)));

constexpr int NB = 8, SEQ = 2048, NMETA = 16, LL = 2064, DM = 1024, FF = 4096, DIN = 4864, NPROJ = 1792;
constexpr int NREAL = NB * SEQ;
constexpr int TPR = NREAL + 256;
constexpr int LDS_BYTES = 147456;

constexpr size_t MiB = 1u << 20;
constexpr size_t WS_CTL = 0;
constexpr size_t WS_ROPE = 1 * MiB;
constexpr size_t WS_ABAR = 2 * MiB;
constexpr size_t WS_BMAT = 2 * MiB + 65536;
constexpr size_t WS_CMAT = WS_BMAT + 524288;
constexpr size_t WS_HM = 4 * MiB;
constexpr size_t WS_W = 5 * MiB;
constexpr size_t OW_IN = 0, OW_GLU = (size_t)DIN * DM * 2, OW_POOL = OW_GLU + 512 * 512 * 2, OW_BR = OW_POOL + 512 * 512 * 2,
                 OW_OUT = OW_BR + 3 * 1024 * 512 * 2, OW_UP = OW_OUT + 1024 * 1024 * 2, OW_DN = OW_UP + (size_t)FF * DM * 2, LW_BYTES = OW_DN + (size_t)FF * DM * 2;
constexpr size_t WS_HB = 68 * MiB;
constexpr size_t WS_X = 101 * MiB;
constexpr size_t UU = (size_t)TPR * 512 * 2;
constexpr size_t WS_YF = WS_X, WS_YP = WS_X, WS_Q = WS_X + 2 * UU, WS_K = WS_Q + UU, WS_V = WS_K + UU / 4, WS_MG = WS_X + 2 * UU,
                 WS_SU = WS_X + 4 * UU, WS_YA = WS_X + 8 * UU  , WS_PU = WS_X + 5 * UU, WS_YS = WS_PU, WS_Z = WS_X + 6 * UU, WS_PD = WS_X + 7 * UU, WS_BR = WS_Z, WS_ACT = WS_X;
constexpr size_t WS_RS = WS_X + 9 * UU;
constexpr size_t WS_END = WS_RS + (size_t)5 * TPR * 16 * 4;
static_assert(WS_W + 2 * LW_BYTES <= WS_HB && WS_HB + (size_t)TPR * 1024 * 2 <= WS_X && WS_END <= 256 * MiB, "ws map");
static_assert((size_t)256 * 2064 * 16 * 4 <= 2 * UU, "YF fits");

__device__ __forceinline__ unsigned pk2(float lo, float hi) { unsigned r; asm("v_cvt_pk_bf16_f32 %0, %1, %2" : "=v"(r) : "v"(lo), "v"(hi)); return r; }
__device__ __forceinline__ unsigned f2bf(float f) { return pk2(f, 0.f) & 0xffffu; }
__device__ __forceinline__ float bf2f(unsigned b) { return __uint_as_float(b << 16); }
__device__ __forceinline__ int tok_row(int b, int l) { return l >= NMETA ? b * SEQ + l - NMETA : NREAL + b * NMETA + l; }
#define LDS_FENCE() asm volatile("s_waitcnt lgkmcnt(0)" ::: "memory")
#define SSM_SYNC() do { asm volatile("s_waitcnt vmcnt(0) lgkmcnt(0)" ::: "memory"); __syncthreads(); } while (0)
__device__ __forceinline__ float row_rstd(const float* rs, int R) {
    const f32x4 a = *(const f32x4*)(rs + (size_t)R * 4), b = *(const f32x4*)(rs + ((size_t)TPR + R) * 4), c = *(const f32x4*)(rs + ((size_t)2 * TPR + R) * 4), d = *(const f32x4*)(rs + ((size_t)3 * TPR + R) * 4);
    const float s = (((a[0] + a[1]) + (a[2] + a[3])) + ((b[0] + b[1]) + (b[2] + b[3]))) + (((c[0] + c[1]) + (c[2] + c[3])) + ((d[0] + d[1]) + (d[2] + d[3])));
    return rsqrtf(s * (1.0f / 1024.0f) + 1e-6f);
}

__device__ __forceinline__ void dsincos(double a, double& s, double& c) {
    const double q = rint(a * 0.63661977236758134308);
    double r = fma(-q, 1.57079632679489655800e+00, a); r = fma(-q, 6.12323399573676603587e-17, r);
    const double r2 = r * r;
    double sp = -7.6471637318198164759e-13; sp = fma(sp, r2, 1.6059043836821614599e-10); sp = fma(sp, r2, -2.5052108385441718775e-08); sp = fma(sp, r2, 2.7557319223985890653e-06);
    sp = fma(sp, r2, -1.9841269841269841270e-04); sp = fma(sp, r2, 8.3333333333333333333e-03); sp = fma(sp, r2, -1.6666666666666666667e-01); sp = fma(sp * r2, r, r);
    double cp = 4.7794773323873852974e-14; cp = fma(cp, r2, -1.1470745597729724714e-11); cp = fma(cp, r2, 2.0876756987868098979e-09); cp = fma(cp, r2, -2.7557319223985890653e-07);
    cp = fma(cp, r2, 2.4801587301587301587e-05); cp = fma(cp, r2, -1.3888888888888888889e-03); cp = fma(cp, r2, 4.1666666666666666667e-02); cp = fma(cp, r2, -0.5); cp = fma(cp, r2, 1.0);
    const int qi = ((int)q) & 3;
    s = (qi == 0) ? sp : (qi == 1) ? cp : (qi == 2) ? -sp : -cp;
    c = (qi == 0) ? cp : (qi == 1) ? -sp : (qi == 2) ? -cp : sp;
}
__device__ __forceinline__ double dexp(double x) {
    const double k = rint(x * 1.44269504088896340736);
    double r = fma(-k, 6.93147180369123816490e-01, x); r = fma(-k, 1.90821492927058770002e-10, r);
    double p = 1.0 / 6227020800.0; p = fma(p, r, 1.0 / 479001600.0); p = fma(p, r, 1.0 / 39916800.0); p = fma(p, r, 1.0 / 3628800.0); p = fma(p, r, 1.0 / 362880.0); p = fma(p, r, 1.0 / 40320.0);
    p = fma(p, r, 1.0 / 5040.0); p = fma(p, r, 1.0 / 720.0); p = fma(p, r, 1.0 / 120.0); p = fma(p, r, 1.0 / 24.0); p = fma(p, r, 1.0 / 6.0); p = fma(p, r, 0.5); p = fma(p, r, 1.0); p = fma(p, r, 1.0);
    const long long bits = ((long long)(1023 + (int)k)) << 52;
    return p * __longlong_as_double(bits);
}

struct EpiInProj {
    static constexpr bool PERM = false, AFTER_DRAIN = false;
    const float* rowss; const float* rope; bf16 *Q, *K, *V, *SU, *PU;
    __device__ __forceinline__ void operator()(const f32x4 (&acc)[2][2][4][2], const pg8::Unit& u, int wr, int wc, int fr, int fq) const {
#pragma unroll
        for (int ai = 0; ai < 2; ++ai)
#pragma unroll
            for (int m = 0; m < 4; ++m) {
                const int R = u.pm * 256 + ai * 128 + wr * 64 + m * 16 + fr;
                const float rs = row_rstd(rowss, R);
                const int l = R < NREAL ? (R & 2047) + NMETA : (R & 15);
#pragma unroll
                for (int bj = 0; bj < 2; ++bj)
#pragma unroll
                    for (int n = 0; n < 2; ++n) {
                        const int c = u.pn * 256 + bj * 128 + wc * 32 + n * 16 + 4 * fq;
                        const f32x4 v = acc[ai][bj][m][n] * rs;
                        u32x2 w;
                        if (c < 640) {
                            const int i0 = (c & 63) >> 1;
                            const f32x4 cs = *(const f32x4*)(rope + ((size_t)l * 32 + i0) * 2);
                            float o0 = v[0] * cs[0] - v[1] * cs[1], o1 = v[1] * cs[0] + v[0] * cs[1], o2 = v[2] * cs[2] - v[3] * cs[3], o3 = v[3] * cs[2] + v[2] * cs[3];
                            if (c < 512) { w.x = pk2(o0 * 0.125f, o1 * 0.125f); w.y = pk2(o2 * 0.125f, o3 * 0.125f); *(u32x2*)(Q + (size_t)R * 512 + c) = w; }
                            else { w.x = pk2(o0, o1); w.y = pk2(o2, o3); *(u32x2*)(K + (size_t)R * 128 + (c - 512)) = w; }
                        } else {
                            w.x = pk2(v[0], v[1]); w.y = pk2(v[2], v[3]);
                            if (c < 768) *(u32x2*)(V + (size_t)R * 128 + (c - 640)) = w;
                            else if (c < 1280) *(u32x2*)(SU + (size_t)R * 512 + (c - 768)) = w;
                            else *(u32x2*)(PU + (size_t)R * 512 + (c - 1280)) = w;
                        }
                    }
            }
    }
};
#define EPI_BODY() \
    __device__ __forceinline__ void rg(int R, int pn, int wc, int fq, const f32x4 (&a4)[2][2]) const { \
        _Pragma("unroll") for (int bj = 0; bj < 2; ++bj) _Pragma("unroll") for (int n = 0; n < 2; ++n) q(R, pn * 256 + bj * 128 + wc * 32 + n * 16 + 4 * fq, a4[bj][n]); } \
    __device__ __forceinline__ void tq(int R, int c, const f32x4& v) const { q(R, c, v); } \
    EPI_OP()
#define EPI_OP() \
    __device__ __forceinline__ void operator()(const f32x4 (&acc)[2][2][4][2], const pg8::Unit& u, int wr, int wc, int fr, int fq) const { \
        _Pragma("unroll") for (int ai = 0; ai < 2; ++ai) _Pragma("unroll") for (int m = 0; m < 4; ++m) { \
            const f32x4 a4[2][2] = {{acc[ai][0][m][0], acc[ai][0][m][1]}, {acc[ai][1][m][0], acc[ai][1][m][1]}}; \
            rg(u.pm * 256 + ai * 128 + wr * 64 + m * 16 + fr, u.pn, wc, fq, a4); } }
#define EPI_BODY_RS() \
    __device__ __forceinline__ void rg(int R, int pn, int wc, int fq, const f32x4 (&a4)[2][2]) const { const float rs = row_rstd(rowss, R); \
        _Pragma("unroll") for (int bj = 0; bj < 2; ++bj) _Pragma("unroll") for (int n = 0; n < 2; ++n) q(R, pn * 256 + bj * 128 + wc * 32 + n * 16 + 4 * fq, a4[bj][n], rs); } \
    __device__ __forceinline__ void tq(int R, int c, const f32x4& v) const { q(R, c, v, row_rstd(rowss, R)); } \
    EPI_OP()
struct EpiGlu {
    static constexpr bool PERM = false, AFTER_DRAIN = false;
    const bf16* Z; const float* bias; bf16* YS;
    __device__ __forceinline__ void q(int R, int c, const f32x4& a) const {
        const f32x4 v = a + *(const f32x4*)(bias + c);
        const u32x2 zz = *(const u32x2*)(Z + (size_t)R * 512 + c);
        const float z0 = bf2f(zz.x & 0xffffu), z1 = bf2f(zz.x >> 16), z2 = bf2f(zz.y & 0xffffu), z3 = bf2f(zz.y >> 16);
        u32x2 w; w.x = pk2(z0 * __builtin_amdgcn_rcpf(1.0f + __expf(-v[0])), z1 * __builtin_amdgcn_rcpf(1.0f + __expf(-v[1]))); w.y = pk2(z2 * __builtin_amdgcn_rcpf(1.0f + __expf(-v[2])), z3 * __builtin_amdgcn_rcpf(1.0f + __expf(-v[3])));
        *(u32x2*)(YS + (size_t)R * 512 + c) = w;
    }
    EPI_BODY()
};
struct EpiScale {
    static constexpr bool PERM = false, AFTER_DRAIN = false;
    bf16* O; int ldc; const float* scale;
    __device__ __forceinline__ void q(int R, int c, const f32x4& a) const {
        f32x4 v = a;
        if (scale) v = v * *(const f32x4*)(scale + c);
        u32x2 w; w.x = pk2(v[0], v[1]); w.y = pk2(v[2], v[3]);
        *(u32x2*)(O + (size_t)R * ldc + c) = w;
    }
    EPI_BODY()
};
template <bool FIRST> struct EpiGate {
    static constexpr bool PERM = false, AFTER_DRAIN = false;
    const float* rowss; const bf16* BR; bf16* MG;
    __device__ __forceinline__ void q(int R, int c, const f32x4& a, float rs) const {
        const f32x4 v = a * rs;
        const u32x2 bb = *(const u32x2*)(BR + (size_t)R * 1024 + c);
        float o0 = bf2f(bb.x & 0xffffu) * __builtin_amdgcn_rcpf(1.0f + __expf(-v[0])), o1 = bf2f(bb.x >> 16) * __builtin_amdgcn_rcpf(1.0f + __expf(-v[1]));
        float o2 = bf2f(bb.y & 0xffffu) * __builtin_amdgcn_rcpf(1.0f + __expf(-v[2])), o3 = bf2f(bb.y >> 16) * __builtin_amdgcn_rcpf(1.0f + __expf(-v[3]));
        if (!FIRST) { const u32x2 mm = *(const u32x2*)(MG + (size_t)R * 1024 + c);
            o0 += bf2f(mm.x & 0xffffu); o1 += bf2f(mm.x >> 16); o2 += bf2f(mm.y & 0xffffu); o3 += bf2f(mm.y >> 16); }
        u32x2 w; w.x = pk2(o0, o1); w.y = pk2(o2, o3);
        *(u32x2*)(MG + (size_t)R * 1024 + c) = w;
    }
    EPI_BODY_RS()
};
struct EpiRes {
    static constexpr bool PERM = false, AFTER_DRAIN = false;
    float* Hreal; float* Hmeta; bf16* HB; float* rowss_out;
    __device__ __forceinline__ float q(int R, int c, const f32x4& a) const {
        float* hrow = R < NREAL ? Hreal + (size_t)R * 1024 : Hmeta + (size_t)(R - NREAL) * 1024;
        const f32x4 h = *(const f32x4*)(hrow + c) + a;
        *(f32x4*)(hrow + c) = h;
        u32x2 w; w.x = pk2(h[0], h[1]); w.y = pk2(h[2], h[3]);
        *(u32x2*)(HB + (size_t)R * 1024 + c) = w;
        return (h[0] * h[0] + h[1] * h[1]) + (h[2] * h[2] + h[3] * h[3]);
    }
    __device__ __forceinline__ void rg(int R, int pn, int wc, int fq, const f32x4 (&a4)[2][2]) const {
        float ss = 0.f;
#pragma unroll
        for (int bj = 0; bj < 2; ++bj)
#pragma unroll
            for (int n = 0; n < 2; ++n) ss += q(R, pn * 256 + bj * 128 + wc * 32 + n * 16 + 4 * fq, a4[bj][n]);
        ss += __shfl_xor(ss, 16); ss += __shfl_xor(ss, 32);
        if (fq == 0) rowss_out[((size_t)pn * TPR + R) * 4 + wc] = ss;
    }
    __device__ __forceinline__ void tq(int R, int c, const f32x4& v) const {
        float ss = q(R, c, v);
        ss += __shfl_xor(ss, 16); ss += __shfl_xor(ss, 32);
        if ((threadIdx.x & 48) == 0) atomicAdd(rowss_out + (size_t)R * 4, ss);
    }
    EPI_OP()
};
struct EpiUp {
    static constexpr bool PERM = false, AFTER_DRAIN = false;
    const float* rowss; bf16* ACT;
    __device__ __forceinline__ void q(int R, int c, const f32x4& a, float rs) const {
        f32x4 v = a * rs;
#pragma unroll
        for (int j = 0; j < 4; ++j) { const float r = fmaxf(v[j], 0.f); v[j] = r * r; }
        u32x2 w; w.x = pk2(v[0], v[1]); w.y = pk2(v[2], v[3]);
        *(u32x2*)(ACT + (size_t)R * FF + c) = w;
    }
    EPI_BODY_RS()
};
template <class Epi>
__device__ __forceinline__ void thin_gemm(LAS unsigned char* lds, const bf16* A, const bf16* Bt, int K, int N, const Epi& E, int vb, int vg) {
    int tid_l = threadIdx.x; asm volatile("" : "+v"(tid_l));
    const int lane = tid_l & 63, w = __builtin_amdgcn_readfirstlane(tid_l >> 6), fr = lane & 15, fq = lane >> 4;
    LAS f32x4* red = (LAS f32x4*)lds;
    const int kw = K >> 3;
    for (int pc = vb; pc < N / 16; pc += vg) {
        const bf16* ap = A + (size_t)(NREAL + fr) * K + w * kw + 8 * fq;
        const bf16* bp = Bt + (size_t)(16 * pc + fr) * K + w * kw + 8 * fq;
        f32x4 acc[8];
#pragma unroll
        for (int rb = 0; rb < 8; ++rb) acc[rb] = (f32x4){0.f, 0.f, 0.f, 0.f};
#pragma unroll 2
        for (int k0 = 0; k0 < kw; k0 += 32) {
            const bf16x8 bf = *(const bf16x8*)(bp + k0);
            bf16x8 af[8];
#pragma unroll
            for (int rb = 0; rb < 8; ++rb) af[rb] = *(const bf16x8*)(ap + (size_t)(16 * rb) * K + k0);
#pragma unroll
            for (int rb = 0; rb < 8; ++rb) acc[rb] = __builtin_amdgcn_mfma_f32_16x16x32_bf16(bf, af[rb], acc[rb], 0, 0, 0);
        }
        asm volatile("s_nop 15\n\ts_nop 15" : "+v"(acc[0]), "+v"(acc[1]), "+v"(acc[2]), "+v"(acc[3]), "+v"(acc[4]), "+v"(acc[5]), "+v"(acc[6]), "+v"(acc[7]));
#pragma unroll
        for (int rb = 0; rb < 8; ++rb) red[(w * 8 + rb) * 64 + lane] = acc[rb];
        LDS_FENCE(); __syncthreads();
        f32x4 v = red[(0 * 8 + w) * 64 + lane];
#pragma unroll
        for (int ww = 1; ww < 8; ++ww) v = v + red[(ww * 8 + w) * 64 + lane];
        LDS_FENCE(); __syncthreads();
        E.tq(NREAL + 16 * w + fr, 16 * pc + 4 * fq, v);
    }
}

struct Args { const float* in[23]; float* out; unsigned char* ws; };

__device__ __forceinline__ void p0_item(const float* W, int ldw, int K, const float* scale, bf16* WT, int permrows, LAS float* scr, int item, int nblk, int lane) {
    const int kb = item / nblk, nb = item % nblk, k0 = 64 * kb, n0 = 32 * nb;
    const int dn = n0 + (lane & 31); int sc = dn;
    if (dn < permrows) { const int j = dn & 63; sc = (dn & ~63) + ((j & 1) ? 32 + (j >> 1) : (j >> 1)); }
#pragma unroll 8
    for (int i = 0; i < 32; ++i) { const int kk = 2 * i + (lane >> 5); float w = W[(size_t)(k0 + kk) * ldw + sc]; if (scale) w *= scale[k0 + kk]; scr[kk * 33 + (lane & 31)] = w; }
    LDS_FENCE();
    const int c = lane & 7;
#pragma unroll
    for (int j = 0; j < 4; ++j) { const int n = (lane >> 3) + 8 * j; const LAS float* s = scr + (8 * c) * 33 + n;
        u32x4 o; o.x = pk2(s[0 * 33], s[1 * 33]); o.y = pk2(s[2 * 33], s[3 * 33]); o.z = pk2(s[4 * 33], s[5 * 33]); o.w = pk2(s[6 * 33], s[7 * 33]);
        *(u32x4*)(WT + (size_t)(n0 + n) * K + k0 + 8 * c) = o; }
    LDS_FENCE();
}

__device__ __forceinline__ void p0_prologue(const Args& a, LAS unsigned char* lds) {
    int tl_ = threadIdx.x; asm volatile("" : "+v"(tl_));
    const int tid = tl_, lane = tid & 63, wave = __builtin_amdgcn_readfirstlane(tid >> 6);
    const int gw = blockIdx.x * 8 + wave, NGW = gridDim.x * 8;
    const int gt = blockIdx.x * 512 + tid, NGT = gridDim.x * 512;
    unsigned char* ws = a.ws;
    LAS float* scr = (LAS float*)(lds + wave * 16384);
    for (int i = gt; i < 4 * 4 * 128 * 4; i += NGT) { const int idx = 1 + (i >> 11), pn = (i >> 9) & 3, r = (i >> 2) & 127, sl = i & 3;
        ((float*)(ws + WS_RS))[((size_t)idx * 4 * TPR + (size_t)pn * TPR + NREAL + r) * 4 + sl] = 0.f; }
    constexpr int I_IN = 16 * 152, I_GLU = 8 * 16, I_BR = 8 * 32, I_OUT = 16 * 32, I_UP = 16 * 128, I_DN = 64 * 32, I_L = I_IN + I_GLU + 3 * I_BR + I_OUT + I_UP + I_DN;
    for (int it = gw; it < 2 * I_L; it += NGW) {
        const int layer = it / I_L; int r = it % I_L;
        unsigned char* wl = ws + WS_W + (size_t)layer * LW_BYTES;
        if (r < I_IN) { p0_item(a.in[3] + (size_t)layer * DM * DIN, DIN, DM, a.in[2] + layer * DM, (bf16*)(wl + OW_IN), 640, scr, r, 152, lane); continue; } r -= I_IN;
        if (r < I_GLU) { p0_item(a.in[13] + (size_t)layer * 512 * 512, 512, 512, nullptr, (bf16*)(wl + OW_GLU), 0, scr, r, 16, lane); continue; } r -= I_GLU;
        if (r < 3 * I_BR) { const int c = r / I_BR; p0_item(a.in[17] + ((size_t)layer * 3 + c) * 512 * 1024, 1024, 512, nullptr, (bf16*)(wl + OW_BR) + (size_t)c * 1024 * 512, 0, scr, r % I_BR, 32, lane); continue; } r -= 3 * I_BR;
        if (r < I_OUT) { p0_item(a.in[18] + (size_t)layer * DM * DM, DM, DM, nullptr, (bf16*)(wl + OW_OUT), 0, scr, r, 32, lane); continue; } r -= I_OUT;
        if (r < I_UP) { p0_item(a.in[20] + (size_t)layer * DM * FF, FF, DM, a.in[19] + layer * DM, (bf16*)(wl + OW_UP), 0, scr, r, 128, lane); continue; } r -= I_UP;
        p0_item(a.in[21] + (size_t)layer * FF * DM, DM, FF, nullptr, (bf16*)(wl + OW_DN), 0, scr, r, 32, lane);
    }
    for (int i = gt; i < 2 * 512 * 512; i += NGT) {
        const int layer = i >> 18, n = (i >> 9) & 511, k = i & 511;
        float w = 0.f;
        if ((n >> 7) == (k >> 7)) w = a.in[15][(((size_t)layer * 4 + (n >> 7)) * 128 + (k & 127)) * 128 + (n & 127)];
        ((bf16*)(ws + WS_W + (size_t)layer * LW_BYTES + OW_POOL))[(size_t)n * 512 + k] = (bf16)f2bf(w);
    }
    for (int i = gt; i < LL * 32; i += NGT) {
        const int l = i >> 5, f = i & 31;
        const float invf = (float)dexp(-(double)f * (9.21034037197618273607 / 32.0));
        const float ang = (float)l * invf;
        double s, c; dsincos((double)ang, s, c);
        float* rp = (float*)(ws + WS_ROPE) + (size_t)i * 2; rp[0] = (float)c; rp[1] = (float)s;
    }
    for (int i = gt; i < 2 * 2 * 32 * 64; i += NGT) {
        const int n = i & 63, pidx = i >> 6;
        const double lr = (double)a.in[5][i], li = (double)a.in[6][i];
        const double dt = (double)(float)dexp((double)a.in[7][pidx]);
        const double mag = dexp(lr * dt); double sn, cn; dsincos(li * dt, sn, cn);
        const double are = mag * cn, aim = mag * sn, den = lr * lr + li * li, nre = are - 1.0;
        const double fre = (nre * lr + aim * li) / den, fim = (aim * lr - nre * li) / den;
        float* ab = (float*)(ws + WS_ABAR) + (size_t)i * 2; ab[0] = (float)are; ab[1] = (float)aim;
        bf16* bm = (bf16*)(ws + WS_BMAT) + (size_t)pidx * 128 * 16;
        bf16* cm = (bf16*)(ws + WS_CMAT) + (size_t)pidx * 16 * 128;
        for (int q = 0; q < 16; ++q) {
            const double br = (double)a.in[8][(size_t)i * 16 + q], bi = (double)a.in[9][(size_t)i * 16 + q];
            bm[n * 16 + q] = (bf16)f2bf((float)(fre * br - fim * bi));
            bm[(64 + n) * 16 + q] = (bf16)f2bf((float)(fre * bi + fim * br));
            cm[q * 128 + n] = (bf16)f2bf(a.in[10][((size_t)pidx * 16 + q) * 64 + n]);
            cm[q * 128 + 64 + n] = (bf16)f2bf(-a.in[11][((size_t)pidx * 16 + q) * 64 + n]);
        }
    }
    for (int R = gw; R < TPR; R += NGW) {
        const int mrow = R - NREAL;
        const float* src = R < NREAL ? a.in[0] + (size_t)R * DM : a.in[1] + (size_t)(mrow & 15) * DM;
        float* dst = R < NREAL ? a.out + (size_t)R * DM : (float*)(ws + WS_HM) + (size_t)mrow * DM;
        bf16* hb = (bf16*)(ws + WS_HB) + (size_t)R * DM;
        const bool pad = mrow >= NB * NMETA;
        float ss = 0.f;
#pragma unroll
        for (int j = 0; j < 4; ++j) {
            f32x4 v = *(const f32x4*)(src + 4 * lane + 256 * j);
            if (pad) v = (f32x4){0.f, 0.f, 0.f, 0.f};
            *(f32x4*)(dst + 4 * lane + 256 * j) = v;
            ss += (v[0] * v[0] + v[1] * v[1]) + (v[2] * v[2] + v[3] * v[3]);
            u32x2 w; w.x = pk2(v[0], v[1]); w.y = pk2(v[2], v[3]);
            *(u32x2*)(hb + 4 * lane + 256 * j) = w;
        }
#pragma unroll
        for (int o = 1; o < 64; o <<= 1) ss += __shfl_xor(ss, o);
        if (lane < 16) ((float*)(ws + WS_RS))[((size_t)(lane >> 2) * TPR + R) * 4 + (lane & 3)] = lane == 0 ? ss : 0.f;
    }
}

__device__ __forceinline__ void ssm_task(LAS unsigned char* lds, int task, int layer, const bf16* SU, float* YF,
                                         const float* abar_all, const bf16* bmat_all, const bf16* cmat_all) {
    int tid_l = threadIdx.x; asm volatile("" : "+v"(tid_l));
    const int tid = tid_l, lane = tid & 63, wave = __builtin_amdgcn_readfirstlane(tid >> 6);
    const int b = task >> 5, g = task & 31;
    __syncthreads();
    LAS float* BU = (LAS float*)(lds + wave * 12800);
    LAS unsigned short* X = (LAS unsigned short*)(lds + wave * 12800 + 8448);
    LAS float* SX = (LAS float*)(lds + 8 * 12800);
    const int blk0 = wave == 0 ? 0 : 16 * wave + 1, nblk = wave == 0 ? 17 : 16;
    bf16* yfb = (bf16*)YF + (size_t)task * LL * 16;
    const int fr = lane & 15, fq = lane >> 4;
    const bf16x8 zero8 = {0, 0, 0, 0, 0, 0, 0, 0};
    for (int dir = 0; dir < 2; ++dir) {
        const int pidx = (layer * 2 + dir) * 32 + g;
        const float are = abar_all[((size_t)pidx * 64 + lane) * 2], aim = abar_all[((size_t)pidx * 64 + lane) * 2 + 1];
        bf16x8 bfr[8], cfr[4];
        const bf16* bm = bmat_all + (size_t)pidx * 128 * 16;
#pragma unroll
        for (int nt = 0; nt < 8; ++nt) bfr[nt] = fq < 2 ? *(const bf16x8*)(bm + (nt * 16 + fr) * 16 + 8 * fq) : zero8;
        const bf16* cm = cmat_all + (size_t)pidx * 16 * 128;
#pragma unroll
        for (int ks = 0; ks < 4; ++ks) cfr[ks] = *(const bf16x8*)(cm + fr * 128 + ks * 32 + 8 * fq);
        float p16r = are, p16i = aim;
#pragma unroll
        for (int i = 0; i < 4; ++i) { const float tr = p16r * p16r - p16i * p16i, ti = 2.f * p16r * p16i; p16r = tr; p16i = ti; }
        float p256r = p16r, p256i = p16i;
#pragma unroll
        for (int i = 0; i < 4; ++i) { const float tr = p256r * p256r - p256i * p256i, ti = 2.f * p256r * p256i; p256r = tr; p256i = ti; }
        const float p272r = p256r * p16r - p256i * p16i, p272i = p256r * p16i + p256i * p16r;

        float xre = 0.f, xim = 0.f;
        for (int pass = 0; pass < 2; ++pass) {
            bf16x8 unext;
            { const int blkf = dir == 0 ? blk0 : blk0 + nblk - 1; const int Rf = blkf == 0 ? NREAL + b * NMETA : b * SEQ + blkf * 16 - NMETA;
              unext = fq < 2 ? *(const bf16x8*)(SU + (size_t)(Rf + fr) * 512 + g * 16 + 8 * fq) : zero8; }
            for (int ib = 0; ib < nblk; ++ib) {
                const int blk = dir == 0 ? blk0 + ib : blk0 + nblk - 1 - ib;
                const bf16x8 ufr = unext;
                if (ib + 1 < nblk) { const int blkn = dir == 0 ? blk + 1 : blk - 1; const int Rn = blkn == 0 ? NREAL + b * NMETA : b * SEQ + blkn * 16 - NMETA;
                    unext = fq < 2 ? *(const bf16x8*)(SU + (size_t)(Rn + fr) * 512 + g * 16 + 8 * fq) : zero8; }
                f32x4 dd[8];
#pragma unroll
                for (int nt = 0; nt < 8; ++nt) { dd[nt] = (f32x4){0.f, 0.f, 0.f, 0.f}; dd[nt] = __builtin_amdgcn_mfma_f32_16x16x32_bf16(ufr, bfr[nt], dd[nt], 0, 0, 0); }
                asm volatile("s_nop 15\n\ts_nop 15" : "+v"(dd[0]), "+v"(dd[1]), "+v"(dd[2]), "+v"(dd[3]), "+v"(dd[4]), "+v"(dd[5]), "+v"(dd[6]), "+v"(dd[7]));
#pragma unroll
                for (int nt = 0; nt < 8; ++nt)
#pragma unroll
                    for (int r = 0; r < 4; ++r) BU[(4 * fq + r) * 132 + nt * 16 + fr] = dd[nt][r];
                LDS_FENCE();
                float bur[16], bui[16];
#pragma unroll
                for (int i = 0; i < 16; ++i) { const int tt = dir == 0 ? i : 15 - i; bur[i] = BU[tt * 132 + lane]; bui[i] = BU[tt * 132 + 64 + lane]; }
                if (pass == 0) {
#pragma unroll
                    for (int i = 0; i < 16; ++i) {
                        const float bre = bur[i], bim = bui[i];
                        const float nr = are * xre - aim * xim + bre, ni = are * xim + aim * xre + bim; xre = nr; xim = ni;
                    }
                    LDS_FENCE();
                } else {
#pragma unroll
                    for (int i = 0; i < 16; ++i) {
                        const int tt = dir == 0 ? i : 15 - i;
                        const float bre = bur[i], bim = bui[i];
                        const float nr = are * xre - aim * xim + bre, ni = are * xim + aim * xre + bim; xre = nr; xim = ni;
                        X[tt * 136 + lane] = (unsigned short)f2bf(xre); X[tt * 136 + 64 + lane] = (unsigned short)f2bf(xim);
                    }
                    LDS_FENCE();
                    f32x4 y = {0.f, 0.f, 0.f, 0.f};
#pragma unroll
                    for (int ks = 0; ks < 4; ++ks) {
                        const bf16x8 afr = *(const LAS bf16x8*)(X + fr * 136 + ks * 32 + 8 * fq);
                        y = __builtin_amdgcn_mfma_f32_16x16x32_bf16(afr, cfr[ks], y, 0, 0, 0);
                    }
                    asm volatile("s_nop 15\n\ts_nop 15" : "+v"(y));
                    LDS_FENCE();
                    {
                        bf16* yd = yfb + (size_t)dir * 256 * LL * 16;
#pragma unroll
                        for (int r = 0; r < 4; ++r) yd[(size_t)(blk * 16 + 4 * fq + r) * 16 + fr] = (bf16)f2bf(y[r]);
                    }
                }
            }
            if (pass == 0) {
                SX[(wave * 64 + lane) * 2] = xre; SX[(wave * 64 + lane) * 2 + 1] = xim;
                LDS_FENCE(); __syncthreads();
                float cre = 0.f, cim = 0.f;
                if (dir == 0) {
                    for (int w = 0; w < wave; ++w) { const float pr = w == 0 ? p272r : p256r, pi = w == 0 ? p272i : p256i;
                        const float sr = SX[(w * 64 + lane) * 2], si = SX[(w * 64 + lane) * 2 + 1];
                        const float nr = pr * cre - pi * cim + sr, ni = pr * cim + pi * cre + si; cre = nr; cim = ni; }
                } else {
                    for (int w = 7; w > wave; --w) {
                        const float sr = SX[(w * 64 + lane) * 2], si = SX[(w * 64 + lane) * 2 + 1];
                        const float nr = p256r * cre - p256i * cim + sr, ni = p256r * cim + p256i * cre + si; cre = nr; cim = ni; }
                }
                xre = cre; xim = cim;
            }
        }
        LDS_FENCE(); __syncthreads();
    }
}

constexpr int ATT_KROW = 72, ATT_VROW = 40, ATT_KT = 32 * ATT_KROW * 2  , ATT_VT = 64 * ATT_VROW * 2  , ATT_MAXT = 11, ATT_VOFF = ATT_MAXT * ATT_KT;
static_assert(ATT_VOFF + ATT_MAXT * ATT_VT <= 131072, "attention LDS");
__device__ __forceinline__ void attn_task(LAS unsigned char* lds, int task, const bf16* Q, const bf16* K, const bf16* V, bf16* YA, const float* sink) {
    int tid_l = threadIdx.x; asm volatile("" : "+v"(tid_l));
    const int tid = tid_l, lane = tid & 63, wave = __builtin_amdgcn_readfirstlane(tid >> 6);
    const int qb = task % 33, bh = task / 33, h = bh & 1, b = bh >> 1;
    const int l0 = qb * 64;
    __syncthreads();
    int jlo = (l0 - 128) >> 5; if (jlo < 1) jlo = 1;
    int jhi = (l0 + 191) >> 5; if (jhi > 64) jhi = 64;
    const int ntiles = 1 + (jhi - jlo + 1);
    LAS unsigned short* Ks = (LAS unsigned short*)lds;
    LAS unsigned short* Vs = (LAS unsigned short*)(lds + ATT_VOFF);
    for (int idx = tid; idx < ntiles * 32 * 8; idx += 512) {
        const int ch = idx & 7, key = idx >> 3, slot = key >> 5, kk = key & 31;
        const int lk = (slot == 0 ? 0 : (jlo + slot - 1) * 32) + kk;
        u32x4 kv = {0u, 0u, 0u, 0u}, vv = {0u, 0u, 0u, 0u};
        if (lk < LL) { const size_t R = (size_t)tok_row(b, lk);
            kv = *(const u32x4*)(K + R * 128 + h * 64 + ch * 8); vv = *(const u32x4*)(V + R * 128 + h * 64 + ch * 8); }
        *(LAS u32x4*)(Ks + slot * (ATT_KT / 2) + kk * ATT_KROW + ch * 8) = kv;
        LAS unsigned short* vd = Vs + slot * (ATT_VT / 2) + (ch * 8) * ATT_VROW + kk;
        vd[0 * ATT_VROW] = (unsigned short)(vv.x & 0xffffu); vd[1 * ATT_VROW] = (unsigned short)(vv.x >> 16);
        vd[2 * ATT_VROW] = (unsigned short)(vv.y & 0xffffu); vd[3 * ATT_VROW] = (unsigned short)(vv.y >> 16);
        vd[4 * ATT_VROW] = (unsigned short)(vv.z & 0xffffu); vd[5 * ATT_VROW] = (unsigned short)(vv.z >> 16);
        vd[6 * ATT_VROW] = (unsigned short)(vv.w & 0xffffu); vd[7 * ATT_VROW] = (unsigned short)(vv.w >> 16);
    }
    LDS_FENCE(); __syncthreads();
    const int head = h * 4 + (wave >> 1), r32 = lane & 31, hi = lane >> 5;
    const int lq = l0 + 32 * (wave & 1) + r32;
    const bool qvalid = lq < LL;
    const size_t Rq = (size_t)tok_row(b, qvalid ? lq : LL - 1);
    bf16x8 qf[4];
#pragma unroll
    for (int ks = 0; ks < 4; ++ks) qf[ks] = *(const bf16x8*)(Q + Rq * 512 + head * 64 + ks * 16 + 8 * hi);
    float mrun = sink[head], lsum = hi == 0 ? 1.0f : 0.0f;
    f32x16 o0, o1;
#pragma unroll
    for (int i = 0; i < 16; ++i) { o0[i] = 0.f; o1[i] = 0.f; }
    for (int slot = 0; slot < ntiles; ++slot) {
        const int kbase = slot == 0 ? 0 : (jlo + slot - 1) * 32;
        const LAS unsigned short* kt = Ks + slot * (ATT_KT / 2);
        f32x16 s;
#pragma unroll
        for (int i = 0; i < 16; ++i) s[i] = 0.f;
#pragma unroll
        for (int ks = 0; ks < 4; ++ks) {
            const bf16x8 kf = *(const LAS bf16x8*)(kt + r32 * ATT_KROW + ks * 16 + 8 * hi);
            s = __builtin_amdgcn_mfma_f32_32x32x16_bf16(kf, qf[ks], s, 0, 0, 0);
        }
        asm volatile("s_nop 15\n\ts_nop 15" : "+v"(s));
        float mt = -1e30f;
#pragma unroll
        for (int i = 0; i < 16; ++i) {
            const int lk = kbase + (i & 3) + 8 * (i >> 2) + 4 * hi;
            int d = lq - lk; d = d < 0 ? -d : d;
            const bool valid = (lk < NMETA) || (d <= 128 && lk < LL);
            s[i] = valid ? s[i] : -1e30f;
            mt = fmaxf(mt, s[i]);
        }
        mt = fmaxf(mt, __shfl_xor(mt, 32));
        const float mnew = fmaxf(mrun, mt);
        const float alpha = __expf(mrun - mnew);
        mrun = mnew;
        float ps = 0.f;
#pragma unroll
        for (int i = 0; i < 16; ++i) { s[i] = __expf(s[i] - mnew); ps += s[i]; }
        lsum = lsum * alpha + ps;
#pragma unroll
        for (int i = 0; i < 16; ++i) { o0[i] *= alpha; o1[i] *= alpha; }
        const LAS unsigned short* vt = Vs + slot * (ATT_VT / 2);
#pragma unroll
        for (int s2 = 0; s2 < 2; ++s2) {
            union { bf16x8 v; unsigned u[4]; } pf;
            pf.u[0] = pk2(s[8 * s2 + 0], s[8 * s2 + 1]); pf.u[1] = pk2(s[8 * s2 + 2], s[8 * s2 + 3]);
            pf.u[2] = pk2(s[8 * s2 + 4], s[8 * s2 + 5]); pf.u[3] = pk2(s[8 * s2 + 6], s[8 * s2 + 7]);
#pragma unroll
            for (int dt = 0; dt < 2; ++dt) {
                union { bf16x8 v; u32x2 u[2]; } vf;
                const LAS unsigned short* vp = vt + (dt * 32 + r32) * ATT_VROW + 16 * s2 + 4 * hi;
                vf.u[0] = *(const LAS u32x2*)(vp); vf.u[1] = *(const LAS u32x2*)(vp + 8);
                if (dt == 0) o0 = __builtin_amdgcn_mfma_f32_32x32x16_bf16(vf.v, pf.v, o0, 0, 0, 0);
                else o1 = __builtin_amdgcn_mfma_f32_32x32x16_bf16(vf.v, pf.v, o1, 0, 0, 0);
            }
        }
    }
    asm volatile("s_nop 15\n\ts_nop 15" : "+v"(o0), "+v"(o1));
    lsum += __shfl_xor(lsum, 32);
    const float inv = 1.0f / lsum;
    if (qvalid) {
#pragma unroll
        for (int g4 = 0; g4 < 4; ++g4) {
            u32x2 w0, w1;
            w0.x = pk2(o0[4 * g4] * inv, o0[4 * g4 + 1] * inv); w0.y = pk2(o0[4 * g4 + 2] * inv, o0[4 * g4 + 3] * inv);
            w1.x = pk2(o1[4 * g4] * inv, o1[4 * g4 + 1] * inv); w1.y = pk2(o1[4 * g4 + 2] * inv, o1[4 * g4 + 3] * inv);
            *(u32x2*)(YA + Rq * 512 + head * 64 + 8 * g4 + 4 * hi) = w0;
            *(u32x2*)(YA + Rq * 512 + head * 64 + 32 + 8 * g4 + 4 * hi) = w1;
        }
    }
    __syncthreads();
}

__device__ __forceinline__ void pool_diff(const bf16* PU, bf16* PD) {
    int tl_ = threadIdx.x; asm volatile("" : "+v"(tl_)); const int gt = blockIdx.x * 512 + tl_, NGT = gridDim.x * 512;
    for (int i = gt; i < NB * LL * 64; i += NGT) {
        const int ch = i & 63, tk = i >> 6, b = tk / LL, l = tk % LL;
        const int half = 1 << (ch >> 4);
        const int lo = l - half < 0 ? 0 : l - half, hh = l + half > LL ? LL : l + half;
        float s[8];
#pragma unroll
        for (int j = 0; j < 8; ++j) s[j] = 0.f;
        for (int lp = lo; lp < hh; ++lp) {
            const u32x4 v = *(const u32x4*)(PU + (size_t)tok_row(b, lp) * 512 + ch * 8);
            s[0] += bf2f(v.x & 0xffffu); s[1] += bf2f(v.x >> 16); s[2] += bf2f(v.y & 0xffffu); s[3] += bf2f(v.y >> 16);
            s[4] += bf2f(v.z & 0xffffu); s[5] += bf2f(v.z >> 16); s[6] += bf2f(v.w & 0xffffu); s[7] += bf2f(v.w >> 16);
        }
        const float ic = 1.0f / (float)(hh - lo);
        const size_t R = (size_t)tok_row(b, l);
        const u32x4 v = *(const u32x4*)(PU + R * 512 + ch * 8);
        u32x4 o;
        o.x = pk2(s[0] * ic - bf2f(v.x & 0xffffu), s[1] * ic - bf2f(v.x >> 16)); o.y = pk2(s[2] * ic - bf2f(v.y & 0xffffu), s[3] * ic - bf2f(v.y >> 16));
        o.z = pk2(s[4] * ic - bf2f(v.z & 0xffffu), s[5] * ic - bf2f(v.z >> 16)); o.w = pk2(s[6] * ic - bf2f(v.w & 0xffffu), s[7] * ic - bf2f(v.w >> 16));
        *(u32x4*)(PD + R * 512 + ch * 8) = o;
    }
}

__device__ __forceinline__ void z_pass(const float* YF, const bf16* SU, const float* dskip, bf16* Z) {
    int tl_ = threadIdx.x; asm volatile("" : "+v"(tl_)); const int gt = blockIdx.x * 512 + tl_, NGT = gridDim.x * 512;
    for (int i = gt; i < NB * LL * 64; i += NGT) {
        const int ch = i & 63, tk = i >> 6, b = tk / LL, l = tk % LL, g = ch >> 1;
        const size_t R = (size_t)tok_row(b, l);
        const bf16* yp = (const bf16*)YF + ((size_t)(b * 32 + g) * LL + l) * 16 + (ch & 1) * 8;
        const u32x4 ya = *(const u32x4*)yp, yb = *(const u32x4*)(yp + (size_t)256 * LL * 16);
        f32x4 y0, y1;
        y0[0] = bf2f(ya.x & 0xffffu) + bf2f(yb.x & 0xffffu); y0[1] = bf2f(ya.x >> 16) + bf2f(yb.x >> 16); y0[2] = bf2f(ya.y & 0xffffu) + bf2f(yb.y & 0xffffu); y0[3] = bf2f(ya.y >> 16) + bf2f(yb.y >> 16);
        y1[0] = bf2f(ya.z & 0xffffu) + bf2f(yb.z & 0xffffu); y1[1] = bf2f(ya.z >> 16) + bf2f(yb.z >> 16); y1[2] = bf2f(ya.w & 0xffffu) + bf2f(yb.w & 0xffffu); y1[3] = bf2f(ya.w >> 16) + bf2f(yb.w >> 16);
        const f32x4 d0 = *(const f32x4*)(dskip + ch * 8), d1 = *(const f32x4*)(dskip + ch * 8 + 4);
        const u32x4 uu = *(const u32x4*)(SU + R * 512 + ch * 8);
        float t[8];
        t[0] = y0[0] + d0[0] * bf2f(uu.x & 0xffffu); t[1] = y0[1] + d0[1] * bf2f(uu.x >> 16); t[2] = y0[2] + d0[2] * bf2f(uu.y & 0xffffu); t[3] = y0[3] + d0[3] * bf2f(uu.y >> 16);
        t[4] = y1[0] + d1[0] * bf2f(uu.z & 0xffffu); t[5] = y1[1] + d1[1] * bf2f(uu.z >> 16); t[6] = y1[2] + d1[2] * bf2f(uu.w & 0xffffu); t[7] = y1[3] + d1[3] * bf2f(uu.w >> 16);
#pragma unroll
        for (int j = 0; j < 8; ++j) t[j] = 0.5f * t[j] * (1.0f + erff(t[j] * 0.70710678118654752f));
        u32x4 o; o.x = pk2(t[0], t[1]); o.y = pk2(t[2], t[3]); o.z = pk2(t[4], t[5]); o.w = pk2(t[6], t[7]);
        *(u32x4*)(Z + R * 512 + ch * 8) = o;
    }
}

#define XB_TMO      128
#define XB_XCNT(j)  (256  + 64 * (j))
#define XB_XSUB(j)  (1280 + 64 * (j))
#define XB_XGEN(j)  (2304 + 64 * (j))
#define XB_TOP      3328
#define XB_TOPGEN   3392
#define XCD_BAR_WORDS 3456
#define XB_SPIN_CAP (1u << 18)

__device__ __forceinline__ unsigned xb_ld(unsigned* p)              { return __hip_atomic_load(p, __ATOMIC_RELAXED, __HIP_MEMORY_SCOPE_AGENT); }
__device__ __forceinline__ unsigned xb_add(unsigned* p, unsigned v) { return __hip_atomic_fetch_add(p, v, __ATOMIC_RELAXED, __HIP_MEMORY_SCOPE_AGENT); }
__device__ __forceinline__ unsigned xb_xcc_id() { return (unsigned)__builtin_amdgcn_s_getreg((3 << 11) | 20) & 0xFu; }
#define XB_SPIN(cond, bar) do { unsigned _sp = 0; while (cond) { __builtin_amdgcn_s_sleep(1); \
    if ((++_sp & 255u) == 0u) { if (xb_ld(&(bar)[XB_TMO])) break; if (_sp > XB_SPIN_CAP) { atomicAdd(&(bar)[XB_TMO], 1u); break; } } } } while (0)

struct XcdBarrier {
    unsigned* bar; unsigned x;
    volatile LAS unsigned* st;
};

__device__ __forceinline__ XcdBarrier xcd_barrier_post(unsigned* bar, volatile LAS unsigned* st) {
    XcdBarrier b; b.bar = bar; b.x = xb_xcc_id(); b.st = st;
    if (threadIdx.x == 0) (void)xb_add(&bar[XB_XCNT(b.x)], 1u);
    return b;
}
__device__ __forceinline__ void xcd_barrier_complete(unsigned* bar, unsigned x, unsigned& nloc, unsigned& nx) {
    const unsigned G = gridDim.x * gridDim.y * gridDim.z;
    unsigned sum, cnt, mine, sp = 0u;
    for (;;) {
        sum = 0u; cnt = 0u; mine = 0u;
#pragma unroll
        for (unsigned j = 0; j < 16; ++j) { const unsigned c = xb_ld(&bar[XB_XCNT(j)]); sum += c; cnt += (c > 0u) ? 1u : 0u; mine = (j == x) ? c : mine; }
        if (sum == G) break;
        __builtin_amdgcn_s_sleep(1);
        if ((++sp & 255u) == 0u) { if (xb_ld(&bar[XB_TMO])) break; if (sp > XB_SPIN_CAP) { atomicAdd(&bar[XB_TMO], 1u); break; } }
    }
    nloc = mine > 0u ? mine : 1u; nx = cnt > 0u ? cnt : 1u;
}

__device__ __forceinline__ void xcd_barrier(const XcdBarrier& b) {
    asm volatile("s_waitcnt vmcnt(0)" ::: "memory");
    __syncthreads();
    if (threadIdx.x == 0) {
        unsigned* bar = b.bar;
        __builtin_amdgcn_s_waitcnt(0);
        unsigned nloc = b.st[0], nx = b.st[1];
        if (nloc == 0u) { xcd_barrier_complete(bar, b.x, nloc, nx); b.st[0] = nloc; b.st[1] = nx; }
        const unsigned old = xb_add(&bar[XB_XSUB(b.x)], 1u);
        const unsigned gen = old / nloc;
        if (old + 1u == (gen + 1u) * nloc) {
            __builtin_amdgcn_fence(__ATOMIC_RELEASE, "agent");
            asm volatile("s_waitcnt vmcnt(0)" ::: "memory");
            const unsigned og = xb_add(&bar[XB_TOP], 1u);
            const unsigned tg = og / nx;
            if (og + 1u == (tg + 1u) * nx) xb_add(&bar[XB_TOPGEN], 1u);
            else XB_SPIN(xb_ld(&bar[XB_TOPGEN]) == tg, bar);
            __builtin_amdgcn_fence(__ATOMIC_ACQUIRE, "agent");
            xb_add(&bar[XB_XGEN(b.x)], 1u);
            asm volatile("s_waitcnt vmcnt(0)" ::: "memory");
        } else {
            XB_SPIN(xb_ld(&bar[XB_XGEN(b.x)]) == gen, bar);
            __builtin_amdgcn_fence(__ATOMIC_ACQUIRE, "agent");
            asm volatile("s_waitcnt vmcnt(0)" ::: "memory");
        }
    }
    __syncthreads();
}

#ifndef MK_ALIGN
#define MK_ALIGN true
#endif
#ifndef MK_SP2
#define MK_SP2 true
#endif
#ifndef MK_SPLIT
#define MK_SPLIT 0
#endif
constexpr int NPL = 8, NPHASE = 1 + 2 * NPL + 1, PH_FINAL = NPHASE - 1;

typedef const __attribute__((address_space(4))) Args* KArgsP;
#define KARGS() ({ auto kp_ = __builtin_amdgcn_kernarg_segment_ptr(); asm volatile("" : "+s"(kp_)); (KArgsP)kp_; })
__global__ void __launch_bounds__(512, 2) fwd_kernel(Args a_unused, int ph_lo, int ph_hi) {
    (void)a_unused;
    extern __shared__ __attribute__((aligned(16))) unsigned char lds_raw[];
    LAS unsigned char* lds = (LAS unsigned char*)lds_raw;
    const int G = gridDim.x, bid = blockIdx.x;
#if MK_SPLIT
#define GRID_SYNC() do {} while (0)
    (void)lds;
#else
#define CG_SYNC() do { asm volatile("s_waitcnt vmcnt(0)" ::: "memory"); __syncthreads(); \
    if (threadIdx.x == 0) { __builtin_amdgcn_fence(__ATOMIC_RELEASE, "agent"); asm volatile("s_waitcnt vmcnt(0)" ::: "memory"); } \
    __syncthreads(); grid.sync(); \
    if (threadIdx.x == 0) { __builtin_amdgcn_fence(__ATOMIC_ACQUIRE, "agent"); asm volatile("s_waitcnt vmcnt(0)" ::: "memory"); } \
    __syncthreads(); } while (0)
    cg::grid_group grid = cg::this_grid();
    unsigned* barw = (unsigned*)(KARGS()->ws + WS_CTL);
    if (bid == 0) for (int i = threadIdx.x; i < XCD_BAR_WORDS; i += 512) __hip_atomic_store(barw + i, 0u, __ATOMIC_RELAXED, __HIP_MEMORY_SCOPE_AGENT);
    volatile LAS unsigned* xst = (volatile LAS unsigned*)(lds + 131072 + 64);
    if (threadIdx.x < 2) xst[threadIdx.x] = 0u;
    CG_SYNC();
    const XcdBarrier xbar = xcd_barrier_post(barw, xst);
#define GRID_SYNC() xcd_barrier(xbar)

#endif
#ifndef PHMASK
#define PHMASK 0xFFFFu
#endif
#define IN(k) (((PHMASK >> ((k) == 0 ? 0 : (k) == PH_FINAL ? 9 : 1 + ((k) - 1) % NPL)) & 1u) && ph_lo <= (k) && (k) < ph_hi)
#define SEAM(k) do { if (IN(k) && (k) + 1 < ph_hi) GRID_SYNC(); } while (0)
#define PHASE_BEGIN() KArgsP ka = KARGS(); unsigned char* ws = ka->ws; asm volatile("" : "+s"(ws)); float* rowss = (float*)(ws + WS_RS); float* Hm = (float*)(ws + WS_HM); bf16* HB = (bf16*)(ws + WS_HB); unsigned char* wl = ws + WS_W + (size_t)layer * LW_BYTES; \
    const int MT = NREAL; const bool META = layer != MK_NLAYER - 1;     \
    const float* rs_mix = rowss + (size_t)(2 * layer) * TPR * 16; float* rs_mlp = rowss + (size_t)(2 * layer + 1) * TPR * 16; float* rs_next = rowss + (size_t)(2 * layer + 2) * TPR * 16; (void)MT; (void)META; (void)Hm; (void)HB; (void)wl; (void)rs_mix; (void)rs_mlp; (void)rs_next;

    if (IN(0)) { Args al; { KArgsP kp = KARGS(); for (int i = 0; i < 23; ++i) al.in[i] = kp->in[i]; al.out = kp->out; al.ws = kp->ws; } p0_prologue(al, lds); }
    SEAM(0);
#ifndef MK_NLAYER
#define MK_NLAYER 2
#endif
#ifndef MK_RSIDX
#define MK_RSIDX 4
#endif
#pragma unroll 1
    for (int layer = 0; layer < MK_NLAYER; ++layer) {
        const int p = 1 + NPL * layer;
        if (IN(p)) { PHASE_BEGIN();
            pg8::Gemm g{HB, (const bf16*)(wl + OW_IN), TPR, NPROJ, DM}; pg8::StaticOrder S; S.init(TPR, NPROJ, G, bid);
            EpiInProj E{rs_mix, (const float*)(ws + WS_ROPE), (bf16*)(ws + WS_Q), (bf16*)(ws + WS_K), (bf16*)(ws + WS_V), (bf16*)(ws + WS_SU), (bf16*)(ws + WS_PU)};
            pg8::gemm_phase<EpiInProj, pg8::StaticOrder, MK_ALIGN, MK_SP2>(lds, g, S, E);
        }
        SEAM(p);
        if (IN(p + 1)) { PHASE_BEGIN();
            for (int t = bid; t < 256; t += G)
                ssm_task(lds, t, layer, (const bf16*)(ws + WS_SU), (float*)(ws + WS_YF), (const float*)(ws + WS_ABAR), (const bf16*)(ws + WS_BMAT), (const bf16*)(ws + WS_CMAT));
            for (int t = bid; t < NB * 2 * 33; t += G)
                attn_task(lds, t, (const bf16*)(ws + WS_Q), (const bf16*)(ws + WS_K), (const bf16*)(ws + WS_V), (bf16*)(ws + WS_YA), ka->in[4] + layer * 8);
            pool_diff((const bf16*)(ws + WS_PU), (bf16*)(ws + WS_PD));
        }
        SEAM(p + 1);
        if (IN(p + 2)) { PHASE_BEGIN();
            z_pass((const float*)(ws + WS_YF), (const bf16*)(ws + WS_SU), ka->in[12] + layer * 512, (bf16*)(ws + WS_Z));
        }
        SEAM(p + 2);
        if (IN(p + 3)) { PHASE_BEGIN();
            const int hg = G >> 1;
            if (bid < hg) { pg8::Gemm g{(const bf16*)(ws + WS_Z), (const bf16*)(wl + OW_GLU), MT, 512, 512}; pg8::StaticOrder S; S.init(MT, 512, hg, bid);
              EpiGlu E{(const bf16*)(ws + WS_Z), ka->in[14] + layer * 512, (bf16*)(ws + WS_YS)};
              pg8::gemm_phase<EpiGlu, pg8::StaticOrder, MK_ALIGN, MK_SP2>(lds, g, S, E); if (META) thin_gemm<EpiGlu>(lds, g.A, g.Bt, g.K, g.N, E, bid, hg); }
            else { pg8::Gemm g{(const bf16*)(ws + WS_PD), (const bf16*)(wl + OW_POOL), MT, 512, 512}; pg8::StaticOrder S; S.init(MT, 512, G - hg, bid - hg);
              EpiScale E{(bf16*)(ws + WS_YP), 512, ka->in[16] + layer * 512};
              pg8::gemm_phase<EpiScale, pg8::StaticOrder, MK_ALIGN, MK_SP2>(lds, g, S, E); if (META) thin_gemm<EpiScale>(lds, g.A, g.Bt, g.K, g.N, E, bid - hg, G - hg); }
        }
        SEAM(p + 3);
        if (IN(p + 4)) { PHASE_BEGIN();
#pragma unroll 1
            for (int c = 0; c < 3; ++c) {
                const bf16* Yc = (const bf16*)(ws + (c == 0 ? WS_YA : c == 1 ? WS_YS : WS_YP));
                { pg8::Gemm g{Yc, (const bf16*)(wl + OW_BR) + (size_t)c * 1024 * 512, MT, 1024, 512}; pg8::StaticOrder S; S.init(MT, 1024, G, bid);
                  EpiScale E{(bf16*)(ws + WS_BR), 1024, nullptr};
                  pg8::gemm_phase<EpiScale, pg8::StaticOrder, MK_ALIGN, MK_SP2>(lds, g, S, E); if (META) thin_gemm<EpiScale>(lds, g.A, g.Bt, g.K, g.N, E, bid, G); }
                pg8::Gemm g{HB, (const bf16*)(wl + OW_IN) + (size_t)(NPROJ + c * 1024) * DM, MT, 1024, DM}; pg8::StaticOrder S; S.init(MT, 1024, G, bid);
                if (c == 0) { EpiGate<true> E{rs_mix, (const bf16*)(ws + WS_BR), (bf16*)(ws + WS_MG)}; pg8::gemm_phase<EpiGate<true>, pg8::StaticOrder, MK_ALIGN, MK_SP2>(lds, g, S, E); if (META) thin_gemm<EpiGate<true>>(lds, g.A, g.Bt, g.K, g.N, E, bid, G); }
                else { EpiGate<false> E{rs_mix, (const bf16*)(ws + WS_BR), (bf16*)(ws + WS_MG)}; pg8::gemm_phase<EpiGate<false>, pg8::StaticOrder, MK_ALIGN, MK_SP2>(lds, g, S, E); if (META) thin_gemm<EpiGate<false>>(lds, g.A, g.Bt, g.K, g.N, E, bid, G); }
            }
        }
        SEAM(p + 4);
        if (IN(p + 5)) { PHASE_BEGIN();
            pg8::Gemm g{(const bf16*)(ws + WS_MG), (const bf16*)(wl + OW_OUT), MT, DM, DM}; pg8::StaticOrder S; S.init(MT, DM, G, bid);
            EpiRes E{ka->out, Hm, HB, rs_mlp};
            pg8::gemm_phase<EpiRes, pg8::StaticOrder, MK_ALIGN, MK_SP2>(lds, g, S, E); if (META) thin_gemm<EpiRes>(lds, g.A, g.Bt, g.K, g.N, E, bid, G);
        }
        SEAM(p + 5);
        if (IN(p + 6)) { PHASE_BEGIN();
            pg8::Gemm g{HB, (const bf16*)(wl + OW_UP), MT, FF, DM}; pg8::StaticOrder S; S.init(MT, FF, G, bid);
            EpiUp E{rs_mlp, (bf16*)(ws + WS_ACT)};
            pg8::gemm_phase<EpiUp, pg8::StaticOrder, MK_ALIGN, MK_SP2>(lds, g, S, E); if (META) thin_gemm<EpiUp>(lds, g.A, g.Bt, g.K, g.N, E, bid, G);
        }
        SEAM(p + 6);
        if (IN(p + 7)) { PHASE_BEGIN();
            pg8::Gemm g{(const bf16*)(ws + WS_ACT), (const bf16*)(wl + OW_DN), MT, DM, FF}; pg8::StaticOrder S; S.init(MT, DM, G, bid);
            EpiRes E{ka->out, Hm, HB, rs_next};
            pg8::gemm_phase<EpiRes, pg8::StaticOrder, MK_ALIGN, MK_SP2>(lds, g, S, E); if (META) thin_gemm<EpiRes>(lds, g.A, g.Bt, g.K, g.N, E, bid, G);
        }
        SEAM(p + 7);
    }
#ifdef MK_DUMP_OFF
    if (IN(PH_FINAL)) { KArgsP ka = KARGS();
        const bf16* src = (const bf16*)(ka->ws + (MK_DUMP_OFF)); const bf16* src2 = (const bf16*)(ka->ws + (MK_DUMP_OFF2));
        for (int i = bid * 512 + threadIdx.x; i < NREAL * 1024; i += G * 512) { const int R = MK_DUMP_ROW(i >> 10), c = i & 1023; ka->out[i] = c < 512 ? bf2f(src[(size_t)R * (MK_DUMP_LD) + (c % (MK_DUMP_LD))]) : bf2f(src2[(size_t)R * (MK_DUMP_LD2) + (c % (MK_DUMP_LD2))]); }
    }
#else
    if (IN(PH_FINAL)) { KArgsP ka = KARGS();
        const float* rs = (const float*)(ka->ws + WS_RS) + (size_t)MK_RSIDX * TPR * 16; const float* gain = ka->in[22];
        int tl_ = threadIdx.x; asm volatile("" : "+v"(tl_));
        for (int i = bid * 512 + tl_; i < NREAL * 256; i += G * 512) {
            const int R = i >> 8, c4 = (i & 255) * 4;
            const float r = row_rstd(rs, R);
            f32x4 v = *(const f32x4*)(ka->out + (size_t)R * DM + c4); const f32x4 gn = *(const f32x4*)(gain + c4);
            v = v * r * gn;
            *(f32x4*)(ka->out + (size_t)R * DM + c4) = v;
        }
    }
#endif
#undef IN
#undef SEAM
}

extern "C" void kernel_launch(void* const* d_in, const int* in_sizes, int n_in, void* d_out, int out_size, void* d_ws, size_t ws_size, hipStream_t stream) {
    static int grid = 0;
    if (grid == 0) {
        if (n_in != 23 || out_size != NREAL * DM || ws_size < WS_END) { fprintf(stderr, "kernel_launch: unexpected shapes (n_in %d out %d ws %zu)\n", n_in, out_size, ws_size); grid = -1; return; }
        int dev = 0, cus = 0, per_cu = 0;
        hipGetDevice(&dev); hipDeviceGetAttribute(&cus, hipDeviceAttributeMultiprocessorCount, dev);
        if (hipFuncSetAttribute((const void*)fwd_kernel, hipFuncAttributeMaxDynamicSharedMemorySize, LDS_BYTES) != hipSuccess) { fprintf(stderr, "kernel_launch: hipFuncSetAttribute failed\n"); grid = -1; return; }
        if (hipOccupancyMaxActiveBlocksPerMultiprocessor(&per_cu, (const void*)fwd_kernel, 512, LDS_BYTES) != hipSuccess || per_cu < 1) { fprintf(stderr, "kernel_launch: occupancy query gave %d\n", per_cu); per_cu = 1; }
        (void)hipGetLastError();
        grid = cus * (per_cu > 1 ? 1 : per_cu);
        if (grid <= 0) grid = 256;
    }
    if (grid < 0) return;
    Args a{};
    for (int i = 0; i < 23; ++i) a.in[i] = (const float*)d_in[i];
    a.out = (float*)d_out; a.ws = (unsigned char*)d_ws;
#if MK_SPLIT
    for (int ph = 0; ph < NPHASE; ++ph) hipLaunchKernelGGL(fwd_kernel, dim3(grid), dim3(512), LDS_BYTES, stream, a, ph, ph + 1);
#else
    int lo = 0, hi = NPHASE;
    void* kargs[] = {(void*)&a, (void*)&lo, (void*)&hi};
    hipError_t e = hipLaunchCooperativeKernel((const void*)fwd_kernel, dim3(grid), dim3(512), kargs, LDS_BYTES, stream);
    if (e != hipSuccess) fprintf(stderr, "kernel_launch: cooperative launch failed: %s (grid %d)\n", hipGetErrorString(e), grid);
#endif
}
```

```cpp
#include <hip/hip_runtime.h>
#include <hip/hip_cooperative_groups.h>
#include <cstdio>
#include <cstdint>
namespace cg = cooperative_groups;
namespace pg8 {
#define PG8_LAS __attribute__((address_space(3)))
typedef unsigned short bf16_t;
typedef short bf16x8 __attribute__((ext_vector_type(8)));
typedef float f32x4 __attribute__((ext_vector_type(4)));
typedef unsigned u32x4 __attribute__((ext_vector_type(4)));
constexpr int BM = 256, BK = 64, HALF = 128, HTB = HALF * BK * 2  , STAGE_BYTES = 8 * HTB, NXCD = 8, WGM = 8;

__host__ __device__ __forceinline__ int lds_byte(int r, int c) { const int st = (r >> 4) * 2 + (c >> 5), rr = r & 15, cc = c & 31, ob = rr * 64 + cc * 2; return st * 1024 + (ob ^ (((ob >> 9) & 1) << 5)); }
__host__ __device__ __forceinline__ void stage_rc(int b, int& R, int& C) { const int st = b / 1024, sb = b % 1024, swz = sb ^ (((sb >> 9) & 1) << 5); R = (st >> 1) * 16 + swz / 64; C = (st & 1) * 32 + (swz % 64) / 2; }
__host__ __device__ __forceinline__ int perm32(int rho) { const int n = rho >> 4, i = rho & 15; return 8 * (i >> 2) + 4 * n + (i & 3); }

struct Unit { int pm, pn; };
struct Gemm { const bf16_t* A; const bf16_t* Bt; int M, N, K; };

struct StaticOrder {
    int nM, nN, nwg, G, c;
    __host__ __device__ void init(int M, int N, int G_, int c_) { nM = M / BM; nN = N / BM; nwg = nM * nN; G = G_; c = c_; }
    __host__ __device__ bool next(int i, Unit& u) const {
        const long L = (long)i * G + c; if (L >= nwg) return false;
        int wgid = (int)L; { const int q = nwg / NXCD, r = nwg % NXCD, xcd = wgid % NXCD, off = wgid / NXCD; wgid = (xcd < r ? xcd * (q + 1) : r * (q + 1) + (xcd - r) * q) + off; }
        const int nig = WGM * nN, gid = wgid / nig, fm = gid * WGM, gsz = (nM - fm) < WGM ? (nM - fm) : WGM;
        u.pm = fm + ((wgid % nig) % gsz); u.pn = (wgid % nig) / gsz; return true;
    }
    __device__ __forceinline__ void a_ready(const Unit&) const {}
    __device__ __forceinline__ void done(const Unit&) const {}
};

__device__ __forceinline__ unsigned cvt_pk_bf16(float lo, float hi) { unsigned r; asm volatile("v_cvt_pk_bf16_f32 %0, %1, %2" : "=v"(r) : "v"(lo), "v"(hi)); return r; }
template <class Epi, class Sched, bool ALIGN_EPI = false, bool SP2 = false>
__device__ __forceinline__ void gemm_phase(PG8_LAS unsigned char* lds, const Gemm g, const Sched& S, const Epi& E) {
    int tid_l = threadIdx.x; asm volatile("" : "+v"(tid_l));
    const int tid = tid_l, wid = __builtin_amdgcn_readfirstlane(tid >> 6), lane = tid & 63, wr = wid >> 2, wc = wid & 3, fr = lane & 15, fq = lane >> 4;
    const int K = g.K, nt = K / BK;
    unsigned voffA[2], voffB[2];
#pragma unroll
    for (int i = 0; i < 2; ++i) { int R, C; stage_rc(tid * 16 + i * 8192, R, C); const int Rb = Epi::PERM ? ((R & ~31) + perm32(R & 31)) : R;
        voffA[i] = (unsigned)(R * K + C) * 2u; voffB[i] = (unsigned)(Rb * K + C) * 2u; }
    const size_t kstep = (size_t)(BK * 2);
    const size_t hstep = (size_t)HALF * K * 2;
    const size_t tstep = 2 * hstep;
    const unsigned ldsw = (unsigned)wid * 1024u;
    const int aoff = lds_byte(wr * 64 + fr, fq * 8), boff = lds_byte(wc * 32 + fr, fq * 8);
#define PG8_SA(b, h) (((b) * 2 + (h)) * HTB)
#define PG8_SB(b, h) ((4 + (b) * 2 + (h)) * HTB)
#define PG8_STAGE(bufoff, gbase, voff) do { _Pragma("unroll") for (int _i = 0; _i < 2; ++_i) \
        __builtin_amdgcn_global_load_lds((const unsigned*)((const char*)(gbase) + (voff)[_i]), (PG8_LAS unsigned*)(lds + (bufoff) + ldsw + _i * 8192), 16, 0, 0); } while (0)
#define PG8_LDA(dst, b, h) do { _Pragma("unroll") for (int m = 0; m < 4; ++m) _Pragma("unroll") for (int k = 0; k < 2; ++k) dst[m][k] = *(const PG8_LAS bf16x8*)(lds + PG8_SA(b, h) + aoff + m * 2048 + k * 1024); } while (0)
#define PG8_LDB(dst, b, h) do { _Pragma("unroll") for (int n = 0; n < 2; ++n) _Pragma("unroll") for (int k = 0; k < 2; ++k) dst[n][k] = *(const PG8_LAS bf16x8*)(lds + PG8_SB(b, h) + boff + n * 2048 + k * 1024); } while (0)
#define PG8_MMA(ai, bj, At, Bt) do { __builtin_amdgcn_s_setprio(1); _Pragma("unroll") for (int m = 0; m < 4; ++m) _Pragma("unroll") for (int n = 0; n < 2; ++n) _Pragma("unroll") for (int k = 0; k < 2; ++k) \
        acc[ai][bj][m][n] = __builtin_amdgcn_mfma_f32_16x16x32_bf16(Bt[n][k], At[m][k], acc[ai][bj][m][n], 0, 0, 0); __builtin_amdgcn_s_setprio(0); } while (0)
#define PG8_WAIT_V(n) asm volatile("s_waitcnt vmcnt(" #n ")" ::: "memory")
#define PG8_WAIT_L(n) asm volatile("s_waitcnt lgkmcnt(" #n ")" ::: "memory")
#define PG8_BAR __builtin_amdgcn_s_barrier()
#define PG8_SCHED __builtin_amdgcn_sched_barrier(0)
    Unit cur, nxt; int ui = 0;
    if (!S.next(0, cur)) return;
    f32x4 acc[2][2][4][2];
#pragma unroll
    for (int a = 0; a < 2; ++a)
#pragma unroll
        for (int b = 0; b < 2; ++b)
#pragma unroll
            for (int m = 0; m < 4; ++m)
#pragma unroll
                for (int n = 0; n < 2; ++n) acc[a][b][m][n] = (f32x4){0.f, 0.f, 0.f, 0.f};
    bf16x8 At[4][2], B0[2][2], B1[2][2];
    const char* cA = (const char*)g.A + (size_t)cur.pm * tstep; const char* cB = (const char*)g.Bt + (size_t)cur.pn * tstep;
    S.a_ready(cur);
    if constexpr (SP2) {
        PG8_STAGE(PG8_SB(0, 0), cB, voffB); PG8_STAGE(PG8_SB(0, 1), cB + hstep, voffB); PG8_STAGE(PG8_SA(0, 0), cA, voffA); PG8_STAGE(PG8_SA(0, 1), cA + hstep, voffA);
        if (wr == 1) PG8_BAR;
        PG8_WAIT_V(2); PG8_BAR;
        PG8_STAGE(PG8_SB(1, 0), cB + kstep, voffB); PG8_STAGE(PG8_SA(1, 0), cA + kstep, voffA); PG8_STAGE(PG8_SB(1, 1), cB + hstep + kstep, voffB);
        PG8_WAIT_V(6); PG8_BAR;
    } else {
        PG8_STAGE(PG8_SB(0, 0), cB, voffB); PG8_STAGE(PG8_SA(0, 0), cA, voffA); PG8_STAGE(PG8_SB(0, 1), cB + hstep, voffB); PG8_STAGE(PG8_SA(0, 1), cA + hstep, voffA);
        if (wr == 1) PG8_BAR;
        PG8_WAIT_V(4); PG8_BAR;
        PG8_STAGE(PG8_SB(1, 0), cB + kstep, voffB); PG8_STAGE(PG8_SA(1, 0), cA + kstep, voffA); PG8_STAGE(PG8_SB(1, 1), cB + hstep + kstep, voffB);
        PG8_WAIT_V(6); PG8_BAR;
    }
    for (;;) {
        const bool has_next = S.next(ui + 1, nxt);
        const char* nA = has_next ? (const char*)g.A + (size_t)nxt.pm * tstep : cA; const char* nB = has_next ? (const char*)g.Bt + (size_t)nxt.pn * tstep : cB;
        for (int t = 0; t < nt; t += 2) {
            const bool last = (t == nt - 2);
            const char* a1 = cA + (size_t)(t + 1) * kstep;
            const char* a2 = last ? nA : cA + (size_t)(t + 2) * kstep; const char* b2 = last ? nB : cB + (size_t)(t + 2) * kstep;
            const char* a3 = a2 + kstep; const char* b3 = b2 + kstep;
            if (last && has_next) S.a_ready(nxt);
            if constexpr (SP2) {
            PG8_LDB(B0, 0, 0); PG8_LDB(B1, 0, 1); PG8_SCHED; PG8_LDA(At, 0, 0); PG8_STAGE(PG8_SA(1, 1), a1 + hstep, voffA);
            PG8_WAIT_V(8); PG8_WAIT_L(0); PG8_BAR; PG8_MMA(0, 0, At, B0); PG8_MMA(0, 1, At, B1); PG8_BAR; PG8_SCHED;
            PG8_LDA(At, 0, 1); PG8_STAGE(PG8_SB(0, 0), b2, voffB); PG8_STAGE(PG8_SB(0, 1), b2 + hstep, voffB); PG8_STAGE(PG8_SA(0, 0), a2, voffA);
            PG8_WAIT_V(8); PG8_WAIT_L(0); PG8_BAR; PG8_MMA(1, 0, At, B0); PG8_MMA(1, 1, At, B1); PG8_BAR; PG8_SCHED;
            PG8_LDB(B0, 1, 0); PG8_LDB(B1, 1, 1); PG8_SCHED; PG8_LDA(At, 1, 0); PG8_STAGE(PG8_SA(0, 1), a2 + hstep, voffA);
            PG8_WAIT_V(8); PG8_WAIT_L(0); PG8_BAR; PG8_MMA(0, 0, At, B0); PG8_MMA(0, 1, At, B1); PG8_BAR; PG8_SCHED;
            PG8_LDA(At, 1, 1); PG8_STAGE(PG8_SB(1, 0), b3, voffB); PG8_STAGE(PG8_SB(1, 1), b3 + hstep, voffB); PG8_STAGE(PG8_SA(1, 0), a3, voffA);
            PG8_WAIT_V(8); PG8_WAIT_L(0); PG8_BAR; PG8_MMA(1, 0, At, B0); PG8_MMA(1, 1, At, B1); PG8_BAR; PG8_SCHED;
            } else {
            PG8_LDB(B0, 0, 0); PG8_SCHED; PG8_LDA(At, 0, 0); PG8_STAGE(PG8_SA(1, 1), a1 + hstep, voffA);
            PG8_WAIT_L(8); PG8_BAR; PG8_WAIT_L(0); PG8_MMA(0, 0, At, B0); PG8_BAR; PG8_SCHED;
            PG8_LDB(B1, 0, 1); PG8_STAGE(PG8_SB(0, 0), b2, voffB);
            PG8_BAR; PG8_WAIT_L(0); PG8_MMA(0, 1, At, B1); PG8_BAR;
            PG8_LDA(At, 0, 1); PG8_STAGE(PG8_SA(0, 0), a2, voffA);
            PG8_BAR; PG8_WAIT_L(0); PG8_MMA(1, 0, At, B0); PG8_BAR; PG8_SCHED;
            PG8_STAGE(PG8_SB(0, 1), b2 + hstep, voffB);
            PG8_WAIT_V(6); PG8_BAR; PG8_MMA(1, 1, At, B1); PG8_BAR;
            PG8_LDB(B0, 1, 0); PG8_SCHED; PG8_LDA(At, 1, 0); PG8_STAGE(PG8_SA(0, 1), a2 + hstep, voffA);
            PG8_WAIT_L(8); PG8_BAR; PG8_WAIT_L(0); PG8_MMA(0, 0, At, B0); PG8_BAR; PG8_SCHED;
            PG8_LDB(B1, 1, 1); PG8_STAGE(PG8_SB(1, 0), b3, voffB);
            PG8_BAR; PG8_WAIT_L(0); PG8_MMA(0, 1, At, B1); PG8_BAR;
            PG8_LDA(At, 1, 1); PG8_STAGE(PG8_SA(1, 0), a3, voffA);
            PG8_BAR; PG8_WAIT_L(0); PG8_MMA(1, 0, At, B0); PG8_BAR; PG8_SCHED;
            PG8_STAGE(PG8_SB(1, 1), b3 + hstep, voffB);
            PG8_WAIT_V(6); PG8_BAR; PG8_MMA(1, 1, At, B1); PG8_BAR;
            }
        }
        if constexpr (ALIGN_EPI) { if (wr == 0) PG8_BAR; }
        asm volatile("s_nop 15\n\ts_nop 15" ::: "memory");
        if constexpr (!Epi::AFTER_DRAIN) { E(acc, cur, wr, wc, fr, fq); S.done(cur); }
        if (!has_next) break;
#pragma unroll
        for (int a = 0; a < 2; ++a)
#pragma unroll
            for (int b = 0; b < 2; ++b)
#pragma unroll
                for (int m = 0; m < 4; ++m)
#pragma unroll
                    for (int n = 0; n < 2; ++n) acc[a][b][m][n] = (f32x4){0.f, 0.f, 0.f, 0.f};
        cur = nxt; cA = nA; cB = nB; ++ui;
        if constexpr (ALIGN_EPI) { if (wr == 1) PG8_BAR; }
    }
    PG8_WAIT_V(0);
    if constexpr (!ALIGN_EPI) { if (wr == 0) PG8_BAR; }
    PG8_BAR;
    if constexpr (Epi::AFTER_DRAIN) { E.fused(acc, cur, wr, wc, fr, fq, lds, wid, lane); S.done(cur); }
#undef PG8_SA
#undef PG8_SB
#undef PG8_STAGE
#undef PG8_LDA
#undef PG8_LDB
#undef PG8_MMA
#undef PG8_WAIT_V
#undef PG8_WAIT_L
#undef PG8_BAR
#undef PG8_SCHED
}
}

#define LAS __attribute__((address_space(3)))
typedef unsigned short bf16;
typedef short bf16x8 __attribute__((ext_vector_type(8)));
typedef float f32x4 __attribute__((ext_vector_type(4)));
typedef float f32x16 __attribute__((ext_vector_type(16)));
typedef unsigned u32x2 __attribute__((ext_vector_type(2)));
typedef unsigned u32x4 __attribute__((ext_vector_type(4)));

constexpr int NB = 8, SEQ = 2048, NMETA = 16, LL = 2064, DM = 1024, FF = 4096, DIN = 4864, NPROJ = 1792;
constexpr int NREAL = NB * SEQ;
constexpr int TPR = NREAL + 256;
constexpr int LDS_BYTES = 147456;

constexpr size_t MiB = 1u << 20;
constexpr size_t WS_CTL = 0;
constexpr size_t WS_ROPE = 1 * MiB;
constexpr size_t WS_ABAR = 2 * MiB;
constexpr size_t WS_BMAT = 2 * MiB + 65536;
constexpr size_t WS_CMAT = WS_BMAT + 524288;
constexpr size_t WS_HM = 4 * MiB;
constexpr size_t WS_W = 5 * MiB;
constexpr size_t OW_IN = 0, OW_GLU = (size_t)DIN * DM * 2, OW_POOL = OW_GLU + 512 * 512 * 2, OW_BR = OW_POOL + 512 * 512 * 2,
                 OW_OUT = OW_BR + 3 * 1024 * 512 * 2, OW_UP = OW_OUT + 1024 * 1024 * 2, OW_DN = OW_UP + (size_t)FF * DM * 2, LW_BYTES = OW_DN + (size_t)FF * DM * 2;
constexpr size_t WS_HB = 68 * MiB;
constexpr size_t WS_X = 101 * MiB;
constexpr size_t UU = (size_t)TPR * 512 * 2;
constexpr size_t WS_YF = WS_X, WS_YP = WS_X, WS_Q = WS_X + 2 * UU, WS_K = WS_Q + UU, WS_V = WS_K + UU / 4, WS_MG = WS_X + 2 * UU,
                 WS_SU = WS_X + 4 * UU, WS_YA = WS_X + 8 * UU  , WS_PU = WS_X + 5 * UU, WS_YS = WS_PU, WS_Z = WS_X + 6 * UU, WS_PD = WS_X + 7 * UU, WS_BR = WS_Z, WS_ACT = WS_X;
constexpr size_t WS_RS = WS_X + 9 * UU;
constexpr size_t WS_END = WS_RS + (size_t)5 * TPR * 16 * 4;
static_assert(WS_W + 2 * LW_BYTES <= WS_HB && WS_HB + (size_t)TPR * 1024 * 2 <= WS_X && WS_END <= 256 * MiB, "ws map");
static_assert((size_t)256 * 2064 * 16 * 4 <= 2 * UU, "YF fits");

__device__ __forceinline__ unsigned pk2(float lo, float hi) { unsigned r; asm("v_cvt_pk_bf16_f32 %0, %1, %2" : "=v"(r) : "v"(lo), "v"(hi)); return r; }
__device__ __forceinline__ unsigned f2bf(float f) { return pk2(f, 0.f) & 0xffffu; }
__device__ __forceinline__ float bf2f(unsigned b) { return __uint_as_float(b << 16); }
__device__ __forceinline__ int tok_row(int b, int l) { return l >= NMETA ? b * SEQ + l - NMETA : NREAL + b * NMETA + l; }
#define LDS_FENCE() asm volatile("s_waitcnt lgkmcnt(0)" ::: "memory")
#define SSM_SYNC() do { asm volatile("s_waitcnt vmcnt(0) lgkmcnt(0)" ::: "memory"); __syncthreads(); } while (0)
__device__ __forceinline__ float row_rstd(const float* rs, int R) {
    const f32x4 a = *(const f32x4*)(rs + (size_t)R * 4), b = *(const f32x4*)(rs + ((size_t)TPR + R) * 4), c = *(const f32x4*)(rs + ((size_t)2 * TPR + R) * 4), d = *(const f32x4*)(rs + ((size_t)3 * TPR + R) * 4);
    const float s = (((a[0] + a[1]) + (a[2] + a[3])) + ((b[0] + b[1]) + (b[2] + b[3]))) + (((c[0] + c[1]) + (c[2] + c[3])) + ((d[0] + d[1]) + (d[2] + d[3])));
    return rsqrtf(s * (1.0f / 1024.0f) + 1e-6f);
}

__device__ __forceinline__ void dsincos(double a, double& s, double& c) {
    const double q = rint(a * 0.63661977236758134308);
    double r = fma(-q, 1.57079632679489655800e+00, a); r = fma(-q, 6.12323399573676603587e-17, r);
    const double r2 = r * r;
    double sp = -7.6471637318198164759e-13; sp = fma(sp, r2, 1.6059043836821614599e-10); sp = fma(sp, r2, -2.5052108385441718775e-08); sp = fma(sp, r2, 2.7557319223985890653e-06);
    sp = fma(sp, r2, -1.9841269841269841270e-04); sp = fma(sp, r2, 8.3333333333333333333e-03); sp = fma(sp, r2, -1.6666666666666666667e-01); sp = fma(sp * r2, r, r);
    double cp = 4.7794773323873852974e-14; cp = fma(cp, r2, -1.1470745597729724714e-11); cp = fma(cp, r2, 2.0876756987868098979e-09); cp = fma(cp, r2, -2.7557319223985890653e-07);
    cp = fma(cp, r2, 2.4801587301587301587e-05); cp = fma(cp, r2, -1.3888888888888888889e-03); cp = fma(cp, r2, 4.1666666666666666667e-02); cp = fma(cp, r2, -0.5); cp = fma(cp, r2, 1.0);
    const int qi = ((int)q) & 3;
    s = (qi == 0) ? sp : (qi == 1) ? cp : (qi == 2) ? -sp : -cp;
    c = (qi == 0) ? cp : (qi == 1) ? -sp : (qi == 2) ? -cp : sp;
}
__device__ __forceinline__ double dexp(double x) {
    const double k = rint(x * 1.44269504088896340736);
    double r = fma(-k, 6.93147180369123816490e-01, x); r = fma(-k, 1.90821492927058770002e-10, r);
    double p = 1.0 / 6227020800.0; p = fma(p, r, 1.0 / 479001600.0); p = fma(p, r, 1.0 / 39916800.0); p = fma(p, r, 1.0 / 3628800.0); p = fma(p, r, 1.0 / 362880.0); p = fma(p, r, 1.0 / 40320.0);
    p = fma(p, r, 1.0 / 5040.0); p = fma(p, r, 1.0 / 720.0); p = fma(p, r, 1.0 / 120.0); p = fma(p, r, 1.0 / 24.0); p = fma(p, r, 1.0 / 6.0); p = fma(p, r, 0.5); p = fma(p, r, 1.0); p = fma(p, r, 1.0);
    const long long bits = ((long long)(1023 + (int)k)) << 52;
    return p * __longlong_as_double(bits);
}

struct EpiInProj {
    static constexpr bool PERM = true, AFTER_DRAIN = false;
    const float* rowss; const float* rope; bf16 *Q, *K, *V, *SU, *PU;
    __device__ __forceinline__ u32x2 quad(int l, int c, const f32x4& v) const {
        u32x2 w;
        if (c < 640) {
            const int i0 = (c & 63) >> 1;
            const f32x4 cs = *(const f32x4*)(rope + ((size_t)l * 32 + i0) * 2);
            float o0 = v[0] * cs[0] - v[1] * cs[1], o1 = v[1] * cs[0] + v[0] * cs[1], o2 = v[2] * cs[2] - v[3] * cs[3], o3 = v[3] * cs[2] + v[2] * cs[3];
            if (c < 512) { o0 *= 0.125f; o1 *= 0.125f; o2 *= 0.125f; o3 *= 0.125f; }
            w.x = pk2(o0, o1); w.y = pk2(o2, o3);
        } else { w.x = pk2(v[0], v[1]); w.y = pk2(v[2], v[3]); }
        return w;
    }
    __device__ __forceinline__ void operator()(const f32x4 (&acc)[2][2][4][2], const pg8::Unit& u, int wr, int wc, int fr, int fq) const {
#pragma unroll
        for (int ai = 0; ai < 2; ++ai)
#pragma unroll
            for (int m = 0; m < 4; ++m) {
                const int R = u.pm * 256 + ai * 128 + wr * 64 + m * 16 + fr;
                const float rs = row_rstd(rowss, R);
                const int l = R < NREAL ? (R & 2047) + NMETA : (R & 15);
#pragma unroll
                for (int bj = 0; bj < 2; ++bj) {
                    const int c = u.pn * 256 + bj * 128 + wc * 32 + 8 * fq;
                    const u32x2 w0 = quad(l, c, acc[ai][bj][m][0] * rs), w1 = quad(l, c + 4, acc[ai][bj][m][1] * rs);
                    u32x4 w; w.x = w0.x; w.y = w0.y; w.z = w1.x; w.w = w1.y;
                    bf16* dst = c < 512 ? Q + (size_t)R * 512 + c : c < 640 ? K + (size_t)R * 128 + (c - 512) : c < 768 ? V + (size_t)R * 128 + (c - 640)
                              : c < 1280 ? SU + (size_t)R * 512 + (c - 768) : PU + (size_t)R * 512 + (c - 1280);
                    *(u32x4*)dst = w;
                }
            }
    }
};
#define EPI_BODY() \
    __device__ __forceinline__ void rg(int R, int pn, int wc, int fq, const f32x4 (&a4)[2][2]) const { \
        _Pragma("unroll") for (int bj = 0; bj < 2; ++bj) q2(R, pn * 256 + bj * 128 + wc * 32 + 8 * fq, a4[bj][0], a4[bj][1]); } \
    __device__ __forceinline__ void tq(int R, int c, const f32x4& v) const { q(R, c, v); } \
    EPI_OP()
#define EPI_OP() \
    __device__ __forceinline__ void operator()(const f32x4 (&acc)[2][2][4][2], const pg8::Unit& u, int wr, int wc, int fr, int fq) const { \
        _Pragma("unroll") for (int ai = 0; ai < 2; ++ai) _Pragma("unroll") for (int m = 0; m < 4; ++m) { \
            const f32x4 a4[2][2] = {{acc[ai][0][m][0], acc[ai][0][m][1]}, {acc[ai][1][m][0], acc[ai][1][m][1]}}; \
            rg(u.pm * 256 + ai * 128 + wr * 64 + m * 16 + fr, u.pn, wc, fq, a4); } }
#define EPI_BODY_RS() \
    __device__ __forceinline__ void rg(int R, int pn, int wc, int fq, const f32x4 (&a4)[2][2]) const { const float rs = row_rstd(rowss, R); \
        _Pragma("unroll") for (int bj = 0; bj < 2; ++bj) q2(R, pn * 256 + bj * 128 + wc * 32 + 8 * fq, a4[bj][0], a4[bj][1], rs); } \
    __device__ __forceinline__ void tq(int R, int c, const f32x4& v) const { q(R, c, v, row_rstd(rowss, R)); } \
    EPI_OP()
struct EpiGlu {
    static constexpr bool PERM = true, AFTER_DRAIN = false;
    const bf16* Z; const float* bias; bf16* YS;
    __device__ __forceinline__ void q(int R, int c, const f32x4& a) const {
        const f32x4 v = a + *(const f32x4*)(bias + c);
        const u32x2 zz = *(const u32x2*)(Z + (size_t)R * 512 + c);
        const float z0 = bf2f(zz.x & 0xffffu), z1 = bf2f(zz.x >> 16), z2 = bf2f(zz.y & 0xffffu), z3 = bf2f(zz.y >> 16);
        u32x2 w; w.x = pk2(z0 * __builtin_amdgcn_rcpf(1.0f + __expf(-v[0])), z1 * __builtin_amdgcn_rcpf(1.0f + __expf(-v[1]))); w.y = pk2(z2 * __builtin_amdgcn_rcpf(1.0f + __expf(-v[2])), z3 * __builtin_amdgcn_rcpf(1.0f + __expf(-v[3])));
        *(u32x2*)(YS + (size_t)R * 512 + c) = w;
    }
    __device__ __forceinline__ void q2(int R, int c, const f32x4& a0, const f32x4& a1) const {
        const f32x4 v0 = a0 + *(const f32x4*)(bias + c), v1 = a1 + *(const f32x4*)(bias + c + 4);
        const u32x4 zz = *(const u32x4*)(Z + (size_t)R * 512 + c);
        u32x4 w;
        w.x = pk2(bf2f(zz.x & 0xffffu) * __builtin_amdgcn_rcpf(1.0f + __expf(-v0[0])), bf2f(zz.x >> 16) * __builtin_amdgcn_rcpf(1.0f + __expf(-v0[1])));
        w.y = pk2(bf2f(zz.y & 0xffffu) * __builtin_amdgcn_rcpf(1.0f + __expf(-v0[2])), bf2f(zz.y >> 16) * __builtin_amdgcn_rcpf(1.0f + __expf(-v0[3])));
        w.z = pk2(bf2f(zz.z & 0xffffu) * __builtin_amdgcn_rcpf(1.0f + __expf(-v1[0])), bf2f(zz.z >> 16) * __builtin_amdgcn_rcpf(1.0f + __expf(-v1[1])));
        w.w = pk2(bf2f(zz.w & 0xffffu) * __builtin_amdgcn_rcpf(1.0f + __expf(-v1[2])), bf2f(zz.w >> 16) * __builtin_amdgcn_rcpf(1.0f + __expf(-v1[3])));
        *(u32x4*)(YS + (size_t)R * 512 + c) = w;
    }
    EPI_BODY()
};
struct EpiScale {
    static constexpr bool PERM = true, AFTER_DRAIN = false;
    bf16* O; int ldc; const float* scale;
    __device__ __forceinline__ void q(int R, int c, const f32x4& a) const {
        f32x4 v = a;
        if (scale) v = v * *(const f32x4*)(scale + c);
        u32x2 w; w.x = pk2(v[0], v[1]); w.y = pk2(v[2], v[3]);
        *(u32x2*)(O + (size_t)R * ldc + c) = w;
    }
    __device__ __forceinline__ void q2(int R, int c, const f32x4& a0, const f32x4& a1) const {
        f32x4 v0 = a0, v1 = a1;
        if (scale) { v0 = v0 * *(const f32x4*)(scale + c); v1 = v1 * *(const f32x4*)(scale + c + 4); }
        u32x4 w; w.x = pk2(v0[0], v0[1]); w.y = pk2(v0[2], v0[3]); w.z = pk2(v1[0], v1[1]); w.w = pk2(v1[2], v1[3]);
        *(u32x4*)(O + (size_t)R * ldc + c) = w;
    }
    EPI_BODY()
};
template <bool FIRST> struct EpiGate {
    static constexpr bool PERM = true, AFTER_DRAIN = false;
    const float* rowss; const bf16* BR; bf16* MG;
    __device__ __forceinline__ void q(int R, int c, const f32x4& a, float rs) const {
        const f32x4 v = a * rs;
        const u32x2 bb = *(const u32x2*)(BR + (size_t)R * 1024 + c);
        float o0 = bf2f(bb.x & 0xffffu) * __builtin_amdgcn_rcpf(1.0f + __expf(-v[0])), o1 = bf2f(bb.x >> 16) * __builtin_amdgcn_rcpf(1.0f + __expf(-v[1]));
        float o2 = bf2f(bb.y & 0xffffu) * __builtin_amdgcn_rcpf(1.0f + __expf(-v[2])), o3 = bf2f(bb.y >> 16) * __builtin_amdgcn_rcpf(1.0f + __expf(-v[3]));
        if (!FIRST) { const u32x2 mm = *(const u32x2*)(MG + (size_t)R * 1024 + c);
            o0 += bf2f(mm.x & 0xffffu); o1 += bf2f(mm.x >> 16); o2 += bf2f(mm.y & 0xffffu); o3 += bf2f(mm.y >> 16); }
        u32x2 w; w.x = pk2(o0, o1); w.y = pk2(o2, o3);
        *(u32x2*)(MG + (size_t)R * 1024 + c) = w;
    }
    __device__ __forceinline__ void q2(int R, int c, const f32x4& a0, const f32x4& a1, float rs) const {
        const f32x4 v0 = a0 * rs, v1 = a1 * rs;
        const u32x4 bb = *(const u32x4*)(BR + (size_t)R * 1024 + c);
        float o[8];
        o[0] = bf2f(bb.x & 0xffffu) * __builtin_amdgcn_rcpf(1.0f + __expf(-v0[0])); o[1] = bf2f(bb.x >> 16) * __builtin_amdgcn_rcpf(1.0f + __expf(-v0[1]));
        o[2] = bf2f(bb.y & 0xffffu) * __builtin_amdgcn_rcpf(1.0f + __expf(-v0[2])); o[3] = bf2f(bb.y >> 16) * __builtin_amdgcn_rcpf(1.0f + __expf(-v0[3]));
        o[4] = bf2f(bb.z & 0xffffu) * __builtin_amdgcn_rcpf(1.0f + __expf(-v1[0])); o[5] = bf2f(bb.z >> 16) * __builtin_amdgcn_rcpf(1.0f + __expf(-v1[1]));
        o[6] = bf2f(bb.w & 0xffffu) * __builtin_amdgcn_rcpf(1.0f + __expf(-v1[2])); o[7] = bf2f(bb.w >> 16) * __builtin_amdgcn_rcpf(1.0f + __expf(-v1[3]));
        if (!FIRST) { const u32x4 mm = *(const u32x4*)(MG + (size_t)R * 1024 + c);
            o[0] += bf2f(mm.x & 0xffffu); o[1] += bf2f(mm.x >> 16); o[2] += bf2f(mm.y & 0xffffu); o[3] += bf2f(mm.y >> 16);
            o[4] += bf2f(mm.z & 0xffffu); o[5] += bf2f(mm.z >> 16); o[6] += bf2f(mm.w & 0xffffu); o[7] += bf2f(mm.w >> 16); }
        u32x4 w; w.x = pk2(o[0], o[1]); w.y = pk2(o[2], o[3]); w.z = pk2(o[4], o[5]); w.w = pk2(o[6], o[7]);
        *(u32x4*)(MG + (size_t)R * 1024 + c) = w;
    }
    EPI_BODY_RS()
};
struct EpiRes {
    static constexpr bool PERM = true, AFTER_DRAIN = false;
    float* Hreal; float* Hmeta; bf16* HB; float* rowss_out;
    __device__ __forceinline__ float q(int R, int c, const f32x4& a) const {
        float* hrow = R < NREAL ? Hreal + (size_t)R * 1024 : Hmeta + (size_t)(R - NREAL) * 1024;
        const f32x4 h = *(const f32x4*)(hrow + c) + a;
        *(f32x4*)(hrow + c) = h;
        u32x2 w; w.x = pk2(h[0], h[1]); w.y = pk2(h[2], h[3]);
        *(u32x2*)(HB + (size_t)R * 1024 + c) = w;
        return (h[0] * h[0] + h[1] * h[1]) + (h[2] * h[2] + h[3] * h[3]);
    }
    __device__ __forceinline__ void rg(int R, int pn, int wc, int fq, const f32x4 (&a4)[2][2]) const {
        float ss = 0.f;
#pragma unroll
        for (int bj = 0; bj < 2; ++bj)
#pragma unroll
            for (int n = 0; n < 2; ++n) ss += q(R, pn * 256 + bj * 128 + wc * 32 + 8 * fq + 4 * n, a4[bj][n]);
        ss += __shfl_xor(ss, 16); ss += __shfl_xor(ss, 32);
        if (fq == 0) rowss_out[((size_t)pn * TPR + R) * 4 + wc] = ss;
    }
    __device__ __forceinline__ void tq(int R, int c, const f32x4& v) const {
        float ss = q(R, c, v);
        ss += __shfl_xor(ss, 16); ss += __shfl_xor(ss, 32);
        if ((threadIdx.x & 48) == 0) atomicAdd(rowss_out + (size_t)R * 4, ss);
    }
    EPI_OP()
};
struct EpiUp {
    static constexpr bool PERM = true, AFTER_DRAIN = false;
    const float* rowss; bf16* ACT;
    __device__ __forceinline__ void q(int R, int c, const f32x4& a, float rs) const {
        f32x4 v = a * rs;
#pragma unroll
        for (int j = 0; j < 4; ++j) { const float r = fmaxf(v[j], 0.f); v[j] = r * r; }
        u32x2 w; w.x = pk2(v[0], v[1]); w.y = pk2(v[2], v[3]);
        *(u32x2*)(ACT + (size_t)R * FF + c) = w;
    }
    __device__ __forceinline__ void q2(int R, int c, const f32x4& a0, const f32x4& a1, float rs) const {
        f32x4 v0 = a0 * rs, v1 = a1 * rs;
#pragma unroll
        for (int j = 0; j < 4; ++j) { const float r0 = fmaxf(v0[j], 0.f), r1 = fmaxf(v1[j], 0.f); v0[j] = r0 * r0; v1[j] = r1 * r1; }
        u32x4 w; w.x = pk2(v0[0], v0[1]); w.y = pk2(v0[2], v0[3]); w.z = pk2(v1[0], v1[1]); w.w = pk2(v1[2], v1[3]);
        *(u32x4*)(ACT + (size_t)R * FF + c) = w;
    }
    EPI_BODY_RS()
};
template <class Epi>
__device__ __forceinline__ void thin_gemm(LAS unsigned char* lds, const bf16* A, const bf16* Bt, int K, int N, const Epi& E, int vb, int vg) {
    int tid_l = threadIdx.x; asm volatile("" : "+v"(tid_l));
    const int lane = tid_l & 63, w = __builtin_amdgcn_readfirstlane(tid_l >> 6), fr = lane & 15, fq = lane >> 4;
    LAS f32x4* red = (LAS f32x4*)lds;
    const int kw = K >> 3;
    for (int pc = vb; pc < N / 16; pc += vg) {
        const bf16* ap = A + (size_t)(NREAL + fr) * K + w * kw + 8 * fq;
        const bf16* bp = Bt + (size_t)(16 * pc + fr) * K + w * kw + 8 * fq;
        f32x4 acc[8];
#pragma unroll
        for (int rb = 0; rb < 8; ++rb) acc[rb] = (f32x4){0.f, 0.f, 0.f, 0.f};
#pragma unroll 2
        for (int k0 = 0; k0 < kw; k0 += 32) {
            const bf16x8 bf = *(const bf16x8*)(bp + k0);
            bf16x8 af[8];
#pragma unroll
            for (int rb = 0; rb < 8; ++rb) af[rb] = *(const bf16x8*)(ap + (size_t)(16 * rb) * K + k0);
#pragma unroll
            for (int rb = 0; rb < 8; ++rb) acc[rb] = __builtin_amdgcn_mfma_f32_16x16x32_bf16(bf, af[rb], acc[rb], 0, 0, 0);
        }
        asm volatile("s_nop 15\n\ts_nop 15" : "+v"(acc[0]), "+v"(acc[1]), "+v"(acc[2]), "+v"(acc[3]), "+v"(acc[4]), "+v"(acc[5]), "+v"(acc[6]), "+v"(acc[7]));
#pragma unroll
        for (int rb = 0; rb < 8; ++rb) red[(w * 8 + rb) * 64 + lane] = acc[rb];
        LDS_FENCE(); __syncthreads();
        f32x4 v = red[(0 * 8 + w) * 64 + lane];
#pragma unroll
        for (int ww = 1; ww < 8; ++ww) v = v + red[(ww * 8 + w) * 64 + lane];
        LDS_FENCE(); __syncthreads();
        E.tq(NREAL + 16 * w + fr, 16 * pc + 4 * fq, v);
    }
}

struct Args { const float* in[23]; float* out; unsigned char* ws; };

__device__ __forceinline__ void p0_item(const float* W, int ldw, int K, const float* scale, bf16* WT, int permrows, LAS float* scr, int item, int nblk, int lane) {
    const int kb = item / nblk, nb = item % nblk, k0 = 64 * kb, n0 = 64 * nb;
#pragma unroll 4
    for (int i = 0; i < 16; ++i) {
        const int kk = 4 * i + (lane >> 4), c4 = (lane & 15) * 4;
        f32x4 w = *(const f32x4*)(W + (size_t)(k0 + kk) * ldw + n0 + c4);
        if (scale) w = w * scale[k0 + kk];
        scr[kk * 65 + c4] = w[0]; scr[kk * 65 + c4 + 1] = w[1]; scr[kk * 65 + c4 + 2] = w[2]; scr[kk * 65 + c4 + 3] = w[3];
    }
    LDS_FENCE();
    const int c = lane & 7;
#pragma unroll
    for (int j = 0; j < 8; ++j) {
        const int n = (lane >> 3) + 8 * j;
        const int sc = (n0 + n) < permrows ? ((n & 1) ? 32 + (n >> 1) : (n >> 1)) : n;
        const LAS float* s = scr + (8 * c) * 65 + sc;
        u32x4 o; o.x = pk2(s[0 * 65], s[1 * 65]); o.y = pk2(s[2 * 65], s[3 * 65]); o.z = pk2(s[4 * 65], s[5 * 65]); o.w = pk2(s[6 * 65], s[7 * 65]);
        *(u32x4*)(WT + (size_t)(n0 + n) * K + k0 + 8 * c) = o;
    }
    LDS_FENCE();
}

__device__ __forceinline__ void p0_prologue(const Args& a, LAS unsigned char* lds) {
    int tl_ = threadIdx.x; asm volatile("" : "+v"(tl_));
    const int tid = tl_, lane = tid & 63, wave = __builtin_amdgcn_readfirstlane(tid >> 6);
    const int gw = blockIdx.x * 8 + wave, NGW = gridDim.x * 8;
    const int gt = blockIdx.x * 512 + tid, NGT = gridDim.x * 512;
    unsigned char* ws = a.ws;
    LAS float* scr = (LAS float*)(lds + wave * 17408);
    for (int i = gt; i < 4 * 4 * 128 * 4; i += NGT) { const int idx = 1 + (i >> 11), pn = (i >> 9) & 3, r = (i >> 2) & 127, sl = i & 3;
        ((float*)(ws + WS_RS))[((size_t)idx * 4 * TPR + (size_t)pn * TPR + NREAL + r) * 4 + sl] = 0.f; }
    constexpr int I_IN = 16 * 76, I_GLU = 8 * 8, I_BR = 8 * 16, I_OUT = 16 * 16, I_UP = 16 * 64, I_DN = 64 * 16, I_L = I_IN + I_GLU + 3 * I_BR + I_OUT + I_UP + I_DN;
    for (int it = gw; it < 2 * I_L; it += NGW) {
        const int layer = it / I_L; int r = it % I_L;
        unsigned char* wl = ws + WS_W + (size_t)layer * LW_BYTES;
        if (r < I_IN) { p0_item(a.in[3] + (size_t)layer * DM * DIN, DIN, DM, a.in[2] + layer * DM, (bf16*)(wl + OW_IN), 640, scr, r, 76, lane); continue; } r -= I_IN;
        if (r < I_GLU) { p0_item(a.in[13] + (size_t)layer * 512 * 512, 512, 512, nullptr, (bf16*)(wl + OW_GLU), 0, scr, r, 8, lane); continue; } r -= I_GLU;
        if (r < 3 * I_BR) { const int c = r / I_BR; p0_item(a.in[17] + ((size_t)layer * 3 + c) * 512 * 1024, 1024, 512, nullptr, (bf16*)(wl + OW_BR) + (size_t)c * 1024 * 512, 0, scr, r % I_BR, 16, lane); continue; } r -= 3 * I_BR;
        if (r < I_OUT) { p0_item(a.in[18] + (size_t)layer * DM * DM, DM, DM, nullptr, (bf16*)(wl + OW_OUT), 0, scr, r, 16, lane); continue; } r -= I_OUT;
        if (r < I_UP) { p0_item(a.in[20] + (size_t)layer * DM * FF, FF, DM, a.in[19] + layer * DM, (bf16*)(wl + OW_UP), 0, scr, r, 64, lane); continue; } r -= I_UP;
        p0_item(a.in[21] + (size_t)layer * FF * DM, DM, FF, nullptr, (bf16*)(wl + OW_DN), 0, scr, r, 16, lane);
    }
    for (int i = gt; i < 2 * 512 * 512; i += NGT) {
        const int layer = i >> 18, n = (i >> 9) & 511, k = i & 511;
        float w = 0.f;
        if ((n >> 7) == (k >> 7)) w = a.in[15][(((size_t)layer * 4 + (n >> 7)) * 128 + (k & 127)) * 128 + (n & 127)];
        ((bf16*)(ws + WS_W + (size_t)layer * LW_BYTES + OW_POOL))[(size_t)n * 512 + k] = (bf16)f2bf(w);
    }
    for (int i = gt; i < LL * 32; i += NGT) {
        const int l = i >> 5, f = i & 31;
        const float invf = (float)dexp(-(double)f * (9.21034037197618273607 / 32.0));
        const float ang = (float)l * invf;
        double s, c; dsincos((double)ang, s, c);
        float* rp = (float*)(ws + WS_ROPE) + (size_t)i * 2; rp[0] = (float)c; rp[1] = (float)s;
    }
    for (int i = gt; i < 2 * 2 * 32 * 64; i += NGT) {
        const int n = i & 63, pidx = i >> 6;
        const double lr = (double)a.in[5][i], li = (double)a.in[6][i];
        const double dt = (double)(float)dexp((double)a.in[7][pidx]);
        const double mag = dexp(lr * dt); double sn, cn; dsincos(li * dt, sn, cn);
        const double are = mag * cn, aim = mag * sn, den = lr * lr + li * li, nre = are - 1.0;
        const double fre = (nre * lr + aim * li) / den, fim = (aim * lr - nre * li) / den;
        float* ab = (float*)(ws + WS_ABAR) + (size_t)i * 2; ab[0] = (float)are; ab[1] = (float)aim;
        bf16* bm = (bf16*)(ws + WS_BMAT) + (size_t)pidx * 128 * 16;
        bf16* cm = (bf16*)(ws + WS_CMAT) + (size_t)pidx * 16 * 128;
        for (int q = 0; q < 16; ++q) {
            const double br = (double)a.in[8][(size_t)i * 16 + q], bi = (double)a.in[9][(size_t)i * 16 + q];
            bm[n * 16 + q] = (bf16)f2bf((float)(fre * br - fim * bi));
            bm[(64 + n) * 16 + q] = (bf16)f2bf((float)(fre * bi + fim * br));
            cm[q * 128 + n] = (bf16)f2bf(a.in[10][((size_t)pidx * 16 + q) * 64 + n]);
            cm[q * 128 + 64 + n] = (bf16)f2bf(-a.in[11][((size_t)pidx * 16 + q) * 64 + n]);
        }
    }
    for (int R = gw; R < TPR; R += NGW) {
        const int mrow = R - NREAL;
        const float* src = R < NREAL ? a.in[0] + (size_t)R * DM : a.in[1] + (size_t)(mrow & 15) * DM;
        float* dst = R < NREAL ? a.out + (size_t)R * DM : (float*)(ws + WS_HM) + (size_t)mrow * DM;
        bf16* hb = (bf16*)(ws + WS_HB) + (size_t)R * DM;
        const bool pad = mrow >= NB * NMETA;
        float ss = 0.f;
#pragma unroll
        for (int j = 0; j < 4; ++j) {
            f32x4 v = *(const f32x4*)(src + 4 * lane + 256 * j);
            if (pad) v = (f32x4){0.f, 0.f, 0.f, 0.f};
            *(f32x4*)(dst + 4 * lane + 256 * j) = v;
            ss += (v[0] * v[0] + v[1] * v[1]) + (v[2] * v[2] + v[3] * v[3]);
            u32x2 w; w.x = pk2(v[0], v[1]); w.y = pk2(v[2], v[3]);
            *(u32x2*)(hb + 4 * lane + 256 * j) = w;
        }
#pragma unroll
        for (int o = 1; o < 64; o <<= 1) ss += __shfl_xor(ss, o);
        if (lane < 16) ((float*)(ws + WS_RS))[((size_t)(lane >> 2) * TPR + R) * 4 + (lane & 3)] = lane == 0 ? ss : 0.f;
    }
}

__device__ __forceinline__ void ssm_task(LAS unsigned char* lds, int task, int layer, const bf16* SU, float* YF,
                                         const float* abar_all, const bf16* bmat_all, const bf16* cmat_all) {
    int tid_l = threadIdx.x; asm volatile("" : "+v"(tid_l));
    const int tid = tid_l, lane = tid & 63, wave = __builtin_amdgcn_readfirstlane(tid >> 6);
    const int b = task >> 5, g = task & 31;
    __syncthreads();
    LAS float* BU = (LAS float*)(lds + wave * 12800);
    LAS unsigned short* X = (LAS unsigned short*)(lds + wave * 12800 + 8448);
    LAS float* SX = (LAS float*)(lds + 8 * 12800);
    const int blk0 = wave == 0 ? 0 : 16 * wave + 1, nblk = wave == 0 ? 17 : 16;
    bf16* yfb = (bf16*)YF + (size_t)task * LL * 16;
    const int fr = lane & 15, fq = lane >> 4;
    const bf16x8 zero8 = {0, 0, 0, 0, 0, 0, 0, 0};
    for (int dir = 0; dir < 2; ++dir) {
        const int pidx = (layer * 2 + dir) * 32 + g;
        const float are = abar_all[((size_t)pidx * 64 + lane) * 2], aim = abar_all[((size_t)pidx * 64 + lane) * 2 + 1];
        bf16x8 bfr[8], cfr[4];
        const bf16* bm = bmat_all + (size_t)pidx * 128 * 16;
#pragma unroll
        for (int nt = 0; nt < 8; ++nt) bfr[nt] = fq < 2 ? *(const bf16x8*)(bm + (nt * 16 + fr) * 16 + 8 * fq) : zero8;
        const bf16* cm = cmat_all + (size_t)pidx * 16 * 128;
#pragma unroll
        for (int ks = 0; ks < 4; ++ks) cfr[ks] = *(const bf16x8*)(cm + fr * 128 + ks * 32 + 8 * fq);
        float p16r = are, p16i = aim;
#pragma unroll
        for (int i = 0; i < 4; ++i) { const float tr = p16r * p16r - p16i * p16i, ti = 2.f * p16r * p16i; p16r = tr; p16i = ti; }
        float p256r = p16r, p256i = p16i;
#pragma unroll
        for (int i = 0; i < 4; ++i) { const float tr = p256r * p256r - p256i * p256i, ti = 2.f * p256r * p256i; p256r = tr; p256i = ti; }
        const float p272r = p256r * p16r - p256i * p16i, p272i = p256r * p16i + p256i * p16r;

        float xre = 0.f, xim = 0.f;
        for (int pass = 0; pass < 2; ++pass) {
            bf16x8 unext;
            { const int blkf = dir == 0 ? blk0 : blk0 + nblk - 1; const int Rf = blkf == 0 ? NREAL + b * NMETA : b * SEQ + blkf * 16 - NMETA;
              unext = fq < 2 ? *(const bf16x8*)(SU + (size_t)(Rf + fr) * 512 + g * 16 + 8 * fq) : zero8; }
            for (int ib = 0; ib < nblk; ++ib) {
                const int blk = dir == 0 ? blk0 + ib : blk0 + nblk - 1 - ib;
                const bf16x8 ufr = unext;
                if (ib + 1 < nblk) { const int blkn = dir == 0 ? blk + 1 : blk - 1; const int Rn = blkn == 0 ? NREAL + b * NMETA : b * SEQ + blkn * 16 - NMETA;
                    unext = fq < 2 ? *(const bf16x8*)(SU + (size_t)(Rn + fr) * 512 + g * 16 + 8 * fq) : zero8; }
                f32x4 dd[8];
#pragma unroll
                for (int nt = 0; nt < 8; ++nt) { dd[nt] = (f32x4){0.f, 0.f, 0.f, 0.f}; dd[nt] = __builtin_amdgcn_mfma_f32_16x16x32_bf16(ufr, bfr[nt], dd[nt], 0, 0, 0); }
                asm volatile("s_nop 15\n\ts_nop 15" : "+v"(dd[0]), "+v"(dd[1]), "+v"(dd[2]), "+v"(dd[3]), "+v"(dd[4]), "+v"(dd[5]), "+v"(dd[6]), "+v"(dd[7]));
#pragma unroll
                for (int nt = 0; nt < 8; ++nt)
#pragma unroll
                    for (int r = 0; r < 4; ++r) BU[(4 * fq + r) * 132 + nt * 16 + fr] = dd[nt][r];
                LDS_FENCE();
                float bur[16], bui[16];
#pragma unroll
                for (int i = 0; i < 16; ++i) { const int tt = dir == 0 ? i : 15 - i; bur[i] = BU[tt * 132 + lane]; bui[i] = BU[tt * 132 + 64 + lane]; }
                if (pass == 0) {
#pragma unroll
                    for (int i = 0; i < 16; ++i) {
                        const float bre = bur[i], bim = bui[i];
                        const float nr = are * xre - aim * xim + bre, ni = are * xim + aim * xre + bim; xre = nr; xim = ni;
                    }
                    LDS_FENCE();
                } else {
#pragma unroll
                    for (int i = 0; i < 16; ++i) {
                        const int tt = dir == 0 ? i : 15 - i;
                        const float bre = bur[i], bim = bui[i];
                        const float nr = are * xre - aim * xim + bre, ni = are * xim + aim * xre + bim; xre = nr; xim = ni;
                        X[tt * 136 + lane] = (unsigned short)f2bf(xre); X[tt * 136 + 64 + lane] = (unsigned short)f2bf(xim);
                    }
                    LDS_FENCE();
                    f32x4 y = {0.f, 0.f, 0.f, 0.f};
#pragma unroll
                    for (int ks = 0; ks < 4; ++ks) {
                        const bf16x8 afr = *(const LAS bf16x8*)(X + fr * 136 + ks * 32 + 8 * fq);
                        y = __builtin_amdgcn_mfma_f32_16x16x32_bf16(afr, cfr[ks], y, 0, 0, 0);
                    }
                    asm volatile("s_nop 15\n\ts_nop 15" : "+v"(y));
                    LDS_FENCE();
                    {
                        bf16* yd = yfb + (size_t)dir * 256 * LL * 16;
#pragma unroll
                        for (int r = 0; r < 4; ++r) yd[(size_t)(blk * 16 + 4 * fq + r) * 16 + fr] = (bf16)f2bf(y[r]);
                    }
                }
            }
            if (pass == 0) {
                SX[(wave * 64 + lane) * 2] = xre; SX[(wave * 64 + lane) * 2 + 1] = xim;
                LDS_FENCE(); __syncthreads();
                float cre = 0.f, cim = 0.f;
                if (dir == 0) {
                    for (int w = 0; w < wave; ++w) { const float pr = w == 0 ? p272r : p256r, pi = w == 0 ? p272i : p256i;
                        const float sr = SX[(w * 64 + lane) * 2], si = SX[(w * 64 + lane) * 2 + 1];
                        const float nr = pr * cre - pi * cim + sr, ni = pr * cim + pi * cre + si; cre = nr; cim = ni; }
                } else {
                    for (int w = 7; w > wave; --w) {
                        const float sr = SX[(w * 64 + lane) * 2], si = SX[(w * 64 + lane) * 2 + 1];
                        const float nr = p256r * cre - p256i * cim + sr, ni = p256r * cim + p256i * cre + si; cre = nr; cim = ni; }
                }
                xre = cre; xim = cim;
            }
        }
        LDS_FENCE(); __syncthreads();
    }
}

constexpr int ATT_KROW = 72, ATT_VROW = 40, ATT_KT = 32 * ATT_KROW * 2  , ATT_VT = 64 * ATT_VROW * 2  , ATT_MAXT = 11, ATT_VOFF = ATT_MAXT * ATT_KT;
static_assert(ATT_VOFF + ATT_MAXT * ATT_VT <= 131072, "attention LDS");
__device__ __forceinline__ void attn_task(LAS unsigned char* lds, int task, const bf16* Q, const bf16* K, const bf16* V, bf16* YA, const float* sink) {
    int tid_l = threadIdx.x; asm volatile("" : "+v"(tid_l));
    const int tid = tid_l, lane = tid & 63, wave = __builtin_amdgcn_readfirstlane(tid >> 6);
    const int qb = task % 33, bh = task / 33, h = bh & 1, b = bh >> 1;
    const int l0 = qb * 64;
    __syncthreads();
    int jlo = (l0 - 128) >> 5; if (jlo < 1) jlo = 1;
    int jhi = (l0 + 191) >> 5; if (jhi > 64) jhi = 64;
    const int ntiles = 1 + (jhi - jlo + 1);
    LAS unsigned short* Ks = (LAS unsigned short*)lds;
    LAS unsigned short* Vs = (LAS unsigned short*)(lds + ATT_VOFF);
    for (int idx = tid; idx < ntiles * 32 * 8; idx += 512) {
        const int ch = idx & 7, key = idx >> 3, slot = key >> 5, kk = key & 31;
        const int lk = (slot == 0 ? 0 : (jlo + slot - 1) * 32) + kk;
        u32x4 kv = {0u, 0u, 0u, 0u}, vv = {0u, 0u, 0u, 0u};
        if (lk < LL) { const size_t R = (size_t)tok_row(b, lk);
            kv = *(const u32x4*)(K + R * 128 + h * 64 + ch * 8); vv = *(const u32x4*)(V + R * 128 + h * 64 + ch * 8); }
        *(LAS u32x4*)(Ks + slot * (ATT_KT / 2) + kk * ATT_KROW + ch * 8) = kv;
        LAS unsigned short* vd = Vs + slot * (ATT_VT / 2) + (ch * 8) * ATT_VROW + kk;
        vd[0 * ATT_VROW] = (unsigned short)(vv.x & 0xffffu); vd[1 * ATT_VROW] = (unsigned short)(vv.x >> 16);
        vd[2 * ATT_VROW] = (unsigned short)(vv.y & 0xffffu); vd[3 * ATT_VROW] = (unsigned short)(vv.y >> 16);
        vd[4 * ATT_VROW] = (unsigned short)(vv.z & 0xffffu); vd[5 * ATT_VROW] = (unsigned short)(vv.z >> 16);
        vd[6 * ATT_VROW] = (unsigned short)(vv.w & 0xffffu); vd[7 * ATT_VROW] = (unsigned short)(vv.w >> 16);
    }
    LDS_FENCE(); __syncthreads();
    const int head = h * 4 + (wave >> 1), r32 = lane & 31, hi = lane >> 5;
    const int lq = l0 + 32 * (wave & 1) + r32;
    const bool qvalid = lq < LL;
    const size_t Rq = (size_t)tok_row(b, qvalid ? lq : LL - 1);
    bf16x8 qf[4];
#pragma unroll
    for (int ks = 0; ks < 4; ++ks) qf[ks] = *(const bf16x8*)(Q + Rq * 512 + head * 64 + ks * 16 + 8 * hi);
    float mrun = sink[head], lsum = hi == 0 ? 1.0f : 0.0f;
    f32x16 o0, o1;
#pragma unroll
    for (int i = 0; i < 16; ++i) { o0[i] = 0.f; o1[i] = 0.f; }
    for (int slot = 0; slot < ntiles; ++slot) {
        const int kbase = slot == 0 ? 0 : (jlo + slot - 1) * 32;
        const LAS unsigned short* kt = Ks + slot * (ATT_KT / 2);
        f32x16 s;
#pragma unroll
        for (int i = 0; i < 16; ++i) s[i] = 0.f;
#pragma unroll
        for (int ks = 0; ks < 4; ++ks) {
            const bf16x8 kf = *(const LAS bf16x8*)(kt + r32 * ATT_KROW + ks * 16 + 8 * hi);
            s = __builtin_amdgcn_mfma_f32_32x32x16_bf16(kf, qf[ks], s, 0, 0, 0);
        }
        asm volatile("s_nop 15\n\ts_nop 15" : "+v"(s));
        float mt = -1e30f;
#pragma unroll
        for (int i = 0; i < 16; ++i) {
            const int lk = kbase + (i & 3) + 8 * (i >> 2) + 4 * hi;
            int d = lq - lk; d = d < 0 ? -d : d;
            const bool valid = (lk < NMETA) || (d <= 128 && lk < LL);
            s[i] = valid ? s[i] : -1e30f;
            mt = fmaxf(mt, s[i]);
        }
        mt = fmaxf(mt, __shfl_xor(mt, 32));
        const float mnew = fmaxf(mrun, mt);
        const float alpha = __expf(mrun - mnew);
        mrun = mnew;
        float ps = 0.f;
#pragma unroll
        for (int i = 0; i < 16; ++i) { s[i] = __expf(s[i] - mnew); ps += s[i]; }
        lsum = lsum * alpha + ps;
#pragma unroll
        for (int i = 0; i < 16; ++i) { o0[i] *= alpha; o1[i] *= alpha; }
        const LAS unsigned short* vt = Vs + slot * (ATT_VT / 2);
#pragma unroll
        for (int s2 = 0; s2 < 2; ++s2) {
            union { bf16x8 v; unsigned u[4]; } pf;
            pf.u[0] = pk2(s[8 * s2 + 0], s[8 * s2 + 1]); pf.u[1] = pk2(s[8 * s2 + 2], s[8 * s2 + 3]);
            pf.u[2] = pk2(s[8 * s2 + 4], s[8 * s2 + 5]); pf.u[3] = pk2(s[8 * s2 + 6], s[8 * s2 + 7]);
#pragma unroll
            for (int dt = 0; dt < 2; ++dt) {
                union { bf16x8 v; u32x2 u[2]; } vf;
                const LAS unsigned short* vp = vt + (dt * 32 + r32) * ATT_VROW + 16 * s2 + 4 * hi;
                vf.u[0] = *(const LAS u32x2*)(vp); vf.u[1] = *(const LAS u32x2*)(vp + 8);
                if (dt == 0) o0 = __builtin_amdgcn_mfma_f32_32x32x16_bf16(vf.v, pf.v, o0, 0, 0, 0);
                else o1 = __builtin_amdgcn_mfma_f32_32x32x16_bf16(vf.v, pf.v, o1, 0, 0, 0);
            }
        }
    }
    asm volatile("s_nop 15\n\ts_nop 15" : "+v"(o0), "+v"(o1));
    lsum += __shfl_xor(lsum, 32);
    const float inv = 1.0f / lsum;
    if (qvalid) {
#pragma unroll
        for (int g4 = 0; g4 < 4; ++g4) {
            u32x2 w0, w1;
            w0.x = pk2(o0[4 * g4] * inv, o0[4 * g4 + 1] * inv); w0.y = pk2(o0[4 * g4 + 2] * inv, o0[4 * g4 + 3] * inv);
            w1.x = pk2(o1[4 * g4] * inv, o1[4 * g4 + 1] * inv); w1.y = pk2(o1[4 * g4 + 2] * inv, o1[4 * g4 + 3] * inv);
            *(u32x2*)(YA + Rq * 512 + head * 64 + 8 * g4 + 4 * hi) = w0;
            *(u32x2*)(YA + Rq * 512 + head * 64 + 32 + 8 * g4 + 4 * hi) = w1;
        }
    }
    __syncthreads();
}

__device__ __forceinline__ void pool_diff(const bf16* PU, bf16* PD) {
    int tl_ = threadIdx.x; asm volatile("" : "+v"(tl_)); const int gt = blockIdx.x * 512 + tl_, NGT = gridDim.x * 512;
    for (int i = gt; i < NB * LL * 64; i += NGT) {
        const int ch = i & 63, tk = i >> 6, b = tk / LL, l = tk % LL;
        const int half = 1 << (ch >> 4);
        const int lo = l - half < 0 ? 0 : l - half, hh = l + half > LL ? LL : l + half;
        float s[8];
#pragma unroll
        for (int j = 0; j < 8; ++j) s[j] = 0.f;
        for (int lp = lo; lp < hh; ++lp) {
            const u32x4 v = *(const u32x4*)(PU + (size_t)tok_row(b, lp) * 512 + ch * 8);
            s[0] += bf2f(v.x & 0xffffu); s[1] += bf2f(v.x >> 16); s[2] += bf2f(v.y & 0xffffu); s[3] += bf2f(v.y >> 16);
            s[4] += bf2f(v.z & 0xffffu); s[5] += bf2f(v.z >> 16); s[6] += bf2f(v.w & 0xffffu); s[7] += bf2f(v.w >> 16);
        }
        const float ic = 1.0f / (float)(hh - lo);
        const size_t R = (size_t)tok_row(b, l);
        const u32x4 v = *(const u32x4*)(PU + R * 512 + ch * 8);
        u32x4 o;
        o.x = pk2(s[0] * ic - bf2f(v.x & 0xffffu), s[1] * ic - bf2f(v.x >> 16)); o.y = pk2(s[2] * ic - bf2f(v.y & 0xffffu), s[3] * ic - bf2f(v.y >> 16));
        o.z = pk2(s[4] * ic - bf2f(v.z & 0xffffu), s[5] * ic - bf2f(v.z >> 16)); o.w = pk2(s[6] * ic - bf2f(v.w & 0xffffu), s[7] * ic - bf2f(v.w >> 16));
        *(u32x4*)(PD + R * 512 + ch * 8) = o;
    }
}

__device__ __forceinline__ void z_pass(const float* YF, const bf16* SU, const float* dskip, bf16* Z) {
    int tl_ = threadIdx.x; asm volatile("" : "+v"(tl_)); const int gt = blockIdx.x * 512 + tl_, NGT = gridDim.x * 512;
    for (int i = gt; i < NB * LL * 64; i += NGT) {
        const int ch = i & 63, tk = i >> 6, b = tk / LL, l = tk % LL, g = ch >> 1;
        const size_t R = (size_t)tok_row(b, l);
        const bf16* yp = (const bf16*)YF + ((size_t)(b * 32 + g) * LL + l) * 16 + (ch & 1) * 8;
        const u32x4 ya = *(const u32x4*)yp, yb = *(const u32x4*)(yp + (size_t)256 * LL * 16);
        f32x4 y0, y1;
        y0[0] = bf2f(ya.x & 0xffffu) + bf2f(yb.x & 0xffffu); y0[1] = bf2f(ya.x >> 16) + bf2f(yb.x >> 16); y0[2] = bf2f(ya.y & 0xffffu) + bf2f(yb.y & 0xffffu); y0[3] = bf2f(ya.y >> 16) + bf2f(yb.y >> 16);
        y1[0] = bf2f(ya.z & 0xffffu) + bf2f(yb.z & 0xffffu); y1[1] = bf2f(ya.z >> 16) + bf2f(yb.z >> 16); y1[2] = bf2f(ya.w & 0xffffu) + bf2f(yb.w & 0xffffu); y1[3] = bf2f(ya.w >> 16) + bf2f(yb.w >> 16);
        const f32x4 d0 = *(const f32x4*)(dskip + ch * 8), d1 = *(const f32x4*)(dskip + ch * 8 + 4);
        const u32x4 uu = *(const u32x4*)(SU + R * 512 + ch * 8);
        float t[8];
        t[0] = y0[0] + d0[0] * bf2f(uu.x & 0xffffu); t[1] = y0[1] + d0[1] * bf2f(uu.x >> 16); t[2] = y0[2] + d0[2] * bf2f(uu.y & 0xffffu); t[3] = y0[3] + d0[3] * bf2f(uu.y >> 16);
        t[4] = y1[0] + d1[0] * bf2f(uu.z & 0xffffu); t[5] = y1[1] + d1[1] * bf2f(uu.z >> 16); t[6] = y1[2] + d1[2] * bf2f(uu.w & 0xffffu); t[7] = y1[3] + d1[3] * bf2f(uu.w >> 16);
#pragma unroll
        for (int j = 0; j < 8; ++j) t[j] = 0.5f * t[j] * (1.0f + erff(t[j] * 0.70710678118654752f));
        u32x4 o; o.x = pk2(t[0], t[1]); o.y = pk2(t[2], t[3]); o.z = pk2(t[4], t[5]); o.w = pk2(t[6], t[7]);
        *(u32x4*)(Z + R * 512 + ch * 8) = o;
    }
}

#define XB_TMO      128
#define XB_XCNT(j)  (256  + 64 * (j))
#define XB_XSUB(j)  (1280 + 64 * (j))
#define XB_XGEN(j)  (2304 + 64 * (j))
#define XB_TOP      3328
#define XB_TOPGEN   3392
#define XCD_BAR_WORDS 3456
#define XB_SPIN_CAP (1u << 18)

__device__ __forceinline__ unsigned xb_ld(unsigned* p)              { return __hip_atomic_load(p, __ATOMIC_RELAXED, __HIP_MEMORY_SCOPE_AGENT); }
__device__ __forceinline__ unsigned xb_add(unsigned* p, unsigned v) { return __hip_atomic_fetch_add(p, v, __ATOMIC_RELAXED, __HIP_MEMORY_SCOPE_AGENT); }
__device__ __forceinline__ unsigned xb_xcc_id() { return (unsigned)__builtin_amdgcn_s_getreg((3 << 11) | 20) & 0xFu; }
#define XB_SPIN(cond, bar) do { unsigned _sp = 0; while (cond) { __builtin_amdgcn_s_sleep(1); \
    if ((++_sp & 255u) == 0u) { if (xb_ld(&(bar)[XB_TMO])) break; if (_sp > XB_SPIN_CAP) { atomicAdd(&(bar)[XB_TMO], 1u); break; } } } } while (0)

struct XcdBarrier {
    unsigned* bar; unsigned x;
    volatile LAS unsigned* st;
};

__device__ __forceinline__ XcdBarrier xcd_barrier_post(unsigned* bar, volatile LAS unsigned* st) {
    XcdBarrier b; b.bar = bar; b.x = xb_xcc_id(); b.st = st;
    if (threadIdx.x == 0) (void)xb_add(&bar[XB_XCNT(b.x)], 1u);
    return b;
}
__device__ __forceinline__ void xcd_barrier_complete(unsigned* bar, unsigned x, unsigned& nloc, unsigned& nx) {
    const unsigned G = gridDim.x * gridDim.y * gridDim.z;
    unsigned sum, cnt, mine, sp = 0u;
    for (;;) {
        sum = 0u; cnt = 0u; mine = 0u;
#pragma unroll
        for (unsigned j = 0; j < 16; ++j) { const unsigned c = xb_ld(&bar[XB_XCNT(j)]); sum += c; cnt += (c > 0u) ? 1u : 0u; mine = (j == x) ? c : mine; }
        if (sum == G) break;
        __builtin_amdgcn_s_sleep(1);
        if ((++sp & 255u) == 0u) { if (xb_ld(&bar[XB_TMO])) break; if (sp > XB_SPIN_CAP) { atomicAdd(&bar[XB_TMO], 1u); break; } }
    }
    nloc = mine > 0u ? mine : 1u; nx = cnt > 0u ? cnt : 1u;
}

__device__ __forceinline__ void xcd_barrier(const XcdBarrier& b) {
    asm volatile("s_waitcnt vmcnt(0)" ::: "memory");
    __syncthreads();
    if (threadIdx.x == 0) {
        unsigned* bar = b.bar;
        __builtin_amdgcn_s_waitcnt(0);
        unsigned nloc = b.st[0], nx = b.st[1];
        if (nloc == 0u) { xcd_barrier_complete(bar, b.x, nloc, nx); b.st[0] = nloc; b.st[1] = nx; }
        const unsigned old = xb_add(&bar[XB_XSUB(b.x)], 1u);
        const unsigned gen = old / nloc;
        if (old + 1u == (gen + 1u) * nloc) {
            __builtin_amdgcn_fence(__ATOMIC_RELEASE, "agent");
            asm volatile("s_waitcnt vmcnt(0)" ::: "memory");
            const unsigned og = xb_add(&bar[XB_TOP], 1u);
            const unsigned tg = og / nx;
            if (og + 1u == (tg + 1u) * nx) xb_add(&bar[XB_TOPGEN], 1u);
            else XB_SPIN(xb_ld(&bar[XB_TOPGEN]) == tg, bar);
            __builtin_amdgcn_fence(__ATOMIC_ACQUIRE, "agent");
            xb_add(&bar[XB_XGEN(b.x)], 1u);
            asm volatile("s_waitcnt vmcnt(0)" ::: "memory");
        } else {
            XB_SPIN(xb_ld(&bar[XB_XGEN(b.x)]) == gen, bar);
            __builtin_amdgcn_fence(__ATOMIC_ACQUIRE, "agent");
            asm volatile("s_waitcnt vmcnt(0)" ::: "memory");
        }
    }
    __syncthreads();
}

#ifndef MK_ALIGN
#define MK_ALIGN true
#endif
#ifndef MK_SP2
#define MK_SP2 true
#endif
#ifndef MK_SPLIT
#define MK_SPLIT 0
#endif
constexpr int NPL = 8, NPHASE = 1 + 2 * NPL + 1, PH_FINAL = NPHASE - 1;

typedef const __attribute__((address_space(4))) Args* KArgsP;
#define KARGS() ({ auto kp_ = __builtin_amdgcn_kernarg_segment_ptr(); asm volatile("" : "+s"(kp_)); (KArgsP)kp_; })
__global__ void __launch_bounds__(512, 2) fwd_kernel(Args a_unused, int ph_lo, int ph_hi) {
    (void)a_unused;
    extern __shared__ __attribute__((aligned(16))) unsigned char lds_raw[];
    LAS unsigned char* lds = (LAS unsigned char*)lds_raw;
    const int G = gridDim.x, bid = blockIdx.x;
#if MK_SPLIT
#define GRID_SYNC() do {} while (0)
    (void)lds;
#else
#define CG_SYNC() do { asm volatile("s_waitcnt vmcnt(0)" ::: "memory"); __syncthreads(); \
    if (threadIdx.x == 0) { __builtin_amdgcn_fence(__ATOMIC_RELEASE, "agent"); asm volatile("s_waitcnt vmcnt(0)" ::: "memory"); } \
    __syncthreads(); grid.sync(); \
    if (threadIdx.x == 0) { __builtin_amdgcn_fence(__ATOMIC_ACQUIRE, "agent"); asm volatile("s_waitcnt vmcnt(0)" ::: "memory"); } \
    __syncthreads(); } while (0)
    cg::grid_group grid = cg::this_grid();
    unsigned* barw = (unsigned*)(KARGS()->ws + WS_CTL);
    if (bid == 0) for (int i = threadIdx.x; i < XCD_BAR_WORDS; i += 512) __hip_atomic_store(barw + i, 0u, __ATOMIC_RELAXED, __HIP_MEMORY_SCOPE_AGENT);
    volatile LAS unsigned* xst = (volatile LAS unsigned*)(lds + LDS_BYTES - 64);
    if (threadIdx.x < 2) xst[threadIdx.x] = 0u;
    CG_SYNC();
    const XcdBarrier xbar = xcd_barrier_post(barw, xst);
#define GRID_SYNC() xcd_barrier(xbar)

#endif
#ifndef PHMASK
#define PHMASK 0xFFFFu
#endif
#define IN(k) (((PHMASK >> ((k) == 0 ? 0 : (k) == PH_FINAL ? 9 : 1 + ((k) - 1) % NPL)) & 1u) && ph_lo <= (k) && (k) < ph_hi)
#define SEAM(k) do { if (IN(k) && (k) + 1 < ph_hi) GRID_SYNC(); } while (0)
#define PHASE_BEGIN() KArgsP ka = KARGS(); unsigned char* ws = ka->ws; asm volatile("" : "+s"(ws)); float* rowss = (float*)(ws + WS_RS); float* Hm = (float*)(ws + WS_HM); bf16* HB = (bf16*)(ws + WS_HB); unsigned char* wl = ws + WS_W + (size_t)layer * LW_BYTES; \
    const int MT = NREAL; const bool META = layer != MK_NLAYER - 1;     \
    const float* rs_mix = rowss + (size_t)(2 * layer) * TPR * 16; float* rs_mlp = rowss + (size_t)(2 * layer + 1) * TPR * 16; float* rs_next = rowss + (size_t)(2 * layer + 2) * TPR * 16; (void)MT; (void)META; (void)Hm; (void)HB; (void)wl; (void)rs_mix; (void)rs_mlp; (void)rs_next;

    if (IN(0)) { Args al; { KArgsP kp = KARGS(); for (int i = 0; i < 23; ++i) al.in[i] = kp->in[i]; al.out = kp->out; al.ws = kp->ws; } p0_prologue(al, lds); }
    SEAM(0);
#ifndef MK_NLAYER
#define MK_NLAYER 2
#endif
#ifndef MK_RSIDX
#define MK_RSIDX 4
#endif
#pragma unroll 1
    for (int layer = 0; layer < MK_NLAYER; ++layer) {
        const int p = 1 + NPL * layer;
        if (IN(p)) { PHASE_BEGIN();
            pg8::Gemm g{HB, (const bf16*)(wl + OW_IN), TPR, NPROJ, DM}; pg8::StaticOrder S; S.init(TPR, NPROJ, G, bid);
            EpiInProj E{rs_mix, (const float*)(ws + WS_ROPE), (bf16*)(ws + WS_Q), (bf16*)(ws + WS_K), (bf16*)(ws + WS_V), (bf16*)(ws + WS_SU), (bf16*)(ws + WS_PU)};
            pg8::gemm_phase<EpiInProj, pg8::StaticOrder, MK_ALIGN, MK_SP2>(lds, g, S, E);
        }
        SEAM(p);
        if (IN(p + 1)) { PHASE_BEGIN();
            for (int t = bid; t < 256; t += G)
                ssm_task(lds, t, layer, (const bf16*)(ws + WS_SU), (float*)(ws + WS_YF), (const float*)(ws + WS_ABAR), (const bf16*)(ws + WS_BMAT), (const bf16*)(ws + WS_CMAT));
            for (int t = bid; t < NB * 2 * 33; t += G)
                attn_task(lds, t, (const bf16*)(ws + WS_Q), (const bf16*)(ws + WS_K), (const bf16*)(ws + WS_V), (bf16*)(ws + WS_YA), ka->in[4] + layer * 8);
            pool_diff((const bf16*)(ws + WS_PU), (bf16*)(ws + WS_PD));
        }
        SEAM(p + 1);
        if (IN(p + 2)) { PHASE_BEGIN();
            z_pass((const float*)(ws + WS_YF), (const bf16*)(ws + WS_SU), ka->in[12] + layer * 512, (bf16*)(ws + WS_Z));
        }
        SEAM(p + 2);
        if (IN(p + 3)) { PHASE_BEGIN();
            const int hg = G >> 1;
            if (bid < hg) { pg8::Gemm g{(const bf16*)(ws + WS_Z), (const bf16*)(wl + OW_GLU), MT, 512, 512}; pg8::StaticOrder S; S.init(MT, 512, hg, bid);
              EpiGlu E{(const bf16*)(ws + WS_Z), ka->in[14] + layer * 512, (bf16*)(ws + WS_YS)};
              pg8::gemm_phase<EpiGlu, pg8::StaticOrder, MK_ALIGN, MK_SP2>(lds, g, S, E); if (META) thin_gemm<EpiGlu>(lds, g.A, g.Bt, g.K, g.N, E, bid, hg); }
            else { pg8::Gemm g{(const bf16*)(ws + WS_PD), (const bf16*)(wl + OW_POOL), MT, 512, 512}; pg8::StaticOrder S; S.init(MT, 512, G - hg, bid - hg);
              EpiScale E{(bf16*)(ws + WS_YP), 512, ka->in[16] + layer * 512};
              pg8::gemm_phase<EpiScale, pg8::StaticOrder, MK_ALIGN, MK_SP2>(lds, g, S, E); if (META) thin_gemm<EpiScale>(lds, g.A, g.Bt, g.K, g.N, E, bid - hg, G - hg); }
        }
        SEAM(p + 3);
        if (IN(p + 4)) { PHASE_BEGIN();
#pragma unroll 1
            for (int c = 0; c < 3; ++c) {
                const bf16* Yc = (const bf16*)(ws + (c == 0 ? WS_YA : c == 1 ? WS_YS : WS_YP));
                { pg8::Gemm g{Yc, (const bf16*)(wl + OW_BR) + (size_t)c * 1024 * 512, MT, 1024, 512}; pg8::StaticOrder S; S.init(MT, 1024, G, bid);
                  EpiScale E{(bf16*)(ws + WS_BR), 1024, nullptr};
                  pg8::gemm_phase<EpiScale, pg8::StaticOrder, MK_ALIGN, MK_SP2>(lds, g, S, E); if (META) thin_gemm<EpiScale>(lds, g.A, g.Bt, g.K, g.N, E, bid, G); }
                pg8::Gemm g{HB, (const bf16*)(wl + OW_IN) + (size_t)(NPROJ + c * 1024) * DM, MT, 1024, DM}; pg8::StaticOrder S; S.init(MT, 1024, G, bid);
                if (c == 0) { EpiGate<true> E{rs_mix, (const bf16*)(ws + WS_BR), (bf16*)(ws + WS_MG)}; pg8::gemm_phase<EpiGate<true>, pg8::StaticOrder, MK_ALIGN, MK_SP2>(lds, g, S, E); if (META) thin_gemm<EpiGate<true>>(lds, g.A, g.Bt, g.K, g.N, E, bid, G); }
                else { EpiGate<false> E{rs_mix, (const bf16*)(ws + WS_BR), (bf16*)(ws + WS_MG)}; pg8::gemm_phase<EpiGate<false>, pg8::StaticOrder, MK_ALIGN, MK_SP2>(lds, g, S, E); if (META) thin_gemm<EpiGate<false>>(lds, g.A, g.Bt, g.K, g.N, E, bid, G); }
            }
        }
        SEAM(p + 4);
        if (IN(p + 5)) { PHASE_BEGIN();
            pg8::Gemm g{(const bf16*)(ws + WS_MG), (const bf16*)(wl + OW_OUT), MT, DM, DM}; pg8::StaticOrder S; S.init(MT, DM, G, bid);
            EpiRes E{ka->out, Hm, HB, rs_mlp};
            pg8::gemm_phase<EpiRes, pg8::StaticOrder, MK_ALIGN, MK_SP2>(lds, g, S, E); if (META) thin_gemm<EpiRes>(lds, g.A, g.Bt, g.K, g.N, E, bid, G);
        }
        SEAM(p + 5);
        if (IN(p + 6)) { PHASE_BEGIN();
            pg8::Gemm g{HB, (const bf16*)(wl + OW_UP), MT, FF, DM}; pg8::StaticOrder S; S.init(MT, FF, G, bid);
            EpiUp E{rs_mlp, (bf16*)(ws + WS_ACT)};
            pg8::gemm_phase<EpiUp, pg8::StaticOrder, MK_ALIGN, MK_SP2>(lds, g, S, E); if (META) thin_gemm<EpiUp>(lds, g.A, g.Bt, g.K, g.N, E, bid, G);
        }
        SEAM(p + 6);
        if (IN(p + 7)) { PHASE_BEGIN();
            pg8::Gemm g{(const bf16*)(ws + WS_ACT), (const bf16*)(wl + OW_DN), MT, DM, FF}; pg8::StaticOrder S; S.init(MT, DM, G, bid);
            EpiRes E{ka->out, Hm, HB, rs_next};
            pg8::gemm_phase<EpiRes, pg8::StaticOrder, MK_ALIGN, MK_SP2>(lds, g, S, E); if (META) thin_gemm<EpiRes>(lds, g.A, g.Bt, g.K, g.N, E, bid, G);
        }
        SEAM(p + 7);
    }
#ifdef MK_DUMP_OFF
    if (IN(PH_FINAL)) { KArgsP ka = KARGS();
        const bf16* src = (const bf16*)(ka->ws + (MK_DUMP_OFF)); const bf16* src2 = (const bf16*)(ka->ws + (MK_DUMP_OFF2));
        for (int i = bid * 512 + threadIdx.x; i < NREAL * 1024; i += G * 512) { const int R = MK_DUMP_ROW(i >> 10), c = i & 1023; ka->out[i] = c < 512 ? bf2f(src[(size_t)R * (MK_DUMP_LD) + (c % (MK_DUMP_LD))]) : bf2f(src2[(size_t)R * (MK_DUMP_LD2) + (c % (MK_DUMP_LD2))]); }
    }
#else
    if (IN(PH_FINAL)) { KArgsP ka = KARGS();
        const float* rs = (const float*)(ka->ws + WS_RS) + (size_t)MK_RSIDX * TPR * 16; const float* gain = ka->in[22];
        int tl_ = threadIdx.x; asm volatile("" : "+v"(tl_));
        for (int i = bid * 512 + tl_; i < NREAL * 256; i += G * 512) {
            const int R = i >> 8, c4 = (i & 255) * 4;
            const float r = row_rstd(rs, R);
            f32x4 v = *(const f32x4*)(ka->out + (size_t)R * DM + c4); const f32x4 gn = *(const f32x4*)(gain + c4);
            v = v * r * gn;
            *(f32x4*)(ka->out + (size_t)R * DM + c4) = v;
        }
    }
#endif
#undef IN
#undef SEAM
}

extern "C" void kernel_launch(void* const* d_in, const int* in_sizes, int n_in, void* d_out, int out_size, void* d_ws, size_t ws_size, hipStream_t stream) {
    static int grid = 0;
    if (grid == 0) {
        if (n_in != 23 || out_size != NREAL * DM || ws_size < WS_END) { fprintf(stderr, "kernel_launch: unexpected shapes (n_in %d out %d ws %zu)\n", n_in, out_size, ws_size); grid = -1; return; }
        int dev = 0, cus = 0, per_cu = 0;
        hipGetDevice(&dev); hipDeviceGetAttribute(&cus, hipDeviceAttributeMultiprocessorCount, dev);
        if (hipFuncSetAttribute((const void*)fwd_kernel, hipFuncAttributeMaxDynamicSharedMemorySize, LDS_BYTES) != hipSuccess) { fprintf(stderr, "kernel_launch: hipFuncSetAttribute failed\n"); grid = -1; return; }
        if (hipOccupancyMaxActiveBlocksPerMultiprocessor(&per_cu, (const void*)fwd_kernel, 512, LDS_BYTES) != hipSuccess || per_cu < 1) { fprintf(stderr, "kernel_launch: occupancy query gave %d\n", per_cu); per_cu = 1; }
        (void)hipGetLastError();
        grid = cus * (per_cu > 1 ? 1 : per_cu);
        if (grid <= 0) grid = 256;
    }
    if (grid < 0) return;
    Args a{};
    for (int i = 0; i < 23; ++i) a.in[i] = (const float*)d_in[i];
    a.out = (float*)d_out; a.ws = (unsigned char*)d_ws;
#if MK_SPLIT
    for (int ph = 0; ph < NPHASE; ++ph) hipLaunchKernelGGL(fwd_kernel, dim3(grid), dim3(512), LDS_BYTES, stream, a, ph, ph + 1);
#else
    int lo = 0, hi = NPHASE;
    void* kargs[] = {(void*)&a, (void*)&lo, (void*)&hi};
    hipError_t e = hipLaunchCooperativeKernel((const void*)fwd_kernel, dim3(grid), dim3(512), kargs, LDS_BYTES, stream);
    if (e != hipSuccess) fprintf(stderr, "kernel_launch: cooperative launch failed: %s (grid %d)\n", hipGetErrorString(e), grid);
#endif
}
```

```cpp
#include <hip/hip_runtime.h>
#include <hip/hip_cooperative_groups.h>
#include <cstdio>
#include <cstdint>
namespace cg = cooperative_groups;
namespace pg8 {
#define PG8_LAS __attribute__((address_space(3)))
typedef unsigned short bf16_t;
typedef short bf16x8 __attribute__((ext_vector_type(8)));
typedef float f32x4 __attribute__((ext_vector_type(4)));
typedef unsigned u32x4 __attribute__((ext_vector_type(4)));
constexpr int BM = 256, BK = 64, HALF = 128, HTB = HALF * BK * 2  , STAGE_BYTES = 8 * HTB, NXCD = 8, WGM = 8;

__host__ __device__ __forceinline__ int lds_byte(int r, int c) { const int st = (r >> 4) * 2 + (c >> 5), rr = r & 15, cc = c & 31, ob = rr * 64 + cc * 2; return st * 1024 + (ob ^ (((ob >> 9) & 1) << 5)); }
__host__ __device__ __forceinline__ void stage_rc(int b, int& R, int& C) { const int st = b / 1024, sb = b % 1024, swz = sb ^ (((sb >> 9) & 1) << 5); R = (st >> 1) * 16 + swz / 64; C = (st & 1) * 32 + (swz % 64) / 2; }
__host__ __device__ __forceinline__ int perm32(int rho) { const int n = rho >> 4, i = rho & 15; return 8 * (i >> 2) + 4 * n + (i & 3); }

struct Unit { int pm, pn; };
struct Gemm { const bf16_t* A; const bf16_t* Bt; int M, N, K; };

struct StaticOrder {
    int nM, nN, nwg, G, c;
    __host__ __device__ void init(int M, int N, int G_, int c_) { nM = M / BM; nN = N / BM; nwg = nM * nN; G = G_; c = c_; }
    __host__ __device__ bool next(int i, Unit& u) const {
        const long L = (long)i * G + c; if (L >= nwg) return false;
        int wgid = (int)L; { const int q = nwg / NXCD, r = nwg % NXCD, xcd = wgid % NXCD, off = wgid / NXCD; wgid = (xcd < r ? xcd * (q + 1) : r * (q + 1) + (xcd - r) * q) + off; }
        const int nig = WGM * nN, gid = wgid / nig, fm = gid * WGM, gsz = (nM - fm) < WGM ? (nM - fm) : WGM;
        u.pm = fm + ((wgid % nig) % gsz); u.pn = (wgid % nig) / gsz; return true;
    }
    __device__ __forceinline__ void a_ready(const Unit&) const {}
    __device__ __forceinline__ void done(const Unit&) const {}
};

__device__ __forceinline__ unsigned cvt_pk_bf16(float lo, float hi) { unsigned r; asm volatile("v_cvt_pk_bf16_f32 %0, %1, %2" : "=v"(r) : "v"(lo), "v"(hi)); return r; }
template <class Epi, class Sched, bool ALIGN_EPI = false, bool SP2 = false>
__device__ __forceinline__ void gemm_phase(PG8_LAS unsigned char* lds, const Gemm g, const Sched& S, const Epi& E) {
    int tid_l = threadIdx.x; asm volatile("" : "+v"(tid_l));
    const int tid = tid_l, wid = __builtin_amdgcn_readfirstlane(tid >> 6), lane = tid & 63, wr = wid >> 2, wc = wid & 3, fr = lane & 15, fq = lane >> 4;
    const int K = g.K, nt = K / BK;
    unsigned voffA[2], voffB[2];
#pragma unroll
    for (int i = 0; i < 2; ++i) { int R, C; stage_rc(tid * 16 + i * 8192, R, C); const int Rb = Epi::PERM ? ((R & ~31) + perm32(R & 31)) : R;
        voffA[i] = (unsigned)(R * K + C) * 2u; voffB[i] = (unsigned)(Rb * K + C) * 2u; }
    const size_t kstep = (size_t)(BK * 2);
    const size_t hstep = (size_t)HALF * K * 2;
    const size_t tstep = 2 * hstep;
    const unsigned ldsw = (unsigned)wid * 1024u;
    const int aoff = lds_byte(wr * 64 + fr, fq * 8), boff = lds_byte(wc * 32 + fr, fq * 8);
#define PG8_SA(b, h) (((b) * 2 + (h)) * HTB)
#define PG8_SB(b, h) ((4 + (b) * 2 + (h)) * HTB)
#define PG8_STAGE(bufoff, gbase, voff) do { _Pragma("unroll") for (int _i = 0; _i < 2; ++_i) \
        __builtin_amdgcn_global_load_lds((const unsigned*)((const char*)(gbase) + (voff)[_i]), (PG8_LAS unsigned*)(lds + (bufoff) + ldsw + _i * 8192), 16, 0, 0); } while (0)
#define PG8_LDA(dst, b, h) do { _Pragma("unroll") for (int m = 0; m < 4; ++m) _Pragma("unroll") for (int k = 0; k < 2; ++k) dst[m][k] = *(const PG8_LAS bf16x8*)(lds + PG8_SA(b, h) + aoff + m * 2048 + k * 1024); } while (0)
#define PG8_LDB(dst, b, h) do { _Pragma("unroll") for (int n = 0; n < 2; ++n) _Pragma("unroll") for (int k = 0; k < 2; ++k) dst[n][k] = *(const PG8_LAS bf16x8*)(lds + PG8_SB(b, h) + boff + n * 2048 + k * 1024); } while (0)
#define PG8_MMA(ai, bj, At, Bt) do { __builtin_amdgcn_s_setprio(1); _Pragma("unroll") for (int m = 0; m < 4; ++m) _Pragma("unroll") for (int n = 0; n < 2; ++n) _Pragma("unroll") for (int k = 0; k < 2; ++k) \
        acc[ai][bj][m][n] = __builtin_amdgcn_mfma_f32_16x16x32_bf16(Bt[n][k], At[m][k], acc[ai][bj][m][n], 0, 0, 0); __builtin_amdgcn_s_setprio(0); } while (0)
#define PG8_WAIT_V(n) asm volatile("s_waitcnt vmcnt(" #n ")" ::: "memory")
#define PG8_WAIT_L(n) asm volatile("s_waitcnt lgkmcnt(" #n ")" ::: "memory")
#define PG8_BAR __builtin_amdgcn_s_barrier()
#define PG8_SCHED __builtin_amdgcn_sched_barrier(0)
    Unit cur, nxt; int ui = 0;
    if (!S.next(0, cur)) return;
    f32x4 acc[2][2][4][2];
#pragma unroll
    for (int a = 0; a < 2; ++a)
#pragma unroll
        for (int b = 0; b < 2; ++b)
#pragma unroll
            for (int m = 0; m < 4; ++m)
#pragma unroll
                for (int n = 0; n < 2; ++n) acc[a][b][m][n] = (f32x4){0.f, 0.f, 0.f, 0.f};
    bf16x8 At[4][2], B0[2][2], B1[2][2];
    const char* cA = (const char*)g.A + (size_t)cur.pm * tstep; const char* cB = (const char*)g.Bt + (size_t)cur.pn * tstep;
    S.a_ready(cur);
    if constexpr (SP2) {
        PG8_STAGE(PG8_SB(0, 0), cB, voffB); PG8_STAGE(PG8_SB(0, 1), cB + hstep, voffB); PG8_STAGE(PG8_SA(0, 0), cA, voffA); PG8_STAGE(PG8_SA(0, 1), cA + hstep, voffA);
        if (wr == 1) PG8_BAR;
        PG8_WAIT_V(2); PG8_BAR;
        PG8_STAGE(PG8_SB(1, 0), cB + kstep, voffB); PG8_STAGE(PG8_SA(1, 0), cA + kstep, voffA); PG8_STAGE(PG8_SB(1, 1), cB + hstep + kstep, voffB);
        PG8_WAIT_V(6); PG8_BAR;
    } else {
        PG8_STAGE(PG8_SB(0, 0), cB, voffB); PG8_STAGE(PG8_SA(0, 0), cA, voffA); PG8_STAGE(PG8_SB(0, 1), cB + hstep, voffB); PG8_STAGE(PG8_SA(0, 1), cA + hstep, voffA);
        if (wr == 1) PG8_BAR;
        PG8_WAIT_V(4); PG8_BAR;
        PG8_STAGE(PG8_SB(1, 0), cB + kstep, voffB); PG8_STAGE(PG8_SA(1, 0), cA + kstep, voffA); PG8_STAGE(PG8_SB(1, 1), cB + hstep + kstep, voffB);
        PG8_WAIT_V(6); PG8_BAR;
    }
    for (;;) {
        const bool has_next = S.next(ui + 1, nxt);
        const char* nA = has_next ? (const char*)g.A + (size_t)nxt.pm * tstep : cA; const char* nB = has_next ? (const char*)g.Bt + (size_t)nxt.pn * tstep : cB;
        for (int t = 0; t < nt; t += 2) {
            const bool last = (t == nt - 2);
            const char* a1 = cA + (size_t)(t + 1) * kstep;
            const char* a2 = last ? nA : cA + (size_t)(t + 2) * kstep; const char* b2 = last ? nB : cB + (size_t)(t + 2) * kstep;
            const char* a3 = a2 + kstep; const char* b3 = b2 + kstep;
            if (last && has_next) S.a_ready(nxt);
            if constexpr (SP2) {
            PG8_LDB(B0, 0, 0); PG8_LDB(B1, 0, 1); PG8_SCHED; PG8_LDA(At, 0, 0); PG8_STAGE(PG8_SA(1, 1), a1 + hstep, voffA);
            PG8_WAIT_V(8); PG8_WAIT_L(0); PG8_BAR; PG8_MMA(0, 0, At, B0); PG8_MMA(0, 1, At, B1); PG8_BAR; PG8_SCHED;
            PG8_LDA(At, 0, 1); PG8_STAGE(PG8_SB(0, 0), b2, voffB); PG8_STAGE(PG8_SB(0, 1), b2 + hstep, voffB); PG8_STAGE(PG8_SA(0, 0), a2, voffA);
            PG8_WAIT_V(8); PG8_WAIT_L(0); PG8_BAR; PG8_MMA(1, 0, At, B0); PG8_MMA(1, 1, At, B1); PG8_BAR; PG8_SCHED;
            PG8_LDB(B0, 1, 0); PG8_LDB(B1, 1, 1); PG8_SCHED; PG8_LDA(At, 1, 0); PG8_STAGE(PG8_SA(0, 1), a2 + hstep, voffA);
            PG8_WAIT_V(8); PG8_WAIT_L(0); PG8_BAR; PG8_MMA(0, 0, At, B0); PG8_MMA(0, 1, At, B1); PG8_BAR; PG8_SCHED;
            PG8_LDA(At, 1, 1); PG8_STAGE(PG8_SB(1, 0), b3, voffB); PG8_STAGE(PG8_SB(1, 1), b3 + hstep, voffB); PG8_STAGE(PG8_SA(1, 0), a3, voffA);
            PG8_WAIT_V(8); PG8_WAIT_L(0); PG8_BAR; PG8_MMA(1, 0, At, B0); PG8_MMA(1, 1, At, B1); PG8_BAR; PG8_SCHED;
            } else {
            PG8_LDB(B0, 0, 0); PG8_SCHED; PG8_LDA(At, 0, 0); PG8_STAGE(PG8_SA(1, 1), a1 + hstep, voffA);
            PG8_WAIT_L(8); PG8_BAR; PG8_WAIT_L(0); PG8_MMA(0, 0, At, B0); PG8_BAR; PG8_SCHED;
            PG8_LDB(B1, 0, 1); PG8_STAGE(PG8_SB(0, 0), b2, voffB);
            PG8_BAR; PG8_WAIT_L(0); PG8_MMA(0, 1, At, B1); PG8_BAR;
            PG8_LDA(At, 0, 1); PG8_STAGE(PG8_SA(0, 0), a2, voffA);
            PG8_BAR; PG8_WAIT_L(0); PG8_MMA(1, 0, At, B0); PG8_BAR; PG8_SCHED;
            PG8_STAGE(PG8_SB(0, 1), b2 + hstep, voffB);
            PG8_WAIT_V(6); PG8_BAR; PG8_MMA(1, 1, At, B1); PG8_BAR;
            PG8_LDB(B0, 1, 0); PG8_SCHED; PG8_LDA(At, 1, 0); PG8_STAGE(PG8_SA(0, 1), a2 + hstep, voffA);
            PG8_WAIT_L(8); PG8_BAR; PG8_WAIT_L(0); PG8_MMA(0, 0, At, B0); PG8_BAR; PG8_SCHED;
            PG8_LDB(B1, 1, 1); PG8_STAGE(PG8_SB(1, 0), b3, voffB);
            PG8_BAR; PG8_WAIT_L(0); PG8_MMA(0, 1, At, B1); PG8_BAR;
            PG8_LDA(At, 1, 1); PG8_STAGE(PG8_SA(1, 0), a3, voffA);
            PG8_BAR; PG8_WAIT_L(0); PG8_MMA(1, 0, At, B0); PG8_BAR; PG8_SCHED;
            PG8_STAGE(PG8_SB(1, 1), b3 + hstep, voffB);
            PG8_WAIT_V(6); PG8_BAR; PG8_MMA(1, 1, At, B1); PG8_BAR;
            }
        }
        if constexpr (ALIGN_EPI) { if (wr == 0) PG8_BAR; }
        asm volatile("s_nop 15\n\ts_nop 15" ::: "memory");
        if constexpr (!Epi::AFTER_DRAIN) { E(acc, cur, wr, wc, fr, fq); S.done(cur); }
        if (!has_next) break;
#pragma unroll
        for (int a = 0; a < 2; ++a)
#pragma unroll
            for (int b = 0; b < 2; ++b)
#pragma unroll
                for (int m = 0; m < 4; ++m)
#pragma unroll
                    for (int n = 0; n < 2; ++n) acc[a][b][m][n] = (f32x4){0.f, 0.f, 0.f, 0.f};
        cur = nxt; cA = nA; cB = nB; ++ui;
        if constexpr (ALIGN_EPI) { if (wr == 1) PG8_BAR; }
    }
    PG8_WAIT_V(0);
    if constexpr (!ALIGN_EPI) { if (wr == 0) PG8_BAR; }
    PG8_BAR;
    if constexpr (Epi::AFTER_DRAIN) { E.fused(acc, cur, wr, wc, fr, fq, lds, wid, lane); S.done(cur); }
#undef PG8_SA
#undef PG8_SB
#undef PG8_STAGE
#undef PG8_LDA
#undef PG8_LDB
#undef PG8_MMA
#undef PG8_WAIT_V
#undef PG8_WAIT_L
#undef PG8_BAR
#undef PG8_SCHED
}
}

#define LAS __attribute__((address_space(3)))
typedef unsigned short bf16;
typedef short bf16x8 __attribute__((ext_vector_type(8)));
typedef float f32x4 __attribute__((ext_vector_type(4)));
typedef float f32x16 __attribute__((ext_vector_type(16)));
typedef unsigned u32x2 __attribute__((ext_vector_type(2)));
typedef unsigned u32x4 __attribute__((ext_vector_type(4)));

constexpr int NB = 8, SEQ = 2048, NMETA = 16, LL = 2064, DM = 1024, FF = 4096, DIN = 4864, NPROJ = 1792;
constexpr int NREAL = NB * SEQ;
constexpr int TPR = NREAL + 256;
constexpr int LDS_BYTES = 147456;

constexpr size_t MiB = 1u << 20;
constexpr size_t WS_CTL = 0;
constexpr size_t WS_ROPE = 1 * MiB;
constexpr size_t WS_ABAR = 2 * MiB;
constexpr size_t WS_BMAT = 2 * MiB + 65536;
constexpr size_t WS_CMAT = WS_BMAT + 524288;
constexpr size_t WS_HM = 4 * MiB;
constexpr size_t WS_W = 5 * MiB;
constexpr size_t OW_IN = 0, OW_GLU = (size_t)DIN * DM * 2, OW_POOL = OW_GLU + 512 * 512 * 2, OW_BR = OW_POOL + 512 * 512 * 2,
                 OW_OUT = OW_BR + 3 * 1024 * 512 * 2, OW_UP = OW_OUT + 1024 * 1024 * 2, OW_DN = OW_UP + (size_t)FF * DM * 2, LW_BYTES = OW_DN + (size_t)FF * DM * 2;
constexpr size_t WS_HB = 68 * MiB;
constexpr size_t WS_X = 101 * MiB;
constexpr size_t UU = (size_t)TPR * 512 * 2;
constexpr size_t WS_YF = WS_X, WS_YP = WS_X, WS_Q = WS_X + 2 * UU, WS_K = WS_Q + UU, WS_V = WS_K + UU / 4, WS_MG = WS_X + 2 * UU,
                 WS_SU = WS_X + 4 * UU, WS_YA = WS_X + 8 * UU  , WS_PU = WS_X + 5 * UU, WS_YS = WS_PU, WS_Z = WS_X + 6 * UU, WS_PD = WS_X + 7 * UU, WS_BR = WS_Z, WS_ACT = WS_X;
constexpr size_t WS_RS = WS_X + 9 * UU;
constexpr size_t WS_END = WS_RS + (size_t)5 * TPR * 16 * 4;
static_assert(WS_W + 2 * LW_BYTES <= WS_HB && WS_HB + (size_t)TPR * 1024 * 2 <= WS_X && WS_END <= 256 * MiB, "ws map");
static_assert((size_t)256 * 2064 * 16 * 4 <= 2 * UU, "YF fits");

__device__ __forceinline__ unsigned pk2(float lo, float hi) { unsigned r; asm("v_cvt_pk_bf16_f32 %0, %1, %2" : "=v"(r) : "v"(lo), "v"(hi)); return r; }
__device__ __forceinline__ unsigned f2bf(float f) { return pk2(f, 0.f) & 0xffffu; }
__device__ __forceinline__ float bf2f(unsigned b) { return __uint_as_float(b << 16); }
__device__ __forceinline__ int tok_row(int b, int l) { return l >= NMETA ? b * SEQ + l - NMETA : NREAL + b * NMETA + l; }
#define LDS_FENCE() asm volatile("s_waitcnt lgkmcnt(0)" ::: "memory")
#define SSM_SYNC() do { asm volatile("s_waitcnt vmcnt(0) lgkmcnt(0)" ::: "memory"); __syncthreads(); } while (0)
__device__ __forceinline__ float row_rstd(const float* rs, int R) {
    const f32x4 a = *(const f32x4*)(rs + (size_t)R * 4), b = *(const f32x4*)(rs + ((size_t)TPR + R) * 4), c = *(const f32x4*)(rs + ((size_t)2 * TPR + R) * 4), d = *(const f32x4*)(rs + ((size_t)3 * TPR + R) * 4);
    const float s = (((a[0] + a[1]) + (a[2] + a[3])) + ((b[0] + b[1]) + (b[2] + b[3]))) + (((c[0] + c[1]) + (c[2] + c[3])) + ((d[0] + d[1]) + (d[2] + d[3])));
    return rsqrtf(s * (1.0f / 1024.0f) + 1e-6f);
}

__device__ __forceinline__ void dsincos(double a, double& s, double& c) {
    const double q = rint(a * 0.63661977236758134308);
    double r = fma(-q, 1.57079632679489655800e+00, a); r = fma(-q, 6.12323399573676603587e-17, r);
    const double r2 = r * r;
    double sp = -7.6471637318198164759e-13; sp = fma(sp, r2, 1.6059043836821614599e-10); sp = fma(sp, r2, -2.5052108385441718775e-08); sp = fma(sp, r2, 2.7557319223985890653e-06);
    sp = fma(sp, r2, -1.9841269841269841270e-04); sp = fma(sp, r2, 8.3333333333333333333e-03); sp = fma(sp, r2, -1.6666666666666666667e-01); sp = fma(sp * r2, r, r);
    double cp = 4.7794773323873852974e-14; cp = fma(cp, r2, -1.1470745597729724714e-11); cp = fma(cp, r2, 2.0876756987868098979e-09); cp = fma(cp, r2, -2.7557319223985890653e-07);
    cp = fma(cp, r2, 2.4801587301587301587e-05); cp = fma(cp, r2, -1.3888888888888888889e-03); cp = fma(cp, r2, 4.1666666666666666667e-02); cp = fma(cp, r2, -0.5); cp = fma(cp, r2, 1.0);
    const int qi = ((int)q) & 3;
    s = (qi == 0) ? sp : (qi == 1) ? cp : (qi == 2) ? -sp : -cp;
    c = (qi == 0) ? cp : (qi == 1) ? -sp : (qi == 2) ? -cp : sp;
}
__device__ __forceinline__ double dexp(double x) {
    const double k = rint(x * 1.44269504088896340736);
    double r = fma(-k, 6.93147180369123816490e-01, x); r = fma(-k, 1.90821492927058770002e-10, r);
    double p = 1.0 / 6227020800.0; p = fma(p, r, 1.0 / 479001600.0); p = fma(p, r, 1.0 / 39916800.0); p = fma(p, r, 1.0 / 3628800.0); p = fma(p, r, 1.0 / 362880.0); p = fma(p, r, 1.0 / 40320.0);
    p = fma(p, r, 1.0 / 5040.0); p = fma(p, r, 1.0 / 720.0); p = fma(p, r, 1.0 / 120.0); p = fma(p, r, 1.0 / 24.0); p = fma(p, r, 1.0 / 6.0); p = fma(p, r, 0.5); p = fma(p, r, 1.0); p = fma(p, r, 1.0);
    const long long bits = ((long long)(1023 + (int)k)) << 52;
    return p * __longlong_as_double(bits);
}

struct EpiInProj {
    static constexpr bool PERM = true, AFTER_DRAIN = false;
    const float* rowss; const float* rope; bf16 *Q, *K, *V, *SU, *PU;
    __device__ __forceinline__ u32x2 quad(int l, int c, const f32x4& v) const {
        u32x2 w;
        if (c < 640) {
            const int i0 = (c & 63) >> 1;
            const f32x4 cs = *(const f32x4*)(rope + ((size_t)l * 32 + i0) * 2);
            float o0 = v[0] * cs[0] - v[1] * cs[1], o1 = v[1] * cs[0] + v[0] * cs[1], o2 = v[2] * cs[2] - v[3] * cs[3], o3 = v[3] * cs[2] + v[2] * cs[3];
            if (c < 512) { o0 *= 0.125f; o1 *= 0.125f; o2 *= 0.125f; o3 *= 0.125f; }
            w.x = pk2(o0, o1); w.y = pk2(o2, o3);
        } else { w.x = pk2(v[0], v[1]); w.y = pk2(v[2], v[3]); }
        return w;
    }
    __device__ __forceinline__ void operator()(const f32x4 (&acc)[2][2][4][2], const pg8::Unit& u, int wr, int wc, int fr, int fq) const {
#pragma unroll
        for (int ai = 0; ai < 2; ++ai)
#pragma unroll
            for (int m = 0; m < 4; ++m) {
                const int R = u.pm * 256 + ai * 128 + wr * 64 + m * 16 + fr;
                const float rs = row_rstd(rowss, R);
                const int l = R < NREAL ? (R & 2047) + NMETA : (R & 15);
#pragma unroll
                for (int bj = 0; bj < 2; ++bj) {
                    const int c = u.pn * 256 + bj * 128 + wc * 32 + 8 * fq;
                    const u32x2 w0 = quad(l, c, acc[ai][bj][m][0] * rs), w1 = quad(l, c + 4, acc[ai][bj][m][1] * rs);
                    u32x4 w; w.x = w0.x; w.y = w0.y; w.z = w1.x; w.w = w1.y;
                    bf16* dst = c < 512 ? Q + (size_t)R * 512 + c : c < 640 ? K + (size_t)R * 128 + (c - 512) : c < 768 ? V + (size_t)R * 128 + (c - 640)
                              : c < 1280 ? SU + (size_t)R * 512 + (c - 768) : PU + (size_t)R * 512 + (c - 1280);
                    *(u32x4*)dst = w;
                }
            }
    }
};
#define EPI_BODY() \
    __device__ __forceinline__ void rg(int R, int pn, int wc, int fq, const f32x4 (&a4)[2][2]) const { \
        _Pragma("unroll") for (int bj = 0; bj < 2; ++bj) q2(R, pn * 256 + bj * 128 + wc * 32 + 8 * fq, a4[bj][0], a4[bj][1]); } \
    __device__ __forceinline__ void tq(int R, int c, const f32x4& v) const { q(R, c, v); } \
    EPI_OP()
#define EPI_OP() \
    __device__ __forceinline__ void operator()(const f32x4 (&acc)[2][2][4][2], const pg8::Unit& u, int wr, int wc, int fr, int fq) const { \
        _Pragma("unroll") for (int ai = 0; ai < 2; ++ai) _Pragma("unroll") for (int m = 0; m < 4; ++m) { \
            const f32x4 a4[2][2] = {{acc[ai][0][m][0], acc[ai][0][m][1]}, {acc[ai][1][m][0], acc[ai][1][m][1]}}; \
            rg(u.pm * 256 + ai * 128 + wr * 64 + m * 16 + fr, u.pn, wc, fq, a4); } }
#define EPI_BODY_RS() \
    __device__ __forceinline__ void rg(int R, int pn, int wc, int fq, const f32x4 (&a4)[2][2]) const { const float rs = row_rstd(rowss, R); \
        _Pragma("unroll") for (int bj = 0; bj < 2; ++bj) q2(R, pn * 256 + bj * 128 + wc * 32 + 8 * fq, a4[bj][0], a4[bj][1], rs); } \
    __device__ __forceinline__ void tq(int R, int c, const f32x4& v) const { q(R, c, v, row_rstd(rowss, R)); } \
    EPI_OP()
struct EpiGlu {
    static constexpr bool PERM = true, AFTER_DRAIN = false;
    const bf16* Z; const float* bias; bf16* YS;
    __device__ __forceinline__ void q(int R, int c, const f32x4& a) const {
        const f32x4 v = a + *(const f32x4*)(bias + c);
        const u32x2 zz = *(const u32x2*)(Z + (size_t)R * 512 + c);
        const float z0 = bf2f(zz.x & 0xffffu), z1 = bf2f(zz.x >> 16), z2 = bf2f(zz.y & 0xffffu), z3 = bf2f(zz.y >> 16);
        u32x2 w; w.x = pk2(z0 * __builtin_amdgcn_rcpf(1.0f + __expf(-v[0])), z1 * __builtin_amdgcn_rcpf(1.0f + __expf(-v[1]))); w.y = pk2(z2 * __builtin_amdgcn_rcpf(1.0f + __expf(-v[2])), z3 * __builtin_amdgcn_rcpf(1.0f + __expf(-v[3])));
        *(u32x2*)(YS + (size_t)R * 512 + c) = w;
    }
    __device__ __forceinline__ void q2(int R, int c, const f32x4& a0, const f32x4& a1) const {
        const f32x4 v0 = a0 + *(const f32x4*)(bias + c), v1 = a1 + *(const f32x4*)(bias + c + 4);
        const u32x4 zz = *(const u32x4*)(Z + (size_t)R * 512 + c);
        u32x4 w;
        w.x = pk2(bf2f(zz.x & 0xffffu) * __builtin_amdgcn_rcpf(1.0f + __expf(-v0[0])), bf2f(zz.x >> 16) * __builtin_amdgcn_rcpf(1.0f + __expf(-v0[1])));
        w.y = pk2(bf2f(zz.y & 0xffffu) * __builtin_amdgcn_rcpf(1.0f + __expf(-v0[2])), bf2f(zz.y >> 16) * __builtin_amdgcn_rcpf(1.0f + __expf(-v0[3])));
        w.z = pk2(bf2f(zz.z & 0xffffu) * __builtin_amdgcn_rcpf(1.0f + __expf(-v1[0])), bf2f(zz.z >> 16) * __builtin_amdgcn_rcpf(1.0f + __expf(-v1[1])));
        w.w = pk2(bf2f(zz.w & 0xffffu) * __builtin_amdgcn_rcpf(1.0f + __expf(-v1[2])), bf2f(zz.w >> 16) * __builtin_amdgcn_rcpf(1.0f + __expf(-v1[3])));
        *(u32x4*)(YS + (size_t)R * 512 + c) = w;
    }
    EPI_BODY()
};
struct EpiScale {
    static constexpr bool PERM = true, AFTER_DRAIN = false;
    bf16* O; int ldc; const float* scale;
    __device__ __forceinline__ void q(int R, int c, const f32x4& a) const {
        f32x4 v = a;
        if (scale) v = v * *(const f32x4*)(scale + c);
        u32x2 w; w.x = pk2(v[0], v[1]); w.y = pk2(v[2], v[3]);
        *(u32x2*)(O + (size_t)R * ldc + c) = w;
    }
    __device__ __forceinline__ void q2(int R, int c, const f32x4& a0, const f32x4& a1) const {
        f32x4 v0 = a0, v1 = a1;
        if (scale) { v0 = v0 * *(const f32x4*)(scale + c); v1 = v1 * *(const f32x4*)(scale + c + 4); }
        u32x4 w; w.x = pk2(v0[0], v0[1]); w.y = pk2(v0[2], v0[3]); w.z = pk2(v1[0], v1[1]); w.w = pk2(v1[2], v1[3]);
        *(u32x4*)(O + (size_t)R * ldc + c) = w;
    }
    EPI_BODY()
};
template <bool FIRST> struct EpiGate {
    static constexpr bool PERM = true, AFTER_DRAIN = false;
    const float* rowss; const bf16* BR; bf16* MG;
    __device__ __forceinline__ void q(int R, int c, const f32x4& a, float rs) const {
        const f32x4 v = a * rs;
        const u32x2 bb = *(const u32x2*)(BR + (size_t)R * 1024 + c);
        float o0 = bf2f(bb.x & 0xffffu) * __builtin_amdgcn_rcpf(1.0f + __expf(-v[0])), o1 = bf2f(bb.x >> 16) * __builtin_amdgcn_rcpf(1.0f + __expf(-v[1]));
        float o2 = bf2f(bb.y & 0xffffu) * __builtin_amdgcn_rcpf(1.0f + __expf(-v[2])), o3 = bf2f(bb.y >> 16) * __builtin_amdgcn_rcpf(1.0f + __expf(-v[3]));
        if (!FIRST) { const u32x2 mm = *(const u32x2*)(MG + (size_t)R * 1024 + c);
            o0 += bf2f(mm.x & 0xffffu); o1 += bf2f(mm.x >> 16); o2 += bf2f(mm.y & 0xffffu); o3 += bf2f(mm.y >> 16); }
        u32x2 w; w.x = pk2(o0, o1); w.y = pk2(o2, o3);
        *(u32x2*)(MG + (size_t)R * 1024 + c) = w;
    }
    __device__ __forceinline__ void q2(int R, int c, const f32x4& a0, const f32x4& a1, float rs) const {
        const f32x4 v0 = a0 * rs, v1 = a1 * rs;
        const u32x4 bb = *(const u32x4*)(BR + (size_t)R * 1024 + c);
        float o[8];
        o[0] = bf2f(bb.x & 0xffffu) * __builtin_amdgcn_rcpf(1.0f + __expf(-v0[0])); o[1] = bf2f(bb.x >> 16) * __builtin_amdgcn_rcpf(1.0f + __expf(-v0[1]));
        o[2] = bf2f(bb.y & 0xffffu) * __builtin_amdgcn_rcpf(1.0f + __expf(-v0[2])); o[3] = bf2f(bb.y >> 16) * __builtin_amdgcn_rcpf(1.0f + __expf(-v0[3]));
        o[4] = bf2f(bb.z & 0xffffu) * __builtin_amdgcn_rcpf(1.0f + __expf(-v1[0])); o[5] = bf2f(bb.z >> 16) * __builtin_amdgcn_rcpf(1.0f + __expf(-v1[1]));
        o[6] = bf2f(bb.w & 0xffffu) * __builtin_amdgcn_rcpf(1.0f + __expf(-v1[2])); o[7] = bf2f(bb.w >> 16) * __builtin_amdgcn_rcpf(1.0f + __expf(-v1[3]));
        if (!FIRST) { const u32x4 mm = *(const u32x4*)(MG + (size_t)R * 1024 + c);
            o[0] += bf2f(mm.x & 0xffffu); o[1] += bf2f(mm.x >> 16); o[2] += bf2f(mm.y & 0xffffu); o[3] += bf2f(mm.y >> 16);
            o[4] += bf2f(mm.z & 0xffffu); o[5] += bf2f(mm.z >> 16); o[6] += bf2f(mm.w & 0xffffu); o[7] += bf2f(mm.w >> 16); }
        u32x4 w; w.x = pk2(o[0], o[1]); w.y = pk2(o[2], o[3]); w.z = pk2(o[4], o[5]); w.w = pk2(o[6], o[7]);
        *(u32x4*)(MG + (size_t)R * 1024 + c) = w;
    }
    EPI_BODY_RS()
};
struct EpiRes {
    static constexpr bool PERM = true, AFTER_DRAIN = false;
    float* Hreal; float* Hmeta; bf16* HB; float* rowss_out; const float* Hin;
    __device__ __forceinline__ float q(int R, int c, const f32x4& a) const {
        float* hrow = R < NREAL ? Hreal + (size_t)R * 1024 : Hmeta + (size_t)(R - NREAL) * 1024;
        const float* hin = R < NREAL ? Hin + (size_t)R * 1024 : hrow;
        const f32x4 h = *(const f32x4*)(hin + c) + a;
        *(f32x4*)(hrow + c) = h;
        u32x2 w; w.x = pk2(h[0], h[1]); w.y = pk2(h[2], h[3]);
        *(u32x2*)(HB + (size_t)R * 1024 + c) = w;
        return (h[0] * h[0] + h[1] * h[1]) + (h[2] * h[2] + h[3] * h[3]);
    }
    __device__ __forceinline__ void rg(int R, int pn, int wc, int fq, const f32x4 (&a4)[2][2]) const {
        float ss = 0.f;
#pragma unroll
        for (int bj = 0; bj < 2; ++bj)
#pragma unroll
            for (int n = 0; n < 2; ++n) ss += q(R, pn * 256 + bj * 128 + wc * 32 + 8 * fq + 4 * n, a4[bj][n]);
        ss += __shfl_xor(ss, 16); ss += __shfl_xor(ss, 32);
        if (fq == 0) rowss_out[((size_t)pn * TPR + R) * 4 + wc] = ss;
    }
    __device__ __forceinline__ void tq(int R, int c, const f32x4& v) const {
        float ss = q(R, c, v);
        ss += __shfl_xor(ss, 16); ss += __shfl_xor(ss, 32);
        if ((threadIdx.x & 48) == 0) atomicAdd(rowss_out + (size_t)R * 4, ss);
    }
    EPI_OP()
};
struct EpiUp {
    static constexpr bool PERM = true, AFTER_DRAIN = false;
    const float* rowss; bf16* ACT;
    __device__ __forceinline__ void q(int R, int c, const f32x4& a, float rs) const {
        f32x4 v = a * rs;
#pragma unroll
        for (int j = 0; j < 4; ++j) { const float r = fmaxf(v[j], 0.f); v[j] = r * r; }
        u32x2 w; w.x = pk2(v[0], v[1]); w.y = pk2(v[2], v[3]);
        *(u32x2*)(ACT + (size_t)R * FF + c) = w;
    }
    __device__ __forceinline__ void q2(int R, int c, const f32x4& a0, const f32x4& a1, float rs) const {
        f32x4 v0 = a0 * rs, v1 = a1 * rs;
#pragma unroll
        for (int j = 0; j < 4; ++j) { const float r0 = fmaxf(v0[j], 0.f), r1 = fmaxf(v1[j], 0.f); v0[j] = r0 * r0; v1[j] = r1 * r1; }
        u32x4 w; w.x = pk2(v0[0], v0[1]); w.y = pk2(v0[2], v0[3]); w.z = pk2(v1[0], v1[1]); w.w = pk2(v1[2], v1[3]);
        *(u32x4*)(ACT + (size_t)R * FF + c) = w;
    }
    EPI_BODY_RS()
};
template <class Epi>
__device__ __forceinline__ void thin_gemm(LAS unsigned char* lds, const bf16* A, const bf16* Bt, int K, int N, const Epi& E, int vb, int vg) {
    int tid_l = threadIdx.x; asm volatile("" : "+v"(tid_l));
    const int lane = tid_l & 63, w = __builtin_amdgcn_readfirstlane(tid_l >> 6), fr = lane & 15, fq = lane >> 4;
    LAS f32x4* red = (LAS f32x4*)lds;
    const int kw = K >> 3;
    for (int pc = vb; pc < N / 16; pc += vg) {
        const bf16* ap = A + (size_t)(NREAL + fr) * K + w * kw + 8 * fq;
        const bf16* bp = Bt + (size_t)(16 * pc + fr) * K + w * kw + 8 * fq;
        f32x4 acc[8];
#pragma unroll
        for (int rb = 0; rb < 8; ++rb) acc[rb] = (f32x4){0.f, 0.f, 0.f, 0.f};
#pragma unroll 2
        for (int k0 = 0; k0 < kw; k0 += 32) {
            const bf16x8 bf = *(const bf16x8*)(bp + k0);
            bf16x8 af[8];
#pragma unroll
            for (int rb = 0; rb < 8; ++rb) af[rb] = *(const bf16x8*)(ap + (size_t)(16 * rb) * K + k0);
#pragma unroll
            for (int rb = 0; rb < 8; ++rb) acc[rb] = __builtin_amdgcn_mfma_f32_16x16x32_bf16(bf, af[rb], acc[rb], 0, 0, 0);
        }
        asm volatile("s_nop 15\n\ts_nop 15" : "+v"(acc[0]), "+v"(acc[1]), "+v"(acc[2]), "+v"(acc[3]), "+v"(acc[4]), "+v"(acc[5]), "+v"(acc[6]), "+v"(acc[7]));
#pragma unroll
        for (int rb = 0; rb < 8; ++rb) red[(w * 8 + rb) * 64 + lane] = acc[rb];
        LDS_FENCE(); __syncthreads();
        f32x4 v = red[(0 * 8 + w) * 64 + lane];
#pragma unroll
        for (int ww = 1; ww < 8; ++ww) v = v + red[(ww * 8 + w) * 64 + lane];
        LDS_FENCE(); __syncthreads();
        E.tq(NREAL + 16 * w + fr, 16 * pc + 4 * fq, v);
    }
}

struct Args { const float* in[23]; float* out; unsigned char* ws; };

__device__ __forceinline__ void p0_item(const float* W, int ldw, int K, const float* scale, bf16* WT, int permrows, LAS float* scr, int item, int nblk, int lane) {
    const int kb = item / nblk, nb = item % nblk, k0 = 64 * kb, n0 = 64 * nb;
#pragma unroll 4
    for (int i = 0; i < 16; ++i) {
        const int kk = 4 * i + (lane >> 4), c4 = (lane & 15) * 4;
        f32x4 w = *(const f32x4*)(W + (size_t)(k0 + kk) * ldw + n0 + c4);
        if (scale) w = w * scale[k0 + kk];
        scr[kk * 65 + c4] = w[0]; scr[kk * 65 + c4 + 1] = w[1]; scr[kk * 65 + c4 + 2] = w[2]; scr[kk * 65 + c4 + 3] = w[3];
    }
    LDS_FENCE();
    const int c = lane & 7;
#pragma unroll
    for (int j = 0; j < 8; ++j) {
        const int n = (lane >> 3) + 8 * j;
        const int sc = (n0 + n) < permrows ? ((n & 1) ? 32 + (n >> 1) : (n >> 1)) : n;
        const LAS float* s = scr + (8 * c) * 65 + sc;
        u32x4 o; o.x = pk2(s[0 * 65], s[1 * 65]); o.y = pk2(s[2 * 65], s[3 * 65]); o.z = pk2(s[4 * 65], s[5 * 65]); o.w = pk2(s[6 * 65], s[7 * 65]);
        *(u32x4*)(WT + (size_t)(n0 + n) * K + k0 + 8 * c) = o;
    }
    LDS_FENCE();
}

__device__ __forceinline__ void p0_prologue(const Args& a, LAS unsigned char* lds) {
    int tl_ = threadIdx.x; asm volatile("" : "+v"(tl_));
    const int tid = tl_, lane = tid & 63, wave = __builtin_amdgcn_readfirstlane(tid >> 6);
    const int gw = blockIdx.x * 8 + wave, NGW = gridDim.x * 8;
    const int gt = blockIdx.x * 512 + tid, NGT = gridDim.x * 512;
    unsigned char* ws = a.ws;
    LAS float* scr = (LAS float*)(lds + wave * 17408);
    for (int i = gt; i < 4 * 4 * 128 * 4; i += NGT) { const int idx = 1 + (i >> 11), pn = (i >> 9) & 3, r = (i >> 2) & 127, sl = i & 3;
        ((float*)(ws + WS_RS))[((size_t)idx * 4 * TPR + (size_t)pn * TPR + NREAL + r) * 4 + sl] = 0.f; }
    constexpr int I_IN = 16 * 76, I_GLU = 8 * 8, I_BR = 8 * 16, I_OUT = 16 * 16, I_UP = 16 * 64, I_DN = 64 * 16, I_L = I_IN + I_GLU + 3 * I_BR + I_OUT + I_UP + I_DN;
    for (int it = gw; it < 2 * I_L; it += NGW) {
        const int layer = it / I_L; int r = it % I_L;
        unsigned char* wl = ws + WS_W + (size_t)layer * LW_BYTES;
        if (r < I_IN) { p0_item(a.in[3] + (size_t)layer * DM * DIN, DIN, DM, a.in[2] + layer * DM, (bf16*)(wl + OW_IN), 640, scr, r, 76, lane); continue; } r -= I_IN;
        if (r < I_GLU) { p0_item(a.in[13] + (size_t)layer * 512 * 512, 512, 512, nullptr, (bf16*)(wl + OW_GLU), 0, scr, r, 8, lane); continue; } r -= I_GLU;
        if (r < 3 * I_BR) { const int c = r / I_BR; p0_item(a.in[17] + ((size_t)layer * 3 + c) * 512 * 1024, 1024, 512, nullptr, (bf16*)(wl + OW_BR) + (size_t)c * 1024 * 512, 0, scr, r % I_BR, 16, lane); continue; } r -= 3 * I_BR;
        if (r < I_OUT) { p0_item(a.in[18] + (size_t)layer * DM * DM, DM, DM, nullptr, (bf16*)(wl + OW_OUT), 0, scr, r, 16, lane); continue; } r -= I_OUT;
        if (r < I_UP) { p0_item(a.in[20] + (size_t)layer * DM * FF, FF, DM, a.in[19] + layer * DM, (bf16*)(wl + OW_UP), 0, scr, r, 64, lane); continue; } r -= I_UP;
        p0_item(a.in[21] + (size_t)layer * FF * DM, DM, FF, nullptr, (bf16*)(wl + OW_DN), 0, scr, r, 16, lane);
    }
    for (int i = gt; i < 2 * 512 * 512; i += NGT) {
        const int layer = i >> 18, n = (i >> 9) & 511, k = i & 511;
        float w = 0.f;
        if ((n >> 7) == (k >> 7)) w = a.in[15][(((size_t)layer * 4 + (n >> 7)) * 128 + (k & 127)) * 128 + (n & 127)];
        ((bf16*)(ws + WS_W + (size_t)layer * LW_BYTES + OW_POOL))[(size_t)n * 512 + k] = (bf16)f2bf(w);
    }
    for (int i = gt; i < LL * 32; i += NGT) {
        const int l = i >> 5, f = i & 31;
        const float invf = (float)dexp(-(double)f * (9.21034037197618273607 / 32.0));
        const float ang = (float)l * invf;
        double s, c; dsincos((double)ang, s, c);
        float* rp = (float*)(ws + WS_ROPE) + (size_t)i * 2; rp[0] = (float)c; rp[1] = (float)s;
    }
    for (int i = gt; i < 2 * 2 * 32 * 64; i += NGT) {
        const int n = i & 63, pidx = i >> 6;
        const double lr = (double)a.in[5][i], li = (double)a.in[6][i];
        const double dt = (double)(float)dexp((double)a.in[7][pidx]);
        const double mag = dexp(lr * dt); double sn, cn; dsincos(li * dt, sn, cn);
        const double are = mag * cn, aim = mag * sn, den = lr * lr + li * li, nre = are - 1.0;
        const double fre = (nre * lr + aim * li) / den, fim = (aim * lr - nre * li) / den;
        float* ab = (float*)(ws + WS_ABAR) + (size_t)i * 2; ab[0] = (float)are; ab[1] = (float)aim;
        bf16* bm = (bf16*)(ws + WS_BMAT) + (size_t)pidx * 128 * 16;
        bf16* cm = (bf16*)(ws + WS_CMAT) + (size_t)pidx * 16 * 128;
        for (int q = 0; q < 16; ++q) {
            const double br = (double)a.in[8][(size_t)i * 16 + q], bi = (double)a.in[9][(size_t)i * 16 + q];
            bm[n * 16 + q] = (bf16)f2bf((float)(fre * br - fim * bi));
            bm[(64 + n) * 16 + q] = (bf16)f2bf((float)(fre * bi + fim * br));
            cm[q * 128 + n] = (bf16)f2bf(a.in[10][((size_t)pidx * 16 + q) * 64 + n]);
            cm[q * 128 + 64 + n] = (bf16)f2bf(-a.in[11][((size_t)pidx * 16 + q) * 64 + n]);
        }
    }
    for (int R = gw; R < TPR; R += NGW) {
        const int mrow = R - NREAL;
        const float* src = R < NREAL ? a.in[0] + (size_t)R * DM : a.in[1] + (size_t)(mrow & 15) * DM;
        float* dst = R < NREAL ? a.out + (size_t)R * DM : (float*)(ws + WS_HM) + (size_t)mrow * DM;
        bf16* hb = (bf16*)(ws + WS_HB) + (size_t)R * DM;
        const bool pad = mrow >= NB * NMETA;
        float ss = 0.f;
#pragma unroll
        for (int j = 0; j < 4; ++j) {
            f32x4 v = *(const f32x4*)(src + 4 * lane + 256 * j);
            if (pad) v = (f32x4){0.f, 0.f, 0.f, 0.f};
            if (R >= NREAL) *(f32x4*)(dst + 4 * lane + 256 * j) = v;
            ss += (v[0] * v[0] + v[1] * v[1]) + (v[2] * v[2] + v[3] * v[3]);
            u32x2 w; w.x = pk2(v[0], v[1]); w.y = pk2(v[2], v[3]);
            *(u32x2*)(hb + 4 * lane + 256 * j) = w;
        }
#pragma unroll
        for (int o = 1; o < 64; o <<= 1) ss += __shfl_xor(ss, o);
        if (lane < 16) ((float*)(ws + WS_RS))[((size_t)(lane >> 2) * TPR + R) * 4 + (lane & 3)] = lane == 0 ? ss : 0.f;
    }
}

__device__ __forceinline__ void ssm_task(LAS unsigned char* lds, int task, int layer, const bf16* SU, float* YF,
                                         const float* abar_all, const bf16* bmat_all, const bf16* cmat_all) {
    int tid_l = threadIdx.x; asm volatile("" : "+v"(tid_l));
    const int tid = tid_l, lane = tid & 63, wave = __builtin_amdgcn_readfirstlane(tid >> 6);
    const int b = task >> 5, g = task & 31;
    __syncthreads();
    LAS float* BU = (LAS float*)(lds + wave * 12800);
    LAS unsigned short* X = (LAS unsigned short*)(lds + wave * 12800 + 8448);
    LAS float* SX = (LAS float*)(lds + 8 * 12800);
    const int blk0 = wave == 0 ? 0 : 16 * wave + 1, nblk = wave == 0 ? 17 : 16;
    bf16* yfb = (bf16*)YF + (size_t)task * LL * 16;
    const int fr = lane & 15, fq = lane >> 4;
    const bf16x8 zero8 = {0, 0, 0, 0, 0, 0, 0, 0};
    for (int dir = 0; dir < 2; ++dir) {
        const int pidx = (layer * 2 + dir) * 32 + g;
        const float are = abar_all[((size_t)pidx * 64 + lane) * 2], aim = abar_all[((size_t)pidx * 64 + lane) * 2 + 1];
        bf16x8 bfr[8], cfr[4];
        const bf16* bm = bmat_all + (size_t)pidx * 128 * 16;
#pragma unroll
        for (int nt = 0; nt < 8; ++nt) bfr[nt] = fq < 2 ? *(const bf16x8*)(bm + (nt * 16 + fr) * 16 + 8 * fq) : zero8;
        const bf16* cm = cmat_all + (size_t)pidx * 16 * 128;
#pragma unroll
        for (int ks = 0; ks < 4; ++ks) cfr[ks] = *(const bf16x8*)(cm + fr * 128 + ks * 32 + 8 * fq);
        float p16r = are, p16i = aim;
#pragma unroll
        for (int i = 0; i < 4; ++i) { const float tr = p16r * p16r - p16i * p16i, ti = 2.f * p16r * p16i; p16r = tr; p16i = ti; }
        float p256r = p16r, p256i = p16i;
#pragma unroll
        for (int i = 0; i < 4; ++i) { const float tr = p256r * p256r - p256i * p256i, ti = 2.f * p256r * p256i; p256r = tr; p256i = ti; }
        const float p272r = p256r * p16r - p256i * p16i, p272i = p256r * p16i + p256i * p16r;

        float xre = 0.f, xim = 0.f;
        for (int pass = 0; pass < 2; ++pass) {
            bf16x8 unext;
            { const int blkf = dir == 0 ? blk0 : blk0 + nblk - 1; const int Rf = blkf == 0 ? NREAL + b * NMETA : b * SEQ + blkf * 16 - NMETA;
              unext = fq < 2 ? *(const bf16x8*)(SU + (size_t)(Rf + fr) * 512 + g * 16 + 8 * fq) : zero8; }
            for (int ib = 0; ib < nblk; ++ib) {
                const int blk = dir == 0 ? blk0 + ib : blk0 + nblk - 1 - ib;
                const bf16x8 ufr = unext;
                if (ib + 1 < nblk) { const int blkn = dir == 0 ? blk + 1 : blk - 1; const int Rn = blkn == 0 ? NREAL + b * NMETA : b * SEQ + blkn * 16 - NMETA;
                    unext = fq < 2 ? *(const bf16x8*)(SU + (size_t)(Rn + fr) * 512 + g * 16 + 8 * fq) : zero8; }
                f32x4 dd[8];
#pragma unroll
                for (int nt = 0; nt < 8; ++nt) { dd[nt] = (f32x4){0.f, 0.f, 0.f, 0.f}; dd[nt] = __builtin_amdgcn_mfma_f32_16x16x32_bf16(ufr, bfr[nt], dd[nt], 0, 0, 0); }
                asm volatile("s_nop 15\n\ts_nop 15" : "+v"(dd[0]), "+v"(dd[1]), "+v"(dd[2]), "+v"(dd[3]), "+v"(dd[4]), "+v"(dd[5]), "+v"(dd[6]), "+v"(dd[7]));
#pragma unroll
                for (int nt = 0; nt < 8; ++nt)
#pragma unroll
                    for (int r = 0; r < 4; ++r) BU[(4 * fq + r) * 132 + nt * 16 + fr] = dd[nt][r];
                LDS_FENCE();
                float bur[16], bui[16];
#pragma unroll
                for (int i = 0; i < 16; ++i) { const int tt = dir == 0 ? i : 15 - i; bur[i] = BU[tt * 132 + lane]; bui[i] = BU[tt * 132 + 64 + lane]; }
                if (pass == 0) {
#pragma unroll
                    for (int i = 0; i < 16; ++i) {
                        const float bre = bur[i], bim = bui[i];
                        const float nr = are * xre - aim * xim + bre, ni = are * xim + aim * xre + bim; xre = nr; xim = ni;
                    }
                    LDS_FENCE();
                } else {
#pragma unroll
                    for (int i = 0; i < 16; ++i) {
                        const int tt = dir == 0 ? i : 15 - i;
                        const float bre = bur[i], bim = bui[i];
                        const float nr = are * xre - aim * xim + bre, ni = are * xim + aim * xre + bim; xre = nr; xim = ni;
                        X[tt * 136 + lane] = (unsigned short)f2bf(xre); X[tt * 136 + 64 + lane] = (unsigned short)f2bf(xim);
                    }
                    LDS_FENCE();
                    f32x4 y = {0.f, 0.f, 0.f, 0.f};
#pragma unroll
                    for (int ks = 0; ks < 4; ++ks) {
                        const bf16x8 afr = *(const LAS bf16x8*)(X + fr * 136 + ks * 32 + 8 * fq);
                        y = __builtin_amdgcn_mfma_f32_16x16x32_bf16(afr, cfr[ks], y, 0, 0, 0);
                    }
                    asm volatile("s_nop 15\n\ts_nop 15" : "+v"(y));
                    LDS_FENCE();
                    {
                        bf16* yd = yfb + (size_t)dir * 256 * LL * 16;
#pragma unroll
                        for (int r = 0; r < 4; ++r) yd[(size_t)(blk * 16 + 4 * fq + r) * 16 + fr] = (bf16)f2bf(y[r]);
                    }
                }
            }
            if (pass == 0) {
                SX[(wave * 64 + lane) * 2] = xre; SX[(wave * 64 + lane) * 2 + 1] = xim;
                LDS_FENCE(); __syncthreads();
                float cre = 0.f, cim = 0.f;
                if (dir == 0) {
                    for (int w = 0; w < wave; ++w) { const float pr = w == 0 ? p272r : p256r, pi = w == 0 ? p272i : p256i;
                        const float sr = SX[(w * 64 + lane) * 2], si = SX[(w * 64 + lane) * 2 + 1];
                        const float nr = pr * cre - pi * cim + sr, ni = pr * cim + pi * cre + si; cre = nr; cim = ni; }
                } else {
                    for (int w = 7; w > wave; --w) {
                        const float sr = SX[(w * 64 + lane) * 2], si = SX[(w * 64 + lane) * 2 + 1];
                        const float nr = p256r * cre - p256i * cim + sr, ni = p256r * cim + p256i * cre + si; cre = nr; cim = ni; }
                }
                xre = cre; xim = cim;
            }
        }
        LDS_FENCE(); __syncthreads();
    }
}

constexpr int ATT_KROW = 72, ATT_VROW = 40, ATT_KT = 32 * ATT_KROW * 2  , ATT_VT = 64 * ATT_VROW * 2  , ATT_MAXT = 11, ATT_VOFF = ATT_MAXT * ATT_KT;
static_assert(ATT_VOFF + ATT_MAXT * ATT_VT <= 131072, "attention LDS");
__device__ __forceinline__ void attn_task(LAS unsigned char* lds, int task, const bf16* Q, const bf16* K, const bf16* V, bf16* YA, const float* sink) {
    int tid_l = threadIdx.x; asm volatile("" : "+v"(tid_l));
    const int tid = tid_l, lane = tid & 63, wave = __builtin_amdgcn_readfirstlane(tid >> 6);
    const int qb = task % 33, bh = task / 33, h = bh & 1, b = bh >> 1;
    const int l0 = qb * 64;
    __syncthreads();
    int jlo = (l0 - 128) >> 5; if (jlo < 1) jlo = 1;
    int jhi = (l0 + 191) >> 5; if (jhi > 64) jhi = 64;
    const int ntiles = 1 + (jhi - jlo + 1);
    LAS unsigned short* Ks = (LAS unsigned short*)lds;
    LAS unsigned short* Vs = (LAS unsigned short*)(lds + ATT_VOFF);
    for (int idx = tid; idx < ntiles * 32 * 8; idx += 512) {
        const int ch = idx & 7, key = idx >> 3, slot = key >> 5, kk = key & 31;
        const int lk = (slot == 0 ? 0 : (jlo + slot - 1) * 32) + kk;
        u32x4 kv = {0u, 0u, 0u, 0u}, vv = {0u, 0u, 0u, 0u};
        if (lk < LL) { const size_t R = (size_t)tok_row(b, lk);
            kv = *(const u32x4*)(K + R * 128 + h * 64 + ch * 8); vv = *(const u32x4*)(V + R * 128 + h * 64 + ch * 8); }
        *(LAS u32x4*)(Ks + slot * (ATT_KT / 2) + kk * ATT_KROW + ch * 8) = kv;
        LAS unsigned short* vd = Vs + slot * (ATT_VT / 2) + (ch * 8) * ATT_VROW + kk;
        vd[0 * ATT_VROW] = (unsigned short)(vv.x & 0xffffu); vd[1 * ATT_VROW] = (unsigned short)(vv.x >> 16);
        vd[2 * ATT_VROW] = (unsigned short)(vv.y & 0xffffu); vd[3 * ATT_VROW] = (unsigned short)(vv.y >> 16);
        vd[4 * ATT_VROW] = (unsigned short)(vv.z & 0xffffu); vd[5 * ATT_VROW] = (unsigned short)(vv.z >> 16);
        vd[6 * ATT_VROW] = (unsigned short)(vv.w & 0xffffu); vd[7 * ATT_VROW] = (unsigned short)(vv.w >> 16);
    }
    LDS_FENCE(); __syncthreads();
    const int head = h * 4 + (wave >> 1), r32 = lane & 31, hi = lane >> 5;
    const int lq = l0 + 32 * (wave & 1) + r32;
    const bool qvalid = lq < LL;
    const size_t Rq = (size_t)tok_row(b, qvalid ? lq : LL - 1);
    bf16x8 qf[4];
#pragma unroll
    for (int ks = 0; ks < 4; ++ks) qf[ks] = *(const bf16x8*)(Q + Rq * 512 + head * 64 + ks * 16 + 8 * hi);
    float mrun = sink[head], lsum = hi == 0 ? 1.0f : 0.0f;
    f32x16 o0, o1;
#pragma unroll
    for (int i = 0; i < 16; ++i) { o0[i] = 0.f; o1[i] = 0.f; }
    const int lqw = l0 + 32 * (wave & 1);
    for (int slot = 0; slot < ntiles; ++slot) {
        const int kbase = slot == 0 ? 0 : (jlo + slot - 1) * 32;
        if (lqw >= LL || (slot != 0 && (kbase + 31 < lqw - 128 || kbase > lqw + 31 + 128))) continue;
        const LAS unsigned short* kt = Ks + slot * (ATT_KT / 2);
        f32x16 s;
#pragma unroll
        for (int i = 0; i < 16; ++i) s[i] = 0.f;
#pragma unroll
        for (int ks = 0; ks < 4; ++ks) {
            const bf16x8 kf = *(const LAS bf16x8*)(kt + r32 * ATT_KROW + ks * 16 + 8 * hi);
            s = __builtin_amdgcn_mfma_f32_32x32x16_bf16(kf, qf[ks], s, 0, 0, 0);
        }
        asm volatile("s_nop 15\n\ts_nop 15" : "+v"(s));
        float mt = -1e30f;
#pragma unroll
        for (int i = 0; i < 16; ++i) {
            const int lk = kbase + (i & 3) + 8 * (i >> 2) + 4 * hi;
            int d = lq - lk; d = d < 0 ? -d : d;
            const bool valid = (lk < NMETA) || (d <= 128 && lk < LL);
            s[i] = valid ? s[i] : -1e30f;
            mt = fmaxf(mt, s[i]);
        }
        mt = fmaxf(mt, __shfl_xor(mt, 32));
        const float mnew = fmaxf(mrun, mt);
        const float alpha = __expf(mrun - mnew);
        mrun = mnew;
        float ps = 0.f;
#pragma unroll
        for (int i = 0; i < 16; ++i) { s[i] = __expf(s[i] - mnew); ps += s[i]; }
        lsum = lsum * alpha + ps;
#pragma unroll
        for (int i = 0; i < 16; ++i) { o0[i] *= alpha; o1[i] *= alpha; }
        const LAS unsigned short* vt = Vs + slot * (ATT_VT / 2);
#pragma unroll
        for (int s2 = 0; s2 < 2; ++s2) {
            union { bf16x8 v; unsigned u[4]; } pf;
            pf.u[0] = pk2(s[8 * s2 + 0], s[8 * s2 + 1]); pf.u[1] = pk2(s[8 * s2 + 2], s[8 * s2 + 3]);
            pf.u[2] = pk2(s[8 * s2 + 4], s[8 * s2 + 5]); pf.u[3] = pk2(s[8 * s2 + 6], s[8 * s2 + 7]);
#pragma unroll
            for (int dt = 0; dt < 2; ++dt) {
                union { bf16x8 v; u32x2 u[2]; } vf;
                const LAS unsigned short* vp = vt + (dt * 32 + r32) * ATT_VROW + 16 * s2 + 4 * hi;
                vf.u[0] = *(const LAS u32x2*)(vp); vf.u[1] = *(const LAS u32x2*)(vp + 8);
                if (dt == 0) o0 = __builtin_amdgcn_mfma_f32_32x32x16_bf16(vf.v, pf.v, o0, 0, 0, 0);
                else o1 = __builtin_amdgcn_mfma_f32_32x32x16_bf16(vf.v, pf.v, o1, 0, 0, 0);
            }
        }
    }
    asm volatile("s_nop 15\n\ts_nop 15" : "+v"(o0), "+v"(o1));
    lsum += __shfl_xor(lsum, 32);
    const float inv = 1.0f / lsum;
    if (qvalid) {
#pragma unroll
        for (int g4 = 0; g4 < 4; ++g4) {
            u32x2 w0, w1;
            w0.x = pk2(o0[4 * g4] * inv, o0[4 * g4 + 1] * inv); w0.y = pk2(o0[4 * g4 + 2] * inv, o0[4 * g4 + 3] * inv);
            w1.x = pk2(o1[4 * g4] * inv, o1[4 * g4 + 1] * inv); w1.y = pk2(o1[4 * g4 + 2] * inv, o1[4 * g4 + 3] * inv);
            *(u32x2*)(YA + Rq * 512 + head * 64 + 8 * g4 + 4 * hi) = w0;
            *(u32x2*)(YA + Rq * 512 + head * 64 + 32 + 8 * g4 + 4 * hi) = w1;
        }
    }
    __syncthreads();
}

__device__ __forceinline__ void pool_diff(const bf16* PU, bf16* PD) {
    int tl_ = threadIdx.x; asm volatile("" : "+v"(tl_)); const int gt = blockIdx.x * 512 + tl_, NGT = gridDim.x * 512;
    for (int i = gt; i < NB * LL * 64; i += NGT) {
        const int ch = i & 63, tk = i >> 6, b = tk / LL, l = tk % LL;
        const int half = 1 << (ch >> 4);
        const int lo = l - half < 0 ? 0 : l - half, hh = l + half > LL ? LL : l + half;
        float s[8];
#pragma unroll
        for (int j = 0; j < 8; ++j) s[j] = 0.f;
        for (int lp = lo; lp < hh; ++lp) {
            const u32x4 v = *(const u32x4*)(PU + (size_t)tok_row(b, lp) * 512 + ch * 8);
            s[0] += bf2f(v.x & 0xffffu); s[1] += bf2f(v.x >> 16); s[2] += bf2f(v.y & 0xffffu); s[3] += bf2f(v.y >> 16);
            s[4] += bf2f(v.z & 0xffffu); s[5] += bf2f(v.z >> 16); s[6] += bf2f(v.w & 0xffffu); s[7] += bf2f(v.w >> 16);
        }
        const float ic = 1.0f / (float)(hh - lo);
        const size_t R = (size_t)tok_row(b, l);
        const u32x4 v = *(const u32x4*)(PU + R * 512 + ch * 8);
        u32x4 o;
        o.x = pk2(s[0] * ic - bf2f(v.x & 0xffffu), s[1] * ic - bf2f(v.x >> 16)); o.y = pk2(s[2] * ic - bf2f(v.y & 0xffffu), s[3] * ic - bf2f(v.y >> 16));
        o.z = pk2(s[4] * ic - bf2f(v.z & 0xffffu), s[5] * ic - bf2f(v.z >> 16)); o.w = pk2(s[6] * ic - bf2f(v.w & 0xffffu), s[7] * ic - bf2f(v.w >> 16));
        *(u32x4*)(PD + R * 512 + ch * 8) = o;
    }
}

__device__ __forceinline__ void z_pass(const float* YF, const bf16* SU, const float* dskip, bf16* Z) {
    int tl_ = threadIdx.x; asm volatile("" : "+v"(tl_)); const int gt = blockIdx.x * 512 + tl_, NGT = gridDim.x * 512;
    for (int i = gt; i < NB * LL * 64; i += NGT) {
        const int ch = i & 63, tk = i >> 6, b = tk / LL, l = tk % LL, g = ch >> 1;
        const size_t R = (size_t)tok_row(b, l);
        const bf16* yp = (const bf16*)YF + ((size_t)(b * 32 + g) * LL + l) * 16 + (ch & 1) * 8;
        const u32x4 ya = *(const u32x4*)yp, yb = *(const u32x4*)(yp + (size_t)256 * LL * 16);
        f32x4 y0, y1;
        y0[0] = bf2f(ya.x & 0xffffu) + bf2f(yb.x & 0xffffu); y0[1] = bf2f(ya.x >> 16) + bf2f(yb.x >> 16); y0[2] = bf2f(ya.y & 0xffffu) + bf2f(yb.y & 0xffffu); y0[3] = bf2f(ya.y >> 16) + bf2f(yb.y >> 16);
        y1[0] = bf2f(ya.z & 0xffffu) + bf2f(yb.z & 0xffffu); y1[1] = bf2f(ya.z >> 16) + bf2f(yb.z >> 16); y1[2] = bf2f(ya.w & 0xffffu) + bf2f(yb.w & 0xffffu); y1[3] = bf2f(ya.w >> 16) + bf2f(yb.w >> 16);
        const f32x4 d0 = *(const f32x4*)(dskip + ch * 8), d1 = *(const f32x4*)(dskip + ch * 8 + 4);
        const u32x4 uu = *(const u32x4*)(SU + R * 512 + ch * 8);
        float t[8];
        t[0] = y0[0] + d0[0] * bf2f(uu.x & 0xffffu); t[1] = y0[1] + d0[1] * bf2f(uu.x >> 16); t[2] = y0[2] + d0[2] * bf2f(uu.y & 0xffffu); t[3] = y0[3] + d0[3] * bf2f(uu.y >> 16);
        t[4] = y1[0] + d1[0] * bf2f(uu.z & 0xffffu); t[5] = y1[1] + d1[1] * bf2f(uu.z >> 16); t[6] = y1[2] + d1[2] * bf2f(uu.w & 0xffffu); t[7] = y1[3] + d1[3] * bf2f(uu.w >> 16);
#pragma unroll
        for (int j = 0; j < 8; ++j) t[j] = 0.5f * t[j] * (1.0f + erff(t[j] * 0.70710678118654752f));
        u32x4 o; o.x = pk2(t[0], t[1]); o.y = pk2(t[2], t[3]); o.z = pk2(t[4], t[5]); o.w = pk2(t[6], t[7]);
        *(u32x4*)(Z + R * 512 + ch * 8) = o;
    }
}

#define XB_TMO      128
#define XB_XCNT(j)  (256  + 64 * (j))
#define XB_XSUB(j)  (1280 + 64 * (j))
#define XB_XGEN(j)  (2304 + 64 * (j))
#define XB_TOP      3328
#define XB_TOPGEN   3392
#define XCD_BAR_WORDS 3456
#define XB_SPIN_CAP (1u << 18)

__device__ __forceinline__ unsigned xb_ld(unsigned* p)              { return __hip_atomic_load(p, __ATOMIC_RELAXED, __HIP_MEMORY_SCOPE_AGENT); }
__device__ __forceinline__ unsigned xb_add(unsigned* p, unsigned v) { return __hip_atomic_fetch_add(p, v, __ATOMIC_RELAXED, __HIP_MEMORY_SCOPE_AGENT); }
__device__ __forceinline__ unsigned xb_xcc_id() { return (unsigned)__builtin_amdgcn_s_getreg((3 << 11) | 20) & 0xFu; }
#define XB_SPIN(cond, bar) do { unsigned _sp = 0; while (cond) { __builtin_amdgcn_s_sleep(1); \
    if ((++_sp & 255u) == 0u) { if (xb_ld(&(bar)[XB_TMO])) break; if (_sp > XB_SPIN_CAP) { atomicAdd(&(bar)[XB_TMO], 1u); break; } } } } while (0)

struct XcdBarrier {
    unsigned* bar; unsigned x;
    volatile LAS unsigned* st;
};

__device__ __forceinline__ XcdBarrier xcd_barrier_post(unsigned* bar, volatile LAS unsigned* st) {
    XcdBarrier b; b.bar = bar; b.x = xb_xcc_id(); b.st = st;
    if (threadIdx.x == 0) (void)xb_add(&bar[XB_XCNT(b.x)], 1u);
    return b;
}
__device__ __forceinline__ void xcd_barrier_complete(unsigned* bar, unsigned x, unsigned& nloc, unsigned& nx) {
    const unsigned G = gridDim.x * gridDim.y * gridDim.z;
    unsigned sum, cnt, mine, sp = 0u;
    for (;;) {
        sum = 0u; cnt = 0u; mine = 0u;
#pragma unroll
        for (unsigned j = 0; j < 16; ++j) { const unsigned c = xb_ld(&bar[XB_XCNT(j)]); sum += c; cnt += (c > 0u) ? 1u : 0u; mine = (j == x) ? c : mine; }
        if (sum == G) break;
        __builtin_amdgcn_s_sleep(1);
        if ((++sp & 255u) == 0u) { if (xb_ld(&bar[XB_TMO])) break; if (sp > XB_SPIN_CAP) { atomicAdd(&bar[XB_TMO], 1u); break; } }
    }
    nloc = mine > 0u ? mine : 1u; nx = cnt > 0u ? cnt : 1u;
}

__device__ __forceinline__ void xcd_barrier(const XcdBarrier& b) {
    asm volatile("s_waitcnt vmcnt(0)" ::: "memory");
    __syncthreads();
    if (threadIdx.x == 0) {
        unsigned* bar = b.bar;
        __builtin_amdgcn_s_waitcnt(0);
        unsigned nloc = b.st[0], nx = b.st[1];
        if (nloc == 0u) { xcd_barrier_complete(bar, b.x, nloc, nx); b.st[0] = nloc; b.st[1] = nx; }
        const unsigned old = xb_add(&bar[XB_XSUB(b.x)], 1u);
        const unsigned gen = old / nloc;
        if (old + 1u == (gen + 1u) * nloc) {
            __builtin_amdgcn_fence(__ATOMIC_RELEASE, "agent");
            asm volatile("s_waitcnt vmcnt(0)" ::: "memory");
            const unsigned og = xb_add(&bar[XB_TOP], 1u);
            const unsigned tg = og / nx;
            if (og + 1u == (tg + 1u) * nx) xb_add(&bar[XB_TOPGEN], 1u);
            else XB_SPIN(xb_ld(&bar[XB_TOPGEN]) == tg, bar);
            __builtin_amdgcn_fence(__ATOMIC_ACQUIRE, "agent");
            xb_add(&bar[XB_XGEN(b.x)], 1u);
            asm volatile("s_waitcnt vmcnt(0)" ::: "memory");
        } else {
            XB_SPIN(xb_ld(&bar[XB_XGEN(b.x)]) == gen, bar);
            __builtin_amdgcn_fence(__ATOMIC_ACQUIRE, "agent");
            asm volatile("s_waitcnt vmcnt(0)" ::: "memory");
        }
    }
    __syncthreads();
}

#ifndef MK_ALIGN
#define MK_ALIGN true
#endif
#ifndef MK_SP2
#define MK_SP2 true
#endif
#ifndef MK_SPLIT
#define MK_SPLIT 0
#endif
constexpr int NPL = 8, NPHASE = 1 + 2 * NPL + 1, PH_FINAL = NPHASE - 1;

typedef const __attribute__((address_space(4))) Args* KArgsP;
#define KARGS() ({ auto kp_ = __builtin_amdgcn_kernarg_segment_ptr(); asm volatile("" : "+s"(kp_)); (KArgsP)kp_; })
__global__ void __launch_bounds__(512, 2) fwd_kernel(Args a_unused, int ph_lo, int ph_hi) {
    (void)a_unused;
    extern __shared__ __attribute__((aligned(16))) unsigned char lds_raw[];
    LAS unsigned char* lds = (LAS unsigned char*)lds_raw;
    const int G = gridDim.x, bid = blockIdx.x;
#if MK_SPLIT
#define GRID_SYNC() do {} while (0)
    (void)lds;
#else
#define CG_SYNC() do { asm volatile("s_waitcnt vmcnt(0)" ::: "memory"); __syncthreads(); \
    if (threadIdx.x == 0) { __builtin_amdgcn_fence(__ATOMIC_RELEASE, "agent"); asm volatile("s_waitcnt vmcnt(0)" ::: "memory"); } \
    __syncthreads(); grid.sync(); \
    if (threadIdx.x == 0) { __builtin_amdgcn_fence(__ATOMIC_ACQUIRE, "agent"); asm volatile("s_waitcnt vmcnt(0)" ::: "memory"); } \
    __syncthreads(); } while (0)
    cg::grid_group grid = cg::this_grid();
    unsigned* barw = (unsigned*)(KARGS()->ws + WS_CTL);
    if (bid == 0) for (int i = threadIdx.x; i < XCD_BAR_WORDS; i += 512) __hip_atomic_store(barw + i, 0u, __ATOMIC_RELAXED, __HIP_MEMORY_SCOPE_AGENT);
    volatile LAS unsigned* xst = (volatile LAS unsigned*)(lds + LDS_BYTES - 64);
    if (threadIdx.x < 2) xst[threadIdx.x] = 0u;
    CG_SYNC();
    const XcdBarrier xbar = xcd_barrier_post(barw, xst);
#define GRID_SYNC() xcd_barrier(xbar)

#endif
#ifndef PHMASK
#define PHMASK 0xFFFFu
#endif
#define IN(k) (((PHMASK >> ((k) == 0 ? 0 : (k) == PH_FINAL ? 9 : 1 + ((k) - 1) % NPL)) & 1u) && ph_lo <= (k) && (k) < ph_hi)
#define SEAM(k) do { if (IN(k) && (k) + 1 < ph_hi) GRID_SYNC(); } while (0)
#define PHASE_BEGIN() KArgsP ka = KARGS(); unsigned char* ws = ka->ws; asm volatile("" : "+s"(ws)); float* rowss = (float*)(ws + WS_RS); float* Hm = (float*)(ws + WS_HM); bf16* HB = (bf16*)(ws + WS_HB); unsigned char* wl = ws + WS_W + (size_t)layer * LW_BYTES; \
    const int MT = NREAL; const bool META = layer != MK_NLAYER - 1;     \
    const float* rs_mix = rowss + (size_t)(2 * layer) * TPR * 16; float* rs_mlp = rowss + (size_t)(2 * layer + 1) * TPR * 16; float* rs_next = rowss + (size_t)(2 * layer + 2) * TPR * 16; (void)MT; (void)META; (void)Hm; (void)HB; (void)wl; (void)rs_mix; (void)rs_mlp; (void)rs_next;

    if (IN(0)) { Args al; { KArgsP kp = KARGS(); for (int i = 0; i < 23; ++i) al.in[i] = kp->in[i]; al.out = kp->out; al.ws = kp->ws; } p0_prologue(al, lds); }
    SEAM(0);
#ifndef MK_NLAYER
#define MK_NLAYER 2
#endif
#ifndef MK_RSIDX
#define MK_RSIDX 4
#endif
#pragma unroll 1
    for (int layer = 0; layer < MK_NLAYER; ++layer) {
        const int p = 1 + NPL * layer;
        if (IN(p)) { PHASE_BEGIN();
            pg8::Gemm g{HB, (const bf16*)(wl + OW_IN), TPR, NPROJ, DM}; pg8::StaticOrder S; S.init(TPR, NPROJ, G, bid);
            EpiInProj E{rs_mix, (const float*)(ws + WS_ROPE), (bf16*)(ws + WS_Q), (bf16*)(ws + WS_K), (bf16*)(ws + WS_V), (bf16*)(ws + WS_SU), (bf16*)(ws + WS_PU)};
            pg8::gemm_phase<EpiInProj, pg8::StaticOrder, MK_ALIGN, MK_SP2>(lds, g, S, E);
        }
        SEAM(p);
        if (IN(p + 1)) { PHASE_BEGIN();
            for (int t = bid; t < 256; t += G)
                ssm_task(lds, t, layer, (const bf16*)(ws + WS_SU), (float*)(ws + WS_YF), (const float*)(ws + WS_ABAR), (const bf16*)(ws + WS_BMAT), (const bf16*)(ws + WS_CMAT));
            for (int t = bid; t < NB * 2 * 33; t += G)
                attn_task(lds, t, (const bf16*)(ws + WS_Q), (const bf16*)(ws + WS_K), (const bf16*)(ws + WS_V), (bf16*)(ws + WS_YA), ka->in[4] + layer * 8);
            pool_diff((const bf16*)(ws + WS_PU), (bf16*)(ws + WS_PD));
        }
        SEAM(p + 1);
        if (IN(p + 2)) { PHASE_BEGIN();
            z_pass((const float*)(ws + WS_YF), (const bf16*)(ws + WS_SU), ka->in[12] + layer * 512, (bf16*)(ws + WS_Z));
        }
        SEAM(p + 2);
        if (IN(p + 3)) { PHASE_BEGIN();
            const int hg = G >> 1;
            if (bid < hg) { pg8::Gemm g{(const bf16*)(ws + WS_Z), (const bf16*)(wl + OW_GLU), MT, 512, 512}; pg8::StaticOrder S; S.init(MT, 512, hg, bid);
              EpiGlu E{(const bf16*)(ws + WS_Z), ka->in[14] + layer * 512, (bf16*)(ws + WS_YS)};
              pg8::gemm_phase<EpiGlu, pg8::StaticOrder, MK_ALIGN, MK_SP2>(lds, g, S, E); if (META) thin_gemm<EpiGlu>(lds, g.A, g.Bt, g.K, g.N, E, bid, hg); }
            else { pg8::Gemm g{(const bf16*)(ws + WS_PD), (const bf16*)(wl + OW_POOL), MT, 512, 512}; pg8::StaticOrder S; S.init(MT, 512, G - hg, bid - hg);
              EpiScale E{(bf16*)(ws + WS_YP), 512, ka->in[16] + layer * 512};
              pg8::gemm_phase<EpiScale, pg8::StaticOrder, MK_ALIGN, MK_SP2>(lds, g, S, E); if (META) thin_gemm<EpiScale>(lds, g.A, g.Bt, g.K, g.N, E, bid - hg, G - hg); }
        }
        SEAM(p + 3);
        if (IN(p + 4)) { PHASE_BEGIN();
#pragma unroll 1
            for (int c = 0; c < 3; ++c) {
                const bf16* Yc = (const bf16*)(ws + (c == 0 ? WS_YA : c == 1 ? WS_YS : WS_YP));
                { pg8::Gemm g{Yc, (const bf16*)(wl + OW_BR) + (size_t)c * 1024 * 512, MT, 1024, 512}; pg8::StaticOrder S; S.init(MT, 1024, G, bid);
                  EpiScale E{(bf16*)(ws + WS_BR), 1024, nullptr};
                  pg8::gemm_phase<EpiScale, pg8::StaticOrder, MK_ALIGN, MK_SP2>(lds, g, S, E); if (META) thin_gemm<EpiScale>(lds, g.A, g.Bt, g.K, g.N, E, bid, G); }
                pg8::Gemm g{HB, (const bf16*)(wl + OW_IN) + (size_t)(NPROJ + c * 1024) * DM, MT, 1024, DM}; pg8::StaticOrder S; S.init(MT, 1024, G, bid);
                if (c == 0) { EpiGate<true> E{rs_mix, (const bf16*)(ws + WS_BR), (bf16*)(ws + WS_MG)}; pg8::gemm_phase<EpiGate<true>, pg8::StaticOrder, MK_ALIGN, MK_SP2>(lds, g, S, E); if (META) thin_gemm<EpiGate<true>>(lds, g.A, g.Bt, g.K, g.N, E, bid, G); }
                else { EpiGate<false> E{rs_mix, (const bf16*)(ws + WS_BR), (bf16*)(ws + WS_MG)}; pg8::gemm_phase<EpiGate<false>, pg8::StaticOrder, MK_ALIGN, MK_SP2>(lds, g, S, E); if (META) thin_gemm<EpiGate<false>>(lds, g.A, g.Bt, g.K, g.N, E, bid, G); }
            }
        }
        SEAM(p + 4);
        if (IN(p + 5)) { PHASE_BEGIN();
            pg8::Gemm g{(const bf16*)(ws + WS_MG), (const bf16*)(wl + OW_OUT), MT, DM, DM}; pg8::StaticOrder S; S.init(MT, DM, G, bid);
            EpiRes E{ka->out, Hm, HB, rs_mlp, layer == 0 ? ka->in[0] : (const float*)ka->out};
            pg8::gemm_phase<EpiRes, pg8::StaticOrder, MK_ALIGN, MK_SP2>(lds, g, S, E); if (META) thin_gemm<EpiRes>(lds, g.A, g.Bt, g.K, g.N, E, bid, G);
        }
        SEAM(p + 5);
        if (IN(p + 6)) { PHASE_BEGIN();
            pg8::Gemm g{HB, (const bf16*)(wl + OW_UP), MT, FF, DM}; pg8::StaticOrder S; S.init(MT, FF, G, bid);
            EpiUp E{rs_mlp, (bf16*)(ws + WS_ACT)};
            pg8::gemm_phase<EpiUp, pg8::StaticOrder, MK_ALIGN, MK_SP2>(lds, g, S, E); if (META) thin_gemm<EpiUp>(lds, g.A, g.Bt, g.K, g.N, E, bid, G);
        }
        SEAM(p + 6);
        if (IN(p + 7)) { PHASE_BEGIN();
            pg8::Gemm g{(const bf16*)(ws + WS_ACT), (const bf16*)(wl + OW_DN), MT, DM, FF}; pg8::StaticOrder S; S.init(MT, DM, G, bid);
            EpiRes E{ka->out, Hm, HB, rs_next, (const float*)ka->out};
            pg8::gemm_phase<EpiRes, pg8::StaticOrder, MK_ALIGN, MK_SP2>(lds, g, S, E); if (META) thin_gemm<EpiRes>(lds, g.A, g.Bt, g.K, g.N, E, bid, G);
        }
        SEAM(p + 7);
    }
#ifdef MK_DUMP_OFF
    if (IN(PH_FINAL)) { KArgsP ka = KARGS();
        const bf16* src = (const bf16*)(ka->ws + (MK_DUMP_OFF)); const bf16* src2 = (const bf16*)(ka->ws + (MK_DUMP_OFF2));
        for (int i = bid * 512 + threadIdx.x; i < NREAL * 1024; i += G * 512) { const int R = MK_DUMP_ROW(i >> 10), c = i & 1023; ka->out[i] = c < 512 ? bf2f(src[(size_t)R * (MK_DUMP_LD) + (c % (MK_DUMP_LD))]) : bf2f(src2[(size_t)R * (MK_DUMP_LD2) + (c % (MK_DUMP_LD2))]); }
    }
#else
    if (IN(PH_FINAL)) { KArgsP ka = KARGS();
        const float* rs = (const float*)(ka->ws + WS_RS) + (size_t)MK_RSIDX * TPR * 16; const float* gain = ka->in[22];
        int tl_ = threadIdx.x; asm volatile("" : "+v"(tl_));
        for (int i = bid * 512 + tl_; i < NREAL * 256; i += G * 512) {
            const int R = i >> 8, c4 = (i & 255) * 4;
            const float r = row_rstd(rs, R);
            f32x4 v = *(const f32x4*)(ka->out + (size_t)R * DM + c4); const f32x4 gn = *(const f32x4*)(gain + c4);
            v = v * r * gn;
            *(f32x4*)(ka->out + (size_t)R * DM + c4) = v;
        }
    }
#endif
#undef IN
#undef SEAM
}

extern "C" void kernel_launch(void* const* d_in, const int* in_sizes, int n_in, void* d_out, int out_size, void* d_ws, size_t ws_size, hipStream_t stream) {
    static int grid = 0;
    if (grid == 0) {
        if (n_in != 23 || out_size != NREAL * DM || ws_size < WS_END) { fprintf(stderr, "kernel_launch: unexpected shapes (n_in %d out %d ws %zu)\n", n_in, out_size, ws_size); grid = -1; return; }
        int dev = 0, cus = 0, per_cu = 0;
        hipGetDevice(&dev); hipDeviceGetAttribute(&cus, hipDeviceAttributeMultiprocessorCount, dev);
        if (hipFuncSetAttribute((const void*)fwd_kernel, hipFuncAttributeMaxDynamicSharedMemorySize, LDS_BYTES) != hipSuccess) { fprintf(stderr, "kernel_launch: hipFuncSetAttribute failed\n"); grid = -1; return; }
        if (hipOccupancyMaxActiveBlocksPerMultiprocessor(&per_cu, (const void*)fwd_kernel, 512, LDS_BYTES) != hipSuccess || per_cu < 1) { fprintf(stderr, "kernel_launch: occupancy query gave %d\n", per_cu); per_cu = 1; }
        (void)hipGetLastError();
        grid = cus * (per_cu > 1 ? 1 : per_cu);
        if (grid <= 0) grid = 256;
    }
    if (grid < 0) return;
    Args a{};
    for (int i = 0; i < 23; ++i) a.in[i] = (const float*)d_in[i];
    a.out = (float*)d_out; a.ws = (unsigned char*)d_ws;
#if MK_SPLIT
    for (int ph = 0; ph < NPHASE; ++ph) hipLaunchKernelGGL(fwd_kernel, dim3(grid), dim3(512), LDS_BYTES, stream, a, ph, ph + 1);
#else
    int lo = 0, hi = NPHASE;
    void* kargs[] = {(void*)&a, (void*)&lo, (void*)&hi};
    hipError_t e = hipLaunchCooperativeKernel((const void*)fwd_kernel, dim3(grid), dim3(512), kargs, LDS_BYTES, stream);
    if (e != hipSuccess) fprintf(stderr, "kernel_launch: cooperative launch failed: %s (grid %d)\n", hipGetErrorString(e), grid);
#endif
}
```

```cpp
#include <hip/hip_runtime.h>
#include <hip/hip_cooperative_groups.h>
#include <cstdio>
#include <cstdint>
namespace cg = cooperative_groups;
namespace pg8 {
#define PG8_LAS __attribute__((address_space(3)))
typedef unsigned short bf16_t;
typedef short bf16x8 __attribute__((ext_vector_type(8)));
typedef float f32x4 __attribute__((ext_vector_type(4)));
typedef unsigned u32x4 __attribute__((ext_vector_type(4)));
constexpr int BM = 256, BK = 64, HALF = 128, HTB = HALF * BK * 2  , STAGE_BYTES = 8 * HTB, NXCD = 8, WGM = 8;

__host__ __device__ __forceinline__ int lds_byte(int r, int c) { const int st = (r >> 4) * 2 + (c >> 5), rr = r & 15, cc = c & 31, ob = rr * 64 + cc * 2; return st * 1024 + (ob ^ (((ob >> 9) & 1) << 5)); }
__host__ __device__ __forceinline__ void stage_rc(int b, int& R, int& C) { const int st = b / 1024, sb = b % 1024, swz = sb ^ (((sb >> 9) & 1) << 5); R = (st >> 1) * 16 + swz / 64; C = (st & 1) * 32 + (swz % 64) / 2; }
__host__ __device__ __forceinline__ int perm32(int rho) { const int n = rho >> 4, i = rho & 15; return 8 * (i >> 2) + 4 * n + (i & 3); }

struct Unit { int pm, pn; };
struct Gemm { const bf16_t* A; const bf16_t* Bt; int M, N, K; };

struct StaticOrder {
    int nM, nN, nwg, G, c;
    __host__ __device__ void init(int M, int N, int G_, int c_) { nM = M / BM; nN = N / BM; nwg = nM * nN; G = G_; c = c_; }
    __host__ __device__ bool next(int i, Unit& u) const {
        const long L = (long)i * G + c; if (L >= nwg) return false;
        int wgid = (int)L; { const int q = nwg / NXCD, r = nwg % NXCD, xcd = wgid % NXCD, off = wgid / NXCD; wgid = (xcd < r ? xcd * (q + 1) : r * (q + 1) + (xcd - r) * q) + off; }
        const int nig = WGM * nN, gid = wgid / nig, fm = gid * WGM, gsz = (nM - fm) < WGM ? (nM - fm) : WGM;
        u.pm = fm + ((wgid % nig) % gsz); u.pn = (wgid % nig) / gsz; return true;
    }
    __device__ __forceinline__ void a_ready(const Unit&) const {}
    __device__ __forceinline__ void done(const Unit&) const {}
};

__device__ __forceinline__ unsigned cvt_pk_bf16(float lo, float hi) { unsigned r; asm volatile("v_cvt_pk_bf16_f32 %0, %1, %2" : "=v"(r) : "v"(lo), "v"(hi)); return r; }
template <class Epi, class Sched, bool ALIGN_EPI = false, bool SP2 = false>
__device__ __forceinline__ void gemm_phase(PG8_LAS unsigned char* lds, const Gemm g, const Sched& S, const Epi& E) {
    int tid_l = threadIdx.x; asm volatile("" : "+v"(tid_l));
    const int tid = tid_l, wid = __builtin_amdgcn_readfirstlane(tid >> 6), lane = tid & 63, wr = wid >> 2, wc = wid & 3, fr = lane & 15, fq = lane >> 4;
    const int K = g.K, nt = K / BK;
    unsigned voffA[2], voffB[2];
#pragma unroll
    for (int i = 0; i < 2; ++i) { int R, C; stage_rc(tid * 16 + i * 8192, R, C); const int Rb = Epi::PERM ? ((R & ~31) + perm32(R & 31)) : R;
        voffA[i] = (unsigned)(R * K + C) * 2u; voffB[i] = (unsigned)(Rb * K + C) * 2u; }
    const size_t kstep = (size_t)(BK * 2);
    const size_t hstep = (size_t)HALF * K * 2;
    const size_t tstep = 2 * hstep;
    const unsigned ldsw = (unsigned)wid * 1024u;
    const int aoff = lds_byte(wr * 64 + fr, fq * 8), boff = lds_byte(wc * 32 + fr, fq * 8);
#define PG8_SA(b, h) (((b) * 2 + (h)) * HTB)
#define PG8_SB(b, h) ((4 + (b) * 2 + (h)) * HTB)
#define PG8_STAGE(bufoff, gbase, voff) do { _Pragma("unroll") for (int _i = 0; _i < 2; ++_i) \
        __builtin_amdgcn_global_load_lds((const unsigned*)((const char*)(gbase) + (voff)[_i]), (PG8_LAS unsigned*)(lds + (bufoff) + ldsw + _i * 8192), 16, 0, 0); } while (0)
#define PG8_LDA(dst, b, h) do { _Pragma("unroll") for (int m = 0; m < 4; ++m) _Pragma("unroll") for (int k = 0; k < 2; ++k) dst[m][k] = *(const PG8_LAS bf16x8*)(lds + PG8_SA(b, h) + aoff + m * 2048 + k * 1024); } while (0)
#define PG8_LDB(dst, b, h) do { _Pragma("unroll") for (int n = 0; n < 2; ++n) _Pragma("unroll") for (int k = 0; k < 2; ++k) dst[n][k] = *(const PG8_LAS bf16x8*)(lds + PG8_SB(b, h) + boff + n * 2048 + k * 1024); } while (0)
#define PG8_MMA(ai, bj, At, Bt) do { __builtin_amdgcn_s_setprio(1); _Pragma("unroll") for (int m = 0; m < 4; ++m) _Pragma("unroll") for (int n = 0; n < 2; ++n) _Pragma("unroll") for (int k = 0; k < 2; ++k) \
        acc[ai][bj][m][n] = __builtin_amdgcn_mfma_f32_16x16x32_bf16(Bt[n][k], At[m][k], acc[ai][bj][m][n], 0, 0, 0); __builtin_amdgcn_s_setprio(0); } while (0)
#define PG8_WAIT_V(n) asm volatile("s_waitcnt vmcnt(" #n ")" ::: "memory")
#define PG8_WAIT_L(n) asm volatile("s_waitcnt lgkmcnt(" #n ")" ::: "memory")
#define PG8_BAR __builtin_amdgcn_s_barrier()
#define PG8_SCHED __builtin_amdgcn_sched_barrier(0)
    Unit cur, nxt; int ui = 0;
    if (!S.next(0, cur)) return;
    f32x4 acc[2][2][4][2];
#pragma unroll
    for (int a = 0; a < 2; ++a)
#pragma unroll
        for (int b = 0; b < 2; ++b)
#pragma unroll
            for (int m = 0; m < 4; ++m)
#pragma unroll
                for (int n = 0; n < 2; ++n) acc[a][b][m][n] = (f32x4){0.f, 0.f, 0.f, 0.f};
    bf16x8 At[4][2], B0[2][2], B1[2][2];
    const char* cA = (const char*)g.A + (size_t)cur.pm * tstep; const char* cB = (const char*)g.Bt + (size_t)cur.pn * tstep;
    S.a_ready(cur);
    if constexpr (SP2) {
        PG8_STAGE(PG8_SB(0, 0), cB, voffB); PG8_STAGE(PG8_SB(0, 1), cB + hstep, voffB); PG8_STAGE(PG8_SA(0, 0), cA, voffA); PG8_STAGE(PG8_SA(0, 1), cA + hstep, voffA);
        if (wr == 1) PG8_BAR;
        PG8_WAIT_V(2); PG8_BAR;
        PG8_STAGE(PG8_SB(1, 0), cB + kstep, voffB); PG8_STAGE(PG8_SA(1, 0), cA + kstep, voffA); PG8_STAGE(PG8_SB(1, 1), cB + hstep + kstep, voffB);
        PG8_WAIT_V(6); PG8_BAR;
    } else {
        PG8_STAGE(PG8_SB(0, 0), cB, voffB); PG8_STAGE(PG8_SA(0, 0), cA, voffA); PG8_STAGE(PG8_SB(0, 1), cB + hstep, voffB); PG8_STAGE(PG8_SA(0, 1), cA + hstep, voffA);
        if (wr == 1) PG8_BAR;
        PG8_WAIT_V(4); PG8_BAR;
        PG8_STAGE(PG8_SB(1, 0), cB + kstep, voffB); PG8_STAGE(PG8_SA(1, 0), cA + kstep, voffA); PG8_STAGE(PG8_SB(1, 1), cB + hstep + kstep, voffB);
        PG8_WAIT_V(6); PG8_BAR;
    }
    for (;;) {
        const bool has_next = S.next(ui + 1, nxt);
        const char* nA = has_next ? (const char*)g.A + (size_t)nxt.pm * tstep : cA; const char* nB = has_next ? (const char*)g.Bt + (size_t)nxt.pn * tstep : cB;
        for (int t = 0; t < nt; t += 2) {
            const bool last = (t == nt - 2);
            const char* a1 = cA + (size_t)(t + 1) * kstep;
            const char* a2 = last ? nA : cA + (size_t)(t + 2) * kstep; const char* b2 = last ? nB : cB + (size_t)(t + 2) * kstep;
            const char* a3 = a2 + kstep; const char* b3 = b2 + kstep;
            if (last && has_next) S.a_ready(nxt);
            if constexpr (SP2) {
            PG8_LDB(B0, 0, 0); PG8_LDB(B1, 0, 1); PG8_SCHED; PG8_LDA(At, 0, 0); PG8_STAGE(PG8_SA(1, 1), a1 + hstep, voffA);
            PG8_WAIT_V(8); PG8_WAIT_L(0); PG8_BAR; PG8_MMA(0, 0, At, B0); PG8_MMA(0, 1, At, B1); PG8_BAR; PG8_SCHED;
            PG8_LDA(At, 0, 1); PG8_STAGE(PG8_SB(0, 0), b2, voffB); PG8_STAGE(PG8_SB(0, 1), b2 + hstep, voffB); PG8_STAGE(PG8_SA(0, 0), a2, voffA);
            PG8_WAIT_V(8); PG8_WAIT_L(0); PG8_BAR; PG8_MMA(1, 0, At, B0); PG8_MMA(1, 1, At, B1); PG8_BAR; PG8_SCHED;
            PG8_LDB(B0, 1, 0); PG8_LDB(B1, 1, 1); PG8_SCHED; PG8_LDA(At, 1, 0); PG8_STAGE(PG8_SA(0, 1), a2 + hstep, voffA);
            PG8_WAIT_V(8); PG8_WAIT_L(0); PG8_BAR; PG8_MMA(0, 0, At, B0); PG8_MMA(0, 1, At, B1); PG8_BAR; PG8_SCHED;
            PG8_LDA(At, 1, 1); PG8_STAGE(PG8_SB(1, 0), b3, voffB); PG8_STAGE(PG8_SB(1, 1), b3 + hstep, voffB); PG8_STAGE(PG8_SA(1, 0), a3, voffA);
            PG8_WAIT_V(8); PG8_WAIT_L(0); PG8_BAR; PG8_MMA(1, 0, At, B0); PG8_MMA(1, 1, At, B1); PG8_BAR; PG8_SCHED;
            } else {
            PG8_LDB(B0, 0, 0); PG8_SCHED; PG8_LDA(At, 0, 0); PG8_STAGE(PG8_SA(1, 1), a1 + hstep, voffA);
            PG8_WAIT_L(8); PG8_BAR; PG8_WAIT_L(0); PG8_MMA(0, 0, At, B0); PG8_BAR; PG8_SCHED;
            PG8_LDB(B1, 0, 1); PG8_STAGE(PG8_SB(0, 0), b2, voffB);
            PG8_BAR; PG8_WAIT_L(0); PG8_MMA(0, 1, At, B1); PG8_BAR;
            PG8_LDA(At, 0, 1); PG8_STAGE(PG8_SA(0, 0), a2, voffA);
            PG8_BAR; PG8_WAIT_L(0); PG8_MMA(1, 0, At, B0); PG8_BAR; PG8_SCHED;
            PG8_STAGE(PG8_SB(0, 1), b2 + hstep, voffB);
            PG8_WAIT_V(6); PG8_BAR; PG8_MMA(1, 1, At, B1); PG8_BAR;
            PG8_LDB(B0, 1, 0); PG8_SCHED; PG8_LDA(At, 1, 0); PG8_STAGE(PG8_SA(0, 1), a2 + hstep, voffA);
            PG8_WAIT_L(8); PG8_BAR; PG8_WAIT_L(0); PG8_MMA(0, 0, At, B0); PG8_BAR; PG8_SCHED;
            PG8_LDB(B1, 1, 1); PG8_STAGE(PG8_SB(1, 0), b3, voffB);
            PG8_BAR; PG8_WAIT_L(0); PG8_MMA(0, 1, At, B1); PG8_BAR;
            PG8_LDA(At, 1, 1); PG8_STAGE(PG8_SA(1, 0), a3, voffA);
            PG8_BAR; PG8_WAIT_L(0); PG8_MMA(1, 0, At, B0); PG8_BAR; PG8_SCHED;
            PG8_STAGE(PG8_SB(1, 1), b3 + hstep, voffB);
            PG8_WAIT_V(6); PG8_BAR; PG8_MMA(1, 1, At, B1); PG8_BAR;
            }
        }
        if constexpr (ALIGN_EPI) { if (wr == 0) PG8_BAR; }
        asm volatile("s_nop 15\n\ts_nop 15" ::: "memory");
        if constexpr (!Epi::AFTER_DRAIN) { E(acc, cur, wr, wc, fr, fq); S.done(cur); }
        if (!has_next) break;
#pragma unroll
        for (int a = 0; a < 2; ++a)
#pragma unroll
            for (int b = 0; b < 2; ++b)
#pragma unroll
                for (int m = 0; m < 4; ++m)
#pragma unroll
                    for (int n = 0; n < 2; ++n) acc[a][b][m][n] = (f32x4){0.f, 0.f, 0.f, 0.f};
        cur = nxt; cA = nA; cB = nB; ++ui;
        if constexpr (ALIGN_EPI) { if (wr == 1) PG8_BAR; }
    }
    PG8_WAIT_V(0);
    if constexpr (!ALIGN_EPI) { if (wr == 0) PG8_BAR; }
    PG8_BAR;
    if constexpr (Epi::AFTER_DRAIN) { E.fused(acc, cur, wr, wc, fr, fq, lds, wid, lane); S.done(cur); }
#undef PG8_SA
#undef PG8_SB
#undef PG8_STAGE
#undef PG8_LDA
#undef PG8_LDB
#undef PG8_MMA
#undef PG8_WAIT_V
#undef PG8_WAIT_L
#undef PG8_BAR
#undef PG8_SCHED
}
}

#define LAS __attribute__((address_space(3)))
typedef unsigned short bf16;
typedef short bf16x8 __attribute__((ext_vector_type(8)));
typedef float f32x4 __attribute__((ext_vector_type(4)));
typedef float f32x16 __attribute__((ext_vector_type(16)));
typedef unsigned u32x2 __attribute__((ext_vector_type(2)));
typedef unsigned u32x4 __attribute__((ext_vector_type(4)));

constexpr int NB = 8, SEQ = 2048, NMETA = 16, LL = 2064, DM = 1024, FF = 4096, DIN = 4864, NPROJ = 1792;
constexpr int NREAL = NB * SEQ;
constexpr int TPR = NREAL + 256;
constexpr int LDS_BYTES = 147456;

constexpr size_t MiB = 1u << 20;
constexpr size_t WS_CTL = 0;
constexpr size_t WS_ROPE = 1 * MiB;
constexpr size_t WS_ABAR = 2 * MiB;
constexpr size_t WS_BMAT = 2 * MiB + 65536;
constexpr size_t WS_CMAT = WS_BMAT + 524288;
constexpr size_t WS_HM = 4 * MiB;
constexpr size_t WS_W = 5 * MiB;
constexpr size_t OW_IN = 0, OW_GLU = (size_t)DIN * DM * 2, OW_POOL = OW_GLU + 512 * 512 * 2, OW_BR = OW_POOL + 512 * 512 * 2,
                 OW_OUT = OW_BR + 3 * 1024 * 512 * 2, OW_UP = OW_OUT + 1024 * 1024 * 2, OW_DN = OW_UP + (size_t)FF * DM * 2, LW_BYTES = OW_DN + (size_t)FF * DM * 2;
constexpr size_t WS_HB = 68 * MiB;
constexpr size_t WS_X = 101 * MiB;
constexpr size_t UU = (size_t)TPR * 512 * 2;
constexpr size_t WS_YF = WS_X, WS_YP = WS_X, WS_Q = WS_X + 2 * UU, WS_K = WS_Q + UU, WS_V = WS_K + UU / 4, WS_MG = WS_X + 2 * UU,
                 WS_SU = WS_X + 4 * UU, WS_YA = WS_X + 8 * UU  , WS_PU = WS_X + 5 * UU, WS_YS = WS_PU, WS_Z = WS_X + 6 * UU, WS_PD = WS_X + 7 * UU, WS_BR = WS_Z, WS_ACT = WS_X;
constexpr size_t WS_RS = WS_X + 9 * UU;
constexpr size_t WS_END = WS_RS + (size_t)5 * TPR * 16 * 4;
static_assert(WS_W + 2 * LW_BYTES <= WS_HB && WS_HB + (size_t)TPR * 1024 * 2 <= WS_X && WS_END <= 256 * MiB, "ws map");
static_assert((size_t)256 * 2064 * 16 * 4 <= 2 * UU, "YF fits");

__device__ __forceinline__ unsigned pk2(float lo, float hi) { unsigned r; asm("v_cvt_pk_bf16_f32 %0, %1, %2" : "=v"(r) : "v"(lo), "v"(hi)); return r; }
__device__ __forceinline__ unsigned f2bf(float f) { return pk2(f, 0.f) & 0xffffu; }
__device__ __forceinline__ float bf2f(unsigned b) { return __uint_as_float(b << 16); }
__device__ __forceinline__ int tok_row(int b, int l) { return l >= NMETA ? b * SEQ + l - NMETA : NREAL + b * NMETA + l; }
#define LDS_FENCE() asm volatile("s_waitcnt lgkmcnt(0)" ::: "memory")
#define SSM_SYNC() do { asm volatile("s_waitcnt vmcnt(0) lgkmcnt(0)" ::: "memory"); __syncthreads(); } while (0)
__device__ __forceinline__ float row_rstd(const float* rs, int R) {
    const f32x4 a = *(const f32x4*)(rs + (size_t)R * 4), b = *(const f32x4*)(rs + ((size_t)TPR + R) * 4), c = *(const f32x4*)(rs + ((size_t)2 * TPR + R) * 4), d = *(const f32x4*)(rs + ((size_t)3 * TPR + R) * 4);
    const float s = (((a[0] + a[1]) + (a[2] + a[3])) + ((b[0] + b[1]) + (b[2] + b[3]))) + (((c[0] + c[1]) + (c[2] + c[3])) + ((d[0] + d[1]) + (d[2] + d[3])));
    return rsqrtf(s * (1.0f / 1024.0f) + 1e-6f);
}

__device__ __forceinline__ void dsincos(double a, double& s, double& c) {
    const double q = rint(a * 0.63661977236758134308);
    double r = fma(-q, 1.57079632679489655800e+00, a); r = fma(-q, 6.12323399573676603587e-17, r);
    const double r2 = r * r;
    double sp = -7.6471637318198164759e-13; sp = fma(sp, r2, 1.6059043836821614599e-10); sp = fma(sp, r2, -2.5052108385441718775e-08); sp = fma(sp, r2, 2.7557319223985890653e-06);
    sp = fma(sp, r2, -1.9841269841269841270e-04); sp = fma(sp, r2, 8.3333333333333333333e-03); sp = fma(sp, r2, -1.6666666666666666667e-01); sp = fma(sp * r2, r, r);
    double cp = 4.7794773323873852974e-14; cp = fma(cp, r2, -1.1470745597729724714e-11); cp = fma(cp, r2, 2.0876756987868098979e-09); cp = fma(cp, r2, -2.7557319223985890653e-07);
    cp = fma(cp, r2, 2.4801587301587301587e-05); cp = fma(cp, r2, -1.3888888888888888889e-03); cp = fma(cp, r2, 4.1666666666666666667e-02); cp = fma(cp, r2, -0.5); cp = fma(cp, r2, 1.0);
    const int qi = ((int)q) & 3;
    s = (qi == 0) ? sp : (qi == 1) ? cp : (qi == 2) ? -sp : -cp;
    c = (qi == 0) ? cp : (qi == 1) ? -sp : (qi == 2) ? -cp : sp;
}
__device__ __forceinline__ double dexp(double x) {
    const double k = rint(x * 1.44269504088896340736);
    double r = fma(-k, 6.93147180369123816490e-01, x); r = fma(-k, 1.90821492927058770002e-10, r);
    double p = 1.0 / 6227020800.0; p = fma(p, r, 1.0 / 479001600.0); p = fma(p, r, 1.0 / 39916800.0); p = fma(p, r, 1.0 / 3628800.0); p = fma(p, r, 1.0 / 362880.0); p = fma(p, r, 1.0 / 40320.0);
    p = fma(p, r, 1.0 / 5040.0); p = fma(p, r, 1.0 / 720.0); p = fma(p, r, 1.0 / 120.0); p = fma(p, r, 1.0 / 24.0); p = fma(p, r, 1.0 / 6.0); p = fma(p, r, 0.5); p = fma(p, r, 1.0); p = fma(p, r, 1.0);
    const long long bits = ((long long)(1023 + (int)k)) << 52;
    return p * __longlong_as_double(bits);
}

struct EpiInProj {
    static constexpr bool PERM = true, AFTER_DRAIN = false;
    const float* rowss; const float* rope; bf16 *Q, *K, *V, *SU, *PU;
    __device__ __forceinline__ u32x2 quad(int l, int c, const f32x4& v) const {
        u32x2 w;
        if (c < 640) {
            const int i0 = (c & 63) >> 1;
            const f32x4 cs = *(const f32x4*)(rope + ((size_t)l * 32 + i0) * 2);
            float o0 = v[0] * cs[0] - v[1] * cs[1], o1 = v[1] * cs[0] + v[0] * cs[1], o2 = v[2] * cs[2] - v[3] * cs[3], o3 = v[3] * cs[2] + v[2] * cs[3];
            if (c < 512) { o0 *= 0.125f; o1 *= 0.125f; o2 *= 0.125f; o3 *= 0.125f; }
            w.x = pk2(o0, o1); w.y = pk2(o2, o3);
        } else { w.x = pk2(v[0], v[1]); w.y = pk2(v[2], v[3]); }
        return w;
    }
    __device__ __forceinline__ void operator()(const f32x4 (&acc)[2][2][4][2], const pg8::Unit& u, int wr, int wc, int fr, int fq) const {
#pragma unroll
        for (int ai = 0; ai < 2; ++ai)
#pragma unroll
            for (int m = 0; m < 4; ++m) {
                const int R = u.pm * 256 + ai * 128 + wr * 64 + m * 16 + fr;
                const float rs = row_rstd(rowss, R);
                const int l = R < NREAL ? (R & 2047) + NMETA : (R & 15);
#pragma unroll
                for (int bj = 0; bj < 2; ++bj) {
                    const int c = u.pn * 256 + bj * 128 + wc * 32 + 8 * fq;
                    const u32x2 w0 = quad(l, c, acc[ai][bj][m][0] * rs), w1 = quad(l, c + 4, acc[ai][bj][m][1] * rs);
                    u32x4 w; w.x = w0.x; w.y = w0.y; w.z = w1.x; w.w = w1.y;
                    bf16* dst = c < 512 ? Q + (size_t)R * 512 + c : c < 640 ? K + (size_t)R * 128 + (c - 512) : c < 768 ? V + (size_t)R * 128 + (c - 640)
                              : c < 1280 ? SU + (size_t)R * 512 + (c - 768) : PU + (size_t)R * 512 + (c - 1280);
                    *(u32x4*)dst = w;
                }
            }
    }
};
#define EPI_BODY() \
    __device__ __forceinline__ void rg(int R, int pn, int wc, int fq, const f32x4 (&a4)[2][2]) const { \
        _Pragma("unroll") for (int bj = 0; bj < 2; ++bj) q2(R, pn * 256 + bj * 128 + wc * 32 + 8 * fq, a4[bj][0], a4[bj][1]); } \
    __device__ __forceinline__ void tq(int R, int c, const f32x4& v) const { q(R, c, v); } \
    EPI_OP()
#define EPI_OP() \
    __device__ __forceinline__ void operator()(const f32x4 (&acc)[2][2][4][2], const pg8::Unit& u, int wr, int wc, int fr, int fq) const { \
        _Pragma("unroll") for (int ai = 0; ai < 2; ++ai) _Pragma("unroll") for (int m = 0; m < 4; ++m) { \
            const f32x4 a4[2][2] = {{acc[ai][0][m][0], acc[ai][0][m][1]}, {acc[ai][1][m][0], acc[ai][1][m][1]}}; \
            rg(u.pm * 256 + ai * 128 + wr * 64 + m * 16 + fr, u.pn, wc, fq, a4); } }
#define EPI_BODY_RS() \
    __device__ __forceinline__ void rg(int R, int pn, int wc, int fq, const f32x4 (&a4)[2][2]) const { const float rs = row_rstd(rowss, R); \
        _Pragma("unroll") for (int bj = 0; bj < 2; ++bj) q2(R, pn * 256 + bj * 128 + wc * 32 + 8 * fq, a4[bj][0], a4[bj][1], rs); } \
    __device__ __forceinline__ void tq(int R, int c, const f32x4& v) const { q(R, c, v, row_rstd(rowss, R)); } \
    EPI_OP()
struct EpiGlu {
    static constexpr bool PERM = true, AFTER_DRAIN = false;
    const bf16* Z; const float* bias; bf16* YS;
    __device__ __forceinline__ void q(int R, int c, const f32x4& a) const {
        const f32x4 v = a + *(const f32x4*)(bias + c);
        const u32x2 zz = *(const u32x2*)(Z + (size_t)R * 512 + c);
        const float z0 = bf2f(zz.x & 0xffffu), z1 = bf2f(zz.x >> 16), z2 = bf2f(zz.y & 0xffffu), z3 = bf2f(zz.y >> 16);
        u32x2 w; w.x = pk2(z0 * __builtin_amdgcn_rcpf(1.0f + __expf(-v[0])), z1 * __builtin_amdgcn_rcpf(1.0f + __expf(-v[1]))); w.y = pk2(z2 * __builtin_amdgcn_rcpf(1.0f + __expf(-v[2])), z3 * __builtin_amdgcn_rcpf(1.0f + __expf(-v[3])));
        *(u32x2*)(YS + (size_t)R * 512 + c) = w;
    }
    __device__ __forceinline__ void q2(int R, int c, const f32x4& a0, const f32x4& a1) const {
        const f32x4 v0 = a0 + *(const f32x4*)(bias + c), v1 = a1 + *(const f32x4*)(bias + c + 4);
        const u32x4 zz = *(const u32x4*)(Z + (size_t)R * 512 + c);
        u32x4 w;
        w.x = pk2(bf2f(zz.x & 0xffffu) * __builtin_amdgcn_rcpf(1.0f + __expf(-v0[0])), bf2f(zz.x >> 16) * __builtin_amdgcn_rcpf(1.0f + __expf(-v0[1])));
        w.y = pk2(bf2f(zz.y & 0xffffu) * __builtin_amdgcn_rcpf(1.0f + __expf(-v0[2])), bf2f(zz.y >> 16) * __builtin_amdgcn_rcpf(1.0f + __expf(-v0[3])));
        w.z = pk2(bf2f(zz.z & 0xffffu) * __builtin_amdgcn_rcpf(1.0f + __expf(-v1[0])), bf2f(zz.z >> 16) * __builtin_amdgcn_rcpf(1.0f + __expf(-v1[1])));
        w.w = pk2(bf2f(zz.w & 0xffffu) * __builtin_amdgcn_rcpf(1.0f + __expf(-v1[2])), bf2f(zz.w >> 16) * __builtin_amdgcn_rcpf(1.0f + __expf(-v1[3])));
        *(u32x4*)(YS + (size_t)R * 512 + c) = w;
    }
    EPI_BODY()
};
struct EpiScale {
    static constexpr bool PERM = true, AFTER_DRAIN = false;
    bf16* O; int ldc; const float* scale;
    __device__ __forceinline__ void q(int R, int c, const f32x4& a) const {
        f32x4 v = a;
        if (scale) v = v * *(const f32x4*)(scale + c);
        u32x2 w; w.x = pk2(v[0], v[1]); w.y = pk2(v[2], v[3]);
        *(u32x2*)(O + (size_t)R * ldc + c) = w;
    }
    __device__ __forceinline__ void q2(int R, int c, const f32x4& a0, const f32x4& a1) const {
        f32x4 v0 = a0, v1 = a1;
        if (scale) { v0 = v0 * *(const f32x4*)(scale + c); v1 = v1 * *(const f32x4*)(scale + c + 4); }
        u32x4 w; w.x = pk2(v0[0], v0[1]); w.y = pk2(v0[2], v0[3]); w.z = pk2(v1[0], v1[1]); w.w = pk2(v1[2], v1[3]);
        *(u32x4*)(O + (size_t)R * ldc + c) = w;
    }
    EPI_BODY()
};
template <bool FIRST> struct EpiGate {
    static constexpr bool PERM = true, AFTER_DRAIN = false;
    const float* rowss; const bf16* BR; bf16* MG;
    __device__ __forceinline__ void q(int R, int c, const f32x4& a, float rs) const {
        const f32x4 v = a * rs;
        const u32x2 bb = *(const u32x2*)(BR + (size_t)R * 1024 + c);
        float o0 = bf2f(bb.x & 0xffffu) * __builtin_amdgcn_rcpf(1.0f + __expf(-v[0])), o1 = bf2f(bb.x >> 16) * __builtin_amdgcn_rcpf(1.0f + __expf(-v[1]));
        float o2 = bf2f(bb.y & 0xffffu) * __builtin_amdgcn_rcpf(1.0f + __expf(-v[2])), o3 = bf2f(bb.y >> 16) * __builtin_amdgcn_rcpf(1.0f + __expf(-v[3]));
        if (!FIRST) { const u32x2 mm = *(const u32x2*)(MG + (size_t)R * 1024 + c);
            o0 += bf2f(mm.x & 0xffffu); o1 += bf2f(mm.x >> 16); o2 += bf2f(mm.y & 0xffffu); o3 += bf2f(mm.y >> 16); }
        u32x2 w; w.x = pk2(o0, o1); w.y = pk2(o2, o3);
        *(u32x2*)(MG + (size_t)R * 1024 + c) = w;
    }
    __device__ __forceinline__ void q2(int R, int c, const f32x4& a0, const f32x4& a1, float rs) const {
        const f32x4 v0 = a0 * rs, v1 = a1 * rs;
        const u32x4 bb = *(const u32x4*)(BR + (size_t)R * 1024 + c);
        float o[8];
        o[0] = bf2f(bb.x & 0xffffu) * __builtin_amdgcn_rcpf(1.0f + __expf(-v0[0])); o[1] = bf2f(bb.x >> 16) * __builtin_amdgcn_rcpf(1.0f + __expf(-v0[1]));
        o[2] = bf2f(bb.y & 0xffffu) * __builtin_amdgcn_rcpf(1.0f + __expf(-v0[2])); o[3] = bf2f(bb.y >> 16) * __builtin_amdgcn_rcpf(1.0f + __expf(-v0[3]));
        o[4] = bf2f(bb.z & 0xffffu) * __builtin_amdgcn_rcpf(1.0f + __expf(-v1[0])); o[5] = bf2f(bb.z >> 16) * __builtin_amdgcn_rcpf(1.0f + __expf(-v1[1]));
        o[6] = bf2f(bb.w & 0xffffu) * __builtin_amdgcn_rcpf(1.0f + __expf(-v1[2])); o[7] = bf2f(bb.w >> 16) * __builtin_amdgcn_rcpf(1.0f + __expf(-v1[3]));
        if (!FIRST) { const u32x4 mm = *(const u32x4*)(MG + (size_t)R * 1024 + c);
            o[0] += bf2f(mm.x & 0xffffu); o[1] += bf2f(mm.x >> 16); o[2] += bf2f(mm.y & 0xffffu); o[3] += bf2f(mm.y >> 16);
            o[4] += bf2f(mm.z & 0xffffu); o[5] += bf2f(mm.z >> 16); o[6] += bf2f(mm.w & 0xffffu); o[7] += bf2f(mm.w >> 16); }
        u32x4 w; w.x = pk2(o[0], o[1]); w.y = pk2(o[2], o[3]); w.z = pk2(o[4], o[5]); w.w = pk2(o[6], o[7]);
        *(u32x4*)(MG + (size_t)R * 1024 + c) = w;
    }
    EPI_BODY_RS()
};
struct EpiRes {
    static constexpr bool PERM = true, AFTER_DRAIN = false;
    float* Hreal; float* Hmeta; bf16* HB; float* rowss_out; const float* Hin;
    __device__ __forceinline__ float q(int R, int c, const f32x4& a) const {
        float* hrow = R < NREAL ? Hreal + (size_t)R * 1024 : Hmeta + (size_t)(R - NREAL) * 1024;
        const float* hin = R < NREAL ? Hin + (size_t)R * 1024 : hrow;
        const f32x4 h = *(const f32x4*)(hin + c) + a;
        *(f32x4*)(hrow + c) = h;
        u32x2 w; w.x = pk2(h[0], h[1]); w.y = pk2(h[2], h[3]);
        *(u32x2*)(HB + (size_t)R * 1024 + c) = w;
        return (h[0] * h[0] + h[1] * h[1]) + (h[2] * h[2] + h[3] * h[3]);
    }
    __device__ __forceinline__ void rg(int R, int pn, int wc, int fq, const f32x4 (&a4)[2][2]) const {
        float ss = 0.f;
#pragma unroll
        for (int bj = 0; bj < 2; ++bj)
#pragma unroll
            for (int n = 0; n < 2; ++n) ss += q(R, pn * 256 + bj * 128 + wc * 32 + 8 * fq + 4 * n, a4[bj][n]);
        ss += __shfl_xor(ss, 16); ss += __shfl_xor(ss, 32);
        if (fq == 0) rowss_out[((size_t)pn * TPR + R) * 4 + wc] = ss;
    }
    __device__ __forceinline__ void tq(int R, int c, const f32x4& v) const {
        float ss = q(R, c, v);
        ss += __shfl_xor(ss, 16); ss += __shfl_xor(ss, 32);
        if ((threadIdx.x & 48) == 0) atomicAdd(rowss_out + (size_t)R * 4, ss);
    }
    EPI_OP()
};
struct EpiUp {
    static constexpr bool PERM = true, AFTER_DRAIN = false;
    const float* rowss; bf16* ACT;
    __device__ __forceinline__ void q(int R, int c, const f32x4& a, float rs) const {
        f32x4 v = a * rs;
#pragma unroll
        for (int j = 0; j < 4; ++j) { const float r = fmaxf(v[j], 0.f); v[j] = r * r; }
        u32x2 w; w.x = pk2(v[0], v[1]); w.y = pk2(v[2], v[3]);
        *(u32x2*)(ACT + (size_t)R * FF + c) = w;
    }
    __device__ __forceinline__ void q2(int R, int c, const f32x4& a0, const f32x4& a1, float rs) const {
        f32x4 v0 = a0 * rs, v1 = a1 * rs;
#pragma unroll
        for (int j = 0; j < 4; ++j) { const float r0 = fmaxf(v0[j], 0.f), r1 = fmaxf(v1[j], 0.f); v0[j] = r0 * r0; v1[j] = r1 * r1; }
        u32x4 w; w.x = pk2(v0[0], v0[1]); w.y = pk2(v0[2], v0[3]); w.z = pk2(v1[0], v1[1]); w.w = pk2(v1[2], v1[3]);
        *(u32x4*)(ACT + (size_t)R * FF + c) = w;
    }
    EPI_BODY_RS()
};
template <class Epi>
__device__ __forceinline__ void thin_gemm(LAS unsigned char* lds, const bf16* A, const bf16* Bt, int K, int N, const Epi& E, int vb, int vg) {
    int tid_l = threadIdx.x; asm volatile("" : "+v"(tid_l));
    const int lane = tid_l & 63, w = __builtin_amdgcn_readfirstlane(tid_l >> 6), fr = lane & 15, fq = lane >> 4;
    LAS f32x4* red = (LAS f32x4*)lds;
    const int kw = K >> 3;
    for (int pc = vb; pc < N / 16; pc += vg) {
        const bf16* ap = A + (size_t)(NREAL + fr) * K + w * kw + 8 * fq;
        const bf16* bp = Bt + (size_t)(16 * pc + fr) * K + w * kw + 8 * fq;
        f32x4 acc[8];
#pragma unroll
        for (int rb = 0; rb < 8; ++rb) acc[rb] = (f32x4){0.f, 0.f, 0.f, 0.f};
#pragma unroll 2
        for (int k0 = 0; k0 < kw; k0 += 32) {
            const bf16x8 bf = *(const bf16x8*)(bp + k0);
            bf16x8 af[8];
#pragma unroll
            for (int rb = 0; rb < 8; ++rb) af[rb] = *(const bf16x8*)(ap + (size_t)(16 * rb) * K + k0);
#pragma unroll
            for (int rb = 0; rb < 8; ++rb) acc[rb] = __builtin_amdgcn_mfma_f32_16x16x32_bf16(bf, af[rb], acc[rb], 0, 0, 0);
        }
        asm volatile("s_nop 15\n\ts_nop 15" : "+v"(acc[0]), "+v"(acc[1]), "+v"(acc[2]), "+v"(acc[3]), "+v"(acc[4]), "+v"(acc[5]), "+v"(acc[6]), "+v"(acc[7]));
#pragma unroll
        for (int rb = 0; rb < 8; ++rb) red[(w * 8 + rb) * 64 + lane] = acc[rb];
        LDS_FENCE(); __syncthreads();
        f32x4 v = red[(0 * 8 + w) * 64 + lane];
#pragma unroll
        for (int ww = 1; ww < 8; ++ww) v = v + red[(ww * 8 + w) * 64 + lane];
        LDS_FENCE(); __syncthreads();
        E.tq(NREAL + 16 * w + fr, 16 * pc + 4 * fq, v);
    }
}

struct Args { const float* in[23]; float* out; unsigned char* ws; };

__device__ __forceinline__ void p0_item(const float* W, int ldw, int K, const float* scale, bf16* WT, int permrows, LAS float* scr, int item, int nblk, int lane) {
    const int kb = item / nblk, nb = item % nblk, k0 = 64 * kb, n0 = 64 * nb;
#pragma unroll 4
    for (int i = 0; i < 16; ++i) {
        const int kk = 4 * i + (lane >> 4), c4 = (lane & 15) * 4;
        f32x4 w = *(const f32x4*)(W + (size_t)(k0 + kk) * ldw + n0 + c4);
        if (scale) w = w * scale[k0 + kk];
        scr[kk * 65 + c4] = w[0]; scr[kk * 65 + c4 + 1] = w[1]; scr[kk * 65 + c4 + 2] = w[2]; scr[kk * 65 + c4 + 3] = w[3];
    }
    LDS_FENCE();
    const int c = lane & 7;
#pragma unroll
    for (int j = 0; j < 8; ++j) {
        const int n = (lane >> 3) + 8 * j;
        const int sc = (n0 + n) < permrows ? ((n & 1) ? 32 + (n >> 1) : (n >> 1)) : n;
        const LAS float* s = scr + (8 * c) * 65 + sc;
        u32x4 o; o.x = pk2(s[0 * 65], s[1 * 65]); o.y = pk2(s[2 * 65], s[3 * 65]); o.z = pk2(s[4 * 65], s[5 * 65]); o.w = pk2(s[6 * 65], s[7 * 65]);
        *(u32x4*)(WT + (size_t)(n0 + n) * K + k0 + 8 * c) = o;
    }
    LDS_FENCE();
}

__device__ __forceinline__ void p0_prologue(const Args& a, LAS unsigned char* lds) {
    int tl_ = threadIdx.x; asm volatile("" : "+v"(tl_));
    const int tid = tl_, lane = tid & 63, wave = __builtin_amdgcn_readfirstlane(tid >> 6);
    const int gw = blockIdx.x * 8 + wave, NGW = gridDim.x * 8;
    const int gt = blockIdx.x * 512 + tid, NGT = gridDim.x * 512;
    unsigned char* ws = a.ws;
    LAS float* scr = (LAS float*)(lds + wave * 17408);
    for (int i = gt; i < 4 * 4 * 128 * 4; i += NGT) { const int idx = 1 + (i >> 11), pn = (i >> 9) & 3, r = (i >> 2) & 127, sl = i & 3;
        ((float*)(ws + WS_RS))[((size_t)idx * 4 * TPR + (size_t)pn * TPR + NREAL + r) * 4 + sl] = 0.f; }
    constexpr int I_IN = 16 * 76, I_GLU = 8 * 8, I_BR = 8 * 16, I_OUT = 16 * 16, I_UP = 16 * 64, I_DN = 64 * 16, I_L = I_IN + I_GLU + 3 * I_BR + I_OUT + I_UP + I_DN;
    for (int it = gw; it < 2 * I_L; it += NGW) {
        const int layer = it / I_L; int r = it % I_L;
        unsigned char* wl = ws + WS_W + (size_t)layer * LW_BYTES;
        if (r < I_IN) { p0_item(a.in[3] + (size_t)layer * DM * DIN, DIN, DM, a.in[2] + layer * DM, (bf16*)(wl + OW_IN), 640, scr, r, 76, lane); continue; } r -= I_IN;
        if (r < I_GLU) { p0_item(a.in[13] + (size_t)layer * 512 * 512, 512, 512, nullptr, (bf16*)(wl + OW_GLU), 0, scr, r, 8, lane); continue; } r -= I_GLU;
        if (r < 3 * I_BR) { const int c = r / I_BR; p0_item(a.in[17] + ((size_t)layer * 3 + c) * 512 * 1024, 1024, 512, nullptr, (bf16*)(wl + OW_BR) + (size_t)c * 1024 * 512, 0, scr, r % I_BR, 16, lane); continue; } r -= 3 * I_BR;
        if (r < I_OUT) { p0_item(a.in[18] + (size_t)layer * DM * DM, DM, DM, nullptr, (bf16*)(wl + OW_OUT), 0, scr, r, 16, lane); continue; } r -= I_OUT;
        if (r < I_UP) { p0_item(a.in[20] + (size_t)layer * DM * FF, FF, DM, a.in[19] + layer * DM, (bf16*)(wl + OW_UP), 0, scr, r, 64, lane); continue; } r -= I_UP;
        p0_item(a.in[21] + (size_t)layer * FF * DM, DM, FF, nullptr, (bf16*)(wl + OW_DN), 0, scr, r, 16, lane);
    }
    for (int i = gt; i < 2 * 512 * 512; i += NGT) {
        const int layer = i >> 18, n = (i >> 9) & 511, k = i & 511;
        float w = 0.f;
        if ((n >> 7) == (k >> 7)) w = a.in[15][(((size_t)layer * 4 + (n >> 7)) * 128 + (k & 127)) * 128 + (n & 127)];
        ((bf16*)(ws + WS_W + (size_t)layer * LW_BYTES + OW_POOL))[(size_t)n * 512 + k] = (bf16)f2bf(w);
    }
    for (int i = gt; i < LL * 32; i += NGT) {
        const int l = i >> 5, f = i & 31;
        const float invf = (float)dexp(-(double)f * (9.21034037197618273607 / 32.0));
        const float ang = (float)l * invf;
        double s, c; dsincos((double)ang, s, c);
        float* rp = (float*)(ws + WS_ROPE) + (size_t)i * 2; rp[0] = (float)c; rp[1] = (float)s;
    }
    for (int i = gt; i < 2 * 2 * 32 * 64; i += NGT) {
        const int n = i & 63, pidx = i >> 6;
        const double lr = (double)a.in[5][i], li = (double)a.in[6][i];
        const double dt = (double)(float)dexp((double)a.in[7][pidx]);
        const double mag = dexp(lr * dt); double sn, cn; dsincos(li * dt, sn, cn);
        const double are = mag * cn, aim = mag * sn, den = lr * lr + li * li, nre = are - 1.0;
        const double fre = (nre * lr + aim * li) / den, fim = (aim * lr - nre * li) / den;
        float* ab = (float*)(ws + WS_ABAR) + (size_t)i * 2; ab[0] = (float)are; ab[1] = (float)aim;
        bf16* bm = (bf16*)(ws + WS_BMAT) + (size_t)pidx * 128 * 16;
        bf16* cm = (bf16*)(ws + WS_CMAT) + (size_t)pidx * 16 * 128;
        for (int q = 0; q < 16; ++q) {
            const double br = (double)a.in[8][(size_t)i * 16 + q], bi = (double)a.in[9][(size_t)i * 16 + q];
            bm[n * 16 + q] = (bf16)f2bf((float)(fre * br - fim * bi));
            bm[(64 + n) * 16 + q] = (bf16)f2bf((float)(fre * bi + fim * br));
            cm[q * 128 + n] = (bf16)f2bf(a.in[10][((size_t)pidx * 16 + q) * 64 + n]);
            cm[q * 128 + 64 + n] = (bf16)f2bf(-a.in[11][((size_t)pidx * 16 + q) * 64 + n]);
        }
    }
    for (int R = gw; R < TPR; R += NGW) {
        const int mrow = R - NREAL;
        const float* src = R < NREAL ? a.in[0] + (size_t)R * DM : a.in[1] + (size_t)(mrow & 15) * DM;
        float* dst = R < NREAL ? a.out + (size_t)R * DM : (float*)(ws + WS_HM) + (size_t)mrow * DM;
        bf16* hb = (bf16*)(ws + WS_HB) + (size_t)R * DM;
        const bool pad = mrow >= NB * NMETA;
        float ss = 0.f;
#pragma unroll
        for (int j = 0; j < 4; ++j) {
            f32x4 v = *(const f32x4*)(src + 4 * lane + 256 * j);
            if (pad) v = (f32x4){0.f, 0.f, 0.f, 0.f};
            if (R >= NREAL) *(f32x4*)(dst + 4 * lane + 256 * j) = v;
            ss += (v[0] * v[0] + v[1] * v[1]) + (v[2] * v[2] + v[3] * v[3]);
            u32x2 w; w.x = pk2(v[0], v[1]); w.y = pk2(v[2], v[3]);
            *(u32x2*)(hb + 4 * lane + 256 * j) = w;
        }
#pragma unroll
        for (int o = 1; o < 64; o <<= 1) ss += __shfl_xor(ss, o);
        if (lane < 16) ((float*)(ws + WS_RS))[((size_t)(lane >> 2) * TPR + R) * 4 + (lane & 3)] = lane == 0 ? ss : 0.f;
    }
}

__device__ __forceinline__ void ssm_task(LAS unsigned char* lds, int task, int layer, const bf16* SU, float* YF,
                                         const float* abar_all, const bf16* bmat_all, const bf16* cmat_all) {
    int tid_l = threadIdx.x; asm volatile("" : "+v"(tid_l));
    const int tid = tid_l, lane = tid & 63, wave = __builtin_amdgcn_readfirstlane(tid >> 6);
    const int b = task >> 5, g = task & 31;
    __syncthreads();
    LAS float* BU = (LAS float*)(lds + wave * 12800);
    LAS unsigned short* X = (LAS unsigned short*)(lds + wave * 12800 + 8448);
    LAS float* SX = (LAS float*)(lds + 8 * 12800);
    const int blk0 = wave == 0 ? 0 : 16 * wave + 1, nblk = wave == 0 ? 17 : 16;
    bf16* yfb = (bf16*)YF + (size_t)task * LL * 16;
    const int fr = lane & 15, fq = lane >> 4;
    const bf16x8 zero8 = {0, 0, 0, 0, 0, 0, 0, 0};
    for (int dir = 0; dir < 2; ++dir) {
        const int pidx = (layer * 2 + dir) * 32 + g;
        const float are = abar_all[((size_t)pidx * 64 + lane) * 2], aim = abar_all[((size_t)pidx * 64 + lane) * 2 + 1];
        bf16x8 bfr[8], cfr[4];
        const bf16* bm = bmat_all + (size_t)pidx * 128 * 16;
#pragma unroll
        for (int nt = 0; nt < 8; ++nt) bfr[nt] = fq < 2 ? *(const bf16x8*)(bm + (nt * 16 + fr) * 16 + 8 * fq) : zero8;
        const bf16* cm = cmat_all + (size_t)pidx * 16 * 128;
#pragma unroll
        for (int ks = 0; ks < 4; ++ks) cfr[ks] = *(const bf16x8*)(cm + fr * 128 + ks * 32 + 8 * fq);
        float p16r = are, p16i = aim;
#pragma unroll
        for (int i = 0; i < 4; ++i) { const float tr = p16r * p16r - p16i * p16i, ti = 2.f * p16r * p16i; p16r = tr; p16i = ti; }
        float p256r = p16r, p256i = p16i;
#pragma unroll
        for (int i = 0; i < 4; ++i) { const float tr = p256r * p256r - p256i * p256i, ti = 2.f * p256r * p256i; p256r = tr; p256i = ti; }
        const float p272r = p256r * p16r - p256i * p16i, p272i = p256r * p16i + p256i * p16r;

        float xre = 0.f, xim = 0.f;
        for (int pass = 0; pass < 2; ++pass) {
            bf16x8 unext;
            { const int blkf = dir == 0 ? blk0 : blk0 + nblk - 1; const int Rf = blkf == 0 ? NREAL + b * NMETA : b * SEQ + blkf * 16 - NMETA;
              unext = fq < 2 ? *(const bf16x8*)(SU + (size_t)(Rf + fr) * 512 + g * 16 + 8 * fq) : zero8; }
            for (int ib = 0; ib < nblk; ++ib) {
                const int blk = dir == 0 ? blk0 + ib : blk0 + nblk - 1 - ib;
                const bf16x8 ufr = unext;
                if (ib + 1 < nblk) { const int blkn = dir == 0 ? blk + 1 : blk - 1; const int Rn = blkn == 0 ? NREAL + b * NMETA : b * SEQ + blkn * 16 - NMETA;
                    unext = fq < 2 ? *(const bf16x8*)(SU + (size_t)(Rn + fr) * 512 + g * 16 + 8 * fq) : zero8; }
                f32x4 dd[8];
#pragma unroll
                for (int nt = 0; nt < 8; ++nt) { dd[nt] = (f32x4){0.f, 0.f, 0.f, 0.f}; dd[nt] = __builtin_amdgcn_mfma_f32_16x16x32_bf16(ufr, bfr[nt], dd[nt], 0, 0, 0); }
                asm volatile("s_nop 15\n\ts_nop 15" : "+v"(dd[0]), "+v"(dd[1]), "+v"(dd[2]), "+v"(dd[3]), "+v"(dd[4]), "+v"(dd[5]), "+v"(dd[6]), "+v"(dd[7]));
#pragma unroll
                for (int nt = 0; nt < 8; ++nt)
#pragma unroll
                    for (int r = 0; r < 4; ++r) BU[(4 * fq + r) * 132 + nt * 16 + fr] = dd[nt][r];
                LDS_FENCE();
                float bur[16], bui[16];
#pragma unroll
                for (int i = 0; i < 16; ++i) { const int tt = dir == 0 ? i : 15 - i; bur[i] = BU[tt * 132 + lane]; bui[i] = BU[tt * 132 + 64 + lane]; }
                if (pass == 0) {
#pragma unroll
                    for (int i = 0; i < 16; ++i) {
                        const float bre = bur[i], bim = bui[i];
                        const float nr = are * xre - aim * xim + bre, ni = are * xim + aim * xre + bim; xre = nr; xim = ni;
                    }
                    LDS_FENCE();
                } else {
#pragma unroll
                    for (int i = 0; i < 16; ++i) {
                        const int tt = dir == 0 ? i : 15 - i;
                        const float bre = bur[i], bim = bui[i];
                        const float nr = are * xre - aim * xim + bre, ni = are * xim + aim * xre + bim; xre = nr; xim = ni;
                        X[tt * 136 + lane] = (unsigned short)f2bf(xre); X[tt * 136 + 64 + lane] = (unsigned short)f2bf(xim);
                    }
                    LDS_FENCE();
                    f32x4 y = {0.f, 0.f, 0.f, 0.f};
#pragma unroll
                    for (int ks = 0; ks < 4; ++ks) {
                        const bf16x8 afr = *(const LAS bf16x8*)(X + fr * 136 + ks * 32 + 8 * fq);
                        y = __builtin_amdgcn_mfma_f32_16x16x32_bf16(afr, cfr[ks], y, 0, 0, 0);
                    }
                    asm volatile("s_nop 15\n\ts_nop 15" : "+v"(y));
                    LDS_FENCE();
                    {
                        bf16* yd = yfb + (size_t)dir * 256 * LL * 16;
#pragma unroll
                        for (int r = 0; r < 4; ++r) yd[(size_t)(blk * 16 + 4 * fq + r) * 16 + fr] = (bf16)f2bf(y[r]);
                    }
                }
            }
            if (pass == 0) {
                SX[(wave * 64 + lane) * 2] = xre; SX[(wave * 64 + lane) * 2 + 1] = xim;
                LDS_FENCE(); __syncthreads();
                float cre = 0.f, cim = 0.f;
                if (dir == 0) {
                    for (int w = 0; w < wave; ++w) { const float pr = w == 0 ? p272r : p256r, pi = w == 0 ? p272i : p256i;
                        const float sr = SX[(w * 64 + lane) * 2], si = SX[(w * 64 + lane) * 2 + 1];
                        const float nr = pr * cre - pi * cim + sr, ni = pr * cim + pi * cre + si; cre = nr; cim = ni; }
                } else {
                    for (int w = 7; w > wave; --w) {
                        const float sr = SX[(w * 64 + lane) * 2], si = SX[(w * 64 + lane) * 2 + 1];
                        const float nr = p256r * cre - p256i * cim + sr, ni = p256r * cim + p256i * cre + si; cre = nr; cim = ni; }
                }
                xre = cre; xim = cim;
            }
        }
        LDS_FENCE(); __syncthreads();
    }
}

constexpr int ATT_KROW = 72, ATT_VROW = 40, ATT_KT = 32 * ATT_KROW * 2  , ATT_VT = 64 * ATT_VROW * 2  , ATT_MAXT = 11, ATT_VOFF = ATT_MAXT * ATT_KT;
static_assert(ATT_VOFF + ATT_MAXT * ATT_VT <= 131072, "attention LDS");
__device__ __forceinline__ void attn_task(LAS unsigned char* lds, int task, const bf16* Q, const bf16* K, const bf16* V, bf16* YA, const float* sink) {
    int tid_l = threadIdx.x; asm volatile("" : "+v"(tid_l));
    const int tid = tid_l, lane = tid & 63, wave = __builtin_amdgcn_readfirstlane(tid >> 6);
    const int qb = task % 33, bh = task / 33, h = bh & 1, b = bh >> 1;
    const int l0 = qb * 64;
    __syncthreads();
    int jlo = (l0 - 128) >> 5; if (jlo < 1) jlo = 1;
    int jhi = (l0 + 191) >> 5; if (jhi > 64) jhi = 64;
    const int ntiles = 1 + (jhi - jlo + 1);
    LAS unsigned short* Ks = (LAS unsigned short*)lds;
    LAS unsigned short* Vs = (LAS unsigned short*)(lds + ATT_VOFF);
    for (int idx = tid; idx < ntiles * 32 * 8; idx += 512) {
        const int ch = idx & 7, key = idx >> 3, slot = key >> 5, kk = key & 31;
        const int lk = (slot == 0 ? 0 : (jlo + slot - 1) * 32) + kk;
        u32x4 kv = {0u, 0u, 0u, 0u}, vv = {0u, 0u, 0u, 0u};
        if (lk < LL) { const size_t R = (size_t)tok_row(b, lk);
            kv = *(const u32x4*)(K + R * 128 + h * 64 + ch * 8); vv = *(const u32x4*)(V + R * 128 + h * 64 + ch * 8); }
        *(LAS u32x4*)(Ks + slot * (ATT_KT / 2) + kk * ATT_KROW + ch * 8) = kv;
        LAS unsigned short* vd = Vs + slot * (ATT_VT / 2) + (ch * 8) * ATT_VROW + kk;
        vd[0 * ATT_VROW] = (unsigned short)(vv.x & 0xffffu); vd[1 * ATT_VROW] = (unsigned short)(vv.x >> 16);
        vd[2 * ATT_VROW] = (unsigned short)(vv.y & 0xffffu); vd[3 * ATT_VROW] = (unsigned short)(vv.y >> 16);
        vd[4 * ATT_VROW] = (unsigned short)(vv.z & 0xffffu); vd[5 * ATT_VROW] = (unsigned short)(vv.z >> 16);
        vd[6 * ATT_VROW] = (unsigned short)(vv.w & 0xffffu); vd[7 * ATT_VROW] = (unsigned short)(vv.w >> 16);
    }
    LDS_FENCE(); __syncthreads();
    const int head = h * 4 + (wave >> 1), r32 = lane & 31, hi = lane >> 5;
    const int lq = l0 + 32 * (wave & 1) + r32;
    const bool qvalid = lq < LL;
    const size_t Rq = (size_t)tok_row(b, qvalid ? lq : LL - 1);
    bf16x8 qf[4];
#pragma unroll
    for (int ks = 0; ks < 4; ++ks) qf[ks] = *(const bf16x8*)(Q + Rq * 512 + head * 64 + ks * 16 + 8 * hi);
    float mrun = sink[head], lsum = hi == 0 ? 1.0f : 0.0f;
    f32x16 o0, o1;
#pragma unroll
    for (int i = 0; i < 16; ++i) { o0[i] = 0.f; o1[i] = 0.f; }
    const int lqw = l0 + 32 * (wave & 1);
    for (int slot = 0; slot < ntiles; ++slot) {
        const int kbase = slot == 0 ? 0 : (jlo + slot - 1) * 32;
        if (lqw >= LL || (slot != 0 && (kbase + 31 < lqw - 128 || kbase > lqw + 31 + 128))) continue;
        const LAS unsigned short* kt = Ks + slot * (ATT_KT / 2);
        f32x16 s;
#pragma unroll
        for (int i = 0; i < 16; ++i) s[i] = 0.f;
#pragma unroll
        for (int ks = 0; ks < 4; ++ks) {
            const bf16x8 kf = *(const LAS bf16x8*)(kt + r32 * ATT_KROW + ks * 16 + 8 * hi);
            s = __builtin_amdgcn_mfma_f32_32x32x16_bf16(kf, qf[ks], s, 0, 0, 0);
        }
        asm volatile("s_nop 15\n\ts_nop 15" : "+v"(s));
        float mt = -1e30f;
#pragma unroll
        for (int i = 0; i < 16; ++i) {
            const int lk = kbase + (i & 3) + 8 * (i >> 2) + 4 * hi;
            int d = lq - lk; d = d < 0 ? -d : d;
            const bool valid = (lk < NMETA) || (d <= 128 && lk < LL);
            s[i] = valid ? s[i] : -1e30f;
            mt = fmaxf(mt, s[i]);
        }
        mt = fmaxf(mt, __shfl_xor(mt, 32));
        const float mnew = fmaxf(mrun, mt);
        const float alpha = __expf(mrun - mnew);
        mrun = mnew;
        float ps = 0.f;
#pragma unroll
        for (int i = 0; i < 16; ++i) { s[i] = __expf(s[i] - mnew); ps += s[i]; }
        lsum = lsum * alpha + ps;
#pragma unroll
        for (int i = 0; i < 16; ++i) { o0[i] *= alpha; o1[i] *= alpha; }
        const LAS unsigned short* vt = Vs + slot * (ATT_VT / 2);
#pragma unroll
        for (int s2 = 0; s2 < 2; ++s2) {
            union { bf16x8 v; unsigned u[4]; } pf;
            pf.u[0] = pk2(s[8 * s2 + 0], s[8 * s2 + 1]); pf.u[1] = pk2(s[8 * s2 + 2], s[8 * s2 + 3]);
            pf.u[2] = pk2(s[8 * s2 + 4], s[8 * s2 + 5]); pf.u[3] = pk2(s[8 * s2 + 6], s[8 * s2 + 7]);
#pragma unroll
            for (int dt = 0; dt < 2; ++dt) {
                union { bf16x8 v; u32x2 u[2]; } vf;
                const LAS unsigned short* vp = vt + (dt * 32 + r32) * ATT_VROW + 16 * s2 + 4 * hi;
                vf.u[0] = *(const LAS u32x2*)(vp); vf.u[1] = *(const LAS u32x2*)(vp + 8);
                if (dt == 0) o0 = __builtin_amdgcn_mfma_f32_32x32x16_bf16(vf.v, pf.v, o0, 0, 0, 0);
                else o1 = __builtin_amdgcn_mfma_f32_32x32x16_bf16(vf.v, pf.v, o1, 0, 0, 0);
            }
        }
    }
    asm volatile("s_nop 15\n\ts_nop 15" : "+v"(o0), "+v"(o1));
    lsum += __shfl_xor(lsum, 32);
    const float inv = 1.0f / lsum;
    if (qvalid) {
#pragma unroll
        for (int g4 = 0; g4 < 4; ++g4) {
            u32x2 w0, w1;
            w0.x = pk2(o0[4 * g4] * inv, o0[4 * g4 + 1] * inv); w0.y = pk2(o0[4 * g4 + 2] * inv, o0[4 * g4 + 3] * inv);
            w1.x = pk2(o1[4 * g4] * inv, o1[4 * g4 + 1] * inv); w1.y = pk2(o1[4 * g4 + 2] * inv, o1[4 * g4 + 3] * inv);
            *(u32x2*)(YA + Rq * 512 + head * 64 + 8 * g4 + 4 * hi) = w0;
            *(u32x2*)(YA + Rq * 512 + head * 64 + 32 + 8 * g4 + 4 * hi) = w1;
        }
    }
    __syncthreads();
}

__device__ __forceinline__ void pool_diff(LAS unsigned char* lds, const bf16* PU, bf16* PD) {
    int tl_ = threadIdx.x; asm volatile("" : "+v"(tl_));
    constexpr int TOK = 65, HALO = 8, ROWS = TOK + 2 * HALO, NTOK = NB * LL;
    for (int blk = blockIdx.x; blk * TOK < NTOK; blk += gridDim.x) {
        const int f0 = blk * TOK;
        __syncthreads();
        for (int i = tl_; i < ROWS * 64; i += 512) {
            const int r = i >> 6, ch = i & 63, f = f0 - HALO + r;
            u32x4 v = {0u, 0u, 0u, 0u};
            if (f >= 0 && f < NTOK) { const int b = f / LL, l = f % LL; v = *(const u32x4*)(PU + (size_t)tok_row(b, l) * 512 + ch * 8); }
            *(LAS u32x4*)(lds + (size_t)i * 16) = v;
        }
        LDS_FENCE(); __syncthreads();
        for (int i = tl_; i < TOK * 64; i += 512) {
            const int t = i >> 6, ch = i & 63, f = f0 + t;
            if (f >= NTOK) continue;
            const int b = f / LL, l = f % LL, half = 1 << (ch >> 4);
            const int lo = l - half < 0 ? 0 : l - half, hh = l + half > LL ? LL : l + half;
            float s[8];
#pragma unroll
            for (int j = 0; j < 8; ++j) s[j] = 0.f;
            for (int lp = lo; lp < hh; ++lp) {
                const u32x4 v = *(const LAS u32x4*)(lds + (size_t)((t + HALO + lp - l) * 64 + ch) * 16);
                s[0] += bf2f(v.x & 0xffffu); s[1] += bf2f(v.x >> 16); s[2] += bf2f(v.y & 0xffffu); s[3] += bf2f(v.y >> 16);
                s[4] += bf2f(v.z & 0xffffu); s[5] += bf2f(v.z >> 16); s[6] += bf2f(v.w & 0xffffu); s[7] += bf2f(v.w >> 16);
            }
            const float ic = 1.0f / (float)(hh - lo);
            const u32x4 v = *(const LAS u32x4*)(lds + (size_t)((t + HALO) * 64 + ch) * 16);
            u32x4 o;
            o.x = pk2(s[0] * ic - bf2f(v.x & 0xffffu), s[1] * ic - bf2f(v.x >> 16)); o.y = pk2(s[2] * ic - bf2f(v.y & 0xffffu), s[3] * ic - bf2f(v.y >> 16));
            o.z = pk2(s[4] * ic - bf2f(v.z & 0xffffu), s[5] * ic - bf2f(v.z >> 16)); o.w = pk2(s[6] * ic - bf2f(v.w & 0xffffu), s[7] * ic - bf2f(v.w >> 16));
            *(u32x4*)(PD + (size_t)tok_row(b, l) * 512 + ch * 8) = o;
        }
    }
    __syncthreads();
}

__device__ __forceinline__ void z_pass(const float* YF, const bf16* SU, const float* dskip, bf16* Z) {
    int tl_ = threadIdx.x; asm volatile("" : "+v"(tl_)); const int gt = blockIdx.x * 512 + tl_, NGT = gridDim.x * 512;
    for (int i = gt; i < NB * LL * 64; i += NGT) {
        const int ch = i & 63, tk = i >> 6, b = tk / LL, l = tk % LL, g = ch >> 1;
        const size_t R = (size_t)tok_row(b, l);
        const bf16* yp = (const bf16*)YF + ((size_t)(b * 32 + g) * LL + l) * 16 + (ch & 1) * 8;
        const u32x4 ya = *(const u32x4*)yp, yb = *(const u32x4*)(yp + (size_t)256 * LL * 16);
        f32x4 y0, y1;
        y0[0] = bf2f(ya.x & 0xffffu) + bf2f(yb.x & 0xffffu); y0[1] = bf2f(ya.x >> 16) + bf2f(yb.x >> 16); y0[2] = bf2f(ya.y & 0xffffu) + bf2f(yb.y & 0xffffu); y0[3] = bf2f(ya.y >> 16) + bf2f(yb.y >> 16);
        y1[0] = bf2f(ya.z & 0xffffu) + bf2f(yb.z & 0xffffu); y1[1] = bf2f(ya.z >> 16) + bf2f(yb.z >> 16); y1[2] = bf2f(ya.w & 0xffffu) + bf2f(yb.w & 0xffffu); y1[3] = bf2f(ya.w >> 16) + bf2f(yb.w >> 16);
        const f32x4 d0 = *(const f32x4*)(dskip + ch * 8), d1 = *(const f32x4*)(dskip + ch * 8 + 4);
        const u32x4 uu = *(const u32x4*)(SU + R * 512 + ch * 8);
        float t[8];
        t[0] = y0[0] + d0[0] * bf2f(uu.x & 0xffffu); t[1] = y0[1] + d0[1] * bf2f(uu.x >> 16); t[2] = y0[2] + d0[2] * bf2f(uu.y & 0xffffu); t[3] = y0[3] + d0[3] * bf2f(uu.y >> 16);
        t[4] = y1[0] + d1[0] * bf2f(uu.z & 0xffffu); t[5] = y1[1] + d1[1] * bf2f(uu.z >> 16); t[6] = y1[2] + d1[2] * bf2f(uu.w & 0xffffu); t[7] = y1[3] + d1[3] * bf2f(uu.w >> 16);
#pragma unroll
        for (int j = 0; j < 8; ++j) t[j] = 0.5f * t[j] * (1.0f + erff(t[j] * 0.70710678118654752f));
        u32x4 o; o.x = pk2(t[0], t[1]); o.y = pk2(t[2], t[3]); o.z = pk2(t[4], t[5]); o.w = pk2(t[6], t[7]);
        *(u32x4*)(Z + R * 512 + ch * 8) = o;
    }
}

#define XB_TMO      128
#define XB_XCNT(j)  (256  + 64 * (j))
#define XB_XSUB(j)  (1280 + 64 * (j))
#define XB_XGEN(j)  (2304 + 64 * (j))
#define XB_TOP      3328
#define XB_TOPGEN   3392
#define XCD_BAR_WORDS 3456
#define XB_SPIN_CAP (1u << 18)

__device__ __forceinline__ unsigned xb_ld(unsigned* p)              { return __hip_atomic_load(p, __ATOMIC_RELAXED, __HIP_MEMORY_SCOPE_AGENT); }
__device__ __forceinline__ unsigned xb_add(unsigned* p, unsigned v) { return __hip_atomic_fetch_add(p, v, __ATOMIC_RELAXED, __HIP_MEMORY_SCOPE_AGENT); }
__device__ __forceinline__ unsigned xb_xcc_id() { return (unsigned)__builtin_amdgcn_s_getreg((3 << 11) | 20) & 0xFu; }
#define XB_SPIN(cond, bar) do { unsigned _sp = 0; while (cond) { __builtin_amdgcn_s_sleep(1); \
    if ((++_sp & 255u) == 0u) { if (xb_ld(&(bar)[XB_TMO])) break; if (_sp > XB_SPIN_CAP) { atomicAdd(&(bar)[XB_TMO], 1u); break; } } } } while (0)

struct XcdBarrier {
    unsigned* bar; unsigned x;
    volatile LAS unsigned* st;
};

__device__ __forceinline__ XcdBarrier xcd_barrier_post(unsigned* bar, volatile LAS unsigned* st) {
    XcdBarrier b; b.bar = bar; b.x = xb_xcc_id(); b.st = st;
    if (threadIdx.x == 0) (void)xb_add(&bar[XB_XCNT(b.x)], 1u);
    return b;
}
__device__ __forceinline__ void xcd_barrier_complete(unsigned* bar, unsigned x, unsigned& nloc, unsigned& nx) {
    const unsigned G = gridDim.x * gridDim.y * gridDim.z;
    unsigned sum, cnt, mine, sp = 0u;
    for (;;) {
        sum = 0u; cnt = 0u; mine = 0u;
#pragma unroll
        for (unsigned j = 0; j < 16; ++j) { const unsigned c = xb_ld(&bar[XB_XCNT(j)]); sum += c; cnt += (c > 0u) ? 1u : 0u; mine = (j == x) ? c : mine; }
        if (sum == G) break;
        __builtin_amdgcn_s_sleep(1);
        if ((++sp & 255u) == 0u) { if (xb_ld(&bar[XB_TMO])) break; if (sp > XB_SPIN_CAP) { atomicAdd(&bar[XB_TMO], 1u); break; } }
    }
    nloc = mine > 0u ? mine : 1u; nx = cnt > 0u ? cnt : 1u;
}

__device__ __forceinline__ void xcd_barrier(const XcdBarrier& b) {
    asm volatile("s_waitcnt vmcnt(0)" ::: "memory");
    __syncthreads();
    if (threadIdx.x == 0) {
        unsigned* bar = b.bar;
        __builtin_amdgcn_s_waitcnt(0);
        unsigned nloc = b.st[0], nx = b.st[1];
        if (nloc == 0u) { xcd_barrier_complete(bar, b.x, nloc, nx); b.st[0] = nloc; b.st[1] = nx; }
        const unsigned old = xb_add(&bar[XB_XSUB(b.x)], 1u);
        const unsigned gen = old / nloc;
        if (old + 1u == (gen + 1u) * nloc) {
            __builtin_amdgcn_fence(__ATOMIC_RELEASE, "agent");
            asm volatile("s_waitcnt vmcnt(0)" ::: "memory");
            const unsigned og = xb_add(&bar[XB_TOP], 1u);
            const unsigned tg = og / nx;
            if (og + 1u == (tg + 1u) * nx) xb_add(&bar[XB_TOPGEN], 1u);
            else XB_SPIN(xb_ld(&bar[XB_TOPGEN]) == tg, bar);
            __builtin_amdgcn_fence(__ATOMIC_ACQUIRE, "agent");
            xb_add(&bar[XB_XGEN(b.x)], 1u);
            asm volatile("s_waitcnt vmcnt(0)" ::: "memory");
        } else {
            XB_SPIN(xb_ld(&bar[XB_XGEN(b.x)]) == gen, bar);
            __builtin_amdgcn_fence(__ATOMIC_ACQUIRE, "agent");
            asm volatile("s_waitcnt vmcnt(0)" ::: "memory");
        }
    }
    __syncthreads();
}

#ifndef MK_ALIGN
#define MK_ALIGN true
#endif
#ifndef MK_SP2
#define MK_SP2 true
#endif
#ifndef MK_SPLIT
#define MK_SPLIT 0
#endif
constexpr int NPL = 8, NPHASE = 1 + 2 * NPL + 1, PH_FINAL = NPHASE - 1;

typedef const __attribute__((address_space(4))) Args* KArgsP;
#define KARGS() ({ auto kp_ = __builtin_amdgcn_kernarg_segment_ptr(); asm volatile("" : "+s"(kp_)); (KArgsP)kp_; })
__global__ void __launch_bounds__(512, 2) fwd_kernel(Args a_unused, int ph_lo, int ph_hi) {
    (void)a_unused;
    extern __shared__ __attribute__((aligned(16))) unsigned char lds_raw[];
    LAS unsigned char* lds = (LAS unsigned char*)lds_raw;
    const int G = gridDim.x, bid = blockIdx.x;
#if MK_SPLIT
#define GRID_SYNC() do {} while (0)
    (void)lds;
#else
#define CG_SYNC() do { asm volatile("s_waitcnt vmcnt(0)" ::: "memory"); __syncthreads(); \
    if (threadIdx.x == 0) { __builtin_amdgcn_fence(__ATOMIC_RELEASE, "agent"); asm volatile("s_waitcnt vmcnt(0)" ::: "memory"); } \
    __syncthreads(); grid.sync(); \
    if (threadIdx.x == 0) { __builtin_amdgcn_fence(__ATOMIC_ACQUIRE, "agent"); asm volatile("s_waitcnt vmcnt(0)" ::: "memory"); } \
    __syncthreads(); } while (0)
    cg::grid_group grid = cg::this_grid();
    unsigned* barw = (unsigned*)(KARGS()->ws + WS_CTL);
    if (bid == 0) for (int i = threadIdx.x; i < XCD_BAR_WORDS; i += 512) __hip_atomic_store(barw + i, 0u, __ATOMIC_RELAXED, __HIP_MEMORY_SCOPE_AGENT);
    volatile LAS unsigned* xst = (volatile LAS unsigned*)(lds + LDS_BYTES - 64);
    if (threadIdx.x < 2) xst[threadIdx.x] = 0u;
    CG_SYNC();
    const XcdBarrier xbar = xcd_barrier_post(barw, xst);
#define GRID_SYNC() xcd_barrier(xbar)

#endif
#ifndef PHMASK
#define PHMASK 0xFFFFu
#endif
#define IN(k) (((PHMASK >> ((k) == 0 ? 0 : (k) == PH_FINAL ? 9 : 1 + ((k) - 1) % NPL)) & 1u) && ph_lo <= (k) && (k) < ph_hi)
#define SEAM(k) do { if (IN(k) && (k) + 1 < ph_hi) GRID_SYNC(); } while (0)
#define PHASE_BEGIN() KArgsP ka = KARGS(); unsigned char* ws = ka->ws; asm volatile("" : "+s"(ws)); float* rowss = (float*)(ws + WS_RS); float* Hm = (float*)(ws + WS_HM); bf16* HB = (bf16*)(ws + WS_HB); unsigned char* wl = ws + WS_W + (size_t)layer * LW_BYTES; \
    const int MT = NREAL; const bool META = layer != MK_NLAYER - 1;     \
    const float* rs_mix = rowss + (size_t)(2 * layer) * TPR * 16; float* rs_mlp = rowss + (size_t)(2 * layer + 1) * TPR * 16; float* rs_next = rowss + (size_t)(2 * layer + 2) * TPR * 16; (void)MT; (void)META; (void)Hm; (void)HB; (void)wl; (void)rs_mix; (void)rs_mlp; (void)rs_next;

    if (IN(0)) { Args al; { KArgsP kp = KARGS(); for (int i = 0; i < 23; ++i) al.in[i] = kp->in[i]; al.out = kp->out; al.ws = kp->ws; } p0_prologue(al, lds); }
    SEAM(0);
#ifndef MK_NLAYER
#define MK_NLAYER 2
#endif
#ifndef MK_RSIDX
#define MK_RSIDX 4
#endif
#pragma unroll 1
    for (int layer = 0; layer < MK_NLAYER; ++layer) {
        const int p = 1 + NPL * layer;
        if (IN(p)) { PHASE_BEGIN();
            pg8::Gemm g{HB, (const bf16*)(wl + OW_IN), TPR, NPROJ, DM}; pg8::StaticOrder S; S.init(TPR, NPROJ, G, bid);
            EpiInProj E{rs_mix, (const float*)(ws + WS_ROPE), (bf16*)(ws + WS_Q), (bf16*)(ws + WS_K), (bf16*)(ws + WS_V), (bf16*)(ws + WS_SU), (bf16*)(ws + WS_PU)};
            pg8::gemm_phase<EpiInProj, pg8::StaticOrder, MK_ALIGN, MK_SP2>(lds, g, S, E);
        }
        SEAM(p);
        if (IN(p + 1)) { PHASE_BEGIN();
            for (int t = bid; t < 256; t += G)
                ssm_task(lds, t, layer, (const bf16*)(ws + WS_SU), (float*)(ws + WS_YF), (const float*)(ws + WS_ABAR), (const bf16*)(ws + WS_BMAT), (const bf16*)(ws + WS_CMAT));
            for (int t = bid; t < NB * 2 * 33; t += G)
                attn_task(lds, t, (const bf16*)(ws + WS_Q), (const bf16*)(ws + WS_K), (const bf16*)(ws + WS_V), (bf16*)(ws + WS_YA), ka->in[4] + layer * 8);
            pool_diff(lds, (const bf16*)(ws + WS_PU), (bf16*)(ws + WS_PD));
        }
        SEAM(p + 1);
        if (IN(p + 2)) { PHASE_BEGIN();
            z_pass((const float*)(ws + WS_YF), (const bf16*)(ws + WS_SU), ka->in[12] + layer * 512, (bf16*)(ws + WS_Z));
        }
        SEAM(p + 2);
        if (IN(p + 3)) { PHASE_BEGIN();
            const int hg = G >> 1;
            if (bid < hg) { pg8::Gemm g{(const bf16*)(ws + WS_Z), (const bf16*)(wl + OW_GLU), MT, 512, 512}; pg8::StaticOrder S; S.init(MT, 512, hg, bid);
              EpiGlu E{(const bf16*)(ws + WS_Z), ka->in[14] + layer * 512, (bf16*)(ws + WS_YS)};
              pg8::gemm_phase<EpiGlu, pg8::StaticOrder, MK_ALIGN, MK_SP2>(lds, g, S, E); if (META) thin_gemm<EpiGlu>(lds, g.A, g.Bt, g.K, g.N, E, bid, hg); }
            else { pg8::Gemm g{(const bf16*)(ws + WS_PD), (const bf16*)(wl + OW_POOL), MT, 512, 512}; pg8::StaticOrder S; S.init(MT, 512, G - hg, bid - hg);
              EpiScale E{(bf16*)(ws + WS_YP), 512, ka->in[16] + layer * 512};
              pg8::gemm_phase<EpiScale, pg8::StaticOrder, MK_ALIGN, MK_SP2>(lds, g, S, E); if (META) thin_gemm<EpiScale>(lds, g.A, g.Bt, g.K, g.N, E, bid - hg, G - hg); }
        }
        SEAM(p + 3);
        if (IN(p + 4)) { PHASE_BEGIN();
#pragma unroll 1
            for (int c = 0; c < 3; ++c) {
                const bf16* Yc = (const bf16*)(ws + (c == 0 ? WS_YA : c == 1 ? WS_YS : WS_YP));
                { pg8::Gemm g{Yc, (const bf16*)(wl + OW_BR) + (size_t)c * 1024 * 512, MT, 1024, 512}; pg8::StaticOrder S; S.init(MT, 1024, G, bid);
                  EpiScale E{(bf16*)(ws + WS_BR), 1024, nullptr};
                  pg8::gemm_phase<EpiScale, pg8::StaticOrder, MK_ALIGN, MK_SP2>(lds, g, S, E); if (META) thin_gemm<EpiScale>(lds, g.A, g.Bt, g.K, g.N, E, bid, G); }
                pg8::Gemm g{HB, (const bf16*)(wl + OW_IN) + (size_t)(NPROJ + c * 1024) * DM, MT, 1024, DM}; pg8::StaticOrder S; S.init(MT, 1024, G, bid);
                if (c == 0) { EpiGate<true> E{rs_mix, (const bf16*)(ws + WS_BR), (bf16*)(ws + WS_MG)}; pg8::gemm_phase<EpiGate<true>, pg8::StaticOrder, MK_ALIGN, MK_SP2>(lds, g, S, E); if (META) thin_gemm<EpiGate<true>>(lds, g.A, g.Bt, g.K, g.N, E, bid, G); }
                else { EpiGate<false> E{rs_mix, (const bf16*)(ws + WS_BR), (bf16*)(ws + WS_MG)}; pg8::gemm_phase<EpiGate<false>, pg8::StaticOrder, MK_ALIGN, MK_SP2>(lds, g, S, E); if (META) thin_gemm<EpiGate<false>>(lds, g.A, g.Bt, g.K, g.N, E, bid, G); }
            }
        }
        SEAM(p + 4);
        if (IN(p + 5)) { PHASE_BEGIN();
            pg8::Gemm g{(const bf16*)(ws + WS_MG), (const bf16*)(wl + OW_OUT), MT, DM, DM}; pg8::StaticOrder S; S.init(MT, DM, G, bid);
            EpiRes E{ka->out, Hm, HB, rs_mlp, layer == 0 ? ka->in[0] : (const float*)ka->out};
            pg8::gemm_phase<EpiRes, pg8::StaticOrder, MK_ALIGN, MK_SP2>(lds, g, S, E); if (META) thin_gemm<EpiRes>(lds, g.A, g.Bt, g.K, g.N, E, bid, G);
        }
        SEAM(p + 5);
        if (IN(p + 6)) { PHASE_BEGIN();
            pg8::Gemm g{HB, (const bf16*)(wl + OW_UP), MT, FF, DM}; pg8::StaticOrder S; S.init(MT, FF, G, bid);
            EpiUp E{rs_mlp, (bf16*)(ws + WS_ACT)};
            pg8::gemm_phase<EpiUp, pg8::StaticOrder, MK_ALIGN, MK_SP2>(lds, g, S, E); if (META) thin_gemm<EpiUp>(lds, g.A, g.Bt, g.K, g.N, E, bid, G);
        }
        SEAM(p + 6);
        if (IN(p + 7)) { PHASE_BEGIN();
            pg8::Gemm g{(const bf16*)(ws + WS_ACT), (const bf16*)(wl + OW_DN), MT, DM, FF}; pg8::StaticOrder S; S.init(MT, DM, G, bid);
            EpiRes E{ka->out, Hm, HB, rs_next, (const float*)ka->out};
            pg8::gemm_phase<EpiRes, pg8::StaticOrder, MK_ALIGN, MK_SP2>(lds, g, S, E); if (META) thin_gemm<EpiRes>(lds, g.A, g.Bt, g.K, g.N, E, bid, G);
        }
        SEAM(p + 7);
    }
#ifdef MK_DUMP_OFF
    if (IN(PH_FINAL)) { KArgsP ka = KARGS();
        const bf16* src = (const bf16*)(ka->ws + (MK_DUMP_OFF)); const bf16* src2 = (const bf16*)(ka->ws + (MK_DUMP_OFF2));
        for (int i = bid * 512 + threadIdx.x; i < NREAL * 1024; i += G * 512) { const int R = MK_DUMP_ROW(i >> 10), c = i & 1023; ka->out[i] = c < 512 ? bf2f(src[(size_t)R * (MK_DUMP_LD) + (c % (MK_DUMP_LD))]) : bf2f(src2[(size_t)R * (MK_DUMP_LD2) + (c % (MK_DUMP_LD2))]); }
    }
#else
    if (IN(PH_FINAL)) { KArgsP ka = KARGS();
        const float* rs = (const float*)(ka->ws + WS_RS) + (size_t)MK_RSIDX * TPR * 16; const float* gain = ka->in[22];
        int tl_ = threadIdx.x; asm volatile("" : "+v"(tl_));
        for (int i = bid * 512 + tl_; i < NREAL * 256; i += G * 512) {
            const int R = i >> 8, c4 = (i & 255) * 4;
            const float r = row_rstd(rs, R);
            f32x4 v = *(const f32x4*)(ka->out + (size_t)R * DM + c4); const f32x4 gn = *(const f32x4*)(gain + c4);
            v = v * r * gn;
            *(f32x4*)(ka->out + (size_t)R * DM + c4) = v;
        }
    }
#endif
#undef IN
#undef SEAM
}

extern "C" void kernel_launch(void* const* d_in, const int* in_sizes, int n_in, void* d_out, int out_size, void* d_ws, size_t ws_size, hipStream_t stream) {
    static int grid = 0;
    if (grid == 0) {
        if (n_in != 23 || out_size != NREAL * DM || ws_size < WS_END) { fprintf(stderr, "kernel_launch: unexpected shapes (n_in %d out %d ws %zu)\n", n_in, out_size, ws_size); grid = -1; return; }
        int dev = 0, cus = 0, per_cu = 0;
        hipGetDevice(&dev); hipDeviceGetAttribute(&cus, hipDeviceAttributeMultiprocessorCount, dev);
        if (hipFuncSetAttribute((const void*)fwd_kernel, hipFuncAttributeMaxDynamicSharedMemorySize, LDS_BYTES) != hipSuccess) { fprintf(stderr, "kernel_launch: hipFuncSetAttribute failed\n"); grid = -1; return; }
        if (hipOccupancyMaxActiveBlocksPerMultiprocessor(&per_cu, (const void*)fwd_kernel, 512, LDS_BYTES) != hipSuccess || per_cu < 1) { fprintf(stderr, "kernel_launch: occupancy query gave %d\n", per_cu); per_cu = 1; }
        (void)hipGetLastError();
        grid = cus * (per_cu > 1 ? 1 : per_cu);
        if (grid <= 0) grid = 256;
    }
    if (grid < 0) return;
    Args a{};
    for (int i = 0; i < 23; ++i) a.in[i] = (const float*)d_in[i];
    a.out = (float*)d_out; a.ws = (unsigned char*)d_ws;
#if MK_SPLIT
    for (int ph = 0; ph < NPHASE; ++ph) hipLaunchKernelGGL(fwd_kernel, dim3(grid), dim3(512), LDS_BYTES, stream, a, ph, ph + 1);
#else
    int lo = 0, hi = NPHASE;
    void* kargs[] = {(void*)&a, (void*)&lo, (void*)&hi};
    hipError_t e = hipLaunchCooperativeKernel((const void*)fwd_kernel, dim3(grid), dim3(512), kargs, LDS_BYTES, stream);
    if (e != hipSuccess) fprintf(stderr, "kernel_launch: cooperative launch failed: %s (grid %d)\n", hipGetErrorString(e), grid);
#endif
}
```

```cpp
#include <hip/hip_runtime.h>
#include <hip/hip_cooperative_groups.h>
#include <cstdio>
#include <cstdint>
namespace cg = cooperative_groups;
namespace pg8 {
#define PG8_LAS __attribute__((address_space(3)))
typedef unsigned short bf16_t;
typedef short bf16x8 __attribute__((ext_vector_type(8)));
typedef float f32x4 __attribute__((ext_vector_type(4)));
typedef unsigned u32x4 __attribute__((ext_vector_type(4)));
constexpr int BM = 256, BK = 64, HALF = 128, HTB = HALF * BK * 2  , STAGE_BYTES = 8 * HTB, NXCD = 8, WGM = 8;

__host__ __device__ __forceinline__ int lds_byte(int r, int c) { const int st = (r >> 4) * 2 + (c >> 5), rr = r & 15, cc = c & 31, ob = rr * 64 + cc * 2; return st * 1024 + (ob ^ (((ob >> 9) & 1) << 5)); }
__host__ __device__ __forceinline__ void stage_rc(int b, int& R, int& C) { const int st = b / 1024, sb = b % 1024, swz = sb ^ (((sb >> 9) & 1) << 5); R = (st >> 1) * 16 + swz / 64; C = (st & 1) * 32 + (swz % 64) / 2; }
__host__ __device__ __forceinline__ int perm32(int rho) { const int n = rho >> 4, i = rho & 15; return 8 * (i >> 2) + 4 * n + (i & 3); }

struct Unit { int pm, pn; };
struct Gemm { const bf16_t* A; const bf16_t* Bt; int M, N, K; };

struct StaticOrder {
    int nM, nN, nwg, G, c;
    __host__ __device__ void init(int M, int N, int G_, int c_) { nM = M / BM; nN = N / BM; nwg = nM * nN; G = G_; c = c_; }
    __host__ __device__ bool next(int i, Unit& u) const {
        const long L = (long)i * G + c; if (L >= nwg) return false;
        int wgid = (int)L; { const int q = nwg / NXCD, r = nwg % NXCD, xcd = wgid % NXCD, off = wgid / NXCD; wgid = (xcd < r ? xcd * (q + 1) : r * (q + 1) + (xcd - r) * q) + off; }
        const int nig = WGM * nN, gid = wgid / nig, fm = gid * WGM, gsz = (nM - fm) < WGM ? (nM - fm) : WGM;
        u.pm = fm + ((wgid % nig) % gsz); u.pn = (wgid % nig) / gsz; return true;
    }
    __device__ __forceinline__ void a_ready(const Unit&) const {}
    __device__ __forceinline__ void done(const Unit&) const {}
};

__device__ __forceinline__ unsigned cvt_pk_bf16(float lo, float hi) { unsigned r; asm volatile("v_cvt_pk_bf16_f32 %0, %1, %2" : "=v"(r) : "v"(lo), "v"(hi)); return r; }
template <class Epi, class Sched, bool ALIGN_EPI = false, bool SP2 = false>
__device__ __forceinline__ void gemm_phase(PG8_LAS unsigned char* lds, const Gemm g, const Sched& S, const Epi& E) {
    int tid_l = threadIdx.x; asm volatile("" : "+v"(tid_l));
    const int tid = tid_l, wid = __builtin_amdgcn_readfirstlane(tid >> 6), lane = tid & 63, wr = wid >> 2, wc = wid & 3, fr = lane & 15, fq = lane >> 4;
    const int K = g.K, nt = K / BK;
    unsigned voffA[2], voffB[2];
#pragma unroll
    for (int i = 0; i < 2; ++i) { int R, C; stage_rc(tid * 16 + i * 8192, R, C); const int Rb = Epi::PERM ? ((R & ~31) + perm32(R & 31)) : R;
        voffA[i] = (unsigned)(R * K + C) * 2u; voffB[i] = (unsigned)(Rb * K + C) * 2u; }
    const size_t kstep = (size_t)(BK * 2);
    const size_t hstep = (size_t)HALF * K * 2;
    const size_t tstep = 2 * hstep;
    const unsigned ldsw = (unsigned)wid * 1024u;
    const int aoff = lds_byte(wr * 64 + fr, fq * 8), boff = lds_byte(wc * 32 + fr, fq * 8);
#define PG8_SA(b, h) (((b) * 2 + (h)) * HTB)
#define PG8_SB(b, h) ((4 + (b) * 2 + (h)) * HTB)
#define PG8_STAGE(bufoff, gbase, voff) do { _Pragma("unroll") for (int _i = 0; _i < 2; ++_i) \
        __builtin_amdgcn_global_load_lds((const unsigned*)((const char*)(gbase) + (voff)[_i]), (PG8_LAS unsigned*)(lds + (bufoff) + ldsw + _i * 8192), 16, 0, 0); } while (0)
#define PG8_LDA(dst, b, h) do { _Pragma("unroll") for (int m = 0; m < 4; ++m) _Pragma("unroll") for (int k = 0; k < 2; ++k) dst[m][k] = *(const PG8_LAS bf16x8*)(lds + PG8_SA(b, h) + aoff + m * 2048 + k * 1024); } while (0)
#define PG8_LDB(dst, b, h) do { _Pragma("unroll") for (int n = 0; n < 2; ++n) _Pragma("unroll") for (int k = 0; k < 2; ++k) dst[n][k] = *(const PG8_LAS bf16x8*)(lds + PG8_SB(b, h) + boff + n * 2048 + k * 1024); } while (0)
#define PG8_MMA(ai, bj, At, Bt) do { __builtin_amdgcn_s_setprio(1); _Pragma("unroll") for (int m = 0; m < 4; ++m) _Pragma("unroll") for (int n = 0; n < 2; ++n) _Pragma("unroll") for (int k = 0; k < 2; ++k) \
        acc[ai][bj][m][n] = __builtin_amdgcn_mfma_f32_16x16x32_bf16(Bt[n][k], At[m][k], acc[ai][bj][m][n], 0, 0, 0); __builtin_amdgcn_s_setprio(0); } while (0)
#define PG8_WAIT_V(n) asm volatile("s_waitcnt vmcnt(" #n ")" ::: "memory")
#define PG8_WAIT_L(n) asm volatile("s_waitcnt lgkmcnt(" #n ")" ::: "memory")
#define PG8_BAR __builtin_amdgcn_s_barrier()
#define PG8_SCHED __builtin_amdgcn_sched_barrier(0)
    Unit cur, nxt; int ui = 0;
    if (!S.next(0, cur)) return;
    f32x4 acc[2][2][4][2];
#pragma unroll
    for (int a = 0; a < 2; ++a)
#pragma unroll
        for (int b = 0; b < 2; ++b)
#pragma unroll
            for (int m = 0; m < 4; ++m)
#pragma unroll
                for (int n = 0; n < 2; ++n) acc[a][b][m][n] = (f32x4){0.f, 0.f, 0.f, 0.f};
    bf16x8 At[4][2], B0[2][2], B1[2][2];
    const char* cA = (const char*)g.A + (size_t)cur.pm * tstep; const char* cB = (const char*)g.Bt + (size_t)cur.pn * tstep;
    S.a_ready(cur);
    if constexpr (SP2) {
        PG8_STAGE(PG8_SB(0, 0), cB, voffB); PG8_STAGE(PG8_SB(0, 1), cB + hstep, voffB); PG8_STAGE(PG8_SA(0, 0), cA, voffA); PG8_STAGE(PG8_SA(0, 1), cA + hstep, voffA);
        if (wr == 1) PG8_BAR;
        PG8_WAIT_V(2); PG8_BAR;
        PG8_STAGE(PG8_SB(1, 0), cB + kstep, voffB); PG8_STAGE(PG8_SA(1, 0), cA + kstep, voffA); PG8_STAGE(PG8_SB(1, 1), cB + hstep + kstep, voffB);
        PG8_WAIT_V(6); PG8_BAR;
    } else {
        PG8_STAGE(PG8_SB(0, 0), cB, voffB); PG8_STAGE(PG8_SA(0, 0), cA, voffA); PG8_STAGE(PG8_SB(0, 1), cB + hstep, voffB); PG8_STAGE(PG8_SA(0, 1), cA + hstep, voffA);
        if (wr == 1) PG8_BAR;
        PG8_WAIT_V(4); PG8_BAR;
        PG8_STAGE(PG8_SB(1, 0), cB + kstep, voffB); PG8_STAGE(PG8_SA(1, 0), cA + kstep, voffA); PG8_STAGE(PG8_SB(1, 1), cB + hstep + kstep, voffB);
        PG8_WAIT_V(6); PG8_BAR;
    }
    for (;;) {
        const bool has_next = S.next(ui + 1, nxt);
        const char* nA = has_next ? (const char*)g.A + (size_t)nxt.pm * tstep : cA; const char* nB = has_next ? (const char*)g.Bt + (size_t)nxt.pn * tstep : cB;
        for (int t = 0; t < nt; t += 2) {
            const bool last = (t == nt - 2);
            const char* a1 = cA + (size_t)(t + 1) * kstep;
            const char* a2 = last ? nA : cA + (size_t)(t + 2) * kstep; const char* b2 = last ? nB : cB + (size_t)(t + 2) * kstep;
            const char* a3 = a2 + kstep; const char* b3 = b2 + kstep;
            if (last && has_next) S.a_ready(nxt);
            if constexpr (SP2) {
            PG8_LDB(B0, 0, 0); PG8_LDB(B1, 0, 1); PG8_SCHED; PG8_LDA(At, 0, 0); PG8_STAGE(PG8_SA(1, 1), a1 + hstep, voffA);
            PG8_WAIT_V(8); PG8_WAIT_L(0); PG8_BAR; PG8_MMA(0, 0, At, B0); PG8_MMA(0, 1, At, B1); PG8_BAR; PG8_SCHED;
            PG8_LDA(At, 0, 1); PG8_STAGE(PG8_SB(0, 0), b2, voffB); PG8_STAGE(PG8_SB(0, 1), b2 + hstep, voffB); PG8_STAGE(PG8_SA(0, 0), a2, voffA);
            PG8_WAIT_V(8); PG8_WAIT_L(0); PG8_BAR; PG8_MMA(1, 0, At, B0); PG8_MMA(1, 1, At, B1); PG8_BAR; PG8_SCHED;
            PG8_LDB(B0, 1, 0); PG8_LDB(B1, 1, 1); PG8_SCHED; PG8_LDA(At, 1, 0); PG8_STAGE(PG8_SA(0, 1), a2 + hstep, voffA);
            PG8_WAIT_V(8); PG8_WAIT_L(0); PG8_BAR; PG8_MMA(0, 0, At, B0); PG8_MMA(0, 1, At, B1); PG8_BAR; PG8_SCHED;
            PG8_LDA(At, 1, 1); PG8_STAGE(PG8_SB(1, 0), b3, voffB); PG8_STAGE(PG8_SB(1, 1), b3 + hstep, voffB); PG8_STAGE(PG8_SA(1, 0), a3, voffA);
            PG8_WAIT_V(8); PG8_WAIT_L(0); PG8_BAR; PG8_MMA(1, 0, At, B0); PG8_MMA(1, 1, At, B1); PG8_BAR; PG8_SCHED;
            } else {
            PG8_LDB(B0, 0, 0); PG8_SCHED; PG8_LDA(At, 0, 0); PG8_STAGE(PG8_SA(1, 1), a1 + hstep, voffA);
            PG8_WAIT_L(8); PG8_BAR; PG8_WAIT_L(0); PG8_MMA(0, 0, At, B0); PG8_BAR; PG8_SCHED;
            PG8_LDB(B1, 0, 1); PG8_STAGE(PG8_SB(0, 0), b2, voffB);
            PG8_BAR; PG8_WAIT_L(0); PG8_MMA(0, 1, At, B1); PG8_BAR;
            PG8_LDA(At, 0, 1); PG8_STAGE(PG8_SA(0, 0), a2, voffA);
            PG8_BAR; PG8_WAIT_L(0); PG8_MMA(1, 0, At, B0); PG8_BAR; PG8_SCHED;
            PG8_STAGE(PG8_SB(0, 1), b2 + hstep, voffB);
            PG8_WAIT_V(6); PG8_BAR; PG8_MMA(1, 1, At, B1); PG8_BAR;
            PG8_LDB(B0, 1, 0); PG8_SCHED; PG8_LDA(At, 1, 0); PG8_STAGE(PG8_SA(0, 1), a2 + hstep, voffA);
            PG8_WAIT_L(8); PG8_BAR; PG8_WAIT_L(0); PG8_MMA(0, 0, At, B0); PG8_BAR; PG8_SCHED;
            PG8_LDB(B1, 1, 1); PG8_STAGE(PG8_SB(1, 0), b3, voffB);
            PG8_BAR; PG8_WAIT_L(0); PG8_MMA(0, 1, At, B1); PG8_BAR;
            PG8_LDA(At, 1, 1); PG8_STAGE(PG8_SA(1, 0), a3, voffA);
            PG8_BAR; PG8_WAIT_L(0); PG8_MMA(1, 0, At, B0); PG8_BAR; PG8_SCHED;
            PG8_STAGE(PG8_SB(1, 1), b3 + hstep, voffB);
            PG8_WAIT_V(6); PG8_BAR; PG8_MMA(1, 1, At, B1); PG8_BAR;
            }
        }
        if constexpr (ALIGN_EPI) { if (wr == 0) PG8_BAR; }
        asm volatile("s_nop 15\n\ts_nop 15" ::: "memory");
        if constexpr (!Epi::AFTER_DRAIN) { E(acc, cur, wr, wc, fr, fq); S.done(cur); }
        if (!has_next) break;
#pragma unroll
        for (int a = 0; a < 2; ++a)
#pragma unroll
            for (int b = 0; b < 2; ++b)
#pragma unroll
                for (int m = 0; m < 4; ++m)
#pragma unroll
                    for (int n = 0; n < 2; ++n) acc[a][b][m][n] = (f32x4){0.f, 0.f, 0.f, 0.f};
        cur = nxt; cA = nA; cB = nB; ++ui;
        if constexpr (ALIGN_EPI) { if (wr == 1) PG8_BAR; }
    }
    PG8_WAIT_V(0);
    if constexpr (!ALIGN_EPI) { if (wr == 0) PG8_BAR; }
    PG8_BAR;
    if constexpr (Epi::AFTER_DRAIN) { E.fused(acc, cur, wr, wc, fr, fq, lds, wid, lane); S.done(cur); }
#undef PG8_SA
#undef PG8_SB
#undef PG8_STAGE
#undef PG8_LDA
#undef PG8_LDB
#undef PG8_MMA
#undef PG8_WAIT_V
#undef PG8_WAIT_L
#undef PG8_BAR
#undef PG8_SCHED
}
}

#define LAS __attribute__((address_space(3)))
typedef unsigned short bf16;
typedef short bf16x8 __attribute__((ext_vector_type(8)));
typedef float f32x4 __attribute__((ext_vector_type(4)));
typedef float f32x16 __attribute__((ext_vector_type(16)));
typedef unsigned u32x2 __attribute__((ext_vector_type(2)));
typedef unsigned u32x4 __attribute__((ext_vector_type(4)));

constexpr int NB = 8, SEQ = 2048, NMETA = 16, LL = 2064, DM = 1024, FF = 4096, DIN = 4864, NPROJ = 1792;
constexpr int NREAL = NB * SEQ;
constexpr int TPR = NREAL + 256;
constexpr int LDS_BYTES = 147456;

constexpr size_t MiB = 1u << 20;
constexpr size_t WS_CTL = 0;
constexpr size_t WS_ROPE = 1 * MiB;
constexpr size_t WS_ABAR = 2 * MiB;
constexpr size_t WS_BMAT = 2 * MiB + 65536;
constexpr size_t WS_CMAT = WS_BMAT + 524288;
constexpr size_t WS_HM = 4 * MiB;
constexpr size_t WS_W = 5 * MiB;
constexpr size_t OW_IN = 0, OW_GLU = (size_t)DIN * DM * 2, OW_POOL = OW_GLU + 512 * 512 * 2, OW_BR = OW_POOL + 512 * 512 * 2,
                 OW_OUT = OW_BR + 3 * 1024 * 512 * 2, OW_UP = OW_OUT + 1024 * 1024 * 2, OW_DN = OW_UP + (size_t)FF * DM * 2, LW_BYTES = OW_DN + (size_t)FF * DM * 2;
constexpr size_t WS_HB = 68 * MiB;
constexpr size_t WS_X = 101 * MiB;
constexpr size_t UU = (size_t)TPR * 512 * 2;
constexpr size_t WS_YF = WS_X, WS_YP = WS_X, WS_Q = WS_X + 2 * UU, WS_K = WS_Q + UU, WS_V = WS_K + UU / 4, WS_MG = WS_X + 2 * UU,
                 WS_SU = WS_X + 4 * UU, WS_YA = WS_X + 8 * UU  , WS_PU = WS_X + 5 * UU, WS_YS = WS_PU, WS_Z = WS_X + 6 * UU, WS_PD = WS_X + 7 * UU, WS_BR = WS_Z, WS_ACT = WS_X;
constexpr size_t WS_RS = WS_X + 9 * UU;
constexpr size_t WS_END = WS_RS + (size_t)5 * TPR * 16 * 4;
static_assert(WS_W + 2 * LW_BYTES <= WS_HB && WS_HB + (size_t)TPR * 1024 * 2 <= WS_X && WS_END <= 256 * MiB, "ws map");
static_assert((size_t)256 * 2064 * 16 * 4 <= 2 * UU, "YF fits");

__device__ __forceinline__ unsigned pk2(float lo, float hi) { unsigned r; asm("v_cvt_pk_bf16_f32 %0, %1, %2" : "=v"(r) : "v"(lo), "v"(hi)); return r; }
__device__ __forceinline__ unsigned f2bf(float f) { return pk2(f, 0.f) & 0xffffu; }
__device__ __forceinline__ float bf2f(unsigned b) { return __uint_as_float(b << 16); }
__device__ __forceinline__ int tok_row(int b, int l) { return l >= NMETA ? b * SEQ + l - NMETA : NREAL + b * NMETA + l; }
#define LDS_FENCE() asm volatile("s_waitcnt lgkmcnt(0)" ::: "memory")
#define SSM_SYNC() do { asm volatile("s_waitcnt vmcnt(0) lgkmcnt(0)" ::: "memory"); __syncthreads(); } while (0)
__device__ __forceinline__ float row_rstd(const float* rs, int R) {
    const f32x4 a = *(const f32x4*)(rs + (size_t)R * 4), b = *(const f32x4*)(rs + ((size_t)TPR + R) * 4), c = *(const f32x4*)(rs + ((size_t)2 * TPR + R) * 4), d = *(const f32x4*)(rs + ((size_t)3 * TPR + R) * 4);
    const float s = (((a[0] + a[1]) + (a[2] + a[3])) + ((b[0] + b[1]) + (b[2] + b[3]))) + (((c[0] + c[1]) + (c[2] + c[3])) + ((d[0] + d[1]) + (d[2] + d[3])));
    return rsqrtf(s * (1.0f / 1024.0f) + 1e-6f);
}

__device__ __forceinline__ void dsincos(double a, double& s, double& c) {
    const double q = rint(a * 0.63661977236758134308);
    double r = fma(-q, 1.57079632679489655800e+00, a); r = fma(-q, 6.12323399573676603587e-17, r);
    const double r2 = r * r;
    double sp = -7.6471637318198164759e-13; sp = fma(sp, r2, 1.6059043836821614599e-10); sp = fma(sp, r2, -2.5052108385441718775e-08); sp = fma(sp, r2, 2.7557319223985890653e-06);
    sp = fma(sp, r2, -1.9841269841269841270e-04); sp = fma(sp, r2, 8.3333333333333333333e-03); sp = fma(sp, r2, -1.6666666666666666667e-01); sp = fma(sp * r2, r, r);
    double cp = 4.7794773323873852974e-14; cp = fma(cp, r2, -1.1470745597729724714e-11); cp = fma(cp, r2, 2.0876756987868098979e-09); cp = fma(cp, r2, -2.7557319223985890653e-07);
    cp = fma(cp, r2, 2.4801587301587301587e-05); cp = fma(cp, r2, -1.3888888888888888889e-03); cp = fma(cp, r2, 4.1666666666666666667e-02); cp = fma(cp, r2, -0.5); cp = fma(cp, r2, 1.0);
    const int qi = ((int)q) & 3;
    s = (qi == 0) ? sp : (qi == 1) ? cp : (qi == 2) ? -sp : -cp;
    c = (qi == 0) ? cp : (qi == 1) ? -sp : (qi == 2) ? -cp : sp;
}
__device__ __forceinline__ double dexp(double x) {
    const double k = rint(x * 1.44269504088896340736);
    double r = fma(-k, 6.93147180369123816490e-01, x); r = fma(-k, 1.90821492927058770002e-10, r);
    double p = 1.0 / 6227020800.0; p = fma(p, r, 1.0 / 479001600.0); p = fma(p, r, 1.0 / 39916800.0); p = fma(p, r, 1.0 / 3628800.0); p = fma(p, r, 1.0 / 362880.0); p = fma(p, r, 1.0 / 40320.0);
    p = fma(p, r, 1.0 / 5040.0); p = fma(p, r, 1.0 / 720.0); p = fma(p, r, 1.0 / 120.0); p = fma(p, r, 1.0 / 24.0); p = fma(p, r, 1.0 / 6.0); p = fma(p, r, 0.5); p = fma(p, r, 1.0); p = fma(p, r, 1.0);
    const long long bits = ((long long)(1023 + (int)k)) << 52;
    return p * __longlong_as_double(bits);
}

struct EpiInProj {
    static constexpr bool PERM = true, AFTER_DRAIN = false;
    const float* rowss; const float* rope; bf16 *Q, *K, *V, *SU, *PU;
    __device__ __forceinline__ u32x2 quad(int l, int c, const f32x4& v) const {
        u32x2 w;
        if (c < 640) {
            const int i0 = (c & 63) >> 1;
            const f32x4 cs = *(const f32x4*)(rope + ((size_t)l * 32 + i0) * 2);
            float o0 = v[0] * cs[0] - v[1] * cs[1], o1 = v[1] * cs[0] + v[0] * cs[1], o2 = v[2] * cs[2] - v[3] * cs[3], o3 = v[3] * cs[2] + v[2] * cs[3];
            if (c < 512) { o0 *= 0.125f; o1 *= 0.125f; o2 *= 0.125f; o3 *= 0.125f; }
            w.x = pk2(o0, o1); w.y = pk2(o2, o3);
        } else { w.x = pk2(v[0], v[1]); w.y = pk2(v[2], v[3]); }
        return w;
    }
    __device__ __forceinline__ void operator()(const f32x4 (&acc)[2][2][4][2], const pg8::Unit& u, int wr, int wc, int fr, int fq) const {
#pragma unroll
        for (int ai = 0; ai < 2; ++ai)
#pragma unroll
            for (int m = 0; m < 4; ++m) {
                const int R = u.pm * 256 + ai * 128 + wr * 64 + m * 16 + fr;
                const float rs = row_rstd(rowss, R);
                const int l = R < NREAL ? (R & 2047) + NMETA : (R & 15);
#pragma unroll
                for (int bj = 0; bj < 2; ++bj) {
                    const int c = u.pn * 256 + bj * 128 + wc * 32 + 8 * fq;
                    const u32x2 w0 = quad(l, c, acc[ai][bj][m][0] * rs), w1 = quad(l, c + 4, acc[ai][bj][m][1] * rs);
                    u32x4 w; w.x = w0.x; w.y = w0.y; w.z = w1.x; w.w = w1.y;
                    bf16* dst = c < 512 ? Q + (size_t)R * 512 + c : c < 640 ? K + (size_t)R * 128 + (c - 512) : c < 768 ? V + (size_t)R * 128 + (c - 640)
                              : c < 1280 ? SU + (size_t)R * 512 + (c - 768) : PU + (size_t)R * 512 + (c - 1280);
                    *(u32x4*)dst = w;
                }
            }
    }
};
#define EPI_BODY() \
    __device__ __forceinline__ void rg(int R, int pn, int wc, int fq, const f32x4 (&a4)[2][2]) const { \
        _Pragma("unroll") for (int bj = 0; bj < 2; ++bj) q2(R, pn * 256 + bj * 128 + wc * 32 + 8 * fq, a4[bj][0], a4[bj][1]); } \
    __device__ __forceinline__ void tq(int R, int c, const f32x4& v) const { q(R, c, v); } \
    EPI_OP()
#define EPI_OP() \
    __device__ __forceinline__ void operator()(const f32x4 (&acc)[2][2][4][2], const pg8::Unit& u, int wr, int wc, int fr, int fq) const { \
        _Pragma("unroll") for (int ai = 0; ai < 2; ++ai) _Pragma("unroll") for (int m = 0; m < 4; ++m) { \
            const f32x4 a4[2][2] = {{acc[ai][0][m][0], acc[ai][0][m][1]}, {acc[ai][1][m][0], acc[ai][1][m][1]}}; \
            rg(u.pm * 256 + ai * 128 + wr * 64 + m * 16 + fr, u.pn, wc, fq, a4); } }
#define EPI_BODY_RS() \
    __device__ __forceinline__ void rg(int R, int pn, int wc, int fq, const f32x4 (&a4)[2][2]) const { const float rs = row_rstd(rowss, R); \
        _Pragma("unroll") for (int bj = 0; bj < 2; ++bj) q2(R, pn * 256 + bj * 128 + wc * 32 + 8 * fq, a4[bj][0], a4[bj][1], rs); } \
    __device__ __forceinline__ void tq(int R, int c, const f32x4& v) const { q(R, c, v, row_rstd(rowss, R)); } \
    EPI_OP()
struct EpiGlu {
    static constexpr bool PERM = true, AFTER_DRAIN = false;
    const bf16* Z; const float* bias; bf16* YS;
    __device__ __forceinline__ void q(int R, int c, const f32x4& a) const {
        const f32x4 v = a + *(const f32x4*)(bias + c);
        const u32x2 zz = *(const u32x2*)(Z + (size_t)R * 512 + c);
        const float z0 = bf2f(zz.x & 0xffffu), z1 = bf2f(zz.x >> 16), z2 = bf2f(zz.y & 0xffffu), z3 = bf2f(zz.y >> 16);
        u32x2 w; w.x = pk2(z0 * __builtin_amdgcn_rcpf(1.0f + __expf(-v[0])), z1 * __builtin_amdgcn_rcpf(1.0f + __expf(-v[1]))); w.y = pk2(z2 * __builtin_amdgcn_rcpf(1.0f + __expf(-v[2])), z3 * __builtin_amdgcn_rcpf(1.0f + __expf(-v[3])));
        *(u32x2*)(YS + (size_t)R * 512 + c) = w;
    }
    __device__ __forceinline__ void q2(int R, int c, const f32x4& a0, const f32x4& a1) const {
        const f32x4 v0 = a0 + *(const f32x4*)(bias + c), v1 = a1 + *(const f32x4*)(bias + c + 4);
        const u32x4 zz = *(const u32x4*)(Z + (size_t)R * 512 + c);
        u32x4 w;
        w.x = pk2(bf2f(zz.x & 0xffffu) * __builtin_amdgcn_rcpf(1.0f + __expf(-v0[0])), bf2f(zz.x >> 16) * __builtin_amdgcn_rcpf(1.0f + __expf(-v0[1])));
        w.y = pk2(bf2f(zz.y & 0xffffu) * __builtin_amdgcn_rcpf(1.0f + __expf(-v0[2])), bf2f(zz.y >> 16) * __builtin_amdgcn_rcpf(1.0f + __expf(-v0[3])));
        w.z = pk2(bf2f(zz.z & 0xffffu) * __builtin_amdgcn_rcpf(1.0f + __expf(-v1[0])), bf2f(zz.z >> 16) * __builtin_amdgcn_rcpf(1.0f + __expf(-v1[1])));
        w.w = pk2(bf2f(zz.w & 0xffffu) * __builtin_amdgcn_rcpf(1.0f + __expf(-v1[2])), bf2f(zz.w >> 16) * __builtin_amdgcn_rcpf(1.0f + __expf(-v1[3])));
        *(u32x4*)(YS + (size_t)R * 512 + c) = w;
    }
    EPI_BODY()
};
struct EpiScale {
    static constexpr bool PERM = true, AFTER_DRAIN = false;
    bf16* O; int ldc; const float* scale;
    __device__ __forceinline__ void q(int R, int c, const f32x4& a) const {
        f32x4 v = a;
        if (scale) v = v * *(const f32x4*)(scale + c);
        u32x2 w; w.x = pk2(v[0], v[1]); w.y = pk2(v[2], v[3]);
        *(u32x2*)(O + (size_t)R * ldc + c) = w;
    }
    __device__ __forceinline__ void q2(int R, int c, const f32x4& a0, const f32x4& a1) const {
        f32x4 v0 = a0, v1 = a1;
        if (scale) { v0 = v0 * *(const f32x4*)(scale + c); v1 = v1 * *(const f32x4*)(scale + c + 4); }
        u32x4 w; w.x = pk2(v0[0], v0[1]); w.y = pk2(v0[2], v0[3]); w.z = pk2(v1[0], v1[1]); w.w = pk2(v1[2], v1[3]);
        *(u32x4*)(O + (size_t)R * ldc + c) = w;
    }
    EPI_BODY()
};
template <bool FIRST> struct EpiGate {
    static constexpr bool PERM = true, AFTER_DRAIN = false;
    const float* rowss; const bf16* BR; bf16* MG;
    __device__ __forceinline__ void q(int R, int c, const f32x4& a, float rs) const {
        const f32x4 v = a * rs;
        const u32x2 bb = *(const u32x2*)(BR + (size_t)R * 1024 + c);
        float o0 = bf2f(bb.x & 0xffffu) * __builtin_amdgcn_rcpf(1.0f + __expf(-v[0])), o1 = bf2f(bb.x >> 16) * __builtin_amdgcn_rcpf(1.0f + __expf(-v[1]));
        float o2 = bf2f(bb.y & 0xffffu) * __builtin_amdgcn_rcpf(1.0f + __expf(-v[2])), o3 = bf2f(bb.y >> 16) * __builtin_amdgcn_rcpf(1.0f + __expf(-v[3]));
        if (!FIRST) { const u32x2 mm = *(const u32x2*)(MG + (size_t)R * 1024 + c);
            o0 += bf2f(mm.x & 0xffffu); o1 += bf2f(mm.x >> 16); o2 += bf2f(mm.y & 0xffffu); o3 += bf2f(mm.y >> 16); }
        u32x2 w; w.x = pk2(o0, o1); w.y = pk2(o2, o3);
        *(u32x2*)(MG + (size_t)R * 1024 + c) = w;
    }
    __device__ __forceinline__ void q2(int R, int c, const f32x4& a0, const f32x4& a1, float rs) const {
        const f32x4 v0 = a0 * rs, v1 = a1 * rs;
        const u32x4 bb = *(const u32x4*)(BR + (size_t)R * 1024 + c);
        float o[8];
        o[0] = bf2f(bb.x & 0xffffu) * __builtin_amdgcn_rcpf(1.0f + __expf(-v0[0])); o[1] = bf2f(bb.x >> 16) * __builtin_amdgcn_rcpf(1.0f + __expf(-v0[1]));
        o[2] = bf2f(bb.y & 0xffffu) * __builtin_amdgcn_rcpf(1.0f + __expf(-v0[2])); o[3] = bf2f(bb.y >> 16) * __builtin_amdgcn_rcpf(1.0f + __expf(-v0[3]));
        o[4] = bf2f(bb.z & 0xffffu) * __builtin_amdgcn_rcpf(1.0f + __expf(-v1[0])); o[5] = bf2f(bb.z >> 16) * __builtin_amdgcn_rcpf(1.0f + __expf(-v1[1]));
        o[6] = bf2f(bb.w & 0xffffu) * __builtin_amdgcn_rcpf(1.0f + __expf(-v1[2])); o[7] = bf2f(bb.w >> 16) * __builtin_amdgcn_rcpf(1.0f + __expf(-v1[3]));
        if (!FIRST) { const u32x4 mm = *(const u32x4*)(MG + (size_t)R * 1024 + c);
            o[0] += bf2f(mm.x & 0xffffu); o[1] += bf2f(mm.x >> 16); o[2] += bf2f(mm.y & 0xffffu); o[3] += bf2f(mm.y >> 16);
            o[4] += bf2f(mm.z & 0xffffu); o[5] += bf2f(mm.z >> 16); o[6] += bf2f(mm.w & 0xffffu); o[7] += bf2f(mm.w >> 16); }
        u32x4 w; w.x = pk2(o[0], o[1]); w.y = pk2(o[2], o[3]); w.z = pk2(o[4], o[5]); w.w = pk2(o[6], o[7]);
        *(u32x4*)(MG + (size_t)R * 1024 + c) = w;
    }
    EPI_BODY_RS()
};
struct EpiRes {
    static constexpr bool PERM = true, AFTER_DRAIN = false;
    float* Hreal; float* Hmeta; bf16* HB; float* rowss_out; const float* Hin;
    __device__ __forceinline__ float q(int R, int c, const f32x4& a) const {
        float* hrow = R < NREAL ? Hreal + (size_t)R * 1024 : Hmeta + (size_t)(R - NREAL) * 1024;
        const float* hin = R < NREAL ? Hin + (size_t)R * 1024 : hrow;
        const f32x4 h = *(const f32x4*)(hin + c) + a;
        *(f32x4*)(hrow + c) = h;
        u32x2 w; w.x = pk2(h[0], h[1]); w.y = pk2(h[2], h[3]);
        *(u32x2*)(HB + (size_t)R * 1024 + c) = w;
        return (h[0] * h[0] + h[1] * h[1]) + (h[2] * h[2] + h[3] * h[3]);
    }
    __device__ __forceinline__ void rg(int R, int pn, int wc, int fq, const f32x4 (&a4)[2][2]) const {
        float ss = 0.f;
#pragma unroll
        for (int bj = 0; bj < 2; ++bj)
#pragma unroll
            for (int n = 0; n < 2; ++n) ss += q(R, pn * 256 + bj * 128 + wc * 32 + 8 * fq + 4 * n, a4[bj][n]);
        ss += __shfl_xor(ss, 16); ss += __shfl_xor(ss, 32);
        if (fq == 0) rowss_out[((size_t)pn * TPR + R) * 4 + wc] = ss;
    }
    __device__ __forceinline__ void tq(int R, int c, const f32x4& v) const {
        float ss = q(R, c, v);
        ss += __shfl_xor(ss, 16); ss += __shfl_xor(ss, 32);
        if ((threadIdx.x & 48) == 0) atomicAdd(rowss_out + (size_t)R * 4, ss);
    }
    EPI_OP()
};
struct EpiUp {
    static constexpr bool PERM = true, AFTER_DRAIN = false;
    const float* rowss; bf16* ACT;
    __device__ __forceinline__ void q(int R, int c, const f32x4& a, float rs) const {
        f32x4 v = a * rs;
#pragma unroll
        for (int j = 0; j < 4; ++j) { const float r = fmaxf(v[j], 0.f); v[j] = r * r; }
        u32x2 w; w.x = pk2(v[0], v[1]); w.y = pk2(v[2], v[3]);
        *(u32x2*)(ACT + (size_t)R * FF + c) = w;
    }
    __device__ __forceinline__ void q2(int R, int c, const f32x4& a0, const f32x4& a1, float rs) const {
        f32x4 v0 = a0 * rs, v1 = a1 * rs;
#pragma unroll
        for (int j = 0; j < 4; ++j) { const float r0 = fmaxf(v0[j], 0.f), r1 = fmaxf(v1[j], 0.f); v0[j] = r0 * r0; v1[j] = r1 * r1; }
        u32x4 w; w.x = pk2(v0[0], v0[1]); w.y = pk2(v0[2], v0[3]); w.z = pk2(v1[0], v1[1]); w.w = pk2(v1[2], v1[3]);
        *(u32x4*)(ACT + (size_t)R * FF + c) = w;
    }
    EPI_BODY_RS()
};
template <class Epi>
__device__ __forceinline__ void thin_gemm(LAS unsigned char* lds, const bf16* A, const bf16* Bt, int K, int N, const Epi& E, int vb, int vg) {
    int tid_l = threadIdx.x; asm volatile("" : "+v"(tid_l));
    const int lane = tid_l & 63, w = __builtin_amdgcn_readfirstlane(tid_l >> 6), fr = lane & 15, fq = lane >> 4;
    LAS f32x4* red = (LAS f32x4*)lds;
    const int kw = K >> 3;
    for (int pc = vb; pc < N / 16; pc += vg) {
        const bf16* ap = A + (size_t)(NREAL + fr) * K + w * kw + 8 * fq;
        const bf16* bp = Bt + (size_t)(16 * pc + fr) * K + w * kw + 8 * fq;
        f32x4 acc[8];
#pragma unroll
        for (int rb = 0; rb < 8; ++rb) acc[rb] = (f32x4){0.f, 0.f, 0.f, 0.f};
#pragma unroll 2
        for (int k0 = 0; k0 < kw; k0 += 32) {
            const bf16x8 bf = *(const bf16x8*)(bp + k0);
            bf16x8 af[8];
#pragma unroll
            for (int rb = 0; rb < 8; ++rb) af[rb] = *(const bf16x8*)(ap + (size_t)(16 * rb) * K + k0);
#pragma unroll
            for (int rb = 0; rb < 8; ++rb) acc[rb] = __builtin_amdgcn_mfma_f32_16x16x32_bf16(bf, af[rb], acc[rb], 0, 0, 0);
        }
        asm volatile("s_nop 15\n\ts_nop 15" : "+v"(acc[0]), "+v"(acc[1]), "+v"(acc[2]), "+v"(acc[3]), "+v"(acc[4]), "+v"(acc[5]), "+v"(acc[6]), "+v"(acc[7]));
#pragma unroll
        for (int rb = 0; rb < 8; ++rb) red[(w * 8 + rb) * 64 + lane] = acc[rb];
        LDS_FENCE(); __syncthreads();
        f32x4 v = red[(0 * 8 + w) * 64 + lane];
#pragma unroll
        for (int ww = 1; ww < 8; ++ww) v = v + red[(ww * 8 + w) * 64 + lane];
        LDS_FENCE(); __syncthreads();
        E.tq(NREAL + 16 * w + fr, 16 * pc + 4 * fq, v);
    }
}

struct Args { const float* in[23]; float* out; unsigned char* ws; };

__device__ __forceinline__ void p0_item(const float* W, int ldw, int K, const float* scale, bf16* WT, int permrows, LAS float* scr, int item, int nblk, int lane) {
    const int kb = item / nblk, nb = item % nblk, k0 = 64 * kb, n0 = 64 * nb;
#pragma unroll 4
    for (int i = 0; i < 16; ++i) {
        const int kk = 4 * i + (lane >> 4), c4 = (lane & 15) * 4;
        f32x4 w = *(const f32x4*)(W + (size_t)(k0 + kk) * ldw + n0 + c4);
        if (scale) w = w * scale[k0 + kk];
        scr[kk * 65 + c4] = w[0]; scr[kk * 65 + c4 + 1] = w[1]; scr[kk * 65 + c4 + 2] = w[2]; scr[kk * 65 + c4 + 3] = w[3];
    }
    LDS_FENCE();
    const int c = lane & 7;
#pragma unroll
    for (int j = 0; j < 8; ++j) {
        const int n = (lane >> 3) + 8 * j;
        const int sc = (n0 + n) < permrows ? ((n & 1) ? 32 + (n >> 1) : (n >> 1)) : n;
        const LAS float* s = scr + (8 * c) * 65 + sc;
        u32x4 o; o.x = pk2(s[0 * 65], s[1 * 65]); o.y = pk2(s[2 * 65], s[3 * 65]); o.z = pk2(s[4 * 65], s[5 * 65]); o.w = pk2(s[6 * 65], s[7 * 65]);
        *(u32x4*)(WT + (size_t)(n0 + n) * K + k0 + 8 * c) = o;
    }
    LDS_FENCE();
}

__device__ __forceinline__ void p0_prologue(const Args& a, LAS unsigned char* lds) {
    int tl_ = threadIdx.x; asm volatile("" : "+v"(tl_));
    const int tid = tl_, lane = tid & 63, wave = __builtin_amdgcn_readfirstlane(tid >> 6);
    const int gw = blockIdx.x * 8 + wave, NGW = gridDim.x * 8;
    const int gt = blockIdx.x * 512 + tid, NGT = gridDim.x * 512;
    unsigned char* ws = a.ws;
    LAS float* scr = (LAS float*)(lds + wave * 17408);
    for (int i = gt; i < 4 * 4 * 128 * 4; i += NGT) { const int idx = 1 + (i >> 11), pn = (i >> 9) & 3, r = (i >> 2) & 127, sl = i & 3;
        ((float*)(ws + WS_RS))[((size_t)idx * 4 * TPR + (size_t)pn * TPR + NREAL + r) * 4 + sl] = 0.f; }
    constexpr int I_IN = 16 * 76, I_GLU = 8 * 8, I_BR = 8 * 16, I_OUT = 16 * 16, I_UP = 16 * 64, I_DN = 64 * 16, I_L = I_IN + I_GLU + 3 * I_BR + I_OUT + I_UP + I_DN;
    for (int it = gw; it < 2 * I_L; it += NGW) {
        const int layer = it / I_L; int r = it % I_L;
        unsigned char* wl = ws + WS_W + (size_t)layer * LW_BYTES;
        if (r < I_IN) { p0_item(a.in[3] + (size_t)layer * DM * DIN, DIN, DM, a.in[2] + layer * DM, (bf16*)(wl + OW_IN), 640, scr, r, 76, lane); continue; } r -= I_IN;
        if (r < I_GLU) { p0_item(a.in[13] + (size_t)layer * 512 * 512, 512, 512, nullptr, (bf16*)(wl + OW_GLU), 0, scr, r, 8, lane); continue; } r -= I_GLU;
        if (r < 3 * I_BR) { const int c = r / I_BR; p0_item(a.in[17] + ((size_t)layer * 3 + c) * 512 * 1024, 1024, 512, nullptr, (bf16*)(wl + OW_BR) + (size_t)c * 1024 * 512, 0, scr, r % I_BR, 16, lane); continue; } r -= 3 * I_BR;
        if (r < I_OUT) { p0_item(a.in[18] + (size_t)layer * DM * DM, DM, DM, nullptr, (bf16*)(wl + OW_OUT), 0, scr, r, 16, lane); continue; } r -= I_OUT;
        if (r < I_UP) { p0_item(a.in[20] + (size_t)layer * DM * FF, FF, DM, a.in[19] + layer * DM, (bf16*)(wl + OW_UP), 0, scr, r, 64, lane); continue; } r -= I_UP;
        p0_item(a.in[21] + (size_t)layer * FF * DM, DM, FF, nullptr, (bf16*)(wl + OW_DN), 0, scr, r, 16, lane);
    }
    for (int i = gt; i < 2 * 512 * 512; i += NGT) {
        const int layer = i >> 18, n = (i >> 9) & 511, k = i & 511;
        float w = 0.f;
        if ((n >> 7) == (k >> 7)) w = a.in[15][(((size_t)layer * 4 + (n >> 7)) * 128 + (k & 127)) * 128 + (n & 127)];
        ((bf16*)(ws + WS_W + (size_t)layer * LW_BYTES + OW_POOL))[(size_t)n * 512 + k] = (bf16)f2bf(w);
    }
    for (int i = gt; i < LL * 32; i += NGT) {
        const int l = i >> 5, f = i & 31;
        const float invf = (float)dexp(-(double)f * (9.21034037197618273607 / 32.0));
        const float ang = (float)l * invf;
        double s, c; dsincos((double)ang, s, c);
        float* rp = (float*)(ws + WS_ROPE) + (size_t)i * 2; rp[0] = (float)c; rp[1] = (float)s;
    }
    for (int i = gt; i < 2 * 2 * 32 * 64; i += NGT) {
        const int n = i & 63, pidx = i >> 6;
        const double lr = (double)a.in[5][i], li = (double)a.in[6][i];
        const double dt = (double)(float)dexp((double)a.in[7][pidx]);
        const double mag = dexp(lr * dt); double sn, cn; dsincos(li * dt, sn, cn);
        const double are = mag * cn, aim = mag * sn, den = lr * lr + li * li, nre = are - 1.0;
        const double fre = (nre * lr + aim * li) / den, fim = (aim * lr - nre * li) / den;
        float* ab = (float*)(ws + WS_ABAR) + (size_t)i * 2; ab[0] = (float)are; ab[1] = (float)aim;
        bf16* bm = (bf16*)(ws + WS_BMAT) + (size_t)pidx * 128 * 16;
        bf16* cm = (bf16*)(ws + WS_CMAT) + (size_t)pidx * 16 * 128;
        for (int q = 0; q < 16; ++q) {
            const double br = (double)a.in[8][(size_t)i * 16 + q], bi = (double)a.in[9][(size_t)i * 16 + q];
            bm[n * 16 + q] = (bf16)f2bf((float)(fre * br - fim * bi));
            bm[(64 + n) * 16 + q] = (bf16)f2bf((float)(fre * bi + fim * br));
            cm[q * 128 + n] = (bf16)f2bf(a.in[10][((size_t)pidx * 16 + q) * 64 + n]);
            cm[q * 128 + 64 + n] = (bf16)f2bf(-a.in[11][((size_t)pidx * 16 + q) * 64 + n]);
        }
    }
    for (int R = gw; R < TPR; R += NGW) {
        const int mrow = R - NREAL;
        const float* src = R < NREAL ? a.in[0] + (size_t)R * DM : a.in[1] + (size_t)(mrow & 15) * DM;
        float* dst = R < NREAL ? a.out + (size_t)R * DM : (float*)(ws + WS_HM) + (size_t)mrow * DM;
        bf16* hb = (bf16*)(ws + WS_HB) + (size_t)R * DM;
        const bool pad = mrow >= NB * NMETA;
        float ss = 0.f;
#pragma unroll
        for (int j = 0; j < 4; ++j) {
            f32x4 v = *(const f32x4*)(src + 4 * lane + 256 * j);
            if (pad) v = (f32x4){0.f, 0.f, 0.f, 0.f};
            if (R >= NREAL) *(f32x4*)(dst + 4 * lane + 256 * j) = v;
            ss += (v[0] * v[0] + v[1] * v[1]) + (v[2] * v[2] + v[3] * v[3]);
            u32x2 w; w.x = pk2(v[0], v[1]); w.y = pk2(v[2], v[3]);
            *(u32x2*)(hb + 4 * lane + 256 * j) = w;
        }
#pragma unroll
        for (int o = 1; o < 64; o <<= 1) ss += __shfl_xor(ss, o);
        if (lane < 16) ((float*)(ws + WS_RS))[((size_t)(lane >> 2) * TPR + R) * 4 + (lane & 3)] = lane == 0 ? ss : 0.f;
    }
}

__device__ __forceinline__ void ssm_task(LAS unsigned char* lds, int task, int layer, const bf16* SU, float* YF,
                                         const float* abar_all, const bf16* bmat_all, const bf16* cmat_all) {
    int tid_l = threadIdx.x; asm volatile("" : "+v"(tid_l));
    const int tid = tid_l, lane = tid & 63, wave = __builtin_amdgcn_readfirstlane(tid >> 6);
    const int b = task >> 5, g = task & 31;
    __syncthreads();
    LAS float* BU = (LAS float*)(lds + wave * 12800);
    LAS unsigned short* X = (LAS unsigned short*)(lds + wave * 12800 + 8448);
    LAS float* SX = (LAS float*)(lds + 8 * 12800);
    const int blk0 = wave == 0 ? 0 : 16 * wave + 1, nblk = wave == 0 ? 17 : 16;
    bf16* yfb = (bf16*)YF + (size_t)task * LL * 16;
    const int fr = lane & 15, fq = lane >> 4;
    const bf16x8 zero8 = {0, 0, 0, 0, 0, 0, 0, 0};
    for (int dir = 0; dir < 2; ++dir) {
        const int pidx = (layer * 2 + dir) * 32 + g;
        const float are = abar_all[((size_t)pidx * 64 + lane) * 2], aim = abar_all[((size_t)pidx * 64 + lane) * 2 + 1];
        bf16x8 bfr[8], cfr[4];
        const bf16* bm = bmat_all + (size_t)pidx * 128 * 16;
#pragma unroll
        for (int nt = 0; nt < 8; ++nt) bfr[nt] = fq < 2 ? *(const bf16x8*)(bm + (nt * 16 + fr) * 16 + 8 * fq) : zero8;
        const bf16* cm = cmat_all + (size_t)pidx * 16 * 128;
#pragma unroll
        for (int ks = 0; ks < 4; ++ks) cfr[ks] = *(const bf16x8*)(cm + fr * 128 + ks * 32 + 8 * fq);
        float p16r = are, p16i = aim;
#pragma unroll
        for (int i = 0; i < 4; ++i) { const float tr = p16r * p16r - p16i * p16i, ti = 2.f * p16r * p16i; p16r = tr; p16i = ti; }
        float p256r = p16r, p256i = p16i;
#pragma unroll
        for (int i = 0; i < 4; ++i) { const float tr = p256r * p256r - p256i * p256i, ti = 2.f * p256r * p256i; p256r = tr; p256i = ti; }
        const float p272r = p256r * p16r - p256i * p16i, p272i = p256r * p16i + p256i * p16r;

        float xre = 0.f, xim = 0.f;
        for (int pass = 0; pass < 2; ++pass) {
            bf16x8 unext;
            { const int blkf = dir == 0 ? blk0 : blk0 + nblk - 1; const int Rf = blkf == 0 ? NREAL + b * NMETA : b * SEQ + blkf * 16 - NMETA;
              unext = fq < 2 ? *(const bf16x8*)(SU + (size_t)(Rf + fr) * 512 + g * 16 + 8 * fq) : zero8; }
            for (int ib = 0; ib < nblk; ++ib) {
                const int blk = dir == 0 ? blk0 + ib : blk0 + nblk - 1 - ib;
                const bf16x8 ufr = unext;
                if (ib + 1 < nblk) { const int blkn = dir == 0 ? blk + 1 : blk - 1; const int Rn = blkn == 0 ? NREAL + b * NMETA : b * SEQ + blkn * 16 - NMETA;
                    unext = fq < 2 ? *(const bf16x8*)(SU + (size_t)(Rn + fr) * 512 + g * 16 + 8 * fq) : zero8; }
                f32x4 dd[8];
#pragma unroll
                for (int nt = 0; nt < 8; ++nt) { dd[nt] = (f32x4){0.f, 0.f, 0.f, 0.f}; dd[nt] = __builtin_amdgcn_mfma_f32_16x16x32_bf16(ufr, bfr[nt], dd[nt], 0, 0, 0); }
                asm volatile("s_nop 15\n\ts_nop 15" : "+v"(dd[0]), "+v"(dd[1]), "+v"(dd[2]), "+v"(dd[3]), "+v"(dd[4]), "+v"(dd[5]), "+v"(dd[6]), "+v"(dd[7]));
#pragma unroll
                for (int nt = 0; nt < 8; ++nt)
#pragma unroll
                    for (int r = 0; r < 4; ++r) BU[(4 * fq + r) * 132 + nt * 16 + fr] = dd[nt][r];
                LDS_FENCE();
                float bur[16], bui[16];
#pragma unroll
                for (int i = 0; i < 16; ++i) { const int tt = dir == 0 ? i : 15 - i; bur[i] = BU[tt * 132 + lane]; bui[i] = BU[tt * 132 + 64 + lane]; }
                if (pass == 0) {
#pragma unroll
                    for (int i = 0; i < 16; ++i) {
                        const float bre = bur[i], bim = bui[i];
                        const float nr = are * xre - aim * xim + bre, ni = are * xim + aim * xre + bim; xre = nr; xim = ni;
                    }
                    LDS_FENCE();
                } else {
#pragma unroll
                    for (int i = 0; i < 16; ++i) {
                        const int tt = dir == 0 ? i : 15 - i;
                        const float bre = bur[i], bim = bui[i];
                        const float nr = are * xre - aim * xim + bre, ni = are * xim + aim * xre + bim; xre = nr; xim = ni;
                        X[tt * 136 + lane] = (unsigned short)f2bf(xre); X[tt * 136 + 64 + lane] = (unsigned short)f2bf(xim);
                    }
                    LDS_FENCE();
                    f32x4 y = {0.f, 0.f, 0.f, 0.f};
#pragma unroll
                    for (int ks = 0; ks < 4; ++ks) {
                        const bf16x8 afr = *(const LAS bf16x8*)(X + fr * 136 + ks * 32 + 8 * fq);
                        y = __builtin_amdgcn_mfma_f32_16x16x32_bf16(afr, cfr[ks], y, 0, 0, 0);
                    }
                    asm volatile("s_nop 15\n\ts_nop 15" : "+v"(y));
                    LDS_FENCE();
                    {
                        bf16* yd = yfb + (size_t)dir * 256 * LL * 16;
#pragma unroll
                        for (int r = 0; r < 4; ++r) yd[(size_t)(blk * 16 + 4 * fq + r) * 16 + fr] = (bf16)f2bf(y[r]);
                    }
                }
            }
            if (pass == 0) {
                SX[(wave * 64 + lane) * 2] = xre; SX[(wave * 64 + lane) * 2 + 1] = xim;
                LDS_FENCE(); __syncthreads();
                float cre = 0.f, cim = 0.f;
                if (dir == 0) {
                    for (int w = 0; w < wave; ++w) { const float pr = w == 0 ? p272r : p256r, pi = w == 0 ? p272i : p256i;
                        const float sr = SX[(w * 64 + lane) * 2], si = SX[(w * 64 + lane) * 2 + 1];
                        const float nr = pr * cre - pi * cim + sr, ni = pr * cim + pi * cre + si; cre = nr; cim = ni; }
                } else {
                    for (int w = 7; w > wave; --w) {
                        const float sr = SX[(w * 64 + lane) * 2], si = SX[(w * 64 + lane) * 2 + 1];
                        const float nr = p256r * cre - p256i * cim + sr, ni = p256r * cim + p256i * cre + si; cre = nr; cim = ni; }
                }
                xre = cre; xim = cim;
            }
        }
        LDS_FENCE(); __syncthreads();
    }
}

constexpr int ATT_KROW = 72, ATT_VROW = 40, ATT_KT = 32 * ATT_KROW * 2  , ATT_VT = 64 * ATT_VROW * 2  , ATT_MAXT = 11, ATT_VOFF = ATT_MAXT * ATT_KT;
static_assert(ATT_VOFF + ATT_MAXT * ATT_VT <= 131072, "attention LDS");
__device__ __forceinline__ void attn_task(LAS unsigned char* lds, int task, const bf16* Q, const bf16* K, const bf16* V, bf16* YA, const float* sink) {
    int tid_l = threadIdx.x; asm volatile("" : "+v"(tid_l));
    const int tid = tid_l, lane = tid & 63, wave = __builtin_amdgcn_readfirstlane(tid >> 6);
    const int qb = task % 33, bh = task / 33, h = bh & 1, b = bh >> 1;
    const int l0 = qb * 64;
    __syncthreads();
    int jlo = (l0 - 128) >> 5; if (jlo < 1) jlo = 1;
    int jhi = (l0 + 191) >> 5; if (jhi > 64) jhi = 64;
    const int ntiles = 1 + (jhi - jlo + 1);
    LAS unsigned short* Ks = (LAS unsigned short*)lds;
    LAS unsigned short* Vs = (LAS unsigned short*)(lds + ATT_VOFF);
    for (int idx = tid; idx < ntiles * 32 * 8; idx += 512) {
        const int ch = idx & 7, key = idx >> 3, slot = key >> 5, kk = key & 31;
        const int lk = (slot == 0 ? 0 : (jlo + slot - 1) * 32) + kk;
        u32x4 kv = {0u, 0u, 0u, 0u}, vv = {0u, 0u, 0u, 0u};
        if (lk < LL) { const size_t R = (size_t)tok_row(b, lk);
            kv = *(const u32x4*)(K + R * 128 + h * 64 + ch * 8); vv = *(const u32x4*)(V + R * 128 + h * 64 + ch * 8); }
        *(LAS u32x4*)(Ks + slot * (ATT_KT / 2) + kk * ATT_KROW + ch * 8) = kv;
        LAS unsigned short* vd = Vs + slot * (ATT_VT / 2) + (ch * 8) * ATT_VROW + kk;
        vd[0 * ATT_VROW] = (unsigned short)(vv.x & 0xffffu); vd[1 * ATT_VROW] = (unsigned short)(vv.x >> 16);
        vd[2 * ATT_VROW] = (unsigned short)(vv.y & 0xffffu); vd[3 * ATT_VROW] = (unsigned short)(vv.y >> 16);
        vd[4 * ATT_VROW] = (unsigned short)(vv.z & 0xffffu); vd[5 * ATT_VROW] = (unsigned short)(vv.z >> 16);
        vd[6 * ATT_VROW] = (unsigned short)(vv.w & 0xffffu); vd[7 * ATT_VROW] = (unsigned short)(vv.w >> 16);
    }
    LDS_FENCE(); __syncthreads();
    const int head = h * 4 + (wave >> 1), r32 = lane & 31, hi = lane >> 5;
    const int lq = l0 + 32 * (wave & 1) + r32;
    const bool qvalid = lq < LL;
    const size_t Rq = (size_t)tok_row(b, qvalid ? lq : LL - 1);
    bf16x8 qf[4];
#pragma unroll
    for (int ks = 0; ks < 4; ++ks) qf[ks] = *(const bf16x8*)(Q + Rq * 512 + head * 64 + ks * 16 + 8 * hi);
    float mrun = sink[head], lsum = hi == 0 ? 1.0f : 0.0f;
    f32x16 o0, o1;
#pragma unroll
    for (int i = 0; i < 16; ++i) { o0[i] = 0.f; o1[i] = 0.f; }
    const int lqw = l0 + 32 * (wave & 1);
    for (int slot = 0; slot < ntiles; ++slot) {
        const int kbase = slot == 0 ? 0 : (jlo + slot - 1) * 32;
        if (lqw >= LL || (slot != 0 && (kbase + 31 < lqw - 128 || kbase > lqw + 31 + 128))) continue;
        const LAS unsigned short* kt = Ks + slot * (ATT_KT / 2);
        f32x16 s;
#pragma unroll
        for (int i = 0; i < 16; ++i) s[i] = 0.f;
#pragma unroll
        for (int ks = 0; ks < 4; ++ks) {
            const bf16x8 kf = *(const LAS bf16x8*)(kt + r32 * ATT_KROW + ks * 16 + 8 * hi);
            s = __builtin_amdgcn_mfma_f32_32x32x16_bf16(kf, qf[ks], s, 0, 0, 0);
        }
        asm volatile("s_nop 15\n\ts_nop 15" : "+v"(s));
        float mt = -1e30f;
#pragma unroll
        for (int i = 0; i < 16; ++i) {
            const int lk = kbase + (i & 3) + 8 * (i >> 2) + 4 * hi;
            int d = lq - lk; d = d < 0 ? -d : d;
            const bool valid = (lk < NMETA) || (d <= 128 && lk < LL);
            s[i] = valid ? s[i] : -1e30f;
            mt = fmaxf(mt, s[i]);
        }
        mt = fmaxf(mt, __shfl_xor(mt, 32));
        const float mnew = fmaxf(mrun, mt);
        const float alpha = __expf(mrun - mnew);
        mrun = mnew;
        float ps = 0.f;
#pragma unroll
        for (int i = 0; i < 16; ++i) { s[i] = __expf(s[i] - mnew); ps += s[i]; }
        lsum = lsum * alpha + ps;
#pragma unroll
        for (int i = 0; i < 16; ++i) { o0[i] *= alpha; o1[i] *= alpha; }
        const LAS unsigned short* vt = Vs + slot * (ATT_VT / 2);
#pragma unroll
        for (int s2 = 0; s2 < 2; ++s2) {
            union { bf16x8 v; unsigned u[4]; } pf;
            pf.u[0] = pk2(s[8 * s2 + 0], s[8 * s2 + 1]); pf.u[1] = pk2(s[8 * s2 + 2], s[8 * s2 + 3]);
            pf.u[2] = pk2(s[8 * s2 + 4], s[8 * s2 + 5]); pf.u[3] = pk2(s[8 * s2 + 6], s[8 * s2 + 7]);
#pragma unroll
            for (int dt = 0; dt < 2; ++dt) {
                union { bf16x8 v; u32x2 u[2]; } vf;
                const LAS unsigned short* vp = vt + (dt * 32 + r32) * ATT_VROW + 16 * s2 + 4 * hi;
                vf.u[0] = *(const LAS u32x2*)(vp); vf.u[1] = *(const LAS u32x2*)(vp + 8);
                if (dt == 0) o0 = __builtin_amdgcn_mfma_f32_32x32x16_bf16(vf.v, pf.v, o0, 0, 0, 0);
                else o1 = __builtin_amdgcn_mfma_f32_32x32x16_bf16(vf.v, pf.v, o1, 0, 0, 0);
            }
        }
    }
    asm volatile("s_nop 15\n\ts_nop 15" : "+v"(o0), "+v"(o1));
    lsum += __shfl_xor(lsum, 32);
    const float inv = 1.0f / lsum;
    if (qvalid) {
#pragma unroll
        for (int g4 = 0; g4 < 4; ++g4) {
            u32x2 w0, w1;
            w0.x = pk2(o0[4 * g4] * inv, o0[4 * g4 + 1] * inv); w0.y = pk2(o0[4 * g4 + 2] * inv, o0[4 * g4 + 3] * inv);
            w1.x = pk2(o1[4 * g4] * inv, o1[4 * g4 + 1] * inv); w1.y = pk2(o1[4 * g4 + 2] * inv, o1[4 * g4 + 3] * inv);
            *(u32x2*)(YA + Rq * 512 + head * 64 + 8 * g4 + 4 * hi) = w0;
            *(u32x2*)(YA + Rq * 512 + head * 64 + 32 + 8 * g4 + 4 * hi) = w1;
        }
    }
    __syncthreads();
}

__device__ __forceinline__ void pool_diff(LAS unsigned char* lds, const bf16* PU, bf16* PD) {
    int tl_ = threadIdx.x; asm volatile("" : "+v"(tl_));
    constexpr int TOK = 65, HALO = 8, ROWS = TOK + 2 * HALO, NTOK = NB * LL;
    for (int blk = blockIdx.x; blk * TOK < NTOK; blk += gridDim.x) {
        const int f0 = blk * TOK;
        __syncthreads();
        for (int i = tl_; i < ROWS * 64; i += 512) {
            const int r = i >> 6, ch = i & 63, f = f0 - HALO + r;
            u32x4 v = {0u, 0u, 0u, 0u};
            if (f >= 0 && f < NTOK) { const int b = f / LL, l = f % LL; v = *(const u32x4*)(PU + (size_t)tok_row(b, l) * 512 + ch * 8); }
            *(LAS u32x4*)(lds + (size_t)i * 16) = v;
        }
        LDS_FENCE(); __syncthreads();
        for (int i = tl_; i < TOK * 64; i += 512) {
            const int t = i >> 6, ch = i & 63, f = f0 + t;
            if (f >= NTOK) continue;
            const int b = f / LL, l = f % LL, half = 1 << (ch >> 4);
            const int lo = l - half < 0 ? 0 : l - half, hh = l + half > LL ? LL : l + half;
            float s[8];
#pragma unroll
            for (int j = 0; j < 8; ++j) s[j] = 0.f;
            for (int lp = lo; lp < hh; ++lp) {
                const u32x4 v = *(const LAS u32x4*)(lds + (size_t)((t + HALO + lp - l) * 64 + ch) * 16);
                s[0] += bf2f(v.x & 0xffffu); s[1] += bf2f(v.x >> 16); s[2] += bf2f(v.y & 0xffffu); s[3] += bf2f(v.y >> 16);
                s[4] += bf2f(v.z & 0xffffu); s[5] += bf2f(v.z >> 16); s[6] += bf2f(v.w & 0xffffu); s[7] += bf2f(v.w >> 16);
            }
            const float ic = 1.0f / (float)(hh - lo);
            const u32x4 v = *(const LAS u32x4*)(lds + (size_t)((t + HALO) * 64 + ch) * 16);
            u32x4 o;
            o.x = pk2(s[0] * ic - bf2f(v.x & 0xffffu), s[1] * ic - bf2f(v.x >> 16)); o.y = pk2(s[2] * ic - bf2f(v.y & 0xffffu), s[3] * ic - bf2f(v.y >> 16));
            o.z = pk2(s[4] * ic - bf2f(v.z & 0xffffu), s[5] * ic - bf2f(v.z >> 16)); o.w = pk2(s[6] * ic - bf2f(v.w & 0xffffu), s[7] * ic - bf2f(v.w >> 16));
            *(u32x4*)(PD + (size_t)tok_row(b, l) * 512 + ch * 8) = o;
        }
    }
    __syncthreads();
}

__device__ __forceinline__ void z_pass(const float* YF, const bf16* SU, const float* dskip, bf16* Z) {
    int tl_ = threadIdx.x; asm volatile("" : "+v"(tl_)); const int gt = blockIdx.x * 512 + tl_, NGT = gridDim.x * 512;
    for (int i = gt; i < NB * LL * 64; i += NGT) {
        const int ch = i & 63, tk = i >> 6, b = tk / LL, l = tk % LL, g = ch >> 1;
        const size_t R = (size_t)tok_row(b, l);
        const bf16* yp = (const bf16*)YF + ((size_t)(b * 32 + g) * LL + l) * 16 + (ch & 1) * 8;
        const u32x4 ya = *(const u32x4*)yp, yb = *(const u32x4*)(yp + (size_t)256 * LL * 16);
        f32x4 y0, y1;
        y0[0] = bf2f(ya.x & 0xffffu) + bf2f(yb.x & 0xffffu); y0[1] = bf2f(ya.x >> 16) + bf2f(yb.x >> 16); y0[2] = bf2f(ya.y & 0xffffu) + bf2f(yb.y & 0xffffu); y0[3] = bf2f(ya.y >> 16) + bf2f(yb.y >> 16);
        y1[0] = bf2f(ya.z & 0xffffu) + bf2f(yb.z & 0xffffu); y1[1] = bf2f(ya.z >> 16) + bf2f(yb.z >> 16); y1[2] = bf2f(ya.w & 0xffffu) + bf2f(yb.w & 0xffffu); y1[3] = bf2f(ya.w >> 16) + bf2f(yb.w >> 16);
        const f32x4 d0 = *(const f32x4*)(dskip + ch * 8), d1 = *(const f32x4*)(dskip + ch * 8 + 4);
        const u32x4 uu = *(const u32x4*)(SU + R * 512 + ch * 8);
        float t[8];
        t[0] = y0[0] + d0[0] * bf2f(uu.x & 0xffffu); t[1] = y0[1] + d0[1] * bf2f(uu.x >> 16); t[2] = y0[2] + d0[2] * bf2f(uu.y & 0xffffu); t[3] = y0[3] + d0[3] * bf2f(uu.y >> 16);
        t[4] = y1[0] + d1[0] * bf2f(uu.z & 0xffffu); t[5] = y1[1] + d1[1] * bf2f(uu.z >> 16); t[6] = y1[2] + d1[2] * bf2f(uu.w & 0xffffu); t[7] = y1[3] + d1[3] * bf2f(uu.w >> 16);
#pragma unroll
        for (int j = 0; j < 8; ++j) {
            const float v = t[j], tt = __builtin_amdgcn_rcpf(fabsf(v) * 0.2316418882f + 1.0f);
            float q = tt * 0.5307027145f + (-0.7265760135f); q = q * tt + 0.7107068705f; q = q * tt + (-0.142248368f); q = q * tt + 0.127414796f; q = q * tt;
            const float m = v * (q * __builtin_amdgcn_exp2f(v * v * (-0.72134752044f)));
            t[j] = v < 0.f ? m : v - m;
        }
        u32x4 o; o.x = pk2(t[0], t[1]); o.y = pk2(t[2], t[3]); o.z = pk2(t[4], t[5]); o.w = pk2(t[6], t[7]);
        *(u32x4*)(Z + R * 512 + ch * 8) = o;
    }
}

#define XB_TMO      128
#define XB_XCNT(j)  (256  + 64 * (j))
#define XB_XSUB(j)  (1280 + 64 * (j))
#define XB_XGEN(j)  (2304 + 64 * (j))
#define XB_TOP      3328
#define XB_TOPGEN   3392
#define XCD_BAR_WORDS 3456
#define XB_SPIN_CAP (1u << 18)

__device__ __forceinline__ unsigned xb_ld(unsigned* p)              { return __hip_atomic_load(p, __ATOMIC_RELAXED, __HIP_MEMORY_SCOPE_AGENT); }
__device__ __forceinline__ unsigned xb_add(unsigned* p, unsigned v) { return __hip_atomic_fetch_add(p, v, __ATOMIC_RELAXED, __HIP_MEMORY_SCOPE_AGENT); }
__device__ __forceinline__ unsigned xb_xcc_id() { return (unsigned)__builtin_amdgcn_s_getreg((3 << 11) | 20) & 0xFu; }
#define XB_SPIN(cond, bar) do { unsigned _sp = 0; while (cond) { __builtin_amdgcn_s_sleep(1); \
    if ((++_sp & 255u) == 0u) { if (xb_ld(&(bar)[XB_TMO])) break; if (_sp > XB_SPIN_CAP) { atomicAdd(&(bar)[XB_TMO], 1u); break; } } } } while (0)

struct XcdBarrier {
    unsigned* bar; unsigned x;
    volatile LAS unsigned* st;
};

__device__ __forceinline__ XcdBarrier xcd_barrier_post(unsigned* bar, volatile LAS unsigned* st) {
    XcdBarrier b; b.bar = bar; b.x = xb_xcc_id(); b.st = st;
    if (threadIdx.x == 0) (void)xb_add(&bar[XB_XCNT(b.x)], 1u);
    return b;
}
__device__ __forceinline__ void xcd_barrier_complete(unsigned* bar, unsigned x, unsigned& nloc, unsigned& nx) {
    const unsigned G = gridDim.x * gridDim.y * gridDim.z;
    unsigned sum, cnt, mine, sp = 0u;
    for (;;) {
        sum = 0u; cnt = 0u; mine = 0u;
#pragma unroll
        for (unsigned j = 0; j < 16; ++j) { const unsigned c = xb_ld(&bar[XB_XCNT(j)]); sum += c; cnt += (c > 0u) ? 1u : 0u; mine = (j == x) ? c : mine; }
        if (sum == G) break;
        __builtin_amdgcn_s_sleep(1);
        if ((++sp & 255u) == 0u) { if (xb_ld(&bar[XB_TMO])) break; if (sp > XB_SPIN_CAP) { atomicAdd(&bar[XB_TMO], 1u); break; } }
    }
    nloc = mine > 0u ? mine : 1u; nx = cnt > 0u ? cnt : 1u;
}

__device__ __forceinline__ void xcd_barrier(const XcdBarrier& b) {
    asm volatile("s_waitcnt vmcnt(0)" ::: "memory");
    __syncthreads();
    if (threadIdx.x == 0) {
        unsigned* bar = b.bar;
        __builtin_amdgcn_s_waitcnt(0);
        unsigned nloc = b.st[0], nx = b.st[1];
        if (nloc == 0u) { xcd_barrier_complete(bar, b.x, nloc, nx); b.st[0] = nloc; b.st[1] = nx; }
        const unsigned old = xb_add(&bar[XB_XSUB(b.x)], 1u);
        const unsigned gen = old / nloc;
        if (old + 1u == (gen + 1u) * nloc) {
            __builtin_amdgcn_fence(__ATOMIC_RELEASE, "agent");
            asm volatile("s_waitcnt vmcnt(0)" ::: "memory");
            const unsigned og = xb_add(&bar[XB_TOP], 1u);
            const unsigned tg = og / nx;
            if (og + 1u == (tg + 1u) * nx) xb_add(&bar[XB_TOPGEN], 1u);
            else XB_SPIN(xb_ld(&bar[XB_TOPGEN]) == tg, bar);
            __builtin_amdgcn_fence(__ATOMIC_ACQUIRE, "agent");
            xb_add(&bar[XB_XGEN(b.x)], 1u);
            asm volatile("s_waitcnt vmcnt(0)" ::: "memory");
        } else {
            XB_SPIN(xb_ld(&bar[XB_XGEN(b.x)]) == gen, bar);
            __builtin_amdgcn_fence(__ATOMIC_ACQUIRE, "agent");
            asm volatile("s_waitcnt vmcnt(0)" ::: "memory");
        }
    }
    __syncthreads();
}

#ifndef MK_ALIGN
#define MK_ALIGN true
#endif
#ifndef MK_SP2
#define MK_SP2 true
#endif
#ifndef MK_SPLIT
#define MK_SPLIT 0
#endif
constexpr int NPL = 8, NPHASE = 1 + 2 * NPL + 1, PH_FINAL = NPHASE - 1;

typedef const __attribute__((address_space(4))) Args* KArgsP;
#define KARGS() ({ auto kp_ = __builtin_amdgcn_kernarg_segment_ptr(); asm volatile("" : "+s"(kp_)); (KArgsP)kp_; })
__global__ void __launch_bounds__(512, 2) fwd_kernel(Args a_unused, int ph_lo, int ph_hi) {
    (void)a_unused;
    extern __shared__ __attribute__((aligned(16))) unsigned char lds_raw[];
    LAS unsigned char* lds = (LAS unsigned char*)lds_raw;
    const int G = gridDim.x, bid = blockIdx.x;
#if MK_SPLIT
#define GRID_SYNC() do {} while (0)
    (void)lds;
#else
#define CG_SYNC() do { asm volatile("s_waitcnt vmcnt(0)" ::: "memory"); __syncthreads(); \
    if (threadIdx.x == 0) { __builtin_amdgcn_fence(__ATOMIC_RELEASE, "agent"); asm volatile("s_waitcnt vmcnt(0)" ::: "memory"); } \
    __syncthreads(); grid.sync(); \
    if (threadIdx.x == 0) { __builtin_amdgcn_fence(__ATOMIC_ACQUIRE, "agent"); asm volatile("s_waitcnt vmcnt(0)" ::: "memory"); } \
    __syncthreads(); } while (0)
    cg::grid_group grid = cg::this_grid();
    unsigned* barw = (unsigned*)(KARGS()->ws + WS_CTL);
    if (bid == 0) for (int i = threadIdx.x; i < XCD_BAR_WORDS; i += 512) __hip_atomic_store(barw + i, 0u, __ATOMIC_RELAXED, __HIP_MEMORY_SCOPE_AGENT);
    volatile LAS unsigned* xst = (volatile LAS unsigned*)(lds + LDS_BYTES - 64);
    if (threadIdx.x < 2) xst[threadIdx.x] = 0u;
    CG_SYNC();
    const XcdBarrier xbar = xcd_barrier_post(barw, xst);
#define GRID_SYNC() xcd_barrier(xbar)

#endif
#ifndef PHMASK
#define PHMASK 0xFFFFu
#endif
#define IN(k) (((PHMASK >> ((k) == 0 ? 0 : (k) == PH_FINAL ? 9 : 1 + ((k) - 1) % NPL)) & 1u) && ph_lo <= (k) && (k) < ph_hi)
#define SEAM(k) do { if (IN(k) && (k) + 1 < ph_hi) GRID_SYNC(); } while (0)
#define PHASE_BEGIN() KArgsP ka = KARGS(); unsigned char* ws = ka->ws; asm volatile("" : "+s"(ws)); float* rowss = (float*)(ws + WS_RS); float* Hm = (float*)(ws + WS_HM); bf16* HB = (bf16*)(ws + WS_HB); unsigned char* wl = ws + WS_W + (size_t)layer * LW_BYTES; \
    const int MT = NREAL; const bool META = layer != MK_NLAYER - 1;     \
    const float* rs_mix = rowss + (size_t)(2 * layer) * TPR * 16; float* rs_mlp = rowss + (size_t)(2 * layer + 1) * TPR * 16; float* rs_next = rowss + (size_t)(2 * layer + 2) * TPR * 16; (void)MT; (void)META; (void)Hm; (void)HB; (void)wl; (void)rs_mix; (void)rs_mlp; (void)rs_next;

    if (IN(0)) { Args al; { KArgsP kp = KARGS(); for (int i = 0; i < 23; ++i) al.in[i] = kp->in[i]; al.out = kp->out; al.ws = kp->ws; } p0_prologue(al, lds); }
    SEAM(0);
#ifndef MK_NLAYER
#define MK_NLAYER 2
#endif
#ifndef MK_RSIDX
#define MK_RSIDX 4
#endif
#pragma unroll 1
    for (int layer = 0; layer < MK_NLAYER; ++layer) {
        const int p = 1 + NPL * layer;
        if (IN(p)) { PHASE_BEGIN();
            pg8::Gemm g{HB, (const bf16*)(wl + OW_IN), TPR, NPROJ, DM}; pg8::StaticOrder S; S.init(TPR, NPROJ, G, bid);
            EpiInProj E{rs_mix, (const float*)(ws + WS_ROPE), (bf16*)(ws + WS_Q), (bf16*)(ws + WS_K), (bf16*)(ws + WS_V), (bf16*)(ws + WS_SU), (bf16*)(ws + WS_PU)};
            pg8::gemm_phase<EpiInProj, pg8::StaticOrder, MK_ALIGN, MK_SP2>(lds, g, S, E);
        }
        SEAM(p);
        if (IN(p + 1)) { PHASE_BEGIN();
            for (int t = bid; t < 256; t += G)
                ssm_task(lds, t, layer, (const bf16*)(ws + WS_SU), (float*)(ws + WS_YF), (const float*)(ws + WS_ABAR), (const bf16*)(ws + WS_BMAT), (const bf16*)(ws + WS_CMAT));
            for (int t = bid; t < NB * 2 * 33; t += G)
                attn_task(lds, t, (const bf16*)(ws + WS_Q), (const bf16*)(ws + WS_K), (const bf16*)(ws + WS_V), (bf16*)(ws + WS_YA), ka->in[4] + layer * 8);
            pool_diff(lds, (const bf16*)(ws + WS_PU), (bf16*)(ws + WS_PD));
        }
        SEAM(p + 1);
        if (IN(p + 2)) { PHASE_BEGIN();
            z_pass((const float*)(ws + WS_YF), (const bf16*)(ws + WS_SU), ka->in[12] + layer * 512, (bf16*)(ws + WS_Z));
        }
        SEAM(p + 2);
        if (IN(p + 3)) { PHASE_BEGIN();
            const int hg = G >> 1;
            if (bid < hg) { pg8::Gemm g{(const bf16*)(ws + WS_Z), (const bf16*)(wl + OW_GLU), MT, 512, 512}; pg8::StaticOrder S; S.init(MT, 512, hg, bid);
              EpiGlu E{(const bf16*)(ws + WS_Z), ka->in[14] + layer * 512, (bf16*)(ws + WS_YS)};
              pg8::gemm_phase<EpiGlu, pg8::StaticOrder, MK_ALIGN, MK_SP2>(lds, g, S, E); if (META) thin_gemm<EpiGlu>(lds, g.A, g.Bt, g.K, g.N, E, bid, hg); }
            else { pg8::Gemm g{(const bf16*)(ws + WS_PD), (const bf16*)(wl + OW_POOL), MT, 512, 512}; pg8::StaticOrder S; S.init(MT, 512, G - hg, bid - hg);
              EpiScale E{(bf16*)(ws + WS_YP), 512, ka->in[16] + layer * 512};
              pg8::gemm_phase<EpiScale, pg8::StaticOrder, MK_ALIGN, MK_SP2>(lds, g, S, E); if (META) thin_gemm<EpiScale>(lds, g.A, g.Bt, g.K, g.N, E, bid - hg, G - hg); }
        }
        SEAM(p + 3);
        if (IN(p + 4)) { PHASE_BEGIN();
#pragma unroll 1
            for (int c = 0; c < 3; ++c) {
                const bf16* Yc = (const bf16*)(ws + (c == 0 ? WS_YA : c == 1 ? WS_YS : WS_YP));
                { pg8::Gemm g{Yc, (const bf16*)(wl + OW_BR) + (size_t)c * 1024 * 512, MT, 1024, 512}; pg8::StaticOrder S; S.init(MT, 1024, G, bid);
                  EpiScale E{(bf16*)(ws + WS_BR), 1024, nullptr};
                  pg8::gemm_phase<EpiScale, pg8::StaticOrder, MK_ALIGN, MK_SP2>(lds, g, S, E); if (META) thin_gemm<EpiScale>(lds, g.A, g.Bt, g.K, g.N, E, bid, G); }
                pg8::Gemm g{HB, (const bf16*)(wl + OW_IN) + (size_t)(NPROJ + c * 1024) * DM, MT, 1024, DM}; pg8::StaticOrder S; S.init(MT, 1024, G, bid);
                if (c == 0) { EpiGate<true> E{rs_mix, (const bf16*)(ws + WS_BR), (bf16*)(ws + WS_MG)}; pg8::gemm_phase<EpiGate<true>, pg8::StaticOrder, MK_ALIGN, MK_SP2>(lds, g, S, E); if (META) thin_gemm<EpiGate<true>>(lds, g.A, g.Bt, g.K, g.N, E, bid, G); }
                else { EpiGate<false> E{rs_mix, (const bf16*)(ws + WS_BR), (bf16*)(ws + WS_MG)}; pg8::gemm_phase<EpiGate<false>, pg8::StaticOrder, MK_ALIGN, MK_SP2>(lds, g, S, E); if (META) thin_gemm<EpiGate<false>>(lds, g.A, g.Bt, g.K, g.N, E, bid, G); }
            }
        }
        SEAM(p + 4);
        if (IN(p + 5)) { PHASE_BEGIN();
            pg8::Gemm g{(const bf16*)(ws + WS_MG), (const bf16*)(wl + OW_OUT), MT, DM, DM}; pg8::StaticOrder S; S.init(MT, DM, G, bid);
            EpiRes E{ka->out, Hm, HB, rs_mlp, layer == 0 ? ka->in[0] : (const float*)ka->out};
            pg8::gemm_phase<EpiRes, pg8::StaticOrder, MK_ALIGN, MK_SP2>(lds, g, S, E); if (META) thin_gemm<EpiRes>(lds, g.A, g.Bt, g.K, g.N, E, bid, G);
        }
        SEAM(p + 5);
        if (IN(p + 6)) { PHASE_BEGIN();
            pg8::Gemm g{HB, (const bf16*)(wl + OW_UP), MT, FF, DM}; pg8::StaticOrder S; S.init(MT, FF, G, bid);
            EpiUp E{rs_mlp, (bf16*)(ws + WS_ACT)};
            pg8::gemm_phase<EpiUp, pg8::StaticOrder, MK_ALIGN, MK_SP2>(lds, g, S, E); if (META) thin_gemm<EpiUp>(lds, g.A, g.Bt, g.K, g.N, E, bid, G);
        }
        SEAM(p + 6);
        if (IN(p + 7)) { PHASE_BEGIN();
            pg8::Gemm g{(const bf16*)(ws + WS_ACT), (const bf16*)(wl + OW_DN), MT, DM, FF}; pg8::StaticOrder S; S.init(MT, DM, G, bid);
            EpiRes E{ka->out, Hm, HB, rs_next, (const float*)ka->out};
            pg8::gemm_phase<EpiRes, pg8::StaticOrder, MK_ALIGN, MK_SP2>(lds, g, S, E); if (META) thin_gemm<EpiRes>(lds, g.A, g.Bt, g.K, g.N, E, bid, G);
        }
        SEAM(p + 7);
    }
#ifdef MK_DUMP_OFF
    if (IN(PH_FINAL)) { KArgsP ka = KARGS();
        const bf16* src = (const bf16*)(ka->ws + (MK_DUMP_OFF)); const bf16* src2 = (const bf16*)(ka->ws + (MK_DUMP_OFF2));
        for (int i = bid * 512 + threadIdx.x; i < NREAL * 1024; i += G * 512) { const int R = MK_DUMP_ROW(i >> 10), c = i & 1023; ka->out[i] = c < 512 ? bf2f(src[(size_t)R * (MK_DUMP_LD) + (c % (MK_DUMP_LD))]) : bf2f(src2[(size_t)R * (MK_DUMP_LD2) + (c % (MK_DUMP_LD2))]); }
    }
#else
    if (IN(PH_FINAL)) { KArgsP ka = KARGS();
        const float* rs = (const float*)(ka->ws + WS_RS) + (size_t)MK_RSIDX * TPR * 16; const float* gain = ka->in[22];
        int tl_ = threadIdx.x; asm volatile("" : "+v"(tl_));
        for (int i = bid * 512 + tl_; i < NREAL * 256; i += G * 512) {
            const int R = i >> 8, c4 = (i & 255) * 4;
            const float r = row_rstd(rs, R);
            f32x4 v = *(const f32x4*)(ka->out + (size_t)R * DM + c4); const f32x4 gn = *(const f32x4*)(gain + c4);
            v = v * r * gn;
            *(f32x4*)(ka->out + (size_t)R * DM + c4) = v;
        }
    }
#endif
#undef IN
#undef SEAM
}

extern "C" void kernel_launch(void* const* d_in, const int* in_sizes, int n_in, void* d_out, int out_size, void* d_ws, size_t ws_size, hipStream_t stream) {
    static int grid = 0;
    if (grid == 0) {
        if (n_in != 23 || out_size != NREAL * DM || ws_size < WS_END) { fprintf(stderr, "kernel_launch: unexpected shapes (n_in %d out %d ws %zu)\n", n_in, out_size, ws_size); grid = -1; return; }
        int dev = 0, cus = 0, per_cu = 0;
        hipGetDevice(&dev); hipDeviceGetAttribute(&cus, hipDeviceAttributeMultiprocessorCount, dev);
        if (hipFuncSetAttribute((const void*)fwd_kernel, hipFuncAttributeMaxDynamicSharedMemorySize, LDS_BYTES) != hipSuccess) { fprintf(stderr, "kernel_launch: hipFuncSetAttribute failed\n"); grid = -1; return; }
        if (hipOccupancyMaxActiveBlocksPerMultiprocessor(&per_cu, (const void*)fwd_kernel, 512, LDS_BYTES) != hipSuccess || per_cu < 1) { fprintf(stderr, "kernel_launch: occupancy query gave %d\n", per_cu); per_cu = 1; }
        (void)hipGetLastError();
        grid = cus * (per_cu > 1 ? 1 : per_cu);
        if (grid <= 0) grid = 256;
    }
    if (grid < 0) return;
    Args a{};
    for (int i = 0; i < 23; ++i) a.in[i] = (const float*)d_in[i];
    a.out = (float*)d_out; a.ws = (unsigned char*)d_ws;
#if MK_SPLIT
    for (int ph = 0; ph < NPHASE; ++ph) hipLaunchKernelGGL(fwd_kernel, dim3(grid), dim3(512), LDS_BYTES, stream, a, ph, ph + 1);
#else
    int lo = 0, hi = NPHASE;
    void* kargs[] = {(void*)&a, (void*)&lo, (void*)&hi};
    hipError_t e = hipLaunchCooperativeKernel((const void*)fwd_kernel, dim3(grid), dim3(512), kargs, LDS_BYTES, stream);
    if (e != hipSuccess) fprintf(stderr, "kernel_launch: cooperative launch failed: %s (grid %d)\n", hipGetErrorString(e), grid);
#endif
}
```

```cpp
#include <hip/hip_runtime.h>
#include <hip/hip_cooperative_groups.h>
#include <cstdio>
#include <cstdint>
namespace cg = cooperative_groups;
namespace pg8 {
#define PG8_LAS __attribute__((address_space(3)))
typedef unsigned short bf16_t;
typedef short bf16x8 __attribute__((ext_vector_type(8)));
typedef float f32x4 __attribute__((ext_vector_type(4)));
typedef unsigned u32x4 __attribute__((ext_vector_type(4)));
constexpr int BM = 256, BK = 64, HALF = 128, HTB = HALF * BK * 2  , STAGE_BYTES = 8 * HTB, NXCD = 8, WGM = 8;

__host__ __device__ __forceinline__ int lds_byte(int r, int c) { const int st = (r >> 4) * 2 + (c >> 5), rr = r & 15, cc = c & 31, ob = rr * 64 + cc * 2; return st * 1024 + (ob ^ (((ob >> 9) & 1) << 5)); }
__host__ __device__ __forceinline__ void stage_rc(int b, int& R, int& C) { const int st = b / 1024, sb = b % 1024, swz = sb ^ (((sb >> 9) & 1) << 5); R = (st >> 1) * 16 + swz / 64; C = (st & 1) * 32 + (swz % 64) / 2; }
__host__ __device__ __forceinline__ int perm32(int rho) { const int n = rho >> 4, i = rho & 15; return 8 * (i >> 2) + 4 * n + (i & 3); }

struct Unit { int pm, pn; };
struct Gemm { const bf16_t* A; const bf16_t* Bt; int M, N, K; };

struct StaticOrder {
    int nM, nN, nwg, G, c;
    __host__ __device__ void init(int M, int N, int G_, int c_) { nM = M / BM; nN = N / BM; nwg = nM * nN; G = G_; c = c_; }
    __host__ __device__ bool next(int i, Unit& u) const {
        const long L = (long)i * G + c; if (L >= nwg) return false;
        int wgid = (int)L; { const int q = nwg / NXCD, r = nwg % NXCD, xcd = wgid % NXCD, off = wgid / NXCD; wgid = (xcd < r ? xcd * (q + 1) : r * (q + 1) + (xcd - r) * q) + off; }
        const int nig = WGM * nN, gid = wgid / nig, fm = gid * WGM, gsz = (nM - fm) < WGM ? (nM - fm) : WGM;
        u.pm = fm + ((wgid % nig) % gsz); u.pn = (wgid % nig) / gsz; return true;
    }
    __device__ __forceinline__ void a_ready(const Unit&) const {}
    __device__ __forceinline__ void done(const Unit&) const {}
};

__device__ __forceinline__ unsigned cvt_pk_bf16(float lo, float hi) { unsigned r; asm volatile("v_cvt_pk_bf16_f32 %0, %1, %2" : "=v"(r) : "v"(lo), "v"(hi)); return r; }
template <class Epi, class Sched, bool ALIGN_EPI = false, bool SP2 = false>
__device__ __forceinline__ void gemm_phase(PG8_LAS unsigned char* lds, const Gemm g, const Sched& S, const Epi& E) {
    int tid_l = threadIdx.x; asm volatile("" : "+v"(tid_l));
    const int tid = tid_l, wid = __builtin_amdgcn_readfirstlane(tid >> 6), lane = tid & 63, wr = wid >> 2, wc = wid & 3, fr = lane & 15, fq = lane >> 4;
    const int K = g.K, nt = K / BK;
    unsigned voffA[2], voffB[2];
#pragma unroll
    for (int i = 0; i < 2; ++i) { int R, C; stage_rc(tid * 16 + i * 8192, R, C); const int Rb = Epi::PERM ? ((R & ~31) + perm32(R & 31)) : R;
        voffA[i] = (unsigned)(R * K + C) * 2u; voffB[i] = (unsigned)(Rb * K + C) * 2u; }
    const size_t kstep = (size_t)(BK * 2);
    const size_t hstep = (size_t)HALF * K * 2;
    const size_t tstep = 2 * hstep;
    const unsigned ldsw = (unsigned)wid * 1024u;
    const int aoff = lds_byte(wr * 64 + fr, fq * 8), boff = lds_byte(wc * 32 + fr, fq * 8);
#define PG8_SA(b, h) (((b) * 2 + (h)) * HTB)
#define PG8_SB(b, h) ((4 + (b) * 2 + (h)) * HTB)
#define PG8_STAGE(bufoff, gbase, voff) do { _Pragma("unroll") for (int _i = 0; _i < 2; ++_i) \
        __builtin_amdgcn_global_load_lds((const unsigned*)((const char*)(gbase) + (voff)[_i]), (PG8_LAS unsigned*)(lds + (bufoff) + ldsw + _i * 8192), 16, 0, 0); } while (0)
#define PG8_LDA(dst, b, h) do { _Pragma("unroll") for (int m = 0; m < 4; ++m) _Pragma("unroll") for (int k = 0; k < 2; ++k) dst[m][k] = *(const PG8_LAS bf16x8*)(lds + PG8_SA(b, h) + aoff + m * 2048 + k * 1024); } while (0)
#define PG8_LDB(dst, b, h) do { _Pragma("unroll") for (int n = 0; n < 2; ++n) _Pragma("unroll") for (int k = 0; k < 2; ++k) dst[n][k] = *(const PG8_LAS bf16x8*)(lds + PG8_SB(b, h) + boff + n * 2048 + k * 1024); } while (0)
#define PG8_MMA(ai, bj, At, Bt) do { __builtin_amdgcn_s_setprio(1); _Pragma("unroll") for (int m = 0; m < 4; ++m) _Pragma("unroll") for (int n = 0; n < 2; ++n) _Pragma("unroll") for (int k = 0; k < 2; ++k) \
        acc[ai][bj][m][n] = __builtin_amdgcn_mfma_f32_16x16x32_bf16(Bt[n][k], At[m][k], acc[ai][bj][m][n], 0, 0, 0); __builtin_amdgcn_s_setprio(0); } while (0)
#define PG8_WAIT_V(n) asm volatile("s_waitcnt vmcnt(" #n ")" ::: "memory")
#define PG8_WAIT_L(n) asm volatile("s_waitcnt lgkmcnt(" #n ")" ::: "memory")
#define PG8_BAR __builtin_amdgcn_s_barrier()
#define PG8_SCHED __builtin_amdgcn_sched_barrier(0)
    Unit cur, nxt; int ui = 0;
    if (!S.next(0, cur)) return;
    f32x4 acc[2][2][4][2];
#pragma unroll
    for (int a = 0; a < 2; ++a)
#pragma unroll
        for (int b = 0; b < 2; ++b)
#pragma unroll
            for (int m = 0; m < 4; ++m)
#pragma unroll
                for (int n = 0; n < 2; ++n) acc[a][b][m][n] = (f32x4){0.f, 0.f, 0.f, 0.f};
    bf16x8 At[4][2], B0[2][2], B1[2][2];
    const char* cA = (const char*)g.A + (size_t)cur.pm * tstep; const char* cB = (const char*)g.Bt + (size_t)cur.pn * tstep;
    S.a_ready(cur);
    if constexpr (SP2) {
        PG8_STAGE(PG8_SB(0, 0), cB, voffB); PG8_STAGE(PG8_SB(0, 1), cB + hstep, voffB); PG8_STAGE(PG8_SA(0, 0), cA, voffA); PG8_STAGE(PG8_SA(0, 1), cA + hstep, voffA);
        if (wr == 1) PG8_BAR;
        PG8_WAIT_V(2); PG8_BAR;
        PG8_STAGE(PG8_SB(1, 0), cB + kstep, voffB); PG8_STAGE(PG8_SA(1, 0), cA + kstep, voffA); PG8_STAGE(PG8_SB(1, 1), cB + hstep + kstep, voffB);
        PG8_WAIT_V(6); PG8_BAR;
    } else {
        PG8_STAGE(PG8_SB(0, 0), cB, voffB); PG8_STAGE(PG8_SA(0, 0), cA, voffA); PG8_STAGE(PG8_SB(0, 1), cB + hstep, voffB); PG8_STAGE(PG8_SA(0, 1), cA + hstep, voffA);
        if (wr == 1) PG8_BAR;
        PG8_WAIT_V(4); PG8_BAR;
        PG8_STAGE(PG8_SB(1, 0), cB + kstep, voffB); PG8_STAGE(PG8_SA(1, 0), cA + kstep, voffA); PG8_STAGE(PG8_SB(1, 1), cB + hstep + kstep, voffB);
        PG8_WAIT_V(6); PG8_BAR;
    }
    for (;;) {
        const bool has_next = S.next(ui + 1, nxt);
        const char* nA = has_next ? (const char*)g.A + (size_t)nxt.pm * tstep : cA; const char* nB = has_next ? (const char*)g.Bt + (size_t)nxt.pn * tstep : cB;
        for (int t = 0; t < nt; t += 2) {
            const bool last = (t == nt - 2);
            const char* a1 = cA + (size_t)(t + 1) * kstep;
            const char* a2 = last ? nA : cA + (size_t)(t + 2) * kstep; const char* b2 = last ? nB : cB + (size_t)(t + 2) * kstep;
            const char* a3 = a2 + kstep; const char* b3 = b2 + kstep;
            if (last && has_next) S.a_ready(nxt);
            if constexpr (SP2) {
            PG8_LDB(B0, 0, 0); PG8_LDB(B1, 0, 1); PG8_SCHED; PG8_LDA(At, 0, 0); PG8_STAGE(PG8_SA(1, 1), a1 + hstep, voffA);
            PG8_WAIT_V(8); PG8_WAIT_L(0); PG8_BAR; PG8_MMA(0, 0, At, B0); PG8_MMA(0, 1, At, B1); PG8_BAR; PG8_SCHED;
            PG8_LDA(At, 0, 1); PG8_STAGE(PG8_SB(0, 0), b2, voffB); PG8_STAGE(PG8_SB(0, 1), b2 + hstep, voffB); PG8_STAGE(PG8_SA(0, 0), a2, voffA);
            PG8_WAIT_V(8); PG8_WAIT_L(0); PG8_BAR; PG8_MMA(1, 0, At, B0); PG8_MMA(1, 1, At, B1); PG8_BAR; PG8_SCHED;
            PG8_LDB(B0, 1, 0); PG8_LDB(B1, 1, 1); PG8_SCHED; PG8_LDA(At, 1, 0); PG8_STAGE(PG8_SA(0, 1), a2 + hstep, voffA);
            PG8_WAIT_V(8); PG8_WAIT_L(0); PG8_BAR; PG8_MMA(0, 0, At, B0); PG8_MMA(0, 1, At, B1); PG8_BAR; PG8_SCHED;
            PG8_LDA(At, 1, 1); PG8_STAGE(PG8_SB(1, 0), b3, voffB); PG8_STAGE(PG8_SB(1, 1), b3 + hstep, voffB); PG8_STAGE(PG8_SA(1, 0), a3, voffA);
            PG8_WAIT_V(8); PG8_WAIT_L(0); PG8_BAR; PG8_MMA(1, 0, At, B0); PG8_MMA(1, 1, At, B1); PG8_BAR; PG8_SCHED;
            } else {
            PG8_LDB(B0, 0, 0); PG8_SCHED; PG8_LDA(At, 0, 0); PG8_STAGE(PG8_SA(1, 1), a1 + hstep, voffA);
            PG8_WAIT_L(8); PG8_BAR; PG8_WAIT_L(0); PG8_MMA(0, 0, At, B0); PG8_BAR; PG8_SCHED;
            PG8_LDB(B1, 0, 1); PG8_STAGE(PG8_SB(0, 0), b2, voffB);
            PG8_BAR; PG8_WAIT_L(0); PG8_MMA(0, 1, At, B1); PG8_BAR;
            PG8_LDA(At, 0, 1); PG8_STAGE(PG8_SA(0, 0), a2, voffA);
            PG8_BAR; PG8_WAIT_L(0); PG8_MMA(1, 0, At, B0); PG8_BAR; PG8_SCHED;
            PG8_STAGE(PG8_SB(0, 1), b2 + hstep, voffB);
            PG8_WAIT_V(6); PG8_BAR; PG8_MMA(1, 1, At, B1); PG8_BAR;
            PG8_LDB(B0, 1, 0); PG8_SCHED; PG8_LDA(At, 1, 0); PG8_STAGE(PG8_SA(0, 1), a2 + hstep, voffA);
            PG8_WAIT_L(8); PG8_BAR; PG8_WAIT_L(0); PG8_MMA(0, 0, At, B0); PG8_BAR; PG8_SCHED;
            PG8_LDB(B1, 1, 1); PG8_STAGE(PG8_SB(1, 0), b3, voffB);
            PG8_BAR; PG8_WAIT_L(0); PG8_MMA(0, 1, At, B1); PG8_BAR;
            PG8_LDA(At, 1, 1); PG8_STAGE(PG8_SA(1, 0), a3, voffA);
            PG8_BAR; PG8_WAIT_L(0); PG8_MMA(1, 0, At, B0); PG8_BAR; PG8_SCHED;
            PG8_STAGE(PG8_SB(1, 1), b3 + hstep, voffB);
            PG8_WAIT_V(6); PG8_BAR; PG8_MMA(1, 1, At, B1); PG8_BAR;
            }
        }
        if constexpr (ALIGN_EPI) { if (wr == 0) PG8_BAR; }
        asm volatile("s_nop 15\n\ts_nop 15" ::: "memory");
        if constexpr (!Epi::AFTER_DRAIN) { E(acc, cur, wr, wc, fr, fq); S.done(cur); }
        if (!has_next) break;
#pragma unroll
        for (int a = 0; a < 2; ++a)
#pragma unroll
            for (int b = 0; b < 2; ++b)
#pragma unroll
                for (int m = 0; m < 4; ++m)
#pragma unroll
                    for (int n = 0; n < 2; ++n) acc[a][b][m][n] = (f32x4){0.f, 0.f, 0.f, 0.f};
        cur = nxt; cA = nA; cB = nB; ++ui;
        if constexpr (ALIGN_EPI) { if (wr == 1) PG8_BAR; }
    }
    PG8_WAIT_V(0);
    if constexpr (!ALIGN_EPI) { if (wr == 0) PG8_BAR; }
    PG8_BAR;
    if constexpr (Epi::AFTER_DRAIN) { E.fused(acc, cur, wr, wc, fr, fq, lds, wid, lane); S.done(cur); }
#undef PG8_SA
#undef PG8_SB
#undef PG8_STAGE
#undef PG8_LDA
#undef PG8_LDB
#undef PG8_MMA
#undef PG8_WAIT_V
#undef PG8_WAIT_L
#undef PG8_BAR
#undef PG8_SCHED
}
}

#define LAS __attribute__((address_space(3)))
typedef unsigned short bf16;
typedef short bf16x8 __attribute__((ext_vector_type(8)));
typedef float f32x4 __attribute__((ext_vector_type(4)));
typedef float f32x16 __attribute__((ext_vector_type(16)));
typedef unsigned u32x2 __attribute__((ext_vector_type(2)));
typedef unsigned u32x4 __attribute__((ext_vector_type(4)));

constexpr int NB = 8, SEQ = 2048, NMETA = 16, LL = 2064, DM = 1024, FF = 4096, DIN = 4864, NPROJ = 1792;
constexpr int NREAL = NB * SEQ;
constexpr int TPR = NREAL + 256;
constexpr int LDS_BYTES = 147456;

constexpr size_t MiB = 1u << 20;
constexpr size_t WS_CTL = 0;
constexpr size_t WS_ROPE = 1 * MiB;
constexpr size_t WS_ABAR = 2 * MiB;
constexpr size_t WS_BMAT = 2 * MiB + 65536;
constexpr size_t WS_CMAT = WS_BMAT + 524288;
constexpr size_t WS_HM = 4 * MiB;
constexpr size_t WS_W = 5 * MiB;
constexpr size_t OW_IN = 0, OW_GLU = (size_t)DIN * DM * 2, OW_POOL = OW_GLU + 512 * 512 * 2, OW_BR = OW_POOL + 512 * 512 * 2,
                 OW_OUT = OW_BR + 3 * 1024 * 512 * 2, OW_UP = OW_OUT + 1024 * 1024 * 2, OW_DN = OW_UP + (size_t)FF * DM * 2, LW_BYTES = OW_DN + (size_t)FF * DM * 2;
constexpr size_t WS_HB = 68 * MiB;
constexpr size_t WS_X = 101 * MiB;
constexpr size_t UU = (size_t)TPR * 512 * 2;
constexpr size_t WS_YF = WS_X, WS_YP = WS_X, WS_Q = WS_X + 2 * UU, WS_K = WS_Q + UU, WS_V = WS_K + UU / 4, WS_MG = WS_X + 2 * UU,
                 WS_SU = WS_X + 4 * UU, WS_YA = WS_X + 8 * UU  , WS_PU = WS_X + 5 * UU, WS_YS = WS_PU, WS_Z = WS_X + 6 * UU, WS_PD = WS_X + 7 * UU, WS_BR = WS_Z, WS_ACT = WS_X;
constexpr size_t WS_RS = WS_X + 9 * UU;
constexpr size_t WS_END = WS_RS + (size_t)5 * TPR * 16 * 4;
static_assert(WS_W + 2 * LW_BYTES <= WS_HB && WS_HB + (size_t)TPR * 1024 * 2 <= WS_X && WS_END <= 256 * MiB, "ws map");
static_assert((size_t)256 * 2064 * 16 * 4 <= 2 * UU, "YF fits");

__device__ __forceinline__ unsigned pk2(float lo, float hi) { unsigned r; asm("v_cvt_pk_bf16_f32 %0, %1, %2" : "=v"(r) : "v"(lo), "v"(hi)); return r; }
__device__ __forceinline__ unsigned f2bf(float f) { return pk2(f, 0.f) & 0xffffu; }
__device__ __forceinline__ float bf2f(unsigned b) { return __uint_as_float(b << 16); }
__device__ __forceinline__ int tok_row(int b, int l) { return l >= NMETA ? b * SEQ + l - NMETA : NREAL + b * NMETA + l; }
#define LDS_FENCE() asm volatile("s_waitcnt lgkmcnt(0)" ::: "memory")
#define SSM_SYNC() do { asm volatile("s_waitcnt vmcnt(0) lgkmcnt(0)" ::: "memory"); __syncthreads(); } while (0)
__device__ __forceinline__ float row_rstd(const float* rs, int R) {
    const f32x4 a = *(const f32x4*)(rs + (size_t)R * 4), b = *(const f32x4*)(rs + ((size_t)TPR + R) * 4), c = *(const f32x4*)(rs + ((size_t)2 * TPR + R) * 4), d = *(const f32x4*)(rs + ((size_t)3 * TPR + R) * 4);
    const float s = (((a[0] + a[1]) + (a[2] + a[3])) + ((b[0] + b[1]) + (b[2] + b[3]))) + (((c[0] + c[1]) + (c[2] + c[3])) + ((d[0] + d[1]) + (d[2] + d[3])));
    return rsqrtf(s * (1.0f / 1024.0f) + 1e-6f);
}

__device__ __forceinline__ void dsincos(double a, double& s, double& c) {
    const double q = rint(a * 0.63661977236758134308);
    double r = fma(-q, 1.57079632679489655800e+00, a); r = fma(-q, 6.12323399573676603587e-17, r);
    const double r2 = r * r;
    double sp = -7.6471637318198164759e-13; sp = fma(sp, r2, 1.6059043836821614599e-10); sp = fma(sp, r2, -2.5052108385441718775e-08); sp = fma(sp, r2, 2.7557319223985890653e-06);
    sp = fma(sp, r2, -1.9841269841269841270e-04); sp = fma(sp, r2, 8.3333333333333333333e-03); sp = fma(sp, r2, -1.6666666666666666667e-01); sp = fma(sp * r2, r, r);
    double cp = 4.7794773323873852974e-14; cp = fma(cp, r2, -1.1470745597729724714e-11); cp = fma(cp, r2, 2.0876756987868098979e-09); cp = fma(cp, r2, -2.7557319223985890653e-07);
    cp = fma(cp, r2, 2.4801587301587301587e-05); cp = fma(cp, r2, -1.3888888888888888889e-03); cp = fma(cp, r2, 4.1666666666666666667e-02); cp = fma(cp, r2, -0.5); cp = fma(cp, r2, 1.0);
    const int qi = ((int)q) & 3;
    s = (qi == 0) ? sp : (qi == 1) ? cp : (qi == 2) ? -sp : -cp;
    c = (qi == 0) ? cp : (qi == 1) ? -sp : (qi == 2) ? -cp : sp;
}
__device__ __forceinline__ double dexp(double x) {
    const double k = rint(x * 1.44269504088896340736);
    double r = fma(-k, 6.93147180369123816490e-01, x); r = fma(-k, 1.90821492927058770002e-10, r);
    double p = 1.0 / 6227020800.0; p = fma(p, r, 1.0 / 479001600.0); p = fma(p, r, 1.0 / 39916800.0); p = fma(p, r, 1.0 / 3628800.0); p = fma(p, r, 1.0 / 362880.0); p = fma(p, r, 1.0 / 40320.0);
    p = fma(p, r, 1.0 / 5040.0); p = fma(p, r, 1.0 / 720.0); p = fma(p, r, 1.0 / 120.0); p = fma(p, r, 1.0 / 24.0); p = fma(p, r, 1.0 / 6.0); p = fma(p, r, 0.5); p = fma(p, r, 1.0); p = fma(p, r, 1.0);
    const long long bits = ((long long)(1023 + (int)k)) << 52;
    return p * __longlong_as_double(bits);
}

struct EpiInProj {
    static constexpr bool PERM = true, AFTER_DRAIN = false;
    const float* rowss; const float* rope; bf16 *Q, *K, *V, *SU, *PU;
    __device__ __forceinline__ u32x2 quad(int l, int c, const f32x4& v) const {
        u32x2 w;
        if (c < 640) {
            const int i0 = (c & 63) >> 1;
            const f32x4 cs = *(const f32x4*)(rope + ((size_t)l * 32 + i0) * 2);
            float o0 = v[0] * cs[0] - v[1] * cs[1], o1 = v[1] * cs[0] + v[0] * cs[1], o2 = v[2] * cs[2] - v[3] * cs[3], o3 = v[3] * cs[2] + v[2] * cs[3];
            if (c < 512) { o0 *= 0.125f; o1 *= 0.125f; o2 *= 0.125f; o3 *= 0.125f; }
            w.x = pk2(o0, o1); w.y = pk2(o2, o3);
        } else { w.x = pk2(v[0], v[1]); w.y = pk2(v[2], v[3]); }
        return w;
    }
    __device__ __forceinline__ void operator()(const f32x4 (&acc)[2][2][4][2], const pg8::Unit& u, int wr, int wc, int fr, int fq) const {
#pragma unroll
        for (int ai = 0; ai < 2; ++ai)
#pragma unroll
            for (int m = 0; m < 4; ++m) {
                const int R = u.pm * 256 + ai * 128 + wr * 64 + m * 16 + fr;
                const float rs = row_rstd(rowss, R);
                const int l = R < NREAL ? (R & 2047) + NMETA : (R & 15);
#pragma unroll
                for (int bj = 0; bj < 2; ++bj) {
                    const int c = u.pn * 256 + bj * 128 + wc * 32 + 8 * fq;
                    const u32x2 w0 = quad(l, c, acc[ai][bj][m][0] * rs), w1 = quad(l, c + 4, acc[ai][bj][m][1] * rs);
                    u32x4 w; w.x = w0.x; w.y = w0.y; w.z = w1.x; w.w = w1.y;
                    bf16* dst = c < 512 ? Q + (size_t)R * 512 + c : c < 640 ? K + (size_t)R * 128 + (c - 512) : c < 768 ? V + (size_t)R * 128 + (c - 640)
                              : c < 1280 ? SU + (size_t)R * 512 + (c - 768) : PU + (size_t)R * 512 + (c - 1280);
                    *(u32x4*)dst = w;
                }
            }
    }
};
#define EPI_BODY() \
    __device__ __forceinline__ void rg(int R, int pn, int wc, int fq, const f32x4 (&a4)[2][2]) const { \
        _Pragma("unroll") for (int bj = 0; bj < 2; ++bj) q2(R, pn * 256 + bj * 128 + wc * 32 + 8 * fq, a4[bj][0], a4[bj][1]); } \
    __device__ __forceinline__ void tq(int R, int c, const f32x4& v) const { q(R, c, v); } \
    EPI_OP()
#define EPI_OP() \
    __device__ __forceinline__ void operator()(const f32x4 (&acc)[2][2][4][2], const pg8::Unit& u, int wr, int wc, int fr, int fq) const { \
        _Pragma("unroll") for (int ai = 0; ai < 2; ++ai) _Pragma("unroll") for (int m = 0; m < 4; ++m) { \
            const f32x4 a4[2][2] = {{acc[ai][0][m][0], acc[ai][0][m][1]}, {acc[ai][1][m][0], acc[ai][1][m][1]}}; \
            rg(u.pm * 256 + ai * 128 + wr * 64 + m * 16 + fr, u.pn, wc, fq, a4); } }
#define EPI_BODY_RS() \
    __device__ __forceinline__ void rg(int R, int pn, int wc, int fq, const f32x4 (&a4)[2][2]) const { const float rs = row_rstd(rowss, R); \
        _Pragma("unroll") for (int bj = 0; bj < 2; ++bj) q2(R, pn * 256 + bj * 128 + wc * 32 + 8 * fq, a4[bj][0], a4[bj][1], rs); } \
    __device__ __forceinline__ void tq(int R, int c, const f32x4& v) const { q(R, c, v, row_rstd(rowss, R)); } \
    EPI_OP()
struct EpiGlu {
    static constexpr bool PERM = true, AFTER_DRAIN = false;
    const bf16* Z; const float* bias; bf16* YS;
    __device__ __forceinline__ void q(int R, int c, const f32x4& a) const {
        const f32x4 v = a + *(const f32x4*)(bias + c);
        const u32x2 zz = *(const u32x2*)(Z + (size_t)R * 512 + c);
        const float z0 = bf2f(zz.x & 0xffffu), z1 = bf2f(zz.x >> 16), z2 = bf2f(zz.y & 0xffffu), z3 = bf2f(zz.y >> 16);
        u32x2 w; w.x = pk2(z0 * __builtin_amdgcn_rcpf(1.0f + __expf(-v[0])), z1 * __builtin_amdgcn_rcpf(1.0f + __expf(-v[1]))); w.y = pk2(z2 * __builtin_amdgcn_rcpf(1.0f + __expf(-v[2])), z3 * __builtin_amdgcn_rcpf(1.0f + __expf(-v[3])));
        *(u32x2*)(YS + (size_t)R * 512 + c) = w;
    }
    __device__ __forceinline__ void q2(int R, int c, const f32x4& a0, const f32x4& a1) const {
        const f32x4 v0 = a0 + *(const f32x4*)(bias + c), v1 = a1 + *(const f32x4*)(bias + c + 4);
        const u32x4 zz = *(const u32x4*)(Z + (size_t)R * 512 + c);
        u32x4 w;
        w.x = pk2(bf2f(zz.x & 0xffffu) * __builtin_amdgcn_rcpf(1.0f + __expf(-v0[0])), bf2f(zz.x >> 16) * __builtin_amdgcn_rcpf(1.0f + __expf(-v0[1])));
        w.y = pk2(bf2f(zz.y & 0xffffu) * __builtin_amdgcn_rcpf(1.0f + __expf(-v0[2])), bf2f(zz.y >> 16) * __builtin_amdgcn_rcpf(1.0f + __expf(-v0[3])));
        w.z = pk2(bf2f(zz.z & 0xffffu) * __builtin_amdgcn_rcpf(1.0f + __expf(-v1[0])), bf2f(zz.z >> 16) * __builtin_amdgcn_rcpf(1.0f + __expf(-v1[1])));
        w.w = pk2(bf2f(zz.w & 0xffffu) * __builtin_amdgcn_rcpf(1.0f + __expf(-v1[2])), bf2f(zz.w >> 16) * __builtin_amdgcn_rcpf(1.0f + __expf(-v1[3])));
        *(u32x4*)(YS + (size_t)R * 512 + c) = w;
    }
    EPI_BODY()
};
struct EpiScale {
    static constexpr bool PERM = true, AFTER_DRAIN = false;
    bf16* O; int ldc; const float* scale;
    __device__ __forceinline__ void q(int R, int c, const f32x4& a) const {
        f32x4 v = a;
        if (scale) v = v * *(const f32x4*)(scale + c);
        u32x2 w; w.x = pk2(v[0], v[1]); w.y = pk2(v[2], v[3]);
        *(u32x2*)(O + (size_t)R * ldc + c) = w;
    }
    __device__ __forceinline__ void q2(int R, int c, const f32x4& a0, const f32x4& a1) const {
        f32x4 v0 = a0, v1 = a1;
        if (scale) { v0 = v0 * *(const f32x4*)(scale + c); v1 = v1 * *(const f32x4*)(scale + c + 4); }
        u32x4 w; w.x = pk2(v0[0], v0[1]); w.y = pk2(v0[2], v0[3]); w.z = pk2(v1[0], v1[1]); w.w = pk2(v1[2], v1[3]);
        *(u32x4*)(O + (size_t)R * ldc + c) = w;
    }
    EPI_BODY()
};
template <bool FIRST> struct EpiGate {
    static constexpr bool PERM = true, AFTER_DRAIN = false;
    const float* rowss; const bf16* BR; bf16* MG;
    __device__ __forceinline__ void q(int R, int c, const f32x4& a, float rs) const {
        const f32x4 v = a * rs;
        const u32x2 bb = *(const u32x2*)(BR + (size_t)R * 1024 + c);
        float o0 = bf2f(bb.x & 0xffffu) * __builtin_amdgcn_rcpf(1.0f + __expf(-v[0])), o1 = bf2f(bb.x >> 16) * __builtin_amdgcn_rcpf(1.0f + __expf(-v[1]));
        float o2 = bf2f(bb.y & 0xffffu) * __builtin_amdgcn_rcpf(1.0f + __expf(-v[2])), o3 = bf2f(bb.y >> 16) * __builtin_amdgcn_rcpf(1.0f + __expf(-v[3]));
        if (!FIRST) { const u32x2 mm = *(const u32x2*)(MG + (size_t)R * 1024 + c);
            o0 += bf2f(mm.x & 0xffffu); o1 += bf2f(mm.x >> 16); o2 += bf2f(mm.y & 0xffffu); o3 += bf2f(mm.y >> 16); }
        u32x2 w; w.x = pk2(o0, o1); w.y = pk2(o2, o3);
        *(u32x2*)(MG + (size_t)R * 1024 + c) = w;
    }
    __device__ __forceinline__ void q2(int R, int c, const f32x4& a0, const f32x4& a1, float rs) const {
        const f32x4 v0 = a0 * rs, v1 = a1 * rs;
        const u32x4 bb = *(const u32x4*)(BR + (size_t)R * 1024 + c);
        float o[8];
        o[0] = bf2f(bb.x & 0xffffu) * __builtin_amdgcn_rcpf(1.0f + __expf(-v0[0])); o[1] = bf2f(bb.x >> 16) * __builtin_amdgcn_rcpf(1.0f + __expf(-v0[1]));
        o[2] = bf2f(bb.y & 0xffffu) * __builtin_amdgcn_rcpf(1.0f + __expf(-v0[2])); o[3] = bf2f(bb.y >> 16) * __builtin_amdgcn_rcpf(1.0f + __expf(-v0[3]));
        o[4] = bf2f(bb.z & 0xffffu) * __builtin_amdgcn_rcpf(1.0f + __expf(-v1[0])); o[5] = bf2f(bb.z >> 16) * __builtin_amdgcn_rcpf(1.0f + __expf(-v1[1]));
        o[6] = bf2f(bb.w & 0xffffu) * __builtin_amdgcn_rcpf(1.0f + __expf(-v1[2])); o[7] = bf2f(bb.w >> 16) * __builtin_amdgcn_rcpf(1.0f + __expf(-v1[3]));
        if (!FIRST) { const u32x4 mm = *(const u32x4*)(MG + (size_t)R * 1024 + c);
            o[0] += bf2f(mm.x & 0xffffu); o[1] += bf2f(mm.x >> 16); o[2] += bf2f(mm.y & 0xffffu); o[3] += bf2f(mm.y >> 16);
            o[4] += bf2f(mm.z & 0xffffu); o[5] += bf2f(mm.z >> 16); o[6] += bf2f(mm.w & 0xffffu); o[7] += bf2f(mm.w >> 16); }
        u32x4 w; w.x = pk2(o[0], o[1]); w.y = pk2(o[2], o[3]); w.z = pk2(o[4], o[5]); w.w = pk2(o[6], o[7]);
        *(u32x4*)(MG + (size_t)R * 1024 + c) = w;
    }
    EPI_BODY_RS()
};
struct EpiRes {
    static constexpr bool PERM = true, AFTER_DRAIN = false;
    float* Hreal; float* Hmeta; bf16* HB; float* rowss_out; const float* Hin;
    __device__ __forceinline__ float q(int R, int c, const f32x4& a) const {
        float* hrow = R < NREAL ? Hreal + (size_t)R * 1024 : Hmeta + (size_t)(R - NREAL) * 1024;
        const float* hin = R < NREAL ? Hin + (size_t)R * 1024 : hrow;
        const f32x4 h = *(const f32x4*)(hin + c) + a;
        *(f32x4*)(hrow + c) = h;
        if (HB) { u32x2 w; w.x = pk2(h[0], h[1]); w.y = pk2(h[2], h[3]); *(u32x2*)(HB + (size_t)R * 1024 + c) = w; }
        return (h[0] * h[0] + h[1] * h[1]) + (h[2] * h[2] + h[3] * h[3]);
    }
    __device__ __forceinline__ void rg(int R, int pn, int wc, int fq, const f32x4 (&a4)[2][2]) const {
        float ss = 0.f;
#pragma unroll
        for (int bj = 0; bj < 2; ++bj)
#pragma unroll
            for (int n = 0; n < 2; ++n) ss += q(R, pn * 256 + bj * 128 + wc * 32 + 8 * fq + 4 * n, a4[bj][n]);
        ss += __shfl_xor(ss, 16); ss += __shfl_xor(ss, 32);
        if (fq == 0) rowss_out[((size_t)pn * TPR + R) * 4 + wc] = ss;
    }
    __device__ __forceinline__ void tq(int R, int c, const f32x4& v) const {
        float ss = q(R, c, v);
        ss += __shfl_xor(ss, 16); ss += __shfl_xor(ss, 32);
        if ((threadIdx.x & 48) == 0) atomicAdd(rowss_out + (size_t)R * 4, ss);
    }
    EPI_OP()
};
struct EpiUp {
    static constexpr bool PERM = true, AFTER_DRAIN = false;
    const float* rowss; bf16* ACT;
    __device__ __forceinline__ void q(int R, int c, const f32x4& a, float rs) const {
        f32x4 v = a * rs;
#pragma unroll
        for (int j = 0; j < 4; ++j) { const float r = fmaxf(v[j], 0.f); v[j] = r * r; }
        u32x2 w; w.x = pk2(v[0], v[1]); w.y = pk2(v[2], v[3]);
        *(u32x2*)(ACT + (size_t)R * FF + c) = w;
    }
    __device__ __forceinline__ void q2(int R, int c, const f32x4& a0, const f32x4& a1, float rs) const {
        f32x4 v0 = a0 * rs, v1 = a1 * rs;
#pragma unroll
        for (int j = 0; j < 4; ++j) { const float r0 = fmaxf(v0[j], 0.f), r1 = fmaxf(v1[j], 0.f); v0[j] = r0 * r0; v1[j] = r1 * r1; }
        u32x4 w; w.x = pk2(v0[0], v0[1]); w.y = pk2(v0[2], v0[3]); w.z = pk2(v1[0], v1[1]); w.w = pk2(v1[2], v1[3]);
        *(u32x4*)(ACT + (size_t)R * FF + c) = w;
    }
    EPI_BODY_RS()
};
template <class Epi>
__device__ __forceinline__ void thin_gemm(LAS unsigned char* lds, const bf16* A, const bf16* Bt, int K, int N, const Epi& E, int vb, int vg) {
    int tid_l = threadIdx.x; asm volatile("" : "+v"(tid_l));
    const int lane = tid_l & 63, w = __builtin_amdgcn_readfirstlane(tid_l >> 6), fr = lane & 15, fq = lane >> 4;
    LAS f32x4* red = (LAS f32x4*)lds;
    const int kw = K >> 3;
    for (int pc = vb; pc < N / 16; pc += vg) {
        const bf16* ap = A + (size_t)(NREAL + fr) * K + w * kw + 8 * fq;
        const bf16* bp = Bt + (size_t)(16 * pc + fr) * K + w * kw + 8 * fq;
        f32x4 acc[8];
#pragma unroll
        for (int rb = 0; rb < 8; ++rb) acc[rb] = (f32x4){0.f, 0.f, 0.f, 0.f};
#pragma unroll 2
        for (int k0 = 0; k0 < kw; k0 += 32) {
            const bf16x8 bf = *(const bf16x8*)(bp + k0);
            bf16x8 af[8];
#pragma unroll
            for (int rb = 0; rb < 8; ++rb) af[rb] = *(const bf16x8*)(ap + (size_t)(16 * rb) * K + k0);
#pragma unroll
            for (int rb = 0; rb < 8; ++rb) acc[rb] = __builtin_amdgcn_mfma_f32_16x16x32_bf16(bf, af[rb], acc[rb], 0, 0, 0);
        }
        asm volatile("s_nop 15\n\ts_nop 15" : "+v"(acc[0]), "+v"(acc[1]), "+v"(acc[2]), "+v"(acc[3]), "+v"(acc[4]), "+v"(acc[5]), "+v"(acc[6]), "+v"(acc[7]));
#pragma unroll
        for (int rb = 0; rb < 8; ++rb) red[(w * 8 + rb) * 64 + lane] = acc[rb];
        LDS_FENCE(); __syncthreads();
        f32x4 v = red[(0 * 8 + w) * 64 + lane];
#pragma unroll
        for (int ww = 1; ww < 8; ++ww) v = v + red[(ww * 8 + w) * 64 + lane];
        LDS_FENCE(); __syncthreads();
        E.tq(NREAL + 16 * w + fr, 16 * pc + 4 * fq, v);
    }
}

struct Args { const float* in[23]; float* out; unsigned char* ws; };

__device__ __forceinline__ void p0_item(const float* W, int ldw, int K, const float* scale, bf16* WT, int permrows, LAS float* scr, int item, int nblk, int lane) {
    const int kb = item / nblk, nb = item % nblk, k0 = 64 * kb, n0 = 64 * nb;
#pragma unroll 4
    for (int i = 0; i < 16; ++i) {
        const int kk = 4 * i + (lane >> 4), c4 = (lane & 15) * 4;
        f32x4 w = *(const f32x4*)(W + (size_t)(k0 + kk) * ldw + n0 + c4);
        if (scale) w = w * scale[k0 + kk];
        scr[kk * 65 + c4] = w[0]; scr[kk * 65 + c4 + 1] = w[1]; scr[kk * 65 + c4 + 2] = w[2]; scr[kk * 65 + c4 + 3] = w[3];
    }
    LDS_FENCE();
    const int c = lane & 7;
#pragma unroll
    for (int j = 0; j < 8; ++j) {
        const int n = (lane >> 3) + 8 * j;
        const int sc = (n0 + n) < permrows ? ((n & 1) ? 32 + (n >> 1) : (n >> 1)) : n;
        const LAS float* s = scr + (8 * c) * 65 + sc;
        u32x4 o; o.x = pk2(s[0 * 65], s[1 * 65]); o.y = pk2(s[2 * 65], s[3 * 65]); o.z = pk2(s[4 * 65], s[5 * 65]); o.w = pk2(s[6 * 65], s[7 * 65]);
        *(u32x4*)(WT + (size_t)(n0 + n) * K + k0 + 8 * c) = o;
    }
    LDS_FENCE();
}

__device__ __forceinline__ void p0_prologue(const Args& a, LAS unsigned char* lds) {
    int tl_ = threadIdx.x; asm volatile("" : "+v"(tl_));
    const int tid = tl_, lane = tid & 63, wave = __builtin_amdgcn_readfirstlane(tid >> 6);
    const int gw = blockIdx.x * 8 + wave, NGW = gridDim.x * 8;
    const int gt = blockIdx.x * 512 + tid, NGT = gridDim.x * 512;
    unsigned char* ws = a.ws;
    LAS float* scr = (LAS float*)(lds + wave * 17408);
    for (int i = gt; i < 4 * 4 * 128 * 4; i += NGT) { const int idx = 1 + (i >> 11), pn = (i >> 9) & 3, r = (i >> 2) & 127, sl = i & 3;
        ((float*)(ws + WS_RS))[((size_t)idx * 4 * TPR + (size_t)pn * TPR + NREAL + r) * 4 + sl] = 0.f; }
    constexpr int I_IN = 16 * 76, I_GLU = 8 * 8, I_BR = 8 * 16, I_OUT = 16 * 16, I_UP = 16 * 64, I_DN = 64 * 16, I_L = I_IN + I_GLU + 3 * I_BR + I_OUT + I_UP + I_DN;
    for (int it = gw; it < 2 * I_L; it += NGW) {
        const int layer = it / I_L; int r = it % I_L;
        unsigned char* wl = ws + WS_W + (size_t)layer * LW_BYTES;
        if (r < I_IN) { p0_item(a.in[3] + (size_t)layer * DM * DIN, DIN, DM, a.in[2] + layer * DM, (bf16*)(wl + OW_IN), 640, scr, r, 76, lane); continue; } r -= I_IN;
        if (r < I_GLU) { p0_item(a.in[13] + (size_t)layer * 512 * 512, 512, 512, nullptr, (bf16*)(wl + OW_GLU), 0, scr, r, 8, lane); continue; } r -= I_GLU;
        if (r < 3 * I_BR) { const int c = r / I_BR; p0_item(a.in[17] + ((size_t)layer * 3 + c) * 512 * 1024, 1024, 512, nullptr, (bf16*)(wl + OW_BR) + (size_t)c * 1024 * 512, 0, scr, r % I_BR, 16, lane); continue; } r -= 3 * I_BR;
        if (r < I_OUT) { p0_item(a.in[18] + (size_t)layer * DM * DM, DM, DM, nullptr, (bf16*)(wl + OW_OUT), 0, scr, r, 16, lane); continue; } r -= I_OUT;
        if (r < I_UP) { p0_item(a.in[20] + (size_t)layer * DM * FF, FF, DM, a.in[19] + layer * DM, (bf16*)(wl + OW_UP), 0, scr, r, 64, lane); continue; } r -= I_UP;
        p0_item(a.in[21] + (size_t)layer * FF * DM, DM, FF, nullptr, (bf16*)(wl + OW_DN), 0, scr, r, 16, lane);
    }
    for (int i = gt; i < 2 * 512 * 512; i += NGT) {
        const int layer = i >> 18, n = (i >> 9) & 511, k = i & 511;
        float w = 0.f;
        if ((n >> 7) == (k >> 7)) w = a.in[15][(((size_t)layer * 4 + (n >> 7)) * 128 + (k & 127)) * 128 + (n & 127)];
        ((bf16*)(ws + WS_W + (size_t)layer * LW_BYTES + OW_POOL))[(size_t)n * 512 + k] = (bf16)f2bf(w);
    }
    for (int i = gt; i < LL * 32; i += NGT) {
        const int l = i >> 5, f = i & 31;
        const float invf = (float)dexp(-(double)f * (9.21034037197618273607 / 32.0));
        const float ang = (float)l * invf;
        double s, c; dsincos((double)ang, s, c);
        float* rp = (float*)(ws + WS_ROPE) + (size_t)i * 2; rp[0] = (float)c; rp[1] = (float)s;
    }
    for (int i = gt; i < 2 * 2 * 32 * 64; i += NGT) {
        const int n = i & 63, pidx = i >> 6;
        const double lr = (double)a.in[5][i], li = (double)a.in[6][i];
        const double dt = (double)(float)dexp((double)a.in[7][pidx]);
        const double mag = dexp(lr * dt); double sn, cn; dsincos(li * dt, sn, cn);
        const double are = mag * cn, aim = mag * sn, den = lr * lr + li * li, nre = are - 1.0;
        const double fre = (nre * lr + aim * li) / den, fim = (aim * lr - nre * li) / den;
        float* ab = (float*)(ws + WS_ABAR) + (size_t)i * 2; ab[0] = (float)are; ab[1] = (float)aim;
        bf16* bm = (bf16*)(ws + WS_BMAT) + (size_t)pidx * 128 * 16;
        bf16* cm = (bf16*)(ws + WS_CMAT) + (size_t)pidx * 16 * 128;
        for (int q = 0; q < 16; ++q) {
            const double br = (double)a.in[8][(size_t)i * 16 + q], bi = (double)a.in[9][(size_t)i * 16 + q];
            bm[n * 16 + q] = (bf16)f2bf((float)(fre * br - fim * bi));
            bm[(64 + n) * 16 + q] = (bf16)f2bf((float)(fre * bi + fim * br));
            cm[q * 128 + n] = (bf16)f2bf(a.in[10][((size_t)pidx * 16 + q) * 64 + n]);
            cm[q * 128 + 64 + n] = (bf16)f2bf(-a.in[11][((size_t)pidx * 16 + q) * 64 + n]);
        }
    }
    for (int R = gw; R < TPR; R += NGW) {
        const int mrow = R - NREAL;
        const float* src = R < NREAL ? a.in[0] + (size_t)R * DM : a.in[1] + (size_t)(mrow & 15) * DM;
        float* dst = R < NREAL ? a.out + (size_t)R * DM : (float*)(ws + WS_HM) + (size_t)mrow * DM;
        bf16* hb = (bf16*)(ws + WS_HB) + (size_t)R * DM;
        const bool pad = mrow >= NB * NMETA;
        float ss = 0.f;
#pragma unroll
        for (int j = 0; j < 4; ++j) {
            f32x4 v = *(const f32x4*)(src + 4 * lane + 256 * j);
            if (pad) v = (f32x4){0.f, 0.f, 0.f, 0.f};
            if (R >= NREAL) *(f32x4*)(dst + 4 * lane + 256 * j) = v;
            ss += (v[0] * v[0] + v[1] * v[1]) + (v[2] * v[2] + v[3] * v[3]);
            u32x2 w; w.x = pk2(v[0], v[1]); w.y = pk2(v[2], v[3]);
            *(u32x2*)(hb + 4 * lane + 256 * j) = w;
        }
#pragma unroll
        for (int o = 1; o < 64; o <<= 1) ss += __shfl_xor(ss, o);
        if (lane < 16) ((float*)(ws + WS_RS))[((size_t)(lane >> 2) * TPR + R) * 4 + (lane & 3)] = lane == 0 ? ss : 0.f;
    }
}

__device__ __forceinline__ void ssm_task(LAS unsigned char* lds, int task, int layer, const bf16* SU, float* YF,
                                         const float* abar_all, const bf16* bmat_all, const bf16* cmat_all) {
    int tid_l = threadIdx.x; asm volatile("" : "+v"(tid_l));
    const int tid = tid_l, lane = tid & 63, wave = __builtin_amdgcn_readfirstlane(tid >> 6);
    const int b = task >> 5, g = task & 31;
    __syncthreads();
    LAS float* BU = (LAS float*)(lds + wave * 12800);
    LAS unsigned short* X = (LAS unsigned short*)(lds + wave * 12800 + 8448);
    LAS float* SX = (LAS float*)(lds + 8 * 12800);
    const int blk0 = wave == 0 ? 0 : 16 * wave + 1, nblk = wave == 0 ? 17 : 16;
    bf16* yfb = (bf16*)YF + (size_t)task * LL * 16;
    const int fr = lane & 15, fq = lane >> 4;
    const bf16x8 zero8 = {0, 0, 0, 0, 0, 0, 0, 0};
    for (int dir = 0; dir < 2; ++dir) {
        const int pidx = (layer * 2 + dir) * 32 + g;
        const float are = abar_all[((size_t)pidx * 64 + lane) * 2], aim = abar_all[((size_t)pidx * 64 + lane) * 2 + 1];
        bf16x8 bfr[8], cfr[4];
        const bf16* bm = bmat_all + (size_t)pidx * 128 * 16;
#pragma unroll
        for (int nt = 0; nt < 8; ++nt) bfr[nt] = fq < 2 ? *(const bf16x8*)(bm + (nt * 16 + fr) * 16 + 8 * fq) : zero8;
        const bf16* cm = cmat_all + (size_t)pidx * 16 * 128;
#pragma unroll
        for (int ks = 0; ks < 4; ++ks) cfr[ks] = *(const bf16x8*)(cm + fr * 128 + ks * 32 + 8 * fq);
        float p16r = are, p16i = aim;
#pragma unroll
        for (int i = 0; i < 4; ++i) { const float tr = p16r * p16r - p16i * p16i, ti = 2.f * p16r * p16i; p16r = tr; p16i = ti; }
        float p256r = p16r, p256i = p16i;
#pragma unroll
        for (int i = 0; i < 4; ++i) { const float tr = p256r * p256r - p256i * p256i, ti = 2.f * p256r * p256i; p256r = tr; p256i = ti; }
        const float p272r = p256r * p16r - p256i * p16i, p272i = p256r * p16i + p256i * p16r;

        float xre = 0.f, xim = 0.f;
        for (int pass = 0; pass < 2; ++pass) {
            bf16x8 unext;
            { const int blkf = dir == 0 ? blk0 : blk0 + nblk - 1; const int Rf = blkf == 0 ? NREAL + b * NMETA : b * SEQ + blkf * 16 - NMETA;
              unext = fq < 2 ? *(const bf16x8*)(SU + (size_t)(Rf + fr) * 512 + g * 16 + 8 * fq) : zero8; }
            for (int ib = 0; ib < nblk; ++ib) {
                const int blk = dir == 0 ? blk0 + ib : blk0 + nblk - 1 - ib;
                const bf16x8 ufr = unext;
                if (ib + 1 < nblk) { const int blkn = dir == 0 ? blk + 1 : blk - 1; const int Rn = blkn == 0 ? NREAL + b * NMETA : b * SEQ + blkn * 16 - NMETA;
                    unext = fq < 2 ? *(const bf16x8*)(SU + (size_t)(Rn + fr) * 512 + g * 16 + 8 * fq) : zero8; }
                f32x4 dd[8];
#pragma unroll
                for (int nt = 0; nt < 8; ++nt) { dd[nt] = (f32x4){0.f, 0.f, 0.f, 0.f}; dd[nt] = __builtin_amdgcn_mfma_f32_16x16x32_bf16(ufr, bfr[nt], dd[nt], 0, 0, 0); }
                asm volatile("s_nop 15\n\ts_nop 15" : "+v"(dd[0]), "+v"(dd[1]), "+v"(dd[2]), "+v"(dd[3]), "+v"(dd[4]), "+v"(dd[5]), "+v"(dd[6]), "+v"(dd[7]));
#pragma unroll
                for (int nt = 0; nt < 8; ++nt)
#pragma unroll
                    for (int r = 0; r < 4; ++r) BU[(4 * fq + r) * 132 + nt * 16 + fr] = dd[nt][r];
                LDS_FENCE();
                float bur[16], bui[16];
#pragma unroll
                for (int i = 0; i < 16; ++i) { const int tt = dir == 0 ? i : 15 - i; bur[i] = BU[tt * 132 + lane]; bui[i] = BU[tt * 132 + 64 + lane]; }
                if (pass == 0) {
#pragma unroll
                    for (int i = 0; i < 16; ++i) {
                        const float bre = bur[i], bim = bui[i];
                        const float nr = are * xre - aim * xim + bre, ni = are * xim + aim * xre + bim; xre = nr; xim = ni;
                    }
                    LDS_FENCE();
                } else {
#pragma unroll
                    for (int i = 0; i < 16; ++i) {
                        const int tt = dir == 0 ? i : 15 - i;
                        const float bre = bur[i], bim = bui[i];
                        const float nr = are * xre - aim * xim + bre, ni = are * xim + aim * xre + bim; xre = nr; xim = ni;
                        X[tt * 136 + lane] = (unsigned short)f2bf(xre); X[tt * 136 + 64 + lane] = (unsigned short)f2bf(xim);
                    }
                    LDS_FENCE();
                    f32x4 y = {0.f, 0.f, 0.f, 0.f};
#pragma unroll
                    for (int ks = 0; ks < 4; ++ks) {
                        const bf16x8 afr = *(const LAS bf16x8*)(X + fr * 136 + ks * 32 + 8 * fq);
                        y = __builtin_amdgcn_mfma_f32_16x16x32_bf16(afr, cfr[ks], y, 0, 0, 0);
                    }
                    asm volatile("s_nop 15\n\ts_nop 15" : "+v"(y));
                    LDS_FENCE();
                    {
                        bf16* yd = yfb + (size_t)dir * 256 * LL * 16;
#pragma unroll
                        for (int r = 0; r < 4; ++r) yd[(size_t)(blk * 16 + 4 * fq + r) * 16 + fr] = (bf16)f2bf(y[r]);
                    }
                }
            }
            if (pass == 0) {
                SX[(wave * 64 + lane) * 2] = xre; SX[(wave * 64 + lane) * 2 + 1] = xim;
                LDS_FENCE(); __syncthreads();
                float cre = 0.f, cim = 0.f;
                if (dir == 0) {
                    for (int w = 0; w < wave; ++w) { const float pr = w == 0 ? p272r : p256r, pi = w == 0 ? p272i : p256i;
                        const float sr = SX[(w * 64 + lane) * 2], si = SX[(w * 64 + lane) * 2 + 1];
                        const float nr = pr * cre - pi * cim + sr, ni = pr * cim + pi * cre + si; cre = nr; cim = ni; }
                } else {
                    for (int w = 7; w > wave; --w) {
                        const float sr = SX[(w * 64 + lane) * 2], si = SX[(w * 64 + lane) * 2 + 1];
                        const float nr = p256r * cre - p256i * cim + sr, ni = p256r * cim + p256i * cre + si; cre = nr; cim = ni; }
                }
                xre = cre; xim = cim;
            }
        }
        LDS_FENCE(); __syncthreads();
    }
}

constexpr int ATT_KROW = 72, ATT_VROW = 40, ATT_KT = 32 * ATT_KROW * 2  , ATT_VT = 64 * ATT_VROW * 2  , ATT_MAXT = 11, ATT_VOFF = ATT_MAXT * ATT_KT;
static_assert(ATT_VOFF + ATT_MAXT * ATT_VT <= 131072, "attention LDS");
__device__ __forceinline__ void attn_task(LAS unsigned char* lds, int task, const bf16* Q, const bf16* K, const bf16* V, bf16* YA, const float* sink) {
    int tid_l = threadIdx.x; asm volatile("" : "+v"(tid_l));
    const int tid = tid_l, lane = tid & 63, wave = __builtin_amdgcn_readfirstlane(tid >> 6);
    const int qb = task % 33, bh = task / 33, h = bh & 1, b = bh >> 1;
    const int l0 = qb * 64;
    __syncthreads();
    int jlo = (l0 - 128) >> 5; if (jlo < 1) jlo = 1;
    int jhi = (l0 + 191) >> 5; if (jhi > 64) jhi = 64;
    const int ntiles = 1 + (jhi - jlo + 1);
    LAS unsigned short* Ks = (LAS unsigned short*)lds;
    LAS unsigned short* Vs = (LAS unsigned short*)(lds + ATT_VOFF);
    for (int idx = tid; idx < ntiles * 32 * 8; idx += 512) {
        const int ch = idx & 7, key = idx >> 3, slot = key >> 5, kk = key & 31;
        const int lk = (slot == 0 ? 0 : (jlo + slot - 1) * 32) + kk;
        u32x4 kv = {0u, 0u, 0u, 0u}, vv = {0u, 0u, 0u, 0u};
        if (lk < LL) { const size_t R = (size_t)tok_row(b, lk);
            kv = *(const u32x4*)(K + R * 128 + h * 64 + ch * 8); vv = *(const u32x4*)(V + R * 128 + h * 64 + ch * 8); }
        *(LAS u32x4*)(Ks + slot * (ATT_KT / 2) + kk * ATT_KROW + ch * 8) = kv;
        LAS unsigned short* vd = Vs + slot * (ATT_VT / 2) + (ch * 8) * ATT_VROW + kk;
        vd[0 * ATT_VROW] = (unsigned short)(vv.x & 0xffffu); vd[1 * ATT_VROW] = (unsigned short)(vv.x >> 16);
        vd[2 * ATT_VROW] = (unsigned short)(vv.y & 0xffffu); vd[3 * ATT_VROW] = (unsigned short)(vv.y >> 16);
        vd[4 * ATT_VROW] = (unsigned short)(vv.z & 0xffffu); vd[5 * ATT_VROW] = (unsigned short)(vv.z >> 16);
        vd[6 * ATT_VROW] = (unsigned short)(vv.w & 0xffffu); vd[7 * ATT_VROW] = (unsigned short)(vv.w >> 16);
    }
    LDS_FENCE(); __syncthreads();
    const int head = h * 4 + (wave >> 1), r32 = lane & 31, hi = lane >> 5;
    const int lq = l0 + 32 * (wave & 1) + r32;
    const bool qvalid = lq < LL;
    const size_t Rq = (size_t)tok_row(b, qvalid ? lq : LL - 1);
    bf16x8 qf[4];
#pragma unroll
    for (int ks = 0; ks < 4; ++ks) qf[ks] = *(const bf16x8*)(Q + Rq * 512 + head * 64 + ks * 16 + 8 * hi);
    float mrun = sink[head], lsum = hi == 0 ? 1.0f : 0.0f;
    f32x16 o0, o1;
#pragma unroll
    for (int i = 0; i < 16; ++i) { o0[i] = 0.f; o1[i] = 0.f; }
    const int lqw = l0 + 32 * (wave & 1);
    for (int slot = 0; slot < ntiles; ++slot) {
        const int kbase = slot == 0 ? 0 : (jlo + slot - 1) * 32;
        if (lqw >= LL || (slot != 0 && (kbase + 31 < lqw - 128 || kbase > lqw + 31 + 128))) continue;
        const LAS unsigned short* kt = Ks + slot * (ATT_KT / 2);
        f32x16 s;
#pragma unroll
        for (int i = 0; i < 16; ++i) s[i] = 0.f;
#pragma unroll
        for (int ks = 0; ks < 4; ++ks) {
            const bf16x8 kf = *(const LAS bf16x8*)(kt + r32 * ATT_KROW + ks * 16 + 8 * hi);
            s = __builtin_amdgcn_mfma_f32_32x32x16_bf16(kf, qf[ks], s, 0, 0, 0);
        }
        asm volatile("s_nop 15\n\ts_nop 15" : "+v"(s));
        float mt = -1e30f;
#pragma unroll
        for (int i = 0; i < 16; ++i) {
            const int lk = kbase + (i & 3) + 8 * (i >> 2) + 4 * hi;
            int d = lq - lk; d = d < 0 ? -d : d;
            const bool valid = (lk < NMETA) || (d <= 128 && lk < LL);
            s[i] = valid ? s[i] : -1e30f;
            mt = fmaxf(mt, s[i]);
        }
        mt = fmaxf(mt, __shfl_xor(mt, 32));
        const float mnew = fmaxf(mrun, mt);
        const float alpha = __expf(mrun - mnew);
        mrun = mnew;
        float ps = 0.f;
#pragma unroll
        for (int i = 0; i < 16; ++i) { s[i] = __expf(s[i] - mnew); ps += s[i]; }
        lsum = lsum * alpha + ps;
#pragma unroll
        for (int i = 0; i < 16; ++i) { o0[i] *= alpha; o1[i] *= alpha; }
        const LAS unsigned short* vt = Vs + slot * (ATT_VT / 2);
#pragma unroll
        for (int s2 = 0; s2 < 2; ++s2) {
            union { bf16x8 v; unsigned u[4]; } pf;
            pf.u[0] = pk2(s[8 * s2 + 0], s[8 * s2 + 1]); pf.u[1] = pk2(s[8 * s2 + 2], s[8 * s2 + 3]);
            pf.u[2] = pk2(s[8 * s2 + 4], s[8 * s2 + 5]); pf.u[3] = pk2(s[8 * s2 + 6], s[8 * s2 + 7]);
#pragma unroll
            for (int dt = 0; dt < 2; ++dt) {
                union { bf16x8 v; u32x2 u[2]; } vf;
                const LAS unsigned short* vp = vt + (dt * 32 + r32) * ATT_VROW + 16 * s2 + 4 * hi;
                vf.u[0] = *(const LAS u32x2*)(vp); vf.u[1] = *(const LAS u32x2*)(vp + 8);
                if (dt == 0) o0 = __builtin_amdgcn_mfma_f32_32x32x16_bf16(vf.v, pf.v, o0, 0, 0, 0);
                else o1 = __builtin_amdgcn_mfma_f32_32x32x16_bf16(vf.v, pf.v, o1, 0, 0, 0);
            }
        }
    }
    asm volatile("s_nop 15\n\ts_nop 15" : "+v"(o0), "+v"(o1));
    lsum += __shfl_xor(lsum, 32);
    const float inv = 1.0f / lsum;
    if (qvalid) {
#pragma unroll
        for (int g4 = 0; g4 < 4; ++g4) {
            u32x2 w0, w1;
            w0.x = pk2(o0[4 * g4] * inv, o0[4 * g4 + 1] * inv); w0.y = pk2(o0[4 * g4 + 2] * inv, o0[4 * g4 + 3] * inv);
            w1.x = pk2(o1[4 * g4] * inv, o1[4 * g4 + 1] * inv); w1.y = pk2(o1[4 * g4 + 2] * inv, o1[4 * g4 + 3] * inv);
            *(u32x2*)(YA + Rq * 512 + head * 64 + 8 * g4 + 4 * hi) = w0;
            *(u32x2*)(YA + Rq * 512 + head * 64 + 32 + 8 * g4 + 4 * hi) = w1;
        }
    }
    __syncthreads();
}

__device__ __forceinline__ void pool_diff(LAS unsigned char* lds, const bf16* PU, bf16* PD) {
    int tl_ = threadIdx.x; asm volatile("" : "+v"(tl_));
    constexpr int TOK = 65, HALO = 8, ROWS = TOK + 2 * HALO, NTOK = NB * LL;
    for (int blk = blockIdx.x; blk * TOK < NTOK; blk += gridDim.x) {
        const int f0 = blk * TOK;
        __syncthreads();
        for (int i = tl_; i < ROWS * 64; i += 512) {
            const int r = i >> 6, ch = i & 63, f = f0 - HALO + r;
            u32x4 v = {0u, 0u, 0u, 0u};
            if (f >= 0 && f < NTOK) { const int b = f / LL, l = f % LL; v = *(const u32x4*)(PU + (size_t)tok_row(b, l) * 512 + ch * 8); }
            *(LAS u32x4*)(lds + (size_t)i * 16) = v;
        }
        LDS_FENCE(); __syncthreads();
        for (int i = tl_; i < TOK * 64; i += 512) {
            const int t = i >> 6, ch = i & 63, f = f0 + t;
            if (f >= NTOK) continue;
            const int b = f / LL, l = f % LL, half = 1 << (ch >> 4);
            const int lo = l - half < 0 ? 0 : l - half, hh = l + half > LL ? LL : l + half;
            float s[8];
#pragma unroll
            for (int j = 0; j < 8; ++j) s[j] = 0.f;
            for (int lp = lo; lp < hh; ++lp) {
                const u32x4 v = *(const LAS u32x4*)(lds + (size_t)((t + HALO + lp - l) * 64 + ch) * 16);
                s[0] += bf2f(v.x & 0xffffu); s[1] += bf2f(v.x >> 16); s[2] += bf2f(v.y & 0xffffu); s[3] += bf2f(v.y >> 16);
                s[4] += bf2f(v.z & 0xffffu); s[5] += bf2f(v.z >> 16); s[6] += bf2f(v.w & 0xffffu); s[7] += bf2f(v.w >> 16);
            }
            const float ic = 1.0f / (float)(hh - lo);
            const u32x4 v = *(const LAS u32x4*)(lds + (size_t)((t + HALO) * 64 + ch) * 16);
            u32x4 o;
            o.x = pk2(s[0] * ic - bf2f(v.x & 0xffffu), s[1] * ic - bf2f(v.x >> 16)); o.y = pk2(s[2] * ic - bf2f(v.y & 0xffffu), s[3] * ic - bf2f(v.y >> 16));
            o.z = pk2(s[4] * ic - bf2f(v.z & 0xffffu), s[5] * ic - bf2f(v.z >> 16)); o.w = pk2(s[6] * ic - bf2f(v.w & 0xffffu), s[7] * ic - bf2f(v.w >> 16));
            *(u32x4*)(PD + (size_t)tok_row(b, l) * 512 + ch * 8) = o;
        }
    }
    __syncthreads();
}

__device__ __forceinline__ void z_pass(const float* YF, const bf16* SU, const float* dskip, bf16* Z) {
    int tl_ = threadIdx.x; asm volatile("" : "+v"(tl_)); const int gt = blockIdx.x * 512 + tl_, NGT = gridDim.x * 512;
    for (int i = gt; i < NB * LL * 64; i += NGT) {
        const int ch = i & 63, tk = i >> 6, b = tk / LL, l = tk % LL, g = ch >> 1;
        const size_t R = (size_t)tok_row(b, l);
        const bf16* yp = (const bf16*)YF + ((size_t)(b * 32 + g) * LL + l) * 16 + (ch & 1) * 8;
        const u32x4 ya = *(const u32x4*)yp, yb = *(const u32x4*)(yp + (size_t)256 * LL * 16);
        f32x4 y0, y1;
        y0[0] = bf2f(ya.x & 0xffffu) + bf2f(yb.x & 0xffffu); y0[1] = bf2f(ya.x >> 16) + bf2f(yb.x >> 16); y0[2] = bf2f(ya.y & 0xffffu) + bf2f(yb.y & 0xffffu); y0[3] = bf2f(ya.y >> 16) + bf2f(yb.y >> 16);
        y1[0] = bf2f(ya.z & 0xffffu) + bf2f(yb.z & 0xffffu); y1[1] = bf2f(ya.z >> 16) + bf2f(yb.z >> 16); y1[2] = bf2f(ya.w & 0xffffu) + bf2f(yb.w & 0xffffu); y1[3] = bf2f(ya.w >> 16) + bf2f(yb.w >> 16);
        const f32x4 d0 = *(const f32x4*)(dskip + ch * 8), d1 = *(const f32x4*)(dskip + ch * 8 + 4);
        const u32x4 uu = *(const u32x4*)(SU + R * 512 + ch * 8);
        float t[8];
        t[0] = y0[0] + d0[0] * bf2f(uu.x & 0xffffu); t[1] = y0[1] + d0[1] * bf2f(uu.x >> 16); t[2] = y0[2] + d0[2] * bf2f(uu.y & 0xffffu); t[3] = y0[3] + d0[3] * bf2f(uu.y >> 16);
        t[4] = y1[0] + d1[0] * bf2f(uu.z & 0xffffu); t[5] = y1[1] + d1[1] * bf2f(uu.z >> 16); t[6] = y1[2] + d1[2] * bf2f(uu.w & 0xffffu); t[7] = y1[3] + d1[3] * bf2f(uu.w >> 16);
#pragma unroll
        for (int j = 0; j < 8; ++j) {
            const float v = t[j], tt = __builtin_amdgcn_rcpf(fabsf(v) * 0.2316418882f + 1.0f);
            float q = tt * 0.5307027145f + (-0.7265760135f); q = q * tt + 0.7107068705f; q = q * tt + (-0.142248368f); q = q * tt + 0.127414796f; q = q * tt;
            const float m = v * (q * __builtin_amdgcn_exp2f(v * v * (-0.72134752044f)));
            t[j] = v < 0.f ? m : v - m;
        }
        u32x4 o; o.x = pk2(t[0], t[1]); o.y = pk2(t[2], t[3]); o.z = pk2(t[4], t[5]); o.w = pk2(t[6], t[7]);
        *(u32x4*)(Z + R * 512 + ch * 8) = o;
    }
}

#define XB_TMO      128
#define XB_XCNT(j)  (256  + 64 * (j))
#define XB_XSUB(j)  (1280 + 64 * (j))
#define XB_XGEN(j)  (2304 + 64 * (j))
#define XB_TOP      3328
#define XB_TOPGEN   3392
#define XCD_BAR_WORDS 3456
#define XB_SPIN_CAP (1u << 18)

__device__ __forceinline__ unsigned xb_ld(unsigned* p)              { return __hip_atomic_load(p, __ATOMIC_RELAXED, __HIP_MEMORY_SCOPE_AGENT); }
__device__ __forceinline__ unsigned xb_add(unsigned* p, unsigned v) { return __hip_atomic_fetch_add(p, v, __ATOMIC_RELAXED, __HIP_MEMORY_SCOPE_AGENT); }
__device__ __forceinline__ unsigned xb_xcc_id() { return (unsigned)__builtin_amdgcn_s_getreg((3 << 11) | 20) & 0xFu; }
#define XB_SPIN(cond, bar) do { unsigned _sp = 0; while (cond) { __builtin_amdgcn_s_sleep(1); \
    if ((++_sp & 255u) == 0u) { if (xb_ld(&(bar)[XB_TMO])) break; if (_sp > XB_SPIN_CAP) { atomicAdd(&(bar)[XB_TMO], 1u); break; } } } } while (0)

struct XcdBarrier {
    unsigned* bar; unsigned x;
    volatile LAS unsigned* st;
};

__device__ __forceinline__ XcdBarrier xcd_barrier_post(unsigned* bar, volatile LAS unsigned* st) {
    XcdBarrier b; b.bar = bar; b.x = xb_xcc_id(); b.st = st;
    if (threadIdx.x == 0) (void)xb_add(&bar[XB_XCNT(b.x)], 1u);
    return b;
}
__device__ __forceinline__ void xcd_barrier_complete(unsigned* bar, unsigned x, unsigned& nloc, unsigned& nx) {
    const unsigned G = gridDim.x * gridDim.y * gridDim.z;
    unsigned sum, cnt, mine, sp = 0u;
    for (;;) {
        sum = 0u; cnt = 0u; mine = 0u;
#pragma unroll
        for (unsigned j = 0; j < 16; ++j) { const unsigned c = xb_ld(&bar[XB_XCNT(j)]); sum += c; cnt += (c > 0u) ? 1u : 0u; mine = (j == x) ? c : mine; }
        if (sum == G) break;
        __builtin_amdgcn_s_sleep(1);
        if ((++sp & 255u) == 0u) { if (xb_ld(&bar[XB_TMO])) break; if (sp > XB_SPIN_CAP) { atomicAdd(&bar[XB_TMO], 1u); break; } }
    }
    nloc = mine > 0u ? mine : 1u; nx = cnt > 0u ? cnt : 1u;
}

__device__ __forceinline__ void xcd_barrier(const XcdBarrier& b) {
    asm volatile("s_waitcnt vmcnt(0)" ::: "memory");
    __syncthreads();
    if (threadIdx.x == 0) {
        unsigned* bar = b.bar;
        __builtin_amdgcn_s_waitcnt(0);
        unsigned nloc = b.st[0], nx = b.st[1];
        if (nloc == 0u) { xcd_barrier_complete(bar, b.x, nloc, nx); b.st[0] = nloc; b.st[1] = nx; }
        const unsigned old = xb_add(&bar[XB_XSUB(b.x)], 1u);
        const unsigned gen = old / nloc;
        if (old + 1u == (gen + 1u) * nloc) {
            __builtin_amdgcn_fence(__ATOMIC_RELEASE, "agent");
            asm volatile("s_waitcnt vmcnt(0)" ::: "memory");
            const unsigned og = xb_add(&bar[XB_TOP], 1u);
            const unsigned tg = og / nx;
            if (og + 1u == (tg + 1u) * nx) xb_add(&bar[XB_TOPGEN], 1u);
            else XB_SPIN(xb_ld(&bar[XB_TOPGEN]) == tg, bar);
            __builtin_amdgcn_fence(__ATOMIC_ACQUIRE, "agent");
            xb_add(&bar[XB_XGEN(b.x)], 1u);
            asm volatile("s_waitcnt vmcnt(0)" ::: "memory");
        } else {
            XB_SPIN(xb_ld(&bar[XB_XGEN(b.x)]) == gen, bar);
            __builtin_amdgcn_fence(__ATOMIC_ACQUIRE, "agent");
            asm volatile("s_waitcnt vmcnt(0)" ::: "memory");
        }
    }
    __syncthreads();
}

#ifndef MK_ALIGN
#define MK_ALIGN true
#endif
#ifndef MK_SP2
#define MK_SP2 true
#endif
#ifndef MK_SPLIT
#define MK_SPLIT 0
#endif
constexpr int NPL = 8, NPHASE = 1 + 2 * NPL + 1, PH_FINAL = NPHASE - 1;

typedef const __attribute__((address_space(4))) Args* KArgsP;
#define KARGS() ({ auto kp_ = __builtin_amdgcn_kernarg_segment_ptr(); asm volatile("" : "+s"(kp_)); (KArgsP)kp_; })
__global__ void __launch_bounds__(512, 2) fwd_kernel(Args a_unused, int ph_lo, int ph_hi) {
    (void)a_unused;
    extern __shared__ __attribute__((aligned(16))) unsigned char lds_raw[];
    LAS unsigned char* lds = (LAS unsigned char*)lds_raw;
    const int G = gridDim.x, bid = blockIdx.x;
#if MK_SPLIT
#define GRID_SYNC() do {} while (0)
    (void)lds;
#else
#define CG_SYNC() do { asm volatile("s_waitcnt vmcnt(0)" ::: "memory"); __syncthreads(); \
    if (threadIdx.x == 0) { __builtin_amdgcn_fence(__ATOMIC_RELEASE, "agent"); asm volatile("s_waitcnt vmcnt(0)" ::: "memory"); } \
    __syncthreads(); grid.sync(); \
    if (threadIdx.x == 0) { __builtin_amdgcn_fence(__ATOMIC_ACQUIRE, "agent"); asm volatile("s_waitcnt vmcnt(0)" ::: "memory"); } \
    __syncthreads(); } while (0)
    cg::grid_group grid = cg::this_grid();
    unsigned* barw = (unsigned*)(KARGS()->ws + WS_CTL);
    if (bid == 0) for (int i = threadIdx.x; i < XCD_BAR_WORDS; i += 512) __hip_atomic_store(barw + i, 0u, __ATOMIC_RELAXED, __HIP_MEMORY_SCOPE_AGENT);
    volatile LAS unsigned* xst = (volatile LAS unsigned*)(lds + LDS_BYTES - 64);
    if (threadIdx.x < 2) xst[threadIdx.x] = 0u;
    CG_SYNC();
    const XcdBarrier xbar = xcd_barrier_post(barw, xst);
#define GRID_SYNC() xcd_barrier(xbar)

#endif
#ifndef PHMASK
#define PHMASK 0xFFFFu
#endif
#define IN(k) (((PHMASK >> ((k) == 0 ? 0 : (k) == PH_FINAL ? 9 : 1 + ((k) - 1) % NPL)) & 1u) && ph_lo <= (k) && (k) < ph_hi)
#define SEAM(k) do { if (IN(k) && (k) + 1 < ph_hi) GRID_SYNC(); } while (0)
#define PHASE_BEGIN() KArgsP ka = KARGS(); unsigned char* ws = ka->ws; asm volatile("" : "+s"(ws)); float* rowss = (float*)(ws + WS_RS); float* Hm = (float*)(ws + WS_HM); bf16* HB = (bf16*)(ws + WS_HB); unsigned char* wl = ws + WS_W + (size_t)layer * LW_BYTES; \
    const int MT = NREAL; const bool META = layer != MK_NLAYER - 1;     \
    const float* rs_mix = rowss + (size_t)(2 * layer) * TPR * 16; float* rs_mlp = rowss + (size_t)(2 * layer + 1) * TPR * 16; float* rs_next = rowss + (size_t)(2 * layer + 2) * TPR * 16; (void)MT; (void)META; (void)Hm; (void)HB; (void)wl; (void)rs_mix; (void)rs_mlp; (void)rs_next;

    if (IN(0)) { Args al; { KArgsP kp = KARGS(); for (int i = 0; i < 23; ++i) al.in[i] = kp->in[i]; al.out = kp->out; al.ws = kp->ws; } p0_prologue(al, lds); }
    SEAM(0);
#ifndef MK_NLAYER
#define MK_NLAYER 2
#endif
#ifndef MK_RSIDX
#define MK_RSIDX 4
#endif
#pragma unroll 1
    for (int layer = 0; layer < MK_NLAYER; ++layer) {
        const int p = 1 + NPL * layer;
        if (IN(p)) { PHASE_BEGIN();
            pg8::Gemm g{HB, (const bf16*)(wl + OW_IN), TPR, NPROJ, DM}; pg8::StaticOrder S; S.init(TPR, NPROJ, G, bid);
            EpiInProj E{rs_mix, (const float*)(ws + WS_ROPE), (bf16*)(ws + WS_Q), (bf16*)(ws + WS_K), (bf16*)(ws + WS_V), (bf16*)(ws + WS_SU), (bf16*)(ws + WS_PU)};
            pg8::gemm_phase<EpiInProj, pg8::StaticOrder, MK_ALIGN, MK_SP2>(lds, g, S, E);
        }
        SEAM(p);
        if (IN(p + 1)) { PHASE_BEGIN();
            for (int t = bid; t < 256; t += G)
                ssm_task(lds, t, layer, (const bf16*)(ws + WS_SU), (float*)(ws + WS_YF), (const float*)(ws + WS_ABAR), (const bf16*)(ws + WS_BMAT), (const bf16*)(ws + WS_CMAT));
            for (int t = bid; t < NB * 2 * 33; t += G)
                attn_task(lds, t, (const bf16*)(ws + WS_Q), (const bf16*)(ws + WS_K), (const bf16*)(ws + WS_V), (bf16*)(ws + WS_YA), ka->in[4] + layer * 8);
            pool_diff(lds, (const bf16*)(ws + WS_PU), (bf16*)(ws + WS_PD));
        }
        SEAM(p + 1);
        if (IN(p + 2)) { PHASE_BEGIN();
            z_pass((const float*)(ws + WS_YF), (const bf16*)(ws + WS_SU), ka->in[12] + layer * 512, (bf16*)(ws + WS_Z));
        }
        SEAM(p + 2);
        if (IN(p + 3)) { PHASE_BEGIN();
            const int hg = G >> 1;
            if (bid < hg) { pg8::Gemm g{(const bf16*)(ws + WS_Z), (const bf16*)(wl + OW_GLU), MT, 512, 512}; pg8::StaticOrder S; S.init(MT, 512, hg, bid);
              EpiGlu E{(const bf16*)(ws + WS_Z), ka->in[14] + layer * 512, (bf16*)(ws + WS_YS)};
              pg8::gemm_phase<EpiGlu, pg8::StaticOrder, MK_ALIGN, MK_SP2>(lds, g, S, E); if (META) thin_gemm<EpiGlu>(lds, g.A, g.Bt, g.K, g.N, E, bid, hg); }
            else { pg8::Gemm g{(const bf16*)(ws + WS_PD), (const bf16*)(wl + OW_POOL), MT, 512, 512}; pg8::StaticOrder S; S.init(MT, 512, G - hg, bid - hg);
              EpiScale E{(bf16*)(ws + WS_YP), 512, ka->in[16] + layer * 512};
              pg8::gemm_phase<EpiScale, pg8::StaticOrder, MK_ALIGN, MK_SP2>(lds, g, S, E); if (META) thin_gemm<EpiScale>(lds, g.A, g.Bt, g.K, g.N, E, bid - hg, G - hg); }
        }
        SEAM(p + 3);
        if (IN(p + 4)) { PHASE_BEGIN();
#pragma unroll 1
            for (int c = 0; c < 3; ++c) {
                const bf16* Yc = (const bf16*)(ws + (c == 0 ? WS_YA : c == 1 ? WS_YS : WS_YP));
                { pg8::Gemm g{Yc, (const bf16*)(wl + OW_BR) + (size_t)c * 1024 * 512, MT, 1024, 512}; pg8::StaticOrder S; S.init(MT, 1024, G, bid);
                  EpiScale E{(bf16*)(ws + WS_BR), 1024, nullptr};
                  pg8::gemm_phase<EpiScale, pg8::StaticOrder, MK_ALIGN, MK_SP2>(lds, g, S, E); if (META) thin_gemm<EpiScale>(lds, g.A, g.Bt, g.K, g.N, E, bid, G); }
                pg8::Gemm g{HB, (const bf16*)(wl + OW_IN) + (size_t)(NPROJ + c * 1024) * DM, MT, 1024, DM}; pg8::StaticOrder S; S.init(MT, 1024, G, bid);
                if (c == 0) { EpiGate<true> E{rs_mix, (const bf16*)(ws + WS_BR), (bf16*)(ws + WS_MG)}; pg8::gemm_phase<EpiGate<true>, pg8::StaticOrder, MK_ALIGN, MK_SP2>(lds, g, S, E); if (META) thin_gemm<EpiGate<true>>(lds, g.A, g.Bt, g.K, g.N, E, bid, G); }
                else { EpiGate<false> E{rs_mix, (const bf16*)(ws + WS_BR), (bf16*)(ws + WS_MG)}; pg8::gemm_phase<EpiGate<false>, pg8::StaticOrder, MK_ALIGN, MK_SP2>(lds, g, S, E); if (META) thin_gemm<EpiGate<false>>(lds, g.A, g.Bt, g.K, g.N, E, bid, G); }
            }
        }
        SEAM(p + 4);
        if (IN(p + 5)) { PHASE_BEGIN();
            pg8::Gemm g{(const bf16*)(ws + WS_MG), (const bf16*)(wl + OW_OUT), MT, DM, DM}; pg8::StaticOrder S; S.init(MT, DM, G, bid);
            EpiRes E{ka->out, Hm, HB, rs_mlp, layer == 0 ? ka->in[0] : (const float*)ka->out};
            pg8::gemm_phase<EpiRes, pg8::StaticOrder, MK_ALIGN, MK_SP2>(lds, g, S, E); if (META) thin_gemm<EpiRes>(lds, g.A, g.Bt, g.K, g.N, E, bid, G);
        }
        SEAM(p + 5);
        if (IN(p + 6)) { PHASE_BEGIN();
            pg8::Gemm g{HB, (const bf16*)(wl + OW_UP), MT, FF, DM}; pg8::StaticOrder S; S.init(MT, FF, G, bid);
            EpiUp E{rs_mlp, (bf16*)(ws + WS_ACT)};
            pg8::gemm_phase<EpiUp, pg8::StaticOrder, MK_ALIGN, MK_SP2>(lds, g, S, E); if (META) thin_gemm<EpiUp>(lds, g.A, g.Bt, g.K, g.N, E, bid, G);
        }
        SEAM(p + 6);
        if (IN(p + 7)) { PHASE_BEGIN();
            pg8::Gemm g{(const bf16*)(ws + WS_ACT), (const bf16*)(wl + OW_DN), MT, DM, FF}; pg8::StaticOrder S; S.init(MT, DM, G, bid);
            EpiRes E{ka->out, Hm, layer == MK_NLAYER - 1 ? (bf16*)nullptr : HB, rs_next, (const float*)ka->out};
            pg8::gemm_phase<EpiRes, pg8::StaticOrder, MK_ALIGN, MK_SP2>(lds, g, S, E); if (META) thin_gemm<EpiRes>(lds, g.A, g.Bt, g.K, g.N, E, bid, G);
        }
        SEAM(p + 7);
    }
#ifdef MK_DUMP_OFF
    if (IN(PH_FINAL)) { KArgsP ka = KARGS();
        const bf16* src = (const bf16*)(ka->ws + (MK_DUMP_OFF)); const bf16* src2 = (const bf16*)(ka->ws + (MK_DUMP_OFF2));
        for (int i = bid * 512 + threadIdx.x; i < NREAL * 1024; i += G * 512) { const int R = MK_DUMP_ROW(i >> 10), c = i & 1023; ka->out[i] = c < 512 ? bf2f(src[(size_t)R * (MK_DUMP_LD) + (c % (MK_DUMP_LD))]) : bf2f(src2[(size_t)R * (MK_DUMP_LD2) + (c % (MK_DUMP_LD2))]); }
    }
#else
    if (IN(PH_FINAL)) { KArgsP ka = KARGS();
        const float* rs = (const float*)(ka->ws + WS_RS) + (size_t)MK_RSIDX * TPR * 16; const float* gain = ka->in[22];
        int tl_ = threadIdx.x; asm volatile("" : "+v"(tl_));
        for (int i = bid * 512 + tl_; i < NREAL * 256; i += G * 512) {
            const int R = i >> 8, c4 = (i & 255) * 4;
            const float r = row_rstd(rs, R);
            f32x4 v = *(const f32x4*)(ka->out + (size_t)R * DM + c4); const f32x4 gn = *(const f32x4*)(gain + c4);
            v = v * r * gn;
            *(f32x4*)(ka->out + (size_t)R * DM + c4) = v;
        }
    }
#endif
#undef IN
#undef SEAM
}

extern "C" void kernel_launch(void* const* d_in, const int* in_sizes, int n_in, void* d_out, int out_size, void* d_ws, size_t ws_size, hipStream_t stream) {
    static int grid = 0;
    if (grid == 0) {
        if (n_in != 23 || out_size != NREAL * DM || ws_size < WS_END) { fprintf(stderr, "kernel_launch: unexpected shapes (n_in %d out %d ws %zu)\n", n_in, out_size, ws_size); grid = -1; return; }
        int dev = 0, cus = 0, per_cu = 0;
        hipGetDevice(&dev); hipDeviceGetAttribute(&cus, hipDeviceAttributeMultiprocessorCount, dev);
        if (hipFuncSetAttribute((const void*)fwd_kernel, hipFuncAttributeMaxDynamicSharedMemorySize, LDS_BYTES) != hipSuccess) { fprintf(stderr, "kernel_launch: hipFuncSetAttribute failed\n"); grid = -1; return; }
        if (hipOccupancyMaxActiveBlocksPerMultiprocessor(&per_cu, (const void*)fwd_kernel, 512, LDS_BYTES) != hipSuccess || per_cu < 1) { fprintf(stderr, "kernel_launch: occupancy query gave %d\n", per_cu); per_cu = 1; }
        (void)hipGetLastError();
        grid = cus * (per_cu > 1 ? 1 : per_cu);
        if (grid <= 0) grid = 256;
    }
    if (grid < 0) return;
    Args a{};
    for (int i = 0; i < 23; ++i) a.in[i] = (const float*)d_in[i];
    a.out = (float*)d_out; a.ws = (unsigned char*)d_ws;
#if MK_SPLIT
    for (int ph = 0; ph < NPHASE; ++ph) hipLaunchKernelGGL(fwd_kernel, dim3(grid), dim3(512), LDS_BYTES, stream, a, ph, ph + 1);
#else
    int lo = 0, hi = NPHASE;
    void* kargs[] = {(void*)&a, (void*)&lo, (void*)&hi};
    hipError_t e = hipLaunchCooperativeKernel((const void*)fwd_kernel, dim3(grid), dim3(512), kargs, LDS_BYTES, stream);
    if (e != hipSuccess) fprintf(stderr, "kernel_launch: cooperative launch failed: %s (grid %d)\n", hipGetErrorString(e), grid);
#endif
}
```

```cpp
#include <hip/hip_runtime.h>
#include <hip/hip_cooperative_groups.h>
#include <cstdio>
#include <cstdint>
namespace cg = cooperative_groups;
namespace pg8 {
#define PG8_LAS __attribute__((address_space(3)))
typedef unsigned short bf16_t;
typedef short bf16x8 __attribute__((ext_vector_type(8)));
typedef float f32x4 __attribute__((ext_vector_type(4)));
typedef unsigned u32x4 __attribute__((ext_vector_type(4)));
constexpr int BM = 256, BK = 64, HALF = 128, HTB = HALF * BK * 2  , STAGE_BYTES = 8 * HTB, NXCD = 8, WGM = 8;

__host__ __device__ __forceinline__ int lds_byte(int r, int c) { const int st = (r >> 4) * 2 + (c >> 5), rr = r & 15, cc = c & 31, ob = rr * 64 + cc * 2; return st * 1024 + (ob ^ (((ob >> 9) & 1) << 5)); }
__host__ __device__ __forceinline__ void stage_rc(int b, int& R, int& C) { const int st = b / 1024, sb = b % 1024, swz = sb ^ (((sb >> 9) & 1) << 5); R = (st >> 1) * 16 + swz / 64; C = (st & 1) * 32 + (swz % 64) / 2; }
__host__ __device__ __forceinline__ int perm32(int rho) { const int n = rho >> 4, i = rho & 15; return 8 * (i >> 2) + 4 * n + (i & 3); }

struct Unit { int pm, pn; };
struct Gemm { const bf16_t* A; const bf16_t* Bt; int M, N, K; };

struct StaticOrder {
    int nM, nN, nwg, G, c;
    __host__ __device__ void init(int M, int N, int G_, int c_) { nM = M / BM; nN = N / BM; nwg = nM * nN; G = G_; c = c_; }
    __host__ __device__ bool next(int i, Unit& u) const {
        const long L = (long)i * G + c; if (L >= nwg) return false;
        int wgid = (int)L; { const int q = nwg / NXCD, r = nwg % NXCD, xcd = wgid % NXCD, off = wgid / NXCD; wgid = (xcd < r ? xcd * (q + 1) : r * (q + 1) + (xcd - r) * q) + off; }
        const int nig = WGM * nN, gid = wgid / nig, fm = gid * WGM, gsz = (nM - fm) < WGM ? (nM - fm) : WGM;
        u.pm = fm + ((wgid % nig) % gsz); u.pn = (wgid % nig) / gsz; return true;
    }
    __device__ __forceinline__ void a_ready(const Unit&) const {}
    __device__ __forceinline__ void done(const Unit&) const {}
};

__device__ __forceinline__ unsigned cvt_pk_bf16(float lo, float hi) { unsigned r; asm volatile("v_cvt_pk_bf16_f32 %0, %1, %2" : "=v"(r) : "v"(lo), "v"(hi)); return r; }
template <class Epi, class Sched, bool ALIGN_EPI = false, bool SP2 = false>
__device__ __forceinline__ void gemm_phase(PG8_LAS unsigned char* lds, const Gemm g, const Sched& S, const Epi& E) {
    int tid_l = threadIdx.x; asm volatile("" : "+v"(tid_l));
    const int tid = tid_l, wid = __builtin_amdgcn_readfirstlane(tid >> 6), lane = tid & 63, wr = wid >> 2, wc = wid & 3, fr = lane & 15, fq = lane >> 4;
    const int K = g.K, nt = K / BK;
    unsigned voffA[2], voffB[2];
#pragma unroll
    for (int i = 0; i < 2; ++i) { int R, C; stage_rc(tid * 16 + i * 8192, R, C); const int Rb = Epi::PERM ? ((R & ~31) + perm32(R & 31)) : R;
        voffA[i] = (unsigned)(R * K + C) * 2u; voffB[i] = (unsigned)(Rb * K + C) * 2u; }
    const size_t kstep = (size_t)(BK * 2);
    const size_t hstep = (size_t)HALF * K * 2;
    const size_t tstep = 2 * hstep;
    const unsigned ldsw = (unsigned)wid * 1024u;
    const int aoff = lds_byte(wr * 64 + fr, fq * 8), boff = lds_byte(wc * 32 + fr, fq * 8);
#define PG8_SA(b, h) (((b) * 2 + (h)) * HTB)
#define PG8_SB(b, h) ((4 + (b) * 2 + (h)) * HTB)
#define PG8_STAGE(bufoff, gbase, voff) do { _Pragma("unroll") for (int _i = 0; _i < 2; ++_i) \
        __builtin_amdgcn_global_load_lds((const unsigned*)((const char*)(gbase) + (voff)[_i]), (PG8_LAS unsigned*)(lds + (bufoff) + ldsw + _i * 8192), 16, 0, 0); } while (0)
#define PG8_LDA(dst, b, h) do { _Pragma("unroll") for (int m = 0; m < 4; ++m) _Pragma("unroll") for (int k = 0; k < 2; ++k) dst[m][k] = *(const PG8_LAS bf16x8*)(lds + PG8_SA(b, h) + aoff + m * 2048 + k * 1024); } while (0)
#define PG8_LDB(dst, b, h) do { _Pragma("unroll") for (int n = 0; n < 2; ++n) _Pragma("unroll") for (int k = 0; k < 2; ++k) dst[n][k] = *(const PG8_LAS bf16x8*)(lds + PG8_SB(b, h) + boff + n * 2048 + k * 1024); } while (0)
#define PG8_MMA(ai, bj, At, Bt) do { __builtin_amdgcn_s_setprio(1); _Pragma("unroll") for (int m = 0; m < 4; ++m) _Pragma("unroll") for (int n = 0; n < 2; ++n) _Pragma("unroll") for (int k = 0; k < 2; ++k) \
        acc[ai][bj][m][n] = __builtin_amdgcn_mfma_f32_16x16x32_bf16(Bt[n][k], At[m][k], acc[ai][bj][m][n], 0, 0, 0); __builtin_amdgcn_s_setprio(0); } while (0)
#define PG8_WAIT_V(n) asm volatile("s_waitcnt vmcnt(" #n ")" ::: "memory")
#define PG8_WAIT_L(n) asm volatile("s_waitcnt lgkmcnt(" #n ")" ::: "memory")
#define PG8_BAR __builtin_amdgcn_s_barrier()
#define PG8_SCHED __builtin_amdgcn_sched_barrier(0)
    Unit cur, nxt; int ui = 0;
    if (!S.next(0, cur)) return;
    f32x4 acc[2][2][4][2];
#pragma unroll
    for (int a = 0; a < 2; ++a)
#pragma unroll
        for (int b = 0; b < 2; ++b)
#pragma unroll
            for (int m = 0; m < 4; ++m)
#pragma unroll
                for (int n = 0; n < 2; ++n) acc[a][b][m][n] = (f32x4){0.f, 0.f, 0.f, 0.f};
    bf16x8 At[4][2], B0[2][2], B1[2][2];
    const char* cA = (const char*)g.A + (size_t)cur.pm * tstep; const char* cB = (const char*)g.Bt + (size_t)cur.pn * tstep;
    S.a_ready(cur);
    if constexpr (SP2) {
        PG8_STAGE(PG8_SB(0, 0), cB, voffB); PG8_STAGE(PG8_SB(0, 1), cB + hstep, voffB); PG8_STAGE(PG8_SA(0, 0), cA, voffA); PG8_STAGE(PG8_SA(0, 1), cA + hstep, voffA);
        if (wr == 1) PG8_BAR;
        PG8_WAIT_V(2); PG8_BAR;
        PG8_STAGE(PG8_SB(1, 0), cB + kstep, voffB); PG8_STAGE(PG8_SA(1, 0), cA + kstep, voffA); PG8_STAGE(PG8_SB(1, 1), cB + hstep + kstep, voffB);
        PG8_WAIT_V(6); PG8_BAR;
    } else {
        PG8_STAGE(PG8_SB(0, 0), cB, voffB); PG8_STAGE(PG8_SA(0, 0), cA, voffA); PG8_STAGE(PG8_SB(0, 1), cB + hstep, voffB); PG8_STAGE(PG8_SA(0, 1), cA + hstep, voffA);
        if (wr == 1) PG8_BAR;
        PG8_WAIT_V(4); PG8_BAR;
        PG8_STAGE(PG8_SB(1, 0), cB + kstep, voffB); PG8_STAGE(PG8_SA(1, 0), cA + kstep, voffA); PG8_STAGE(PG8_SB(1, 1), cB + hstep + kstep, voffB);
        PG8_WAIT_V(6); PG8_BAR;
    }
    for (;;) {
        const bool has_next = S.next(ui + 1, nxt);
        const char* nA = has_next ? (const char*)g.A + (size_t)nxt.pm * tstep : cA; const char* nB = has_next ? (const char*)g.Bt + (size_t)nxt.pn * tstep : cB;
        for (int t = 0; t < nt; t += 2) {
            const bool last = (t == nt - 2);
            const char* a1 = cA + (size_t)(t + 1) * kstep;
            const char* a2 = last ? nA : cA + (size_t)(t + 2) * kstep; const char* b2 = last ? nB : cB + (size_t)(t + 2) * kstep;
            const char* a3 = a2 + kstep; const char* b3 = b2 + kstep;
            if (last && has_next) S.a_ready(nxt);
            if constexpr (SP2) {
            PG8_LDB(B0, 0, 0); PG8_LDB(B1, 0, 1); PG8_SCHED; PG8_LDA(At, 0, 0); PG8_STAGE(PG8_SA(1, 1), a1 + hstep, voffA);
            PG8_WAIT_V(8); PG8_WAIT_L(0); PG8_BAR; PG8_MMA(0, 0, At, B0); PG8_MMA(0, 1, At, B1); PG8_BAR; PG8_SCHED;
            PG8_LDA(At, 0, 1); PG8_STAGE(PG8_SB(0, 0), b2, voffB); PG8_STAGE(PG8_SB(0, 1), b2 + hstep, voffB); PG8_STAGE(PG8_SA(0, 0), a2, voffA);
            PG8_WAIT_V(8); PG8_WAIT_L(0); PG8_BAR; PG8_MMA(1, 0, At, B0); PG8_MMA(1, 1, At, B1); PG8_BAR; PG8_SCHED;
            PG8_LDB(B0, 1, 0); PG8_LDB(B1, 1, 1); PG8_SCHED; PG8_LDA(At, 1, 0); PG8_STAGE(PG8_SA(0, 1), a2 + hstep, voffA);
            PG8_WAIT_V(8); PG8_WAIT_L(0); PG8_BAR; PG8_MMA(0, 0, At, B0); PG8_MMA(0, 1, At, B1); PG8_BAR; PG8_SCHED;
            PG8_LDA(At, 1, 1); PG8_STAGE(PG8_SB(1, 0), b3, voffB); PG8_STAGE(PG8_SB(1, 1), b3 + hstep, voffB); PG8_STAGE(PG8_SA(1, 0), a3, voffA);
            PG8_WAIT_V(8); PG8_WAIT_L(0); PG8_BAR; PG8_MMA(1, 0, At, B0); PG8_MMA(1, 1, At, B1); PG8_BAR; PG8_SCHED;
            } else {
            PG8_LDB(B0, 0, 0); PG8_SCHED; PG8_LDA(At, 0, 0); PG8_STAGE(PG8_SA(1, 1), a1 + hstep, voffA);
            PG8_WAIT_L(8); PG8_BAR; PG8_WAIT_L(0); PG8_MMA(0, 0, At, B0); PG8_BAR; PG8_SCHED;
            PG8_LDB(B1, 0, 1); PG8_STAGE(PG8_SB(0, 0), b2, voffB);
            PG8_BAR; PG8_WAIT_L(0); PG8_MMA(0, 1, At, B1); PG8_BAR;
            PG8_LDA(At, 0, 1); PG8_STAGE(PG8_SA(0, 0), a2, voffA);
            PG8_BAR; PG8_WAIT_L(0); PG8_MMA(1, 0, At, B0); PG8_BAR; PG8_SCHED;
            PG8_STAGE(PG8_SB(0, 1), b2 + hstep, voffB);
            PG8_WAIT_V(6); PG8_BAR; PG8_MMA(1, 1, At, B1); PG8_BAR;
            PG8_LDB(B0, 1, 0); PG8_SCHED; PG8_LDA(At, 1, 0); PG8_STAGE(PG8_SA(0, 1), a2 + hstep, voffA);
            PG8_WAIT_L(8); PG8_BAR; PG8_WAIT_L(0); PG8_MMA(0, 0, At, B0); PG8_BAR; PG8_SCHED;
            PG8_LDB(B1, 1, 1); PG8_STAGE(PG8_SB(1, 0), b3, voffB);
            PG8_BAR; PG8_WAIT_L(0); PG8_MMA(0, 1, At, B1); PG8_BAR;
            PG8_LDA(At, 1, 1); PG8_STAGE(PG8_SA(1, 0), a3, voffA);
            PG8_BAR; PG8_WAIT_L(0); PG8_MMA(1, 0, At, B0); PG8_BAR; PG8_SCHED;
            PG8_STAGE(PG8_SB(1, 1), b3 + hstep, voffB);
            PG8_WAIT_V(6); PG8_BAR; PG8_MMA(1, 1, At, B1); PG8_BAR;
            }
        }
        if constexpr (ALIGN_EPI) { if (wr == 0) PG8_BAR; }
        asm volatile("s_nop 15\n\ts_nop 15" ::: "memory");
        if constexpr (!Epi::AFTER_DRAIN) { E(acc, cur, wr, wc, fr, fq); S.done(cur); }
        if (!has_next) break;
#pragma unroll
        for (int a = 0; a < 2; ++a)
#pragma unroll
            for (int b = 0; b < 2; ++b)
#pragma unroll
                for (int m = 0; m < 4; ++m)
#pragma unroll
                    for (int n = 0; n < 2; ++n) acc[a][b][m][n] = (f32x4){0.f, 0.f, 0.f, 0.f};
        cur = nxt; cA = nA; cB = nB; ++ui;
        if constexpr (ALIGN_EPI) { if (wr == 1) PG8_BAR; }
    }
    PG8_WAIT_V(0);
    if constexpr (!ALIGN_EPI) { if (wr == 0) PG8_BAR; }
    PG8_BAR;
    if constexpr (Epi::AFTER_DRAIN) { E.fused(acc, cur, wr, wc, fr, fq, lds, wid, lane); S.done(cur); }
#undef PG8_SA
#undef PG8_SB
#undef PG8_STAGE
#undef PG8_LDA
#undef PG8_LDB
#undef PG8_MMA
#undef PG8_WAIT_V
#undef PG8_WAIT_L
#undef PG8_BAR
#undef PG8_SCHED
}
}

#define LAS __attribute__((address_space(3)))
typedef unsigned short bf16;
typedef short bf16x8 __attribute__((ext_vector_type(8)));
typedef float f32x4 __attribute__((ext_vector_type(4)));
typedef float f32x16 __attribute__((ext_vector_type(16)));
typedef unsigned u32x2 __attribute__((ext_vector_type(2)));
typedef unsigned u32x4 __attribute__((ext_vector_type(4)));

constexpr int NB = 8, SEQ = 2048, NMETA = 16, LL = 2064, DM = 1024, FF = 4096, DIN = 4864, NPROJ = 1792;
constexpr int NREAL = NB * SEQ;
constexpr int TPR = NREAL + 256;
constexpr int LDS_BYTES = 147456;

constexpr size_t MiB = 1u << 20;
constexpr size_t WS_CTL = 0;
constexpr size_t WS_ROPE = 1 * MiB;
constexpr size_t WS_ABAR = 2 * MiB;
constexpr size_t WS_BMAT = 2 * MiB + 65536;
constexpr size_t WS_CMAT = WS_BMAT + 524288;
constexpr size_t WS_HM = 4 * MiB;
constexpr size_t WS_W = 5 * MiB;
constexpr size_t OW_IN = 0, OW_GLU = (size_t)DIN * DM * 2, OW_POOL = OW_GLU + 512 * 512 * 2, OW_BR = OW_POOL + 512 * 512 * 2,
                 OW_OUT = OW_BR + 3 * 1024 * 512 * 2, OW_UP = OW_OUT + 1024 * 1024 * 2, OW_DN = OW_UP + (size_t)FF * DM * 2, LW_BYTES = OW_DN + (size_t)FF * DM * 2;
constexpr size_t WS_HB = 68 * MiB;
constexpr size_t WS_X = 101 * MiB;
constexpr size_t UU = (size_t)TPR * 512 * 2;
constexpr size_t WS_YF = WS_X, WS_YP = WS_X, WS_Q = WS_X + 2 * UU, WS_K = WS_Q + UU, WS_V = WS_K + UU / 4, WS_MG = WS_X + 2 * UU,
                 WS_SU = WS_X + 4 * UU, WS_YA = WS_X + 8 * UU  , WS_PU = WS_X + 5 * UU, WS_YS = WS_PU, WS_Z = WS_X + 6 * UU, WS_PD = WS_X + 7 * UU, WS_BR = WS_Z, WS_ACT = WS_X;
constexpr size_t WS_RS = WS_X + 9 * UU;
constexpr size_t WS_END = WS_RS + (size_t)5 * TPR * 16 * 4;
static_assert(WS_W + 2 * LW_BYTES <= WS_HB && WS_HB + (size_t)TPR * 1024 * 2 <= WS_X && WS_END <= 256 * MiB, "ws map");
static_assert((size_t)256 * 2064 * 16 * 4 <= 2 * UU, "YF fits");

__device__ __forceinline__ unsigned pk2(float lo, float hi) { unsigned r; asm("v_cvt_pk_bf16_f32 %0, %1, %2" : "=v"(r) : "v"(lo), "v"(hi)); return r; }
__device__ __forceinline__ unsigned f2bf(float f) { return pk2(f, 0.f) & 0xffffu; }
__device__ __forceinline__ float bf2f(unsigned b) { return __uint_as_float(b << 16); }
__device__ __forceinline__ int tok_row(int b, int l) { return l >= NMETA ? b * SEQ + l - NMETA : NREAL + b * NMETA + l; }
#define LDS_FENCE() asm volatile("s_waitcnt lgkmcnt(0)" ::: "memory")
#define SSM_SYNC() do { asm volatile("s_waitcnt vmcnt(0) lgkmcnt(0)" ::: "memory"); __syncthreads(); } while (0)
__device__ __forceinline__ float row_rstd(const float* rs, int R) {
    const f32x4 a = *(const f32x4*)(rs + (size_t)R * 4), b = *(const f32x4*)(rs + ((size_t)TPR + R) * 4), c = *(const f32x4*)(rs + ((size_t)2 * TPR + R) * 4), d = *(const f32x4*)(rs + ((size_t)3 * TPR + R) * 4);
    const float s = (((a[0] + a[1]) + (a[2] + a[3])) + ((b[0] + b[1]) + (b[2] + b[3]))) + (((c[0] + c[1]) + (c[2] + c[3])) + ((d[0] + d[1]) + (d[2] + d[3])));
    return rsqrtf(s * (1.0f / 1024.0f) + 1e-6f);
}

__device__ __forceinline__ void dsincos(double a, double& s, double& c) {
    const double q = rint(a * 0.63661977236758134308);
    double r = fma(-q, 1.57079632679489655800e+00, a); r = fma(-q, 6.12323399573676603587e-17, r);
    const double r2 = r * r;
    double sp = -7.6471637318198164759e-13; sp = fma(sp, r2, 1.6059043836821614599e-10); sp = fma(sp, r2, -2.5052108385441718775e-08); sp = fma(sp, r2, 2.7557319223985890653e-06);
    sp = fma(sp, r2, -1.9841269841269841270e-04); sp = fma(sp, r2, 8.3333333333333333333e-03); sp = fma(sp, r2, -1.6666666666666666667e-01); sp = fma(sp * r2, r, r);
    double cp = 4.7794773323873852974e-14; cp = fma(cp, r2, -1.1470745597729724714e-11); cp = fma(cp, r2, 2.0876756987868098979e-09); cp = fma(cp, r2, -2.7557319223985890653e-07);
    cp = fma(cp, r2, 2.4801587301587301587e-05); cp = fma(cp, r2, -1.3888888888888888889e-03); cp = fma(cp, r2, 4.1666666666666666667e-02); cp = fma(cp, r2, -0.5); cp = fma(cp, r2, 1.0);
    const int qi = ((int)q) & 3;
    s = (qi == 0) ? sp : (qi == 1) ? cp : (qi == 2) ? -sp : -cp;
    c = (qi == 0) ? cp : (qi == 1) ? -sp : (qi == 2) ? -cp : sp;
}
__device__ __forceinline__ double dexp(double x) {
    const double k = rint(x * 1.44269504088896340736);
    double r = fma(-k, 6.93147180369123816490e-01, x); r = fma(-k, 1.90821492927058770002e-10, r);
    double p = 1.0 / 6227020800.0; p = fma(p, r, 1.0 / 479001600.0); p = fma(p, r, 1.0 / 39916800.0); p = fma(p, r, 1.0 / 3628800.0); p = fma(p, r, 1.0 / 362880.0); p = fma(p, r, 1.0 / 40320.0);
    p = fma(p, r, 1.0 / 5040.0); p = fma(p, r, 1.0 / 720.0); p = fma(p, r, 1.0 / 120.0); p = fma(p, r, 1.0 / 24.0); p = fma(p, r, 1.0 / 6.0); p = fma(p, r, 0.5); p = fma(p, r, 1.0); p = fma(p, r, 1.0);
    const long long bits = ((long long)(1023 + (int)k)) << 52;
    return p * __longlong_as_double(bits);
}

struct EpiInProj {
    static constexpr bool PERM = true, AFTER_DRAIN = false;
    const float* rowss; const float* rope; bf16 *Q, *K, *V, *SU, *PU;
    __device__ __forceinline__ u32x2 quad(int l, int c, const f32x4& v) const {
        u32x2 w;
        if (c < 640) {
            const int i0 = (c & 63) >> 1;
            const f32x4 cs = *(const f32x4*)(rope + ((size_t)l * 32 + i0) * 2);
            float o0 = v[0] * cs[0] - v[1] * cs[1], o1 = v[1] * cs[0] + v[0] * cs[1], o2 = v[2] * cs[2] - v[3] * cs[3], o3 = v[3] * cs[2] + v[2] * cs[3];
            if (c < 512) { o0 *= 0.125f; o1 *= 0.125f; o2 *= 0.125f; o3 *= 0.125f; }
            w.x = pk2(o0, o1); w.y = pk2(o2, o3);
        } else { w.x = pk2(v[0], v[1]); w.y = pk2(v[2], v[3]); }
        return w;
    }
    __device__ __forceinline__ void operator()(const f32x4 (&acc)[2][2][4][2], const pg8::Unit& u, int wr, int wc, int fr, int fq) const {
#pragma unroll
        for (int ai = 0; ai < 2; ++ai)
#pragma unroll
            for (int m = 0; m < 4; ++m) {
                const int R = u.pm * 256 + ai * 128 + wr * 64 + m * 16 + fr;
                const float rs = row_rstd(rowss, R);
                const int l = R < NREAL ? (R & 2047) + NMETA : (R & 15);
#pragma unroll
                for (int bj = 0; bj < 2; ++bj) {
                    const int c = u.pn * 256 + bj * 128 + wc * 32 + 8 * fq;
                    const u32x2 w0 = quad(l, c, acc[ai][bj][m][0] * rs), w1 = quad(l, c + 4, acc[ai][bj][m][1] * rs);
                    u32x4 w; w.x = w0.x; w.y = w0.y; w.z = w1.x; w.w = w1.y;
                    bf16* dst = c < 512 ? Q + (size_t)R * 512 + c : c < 640 ? K + (size_t)R * 128 + (c - 512) : c < 768 ? V + (size_t)R * 128 + (c - 640)
                              : c < 1280 ? SU + (size_t)R * 512 + (c - 768) : PU + (size_t)R * 512 + (c - 1280);
                    *(u32x4*)dst = w;
                }
            }
    }
};
#define EPI_BODY() \
    __device__ __forceinline__ void rg(int R, int pn, int wc, int fq, const f32x4 (&a4)[2][2]) const { \
        _Pragma("unroll") for (int bj = 0; bj < 2; ++bj) q2(R, pn * 256 + bj * 128 + wc * 32 + 8 * fq, a4[bj][0], a4[bj][1]); } \
    __device__ __forceinline__ void tq(int R, int c, const f32x4& v) const { q(R, c, v); } \
    EPI_OP()
#define EPI_OP() \
    __device__ __forceinline__ void operator()(const f32x4 (&acc)[2][2][4][2], const pg8::Unit& u, int wr, int wc, int fr, int fq) const { \
        _Pragma("unroll") for (int ai = 0; ai < 2; ++ai) _Pragma("unroll") for (int m = 0; m < 4; ++m) { \
            const f32x4 a4[2][2] = {{acc[ai][0][m][0], acc[ai][0][m][1]}, {acc[ai][1][m][0], acc[ai][1][m][1]}}; \
            rg(u.pm * 256 + ai * 128 + wr * 64 + m * 16 + fr, u.pn, wc, fq, a4); } }
#define EPI_BODY_RS() \
    __device__ __forceinline__ void rg(int R, int pn, int wc, int fq, const f32x4 (&a4)[2][2]) const { const float rs = row_rstd(rowss, R); \
        _Pragma("unroll") for (int bj = 0; bj < 2; ++bj) q2(R, pn * 256 + bj * 128 + wc * 32 + 8 * fq, a4[bj][0], a4[bj][1], rs); } \
    __device__ __forceinline__ void tq(int R, int c, const f32x4& v) const { q(R, c, v, row_rstd(rowss, R)); } \
    EPI_OP()
struct EpiGlu {
    static constexpr bool PERM = true, AFTER_DRAIN = false;
    const bf16* Z; const float* bias; bf16* YS;
    __device__ __forceinline__ void q(int R, int c, const f32x4& a) const {
        const f32x4 v = a + *(const f32x4*)(bias + c);
        const u32x2 zz = *(const u32x2*)(Z + (size_t)R * 512 + c);
        const float z0 = bf2f(zz.x & 0xffffu), z1 = bf2f(zz.x >> 16), z2 = bf2f(zz.y & 0xffffu), z3 = bf2f(zz.y >> 16);
        u32x2 w; w.x = pk2(z0 * __builtin_amdgcn_rcpf(1.0f + __expf(-v[0])), z1 * __builtin_amdgcn_rcpf(1.0f + __expf(-v[1]))); w.y = pk2(z2 * __builtin_amdgcn_rcpf(1.0f + __expf(-v[2])), z3 * __builtin_amdgcn_rcpf(1.0f + __expf(-v[3])));
        *(u32x2*)(YS + (size_t)R * 512 + c) = w;
    }
    __device__ __forceinline__ void q2(int R, int c, const f32x4& a0, const f32x4& a1) const {
        const f32x4 v0 = a0 + *(const f32x4*)(bias + c), v1 = a1 + *(const f32x4*)(bias + c + 4);
        const u32x4 zz = *(const u32x4*)(Z + (size_t)R * 512 + c);
        u32x4 w;
        w.x = pk2(bf2f(zz.x & 0xffffu) * __builtin_amdgcn_rcpf(1.0f + __expf(-v0[0])), bf2f(zz.x >> 16) * __builtin_amdgcn_rcpf(1.0f + __expf(-v0[1])));
        w.y = pk2(bf2f(zz.y & 0xffffu) * __builtin_amdgcn_rcpf(1.0f + __expf(-v0[2])), bf2f(zz.y >> 16) * __builtin_amdgcn_rcpf(1.0f + __expf(-v0[3])));
        w.z = pk2(bf2f(zz.z & 0xffffu) * __builtin_amdgcn_rcpf(1.0f + __expf(-v1[0])), bf2f(zz.z >> 16) * __builtin_amdgcn_rcpf(1.0f + __expf(-v1[1])));
        w.w = pk2(bf2f(zz.w & 0xffffu) * __builtin_amdgcn_rcpf(1.0f + __expf(-v1[2])), bf2f(zz.w >> 16) * __builtin_amdgcn_rcpf(1.0f + __expf(-v1[3])));
        *(u32x4*)(YS + (size_t)R * 512 + c) = w;
    }
    EPI_BODY()
};
struct EpiScale {
    static constexpr bool PERM = true, AFTER_DRAIN = false;
    bf16* O; int ldc; const float* scale;
    __device__ __forceinline__ void q(int R, int c, const f32x4& a) const {
        f32x4 v = a;
        if (scale) v = v * *(const f32x4*)(scale + c);
        u32x2 w; w.x = pk2(v[0], v[1]); w.y = pk2(v[2], v[3]);
        *(u32x2*)(O + (size_t)R * ldc + c) = w;
    }
    __device__ __forceinline__ void q2(int R, int c, const f32x4& a0, const f32x4& a1) const {
        f32x4 v0 = a0, v1 = a1;
        if (scale) { v0 = v0 * *(const f32x4*)(scale + c); v1 = v1 * *(const f32x4*)(scale + c + 4); }
        u32x4 w; w.x = pk2(v0[0], v0[1]); w.y = pk2(v0[2], v0[3]); w.z = pk2(v1[0], v1[1]); w.w = pk2(v1[2], v1[3]);
        *(u32x4*)(O + (size_t)R * ldc + c) = w;
    }
    EPI_BODY()
};
template <bool FIRST> struct EpiGate {
    static constexpr bool PERM = true, AFTER_DRAIN = false;
    const float* rowss; const bf16* BR; bf16* MG;
    __device__ __forceinline__ void q(int R, int c, const f32x4& a, float rs) const {
        const f32x4 v = a * rs;
        const u32x2 bb = *(const u32x2*)(BR + (size_t)R * 1024 + c);
        float o0 = bf2f(bb.x & 0xffffu) * __builtin_amdgcn_rcpf(1.0f + __expf(-v[0])), o1 = bf2f(bb.x >> 16) * __builtin_amdgcn_rcpf(1.0f + __expf(-v[1]));
        float o2 = bf2f(bb.y & 0xffffu) * __builtin_amdgcn_rcpf(1.0f + __expf(-v[2])), o3 = bf2f(bb.y >> 16) * __builtin_amdgcn_rcpf(1.0f + __expf(-v[3]));
        if (!FIRST) { const u32x2 mm = *(const u32x2*)(MG + (size_t)R * 1024 + c);
            o0 += bf2f(mm.x & 0xffffu); o1 += bf2f(mm.x >> 16); o2 += bf2f(mm.y & 0xffffu); o3 += bf2f(mm.y >> 16); }
        u32x2 w; w.x = pk2(o0, o1); w.y = pk2(o2, o3);
        *(u32x2*)(MG + (size_t)R * 1024 + c) = w;
    }
    __device__ __forceinline__ void q2(int R, int c, const f32x4& a0, const f32x4& a1, float rs) const {
        const f32x4 v0 = a0 * rs, v1 = a1 * rs;
        const u32x4 bb = *(const u32x4*)(BR + (size_t)R * 1024 + c);
        float o[8];
        o[0] = bf2f(bb.x & 0xffffu) * __builtin_amdgcn_rcpf(1.0f + __expf(-v0[0])); o[1] = bf2f(bb.x >> 16) * __builtin_amdgcn_rcpf(1.0f + __expf(-v0[1]));
        o[2] = bf2f(bb.y & 0xffffu) * __builtin_amdgcn_rcpf(1.0f + __expf(-v0[2])); o[3] = bf2f(bb.y >> 16) * __builtin_amdgcn_rcpf(1.0f + __expf(-v0[3]));
        o[4] = bf2f(bb.z & 0xffffu) * __builtin_amdgcn_rcpf(1.0f + __expf(-v1[0])); o[5] = bf2f(bb.z >> 16) * __builtin_amdgcn_rcpf(1.0f + __expf(-v1[1]));
        o[6] = bf2f(bb.w & 0xffffu) * __builtin_amdgcn_rcpf(1.0f + __expf(-v1[2])); o[7] = bf2f(bb.w >> 16) * __builtin_amdgcn_rcpf(1.0f + __expf(-v1[3]));
        if (!FIRST) { const u32x4 mm = *(const u32x4*)(MG + (size_t)R * 1024 + c);
            o[0] += bf2f(mm.x & 0xffffu); o[1] += bf2f(mm.x >> 16); o[2] += bf2f(mm.y & 0xffffu); o[3] += bf2f(mm.y >> 16);
            o[4] += bf2f(mm.z & 0xffffu); o[5] += bf2f(mm.z >> 16); o[6] += bf2f(mm.w & 0xffffu); o[7] += bf2f(mm.w >> 16); }
        u32x4 w; w.x = pk2(o[0], o[1]); w.y = pk2(o[2], o[3]); w.z = pk2(o[4], o[5]); w.w = pk2(o[6], o[7]);
        *(u32x4*)(MG + (size_t)R * 1024 + c) = w;
    }
    EPI_BODY_RS()
};
struct EpiRes {
    static constexpr bool PERM = true, AFTER_DRAIN = false;
    const float* Xin; bf16* HB; float* rowss_out;
    __device__ __forceinline__ float q(int R, int c, const f32x4& a) const {
        f32x4 h;
        if (Xin && R < NREAL) h = *(const f32x4*)(Xin + (size_t)R * 1024 + c);
        else { const u32x2 hb = *(const u32x2*)(HB + (size_t)R * 1024 + c); h = (f32x4){bf2f(hb.x & 0xffffu), bf2f(hb.x >> 16), bf2f(hb.y & 0xffffu), bf2f(hb.y >> 16)}; }
        h = h + a;
        u32x2 w; w.x = pk2(h[0], h[1]); w.y = pk2(h[2], h[3]);
        *(u32x2*)(HB + (size_t)R * 1024 + c) = w;
        const float r0 = bf2f(w.x & 0xffffu), r1 = bf2f(w.x >> 16), r2 = bf2f(w.y & 0xffffu), r3 = bf2f(w.y >> 16);
        return (r0 * r0 + r1 * r1) + (r2 * r2 + r3 * r3);
    }
    __device__ __forceinline__ float q2(int R, int c, const f32x4& a0, const f32x4& a1) const {
        f32x4 h0, h1;
        if (Xin && R < NREAL) { h0 = *(const f32x4*)(Xin + (size_t)R * 1024 + c); h1 = *(const f32x4*)(Xin + (size_t)R * 1024 + c + 4); }
        else { const u32x4 hb = *(const u32x4*)(HB + (size_t)R * 1024 + c);
            h0 = (f32x4){bf2f(hb.x & 0xffffu), bf2f(hb.x >> 16), bf2f(hb.y & 0xffffu), bf2f(hb.y >> 16)}; h1 = (f32x4){bf2f(hb.z & 0xffffu), bf2f(hb.z >> 16), bf2f(hb.w & 0xffffu), bf2f(hb.w >> 16)}; }
        h0 = h0 + a0; h1 = h1 + a1;
        u32x4 w; w.x = pk2(h0[0], h0[1]); w.y = pk2(h0[2], h0[3]); w.z = pk2(h1[0], h1[1]); w.w = pk2(h1[2], h1[3]);
        *(u32x4*)(HB + (size_t)R * 1024 + c) = w;
        const float r0 = bf2f(w.x & 0xffffu), r1 = bf2f(w.x >> 16), r2 = bf2f(w.y & 0xffffu), r3 = bf2f(w.y >> 16), r4 = bf2f(w.z & 0xffffu), r5 = bf2f(w.z >> 16), r6 = bf2f(w.w & 0xffffu), r7 = bf2f(w.w >> 16);
        return ((r0 * r0 + r1 * r1) + (r2 * r2 + r3 * r3)) + ((r4 * r4 + r5 * r5) + (r6 * r6 + r7 * r7));
    }
    __device__ __forceinline__ void rg(int R, int pn, int wc, int fq, const f32x4 (&a4)[2][2]) const {
        float ss = 0.f;
#pragma unroll
        for (int bj = 0; bj < 2; ++bj) ss += q2(R, pn * 256 + bj * 128 + wc * 32 + 8 * fq, a4[bj][0], a4[bj][1]);
        ss += __shfl_xor(ss, 16); ss += __shfl_xor(ss, 32);
        if (fq == 0) rowss_out[((size_t)pn * TPR + R) * 4 + wc] = ss;
    }
    __device__ __forceinline__ void tq(int R, int c, const f32x4& v) const {
        float ss = q(R, c, v);
        ss += __shfl_xor(ss, 16); ss += __shfl_xor(ss, 32);
        if ((threadIdx.x & 48) == 0) atomicAdd(rowss_out + (size_t)R * 4, ss);
    }
    EPI_OP()
};
struct EpiUp {
    static constexpr bool PERM = true, AFTER_DRAIN = false;
    const float* rowss; bf16* ACT;
    __device__ __forceinline__ void q(int R, int c, const f32x4& a, float rs) const {
        f32x4 v = a * rs;
#pragma unroll
        for (int j = 0; j < 4; ++j) { const float r = fmaxf(v[j], 0.f); v[j] = r * r; }
        u32x2 w; w.x = pk2(v[0], v[1]); w.y = pk2(v[2], v[3]);
        *(u32x2*)(ACT + (size_t)R * FF + c) = w;
    }
    __device__ __forceinline__ void q2(int R, int c, const f32x4& a0, const f32x4& a1, float rs) const {
        f32x4 v0 = a0 * rs, v1 = a1 * rs;
#pragma unroll
        for (int j = 0; j < 4; ++j) { const float r0 = fmaxf(v0[j], 0.f), r1 = fmaxf(v1[j], 0.f); v0[j] = r0 * r0; v1[j] = r1 * r1; }
        u32x4 w; w.x = pk2(v0[0], v0[1]); w.y = pk2(v0[2], v0[3]); w.z = pk2(v1[0], v1[1]); w.w = pk2(v1[2], v1[3]);
        *(u32x4*)(ACT + (size_t)R * FF + c) = w;
    }
    EPI_BODY_RS()
};
template <class Epi>
__device__ __forceinline__ void thin_gemm(LAS unsigned char* lds, const bf16* A, const bf16* Bt, int K, int N, const Epi& E, int vb, int vg) {
    int tid_l = threadIdx.x; asm volatile("" : "+v"(tid_l));
    const int lane = tid_l & 63, w = __builtin_amdgcn_readfirstlane(tid_l >> 6), fr = lane & 15, fq = lane >> 4;
    LAS f32x4* red = (LAS f32x4*)lds;
    const int kw = K >> 3;
    for (int pc = vb; pc < N / 16; pc += vg) {
        const bf16* ap = A + (size_t)(NREAL + fr) * K + w * kw + 8 * fq;
        const bf16* bp = Bt + (size_t)(16 * pc + fr) * K + w * kw + 8 * fq;
        f32x4 acc[8];
#pragma unroll
        for (int rb = 0; rb < 8; ++rb) acc[rb] = (f32x4){0.f, 0.f, 0.f, 0.f};
#pragma unroll 2
        for (int k0 = 0; k0 < kw; k0 += 32) {
            const bf16x8 bf = *(const bf16x8*)(bp + k0);
            bf16x8 af[8];
#pragma unroll
            for (int rb = 0; rb < 8; ++rb) af[rb] = *(const bf16x8*)(ap + (size_t)(16 * rb) * K + k0);
#pragma unroll
            for (int rb = 0; rb < 8; ++rb) acc[rb] = __builtin_amdgcn_mfma_f32_16x16x32_bf16(bf, af[rb], acc[rb], 0, 0, 0);
        }
        asm volatile("s_nop 15\n\ts_nop 15" : "+v"(acc[0]), "+v"(acc[1]), "+v"(acc[2]), "+v"(acc[3]), "+v"(acc[4]), "+v"(acc[5]), "+v"(acc[6]), "+v"(acc[7]));
#pragma unroll
        for (int rb = 0; rb < 8; ++rb) red[(w * 8 + rb) * 64 + lane] = acc[rb];
        LDS_FENCE(); __syncthreads();
        f32x4 v = red[(0 * 8 + w) * 64 + lane];
#pragma unroll
        for (int ww = 1; ww < 8; ++ww) v = v + red[(ww * 8 + w) * 64 + lane];
        LDS_FENCE(); __syncthreads();
        E.tq(NREAL + 16 * w + fr, 16 * pc + 4 * fq, v);
    }
}

struct Args { const float* in[23]; float* out; unsigned char* ws; };

__device__ __forceinline__ void p0_item(const float* W, int ldw, int K, const float* scale, bf16* WT, int permrows, LAS float* scr, int item, int nblk, int lane) {
    const int kb = item / nblk, nb = item % nblk, k0 = 64 * kb, n0 = 64 * nb;
#pragma unroll 4
    for (int i = 0; i < 16; ++i) {
        const int kk = 4 * i + (lane >> 4), c4 = (lane & 15) * 4;
        f32x4 w = *(const f32x4*)(W + (size_t)(k0 + kk) * ldw + n0 + c4);
        if (scale) w = w * scale[k0 + kk];
        scr[kk * 65 + c4] = w[0]; scr[kk * 65 + c4 + 1] = w[1]; scr[kk * 65 + c4 + 2] = w[2]; scr[kk * 65 + c4 + 3] = w[3];
    }
    LDS_FENCE();
    const int c = lane & 7;
#pragma unroll
    for (int j = 0; j < 8; ++j) {
        const int n = (lane >> 3) + 8 * j;
        const int sc = (n0 + n) < permrows ? ((n & 1) ? 32 + (n >> 1) : (n >> 1)) : n;
        const LAS float* s = scr + (8 * c) * 65 + sc;
        u32x4 o; o.x = pk2(s[0 * 65], s[1 * 65]); o.y = pk2(s[2 * 65], s[3 * 65]); o.z = pk2(s[4 * 65], s[5 * 65]); o.w = pk2(s[6 * 65], s[7 * 65]);
        *(u32x4*)(WT + (size_t)(n0 + n) * K + k0 + 8 * c) = o;
    }
    LDS_FENCE();
}

__device__ __forceinline__ void p0_prologue(const Args& a, LAS unsigned char* lds) {
    int tl_ = threadIdx.x; asm volatile("" : "+v"(tl_));
    const int tid = tl_, lane = tid & 63, wave = __builtin_amdgcn_readfirstlane(tid >> 6);
    const int gw = blockIdx.x * 8 + wave, NGW = gridDim.x * 8;
    const int gt = blockIdx.x * 512 + tid, NGT = gridDim.x * 512;
    unsigned char* ws = a.ws;
    LAS float* scr = (LAS float*)(lds + wave * 17408);
    for (int i = gt; i < 4 * 4 * 128 * 4; i += NGT) { const int idx = 1 + (i >> 11), pn = (i >> 9) & 3, r = (i >> 2) & 127, sl = i & 3;
        ((float*)(ws + WS_RS))[((size_t)idx * 4 * TPR + (size_t)pn * TPR + NREAL + r) * 4 + sl] = 0.f; }
    constexpr int I_IN = 16 * 76, I_GLU = 8 * 8, I_BR = 8 * 16, I_OUT = 16 * 16, I_UP = 16 * 64, I_DN = 64 * 16, I_L = I_IN + I_GLU + 3 * I_BR + I_OUT + I_UP + I_DN;
    for (int it = gw; it < 2 * I_L; it += NGW) {
        const int layer = it / I_L; int r = it % I_L;
        unsigned char* wl = ws + WS_W + (size_t)layer * LW_BYTES;
        if (r < I_IN) { p0_item(a.in[3] + (size_t)layer * DM * DIN, DIN, DM, a.in[2] + layer * DM, (bf16*)(wl + OW_IN), 640, scr, r, 76, lane); continue; } r -= I_IN;
        if (r < I_GLU) { p0_item(a.in[13] + (size_t)layer * 512 * 512, 512, 512, nullptr, (bf16*)(wl + OW_GLU), 0, scr, r, 8, lane); continue; } r -= I_GLU;
        if (r < 3 * I_BR) { const int c = r / I_BR; p0_item(a.in[17] + ((size_t)layer * 3 + c) * 512 * 1024, 1024, 512, nullptr, (bf16*)(wl + OW_BR) + (size_t)c * 1024 * 512, 0, scr, r % I_BR, 16, lane); continue; } r -= 3 * I_BR;
        if (r < I_OUT) { p0_item(a.in[18] + (size_t)layer * DM * DM, DM, DM, nullptr, (bf16*)(wl + OW_OUT), 0, scr, r, 16, lane); continue; } r -= I_OUT;
        if (r < I_UP) { p0_item(a.in[20] + (size_t)layer * DM * FF, FF, DM, a.in[19] + layer * DM, (bf16*)(wl + OW_UP), 0, scr, r, 64, lane); continue; } r -= I_UP;
        p0_item(a.in[21] + (size_t)layer * FF * DM, DM, FF, nullptr, (bf16*)(wl + OW_DN), 0, scr, r, 16, lane);
    }
    for (int i = gt; i < 2 * 512 * 512; i += NGT) {
        const int layer = i >> 18, n = (i >> 9) & 511, k = i & 511;
        float w = 0.f;
        if ((n >> 7) == (k >> 7)) w = a.in[15][(((size_t)layer * 4 + (n >> 7)) * 128 + (k & 127)) * 128 + (n & 127)];
        ((bf16*)(ws + WS_W + (size_t)layer * LW_BYTES + OW_POOL))[(size_t)n * 512 + k] = (bf16)f2bf(w);
    }
    for (int i = gt; i < LL * 32; i += NGT) {
        const int l = i >> 5, f = i & 31;
        const float invf = (float)dexp(-(double)f * (9.21034037197618273607 / 32.0));
        const float ang = (float)l * invf;
        double s, c; dsincos((double)ang, s, c);
        float* rp = (float*)(ws + WS_ROPE) + (size_t)i * 2; rp[0] = (float)c; rp[1] = (float)s;
    }
    for (int i = gt; i < 2 * 2 * 32 * 64; i += NGT) {
        const int n = i & 63, pidx = i >> 6;
        const double lr = (double)a.in[5][i], li = (double)a.in[6][i];
        const double dt = (double)(float)dexp((double)a.in[7][pidx]);
        const double mag = dexp(lr * dt); double sn, cn; dsincos(li * dt, sn, cn);
        const double are = mag * cn, aim = mag * sn, den = lr * lr + li * li, nre = are - 1.0;
        const double fre = (nre * lr + aim * li) / den, fim = (aim * lr - nre * li) / den;
        float* ab = (float*)(ws + WS_ABAR) + (size_t)i * 2; ab[0] = (float)are; ab[1] = (float)aim;
        bf16* bm = (bf16*)(ws + WS_BMAT) + (size_t)pidx * 128 * 16;
        bf16* cm = (bf16*)(ws + WS_CMAT) + (size_t)pidx * 16 * 128;
        for (int q = 0; q < 16; ++q) {
            const double br = (double)a.in[8][(size_t)i * 16 + q], bi = (double)a.in[9][(size_t)i * 16 + q];
            bm[n * 16 + q] = (bf16)f2bf((float)(fre * br - fim * bi));
            bm[(64 + n) * 16 + q] = (bf16)f2bf((float)(fre * bi + fim * br));
            cm[q * 128 + n] = (bf16)f2bf(a.in[10][((size_t)pidx * 16 + q) * 64 + n]);
            cm[q * 128 + 64 + n] = (bf16)f2bf(-a.in[11][((size_t)pidx * 16 + q) * 64 + n]);
        }
    }
    for (int R = gw; R < TPR; R += NGW) {
        const int mrow = R - NREAL;
        const float* src = R < NREAL ? a.in[0] + (size_t)R * DM : a.in[1] + (size_t)(mrow & 15) * DM;
        float* dst = R < NREAL ? a.out + (size_t)R * DM : (float*)(ws + WS_HM) + (size_t)mrow * DM;
        bf16* hb = (bf16*)(ws + WS_HB) + (size_t)R * DM;
        const bool pad = mrow >= NB * NMETA;
        float ss = 0.f;
#pragma unroll
        for (int j = 0; j < 4; ++j) {
            f32x4 v = *(const f32x4*)(src + 4 * lane + 256 * j);
            if (pad) v = (f32x4){0.f, 0.f, 0.f, 0.f};
            ss += (v[0] * v[0] + v[1] * v[1]) + (v[2] * v[2] + v[3] * v[3]);
            u32x2 w; w.x = pk2(v[0], v[1]); w.y = pk2(v[2], v[3]);
            *(u32x2*)(hb + 4 * lane + 256 * j) = w;
        }
#pragma unroll
        for (int o = 1; o < 64; o <<= 1) ss += __shfl_xor(ss, o);
        if (lane < 16) ((float*)(ws + WS_RS))[((size_t)(lane >> 2) * TPR + R) * 4 + (lane & 3)] = lane == 0 ? ss : 0.f;
    }
}

__device__ __forceinline__ void ssm_task(LAS unsigned char* lds, int task, int layer, const bf16* SU, float* YF,
                                         const float* abar_all, const bf16* bmat_all, const bf16* cmat_all) {
    int tid_l = threadIdx.x; asm volatile("" : "+v"(tid_l));
    const int tid = tid_l, lane = tid & 63, wave = __builtin_amdgcn_readfirstlane(tid >> 6);
    const int b = task >> 5, g = task & 31;
    __syncthreads();
    LAS float* BU = (LAS float*)(lds + wave * 12800);
    LAS unsigned short* X = (LAS unsigned short*)(lds + wave * 12800 + 8448);
    LAS float* SX = (LAS float*)(lds + 8 * 12800);
    const int blk0 = wave == 0 ? 0 : 16 * wave + 1, nblk = wave == 0 ? 17 : 16;
    bf16* yfb = (bf16*)YF + (size_t)task * LL * 16;
    const int fr = lane & 15, fq = lane >> 4;
    const bf16x8 zero8 = {0, 0, 0, 0, 0, 0, 0, 0};
    for (int dir = 0; dir < 2; ++dir) {
        const int pidx = (layer * 2 + dir) * 32 + g;
        const float are = abar_all[((size_t)pidx * 64 + lane) * 2], aim = abar_all[((size_t)pidx * 64 + lane) * 2 + 1];
        bf16x8 bfr[8], cfr[4];
        const bf16* bm = bmat_all + (size_t)pidx * 128 * 16;
#pragma unroll
        for (int nt = 0; nt < 8; ++nt) bfr[nt] = fq < 2 ? *(const bf16x8*)(bm + (nt * 16 + fr) * 16 + 8 * fq) : zero8;
        const bf16* cm = cmat_all + (size_t)pidx * 16 * 128;
#pragma unroll
        for (int ks = 0; ks < 4; ++ks) cfr[ks] = *(const bf16x8*)(cm + fr * 128 + ks * 32 + 8 * fq);
        float p16r = are, p16i = aim;
#pragma unroll
        for (int i = 0; i < 4; ++i) { const float tr = p16r * p16r - p16i * p16i, ti = 2.f * p16r * p16i; p16r = tr; p16i = ti; }
        float p256r = p16r, p256i = p16i;
#pragma unroll
        for (int i = 0; i < 4; ++i) { const float tr = p256r * p256r - p256i * p256i, ti = 2.f * p256r * p256i; p256r = tr; p256i = ti; }
        const float p272r = p256r * p16r - p256i * p16i, p272i = p256r * p16i + p256i * p16r;

        float xre = 0.f, xim = 0.f;
        for (int pass = 0; pass < 2; ++pass) {
            bf16x8 unext;
            { const int blkf = dir == 0 ? blk0 : blk0 + nblk - 1; const int Rf = blkf == 0 ? NREAL + b * NMETA : b * SEQ + blkf * 16 - NMETA;
              unext = fq < 2 ? *(const bf16x8*)(SU + (size_t)(Rf + fr) * 512 + g * 16 + 8 * fq) : zero8; }
            for (int ib = 0; ib < nblk; ++ib) {
                const int blk = dir == 0 ? blk0 + ib : blk0 + nblk - 1 - ib;
                const bf16x8 ufr = unext;
                if (ib + 1 < nblk) { const int blkn = dir == 0 ? blk + 1 : blk - 1; const int Rn = blkn == 0 ? NREAL + b * NMETA : b * SEQ + blkn * 16 - NMETA;
                    unext = fq < 2 ? *(const bf16x8*)(SU + (size_t)(Rn + fr) * 512 + g * 16 + 8 * fq) : zero8; }
                f32x4 dd[8];
#pragma unroll
                for (int nt = 0; nt < 8; ++nt) { dd[nt] = (f32x4){0.f, 0.f, 0.f, 0.f}; dd[nt] = __builtin_amdgcn_mfma_f32_16x16x32_bf16(ufr, bfr[nt], dd[nt], 0, 0, 0); }
                asm volatile("s_nop 15\n\ts_nop 15" : "+v"(dd[0]), "+v"(dd[1]), "+v"(dd[2]), "+v"(dd[3]), "+v"(dd[4]), "+v"(dd[5]), "+v"(dd[6]), "+v"(dd[7]));
#pragma unroll
                for (int nt = 0; nt < 8; ++nt)
#pragma unroll
                    for (int r = 0; r < 4; ++r) BU[(4 * fq + r) * 132 + nt * 16 + fr] = dd[nt][r];
                LDS_FENCE();
                float bur[16], bui[16];
#pragma unroll
                for (int i = 0; i < 16; ++i) { const int tt = dir == 0 ? i : 15 - i; bur[i] = BU[tt * 132 + lane]; bui[i] = BU[tt * 132 + 64 + lane]; }
                if (pass == 0) {
#pragma unroll
                    for (int i = 0; i < 16; ++i) {
                        const float bre = bur[i], bim = bui[i];
                        const float nr = are * xre - aim * xim + bre, ni = are * xim + aim * xre + bim; xre = nr; xim = ni;
                    }
                    LDS_FENCE();
                } else {
#pragma unroll
                    for (int i = 0; i < 16; ++i) {
                        const int tt = dir == 0 ? i : 15 - i;
                        const float bre = bur[i], bim = bui[i];
                        const float nr = are * xre - aim * xim + bre, ni = are * xim + aim * xre + bim; xre = nr; xim = ni;
                        X[tt * 136 + lane] = (unsigned short)f2bf(xre); X[tt * 136 + 64 + lane] = (unsigned short)f2bf(xim);
                    }
                    LDS_FENCE();
                    f32x4 y = {0.f, 0.f, 0.f, 0.f};
#pragma unroll
                    for (int ks = 0; ks < 4; ++ks) {
                        const bf16x8 afr = *(const LAS bf16x8*)(X + fr * 136 + ks * 32 + 8 * fq);
                        y = __builtin_amdgcn_mfma_f32_16x16x32_bf16(afr, cfr[ks], y, 0, 0, 0);
                    }
                    asm volatile("s_nop 15\n\ts_nop 15" : "+v"(y));
                    LDS_FENCE();
                    {
                        bf16* yd = yfb + (size_t)dir * 256 * LL * 16;
#pragma unroll
                        for (int r = 0; r < 4; ++r) yd[(size_t)(blk * 16 + 4 * fq + r) * 16 + fr] = (bf16)f2bf(y[r]);
                    }
                }
            }
            if (pass == 0) {
                SX[(wave * 64 + lane) * 2] = xre; SX[(wave * 64 + lane) * 2 + 1] = xim;
                LDS_FENCE(); __syncthreads();
                float cre = 0.f, cim = 0.f;
                if (dir == 0) {
                    for (int w = 0; w < wave; ++w) { const float pr = w == 0 ? p272r : p256r, pi = w == 0 ? p272i : p256i;
                        const float sr = SX[(w * 64 + lane) * 2], si = SX[(w * 64 + lane) * 2 + 1];
                        const float nr = pr * cre - pi * cim + sr, ni = pr * cim + pi * cre + si; cre = nr; cim = ni; }
                } else {
                    for (int w = 7; w > wave; --w) {
                        const float sr = SX[(w * 64 + lane) * 2], si = SX[(w * 64 + lane) * 2 + 1];
                        const float nr = p256r * cre - p256i * cim + sr, ni = p256r * cim + p256i * cre + si; cre = nr; cim = ni; }
                }
                xre = cre; xim = cim;
            }
        }
        LDS_FENCE(); __syncthreads();
    }
}

constexpr int ATT_KROW = 72, ATT_VROW = 40, ATT_KT = 32 * ATT_KROW * 2  , ATT_VT = 64 * ATT_VROW * 2  , ATT_MAXT = 11, ATT_VOFF = ATT_MAXT * ATT_KT;
static_assert(ATT_VOFF + ATT_MAXT * ATT_VT <= 131072, "attention LDS");
__device__ __forceinline__ void attn_task(LAS unsigned char* lds, int task, const bf16* Q, const bf16* K, const bf16* V, bf16* YA, const float* sink) {
    int tid_l = threadIdx.x; asm volatile("" : "+v"(tid_l));
    const int tid = tid_l, lane = tid & 63, wave = __builtin_amdgcn_readfirstlane(tid >> 6);
    const int qb = task % 33, bh = task / 33, h = bh & 1, b = bh >> 1;
    const int l0 = qb * 64;
    __syncthreads();
    int jlo = (l0 - 128) >> 5; if (jlo < 1) jlo = 1;
    int jhi = (l0 + 191) >> 5; if (jhi > 64) jhi = 64;
    const int ntiles = 1 + (jhi - jlo + 1);
    LAS unsigned short* Ks = (LAS unsigned short*)lds;
    LAS unsigned short* Vs = (LAS unsigned short*)(lds + ATT_VOFF);
    for (int idx = tid; idx < ntiles * 32 * 8; idx += 512) {
        const int ch = idx & 7, key = idx >> 3, slot = key >> 5, kk = key & 31;
        const int lk = (slot == 0 ? 0 : (jlo + slot - 1) * 32) + kk;
        u32x4 kv = {0u, 0u, 0u, 0u}, vv = {0u, 0u, 0u, 0u};
        if (lk < LL) { const size_t R = (size_t)tok_row(b, lk);
            kv = *(const u32x4*)(K + R * 128 + h * 64 + ch * 8); vv = *(const u32x4*)(V + R * 128 + h * 64 + ch * 8); }
        *(LAS u32x4*)(Ks + slot * (ATT_KT / 2) + kk * ATT_KROW + ch * 8) = kv;
        LAS unsigned short* vd = Vs + slot * (ATT_VT / 2) + (ch * 8) * ATT_VROW + kk;
        vd[0 * ATT_VROW] = (unsigned short)(vv.x & 0xffffu); vd[1 * ATT_VROW] = (unsigned short)(vv.x >> 16);
        vd[2 * ATT_VROW] = (unsigned short)(vv.y & 0xffffu); vd[3 * ATT_VROW] = (unsigned short)(vv.y >> 16);
        vd[4 * ATT_VROW] = (unsigned short)(vv.z & 0xffffu); vd[5 * ATT_VROW] = (unsigned short)(vv.z >> 16);
        vd[6 * ATT_VROW] = (unsigned short)(vv.w & 0xffffu); vd[7 * ATT_VROW] = (unsigned short)(vv.w >> 16);
    }
    LDS_FENCE(); __syncthreads();
    const int head = h * 4 + (wave >> 1), r32 = lane & 31, hi = lane >> 5;
    const int lq = l0 + 32 * (wave & 1) + r32;
    const bool qvalid = lq < LL;
    const size_t Rq = (size_t)tok_row(b, qvalid ? lq : LL - 1);
    bf16x8 qf[4];
#pragma unroll
    for (int ks = 0; ks < 4; ++ks) qf[ks] = *(const bf16x8*)(Q + Rq * 512 + head * 64 + ks * 16 + 8 * hi);
    float mrun = sink[head], lsum = hi == 0 ? 1.0f : 0.0f;
    f32x16 o0, o1;
#pragma unroll
    for (int i = 0; i < 16; ++i) { o0[i] = 0.f; o1[i] = 0.f; }
    const int lqw = l0 + 32 * (wave & 1);
    for (int slot = 0; slot < ntiles; ++slot) {
        const int kbase = slot == 0 ? 0 : (jlo + slot - 1) * 32;
        if (lqw >= LL || (slot != 0 && (kbase + 31 < lqw - 128 || kbase > lqw + 31 + 128))) continue;
        const LAS unsigned short* kt = Ks + slot * (ATT_KT / 2);
        f32x16 s;
#pragma unroll
        for (int i = 0; i < 16; ++i) s[i] = 0.f;
#pragma unroll
        for (int ks = 0; ks < 4; ++ks) {
            const bf16x8 kf = *(const LAS bf16x8*)(kt + r32 * ATT_KROW + ks * 16 + 8 * hi);
            s = __builtin_amdgcn_mfma_f32_32x32x16_bf16(kf, qf[ks], s, 0, 0, 0);
        }
        asm volatile("s_nop 15\n\ts_nop 15" : "+v"(s));
        float mt = -1e30f;
#pragma unroll
        for (int i = 0; i < 16; ++i) {
            const int lk = kbase + (i & 3) + 8 * (i >> 2) + 4 * hi;
            int d = lq - lk; d = d < 0 ? -d : d;
            const bool valid = (lk < NMETA) || (d <= 128 && lk < LL);
            s[i] = valid ? s[i] : -1e30f;
            mt = fmaxf(mt, s[i]);
        }
        mt = fmaxf(mt, __shfl_xor(mt, 32));
        const float mnew = fmaxf(mrun, mt);
        const float alpha = __expf(mrun - mnew);
        mrun = mnew;
        float ps = 0.f;
#pragma unroll
        for (int i = 0; i < 16; ++i) { s[i] = __expf(s[i] - mnew); ps += s[i]; }
        lsum = lsum * alpha + ps;
#pragma unroll
        for (int i = 0; i < 16; ++i) { o0[i] *= alpha; o1[i] *= alpha; }
        const LAS unsigned short* vt = Vs + slot * (ATT_VT / 2);
#pragma unroll
        for (int s2 = 0; s2 < 2; ++s2) {
            union { bf16x8 v; unsigned u[4]; } pf;
            pf.u[0] = pk2(s[8 * s2 + 0], s[8 * s2 + 1]); pf.u[1] = pk2(s[8 * s2 + 2], s[8 * s2 + 3]);
            pf.u[2] = pk2(s[8 * s2 + 4], s[8 * s2 + 5]); pf.u[3] = pk2(s[8 * s2 + 6], s[8 * s2 + 7]);
#pragma unroll
            for (int dt = 0; dt < 2; ++dt) {
                union { bf16x8 v; u32x2 u[2]; } vf;
                const LAS unsigned short* vp = vt + (dt * 32 + r32) * ATT_VROW + 16 * s2 + 4 * hi;
                vf.u[0] = *(const LAS u32x2*)(vp); vf.u[1] = *(const LAS u32x2*)(vp + 8);
                if (dt == 0) o0 = __builtin_amdgcn_mfma_f32_32x32x16_bf16(vf.v, pf.v, o0, 0, 0, 0);
                else o1 = __builtin_amdgcn_mfma_f32_32x32x16_bf16(vf.v, pf.v, o1, 0, 0, 0);
            }
        }
    }
    asm volatile("s_nop 15\n\ts_nop 15" : "+v"(o0), "+v"(o1));
    lsum += __shfl_xor(lsum, 32);
    const float inv = 1.0f / lsum;
    if (qvalid) {
#pragma unroll
        for (int g4 = 0; g4 < 4; ++g4) {
            u32x2 w0, w1;
            w0.x = pk2(o0[4 * g4] * inv, o0[4 * g4 + 1] * inv); w0.y = pk2(o0[4 * g4 + 2] * inv, o0[4 * g4 + 3] * inv);
            w1.x = pk2(o1[4 * g4] * inv, o1[4 * g4 + 1] * inv); w1.y = pk2(o1[4 * g4 + 2] * inv, o1[4 * g4 + 3] * inv);
            *(u32x2*)(YA + Rq * 512 + head * 64 + 8 * g4 + 4 * hi) = w0;
            *(u32x2*)(YA + Rq * 512 + head * 64 + 32 + 8 * g4 + 4 * hi) = w1;
        }
    }
    __syncthreads();
}

__device__ __forceinline__ void pool_diff(LAS unsigned char* lds, const bf16* PU, bf16* PD) {
    int tl_ = threadIdx.x; asm volatile("" : "+v"(tl_));
    constexpr int TOK = 65, HALO = 8, ROWS = TOK + 2 * HALO, NTOK = NB * LL;
    for (int blk = blockIdx.x; blk * TOK < NTOK; blk += gridDim.x) {
        const int f0 = blk * TOK;
        __syncthreads();
        for (int i = tl_; i < ROWS * 64; i += 512) {
            const int r = i >> 6, ch = i & 63, f = f0 - HALO + r;
            u32x4 v = {0u, 0u, 0u, 0u};
            if (f >= 0 && f < NTOK) { const int b = f / LL, l = f % LL; v = *(const u32x4*)(PU + (size_t)tok_row(b, l) * 512 + ch * 8); }
            *(LAS u32x4*)(lds + (size_t)i * 16) = v;
        }
        LDS_FENCE(); __syncthreads();
        for (int i = tl_; i < TOK * 64; i += 512) {
            const int t = i >> 6, ch = i & 63, f = f0 + t;
            if (f >= NTOK) continue;
            const int b = f / LL, l = f % LL, half = 1 << (ch >> 4);
            const int lo = l - half < 0 ? 0 : l - half, hh = l + half > LL ? LL : l + half;
            float s[8];
#pragma unroll
            for (int j = 0; j < 8; ++j) s[j] = 0.f;
            for (int lp = lo; lp < hh; ++lp) {
                const u32x4 v = *(const LAS u32x4*)(lds + (size_t)((t + HALO + lp - l) * 64 + ch) * 16);
                s[0] += bf2f(v.x & 0xffffu); s[1] += bf2f(v.x >> 16); s[2] += bf2f(v.y & 0xffffu); s[3] += bf2f(v.y >> 16);
                s[4] += bf2f(v.z & 0xffffu); s[5] += bf2f(v.z >> 16); s[6] += bf2f(v.w & 0xffffu); s[7] += bf2f(v.w >> 16);
            }
            const float ic = 1.0f / (float)(hh - lo);
            const u32x4 v = *(const LAS u32x4*)(lds + (size_t)((t + HALO) * 64 + ch) * 16);
            u32x4 o;
            o.x = pk2(s[0] * ic - bf2f(v.x & 0xffffu), s[1] * ic - bf2f(v.x >> 16)); o.y = pk2(s[2] * ic - bf2f(v.y & 0xffffu), s[3] * ic - bf2f(v.y >> 16));
            o.z = pk2(s[4] * ic - bf2f(v.z & 0xffffu), s[5] * ic - bf2f(v.z >> 16)); o.w = pk2(s[6] * ic - bf2f(v.w & 0xffffu), s[7] * ic - bf2f(v.w >> 16));
            *(u32x4*)(PD + (size_t)tok_row(b, l) * 512 + ch * 8) = o;
        }
    }
    __syncthreads();
}

__device__ __forceinline__ void z_pass(const float* YF, const bf16* SU, const float* dskip, bf16* Z) {
    int tl_ = threadIdx.x; asm volatile("" : "+v"(tl_)); const int gt = blockIdx.x * 512 + tl_, NGT = gridDim.x * 512;
    for (int i = gt; i < NB * LL * 64; i += NGT) {
        const int ch = i & 63, tk = i >> 6, b = tk / LL, l = tk % LL, g = ch >> 1;
        const size_t R = (size_t)tok_row(b, l);
        const bf16* yp = (const bf16*)YF + ((size_t)(b * 32 + g) * LL + l) * 16 + (ch & 1) * 8;
        const u32x4 ya = *(const u32x4*)yp, yb = *(const u32x4*)(yp + (size_t)256 * LL * 16);
        f32x4 y0, y1;
        y0[0] = bf2f(ya.x & 0xffffu) + bf2f(yb.x & 0xffffu); y0[1] = bf2f(ya.x >> 16) + bf2f(yb.x >> 16); y0[2] = bf2f(ya.y & 0xffffu) + bf2f(yb.y & 0xffffu); y0[3] = bf2f(ya.y >> 16) + bf2f(yb.y >> 16);
        y1[0] = bf2f(ya.z & 0xffffu) + bf2f(yb.z & 0xffffu); y1[1] = bf2f(ya.z >> 16) + bf2f(yb.z >> 16); y1[2] = bf2f(ya.w & 0xffffu) + bf2f(yb.w & 0xffffu); y1[3] = bf2f(ya.w >> 16) + bf2f(yb.w >> 16);
        const f32x4 d0 = *(const f32x4*)(dskip + ch * 8), d1 = *(const f32x4*)(dskip + ch * 8 + 4);
        const u32x4 uu = *(const u32x4*)(SU + R * 512 + ch * 8);
        float t[8];
        t[0] = y0[0] + d0[0] * bf2f(uu.x & 0xffffu); t[1] = y0[1] + d0[1] * bf2f(uu.x >> 16); t[2] = y0[2] + d0[2] * bf2f(uu.y & 0xffffu); t[3] = y0[3] + d0[3] * bf2f(uu.y >> 16);
        t[4] = y1[0] + d1[0] * bf2f(uu.z & 0xffffu); t[5] = y1[1] + d1[1] * bf2f(uu.z >> 16); t[6] = y1[2] + d1[2] * bf2f(uu.w & 0xffffu); t[7] = y1[3] + d1[3] * bf2f(uu.w >> 16);
#pragma unroll
        for (int j = 0; j < 8; ++j) {
            const float v = t[j], tt = __builtin_amdgcn_rcpf(fabsf(v) * 0.2316418882f + 1.0f);
            float q = tt * 0.5307027145f + (-0.7265760135f); q = q * tt + 0.7107068705f; q = q * tt + (-0.142248368f); q = q * tt + 0.127414796f; q = q * tt;
            const float m = v * (q * __builtin_amdgcn_exp2f(v * v * (-0.72134752044f)));
            t[j] = v < 0.f ? m : v - m;
        }
        u32x4 o; o.x = pk2(t[0], t[1]); o.y = pk2(t[2], t[3]); o.z = pk2(t[4], t[5]); o.w = pk2(t[6], t[7]);
        *(u32x4*)(Z + R * 512 + ch * 8) = o;
    }
}

#define XB_TMO      128
#define XB_XCNT(j)  (256  + 64 * (j))
#define XB_XSUB(j)  (1280 + 64 * (j))
#define XB_XGEN(j)  (2304 + 64 * (j))
#define XB_TOP      3328
#define XB_TOPGEN   3392
#define XCD_BAR_WORDS 3456
#define XB_SPIN_CAP (1u << 18)

__device__ __forceinline__ unsigned xb_ld(unsigned* p)              { return __hip_atomic_load(p, __ATOMIC_RELAXED, __HIP_MEMORY_SCOPE_AGENT); }
__device__ __forceinline__ unsigned xb_add(unsigned* p, unsigned v) { return __hip_atomic_fetch_add(p, v, __ATOMIC_RELAXED, __HIP_MEMORY_SCOPE_AGENT); }
__device__ __forceinline__ unsigned xb_xcc_id() { return (unsigned)__builtin_amdgcn_s_getreg((3 << 11) | 20) & 0xFu; }
#define XB_SPIN(cond, bar) do { unsigned _sp = 0; while (cond) { __builtin_amdgcn_s_sleep(1); \
    if ((++_sp & 255u) == 0u) { if (xb_ld(&(bar)[XB_TMO])) break; if (_sp > XB_SPIN_CAP) { atomicAdd(&(bar)[XB_TMO], 1u); break; } } } } while (0)

struct XcdBarrier {
    unsigned* bar; unsigned x;
    volatile LAS unsigned* st;
};

__device__ __forceinline__ XcdBarrier xcd_barrier_post(unsigned* bar, volatile LAS unsigned* st) {
    XcdBarrier b; b.bar = bar; b.x = xb_xcc_id(); b.st = st;
    if (threadIdx.x == 0) (void)xb_add(&bar[XB_XCNT(b.x)], 1u);
    return b;
}
__device__ __forceinline__ void xcd_barrier_complete(unsigned* bar, unsigned x, unsigned& nloc, unsigned& nx) {
    const unsigned G = gridDim.x * gridDim.y * gridDim.z;
    unsigned sum, cnt, mine, sp = 0u;
    for (;;) {
        sum = 0u; cnt = 0u; mine = 0u;
#pragma unroll
        for (unsigned j = 0; j < 16; ++j) { const unsigned c = xb_ld(&bar[XB_XCNT(j)]); sum += c; cnt += (c > 0u) ? 1u : 0u; mine = (j == x) ? c : mine; }
        if (sum == G) break;
        __builtin_amdgcn_s_sleep(1);
        if ((++sp & 255u) == 0u) { if (xb_ld(&bar[XB_TMO])) break; if (sp > XB_SPIN_CAP) { atomicAdd(&bar[XB_TMO], 1u); break; } }
    }
    nloc = mine > 0u ? mine : 1u; nx = cnt > 0u ? cnt : 1u;
}

__device__ __forceinline__ void xcd_barrier(const XcdBarrier& b) {
    asm volatile("s_waitcnt vmcnt(0)" ::: "memory");
    __syncthreads();
    if (threadIdx.x == 0) {
        unsigned* bar = b.bar;
        __builtin_amdgcn_s_waitcnt(0);
        unsigned nloc = b.st[0], nx = b.st[1];
        if (nloc == 0u) { xcd_barrier_complete(bar, b.x, nloc, nx); b.st[0] = nloc; b.st[1] = nx; }
        const unsigned old = xb_add(&bar[XB_XSUB(b.x)], 1u);
        const unsigned gen = old / nloc;
        if (old + 1u == (gen + 1u) * nloc) {
            __builtin_amdgcn_fence(__ATOMIC_RELEASE, "agent");
            asm volatile("s_waitcnt vmcnt(0)" ::: "memory");
            const unsigned og = xb_add(&bar[XB_TOP], 1u);
            const unsigned tg = og / nx;
            if (og + 1u == (tg + 1u) * nx) xb_add(&bar[XB_TOPGEN], 1u);
            else XB_SPIN(xb_ld(&bar[XB_TOPGEN]) == tg, bar);
            __builtin_amdgcn_fence(__ATOMIC_ACQUIRE, "agent");
            xb_add(&bar[XB_XGEN(b.x)], 1u);
            asm volatile("s_waitcnt vmcnt(0)" ::: "memory");
        } else {
            XB_SPIN(xb_ld(&bar[XB_XGEN(b.x)]) == gen, bar);
            __builtin_amdgcn_fence(__ATOMIC_ACQUIRE, "agent");
            asm volatile("s_waitcnt vmcnt(0)" ::: "memory");
        }
    }
    __syncthreads();
}

#ifndef MK_ALIGN
#define MK_ALIGN true
#endif
#ifndef MK_SP2
#define MK_SP2 true
#endif
#ifndef MK_SPLIT
#define MK_SPLIT 0
#endif
constexpr int NPL = 8, NPHASE = 1 + 2 * NPL + 1, PH_FINAL = NPHASE - 1;

typedef const __attribute__((address_space(4))) Args* KArgsP;
#define KARGS() ({ auto kp_ = __builtin_amdgcn_kernarg_segment_ptr(); asm volatile("" : "+s"(kp_)); (KArgsP)kp_; })
__global__ void __launch_bounds__(512, 2) fwd_kernel(Args a_unused, int ph_lo, int ph_hi) {
    (void)a_unused;
    extern __shared__ __attribute__((aligned(16))) unsigned char lds_raw[];
    LAS unsigned char* lds = (LAS unsigned char*)lds_raw;
    const int G = gridDim.x, bid = blockIdx.x;
#if MK_SPLIT
#define GRID_SYNC() do {} while (0)
    (void)lds;
#else
#define CG_SYNC() do { asm volatile("s_waitcnt vmcnt(0)" ::: "memory"); __syncthreads(); \
    if (threadIdx.x == 0) { __builtin_amdgcn_fence(__ATOMIC_RELEASE, "agent"); asm volatile("s_waitcnt vmcnt(0)" ::: "memory"); } \
    __syncthreads(); grid.sync(); \
    if (threadIdx.x == 0) { __builtin_amdgcn_fence(__ATOMIC_ACQUIRE, "agent"); asm volatile("s_waitcnt vmcnt(0)" ::: "memory"); } \
    __syncthreads(); } while (0)
    cg::grid_group grid = cg::this_grid();
    unsigned* barw = (unsigned*)(KARGS()->ws + WS_CTL);
    if (bid == 0) for (int i = threadIdx.x; i < XCD_BAR_WORDS; i += 512) __hip_atomic_store(barw + i, 0u, __ATOMIC_RELAXED, __HIP_MEMORY_SCOPE_AGENT);
    volatile LAS unsigned* xst = (volatile LAS unsigned*)(lds + LDS_BYTES - 64);
    if (threadIdx.x < 2) xst[threadIdx.x] = 0u;
    CG_SYNC();
    const XcdBarrier xbar = xcd_barrier_post(barw, xst);
#define GRID_SYNC() xcd_barrier(xbar)

#endif
#ifndef PHMASK
#define PHMASK 0xFFFFu
#endif
#define IN(k) (((PHMASK >> ((k) == 0 ? 0 : (k) == PH_FINAL ? 9 : 1 + ((k) - 1) % NPL)) & 1u) && ph_lo <= (k) && (k) < ph_hi)
#define SEAM(k) do { if (IN(k) && (k) + 1 < ph_hi) GRID_SYNC(); } while (0)
#define PHASE_BEGIN() KArgsP ka = KARGS(); unsigned char* ws = ka->ws; asm volatile("" : "+s"(ws)); float* rowss = (float*)(ws + WS_RS); float* Hm = (float*)(ws + WS_HM); bf16* HB = (bf16*)(ws + WS_HB); unsigned char* wl = ws + WS_W + (size_t)layer * LW_BYTES; \
    const int MT = NREAL; const bool META = layer != MK_NLAYER - 1;     \
    const float* rs_mix = rowss + (size_t)(2 * layer) * TPR * 16; float* rs_mlp = rowss + (size_t)(2 * layer + 1) * TPR * 16; float* rs_next = rowss + (size_t)(2 * layer + 2) * TPR * 16; (void)MT; (void)META; (void)Hm; (void)HB; (void)wl; (void)rs_mix; (void)rs_mlp; (void)rs_next;

    if (IN(0)) { Args al; { KArgsP kp = KARGS(); for (int i = 0; i < 23; ++i) al.in[i] = kp->in[i]; al.out = kp->out; al.ws = kp->ws; } p0_prologue(al, lds); }
    SEAM(0);
#ifndef MK_NLAYER
#define MK_NLAYER 2
#endif
#ifndef MK_RSIDX
#define MK_RSIDX 4
#endif
#pragma unroll 1
    for (int layer = 0; layer < MK_NLAYER; ++layer) {
        const int p = 1 + NPL * layer;
        if (IN(p)) { PHASE_BEGIN();
            pg8::Gemm g{HB, (const bf16*)(wl + OW_IN), TPR, NPROJ, DM}; pg8::StaticOrder S; S.init(TPR, NPROJ, G, bid);
            EpiInProj E{rs_mix, (const float*)(ws + WS_ROPE), (bf16*)(ws + WS_Q), (bf16*)(ws + WS_K), (bf16*)(ws + WS_V), (bf16*)(ws + WS_SU), (bf16*)(ws + WS_PU)};
            pg8::gemm_phase<EpiInProj, pg8::StaticOrder, MK_ALIGN, MK_SP2>(lds, g, S, E);
        }
        SEAM(p);
        if (IN(p + 1)) { PHASE_BEGIN();
            for (int t = bid; t < 256; t += G)
                ssm_task(lds, t, layer, (const bf16*)(ws + WS_SU), (float*)(ws + WS_YF), (const float*)(ws + WS_ABAR), (const bf16*)(ws + WS_BMAT), (const bf16*)(ws + WS_CMAT));
            for (int t = bid; t < NB * 2 * 33; t += G)
                attn_task(lds, t, (const bf16*)(ws + WS_Q), (const bf16*)(ws + WS_K), (const bf16*)(ws + WS_V), (bf16*)(ws + WS_YA), ka->in[4] + layer * 8);
            pool_diff(lds, (const bf16*)(ws + WS_PU), (bf16*)(ws + WS_PD));
        }
        SEAM(p + 1);
        if (IN(p + 2)) { PHASE_BEGIN();
            z_pass((const float*)(ws + WS_YF), (const bf16*)(ws + WS_SU), ka->in[12] + layer * 512, (bf16*)(ws + WS_Z));
        }
        SEAM(p + 2);
        if (IN(p + 3)) { PHASE_BEGIN();
            const int hg = G >> 1;
            if (bid < hg) { pg8::Gemm g{(const bf16*)(ws + WS_Z), (const bf16*)(wl + OW_GLU), MT, 512, 512}; pg8::StaticOrder S; S.init(MT, 512, hg, bid);
              EpiGlu E{(const bf16*)(ws + WS_Z), ka->in[14] + layer * 512, (bf16*)(ws + WS_YS)};
              pg8::gemm_phase<EpiGlu, pg8::StaticOrder, MK_ALIGN, MK_SP2>(lds, g, S, E); if (META) thin_gemm<EpiGlu>(lds, g.A, g.Bt, g.K, g.N, E, bid, hg); }
            else { pg8::Gemm g{(const bf16*)(ws + WS_PD), (const bf16*)(wl + OW_POOL), MT, 512, 512}; pg8::StaticOrder S; S.init(MT, 512, G - hg, bid - hg);
              EpiScale E{(bf16*)(ws + WS_YP), 512, ka->in[16] + layer * 512};
              pg8::gemm_phase<EpiScale, pg8::StaticOrder, MK_ALIGN, MK_SP2>(lds, g, S, E); if (META) thin_gemm<EpiScale>(lds, g.A, g.Bt, g.K, g.N, E, bid - hg, G - hg); }
        }
        SEAM(p + 3);
        if (IN(p + 4)) { PHASE_BEGIN();
#pragma unroll 1
            for (int c = 0; c < 3; ++c) {
                const bf16* Yc = (const bf16*)(ws + (c == 0 ? WS_YA : c == 1 ? WS_YS : WS_YP));
                { pg8::Gemm g{Yc, (const bf16*)(wl + OW_BR) + (size_t)c * 1024 * 512, MT, 1024, 512}; pg8::StaticOrder S; S.init(MT, 1024, G, bid);
                  EpiScale E{(bf16*)(ws + WS_BR), 1024, nullptr};
                  pg8::gemm_phase<EpiScale, pg8::StaticOrder, MK_ALIGN, MK_SP2>(lds, g, S, E); if (META) thin_gemm<EpiScale>(lds, g.A, g.Bt, g.K, g.N, E, bid, G); }
                pg8::Gemm g{HB, (const bf16*)(wl + OW_IN) + (size_t)(NPROJ + c * 1024) * DM, MT, 1024, DM}; pg8::StaticOrder S; S.init(MT, 1024, G, bid);
                if (c == 0) { EpiGate<true> E{rs_mix, (const bf16*)(ws + WS_BR), (bf16*)(ws + WS_MG)}; pg8::gemm_phase<EpiGate<true>, pg8::StaticOrder, MK_ALIGN, MK_SP2>(lds, g, S, E); if (META) thin_gemm<EpiGate<true>>(lds, g.A, g.Bt, g.K, g.N, E, bid, G); }
                else { EpiGate<false> E{rs_mix, (const bf16*)(ws + WS_BR), (bf16*)(ws + WS_MG)}; pg8::gemm_phase<EpiGate<false>, pg8::StaticOrder, MK_ALIGN, MK_SP2>(lds, g, S, E); if (META) thin_gemm<EpiGate<false>>(lds, g.A, g.Bt, g.K, g.N, E, bid, G); }
            }
        }
        SEAM(p + 4);
        if (IN(p + 5)) { PHASE_BEGIN();
            pg8::Gemm g{(const bf16*)(ws + WS_MG), (const bf16*)(wl + OW_OUT), MT, DM, DM}; pg8::StaticOrder S; S.init(MT, DM, G, bid);
            EpiRes E{layer == 0 ? ka->in[0] : (const float*)nullptr, HB, rs_mlp};
            pg8::gemm_phase<EpiRes, pg8::StaticOrder, MK_ALIGN, MK_SP2>(lds, g, S, E); if (META) thin_gemm<EpiRes>(lds, g.A, g.Bt, g.K, g.N, E, bid, G);
        }
        SEAM(p + 5);
        if (IN(p + 6)) { PHASE_BEGIN();
            pg8::Gemm g{HB, (const bf16*)(wl + OW_UP), MT, FF, DM}; pg8::StaticOrder S; S.init(MT, FF, G, bid);
            EpiUp E{rs_mlp, (bf16*)(ws + WS_ACT)};
            pg8::gemm_phase<EpiUp, pg8::StaticOrder, MK_ALIGN, MK_SP2>(lds, g, S, E); if (META) thin_gemm<EpiUp>(lds, g.A, g.Bt, g.K, g.N, E, bid, G);
        }
        SEAM(p + 6);
        if (IN(p + 7)) { PHASE_BEGIN();
            pg8::Gemm g{(const bf16*)(ws + WS_ACT), (const bf16*)(wl + OW_DN), MT, DM, FF}; pg8::StaticOrder S; S.init(MT, DM, G, bid);
            EpiRes E{(const float*)nullptr, HB, rs_next};
            pg8::gemm_phase<EpiRes, pg8::StaticOrder, MK_ALIGN, MK_SP2>(lds, g, S, E); if (META) thin_gemm<EpiRes>(lds, g.A, g.Bt, g.K, g.N, E, bid, G);
        }
        SEAM(p + 7);
    }
#ifdef MK_DUMP_OFF
    if (IN(PH_FINAL)) { KArgsP ka = KARGS();
        const bf16* src = (const bf16*)(ka->ws + (MK_DUMP_OFF)); const bf16* src2 = (const bf16*)(ka->ws + (MK_DUMP_OFF2));
        for (int i = bid * 512 + threadIdx.x; i < NREAL * 1024; i += G * 512) { const int R = MK_DUMP_ROW(i >> 10), c = i & 1023; ka->out[i] = c < 512 ? bf2f(src[(size_t)R * (MK_DUMP_LD) + (c % (MK_DUMP_LD))]) : bf2f(src2[(size_t)R * (MK_DUMP_LD2) + (c % (MK_DUMP_LD2))]); }
    }
#else
    if (IN(PH_FINAL)) { KArgsP ka = KARGS();
        const float* rs = (const float*)(ka->ws + WS_RS) + (size_t)MK_RSIDX * TPR * 16; const float* gain = ka->in[22];
        int tl_ = threadIdx.x; asm volatile("" : "+v"(tl_));
        for (int i = bid * 512 + tl_; i < NREAL * 256; i += G * 512) {
            const int R = i >> 8, c4 = (i & 255) * 4;
            const float r = row_rstd(rs, R);
            const u32x2 hb = *(const u32x2*)((const bf16*)(ka->ws + WS_HB) + (size_t)R * DM + c4); const f32x4 gn = *(const f32x4*)(gain + c4);
            f32x4 v = {bf2f(hb.x & 0xffffu), bf2f(hb.x >> 16), bf2f(hb.y & 0xffffu), bf2f(hb.y >> 16)};
            v = v * r * gn;
            *(f32x4*)(ka->out + (size_t)R * DM + c4) = v;
        }
    }
#endif
#undef IN
#undef SEAM
}

extern "C" void kernel_launch(void* const* d_in, const int* in_sizes, int n_in, void* d_out, int out_size, void* d_ws, size_t ws_size, hipStream_t stream) {
    static int grid = 0;
    if (grid == 0) {
        if (n_in != 23 || out_size != NREAL * DM || ws_size < WS_END) { fprintf(stderr, "kernel_launch: unexpected shapes (n_in %d out %d ws %zu)\n", n_in, out_size, ws_size); grid = -1; return; }
        int dev = 0, cus = 0, per_cu = 0;
        hipGetDevice(&dev); hipDeviceGetAttribute(&cus, hipDeviceAttributeMultiprocessorCount, dev);
        if (hipFuncSetAttribute((const void*)fwd_kernel, hipFuncAttributeMaxDynamicSharedMemorySize, LDS_BYTES) != hipSuccess) { fprintf(stderr, "kernel_launch: hipFuncSetAttribute failed\n"); grid = -1; return; }
        if (hipOccupancyMaxActiveBlocksPerMultiprocessor(&per_cu, (const void*)fwd_kernel, 512, LDS_BYTES) != hipSuccess || per_cu < 1) { fprintf(stderr, "kernel_launch: occupancy query gave %d\n", per_cu); per_cu = 1; }
        (void)hipGetLastError();
        grid = cus * (per_cu > 1 ? 1 : per_cu);
        if (grid <= 0) grid = 256;
    }
    if (grid < 0) return;
    Args a{};
    for (int i = 0; i < 23; ++i) a.in[i] = (const float*)d_in[i];
    a.out = (float*)d_out; a.ws = (unsigned char*)d_ws;
#if MK_SPLIT
    for (int ph = 0; ph < NPHASE; ++ph) hipLaunchKernelGGL(fwd_kernel, dim3(grid), dim3(512), LDS_BYTES, stream, a, ph, ph + 1);
#else
    int lo = 0, hi = NPHASE;
    void* kargs[] = {(void*)&a, (void*)&lo, (void*)&hi};
    hipError_t e = hipLaunchCooperativeKernel((const void*)fwd_kernel, dim3(grid), dim3(512), kargs, LDS_BYTES, stream);
    if (e != hipSuccess) fprintf(stderr, "kernel_launch: cooperative launch failed: %s (grid %d)\n", hipGetErrorString(e), grid);
#endif
}
```

```cpp
#include <hip/hip_runtime.h>
#include <hip/hip_cooperative_groups.h>
#include <cstdio>
#include <cstdint>
namespace cg = cooperative_groups;
namespace pg8 {
#define PG8_LAS __attribute__((address_space(3)))
typedef unsigned short bf16_t;
typedef short bf16x8 __attribute__((ext_vector_type(8)));
typedef float f32x4 __attribute__((ext_vector_type(4)));
typedef unsigned u32x4 __attribute__((ext_vector_type(4)));
constexpr int BM = 256, BK = 64, HALF = 128, HTB = HALF * BK * 2  , STAGE_BYTES = 8 * HTB, NXCD = 8, WGM = 8;

__host__ __device__ __forceinline__ int lds_byte(int r, int c) { const int st = (r >> 4) * 2 + (c >> 5), rr = r & 15, cc = c & 31, ob = rr * 64 + cc * 2; return st * 1024 + (ob ^ (((ob >> 9) & 1) << 5)); }
__host__ __device__ __forceinline__ void stage_rc(int b, int& R, int& C) { const int st = b / 1024, sb = b % 1024, swz = sb ^ (((sb >> 9) & 1) << 5); R = (st >> 1) * 16 + swz / 64; C = (st & 1) * 32 + (swz % 64) / 2; }
__host__ __device__ __forceinline__ int perm32(int rho) { const int n = rho >> 4, i = rho & 15; return 8 * (i >> 2) + 4 * n + (i & 3); }

struct Unit { int pm, pn; };
struct Gemm { const bf16_t* A; const bf16_t* Bt; int M, N, K; };

struct StaticOrder {
    int nM, nN, nwg, G, c;
    __host__ __device__ void init(int M, int N, int G_, int c_) { nM = M / BM; nN = N / BM; nwg = nM * nN; G = G_; c = c_; }
    __host__ __device__ __forceinline__ bool next(int i, Unit& u) const {
        const long L = (long)i * G + c; if (L >= nwg) return false;
        int wgid = (int)L; { const int q = nwg / NXCD, r = nwg % NXCD, xcd = wgid % NXCD, off = wgid / NXCD; wgid = (xcd < r ? xcd * (q + 1) : r * (q + 1) + (xcd - r) * q) + off; }
        const int nig = WGM * nN, gid = wgid / nig, fm = gid * WGM, gsz = (nM - fm) < WGM ? (nM - fm) : WGM;
        u.pm = fm + ((wgid % nig) % gsz); u.pn = (wgid % nig) / gsz; return true;
    }
    __device__ __forceinline__ void a_ready(const Unit&) const {}
    __device__ __forceinline__ void done(const Unit&) const {}
};

__device__ __forceinline__ unsigned cvt_pk_bf16(float lo, float hi) { unsigned r; asm volatile("v_cvt_pk_bf16_f32 %0, %1, %2" : "=v"(r) : "v"(lo), "v"(hi)); return r; }
template <class Epi, class Sched, bool ALIGN_EPI = false, bool SP2 = false>
__device__ __forceinline__ void gemm_phase(PG8_LAS unsigned char* lds, const Gemm g, const Sched& S, const Epi& E) {
    int tid_l = threadIdx.x; asm volatile("" : "+v"(tid_l));
    const int tid = tid_l, wid = __builtin_amdgcn_readfirstlane(tid >> 6), lane = tid & 63, wr = wid >> 2, wc = wid & 3, fr = lane & 15, fq = lane >> 4;
    const int K = g.K, nt = K / BK;
    unsigned voffA[2], voffB[2];
#pragma unroll
    for (int i = 0; i < 2; ++i) { int R, C; stage_rc(tid * 16 + i * 8192, R, C); const int Rb = Epi::PERM ? ((R & ~31) + perm32(R & 31)) : R;
        voffA[i] = (unsigned)(R * K + C) * 2u; voffB[i] = (unsigned)(Rb * K + C) * 2u; }
    const size_t kstep = (size_t)(BK * 2);
    const size_t hstep = (size_t)HALF * K * 2;
    const size_t tstep = 2 * hstep;
    const unsigned ldsw = (unsigned)wid * 1024u;
    const int aoff = lds_byte(wr * 64 + fr, fq * 8), boff = lds_byte(wc * 32 + fr, fq * 8);
#define PG8_SA(b, h) (((b) * 2 + (h)) * HTB)
#define PG8_SB(b, h) ((4 + (b) * 2 + (h)) * HTB)
#define PG8_STAGE(bufoff, gbase, voff) do { _Pragma("unroll") for (int _i = 0; _i < 2; ++_i) \
        __builtin_amdgcn_global_load_lds((const unsigned*)((const char*)(gbase) + (voff)[_i]), (PG8_LAS unsigned*)(lds + (bufoff) + ldsw + _i * 8192), 16, 0, 0); } while (0)
#define PG8_LDA(dst, b, h) do { _Pragma("unroll") for (int m = 0; m < 4; ++m) _Pragma("unroll") for (int k = 0; k < 2; ++k) dst[m][k] = *(const PG8_LAS bf16x8*)(lds + PG8_SA(b, h) + aoff + m * 2048 + k * 1024); } while (0)
#define PG8_LDB(dst, b, h) do { _Pragma("unroll") for (int n = 0; n < 2; ++n) _Pragma("unroll") for (int k = 0; k < 2; ++k) dst[n][k] = *(const PG8_LAS bf16x8*)(lds + PG8_SB(b, h) + boff + n * 2048 + k * 1024); } while (0)
#define PG8_MMA(ai, bj, At, Bt) do { __builtin_amdgcn_s_setprio(1); _Pragma("unroll") for (int m = 0; m < 4; ++m) _Pragma("unroll") for (int n = 0; n < 2; ++n) _Pragma("unroll") for (int k = 0; k < 2; ++k) \
        acc[ai][bj][m][n] = __builtin_amdgcn_mfma_f32_16x16x32_bf16(Bt[n][k], At[m][k], acc[ai][bj][m][n], 0, 0, 0); __builtin_amdgcn_s_setprio(0); } while (0)
#define PG8_WAIT_V(n) asm volatile("s_waitcnt vmcnt(" #n ")" ::: "memory")
#define PG8_WAIT_L(n) asm volatile("s_waitcnt lgkmcnt(" #n ")" ::: "memory")
#define PG8_BAR __builtin_amdgcn_s_barrier()
#define PG8_SCHED __builtin_amdgcn_sched_barrier(0)
    Unit cur, nxt; int ui = 0;
    if (!S.next(0, cur)) return;
    f32x4 acc[2][2][4][2];
#pragma unroll
    for (int a = 0; a < 2; ++a)
#pragma unroll
        for (int b = 0; b < 2; ++b)
#pragma unroll
            for (int m = 0; m < 4; ++m)
#pragma unroll
                for (int n = 0; n < 2; ++n) acc[a][b][m][n] = (f32x4){0.f, 0.f, 0.f, 0.f};
    bf16x8 At[4][2], B0[2][2], B1[2][2];
    const char* cA = (const char*)g.A + (size_t)cur.pm * tstep; const char* cB = (const char*)g.Bt + (size_t)cur.pn * tstep;
    S.a_ready(cur);
    if constexpr (SP2) {
        PG8_STAGE(PG8_SB(0, 0), cB, voffB); PG8_STAGE(PG8_SB(0, 1), cB + hstep, voffB); PG8_STAGE(PG8_SA(0, 0), cA, voffA); PG8_STAGE(PG8_SA(0, 1), cA + hstep, voffA);
        if (wr == 1) PG8_BAR;
        PG8_WAIT_V(2); PG8_BAR;
        PG8_STAGE(PG8_SB(1, 0), cB + kstep, voffB); PG8_STAGE(PG8_SA(1, 0), cA + kstep, voffA); PG8_STAGE(PG8_SB(1, 1), cB + hstep + kstep, voffB);
        PG8_WAIT_V(6); PG8_BAR;
    } else {
        PG8_STAGE(PG8_SB(0, 0), cB, voffB); PG8_STAGE(PG8_SA(0, 0), cA, voffA); PG8_STAGE(PG8_SB(0, 1), cB + hstep, voffB); PG8_STAGE(PG8_SA(0, 1), cA + hstep, voffA);
        if (wr == 1) PG8_BAR;
        PG8_WAIT_V(4); PG8_BAR;
        PG8_STAGE(PG8_SB(1, 0), cB + kstep, voffB); PG8_STAGE(PG8_SA(1, 0), cA + kstep, voffA); PG8_STAGE(PG8_SB(1, 1), cB + hstep + kstep, voffB);
        PG8_WAIT_V(6); PG8_BAR;
    }
    for (;;) {
        const bool has_next = S.next(ui + 1, nxt);
        const char* nA = has_next ? (const char*)g.A + (size_t)nxt.pm * tstep : cA; const char* nB = has_next ? (const char*)g.Bt + (size_t)nxt.pn * tstep : cB;
        for (int t = 0; t < nt; t += 2) {
            const bool last = (t == nt - 2);
            const char* a1 = cA + (size_t)(t + 1) * kstep;
            const char* a2 = last ? nA : cA + (size_t)(t + 2) * kstep; const char* b2 = last ? nB : cB + (size_t)(t + 2) * kstep;
            const char* a3 = a2 + kstep; const char* b3 = b2 + kstep;
            if (last && has_next) S.a_ready(nxt);
            if constexpr (SP2) {
            PG8_LDB(B0, 0, 0); PG8_LDB(B1, 0, 1); PG8_SCHED; PG8_LDA(At, 0, 0); PG8_STAGE(PG8_SA(1, 1), a1 + hstep, voffA);
            PG8_WAIT_V(8); PG8_WAIT_L(0); PG8_BAR; PG8_MMA(0, 0, At, B0); PG8_MMA(0, 1, At, B1); PG8_BAR; PG8_SCHED;
            PG8_LDA(At, 0, 1); PG8_STAGE(PG8_SB(0, 0), b2, voffB); PG8_STAGE(PG8_SB(0, 1), b2 + hstep, voffB); PG8_STAGE(PG8_SA(0, 0), a2, voffA);
            PG8_WAIT_V(8); PG8_WAIT_L(0); PG8_BAR; PG8_MMA(1, 0, At, B0); PG8_MMA(1, 1, At, B1); PG8_BAR; PG8_SCHED;
            PG8_LDB(B0, 1, 0); PG8_LDB(B1, 1, 1); PG8_SCHED; PG8_LDA(At, 1, 0); PG8_STAGE(PG8_SA(0, 1), a2 + hstep, voffA);
            PG8_WAIT_V(8); PG8_WAIT_L(0); PG8_BAR; PG8_MMA(0, 0, At, B0); PG8_MMA(0, 1, At, B1); PG8_BAR; PG8_SCHED;
            PG8_LDA(At, 1, 1); PG8_STAGE(PG8_SB(1, 0), b3, voffB); PG8_STAGE(PG8_SB(1, 1), b3 + hstep, voffB); PG8_STAGE(PG8_SA(1, 0), a3, voffA);
            PG8_WAIT_V(8); PG8_WAIT_L(0); PG8_BAR; PG8_MMA(1, 0, At, B0); PG8_MMA(1, 1, At, B1); PG8_BAR; PG8_SCHED;
            } else {
            PG8_LDB(B0, 0, 0); PG8_SCHED; PG8_LDA(At, 0, 0); PG8_STAGE(PG8_SA(1, 1), a1 + hstep, voffA);
            PG8_WAIT_L(8); PG8_BAR; PG8_WAIT_L(0); PG8_MMA(0, 0, At, B0); PG8_BAR; PG8_SCHED;
            PG8_LDB(B1, 0, 1); PG8_STAGE(PG8_SB(0, 0), b2, voffB);
            PG8_BAR; PG8_WAIT_L(0); PG8_MMA(0, 1, At, B1); PG8_BAR;
            PG8_LDA(At, 0, 1); PG8_STAGE(PG8_SA(0, 0), a2, voffA);
            PG8_BAR; PG8_WAIT_L(0); PG8_MMA(1, 0, At, B0); PG8_BAR; PG8_SCHED;
            PG8_STAGE(PG8_SB(0, 1), b2 + hstep, voffB);
            PG8_WAIT_V(6); PG8_BAR; PG8_MMA(1, 1, At, B1); PG8_BAR;
            PG8_LDB(B0, 1, 0); PG8_SCHED; PG8_LDA(At, 1, 0); PG8_STAGE(PG8_SA(0, 1), a2 + hstep, voffA);
            PG8_WAIT_L(8); PG8_BAR; PG8_WAIT_L(0); PG8_MMA(0, 0, At, B0); PG8_BAR; PG8_SCHED;
            PG8_LDB(B1, 1, 1); PG8_STAGE(PG8_SB(1, 0), b3, voffB);
            PG8_BAR; PG8_WAIT_L(0); PG8_MMA(0, 1, At, B1); PG8_BAR;
            PG8_LDA(At, 1, 1); PG8_STAGE(PG8_SA(1, 0), a3, voffA);
            PG8_BAR; PG8_WAIT_L(0); PG8_MMA(1, 0, At, B0); PG8_BAR; PG8_SCHED;
            PG8_STAGE(PG8_SB(1, 1), b3 + hstep, voffB);
            PG8_WAIT_V(6); PG8_BAR; PG8_MMA(1, 1, At, B1); PG8_BAR;
            }
        }
        if constexpr (ALIGN_EPI) { if (wr == 0) PG8_BAR; }
        asm volatile("s_nop 15\n\ts_nop 15" ::: "memory");
        if constexpr (!Epi::AFTER_DRAIN) { E(acc, cur, wr, wc, fr, fq); S.done(cur); }
        if (!has_next) break;
#pragma unroll
        for (int a = 0; a < 2; ++a)
#pragma unroll
            for (int b = 0; b < 2; ++b)
#pragma unroll
                for (int m = 0; m < 4; ++m)
#pragma unroll
                    for (int n = 0; n < 2; ++n) acc[a][b][m][n] = (f32x4){0.f, 0.f, 0.f, 0.f};
        cur = nxt; cA = nA; cB = nB; ++ui;
        if constexpr (ALIGN_EPI) { if (wr == 1) PG8_BAR; }
    }
    PG8_WAIT_V(0);
    if constexpr (!ALIGN_EPI) { if (wr == 0) PG8_BAR; }
    PG8_BAR;
    if constexpr (Epi::AFTER_DRAIN) { E.fused(acc, cur, wr, wc, fr, fq, lds, wid, lane); S.done(cur); }
#undef PG8_SA
#undef PG8_SB
#undef PG8_STAGE
#undef PG8_LDA
#undef PG8_LDB
#undef PG8_MMA
#undef PG8_WAIT_V
#undef PG8_WAIT_L
#undef PG8_BAR
#undef PG8_SCHED
}
}

#define LAS __attribute__((address_space(3)))
typedef unsigned short bf16;
typedef short bf16x8 __attribute__((ext_vector_type(8)));
typedef float f32x4 __attribute__((ext_vector_type(4)));
typedef float f32x16 __attribute__((ext_vector_type(16)));
typedef unsigned u32x2 __attribute__((ext_vector_type(2)));
typedef unsigned u32x4 __attribute__((ext_vector_type(4)));

constexpr int NB = 8, SEQ = 2048, NMETA = 16, LL = 2064, DM = 1024, FF = 4096, DIN = 4864, NPROJ = 1792;
constexpr int NREAL = NB * SEQ;
constexpr int TPR = NREAL + 256;
constexpr int LDS_BYTES = 147456;

constexpr size_t MiB = 1u << 20;
constexpr size_t WS_CTL = 0;
constexpr size_t WS_ROPE = 1 * MiB;
constexpr size_t WS_ABAR = 2 * MiB;
constexpr size_t WS_BMAT = 2 * MiB + 65536;
constexpr size_t WS_CMAT = WS_BMAT + 524288;
constexpr size_t WS_HM = 4 * MiB;
constexpr size_t WS_W = 5 * MiB;
constexpr size_t OW_IN = 0, OW_GLU = (size_t)DIN * DM * 2, OW_POOL = OW_GLU + 512 * 512 * 2, OW_BR = OW_POOL + 512 * 512 * 2,
                 OW_OUT = OW_BR + 3 * 1024 * 512 * 2, OW_UP = OW_OUT + 1024 * 1024 * 2, OW_DN = OW_UP + (size_t)FF * DM * 2, LW_BYTES = OW_DN + (size_t)FF * DM * 2;
constexpr size_t WS_HB = 68 * MiB;
constexpr size_t WS_X = 101 * MiB;
constexpr size_t UU = (size_t)TPR * 512 * 2;
constexpr size_t WS_YF = WS_X, WS_YP = WS_X, WS_Q = WS_X + 2 * UU, WS_K = WS_Q + UU, WS_V = WS_K + UU / 4, WS_MG = WS_X + 2 * UU,
                 WS_SU = WS_X + 4 * UU, WS_YA = WS_X + 8 * UU  , WS_PU = WS_X + 5 * UU, WS_YS = WS_PU, WS_Z = WS_X + 6 * UU, WS_PD = WS_X + 7 * UU, WS_BR = WS_Z, WS_ACT = WS_X;
constexpr size_t WS_RS = WS_X + 9 * UU;
constexpr size_t WS_END = WS_RS + (size_t)5 * TPR * 16 * 4;
static_assert(WS_W + 2 * LW_BYTES <= WS_HB && WS_HB + (size_t)TPR * 1024 * 2 <= WS_X && WS_END <= 256 * MiB, "ws map");
static_assert((size_t)256 * 2064 * 16 * 4 <= 2 * UU, "YF fits");

__device__ __forceinline__ unsigned pk2(float lo, float hi) { unsigned r; asm("v_cvt_pk_bf16_f32 %0, %1, %2" : "=v"(r) : "v"(lo), "v"(hi)); return r; }
__device__ __forceinline__ unsigned f2bf(float f) { return pk2(f, 0.f) & 0xffffu; }
__device__ __forceinline__ float bf2f(unsigned b) { return __uint_as_float(b << 16); }
__device__ __forceinline__ int tok_row(int b, int l) { return l >= NMETA ? b * SEQ + l - NMETA : NREAL + b * NMETA + l; }
#define LDS_FENCE() asm volatile("s_waitcnt lgkmcnt(0)" ::: "memory")
#define SSM_SYNC() do { asm volatile("s_waitcnt vmcnt(0) lgkmcnt(0)" ::: "memory"); __syncthreads(); } while (0)
__device__ __forceinline__ float row_rstd(const float* rs, int R) {
    const f32x4 a = *(const f32x4*)(rs + (size_t)R * 4), b = *(const f32x4*)(rs + ((size_t)TPR + R) * 4), c = *(const f32x4*)(rs + ((size_t)2 * TPR + R) * 4), d = *(const f32x4*)(rs + ((size_t)3 * TPR + R) * 4);
    const float s = (((a[0] + a[1]) + (a[2] + a[3])) + ((b[0] + b[1]) + (b[2] + b[3]))) + (((c[0] + c[1]) + (c[2] + c[3])) + ((d[0] + d[1]) + (d[2] + d[3])));
    return rsqrtf(s * (1.0f / 1024.0f) + 1e-6f);
}

__device__ __forceinline__ void dsincos(double a, double& s, double& c) {
    const double q = rint(a * 0.63661977236758134308);
    double r = fma(-q, 1.57079632679489655800e+00, a); r = fma(-q, 6.12323399573676603587e-17, r);
    const double r2 = r * r;
    double sp = -7.6471637318198164759e-13; sp = fma(sp, r2, 1.6059043836821614599e-10); sp = fma(sp, r2, -2.5052108385441718775e-08); sp = fma(sp, r2, 2.7557319223985890653e-06);
    sp = fma(sp, r2, -1.9841269841269841270e-04); sp = fma(sp, r2, 8.3333333333333333333e-03); sp = fma(sp, r2, -1.6666666666666666667e-01); sp = fma(sp * r2, r, r);
    double cp = 4.7794773323873852974e-14; cp = fma(cp, r2, -1.1470745597729724714e-11); cp = fma(cp, r2, 2.0876756987868098979e-09); cp = fma(cp, r2, -2.7557319223985890653e-07);
    cp = fma(cp, r2, 2.4801587301587301587e-05); cp = fma(cp, r2, -1.3888888888888888889e-03); cp = fma(cp, r2, 4.1666666666666666667e-02); cp = fma(cp, r2, -0.5); cp = fma(cp, r2, 1.0);
    const int qi = ((int)q) & 3;
    s = (qi == 0) ? sp : (qi == 1) ? cp : (qi == 2) ? -sp : -cp;
    c = (qi == 0) ? cp : (qi == 1) ? -sp : (qi == 2) ? -cp : sp;
}
__device__ __forceinline__ double dexp(double x) {
    const double k = rint(x * 1.44269504088896340736);
    double r = fma(-k, 6.93147180369123816490e-01, x); r = fma(-k, 1.90821492927058770002e-10, r);
    double p = 1.0 / 6227020800.0; p = fma(p, r, 1.0 / 479001600.0); p = fma(p, r, 1.0 / 39916800.0); p = fma(p, r, 1.0 / 3628800.0); p = fma(p, r, 1.0 / 362880.0); p = fma(p, r, 1.0 / 40320.0);
    p = fma(p, r, 1.0 / 5040.0); p = fma(p, r, 1.0 / 720.0); p = fma(p, r, 1.0 / 120.0); p = fma(p, r, 1.0 / 24.0); p = fma(p, r, 1.0 / 6.0); p = fma(p, r, 0.5); p = fma(p, r, 1.0); p = fma(p, r, 1.0);
    const long long bits = ((long long)(1023 + (int)k)) << 52;
    return p * __longlong_as_double(bits);
}

struct EpiInProj {
    static constexpr bool PERM = true, AFTER_DRAIN = false;
    const float* rowss; const float* rope; bf16 *Q, *K, *V, *SU, *PU;
    __device__ __forceinline__ u32x2 quad(int l, int c, const f32x4& v) const {
        u32x2 w;
        if (c < 640) {
            const int i0 = (c & 63) >> 1;
            const f32x4 cs = *(const f32x4*)(rope + ((size_t)l * 32 + i0) * 2);
            float o0 = v[0] * cs[0] - v[1] * cs[1], o1 = v[1] * cs[0] + v[0] * cs[1], o2 = v[2] * cs[2] - v[3] * cs[3], o3 = v[3] * cs[2] + v[2] * cs[3];
            if (c < 512) { o0 *= 0.125f; o1 *= 0.125f; o2 *= 0.125f; o3 *= 0.125f; }
            w.x = pk2(o0, o1); w.y = pk2(o2, o3);
        } else { w.x = pk2(v[0], v[1]); w.y = pk2(v[2], v[3]); }
        return w;
    }
    __device__ __forceinline__ void operator()(const f32x4 (&acc)[2][2][4][2], const pg8::Unit& u, int wr, int wc, int fr, int fq) const {
#pragma unroll
        for (int ai = 0; ai < 2; ++ai)
#pragma unroll
            for (int m = 0; m < 4; ++m) {
                const int R = u.pm * 256 + ai * 128 + wr * 64 + m * 16 + fr;
                const float rs = row_rstd(rowss, R);
                const int l = R < NREAL ? (R & 2047) + NMETA : (R & 15);
#pragma unroll
                for (int bj = 0; bj < 2; ++bj) {
                    const int c = u.pn * 256 + bj * 128 + wc * 32 + 8 * fq;
                    const u32x2 w0 = quad(l, c, acc[ai][bj][m][0] * rs), w1 = quad(l, c + 4, acc[ai][bj][m][1] * rs);
                    u32x4 w; w.x = w0.x; w.y = w0.y; w.z = w1.x; w.w = w1.y;
                    bf16* dst = c < 512 ? Q + (size_t)R * 512 + c : c < 640 ? K + (size_t)R * 128 + (c - 512) : c < 768 ? V + (size_t)R * 128 + (c - 640)
                              : c < 1280 ? SU + (size_t)R * 512 + (c - 768) : PU + (size_t)R * 512 + (c - 1280);
                    *(u32x4*)dst = w;
                }
            }
    }
};
#define EPI_BODY() \
    __device__ __forceinline__ void rg(int R, int pn, int wc, int fq, const f32x4 (&a4)[2][2]) const { \
        _Pragma("unroll") for (int bj = 0; bj < 2; ++bj) q2(R, pn * 256 + bj * 128 + wc * 32 + 8 * fq, a4[bj][0], a4[bj][1]); } \
    __device__ __forceinline__ void tq(int R, int c, const f32x4& v) const { q(R, c, v); } \
    EPI_OP()
#define EPI_OP() \
    __device__ __forceinline__ void operator()(const f32x4 (&acc)[2][2][4][2], const pg8::Unit& u, int wr, int wc, int fr, int fq) const { \
        _Pragma("unroll") for (int ai = 0; ai < 2; ++ai) _Pragma("unroll") for (int m = 0; m < 4; ++m) { \
            const f32x4 a4[2][2] = {{acc[ai][0][m][0], acc[ai][0][m][1]}, {acc[ai][1][m][0], acc[ai][1][m][1]}}; \
            rg(u.pm * 256 + ai * 128 + wr * 64 + m * 16 + fr, u.pn, wc, fq, a4); } }
#define EPI_BODY_RS() \
    __device__ __forceinline__ void rg(int R, int pn, int wc, int fq, const f32x4 (&a4)[2][2]) const { const float rs = row_rstd(rowss, R); \
        _Pragma("unroll") for (int bj = 0; bj < 2; ++bj) q2(R, pn * 256 + bj * 128 + wc * 32 + 8 * fq, a4[bj][0], a4[bj][1], rs); } \
    __device__ __forceinline__ void tq(int R, int c, const f32x4& v) const { q(R, c, v, row_rstd(rowss, R)); } \
    EPI_OP()
struct EpiGlu {
    static constexpr bool PERM = true, AFTER_DRAIN = false;
    const bf16* Z; const float* bias; bf16* YS;
    __device__ __forceinline__ void q(int R, int c, const f32x4& a) const {
        const f32x4 v = a + *(const f32x4*)(bias + c);
        const u32x2 zz = *(const u32x2*)(Z + (size_t)R * 512 + c);
        const float z0 = bf2f(zz.x & 0xffffu), z1 = bf2f(zz.x >> 16), z2 = bf2f(zz.y & 0xffffu), z3 = bf2f(zz.y >> 16);
        u32x2 w; w.x = pk2(z0 * __builtin_amdgcn_rcpf(1.0f + __expf(-v[0])), z1 * __builtin_amdgcn_rcpf(1.0f + __expf(-v[1]))); w.y = pk2(z2 * __builtin_amdgcn_rcpf(1.0f + __expf(-v[2])), z3 * __builtin_amdgcn_rcpf(1.0f + __expf(-v[3])));
        *(u32x2*)(YS + (size_t)R * 512 + c) = w;
    }
    __device__ __forceinline__ void q2(int R, int c, const f32x4& a0, const f32x4& a1) const {
        const f32x4 v0 = a0 + *(const f32x4*)(bias + c), v1 = a1 + *(const f32x4*)(bias + c + 4);
        const u32x4 zz = *(const u32x4*)(Z + (size_t)R * 512 + c);
        u32x4 w;
        w.x = pk2(bf2f(zz.x & 0xffffu) * __builtin_amdgcn_rcpf(1.0f + __expf(-v0[0])), bf2f(zz.x >> 16) * __builtin_amdgcn_rcpf(1.0f + __expf(-v0[1])));
        w.y = pk2(bf2f(zz.y & 0xffffu) * __builtin_amdgcn_rcpf(1.0f + __expf(-v0[2])), bf2f(zz.y >> 16) * __builtin_amdgcn_rcpf(1.0f + __expf(-v0[3])));
        w.z = pk2(bf2f(zz.z & 0xffffu) * __builtin_amdgcn_rcpf(1.0f + __expf(-v1[0])), bf2f(zz.z >> 16) * __builtin_amdgcn_rcpf(1.0f + __expf(-v1[1])));
        w.w = pk2(bf2f(zz.w & 0xffffu) * __builtin_amdgcn_rcpf(1.0f + __expf(-v1[2])), bf2f(zz.w >> 16) * __builtin_amdgcn_rcpf(1.0f + __expf(-v1[3])));
        *(u32x4*)(YS + (size_t)R * 512 + c) = w;
    }
    EPI_BODY()
};
struct EpiScale {
    static constexpr bool PERM = true, AFTER_DRAIN = false;
    bf16* O; int ldc; const float* scale;
    __device__ __forceinline__ void q(int R, int c, const f32x4& a) const {
        f32x4 v = a;
        if (scale) v = v * *(const f32x4*)(scale + c);
        u32x2 w; w.x = pk2(v[0], v[1]); w.y = pk2(v[2], v[3]);
        *(u32x2*)(O + (size_t)R * ldc + c) = w;
    }
    __device__ __forceinline__ void q2(int R, int c, const f32x4& a0, const f32x4& a1) const {
        f32x4 v0 = a0, v1 = a1;
        if (scale) { v0 = v0 * *(const f32x4*)(scale + c); v1 = v1 * *(const f32x4*)(scale + c + 4); }
        u32x4 w; w.x = pk2(v0[0], v0[1]); w.y = pk2(v0[2], v0[3]); w.z = pk2(v1[0], v1[1]); w.w = pk2(v1[2], v1[3]);
        *(u32x4*)(O + (size_t)R * ldc + c) = w;
    }
    EPI_BODY()
};
template <bool FIRST> struct EpiGate {
    static constexpr bool PERM = true, AFTER_DRAIN = false;
    const float* rowss; const bf16* BR; bf16* MG;
    __device__ __forceinline__ void q(int R, int c, const f32x4& a, float rs) const {
        const f32x4 v = a * rs;
        const u32x2 bb = *(const u32x2*)(BR + (size_t)R * 1024 + c);
        float o0 = bf2f(bb.x & 0xffffu) * __builtin_amdgcn_rcpf(1.0f + __expf(-v[0])), o1 = bf2f(bb.x >> 16) * __builtin_amdgcn_rcpf(1.0f + __expf(-v[1]));
        float o2 = bf2f(bb.y & 0xffffu) * __builtin_amdgcn_rcpf(1.0f + __expf(-v[2])), o3 = bf2f(bb.y >> 16) * __builtin_amdgcn_rcpf(1.0f + __expf(-v[3]));
        if (!FIRST) { const u32x2 mm = *(const u32x2*)(MG + (size_t)R * 1024 + c);
            o0 += bf2f(mm.x & 0xffffu); o1 += bf2f(mm.x >> 16); o2 += bf2f(mm.y & 0xffffu); o3 += bf2f(mm.y >> 16); }
        u32x2 w; w.x = pk2(o0, o1); w.y = pk2(o2, o3);
        *(u32x2*)(MG + (size_t)R * 1024 + c) = w;
    }
    __device__ __forceinline__ void q2(int R, int c, const f32x4& a0, const f32x4& a1, float rs) const {
        const f32x4 v0 = a0 * rs, v1 = a1 * rs;
        const u32x4 bb = *(const u32x4*)(BR + (size_t)R * 1024 + c);
        float o[8];
        o[0] = bf2f(bb.x & 0xffffu) * __builtin_amdgcn_rcpf(1.0f + __expf(-v0[0])); o[1] = bf2f(bb.x >> 16) * __builtin_amdgcn_rcpf(1.0f + __expf(-v0[1]));
        o[2] = bf2f(bb.y & 0xffffu) * __builtin_amdgcn_rcpf(1.0f + __expf(-v0[2])); o[3] = bf2f(bb.y >> 16) * __builtin_amdgcn_rcpf(1.0f + __expf(-v0[3]));
        o[4] = bf2f(bb.z & 0xffffu) * __builtin_amdgcn_rcpf(1.0f + __expf(-v1[0])); o[5] = bf2f(bb.z >> 16) * __builtin_amdgcn_rcpf(1.0f + __expf(-v1[1]));
        o[6] = bf2f(bb.w & 0xffffu) * __builtin_amdgcn_rcpf(1.0f + __expf(-v1[2])); o[7] = bf2f(bb.w >> 16) * __builtin_amdgcn_rcpf(1.0f + __expf(-v1[3]));
        if (!FIRST) { const u32x4 mm = *(const u32x4*)(MG + (size_t)R * 1024 + c);
            o[0] += bf2f(mm.x & 0xffffu); o[1] += bf2f(mm.x >> 16); o[2] += bf2f(mm.y & 0xffffu); o[3] += bf2f(mm.y >> 16);
            o[4] += bf2f(mm.z & 0xffffu); o[5] += bf2f(mm.z >> 16); o[6] += bf2f(mm.w & 0xffffu); o[7] += bf2f(mm.w >> 16); }
        u32x4 w; w.x = pk2(o[0], o[1]); w.y = pk2(o[2], o[3]); w.z = pk2(o[4], o[5]); w.w = pk2(o[6], o[7]);
        *(u32x4*)(MG + (size_t)R * 1024 + c) = w;
    }
    EPI_BODY_RS()
};
struct EpiRes {
    static constexpr bool PERM = true, AFTER_DRAIN = false;
    const float* Xin; bf16* HB; float* rowss_out;
    __device__ __forceinline__ float q(int R, int c, const f32x4& a) const {
        f32x4 h;
        if (Xin && R < NREAL) h = *(const f32x4*)(Xin + (size_t)R * 1024 + c);
        else { const u32x2 hb = *(const u32x2*)(HB + (size_t)R * 1024 + c); h = (f32x4){bf2f(hb.x & 0xffffu), bf2f(hb.x >> 16), bf2f(hb.y & 0xffffu), bf2f(hb.y >> 16)}; }
        h = h + a;
        u32x2 w; w.x = pk2(h[0], h[1]); w.y = pk2(h[2], h[3]);
        *(u32x2*)(HB + (size_t)R * 1024 + c) = w;
        const float r0 = bf2f(w.x & 0xffffu), r1 = bf2f(w.x >> 16), r2 = bf2f(w.y & 0xffffu), r3 = bf2f(w.y >> 16);
        return (r0 * r0 + r1 * r1) + (r2 * r2 + r3 * r3);
    }
    __device__ __forceinline__ float q2(int R, int c, const f32x4& a0, const f32x4& a1) const {
        f32x4 h0, h1;
        if (Xin && R < NREAL) { h0 = *(const f32x4*)(Xin + (size_t)R * 1024 + c); h1 = *(const f32x4*)(Xin + (size_t)R * 1024 + c + 4); }
        else { const u32x4 hb = *(const u32x4*)(HB + (size_t)R * 1024 + c);
            h0 = (f32x4){bf2f(hb.x & 0xffffu), bf2f(hb.x >> 16), bf2f(hb.y & 0xffffu), bf2f(hb.y >> 16)}; h1 = (f32x4){bf2f(hb.z & 0xffffu), bf2f(hb.z >> 16), bf2f(hb.w & 0xffffu), bf2f(hb.w >> 16)}; }
        h0 = h0 + a0; h1 = h1 + a1;
        u32x4 w; w.x = pk2(h0[0], h0[1]); w.y = pk2(h0[2], h0[3]); w.z = pk2(h1[0], h1[1]); w.w = pk2(h1[2], h1[3]);
        *(u32x4*)(HB + (size_t)R * 1024 + c) = w;
        const float r0 = bf2f(w.x & 0xffffu), r1 = bf2f(w.x >> 16), r2 = bf2f(w.y & 0xffffu), r3 = bf2f(w.y >> 16), r4 = bf2f(w.z & 0xffffu), r5 = bf2f(w.z >> 16), r6 = bf2f(w.w & 0xffffu), r7 = bf2f(w.w >> 16);
        return ((r0 * r0 + r1 * r1) + (r2 * r2 + r3 * r3)) + ((r4 * r4 + r5 * r5) + (r6 * r6 + r7 * r7));
    }
    __device__ __forceinline__ void rg(int R, int pn, int wc, int fq, const f32x4 (&a4)[2][2]) const {
        float ss = 0.f;
#pragma unroll
        for (int bj = 0; bj < 2; ++bj) ss += q2(R, pn * 256 + bj * 128 + wc * 32 + 8 * fq, a4[bj][0], a4[bj][1]);
        ss += __shfl_xor(ss, 16); ss += __shfl_xor(ss, 32);
        if (fq == 0) rowss_out[((size_t)pn * TPR + R) * 4 + wc] = ss;
    }
    __device__ __forceinline__ void tq(int R, int c, const f32x4& v) const {
        float ss = q(R, c, v);
        ss += __shfl_xor(ss, 16); ss += __shfl_xor(ss, 32);
        if ((threadIdx.x & 48) == 0) atomicAdd(rowss_out + (size_t)R * 4, ss);
    }
    EPI_OP()
};
struct EpiUp {
    static constexpr bool PERM = true, AFTER_DRAIN = false;
    const float* rowss; bf16* ACT;
    __device__ __forceinline__ void q(int R, int c, const f32x4& a, float rs) const {
        f32x4 v = a * rs;
#pragma unroll
        for (int j = 0; j < 4; ++j) { const float r = fmaxf(v[j], 0.f); v[j] = r * r; }
        u32x2 w; w.x = pk2(v[0], v[1]); w.y = pk2(v[2], v[3]);
        *(u32x2*)(ACT + (size_t)R * FF + c) = w;
    }
    __device__ __forceinline__ void q2(int R, int c, const f32x4& a0, const f32x4& a1, float rs) const {
        f32x4 v0 = a0 * rs, v1 = a1 * rs;
#pragma unroll
        for (int j = 0; j < 4; ++j) { const float r0 = fmaxf(v0[j], 0.f), r1 = fmaxf(v1[j], 0.f); v0[j] = r0 * r0; v1[j] = r1 * r1; }
        u32x4 w; w.x = pk2(v0[0], v0[1]); w.y = pk2(v0[2], v0[3]); w.z = pk2(v1[0], v1[1]); w.w = pk2(v1[2], v1[3]);
        *(u32x4*)(ACT + (size_t)R * FF + c) = w;
    }
    EPI_BODY_RS()
};
struct TripleOrder {
    pg8::StaticOrder S0; int arow, bcol;
    __device__ __forceinline__ void init(int G, int c, int arow_, int bcol_) { S0.init(NREAL, 1024, G, c); arow = arow_; bcol = bcol_; }
    __device__ __forceinline__ bool next(int i, pg8::Unit& u) const { pg8::Unit t; t.pm = 0; t.pn = 0; if (!S0.next(i / 3, t)) return false; const int br = i % 3; u.pm = t.pm + br * arow; u.pn = t.pn + br * bcol; return true; }
    __device__ __forceinline__ void a_ready(const pg8::Unit&) const {}
    __device__ __forceinline__ void done(const pg8::Unit&) const {}
};
struct EpiBr3 {
    static constexpr bool PERM = true, AFTER_DRAIN = false;
    bf16* Bbase; int arow;
    __device__ __forceinline__ void operator()(const f32x4 (&acc)[2][2][4][2], const pg8::Unit& u, int wr, int wc, int fr, int fq) const {
        const int c = u.pn >> 2, pn = u.pn & 3, pm = u.pm - arow * c; bf16* O = Bbase + (size_t)(2 * c + 2 * (c > 0)) * (UU / 2);
#pragma unroll
        for (int ai = 0; ai < 2; ++ai)
#pragma unroll
            for (int m = 0; m < 4; ++m) { const int R = pm * 256 + ai * 128 + wr * 64 + m * 16 + fr;
#pragma unroll
                for (int bj = 0; bj < 2; ++bj) { const f32x4 v0 = acc[ai][bj][m][0], v1 = acc[ai][bj][m][1];
                    u32x4 w; w.x = pk2(v0[0], v0[1]); w.y = pk2(v0[2], v0[3]); w.z = pk2(v1[0], v1[1]); w.w = pk2(v1[2], v1[3]);
                    *(u32x4*)(O + (size_t)R * 1024 + pn * 256 + bj * 128 + wc * 32 + 8 * fq) = w; } }
    }
};
struct EpiGate3 {
    static constexpr bool PERM = true, AFTER_DRAIN = false;
    const float* rowss; const bf16* Bbase; bf16* MG;
    __device__ __forceinline__ void operator()(const f32x4 (&acc)[2][2][4][2], const pg8::Unit& u, int wr, int wc, int fr, int fq) const {
        const int c = u.pn >> 2, pn = u.pn & 3; const bf16* BR = Bbase + (size_t)(2 * c + 2 * (c > 0)) * (UU / 2);
#pragma unroll
        for (int ai = 0; ai < 2; ++ai)
#pragma unroll
            for (int m = 0; m < 4; ++m) { const int R = u.pm * 256 + ai * 128 + wr * 64 + m * 16 + fr; const float rs = row_rstd(rowss, R);
#pragma unroll
                for (int bj = 0; bj < 2; ++bj) { const int cc = pn * 256 + bj * 128 + wc * 32 + 8 * fq;
                    const f32x4 v0 = acc[ai][bj][m][0] * rs, v1 = acc[ai][bj][m][1] * rs;
                    const u32x4 bb = *(const u32x4*)(BR + (size_t)R * 1024 + cc);
                    float o[8];
                    o[0] = bf2f(bb.x & 0xffffu) * __builtin_amdgcn_rcpf(1.0f + __expf(-v0[0])); o[1] = bf2f(bb.x >> 16) * __builtin_amdgcn_rcpf(1.0f + __expf(-v0[1]));
                    o[2] = bf2f(bb.y & 0xffffu) * __builtin_amdgcn_rcpf(1.0f + __expf(-v0[2])); o[3] = bf2f(bb.y >> 16) * __builtin_amdgcn_rcpf(1.0f + __expf(-v0[3]));
                    o[4] = bf2f(bb.z & 0xffffu) * __builtin_amdgcn_rcpf(1.0f + __expf(-v1[0])); o[5] = bf2f(bb.z >> 16) * __builtin_amdgcn_rcpf(1.0f + __expf(-v1[1]));
                    o[6] = bf2f(bb.w & 0xffffu) * __builtin_amdgcn_rcpf(1.0f + __expf(-v1[2])); o[7] = bf2f(bb.w >> 16) * __builtin_amdgcn_rcpf(1.0f + __expf(-v1[3]));
                    if (c != 0) { const u32x4 mm = *(const u32x4*)(MG + (size_t)R * 1024 + cc);
                        o[0] += bf2f(mm.x & 0xffffu); o[1] += bf2f(mm.x >> 16); o[2] += bf2f(mm.y & 0xffffu); o[3] += bf2f(mm.y >> 16);
                        o[4] += bf2f(mm.z & 0xffffu); o[5] += bf2f(mm.z >> 16); o[6] += bf2f(mm.w & 0xffffu); o[7] += bf2f(mm.w >> 16); }
                    u32x4 w; w.x = pk2(o[0], o[1]); w.y = pk2(o[2], o[3]); w.z = pk2(o[4], o[5]); w.w = pk2(o[6], o[7]);
                    *(u32x4*)(MG + (size_t)R * 1024 + cc) = w; } }
    }
};
template <class Epi>
__device__ __forceinline__ void thin_gemm(LAS unsigned char* lds, const bf16* A, const bf16* Bt, int K, int N, const Epi& E, int vb, int vg) {
    int tid_l = threadIdx.x; asm volatile("" : "+v"(tid_l));
    const int lane = tid_l & 63, w = __builtin_amdgcn_readfirstlane(tid_l >> 6), fr = lane & 15, fq = lane >> 4;
    LAS f32x4* red = (LAS f32x4*)lds;
    const int kw = K >> 3;
    for (int pc = vb; pc < N / 16; pc += vg) {
        const bf16* ap = A + (size_t)(NREAL + fr) * K + w * kw + 8 * fq;
        const bf16* bp = Bt + (size_t)(16 * pc + fr) * K + w * kw + 8 * fq;
        f32x4 acc[8];
#pragma unroll
        for (int rb = 0; rb < 8; ++rb) acc[rb] = (f32x4){0.f, 0.f, 0.f, 0.f};
#pragma unroll 2
        for (int k0 = 0; k0 < kw; k0 += 32) {
            const bf16x8 bf = *(const bf16x8*)(bp + k0);
            bf16x8 af[8];
#pragma unroll
            for (int rb = 0; rb < 8; ++rb) af[rb] = *(const bf16x8*)(ap + (size_t)(16 * rb) * K + k0);
#pragma unroll
            for (int rb = 0; rb < 8; ++rb) acc[rb] = __builtin_amdgcn_mfma_f32_16x16x32_bf16(bf, af[rb], acc[rb], 0, 0, 0);
        }
        asm volatile("s_nop 15\n\ts_nop 15" : "+v"(acc[0]), "+v"(acc[1]), "+v"(acc[2]), "+v"(acc[3]), "+v"(acc[4]), "+v"(acc[5]), "+v"(acc[6]), "+v"(acc[7]));
#pragma unroll
        for (int rb = 0; rb < 8; ++rb) red[(w * 8 + rb) * 64 + lane] = acc[rb];
        LDS_FENCE(); __syncthreads();
        f32x4 v = red[(0 * 8 + w) * 64 + lane];
#pragma unroll
        for (int ww = 1; ww < 8; ++ww) v = v + red[(ww * 8 + w) * 64 + lane];
        LDS_FENCE(); __syncthreads();
        E.tq(NREAL + 16 * w + fr, 16 * pc + 4 * fq, v);
    }
}

struct Args { const float* in[23]; float* out; unsigned char* ws; };

__device__ __forceinline__ void p0_item(const float* W, int ldw, int K, const float* scale, bf16* WT, int permrows, LAS float* scr, int item, int nblk, int lane) {
    const int kb = item / nblk, nb = item % nblk, k0 = 64 * kb, n0 = 64 * nb;
#pragma unroll 4
    for (int i = 0; i < 16; ++i) {
        const int kk = 4 * i + (lane >> 4), c4 = (lane & 15) * 4;
        f32x4 w = *(const f32x4*)(W + (size_t)(k0 + kk) * ldw + n0 + c4);
        if (scale) w = w * scale[k0 + kk];
        scr[kk * 65 + c4] = w[0]; scr[kk * 65 + c4 + 1] = w[1]; scr[kk * 65 + c4 + 2] = w[2]; scr[kk * 65 + c4 + 3] = w[3];
    }
    LDS_FENCE();
    const int c = lane & 7;
#pragma unroll
    for (int j = 0; j < 8; ++j) {
        const int n = (lane >> 3) + 8 * j;
        const int sc = (n0 + n) < permrows ? ((n & 1) ? 32 + (n >> 1) : (n >> 1)) : n;
        const LAS float* s = scr + (8 * c) * 65 + sc;
        u32x4 o; o.x = pk2(s[0 * 65], s[1 * 65]); o.y = pk2(s[2 * 65], s[3 * 65]); o.z = pk2(s[4 * 65], s[5 * 65]); o.w = pk2(s[6 * 65], s[7 * 65]);
        *(u32x4*)(WT + (size_t)(n0 + n) * K + k0 + 8 * c) = o;
    }
    LDS_FENCE();
}

__device__ __forceinline__ void p0_prologue(const Args& a, LAS unsigned char* lds) {
    int tl_ = threadIdx.x; asm volatile("" : "+v"(tl_));
    const int tid = tl_, lane = tid & 63, wave = __builtin_amdgcn_readfirstlane(tid >> 6);
    const int gw = blockIdx.x * 8 + wave, NGW = gridDim.x * 8;
    const int gt = blockIdx.x * 512 + tid, NGT = gridDim.x * 512;
    unsigned char* ws = a.ws;
    LAS float* scr = (LAS float*)(lds + wave * 17408);
    for (int i = gt; i < 4 * 4 * 128 * 4; i += NGT) { const int idx = 1 + (i >> 11), pn = (i >> 9) & 3, r = (i >> 2) & 127, sl = i & 3;
        ((float*)(ws + WS_RS))[((size_t)idx * 4 * TPR + (size_t)pn * TPR + NREAL + r) * 4 + sl] = 0.f; }
    constexpr int I_IN = 16 * 76, I_GLU = 8 * 8, I_BR = 8 * 16, I_OUT = 16 * 16, I_UP = 16 * 64, I_DN = 64 * 16, I_L = I_IN + I_GLU + 3 * I_BR + I_OUT + I_UP + I_DN;
    for (int it = gw; it < 2 * I_L; it += NGW) {
        const int layer = it / I_L; int r = it % I_L;
        unsigned char* wl = ws + WS_W + (size_t)layer * LW_BYTES;
        if (r < I_IN) { p0_item(a.in[3] + (size_t)layer * DM * DIN, DIN, DM, a.in[2] + layer * DM, (bf16*)(wl + OW_IN), 640, scr, r, 76, lane); continue; } r -= I_IN;
        if (r < I_GLU) { p0_item(a.in[13] + (size_t)layer * 512 * 512, 512, 512, nullptr, (bf16*)(wl + OW_GLU), 0, scr, r, 8, lane); continue; } r -= I_GLU;
        if (r < 3 * I_BR) { const int c = r / I_BR; p0_item(a.in[17] + ((size_t)layer * 3 + c) * 512 * 1024, 1024, 512, nullptr, (bf16*)(wl + OW_BR) + (size_t)c * 1024 * 512, 0, scr, r % I_BR, 16, lane); continue; } r -= 3 * I_BR;
        if (r < I_OUT) { p0_item(a.in[18] + (size_t)layer * DM * DM, DM, DM, nullptr, (bf16*)(wl + OW_OUT), 0, scr, r, 16, lane); continue; } r -= I_OUT;
        if (r < I_UP) { p0_item(a.in[20] + (size_t)layer * DM * FF, FF, DM, a.in[19] + layer * DM, (bf16*)(wl + OW_UP), 0, scr, r, 64, lane); continue; } r -= I_UP;
        p0_item(a.in[21] + (size_t)layer * FF * DM, DM, FF, nullptr, (bf16*)(wl + OW_DN), 0, scr, r, 16, lane);
    }
    for (int i = gt; i < 2 * 512 * 512; i += NGT) {
        const int layer = i >> 18, n = (i >> 9) & 511, k = i & 511;
        float w = 0.f;
        if ((n >> 7) == (k >> 7)) w = a.in[15][(((size_t)layer * 4 + (n >> 7)) * 128 + (k & 127)) * 128 + (n & 127)];
        ((bf16*)(ws + WS_W + (size_t)layer * LW_BYTES + OW_POOL))[(size_t)n * 512 + k] = (bf16)f2bf(w);
    }
    for (int i = gt; i < LL * 32; i += NGT) {
        const int l = i >> 5, f = i & 31;
        const float invf = (float)dexp(-(double)f * (9.21034037197618273607 / 32.0));
        const float ang = (float)l * invf;
        double s, c; dsincos((double)ang, s, c);
        float* rp = (float*)(ws + WS_ROPE) + (size_t)i * 2; rp[0] = (float)c; rp[1] = (float)s;
    }
    for (int i = gt; i < 2 * 2 * 32 * 64; i += NGT) {
        const int n = i & 63, pidx = i >> 6;
        const double lr = (double)a.in[5][i], li = (double)a.in[6][i];
        const double dt = (double)(float)dexp((double)a.in[7][pidx]);
        const double mag = dexp(lr * dt); double sn, cn; dsincos(li * dt, sn, cn);
        const double are = mag * cn, aim = mag * sn, den = lr * lr + li * li, nre = are - 1.0;
        const double fre = (nre * lr + aim * li) / den, fim = (aim * lr - nre * li) / den;
        float* ab = (float*)(ws + WS_ABAR) + (size_t)i * 2; ab[0] = (float)are; ab[1] = (float)aim;
        bf16* bm = (bf16*)(ws + WS_BMAT) + (size_t)pidx * 128 * 16;
        bf16* cm = (bf16*)(ws + WS_CMAT) + (size_t)pidx * 16 * 128;
        for (int q = 0; q < 16; ++q) {
            const double br = (double)a.in[8][(size_t)i * 16 + q], bi = (double)a.in[9][(size_t)i * 16 + q];
            bm[n * 16 + q] = (bf16)f2bf((float)(fre * br - fim * bi));
            bm[(64 + n) * 16 + q] = (bf16)f2bf((float)(fre * bi + fim * br));
            cm[q * 128 + n] = (bf16)f2bf(a.in[10][((size_t)pidx * 16 + q) * 64 + n]);
            cm[q * 128 + 64 + n] = (bf16)f2bf(-a.in[11][((size_t)pidx * 16 + q) * 64 + n]);
        }
    }
    for (int R = gw; R < TPR; R += NGW) {
        const int mrow = R - NREAL;
        const float* src = R < NREAL ? a.in[0] + (size_t)R * DM : a.in[1] + (size_t)(mrow & 15) * DM;
        float* dst = R < NREAL ? a.out + (size_t)R * DM : (float*)(ws + WS_HM) + (size_t)mrow * DM;
        bf16* hb = (bf16*)(ws + WS_HB) + (size_t)R * DM;
        const bool pad = mrow >= NB * NMETA;
        float ss = 0.f;
#pragma unroll
        for (int j = 0; j < 4; ++j) {
            f32x4 v = *(const f32x4*)(src + 4 * lane + 256 * j);
            if (pad) v = (f32x4){0.f, 0.f, 0.f, 0.f};
            ss += (v[0] * v[0] + v[1] * v[1]) + (v[2] * v[2] + v[3] * v[3]);
            u32x2 w; w.x = pk2(v[0], v[1]); w.y = pk2(v[2], v[3]);
            *(u32x2*)(hb + 4 * lane + 256 * j) = w;
        }
#pragma unroll
        for (int o = 1; o < 64; o <<= 1) ss += __shfl_xor(ss, o);
        if (lane < 16) ((float*)(ws + WS_RS))[((size_t)(lane >> 2) * TPR + R) * 4 + (lane & 3)] = lane == 0 ? ss : 0.f;
    }
}

__device__ __forceinline__ void ssm_task(LAS unsigned char* lds, int task, int layer, const bf16* SU, float* YF,
                                         const float* abar_all, const bf16* bmat_all, const bf16* cmat_all) {
    int tid_l = threadIdx.x; asm volatile("" : "+v"(tid_l));
    const int tid = tid_l, lane = tid & 63, wave = __builtin_amdgcn_readfirstlane(tid >> 6);
    const int b = task >> 5, g = task & 31;
    __syncthreads();
    LAS float* BU = (LAS float*)(lds + wave * 12800);
    LAS unsigned short* X = (LAS unsigned short*)(lds + wave * 12800 + 8448);
    LAS float* SX = (LAS float*)(lds + 8 * 12800);
    const int blk0 = wave == 0 ? 0 : 16 * wave + 1, nblk = wave == 0 ? 17 : 16;
    bf16* yfb = (bf16*)YF + (size_t)task * LL * 16;
    const int fr = lane & 15, fq = lane >> 4;
    const bf16x8 zero8 = {0, 0, 0, 0, 0, 0, 0, 0};
    for (int dir = 0; dir < 2; ++dir) {
        const int pidx = (layer * 2 + dir) * 32 + g;
        const float are = abar_all[((size_t)pidx * 64 + lane) * 2], aim = abar_all[((size_t)pidx * 64 + lane) * 2 + 1];
        bf16x8 bfr[8], cfr[4];
        const bf16* bm = bmat_all + (size_t)pidx * 128 * 16;
#pragma unroll
        for (int nt = 0; nt < 8; ++nt) bfr[nt] = fq < 2 ? *(const bf16x8*)(bm + (nt * 16 + fr) * 16 + 8 * fq) : zero8;
        const bf16* cm = cmat_all + (size_t)pidx * 16 * 128;
#pragma unroll
        for (int ks = 0; ks < 4; ++ks) cfr[ks] = *(const bf16x8*)(cm + fr * 128 + ks * 32 + 8 * fq);
        float p16r = are, p16i = aim;
#pragma unroll
        for (int i = 0; i < 4; ++i) { const float tr = p16r * p16r - p16i * p16i, ti = 2.f * p16r * p16i; p16r = tr; p16i = ti; }
        float p256r = p16r, p256i = p16i;
#pragma unroll
        for (int i = 0; i < 4; ++i) { const float tr = p256r * p256r - p256i * p256i, ti = 2.f * p256r * p256i; p256r = tr; p256i = ti; }
        const float p272r = p256r * p16r - p256i * p16i, p272i = p256r * p16i + p256i * p16r;

        float xre = 0.f, xim = 0.f;
        for (int pass = 0; pass < 2; ++pass) {
            bf16x8 unext;
            { const int blkf = dir == 0 ? blk0 : blk0 + nblk - 1; const int Rf = blkf == 0 ? NREAL + b * NMETA : b * SEQ + blkf * 16 - NMETA;
              unext = fq < 2 ? *(const bf16x8*)(SU + (size_t)(Rf + fr) * 512 + g * 16 + 8 * fq) : zero8; }
            for (int ib = 0; ib < nblk; ++ib) {
                const int blk = dir == 0 ? blk0 + ib : blk0 + nblk - 1 - ib;
                const bf16x8 ufr = unext;
                if (ib + 1 < nblk) { const int blkn = dir == 0 ? blk + 1 : blk - 1; const int Rn = blkn == 0 ? NREAL + b * NMETA : b * SEQ + blkn * 16 - NMETA;
                    unext = fq < 2 ? *(const bf16x8*)(SU + (size_t)(Rn + fr) * 512 + g * 16 + 8 * fq) : zero8; }
                f32x4 dd[8];
#pragma unroll
                for (int nt = 0; nt < 8; ++nt) { dd[nt] = (f32x4){0.f, 0.f, 0.f, 0.f}; dd[nt] = __builtin_amdgcn_mfma_f32_16x16x32_bf16(ufr, bfr[nt], dd[nt], 0, 0, 0); }
                asm volatile("s_nop 15\n\ts_nop 15" : "+v"(dd[0]), "+v"(dd[1]), "+v"(dd[2]), "+v"(dd[3]), "+v"(dd[4]), "+v"(dd[5]), "+v"(dd[6]), "+v"(dd[7]));
#pragma unroll
                for (int nt = 0; nt < 8; ++nt)
#pragma unroll
                    for (int r = 0; r < 4; ++r) BU[(4 * fq + r) * 132 + nt * 16 + fr] = dd[nt][r];
                LDS_FENCE();
                float bur[16], bui[16];
#pragma unroll
                for (int i = 0; i < 16; ++i) { const int tt = dir == 0 ? i : 15 - i; bur[i] = BU[tt * 132 + lane]; bui[i] = BU[tt * 132 + 64 + lane]; }
                if (pass == 0) {
#pragma unroll
                    for (int i = 0; i < 16; ++i) {
                        const float bre = bur[i], bim = bui[i];
                        const float nr = are * xre - aim * xim + bre, ni = are * xim + aim * xre + bim; xre = nr; xim = ni;
                    }
                    LDS_FENCE();
                } else {
#pragma unroll
                    for (int i = 0; i < 16; ++i) {
                        const int tt = dir == 0 ? i : 15 - i;
                        const float bre = bur[i], bim = bui[i];
                        const float nr = are * xre - aim * xim + bre, ni = are * xim + aim * xre + bim; xre = nr; xim = ni;
                        X[tt * 136 + lane] = (unsigned short)f2bf(xre); X[tt * 136 + 64 + lane] = (unsigned short)f2bf(xim);
                    }
                    LDS_FENCE();
                    f32x4 y = {0.f, 0.f, 0.f, 0.f};
#pragma unroll
                    for (int ks = 0; ks < 4; ++ks) {
                        const bf16x8 afr = *(const LAS bf16x8*)(X + fr * 136 + ks * 32 + 8 * fq);
                        y = __builtin_amdgcn_mfma_f32_16x16x32_bf16(afr, cfr[ks], y, 0, 0, 0);
                    }
                    asm volatile("s_nop 15\n\ts_nop 15" : "+v"(y));
                    LDS_FENCE();
                    {
                        bf16* yd = yfb + (size_t)dir * 256 * LL * 16;
#pragma unroll
                        for (int r = 0; r < 4; ++r) yd[(size_t)(blk * 16 + 4 * fq + r) * 16 + fr] = (bf16)f2bf(y[r]);
                    }
                }
            }
            if (pass == 0) {
                SX[(wave * 64 + lane) * 2] = xre; SX[(wave * 64 + lane) * 2 + 1] = xim;
                LDS_FENCE(); __syncthreads();
                float cre = 0.f, cim = 0.f;
                if (dir == 0) {
                    for (int w = 0; w < wave; ++w) { const float pr = w == 0 ? p272r : p256r, pi = w == 0 ? p272i : p256i;
                        const float sr = SX[(w * 64 + lane) * 2], si = SX[(w * 64 + lane) * 2 + 1];
                        const float nr = pr * cre - pi * cim + sr, ni = pr * cim + pi * cre + si; cre = nr; cim = ni; }
                } else {
                    for (int w = 7; w > wave; --w) {
                        const float sr = SX[(w * 64 + lane) * 2], si = SX[(w * 64 + lane) * 2 + 1];
                        const float nr = p256r * cre - p256i * cim + sr, ni = p256r * cim + p256i * cre + si; cre = nr; cim = ni; }
                }
                xre = cre; xim = cim;
            }
        }
        LDS_FENCE(); __syncthreads();
    }
}

constexpr int ATT_KROW = 72, ATT_VROW = 40, ATT_KT = 32 * ATT_KROW * 2  , ATT_VT = 64 * ATT_VROW * 2  , ATT_MAXT = 11, ATT_VOFF = ATT_MAXT * ATT_KT;
static_assert(ATT_VOFF + ATT_MAXT * ATT_VT <= 131072, "attention LDS");
__device__ __forceinline__ void attn_task(LAS unsigned char* lds, int task, const bf16* Q, const bf16* K, const bf16* V, bf16* YA, const float* sink) {
    int tid_l = threadIdx.x; asm volatile("" : "+v"(tid_l));
    const int tid = tid_l, lane = tid & 63, wave = __builtin_amdgcn_readfirstlane(tid >> 6);
    const int qb = task % 33, bh = task / 33, h = bh & 1, b = bh >> 1;
    const int l0 = qb * 64;
    __syncthreads();
    int jlo = (l0 - 128) >> 5; if (jlo < 1) jlo = 1;
    int jhi = (l0 + 191) >> 5; if (jhi > 64) jhi = 64;
    const int ntiles = 1 + (jhi - jlo + 1);
    LAS unsigned short* Ks = (LAS unsigned short*)lds;
    LAS unsigned short* Vs = (LAS unsigned short*)(lds + ATT_VOFF);
    for (int idx = tid; idx < ntiles * 32 * 8; idx += 512) {
        const int ch = idx & 7, key = idx >> 3, slot = key >> 5, kk = key & 31;
        const int lk = (slot == 0 ? 0 : (jlo + slot - 1) * 32) + kk;
        u32x4 kv = {0u, 0u, 0u, 0u}, vv = {0u, 0u, 0u, 0u};
        if (lk < LL) { const size_t R = (size_t)tok_row(b, lk);
            kv = *(const u32x4*)(K + R * 128 + h * 64 + ch * 8); vv = *(const u32x4*)(V + R * 128 + h * 64 + ch * 8); }
        *(LAS u32x4*)(Ks + slot * (ATT_KT / 2) + kk * ATT_KROW + ch * 8) = kv;
        LAS unsigned short* vd = Vs + slot * (ATT_VT / 2) + (ch * 8) * ATT_VROW + kk;
        vd[0 * ATT_VROW] = (unsigned short)(vv.x & 0xffffu); vd[1 * ATT_VROW] = (unsigned short)(vv.x >> 16);
        vd[2 * ATT_VROW] = (unsigned short)(vv.y & 0xffffu); vd[3 * ATT_VROW] = (unsigned short)(vv.y >> 16);
        vd[4 * ATT_VROW] = (unsigned short)(vv.z & 0xffffu); vd[5 * ATT_VROW] = (unsigned short)(vv.z >> 16);
        vd[6 * ATT_VROW] = (unsigned short)(vv.w & 0xffffu); vd[7 * ATT_VROW] = (unsigned short)(vv.w >> 16);
    }
    LDS_FENCE(); __syncthreads();
    const int head = h * 4 + (wave >> 1), r32 = lane & 31, hi = lane >> 5;
    const int lq = l0 + 32 * (wave & 1) + r32;
    const bool qvalid = lq < LL;
    const size_t Rq = (size_t)tok_row(b, qvalid ? lq : LL - 1);
    bf16x8 qf[4];
#pragma unroll
    for (int ks = 0; ks < 4; ++ks) qf[ks] = *(const bf16x8*)(Q + Rq * 512 + head * 64 + ks * 16 + 8 * hi);
    float mrun = sink[head], lsum = hi == 0 ? 1.0f : 0.0f;
    f32x16 o0, o1;
#pragma unroll
    for (int i = 0; i < 16; ++i) { o0[i] = 0.f; o1[i] = 0.f; }
    const int lqw = l0 + 32 * (wave & 1);
    for (int slot = 0; slot < ntiles; ++slot) {
        const int kbase = slot == 0 ? 0 : (jlo + slot - 1) * 32;
        if (lqw >= LL || (slot != 0 && (kbase + 31 < lqw - 128 || kbase > lqw + 31 + 128))) continue;
        const LAS unsigned short* kt = Ks + slot * (ATT_KT / 2);
        f32x16 s;
#pragma unroll
        for (int i = 0; i < 16; ++i) s[i] = 0.f;
#pragma unroll
        for (int ks = 0; ks < 4; ++ks) {
            const bf16x8 kf = *(const LAS bf16x8*)(kt + r32 * ATT_KROW + ks * 16 + 8 * hi);
            s = __builtin_amdgcn_mfma_f32_32x32x16_bf16(kf, qf[ks], s, 0, 0, 0);
        }
        asm volatile("s_nop 15\n\ts_nop 15" : "+v"(s));
        float mt = -1e30f;
#pragma unroll
        for (int i = 0; i < 16; ++i) {
            const int lk = kbase + (i & 3) + 8 * (i >> 2) + 4 * hi;
            int d = lq - lk; d = d < 0 ? -d : d;
            const bool valid = (lk < NMETA) || (d <= 128 && lk < LL);
            s[i] = valid ? s[i] : -1e30f;
            mt = fmaxf(mt, s[i]);
        }
        mt = fmaxf(mt, __shfl_xor(mt, 32));
        const float mnew = fmaxf(mrun, mt);
        const float alpha = __expf(mrun - mnew);
        mrun = mnew;
        float ps = 0.f;
#pragma unroll
        for (int i = 0; i < 16; ++i) { s[i] = __expf(s[i] - mnew); ps += s[i]; }
        lsum = lsum * alpha + ps;
#pragma unroll
        for (int i = 0; i < 16; ++i) { o0[i] *= alpha; o1[i] *= alpha; }
        const LAS unsigned short* vt = Vs + slot * (ATT_VT / 2);
#pragma unroll
        for (int s2 = 0; s2 < 2; ++s2) {
            union { bf16x8 v; unsigned u[4]; } pf;
            pf.u[0] = pk2(s[8 * s2 + 0], s[8 * s2 + 1]); pf.u[1] = pk2(s[8 * s2 + 2], s[8 * s2 + 3]);
            pf.u[2] = pk2(s[8 * s2 + 4], s[8 * s2 + 5]); pf.u[3] = pk2(s[8 * s2 + 6], s[8 * s2 + 7]);
#pragma unroll
            for (int dt = 0; dt < 2; ++dt) {
                union { bf16x8 v; u32x2 u[2]; } vf;
                const LAS unsigned short* vp = vt + (dt * 32 + r32) * ATT_VROW + 16 * s2 + 4 * hi;
                vf.u[0] = *(const LAS u32x2*)(vp); vf.u[1] = *(const LAS u32x2*)(vp + 8);
                if (dt == 0) o0 = __builtin_amdgcn_mfma_f32_32x32x16_bf16(vf.v, pf.v, o0, 0, 0, 0);
                else o1 = __builtin_amdgcn_mfma_f32_32x32x16_bf16(vf.v, pf.v, o1, 0, 0, 0);
            }
        }
    }
    asm volatile("s_nop 15\n\ts_nop 15" : "+v"(o0), "+v"(o1));
    lsum += __shfl_xor(lsum, 32);
    const float inv = 1.0f / lsum;
    if (qvalid) {
#pragma unroll
        for (int g4 = 0; g4 < 4; ++g4) {
            u32x2 w0, w1;
            w0.x = pk2(o0[4 * g4] * inv, o0[4 * g4 + 1] * inv); w0.y = pk2(o0[4 * g4 + 2] * inv, o0[4 * g4 + 3] * inv);
            w1.x = pk2(o1[4 * g4] * inv, o1[4 * g4 + 1] * inv); w1.y = pk2(o1[4 * g4 + 2] * inv, o1[4 * g4 + 3] * inv);
            *(u32x2*)(YA + Rq * 512 + head * 64 + 8 * g4 + 4 * hi) = w0;
            *(u32x2*)(YA + Rq * 512 + head * 64 + 32 + 8 * g4 + 4 * hi) = w1;
        }
    }
    __syncthreads();
}

__device__ __forceinline__ void pool_diff(LAS unsigned char* lds, const bf16* PU, bf16* PD) {
    int tl_ = threadIdx.x; asm volatile("" : "+v"(tl_));
    constexpr int TOK = 65, HALO = 8, ROWS = TOK + 2 * HALO, NTOK = NB * LL;
    for (int blk = blockIdx.x; blk * TOK < NTOK; blk += gridDim.x) {
        const int f0 = blk * TOK;
        __syncthreads();
        for (int i = tl_; i < ROWS * 64; i += 512) {
            const int r = i >> 6, ch = i & 63, f = f0 - HALO + r;
            u32x4 v = {0u, 0u, 0u, 0u};
            if (f >= 0 && f < NTOK) { const int b = f / LL, l = f % LL; v = *(const u32x4*)(PU + (size_t)tok_row(b, l) * 512 + ch * 8); }
            *(LAS u32x4*)(lds + (size_t)i * 16) = v;
        }
        LDS_FENCE(); __syncthreads();
        for (int i = tl_; i < TOK * 64; i += 512) {
            const int t = i >> 6, ch = i & 63, f = f0 + t;
            if (f >= NTOK) continue;
            const int b = f / LL, l = f % LL, half = 1 << (ch >> 4);
            const int lo = l - half < 0 ? 0 : l - half, hh = l + half > LL ? LL : l + half;
            float s[8];
#pragma unroll
            for (int j = 0; j < 8; ++j) s[j] = 0.f;
            for (int lp = lo; lp < hh; ++lp) {
                const u32x4 v = *(const LAS u32x4*)(lds + (size_t)((t + HALO + lp - l) * 64 + ch) * 16);
                s[0] += bf2f(v.x & 0xffffu); s[1] += bf2f(v.x >> 16); s[2] += bf2f(v.y & 0xffffu); s[3] += bf2f(v.y >> 16);
                s[4] += bf2f(v.z & 0xffffu); s[5] += bf2f(v.z >> 16); s[6] += bf2f(v.w & 0xffffu); s[7] += bf2f(v.w >> 16);
            }
            const float ic = 1.0f / (float)(hh - lo);
            const u32x4 v = *(const LAS u32x4*)(lds + (size_t)((t + HALO) * 64 + ch) * 16);
            u32x4 o;
            o.x = pk2(s[0] * ic - bf2f(v.x & 0xffffu), s[1] * ic - bf2f(v.x >> 16)); o.y = pk2(s[2] * ic - bf2f(v.y & 0xffffu), s[3] * ic - bf2f(v.y >> 16));
            o.z = pk2(s[4] * ic - bf2f(v.z & 0xffffu), s[5] * ic - bf2f(v.z >> 16)); o.w = pk2(s[6] * ic - bf2f(v.w & 0xffffu), s[7] * ic - bf2f(v.w >> 16));
            *(u32x4*)(PD + (size_t)tok_row(b, l) * 512 + ch * 8) = o;
        }
    }
    __syncthreads();
}

__device__ __forceinline__ void z_pass(const float* YF, const bf16* SU, const float* dskip, bf16* Z) {
    int tl_ = threadIdx.x; asm volatile("" : "+v"(tl_)); const int gt = blockIdx.x * 512 + tl_, NGT = gridDim.x * 512;
    for (int i = gt; i < NB * LL * 64; i += NGT) {
        const int ch = i & 63, tk = i >> 6, b = tk / LL, l = tk % LL, g = ch >> 1;
        const size_t R = (size_t)tok_row(b, l);
        const bf16* yp = (const bf16*)YF + ((size_t)(b * 32 + g) * LL + l) * 16 + (ch & 1) * 8;
        const u32x4 ya = *(const u32x4*)yp, yb = *(const u32x4*)(yp + (size_t)256 * LL * 16);
        f32x4 y0, y1;
        y0[0] = bf2f(ya.x & 0xffffu) + bf2f(yb.x & 0xffffu); y0[1] = bf2f(ya.x >> 16) + bf2f(yb.x >> 16); y0[2] = bf2f(ya.y & 0xffffu) + bf2f(yb.y & 0xffffu); y0[3] = bf2f(ya.y >> 16) + bf2f(yb.y >> 16);
        y1[0] = bf2f(ya.z & 0xffffu) + bf2f(yb.z & 0xffffu); y1[1] = bf2f(ya.z >> 16) + bf2f(yb.z >> 16); y1[2] = bf2f(ya.w & 0xffffu) + bf2f(yb.w & 0xffffu); y1[3] = bf2f(ya.w >> 16) + bf2f(yb.w >> 16);
        const f32x4 d0 = *(const f32x4*)(dskip + ch * 8), d1 = *(const f32x4*)(dskip + ch * 8 + 4);
        const u32x4 uu = *(const u32x4*)(SU + R * 512 + ch * 8);
        float t[8];
        t[0] = y0[0] + d0[0] * bf2f(uu.x & 0xffffu); t[1] = y0[1] + d0[1] * bf2f(uu.x >> 16); t[2] = y0[2] + d0[2] * bf2f(uu.y & 0xffffu); t[3] = y0[3] + d0[3] * bf2f(uu.y >> 16);
        t[4] = y1[0] + d1[0] * bf2f(uu.z & 0xffffu); t[5] = y1[1] + d1[1] * bf2f(uu.z >> 16); t[6] = y1[2] + d1[2] * bf2f(uu.w & 0xffffu); t[7] = y1[3] + d1[3] * bf2f(uu.w >> 16);
#pragma unroll
        for (int j = 0; j < 8; ++j) {
            const float v = t[j], tt = __builtin_amdgcn_rcpf(fabsf(v) * 0.2316418882f + 1.0f);
            float q = tt * 0.5307027145f + (-0.7265760135f); q = q * tt + 0.7107068705f; q = q * tt + (-0.142248368f); q = q * tt + 0.127414796f; q = q * tt;
            const float m = v * (q * __builtin_amdgcn_exp2f(v * v * (-0.72134752044f)));
            t[j] = v < 0.f ? m : v - m;
        }
        u32x4 o; o.x = pk2(t[0], t[1]); o.y = pk2(t[2], t[3]); o.z = pk2(t[4], t[5]); o.w = pk2(t[6], t[7]);
        *(u32x4*)(Z + R * 512 + ch * 8) = o;
    }
}

#define XB_TMO      128
#define XB_XCNT(j)  (256  + 64 * (j))
#define XB_XSUB(j)  (1280 + 64 * (j))
#define XB_XGEN(j)  (2304 + 64 * (j))
#define XB_TOP      3328
#define XB_TOPGEN   3392
#define XCD_BAR_WORDS 3456
#define XB_SPIN_CAP (1u << 18)

__device__ __forceinline__ unsigned xb_ld(unsigned* p)              { return __hip_atomic_load(p, __ATOMIC_RELAXED, __HIP_MEMORY_SCOPE_AGENT); }
__device__ __forceinline__ unsigned xb_add(unsigned* p, unsigned v) { return __hip_atomic_fetch_add(p, v, __ATOMIC_RELAXED, __HIP_MEMORY_SCOPE_AGENT); }
__device__ __forceinline__ unsigned xb_xcc_id() { return (unsigned)__builtin_amdgcn_s_getreg((3 << 11) | 20) & 0xFu; }
#define XB_SPIN(cond, bar) do { unsigned _sp = 0; while (cond) { __builtin_amdgcn_s_sleep(1); \
    if ((++_sp & 255u) == 0u) { if (xb_ld(&(bar)[XB_TMO])) break; if (_sp > XB_SPIN_CAP) { atomicAdd(&(bar)[XB_TMO], 1u); break; } } } } while (0)

struct XcdBarrier {
    unsigned* bar; unsigned x;
    volatile LAS unsigned* st;
};

__device__ __forceinline__ XcdBarrier xcd_barrier_post(unsigned* bar, volatile LAS unsigned* st) {
    XcdBarrier b; b.bar = bar; b.x = xb_xcc_id(); b.st = st;
    if (threadIdx.x == 0) (void)xb_add(&bar[XB_XCNT(b.x)], 1u);
    return b;
}
__device__ __forceinline__ void xcd_barrier_complete(unsigned* bar, unsigned x, unsigned& nloc, unsigned& nx) {
    const unsigned G = gridDim.x * gridDim.y * gridDim.z;
    unsigned sum, cnt, mine, sp = 0u;
    for (;;) {
        sum = 0u; cnt = 0u; mine = 0u;
#pragma unroll
        for (unsigned j = 0; j < 16; ++j) { const unsigned c = xb_ld(&bar[XB_XCNT(j)]); sum += c; cnt += (c > 0u) ? 1u : 0u; mine = (j == x) ? c : mine; }
        if (sum == G) break;
        __builtin_amdgcn_s_sleep(1);
        if ((++sp & 255u) == 0u) { if (xb_ld(&bar[XB_TMO])) break; if (sp > XB_SPIN_CAP) { atomicAdd(&bar[XB_TMO], 1u); break; } }
    }
    nloc = mine > 0u ? mine : 1u; nx = cnt > 0u ? cnt : 1u;
}

__device__ __forceinline__ void xcd_barrier(const XcdBarrier& b) {
    asm volatile("s_waitcnt vmcnt(0)" ::: "memory");
    __syncthreads();
    if (threadIdx.x == 0) {
        unsigned* bar = b.bar;
        __builtin_amdgcn_s_waitcnt(0);
        unsigned nloc = b.st[0], nx = b.st[1];
        if (nloc == 0u) { xcd_barrier_complete(bar, b.x, nloc, nx); b.st[0] = nloc; b.st[1] = nx; }
        const unsigned old = xb_add(&bar[XB_XSUB(b.x)], 1u);
        const unsigned gen = old / nloc;
        if (old + 1u == (gen + 1u) * nloc) {
            __builtin_amdgcn_fence(__ATOMIC_RELEASE, "agent");
            asm volatile("s_waitcnt vmcnt(0)" ::: "memory");
            const unsigned og = xb_add(&bar[XB_TOP], 1u);
            const unsigned tg = og / nx;
            if (og + 1u == (tg + 1u) * nx) xb_add(&bar[XB_TOPGEN], 1u);
            else XB_SPIN(xb_ld(&bar[XB_TOPGEN]) == tg, bar);
            __builtin_amdgcn_fence(__ATOMIC_ACQUIRE, "agent");
            xb_add(&bar[XB_XGEN(b.x)], 1u);
            asm volatile("s_waitcnt vmcnt(0)" ::: "memory");
        } else {
            XB_SPIN(xb_ld(&bar[XB_XGEN(b.x)]) == gen, bar);
            __builtin_amdgcn_fence(__ATOMIC_ACQUIRE, "agent");
            asm volatile("s_waitcnt vmcnt(0)" ::: "memory");
        }
    }
    __syncthreads();
}

#ifndef MK_ALIGN
#define MK_ALIGN true
#endif
#ifndef MK_SP2
#define MK_SP2 true
#endif
#ifndef MK_SPLIT
#define MK_SPLIT 0
#endif
constexpr int NPL = 8, NPHASE = 1 + 2 * NPL + 1, PH_FINAL = NPHASE - 1;

typedef const __attribute__((address_space(4))) Args* KArgsP;
#define KARGS() ({ auto kp_ = __builtin_amdgcn_kernarg_segment_ptr(); asm volatile("" : "+s"(kp_)); (KArgsP)kp_; })
__global__ void __launch_bounds__(512, 2) fwd_kernel(Args a_unused, int ph_lo, int ph_hi) {
    (void)a_unused;
    extern __shared__ __attribute__((aligned(16))) unsigned char lds_raw[];
    LAS unsigned char* lds = (LAS unsigned char*)lds_raw;
    const int G = gridDim.x, bid = blockIdx.x;
#if MK_SPLIT
#define GRID_SYNC() do {} while (0)
    (void)lds;
#else
#define CG_SYNC() do { asm volatile("s_waitcnt vmcnt(0)" ::: "memory"); __syncthreads(); \
    if (threadIdx.x == 0) { __builtin_amdgcn_fence(__ATOMIC_RELEASE, "agent"); asm volatile("s_waitcnt vmcnt(0)" ::: "memory"); } \
    __syncthreads(); grid.sync(); \
    if (threadIdx.x == 0) { __builtin_amdgcn_fence(__ATOMIC_ACQUIRE, "agent"); asm volatile("s_waitcnt vmcnt(0)" ::: "memory"); } \
    __syncthreads(); } while (0)
    cg::grid_group grid = cg::this_grid();
    unsigned* barw = (unsigned*)(KARGS()->ws + WS_CTL);
    if (bid == 0) for (int i = threadIdx.x; i < XCD_BAR_WORDS; i += 512) __hip_atomic_store(barw + i, 0u, __ATOMIC_RELAXED, __HIP_MEMORY_SCOPE_AGENT);
    volatile LAS unsigned* xst = (volatile LAS unsigned*)(lds + LDS_BYTES - 64);
    if (threadIdx.x < 2) xst[threadIdx.x] = 0u;
    CG_SYNC();
    const XcdBarrier xbar = xcd_barrier_post(barw, xst);
#define GRID_SYNC() xcd_barrier(xbar)

#endif
#ifndef PHMASK
#define PHMASK 0xFFFFu
#endif
#define IN(k) (((PHMASK >> ((k) == 0 ? 0 : (k) == PH_FINAL ? 9 : 1 + ((k) - 1) % NPL)) & 1u) && ph_lo <= (k) && (k) < ph_hi)
#define SEAM(k) do { if (IN(k) && (k) + 1 < ph_hi) GRID_SYNC(); } while (0)
#define PHASE_BEGIN() KArgsP ka = KARGS(); unsigned char* ws = ka->ws; asm volatile("" : "+s"(ws)); float* rowss = (float*)(ws + WS_RS); float* Hm = (float*)(ws + WS_HM); bf16* HB = (bf16*)(ws + WS_HB); unsigned char* wl = ws + WS_W + (size_t)layer * LW_BYTES; \
    const int MT = NREAL; const bool META = layer != MK_NLAYER - 1;     \
    const float* rs_mix = rowss + (size_t)(2 * layer) * TPR * 16; float* rs_mlp = rowss + (size_t)(2 * layer + 1) * TPR * 16; float* rs_next = rowss + (size_t)(2 * layer + 2) * TPR * 16; (void)MT; (void)META; (void)Hm; (void)HB; (void)wl; (void)rs_mix; (void)rs_mlp; (void)rs_next;

    if (IN(0)) { Args al; { KArgsP kp = KARGS(); for (int i = 0; i < 23; ++i) al.in[i] = kp->in[i]; al.out = kp->out; al.ws = kp->ws; } p0_prologue(al, lds); }
    SEAM(0);
#ifndef MK_NLAYER
#define MK_NLAYER 2
#endif
#ifndef MK_RSIDX
#define MK_RSIDX 4
#endif
#pragma unroll 1
    for (int layer = 0; layer < MK_NLAYER; ++layer) {
        const int p = 1 + NPL * layer;
        if (IN(p)) { PHASE_BEGIN();
            pg8::Gemm g{HB, (const bf16*)(wl + OW_IN), TPR, NPROJ, DM}; pg8::StaticOrder S; S.init(TPR, NPROJ, G, bid);
            EpiInProj E{rs_mix, (const float*)(ws + WS_ROPE), (bf16*)(ws + WS_Q), (bf16*)(ws + WS_K), (bf16*)(ws + WS_V), (bf16*)(ws + WS_SU), (bf16*)(ws + WS_PU)};
            pg8::gemm_phase<EpiInProj, pg8::StaticOrder, MK_ALIGN, MK_SP2>(lds, g, S, E);
        }
        SEAM(p);
        if (IN(p + 1)) { PHASE_BEGIN();
            for (int t = bid; t < 256; t += G)
                ssm_task(lds, t, layer, (const bf16*)(ws + WS_SU), (float*)(ws + WS_YF), (const float*)(ws + WS_ABAR), (const bf16*)(ws + WS_BMAT), (const bf16*)(ws + WS_CMAT));
            for (int t = bid; t < NB * 2 * 33; t += G)
                attn_task(lds, t, (const bf16*)(ws + WS_Q), (const bf16*)(ws + WS_K), (const bf16*)(ws + WS_V), (bf16*)ka->out, ka->in[4] + layer * 8);
            pool_diff(lds, (const bf16*)(ws + WS_PU), (bf16*)(ws + WS_PD));
        }
        SEAM(p + 1);
        if (IN(p + 2)) { PHASE_BEGIN();
            z_pass((const float*)(ws + WS_YF), (const bf16*)(ws + WS_SU), ka->in[12] + layer * 512, (bf16*)(ws + WS_Z));
        }
        SEAM(p + 2);
        if (IN(p + 3)) { PHASE_BEGIN();
            const int hg = G >> 1;
            if (bid < hg) { pg8::Gemm g{(const bf16*)(ws + WS_Z), (const bf16*)(wl + OW_GLU), MT, 512, 512}; pg8::StaticOrder S; S.init(MT, 512, hg, bid);
              EpiGlu E{(const bf16*)(ws + WS_Z), ka->in[14] + layer * 512, (bf16*)ka->out + (size_t)TPR * 512};
              pg8::gemm_phase<EpiGlu, pg8::StaticOrder, MK_ALIGN, MK_SP2>(lds, g, S, E); if (META) thin_gemm<EpiGlu>(lds, g.A, g.Bt, g.K, g.N, E, bid, hg); }
            else { pg8::Gemm g{(const bf16*)(ws + WS_PD), (const bf16*)(wl + OW_POOL), MT, 512, 512}; pg8::StaticOrder S; S.init(MT, 512, G - hg, bid - hg);
              EpiScale E{(bf16*)ka->out + (size_t)2 * TPR * 512, 512, ka->in[16] + layer * 512};
              pg8::gemm_phase<EpiScale, pg8::StaticOrder, MK_ALIGN, MK_SP2>(lds, g, S, E); if (META) thin_gemm<EpiScale>(lds, g.A, g.Bt, g.K, g.N, E, bid - hg, G - hg); }
        }
        SEAM(p + 3);
        if (IN(p + 4)) { PHASE_BEGIN();
            bf16* Y3 = (bf16*)ka->out;
            bf16* BR0 = (bf16*)(ws + WS_X), *BR1 = (bf16*)(ws + WS_X + 4 * UU), *BR2 = (bf16*)(ws + WS_X + 6 * UU);
            const bf16* Wbr = (const bf16*)(wl + OW_BR); const bf16* Wg = (const bf16*)(wl + OW_IN) + (size_t)NPROJ * DM; bf16* MG = (bf16*)(ws + WS_MG);
            { pg8::Gemm g{Y3, Wbr, 3 * TPR, 3072, 512}; TripleOrder S; S.init(G, bid, TPR / 256, 4);
              EpiBr3 E{BR0, TPR / 256};
              pg8::gemm_phase<EpiBr3, TripleOrder, MK_ALIGN, MK_SP2>(lds, g, S, E); }
            if (META) {
#pragma unroll 1
                for (int c = 0; c < 3; ++c) { EpiScale E{BR0 + (size_t)(2 * c + 2 * (c > 0)) * (UU / 2), 1024, nullptr};
                    thin_gemm<EpiScale>(lds, Y3 + (size_t)c * TPR * 512, Wbr + (size_t)c * 1024 * 512, 512, 1024, E, bid, G); }
            }
            { pg8::Gemm g{HB, Wg, MT, 3072, DM}; TripleOrder S; S.init(G, bid, 0, 4);
              EpiGate3 E{rs_mix, BR0, MG};
              pg8::gemm_phase<EpiGate3, TripleOrder, MK_ALIGN, MK_SP2>(lds, g, S, E); }
            if (META) {
                { EpiGate<true> E{rs_mix, BR0, MG}; thin_gemm<EpiGate<true>>(lds, HB, Wg, DM, 1024, E, bid, G); }
                { EpiGate<false> E{rs_mix, BR1, MG}; thin_gemm<EpiGate<false>>(lds, HB, Wg + (size_t)1024 * DM, DM, 1024, E, bid, G); }
                { EpiGate<false> E{rs_mix, BR2, MG}; thin_gemm<EpiGate<false>>(lds, HB, Wg + (size_t)2048 * DM, DM, 1024, E, bid, G); }
            }
        }
        SEAM(p + 4);
        if (IN(p + 5)) { PHASE_BEGIN();
            pg8::Gemm g{(const bf16*)(ws + WS_MG), (const bf16*)(wl + OW_OUT), MT, DM, DM}; pg8::StaticOrder S; S.init(MT, DM, G, bid);
            EpiRes E{layer == 0 ? ka->in[0] : (const float*)nullptr, HB, rs_mlp};
            pg8::gemm_phase<EpiRes, pg8::StaticOrder, MK_ALIGN, MK_SP2>(lds, g, S, E); if (META) thin_gemm<EpiRes>(lds, g.A, g.Bt, g.K, g.N, E, bid, G);
        }
        SEAM(p + 5);
        if (IN(p + 6)) { PHASE_BEGIN();
            pg8::Gemm g{HB, (const bf16*)(wl + OW_UP), MT, FF, DM}; pg8::StaticOrder S; S.init(MT, FF, G, bid);
            EpiUp E{rs_mlp, (bf16*)(ws + WS_ACT)};
            pg8::gemm_phase<EpiUp, pg8::StaticOrder, MK_ALIGN, MK_SP2>(lds, g, S, E); if (META) thin_gemm<EpiUp>(lds, g.A, g.Bt, g.K, g.N, E, bid, G);
        }
        SEAM(p + 6);
        if (IN(p + 7)) { PHASE_BEGIN();
            pg8::Gemm g{(const bf16*)(ws + WS_ACT), (const bf16*)(wl + OW_DN), MT, DM, FF}; pg8::StaticOrder S; S.init(MT, DM, G, bid);
            EpiRes E{(const float*)nullptr, HB, rs_next};
            pg8::gemm_phase<EpiRes, pg8::StaticOrder, MK_ALIGN, MK_SP2>(lds, g, S, E); if (META) thin_gemm<EpiRes>(lds, g.A, g.Bt, g.K, g.N, E, bid, G);
        }
        SEAM(p + 7);
    }
#ifdef MK_DUMP_OFF
    if (IN(PH_FINAL)) { KArgsP ka = KARGS();
        const bf16* src = (const bf16*)(ka->ws + (MK_DUMP_OFF)); const bf16* src2 = (const bf16*)(ka->ws + (MK_DUMP_OFF2));
        for (int i = bid * 512 + threadIdx.x; i < NREAL * 1024; i += G * 512) { const int R = MK_DUMP_ROW(i >> 10), c = i & 1023; ka->out[i] = c < 512 ? bf2f(src[(size_t)R * (MK_DUMP_LD) + (c % (MK_DUMP_LD))]) : bf2f(src2[(size_t)R * (MK_DUMP_LD2) + (c % (MK_DUMP_LD2))]); }
    }
#else
    if (IN(PH_FINAL)) { KArgsP ka = KARGS();
        const float* rs = (const float*)(ka->ws + WS_RS) + (size_t)MK_RSIDX * TPR * 16; const float* gain = ka->in[22];
        int tl_ = threadIdx.x; asm volatile("" : "+v"(tl_));
        for (int i = bid * 512 + tl_; i < NREAL * 256; i += G * 512) {
            const int R = i >> 8, c4 = (i & 255) * 4;
            const float r = row_rstd(rs, R);
            const u32x2 hb = *(const u32x2*)((const bf16*)(ka->ws + WS_HB) + (size_t)R * DM + c4); const f32x4 gn = *(const f32x4*)(gain + c4);
            f32x4 v = {bf2f(hb.x & 0xffffu), bf2f(hb.x >> 16), bf2f(hb.y & 0xffffu), bf2f(hb.y >> 16)};
            v = v * r * gn;
            *(f32x4*)(ka->out + (size_t)R * DM + c4) = v;
        }
    }
#endif
#undef IN
#undef SEAM
}

extern "C" void kernel_launch(void* const* d_in, const int* in_sizes, int n_in, void* d_out, int out_size, void* d_ws, size_t ws_size, hipStream_t stream) {
    static int grid = 0;
    if (grid == 0) {
        if (n_in != 23 || out_size != NREAL * DM || ws_size < WS_END) { fprintf(stderr, "kernel_launch: unexpected shapes (n_in %d out %d ws %zu)\n", n_in, out_size, ws_size); grid = -1; return; }
        int dev = 0, cus = 0, per_cu = 0;
        hipGetDevice(&dev); hipDeviceGetAttribute(&cus, hipDeviceAttributeMultiprocessorCount, dev);
        if (hipFuncSetAttribute((const void*)fwd_kernel, hipFuncAttributeMaxDynamicSharedMemorySize, LDS_BYTES) != hipSuccess) { fprintf(stderr, "kernel_launch: hipFuncSetAttribute failed\n"); grid = -1; return; }
        if (hipOccupancyMaxActiveBlocksPerMultiprocessor(&per_cu, (const void*)fwd_kernel, 512, LDS_BYTES) != hipSuccess || per_cu < 1) { fprintf(stderr, "kernel_launch: occupancy query gave %d\n", per_cu); per_cu = 1; }
        (void)hipGetLastError();
        grid = cus * (per_cu > 1 ? 1 : per_cu);
        if (grid <= 0) grid = 256;
    }
    if (grid < 0) return;
    Args a{};
    for (int i = 0; i < 23; ++i) a.in[i] = (const float*)d_in[i];
    a.out = (float*)d_out; a.ws = (unsigned char*)d_ws;
#if MK_SPLIT
    for (int ph = 0; ph < NPHASE; ++ph) hipLaunchKernelGGL(fwd_kernel, dim3(grid), dim3(512), LDS_BYTES, stream, a, ph, ph + 1);
#else
    int lo = 0, hi = NPHASE;
    void* kargs[] = {(void*)&a, (void*)&lo, (void*)&hi};
    hipError_t e = hipLaunchCooperativeKernel((const void*)fwd_kernel, dim3(grid), dim3(512), kargs, LDS_BYTES, stream);
    if (e != hipSuccess) fprintf(stderr, "kernel_launch: cooperative launch failed: %s (grid %d)\n", hipGetErrorString(e), grid);
#endif
}
```

```cpp
#include <hip/hip_runtime.h>
#include <hip/hip_cooperative_groups.h>
#include <cstdio>
#include <cstdint>
namespace cg = cooperative_groups;
namespace pg8 {
#define PG8_LAS __attribute__((address_space(3)))
typedef unsigned short bf16_t;
typedef short bf16x8 __attribute__((ext_vector_type(8)));
typedef float f32x4 __attribute__((ext_vector_type(4)));
typedef unsigned u32x4 __attribute__((ext_vector_type(4)));
constexpr int BM = 256, BK = 64, HALF = 128, HTB = HALF * BK * 2  , STAGE_BYTES = 8 * HTB, NXCD = 8, WGM = 8;

__host__ __device__ __forceinline__ int lds_byte(int r, int c) { const int st = (r >> 4) * 2 + (c >> 5), rr = r & 15, cc = c & 31, ob = rr * 64 + cc * 2; return st * 1024 + (ob ^ (((ob >> 9) & 1) << 5)); }
__host__ __device__ __forceinline__ void stage_rc(int b, int& R, int& C) { const int st = b / 1024, sb = b % 1024, swz = sb ^ (((sb >> 9) & 1) << 5); R = (st >> 1) * 16 + swz / 64; C = (st & 1) * 32 + (swz % 64) / 2; }
__host__ __device__ __forceinline__ int perm32(int rho) { const int n = rho >> 4, i = rho & 15; return 8 * (i >> 2) + 4 * n + (i & 3); }

struct Unit { int pm, pn; };
struct Gemm { const bf16_t* A; const bf16_t* Bt; int M, N, K; };

struct StaticOrder {
    int nM, nN, nwg, G, c;
    __host__ __device__ void init(int M, int N, int G_, int c_) { nM = M / BM; nN = N / BM; nwg = nM * nN; G = G_; c = c_; }
    __host__ __device__ __forceinline__ bool next(int i, Unit& u) const {
        const long L = (long)i * G + c; if (L >= nwg) return false;
        int wgid = (int)L; { const int q = nwg / NXCD, r = nwg % NXCD, xcd = wgid % NXCD, off = wgid / NXCD; wgid = (xcd < r ? xcd * (q + 1) : r * (q + 1) + (xcd - r) * q) + off; }
        const int nig = WGM * nN, gid = wgid / nig, fm = gid * WGM, gsz = (nM - fm) < WGM ? (nM - fm) : WGM;
        u.pm = fm + ((wgid % nig) % gsz); u.pn = (wgid % nig) / gsz; return true;
    }
    __device__ __forceinline__ void a_ready(const Unit&) const {}
    __device__ __forceinline__ void done(const Unit&) const {}
};

__device__ __forceinline__ unsigned cvt_pk_bf16(float lo, float hi) { unsigned r; asm volatile("v_cvt_pk_bf16_f32 %0, %1, %2" : "=v"(r) : "v"(lo), "v"(hi)); return r; }
template <class Epi, class Sched, bool ALIGN_EPI = false, bool SP2 = false>
__device__ __forceinline__ void gemm_phase(PG8_LAS unsigned char* lds, const Gemm g, const Sched& S, const Epi& E) {
    int tid_l = threadIdx.x; asm volatile("" : "+v"(tid_l));
    const int tid = tid_l, wid = __builtin_amdgcn_readfirstlane(tid >> 6), lane = tid & 63, wr = wid >> 2, wc = wid & 3, fr = lane & 15, fq = lane >> 4;
    const int K = g.K, nt = K / BK;
    unsigned voffA[2], voffB[2];
#pragma unroll
    for (int i = 0; i < 2; ++i) { int R, C; stage_rc(tid * 16 + i * 8192, R, C); const int Rb = Epi::PERM ? ((R & ~31) + perm32(R & 31)) : R;
        voffA[i] = (unsigned)(R * K + C) * 2u; voffB[i] = (unsigned)(Rb * K + C) * 2u; }
    const size_t kstep = (size_t)(BK * 2);
    const size_t hstep = (size_t)HALF * K * 2;
    const size_t tstep = 2 * hstep;
    const unsigned ldsw = (unsigned)wid * 1024u;
    const int aoff = lds_byte(wr * 64 + fr, fq * 8), boff = lds_byte(wc * 32 + fr, fq * 8);
#define PG8_SA(b, h) (((b) * 2 + (h)) * HTB)
#define PG8_SB(b, h) ((4 + (b) * 2 + (h)) * HTB)
#define PG8_STAGE(bufoff, gbase, voff) do { _Pragma("unroll") for (int _i = 0; _i < 2; ++_i) \
        __builtin_amdgcn_global_load_lds((const unsigned*)((const char*)(gbase) + (voff)[_i]), (PG8_LAS unsigned*)(lds + (bufoff) + ldsw + _i * 8192), 16, 0, 0); } while (0)
#define PG8_LDA(dst, b, h) do { _Pragma("unroll") for (int m = 0; m < 4; ++m) _Pragma("unroll") for (int k = 0; k < 2; ++k) dst[m][k] = *(const PG8_LAS bf16x8*)(lds + PG8_SA(b, h) + aoff + m * 2048 + k * 1024); } while (0)
#define PG8_LDB(dst, b, h) do { _Pragma("unroll") for (int n = 0; n < 2; ++n) _Pragma("unroll") for (int k = 0; k < 2; ++k) dst[n][k] = *(const PG8_LAS bf16x8*)(lds + PG8_SB(b, h) + boff + n * 2048 + k * 1024); } while (0)
#define PG8_MMA(ai, bj, At, Bt) do { __builtin_amdgcn_s_setprio(1); _Pragma("unroll") for (int m = 0; m < 4; ++m) _Pragma("unroll") for (int n = 0; n < 2; ++n) _Pragma("unroll") for (int k = 0; k < 2; ++k) \
        acc[ai][bj][m][n] = __builtin_amdgcn_mfma_f32_16x16x32_bf16(Bt[n][k], At[m][k], acc[ai][bj][m][n], 0, 0, 0); __builtin_amdgcn_s_setprio(0); } while (0)
#define PG8_WAIT_V(n) asm volatile("s_waitcnt vmcnt(" #n ")" ::: "memory")
#define PG8_WAIT_L(n) asm volatile("s_waitcnt lgkmcnt(" #n ")" ::: "memory")
#define PG8_BAR __builtin_amdgcn_s_barrier()
#define PG8_SCHED __builtin_amdgcn_sched_barrier(0)
    Unit cur, nxt; int ui = 0;
    if (!S.next(0, cur)) return;
    f32x4 acc[2][2][4][2];
#pragma unroll
    for (int a = 0; a < 2; ++a)
#pragma unroll
        for (int b = 0; b < 2; ++b)
#pragma unroll
            for (int m = 0; m < 4; ++m)
#pragma unroll
                for (int n = 0; n < 2; ++n) acc[a][b][m][n] = (f32x4){0.f, 0.f, 0.f, 0.f};
    bf16x8 At[4][2], B0[2][2], B1[2][2];
    const char* cA = (const char*)g.A + (size_t)cur.pm * tstep; const char* cB = (const char*)g.Bt + (size_t)cur.pn * tstep;
    S.a_ready(cur);
    if constexpr (SP2) {
        PG8_STAGE(PG8_SB(0, 0), cB, voffB); PG8_STAGE(PG8_SB(0, 1), cB + hstep, voffB); PG8_STAGE(PG8_SA(0, 0), cA, voffA); PG8_STAGE(PG8_SA(0, 1), cA + hstep, voffA);
        if (wr == 1) PG8_BAR;
        PG8_WAIT_V(2); PG8_BAR;
        PG8_STAGE(PG8_SB(1, 0), cB + kstep, voffB); PG8_STAGE(PG8_SA(1, 0), cA + kstep, voffA); PG8_STAGE(PG8_SB(1, 1), cB + hstep + kstep, voffB);
        PG8_WAIT_V(6); PG8_BAR;
    } else {
        PG8_STAGE(PG8_SB(0, 0), cB, voffB); PG8_STAGE(PG8_SA(0, 0), cA, voffA); PG8_STAGE(PG8_SB(0, 1), cB + hstep, voffB); PG8_STAGE(PG8_SA(0, 1), cA + hstep, voffA);
        if (wr == 1) PG8_BAR;
        PG8_WAIT_V(4); PG8_BAR;
        PG8_STAGE(PG8_SB(1, 0), cB + kstep, voffB); PG8_STAGE(PG8_SA(1, 0), cA + kstep, voffA); PG8_STAGE(PG8_SB(1, 1), cB + hstep + kstep, voffB);
        PG8_WAIT_V(6); PG8_BAR;
    }
    for (;;) {
        const bool has_next = S.next(ui + 1, nxt);
        const char* nA = has_next ? (const char*)g.A + (size_t)nxt.pm * tstep : cA; const char* nB = has_next ? (const char*)g.Bt + (size_t)nxt.pn * tstep : cB;
        for (int t = 0; t < nt; t += 2) {
            const bool last = (t == nt - 2);
            const char* a1 = cA + (size_t)(t + 1) * kstep;
            const char* a2 = last ? nA : cA + (size_t)(t + 2) * kstep; const char* b2 = last ? nB : cB + (size_t)(t + 2) * kstep;
            const char* a3 = a2 + kstep; const char* b3 = b2 + kstep;
            if (last && has_next) S.a_ready(nxt);
            if constexpr (SP2) {
            PG8_LDB(B0, 0, 0); PG8_LDB(B1, 0, 1); PG8_SCHED; PG8_LDA(At, 0, 0); PG8_STAGE(PG8_SA(1, 1), a1 + hstep, voffA);
            PG8_WAIT_V(8); PG8_WAIT_L(0); PG8_BAR; PG8_MMA(0, 0, At, B0); PG8_MMA(0, 1, At, B1); PG8_BAR; PG8_SCHED;
            PG8_LDA(At, 0, 1); PG8_STAGE(PG8_SB(0, 0), b2, voffB); PG8_STAGE(PG8_SB(0, 1), b2 + hstep, voffB); PG8_STAGE(PG8_SA(0, 0), a2, voffA);
            PG8_WAIT_V(8); PG8_WAIT_L(0); PG8_BAR; PG8_MMA(1, 0, At, B0); PG8_MMA(1, 1, At, B1); PG8_BAR; PG8_SCHED;
            PG8_LDB(B0, 1, 0); PG8_LDB(B1, 1, 1); PG8_SCHED; PG8_LDA(At, 1, 0); PG8_STAGE(PG8_SA(0, 1), a2 + hstep, voffA);
            PG8_WAIT_V(8); PG8_WAIT_L(0); PG8_BAR; PG8_MMA(0, 0, At, B0); PG8_MMA(0, 1, At, B1); PG8_BAR; PG8_SCHED;
            PG8_LDA(At, 1, 1); PG8_STAGE(PG8_SB(1, 0), b3, voffB); PG8_STAGE(PG8_SB(1, 1), b3 + hstep, voffB); PG8_STAGE(PG8_SA(1, 0), a3, voffA);
            PG8_WAIT_V(8); PG8_WAIT_L(0); PG8_BAR; PG8_MMA(1, 0, At, B0); PG8_MMA(1, 1, At, B1); PG8_BAR; PG8_SCHED;
            } else {
            PG8_LDB(B0, 0, 0); PG8_SCHED; PG8_LDA(At, 0, 0); PG8_STAGE(PG8_SA(1, 1), a1 + hstep, voffA);
            PG8_WAIT_L(8); PG8_BAR; PG8_WAIT_L(0); PG8_MMA(0, 0, At, B0); PG8_BAR; PG8_SCHED;
            PG8_LDB(B1, 0, 1); PG8_STAGE(PG8_SB(0, 0), b2, voffB);
            PG8_BAR; PG8_WAIT_L(0); PG8_MMA(0, 1, At, B1); PG8_BAR;
            PG8_LDA(At, 0, 1); PG8_STAGE(PG8_SA(0, 0), a2, voffA);
            PG8_BAR; PG8_WAIT_L(0); PG8_MMA(1, 0, At, B0); PG8_BAR; PG8_SCHED;
            PG8_STAGE(PG8_SB(0, 1), b2 + hstep, voffB);
            PG8_WAIT_V(6); PG8_BAR; PG8_MMA(1, 1, At, B1); PG8_BAR;
            PG8_LDB(B0, 1, 0); PG8_SCHED; PG8_LDA(At, 1, 0); PG8_STAGE(PG8_SA(0, 1), a2 + hstep, voffA);
            PG8_WAIT_L(8); PG8_BAR; PG8_WAIT_L(0); PG8_MMA(0, 0, At, B0); PG8_BAR; PG8_SCHED;
            PG8_LDB(B1, 1, 1); PG8_STAGE(PG8_SB(1, 0), b3, voffB);
            PG8_BAR; PG8_WAIT_L(0); PG8_MMA(0, 1, At, B1); PG8_BAR;
            PG8_LDA(At, 1, 1); PG8_STAGE(PG8_SA(1, 0), a3, voffA);
            PG8_BAR; PG8_WAIT_L(0); PG8_MMA(1, 0, At, B0); PG8_BAR; PG8_SCHED;
            PG8_STAGE(PG8_SB(1, 1), b3 + hstep, voffB);
            PG8_WAIT_V(6); PG8_BAR; PG8_MMA(1, 1, At, B1); PG8_BAR;
            }
        }
        if constexpr (ALIGN_EPI) { if (wr == 0) PG8_BAR; }
        asm volatile("s_nop 15\n\ts_nop 15" ::: "memory");
        if constexpr (!Epi::AFTER_DRAIN) { E(acc, cur, wr, wc, fr, fq); S.done(cur); }
        if (!has_next) break;
#pragma unroll
        for (int a = 0; a < 2; ++a)
#pragma unroll
            for (int b = 0; b < 2; ++b)
#pragma unroll
                for (int m = 0; m < 4; ++m)
#pragma unroll
                    for (int n = 0; n < 2; ++n) acc[a][b][m][n] = (f32x4){0.f, 0.f, 0.f, 0.f};
        cur = nxt; cA = nA; cB = nB; ++ui;
        if constexpr (ALIGN_EPI) { if (wr == 1) PG8_BAR; }
    }
    PG8_WAIT_V(0);
    if constexpr (!ALIGN_EPI) { if (wr == 0) PG8_BAR; }
    PG8_BAR;
    if constexpr (Epi::AFTER_DRAIN) { E.fused(acc, cur, wr, wc, fr, fq, lds, wid, lane); S.done(cur); }
#undef PG8_SA
#undef PG8_SB
#undef PG8_STAGE
#undef PG8_LDA
#undef PG8_LDB
#undef PG8_MMA
#undef PG8_WAIT_V
#undef PG8_WAIT_L
#undef PG8_BAR
#undef PG8_SCHED
}
}

#define LAS __attribute__((address_space(3)))
typedef unsigned short bf16;
typedef short bf16x8 __attribute__((ext_vector_type(8)));
typedef float f32x4 __attribute__((ext_vector_type(4)));
typedef float f32x16 __attribute__((ext_vector_type(16)));
typedef unsigned u32x2 __attribute__((ext_vector_type(2)));
typedef unsigned u32x4 __attribute__((ext_vector_type(4)));

constexpr int NB = 8, SEQ = 2048, NMETA = 16, LL = 2064, DM = 1024, FF = 4096, DIN = 4864, NPROJ = 1792;
constexpr int NREAL = NB * SEQ;
constexpr int TPR = NREAL + 256;
constexpr int LDS_BYTES = 147456;

constexpr size_t MiB = 1u << 20;
constexpr size_t WS_CTL = 0;
constexpr size_t WS_ROPE = 1 * MiB;
constexpr size_t WS_ABAR = 2 * MiB;
constexpr size_t WS_BMAT = 2 * MiB + 65536;
constexpr size_t WS_CMAT = WS_BMAT + 524288;
constexpr size_t WS_HM = 4 * MiB;
constexpr size_t WS_W = 5 * MiB;
constexpr size_t OW_IN = 0, OW_GLU = (size_t)DIN * DM * 2, OW_POOL = OW_GLU + 512 * 512 * 2, OW_BR = OW_POOL + 512 * 512 * 2,
                 OW_OUT = OW_BR + 3 * 1024 * 512 * 2, OW_UP = OW_OUT + 1024 * 1024 * 2, OW_DN = OW_UP + (size_t)FF * DM * 2, LW_BYTES = OW_DN + (size_t)FF * DM * 2;
constexpr size_t WS_HB = 68 * MiB;
constexpr size_t WS_X = 101 * MiB;
constexpr size_t UU = (size_t)TPR * 512 * 2;
constexpr size_t WS_YF = WS_X, WS_YP = WS_X, WS_Q = WS_X + 2 * UU, WS_K = WS_Q + UU, WS_V = WS_K + UU / 4, WS_MG = WS_X + 2 * UU,
                 WS_SU = WS_X + 4 * UU, WS_YA = WS_X + 8 * UU  , WS_PU = WS_X + 5 * UU, WS_YS = WS_PU, WS_Z = WS_X + 6 * UU, WS_PD = WS_X + 7 * UU, WS_BR = WS_Z, WS_ACT = WS_X;
constexpr size_t WS_RS = WS_X + 9 * UU;
constexpr size_t WS_END = WS_RS + (size_t)5 * TPR * 16 * 4;
static_assert(WS_W + 2 * LW_BYTES <= WS_HB && WS_HB + (size_t)TPR * 1024 * 2 <= WS_X && WS_END <= 256 * MiB, "ws map");
static_assert((size_t)256 * 2064 * 16 * 4 <= 2 * UU, "YF fits");

__device__ __forceinline__ unsigned pk2(float lo, float hi) { unsigned r; asm("v_cvt_pk_bf16_f32 %0, %1, %2" : "=v"(r) : "v"(lo), "v"(hi)); return r; }
__device__ __forceinline__ unsigned f2bf(float f) { return pk2(f, 0.f) & 0xffffu; }
__device__ __forceinline__ float bf2f(unsigned b) { return __uint_as_float(b << 16); }
__device__ __forceinline__ int tok_row(int b, int l) { return l >= NMETA ? b * SEQ + l - NMETA : NREAL + b * NMETA + l; }
#define LDS_FENCE() asm volatile("s_waitcnt lgkmcnt(0)" ::: "memory")
#define SSM_SYNC() do { asm volatile("s_waitcnt vmcnt(0) lgkmcnt(0)" ::: "memory"); __syncthreads(); } while (0)
__device__ __forceinline__ float row_rstd(const float* rs, int R) {
    const f32x4 a = *(const f32x4*)(rs + (size_t)R * 4), b = *(const f32x4*)(rs + ((size_t)TPR + R) * 4), c = *(const f32x4*)(rs + ((size_t)2 * TPR + R) * 4), d = *(const f32x4*)(rs + ((size_t)3 * TPR + R) * 4);
    const float s = (((a[0] + a[1]) + (a[2] + a[3])) + ((b[0] + b[1]) + (b[2] + b[3]))) + (((c[0] + c[1]) + (c[2] + c[3])) + ((d[0] + d[1]) + (d[2] + d[3])));
    return rsqrtf(s * (1.0f / 1024.0f) + 1e-6f);
}

__device__ __forceinline__ void dsincos(double a, double& s, double& c) {
    const double q = rint(a * 0.63661977236758134308);
    double r = fma(-q, 1.57079632679489655800e+00, a); r = fma(-q, 6.12323399573676603587e-17, r);
    const double r2 = r * r;
    double sp = -7.6471637318198164759e-13; sp = fma(sp, r2, 1.6059043836821614599e-10); sp = fma(sp, r2, -2.5052108385441718775e-08); sp = fma(sp, r2, 2.7557319223985890653e-06);
    sp = fma(sp, r2, -1.9841269841269841270e-04); sp = fma(sp, r2, 8.3333333333333333333e-03); sp = fma(sp, r2, -1.6666666666666666667e-01); sp = fma(sp * r2, r, r);
    double cp = 4.7794773323873852974e-14; cp = fma(cp, r2, -1.1470745597729724714e-11); cp = fma(cp, r2, 2.0876756987868098979e-09); cp = fma(cp, r2, -2.7557319223985890653e-07);
    cp = fma(cp, r2, 2.4801587301587301587e-05); cp = fma(cp, r2, -1.3888888888888888889e-03); cp = fma(cp, r2, 4.1666666666666666667e-02); cp = fma(cp, r2, -0.5); cp = fma(cp, r2, 1.0);
    const int qi = ((int)q) & 3;
    s = (qi == 0) ? sp : (qi == 1) ? cp : (qi == 2) ? -sp : -cp;
    c = (qi == 0) ? cp : (qi == 1) ? -sp : (qi == 2) ? -cp : sp;
}
__device__ __forceinline__ double dexp(double x) {
    const double k = rint(x * 1.44269504088896340736);
    double r = fma(-k, 6.93147180369123816490e-01, x); r = fma(-k, 1.90821492927058770002e-10, r);
    double p = 1.0 / 6227020800.0; p = fma(p, r, 1.0 / 479001600.0); p = fma(p, r, 1.0 / 39916800.0); p = fma(p, r, 1.0 / 3628800.0); p = fma(p, r, 1.0 / 362880.0); p = fma(p, r, 1.0 / 40320.0);
    p = fma(p, r, 1.0 / 5040.0); p = fma(p, r, 1.0 / 720.0); p = fma(p, r, 1.0 / 120.0); p = fma(p, r, 1.0 / 24.0); p = fma(p, r, 1.0 / 6.0); p = fma(p, r, 0.5); p = fma(p, r, 1.0); p = fma(p, r, 1.0);
    const long long bits = ((long long)(1023 + (int)k)) << 52;
    return p * __longlong_as_double(bits);
}

struct EpiInProj {
    static constexpr bool PERM = true, AFTER_DRAIN = false;
    const float* rowss; const float* rope; bf16 *Q, *K, *V, *SU, *PU;
    __device__ __forceinline__ u32x2 quad(int l, int c, const f32x4& v) const {
        u32x2 w;
        if (c < 640) {
            const int i0 = (c & 63) >> 1;
            const f32x4 cs = *(const f32x4*)(rope + ((size_t)l * 32 + i0) * 2);
            float o0 = v[0] * cs[0] - v[1] * cs[1], o1 = v[1] * cs[0] + v[0] * cs[1], o2 = v[2] * cs[2] - v[3] * cs[3], o3 = v[3] * cs[2] + v[2] * cs[3];
            if (c < 512) { o0 *= 0.125f; o1 *= 0.125f; o2 *= 0.125f; o3 *= 0.125f; }
            w.x = pk2(o0, o1); w.y = pk2(o2, o3);
        } else { w.x = pk2(v[0], v[1]); w.y = pk2(v[2], v[3]); }
        return w;
    }
    __device__ __forceinline__ void operator()(const f32x4 (&acc)[2][2][4][2], const pg8::Unit& u, int wr, int wc, int fr, int fq) const {
#pragma unroll
        for (int ai = 0; ai < 2; ++ai)
#pragma unroll
            for (int m = 0; m < 4; ++m) {
                const int R = u.pm * 256 + ai * 128 + wr * 64 + m * 16 + fr;
                const float rs = row_rstd(rowss, R);
                const int l = R < NREAL ? (R & 2047) + NMETA : (R & 15);
#pragma unroll
                for (int bj = 0; bj < 2; ++bj) {
                    const int c = u.pn * 256 + bj * 128 + wc * 32 + 8 * fq;
                    const u32x2 w0 = quad(l, c, acc[ai][bj][m][0] * rs), w1 = quad(l, c + 4, acc[ai][bj][m][1] * rs);
                    u32x4 w; w.x = w0.x; w.y = w0.y; w.z = w1.x; w.w = w1.y;
                    bf16* dst = c < 512 ? Q + (size_t)R * 512 + c : c < 640 ? K + (size_t)R * 128 + (c - 512) : c < 768 ? V + (size_t)R * 128 + (c - 640)
                              : c < 1280 ? SU + (size_t)R * 512 + (c - 768) : PU + (size_t)R * 512 + (c - 1280);
                    *(u32x4*)dst = w;
                }
            }
    }
};
#define EPI_BODY() \
    __device__ __forceinline__ void rg(int R, int pn, int wc, int fq, const f32x4 (&a4)[2][2]) const { \
        _Pragma("unroll") for (int bj = 0; bj < 2; ++bj) q2(R, pn * 256 + bj * 128 + wc * 32 + 8 * fq, a4[bj][0], a4[bj][1]); } \
    __device__ __forceinline__ void tq(int R, int c, const f32x4& v) const { q(R, c, v); } \
    EPI_OP()
#define EPI_OP() \
    __device__ __forceinline__ void operator()(const f32x4 (&acc)[2][2][4][2], const pg8::Unit& u, int wr, int wc, int fr, int fq) const { \
        _Pragma("unroll") for (int ai = 0; ai < 2; ++ai) _Pragma("unroll") for (int m = 0; m < 4; ++m) { \
            const f32x4 a4[2][2] = {{acc[ai][0][m][0], acc[ai][0][m][1]}, {acc[ai][1][m][0], acc[ai][1][m][1]}}; \
            rg(u.pm * 256 + ai * 128 + wr * 64 + m * 16 + fr, u.pn, wc, fq, a4); } }
#define EPI_BODY_RS() \
    __device__ __forceinline__ void rg(int R, int pn, int wc, int fq, const f32x4 (&a4)[2][2]) const { const float rs = row_rstd(rowss, R); \
        _Pragma("unroll") for (int bj = 0; bj < 2; ++bj) q2(R, pn * 256 + bj * 128 + wc * 32 + 8 * fq, a4[bj][0], a4[bj][1], rs); } \
    __device__ __forceinline__ void tq(int R, int c, const f32x4& v) const { q(R, c, v, row_rstd(rowss, R)); } \
    EPI_OP()
struct EpiGlu {
    static constexpr bool PERM = true, AFTER_DRAIN = false;
    const bf16* Z; const float* bias; bf16* YS;
    __device__ __forceinline__ void q(int R, int c, const f32x4& a) const {
        const f32x4 v = a + *(const f32x4*)(bias + c);
        const u32x2 zz = *(const u32x2*)(Z + (size_t)R * 512 + c);
        const float z0 = bf2f(zz.x & 0xffffu), z1 = bf2f(zz.x >> 16), z2 = bf2f(zz.y & 0xffffu), z3 = bf2f(zz.y >> 16);
        u32x2 w; w.x = pk2(z0 * __builtin_amdgcn_rcpf(1.0f + __expf(-v[0])), z1 * __builtin_amdgcn_rcpf(1.0f + __expf(-v[1]))); w.y = pk2(z2 * __builtin_amdgcn_rcpf(1.0f + __expf(-v[2])), z3 * __builtin_amdgcn_rcpf(1.0f + __expf(-v[3])));
        *(u32x2*)(YS + (size_t)R * 512 + c) = w;
    }
    __device__ __forceinline__ void q2(int R, int c, const f32x4& a0, const f32x4& a1) const {
        const f32x4 v0 = a0 + *(const f32x4*)(bias + c), v1 = a1 + *(const f32x4*)(bias + c + 4);
        const u32x4 zz = *(const u32x4*)(Z + (size_t)R * 512 + c);
        u32x4 w;
        w.x = pk2(bf2f(zz.x & 0xffffu) * __builtin_amdgcn_rcpf(1.0f + __expf(-v0[0])), bf2f(zz.x >> 16) * __builtin_amdgcn_rcpf(1.0f + __expf(-v0[1])));
        w.y = pk2(bf2f(zz.y & 0xffffu) * __builtin_amdgcn_rcpf(1.0f + __expf(-v0[2])), bf2f(zz.y >> 16) * __builtin_amdgcn_rcpf(1.0f + __expf(-v0[3])));
        w.z = pk2(bf2f(zz.z & 0xffffu) * __builtin_amdgcn_rcpf(1.0f + __expf(-v1[0])), bf2f(zz.z >> 16) * __builtin_amdgcn_rcpf(1.0f + __expf(-v1[1])));
        w.w = pk2(bf2f(zz.w & 0xffffu) * __builtin_amdgcn_rcpf(1.0f + __expf(-v1[2])), bf2f(zz.w >> 16) * __builtin_amdgcn_rcpf(1.0f + __expf(-v1[3])));
        *(u32x4*)(YS + (size_t)R * 512 + c) = w;
    }
    EPI_BODY()
};
struct EpiScale {
    static constexpr bool PERM = true, AFTER_DRAIN = false;
    bf16* O; int ldc; const float* scale;
    __device__ __forceinline__ void q(int R, int c, const f32x4& a) const {
        f32x4 v = a;
        if (scale) v = v * *(const f32x4*)(scale + c);
        u32x2 w; w.x = pk2(v[0], v[1]); w.y = pk2(v[2], v[3]);
        *(u32x2*)(O + (size_t)R * ldc + c) = w;
    }
    __device__ __forceinline__ void q2(int R, int c, const f32x4& a0, const f32x4& a1) const {
        f32x4 v0 = a0, v1 = a1;
        if (scale) { v0 = v0 * *(const f32x4*)(scale + c); v1 = v1 * *(const f32x4*)(scale + c + 4); }
        u32x4 w; w.x = pk2(v0[0], v0[1]); w.y = pk2(v0[2], v0[3]); w.z = pk2(v1[0], v1[1]); w.w = pk2(v1[2], v1[3]);
        *(u32x4*)(O + (size_t)R * ldc + c) = w;
    }
    EPI_BODY()
};
template <bool FIRST> struct EpiGate {
    static constexpr bool PERM = true, AFTER_DRAIN = false;
    const float* rowss; const bf16* BR; bf16* MG;
    __device__ __forceinline__ void q(int R, int c, const f32x4& a, float rs) const {
        const f32x4 v = a * rs;
        const u32x2 bb = *(const u32x2*)(BR + (size_t)R * 1024 + c);
        float o0 = bf2f(bb.x & 0xffffu) * __builtin_amdgcn_rcpf(1.0f + __expf(-v[0])), o1 = bf2f(bb.x >> 16) * __builtin_amdgcn_rcpf(1.0f + __expf(-v[1]));
        float o2 = bf2f(bb.y & 0xffffu) * __builtin_amdgcn_rcpf(1.0f + __expf(-v[2])), o3 = bf2f(bb.y >> 16) * __builtin_amdgcn_rcpf(1.0f + __expf(-v[3]));
        if (!FIRST) { const u32x2 mm = *(const u32x2*)(MG + (size_t)R * 1024 + c);
            o0 += bf2f(mm.x & 0xffffu); o1 += bf2f(mm.x >> 16); o2 += bf2f(mm.y & 0xffffu); o3 += bf2f(mm.y >> 16); }
        u32x2 w; w.x = pk2(o0, o1); w.y = pk2(o2, o3);
        *(u32x2*)(MG + (size_t)R * 1024 + c) = w;
    }
    __device__ __forceinline__ void q2(int R, int c, const f32x4& a0, const f32x4& a1, float rs) const {
        const f32x4 v0 = a0 * rs, v1 = a1 * rs;
        const u32x4 bb = *(const u32x4*)(BR + (size_t)R * 1024 + c);
        float o[8];
        o[0] = bf2f(bb.x & 0xffffu) * __builtin_amdgcn_rcpf(1.0f + __expf(-v0[0])); o[1] = bf2f(bb.x >> 16) * __builtin_amdgcn_rcpf(1.0f + __expf(-v0[1]));
        o[2] = bf2f(bb.y & 0xffffu) * __builtin_amdgcn_rcpf(1.0f + __expf(-v0[2])); o[3] = bf2f(bb.y >> 16) * __builtin_amdgcn_rcpf(1.0f + __expf(-v0[3]));
        o[4] = bf2f(bb.z & 0xffffu) * __builtin_amdgcn_rcpf(1.0f + __expf(-v1[0])); o[5] = bf2f(bb.z >> 16) * __builtin_amdgcn_rcpf(1.0f + __expf(-v1[1]));
        o[6] = bf2f(bb.w & 0xffffu) * __builtin_amdgcn_rcpf(1.0f + __expf(-v1[2])); o[7] = bf2f(bb.w >> 16) * __builtin_amdgcn_rcpf(1.0f + __expf(-v1[3]));
        if (!FIRST) { const u32x4 mm = *(const u32x4*)(MG + (size_t)R * 1024 + c);
            o[0] += bf2f(mm.x & 0xffffu); o[1] += bf2f(mm.x >> 16); o[2] += bf2f(mm.y & 0xffffu); o[3] += bf2f(mm.y >> 16);
            o[4] += bf2f(mm.z & 0xffffu); o[5] += bf2f(mm.z >> 16); o[6] += bf2f(mm.w & 0xffffu); o[7] += bf2f(mm.w >> 16); }
        u32x4 w; w.x = pk2(o[0], o[1]); w.y = pk2(o[2], o[3]); w.z = pk2(o[4], o[5]); w.w = pk2(o[6], o[7]);
        *(u32x4*)(MG + (size_t)R * 1024 + c) = w;
    }
    EPI_BODY_RS()
};
struct EpiRes {
    static constexpr bool PERM = true, AFTER_DRAIN = false;
    const float* Xin; bf16* HB; float* rowss_out;
    __device__ __forceinline__ float q(int R, int c, const f32x4& a) const {
        f32x4 h;
        if (Xin && R < NREAL) h = *(const f32x4*)(Xin + (size_t)R * 1024 + c);
        else { const u32x2 hb = *(const u32x2*)(HB + (size_t)R * 1024 + c); h = (f32x4){bf2f(hb.x & 0xffffu), bf2f(hb.x >> 16), bf2f(hb.y & 0xffffu), bf2f(hb.y >> 16)}; }
        h = h + a;
        u32x2 w; w.x = pk2(h[0], h[1]); w.y = pk2(h[2], h[3]);
        *(u32x2*)(HB + (size_t)R * 1024 + c) = w;
        const float r0 = bf2f(w.x & 0xffffu), r1 = bf2f(w.x >> 16), r2 = bf2f(w.y & 0xffffu), r3 = bf2f(w.y >> 16);
        return (r0 * r0 + r1 * r1) + (r2 * r2 + r3 * r3);
    }
    __device__ __forceinline__ float q2(int R, int c, const f32x4& a0, const f32x4& a1) const {
        f32x4 h0, h1;
        if (Xin && R < NREAL) { h0 = *(const f32x4*)(Xin + (size_t)R * 1024 + c); h1 = *(const f32x4*)(Xin + (size_t)R * 1024 + c + 4); }
        else { const u32x4 hb = *(const u32x4*)(HB + (size_t)R * 1024 + c);
            h0 = (f32x4){bf2f(hb.x & 0xffffu), bf2f(hb.x >> 16), bf2f(hb.y & 0xffffu), bf2f(hb.y >> 16)}; h1 = (f32x4){bf2f(hb.z & 0xffffu), bf2f(hb.z >> 16), bf2f(hb.w & 0xffffu), bf2f(hb.w >> 16)}; }
        h0 = h0 + a0; h1 = h1 + a1;
        u32x4 w; w.x = pk2(h0[0], h0[1]); w.y = pk2(h0[2], h0[3]); w.z = pk2(h1[0], h1[1]); w.w = pk2(h1[2], h1[3]);
        *(u32x4*)(HB + (size_t)R * 1024 + c) = w;
        const float r0 = bf2f(w.x & 0xffffu), r1 = bf2f(w.x >> 16), r2 = bf2f(w.y & 0xffffu), r3 = bf2f(w.y >> 16), r4 = bf2f(w.z & 0xffffu), r5 = bf2f(w.z >> 16), r6 = bf2f(w.w & 0xffffu), r7 = bf2f(w.w >> 16);
        return ((r0 * r0 + r1 * r1) + (r2 * r2 + r3 * r3)) + ((r4 * r4 + r5 * r5) + (r6 * r6 + r7 * r7));
    }
    __device__ __forceinline__ void rg(int R, int pn, int wc, int fq, const f32x4 (&a4)[2][2]) const {
        float ss = 0.f;
#pragma unroll
        for (int bj = 0; bj < 2; ++bj) ss += q2(R, pn * 256 + bj * 128 + wc * 32 + 8 * fq, a4[bj][0], a4[bj][1]);
        ss += __shfl_xor(ss, 16); ss += __shfl_xor(ss, 32);
        if (fq == 0) rowss_out[((size_t)pn * TPR + R) * 4 + wc] = ss;
    }
    __device__ __forceinline__ void tq(int R, int c, const f32x4& v) const {
        float ss = q(R, c, v);
        ss += __shfl_xor(ss, 16); ss += __shfl_xor(ss, 32);
        if ((threadIdx.x & 48) == 0) atomicAdd(rowss_out + (size_t)R * 4, ss);
    }
    EPI_OP()
};
struct EpiUp {
    static constexpr bool PERM = true, AFTER_DRAIN = false;
    const float* rowss; bf16* ACT;
    __device__ __forceinline__ void q(int R, int c, const f32x4& a, float rs) const {
        f32x4 v = a * rs;
#pragma unroll
        for (int j = 0; j < 4; ++j) { const float r = fmaxf(v[j], 0.f); v[j] = r * r; }
        u32x2 w; w.x = pk2(v[0], v[1]); w.y = pk2(v[2], v[3]);
        *(u32x2*)(ACT + (size_t)R * FF + c) = w;
    }
    __device__ __forceinline__ void q2(int R, int c, const f32x4& a0, const f32x4& a1, float rs) const {
        f32x4 v0 = a0 * rs, v1 = a1 * rs;
#pragma unroll
        for (int j = 0; j < 4; ++j) { const float r0 = fmaxf(v0[j], 0.f), r1 = fmaxf(v1[j], 0.f); v0[j] = r0 * r0; v1[j] = r1 * r1; }
        u32x4 w; w.x = pk2(v0[0], v0[1]); w.y = pk2(v0[2], v0[3]); w.z = pk2(v1[0], v1[1]); w.w = pk2(v1[2], v1[3]);
        *(u32x4*)(ACT + (size_t)R * FF + c) = w;
    }
    EPI_BODY_RS()
};
struct TripleOrder {
    pg8::StaticOrder S0; int arow, bcol;
    __device__ __forceinline__ void init(int G, int c, int arow_, int bcol_) { S0.init(NREAL, 1024, G, c); arow = arow_; bcol = bcol_; }
    __device__ __forceinline__ bool next(int i, pg8::Unit& u) const { pg8::Unit t; t.pm = 0; t.pn = 0; if (!S0.next(i / 3, t)) return false; const int br = i % 3; u.pm = t.pm + br * arow; u.pn = t.pn + br * bcol; return true; }
    __device__ __forceinline__ void a_ready(const pg8::Unit&) const {}
    __device__ __forceinline__ void done(const pg8::Unit&) const {}
};
struct EpiBr3 {
    static constexpr bool PERM = true, AFTER_DRAIN = false;
    bf16* Bbase; int arow;
    __device__ __forceinline__ void operator()(const f32x4 (&acc)[2][2][4][2], const pg8::Unit& u, int wr, int wc, int fr, int fq) const {
        const int c = u.pn >> 2, pn = u.pn & 3, pm = u.pm - arow * c; bf16* O = Bbase + (size_t)(2 * c + 2 * (c > 0)) * (UU / 2);
#pragma unroll
        for (int ai = 0; ai < 2; ++ai)
#pragma unroll
            for (int m = 0; m < 4; ++m) { const int R = pm * 256 + ai * 128 + wr * 64 + m * 16 + fr;
#pragma unroll
                for (int bj = 0; bj < 2; ++bj) { const f32x4 v0 = acc[ai][bj][m][0], v1 = acc[ai][bj][m][1];
                    u32x4 w; w.x = pk2(v0[0], v0[1]); w.y = pk2(v0[2], v0[3]); w.z = pk2(v1[0], v1[1]); w.w = pk2(v1[2], v1[3]);
                    *(u32x4*)(O + (size_t)R * 1024 + pn * 256 + bj * 128 + wc * 32 + 8 * fq) = w; } }
    }
};
struct EpiGate3 {
    static constexpr bool PERM = true, AFTER_DRAIN = false;
    const float* rowss; const bf16* Bbase; bf16* MG;
    __device__ __forceinline__ void operator()(const f32x4 (&acc)[2][2][4][2], const pg8::Unit& u, int wr, int wc, int fr, int fq) const {
        const int c = u.pn >> 2, pn = u.pn & 3; const bf16* BR = Bbase + (size_t)(2 * c + 2 * (c > 0)) * (UU / 2);
#pragma unroll
        for (int ai = 0; ai < 2; ++ai)
#pragma unroll
            for (int m = 0; m < 4; ++m) { const int R = u.pm * 256 + ai * 128 + wr * 64 + m * 16 + fr; const float rs = row_rstd(rowss, R);
#pragma unroll
                for (int bj = 0; bj < 2; ++bj) { const int cc = pn * 256 + bj * 128 + wc * 32 + 8 * fq;
                    const f32x4 v0 = acc[ai][bj][m][0] * rs, v1 = acc[ai][bj][m][1] * rs;
                    const u32x4 bb = *(const u32x4*)(BR + (size_t)R * 1024 + cc);
                    float o[8];
                    o[0] = bf2f(bb.x & 0xffffu) * __builtin_amdgcn_rcpf(1.0f + __expf(-v0[0])); o[1] = bf2f(bb.x >> 16) * __builtin_amdgcn_rcpf(1.0f + __expf(-v0[1]));
                    o[2] = bf2f(bb.y & 0xffffu) * __builtin_amdgcn_rcpf(1.0f + __expf(-v0[2])); o[3] = bf2f(bb.y >> 16) * __builtin_amdgcn_rcpf(1.0f + __expf(-v0[3]));
                    o[4] = bf2f(bb.z & 0xffffu) * __builtin_amdgcn_rcpf(1.0f + __expf(-v1[0])); o[5] = bf2f(bb.z >> 16) * __builtin_amdgcn_rcpf(1.0f + __expf(-v1[1]));
                    o[6] = bf2f(bb.w & 0xffffu) * __builtin_amdgcn_rcpf(1.0f + __expf(-v1[2])); o[7] = bf2f(bb.w >> 16) * __builtin_amdgcn_rcpf(1.0f + __expf(-v1[3]));
                    if (c != 0) { const u32x4 mm = *(const u32x4*)(MG + (size_t)R * 1024 + cc);
                        o[0] += bf2f(mm.x & 0xffffu); o[1] += bf2f(mm.x >> 16); o[2] += bf2f(mm.y & 0xffffu); o[3] += bf2f(mm.y >> 16);
                        o[4] += bf2f(mm.z & 0xffffu); o[5] += bf2f(mm.z >> 16); o[6] += bf2f(mm.w & 0xffffu); o[7] += bf2f(mm.w >> 16); }
                    u32x4 w; w.x = pk2(o[0], o[1]); w.y = pk2(o[2], o[3]); w.z = pk2(o[4], o[5]); w.w = pk2(o[6], o[7]);
                    *(u32x4*)(MG + (size_t)R * 1024 + cc) = w; } }
    }
};
template <class Epi>
__device__ __forceinline__ void thin_gemm(LAS unsigned char* lds, const bf16* A, const bf16* Bt, int K, int N, const Epi& E, int vb, int vg) {
    int tid_l = threadIdx.x; asm volatile("" : "+v"(tid_l));
    const int lane = tid_l & 63, w = __builtin_amdgcn_readfirstlane(tid_l >> 6), fr = lane & 15, fq = lane >> 4;
    LAS f32x4* red = (LAS f32x4*)lds;
    const int kw = K >> 3;
    for (int pc = vb; pc < N / 16; pc += vg) {
        const bf16* ap = A + (size_t)(NREAL + fr) * K + w * kw + 8 * fq;
        const bf16* bp = Bt + (size_t)(16 * pc + fr) * K + w * kw + 8 * fq;
        f32x4 acc[8];
#pragma unroll
        for (int rb = 0; rb < 8; ++rb) acc[rb] = (f32x4){0.f, 0.f, 0.f, 0.f};
#pragma unroll 2
        for (int k0 = 0; k0 < kw; k0 += 32) {
            const bf16x8 bf = *(const bf16x8*)(bp + k0);
            bf16x8 af[8];
#pragma unroll
            for (int rb = 0; rb < 8; ++rb) af[rb] = *(const bf16x8*)(ap + (size_t)(16 * rb) * K + k0);
#pragma unroll
            for (int rb = 0; rb < 8; ++rb) acc[rb] = __builtin_amdgcn_mfma_f32_16x16x32_bf16(bf, af[rb], acc[rb], 0, 0, 0);
        }
        asm volatile("s_nop 15\n\ts_nop 15" : "+v"(acc[0]), "+v"(acc[1]), "+v"(acc[2]), "+v"(acc[3]), "+v"(acc[4]), "+v"(acc[5]), "+v"(acc[6]), "+v"(acc[7]));
#pragma unroll
        for (int rb = 0; rb < 8; ++rb) red[(w * 8 + rb) * 64 + lane] = acc[rb];
        LDS_FENCE(); __syncthreads();
        f32x4 v = red[(0 * 8 + w) * 64 + lane];
#pragma unroll
        for (int ww = 1; ww < 8; ++ww) v = v + red[(ww * 8 + w) * 64 + lane];
        LDS_FENCE(); __syncthreads();
        E.tq(NREAL + 16 * w + fr, 16 * pc + 4 * fq, v);
    }
}

struct Args { const float* in[23]; float* out; unsigned char* ws; };

__device__ __forceinline__ void p0_item(const float* W, int ldw, int K, const float* scale, bf16* WT, int permrows, LAS float* scr, int item, int nblk, int lane) {
    const int kb = item / nblk, nb = item % nblk, k0 = 64 * kb, n0 = 64 * nb;
#pragma unroll 4
    for (int i = 0; i < 16; ++i) {
        const int kk = 4 * i + (lane >> 4), c4 = (lane & 15) * 4;
        f32x4 w = *(const f32x4*)(W + (size_t)(k0 + kk) * ldw + n0 + c4);
        if (scale) w = w * scale[k0 + kk];
        scr[kk * 65 + c4] = w[0]; scr[kk * 65 + c4 + 1] = w[1]; scr[kk * 65 + c4 + 2] = w[2]; scr[kk * 65 + c4 + 3] = w[3];
    }
    LDS_FENCE();
    const int c = lane & 7;
#pragma unroll
    for (int j = 0; j < 8; ++j) {
        const int n = (lane >> 3) + 8 * j;
        const int sc = (n0 + n) < permrows ? ((n & 1) ? 32 + (n >> 1) : (n >> 1)) : n;
        const LAS float* s = scr + (8 * c) * 65 + sc;
        u32x4 o; o.x = pk2(s[0 * 65], s[1 * 65]); o.y = pk2(s[2 * 65], s[3 * 65]); o.z = pk2(s[4 * 65], s[5 * 65]); o.w = pk2(s[6 * 65], s[7 * 65]);
        *(u32x4*)(WT + (size_t)(n0 + n) * K + k0 + 8 * c) = o;
    }
    LDS_FENCE();
}

typedef const __attribute__((address_space(4))) Args* KArgsP;
__device__ __forceinline__ void convert_layer_weights(KArgsP ka, LAS unsigned char* lds, int layer, int vw, int nvw, int wave, int lane) {
    unsigned char* ws = ka->ws;
    LAS float* scr = (LAS float*)(lds + wave * 17408);
    constexpr int I_IN = 16 * 76, I_GLU = 8 * 8, I_BR = 8 * 16, I_OUT = 16 * 16, I_UP = 16 * 64, I_DN = 64 * 16, I_L = I_IN + I_GLU + 3 * I_BR + I_OUT + I_UP + I_DN;
    unsigned char* wl = ws + WS_W + (size_t)layer * LW_BYTES;
    for (int it = vw; it < I_L; it += nvw) {
        int r = it;
        if (r < I_IN) { p0_item(ka->in[3] + (size_t)layer * DM * DIN, DIN, DM, ka->in[2] + layer * DM, (bf16*)(wl + OW_IN), 640, scr, r, 76, lane); continue; } r -= I_IN;
        if (r < I_GLU) { p0_item(ka->in[13] + (size_t)layer * 512 * 512, 512, 512, nullptr, (bf16*)(wl + OW_GLU), 0, scr, r, 8, lane); continue; } r -= I_GLU;
        if (r < 3 * I_BR) { const int c = r / I_BR; p0_item(ka->in[17] + ((size_t)layer * 3 + c) * 512 * 1024, 1024, 512, nullptr, (bf16*)(wl + OW_BR) + (size_t)c * 1024 * 512, 0, scr, r % I_BR, 16, lane); continue; } r -= 3 * I_BR;
        if (r < I_OUT) { p0_item(ka->in[18] + (size_t)layer * DM * DM, DM, DM, nullptr, (bf16*)(wl + OW_OUT), 0, scr, r, 16, lane); continue; } r -= I_OUT;
        if (r < I_UP) { p0_item(ka->in[20] + (size_t)layer * DM * FF, FF, DM, ka->in[19] + layer * DM, (bf16*)(wl + OW_UP), 0, scr, r, 64, lane); continue; } r -= I_UP;
        p0_item(ka->in[21] + (size_t)layer * FF * DM, DM, FF, nullptr, (bf16*)(wl + OW_DN), 0, scr, r, 16, lane);
    }
    for (int i = vw * 64 + lane; i < 512 * 64; i += nvw * 64) {
        const int n = i >> 6, k0 = (i & 63) * 8;
        u32x4 o = {0u, 0u, 0u, 0u};
        if ((n >> 7) == (k0 >> 7)) { const float* src = ka->in[15] + (((size_t)layer * 4 + (n >> 7)) * 128 + (k0 & 127)) * 128 + (n & 127);
            o.x = pk2(src[0], src[128]); o.y = pk2(src[256], src[384]); o.z = pk2(src[512], src[640]); o.w = pk2(src[768], src[896]); }
        *(u32x4*)((bf16*)(wl + OW_POOL) + (size_t)n * 512 + k0) = o;
    }
}

__device__ __forceinline__ void p0_prologue(const Args& a, LAS unsigned char* lds) {
    int tl_ = threadIdx.x; asm volatile("" : "+v"(tl_));
    const int tid = tl_, lane = tid & 63, wave = __builtin_amdgcn_readfirstlane(tid >> 6);
    const int gw = blockIdx.x * 8 + wave, NGW = gridDim.x * 8;
    const int gt = blockIdx.x * 512 + tid, NGT = gridDim.x * 512;
    unsigned char* ws = a.ws;
    for (int i = gt; i < 4 * 4 * 128 * 4; i += NGT) { const int idx = 1 + (i >> 11), pn = (i >> 9) & 3, r = (i >> 2) & 127, sl = i & 3;
        ((float*)(ws + WS_RS))[((size_t)idx * 4 * TPR + (size_t)pn * TPR + NREAL + r) * 4 + sl] = 0.f; }
    for (int i = gt; i < LL * 32; i += NGT) {
        const int l = i >> 5, f = i & 31;
        const float invf = (float)dexp(-(double)f * (9.21034037197618273607 / 32.0));
        const float ang = (float)l * invf;
        double s, c; dsincos((double)ang, s, c);
        float* rp = (float*)(ws + WS_ROPE) + (size_t)i * 2; rp[0] = (float)c; rp[1] = (float)s;
    }
    for (int i = gt; i < 2 * 2 * 32 * 64; i += NGT) {
        const int n = i & 63, pidx = i >> 6;
        const double lr = (double)a.in[5][i], li = (double)a.in[6][i];
        const double dt = (double)(float)dexp((double)a.in[7][pidx]);
        const double mag = dexp(lr * dt); double sn, cn; dsincos(li * dt, sn, cn);
        const double are = mag * cn, aim = mag * sn, den = lr * lr + li * li, nre = are - 1.0;
        const double fre = (nre * lr + aim * li) / den, fim = (aim * lr - nre * li) / den;
        float* ab = (float*)(ws + WS_ABAR) + (size_t)i * 2; ab[0] = (float)are; ab[1] = (float)aim;
        bf16* bm = (bf16*)(ws + WS_BMAT) + (size_t)pidx * 128 * 16;
        bf16* cm = (bf16*)(ws + WS_CMAT) + (size_t)pidx * 16 * 128;
        for (int q = 0; q < 16; ++q) {
            const double br = (double)a.in[8][(size_t)i * 16 + q], bi = (double)a.in[9][(size_t)i * 16 + q];
            bm[n * 16 + q] = (bf16)f2bf((float)(fre * br - fim * bi));
            bm[(64 + n) * 16 + q] = (bf16)f2bf((float)(fre * bi + fim * br));
            cm[q * 128 + n] = (bf16)f2bf(a.in[10][((size_t)pidx * 16 + q) * 64 + n]);
            cm[q * 128 + 64 + n] = (bf16)f2bf(-a.in[11][((size_t)pidx * 16 + q) * 64 + n]);
        }
    }
    for (int R = gw; R < TPR; R += NGW) {
        const int mrow = R - NREAL;
        const float* src = R < NREAL ? a.in[0] + (size_t)R * DM : a.in[1] + (size_t)(mrow & 15) * DM;
        float* dst = R < NREAL ? a.out + (size_t)R * DM : (float*)(ws + WS_HM) + (size_t)mrow * DM;
        bf16* hb = (bf16*)(ws + WS_HB) + (size_t)R * DM;
        const bool pad = mrow >= NB * NMETA;
        float ss = 0.f;
#pragma unroll
        for (int j = 0; j < 4; ++j) {
            f32x4 v = *(const f32x4*)(src + 4 * lane + 256 * j);
            if (pad) v = (f32x4){0.f, 0.f, 0.f, 0.f};
            ss += (v[0] * v[0] + v[1] * v[1]) + (v[2] * v[2] + v[3] * v[3]);
            u32x2 w; w.x = pk2(v[0], v[1]); w.y = pk2(v[2], v[3]);
            *(u32x2*)(hb + 4 * lane + 256 * j) = w;
        }
#pragma unroll
        for (int o = 1; o < 64; o <<= 1) ss += __shfl_xor(ss, o);
        if (lane < 16) ((float*)(ws + WS_RS))[((size_t)(lane >> 2) * TPR + R) * 4 + (lane & 3)] = lane == 0 ? ss : 0.f;
    }
}

__device__ __forceinline__ void ssm_task(LAS unsigned char* lds, int task, int layer, const bf16* SU, float* YF,
                                         const float* abar_all, const bf16* bmat_all, const bf16* cmat_all) {
    int tid_l = threadIdx.x; asm volatile("" : "+v"(tid_l));
    const int tid = tid_l, lane = tid & 63, wave = __builtin_amdgcn_readfirstlane(tid >> 6);
    const int b = task >> 5, g = task & 31;
    __syncthreads();
    LAS float* BU = (LAS float*)(lds + wave * 12800);
    LAS unsigned short* X = (LAS unsigned short*)(lds + wave * 12800 + 8448);
    LAS float* SX = (LAS float*)(lds + 8 * 12800);
    const int blk0 = wave == 0 ? 0 : 16 * wave + 1, nblk = wave == 0 ? 17 : 16;
    bf16* yfb = (bf16*)YF + (size_t)task * LL * 16;
    const int fr = lane & 15, fq = lane >> 4;
    const bf16x8 zero8 = {0, 0, 0, 0, 0, 0, 0, 0};
    for (int dir = 0; dir < 2; ++dir) {
        const int pidx = (layer * 2 + dir) * 32 + g;
        const float are = abar_all[((size_t)pidx * 64 + lane) * 2], aim = abar_all[((size_t)pidx * 64 + lane) * 2 + 1];
        bf16x8 bfr[8], cfr[4];
        const bf16* bm = bmat_all + (size_t)pidx * 128 * 16;
#pragma unroll
        for (int nt = 0; nt < 8; ++nt) bfr[nt] = fq < 2 ? *(const bf16x8*)(bm + (nt * 16 + fr) * 16 + 8 * fq) : zero8;
        const bf16* cm = cmat_all + (size_t)pidx * 16 * 128;
#pragma unroll
        for (int ks = 0; ks < 4; ++ks) cfr[ks] = *(const bf16x8*)(cm + fr * 128 + ks * 32 + 8 * fq);
        float p16r = are, p16i = aim;
#pragma unroll
        for (int i = 0; i < 4; ++i) { const float tr = p16r * p16r - p16i * p16i, ti = 2.f * p16r * p16i; p16r = tr; p16i = ti; }
        float p256r = p16r, p256i = p16i;
#pragma unroll
        for (int i = 0; i < 4; ++i) { const float tr = p256r * p256r - p256i * p256i, ti = 2.f * p256r * p256i; p256r = tr; p256i = ti; }
        const float p272r = p256r * p16r - p256i * p16i, p272i = p256r * p16i + p256i * p16r;

        float xre = 0.f, xim = 0.f;
        for (int pass = 0; pass < 2; ++pass) {
            bf16x8 unext;
            { const int blkf = dir == 0 ? blk0 : blk0 + nblk - 1; const int Rf = blkf == 0 ? NREAL + b * NMETA : b * SEQ + blkf * 16 - NMETA;
              unext = fq < 2 ? *(const bf16x8*)(SU + (size_t)(Rf + fr) * 512 + g * 16 + 8 * fq) : zero8; }
            for (int ib = 0; ib < nblk; ++ib) {
                const int blk = dir == 0 ? blk0 + ib : blk0 + nblk - 1 - ib;
                const bf16x8 ufr = unext;
                if (ib + 1 < nblk) { const int blkn = dir == 0 ? blk + 1 : blk - 1; const int Rn = blkn == 0 ? NREAL + b * NMETA : b * SEQ + blkn * 16 - NMETA;
                    unext = fq < 2 ? *(const bf16x8*)(SU + (size_t)(Rn + fr) * 512 + g * 16 + 8 * fq) : zero8; }
                f32x4 dd[8];
#pragma unroll
                for (int nt = 0; nt < 8; ++nt) { dd[nt] = (f32x4){0.f, 0.f, 0.f, 0.f}; dd[nt] = __builtin_amdgcn_mfma_f32_16x16x32_bf16(ufr, bfr[nt], dd[nt], 0, 0, 0); }
                asm volatile("s_nop 15\n\ts_nop 15" : "+v"(dd[0]), "+v"(dd[1]), "+v"(dd[2]), "+v"(dd[3]), "+v"(dd[4]), "+v"(dd[5]), "+v"(dd[6]), "+v"(dd[7]));
#pragma unroll
                for (int nt = 0; nt < 8; ++nt)
#pragma unroll
                    for (int r = 0; r < 4; ++r) BU[(4 * fq + r) * 132 + nt * 16 + fr] = dd[nt][r];
                LDS_FENCE();
                float bur[16], bui[16];
#pragma unroll
                for (int i = 0; i < 16; ++i) { const int tt = dir == 0 ? i : 15 - i; bur[i] = BU[tt * 132 + lane]; bui[i] = BU[tt * 132 + 64 + lane]; }
                if (pass == 0) {
#pragma unroll
                    for (int i = 0; i < 16; ++i) {
                        const float bre = bur[i], bim = bui[i];
                        const float nr = are * xre - aim * xim + bre, ni = are * xim + aim * xre + bim; xre = nr; xim = ni;
                    }
                    LDS_FENCE();
                } else {
#pragma unroll
                    for (int i = 0; i < 16; ++i) {
                        const int tt = dir == 0 ? i : 15 - i;
                        const float bre = bur[i], bim = bui[i];
                        const float nr = are * xre - aim * xim + bre, ni = are * xim + aim * xre + bim; xre = nr; xim = ni;
                        X[tt * 136 + lane] = (unsigned short)f2bf(xre); X[tt * 136 + 64 + lane] = (unsigned short)f2bf(xim);
                    }
                    LDS_FENCE();
                    f32x4 y = {0.f, 0.f, 0.f, 0.f};
#pragma unroll
                    for (int ks = 0; ks < 4; ++ks) {
                        const bf16x8 afr = *(const LAS bf16x8*)(X + fr * 136 + ks * 32 + 8 * fq);
                        y = __builtin_amdgcn_mfma_f32_16x16x32_bf16(afr, cfr[ks], y, 0, 0, 0);
                    }
                    asm volatile("s_nop 15\n\ts_nop 15" : "+v"(y));
                    LDS_FENCE();
                    {
                        bf16* yd = yfb + (size_t)dir * 256 * LL * 16;
#pragma unroll
                        for (int r = 0; r < 4; ++r) yd[(size_t)(blk * 16 + 4 * fq + r) * 16 + fr] = (bf16)f2bf(y[r]);
                    }
                }
            }
            if (pass == 0) {
                SX[(wave * 64 + lane) * 2] = xre; SX[(wave * 64 + lane) * 2 + 1] = xim;
                LDS_FENCE(); __syncthreads();
                float cre = 0.f, cim = 0.f;
                if (dir == 0) {
                    for (int w = 0; w < wave; ++w) { const float pr = w == 0 ? p272r : p256r, pi = w == 0 ? p272i : p256i;
                        const float sr = SX[(w * 64 + lane) * 2], si = SX[(w * 64 + lane) * 2 + 1];
                        const float nr = pr * cre - pi * cim + sr, ni = pr * cim + pi * cre + si; cre = nr; cim = ni; }
                } else {
                    for (int w = 7; w > wave; --w) {
                        const float sr = SX[(w * 64 + lane) * 2], si = SX[(w * 64 + lane) * 2 + 1];
                        const float nr = p256r * cre - p256i * cim + sr, ni = p256r * cim + p256i * cre + si; cre = nr; cim = ni; }
                }
                xre = cre; xim = cim;
            }
        }
        LDS_FENCE(); __syncthreads();
    }
}

constexpr int ATT_KROW = 72, ATT_VROW = 40, ATT_KT = 32 * ATT_KROW * 2  , ATT_VT = 64 * ATT_VROW * 2  , ATT_MAXT = 11, ATT_VOFF = ATT_MAXT * ATT_KT;
static_assert(ATT_VOFF + ATT_MAXT * ATT_VT <= 131072, "attention LDS");
__device__ __forceinline__ void attn_task(LAS unsigned char* lds, int task, const bf16* Q, const bf16* K, const bf16* V, bf16* YA, const float* sink) {
    int tid_l = threadIdx.x; asm volatile("" : "+v"(tid_l));
    const int tid = tid_l, lane = tid & 63, wave = __builtin_amdgcn_readfirstlane(tid >> 6);
    const int qb = task % 33, bh = task / 33, h = bh & 1, b = bh >> 1;
    const int l0 = qb * 64;
    __syncthreads();
    int jlo = (l0 - 128) >> 5; if (jlo < 1) jlo = 1;
    int jhi = (l0 + 191) >> 5; if (jhi > 64) jhi = 64;
    const int ntiles = 1 + (jhi - jlo + 1);
    LAS unsigned short* Ks = (LAS unsigned short*)lds;
    LAS unsigned short* Vs = (LAS unsigned short*)(lds + ATT_VOFF);
    for (int idx = tid; idx < ntiles * 32 * 8; idx += 512) {
        const int ch = idx & 7, key = idx >> 3, slot = key >> 5, kk = key & 31;
        const int lk = (slot == 0 ? 0 : (jlo + slot - 1) * 32) + kk;
        u32x4 kv = {0u, 0u, 0u, 0u}, vv = {0u, 0u, 0u, 0u};
        if (lk < LL) { const size_t R = (size_t)tok_row(b, lk);
            kv = *(const u32x4*)(K + R * 128 + h * 64 + ch * 8); vv = *(const u32x4*)(V + R * 128 + h * 64 + ch * 8); }
        *(LAS u32x4*)(Ks + slot * (ATT_KT / 2) + kk * ATT_KROW + ch * 8) = kv;
        LAS unsigned short* vd = Vs + slot * (ATT_VT / 2) + (ch * 8) * ATT_VROW + kk;
        vd[0 * ATT_VROW] = (unsigned short)(vv.x & 0xffffu); vd[1 * ATT_VROW] = (unsigned short)(vv.x >> 16);
        vd[2 * ATT_VROW] = (unsigned short)(vv.y & 0xffffu); vd[3 * ATT_VROW] = (unsigned short)(vv.y >> 16);
        vd[4 * ATT_VROW] = (unsigned short)(vv.z & 0xffffu); vd[5 * ATT_VROW] = (unsigned short)(vv.z >> 16);
        vd[6 * ATT_VROW] = (unsigned short)(vv.w & 0xffffu); vd[7 * ATT_VROW] = (unsigned short)(vv.w >> 16);
    }
    LDS_FENCE(); __syncthreads();
    const int head = h * 4 + (wave >> 1), r32 = lane & 31, hi = lane >> 5;
    const int lq = l0 + 32 * (wave & 1) + r32;
    const bool qvalid = lq < LL;
    const size_t Rq = (size_t)tok_row(b, qvalid ? lq : LL - 1);
    bf16x8 qf[4];
#pragma unroll
    for (int ks = 0; ks < 4; ++ks) qf[ks] = *(const bf16x8*)(Q + Rq * 512 + head * 64 + ks * 16 + 8 * hi);
    float mrun = sink[head], lsum = hi == 0 ? 1.0f : 0.0f;
    f32x16 o0, o1;
#pragma unroll
    for (int i = 0; i < 16; ++i) { o0[i] = 0.f; o1[i] = 0.f; }
    const int lqw = l0 + 32 * (wave & 1);
    for (int slot = 0; slot < ntiles; ++slot) {
        const int kbase = slot == 0 ? 0 : (jlo + slot - 1) * 32;
        if (lqw >= LL || (slot != 0 && (kbase + 31 < lqw - 128 || kbase > lqw + 31 + 128))) continue;
        const LAS unsigned short* kt = Ks + slot * (ATT_KT / 2);
        f32x16 s;
#pragma unroll
        for (int i = 0; i < 16; ++i) s[i] = 0.f;
#pragma unroll
        for (int ks = 0; ks < 4; ++ks) {
            const bf16x8 kf = *(const LAS bf16x8*)(kt + r32 * ATT_KROW + ks * 16 + 8 * hi);
            s = __builtin_amdgcn_mfma_f32_32x32x16_bf16(kf, qf[ks], s, 0, 0, 0);
        }
        asm volatile("s_nop 15\n\ts_nop 15" : "+v"(s));
        float mt = -1e30f;
#pragma unroll
        for (int i = 0; i < 16; ++i) {
            const int lk = kbase + (i & 3) + 8 * (i >> 2) + 4 * hi;
            int d = lq - lk; d = d < 0 ? -d : d;
            const bool valid = (lk < NMETA) || (d <= 128 && lk < LL);
            s[i] = valid ? s[i] : -1e30f;
            mt = fmaxf(mt, s[i]);
        }
        mt = fmaxf(mt, __shfl_xor(mt, 32));
        const float mnew = fmaxf(mrun, mt);
        const float alpha = __expf(mrun - mnew);
        mrun = mnew;
        float ps = 0.f;
#pragma unroll
        for (int i = 0; i < 16; ++i) { s[i] = __expf(s[i] - mnew); ps += s[i]; }
        lsum = lsum * alpha + ps;
#pragma unroll
        for (int i = 0; i < 16; ++i) { o0[i] *= alpha; o1[i] *= alpha; }
        const LAS unsigned short* vt = Vs + slot * (ATT_VT / 2);
#pragma unroll
        for (int s2 = 0; s2 < 2; ++s2) {
            union { bf16x8 v; unsigned u[4]; } pf;
            pf.u[0] = pk2(s[8 * s2 + 0], s[8 * s2 + 1]); pf.u[1] = pk2(s[8 * s2 + 2], s[8 * s2 + 3]);
            pf.u[2] = pk2(s[8 * s2 + 4], s[8 * s2 + 5]); pf.u[3] = pk2(s[8 * s2 + 6], s[8 * s2 + 7]);
#pragma unroll
            for (int dt = 0; dt < 2; ++dt) {
                union { bf16x8 v; u32x2 u[2]; } vf;
                const LAS unsigned short* vp = vt + (dt * 32 + r32) * ATT_VROW + 16 * s2 + 4 * hi;
                vf.u[0] = *(const LAS u32x2*)(vp); vf.u[1] = *(const LAS u32x2*)(vp + 8);
                if (dt == 0) o0 = __builtin_amdgcn_mfma_f32_32x32x16_bf16(vf.v, pf.v, o0, 0, 0, 0);
                else o1 = __builtin_amdgcn_mfma_f32_32x32x16_bf16(vf.v, pf.v, o1, 0, 0, 0);
            }
        }
    }
    asm volatile("s_nop 15\n\ts_nop 15" : "+v"(o0), "+v"(o1));
    lsum += __shfl_xor(lsum, 32);
    const float inv = 1.0f / lsum;
    if (qvalid) {
#pragma unroll
        for (int g4 = 0; g4 < 4; ++g4) {
            u32x2 w0, w1;
            w0.x = pk2(o0[4 * g4] * inv, o0[4 * g4 + 1] * inv); w0.y = pk2(o0[4 * g4 + 2] * inv, o0[4 * g4 + 3] * inv);
            w1.x = pk2(o1[4 * g4] * inv, o1[4 * g4 + 1] * inv); w1.y = pk2(o1[4 * g4 + 2] * inv, o1[4 * g4 + 3] * inv);
            *(u32x2*)(YA + Rq * 512 + head * 64 + 8 * g4 + 4 * hi) = w0;
            *(u32x2*)(YA + Rq * 512 + head * 64 + 32 + 8 * g4 + 4 * hi) = w1;
        }
    }
    __syncthreads();
}

__device__ __forceinline__ void pool_diff(LAS unsigned char* lds, const bf16* PU, bf16* PD) {
    int tl_ = threadIdx.x; asm volatile("" : "+v"(tl_));
    constexpr int TOK = 65, HALO = 8, ROWS = TOK + 2 * HALO, NTOK = NB * LL;
    for (int blk = blockIdx.x; blk * TOK < NTOK; blk += gridDim.x) {
        const int f0 = blk * TOK;
        __syncthreads();
        for (int i = tl_; i < ROWS * 64; i += 512) {
            const int r = i >> 6, ch = i & 63, f = f0 - HALO + r;
            u32x4 v = {0u, 0u, 0u, 0u};
            if (f >= 0 && f < NTOK) { const int b = f / LL, l = f % LL; v = *(const u32x4*)(PU + (size_t)tok_row(b, l) * 512 + ch * 8); }
            *(LAS u32x4*)(lds + (size_t)i * 16) = v;
        }
        LDS_FENCE(); __syncthreads();
        for (int i = tl_; i < TOK * 64; i += 512) {
            const int t = i >> 6, ch = i & 63, f = f0 + t;
            if (f >= NTOK) continue;
            const int b = f / LL, l = f % LL, half = 1 << (ch >> 4);
            const int lo = l - half < 0 ? 0 : l - half, hh = l + half > LL ? LL : l + half;
            float s[8];
#pragma unroll
            for (int j = 0; j < 8; ++j) s[j] = 0.f;
            for (int lp = lo; lp < hh; ++lp) {
                const u32x4 v = *(const LAS u32x4*)(lds + (size_t)((t + HALO + lp - l) * 64 + ch) * 16);
                s[0] += bf2f(v.x & 0xffffu); s[1] += bf2f(v.x >> 16); s[2] += bf2f(v.y & 0xffffu); s[3] += bf2f(v.y >> 16);
                s[4] += bf2f(v.z & 0xffffu); s[5] += bf2f(v.z >> 16); s[6] += bf2f(v.w & 0xffffu); s[7] += bf2f(v.w >> 16);
            }
            const float ic = 1.0f / (float)(hh - lo);
            const u32x4 v = *(const LAS u32x4*)(lds + (size_t)((t + HALO) * 64 + ch) * 16);
            u32x4 o;
            o.x = pk2(s[0] * ic - bf2f(v.x & 0xffffu), s[1] * ic - bf2f(v.x >> 16)); o.y = pk2(s[2] * ic - bf2f(v.y & 0xffffu), s[3] * ic - bf2f(v.y >> 16));
            o.z = pk2(s[4] * ic - bf2f(v.z & 0xffffu), s[5] * ic - bf2f(v.z >> 16)); o.w = pk2(s[6] * ic - bf2f(v.w & 0xffffu), s[7] * ic - bf2f(v.w >> 16));
            *(u32x4*)(PD + (size_t)tok_row(b, l) * 512 + ch * 8) = o;
        }
    }
    __syncthreads();
}

__device__ __forceinline__ void z_pass(const float* YF, const bf16* SU, const float* dskip, bf16* Z) {
    int tl_ = threadIdx.x; asm volatile("" : "+v"(tl_)); const int gt = blockIdx.x * 512 + tl_, NGT = gridDim.x * 512;
    for (int i = gt; i < NB * LL * 64; i += NGT) {
        const int ch = i & 63, tk = i >> 6, b = tk / LL, l = tk % LL, g = ch >> 1;
        const size_t R = (size_t)tok_row(b, l);
        const bf16* yp = (const bf16*)YF + ((size_t)(b * 32 + g) * LL + l) * 16 + (ch & 1) * 8;
        const u32x4 ya = *(const u32x4*)yp, yb = *(const u32x4*)(yp + (size_t)256 * LL * 16);
        f32x4 y0, y1;
        y0[0] = bf2f(ya.x & 0xffffu) + bf2f(yb.x & 0xffffu); y0[1] = bf2f(ya.x >> 16) + bf2f(yb.x >> 16); y0[2] = bf2f(ya.y & 0xffffu) + bf2f(yb.y & 0xffffu); y0[3] = bf2f(ya.y >> 16) + bf2f(yb.y >> 16);
        y1[0] = bf2f(ya.z & 0xffffu) + bf2f(yb.z & 0xffffu); y1[1] = bf2f(ya.z >> 16) + bf2f(yb.z >> 16); y1[2] = bf2f(ya.w & 0xffffu) + bf2f(yb.w & 0xffffu); y1[3] = bf2f(ya.w >> 16) + bf2f(yb.w >> 16);
        const f32x4 d0 = *(const f32x4*)(dskip + ch * 8), d1 = *(const f32x4*)(dskip + ch * 8 + 4);
        const u32x4 uu = *(const u32x4*)(SU + R * 512 + ch * 8);
        float t[8];
        t[0] = y0[0] + d0[0] * bf2f(uu.x & 0xffffu); t[1] = y0[1] + d0[1] * bf2f(uu.x >> 16); t[2] = y0[2] + d0[2] * bf2f(uu.y & 0xffffu); t[3] = y0[3] + d0[3] * bf2f(uu.y >> 16);
        t[4] = y1[0] + d1[0] * bf2f(uu.z & 0xffffu); t[5] = y1[1] + d1[1] * bf2f(uu.z >> 16); t[6] = y1[2] + d1[2] * bf2f(uu.w & 0xffffu); t[7] = y1[3] + d1[3] * bf2f(uu.w >> 16);
#pragma unroll
        for (int j = 0; j < 8; ++j) {
            const float v = t[j], tt = __builtin_amdgcn_rcpf(fabsf(v) * 0.2316418882f + 1.0f);
            float q = tt * 0.5307027145f + (-0.7265760135f); q = q * tt + 0.7107068705f; q = q * tt + (-0.142248368f); q = q * tt + 0.127414796f; q = q * tt;
            const float m = v * (q * __builtin_amdgcn_exp2f(v * v * (-0.72134752044f)));
            t[j] = v < 0.f ? m : v - m;
        }
        u32x4 o; o.x = pk2(t[0], t[1]); o.y = pk2(t[2], t[3]); o.z = pk2(t[4], t[5]); o.w = pk2(t[6], t[7]);
        *(u32x4*)(Z + R * 512 + ch * 8) = o;
    }
}

#define XB_TMO      128
#define XB_XCNT(j)  (256  + 64 * (j))
#define XB_XSUB(j)  (1280 + 64 * (j))
#define XB_XGEN(j)  (2304 + 64 * (j))
#define XB_TOP      3328
#define XB_TOPGEN   3392
#define XCD_BAR_WORDS 3456
#define XB_SPIN_CAP (1u << 18)

__device__ __forceinline__ unsigned xb_ld(unsigned* p)              { return __hip_atomic_load(p, __ATOMIC_RELAXED, __HIP_MEMORY_SCOPE_AGENT); }
__device__ __forceinline__ unsigned xb_add(unsigned* p, unsigned v) { return __hip_atomic_fetch_add(p, v, __ATOMIC_RELAXED, __HIP_MEMORY_SCOPE_AGENT); }
__device__ __forceinline__ unsigned xb_xcc_id() { return (unsigned)__builtin_amdgcn_s_getreg((3 << 11) | 20) & 0xFu; }
#define XB_SPIN(cond, bar) do { unsigned _sp = 0; while (cond) { __builtin_amdgcn_s_sleep(1); \
    if ((++_sp & 255u) == 0u) { if (xb_ld(&(bar)[XB_TMO])) break; if (_sp > XB_SPIN_CAP) { atomicAdd(&(bar)[XB_TMO], 1u); break; } } } } while (0)

struct XcdBarrier {
    unsigned* bar; unsigned x;
    volatile LAS unsigned* st;
};

__device__ __forceinline__ XcdBarrier xcd_barrier_post(unsigned* bar, volatile LAS unsigned* st) {
    XcdBarrier b; b.bar = bar; b.x = xb_xcc_id(); b.st = st;
    if (threadIdx.x == 0) (void)xb_add(&bar[XB_XCNT(b.x)], 1u);
    return b;
}
__device__ __forceinline__ void xcd_barrier_complete(unsigned* bar, unsigned x, unsigned& nloc, unsigned& nx) {
    const unsigned G = gridDim.x * gridDim.y * gridDim.z;
    unsigned sum, cnt, mine, sp = 0u;
    for (;;) {
        sum = 0u; cnt = 0u; mine = 0u;
#pragma unroll
        for (unsigned j = 0; j < 16; ++j) { const unsigned c = xb_ld(&bar[XB_XCNT(j)]); sum += c; cnt += (c > 0u) ? 1u : 0u; mine = (j == x) ? c : mine; }
        if (sum == G) break;
        __builtin_amdgcn_s_sleep(1);
        if ((++sp & 255u) == 0u) { if (xb_ld(&bar[XB_TMO])) break; if (sp > XB_SPIN_CAP) { atomicAdd(&bar[XB_TMO], 1u); break; } }
    }
    nloc = mine > 0u ? mine : 1u; nx = cnt > 0u ? cnt : 1u;
}

__device__ __forceinline__ void xcd_barrier(const XcdBarrier& b) {
    asm volatile("s_waitcnt vmcnt(0)" ::: "memory");
    __syncthreads();
    if (threadIdx.x == 0) {
        unsigned* bar = b.bar;
        __builtin_amdgcn_s_waitcnt(0);
        unsigned nloc = b.st[0], nx = b.st[1];
        if (nloc == 0u) { xcd_barrier_complete(bar, b.x, nloc, nx); b.st[0] = nloc; b.st[1] = nx; }
        const unsigned old = xb_add(&bar[XB_XSUB(b.x)], 1u);
        const unsigned gen = old / nloc;
        if (old + 1u == (gen + 1u) * nloc) {
            __builtin_amdgcn_fence(__ATOMIC_RELEASE, "agent");
            asm volatile("s_waitcnt vmcnt(0)" ::: "memory");
            const unsigned og = xb_add(&bar[XB_TOP], 1u);
            const unsigned tg = og / nx;
            if (og + 1u == (tg + 1u) * nx) xb_add(&bar[XB_TOPGEN], 1u);
            else XB_SPIN(xb_ld(&bar[XB_TOPGEN]) == tg, bar);
            __builtin_amdgcn_fence(__ATOMIC_ACQUIRE, "agent");
            xb_add(&bar[XB_XGEN(b.x)], 1u);
            asm volatile("s_waitcnt vmcnt(0)" ::: "memory");
        } else {
            XB_SPIN(xb_ld(&bar[XB_XGEN(b.x)]) == gen, bar);
            __builtin_amdgcn_fence(__ATOMIC_ACQUIRE, "agent");
            asm volatile("s_waitcnt vmcnt(0)" ::: "memory");
        }
    }
    __syncthreads();
}

#ifndef MK_ALIGN
#define MK_ALIGN true
#endif
#ifndef MK_SP2
#define MK_SP2 true
#endif
#ifndef MK_SPLIT
#define MK_SPLIT 0
#endif
#ifndef MK_NLAYER
#define MK_NLAYER 2
#endif
constexpr int NPL = 8, NPHASE = 1 + 2 * NPL + 1, PH_FINAL = NPHASE - 1;

#define KARGS() ({ auto kp_ = __builtin_amdgcn_kernarg_segment_ptr(); asm volatile("" : "+s"(kp_)); (KArgsP)kp_; })
__global__ void __launch_bounds__(512, 2) fwd_kernel(Args a_unused, int ph_lo, int ph_hi) {
    (void)a_unused;
    extern __shared__ __attribute__((aligned(16))) unsigned char lds_raw[];
    LAS unsigned char* lds = (LAS unsigned char*)lds_raw;
    const int G = gridDim.x, bid = blockIdx.x;
#if MK_SPLIT
#define GRID_SYNC() do {} while (0)
    (void)lds;
#else
#define CG_SYNC() do { asm volatile("s_waitcnt vmcnt(0)" ::: "memory"); __syncthreads(); \
    if (threadIdx.x == 0) { __builtin_amdgcn_fence(__ATOMIC_RELEASE, "agent"); asm volatile("s_waitcnt vmcnt(0)" ::: "memory"); } \
    __syncthreads(); grid.sync(); \
    if (threadIdx.x == 0) { __builtin_amdgcn_fence(__ATOMIC_ACQUIRE, "agent"); asm volatile("s_waitcnt vmcnt(0)" ::: "memory"); } \
    __syncthreads(); } while (0)
    cg::grid_group grid = cg::this_grid();
    unsigned* barw = (unsigned*)(KARGS()->ws + WS_CTL);
    if (bid == 0) for (int i = threadIdx.x; i < XCD_BAR_WORDS; i += 512) __hip_atomic_store(barw + i, 0u, __ATOMIC_RELAXED, __HIP_MEMORY_SCOPE_AGENT);
    volatile LAS unsigned* xst = (volatile LAS unsigned*)(lds + LDS_BYTES - 64);
    if (threadIdx.x < 2) xst[threadIdx.x] = 0u;
    CG_SYNC();
    const XcdBarrier xbar = xcd_barrier_post(barw, xst);
#define GRID_SYNC() xcd_barrier(xbar)

#endif
#ifndef PHMASK
#define PHMASK 0xFFFFu
#endif
#define IN(k) (((PHMASK >> ((k) == 0 ? 0 : (k) == PH_FINAL ? 9 : 1 + ((k) - 1) % NPL)) & 1u) && ph_lo <= (k) && (k) < ph_hi)
#define SEAM(k) do { if (IN(k) && (k) + 1 < ph_hi) GRID_SYNC(); } while (0)
#define PHASE_BEGIN() KArgsP ka = KARGS(); unsigned char* ws = ka->ws; asm volatile("" : "+s"(ws)); float* rowss = (float*)(ws + WS_RS); float* Hm = (float*)(ws + WS_HM); bf16* HB = (bf16*)(ws + WS_HB); unsigned char* wl = ws + WS_W + (size_t)layer * LW_BYTES; \
    const int MT = NREAL; const bool META = layer != MK_NLAYER - 1;     \
    const float* rs_mix = rowss + (size_t)(2 * layer) * TPR * 16; float* rs_mlp = rowss + (size_t)(2 * layer + 1) * TPR * 16; float* rs_next = rowss + (size_t)(2 * layer + 2) * TPR * 16; (void)MT; (void)META; (void)Hm; (void)HB; (void)wl; (void)rs_mix; (void)rs_mlp; (void)rs_next;

    if (IN(0)) {
        { int tl_ = threadIdx.x; asm volatile("" : "+v"(tl_)); const int wv = __builtin_amdgcn_readfirstlane(tl_ >> 6);
          convert_layer_weights(KARGS(), lds, 0, bid * 8 + wv, G * 8, wv, tl_ & 63); }
        Args al; { KArgsP kp = KARGS(); for (int i = 0; i < 23; ++i) al.in[i] = kp->in[i]; al.out = kp->out; al.ws = kp->ws; } p0_prologue(al, lds); }
    SEAM(0);
#ifndef MK_NLAYER
#define MK_NLAYER 2
#endif
#ifndef MK_RSIDX
#define MK_RSIDX 4
#endif
#pragma unroll 1
    for (int layer = 0; layer < MK_NLAYER; ++layer) {
        const int p = 1 + NPL * layer;
        if (IN(p)) { PHASE_BEGIN();
            pg8::Gemm g{HB, (const bf16*)(wl + OW_IN), TPR, NPROJ, DM}; pg8::StaticOrder S; S.init(TPR, NPROJ, G, bid);
            EpiInProj E{rs_mix, (const float*)(ws + WS_ROPE), (bf16*)(ws + WS_Q), (bf16*)(ws + WS_K), (bf16*)(ws + WS_V), (bf16*)(ws + WS_SU), (bf16*)(ws + WS_PU)};
            pg8::gemm_phase<EpiInProj, pg8::StaticOrder, MK_ALIGN, MK_SP2>(lds, g, S, E);
        }
        SEAM(p);
        if (IN(p + 1)) { PHASE_BEGIN();
            for (int t = bid; t < 256; t += G)
                ssm_task(lds, t, layer, (const bf16*)(ws + WS_SU), (float*)(ws + WS_YF), (const float*)(ws + WS_ABAR), (const bf16*)(ws + WS_BMAT), (const bf16*)(ws + WS_CMAT));
            for (int t = bid; t < NB * 2 * 33; t += G)
                attn_task(lds, t, (const bf16*)(ws + WS_Q), (const bf16*)(ws + WS_K), (const bf16*)(ws + WS_V), (bf16*)ka->out, ka->in[4] + layer * 8);
            pool_diff(lds, (const bf16*)(ws + WS_PU), (bf16*)(ws + WS_PD));
            if (layer + 1 < MK_NLAYER) {
                int tl_ = threadIdx.x; asm volatile("" : "+v"(tl_)); const int wv = __builtin_amdgcn_readfirstlane(tl_ >> 6);
                convert_layer_weights(ka, lds, layer + 1, bid * 8 + wv, G * 8, wv, tl_ & 63);
                __syncthreads();
            }
        }
        SEAM(p + 1);
        if (IN(p + 2)) { PHASE_BEGIN();
            z_pass((const float*)(ws + WS_YF), (const bf16*)(ws + WS_SU), ka->in[12] + layer * 512, (bf16*)(ws + WS_Z));
        }
        SEAM(p + 2);
        if (IN(p + 3)) { PHASE_BEGIN();
            const int hg = G >> 1;
            if (bid < hg) { pg8::Gemm g{(const bf16*)(ws + WS_Z), (const bf16*)(wl + OW_GLU), MT, 512, 512}; pg8::StaticOrder S; S.init(MT, 512, hg, bid);
              EpiGlu E{(const bf16*)(ws + WS_Z), ka->in[14] + layer * 512, (bf16*)ka->out + (size_t)TPR * 512};
              pg8::gemm_phase<EpiGlu, pg8::StaticOrder, MK_ALIGN, MK_SP2>(lds, g, S, E); if (META) thin_gemm<EpiGlu>(lds, g.A, g.Bt, g.K, g.N, E, bid, hg); }
            else { pg8::Gemm g{(const bf16*)(ws + WS_PD), (const bf16*)(wl + OW_POOL), MT, 512, 512}; pg8::StaticOrder S; S.init(MT, 512, G - hg, bid - hg);
              EpiScale E{(bf16*)ka->out + (size_t)2 * TPR * 512, 512, ka->in[16] + layer * 512};
              pg8::gemm_phase<EpiScale, pg8::StaticOrder, MK_ALIGN, MK_SP2>(lds, g, S, E); if (META) thin_gemm<EpiScale>(lds, g.A, g.Bt, g.K, g.N, E, bid - hg, G - hg); }
        }
        SEAM(p + 3);
        if (IN(p + 4)) { PHASE_BEGIN();
            bf16* Y3 = (bf16*)ka->out;
            bf16* BR0 = (bf16*)(ws + WS_X), *BR1 = (bf16*)(ws + WS_X + 4 * UU), *BR2 = (bf16*)(ws + WS_X + 6 * UU);
            const bf16* Wbr = (const bf16*)(wl + OW_BR); const bf16* Wg = (const bf16*)(wl + OW_IN) + (size_t)NPROJ * DM; bf16* MG = (bf16*)(ws + WS_MG);
            { pg8::Gemm g{Y3, Wbr, 3 * TPR, 3072, 512}; TripleOrder S; S.init(G, bid, TPR / 256, 4);
              EpiBr3 E{BR0, TPR / 256};
              pg8::gemm_phase<EpiBr3, TripleOrder, MK_ALIGN, MK_SP2>(lds, g, S, E); }
            if (META) {
#pragma unroll 1
                for (int c = 0; c < 3; ++c) { EpiScale E{BR0 + (size_t)(2 * c + 2 * (c > 0)) * (UU / 2), 1024, nullptr};
                    thin_gemm<EpiScale>(lds, Y3 + (size_t)c * TPR * 512, Wbr + (size_t)c * 1024 * 512, 512, 1024, E, bid, G); }
            }
            { pg8::Gemm g{HB, Wg, MT, 3072, DM}; TripleOrder S; S.init(G, bid, 0, 4);
              EpiGate3 E{rs_mix, BR0, MG};
              pg8::gemm_phase<EpiGate3, TripleOrder, MK_ALIGN, MK_SP2>(lds, g, S, E); }
            if (META) {
                { EpiGate<true> E{rs_mix, BR0, MG}; thin_gemm<EpiGate<true>>(lds, HB, Wg, DM, 1024, E, bid, G); }
                { EpiGate<false> E{rs_mix, BR1, MG}; thin_gemm<EpiGate<false>>(lds, HB, Wg + (size_t)1024 * DM, DM, 1024, E, bid, G); }
                { EpiGate<false> E{rs_mix, BR2, MG}; thin_gemm<EpiGate<false>>(lds, HB, Wg + (size_t)2048 * DM, DM, 1024, E, bid, G); }
            }
        }
        SEAM(p + 4);
        if (IN(p + 5)) { PHASE_BEGIN();
            pg8::Gemm g{(const bf16*)(ws + WS_MG), (const bf16*)(wl + OW_OUT), MT, DM, DM}; pg8::StaticOrder S; S.init(MT, DM, G, bid);
            EpiRes E{(const float*)nullptr, HB, rs_mlp};
            pg8::gemm_phase<EpiRes, pg8::StaticOrder, MK_ALIGN, MK_SP2>(lds, g, S, E); if (META) thin_gemm<EpiRes>(lds, g.A, g.Bt, g.K, g.N, E, bid, G);
        }
        SEAM(p + 5);
        if (IN(p + 6)) { PHASE_BEGIN();
            pg8::Gemm g{HB, (const bf16*)(wl + OW_UP), MT, FF, DM}; pg8::StaticOrder S; S.init(MT, FF, G, bid);
            EpiUp E{rs_mlp, (bf16*)(ws + WS_ACT)};
            pg8::gemm_phase<EpiUp, pg8::StaticOrder, MK_ALIGN, MK_SP2>(lds, g, S, E); if (META) thin_gemm<EpiUp>(lds, g.A, g.Bt, g.K, g.N, E, bid, G);
        }
        SEAM(p + 6);
        if (IN(p + 7)) { PHASE_BEGIN();
            pg8::Gemm g{(const bf16*)(ws + WS_ACT), (const bf16*)(wl + OW_DN), MT, DM, FF}; pg8::StaticOrder S; S.init(MT, DM, G, bid);
            EpiRes E{(const float*)nullptr, HB, rs_next};
            pg8::gemm_phase<EpiRes, pg8::StaticOrder, MK_ALIGN, MK_SP2>(lds, g, S, E); if (META) thin_gemm<EpiRes>(lds, g.A, g.Bt, g.K, g.N, E, bid, G);
        }
        SEAM(p + 7);
    }
#ifdef MK_DUMP_OFF
    if (IN(PH_FINAL)) { KArgsP ka = KARGS();
        const bf16* src = (const bf16*)(ka->ws + (MK_DUMP_OFF)); const bf16* src2 = (const bf16*)(ka->ws + (MK_DUMP_OFF2));
        for (int i = bid * 512 + threadIdx.x; i < NREAL * 1024; i += G * 512) { const int R = MK_DUMP_ROW(i >> 10), c = i & 1023; ka->out[i] = c < 512 ? bf2f(src[(size_t)R * (MK_DUMP_LD) + (c % (MK_DUMP_LD))]) : bf2f(src2[(size_t)R * (MK_DUMP_LD2) + (c % (MK_DUMP_LD2))]); }
    }
#else
    if (IN(PH_FINAL)) { KArgsP ka = KARGS();
        const float* rs = (const float*)(ka->ws + WS_RS) + (size_t)MK_RSIDX * TPR * 16; const float* gain = ka->in[22];
        int tl_ = threadIdx.x; asm volatile("" : "+v"(tl_));
        for (int i = bid * 512 + tl_; i < NREAL * 256; i += G * 512) {
            const int R = i >> 8, c4 = (i & 255) * 4;
            const float r = row_rstd(rs, R);
            const u32x2 hb = *(const u32x2*)((const bf16*)(ka->ws + WS_HB) + (size_t)R * DM + c4); const f32x4 gn = *(const f32x4*)(gain + c4);
            f32x4 v = {bf2f(hb.x & 0xffffu), bf2f(hb.x >> 16), bf2f(hb.y & 0xffffu), bf2f(hb.y >> 16)};
            v = v * r * gn;
            *(f32x4*)(ka->out + (size_t)R * DM + c4) = v;
        }
    }
#endif
#undef IN
#undef SEAM
}

extern "C" void kernel_launch(void* const* d_in, const int* in_sizes, int n_in, void* d_out, int out_size, void* d_ws, size_t ws_size, hipStream_t stream) {
    static int grid = 0;
    if (grid == 0) {
        if (n_in != 23 || out_size != NREAL * DM || ws_size < WS_END) { fprintf(stderr, "kernel_launch: unexpected shapes (n_in %d out %d ws %zu)\n", n_in, out_size, ws_size); grid = -1; return; }
        int dev = 0, cus = 0, per_cu = 0;
        hipGetDevice(&dev); hipDeviceGetAttribute(&cus, hipDeviceAttributeMultiprocessorCount, dev);
        if (hipFuncSetAttribute((const void*)fwd_kernel, hipFuncAttributeMaxDynamicSharedMemorySize, LDS_BYTES) != hipSuccess) { fprintf(stderr, "kernel_launch: hipFuncSetAttribute failed\n"); grid = -1; return; }
        if (hipOccupancyMaxActiveBlocksPerMultiprocessor(&per_cu, (const void*)fwd_kernel, 512, LDS_BYTES) != hipSuccess || per_cu < 1) { fprintf(stderr, "kernel_launch: occupancy query gave %d\n", per_cu); per_cu = 1; }
        (void)hipGetLastError();
        grid = cus * (per_cu > 1 ? 1 : per_cu);
        if (grid <= 0) grid = 256;
    }
    if (grid < 0) return;
    Args a{};
    for (int i = 0; i < 23; ++i) a.in[i] = (const float*)d_in[i];
    a.out = (float*)d_out; a.ws = (unsigned char*)d_ws;
#if MK_SPLIT
    for (int ph = 0; ph < NPHASE; ++ph) hipLaunchKernelGGL(fwd_kernel, dim3(grid), dim3(512), LDS_BYTES, stream, a, ph, ph + 1);
#else
    int lo = 0, hi = NPHASE;
    void* kargs[] = {(void*)&a, (void*)&lo, (void*)&hi};
    hipError_t e = hipLaunchCooperativeKernel((const void*)fwd_kernel, dim3(grid), dim3(512), kargs, LDS_BYTES, stream);
    if (e != hipSuccess) fprintf(stderr, "kernel_launch: cooperative launch failed: %s (grid %d)\n", hipGetErrorString(e), grid);
#endif
}
```

```cpp
#include <hip/hip_runtime.h>
#include <hip/hip_cooperative_groups.h>
#include <cstdio>
#include <cstdint>
namespace cg = cooperative_groups;
namespace pg8 {
#define PG8_LAS __attribute__((address_space(3)))
typedef unsigned short bf16_t;
typedef short bf16x8 __attribute__((ext_vector_type(8)));
typedef float f32x4 __attribute__((ext_vector_type(4)));
typedef unsigned u32x4 __attribute__((ext_vector_type(4)));
constexpr int BM = 256, BK = 64, HALF = 128, HTB = HALF * BK * 2  , STAGE_BYTES = 8 * HTB, NXCD = 8, WGM = 8;

__host__ __device__ __forceinline__ int lds_byte(int r, int c) { const int st = (r >> 4) * 2 + (c >> 5), rr = r & 15, cc = c & 31, ob = rr * 64 + cc * 2; return st * 1024 + (ob ^ (((ob >> 9) & 1) << 5)); }
__host__ __device__ __forceinline__ void stage_rc(int b, int& R, int& C) { const int st = b / 1024, sb = b % 1024, swz = sb ^ (((sb >> 9) & 1) << 5); R = (st >> 1) * 16 + swz / 64; C = (st & 1) * 32 + (swz % 64) / 2; }
__host__ __device__ __forceinline__ int perm32(int rho) { const int n = rho >> 4, i = rho & 15; return 8 * (i >> 2) + 4 * n + (i & 3); }

struct Unit { int pm, pn; };
struct Gemm { const bf16_t* A; const bf16_t* Bt; int M, N, K; };

struct StaticOrder {
    int nM, nN, nwg, G, c;
    __host__ __device__ void init(int M, int N, int G_, int c_) { nM = M / BM; nN = N / BM; nwg = nM * nN; G = G_; c = c_; }
    __host__ __device__ __forceinline__ bool next(int i, Unit& u) const {
        const long L = (long)i * G + c; if (L >= nwg) return false;
        int wgid = (int)L; { const int q = nwg / NXCD, r = nwg % NXCD, xcd = wgid % NXCD, off = wgid / NXCD; wgid = (xcd < r ? xcd * (q + 1) : r * (q + 1) + (xcd - r) * q) + off; }
        const int nig = WGM * nN, gid = wgid / nig, fm = gid * WGM, gsz = (nM - fm) < WGM ? (nM - fm) : WGM;
        u.pm = fm + ((wgid % nig) % gsz); u.pn = (wgid % nig) / gsz; return true;
    }
    __device__ __forceinline__ void a_ready(const Unit&) const {}
    __device__ __forceinline__ void done(const Unit&) const {}
};

__device__ __forceinline__ unsigned cvt_pk_bf16(float lo, float hi) { unsigned r; asm volatile("v_cvt_pk_bf16_f32 %0, %1, %2" : "=v"(r) : "v"(lo), "v"(hi)); return r; }
template <class Epi, class Sched, bool ALIGN_EPI = false, bool SP2 = false>
__device__ __forceinline__ void gemm_phase(PG8_LAS unsigned char* lds, const Gemm g, const Sched& S, const Epi& E) {
    int tid_l = threadIdx.x; asm volatile("" : "+v"(tid_l));
    const int tid = tid_l, wid = __builtin_amdgcn_readfirstlane(tid >> 6), lane = tid & 63, wr = wid >> 2, wc = wid & 3, fr = lane & 15, fq = lane >> 4;
    const int K = g.K, nt = K / BK;
    unsigned voffA[2], voffB[2];
#pragma unroll
    for (int i = 0; i < 2; ++i) { int R, C; stage_rc(tid * 16 + i * 8192, R, C); const int Rb = Epi::PERM ? ((R & ~31) + perm32(R & 31)) : R;
        voffA[i] = (unsigned)(R * K + C) * 2u; voffB[i] = (unsigned)(Rb * K + C) * 2u; }
    const size_t kstep = (size_t)(BK * 2);
    const size_t hstep = (size_t)HALF * K * 2;
    const size_t tstep = 2 * hstep;
    const unsigned ldsw = (unsigned)wid * 1024u;
    const int aoff = lds_byte(wr * 64 + fr, fq * 8), boff = lds_byte(wc * 32 + fr, fq * 8);
#define PG8_SA(b, h) (((b) * 2 + (h)) * HTB)
#define PG8_SB(b, h) ((4 + (b) * 2 + (h)) * HTB)
#define PG8_STAGE(bufoff, gbase, voff) do { _Pragma("unroll") for (int _i = 0; _i < 2; ++_i) \
        __builtin_amdgcn_global_load_lds((const unsigned*)((const char*)(gbase) + (voff)[_i]), (PG8_LAS unsigned*)(lds + (bufoff) + ldsw + _i * 8192), 16, 0, 0); } while (0)
#define PG8_LDA(dst, b, h) do { _Pragma("unroll") for (int m = 0; m < 4; ++m) _Pragma("unroll") for (int k = 0; k < 2; ++k) dst[m][k] = *(const PG8_LAS bf16x8*)(lds + PG8_SA(b, h) + aoff + m * 2048 + k * 1024); } while (0)
#define PG8_LDB(dst, b, h) do { _Pragma("unroll") for (int n = 0; n < 2; ++n) _Pragma("unroll") for (int k = 0; k < 2; ++k) dst[n][k] = *(const PG8_LAS bf16x8*)(lds + PG8_SB(b, h) + boff + n * 2048 + k * 1024); } while (0)
#define PG8_MMA(ai, bj, At, Bt) do { __builtin_amdgcn_s_setprio(1); _Pragma("unroll") for (int m = 0; m < 4; ++m) _Pragma("unroll") for (int n = 0; n < 2; ++n) _Pragma("unroll") for (int k = 0; k < 2; ++k) \
        acc[ai][bj][m][n] = __builtin_amdgcn_mfma_f32_16x16x32_bf16(Bt[n][k], At[m][k], acc[ai][bj][m][n], 0, 0, 0); __builtin_amdgcn_s_setprio(0); } while (0)
#define PG8_WAIT_V(n) asm volatile("s_waitcnt vmcnt(" #n ")" ::: "memory")
#define PG8_WAIT_L(n) asm volatile("s_waitcnt lgkmcnt(" #n ")" ::: "memory")
#define PG8_BAR __builtin_amdgcn_s_barrier()
#define PG8_SCHED __builtin_amdgcn_sched_barrier(0)
    Unit cur, nxt; int ui = 0;
    if (!S.next(0, cur)) return;
    f32x4 acc[2][2][4][2];
#pragma unroll
    for (int a = 0; a < 2; ++a)
#pragma unroll
        for (int b = 0; b < 2; ++b)
#pragma unroll
            for (int m = 0; m < 4; ++m)
#pragma unroll
                for (int n = 0; n < 2; ++n) acc[a][b][m][n] = (f32x4){0.f, 0.f, 0.f, 0.f};
    bf16x8 At[4][2], B0[2][2], B1[2][2];
    const char* cA = (const char*)g.A + (size_t)cur.pm * tstep; const char* cB = (const char*)g.Bt + (size_t)cur.pn * tstep;
    S.a_ready(cur);
    if constexpr (SP2) {
        PG8_STAGE(PG8_SB(0, 0), cB, voffB); PG8_STAGE(PG8_SB(0, 1), cB + hstep, voffB); PG8_STAGE(PG8_SA(0, 0), cA, voffA); PG8_STAGE(PG8_SA(0, 1), cA + hstep, voffA);
        if (wr == 1) PG8_BAR;
        PG8_WAIT_V(2); PG8_BAR;
        PG8_STAGE(PG8_SB(1, 0), cB + kstep, voffB); PG8_STAGE(PG8_SA(1, 0), cA + kstep, voffA); PG8_STAGE(PG8_SB(1, 1), cB + hstep + kstep, voffB);
        PG8_WAIT_V(6); PG8_BAR;
    } else {
        PG8_STAGE(PG8_SB(0, 0), cB, voffB); PG8_STAGE(PG8_SA(0, 0), cA, voffA); PG8_STAGE(PG8_SB(0, 1), cB + hstep, voffB); PG8_STAGE(PG8_SA(0, 1), cA + hstep, voffA);
        if (wr == 1) PG8_BAR;
        PG8_WAIT_V(4); PG8_BAR;
        PG8_STAGE(PG8_SB(1, 0), cB + kstep, voffB); PG8_STAGE(PG8_SA(1, 0), cA + kstep, voffA); PG8_STAGE(PG8_SB(1, 1), cB + hstep + kstep, voffB);
        PG8_WAIT_V(6); PG8_BAR;
    }
    for (;;) {
        const bool has_next = S.next(ui + 1, nxt);
        const char* nA = has_next ? (const char*)g.A + (size_t)nxt.pm * tstep : cA; const char* nB = has_next ? (const char*)g.Bt + (size_t)nxt.pn * tstep : cB;
        for (int t = 0; t < nt; t += 2) {
            const bool last = (t == nt - 2);
            const char* a1 = cA + (size_t)(t + 1) * kstep;
            const char* a2 = last ? nA : cA + (size_t)(t + 2) * kstep; const char* b2 = last ? nB : cB + (size_t)(t + 2) * kstep;
            const char* a3 = a2 + kstep; const char* b3 = b2 + kstep;
            if (last && has_next) S.a_ready(nxt);
            if constexpr (SP2) {
            PG8_LDB(B0, 0, 0); PG8_LDB(B1, 0, 1); PG8_SCHED; PG8_LDA(At, 0, 0); PG8_STAGE(PG8_SA(1, 1), a1 + hstep, voffA);
            PG8_WAIT_V(8); PG8_WAIT_L(0); PG8_BAR; PG8_MMA(0, 0, At, B0); PG8_MMA(0, 1, At, B1); PG8_BAR; PG8_SCHED;
            PG8_LDA(At, 0, 1); PG8_STAGE(PG8_SB(0, 0), b2, voffB); PG8_STAGE(PG8_SB(0, 1), b2 + hstep, voffB); PG8_STAGE(PG8_SA(0, 0), a2, voffA);
            PG8_WAIT_V(8); PG8_WAIT_L(0); PG8_BAR; PG8_MMA(1, 0, At, B0); PG8_MMA(1, 1, At, B1); PG8_BAR; PG8_SCHED;
            PG8_LDB(B0, 1, 0); PG8_LDB(B1, 1, 1); PG8_SCHED; PG8_LDA(At, 1, 0); PG8_STAGE(PG8_SA(0, 1), a2 + hstep, voffA);
            PG8_WAIT_V(8); PG8_WAIT_L(0); PG8_BAR; PG8_MMA(0, 0, At, B0); PG8_MMA(0, 1, At, B1); PG8_BAR; PG8_SCHED;
            PG8_LDA(At, 1, 1); PG8_STAGE(PG8_SB(1, 0), b3, voffB); PG8_STAGE(PG8_SB(1, 1), b3 + hstep, voffB); PG8_STAGE(PG8_SA(1, 0), a3, voffA);
            PG8_WAIT_V(8); PG8_WAIT_L(0); PG8_BAR; PG8_MMA(1, 0, At, B0); PG8_MMA(1, 1, At, B1); PG8_BAR; PG8_SCHED;
            } else {
            PG8_LDB(B0, 0, 0); PG8_SCHED; PG8_LDA(At, 0, 0); PG8_STAGE(PG8_SA(1, 1), a1 + hstep, voffA);
            PG8_WAIT_L(8); PG8_BAR; PG8_WAIT_L(0); PG8_MMA(0, 0, At, B0); PG8_BAR; PG8_SCHED;
            PG8_LDB(B1, 0, 1); PG8_STAGE(PG8_SB(0, 0), b2, voffB);
            PG8_BAR; PG8_WAIT_L(0); PG8_MMA(0, 1, At, B1); PG8_BAR;
            PG8_LDA(At, 0, 1); PG8_STAGE(PG8_SA(0, 0), a2, voffA);
            PG8_BAR; PG8_WAIT_L(0); PG8_MMA(1, 0, At, B0); PG8_BAR; PG8_SCHED;
            PG8_STAGE(PG8_SB(0, 1), b2 + hstep, voffB);
            PG8_WAIT_V(6); PG8_BAR; PG8_MMA(1, 1, At, B1); PG8_BAR;
            PG8_LDB(B0, 1, 0); PG8_SCHED; PG8_LDA(At, 1, 0); PG8_STAGE(PG8_SA(0, 1), a2 + hstep, voffA);
            PG8_WAIT_L(8); PG8_BAR; PG8_WAIT_L(0); PG8_MMA(0, 0, At, B0); PG8_BAR; PG8_SCHED;
            PG8_LDB(B1, 1, 1); PG8_STAGE(PG8_SB(1, 0), b3, voffB);
            PG8_BAR; PG8_WAIT_L(0); PG8_MMA(0, 1, At, B1); PG8_BAR;
            PG8_LDA(At, 1, 1); PG8_STAGE(PG8_SA(1, 0), a3, voffA);
            PG8_BAR; PG8_WAIT_L(0); PG8_MMA(1, 0, At, B0); PG8_BAR; PG8_SCHED;
            PG8_STAGE(PG8_SB(1, 1), b3 + hstep, voffB);
            PG8_WAIT_V(6); PG8_BAR; PG8_MMA(1, 1, At, B1); PG8_BAR;
            }
        }
        if constexpr (ALIGN_EPI) { if (wr == 0) PG8_BAR; }
        asm volatile("s_nop 15\n\ts_nop 15" ::: "memory");
        if constexpr (!Epi::AFTER_DRAIN) { E(acc, cur, wr, wc, fr, fq); S.done(cur); }
        if (!has_next) break;
#pragma unroll
        for (int a = 0; a < 2; ++a)
#pragma unroll
            for (int b = 0; b < 2; ++b)
#pragma unroll
                for (int m = 0; m < 4; ++m)
#pragma unroll
                    for (int n = 0; n < 2; ++n) acc[a][b][m][n] = (f32x4){0.f, 0.f, 0.f, 0.f};
        cur = nxt; cA = nA; cB = nB; ++ui;
        if constexpr (ALIGN_EPI) { if (wr == 1) PG8_BAR; }
    }
    PG8_WAIT_V(0);
    if constexpr (!ALIGN_EPI) { if (wr == 0) PG8_BAR; }
    PG8_BAR;
    if constexpr (Epi::AFTER_DRAIN) { E.fused(acc, cur, wr, wc, fr, fq, lds, wid, lane); S.done(cur); }
#undef PG8_SA
#undef PG8_SB
#undef PG8_STAGE
#undef PG8_LDA
#undef PG8_LDB
#undef PG8_MMA
#undef PG8_WAIT_V
#undef PG8_WAIT_L
#undef PG8_BAR
#undef PG8_SCHED
}
}

#define LAS __attribute__((address_space(3)))
typedef unsigned short bf16;
typedef short bf16x8 __attribute__((ext_vector_type(8)));
typedef float f32x4 __attribute__((ext_vector_type(4)));
typedef float f32x16 __attribute__((ext_vector_type(16)));
typedef unsigned u32x2 __attribute__((ext_vector_type(2)));
typedef unsigned u32x4 __attribute__((ext_vector_type(4)));

constexpr int NB = 8, SEQ = 2048, NMETA = 16, LL = 2064, DM = 1024, FF = 4096, DIN = 4864, NPROJ = 1792;
constexpr int NREAL = NB * SEQ;
constexpr int TPR = NREAL + 256;
constexpr int LDS_BYTES = 147456;

constexpr size_t MiB = 1u << 20;
constexpr size_t WS_CTL = 0;
constexpr size_t WS_ROPE = 1 * MiB;
constexpr size_t WS_ABAR = 2 * MiB;
constexpr size_t WS_BMAT = 2 * MiB + 65536;
constexpr size_t WS_CMAT = WS_BMAT + 524288;
constexpr size_t WS_HM = 4 * MiB;
constexpr size_t WS_W = 5 * MiB;
constexpr size_t OW_IN = 0, OW_GLU = (size_t)DIN * DM * 2, OW_POOL = OW_GLU + 512 * 512 * 2, OW_BR = OW_POOL + 512 * 512 * 2,
                 OW_OUT = OW_BR + 3 * 1024 * 512 * 2, OW_UP = OW_OUT + 1024 * 1024 * 2, OW_DN = OW_UP + (size_t)FF * DM * 2, LW_BYTES = OW_DN + (size_t)FF * DM * 2;
constexpr size_t WS_HB = 68 * MiB;
constexpr size_t WS_X = 101 * MiB;
constexpr size_t UU = (size_t)TPR * 512 * 2;
constexpr size_t WS_YF = WS_X, WS_YP = WS_X, WS_Q = WS_X + 2 * UU, WS_K = WS_Q + UU, WS_V = WS_K + UU / 4, WS_MG = WS_X + 2 * UU,
                 WS_SU = WS_X + 4 * UU, WS_YA = WS_X + 8 * UU  , WS_PU = WS_X + 5 * UU, WS_YS = WS_PU, WS_Z = WS_X + 6 * UU, WS_PD = WS_X + 7 * UU, WS_BR = WS_Z, WS_ACT = WS_X;
constexpr size_t WS_RS = WS_X + 9 * UU;
constexpr size_t WS_END = WS_RS + (size_t)5 * TPR * 16 * 4;
static_assert(WS_W + 2 * LW_BYTES <= WS_HB && WS_HB + (size_t)TPR * 1024 * 2 <= WS_X && WS_END <= 256 * MiB, "ws map");
static_assert((size_t)256 * 2064 * 16 * 4 <= 2 * UU, "YF fits");

__device__ __forceinline__ unsigned pk2(float lo, float hi) { unsigned r; asm("v_cvt_pk_bf16_f32 %0, %1, %2" : "=v"(r) : "v"(lo), "v"(hi)); return r; }
__device__ __forceinline__ unsigned f2bf(float f) { return pk2(f, 0.f) & 0xffffu; }
__device__ __forceinline__ float bf2f(unsigned b) { return __uint_as_float(b << 16); }
__device__ __forceinline__ int tok_row(int b, int l) { return l >= NMETA ? b * SEQ + l - NMETA : NREAL + b * NMETA + l; }
#define LDS_FENCE() asm volatile("s_waitcnt lgkmcnt(0)" ::: "memory")
#define SSM_SYNC() do { asm volatile("s_waitcnt vmcnt(0) lgkmcnt(0)" ::: "memory"); __syncthreads(); } while (0)
__device__ __forceinline__ float row_rstd(const float* rs, int R) {
    const f32x4 a = *(const f32x4*)(rs + (size_t)R * 4), b = *(const f32x4*)(rs + ((size_t)TPR + R) * 4), c = *(const f32x4*)(rs + ((size_t)2 * TPR + R) * 4), d = *(const f32x4*)(rs + ((size_t)3 * TPR + R) * 4);
    const float s = (((a[0] + a[1]) + (a[2] + a[3])) + ((b[0] + b[1]) + (b[2] + b[3]))) + (((c[0] + c[1]) + (c[2] + c[3])) + ((d[0] + d[1]) + (d[2] + d[3])));
    return rsqrtf(s * (1.0f / 1024.0f) + 1e-6f);
}

__device__ __forceinline__ void dsincos(double a, double& s, double& c) {
    const double q = rint(a * 0.63661977236758134308);
    double r = fma(-q, 1.57079632679489655800e+00, a); r = fma(-q, 6.12323399573676603587e-17, r);
    const double r2 = r * r;
    double sp = -7.6471637318198164759e-13; sp = fma(sp, r2, 1.6059043836821614599e-10); sp = fma(sp, r2, -2.5052108385441718775e-08); sp = fma(sp, r2, 2.7557319223985890653e-06);
    sp = fma(sp, r2, -1.9841269841269841270e-04); sp = fma(sp, r2, 8.3333333333333333333e-03); sp = fma(sp, r2, -1.6666666666666666667e-01); sp = fma(sp * r2, r, r);
    double cp = 4.7794773323873852974e-14; cp = fma(cp, r2, -1.1470745597729724714e-11); cp = fma(cp, r2, 2.0876756987868098979e-09); cp = fma(cp, r2, -2.7557319223985890653e-07);
    cp = fma(cp, r2, 2.4801587301587301587e-05); cp = fma(cp, r2, -1.3888888888888888889e-03); cp = fma(cp, r2, 4.1666666666666666667e-02); cp = fma(cp, r2, -0.5); cp = fma(cp, r2, 1.0);
    const int qi = ((int)q) & 3;
    s = (qi == 0) ? sp : (qi == 1) ? cp : (qi == 2) ? -sp : -cp;
    c = (qi == 0) ? cp : (qi == 1) ? -sp : (qi == 2) ? -cp : sp;
}
__device__ __forceinline__ double dexp(double x) {
    const double k = rint(x * 1.44269504088896340736);
    double r = fma(-k, 6.93147180369123816490e-01, x); r = fma(-k, 1.90821492927058770002e-10, r);
    double p = 1.0 / 6227020800.0; p = fma(p, r, 1.0 / 479001600.0); p = fma(p, r, 1.0 / 39916800.0); p = fma(p, r, 1.0 / 3628800.0); p = fma(p, r, 1.0 / 362880.0); p = fma(p, r, 1.0 / 40320.0);
    p = fma(p, r, 1.0 / 5040.0); p = fma(p, r, 1.0 / 720.0); p = fma(p, r, 1.0 / 120.0); p = fma(p, r, 1.0 / 24.0); p = fma(p, r, 1.0 / 6.0); p = fma(p, r, 0.5); p = fma(p, r, 1.0); p = fma(p, r, 1.0);
    const long long bits = ((long long)(1023 + (int)k)) << 52;
    return p * __longlong_as_double(bits);
}

struct EpiInProj {
    static constexpr bool PERM = true, AFTER_DRAIN = false;
    const float* rowss; const float* rope; bf16 *Q, *K, *V, *SU, *PU;
    __device__ __forceinline__ u32x2 quad(int l, int c, const f32x4& v) const {
        u32x2 w;
        if (c < 640) {
            const int i0 = (c & 63) >> 1;
            const f32x4 cs = *(const f32x4*)(rope + ((size_t)l * 32 + i0) * 2);
            float o0 = v[0] * cs[0] - v[1] * cs[1], o1 = v[1] * cs[0] + v[0] * cs[1], o2 = v[2] * cs[2] - v[3] * cs[3], o3 = v[3] * cs[2] + v[2] * cs[3];
            if (c < 512) { o0 *= 0.125f; o1 *= 0.125f; o2 *= 0.125f; o3 *= 0.125f; }
            w.x = pk2(o0, o1); w.y = pk2(o2, o3);
        } else { w.x = pk2(v[0], v[1]); w.y = pk2(v[2], v[3]); }
        return w;
    }
    __device__ __forceinline__ void operator()(const f32x4 (&acc)[2][2][4][2], const pg8::Unit& u, int wr, int wc, int fr, int fq) const {
#pragma unroll
        for (int ai = 0; ai < 2; ++ai)
#pragma unroll
            for (int m = 0; m < 4; ++m) {
                const int R = u.pm * 256 + ai * 128 + wr * 64 + m * 16 + fr;
                const float rs = row_rstd(rowss, R);
                const int l = R < NREAL ? (R & 2047) + NMETA : (R & 15);
#pragma unroll
                for (int bj = 0; bj < 2; ++bj) {
                    const int c = u.pn * 256 + bj * 128 + wc * 32 + 8 * fq;
                    const u32x2 w0 = quad(l, c, acc[ai][bj][m][0] * rs), w1 = quad(l, c + 4, acc[ai][bj][m][1] * rs);
                    u32x4 w; w.x = w0.x; w.y = w0.y; w.z = w1.x; w.w = w1.y;
                    bf16* dst = c < 512 ? Q + (size_t)R * 512 + c : c < 640 ? K + (size_t)R * 128 + (c - 512) : c < 768 ? V + (size_t)R * 128 + (c - 640)
                              : c < 1280 ? SU + (size_t)R * 512 + (c - 768) : PU + (size_t)R * 512 + (c - 1280);
                    *(u32x4*)dst = w;
                }
            }
    }
};
#define EPI_BODY() \
    __device__ __forceinline__ void rg(int R, int pn, int wc, int fq, const f32x4 (&a4)[2][2]) const { \
        _Pragma("unroll") for (int bj = 0; bj < 2; ++bj) q2(R, pn * 256 + bj * 128 + wc * 32 + 8 * fq, a4[bj][0], a4[bj][1]); } \
    __device__ __forceinline__ void tq(int R, int c, const f32x4& v) const { q(R, c, v); } \
    EPI_OP()
#define EPI_OP() \
    __device__ __forceinline__ void operator()(const f32x4 (&acc)[2][2][4][2], const pg8::Unit& u, int wr, int wc, int fr, int fq) const { \
        _Pragma("unroll") for (int ai = 0; ai < 2; ++ai) _Pragma("unroll") for (int m = 0; m < 4; ++m) { \
            const f32x4 a4[2][2] = {{acc[ai][0][m][0], acc[ai][0][m][1]}, {acc[ai][1][m][0], acc[ai][1][m][1]}}; \
            rg(u.pm * 256 + ai * 128 + wr * 64 + m * 16 + fr, u.pn, wc, fq, a4); } }
#define EPI_BODY_RS() \
    __device__ __forceinline__ void rg(int R, int pn, int wc, int fq, const f32x4 (&a4)[2][2]) const { const float rs = row_rstd(rowss, R); \
        _Pragma("unroll") for (int bj = 0; bj < 2; ++bj) q2(R, pn * 256 + bj * 128 + wc * 32 + 8 * fq, a4[bj][0], a4[bj][1], rs); } \
    __device__ __forceinline__ void tq(int R, int c, const f32x4& v) const { q(R, c, v, row_rstd(rowss, R)); } \
    EPI_OP()
struct EpiGlu {
    static constexpr bool PERM = true, AFTER_DRAIN = false;
    const bf16* Z; const float* bias; bf16* YS;
    __device__ __forceinline__ void q(int R, int c, const f32x4& a) const {
        const f32x4 v = a + *(const f32x4*)(bias + c);
        const u32x2 zz = *(const u32x2*)(Z + (size_t)R * 512 + c);
        const float z0 = bf2f(zz.x & 0xffffu), z1 = bf2f(zz.x >> 16), z2 = bf2f(zz.y & 0xffffu), z3 = bf2f(zz.y >> 16);
        u32x2 w; w.x = pk2(z0 * __builtin_amdgcn_rcpf(1.0f + __expf(-v[0])), z1 * __builtin_amdgcn_rcpf(1.0f + __expf(-v[1]))); w.y = pk2(z2 * __builtin_amdgcn_rcpf(1.0f + __expf(-v[2])), z3 * __builtin_amdgcn_rcpf(1.0f + __expf(-v[3])));
        *(u32x2*)(YS + (size_t)R * 512 + c) = w;
    }
    __device__ __forceinline__ void q2(int R, int c, const f32x4& a0, const f32x4& a1) const {
        const f32x4 v0 = a0 + *(const f32x4*)(bias + c), v1 = a1 + *(const f32x4*)(bias + c + 4);
        const u32x4 zz = *(const u32x4*)(Z + (size_t)R * 512 + c);
        u32x4 w;
        w.x = pk2(bf2f(zz.x & 0xffffu) * __builtin_amdgcn_rcpf(1.0f + __expf(-v0[0])), bf2f(zz.x >> 16) * __builtin_amdgcn_rcpf(1.0f + __expf(-v0[1])));
        w.y = pk2(bf2f(zz.y & 0xffffu) * __builtin_amdgcn_rcpf(1.0f + __expf(-v0[2])), bf2f(zz.y >> 16) * __builtin_amdgcn_rcpf(1.0f + __expf(-v0[3])));
        w.z = pk2(bf2f(zz.z & 0xffffu) * __builtin_amdgcn_rcpf(1.0f + __expf(-v1[0])), bf2f(zz.z >> 16) * __builtin_amdgcn_rcpf(1.0f + __expf(-v1[1])));
        w.w = pk2(bf2f(zz.w & 0xffffu) * __builtin_amdgcn_rcpf(1.0f + __expf(-v1[2])), bf2f(zz.w >> 16) * __builtin_amdgcn_rcpf(1.0f + __expf(-v1[3])));
        *(u32x4*)(YS + (size_t)R * 512 + c) = w;
    }
    EPI_BODY()
};
struct EpiScale {
    static constexpr bool PERM = true, AFTER_DRAIN = false;
    bf16* O; int ldc; const float* scale;
    __device__ __forceinline__ void q(int R, int c, const f32x4& a) const {
        f32x4 v = a;
        if (scale) v = v * *(const f32x4*)(scale + c);
        u32x2 w; w.x = pk2(v[0], v[1]); w.y = pk2(v[2], v[3]);
        *(u32x2*)(O + (size_t)R * ldc + c) = w;
    }
    __device__ __forceinline__ void q2(int R, int c, const f32x4& a0, const f32x4& a1) const {
        f32x4 v0 = a0, v1 = a1;
        if (scale) { v0 = v0 * *(const f32x4*)(scale + c); v1 = v1 * *(const f32x4*)(scale + c + 4); }
        u32x4 w; w.x = pk2(v0[0], v0[1]); w.y = pk2(v0[2], v0[3]); w.z = pk2(v1[0], v1[1]); w.w = pk2(v1[2], v1[3]);
        *(u32x4*)(O + (size_t)R * ldc + c) = w;
    }
    EPI_BODY()
};
template <bool FIRST> struct EpiGate {
    static constexpr bool PERM = true, AFTER_DRAIN = false;
    const float* rowss; const bf16* BR; bf16* MG;
    __device__ __forceinline__ void q(int R, int c, const f32x4& a, float rs) const {
        const f32x4 v = a * rs;
        const u32x2 bb = *(const u32x2*)(BR + (size_t)R * 1024 + c);
        float o0 = bf2f(bb.x & 0xffffu) * __builtin_amdgcn_rcpf(1.0f + __expf(-v[0])), o1 = bf2f(bb.x >> 16) * __builtin_amdgcn_rcpf(1.0f + __expf(-v[1]));
        float o2 = bf2f(bb.y & 0xffffu) * __builtin_amdgcn_rcpf(1.0f + __expf(-v[2])), o3 = bf2f(bb.y >> 16) * __builtin_amdgcn_rcpf(1.0f + __expf(-v[3]));
        if (!FIRST) { const u32x2 mm = *(const u32x2*)(MG + (size_t)R * 1024 + c);
            o0 += bf2f(mm.x & 0xffffu); o1 += bf2f(mm.x >> 16); o2 += bf2f(mm.y & 0xffffu); o3 += bf2f(mm.y >> 16); }
        u32x2 w; w.x = pk2(o0, o1); w.y = pk2(o2, o3);
        *(u32x2*)(MG + (size_t)R * 1024 + c) = w;
    }
    __device__ __forceinline__ void q2(int R, int c, const f32x4& a0, const f32x4& a1, float rs) const {
        const f32x4 v0 = a0 * rs, v1 = a1 * rs;
        const u32x4 bb = *(const u32x4*)(BR + (size_t)R * 1024 + c);
        float o[8];
        o[0] = bf2f(bb.x & 0xffffu) * __builtin_amdgcn_rcpf(1.0f + __expf(-v0[0])); o[1] = bf2f(bb.x >> 16) * __builtin_amdgcn_rcpf(1.0f + __expf(-v0[1]));
        o[2] = bf2f(bb.y & 0xffffu) * __builtin_amdgcn_rcpf(1.0f + __expf(-v0[2])); o[3] = bf2f(bb.y >> 16) * __builtin_amdgcn_rcpf(1.0f + __expf(-v0[3]));
        o[4] = bf2f(bb.z & 0xffffu) * __builtin_amdgcn_rcpf(1.0f + __expf(-v1[0])); o[5] = bf2f(bb.z >> 16) * __builtin_amdgcn_rcpf(1.0f + __expf(-v1[1]));
        o[6] = bf2f(bb.w & 0xffffu) * __builtin_amdgcn_rcpf(1.0f + __expf(-v1[2])); o[7] = bf2f(bb.w >> 16) * __builtin_amdgcn_rcpf(1.0f + __expf(-v1[3]));
        if (!FIRST) { const u32x4 mm = *(const u32x4*)(MG + (size_t)R * 1024 + c);
            o[0] += bf2f(mm.x & 0xffffu); o[1] += bf2f(mm.x >> 16); o[2] += bf2f(mm.y & 0xffffu); o[3] += bf2f(mm.y >> 16);
            o[4] += bf2f(mm.z & 0xffffu); o[5] += bf2f(mm.z >> 16); o[6] += bf2f(mm.w & 0xffffu); o[7] += bf2f(mm.w >> 16); }
        u32x4 w; w.x = pk2(o[0], o[1]); w.y = pk2(o[2], o[3]); w.z = pk2(o[4], o[5]); w.w = pk2(o[6], o[7]);
        *(u32x4*)(MG + (size_t)R * 1024 + c) = w;
    }
    EPI_BODY_RS()
};
struct EpiRes {
    static constexpr bool PERM = true, AFTER_DRAIN = false;
    const float* Xin; bf16* HB; float* rowss_out;
    __device__ __forceinline__ float q(int R, int c, const f32x4& a) const {
        f32x4 h;
        if (Xin && R < NREAL) h = *(const f32x4*)(Xin + (size_t)R * 1024 + c);
        else { const u32x2 hb = *(const u32x2*)(HB + (size_t)R * 1024 + c); h = (f32x4){bf2f(hb.x & 0xffffu), bf2f(hb.x >> 16), bf2f(hb.y & 0xffffu), bf2f(hb.y >> 16)}; }
        h = h + a;
        u32x2 w; w.x = pk2(h[0], h[1]); w.y = pk2(h[2], h[3]);
        *(u32x2*)(HB + (size_t)R * 1024 + c) = w;
        const float r0 = bf2f(w.x & 0xffffu), r1 = bf2f(w.x >> 16), r2 = bf2f(w.y & 0xffffu), r3 = bf2f(w.y >> 16);
        return (r0 * r0 + r1 * r1) + (r2 * r2 + r3 * r3);
    }
    __device__ __forceinline__ float q2(int R, int c, const f32x4& a0, const f32x4& a1) const {
        f32x4 h0, h1;
        if (Xin && R < NREAL) { h0 = *(const f32x4*)(Xin + (size_t)R * 1024 + c); h1 = *(const f32x4*)(Xin + (size_t)R * 1024 + c + 4); }
        else { const u32x4 hb = *(const u32x4*)(HB + (size_t)R * 1024 + c);
            h0 = (f32x4){bf2f(hb.x & 0xffffu), bf2f(hb.x >> 16), bf2f(hb.y & 0xffffu), bf2f(hb.y >> 16)}; h1 = (f32x4){bf2f(hb.z & 0xffffu), bf2f(hb.z >> 16), bf2f(hb.w & 0xffffu), bf2f(hb.w >> 16)}; }
        h0 = h0 + a0; h1 = h1 + a1;
        u32x4 w; w.x = pk2(h0[0], h0[1]); w.y = pk2(h0[2], h0[3]); w.z = pk2(h1[0], h1[1]); w.w = pk2(h1[2], h1[3]);
        *(u32x4*)(HB + (size_t)R * 1024 + c) = w;
        const float r0 = bf2f(w.x & 0xffffu), r1 = bf2f(w.x >> 16), r2 = bf2f(w.y & 0xffffu), r3 = bf2f(w.y >> 16), r4 = bf2f(w.z & 0xffffu), r5 = bf2f(w.z >> 16), r6 = bf2f(w.w & 0xffffu), r7 = bf2f(w.w >> 16);
        return ((r0 * r0 + r1 * r1) + (r2 * r2 + r3 * r3)) + ((r4 * r4 + r5 * r5) + (r6 * r6 + r7 * r7));
    }
    __device__ __forceinline__ void rg(int R, int pn, int wc, int fq, const f32x4 (&a4)[2][2]) const {
        float ss = 0.f;
#pragma unroll
        for (int bj = 0; bj < 2; ++bj) ss += q2(R, pn * 256 + bj * 128 + wc * 32 + 8 * fq, a4[bj][0], a4[bj][1]);
        ss += __shfl_xor(ss, 16); ss += __shfl_xor(ss, 32);
        if (fq == 0) rowss_out[((size_t)pn * TPR + R) * 4 + wc] = ss;
    }
    __device__ __forceinline__ void tq(int R, int c, const f32x4& v) const {
        float ss = q(R, c, v);
        ss += __shfl_xor(ss, 16); ss += __shfl_xor(ss, 32);
        if ((threadIdx.x & 48) == 0) atomicAdd(rowss_out + (size_t)R * 4, ss);
    }
    EPI_OP()
};
struct EpiUp {
    static constexpr bool PERM = true, AFTER_DRAIN = false;
    const float* rowss; bf16* ACT;
    __device__ __forceinline__ void q(int R, int c, const f32x4& a, float rs) const {
        f32x4 v = a * rs;
#pragma unroll
        for (int j = 0; j < 4; ++j) { const float r = fmaxf(v[j], 0.f); v[j] = r * r; }
        u32x2 w; w.x = pk2(v[0], v[1]); w.y = pk2(v[2], v[3]);
        *(u32x2*)(ACT + (size_t)R * FF + c) = w;
    }
    __device__ __forceinline__ void q2(int R, int c, const f32x4& a0, const f32x4& a1, float rs) const {
        f32x4 v0 = a0 * rs, v1 = a1 * rs;
#pragma unroll
        for (int j = 0; j < 4; ++j) { const float r0 = fmaxf(v0[j], 0.f), r1 = fmaxf(v1[j], 0.f); v0[j] = r0 * r0; v1[j] = r1 * r1; }
        u32x4 w; w.x = pk2(v0[0], v0[1]); w.y = pk2(v0[2], v0[3]); w.z = pk2(v1[0], v1[1]); w.w = pk2(v1[2], v1[3]);
        *(u32x4*)(ACT + (size_t)R * FF + c) = w;
    }
    EPI_BODY_RS()
};
struct TripleOrder {
    pg8::StaticOrder S0; int arow, bcol;
    __device__ __forceinline__ void init(int G, int c, int arow_, int bcol_) { S0.init(NREAL, 1024, G, c); arow = arow_; bcol = bcol_; }
    __device__ __forceinline__ bool next(int i, pg8::Unit& u) const { pg8::Unit t; t.pm = 0; t.pn = 0; if (!S0.next(i / 3, t)) return false; const int br = i % 3; u.pm = t.pm + br * arow; u.pn = t.pn + br * bcol; return true; }
    __device__ __forceinline__ void a_ready(const pg8::Unit&) const {}
    __device__ __forceinline__ void done(const pg8::Unit&) const {}
};
struct EpiBr3 {
    static constexpr bool PERM = true, AFTER_DRAIN = false;
    bf16* Bbase; int arow;
    __device__ __forceinline__ void operator()(const f32x4 (&acc)[2][2][4][2], const pg8::Unit& u, int wr, int wc, int fr, int fq) const {
        const int c = u.pn >> 2, pn = u.pn & 3, pm = u.pm - arow * c; bf16* O = Bbase + (size_t)(2 * c + 2 * (c > 0)) * (UU / 2);
#pragma unroll
        for (int ai = 0; ai < 2; ++ai)
#pragma unroll
            for (int m = 0; m < 4; ++m) { const int R = pm * 256 + ai * 128 + wr * 64 + m * 16 + fr;
#pragma unroll
                for (int bj = 0; bj < 2; ++bj) { const f32x4 v0 = acc[ai][bj][m][0], v1 = acc[ai][bj][m][1];
                    u32x4 w; w.x = pk2(v0[0], v0[1]); w.y = pk2(v0[2], v0[3]); w.z = pk2(v1[0], v1[1]); w.w = pk2(v1[2], v1[3]);
                    *(u32x4*)(O + (size_t)R * 1024 + pn * 256 + bj * 128 + wc * 32 + 8 * fq) = w; } }
    }
};
struct EpiGate3 {
    static constexpr bool PERM = true, AFTER_DRAIN = false;
    const float* rowss; const bf16* Bbase; bf16* MG;
    __device__ __forceinline__ void operator()(const f32x4 (&acc)[2][2][4][2], const pg8::Unit& u, int wr, int wc, int fr, int fq) const {
        const int c = u.pn >> 2, pn = u.pn & 3; const bf16* BR = Bbase + (size_t)(2 * c + 2 * (c > 0)) * (UU / 2);
#pragma unroll
        for (int ai = 0; ai < 2; ++ai)
#pragma unroll
            for (int m = 0; m < 4; ++m) { const int R = u.pm * 256 + ai * 128 + wr * 64 + m * 16 + fr; const float rs = row_rstd(rowss, R);
#pragma unroll
                for (int bj = 0; bj < 2; ++bj) { const int cc = pn * 256 + bj * 128 + wc * 32 + 8 * fq;
                    const f32x4 v0 = acc[ai][bj][m][0] * rs, v1 = acc[ai][bj][m][1] * rs;
                    const u32x4 bb = *(const u32x4*)(BR + (size_t)R * 1024 + cc);
                    float o[8];
                    o[0] = bf2f(bb.x & 0xffffu) * __builtin_amdgcn_rcpf(1.0f + __expf(-v0[0])); o[1] = bf2f(bb.x >> 16) * __builtin_amdgcn_rcpf(1.0f + __expf(-v0[1]));
                    o[2] = bf2f(bb.y & 0xffffu) * __builtin_amdgcn_rcpf(1.0f + __expf(-v0[2])); o[3] = bf2f(bb.y >> 16) * __builtin_amdgcn_rcpf(1.0f + __expf(-v0[3]));
                    o[4] = bf2f(bb.z & 0xffffu) * __builtin_amdgcn_rcpf(1.0f + __expf(-v1[0])); o[5] = bf2f(bb.z >> 16) * __builtin_amdgcn_rcpf(1.0f + __expf(-v1[1]));
                    o[6] = bf2f(bb.w & 0xffffu) * __builtin_amdgcn_rcpf(1.0f + __expf(-v1[2])); o[7] = bf2f(bb.w >> 16) * __builtin_amdgcn_rcpf(1.0f + __expf(-v1[3]));
                    if (c != 0) { const u32x4 mm = *(const u32x4*)(MG + (size_t)R * 1024 + cc);
                        o[0] += bf2f(mm.x & 0xffffu); o[1] += bf2f(mm.x >> 16); o[2] += bf2f(mm.y & 0xffffu); o[3] += bf2f(mm.y >> 16);
                        o[4] += bf2f(mm.z & 0xffffu); o[5] += bf2f(mm.z >> 16); o[6] += bf2f(mm.w & 0xffffu); o[7] += bf2f(mm.w >> 16); }
                    u32x4 w; w.x = pk2(o[0], o[1]); w.y = pk2(o[2], o[3]); w.z = pk2(o[4], o[5]); w.w = pk2(o[6], o[7]);
                    *(u32x4*)(MG + (size_t)R * 1024 + cc) = w; } }
    }
};
template <class Epi>
__device__ __forceinline__ void thin_gemm(LAS unsigned char* lds, const bf16* A, const bf16* Bt, int K, int N, const Epi& E, int vb, int vg) {
    int tid_l = threadIdx.x; asm volatile("" : "+v"(tid_l));
    const int lane = tid_l & 63, w = __builtin_amdgcn_readfirstlane(tid_l >> 6), fr = lane & 15, fq = lane >> 4;
    LAS f32x4* red = (LAS f32x4*)lds;
    const int kw = K >> 3;
    for (int pc = vb; pc < N / 16; pc += vg) {
        const bf16* ap = A + (size_t)(NREAL + fr) * K + w * kw + 8 * fq;
        const bf16* bp = Bt + (size_t)(16 * pc + fr) * K + w * kw + 8 * fq;
        f32x4 acc[8];
#pragma unroll
        for (int rb = 0; rb < 8; ++rb) acc[rb] = (f32x4){0.f, 0.f, 0.f, 0.f};
#pragma unroll 2
        for (int k0 = 0; k0 < kw; k0 += 32) {
            const bf16x8 bf = *(const bf16x8*)(bp + k0);
            bf16x8 af[8];
#pragma unroll
            for (int rb = 0; rb < 8; ++rb) af[rb] = *(const bf16x8*)(ap + (size_t)(16 * rb) * K + k0);
#pragma unroll
            for (int rb = 0; rb < 8; ++rb) acc[rb] = __builtin_amdgcn_mfma_f32_16x16x32_bf16(bf, af[rb], acc[rb], 0, 0, 0);
        }
        asm volatile("s_nop 15\n\ts_nop 15" : "+v"(acc[0]), "+v"(acc[1]), "+v"(acc[2]), "+v"(acc[3]), "+v"(acc[4]), "+v"(acc[5]), "+v"(acc[6]), "+v"(acc[7]));
#pragma unroll
        for (int rb = 0; rb < 8; ++rb) red[(w * 8 + rb) * 64 + lane] = acc[rb];
        LDS_FENCE(); __syncthreads();
        f32x4 v = red[(0 * 8 + w) * 64 + lane];
#pragma unroll
        for (int ww = 1; ww < 8; ++ww) v = v + red[(ww * 8 + w) * 64 + lane];
        LDS_FENCE(); __syncthreads();
        E.tq(NREAL + 16 * w + fr, 16 * pc + 4 * fq, v);
    }
}

struct Args { const float* in[23]; float* out; unsigned char* ws; };

__device__ __forceinline__ void p0_item(const float* W, int ldw, int K, const float* scale, bf16* WT, int permrows, LAS float* scr, int item, int nblk, int lane) {
    const int kb = item / nblk, nb = item % nblk, k0 = 64 * kb, n0 = 64 * nb;
#pragma unroll 4
    for (int i = 0; i < 16; ++i) {
        const int kk = 4 * i + (lane >> 4), c4 = (lane & 15) * 4;
        f32x4 w = *(const f32x4*)(W + (size_t)(k0 + kk) * ldw + n0 + c4);
        if (scale) w = w * scale[k0 + kk];
        scr[kk * 65 + c4] = w[0]; scr[kk * 65 + c4 + 1] = w[1]; scr[kk * 65 + c4 + 2] = w[2]; scr[kk * 65 + c4 + 3] = w[3];
    }
    LDS_FENCE();
    const int c = lane & 7;
#pragma unroll
    for (int j = 0; j < 8; ++j) {
        const int n = (lane >> 3) + 8 * j;
        const int sc = (n0 + n) < permrows ? ((n & 1) ? 32 + (n >> 1) : (n >> 1)) : n;
        const LAS float* s = scr + (8 * c) * 65 + sc;
        u32x4 o; o.x = pk2(s[0 * 65], s[1 * 65]); o.y = pk2(s[2 * 65], s[3 * 65]); o.z = pk2(s[4 * 65], s[5 * 65]); o.w = pk2(s[6 * 65], s[7 * 65]);
        *(u32x4*)(WT + (size_t)(n0 + n) * K + k0 + 8 * c) = o;
    }
    LDS_FENCE();
}

typedef const __attribute__((address_space(4))) Args* KArgsP;
__device__ __forceinline__ void convert_layer_weights(KArgsP ka, LAS unsigned char* lds, int layer, int vw, int nvw, int wave, int lane) {
    unsigned char* ws = ka->ws;
    LAS float* scr = (LAS float*)(lds + wave * 17408);
    constexpr int I_IN = 16 * 76, I_GLU = 8 * 8, I_BR = 8 * 16, I_OUT = 16 * 16, I_UP = 16 * 64, I_DN = 64 * 16, I_L = I_IN + I_GLU + 3 * I_BR + I_OUT + I_UP + I_DN;
    unsigned char* wl = ws + WS_W + (size_t)layer * LW_BYTES;
    for (int it = vw; it < I_L; it += nvw) {
        int r = it;
        if (r < I_IN) { p0_item(ka->in[3] + (size_t)layer * DM * DIN, DIN, DM, ka->in[2] + layer * DM, (bf16*)(wl + OW_IN), 640, scr, r, 76, lane); continue; } r -= I_IN;
        if (r < I_GLU) { p0_item(ka->in[13] + (size_t)layer * 512 * 512, 512, 512, nullptr, (bf16*)(wl + OW_GLU), 0, scr, r, 8, lane); continue; } r -= I_GLU;
        if (r < 3 * I_BR) { const int c = r / I_BR; p0_item(ka->in[17] + ((size_t)layer * 3 + c) * 512 * 1024, 1024, 512, nullptr, (bf16*)(wl + OW_BR) + (size_t)c * 1024 * 512, 0, scr, r % I_BR, 16, lane); continue; } r -= 3 * I_BR;
        if (r < I_OUT) { p0_item(ka->in[18] + (size_t)layer * DM * DM, DM, DM, nullptr, (bf16*)(wl + OW_OUT), 0, scr, r, 16, lane); continue; } r -= I_OUT;
        if (r < I_UP) { p0_item(ka->in[20] + (size_t)layer * DM * FF, FF, DM, ka->in[19] + layer * DM, (bf16*)(wl + OW_UP), 0, scr, r, 64, lane); continue; } r -= I_UP;
        p0_item(ka->in[21] + (size_t)layer * FF * DM, DM, FF, nullptr, (bf16*)(wl + OW_DN), 0, scr, r, 16, lane);
    }
    for (int i = vw * 64 + lane; i < 512 * 64; i += nvw * 64) {
        const int n = i >> 6, k0 = (i & 63) * 8;
        u32x4 o = {0u, 0u, 0u, 0u};
        if ((n >> 7) == (k0 >> 7)) { const float* src = ka->in[15] + (((size_t)layer * 4 + (n >> 7)) * 128 + (k0 & 127)) * 128 + (n & 127);
            o.x = pk2(src[0], src[128]); o.y = pk2(src[256], src[384]); o.z = pk2(src[512], src[640]); o.w = pk2(src[768], src[896]); }
        *(u32x4*)((bf16*)(wl + OW_POOL) + (size_t)n * 512 + k0) = o;
    }
}

__device__ __forceinline__ void p0_prologue(const Args& a, LAS unsigned char* lds) {
    int tl_ = threadIdx.x; asm volatile("" : "+v"(tl_));
    const int tid = tl_, lane = tid & 63, wave = __builtin_amdgcn_readfirstlane(tid >> 6);
    const int gw = blockIdx.x * 8 + wave, NGW = gridDim.x * 8;
    const int gt = blockIdx.x * 512 + tid, NGT = gridDim.x * 512;
    unsigned char* ws = a.ws;
    for (int i = gt; i < 4 * 4 * 128 * 4; i += NGT) { const int idx = 1 + (i >> 11), pn = (i >> 9) & 3, r = (i >> 2) & 127, sl = i & 3;
        ((float*)(ws + WS_RS))[((size_t)idx * 4 * TPR + (size_t)pn * TPR + NREAL + r) * 4 + sl] = 0.f; }
    for (int i = gt; i < LL * 32; i += NGT) {
        const int l = i >> 5, f = i & 31;
        const float invf = (float)dexp(-(double)f * (9.21034037197618273607 / 32.0));
        const float ang = (float)l * invf;
        double s, c; dsincos((double)ang, s, c);
        float* rp = (float*)(ws + WS_ROPE) + (size_t)i * 2; rp[0] = (float)c; rp[1] = (float)s;
    }
    for (int i = gt; i < 2 * 2 * 32 * 64; i += NGT) {
        const int n = i & 63, pidx = i >> 6;
        const double lr = (double)a.in[5][i], li = (double)a.in[6][i];
        const double dt = (double)(float)dexp((double)a.in[7][pidx]);
        const double mag = dexp(lr * dt); double sn, cn; dsincos(li * dt, sn, cn);
        const double are = mag * cn, aim = mag * sn, den = lr * lr + li * li, nre = are - 1.0;
        const double fre = (nre * lr + aim * li) / den, fim = (aim * lr - nre * li) / den;
        float* ab = (float*)(ws + WS_ABAR) + (size_t)i * 2; ab[0] = (float)are; ab[1] = (float)aim;
        bf16* bm = (bf16*)(ws + WS_BMAT) + (size_t)pidx * 128 * 16;
        bf16* cm = (bf16*)(ws + WS_CMAT) + (size_t)pidx * 16 * 128;
        for (int q = 0; q < 16; ++q) {
            const double br = (double)a.in[8][(size_t)i * 16 + q], bi = (double)a.in[9][(size_t)i * 16 + q];
            bm[n * 16 + q] = (bf16)f2bf((float)(fre * br - fim * bi));
            bm[(64 + n) * 16 + q] = (bf16)f2bf((float)(fre * bi + fim * br));
            *(unsigned*)(cm + q * 128 + 2 * n) = pk2(a.in[10][((size_t)pidx * 16 + q) * 64 + n], -a.in[11][((size_t)pidx * 16 + q) * 64 + n]);
        }
    }
    for (int R = gw; R < TPR; R += NGW) {
        const int mrow = R - NREAL;
        const float* src = R < NREAL ? a.in[0] + (size_t)R * DM : a.in[1] + (size_t)(mrow & 15) * DM;
        float* dst = R < NREAL ? a.out + (size_t)R * DM : (float*)(ws + WS_HM) + (size_t)mrow * DM;
        bf16* hb = (bf16*)(ws + WS_HB) + (size_t)R * DM;
        const bool pad = mrow >= NB * NMETA;
        float ss = 0.f;
#pragma unroll
        for (int j = 0; j < 4; ++j) {
            f32x4 v = *(const f32x4*)(src + 4 * lane + 256 * j);
            if (pad) v = (f32x4){0.f, 0.f, 0.f, 0.f};
            ss += (v[0] * v[0] + v[1] * v[1]) + (v[2] * v[2] + v[3] * v[3]);
            u32x2 w; w.x = pk2(v[0], v[1]); w.y = pk2(v[2], v[3]);
            *(u32x2*)(hb + 4 * lane + 256 * j) = w;
        }
#pragma unroll
        for (int o = 1; o < 64; o <<= 1) ss += __shfl_xor(ss, o);
        if (lane < 16) ((float*)(ws + WS_RS))[((size_t)(lane >> 2) * TPR + R) * 4 + (lane & 3)] = lane == 0 ? ss : 0.f;
    }
}

__device__ __forceinline__ void ssm_task(LAS unsigned char* lds, int task, int layer, const bf16* SU, float* YF,
                                         const float* abar_all, const bf16* bmat_all, const bf16* cmat_all) {
    int tid_l = threadIdx.x; asm volatile("" : "+v"(tid_l));
    const int tid = tid_l, lane = tid & 63, wave = __builtin_amdgcn_readfirstlane(tid >> 6);
    const int b = task >> 5, g = task & 31;
    __syncthreads();
    LAS float* BU = (LAS float*)(lds + wave * 12800);
    LAS unsigned short* X = (LAS unsigned short*)(lds + wave * 12800 + 8448);
    LAS float* SX = (LAS float*)(lds + 8 * 12800);
    const int blk0 = wave == 0 ? 0 : 16 * wave + 1, nblk = wave == 0 ? 17 : 16;
    bf16* yfb = (bf16*)YF + (size_t)task * LL * 16;
    const int fr = lane & 15, fq = lane >> 4;
    const bf16x8 zero8 = {0, 0, 0, 0, 0, 0, 0, 0};
    for (int dir = 0; dir < 2; ++dir) {
        const int pidx = (layer * 2 + dir) * 32 + g;
        const float are = abar_all[((size_t)pidx * 64 + lane) * 2], aim = abar_all[((size_t)pidx * 64 + lane) * 2 + 1];
        bf16x8 bfr[8], cfr[4];
        const bf16* bm = bmat_all + (size_t)pidx * 128 * 16;
#pragma unroll
        for (int nt = 0; nt < 8; ++nt) bfr[nt] = fq < 2 ? *(const bf16x8*)(bm + (nt * 16 + fr) * 16 + 8 * fq) : zero8;
        const bf16* cm = cmat_all + (size_t)pidx * 16 * 128;
#pragma unroll
        for (int ks = 0; ks < 4; ++ks) cfr[ks] = *(const bf16x8*)(cm + fr * 128 + ks * 32 + 8 * fq);
        float p16r = are, p16i = aim;
#pragma unroll
        for (int i = 0; i < 4; ++i) { const float tr = p16r * p16r - p16i * p16i, ti = 2.f * p16r * p16i; p16r = tr; p16i = ti; }
        float p256r = p16r, p256i = p16i;
#pragma unroll
        for (int i = 0; i < 4; ++i) { const float tr = p256r * p256r - p256i * p256i, ti = 2.f * p256r * p256i; p256r = tr; p256i = ti; }
        const float p272r = p256r * p16r - p256i * p16i, p272i = p256r * p16i + p256i * p16r;

        float xre = 0.f, xim = 0.f;
        for (int pass = 0; pass < 2; ++pass) {
            bf16x8 unext;
            { const int blkf = dir == 0 ? blk0 : blk0 + nblk - 1; const int Rf = blkf == 0 ? NREAL + b * NMETA : b * SEQ + blkf * 16 - NMETA;
              unext = fq < 2 ? *(const bf16x8*)(SU + (size_t)(Rf + fr) * 512 + g * 16 + 8 * fq) : zero8; }
            for (int ib = 0; ib < nblk; ++ib) {
                const int blk = dir == 0 ? blk0 + ib : blk0 + nblk - 1 - ib;
                const bf16x8 ufr = unext;
                if (ib + 1 < nblk) { const int blkn = dir == 0 ? blk + 1 : blk - 1; const int Rn = blkn == 0 ? NREAL + b * NMETA : b * SEQ + blkn * 16 - NMETA;
                    unext = fq < 2 ? *(const bf16x8*)(SU + (size_t)(Rn + fr) * 512 + g * 16 + 8 * fq) : zero8; }
                f32x4 dd[8];
#pragma unroll
                for (int nt = 0; nt < 8; ++nt) { dd[nt] = (f32x4){0.f, 0.f, 0.f, 0.f}; dd[nt] = __builtin_amdgcn_mfma_f32_16x16x32_bf16(ufr, bfr[nt], dd[nt], 0, 0, 0); }
                asm volatile("s_nop 15\n\ts_nop 15" : "+v"(dd[0]), "+v"(dd[1]), "+v"(dd[2]), "+v"(dd[3]), "+v"(dd[4]), "+v"(dd[5]), "+v"(dd[6]), "+v"(dd[7]));
#pragma unroll
                for (int nt = 0; nt < 8; ++nt)
#pragma unroll
                    for (int r = 0; r < 4; ++r) BU[(4 * fq + r) * 132 + nt * 16 + fr] = dd[nt][r];
                LDS_FENCE();
                float bur[16], bui[16];
#pragma unroll
                for (int i = 0; i < 16; ++i) { const int tt = dir == 0 ? i : 15 - i; bur[i] = BU[tt * 132 + lane]; bui[i] = BU[tt * 132 + 64 + lane]; }
                if (pass == 0) {
#pragma unroll
                    for (int i = 0; i < 16; ++i) {
                        const float bre = bur[i], bim = bui[i];
                        const float nr = are * xre - aim * xim + bre, ni = are * xim + aim * xre + bim; xre = nr; xim = ni;
                    }
                    LDS_FENCE();
                } else {
#pragma unroll
                    for (int i = 0; i < 16; ++i) {
                        const int tt = dir == 0 ? i : 15 - i;
                        const float bre = bur[i], bim = bui[i];
                        const float nr = are * xre - aim * xim + bre, ni = are * xim + aim * xre + bim; xre = nr; xim = ni;
                        *(LAS unsigned*)(X + tt * 136 + 2 * lane) = pk2(xre, xim);
                    }
                    LDS_FENCE();
                    f32x4 y = {0.f, 0.f, 0.f, 0.f};
#pragma unroll
                    for (int ks = 0; ks < 4; ++ks) {
                        const bf16x8 afr = *(const LAS bf16x8*)(X + fr * 136 + ks * 32 + 8 * fq);
                        y = __builtin_amdgcn_mfma_f32_16x16x32_bf16(afr, cfr[ks], y, 0, 0, 0);
                    }
                    asm volatile("s_nop 15\n\ts_nop 15" : "+v"(y));
                    LDS_FENCE();
                    {
                        bf16* yd = yfb + (size_t)dir * 256 * LL * 16;
#pragma unroll
                        for (int r = 0; r < 4; ++r) yd[(size_t)(blk * 16 + 4 * fq + r) * 16 + fr] = (bf16)f2bf(y[r]);
                    }
                }
            }
            if (pass == 0) {
                SX[(wave * 64 + lane) * 2] = xre; SX[(wave * 64 + lane) * 2 + 1] = xim;
                LDS_FENCE(); __syncthreads();
                float cre = 0.f, cim = 0.f;
                if (dir == 0) {
                    for (int w = 0; w < wave; ++w) { const float pr = w == 0 ? p272r : p256r, pi = w == 0 ? p272i : p256i;
                        const float sr = SX[(w * 64 + lane) * 2], si = SX[(w * 64 + lane) * 2 + 1];
                        const float nr = pr * cre - pi * cim + sr, ni = pr * cim + pi * cre + si; cre = nr; cim = ni; }
                } else {
                    for (int w = 7; w > wave; --w) {
                        const float sr = SX[(w * 64 + lane) * 2], si = SX[(w * 64 + lane) * 2 + 1];
                        const float nr = p256r * cre - p256i * cim + sr, ni = p256r * cim + p256i * cre + si; cre = nr; cim = ni; }
                }
                xre = cre; xim = cim;
            }
        }
        LDS_FENCE(); __syncthreads();
    }
}

constexpr int ATT_KROW = 72, ATT_VROW = 40, ATT_KT = 32 * ATT_KROW * 2  , ATT_VT = 64 * ATT_VROW * 2  , ATT_MAXT = 11, ATT_VOFF = ATT_MAXT * ATT_KT;
static_assert(ATT_VOFF + ATT_MAXT * ATT_VT <= 131072, "attention LDS");
__device__ __forceinline__ void attn_task(LAS unsigned char* lds, int task, const bf16* Q, const bf16* K, const bf16* V, bf16* YA, const float* sink) {
    int tid_l = threadIdx.x; asm volatile("" : "+v"(tid_l));
    const int tid = tid_l, lane = tid & 63, wave = __builtin_amdgcn_readfirstlane(tid >> 6);
    const int qb = task < 512 ? (task & 31) : 32, bh = task < 512 ? (task >> 5) : task - 512, h = bh & 1, b = bh >> 1;
    const int l0 = qb * 64;
    __syncthreads();
    int jlo = (l0 - 128) >> 5; if (jlo < 1) jlo = 1;
    int jhi = (l0 + 191) >> 5; if (jhi > 64) jhi = 64;
    const int ntiles = 1 + (jhi - jlo + 1);
    LAS unsigned short* Ks = (LAS unsigned short*)lds;
    LAS unsigned short* Vs = (LAS unsigned short*)(lds + ATT_VOFF);
    for (int idx = tid; idx < ntiles * 32 * 8; idx += 512) {
        const int ch = idx & 7, key = idx >> 3, slot = key >> 5, kk = key & 31;
        const int lk = (slot == 0 ? 0 : (jlo + slot - 1) * 32) + kk;
        u32x4 kv = {0u, 0u, 0u, 0u}, vv = {0u, 0u, 0u, 0u};
        if (lk < LL) { const size_t R = (size_t)tok_row(b, lk);
            kv = *(const u32x4*)(K + R * 128 + h * 64 + ch * 8); vv = *(const u32x4*)(V + R * 128 + h * 64 + ch * 8); }
        *(LAS u32x4*)(Ks + slot * (ATT_KT / 2) + kk * ATT_KROW + ch * 8) = kv;
        LAS unsigned short* vd = Vs + slot * (ATT_VT / 2) + (ch * 8) * ATT_VROW + kk;
        vd[0 * ATT_VROW] = (unsigned short)(vv.x & 0xffffu); vd[1 * ATT_VROW] = (unsigned short)(vv.x >> 16);
        vd[2 * ATT_VROW] = (unsigned short)(vv.y & 0xffffu); vd[3 * ATT_VROW] = (unsigned short)(vv.y >> 16);
        vd[4 * ATT_VROW] = (unsigned short)(vv.z & 0xffffu); vd[5 * ATT_VROW] = (unsigned short)(vv.z >> 16);
        vd[6 * ATT_VROW] = (unsigned short)(vv.w & 0xffffu); vd[7 * ATT_VROW] = (unsigned short)(vv.w >> 16);
    }
    LDS_FENCE(); __syncthreads();
    const int head = h * 4 + (wave >> 1), r32 = lane & 31, hi = lane >> 5;
    const int lq = l0 + 32 * (wave & 1) + r32;
    const bool qvalid = lq < LL;
    const size_t Rq = (size_t)tok_row(b, qvalid ? lq : LL - 1);
    bf16x8 qf[4];
#pragma unroll
    for (int ks = 0; ks < 4; ++ks) qf[ks] = *(const bf16x8*)(Q + Rq * 512 + head * 64 + ks * 16 + 8 * hi);
    float mrun = sink[head], lsum = hi == 0 ? 1.0f : 0.0f;
    f32x16 o0, o1;
#pragma unroll
    for (int i = 0; i < 16; ++i) { o0[i] = 0.f; o1[i] = 0.f; }
    const int lqw = l0 + 32 * (wave & 1);
    for (int slot = 0; slot < ntiles; ++slot) {
        const int kbase = slot == 0 ? 0 : (jlo + slot - 1) * 32;
        if (lqw >= LL || (slot != 0 && (kbase + 31 < lqw - 128 || kbase > lqw + 31 + 128))) continue;
        const LAS unsigned short* kt = Ks + slot * (ATT_KT / 2);
        f32x16 s;
#pragma unroll
        for (int i = 0; i < 16; ++i) s[i] = 0.f;
#pragma unroll
        for (int ks = 0; ks < 4; ++ks) {
            const bf16x8 kf = *(const LAS bf16x8*)(kt + r32 * ATT_KROW + ks * 16 + 8 * hi);
            s = __builtin_amdgcn_mfma_f32_32x32x16_bf16(kf, qf[ks], s, 0, 0, 0);
        }
        asm volatile("s_nop 15\n\ts_nop 15" : "+v"(s));
        float mt = -1e30f;
#pragma unroll
        for (int i = 0; i < 16; ++i) {
            const int lk = kbase + (i & 3) + 8 * (i >> 2) + 4 * hi;
            int d = lq - lk; d = d < 0 ? -d : d;
            const bool valid = (lk < NMETA) || (d <= 128 && lk < LL);
            s[i] = valid ? s[i] : -1e30f;
            mt = fmaxf(mt, s[i]);
        }
        mt = fmaxf(mt, __shfl_xor(mt, 32));
        const float mnew = fmaxf(mrun, mt);
        const float alpha = __expf(mrun - mnew);
        mrun = mnew;
        float ps = 0.f;
#pragma unroll
        for (int i = 0; i < 16; ++i) { s[i] = __expf(s[i] - mnew); ps += s[i]; }
        lsum = lsum * alpha + ps;
#pragma unroll
        for (int i = 0; i < 16; ++i) { o0[i] *= alpha; o1[i] *= alpha; }
        const LAS unsigned short* vt = Vs + slot * (ATT_VT / 2);
#pragma unroll
        for (int s2 = 0; s2 < 2; ++s2) {
            union { bf16x8 v; unsigned u[4]; } pf;
            pf.u[0] = pk2(s[8 * s2 + 0], s[8 * s2 + 1]); pf.u[1] = pk2(s[8 * s2 + 2], s[8 * s2 + 3]);
            pf.u[2] = pk2(s[8 * s2 + 4], s[8 * s2 + 5]); pf.u[3] = pk2(s[8 * s2 + 6], s[8 * s2 + 7]);
#pragma unroll
            for (int dt = 0; dt < 2; ++dt) {
                union { bf16x8 v; u32x2 u[2]; } vf;
                const LAS unsigned short* vp = vt + (dt * 32 + r32) * ATT_VROW + 16 * s2 + 4 * hi;
                vf.u[0] = *(const LAS u32x2*)(vp); vf.u[1] = *(const LAS u32x2*)(vp + 8);
                if (dt == 0) o0 = __builtin_amdgcn_mfma_f32_32x32x16_bf16(vf.v, pf.v, o0, 0, 0, 0);
                else o1 = __builtin_amdgcn_mfma_f32_32x32x16_bf16(vf.v, pf.v, o1, 0, 0, 0);
            }
        }
    }
    asm volatile("s_nop 15\n\ts_nop 15" : "+v"(o0), "+v"(o1));
    lsum += __shfl_xor(lsum, 32);
    const float inv = 1.0f / lsum;
    if (qvalid) {
#pragma unroll
        for (int g4 = 0; g4 < 4; ++g4) {
            u32x2 w0, w1;
            w0.x = pk2(o0[4 * g4] * inv, o0[4 * g4 + 1] * inv); w0.y = pk2(o0[4 * g4 + 2] * inv, o0[4 * g4 + 3] * inv);
            w1.x = pk2(o1[4 * g4] * inv, o1[4 * g4 + 1] * inv); w1.y = pk2(o1[4 * g4 + 2] * inv, o1[4 * g4 + 3] * inv);
            *(u32x2*)(YA + Rq * 512 + head * 64 + 8 * g4 + 4 * hi) = w0;
            *(u32x2*)(YA + Rq * 512 + head * 64 + 32 + 8 * g4 + 4 * hi) = w1;
        }
    }
    __syncthreads();
}

__device__ __forceinline__ void pool_diff(LAS unsigned char* lds, const bf16* PU, bf16* PD) {
    int tl_ = threadIdx.x; asm volatile("" : "+v"(tl_));
    constexpr int TOK = 65, HALO = 8, ROWS = TOK + 2 * HALO, NTOK = NB * LL;
    for (int blk = blockIdx.x; blk * TOK < NTOK; blk += gridDim.x) {
        const int f0 = blk * TOK;
        __syncthreads();
        for (int i = tl_; i < ROWS * 64; i += 512) {
            const int r = i >> 6, ch = i & 63, f = f0 - HALO + r;
            u32x4 v = {0u, 0u, 0u, 0u};
            if (f >= 0 && f < NTOK) { const int b = f / LL, l = f % LL; v = *(const u32x4*)(PU + (size_t)tok_row(b, l) * 512 + ch * 8); }
            *(LAS u32x4*)(lds + (size_t)i * 16) = v;
        }
        LDS_FENCE(); __syncthreads();
        for (int i = tl_; i < TOK * 64; i += 512) {
            const int t = i >> 6, ch = i & 63, f = f0 + t;
            if (f >= NTOK) continue;
            const int b = f / LL, l = f % LL, half = 1 << (ch >> 4);
            const int lo = l - half < 0 ? 0 : l - half, hh = l + half > LL ? LL : l + half;
            float s[8];
#pragma unroll
            for (int j = 0; j < 8; ++j) s[j] = 0.f;
            for (int lp = lo; lp < hh; ++lp) {
                const u32x4 v = *(const LAS u32x4*)(lds + (size_t)((t + HALO + lp - l) * 64 + ch) * 16);
                s[0] += bf2f(v.x & 0xffffu); s[1] += bf2f(v.x >> 16); s[2] += bf2f(v.y & 0xffffu); s[3] += bf2f(v.y >> 16);
                s[4] += bf2f(v.z & 0xffffu); s[5] += bf2f(v.z >> 16); s[6] += bf2f(v.w & 0xffffu); s[7] += bf2f(v.w >> 16);
            }
            const float ic = 1.0f / (float)(hh - lo);
            const u32x4 v = *(const LAS u32x4*)(lds + (size_t)((t + HALO) * 64 + ch) * 16);
            u32x4 o;
            o.x = pk2(s[0] * ic - bf2f(v.x & 0xffffu), s[1] * ic - bf2f(v.x >> 16)); o.y = pk2(s[2] * ic - bf2f(v.y & 0xffffu), s[3] * ic - bf2f(v.y >> 16));
            o.z = pk2(s[4] * ic - bf2f(v.z & 0xffffu), s[5] * ic - bf2f(v.z >> 16)); o.w = pk2(s[6] * ic - bf2f(v.w & 0xffffu), s[7] * ic - bf2f(v.w >> 16));
            *(u32x4*)(PD + (size_t)tok_row(b, l) * 512 + ch * 8) = o;
        }
    }
    __syncthreads();
}

__device__ __forceinline__ void z_pass(const float* YF, const bf16* SU, const float* dskip, bf16* Z) {
    int tl_ = threadIdx.x; asm volatile("" : "+v"(tl_)); const int gt = blockIdx.x * 512 + tl_, NGT = gridDim.x * 512;
    for (int i = gt; i < NB * LL * 64; i += NGT) {
        const int ch = i & 63, tk = i >> 6, b = tk / LL, l = tk % LL, g = ch >> 1;
        const size_t R = (size_t)tok_row(b, l);
        const bf16* yp = (const bf16*)YF + ((size_t)(b * 32 + g) * LL + l) * 16 + (ch & 1) * 8;
        const u32x4 ya = *(const u32x4*)yp, yb = *(const u32x4*)(yp + (size_t)256 * LL * 16);
        f32x4 y0, y1;
        y0[0] = bf2f(ya.x & 0xffffu) + bf2f(yb.x & 0xffffu); y0[1] = bf2f(ya.x >> 16) + bf2f(yb.x >> 16); y0[2] = bf2f(ya.y & 0xffffu) + bf2f(yb.y & 0xffffu); y0[3] = bf2f(ya.y >> 16) + bf2f(yb.y >> 16);
        y1[0] = bf2f(ya.z & 0xffffu) + bf2f(yb.z & 0xffffu); y1[1] = bf2f(ya.z >> 16) + bf2f(yb.z >> 16); y1[2] = bf2f(ya.w & 0xffffu) + bf2f(yb.w & 0xffffu); y1[3] = bf2f(ya.w >> 16) + bf2f(yb.w >> 16);
        const f32x4 d0 = *(const f32x4*)(dskip + ch * 8), d1 = *(const f32x4*)(dskip + ch * 8 + 4);
        const u32x4 uu = *(const u32x4*)(SU + R * 512 + ch * 8);
        float t[8];
        t[0] = y0[0] + d0[0] * bf2f(uu.x & 0xffffu); t[1] = y0[1] + d0[1] * bf2f(uu.x >> 16); t[2] = y0[2] + d0[2] * bf2f(uu.y & 0xffffu); t[3] = y0[3] + d0[3] * bf2f(uu.y >> 16);
        t[4] = y1[0] + d1[0] * bf2f(uu.z & 0xffffu); t[5] = y1[1] + d1[1] * bf2f(uu.z >> 16); t[6] = y1[2] + d1[2] * bf2f(uu.w & 0xffffu); t[7] = y1[3] + d1[3] * bf2f(uu.w >> 16);
#pragma unroll
        for (int j = 0; j < 8; ++j) {
            const float v = t[j], tt = __builtin_amdgcn_rcpf(fabsf(v) * 0.2316418882f + 1.0f);
            float q = tt * 0.5307027145f + (-0.7265760135f); q = q * tt + 0.7107068705f; q = q * tt + (-0.142248368f); q = q * tt + 0.127414796f; q = q * tt;
            const float m = v * (q * __builtin_amdgcn_exp2f(v * v * (-0.72134752044f)));
            t[j] = v < 0.f ? m : v - m;
        }
        u32x4 o; o.x = pk2(t[0], t[1]); o.y = pk2(t[2], t[3]); o.z = pk2(t[4], t[5]); o.w = pk2(t[6], t[7]);
        *(u32x4*)(Z + R * 512 + ch * 8) = o;
    }
}

#define XB_TMO      128
#define XB_XCNT(j)  (256  + 64 * (j))
#define XB_XSUB(j)  (1280 + 64 * (j))
#define XB_XGEN(j)  (2304 + 64 * (j))
#define XB_TOP      3328
#define XB_TOPGEN   3392
#define XCD_BAR_WORDS 3456
#define XB_SPIN_CAP (1u << 18)

__device__ __forceinline__ unsigned xb_ld(unsigned* p)              { return __hip_atomic_load(p, __ATOMIC_RELAXED, __HIP_MEMORY_SCOPE_AGENT); }
__device__ __forceinline__ unsigned xb_add(unsigned* p, unsigned v) { return __hip_atomic_fetch_add(p, v, __ATOMIC_RELAXED, __HIP_MEMORY_SCOPE_AGENT); }
__device__ __forceinline__ unsigned xb_xcc_id() { return (unsigned)__builtin_amdgcn_s_getreg((3 << 11) | 20) & 0xFu; }
#define XB_SPIN(cond, bar) do { unsigned _sp = 0; while (cond) { __builtin_amdgcn_s_sleep(1); \
    if ((++_sp & 255u) == 0u) { if (xb_ld(&(bar)[XB_TMO])) break; if (_sp > XB_SPIN_CAP) { atomicAdd(&(bar)[XB_TMO], 1u); break; } } } } while (0)

struct XcdBarrier {
    unsigned* bar; unsigned x;
    volatile LAS unsigned* st;
};

__device__ __forceinline__ XcdBarrier xcd_barrier_post(unsigned* bar, volatile LAS unsigned* st) {
    XcdBarrier b; b.bar = bar; b.x = xb_xcc_id(); b.st = st;
    if (threadIdx.x == 0) (void)xb_add(&bar[XB_XCNT(b.x)], 1u);
    return b;
}
__device__ __forceinline__ void xcd_barrier_complete(unsigned* bar, unsigned x, unsigned& nloc, unsigned& nx) {
    const unsigned G = gridDim.x * gridDim.y * gridDim.z;
    unsigned sum, cnt, mine, sp = 0u;
    for (;;) {
        sum = 0u; cnt = 0u; mine = 0u;
#pragma unroll
        for (unsigned j = 0; j < 16; ++j) { const unsigned c = xb_ld(&bar[XB_XCNT(j)]); sum += c; cnt += (c > 0u) ? 1u : 0u; mine = (j == x) ? c : mine; }
        if (sum == G) break;
        __builtin_amdgcn_s_sleep(1);
        if ((++sp & 255u) == 0u) { if (xb_ld(&bar[XB_TMO])) break; if (sp > XB_SPIN_CAP) { atomicAdd(&bar[XB_TMO], 1u); break; } }
    }
    nloc = mine > 0u ? mine : 1u; nx = cnt > 0u ? cnt : 1u;
}

__device__ __forceinline__ void xcd_barrier(const XcdBarrier& b) {
    asm volatile("s_waitcnt vmcnt(0)" ::: "memory");
    __syncthreads();
    if (threadIdx.x == 0) {
        unsigned* bar = b.bar;
        __builtin_amdgcn_s_waitcnt(0);
        unsigned nloc = b.st[0], nx = b.st[1];
        if (nloc == 0u) { xcd_barrier_complete(bar, b.x, nloc, nx); b.st[0] = nloc; b.st[1] = nx; }
        const unsigned old = xb_add(&bar[XB_XSUB(b.x)], 1u);
        const unsigned gen = old / nloc;
        if (old + 1u == (gen + 1u) * nloc) {
            __builtin_amdgcn_fence(__ATOMIC_RELEASE, "agent");
            asm volatile("s_waitcnt vmcnt(0)" ::: "memory");
            const unsigned og = xb_add(&bar[XB_TOP], 1u);
            const unsigned tg = og / nx;
            if (og + 1u == (tg + 1u) * nx) xb_add(&bar[XB_TOPGEN], 1u);
            else XB_SPIN(xb_ld(&bar[XB_TOPGEN]) == tg, bar);
            __builtin_amdgcn_fence(__ATOMIC_ACQUIRE, "agent");
            xb_add(&bar[XB_XGEN(b.x)], 1u);
            asm volatile("s_waitcnt vmcnt(0)" ::: "memory");
        } else {
            XB_SPIN(xb_ld(&bar[XB_XGEN(b.x)]) == gen, bar);
            __builtin_amdgcn_fence(__ATOMIC_ACQUIRE, "agent");
            asm volatile("s_waitcnt vmcnt(0)" ::: "memory");
        }
    }
    __syncthreads();
}

#ifndef MK_ALIGN
#define MK_ALIGN true
#endif
#ifndef MK_SP2
#define MK_SP2 true
#endif
#ifndef MK_SPLIT
#define MK_SPLIT 0
#endif
#ifndef MK_NLAYER
#define MK_NLAYER 2
#endif
constexpr int NPL = 8, NPHASE = 1 + 2 * NPL + 1, PH_FINAL = NPHASE - 1;

#define KARGS() ({ auto kp_ = __builtin_amdgcn_kernarg_segment_ptr(); asm volatile("" : "+s"(kp_)); (KArgsP)kp_; })
__global__ void __launch_bounds__(512, 2) fwd_kernel(Args a_unused, int ph_lo, int ph_hi) {
    (void)a_unused;
    extern __shared__ __attribute__((aligned(16))) unsigned char lds_raw[];
    LAS unsigned char* lds = (LAS unsigned char*)lds_raw;
    const int G = gridDim.x, bid = blockIdx.x;
#if MK_SPLIT
#define GRID_SYNC() do {} while (0)
    (void)lds;
#else
#define CG_SYNC() do { asm volatile("s_waitcnt vmcnt(0)" ::: "memory"); __syncthreads(); \
    if (threadIdx.x == 0) { __builtin_amdgcn_fence(__ATOMIC_RELEASE, "agent"); asm volatile("s_waitcnt vmcnt(0)" ::: "memory"); } \
    __syncthreads(); grid.sync(); \
    if (threadIdx.x == 0) { __builtin_amdgcn_fence(__ATOMIC_ACQUIRE, "agent"); asm volatile("s_waitcnt vmcnt(0)" ::: "memory"); } \
    __syncthreads(); } while (0)
    cg::grid_group grid = cg::this_grid();
    unsigned* barw = (unsigned*)(KARGS()->ws + WS_CTL);
    if (bid == 0) for (int i = threadIdx.x; i < XCD_BAR_WORDS; i += 512) __hip_atomic_store(barw + i, 0u, __ATOMIC_RELAXED, __HIP_MEMORY_SCOPE_AGENT);
    volatile LAS unsigned* xst = (volatile LAS unsigned*)(lds + LDS_BYTES - 64);
    if (threadIdx.x < 2) xst[threadIdx.x] = 0u;
    CG_SYNC();
    const XcdBarrier xbar = xcd_barrier_post(barw, xst);
#define GRID_SYNC() xcd_barrier(xbar)

#endif
#ifndef PHMASK
#define PHMASK 0xFFFFu
#endif
#define IN(k) (((PHMASK >> ((k) == 0 ? 0 : (k) == PH_FINAL ? 9 : 1 + ((k) - 1) % NPL)) & 1u) && ph_lo <= (k) && (k) < ph_hi)
#define SEAM(k) do { if (IN(k) && (k) + 1 < ph_hi) GRID_SYNC(); } while (0)
#define PHASE_BEGIN() KArgsP ka = KARGS(); unsigned char* ws = ka->ws; asm volatile("" : "+s"(ws)); float* rowss = (float*)(ws + WS_RS); float* Hm = (float*)(ws + WS_HM); bf16* HB = (bf16*)(ws + WS_HB); unsigned char* wl = ws + WS_W + (size_t)layer * LW_BYTES; \
    const int MT = NREAL; const bool META = layer != MK_NLAYER - 1;     \
    const float* rs_mix = rowss + (size_t)(2 * layer) * TPR * 16; float* rs_mlp = rowss + (size_t)(2 * layer + 1) * TPR * 16; float* rs_next = rowss + (size_t)(2 * layer + 2) * TPR * 16; (void)MT; (void)META; (void)Hm; (void)HB; (void)wl; (void)rs_mix; (void)rs_mlp; (void)rs_next;

    if (IN(0)) {
        { int tl_ = threadIdx.x; asm volatile("" : "+v"(tl_)); const int wv = __builtin_amdgcn_readfirstlane(tl_ >> 6);
          convert_layer_weights(KARGS(), lds, 0, bid * 8 + wv, G * 8, wv, tl_ & 63); }
        Args al; { KArgsP kp = KARGS(); for (int i = 0; i < 23; ++i) al.in[i] = kp->in[i]; al.out = kp->out; al.ws = kp->ws; } p0_prologue(al, lds); }
    SEAM(0);
#ifndef MK_NLAYER
#define MK_NLAYER 2
#endif
#ifndef MK_RSIDX
#define MK_RSIDX 4
#endif
#pragma unroll 1
    for (int layer = 0; layer < MK_NLAYER; ++layer) {
        const int p = 1 + NPL * layer;
        if (IN(p)) { PHASE_BEGIN();
            pg8::Gemm g{HB, (const bf16*)(wl + OW_IN), TPR, NPROJ, DM}; pg8::StaticOrder S; S.init(TPR, NPROJ, G, bid);
            EpiInProj E{rs_mix, (const float*)(ws + WS_ROPE), (bf16*)(ws + WS_Q), (bf16*)(ws + WS_K), (bf16*)(ws + WS_V), (bf16*)(ws + WS_SU), (bf16*)(ws + WS_PU)};
            pg8::gemm_phase<EpiInProj, pg8::StaticOrder, MK_ALIGN, MK_SP2>(lds, g, S, E);
        }
        SEAM(p);
        if (IN(p + 1)) { PHASE_BEGIN();
            for (int t = bid; t < 256; t += G)
                ssm_task(lds, t, layer, (const bf16*)(ws + WS_SU), (float*)(ws + WS_YF), (const float*)(ws + WS_ABAR), (const bf16*)(ws + WS_BMAT), (const bf16*)(ws + WS_CMAT));
            for (int t = bid; t < NB * 2 * 33; t += G)
                attn_task(lds, t, (const bf16*)(ws + WS_Q), (const bf16*)(ws + WS_K), (const bf16*)(ws + WS_V), (bf16*)ka->out, ka->in[4] + layer * 8);
            pool_diff(lds, (const bf16*)(ws + WS_PU), (bf16*)(ws + WS_PD));
            if (layer + 1 < MK_NLAYER) {
                int tl_ = threadIdx.x; asm volatile("" : "+v"(tl_)); const int wv = __builtin_amdgcn_readfirstlane(tl_ >> 6);
                convert_layer_weights(ka, lds, layer + 1, bid * 8 + wv, G * 8, wv, tl_ & 63);
                __syncthreads();
            }
        }
        SEAM(p + 1);
        if (IN(p + 2)) { PHASE_BEGIN();
            z_pass((const float*)(ws + WS_YF), (const bf16*)(ws + WS_SU), ka->in[12] + layer * 512, (bf16*)(ws + WS_Z));
        }
        SEAM(p + 2);
        if (IN(p + 3)) { PHASE_BEGIN();
            const int hg = G >> 1;
            if (bid < hg) { pg8::Gemm g{(const bf16*)(ws + WS_Z), (const bf16*)(wl + OW_GLU), MT, 512, 512}; pg8::StaticOrder S; S.init(MT, 512, hg, bid);
              EpiGlu E{(const bf16*)(ws + WS_Z), ka->in[14] + layer * 512, (bf16*)ka->out + (size_t)TPR * 512};
              pg8::gemm_phase<EpiGlu, pg8::StaticOrder, MK_ALIGN, MK_SP2>(lds, g, S, E); if (META) thin_gemm<EpiGlu>(lds, g.A, g.Bt, g.K, g.N, E, bid, hg); }
            else { pg8::Gemm g{(const bf16*)(ws + WS_PD), (const bf16*)(wl + OW_POOL), MT, 512, 512}; pg8::StaticOrder S; S.init(MT, 512, G - hg, bid - hg);
              EpiScale E{(bf16*)ka->out + (size_t)2 * TPR * 512, 512, ka->in[16] + layer * 512};
              pg8::gemm_phase<EpiScale, pg8::StaticOrder, MK_ALIGN, MK_SP2>(lds, g, S, E); if (META) thin_gemm<EpiScale>(lds, g.A, g.Bt, g.K, g.N, E, bid - hg, G - hg); }
        }
        SEAM(p + 3);
        if (IN(p + 4)) { PHASE_BEGIN();
            bf16* Y3 = (bf16*)ka->out;
            bf16* BR0 = (bf16*)(ws + WS_X), *BR1 = (bf16*)(ws + WS_X + 4 * UU), *BR2 = (bf16*)(ws + WS_X + 6 * UU);
            const bf16* Wbr = (const bf16*)(wl + OW_BR); const bf16* Wg = (const bf16*)(wl + OW_IN) + (size_t)NPROJ * DM; bf16* MG = (bf16*)(ws + WS_MG);
            { pg8::Gemm g{Y3, Wbr, 3 * TPR, 3072, 512}; TripleOrder S; S.init(G, bid, TPR / 256, 4);
              EpiBr3 E{BR0, TPR / 256};
              pg8::gemm_phase<EpiBr3, TripleOrder, MK_ALIGN, MK_SP2>(lds, g, S, E); }
            if (META) {
#pragma unroll 1
                for (int c = 0; c < 3; ++c) { EpiScale E{BR0 + (size_t)(2 * c + 2 * (c > 0)) * (UU / 2), 1024, nullptr};
                    thin_gemm<EpiScale>(lds, Y3 + (size_t)c * TPR * 512, Wbr + (size_t)c * 1024 * 512, 512, 1024, E, bid, G); }
            }
            { pg8::Gemm g{HB, Wg, MT, 3072, DM}; TripleOrder S; S.init(G, bid, 0, 4);
              EpiGate3 E{rs_mix, BR0, MG};
              pg8::gemm_phase<EpiGate3, TripleOrder, MK_ALIGN, MK_SP2>(lds, g, S, E); }
            if (META) {
                { EpiGate<true> E{rs_mix, BR0, MG}; thin_gemm<EpiGate<true>>(lds, HB, Wg, DM, 1024, E, bid, G); }
                { EpiGate<false> E{rs_mix, BR1, MG}; thin_gemm<EpiGate<false>>(lds, HB, Wg + (size_t)1024 * DM, DM, 1024, E, bid, G); }
                { EpiGate<false> E{rs_mix, BR2, MG}; thin_gemm<EpiGate<false>>(lds, HB, Wg + (size_t)2048 * DM, DM, 1024, E, bid, G); }
            }
        }
        SEAM(p + 4);
        if (IN(p + 5)) { PHASE_BEGIN();
            pg8::Gemm g{(const bf16*)(ws + WS_MG), (const bf16*)(wl + OW_OUT), MT, DM, DM}; pg8::StaticOrder S; S.init(MT, DM, G, bid);
            EpiRes E{(const float*)nullptr, HB, rs_mlp};
            pg8::gemm_phase<EpiRes, pg8::StaticOrder, MK_ALIGN, MK_SP2>(lds, g, S, E); if (META) thin_gemm<EpiRes>(lds, g.A, g.Bt, g.K, g.N, E, bid, G);
        }
        SEAM(p + 5);
        if (IN(p + 6)) { PHASE_BEGIN();
            pg8::Gemm g{HB, (const bf16*)(wl + OW_UP), MT, FF, DM}; pg8::StaticOrder S; S.init(MT, FF, G, bid);
            EpiUp E{rs_mlp, (bf16*)(ws + WS_ACT)};
            pg8::gemm_phase<EpiUp, pg8::StaticOrder, MK_ALIGN, MK_SP2>(lds, g, S, E); if (META) thin_gemm<EpiUp>(lds, g.A, g.Bt, g.K, g.N, E, bid, G);
        }
        SEAM(p + 6);
        if (IN(p + 7)) { PHASE_BEGIN();
            pg8::Gemm g{(const bf16*)(ws + WS_ACT), (const bf16*)(wl + OW_DN), MT, DM, FF}; pg8::StaticOrder S; S.init(MT, DM, G, bid);
            EpiRes E{(const float*)nullptr, HB, rs_next};
            pg8::gemm_phase<EpiRes, pg8::StaticOrder, MK_ALIGN, MK_SP2>(lds, g, S, E); if (META) thin_gemm<EpiRes>(lds, g.A, g.Bt, g.K, g.N, E, bid, G);
        }
        SEAM(p + 7);
    }
#ifdef MK_DUMP_OFF
    if (IN(PH_FINAL)) { KArgsP ka = KARGS();
        const bf16* src = (const bf16*)(ka->ws + (MK_DUMP_OFF)); const bf16* src2 = (const bf16*)(ka->ws + (MK_DUMP_OFF2));
        for (int i = bid * 512 + threadIdx.x; i < NREAL * 1024; i += G * 512) { const int R = MK_DUMP_ROW(i >> 10), c = i & 1023; ka->out[i] = c < 512 ? bf2f(src[(size_t)R * (MK_DUMP_LD) + (c % (MK_DUMP_LD))]) : bf2f(src2[(size_t)R * (MK_DUMP_LD2) + (c % (MK_DUMP_LD2))]); }
    }
#else
    if (IN(PH_FINAL)) { KArgsP ka = KARGS();
        const float* rs = (const float*)(ka->ws + WS_RS) + (size_t)MK_RSIDX * TPR * 16; const float* gain = ka->in[22];
        int tl_ = threadIdx.x; asm volatile("" : "+v"(tl_));
        for (int i = bid * 512 + tl_; i < NREAL * 256; i += G * 512) {
            const int R = i >> 8, c4 = (i & 255) * 4;
            const float r = row_rstd(rs, R);
            const u32x2 hb = *(const u32x2*)((const bf16*)(ka->ws + WS_HB) + (size_t)R * DM + c4); const f32x4 gn = *(const f32x4*)(gain + c4);
            f32x4 v = {bf2f(hb.x & 0xffffu), bf2f(hb.x >> 16), bf2f(hb.y & 0xffffu), bf2f(hb.y >> 16)};
            v = v * r * gn;
            *(f32x4*)(ka->out + (size_t)R * DM + c4) = v;
        }
    }
#endif
#undef IN
#undef SEAM
}

extern "C" void kernel_launch(void* const* d_in, const int* in_sizes, int n_in, void* d_out, int out_size, void* d_ws, size_t ws_size, hipStream_t stream) {
    static int grid = 0;
    if (grid == 0) {
        if (n_in != 23 || out_size != NREAL * DM || ws_size < WS_END) { fprintf(stderr, "kernel_launch: unexpected shapes (n_in %d out %d ws %zu)\n", n_in, out_size, ws_size); grid = -1; return; }
        int dev = 0, cus = 0, per_cu = 0;
        hipGetDevice(&dev); hipDeviceGetAttribute(&cus, hipDeviceAttributeMultiprocessorCount, dev);
        if (hipFuncSetAttribute((const void*)fwd_kernel, hipFuncAttributeMaxDynamicSharedMemorySize, LDS_BYTES) != hipSuccess) { fprintf(stderr, "kernel_launch: hipFuncSetAttribute failed\n"); grid = -1; return; }
        if (hipOccupancyMaxActiveBlocksPerMultiprocessor(&per_cu, (const void*)fwd_kernel, 512, LDS_BYTES) != hipSuccess || per_cu < 1) { fprintf(stderr, "kernel_launch: occupancy query gave %d\n", per_cu); per_cu = 1; }
        (void)hipGetLastError();
        grid = cus * (per_cu > 1 ? 1 : per_cu);
        if (grid <= 0) grid = 256;
    }
    if (grid < 0) return;
    Args a{};
    for (int i = 0; i < 23; ++i) a.in[i] = (const float*)d_in[i];
    a.out = (float*)d_out; a.ws = (unsigned char*)d_ws;
#if MK_SPLIT
    for (int ph = 0; ph < NPHASE; ++ph) hipLaunchKernelGGL(fwd_kernel, dim3(grid), dim3(512), LDS_BYTES, stream, a, ph, ph + 1);
#else
    int lo = 0, hi = NPHASE;
    void* kargs[] = {(void*)&a, (void*)&lo, (void*)&hi};
    hipError_t e = hipLaunchCooperativeKernel((const void*)fwd_kernel, dim3(grid), dim3(512), kargs, LDS_BYTES, stream);
    if (e != hipSuccess) fprintf(stderr, "kernel_launch: cooperative launch failed: %s (grid %d)\n", hipGetErrorString(e), grid);
#endif
}
```

```cpp
#include <hip/hip_runtime.h>
#include <hip/hip_cooperative_groups.h>
#include <cstdio>
#include <cstdint>
namespace cg = cooperative_groups;
namespace pg8 {
#define PG8_LAS __attribute__((address_space(3)))
typedef unsigned short bf16_t;
typedef short bf16x8 __attribute__((ext_vector_type(8)));
typedef float f32x4 __attribute__((ext_vector_type(4)));
typedef unsigned u32x4 __attribute__((ext_vector_type(4)));
constexpr int BM = 256, BK = 64, HALF = 128, HTB = HALF * BK * 2  , STAGE_BYTES = 8 * HTB, NXCD = 8, WGM = 8;

__host__ __device__ __forceinline__ int lds_byte(int r, int c) { const int st = (r >> 4) * 2 + (c >> 5), rr = r & 15, cc = c & 31, ob = rr * 64 + cc * 2; return st * 1024 + (ob ^ (((ob >> 9) & 1) << 5)); }
__host__ __device__ __forceinline__ void stage_rc(int b, int& R, int& C) { const int st = b / 1024, sb = b % 1024, swz = sb ^ (((sb >> 9) & 1) << 5); R = (st >> 1) * 16 + swz / 64; C = (st & 1) * 32 + (swz % 64) / 2; }
__host__ __device__ __forceinline__ int perm32(int rho) { const int n = rho >> 4, i = rho & 15; return 8 * (i >> 2) + 4 * n + (i & 3); }

struct Unit { int pm, pn; };
struct Gemm { const bf16_t* A; const bf16_t* Bt; int M, N, K; };

struct StaticOrder {
    int nM, nN, nwg, G, c;
    __host__ __device__ void init(int M, int N, int G_, int c_) { nM = M / BM; nN = N / BM; nwg = nM * nN; G = G_; c = c_; }
    __host__ __device__ __forceinline__ bool next(int i, Unit& u) const {
        const long L = (long)i * G + c; if (L >= nwg) return false;
        int wgid = (int)L; { const int q = nwg / NXCD, r = nwg % NXCD, xcd = wgid % NXCD, off = wgid / NXCD; wgid = (xcd < r ? xcd * (q + 1) : r * (q + 1) + (xcd - r) * q) + off; }
        const int nig = WGM * nN, gid = wgid / nig, fm = gid * WGM, gsz = (nM - fm) < WGM ? (nM - fm) : WGM;
        u.pm = fm + ((wgid % nig) % gsz); u.pn = (wgid % nig) / gsz; return true;
    }
    __device__ __forceinline__ void a_ready(const Unit&) const {}
    __device__ __forceinline__ void done(const Unit&) const {}
};

__device__ __forceinline__ unsigned cvt_pk_bf16(float lo, float hi) { unsigned r; asm volatile("v_cvt_pk_bf16_f32 %0, %1, %2" : "=v"(r) : "v"(lo), "v"(hi)); return r; }
template <class Epi, class Sched, bool ALIGN_EPI = false, bool SP2 = false>
__device__ __forceinline__ void gemm_phase(PG8_LAS unsigned char* lds, const Gemm g, const Sched& S, const Epi& E) {
    int tid_l = threadIdx.x; asm volatile("" : "+v"(tid_l));
    const int tid = tid_l, wid = __builtin_amdgcn_readfirstlane(tid >> 6), lane = tid & 63, wr = wid >> 2, wc = wid & 3, fr = lane & 15, fq = lane >> 4;
    const int K = g.K, nt = K / BK;
    unsigned voffA[2], voffB[2];
#pragma unroll
    for (int i = 0; i < 2; ++i) { int R, C; stage_rc(tid * 16 + i * 8192, R, C); const int Rb = Epi::PERM ? ((R & ~31) + perm32(R & 31)) : R;
        voffA[i] = (unsigned)(R * K + C) * 2u; voffB[i] = (unsigned)(Rb * K + C) * 2u; }
    const size_t kstep = (size_t)(BK * 2);
    const size_t hstep = (size_t)HALF * K * 2;
    const size_t tstep = 2 * hstep;
    const unsigned ldsw = (unsigned)wid * 1024u;
    const int aoff = lds_byte(wr * 64 + fr, fq * 8), boff = lds_byte(wc * 32 + fr, fq * 8);
#define PG8_SA(b, h) (((b) * 2 + (h)) * HTB)
#define PG8_SB(b, h) ((4 + (b) * 2 + (h)) * HTB)
#define PG8_STAGE(bufoff, gbase, voff) do { _Pragma("unroll") for (int _i = 0; _i < 2; ++_i) \
        __builtin_amdgcn_global_load_lds((const unsigned*)((const char*)(gbase) + (voff)[_i]), (PG8_LAS unsigned*)(lds + (bufoff) + ldsw + _i * 8192), 16, 0, 0); } while (0)
#define PG8_LDA(dst, b, h) do { _Pragma("unroll") for (int m = 0; m < 4; ++m) _Pragma("unroll") for (int k = 0; k < 2; ++k) dst[m][k] = *(const PG8_LAS bf16x8*)(lds + PG8_SA(b, h) + aoff + m * 2048 + k * 1024); } while (0)
#define PG8_LDB(dst, b, h) do { _Pragma("unroll") for (int n = 0; n < 2; ++n) _Pragma("unroll") for (int k = 0; k < 2; ++k) dst[n][k] = *(const PG8_LAS bf16x8*)(lds + PG8_SB(b, h) + boff + n * 2048 + k * 1024); } while (0)
#define PG8_MMA(ai, bj, At, Bt) do { __builtin_amdgcn_s_setprio(1); _Pragma("unroll") for (int m = 0; m < 4; ++m) _Pragma("unroll") for (int n = 0; n < 2; ++n) _Pragma("unroll") for (int k = 0; k < 2; ++k) \
        acc[ai][bj][m][n] = __builtin_amdgcn_mfma_f32_16x16x32_bf16(Bt[n][k], At[m][k], acc[ai][bj][m][n], 0, 0, 0); __builtin_amdgcn_s_setprio(0); } while (0)
#define PG8_WAIT_V(n) asm volatile("s_waitcnt vmcnt(" #n ")" ::: "memory")
#define PG8_WAIT_L(n) asm volatile("s_waitcnt lgkmcnt(" #n ")" ::: "memory")
#define PG8_BAR __builtin_amdgcn_s_barrier()
#define PG8_SCHED __builtin_amdgcn_sched_barrier(0)
    Unit cur, nxt; int ui = 0;
    if (!S.next(0, cur)) return;
    f32x4 acc[2][2][4][2];
#pragma unroll
    for (int a = 0; a < 2; ++a)
#pragma unroll
        for (int b = 0; b < 2; ++b)
#pragma unroll
            for (int m = 0; m < 4; ++m)
#pragma unroll
                for (int n = 0; n < 2; ++n) acc[a][b][m][n] = (f32x4){0.f, 0.f, 0.f, 0.f};
    bf16x8 At[4][2], B0[2][2], B1[2][2];
    const char* cA = (const char*)g.A + (size_t)cur.pm * tstep; const char* cB = (const char*)g.Bt + (size_t)cur.pn * tstep;
    S.a_ready(cur);
    if constexpr (SP2) {
        PG8_STAGE(PG8_SB(0, 0), cB, voffB); PG8_STAGE(PG8_SB(0, 1), cB + hstep, voffB); PG8_STAGE(PG8_SA(0, 0), cA, voffA); PG8_STAGE(PG8_SA(0, 1), cA + hstep, voffA);
        if (wr == 1) PG8_BAR;
        PG8_WAIT_V(2); PG8_BAR;
        PG8_STAGE(PG8_SB(1, 0), cB + kstep, voffB); PG8_STAGE(PG8_SA(1, 0), cA + kstep, voffA); PG8_STAGE(PG8_SB(1, 1), cB + hstep + kstep, voffB);
        PG8_WAIT_V(6); PG8_BAR;
    } else {
        PG8_STAGE(PG8_SB(0, 0), cB, voffB); PG8_STAGE(PG8_SA(0, 0), cA, voffA); PG8_STAGE(PG8_SB(0, 1), cB + hstep, voffB); PG8_STAGE(PG8_SA(0, 1), cA + hstep, voffA);
        if (wr == 1) PG8_BAR;
        PG8_WAIT_V(4); PG8_BAR;
        PG8_STAGE(PG8_SB(1, 0), cB + kstep, voffB); PG8_STAGE(PG8_SA(1, 0), cA + kstep, voffA); PG8_STAGE(PG8_SB(1, 1), cB + hstep + kstep, voffB);
        PG8_WAIT_V(6); PG8_BAR;
    }
    for (;;) {
        const bool has_next = S.next(ui + 1, nxt);
        const char* nA = has_next ? (const char*)g.A + (size_t)nxt.pm * tstep : cA; const char* nB = has_next ? (const char*)g.Bt + (size_t)nxt.pn * tstep : cB;
        for (int t = 0; t < nt; t += 2) {
            const bool last = (t == nt - 2);
            const char* a1 = cA + (size_t)(t + 1) * kstep;
            const char* a2 = last ? nA : cA + (size_t)(t + 2) * kstep; const char* b2 = last ? nB : cB + (size_t)(t + 2) * kstep;
            const char* a3 = a2 + kstep; const char* b3 = b2 + kstep;
            if (last && has_next) S.a_ready(nxt);
            if constexpr (SP2) {
            PG8_LDB(B0, 0, 0); PG8_LDB(B1, 0, 1); PG8_SCHED; PG8_LDA(At, 0, 0); PG8_STAGE(PG8_SA(1, 1), a1 + hstep, voffA);
            PG8_WAIT_V(8); PG8_WAIT_L(0); PG8_BAR; PG8_MMA(0, 0, At, B0); PG8_MMA(0, 1, At, B1); PG8_BAR; PG8_SCHED;
            PG8_LDA(At, 0, 1); PG8_STAGE(PG8_SB(0, 0), b2, voffB); PG8_STAGE(PG8_SB(0, 1), b2 + hstep, voffB); PG8_STAGE(PG8_SA(0, 0), a2, voffA);
            PG8_WAIT_V(8); PG8_WAIT_L(0); PG8_BAR; PG8_MMA(1, 0, At, B0); PG8_MMA(1, 1, At, B1); PG8_BAR; PG8_SCHED;
            PG8_LDB(B0, 1, 0); PG8_LDB(B1, 1, 1); PG8_SCHED; PG8_LDA(At, 1, 0); PG8_STAGE(PG8_SA(0, 1), a2 + hstep, voffA);
            PG8_WAIT_V(8); PG8_WAIT_L(0); PG8_BAR; PG8_MMA(0, 0, At, B0); PG8_MMA(0, 1, At, B1); PG8_BAR; PG8_SCHED;
            PG8_LDA(At, 1, 1); PG8_STAGE(PG8_SB(1, 0), b3, voffB); PG8_STAGE(PG8_SB(1, 1), b3 + hstep, voffB); PG8_STAGE(PG8_SA(1, 0), a3, voffA);
            PG8_WAIT_V(8); PG8_WAIT_L(0); PG8_BAR; PG8_MMA(1, 0, At, B0); PG8_MMA(1, 1, At, B1); PG8_BAR; PG8_SCHED;
            } else {
            PG8_LDB(B0, 0, 0); PG8_SCHED; PG8_LDA(At, 0, 0); PG8_STAGE(PG8_SA(1, 1), a1 + hstep, voffA);
            PG8_WAIT_L(8); PG8_BAR; PG8_WAIT_L(0); PG8_MMA(0, 0, At, B0); PG8_BAR; PG8_SCHED;
            PG8_LDB(B1, 0, 1); PG8_STAGE(PG8_SB(0, 0), b2, voffB);
            PG8_BAR; PG8_WAIT_L(0); PG8_MMA(0, 1, At, B1); PG8_BAR;
            PG8_LDA(At, 0, 1); PG8_STAGE(PG8_SA(0, 0), a2, voffA);
            PG8_BAR; PG8_WAIT_L(0); PG8_MMA(1, 0, At, B0); PG8_BAR; PG8_SCHED;
            PG8_STAGE(PG8_SB(0, 1), b2 + hstep, voffB);
            PG8_WAIT_V(6); PG8_BAR; PG8_MMA(1, 1, At, B1); PG8_BAR;
            PG8_LDB(B0, 1, 0); PG8_SCHED; PG8_LDA(At, 1, 0); PG8_STAGE(PG8_SA(0, 1), a2 + hstep, voffA);
            PG8_WAIT_L(8); PG8_BAR; PG8_WAIT_L(0); PG8_MMA(0, 0, At, B0); PG8_BAR; PG8_SCHED;
            PG8_LDB(B1, 1, 1); PG8_STAGE(PG8_SB(1, 0), b3, voffB);
            PG8_BAR; PG8_WAIT_L(0); PG8_MMA(0, 1, At, B1); PG8_BAR;
            PG8_LDA(At, 1, 1); PG8_STAGE(PG8_SA(1, 0), a3, voffA);
            PG8_BAR; PG8_WAIT_L(0); PG8_MMA(1, 0, At, B0); PG8_BAR; PG8_SCHED;
            PG8_STAGE(PG8_SB(1, 1), b3 + hstep, voffB);
            PG8_WAIT_V(6); PG8_BAR; PG8_MMA(1, 1, At, B1); PG8_BAR;
            }
        }
        if constexpr (ALIGN_EPI) { if (wr == 0) PG8_BAR; }
        asm volatile("s_nop 15\n\ts_nop 15" ::: "memory");
        if constexpr (!Epi::AFTER_DRAIN) { E(acc, cur, wr, wc, fr, fq); S.done(cur); }
        if (!has_next) break;
#pragma unroll
        for (int a = 0; a < 2; ++a)
#pragma unroll
            for (int b = 0; b < 2; ++b)
#pragma unroll
                for (int m = 0; m < 4; ++m)
#pragma unroll
                    for (int n = 0; n < 2; ++n) acc[a][b][m][n] = (f32x4){0.f, 0.f, 0.f, 0.f};
        cur = nxt; cA = nA; cB = nB; ++ui;
        if constexpr (ALIGN_EPI) { if (wr == 1) PG8_BAR; }
    }
    PG8_WAIT_V(0);
    if constexpr (!ALIGN_EPI) { if (wr == 0) PG8_BAR; }
    PG8_BAR;
    if constexpr (Epi::AFTER_DRAIN) { E.fused(acc, cur, wr, wc, fr, fq, lds, wid, lane); S.done(cur); }
#undef PG8_SA
#undef PG8_SB
#undef PG8_STAGE
#undef PG8_LDA
#undef PG8_LDB
#undef PG8_MMA
#undef PG8_WAIT_V
#undef PG8_WAIT_L
#undef PG8_BAR
#undef PG8_SCHED
}
}

#define LAS __attribute__((address_space(3)))
typedef unsigned short bf16;
typedef short bf16x8 __attribute__((ext_vector_type(8)));
typedef float f32x4 __attribute__((ext_vector_type(4)));
typedef float f32x16 __attribute__((ext_vector_type(16)));
typedef unsigned u32x2 __attribute__((ext_vector_type(2)));
typedef unsigned u32x4 __attribute__((ext_vector_type(4)));

constexpr int NB = 8, SEQ = 2048, NMETA = 16, LL = 2064, DM = 1024, FF = 4096, DIN = 4864, NPROJ = 1792;
constexpr int NREAL = NB * SEQ;
constexpr int TPR = NREAL + 256;
constexpr int LDS_BYTES = 147456;

constexpr size_t MiB = 1u << 20;
constexpr size_t WS_CTL = 0;
constexpr size_t WS_ROPE = 1 * MiB;
constexpr size_t WS_ABAR = 2 * MiB;
constexpr size_t WS_BMAT = 2 * MiB + 65536;
constexpr size_t WS_CMAT = WS_BMAT + 524288;
constexpr size_t WS_HM = 4 * MiB;
constexpr size_t WS_W = 5 * MiB;
constexpr size_t OW_IN = 0, OW_GLU = (size_t)DIN * DM * 2, OW_POOL = OW_GLU + 512 * 512 * 2, OW_BR = OW_POOL + 512 * 512 * 2,
                 OW_OUT = OW_BR + 3 * 1024 * 512 * 2, OW_UP = OW_OUT + 1024 * 1024 * 2, OW_DN = OW_UP + (size_t)FF * DM * 2, LW_BYTES = OW_DN + (size_t)FF * DM * 2;
constexpr size_t WS_HB = 68 * MiB;
constexpr size_t WS_X = 101 * MiB;
constexpr size_t UU = (size_t)TPR * 512 * 2;
constexpr size_t WS_YF = WS_X, WS_YP = WS_X, WS_Q = WS_X + 2 * UU, WS_K = WS_Q + UU, WS_V = WS_K + UU / 4, WS_MG = WS_X + 2 * UU,
                 WS_SU = WS_X + 4 * UU, WS_YA = WS_X + 8 * UU  , WS_PU = WS_X + 5 * UU, WS_YS = WS_PU, WS_Z = WS_X + 6 * UU, WS_PD = WS_X + 7 * UU, WS_BR = WS_Z, WS_ACT = WS_X;
constexpr size_t WS_RS = WS_X + 9 * UU;
constexpr size_t WS_END = WS_RS + (size_t)5 * TPR * 16 * 4;
static_assert(WS_W + 2 * LW_BYTES <= WS_HB && WS_HB + (size_t)TPR * 1024 * 2 <= WS_X && WS_END <= 256 * MiB, "ws map");
static_assert((size_t)256 * 2064 * 16 * 4 <= 2 * UU, "YF fits");

__device__ __forceinline__ unsigned pk2(float lo, float hi) { unsigned r; asm("v_cvt_pk_bf16_f32 %0, %1, %2" : "=v"(r) : "v"(lo), "v"(hi)); return r; }
__device__ __forceinline__ unsigned f2bf(float f) { return pk2(f, 0.f) & 0xffffu; }
__device__ __forceinline__ float bf2f(unsigned b) { return __uint_as_float(b << 16); }
__device__ __forceinline__ int tok_row(int b, int l) { return l >= NMETA ? b * SEQ + l - NMETA : NREAL + b * NMETA + l; }
#define LDS_FENCE() asm volatile("s_waitcnt lgkmcnt(0)" ::: "memory")
#define SSM_SYNC() do { asm volatile("s_waitcnt vmcnt(0) lgkmcnt(0)" ::: "memory"); __syncthreads(); } while (0)
__device__ __forceinline__ float row_rstd(const float* rs, int R) {
    const f32x4 a = *(const f32x4*)(rs + (size_t)R * 4), b = *(const f32x4*)(rs + ((size_t)TPR + R) * 4), c = *(const f32x4*)(rs + ((size_t)2 * TPR + R) * 4), d = *(const f32x4*)(rs + ((size_t)3 * TPR + R) * 4);
    const float s = (((a[0] + a[1]) + (a[2] + a[3])) + ((b[0] + b[1]) + (b[2] + b[3]))) + (((c[0] + c[1]) + (c[2] + c[3])) + ((d[0] + d[1]) + (d[2] + d[3])));
    return rsqrtf(s * (1.0f / 1024.0f) + 1e-6f);
}

__device__ __forceinline__ void dsincos(double a, double& s, double& c) {
    const double q = rint(a * 0.63661977236758134308);
    double r = fma(-q, 1.57079632679489655800e+00, a); r = fma(-q, 6.12323399573676603587e-17, r);
    const double r2 = r * r;
    double sp = -7.6471637318198164759e-13; sp = fma(sp, r2, 1.6059043836821614599e-10); sp = fma(sp, r2, -2.5052108385441718775e-08); sp = fma(sp, r2, 2.7557319223985890653e-06);
    sp = fma(sp, r2, -1.9841269841269841270e-04); sp = fma(sp, r2, 8.3333333333333333333e-03); sp = fma(sp, r2, -1.6666666666666666667e-01); sp = fma(sp * r2, r, r);
    double cp = 4.7794773323873852974e-14; cp = fma(cp, r2, -1.1470745597729724714e-11); cp = fma(cp, r2, 2.0876756987868098979e-09); cp = fma(cp, r2, -2.7557319223985890653e-07);
    cp = fma(cp, r2, 2.4801587301587301587e-05); cp = fma(cp, r2, -1.3888888888888888889e-03); cp = fma(cp, r2, 4.1666666666666666667e-02); cp = fma(cp, r2, -0.5); cp = fma(cp, r2, 1.0);
    const int qi = ((int)q) & 3;
    s = (qi == 0) ? sp : (qi == 1) ? cp : (qi == 2) ? -sp : -cp;
    c = (qi == 0) ? cp : (qi == 1) ? -sp : (qi == 2) ? -cp : sp;
}
__device__ __forceinline__ double dexp(double x) {
    const double k = rint(x * 1.44269504088896340736);
    double r = fma(-k, 6.93147180369123816490e-01, x); r = fma(-k, 1.90821492927058770002e-10, r);
    double p = 1.0 / 6227020800.0; p = fma(p, r, 1.0 / 479001600.0); p = fma(p, r, 1.0 / 39916800.0); p = fma(p, r, 1.0 / 3628800.0); p = fma(p, r, 1.0 / 362880.0); p = fma(p, r, 1.0 / 40320.0);
    p = fma(p, r, 1.0 / 5040.0); p = fma(p, r, 1.0 / 720.0); p = fma(p, r, 1.0 / 120.0); p = fma(p, r, 1.0 / 24.0); p = fma(p, r, 1.0 / 6.0); p = fma(p, r, 0.5); p = fma(p, r, 1.0); p = fma(p, r, 1.0);
    const long long bits = ((long long)(1023 + (int)k)) << 52;
    return p * __longlong_as_double(bits);
}

struct EpiInProj {
    static constexpr bool PERM = true, AFTER_DRAIN = false;
    const float* rowss; const float* rope; bf16 *Q, *K, *V, *SU, *PU;
    __device__ __forceinline__ u32x2 quad(int l, int c, const f32x4& v) const {
        u32x2 w;
        if (c < 640) {
            const int i0 = (c & 63) >> 1;
            const f32x4 cs = *(const f32x4*)(rope + ((size_t)l * 32 + i0) * 2);
            float o0 = v[0] * cs[0] - v[1] * cs[1], o1 = v[1] * cs[0] + v[0] * cs[1], o2 = v[2] * cs[2] - v[3] * cs[3], o3 = v[3] * cs[2] + v[2] * cs[3];
            if (c < 512) { o0 *= 0.125f; o1 *= 0.125f; o2 *= 0.125f; o3 *= 0.125f; }
            w.x = pk2(o0, o1); w.y = pk2(o2, o3);
        } else { w.x = pk2(v[0], v[1]); w.y = pk2(v[2], v[3]); }
        return w;
    }
    __device__ __forceinline__ void operator()(const f32x4 (&acc)[2][2][4][2], const pg8::Unit& u, int wr, int wc, int fr, int fq) const {
#pragma unroll
        for (int ai = 0; ai < 2; ++ai)
#pragma unroll
            for (int m = 0; m < 4; ++m) {
                const int R = u.pm * 256 + ai * 128 + wr * 64 + m * 16 + fr;
                const float rs = row_rstd(rowss, R);
                const int l = R < NREAL ? (R & 2047) + NMETA : (R & 15);
#pragma unroll
                for (int bj = 0; bj < 2; ++bj) {
                    const int c = u.pn * 256 + bj * 128 + wc * 32 + 8 * fq;
                    const u32x2 w0 = quad(l, c, acc[ai][bj][m][0] * rs), w1 = quad(l, c + 4, acc[ai][bj][m][1] * rs);
                    u32x4 w; w.x = w0.x; w.y = w0.y; w.z = w1.x; w.w = w1.y;
                    bf16* dst = c < 512 ? Q + (size_t)R * 512 + c : c < 640 ? K + (size_t)R * 128 + (c - 512) : c < 768 ? V + (size_t)R * 128 + (c - 640)
                              : c < 1280 ? SU + (size_t)R * 512 + (c - 768) : PU + (size_t)R * 512 + (c - 1280);
                    *(u32x4*)dst = w;
                }
            }
    }
};
#define EPI_BODY() \
    __device__ __forceinline__ void rg(int R, int pn, int wc, int fq, const f32x4 (&a4)[2][2]) const { \
        _Pragma("unroll") for (int bj = 0; bj < 2; ++bj) q2(R, pn * 256 + bj * 128 + wc * 32 + 8 * fq, a4[bj][0], a4[bj][1]); } \
    __device__ __forceinline__ void tq(int R, int c, const f32x4& v) const { q(R, c, v); } \
    EPI_OP()
#define EPI_OP() \
    __device__ __forceinline__ void operator()(const f32x4 (&acc)[2][2][4][2], const pg8::Unit& u, int wr, int wc, int fr, int fq) const { \
        _Pragma("unroll") for (int ai = 0; ai < 2; ++ai) _Pragma("unroll") for (int m = 0; m < 4; ++m) { \
            const f32x4 a4[2][2] = {{acc[ai][0][m][0], acc[ai][0][m][1]}, {acc[ai][1][m][0], acc[ai][1][m][1]}}; \
            rg(u.pm * 256 + ai * 128 + wr * 64 + m * 16 + fr, u.pn, wc, fq, a4); } }
#define EPI_BODY_RS() \
    __device__ __forceinline__ void rg(int R, int pn, int wc, int fq, const f32x4 (&a4)[2][2]) const { const float rs = row_rstd(rowss, R); \
        _Pragma("unroll") for (int bj = 0; bj < 2; ++bj) q2(R, pn * 256 + bj * 128 + wc * 32 + 8 * fq, a4[bj][0], a4[bj][1], rs); } \
    __device__ __forceinline__ void tq(int R, int c, const f32x4& v) const { q(R, c, v, row_rstd(rowss, R)); } \
    EPI_OP()
struct EpiGlu {
    static constexpr bool PERM = true, AFTER_DRAIN = false;
    const bf16* Z; const float* bias; bf16* YS;
    __device__ __forceinline__ void q(int R, int c, const f32x4& a) const {
        const f32x4 v = a + *(const f32x4*)(bias + c);
        const u32x2 zz = *(const u32x2*)(Z + (size_t)R * 512 + c);
        const float z0 = bf2f(zz.x & 0xffffu), z1 = bf2f(zz.x >> 16), z2 = bf2f(zz.y & 0xffffu), z3 = bf2f(zz.y >> 16);
        u32x2 w; w.x = pk2(z0 * __builtin_amdgcn_rcpf(1.0f + __expf(-v[0])), z1 * __builtin_amdgcn_rcpf(1.0f + __expf(-v[1]))); w.y = pk2(z2 * __builtin_amdgcn_rcpf(1.0f + __expf(-v[2])), z3 * __builtin_amdgcn_rcpf(1.0f + __expf(-v[3])));
        *(u32x2*)(YS + (size_t)R * 512 + c) = w;
    }
    __device__ __forceinline__ void q2(int R, int c, const f32x4& a0, const f32x4& a1) const {
        const f32x4 v0 = a0 + *(const f32x4*)(bias + c), v1 = a1 + *(const f32x4*)(bias + c + 4);
        const u32x4 zz = *(const u32x4*)(Z + (size_t)R * 512 + c);
        u32x4 w;
        w.x = pk2(bf2f(zz.x & 0xffffu) * __builtin_amdgcn_rcpf(1.0f + __expf(-v0[0])), bf2f(zz.x >> 16) * __builtin_amdgcn_rcpf(1.0f + __expf(-v0[1])));
        w.y = pk2(bf2f(zz.y & 0xffffu) * __builtin_amdgcn_rcpf(1.0f + __expf(-v0[2])), bf2f(zz.y >> 16) * __builtin_amdgcn_rcpf(1.0f + __expf(-v0[3])));
        w.z = pk2(bf2f(zz.z & 0xffffu) * __builtin_amdgcn_rcpf(1.0f + __expf(-v1[0])), bf2f(zz.z >> 16) * __builtin_amdgcn_rcpf(1.0f + __expf(-v1[1])));
        w.w = pk2(bf2f(zz.w & 0xffffu) * __builtin_amdgcn_rcpf(1.0f + __expf(-v1[2])), bf2f(zz.w >> 16) * __builtin_amdgcn_rcpf(1.0f + __expf(-v1[3])));
        *(u32x4*)(YS + (size_t)R * 512 + c) = w;
    }
    EPI_BODY()
};
struct EpiScale {
    static constexpr bool PERM = true, AFTER_DRAIN = false;
    bf16* O; int ldc; const float* scale;
    __device__ __forceinline__ void q(int R, int c, const f32x4& a) const {
        f32x4 v = a;
        if (scale) v = v * *(const f32x4*)(scale + c);
        u32x2 w; w.x = pk2(v[0], v[1]); w.y = pk2(v[2], v[3]);
        *(u32x2*)(O + (size_t)R * ldc + c) = w;
    }
    __device__ __forceinline__ void q2(int R, int c, const f32x4& a0, const f32x4& a1) const {
        f32x4 v0 = a0, v1 = a1;
        if (scale) { v0 = v0 * *(const f32x4*)(scale + c); v1 = v1 * *(const f32x4*)(scale + c + 4); }
        u32x4 w; w.x = pk2(v0[0], v0[1]); w.y = pk2(v0[2], v0[3]); w.z = pk2(v1[0], v1[1]); w.w = pk2(v1[2], v1[3]);
        *(u32x4*)(O + (size_t)R * ldc + c) = w;
    }
    EPI_BODY()
};
template <bool FIRST> struct EpiGate {
    static constexpr bool PERM = true, AFTER_DRAIN = false;
    const float* rowss; const bf16* BR; bf16* MG;
    __device__ __forceinline__ void q(int R, int c, const f32x4& a, float rs) const {
        const f32x4 v = a * rs;
        const u32x2 bb = *(const u32x2*)(BR + (size_t)R * 1024 + c);
        float o0 = bf2f(bb.x & 0xffffu) * __builtin_amdgcn_rcpf(1.0f + __expf(-v[0])), o1 = bf2f(bb.x >> 16) * __builtin_amdgcn_rcpf(1.0f + __expf(-v[1]));
        float o2 = bf2f(bb.y & 0xffffu) * __builtin_amdgcn_rcpf(1.0f + __expf(-v[2])), o3 = bf2f(bb.y >> 16) * __builtin_amdgcn_rcpf(1.0f + __expf(-v[3]));
        if (!FIRST) { const u32x2 mm = *(const u32x2*)(MG + (size_t)R * 1024 + c);
            o0 += bf2f(mm.x & 0xffffu); o1 += bf2f(mm.x >> 16); o2 += bf2f(mm.y & 0xffffu); o3 += bf2f(mm.y >> 16); }
        u32x2 w; w.x = pk2(o0, o1); w.y = pk2(o2, o3);
        *(u32x2*)(MG + (size_t)R * 1024 + c) = w;
    }
    __device__ __forceinline__ void q2(int R, int c, const f32x4& a0, const f32x4& a1, float rs) const {
        const f32x4 v0 = a0 * rs, v1 = a1 * rs;
        const u32x4 bb = *(const u32x4*)(BR + (size_t)R * 1024 + c);
        float o[8];
        o[0] = bf2f(bb.x & 0xffffu) * __builtin_amdgcn_rcpf(1.0f + __expf(-v0[0])); o[1] = bf2f(bb.x >> 16) * __builtin_amdgcn_rcpf(1.0f + __expf(-v0[1]));
        o[2] = bf2f(bb.y & 0xffffu) * __builtin_amdgcn_rcpf(1.0f + __expf(-v0[2])); o[3] = bf2f(bb.y >> 16) * __builtin_amdgcn_rcpf(1.0f + __expf(-v0[3]));
        o[4] = bf2f(bb.z & 0xffffu) * __builtin_amdgcn_rcpf(1.0f + __expf(-v1[0])); o[5] = bf2f(bb.z >> 16) * __builtin_amdgcn_rcpf(1.0f + __expf(-v1[1]));
        o[6] = bf2f(bb.w & 0xffffu) * __builtin_amdgcn_rcpf(1.0f + __expf(-v1[2])); o[7] = bf2f(bb.w >> 16) * __builtin_amdgcn_rcpf(1.0f + __expf(-v1[3]));
        if (!FIRST) { const u32x4 mm = *(const u32x4*)(MG + (size_t)R * 1024 + c);
            o[0] += bf2f(mm.x & 0xffffu); o[1] += bf2f(mm.x >> 16); o[2] += bf2f(mm.y & 0xffffu); o[3] += bf2f(mm.y >> 16);
            o[4] += bf2f(mm.z & 0xffffu); o[5] += bf2f(mm.z >> 16); o[6] += bf2f(mm.w & 0xffffu); o[7] += bf2f(mm.w >> 16); }
        u32x4 w; w.x = pk2(o[0], o[1]); w.y = pk2(o[2], o[3]); w.z = pk2(o[4], o[5]); w.w = pk2(o[6], o[7]);
        *(u32x4*)(MG + (size_t)R * 1024 + c) = w;
    }
    EPI_BODY_RS()
};
struct EpiRes {
    static constexpr bool PERM = true, AFTER_DRAIN = false;
    const float* Xin; bf16* HB; float* rowss_out;
    __device__ __forceinline__ float q(int R, int c, const f32x4& a) const {
        f32x4 h;
        if (Xin && R < NREAL) h = *(const f32x4*)(Xin + (size_t)R * 1024 + c);
        else { const u32x2 hb = *(const u32x2*)(HB + (size_t)R * 1024 + c); h = (f32x4){bf2f(hb.x & 0xffffu), bf2f(hb.x >> 16), bf2f(hb.y & 0xffffu), bf2f(hb.y >> 16)}; }
        h = h + a;
        u32x2 w; w.x = pk2(h[0], h[1]); w.y = pk2(h[2], h[3]);
        *(u32x2*)(HB + (size_t)R * 1024 + c) = w;
        const float r0 = bf2f(w.x & 0xffffu), r1 = bf2f(w.x >> 16), r2 = bf2f(w.y & 0xffffu), r3 = bf2f(w.y >> 16);
        return (r0 * r0 + r1 * r1) + (r2 * r2 + r3 * r3);
    }
    __device__ __forceinline__ float q2(int R, int c, const f32x4& a0, const f32x4& a1) const {
        f32x4 h0, h1;
        if (Xin && R < NREAL) { h0 = *(const f32x4*)(Xin + (size_t)R * 1024 + c); h1 = *(const f32x4*)(Xin + (size_t)R * 1024 + c + 4); }
        else { const u32x4 hb = *(const u32x4*)(HB + (size_t)R * 1024 + c);
            h0 = (f32x4){bf2f(hb.x & 0xffffu), bf2f(hb.x >> 16), bf2f(hb.y & 0xffffu), bf2f(hb.y >> 16)}; h1 = (f32x4){bf2f(hb.z & 0xffffu), bf2f(hb.z >> 16), bf2f(hb.w & 0xffffu), bf2f(hb.w >> 16)}; }
        h0 = h0 + a0; h1 = h1 + a1;
        u32x4 w; w.x = pk2(h0[0], h0[1]); w.y = pk2(h0[2], h0[3]); w.z = pk2(h1[0], h1[1]); w.w = pk2(h1[2], h1[3]);
        *(u32x4*)(HB + (size_t)R * 1024 + c) = w;
        const float r0 = bf2f(w.x & 0xffffu), r1 = bf2f(w.x >> 16), r2 = bf2f(w.y & 0xffffu), r3 = bf2f(w.y >> 16), r4 = bf2f(w.z & 0xffffu), r5 = bf2f(w.z >> 16), r6 = bf2f(w.w & 0xffffu), r7 = bf2f(w.w >> 16);
        return ((r0 * r0 + r1 * r1) + (r2 * r2 + r3 * r3)) + ((r4 * r4 + r5 * r5) + (r6 * r6 + r7 * r7));
    }
    __device__ __forceinline__ void rg(int R, int pn, int wc, int fq, const f32x4 (&a4)[2][2]) const {
        float ss = 0.f;
#pragma unroll
        for (int bj = 0; bj < 2; ++bj) ss += q2(R, pn * 256 + bj * 128 + wc * 32 + 8 * fq, a4[bj][0], a4[bj][1]);
        ss += __shfl_xor(ss, 16); ss += __shfl_xor(ss, 32);
        if (fq == 0) rowss_out[((size_t)pn * TPR + R) * 4 + wc] = ss;
    }
    __device__ __forceinline__ void tq(int R, int c, const f32x4& v) const {
        float ss = q(R, c, v);
        ss += __shfl_xor(ss, 16); ss += __shfl_xor(ss, 32);
        if ((threadIdx.x & 48) == 0) atomicAdd(rowss_out + (size_t)R * 4, ss);
    }
    EPI_OP()
};
struct EpiUp {
    static constexpr bool PERM = true, AFTER_DRAIN = false;
    const float* rowss; bf16* ACT;
    __device__ __forceinline__ void q(int R, int c, const f32x4& a, float rs) const {
        f32x4 v = a * rs;
#pragma unroll
        for (int j = 0; j < 4; ++j) { const float r = fmaxf(v[j], 0.f); v[j] = r * r; }
        u32x2 w; w.x = pk2(v[0], v[1]); w.y = pk2(v[2], v[3]);
        *(u32x2*)(ACT + (size_t)R * FF + c) = w;
    }
    __device__ __forceinline__ void q2(int R, int c, const f32x4& a0, const f32x4& a1, float rs) const {
        f32x4 v0 = a0 * rs, v1 = a1 * rs;
#pragma unroll
        for (int j = 0; j < 4; ++j) { const float r0 = fmaxf(v0[j], 0.f), r1 = fmaxf(v1[j], 0.f); v0[j] = r0 * r0; v1[j] = r1 * r1; }
        u32x4 w; w.x = pk2(v0[0], v0[1]); w.y = pk2(v0[2], v0[3]); w.z = pk2(v1[0], v1[1]); w.w = pk2(v1[2], v1[3]);
        *(u32x4*)(ACT + (size_t)R * FF + c) = w;
    }
    EPI_BODY_RS()
};
struct TripleOrder {
    pg8::StaticOrder S0; int arow, bcol;
    __device__ __forceinline__ void init(int G, int c, int arow_, int bcol_) { S0.init(NREAL, 1024, G, c); arow = arow_; bcol = bcol_; }
    __device__ __forceinline__ bool next(int i, pg8::Unit& u) const { pg8::Unit t; t.pm = 0; t.pn = 0; if (!S0.next(i / 3, t)) return false; const int br = i % 3; u.pm = t.pm + br * arow; u.pn = t.pn + br * bcol; return true; }
    __device__ __forceinline__ void a_ready(const pg8::Unit&) const {}
    __device__ __forceinline__ void done(const pg8::Unit&) const {}
};
struct EpiBr3 {
    static constexpr bool PERM = true, AFTER_DRAIN = false;
    bf16* Bbase; int arow;
    __device__ __forceinline__ void operator()(const f32x4 (&acc)[2][2][4][2], const pg8::Unit& u, int wr, int wc, int fr, int fq) const {
        const int c = u.pn >> 2, pn = u.pn & 3, pm = u.pm - arow * c; bf16* O = Bbase + (size_t)(2 * c + 2 * (c > 0)) * (UU / 2);
#pragma unroll
        for (int ai = 0; ai < 2; ++ai)
#pragma unroll
            for (int m = 0; m < 4; ++m) { const int R = pm * 256 + ai * 128 + wr * 64 + m * 16 + fr;
#pragma unroll
                for (int bj = 0; bj < 2; ++bj) { const f32x4 v0 = acc[ai][bj][m][0], v1 = acc[ai][bj][m][1];
                    u32x4 w; w.x = pk2(v0[0], v0[1]); w.y = pk2(v0[2], v0[3]); w.z = pk2(v1[0], v1[1]); w.w = pk2(v1[2], v1[3]);
                    *(u32x4*)(O + (size_t)R * 1024 + pn * 256 + bj * 128 + wc * 32 + 8 * fq) = w; } }
    }
};
struct EpiGate3 {
    static constexpr bool PERM = true, AFTER_DRAIN = false;
    const float* rowss; const bf16* Bbase; bf16* MG;
    __device__ __forceinline__ void operator()(const f32x4 (&acc)[2][2][4][2], const pg8::Unit& u, int wr, int wc, int fr, int fq) const {
        const int c = u.pn >> 2, pn = u.pn & 3; const bf16* BR = Bbase + (size_t)(2 * c + 2 * (c > 0)) * (UU / 2);
#pragma unroll
        for (int ai = 0; ai < 2; ++ai)
#pragma unroll
            for (int m = 0; m < 4; ++m) { const int R = u.pm * 256 + ai * 128 + wr * 64 + m * 16 + fr; const float rs = row_rstd(rowss, R);
#pragma unroll
                for (int bj = 0; bj < 2; ++bj) { const int cc = pn * 256 + bj * 128 + wc * 32 + 8 * fq;
                    const f32x4 v0 = acc[ai][bj][m][0] * rs, v1 = acc[ai][bj][m][1] * rs;
                    const u32x4 bb = *(const u32x4*)(BR + (size_t)R * 1024 + cc);
                    float o[8];
                    o[0] = bf2f(bb.x & 0xffffu) * __builtin_amdgcn_rcpf(1.0f + __expf(-v0[0])); o[1] = bf2f(bb.x >> 16) * __builtin_amdgcn_rcpf(1.0f + __expf(-v0[1]));
                    o[2] = bf2f(bb.y & 0xffffu) * __builtin_amdgcn_rcpf(1.0f + __expf(-v0[2])); o[3] = bf2f(bb.y >> 16) * __builtin_amdgcn_rcpf(1.0f + __expf(-v0[3]));
                    o[4] = bf2f(bb.z & 0xffffu) * __builtin_amdgcn_rcpf(1.0f + __expf(-v1[0])); o[5] = bf2f(bb.z >> 16) * __builtin_amdgcn_rcpf(1.0f + __expf(-v1[1]));
                    o[6] = bf2f(bb.w & 0xffffu) * __builtin_amdgcn_rcpf(1.0f + __expf(-v1[2])); o[7] = bf2f(bb.w >> 16) * __builtin_amdgcn_rcpf(1.0f + __expf(-v1[3]));
                    if (c != 0) { const u32x4 mm = *(const u32x4*)(MG + (size_t)R * 1024 + cc);
                        o[0] += bf2f(mm.x & 0xffffu); o[1] += bf2f(mm.x >> 16); o[2] += bf2f(mm.y & 0xffffu); o[3] += bf2f(mm.y >> 16);
                        o[4] += bf2f(mm.z & 0xffffu); o[5] += bf2f(mm.z >> 16); o[6] += bf2f(mm.w & 0xffffu); o[7] += bf2f(mm.w >> 16); }
                    u32x4 w; w.x = pk2(o[0], o[1]); w.y = pk2(o[2], o[3]); w.z = pk2(o[4], o[5]); w.w = pk2(o[6], o[7]);
                    *(u32x4*)(MG + (size_t)R * 1024 + cc) = w; } }
    }
};
template <class Epi>
__device__ __forceinline__ void thin_gemm(LAS unsigned char* lds, const bf16* A, const bf16* Bt, int K, int N, const Epi& E, int vb, int vg) {
    int tid_l = threadIdx.x; asm volatile("" : "+v"(tid_l));
    const int lane = tid_l & 63, w = __builtin_amdgcn_readfirstlane(tid_l >> 6), fr = lane & 15, fq = lane >> 4;
    LAS f32x4* red = (LAS f32x4*)lds;
    const int kw = K >> 3;
    for (int pc = vb; pc < N / 16; pc += vg) {
        const bf16* ap = A + (size_t)(NREAL + fr) * K + w * kw + 8 * fq;
        const bf16* bp = Bt + (size_t)(16 * pc + fr) * K + w * kw + 8 * fq;
        f32x4 acc[8];
#pragma unroll
        for (int rb = 0; rb < 8; ++rb) acc[rb] = (f32x4){0.f, 0.f, 0.f, 0.f};
#pragma unroll 2
        for (int k0 = 0; k0 < kw; k0 += 32) {
            const bf16x8 bf = *(const bf16x8*)(bp + k0);
            bf16x8 af[8];
#pragma unroll
            for (int rb = 0; rb < 8; ++rb) af[rb] = *(const bf16x8*)(ap + (size_t)(16 * rb) * K + k0);
#pragma unroll
            for (int rb = 0; rb < 8; ++rb) acc[rb] = __builtin_amdgcn_mfma_f32_16x16x32_bf16(bf, af[rb], acc[rb], 0, 0, 0);
        }
        asm volatile("s_nop 15\n\ts_nop 15" : "+v"(acc[0]), "+v"(acc[1]), "+v"(acc[2]), "+v"(acc[3]), "+v"(acc[4]), "+v"(acc[5]), "+v"(acc[6]), "+v"(acc[7]));
#pragma unroll
        for (int rb = 0; rb < 8; ++rb) red[(w * 8 + rb) * 64 + lane] = acc[rb];
        LDS_FENCE(); __syncthreads();
        f32x4 v = red[(0 * 8 + w) * 64 + lane];
#pragma unroll
        for (int ww = 1; ww < 8; ++ww) v = v + red[(ww * 8 + w) * 64 + lane];
        LDS_FENCE(); __syncthreads();
        E.tq(NREAL + 16 * w + fr, 16 * pc + 4 * fq, v);
    }
}

struct Args { const float* in[23]; float* out; unsigned char* ws; };

__device__ __forceinline__ void p0_item(const float* W, int ldw, int K, const float* scale, bf16* WT, int permrows, LAS float* scr, int item, int nblk, int lane) {
    const int kb = item / nblk, nb = item % nblk, k0 = 64 * kb, n0 = 64 * nb;
#pragma unroll 4
    for (int i = 0; i < 16; ++i) {
        const int kk = 4 * i + (lane >> 4), c4 = (lane & 15) * 4;
        f32x4 w = *(const f32x4*)(W + (size_t)(k0 + kk) * ldw + n0 + c4);
        if (scale) w = w * scale[k0 + kk];
        scr[kk * 65 + c4] = w[0]; scr[kk * 65 + c4 + 1] = w[1]; scr[kk * 65 + c4 + 2] = w[2]; scr[kk * 65 + c4 + 3] = w[3];
    }
    LDS_FENCE();
    const int c = lane & 7;
#pragma unroll
    for (int j = 0; j < 8; ++j) {
        const int n = (lane >> 3) + 8 * j;
        const int sc = (n0 + n) < permrows ? ((n & 1) ? 32 + (n >> 1) : (n >> 1)) : n;
        const LAS float* s = scr + (8 * c) * 65 + sc;
        u32x4 o; o.x = pk2(s[0 * 65], s[1 * 65]); o.y = pk2(s[2 * 65], s[3 * 65]); o.z = pk2(s[4 * 65], s[5 * 65]); o.w = pk2(s[6 * 65], s[7 * 65]);
        *(u32x4*)(WT + (size_t)(n0 + n) * K + k0 + 8 * c) = o;
    }
    LDS_FENCE();
}

typedef const __attribute__((address_space(4))) Args* KArgsP;
__device__ __forceinline__ void convert_layer_weights(KArgsP ka, LAS unsigned char* lds, int layer, int vw, int nvw, int wave, int lane, int part  ) {
    unsigned char* ws = ka->ws;
    LAS float* scr = (LAS float*)(lds + wave * 17408);
    constexpr int I_IN = 16 * 76, I_GLU = 8 * 8, I_BR = 8 * 16, I_OUT = 16 * 16, I_UP = 16 * 64, I_DN = 64 * 16, I_L = I_IN + I_GLU + 3 * I_BR + I_OUT + I_UP + I_DN;
    unsigned char* wl = ws + WS_W + (size_t)layer * LW_BYTES;
    for (int it = (part == 0 ? 0 : I_IN) + vw; it < (part == 0 ? I_IN : I_L); it += nvw) {
        int r = it;
        if (r < I_IN) { p0_item(ka->in[3] + (size_t)layer * DM * DIN, DIN, DM, ka->in[2] + layer * DM, (bf16*)(wl + OW_IN), 640, scr, r, 76, lane); continue; } r -= I_IN;
        if (r < I_GLU) { p0_item(ka->in[13] + (size_t)layer * 512 * 512, 512, 512, nullptr, (bf16*)(wl + OW_GLU), 0, scr, r, 8, lane); continue; } r -= I_GLU;
        if (r < 3 * I_BR) { const int c = r / I_BR; p0_item(ka->in[17] + ((size_t)layer * 3 + c) * 512 * 1024, 1024, 512, nullptr, (bf16*)(wl + OW_BR) + (size_t)c * 1024 * 512, 0, scr, r % I_BR, 16, lane); continue; } r -= 3 * I_BR;
        if (r < I_OUT) { p0_item(ka->in[18] + (size_t)layer * DM * DM, DM, DM, nullptr, (bf16*)(wl + OW_OUT), 0, scr, r, 16, lane); continue; } r -= I_OUT;
        if (r < I_UP) { p0_item(ka->in[20] + (size_t)layer * DM * FF, FF, DM, ka->in[19] + layer * DM, (bf16*)(wl + OW_UP), 0, scr, r, 64, lane); continue; } r -= I_UP;
        p0_item(ka->in[21] + (size_t)layer * FF * DM, DM, FF, nullptr, (bf16*)(wl + OW_DN), 0, scr, r, 16, lane);
    }
    if (part == 1) for (int i = vw * 64 + lane; i < 512 * 64; i += nvw * 64) {
        const int n = i >> 6, k0 = (i & 63) * 8;
        u32x4 o = {0u, 0u, 0u, 0u};
        if ((n >> 7) == (k0 >> 7)) { const float* src = ka->in[15] + (((size_t)layer * 4 + (n >> 7)) * 128 + (k0 & 127)) * 128 + (n & 127);
            o.x = pk2(src[0], src[128]); o.y = pk2(src[256], src[384]); o.z = pk2(src[512], src[640]); o.w = pk2(src[768], src[896]); }
        *(u32x4*)((bf16*)(wl + OW_POOL) + (size_t)n * 512 + k0) = o;
    }
}

__device__ __forceinline__ void p0_prologue(const Args& a, LAS unsigned char* lds) {
    int tl_ = threadIdx.x; asm volatile("" : "+v"(tl_));
    const int tid = tl_, lane = tid & 63, wave = __builtin_amdgcn_readfirstlane(tid >> 6);
    const int gw = blockIdx.x * 8 + wave, NGW = gridDim.x * 8;
    const int gt = blockIdx.x * 512 + tid, NGT = gridDim.x * 512;
    unsigned char* ws = a.ws;
    for (int i = gt; i < 4 * 4 * 128 * 4; i += NGT) { const int idx = 1 + (i >> 11), pn = (i >> 9) & 3, r = (i >> 2) & 127, sl = i & 3;
        ((float*)(ws + WS_RS))[((size_t)idx * 4 * TPR + (size_t)pn * TPR + NREAL + r) * 4 + sl] = 0.f; }
    for (int i = gt; i < LL * 32; i += NGT) {
        const int l = i >> 5, f = i & 31;
        const float invf = (float)dexp(-(double)f * (9.21034037197618273607 / 32.0));
        const float ang = (float)l * invf;
        double s, c; dsincos((double)ang, s, c);
        float* rp = (float*)(ws + WS_ROPE) + (size_t)i * 2; rp[0] = (float)c; rp[1] = (float)s;
    }
    for (int i = gt; i < 2 * 2 * 32 * 64; i += NGT) {
        const int n = i & 63, pidx = i >> 6;
        const double lr = (double)a.in[5][i], li = (double)a.in[6][i];
        const double dt = (double)(float)dexp((double)a.in[7][pidx]);
        const double mag = dexp(lr * dt); double sn, cn; dsincos(li * dt, sn, cn);
        const double are = mag * cn, aim = mag * sn, den = lr * lr + li * li, nre = are - 1.0;
        const double fre = (nre * lr + aim * li) / den, fim = (aim * lr - nre * li) / den;
        float* ab = (float*)(ws + WS_ABAR) + (size_t)i * 2; ab[0] = (float)are; ab[1] = (float)aim;
        bf16* bm = (bf16*)(ws + WS_BMAT) + (size_t)pidx * 128 * 16;
        bf16* cm = (bf16*)(ws + WS_CMAT) + (size_t)pidx * 16 * 128;
        for (int q = 0; q < 16; ++q) {
            const double br = (double)a.in[8][(size_t)i * 16 + q], bi = (double)a.in[9][(size_t)i * 16 + q];
            bm[n * 16 + q] = (bf16)f2bf((float)(fre * br - fim * bi));
            bm[(64 + n) * 16 + q] = (bf16)f2bf((float)(fre * bi + fim * br));
            *(unsigned*)(cm + q * 128 + 2 * n) = pk2(a.in[10][((size_t)pidx * 16 + q) * 64 + n], -a.in[11][((size_t)pidx * 16 + q) * 64 + n]);
        }
    }
    for (int R = gw; R < TPR; R += NGW) {
        const int mrow = R - NREAL;
        const float* src = R < NREAL ? a.in[0] + (size_t)R * DM : a.in[1] + (size_t)(mrow & 15) * DM;
        float* dst = R < NREAL ? a.out + (size_t)R * DM : (float*)(ws + WS_HM) + (size_t)mrow * DM;
        bf16* hb = (bf16*)(ws + WS_HB) + (size_t)R * DM;
        const bool pad = mrow >= NB * NMETA;
        float ss = 0.f;
#pragma unroll
        for (int j = 0; j < 4; ++j) {
            f32x4 v = *(const f32x4*)(src + 4 * lane + 256 * j);
            if (pad) v = (f32x4){0.f, 0.f, 0.f, 0.f};
            ss += (v[0] * v[0] + v[1] * v[1]) + (v[2] * v[2] + v[3] * v[3]);
            u32x2 w; w.x = pk2(v[0], v[1]); w.y = pk2(v[2], v[3]);
            *(u32x2*)(hb + 4 * lane + 256 * j) = w;
        }
#pragma unroll
        for (int o = 1; o < 64; o <<= 1) ss += __shfl_xor(ss, o);
        if (lane < 16) ((float*)(ws + WS_RS))[((size_t)(lane >> 2) * TPR + R) * 4 + (lane & 3)] = lane == 0 ? ss : 0.f;
    }
}

__device__ __forceinline__ void ssm_task(LAS unsigned char* lds, int task, int layer, const bf16* SU, float* YF,
                                         const float* abar_all, const bf16* bmat_all, const bf16* cmat_all) {
    int tid_l = threadIdx.x; asm volatile("" : "+v"(tid_l));
    const int tid = tid_l, lane = tid & 63, wave = __builtin_amdgcn_readfirstlane(tid >> 6);
    const int b = task >> 5, g = task & 31;
    __syncthreads();
    LAS float* BU = (LAS float*)(lds + wave * 12800);
    LAS unsigned short* X = (LAS unsigned short*)(lds + wave * 12800 + 8448);
    LAS float* SX = (LAS float*)(lds + 8 * 12800);
    const int blk0 = wave == 0 ? 0 : 16 * wave + 1, nblk = wave == 0 ? 17 : 16;
    bf16* yfb = (bf16*)YF + (size_t)task * LL * 16;
    const int fr = lane & 15, fq = lane >> 4;
    const bf16x8 zero8 = {0, 0, 0, 0, 0, 0, 0, 0};
    for (int dir = 0; dir < 2; ++dir) {
        const int pidx = (layer * 2 + dir) * 32 + g;
        const float are = abar_all[((size_t)pidx * 64 + lane) * 2], aim = abar_all[((size_t)pidx * 64 + lane) * 2 + 1];
        bf16x8 bfr[8], cfr[4];
        const bf16* bm = bmat_all + (size_t)pidx * 128 * 16;
#pragma unroll
        for (int nt = 0; nt < 8; ++nt) bfr[nt] = fq < 2 ? *(const bf16x8*)(bm + (nt * 16 + fr) * 16 + 8 * fq) : zero8;
        const bf16* cm = cmat_all + (size_t)pidx * 16 * 128;
#pragma unroll
        for (int ks = 0; ks < 4; ++ks) cfr[ks] = *(const bf16x8*)(cm + fr * 128 + ks * 32 + 8 * fq);
        float p16r = are, p16i = aim;
#pragma unroll
        for (int i = 0; i < 4; ++i) { const float tr = p16r * p16r - p16i * p16i, ti = 2.f * p16r * p16i; p16r = tr; p16i = ti; }
        float p256r = p16r, p256i = p16i;
#pragma unroll
        for (int i = 0; i < 4; ++i) { const float tr = p256r * p256r - p256i * p256i, ti = 2.f * p256r * p256i; p256r = tr; p256i = ti; }
        const float p272r = p256r * p16r - p256i * p16i, p272i = p256r * p16i + p256i * p16r;

        float xre = 0.f, xim = 0.f;
        for (int pass = 0; pass < 2; ++pass) {
            bf16x8 unext;
            { const int blkf = dir == 0 ? blk0 : blk0 + nblk - 1; const int Rf = blkf == 0 ? NREAL + b * NMETA : b * SEQ + blkf * 16 - NMETA;
              unext = fq < 2 ? *(const bf16x8*)(SU + (size_t)(Rf + fr) * 512 + g * 16 + 8 * fq) : zero8; }
            for (int ib = 0; ib < nblk; ++ib) {
                const int blk = dir == 0 ? blk0 + ib : blk0 + nblk - 1 - ib;
                const bf16x8 ufr = unext;
                if (ib + 1 < nblk) { const int blkn = dir == 0 ? blk + 1 : blk - 1; const int Rn = blkn == 0 ? NREAL + b * NMETA : b * SEQ + blkn * 16 - NMETA;
                    unext = fq < 2 ? *(const bf16x8*)(SU + (size_t)(Rn + fr) * 512 + g * 16 + 8 * fq) : zero8; }
                f32x4 dd[8];
#pragma unroll
                for (int nt = 0; nt < 8; ++nt) { dd[nt] = (f32x4){0.f, 0.f, 0.f, 0.f}; dd[nt] = __builtin_amdgcn_mfma_f32_16x16x32_bf16(ufr, bfr[nt], dd[nt], 0, 0, 0); }
                asm volatile("s_nop 15\n\ts_nop 15" : "+v"(dd[0]), "+v"(dd[1]), "+v"(dd[2]), "+v"(dd[3]), "+v"(dd[4]), "+v"(dd[5]), "+v"(dd[6]), "+v"(dd[7]));
#pragma unroll
                for (int nt = 0; nt < 8; ++nt)
#pragma unroll
                    for (int r = 0; r < 4; ++r) BU[(4 * fq + r) * 132 + nt * 16 + fr] = dd[nt][r];
                LDS_FENCE();
                float bur[16], bui[16];
#pragma unroll
                for (int i = 0; i < 16; ++i) { const int tt = dir == 0 ? i : 15 - i; bur[i] = BU[tt * 132 + lane]; bui[i] = BU[tt * 132 + 64 + lane]; }
                if (pass == 0) {
#pragma unroll
                    for (int i = 0; i < 16; ++i) {
                        const float bre = bur[i], bim = bui[i];
                        const float nr = are * xre - aim * xim + bre, ni = are * xim + aim * xre + bim; xre = nr; xim = ni;
                    }
                    LDS_FENCE();
                } else {
#pragma unroll
                    for (int i = 0; i < 16; ++i) {
                        const int tt = dir == 0 ? i : 15 - i;
                        const float bre = bur[i], bim = bui[i];
                        const float nr = are * xre - aim * xim + bre, ni = are * xim + aim * xre + bim; xre = nr; xim = ni;
                        *(LAS unsigned*)(X + tt * 136 + 2 * lane) = pk2(xre, xim);
                    }
                    LDS_FENCE();
                    f32x4 y = {0.f, 0.f, 0.f, 0.f};
#pragma unroll
                    for (int ks = 0; ks < 4; ++ks) {
                        const bf16x8 afr = *(const LAS bf16x8*)(X + fr * 136 + ks * 32 + 8 * fq);
                        y = __builtin_amdgcn_mfma_f32_16x16x32_bf16(afr, cfr[ks], y, 0, 0, 0);
                    }
                    asm volatile("s_nop 15\n\ts_nop 15" : "+v"(y));
                    LDS_FENCE();
                    {
                        bf16* yd = yfb + (size_t)dir * 256 * LL * 16;
#pragma unroll
                        for (int r = 0; r < 4; ++r) yd[(size_t)(blk * 16 + 4 * fq + r) * 16 + fr] = (bf16)f2bf(y[r]);
                    }
                }
            }
            if (pass == 0) {
                SX[(wave * 64 + lane) * 2] = xre; SX[(wave * 64 + lane) * 2 + 1] = xim;
                LDS_FENCE(); __syncthreads();
                float cre = 0.f, cim = 0.f;
                if (dir == 0) {
                    for (int w = 0; w < wave; ++w) { const float pr = w == 0 ? p272r : p256r, pi = w == 0 ? p272i : p256i;
                        const float sr = SX[(w * 64 + lane) * 2], si = SX[(w * 64 + lane) * 2 + 1];
                        const float nr = pr * cre - pi * cim + sr, ni = pr * cim + pi * cre + si; cre = nr; cim = ni; }
                } else {
                    for (int w = 7; w > wave; --w) {
                        const float sr = SX[(w * 64 + lane) * 2], si = SX[(w * 64 + lane) * 2 + 1];
                        const float nr = p256r * cre - p256i * cim + sr, ni = p256r * cim + p256i * cre + si; cre = nr; cim = ni; }
                }
                xre = cre; xim = cim;
            }
        }
        LDS_FENCE(); __syncthreads();
    }
}

constexpr int ATT_KROW = 72, ATT_VROW = 40, ATT_KT = 32 * ATT_KROW * 2  , ATT_VT = 64 * ATT_VROW * 2  , ATT_MAXT = 11, ATT_VOFF = ATT_MAXT * ATT_KT;
static_assert(ATT_VOFF + ATT_MAXT * ATT_VT <= 131072, "attention LDS");
__device__ __forceinline__ void attn_task(LAS unsigned char* lds, int task, const bf16* Q, const bf16* K, const bf16* V, bf16* YA, const float* sink) {
    int tid_l = threadIdx.x; asm volatile("" : "+v"(tid_l));
    const int tid = tid_l, lane = tid & 63, wave = __builtin_amdgcn_readfirstlane(tid >> 6);
    const int qb = task < 512 ? (task & 31) : 32, bh = task < 512 ? (task >> 5) : task - 512, h = bh & 1, b = bh >> 1;
    const int l0 = qb * 64;
    __syncthreads();
    int jlo = (l0 - 128) >> 5; if (jlo < 1) jlo = 1;
    int jhi = (l0 + 191) >> 5; if (jhi > 64) jhi = 64;
    const int ntiles = 1 + (jhi - jlo + 1);
    LAS unsigned short* Ks = (LAS unsigned short*)lds;
    LAS unsigned short* Vs = (LAS unsigned short*)(lds + ATT_VOFF);
    for (int idx = tid; idx < ntiles * 32 * 8; idx += 512) {
        const int ch = idx & 7, key = idx >> 3, slot = key >> 5, kk = key & 31;
        const int lk = (slot == 0 ? 0 : (jlo + slot - 1) * 32) + kk;
        u32x4 kv = {0u, 0u, 0u, 0u}, vv = {0u, 0u, 0u, 0u};
        if (lk < LL) { const size_t R = (size_t)tok_row(b, lk);
            kv = *(const u32x4*)(K + R * 128 + h * 64 + ch * 8); vv = *(const u32x4*)(V + R * 128 + h * 64 + ch * 8); }
        *(LAS u32x4*)(Ks + slot * (ATT_KT / 2) + kk * ATT_KROW + ch * 8) = kv;
        LAS unsigned short* vd = Vs + slot * (ATT_VT / 2) + (ch * 8) * ATT_VROW + kk;
        vd[0 * ATT_VROW] = (unsigned short)(vv.x & 0xffffu); vd[1 * ATT_VROW] = (unsigned short)(vv.x >> 16);
        vd[2 * ATT_VROW] = (unsigned short)(vv.y & 0xffffu); vd[3 * ATT_VROW] = (unsigned short)(vv.y >> 16);
        vd[4 * ATT_VROW] = (unsigned short)(vv.z & 0xffffu); vd[5 * ATT_VROW] = (unsigned short)(vv.z >> 16);
        vd[6 * ATT_VROW] = (unsigned short)(vv.w & 0xffffu); vd[7 * ATT_VROW] = (unsigned short)(vv.w >> 16);
    }
    LDS_FENCE(); __syncthreads();
    const int head = h * 4 + (wave >> 1), r32 = lane & 31, hi = lane >> 5;
    const int lq = l0 + 32 * (wave & 1) + r32;
    const bool qvalid = lq < LL;
    const size_t Rq = (size_t)tok_row(b, qvalid ? lq : LL - 1);
    bf16x8 qf[4];
#pragma unroll
    for (int ks = 0; ks < 4; ++ks) qf[ks] = *(const bf16x8*)(Q + Rq * 512 + head * 64 + ks * 16 + 8 * hi);
    float mrun = sink[head], lsum = hi == 0 ? 1.0f : 0.0f;
    f32x16 o0, o1;
#pragma unroll
    for (int i = 0; i < 16; ++i) { o0[i] = 0.f; o1[i] = 0.f; }
    const int lqw = l0 + 32 * (wave & 1);
    for (int slot = 0; slot < ntiles; ++slot) {
        const int kbase = slot == 0 ? 0 : (jlo + slot - 1) * 32;
        if (lqw >= LL || (slot != 0 && (kbase + 31 < lqw - 128 || kbase > lqw + 31 + 128))) continue;
        const LAS unsigned short* kt = Ks + slot * (ATT_KT / 2);
        f32x16 s;
#pragma unroll
        for (int i = 0; i < 16; ++i) s[i] = 0.f;
#pragma unroll
        for (int ks = 0; ks < 4; ++ks) {
            const bf16x8 kf = *(const LAS bf16x8*)(kt + r32 * ATT_KROW + ks * 16 + 8 * hi);
            s = __builtin_amdgcn_mfma_f32_32x32x16_bf16(kf, qf[ks], s, 0, 0, 0);
        }
        asm volatile("s_nop 15\n\ts_nop 15" : "+v"(s));
        float mt = -1e30f;
#pragma unroll
        for (int i = 0; i < 16; ++i) {
            const int lk = kbase + (i & 3) + 8 * (i >> 2) + 4 * hi;
            int d = lq - lk; d = d < 0 ? -d : d;
            const bool valid = (lk < NMETA) || (d <= 128 && lk < LL);
            s[i] = valid ? s[i] : -1e30f;
            mt = fmaxf(mt, s[i]);
        }
        mt = fmaxf(mt, __shfl_xor(mt, 32));
        const float mnew = fmaxf(mrun, mt);
        const float alpha = __expf(mrun - mnew);
        mrun = mnew;
        float ps = 0.f;
#pragma unroll
        for (int i = 0; i < 16; ++i) { s[i] = __expf(s[i] - mnew); ps += s[i]; }
        lsum = lsum * alpha + ps;
#pragma unroll
        for (int i = 0; i < 16; ++i) { o0[i] *= alpha; o1[i] *= alpha; }
        const LAS unsigned short* vt = Vs + slot * (ATT_VT / 2);
#pragma unroll
        for (int s2 = 0; s2 < 2; ++s2) {
            union { bf16x8 v; unsigned u[4]; } pf;
            pf.u[0] = pk2(s[8 * s2 + 0], s[8 * s2 + 1]); pf.u[1] = pk2(s[8 * s2 + 2], s[8 * s2 + 3]);
            pf.u[2] = pk2(s[8 * s2 + 4], s[8 * s2 + 5]); pf.u[3] = pk2(s[8 * s2 + 6], s[8 * s2 + 7]);
#pragma unroll
            for (int dt = 0; dt < 2; ++dt) {
                union { bf16x8 v; u32x2 u[2]; } vf;
                const LAS unsigned short* vp = vt + (dt * 32 + r32) * ATT_VROW + 16 * s2 + 4 * hi;
                vf.u[0] = *(const LAS u32x2*)(vp); vf.u[1] = *(const LAS u32x2*)(vp + 8);
                if (dt == 0) o0 = __builtin_amdgcn_mfma_f32_32x32x16_bf16(vf.v, pf.v, o0, 0, 0, 0);
                else o1 = __builtin_amdgcn_mfma_f32_32x32x16_bf16(vf.v, pf.v, o1, 0, 0, 0);
            }
        }
    }
    asm volatile("s_nop 15\n\ts_nop 15" : "+v"(o0), "+v"(o1));
    lsum += __shfl_xor(lsum, 32);
    const float inv = 1.0f / lsum;
    if (qvalid) {
#pragma unroll
        for (int g4 = 0; g4 < 4; ++g4) {
            u32x2 w0, w1;
            w0.x = pk2(o0[4 * g4] * inv, o0[4 * g4 + 1] * inv); w0.y = pk2(o0[4 * g4 + 2] * inv, o0[4 * g4 + 3] * inv);
            w1.x = pk2(o1[4 * g4] * inv, o1[4 * g4 + 1] * inv); w1.y = pk2(o1[4 * g4 + 2] * inv, o1[4 * g4 + 3] * inv);
            *(u32x2*)(YA + Rq * 512 + head * 64 + 8 * g4 + 4 * hi) = w0;
            *(u32x2*)(YA + Rq * 512 + head * 64 + 32 + 8 * g4 + 4 * hi) = w1;
        }
    }
    __syncthreads();
}

__device__ __forceinline__ void pool_diff(LAS unsigned char* lds, const bf16* PU, bf16* PD) {
    int tl_ = threadIdx.x; asm volatile("" : "+v"(tl_));
    constexpr int TOK = 65, HALO = 8, ROWS = TOK + 2 * HALO, NTOK = NB * LL;
    for (int blk = blockIdx.x; blk * TOK < NTOK; blk += gridDim.x) {
        const int f0 = blk * TOK;
        __syncthreads();
        for (int i = tl_; i < ROWS * 64; i += 512) {
            const int r = i >> 6, ch = i & 63, f = f0 - HALO + r;
            u32x4 v = {0u, 0u, 0u, 0u};
            if (f >= 0 && f < NTOK) { const int b = f / LL, l = f % LL; v = *(const u32x4*)(PU + (size_t)tok_row(b, l) * 512 + ch * 8); }
            *(LAS u32x4*)(lds + (size_t)i * 16) = v;
        }
        LDS_FENCE(); __syncthreads();
        for (int i = tl_; i < TOK * 64; i += 512) {
            const int t = i >> 6, ch = i & 63, f = f0 + t;
            if (f >= NTOK) continue;
            const int b = f / LL, l = f % LL, half = 1 << (ch >> 4);
            const int lo = l - half < 0 ? 0 : l - half, hh = l + half > LL ? LL : l + half;
            float s[8];
#pragma unroll
            for (int j = 0; j < 8; ++j) s[j] = 0.f;
            for (int lp = lo; lp < hh; ++lp) {
                const u32x4 v = *(const LAS u32x4*)(lds + (size_t)((t + HALO + lp - l) * 64 + ch) * 16);
                s[0] += bf2f(v.x & 0xffffu); s[1] += bf2f(v.x >> 16); s[2] += bf2f(v.y & 0xffffu); s[3] += bf2f(v.y >> 16);
                s[4] += bf2f(v.z & 0xffffu); s[5] += bf2f(v.z >> 16); s[6] += bf2f(v.w & 0xffffu); s[7] += bf2f(v.w >> 16);
            }
            const float ic = 1.0f / (float)(hh - lo);
            const u32x4 v = *(const LAS u32x4*)(lds + (size_t)((t + HALO) * 64 + ch) * 16);
            u32x4 o;
            o.x = pk2(s[0] * ic - bf2f(v.x & 0xffffu), s[1] * ic - bf2f(v.x >> 16)); o.y = pk2(s[2] * ic - bf2f(v.y & 0xffffu), s[3] * ic - bf2f(v.y >> 16));
            o.z = pk2(s[4] * ic - bf2f(v.z & 0xffffu), s[5] * ic - bf2f(v.z >> 16)); o.w = pk2(s[6] * ic - bf2f(v.w & 0xffffu), s[7] * ic - bf2f(v.w >> 16));
            *(u32x4*)(PD + (size_t)tok_row(b, l) * 512 + ch * 8) = o;
        }
    }
    __syncthreads();
}

__device__ __forceinline__ void z_pass(const float* YF, const bf16* SU, const float* dskip, bf16* Z) {
    int tl_ = threadIdx.x; asm volatile("" : "+v"(tl_)); const int gt = blockIdx.x * 512 + tl_, NGT = gridDim.x * 512;
    for (int i = gt; i < NB * LL * 64; i += NGT) {
        const int ch = i & 63, tk = i >> 6, b = tk / LL, l = tk % LL, g = ch >> 1;
        const size_t R = (size_t)tok_row(b, l);
        const bf16* yp = (const bf16*)YF + ((size_t)(b * 32 + g) * LL + l) * 16 + (ch & 1) * 8;
        const u32x4 ya = *(const u32x4*)yp, yb = *(const u32x4*)(yp + (size_t)256 * LL * 16);
        f32x4 y0, y1;
        y0[0] = bf2f(ya.x & 0xffffu) + bf2f(yb.x & 0xffffu); y0[1] = bf2f(ya.x >> 16) + bf2f(yb.x >> 16); y0[2] = bf2f(ya.y & 0xffffu) + bf2f(yb.y & 0xffffu); y0[3] = bf2f(ya.y >> 16) + bf2f(yb.y >> 16);
        y1[0] = bf2f(ya.z & 0xffffu) + bf2f(yb.z & 0xffffu); y1[1] = bf2f(ya.z >> 16) + bf2f(yb.z >> 16); y1[2] = bf2f(ya.w & 0xffffu) + bf2f(yb.w & 0xffffu); y1[3] = bf2f(ya.w >> 16) + bf2f(yb.w >> 16);
        const f32x4 d0 = *(const f32x4*)(dskip + ch * 8), d1 = *(const f32x4*)(dskip + ch * 8 + 4);
        const u32x4 uu = *(const u32x4*)(SU + R * 512 + ch * 8);
        float t[8];
        t[0] = y0[0] + d0[0] * bf2f(uu.x & 0xffffu); t[1] = y0[1] + d0[1] * bf2f(uu.x >> 16); t[2] = y0[2] + d0[2] * bf2f(uu.y & 0xffffu); t[3] = y0[3] + d0[3] * bf2f(uu.y >> 16);
        t[4] = y1[0] + d1[0] * bf2f(uu.z & 0xffffu); t[5] = y1[1] + d1[1] * bf2f(uu.z >> 16); t[6] = y1[2] + d1[2] * bf2f(uu.w & 0xffffu); t[7] = y1[3] + d1[3] * bf2f(uu.w >> 16);
#pragma unroll
        for (int j = 0; j < 8; ++j) {
            const float v = t[j], tt = __builtin_amdgcn_rcpf(fabsf(v) * 0.2316418882f + 1.0f);
            float q = tt * 0.5307027145f + (-0.7265760135f); q = q * tt + 0.7107068705f; q = q * tt + (-0.142248368f); q = q * tt + 0.127414796f; q = q * tt;
            const float m = v * (q * __builtin_amdgcn_exp2f(v * v * (-0.72134752044f)));
            t[j] = v < 0.f ? m : v - m;
        }
        u32x4 o; o.x = pk2(t[0], t[1]); o.y = pk2(t[2], t[3]); o.z = pk2(t[4], t[5]); o.w = pk2(t[6], t[7]);
        *(u32x4*)(Z + R * 512 + ch * 8) = o;
    }
}

#define XB_TMO      128
#define XB_XCNT(j)  (256  + 64 * (j))
#define XB_XSUB(j)  (1280 + 64 * (j))
#define XB_XGEN(j)  (2304 + 64 * (j))
#define XB_TOP      3328
#define XB_TOPGEN   3392
#define XCD_BAR_WORDS 3456
#define XB_SPIN_CAP (1u << 18)

__device__ __forceinline__ unsigned xb_ld(unsigned* p)              { return __hip_atomic_load(p, __ATOMIC_RELAXED, __HIP_MEMORY_SCOPE_AGENT); }
__device__ __forceinline__ unsigned xb_add(unsigned* p, unsigned v) { return __hip_atomic_fetch_add(p, v, __ATOMIC_RELAXED, __HIP_MEMORY_SCOPE_AGENT); }
__device__ __forceinline__ unsigned xb_xcc_id() { return (unsigned)__builtin_amdgcn_s_getreg((3 << 11) | 20) & 0xFu; }
#define XB_SPIN(cond, bar) do { unsigned _sp = 0; while (cond) { __builtin_amdgcn_s_sleep(1); \
    if ((++_sp & 255u) == 0u) { if (xb_ld(&(bar)[XB_TMO])) break; if (_sp > XB_SPIN_CAP) { atomicAdd(&(bar)[XB_TMO], 1u); break; } } } } while (0)

struct XcdBarrier {
    unsigned* bar; unsigned x;
    volatile LAS unsigned* st;
};

__device__ __forceinline__ XcdBarrier xcd_barrier_post(unsigned* bar, volatile LAS unsigned* st) {
    XcdBarrier b; b.bar = bar; b.x = xb_xcc_id(); b.st = st;
    if (threadIdx.x == 0) (void)xb_add(&bar[XB_XCNT(b.x)], 1u);
    return b;
}
__device__ __forceinline__ void xcd_barrier_complete(unsigned* bar, unsigned x, unsigned& nloc, unsigned& nx) {
    const unsigned G = gridDim.x * gridDim.y * gridDim.z;
    unsigned sum, cnt, mine, sp = 0u;
    for (;;) {
        sum = 0u; cnt = 0u; mine = 0u;
#pragma unroll
        for (unsigned j = 0; j < 16; ++j) { const unsigned c = xb_ld(&bar[XB_XCNT(j)]); sum += c; cnt += (c > 0u) ? 1u : 0u; mine = (j == x) ? c : mine; }
        if (sum == G) break;
        __builtin_amdgcn_s_sleep(1);
        if ((++sp & 255u) == 0u) { if (xb_ld(&bar[XB_TMO])) break; if (sp > XB_SPIN_CAP) { atomicAdd(&bar[XB_TMO], 1u); break; } }
    }
    nloc = mine > 0u ? mine : 1u; nx = cnt > 0u ? cnt : 1u;
}

__device__ __forceinline__ void xcd_barrier(const XcdBarrier& b) {
    asm volatile("s_waitcnt vmcnt(0)" ::: "memory");
    __syncthreads();
    if (threadIdx.x == 0) {
        unsigned* bar = b.bar;
        __builtin_amdgcn_s_waitcnt(0);
        unsigned nloc = b.st[0], nx = b.st[1];
        if (nloc == 0u) { xcd_barrier_complete(bar, b.x, nloc, nx); b.st[0] = nloc; b.st[1] = nx; }
        const unsigned old = xb_add(&bar[XB_XSUB(b.x)], 1u);
        const unsigned gen = old / nloc;
        if (old + 1u == (gen + 1u) * nloc) {
            __builtin_amdgcn_fence(__ATOMIC_RELEASE, "agent");
            asm volatile("s_waitcnt vmcnt(0)" ::: "memory");
            const unsigned og = xb_add(&bar[XB_TOP], 1u);
            const unsigned tg = og / nx;
            if (og + 1u == (tg + 1u) * nx) xb_add(&bar[XB_TOPGEN], 1u);
            else XB_SPIN(xb_ld(&bar[XB_TOPGEN]) == tg, bar);
            __builtin_amdgcn_fence(__ATOMIC_ACQUIRE, "agent");
            xb_add(&bar[XB_XGEN(b.x)], 1u);
            asm volatile("s_waitcnt vmcnt(0)" ::: "memory");
        } else {
            XB_SPIN(xb_ld(&bar[XB_XGEN(b.x)]) == gen, bar);
            __builtin_amdgcn_fence(__ATOMIC_ACQUIRE, "agent");
            asm volatile("s_waitcnt vmcnt(0)" ::: "memory");
        }
    }
    __syncthreads();
}

#ifndef MK_ALIGN
#define MK_ALIGN true
#endif
#ifndef MK_SP2
#define MK_SP2 true
#endif
#ifndef MK_SPLIT
#define MK_SPLIT 0
#endif
#ifndef MK_NLAYER
#define MK_NLAYER 2
#endif
constexpr int NPL = 8, NPHASE = 1 + 2 * NPL + 1, PH_FINAL = NPHASE - 1;

#define KARGS() ({ auto kp_ = __builtin_amdgcn_kernarg_segment_ptr(); asm volatile("" : "+s"(kp_)); (KArgsP)kp_; })
__global__ void __launch_bounds__(512, 2) fwd_kernel(Args a_unused, int ph_lo, int ph_hi) {
    (void)a_unused;
    extern __shared__ __attribute__((aligned(16))) unsigned char lds_raw[];
    LAS unsigned char* lds = (LAS unsigned char*)lds_raw;
    const int G = gridDim.x, bid = blockIdx.x;
#if MK_SPLIT
#define GRID_SYNC() do {} while (0)
    (void)lds;
#else
#define CG_SYNC() do { asm volatile("s_waitcnt vmcnt(0)" ::: "memory"); __syncthreads(); \
    if (threadIdx.x == 0) { __builtin_amdgcn_fence(__ATOMIC_RELEASE, "agent"); asm volatile("s_waitcnt vmcnt(0)" ::: "memory"); } \
    __syncthreads(); grid.sync(); \
    if (threadIdx.x == 0) { __builtin_amdgcn_fence(__ATOMIC_ACQUIRE, "agent"); asm volatile("s_waitcnt vmcnt(0)" ::: "memory"); } \
    __syncthreads(); } while (0)
    cg::grid_group grid = cg::this_grid();
    unsigned* barw = (unsigned*)(KARGS()->ws + WS_CTL);
    if (bid == 0) for (int i = threadIdx.x; i < XCD_BAR_WORDS; i += 512) __hip_atomic_store(barw + i, 0u, __ATOMIC_RELAXED, __HIP_MEMORY_SCOPE_AGENT);
    volatile LAS unsigned* xst = (volatile LAS unsigned*)(lds + LDS_BYTES - 64);
    if (threadIdx.x < 2) xst[threadIdx.x] = 0u;
    CG_SYNC();
    const XcdBarrier xbar = xcd_barrier_post(barw, xst);
#define GRID_SYNC() xcd_barrier(xbar)

#endif
#ifndef PHMASK
#define PHMASK 0xFFFFu
#endif
#define IN(k) (((PHMASK >> ((k) == 0 ? 0 : (k) == PH_FINAL ? 9 : 1 + ((k) - 1) % NPL)) & 1u) && ph_lo <= (k) && (k) < ph_hi)
#define SEAM(k) do { if (IN(k) && (k) + 1 < ph_hi) GRID_SYNC(); } while (0)
#define PHASE_BEGIN() KArgsP ka = KARGS(); unsigned char* ws = ka->ws; asm volatile("" : "+s"(ws)); float* rowss = (float*)(ws + WS_RS); float* Hm = (float*)(ws + WS_HM); bf16* HB = (bf16*)(ws + WS_HB); unsigned char* wl = ws + WS_W + (size_t)layer * LW_BYTES; \
    const int MT = NREAL; const bool META = layer != MK_NLAYER - 1;     \
    const float* rs_mix = rowss + (size_t)(2 * layer) * TPR * 16; float* rs_mlp = rowss + (size_t)(2 * layer + 1) * TPR * 16; float* rs_next = rowss + (size_t)(2 * layer + 2) * TPR * 16; (void)MT; (void)META; (void)Hm; (void)HB; (void)wl; (void)rs_mix; (void)rs_mlp; (void)rs_next;

    if (IN(0)) {
        { int tl_ = threadIdx.x; asm volatile("" : "+v"(tl_)); const int wv = __builtin_amdgcn_readfirstlane(tl_ >> 6);
          convert_layer_weights(KARGS(), lds, 0, bid * 8 + wv, G * 8, wv, tl_ & 63, 0); }
        Args al; { KArgsP kp = KARGS(); for (int i = 0; i < 23; ++i) al.in[i] = kp->in[i]; al.out = kp->out; al.ws = kp->ws; } p0_prologue(al, lds); }
    SEAM(0);
#ifndef MK_NLAYER
#define MK_NLAYER 2
#endif
#ifndef MK_RSIDX
#define MK_RSIDX 4
#endif
#pragma unroll 1
    for (int layer = 0; layer < MK_NLAYER; ++layer) {
        const int p = 1 + NPL * layer;
        if (IN(p)) { PHASE_BEGIN();
            pg8::Gemm g{HB, (const bf16*)(wl + OW_IN), TPR, NPROJ, DM}; pg8::StaticOrder S; S.init(TPR, NPROJ, G, bid);
            EpiInProj E{rs_mix, (const float*)(ws + WS_ROPE), (bf16*)(ws + WS_Q), (bf16*)(ws + WS_K), (bf16*)(ws + WS_V), (bf16*)(ws + WS_SU), (bf16*)(ws + WS_PU)};
            pg8::gemm_phase<EpiInProj, pg8::StaticOrder, MK_ALIGN, MK_SP2>(lds, g, S, E);
        }
        SEAM(p);
        if (IN(p + 1)) { PHASE_BEGIN();
            for (int t = bid; t < 256; t += G)
                ssm_task(lds, t, layer, (const bf16*)(ws + WS_SU), (float*)(ws + WS_YF), (const float*)(ws + WS_ABAR), (const bf16*)(ws + WS_BMAT), (const bf16*)(ws + WS_CMAT));
            for (int t = bid; t < NB * 2 * 33; t += G)
                attn_task(lds, t, (const bf16*)(ws + WS_Q), (const bf16*)(ws + WS_K), (const bf16*)(ws + WS_V), (bf16*)ka->out, ka->in[4] + layer * 8);
            pool_diff(lds, (const bf16*)(ws + WS_PU), (bf16*)(ws + WS_PD));
            {
                int tl_ = threadIdx.x; asm volatile("" : "+v"(tl_)); const int wv = __builtin_amdgcn_readfirstlane(tl_ >> 6);
                convert_layer_weights(ka, lds, layer, bid * 8 + wv, G * 8, wv, tl_ & 63, 1);
                if (layer + 1 < MK_NLAYER) convert_layer_weights(ka, lds, layer + 1, bid * 8 + wv, G * 8, wv, tl_ & 63, 0);
                __syncthreads();
            }
        }
        SEAM(p + 1);
        if (IN(p + 2)) { PHASE_BEGIN();
            z_pass((const float*)(ws + WS_YF), (const bf16*)(ws + WS_SU), ka->in[12] + layer * 512, (bf16*)(ws + WS_Z));
        }
        SEAM(p + 2);
        if (IN(p + 3)) { PHASE_BEGIN();
            const int hg = G >> 1;
            if (bid < hg) { pg8::Gemm g{(const bf16*)(ws + WS_Z), (const bf16*)(wl + OW_GLU), MT, 512, 512}; pg8::StaticOrder S; S.init(MT, 512, hg, bid);
              EpiGlu E{(const bf16*)(ws + WS_Z), ka->in[14] + layer * 512, (bf16*)ka->out + (size_t)TPR * 512};
              pg8::gemm_phase<EpiGlu, pg8::StaticOrder, MK_ALIGN, MK_SP2>(lds, g, S, E); if (META) thin_gemm<EpiGlu>(lds, g.A, g.Bt, g.K, g.N, E, bid, hg); }
            else { pg8::Gemm g{(const bf16*)(ws + WS_PD), (const bf16*)(wl + OW_POOL), MT, 512, 512}; pg8::StaticOrder S; S.init(MT, 512, G - hg, bid - hg);
              EpiScale E{(bf16*)ka->out + (size_t)2 * TPR * 512, 512, ka->in[16] + layer * 512};
              pg8::gemm_phase<EpiScale, pg8::StaticOrder, MK_ALIGN, MK_SP2>(lds, g, S, E); if (META) thin_gemm<EpiScale>(lds, g.A, g.Bt, g.K, g.N, E, bid - hg, G - hg); }
        }
        SEAM(p + 3);
        if (IN(p + 4)) { PHASE_BEGIN();
            bf16* Y3 = (bf16*)ka->out;
            bf16* BR0 = (bf16*)(ws + WS_X), *BR1 = (bf16*)(ws + WS_X + 4 * UU), *BR2 = (bf16*)(ws + WS_X + 6 * UU);
            const bf16* Wbr = (const bf16*)(wl + OW_BR); const bf16* Wg = (const bf16*)(wl + OW_IN) + (size_t)NPROJ * DM; bf16* MG = (bf16*)(ws + WS_MG);
            { pg8::Gemm g{Y3, Wbr, 3 * TPR, 3072, 512}; TripleOrder S; S.init(G, bid, TPR / 256, 4);
              EpiBr3 E{BR0, TPR / 256};
              pg8::gemm_phase<EpiBr3, TripleOrder, MK_ALIGN, MK_SP2>(lds, g, S, E); }
            if (META) {
#pragma unroll 1
                for (int c = 0; c < 3; ++c) { EpiScale E{BR0 + (size_t)(2 * c + 2 * (c > 0)) * (UU / 2), 1024, nullptr};
                    thin_gemm<EpiScale>(lds, Y3 + (size_t)c * TPR * 512, Wbr + (size_t)c * 1024 * 512, 512, 1024, E, bid, G); }
            }
            { pg8::Gemm g{HB, Wg, MT, 3072, DM}; TripleOrder S; S.init(G, bid, 0, 4);
              EpiGate3 E{rs_mix, BR0, MG};
              pg8::gemm_phase<EpiGate3, TripleOrder, MK_ALIGN, MK_SP2>(lds, g, S, E); }
            if (META) {
                { EpiGate<true> E{rs_mix, BR0, MG}; thin_gemm<EpiGate<true>>(lds, HB, Wg, DM, 1024, E, bid, G); }
                { EpiGate<false> E{rs_mix, BR1, MG}; thin_gemm<EpiGate<false>>(lds, HB, Wg + (size_t)1024 * DM, DM, 1024, E, bid, G); }
                { EpiGate<false> E{rs_mix, BR2, MG}; thin_gemm<EpiGate<false>>(lds, HB, Wg + (size_t)2048 * DM, DM, 1024, E, bid, G); }
            }
        }
        SEAM(p + 4);
        if (IN(p + 5)) { PHASE_BEGIN();
            pg8::Gemm g{(const bf16*)(ws + WS_MG), (const bf16*)(wl + OW_OUT), MT, DM, DM}; pg8::StaticOrder S; S.init(MT, DM, G, bid);
            EpiRes E{(const float*)nullptr, HB, rs_mlp};
            pg8::gemm_phase<EpiRes, pg8::StaticOrder, MK_ALIGN, MK_SP2>(lds, g, S, E); if (META) thin_gemm<EpiRes>(lds, g.A, g.Bt, g.K, g.N, E, bid, G);
        }
        SEAM(p + 5);
        if (IN(p + 6)) { PHASE_BEGIN();
            pg8::Gemm g{HB, (const bf16*)(wl + OW_UP), MT, FF, DM}; pg8::StaticOrder S; S.init(MT, FF, G, bid);
            EpiUp E{rs_mlp, (bf16*)(ws + WS_ACT)};
            pg8::gemm_phase<EpiUp, pg8::StaticOrder, MK_ALIGN, MK_SP2>(lds, g, S, E); if (META) thin_gemm<EpiUp>(lds, g.A, g.Bt, g.K, g.N, E, bid, G);
        }
        SEAM(p + 6);
        if (IN(p + 7)) { PHASE_BEGIN();
            pg8::Gemm g{(const bf16*)(ws + WS_ACT), (const bf16*)(wl + OW_DN), MT, DM, FF}; pg8::StaticOrder S; S.init(MT, DM, G, bid);
            EpiRes E{(const float*)nullptr, HB, rs_next};
            pg8::gemm_phase<EpiRes, pg8::StaticOrder, MK_ALIGN, MK_SP2>(lds, g, S, E); if (META) thin_gemm<EpiRes>(lds, g.A, g.Bt, g.K, g.N, E, bid, G);
        }
        SEAM(p + 7);
    }
#ifdef MK_DUMP_OFF
    if (IN(PH_FINAL)) { KArgsP ka = KARGS();
        const bf16* src = (const bf16*)(ka->ws + (MK_DUMP_OFF)); const bf16* src2 = (const bf16*)(ka->ws + (MK_DUMP_OFF2));
        for (int i = bid * 512 + threadIdx.x; i < NREAL * 1024; i += G * 512) { const int R = MK_DUMP_ROW(i >> 10), c = i & 1023; ka->out[i] = c < 512 ? bf2f(src[(size_t)R * (MK_DUMP_LD) + (c % (MK_DUMP_LD))]) : bf2f(src2[(size_t)R * (MK_DUMP_LD2) + (c % (MK_DUMP_LD2))]); }
    }
#else
    if (IN(PH_FINAL)) { KArgsP ka = KARGS();
        const float* rs = (const float*)(ka->ws + WS_RS) + (size_t)MK_RSIDX * TPR * 16; const float* gain = ka->in[22];
        int tl_ = threadIdx.x; asm volatile("" : "+v"(tl_));
        for (int i = bid * 512 + tl_; i < NREAL * 256; i += G * 512) {
            const int R = i >> 8, c4 = (i & 255) * 4;
            const float r = row_rstd(rs, R);
            const u32x2 hb = *(const u32x2*)((const bf16*)(ka->ws + WS_HB) + (size_t)R * DM + c4); const f32x4 gn = *(const f32x4*)(gain + c4);
            f32x4 v = {bf2f(hb.x & 0xffffu), bf2f(hb.x >> 16), bf2f(hb.y & 0xffffu), bf2f(hb.y >> 16)};
            v = v * r * gn;
            *(f32x4*)(ka->out + (size_t)R * DM + c4) = v;
        }
    }
#endif
#undef IN
#undef SEAM
}

extern "C" void kernel_launch(void* const* d_in, const int* in_sizes, int n_in, void* d_out, int out_size, void* d_ws, size_t ws_size, hipStream_t stream) {
    static int grid = 0;
    if (grid == 0) {
        if (n_in != 23 || out_size != NREAL * DM || ws_size < WS_END) { fprintf(stderr, "kernel_launch: unexpected shapes (n_in %d out %d ws %zu)\n", n_in, out_size, ws_size); grid = -1; return; }
        int dev = 0, cus = 0, per_cu = 0;
        hipGetDevice(&dev); hipDeviceGetAttribute(&cus, hipDeviceAttributeMultiprocessorCount, dev);
        if (hipFuncSetAttribute((const void*)fwd_kernel, hipFuncAttributeMaxDynamicSharedMemorySize, LDS_BYTES) != hipSuccess) { fprintf(stderr, "kernel_launch: hipFuncSetAttribute failed\n"); grid = -1; return; }
        if (hipOccupancyMaxActiveBlocksPerMultiprocessor(&per_cu, (const void*)fwd_kernel, 512, LDS_BYTES) != hipSuccess || per_cu < 1) { fprintf(stderr, "kernel_launch: occupancy query gave %d\n", per_cu); per_cu = 1; }
        (void)hipGetLastError();
        grid = cus * (per_cu > 1 ? 1 : per_cu);
        if (grid <= 0) grid = 256;
    }
    if (grid < 0) return;
    Args a{};
    for (int i = 0; i < 23; ++i) a.in[i] = (const float*)d_in[i];
    a.out = (float*)d_out; a.ws = (unsigned char*)d_ws;
#if MK_SPLIT
    for (int ph = 0; ph < NPHASE; ++ph) hipLaunchKernelGGL(fwd_kernel, dim3(grid), dim3(512), LDS_BYTES, stream, a, ph, ph + 1);
#else
    int lo = 0, hi = NPHASE;
    void* kargs[] = {(void*)&a, (void*)&lo, (void*)&hi};
    hipError_t e = hipLaunchCooperativeKernel((const void*)fwd_kernel, dim3(grid), dim3(512), kargs, LDS_BYTES, stream);
    if (e != hipSuccess) fprintf(stderr, "kernel_launch: cooperative launch failed: %s (grid %d)\n", hipGetErrorString(e), grid);
#endif
}
```

```cpp
#include <hip/hip_runtime.h>
#include <hip/hip_cooperative_groups.h>
#include <cstdio>
#include <cstdint>
namespace cg = cooperative_groups;
namespace pg8 {
#define PG8_LAS __attribute__((address_space(3)))
typedef unsigned short bf16_t;
typedef short bf16x8 __attribute__((ext_vector_type(8)));
typedef float f32x4 __attribute__((ext_vector_type(4)));
typedef unsigned u32x4 __attribute__((ext_vector_type(4)));
constexpr int BM = 256, BK = 64, HALF = 128, HTB = HALF * BK * 2  , STAGE_BYTES = 8 * HTB, NXCD = 8, WGM = 8;

__host__ __device__ __forceinline__ int lds_byte(int r, int c) { const int st = (r >> 4) * 2 + (c >> 5), rr = r & 15, cc = c & 31, ob = rr * 64 + cc * 2; return st * 1024 + (ob ^ (((ob >> 9) & 1) << 5)); }
__host__ __device__ __forceinline__ void stage_rc(int b, int& R, int& C) { const int st = b / 1024, sb = b % 1024, swz = sb ^ (((sb >> 9) & 1) << 5); R = (st >> 1) * 16 + swz / 64; C = (st & 1) * 32 + (swz % 64) / 2; }
__host__ __device__ __forceinline__ int perm32(int rho) { const int n = rho >> 4, i = rho & 15; return 8 * (i >> 2) + 4 * n + (i & 3); }

struct Unit { int pm, pn; };
struct Gemm { const bf16_t* A; const bf16_t* Bt; int M, N, K; };

struct StaticOrder {
    int nM, nN, nwg, G, c;
    __host__ __device__ void init(int M, int N, int G_, int c_) { nM = M / BM; nN = N / BM; nwg = nM * nN; G = G_; c = c_; }
    __host__ __device__ __forceinline__ bool next(int i, Unit& u) const {
        const long L = (long)i * G + c; if (L >= nwg) return false;
        int wgid = (int)L; { const int q = nwg / NXCD, r = nwg % NXCD, xcd = wgid % NXCD, off = wgid / NXCD; wgid = (xcd < r ? xcd * (q + 1) : r * (q + 1) + (xcd - r) * q) + off; }
        const int nig = WGM * nN, gid = wgid / nig, fm = gid * WGM, gsz = (nM - fm) < WGM ? (nM - fm) : WGM;
        u.pm = fm + ((wgid % nig) % gsz); u.pn = (wgid % nig) / gsz; return true;
    }
    __device__ __forceinline__ void a_ready(const Unit&) const {}
    __device__ __forceinline__ void done(const Unit&) const {}
};

__device__ __forceinline__ unsigned cvt_pk_bf16(float lo, float hi) { unsigned r; asm volatile("v_cvt_pk_bf16_f32 %0, %1, %2" : "=v"(r) : "v"(lo), "v"(hi)); return r; }
template <class Epi, class Sched, bool ALIGN_EPI = false, bool SP2 = false>
__device__ __forceinline__ void gemm_phase(PG8_LAS unsigned char* lds, const Gemm g, const Sched& S, const Epi& E) {
    int tid_l = threadIdx.x; asm volatile("" : "+v"(tid_l));
    const int tid = tid_l, wid = __builtin_amdgcn_readfirstlane(tid >> 6), lane = tid & 63, wr = wid >> 2, wc = wid & 3, fr = lane & 15, fq = lane >> 4;
    const int K = g.K, nt = K / BK;
    unsigned voffA[2], voffB[2];
#pragma unroll
    for (int i = 0; i < 2; ++i) { int R, C; stage_rc(tid * 16 + i * 8192, R, C); const int Rb = Epi::PERM ? ((R & ~31) + perm32(R & 31)) : R;
        voffA[i] = (unsigned)(R * K + C) * 2u; voffB[i] = (unsigned)(Rb * K + C) * 2u; }
    const size_t kstep = (size_t)(BK * 2);
    const size_t hstep = (size_t)HALF * K * 2;
    const size_t tstep = 2 * hstep;
    const unsigned ldsw = (unsigned)wid * 1024u;
    const int aoff = lds_byte(wr * 64 + fr, fq * 8), boff = lds_byte(wc * 32 + fr, fq * 8);
#define PG8_SA(b, h) (((b) * 2 + (h)) * HTB)
#define PG8_SB(b, h) ((4 + (b) * 2 + (h)) * HTB)
#define PG8_STAGE(bufoff, gbase, voff) do { _Pragma("unroll") for (int _i = 0; _i < 2; ++_i) \
        __builtin_amdgcn_global_load_lds((const unsigned*)((const char*)(gbase) + (voff)[_i]), (PG8_LAS unsigned*)(lds + (bufoff) + ldsw + _i * 8192), 16, 0, 0); } while (0)
#define PG8_LDA(dst, b, h) do { _Pragma("unroll") for (int m = 0; m < 4; ++m) _Pragma("unroll") for (int k = 0; k < 2; ++k) dst[m][k] = *(const PG8_LAS bf16x8*)(lds + PG8_SA(b, h) + aoff + m * 2048 + k * 1024); } while (0)
#define PG8_LDB(dst, b, h) do { _Pragma("unroll") for (int n = 0; n < 2; ++n) _Pragma("unroll") for (int k = 0; k < 2; ++k) dst[n][k] = *(const PG8_LAS bf16x8*)(lds + PG8_SB(b, h) + boff + n * 2048 + k * 1024); } while (0)
#define PG8_MMA(ai, bj, At, Bt) do { __builtin_amdgcn_s_setprio(1); _Pragma("unroll") for (int m = 0; m < 4; ++m) _Pragma("unroll") for (int n = 0; n < 2; ++n) _Pragma("unroll") for (int k = 0; k < 2; ++k) \
        acc[ai][bj][m][n] = __builtin_amdgcn_mfma_f32_16x16x32_bf16(Bt[n][k], At[m][k], acc[ai][bj][m][n], 0, 0, 0); __builtin_amdgcn_s_setprio(0); } while (0)
#define PG8_WAIT_V(n) asm volatile("s_waitcnt vmcnt(" #n ")" ::: "memory")
#define PG8_WAIT_L(n) asm volatile("s_waitcnt lgkmcnt(" #n ")" ::: "memory")
#define PG8_BAR __builtin_amdgcn_s_barrier()
#define PG8_SCHED __builtin_amdgcn_sched_barrier(0)
    Unit cur, nxt; int ui = 0;
    if (!S.next(0, cur)) return;
    f32x4 acc[2][2][4][2];
#pragma unroll
    for (int a = 0; a < 2; ++a)
#pragma unroll
        for (int b = 0; b < 2; ++b)
#pragma unroll
            for (int m = 0; m < 4; ++m)
#pragma unroll
                for (int n = 0; n < 2; ++n) acc[a][b][m][n] = (f32x4){0.f, 0.f, 0.f, 0.f};
    bf16x8 At[4][2], B0[2][2], B1[2][2];
    const char* cA = (const char*)g.A + (size_t)cur.pm * tstep; const char* cB = (const char*)g.Bt + (size_t)cur.pn * tstep;
    S.a_ready(cur);
    if constexpr (SP2) {
        PG8_STAGE(PG8_SB(0, 0), cB, voffB); PG8_STAGE(PG8_SB(0, 1), cB + hstep, voffB); PG8_STAGE(PG8_SA(0, 0), cA, voffA); PG8_STAGE(PG8_SA(0, 1), cA + hstep, voffA);
        if (wr == 1) PG8_BAR;
        PG8_WAIT_V(2); PG8_BAR;
        PG8_STAGE(PG8_SB(1, 0), cB + kstep, voffB); PG8_STAGE(PG8_SA(1, 0), cA + kstep, voffA); PG8_STAGE(PG8_SB(1, 1), cB + hstep + kstep, voffB);
        PG8_WAIT_V(6); PG8_BAR;
    } else {
        PG8_STAGE(PG8_SB(0, 0), cB, voffB); PG8_STAGE(PG8_SA(0, 0), cA, voffA); PG8_STAGE(PG8_SB(0, 1), cB + hstep, voffB); PG8_STAGE(PG8_SA(0, 1), cA + hstep, voffA);
        if (wr == 1) PG8_BAR;
        PG8_WAIT_V(4); PG8_BAR;
        PG8_STAGE(PG8_SB(1, 0), cB + kstep, voffB); PG8_STAGE(PG8_SA(1, 0), cA + kstep, voffA); PG8_STAGE(PG8_SB(1, 1), cB + hstep + kstep, voffB);
        PG8_WAIT_V(6); PG8_BAR;
    }
    for (;;) {
        const bool has_next = S.next(ui + 1, nxt);
        const char* nA = has_next ? (const char*)g.A + (size_t)nxt.pm * tstep : cA; const char* nB = has_next ? (const char*)g.Bt + (size_t)nxt.pn * tstep : cB;
        for (int t = 0; t < nt; t += 2) {
            const bool last = (t == nt - 2);
            const char* a1 = cA + (size_t)(t + 1) * kstep;
            const char* a2 = last ? nA : cA + (size_t)(t + 2) * kstep; const char* b2 = last ? nB : cB + (size_t)(t + 2) * kstep;
            const char* a3 = a2 + kstep; const char* b3 = b2 + kstep;
            if (last && has_next) S.a_ready(nxt);
            if constexpr (SP2) {
            PG8_LDB(B0, 0, 0); PG8_LDB(B1, 0, 1); PG8_SCHED; PG8_LDA(At, 0, 0); PG8_STAGE(PG8_SA(1, 1), a1 + hstep, voffA);
            PG8_WAIT_V(8); PG8_WAIT_L(0); PG8_BAR; PG8_MMA(0, 0, At, B0); PG8_MMA(0, 1, At, B1); PG8_BAR; PG8_SCHED;
            PG8_LDA(At, 0, 1); PG8_STAGE(PG8_SB(0, 0), b2, voffB); PG8_STAGE(PG8_SB(0, 1), b2 + hstep, voffB); PG8_STAGE(PG8_SA(0, 0), a2, voffA);
            PG8_WAIT_V(8); PG8_WAIT_L(0); PG8_BAR; PG8_MMA(1, 0, At, B0); PG8_MMA(1, 1, At, B1); PG8_BAR; PG8_SCHED;
            PG8_LDB(B0, 1, 0); PG8_LDB(B1, 1, 1); PG8_SCHED; PG8_LDA(At, 1, 0); PG8_STAGE(PG8_SA(0, 1), a2 + hstep, voffA);
            PG8_WAIT_V(8); PG8_WAIT_L(0); PG8_BAR; PG8_MMA(0, 0, At, B0); PG8_MMA(0, 1, At, B1); PG8_BAR; PG8_SCHED;
            PG8_LDA(At, 1, 1); PG8_STAGE(PG8_SB(1, 0), b3, voffB); PG8_STAGE(PG8_SB(1, 1), b3 + hstep, voffB); PG8_STAGE(PG8_SA(1, 0), a3, voffA);
            PG8_WAIT_V(8); PG8_WAIT_L(0); PG8_BAR; PG8_MMA(1, 0, At, B0); PG8_MMA(1, 1, At, B1); PG8_BAR; PG8_SCHED;
            } else {
            PG8_LDB(B0, 0, 0); PG8_SCHED; PG8_LDA(At, 0, 0); PG8_STAGE(PG8_SA(1, 1), a1 + hstep, voffA);
            PG8_WAIT_L(8); PG8_BAR; PG8_WAIT_L(0); PG8_MMA(0, 0, At, B0); PG8_BAR; PG8_SCHED;
            PG8_LDB(B1, 0, 1); PG8_STAGE(PG8_SB(0, 0), b2, voffB);
            PG8_BAR; PG8_WAIT_L(0); PG8_MMA(0, 1, At, B1); PG8_BAR;
            PG8_LDA(At, 0, 1); PG8_STAGE(PG8_SA(0, 0), a2, voffA);
            PG8_BAR; PG8_WAIT_L(0); PG8_MMA(1, 0, At, B0); PG8_BAR; PG8_SCHED;
            PG8_STAGE(PG8_SB(0, 1), b2 + hstep, voffB);
            PG8_WAIT_V(6); PG8_BAR; PG8_MMA(1, 1, At, B1); PG8_BAR;
            PG8_LDB(B0, 1, 0); PG8_SCHED; PG8_LDA(At, 1, 0); PG8_STAGE(PG8_SA(0, 1), a2 + hstep, voffA);
            PG8_WAIT_L(8); PG8_BAR; PG8_WAIT_L(0); PG8_MMA(0, 0, At, B0); PG8_BAR; PG8_SCHED;
            PG8_LDB(B1, 1, 1); PG8_STAGE(PG8_SB(1, 0), b3, voffB);
            PG8_BAR; PG8_WAIT_L(0); PG8_MMA(0, 1, At, B1); PG8_BAR;
            PG8_LDA(At, 1, 1); PG8_STAGE(PG8_SA(1, 0), a3, voffA);
            PG8_BAR; PG8_WAIT_L(0); PG8_MMA(1, 0, At, B0); PG8_BAR; PG8_SCHED;
            PG8_STAGE(PG8_SB(1, 1), b3 + hstep, voffB);
            PG8_WAIT_V(6); PG8_BAR; PG8_MMA(1, 1, At, B1); PG8_BAR;
            }
        }
        if constexpr (ALIGN_EPI) { if (wr == 0) PG8_BAR; }
        asm volatile("s_nop 15\n\ts_nop 15" ::: "memory");
        if constexpr (!Epi::AFTER_DRAIN) { E(acc, cur, wr, wc, fr, fq); S.done(cur); }
        if (!has_next) break;
#pragma unroll
        for (int a = 0; a < 2; ++a)
#pragma unroll
            for (int b = 0; b < 2; ++b)
#pragma unroll
                for (int m = 0; m < 4; ++m)
#pragma unroll
                    for (int n = 0; n < 2; ++n) acc[a][b][m][n] = (f32x4){0.f, 0.f, 0.f, 0.f};
        cur = nxt; cA = nA; cB = nB; ++ui;
        if constexpr (ALIGN_EPI) { if (wr == 1) PG8_BAR; }
    }
    PG8_WAIT_V(0);
    if constexpr (!ALIGN_EPI) { if (wr == 0) PG8_BAR; }
    PG8_BAR;
    if constexpr (Epi::AFTER_DRAIN) { E.fused(acc, cur, wr, wc, fr, fq, lds, wid, lane); S.done(cur); }
#undef PG8_SA
#undef PG8_SB
#undef PG8_STAGE
#undef PG8_LDA
#undef PG8_LDB
#undef PG8_MMA
#undef PG8_WAIT_V
#undef PG8_WAIT_L
#undef PG8_BAR
#undef PG8_SCHED
}
}

#define LAS __attribute__((address_space(3)))
typedef unsigned short bf16;
typedef short bf16x8 __attribute__((ext_vector_type(8)));
typedef float f32x4 __attribute__((ext_vector_type(4)));
typedef float f32x16 __attribute__((ext_vector_type(16)));
typedef unsigned u32x2 __attribute__((ext_vector_type(2)));
typedef unsigned u32x4 __attribute__((ext_vector_type(4)));

constexpr int NB = 8, SEQ = 2048, NMETA = 16, LL = 2064, DM = 1024, FF = 4096, DIN = 4864, NPROJ = 1792;
constexpr int NREAL = NB * SEQ;
constexpr int TPR = NREAL + 256;
constexpr int LDS_BYTES = 147456;

constexpr size_t MiB = 1u << 20;
constexpr size_t WS_CTL = 0;
constexpr size_t WS_ROPE = 1 * MiB;
constexpr size_t WS_ABAR = 2 * MiB;
constexpr size_t WS_BMAT = 2 * MiB + 65536;
constexpr size_t WS_CMAT = WS_BMAT + 524288;
constexpr size_t WS_HM = 4 * MiB;
constexpr size_t WS_W = 5 * MiB;
constexpr size_t OW_IN = 0, OW_GLU = (size_t)DIN * DM * 2, OW_POOL = OW_GLU + 512 * 512 * 2, OW_BR = OW_POOL + 512 * 512 * 2,
                 OW_OUT = OW_BR + 3 * 1024 * 512 * 2, OW_UP = OW_OUT + 1024 * 1024 * 2, OW_DN = OW_UP + (size_t)FF * DM * 2, LW_BYTES = OW_DN + (size_t)FF * DM * 2;
constexpr size_t WS_HB = 68 * MiB;
constexpr size_t WS_X = 101 * MiB;
constexpr size_t UU = (size_t)TPR * 512 * 2;
constexpr size_t WS_YF = WS_X, WS_YP = WS_X, WS_Q = WS_X + 2 * UU, WS_K = WS_Q + UU, WS_V = WS_K + UU / 4, WS_MG = WS_X + 2 * UU,
                 WS_SU = WS_X + 4 * UU, WS_YA = WS_X + 8 * UU  , WS_PU = WS_X + 5 * UU, WS_YS = WS_PU, WS_Z = WS_X + 6 * UU, WS_PD = WS_X + 7 * UU, WS_BR = WS_Z, WS_ACT = WS_X;
constexpr size_t WS_RS = WS_X + 9 * UU;
constexpr size_t WS_END = WS_RS + (size_t)5 * TPR * 16 * 4;
static_assert(WS_W + 2 * LW_BYTES <= WS_HB && WS_HB + (size_t)TPR * 1024 * 2 <= WS_X && WS_END <= 256 * MiB, "ws map");
static_assert((size_t)256 * 2064 * 16 * 4 <= 2 * UU, "YF fits");

__device__ __forceinline__ unsigned pk2(float lo, float hi) { unsigned r; asm("v_cvt_pk_bf16_f32 %0, %1, %2" : "=v"(r) : "v"(lo), "v"(hi)); return r; }
__device__ __forceinline__ unsigned f2bf(float f) { return pk2(f, 0.f) & 0xffffu; }
__device__ __forceinline__ float bf2f(unsigned b) { return __uint_as_float(b << 16); }
__device__ __forceinline__ int tok_row(int b, int l) { return l >= NMETA ? b * SEQ + l - NMETA : NREAL + b * NMETA + l; }
#define LDS_FENCE() asm volatile("s_waitcnt lgkmcnt(0)" ::: "memory")
#define SSM_SYNC() do { asm volatile("s_waitcnt vmcnt(0) lgkmcnt(0)" ::: "memory"); __syncthreads(); } while (0)
__device__ __forceinline__ float row_rstd(const float* rs, int R) {
    const f32x4 a = *(const f32x4*)(rs + (size_t)R * 4), b = *(const f32x4*)(rs + ((size_t)TPR + R) * 4), c = *(const f32x4*)(rs + ((size_t)2 * TPR + R) * 4), d = *(const f32x4*)(rs + ((size_t)3 * TPR + R) * 4);
    const float s = (((a[0] + a[1]) + (a[2] + a[3])) + ((b[0] + b[1]) + (b[2] + b[3]))) + (((c[0] + c[1]) + (c[2] + c[3])) + ((d[0] + d[1]) + (d[2] + d[3])));
    return rsqrtf(s * (1.0f / 1024.0f) + 1e-6f);
}

__device__ __forceinline__ void dsincos(double a, double& s, double& c) {
    const double q = rint(a * 0.63661977236758134308);
    double r = fma(-q, 1.57079632679489655800e+00, a); r = fma(-q, 6.12323399573676603587e-17, r);
    const double r2 = r * r;
    double sp = -7.6471637318198164759e-13; sp = fma(sp, r2, 1.6059043836821614599e-10); sp = fma(sp, r2, -2.5052108385441718775e-08); sp = fma(sp, r2, 2.7557319223985890653e-06);
    sp = fma(sp, r2, -1.9841269841269841270e-04); sp = fma(sp, r2, 8.3333333333333333333e-03); sp = fma(sp, r2, -1.6666666666666666667e-01); sp = fma(sp * r2, r, r);
    double cp = 4.7794773323873852974e-14; cp = fma(cp, r2, -1.1470745597729724714e-11); cp = fma(cp, r2, 2.0876756987868098979e-09); cp = fma(cp, r2, -2.7557319223985890653e-07);
    cp = fma(cp, r2, 2.4801587301587301587e-05); cp = fma(cp, r2, -1.3888888888888888889e-03); cp = fma(cp, r2, 4.1666666666666666667e-02); cp = fma(cp, r2, -0.5); cp = fma(cp, r2, 1.0);
    const int qi = ((int)q) & 3;
    s = (qi == 0) ? sp : (qi == 1) ? cp : (qi == 2) ? -sp : -cp;
    c = (qi == 0) ? cp : (qi == 1) ? -sp : (qi == 2) ? -cp : sp;
}
__device__ __forceinline__ double dexp(double x) {
    const double k = rint(x * 1.44269504088896340736);
    double r = fma(-k, 6.93147180369123816490e-01, x); r = fma(-k, 1.90821492927058770002e-10, r);
    double p = 1.0 / 6227020800.0; p = fma(p, r, 1.0 / 479001600.0); p = fma(p, r, 1.0 / 39916800.0); p = fma(p, r, 1.0 / 3628800.0); p = fma(p, r, 1.0 / 362880.0); p = fma(p, r, 1.0 / 40320.0);
    p = fma(p, r, 1.0 / 5040.0); p = fma(p, r, 1.0 / 720.0); p = fma(p, r, 1.0 / 120.0); p = fma(p, r, 1.0 / 24.0); p = fma(p, r, 1.0 / 6.0); p = fma(p, r, 0.5); p = fma(p, r, 1.0); p = fma(p, r, 1.0);
    const long long bits = ((long long)(1023 + (int)k)) << 52;
    return p * __longlong_as_double(bits);
}

struct EpiInProj {
    static constexpr bool PERM = true, AFTER_DRAIN = false;
    const float* rowss; const float* rope; bf16 *Q, *K, *V, *SU, *PU;
    __device__ __forceinline__ u32x2 quad(int l, int c, const f32x4& v) const {
        u32x2 w;
        if (c < 640) {
            const int i0 = (c & 63) >> 1;
            const f32x4 cs = *(const f32x4*)(rope + ((size_t)l * 32 + i0) * 2);
            float o0 = v[0] * cs[0] - v[1] * cs[1], o1 = v[1] * cs[0] + v[0] * cs[1], o2 = v[2] * cs[2] - v[3] * cs[3], o3 = v[3] * cs[2] + v[2] * cs[3];
            if (c < 512) { o0 *= 0.125f; o1 *= 0.125f; o2 *= 0.125f; o3 *= 0.125f; }
            w.x = pk2(o0, o1); w.y = pk2(o2, o3);
        } else { w.x = pk2(v[0], v[1]); w.y = pk2(v[2], v[3]); }
        return w;
    }
    __device__ __forceinline__ void operator()(const f32x4 (&acc)[2][2][4][2], const pg8::Unit& u, int wr, int wc, int fr, int fq) const {
#pragma unroll
        for (int ai = 0; ai < 2; ++ai)
#pragma unroll
            for (int m = 0; m < 4; ++m) {
                const int R = u.pm * 256 + ai * 128 + wr * 64 + m * 16 + fr;
                const float rs = row_rstd(rowss, R);
                const int l = R < NREAL ? (R & 2047) + NMETA : (R & 15);
#pragma unroll
                for (int bj = 0; bj < 2; ++bj) {
                    const int c = u.pn * 256 + bj * 128 + wc * 32 + 8 * fq;
                    const u32x2 w0 = quad(l, c, acc[ai][bj][m][0] * rs), w1 = quad(l, c + 4, acc[ai][bj][m][1] * rs);
                    u32x4 w; w.x = w0.x; w.y = w0.y; w.z = w1.x; w.w = w1.y;
                    bf16* dst = c < 512 ? Q + (size_t)R * 512 + c : c < 640 ? K + (size_t)R * 128 + (c - 512) : c < 768 ? V + (size_t)R * 128 + (c - 640)
                              : c < 1280 ? SU + (size_t)R * 512 + (c - 768) : PU + (size_t)R * 512 + (c - 1280);
                    *(u32x4*)dst = w;
                }
            }
    }
};
#define EPI_BODY() \
    __device__ __forceinline__ void rg(int R, int pn, int wc, int fq, const f32x4 (&a4)[2][2]) const { \
        _Pragma("unroll") for (int bj = 0; bj < 2; ++bj) q2(R, pn * 256 + bj * 128 + wc * 32 + 8 * fq, a4[bj][0], a4[bj][1]); } \
    __device__ __forceinline__ void tq(int R, int c, const f32x4& v) const { q(R, c, v); } \
    EPI_OP()
#define EPI_OP() \
    __device__ __forceinline__ void operator()(const f32x4 (&acc)[2][2][4][2], const pg8::Unit& u, int wr, int wc, int fr, int fq) const { \
        _Pragma("unroll") for (int ai = 0; ai < 2; ++ai) _Pragma("unroll") for (int m = 0; m < 4; ++m) { \
            const f32x4 a4[2][2] = {{acc[ai][0][m][0], acc[ai][0][m][1]}, {acc[ai][1][m][0], acc[ai][1][m][1]}}; \
            rg(u.pm * 256 + ai * 128 + wr * 64 + m * 16 + fr, u.pn, wc, fq, a4); } }
#define EPI_BODY_RS() \
    __device__ __forceinline__ void rg(int R, int pn, int wc, int fq, const f32x4 (&a4)[2][2]) const { const float rs = row_rstd(rowss, R); \
        _Pragma("unroll") for (int bj = 0; bj < 2; ++bj) q2(R, pn * 256 + bj * 128 + wc * 32 + 8 * fq, a4[bj][0], a4[bj][1], rs); } \
    __device__ __forceinline__ void tq(int R, int c, const f32x4& v) const { q(R, c, v, row_rstd(rowss, R)); } \
    EPI_OP()
struct EpiGlu {
    static constexpr bool PERM = true, AFTER_DRAIN = false;
    const bf16* Z; const float* bias; bf16* YS;
    __device__ __forceinline__ void q(int R, int c, const f32x4& a) const {
        const f32x4 v = a + *(const f32x4*)(bias + c);
        const u32x2 zz = *(const u32x2*)(Z + (size_t)R * 512 + c);
        const float z0 = bf2f(zz.x & 0xffffu), z1 = bf2f(zz.x >> 16), z2 = bf2f(zz.y & 0xffffu), z3 = bf2f(zz.y >> 16);
        u32x2 w; w.x = pk2(z0 * __builtin_amdgcn_rcpf(1.0f + __expf(-v[0])), z1 * __builtin_amdgcn_rcpf(1.0f + __expf(-v[1]))); w.y = pk2(z2 * __builtin_amdgcn_rcpf(1.0f + __expf(-v[2])), z3 * __builtin_amdgcn_rcpf(1.0f + __expf(-v[3])));
        *(u32x2*)(YS + (size_t)R * 512 + c) = w;
    }
    __device__ __forceinline__ void q2(int R, int c, const f32x4& a0, const f32x4& a1) const {
        const f32x4 v0 = a0 + *(const f32x4*)(bias + c), v1 = a1 + *(const f32x4*)(bias + c + 4);
        const u32x4 zz = *(const u32x4*)(Z + (size_t)R * 512 + c);
        u32x4 w;
        w.x = pk2(bf2f(zz.x & 0xffffu) * __builtin_amdgcn_rcpf(1.0f + __expf(-v0[0])), bf2f(zz.x >> 16) * __builtin_amdgcn_rcpf(1.0f + __expf(-v0[1])));
        w.y = pk2(bf2f(zz.y & 0xffffu) * __builtin_amdgcn_rcpf(1.0f + __expf(-v0[2])), bf2f(zz.y >> 16) * __builtin_amdgcn_rcpf(1.0f + __expf(-v0[3])));
        w.z = pk2(bf2f(zz.z & 0xffffu) * __builtin_amdgcn_rcpf(1.0f + __expf(-v1[0])), bf2f(zz.z >> 16) * __builtin_amdgcn_rcpf(1.0f + __expf(-v1[1])));
        w.w = pk2(bf2f(zz.w & 0xffffu) * __builtin_amdgcn_rcpf(1.0f + __expf(-v1[2])), bf2f(zz.w >> 16) * __builtin_amdgcn_rcpf(1.0f + __expf(-v1[3])));
        *(u32x4*)(YS + (size_t)R * 512 + c) = w;
    }
    EPI_BODY()
};
struct EpiScale {
    static constexpr bool PERM = true, AFTER_DRAIN = false;
    bf16* O; int ldc; const float* scale;
    __device__ __forceinline__ void q(int R, int c, const f32x4& a) const {
        f32x4 v = a;
        if (scale) v = v * *(const f32x4*)(scale + c);
        u32x2 w; w.x = pk2(v[0], v[1]); w.y = pk2(v[2], v[3]);
        *(u32x2*)(O + (size_t)R * ldc + c) = w;
    }
    __device__ __forceinline__ void q2(int R, int c, const f32x4& a0, const f32x4& a1) const {
        f32x4 v0 = a0, v1 = a1;
        if (scale) { v0 = v0 * *(const f32x4*)(scale + c); v1 = v1 * *(const f32x4*)(scale + c + 4); }
        u32x4 w; w.x = pk2(v0[0], v0[1]); w.y = pk2(v0[2], v0[3]); w.z = pk2(v1[0], v1[1]); w.w = pk2(v1[2], v1[3]);
        *(u32x4*)(O + (size_t)R * ldc + c) = w;
    }
    EPI_BODY()
};
template <bool FIRST> struct EpiGate {
    static constexpr bool PERM = true, AFTER_DRAIN = false;
    const float* rowss; const bf16* BR; bf16* MG;
    __device__ __forceinline__ void q(int R, int c, const f32x4& a, float rs) const {
        const f32x4 v = a * rs;
        const u32x2 bb = *(const u32x2*)(BR + (size_t)R * 1024 + c);
        float o0 = bf2f(bb.x & 0xffffu) * __builtin_amdgcn_rcpf(1.0f + __expf(-v[0])), o1 = bf2f(bb.x >> 16) * __builtin_amdgcn_rcpf(1.0f + __expf(-v[1]));
        float o2 = bf2f(bb.y & 0xffffu) * __builtin_amdgcn_rcpf(1.0f + __expf(-v[2])), o3 = bf2f(bb.y >> 16) * __builtin_amdgcn_rcpf(1.0f + __expf(-v[3]));
        if (!FIRST) { const u32x2 mm = *(const u32x2*)(MG + (size_t)R * 1024 + c);
            o0 += bf2f(mm.x & 0xffffu); o1 += bf2f(mm.x >> 16); o2 += bf2f(mm.y & 0xffffu); o3 += bf2f(mm.y >> 16); }
        u32x2 w; w.x = pk2(o0, o1); w.y = pk2(o2, o3);
        *(u32x2*)(MG + (size_t)R * 1024 + c) = w;
    }
    __device__ __forceinline__ void q2(int R, int c, const f32x4& a0, const f32x4& a1, float rs) const {
        const f32x4 v0 = a0 * rs, v1 = a1 * rs;
        const u32x4 bb = *(const u32x4*)(BR + (size_t)R * 1024 + c);
        float o[8];
        o[0] = bf2f(bb.x & 0xffffu) * __builtin_amdgcn_rcpf(1.0f + __expf(-v0[0])); o[1] = bf2f(bb.x >> 16) * __builtin_amdgcn_rcpf(1.0f + __expf(-v0[1]));
        o[2] = bf2f(bb.y & 0xffffu) * __builtin_amdgcn_rcpf(1.0f + __expf(-v0[2])); o[3] = bf2f(bb.y >> 16) * __builtin_amdgcn_rcpf(1.0f + __expf(-v0[3]));
        o[4] = bf2f(bb.z & 0xffffu) * __builtin_amdgcn_rcpf(1.0f + __expf(-v1[0])); o[5] = bf2f(bb.z >> 16) * __builtin_amdgcn_rcpf(1.0f + __expf(-v1[1]));
        o[6] = bf2f(bb.w & 0xffffu) * __builtin_amdgcn_rcpf(1.0f + __expf(-v1[2])); o[7] = bf2f(bb.w >> 16) * __builtin_amdgcn_rcpf(1.0f + __expf(-v1[3]));
        if (!FIRST) { const u32x4 mm = *(const u32x4*)(MG + (size_t)R * 1024 + c);
            o[0] += bf2f(mm.x & 0xffffu); o[1] += bf2f(mm.x >> 16); o[2] += bf2f(mm.y & 0xffffu); o[3] += bf2f(mm.y >> 16);
            o[4] += bf2f(mm.z & 0xffffu); o[5] += bf2f(mm.z >> 16); o[6] += bf2f(mm.w & 0xffffu); o[7] += bf2f(mm.w >> 16); }
        u32x4 w; w.x = pk2(o[0], o[1]); w.y = pk2(o[2], o[3]); w.z = pk2(o[4], o[5]); w.w = pk2(o[6], o[7]);
        *(u32x4*)(MG + (size_t)R * 1024 + c) = w;
    }
    EPI_BODY_RS()
};
struct EpiRes {
    static constexpr bool PERM = true, AFTER_DRAIN = false;
    const float* Xin; bf16* HB; float* rowss_out;
    __device__ __forceinline__ float q(int R, int c, const f32x4& a) const {
        f32x4 h;
        if (Xin && R < NREAL) h = *(const f32x4*)(Xin + (size_t)R * 1024 + c);
        else { const u32x2 hb = *(const u32x2*)(HB + (size_t)R * 1024 + c); h = (f32x4){bf2f(hb.x & 0xffffu), bf2f(hb.x >> 16), bf2f(hb.y & 0xffffu), bf2f(hb.y >> 16)}; }
        h = h + a;
        u32x2 w; w.x = pk2(h[0], h[1]); w.y = pk2(h[2], h[3]);
        *(u32x2*)(HB + (size_t)R * 1024 + c) = w;
        const float r0 = bf2f(w.x & 0xffffu), r1 = bf2f(w.x >> 16), r2 = bf2f(w.y & 0xffffu), r3 = bf2f(w.y >> 16);
        return (r0 * r0 + r1 * r1) + (r2 * r2 + r3 * r3);
    }
    __device__ __forceinline__ float q2(int R, int c, const f32x4& a0, const f32x4& a1) const {
        f32x4 h0, h1;
        if (Xin && R < NREAL) { h0 = *(const f32x4*)(Xin + (size_t)R * 1024 + c); h1 = *(const f32x4*)(Xin + (size_t)R * 1024 + c + 4); }
        else { const u32x4 hb = *(const u32x4*)(HB + (size_t)R * 1024 + c);
            h0 = (f32x4){bf2f(hb.x & 0xffffu), bf2f(hb.x >> 16), bf2f(hb.y & 0xffffu), bf2f(hb.y >> 16)}; h1 = (f32x4){bf2f(hb.z & 0xffffu), bf2f(hb.z >> 16), bf2f(hb.w & 0xffffu), bf2f(hb.w >> 16)}; }
        h0 = h0 + a0; h1 = h1 + a1;
        u32x4 w; w.x = pk2(h0[0], h0[1]); w.y = pk2(h0[2], h0[3]); w.z = pk2(h1[0], h1[1]); w.w = pk2(h1[2], h1[3]);
        *(u32x4*)(HB + (size_t)R * 1024 + c) = w;
        const float r0 = bf2f(w.x & 0xffffu), r1 = bf2f(w.x >> 16), r2 = bf2f(w.y & 0xffffu), r3 = bf2f(w.y >> 16), r4 = bf2f(w.z & 0xffffu), r5 = bf2f(w.z >> 16), r6 = bf2f(w.w & 0xffffu), r7 = bf2f(w.w >> 16);
        return ((r0 * r0 + r1 * r1) + (r2 * r2 + r3 * r3)) + ((r4 * r4 + r5 * r5) + (r6 * r6 + r7 * r7));
    }
    __device__ __forceinline__ void rg(int R, int pn, int wc, int fq, const f32x4 (&a4)[2][2]) const {
        float ss = 0.f;
#pragma unroll
        for (int bj = 0; bj < 2; ++bj) ss += q2(R, pn * 256 + bj * 128 + wc * 32 + 8 * fq, a4[bj][0], a4[bj][1]);
        ss += __shfl_xor(ss, 16); ss += __shfl_xor(ss, 32);
        if (fq == 0) rowss_out[((size_t)pn * TPR + R) * 4 + wc] = ss;
    }
    __device__ __forceinline__ void tq(int R, int c, const f32x4& v) const {
        float ss = q(R, c, v);
        ss += __shfl_xor(ss, 16); ss += __shfl_xor(ss, 32);
        if ((threadIdx.x & 48) == 0) atomicAdd(rowss_out + (size_t)R * 4, ss);
    }
    EPI_OP()
};
struct EpiUp {
    static constexpr bool PERM = true, AFTER_DRAIN = false;
    const float* rowss; bf16* ACT;
    __device__ __forceinline__ void q(int R, int c, const f32x4& a, float rs) const {
        f32x4 v = a * rs;
#pragma unroll
        for (int j = 0; j < 4; ++j) { const float r = fmaxf(v[j], 0.f); v[j] = r * r; }
        u32x2 w; w.x = pk2(v[0], v[1]); w.y = pk2(v[2], v[3]);
        *(u32x2*)(ACT + (size_t)R * FF + c) = w;
    }
    __device__ __forceinline__ void q2(int R, int c, const f32x4& a0, const f32x4& a1, float rs) const {
        f32x4 v0 = a0 * rs, v1 = a1 * rs;
#pragma unroll
        for (int j = 0; j < 4; ++j) { const float r0 = fmaxf(v0[j], 0.f), r1 = fmaxf(v1[j], 0.f); v0[j] = r0 * r0; v1[j] = r1 * r1; }
        u32x4 w; w.x = pk2(v0[0], v0[1]); w.y = pk2(v0[2], v0[3]); w.z = pk2(v1[0], v1[1]); w.w = pk2(v1[2], v1[3]);
        *(u32x4*)(ACT + (size_t)R * FF + c) = w;
    }
    EPI_BODY_RS()
};
struct TripleOrder {
    pg8::StaticOrder S0; int arow, bcol;
    __device__ __forceinline__ void init(int G, int c, int arow_, int bcol_) { S0.init(NREAL, 1024, G, c); arow = arow_; bcol = bcol_; }
    __device__ __forceinline__ bool next(int i, pg8::Unit& u) const { pg8::Unit t; t.pm = 0; t.pn = 0; if (!S0.next(i / 3, t)) return false; const int br = i % 3; u.pm = t.pm + br * arow; u.pn = t.pn + br * bcol; return true; }
    __device__ __forceinline__ void a_ready(const pg8::Unit&) const {}
    __device__ __forceinline__ void done(const pg8::Unit&) const {}
};
struct EpiBr3 {
    static constexpr bool PERM = true, AFTER_DRAIN = false;
    bf16* Bbase; int arow;
    __device__ __forceinline__ void operator()(const f32x4 (&acc)[2][2][4][2], const pg8::Unit& u, int wr, int wc, int fr, int fq) const {
        const int c = u.pn >> 2, pn = u.pn & 3, pm = u.pm - arow * c; bf16* O = Bbase + (size_t)(2 * c + 2 * (c > 0)) * (UU / 2);
#pragma unroll
        for (int ai = 0; ai < 2; ++ai)
#pragma unroll
            for (int m = 0; m < 4; ++m) { const int R = pm * 256 + ai * 128 + wr * 64 + m * 16 + fr;
#pragma unroll
                for (int bj = 0; bj < 2; ++bj) { const f32x4 v0 = acc[ai][bj][m][0], v1 = acc[ai][bj][m][1];
                    u32x4 w; w.x = pk2(v0[0], v0[1]); w.y = pk2(v0[2], v0[3]); w.z = pk2(v1[0], v1[1]); w.w = pk2(v1[2], v1[3]);
                    *(u32x4*)(O + (size_t)R * 1024 + pn * 256 + bj * 128 + wc * 32 + 8 * fq) = w; } }
    }
};
struct EpiGate3 {
    static constexpr bool PERM = true, AFTER_DRAIN = false;
    const float* rowss; const bf16* Bbase; bf16* MG;
    __device__ __forceinline__ void operator()(const f32x4 (&acc)[2][2][4][2], const pg8::Unit& u, int wr, int wc, int fr, int fq) const {
        const int c = u.pn >> 2, pn = u.pn & 3; const bf16* BR = Bbase + (size_t)(2 * c + 2 * (c > 0)) * (UU / 2);
#pragma unroll
        for (int ai = 0; ai < 2; ++ai)
#pragma unroll
            for (int m = 0; m < 4; ++m) { const int R = u.pm * 256 + ai * 128 + wr * 64 + m * 16 + fr; const float rs = row_rstd(rowss, R);
#pragma unroll
                for (int bj = 0; bj < 2; ++bj) { const int cc = pn * 256 + bj * 128 + wc * 32 + 8 * fq;
                    const f32x4 v0 = acc[ai][bj][m][0] * rs, v1 = acc[ai][bj][m][1] * rs;
                    const u32x4 bb = *(const u32x4*)(BR + (size_t)R * 1024 + cc);
                    float o[8];
                    o[0] = bf2f(bb.x & 0xffffu) * __builtin_amdgcn_rcpf(1.0f + __expf(-v0[0])); o[1] = bf2f(bb.x >> 16) * __builtin_amdgcn_rcpf(1.0f + __expf(-v0[1]));
                    o[2] = bf2f(bb.y & 0xffffu) * __builtin_amdgcn_rcpf(1.0f + __expf(-v0[2])); o[3] = bf2f(bb.y >> 16) * __builtin_amdgcn_rcpf(1.0f + __expf(-v0[3]));
                    o[4] = bf2f(bb.z & 0xffffu) * __builtin_amdgcn_rcpf(1.0f + __expf(-v1[0])); o[5] = bf2f(bb.z >> 16) * __builtin_amdgcn_rcpf(1.0f + __expf(-v1[1]));
                    o[6] = bf2f(bb.w & 0xffffu) * __builtin_amdgcn_rcpf(1.0f + __expf(-v1[2])); o[7] = bf2f(bb.w >> 16) * __builtin_amdgcn_rcpf(1.0f + __expf(-v1[3]));
                    if (c != 0) { const u32x4 mm = *(const u32x4*)(MG + (size_t)R * 1024 + cc);
                        o[0] += bf2f(mm.x & 0xffffu); o[1] += bf2f(mm.x >> 16); o[2] += bf2f(mm.y & 0xffffu); o[3] += bf2f(mm.y >> 16);
                        o[4] += bf2f(mm.z & 0xffffu); o[5] += bf2f(mm.z >> 16); o[6] += bf2f(mm.w & 0xffffu); o[7] += bf2f(mm.w >> 16); }
                    u32x4 w; w.x = pk2(o[0], o[1]); w.y = pk2(o[2], o[3]); w.z = pk2(o[4], o[5]); w.w = pk2(o[6], o[7]);
                    *(u32x4*)(MG + (size_t)R * 1024 + cc) = w; } }
    }
};
template <class Epi>
__device__ __forceinline__ void thin_gemm(LAS unsigned char* lds, const bf16* A, const bf16* Bt, int K, int N, const Epi& E, int vb, int vg) {
    int tid_l = threadIdx.x; asm volatile("" : "+v"(tid_l));
    const int lane = tid_l & 63, w = __builtin_amdgcn_readfirstlane(tid_l >> 6), fr = lane & 15, fq = lane >> 4;
    LAS f32x4* red = (LAS f32x4*)lds;
    const int kw = K >> 3;
    for (int pc = vb; pc < N / 16; pc += vg) {
        const bf16* ap = A + (size_t)(NREAL + fr) * K + w * kw + 8 * fq;
        const bf16* bp = Bt + (size_t)(16 * pc + fr) * K + w * kw + 8 * fq;
        f32x4 acc[8];
#pragma unroll
        for (int rb = 0; rb < 8; ++rb) acc[rb] = (f32x4){0.f, 0.f, 0.f, 0.f};
#pragma unroll 2
        for (int k0 = 0; k0 < kw; k0 += 32) {
            const bf16x8 bf = *(const bf16x8*)(bp + k0);
            bf16x8 af[8];
#pragma unroll
            for (int rb = 0; rb < 8; ++rb) af[rb] = *(const bf16x8*)(ap + (size_t)(16 * rb) * K + k0);
#pragma unroll
            for (int rb = 0; rb < 8; ++rb) acc[rb] = __builtin_amdgcn_mfma_f32_16x16x32_bf16(bf, af[rb], acc[rb], 0, 0, 0);
        }
        asm volatile("s_nop 15\n\ts_nop 15" : "+v"(acc[0]), "+v"(acc[1]), "+v"(acc[2]), "+v"(acc[3]), "+v"(acc[4]), "+v"(acc[5]), "+v"(acc[6]), "+v"(acc[7]));
#pragma unroll
        for (int rb = 0; rb < 8; ++rb) red[(w * 8 + rb) * 64 + lane] = acc[rb];
        LDS_FENCE(); __syncthreads();
        f32x4 v = red[(0 * 8 + w) * 64 + lane];
#pragma unroll
        for (int ww = 1; ww < 8; ++ww) v = v + red[(ww * 8 + w) * 64 + lane];
        LDS_FENCE(); __syncthreads();
        E.tq(NREAL + 16 * w + fr, 16 * pc + 4 * fq, v);
    }
}

struct Args { const float* in[23]; float* out; unsigned char* ws; };

__device__ __forceinline__ void p0_item(const float* W, int ldw, int K, const float* scale, bf16* WT, int permrows, LAS float* scr, int item, int nblk, int lane) {
    const int kb = item / nblk, nb = item % nblk, k0 = 64 * kb, n0 = 64 * nb;
#pragma unroll 4
    for (int i = 0; i < 16; ++i) {
        const int kk = 4 * i + (lane >> 4), c4 = (lane & 15) * 4;
        f32x4 w = *(const f32x4*)(W + (size_t)(k0 + kk) * ldw + n0 + c4);
        if (scale) w = w * scale[k0 + kk];
        scr[kk * 65 + c4] = w[0]; scr[kk * 65 + c4 + 1] = w[1]; scr[kk * 65 + c4 + 2] = w[2]; scr[kk * 65 + c4 + 3] = w[3];
    }
    LDS_FENCE();
    const int c = lane & 7;
#pragma unroll
    for (int j = 0; j < 8; ++j) {
        const int n = (lane >> 3) + 8 * j;
        const int sc = (n0 + n) < permrows ? ((n & 1) ? 32 + (n >> 1) : (n >> 1)) : n;
        const LAS float* s = scr + (8 * c) * 65 + sc;
        u32x4 o; o.x = pk2(s[0 * 65], s[1 * 65]); o.y = pk2(s[2 * 65], s[3 * 65]); o.z = pk2(s[4 * 65], s[5 * 65]); o.w = pk2(s[6 * 65], s[7 * 65]);
        *(u32x4*)(WT + (size_t)(n0 + n) * K + k0 + 8 * c) = o;
    }
    LDS_FENCE();
}

typedef const __attribute__((address_space(4))) Args* KArgsP;
__device__ __forceinline__ void convert_layer_weights(KArgsP ka, LAS unsigned char* lds, int layer, int vw, int nvw, int wave, int lane, int part  ) {
    unsigned char* ws = ka->ws;
    LAS float* scr = (LAS float*)(lds + wave * 17408);
    constexpr int I_IN = 16 * 76, I_GLU = 8 * 8, I_BR = 8 * 16, I_OUT = 16 * 16, I_UP = 16 * 64, I_DN = 64 * 16, I_L = I_IN + I_GLU + 3 * I_BR + I_OUT + I_UP + I_DN;
    unsigned char* wl = ws + WS_W + (size_t)layer * LW_BYTES;
    for (int it = (part == 0 ? 0 : I_IN) + vw; it < (part == 0 ? I_IN : I_L); it += nvw) {
        int r = it;
        if (r < I_IN) { p0_item(ka->in[3] + (size_t)layer * DM * DIN, DIN, DM, ka->in[2] + layer * DM, (bf16*)(wl + OW_IN), 640, scr, r, 76, lane); continue; } r -= I_IN;
        if (r < I_GLU) { p0_item(ka->in[13] + (size_t)layer * 512 * 512, 512, 512, nullptr, (bf16*)(wl + OW_GLU), 0, scr, r, 8, lane); continue; } r -= I_GLU;
        if (r < 3 * I_BR) { const int c = r / I_BR; p0_item(ka->in[17] + ((size_t)layer * 3 + c) * 512 * 1024, 1024, 512, nullptr, (bf16*)(wl + OW_BR) + (size_t)c * 1024 * 512, 0, scr, r % I_BR, 16, lane); continue; } r -= 3 * I_BR;
        if (r < I_OUT) { p0_item(ka->in[18] + (size_t)layer * DM * DM, DM, DM, nullptr, (bf16*)(wl + OW_OUT), 0, scr, r, 16, lane); continue; } r -= I_OUT;
        if (r < I_UP) { p0_item(ka->in[20] + (size_t)layer * DM * FF, FF, DM, ka->in[19] + layer * DM, (bf16*)(wl + OW_UP), 0, scr, r, 64, lane); continue; } r -= I_UP;
        p0_item(ka->in[21] + (size_t)layer * FF * DM, DM, FF, nullptr, (bf16*)(wl + OW_DN), 0, scr, r, 16, lane);
    }
    if (part == 1) for (int i = vw * 64 + lane; i < 512 * 64; i += nvw * 64) {
        const int n = i >> 6, k0 = (i & 63) * 8;
        u32x4 o = {0u, 0u, 0u, 0u};
        if ((n >> 7) == (k0 >> 7)) { const float* src = ka->in[15] + (((size_t)layer * 4 + (n >> 7)) * 128 + (k0 & 127)) * 128 + (n & 127);
            o.x = pk2(src[0], src[128]); o.y = pk2(src[256], src[384]); o.z = pk2(src[512], src[640]); o.w = pk2(src[768], src[896]); }
        *(u32x4*)((bf16*)(wl + OW_POOL) + (size_t)n * 512 + k0) = o;
    }
}

__device__ __forceinline__ void p0_prologue(const Args& a, LAS unsigned char* lds) {
    int tl_ = threadIdx.x; asm volatile("" : "+v"(tl_));
    const int tid = tl_, lane = tid & 63, wave = __builtin_amdgcn_readfirstlane(tid >> 6);
    const int gw = blockIdx.x * 8 + wave, NGW = gridDim.x * 8;
    const int gt = blockIdx.x * 512 + tid, NGT = gridDim.x * 512;
    unsigned char* ws = a.ws;
    for (int i = gt; i < 4 * 4 * 128 * 4; i += NGT) { const int idx = 1 + (i >> 11), pn = (i >> 9) & 3, r = (i >> 2) & 127, sl = i & 3;
        ((float*)(ws + WS_RS))[((size_t)idx * 4 * TPR + (size_t)pn * TPR + NREAL + r) * 4 + sl] = 0.f; }
    for (int i = gt; i < LL * 32; i += NGT) {
        const int l = i >> 5, f = i & 31;
        const float invf = (float)dexp(-(double)f * (9.21034037197618273607 / 32.0));
        const float ang = (float)l * invf;
        double s, c; dsincos((double)ang, s, c);
        float* rp = (float*)(ws + WS_ROPE) + (size_t)i * 2; rp[0] = (float)c; rp[1] = (float)s;
    }
    for (int j = gt; j < 2 * 2 * 32 * 64 * 16; j += NGT) {
        const int q = j & 15, i = j >> 4, n = i & 63, pidx = i >> 6;
        const double lr = (double)a.in[5][i], li = (double)a.in[6][i];
        const double dt = (double)(float)dexp((double)a.in[7][pidx]);
        const double mag = dexp(lr * dt); double sn, cn; dsincos(li * dt, sn, cn);
        const double are = mag * cn, aim = mag * sn, den = lr * lr + li * li, nre = are - 1.0;
        const double fre = (nre * lr + aim * li) / den, fim = (aim * lr - nre * li) / den;
        if (q == 0) { float* ab = (float*)(ws + WS_ABAR) + (size_t)i * 2; ab[0] = (float)are; ab[1] = (float)aim; }
        bf16* bm = (bf16*)(ws + WS_BMAT) + (size_t)pidx * 128 * 16;
        bf16* cm = (bf16*)(ws + WS_CMAT) + (size_t)pidx * 16 * 128;
        const double br = (double)a.in[8][(size_t)i * 16 + q], bi = (double)a.in[9][(size_t)i * 16 + q];
        bm[n * 16 + q] = (bf16)f2bf((float)(fre * br - fim * bi));
        bm[(64 + n) * 16 + q] = (bf16)f2bf((float)(fre * bi + fim * br));
        *(unsigned*)(cm + q * 128 + 2 * n) = pk2(a.in[10][((size_t)pidx * 16 + q) * 64 + n], -a.in[11][((size_t)pidx * 16 + q) * 64 + n]);
    }
    for (int R = gw; R < TPR; R += NGW) {
        const int mrow = R - NREAL;
        const float* src = R < NREAL ? a.in[0] + (size_t)R * DM : a.in[1] + (size_t)(mrow & 15) * DM;
        float* dst = R < NREAL ? a.out + (size_t)R * DM : (float*)(ws + WS_HM) + (size_t)mrow * DM;
        bf16* hb = (bf16*)(ws + WS_HB) + (size_t)R * DM;
        const bool pad = mrow >= NB * NMETA;
        float ss = 0.f;
#pragma unroll
        for (int j = 0; j < 4; ++j) {
            f32x4 v = *(const f32x4*)(src + 4 * lane + 256 * j);
            if (pad) v = (f32x4){0.f, 0.f, 0.f, 0.f};
            ss += (v[0] * v[0] + v[1] * v[1]) + (v[2] * v[2] + v[3] * v[3]);
            u32x2 w; w.x = pk2(v[0], v[1]); w.y = pk2(v[2], v[3]);
            *(u32x2*)(hb + 4 * lane + 256 * j) = w;
        }
#pragma unroll
        for (int o = 1; o < 64; o <<= 1) ss += __shfl_xor(ss, o);
        if (lane < 16) ((float*)(ws + WS_RS))[((size_t)(lane >> 2) * TPR + R) * 4 + (lane & 3)] = lane == 0 ? ss : 0.f;
    }
}

__device__ __forceinline__ void ssm_task(LAS unsigned char* lds, int task, int layer, const bf16* SU, float* YF,
                                         const float* abar_all, const bf16* bmat_all, const bf16* cmat_all) {
    int tid_l = threadIdx.x; asm volatile("" : "+v"(tid_l));
    const int tid = tid_l, lane = tid & 63, wave = __builtin_amdgcn_readfirstlane(tid >> 6);
    const int b = task >> 5, g = task & 31;
    __syncthreads();
    LAS float* BU = (LAS float*)(lds + wave * 12800);
    LAS unsigned short* X = (LAS unsigned short*)(lds + wave * 12800 + 8448);
    LAS float* SX = (LAS float*)(lds + 8 * 12800);
    const int blk0 = wave == 0 ? 0 : 16 * wave + 1, nblk = wave == 0 ? 17 : 16;
    bf16* yfb = (bf16*)YF + (size_t)task * LL * 16;
    const int fr = lane & 15, fq = lane >> 4;
    const bf16x8 zero8 = {0, 0, 0, 0, 0, 0, 0, 0};
    for (int dir = 0; dir < 2; ++dir) {
        const int pidx = (layer * 2 + dir) * 32 + g;
        const float are = abar_all[((size_t)pidx * 64 + lane) * 2], aim = abar_all[((size_t)pidx * 64 + lane) * 2 + 1];
        bf16x8 bfr[8], cfr[4];
        const bf16* bm = bmat_all + (size_t)pidx * 128 * 16;
#pragma unroll
        for (int nt = 0; nt < 8; ++nt) bfr[nt] = fq < 2 ? *(const bf16x8*)(bm + (nt * 16 + fr) * 16 + 8 * fq) : zero8;
        const bf16* cm = cmat_all + (size_t)pidx * 16 * 128;
#pragma unroll
        for (int ks = 0; ks < 4; ++ks) cfr[ks] = *(const bf16x8*)(cm + fr * 128 + ks * 32 + 8 * fq);
        float p16r = are, p16i = aim;
#pragma unroll
        for (int i = 0; i < 4; ++i) { const float tr = p16r * p16r - p16i * p16i, ti = 2.f * p16r * p16i; p16r = tr; p16i = ti; }
        float p256r = p16r, p256i = p16i;
#pragma unroll
        for (int i = 0; i < 4; ++i) { const float tr = p256r * p256r - p256i * p256i, ti = 2.f * p256r * p256i; p256r = tr; p256i = ti; }
        const float p272r = p256r * p16r - p256i * p16i, p272i = p256r * p16i + p256i * p16r;

        float xre = 0.f, xim = 0.f;
        for (int pass = 0; pass < 2; ++pass) {
            bf16x8 unext;
            { const int blkf = dir == 0 ? blk0 : blk0 + nblk - 1; const int Rf = blkf == 0 ? NREAL + b * NMETA : b * SEQ + blkf * 16 - NMETA;
              unext = fq < 2 ? *(const bf16x8*)(SU + (size_t)(Rf + fr) * 512 + g * 16 + 8 * fq) : zero8; }
            for (int ib = 0; ib < nblk; ++ib) {
                const int blk = dir == 0 ? blk0 + ib : blk0 + nblk - 1 - ib;
                const bf16x8 ufr = unext;
                if (ib + 1 < nblk) { const int blkn = dir == 0 ? blk + 1 : blk - 1; const int Rn = blkn == 0 ? NREAL + b * NMETA : b * SEQ + blkn * 16 - NMETA;
                    unext = fq < 2 ? *(const bf16x8*)(SU + (size_t)(Rn + fr) * 512 + g * 16 + 8 * fq) : zero8; }
                f32x4 dd[8];
#pragma unroll
                for (int nt = 0; nt < 8; ++nt) { dd[nt] = (f32x4){0.f, 0.f, 0.f, 0.f}; dd[nt] = __builtin_amdgcn_mfma_f32_16x16x32_bf16(ufr, bfr[nt], dd[nt], 0, 0, 0); }
                asm volatile("s_nop 15\n\ts_nop 15" : "+v"(dd[0]), "+v"(dd[1]), "+v"(dd[2]), "+v"(dd[3]), "+v"(dd[4]), "+v"(dd[5]), "+v"(dd[6]), "+v"(dd[7]));
#pragma unroll
                for (int nt = 0; nt < 8; ++nt)
#pragma unroll
                    for (int r = 0; r < 4; ++r) BU[(4 * fq + r) * 132 + nt * 16 + fr] = dd[nt][r];
                LDS_FENCE();
                float bur[16], bui[16];
#pragma unroll
                for (int i = 0; i < 16; ++i) { const int tt = dir == 0 ? i : 15 - i; bur[i] = BU[tt * 132 + lane]; bui[i] = BU[tt * 132 + 64 + lane]; }
                if (pass == 0) {
#pragma unroll
                    for (int i = 0; i < 16; ++i) {
                        const float bre = bur[i], bim = bui[i];
                        const float nr = are * xre - aim * xim + bre, ni = are * xim + aim * xre + bim; xre = nr; xim = ni;
                    }
                    LDS_FENCE();
                } else {
#pragma unroll
                    for (int i = 0; i < 16; ++i) {
                        const int tt = dir == 0 ? i : 15 - i;
                        const float bre = bur[i], bim = bui[i];
                        const float nr = are * xre - aim * xim + bre, ni = are * xim + aim * xre + bim; xre = nr; xim = ni;
                        *(LAS unsigned*)(X + tt * 136 + 2 * lane) = pk2(xre, xim);
                    }
                    LDS_FENCE();
                    f32x4 y = {0.f, 0.f, 0.f, 0.f};
#pragma unroll
                    for (int ks = 0; ks < 4; ++ks) {
                        const bf16x8 afr = *(const LAS bf16x8*)(X + fr * 136 + ks * 32 + 8 * fq);
                        y = __builtin_amdgcn_mfma_f32_16x16x32_bf16(afr, cfr[ks], y, 0, 0, 0);
                    }
                    asm volatile("s_nop 15\n\ts_nop 15" : "+v"(y));
                    LDS_FENCE();
                    {
                        bf16* yd = yfb + (size_t)dir * 256 * LL * 16;
#pragma unroll
                        for (int r = 0; r < 4; ++r) yd[(size_t)(blk * 16 + 4 * fq + r) * 16 + fr] = (bf16)f2bf(y[r]);
                    }
                }
            }
            if (pass == 0) {
                SX[(wave * 64 + lane) * 2] = xre; SX[(wave * 64 + lane) * 2 + 1] = xim;
                LDS_FENCE(); __syncthreads();
                float cre = 0.f, cim = 0.f;
                if (dir == 0) {
                    for (int w = 0; w < wave; ++w) { const float pr = w == 0 ? p272r : p256r, pi = w == 0 ? p272i : p256i;
                        const float sr = SX[(w * 64 + lane) * 2], si = SX[(w * 64 + lane) * 2 + 1];
                        const float nr = pr * cre - pi * cim + sr, ni = pr * cim + pi * cre + si; cre = nr; cim = ni; }
                } else {
                    for (int w = 7; w > wave; --w) {
                        const float sr = SX[(w * 64 + lane) * 2], si = SX[(w * 64 + lane) * 2 + 1];
                        const float nr = p256r * cre - p256i * cim + sr, ni = p256r * cim + p256i * cre + si; cre = nr; cim = ni; }
                }
                xre = cre; xim = cim;
            }
        }
        LDS_FENCE(); __syncthreads();
    }
}

constexpr int ATT_KROW = 72, ATT_VROW = 40, ATT_KT = 32 * ATT_KROW * 2  , ATT_VT = 64 * ATT_VROW * 2  , ATT_MAXT = 11, ATT_VOFF = ATT_MAXT * ATT_KT;
static_assert(ATT_VOFF + ATT_MAXT * ATT_VT <= 131072, "attention LDS");
__device__ __forceinline__ void attn_task(LAS unsigned char* lds, int task, const bf16* Q, const bf16* K, const bf16* V, bf16* YA, const float* sink) {
    int tid_l = threadIdx.x; asm volatile("" : "+v"(tid_l));
    const int tid = tid_l, lane = tid & 63, wave = __builtin_amdgcn_readfirstlane(tid >> 6);
    const int qb = task < 512 ? (task & 31) : 32, bh = task < 512 ? (task >> 5) : task - 512, h = bh & 1, b = bh >> 1;
    const int l0 = qb * 64;
    __syncthreads();
    int jlo = (l0 - 128) >> 5; if (jlo < 1) jlo = 1;
    int jhi = (l0 + 191) >> 5; if (jhi > 64) jhi = 64;
    const int ntiles = 1 + (jhi - jlo + 1);
    LAS unsigned short* Ks = (LAS unsigned short*)lds;
    LAS unsigned short* Vs = (LAS unsigned short*)(lds + ATT_VOFF);
    for (int idx = tid; idx < ntiles * 32 * 8; idx += 512) {
        const int ch = idx & 7, key = idx >> 3, slot = key >> 5, kk = key & 31;
        const int lk = (slot == 0 ? 0 : (jlo + slot - 1) * 32) + kk;
        u32x4 kv = {0u, 0u, 0u, 0u}, vv = {0u, 0u, 0u, 0u};
        if (lk < LL) { const size_t R = (size_t)tok_row(b, lk);
            kv = *(const u32x4*)(K + R * 128 + h * 64 + ch * 8); vv = *(const u32x4*)(V + R * 128 + h * 64 + ch * 8); }
        *(LAS u32x4*)(Ks + slot * (ATT_KT / 2) + kk * ATT_KROW + ch * 8) = kv;
        LAS unsigned short* vd = Vs + slot * (ATT_VT / 2) + (ch * 8) * ATT_VROW + kk;
        vd[0 * ATT_VROW] = (unsigned short)(vv.x & 0xffffu); vd[1 * ATT_VROW] = (unsigned short)(vv.x >> 16);
        vd[2 * ATT_VROW] = (unsigned short)(vv.y & 0xffffu); vd[3 * ATT_VROW] = (unsigned short)(vv.y >> 16);
        vd[4 * ATT_VROW] = (unsigned short)(vv.z & 0xffffu); vd[5 * ATT_VROW] = (unsigned short)(vv.z >> 16);
        vd[6 * ATT_VROW] = (unsigned short)(vv.w & 0xffffu); vd[7 * ATT_VROW] = (unsigned short)(vv.w >> 16);
    }
    LDS_FENCE(); __syncthreads();
    const int head = h * 4 + (wave >> 1), r32 = lane & 31, hi = lane >> 5;
    const int lq = l0 + 32 * (wave & 1) + r32;
    const bool qvalid = lq < LL;
    const size_t Rq = (size_t)tok_row(b, qvalid ? lq : LL - 1);
    bf16x8 qf[4];
#pragma unroll
    for (int ks = 0; ks < 4; ++ks) qf[ks] = *(const bf16x8*)(Q + Rq * 512 + head * 64 + ks * 16 + 8 * hi);
    float mrun = sink[head], lsum = hi == 0 ? 1.0f : 0.0f;
    f32x16 o0, o1;
#pragma unroll
    for (int i = 0; i < 16; ++i) { o0[i] = 0.f; o1[i] = 0.f; }
    const int lqw = l0 + 32 * (wave & 1);
    for (int slot = 0; slot < ntiles; ++slot) {
        const int kbase = slot == 0 ? 0 : (jlo + slot - 1) * 32;
        if (lqw >= LL || (slot != 0 && (kbase + 31 < lqw - 128 || kbase > lqw + 31 + 128))) continue;
        const LAS unsigned short* kt = Ks + slot * (ATT_KT / 2);
        f32x16 s;
#pragma unroll
        for (int i = 0; i < 16; ++i) s[i] = 0.f;
#pragma unroll
        for (int ks = 0; ks < 4; ++ks) {
            const bf16x8 kf = *(const LAS bf16x8*)(kt + r32 * ATT_KROW + ks * 16 + 8 * hi);
            s = __builtin_amdgcn_mfma_f32_32x32x16_bf16(kf, qf[ks], s, 0, 0, 0);
        }
        asm volatile("s_nop 15\n\ts_nop 15" : "+v"(s));
        float mt = -1e30f;
#pragma unroll
        for (int i = 0; i < 16; ++i) {
            const int lk = kbase + (i & 3) + 8 * (i >> 2) + 4 * hi;
            int d = lq - lk; d = d < 0 ? -d : d;
            const bool valid = (lk < NMETA) || (d <= 128 && lk < LL);
            s[i] = valid ? s[i] : -1e30f;
            mt = fmaxf(mt, s[i]);
        }
        mt = fmaxf(mt, __shfl_xor(mt, 32));
        const float mnew = fmaxf(mrun, mt);
        const float alpha = __expf(mrun - mnew);
        mrun = mnew;
        float ps = 0.f;
#pragma unroll
        for (int i = 0; i < 16; ++i) { s[i] = __expf(s[i] - mnew); ps += s[i]; }
        lsum = lsum * alpha + ps;
#pragma unroll
        for (int i = 0; i < 16; ++i) { o0[i] *= alpha; o1[i] *= alpha; }
        const LAS unsigned short* vt = Vs + slot * (ATT_VT / 2);
#pragma unroll
        for (int s2 = 0; s2 < 2; ++s2) {
            union { bf16x8 v; unsigned u[4]; } pf;
            pf.u[0] = pk2(s[8 * s2 + 0], s[8 * s2 + 1]); pf.u[1] = pk2(s[8 * s2 + 2], s[8 * s2 + 3]);
            pf.u[2] = pk2(s[8 * s2 + 4], s[8 * s2 + 5]); pf.u[3] = pk2(s[8 * s2 + 6], s[8 * s2 + 7]);
#pragma unroll
            for (int dt = 0; dt < 2; ++dt) {
                union { bf16x8 v; u32x2 u[2]; } vf;
                const LAS unsigned short* vp = vt + (dt * 32 + r32) * ATT_VROW + 16 * s2 + 4 * hi;
                vf.u[0] = *(const LAS u32x2*)(vp); vf.u[1] = *(const LAS u32x2*)(vp + 8);
                if (dt == 0) o0 = __builtin_amdgcn_mfma_f32_32x32x16_bf16(vf.v, pf.v, o0, 0, 0, 0);
                else o1 = __builtin_amdgcn_mfma_f32_32x32x16_bf16(vf.v, pf.v, o1, 0, 0, 0);
            }
        }
    }
    asm volatile("s_nop 15\n\ts_nop 15" : "+v"(o0), "+v"(o1));
    lsum += __shfl_xor(lsum, 32);
    const float inv = 1.0f / lsum;
    if (qvalid) {
#pragma unroll
        for (int g4 = 0; g4 < 4; ++g4) {
            u32x2 w0, w1;
            w0.x = pk2(o0[4 * g4] * inv, o0[4 * g4 + 1] * inv); w0.y = pk2(o0[4 * g4 + 2] * inv, o0[4 * g4 + 3] * inv);
            w1.x = pk2(o1[4 * g4] * inv, o1[4 * g4 + 1] * inv); w1.y = pk2(o1[4 * g4 + 2] * inv, o1[4 * g4 + 3] * inv);
            *(u32x2*)(YA + Rq * 512 + head * 64 + 8 * g4 + 4 * hi) = w0;
            *(u32x2*)(YA + Rq * 512 + head * 64 + 32 + 8 * g4 + 4 * hi) = w1;
        }
    }
    __syncthreads();
}

__device__ __forceinline__ void pool_diff(LAS unsigned char* lds, const bf16* PU, bf16* PD) {
    int tl_ = threadIdx.x; asm volatile("" : "+v"(tl_));
    constexpr int TOK = 65, HALO = 8, ROWS = TOK + 2 * HALO, NTOK = NB * LL;
    for (int blk = blockIdx.x; blk * TOK < NTOK; blk += gridDim.x) {
        const int f0 = blk * TOK;
        __syncthreads();
        for (int i = tl_; i < ROWS * 64; i += 512) {
            const int r = i >> 6, ch = i & 63, f = f0 - HALO + r;
            u32x4 v = {0u, 0u, 0u, 0u};
            if (f >= 0 && f < NTOK) { const int b = f / LL, l = f % LL; v = *(const u32x4*)(PU + (size_t)tok_row(b, l) * 512 + ch * 8); }
            *(LAS u32x4*)(lds + (size_t)i * 16) = v;
        }
        LDS_FENCE(); __syncthreads();
        for (int i = tl_; i < TOK * 64; i += 512) {
            const int t = i >> 6, ch = i & 63, f = f0 + t;
            if (f >= NTOK) continue;
            const int b = f / LL, l = f % LL, half = 1 << (ch >> 4);
            const int lo = l - half < 0 ? 0 : l - half, hh = l + half > LL ? LL : l + half;
            float s[8];
#pragma unroll
            for (int j = 0; j < 8; ++j) s[j] = 0.f;
            for (int lp = lo; lp < hh; ++lp) {
                const u32x4 v = *(const LAS u32x4*)(lds + (size_t)((t + HALO + lp - l) * 64 + ch) * 16);
                s[0] += bf2f(v.x & 0xffffu); s[1] += bf2f(v.x >> 16); s[2] += bf2f(v.y & 0xffffu); s[3] += bf2f(v.y >> 16);
                s[4] += bf2f(v.z & 0xffffu); s[5] += bf2f(v.z >> 16); s[6] += bf2f(v.w & 0xffffu); s[7] += bf2f(v.w >> 16);
            }
            const float ic = 1.0f / (float)(hh - lo);
            const u32x4 v = *(const LAS u32x4*)(lds + (size_t)((t + HALO) * 64 + ch) * 16);
            u32x4 o;
            o.x = pk2(s[0] * ic - bf2f(v.x & 0xffffu), s[1] * ic - bf2f(v.x >> 16)); o.y = pk2(s[2] * ic - bf2f(v.y & 0xffffu), s[3] * ic - bf2f(v.y >> 16));
            o.z = pk2(s[4] * ic - bf2f(v.z & 0xffffu), s[5] * ic - bf2f(v.z >> 16)); o.w = pk2(s[6] * ic - bf2f(v.w & 0xffffu), s[7] * ic - bf2f(v.w >> 16));
            *(u32x4*)(PD + (size_t)tok_row(b, l) * 512 + ch * 8) = o;
        }
    }
    __syncthreads();
}

__device__ __forceinline__ void z_pass(const float* YF, const bf16* SU, const float* dskip, bf16* Z) {
    int tl_ = threadIdx.x; asm volatile("" : "+v"(tl_)); const int gt = blockIdx.x * 512 + tl_, NGT = gridDim.x * 512;
    for (int i = gt; i < NB * LL * 64; i += NGT) {
        const int ch = i & 63, tk = i >> 6, b = tk / LL, l = tk % LL, g = ch >> 1;
        const size_t R = (size_t)tok_row(b, l);
        const bf16* yp = (const bf16*)YF + ((size_t)(b * 32 + g) * LL + l) * 16 + (ch & 1) * 8;
        const u32x4 ya = *(const u32x4*)yp, yb = *(const u32x4*)(yp + (size_t)256 * LL * 16);
        f32x4 y0, y1;
        y0[0] = bf2f(ya.x & 0xffffu) + bf2f(yb.x & 0xffffu); y0[1] = bf2f(ya.x >> 16) + bf2f(yb.x >> 16); y0[2] = bf2f(ya.y & 0xffffu) + bf2f(yb.y & 0xffffu); y0[3] = bf2f(ya.y >> 16) + bf2f(yb.y >> 16);
        y1[0] = bf2f(ya.z & 0xffffu) + bf2f(yb.z & 0xffffu); y1[1] = bf2f(ya.z >> 16) + bf2f(yb.z >> 16); y1[2] = bf2f(ya.w & 0xffffu) + bf2f(yb.w & 0xffffu); y1[3] = bf2f(ya.w >> 16) + bf2f(yb.w >> 16);
        const f32x4 d0 = *(const f32x4*)(dskip + ch * 8), d1 = *(const f32x4*)(dskip + ch * 8 + 4);
        const u32x4 uu = *(const u32x4*)(SU + R * 512 + ch * 8);
        float t[8];
        t[0] = y0[0] + d0[0] * bf2f(uu.x & 0xffffu); t[1] = y0[1] + d0[1] * bf2f(uu.x >> 16); t[2] = y0[2] + d0[2] * bf2f(uu.y & 0xffffu); t[3] = y0[3] + d0[3] * bf2f(uu.y >> 16);
        t[4] = y1[0] + d1[0] * bf2f(uu.z & 0xffffu); t[5] = y1[1] + d1[1] * bf2f(uu.z >> 16); t[6] = y1[2] + d1[2] * bf2f(uu.w & 0xffffu); t[7] = y1[3] + d1[3] * bf2f(uu.w >> 16);
#pragma unroll
        for (int j = 0; j < 8; ++j) {
            const float v = t[j], tt = __builtin_amdgcn_rcpf(fabsf(v) * 0.2316418882f + 1.0f);
            float q = tt * 0.5307027145f + (-0.7265760135f); q = q * tt + 0.7107068705f; q = q * tt + (-0.142248368f); q = q * tt + 0.127414796f; q = q * tt;
            const float m = v * (q * __builtin_amdgcn_exp2f(v * v * (-0.72134752044f)));
            t[j] = v < 0.f ? m : v - m;
        }
        u32x4 o; o.x = pk2(t[0], t[1]); o.y = pk2(t[2], t[3]); o.z = pk2(t[4], t[5]); o.w = pk2(t[6], t[7]);
        *(u32x4*)(Z + R * 512 + ch * 8) = o;
    }
}

#define XB_TMO      128
#define XB_XCNT(j)  (256  + 64 * (j))
#define XB_XSUB(j)  (1280 + 64 * (j))
#define XB_XGEN(j)  (2304 + 64 * (j))
#define XB_TOP      3328
#define XB_TOPGEN   3392
#define XCD_BAR_WORDS 3456
#define XB_SPIN_CAP (1u << 18)

__device__ __forceinline__ unsigned xb_ld(unsigned* p)              { return __hip_atomic_load(p, __ATOMIC_RELAXED, __HIP_MEMORY_SCOPE_AGENT); }
__device__ __forceinline__ unsigned xb_add(unsigned* p, unsigned v) { return __hip_atomic_fetch_add(p, v, __ATOMIC_RELAXED, __HIP_MEMORY_SCOPE_AGENT); }
__device__ __forceinline__ unsigned xb_xcc_id() { return (unsigned)__builtin_amdgcn_s_getreg((3 << 11) | 20) & 0xFu; }
#define XB_SPIN(cond, bar) do { unsigned _sp = 0; while (cond) { __builtin_amdgcn_s_sleep(1); \
    if ((++_sp & 255u) == 0u) { if (xb_ld(&(bar)[XB_TMO])) break; if (_sp > XB_SPIN_CAP) { atomicAdd(&(bar)[XB_TMO], 1u); break; } } } } while (0)

struct XcdBarrier {
    unsigned* bar; unsigned x;
    volatile LAS unsigned* st;
};

__device__ __forceinline__ XcdBarrier xcd_barrier_post(unsigned* bar, volatile LAS unsigned* st) {
    XcdBarrier b; b.bar = bar; b.x = xb_xcc_id(); b.st = st;
    if (threadIdx.x == 0) (void)xb_add(&bar[XB_XCNT(b.x)], 1u);
    return b;
}
__device__ __forceinline__ void xcd_barrier_complete(unsigned* bar, unsigned x, unsigned& nloc, unsigned& nx) {
    const unsigned G = gridDim.x * gridDim.y * gridDim.z;
    unsigned sum, cnt, mine, sp = 0u;
    for (;;) {
        sum = 0u; cnt = 0u; mine = 0u;
#pragma unroll
        for (unsigned j = 0; j < 16; ++j) { const unsigned c = xb_ld(&bar[XB_XCNT(j)]); sum += c; cnt += (c > 0u) ? 1u : 0u; mine = (j == x) ? c : mine; }
        if (sum == G) break;
        __builtin_amdgcn_s_sleep(1);
        if ((++sp & 255u) == 0u) { if (xb_ld(&bar[XB_TMO])) break; if (sp > XB_SPIN_CAP) { atomicAdd(&bar[XB_TMO], 1u); break; } }
    }
    nloc = mine > 0u ? mine : 1u; nx = cnt > 0u ? cnt : 1u;
}

__device__ __forceinline__ void xcd_barrier(const XcdBarrier& b) {
    asm volatile("s_waitcnt vmcnt(0)" ::: "memory");
    __syncthreads();
    if (threadIdx.x == 0) {
        unsigned* bar = b.bar;
        __builtin_amdgcn_s_waitcnt(0);
        unsigned nloc = b.st[0], nx = b.st[1];
        if (nloc == 0u) { xcd_barrier_complete(bar, b.x, nloc, nx); b.st[0] = nloc; b.st[1] = nx; }
        const unsigned old = xb_add(&bar[XB_XSUB(b.x)], 1u);
        const unsigned gen = old / nloc;
        if (old + 1u == (gen + 1u) * nloc) {
            __builtin_amdgcn_fence(__ATOMIC_RELEASE, "agent");
            asm volatile("s_waitcnt vmcnt(0)" ::: "memory");
            const unsigned og = xb_add(&bar[XB_TOP], 1u);
            const unsigned tg = og / nx;
            if (og + 1u == (tg + 1u) * nx) xb_add(&bar[XB_TOPGEN], 1u);
            else XB_SPIN(xb_ld(&bar[XB_TOPGEN]) == tg, bar);
            __builtin_amdgcn_fence(__ATOMIC_ACQUIRE, "agent");
            xb_add(&bar[XB_XGEN(b.x)], 1u);
            asm volatile("s_waitcnt vmcnt(0)" ::: "memory");
        } else {
            XB_SPIN(xb_ld(&bar[XB_XGEN(b.x)]) == gen, bar);
            __builtin_amdgcn_fence(__ATOMIC_ACQUIRE, "agent");
            asm volatile("s_waitcnt vmcnt(0)" ::: "memory");
        }
    }
    __syncthreads();
}

#ifndef MK_ALIGN
#define MK_ALIGN true
#endif
#ifndef MK_SP2
#define MK_SP2 true
#endif
#ifndef MK_SPLIT
#define MK_SPLIT 0
#endif
#ifndef MK_NLAYER
#define MK_NLAYER 2
#endif
constexpr int NPL = 8, NPHASE = 1 + 2 * NPL + 1, PH_FINAL = NPHASE - 1;

#define KARGS() ({ auto kp_ = __builtin_amdgcn_kernarg_segment_ptr(); asm volatile("" : "+s"(kp_)); (KArgsP)kp_; })
__global__ void __launch_bounds__(512, 2) fwd_kernel(Args a_unused, int ph_lo, int ph_hi) {
    (void)a_unused;
    extern __shared__ __attribute__((aligned(16))) unsigned char lds_raw[];
    LAS unsigned char* lds = (LAS unsigned char*)lds_raw;
    const int G = gridDim.x, bid = blockIdx.x;
#if MK_SPLIT
#define GRID_SYNC() do {} while (0)
    (void)lds;
#else
#define CG_SYNC() do { asm volatile("s_waitcnt vmcnt(0)" ::: "memory"); __syncthreads(); \
    if (threadIdx.x == 0) { __builtin_amdgcn_fence(__ATOMIC_RELEASE, "agent"); asm volatile("s_waitcnt vmcnt(0)" ::: "memory"); } \
    __syncthreads(); grid.sync(); \
    if (threadIdx.x == 0) { __builtin_amdgcn_fence(__ATOMIC_ACQUIRE, "agent"); asm volatile("s_waitcnt vmcnt(0)" ::: "memory"); } \
    __syncthreads(); } while (0)
    cg::grid_group grid = cg::this_grid();
    unsigned* barw = (unsigned*)(KARGS()->ws + WS_CTL);
    if (bid == 0) for (int i = threadIdx.x; i < XCD_BAR_WORDS; i += 512) __hip_atomic_store(barw + i, 0u, __ATOMIC_RELAXED, __HIP_MEMORY_SCOPE_AGENT);
    volatile LAS unsigned* xst = (volatile LAS unsigned*)(lds + LDS_BYTES - 64);
    if (threadIdx.x < 2) xst[threadIdx.x] = 0u;
    CG_SYNC();
    const XcdBarrier xbar = xcd_barrier_post(barw, xst);
#define GRID_SYNC() xcd_barrier(xbar)

#endif
#ifndef PHMASK
#define PHMASK 0xFFFFu
#endif
#define IN(k) (((PHMASK >> ((k) == 0 ? 0 : (k) == PH_FINAL ? 9 : 1 + ((k) - 1) % NPL)) & 1u) && ph_lo <= (k) && (k) < ph_hi)
#define SEAM(k) do { if (IN(k) && (k) + 1 < ph_hi) GRID_SYNC(); } while (0)
#define PHASE_BEGIN() KArgsP ka = KARGS(); unsigned char* ws = ka->ws; asm volatile("" : "+s"(ws)); float* rowss = (float*)(ws + WS_RS); float* Hm = (float*)(ws + WS_HM); bf16* HB = (bf16*)(ws + WS_HB); unsigned char* wl = ws + WS_W + (size_t)layer * LW_BYTES; \
    const int MT = NREAL; const bool META = layer != MK_NLAYER - 1;     \
    const float* rs_mix = rowss + (size_t)(2 * layer) * TPR * 16; float* rs_mlp = rowss + (size_t)(2 * layer + 1) * TPR * 16; float* rs_next = rowss + (size_t)(2 * layer + 2) * TPR * 16; (void)MT; (void)META; (void)Hm; (void)HB; (void)wl; (void)rs_mix; (void)rs_mlp; (void)rs_next;

    if (IN(0)) {
        { int tl_ = threadIdx.x; asm volatile("" : "+v"(tl_)); const int wv = __builtin_amdgcn_readfirstlane(tl_ >> 6);
          convert_layer_weights(KARGS(), lds, 0, bid * 8 + wv, G * 8, wv, tl_ & 63, 0); }
        Args al; { KArgsP kp = KARGS(); for (int i = 0; i < 23; ++i) al.in[i] = kp->in[i]; al.out = kp->out; al.ws = kp->ws; } p0_prologue(al, lds); }
    SEAM(0);
#ifndef MK_NLAYER
#define MK_NLAYER 2
#endif
#ifndef MK_RSIDX
#define MK_RSIDX 4
#endif
#pragma unroll 1
    for (int layer = 0; layer < MK_NLAYER; ++layer) {
        const int p = 1 + NPL * layer;
        if (IN(p)) { PHASE_BEGIN();
            pg8::Gemm g{HB, (const bf16*)(wl + OW_IN), TPR, NPROJ, DM}; pg8::StaticOrder S; S.init(TPR, NPROJ, G, bid);
            EpiInProj E{rs_mix, (const float*)(ws + WS_ROPE), (bf16*)(ws + WS_Q), (bf16*)(ws + WS_K), (bf16*)(ws + WS_V), (bf16*)(ws + WS_SU), (bf16*)(ws + WS_PU)};
            pg8::gemm_phase<EpiInProj, pg8::StaticOrder, MK_ALIGN, MK_SP2>(lds, g, S, E);
        }
        SEAM(p);
        if (IN(p + 1)) { PHASE_BEGIN();
            for (int t = bid; t < 256; t += G)
                ssm_task(lds, t, layer, (const bf16*)(ws + WS_SU), (float*)(ws + WS_YF), (const float*)(ws + WS_ABAR), (const bf16*)(ws + WS_BMAT), (const bf16*)(ws + WS_CMAT));
            for (int t = bid; t < NB * 2 * 33; t += G)
                attn_task(lds, t, (const bf16*)(ws + WS_Q), (const bf16*)(ws + WS_K), (const bf16*)(ws + WS_V), (bf16*)ka->out, ka->in[4] + layer * 8);
            pool_diff(lds, (const bf16*)(ws + WS_PU), (bf16*)(ws + WS_PD));
            {
                int tl_ = threadIdx.x; asm volatile("" : "+v"(tl_)); const int wv = __builtin_amdgcn_readfirstlane(tl_ >> 6);
                convert_layer_weights(ka, lds, layer, bid * 8 + wv, G * 8, wv, tl_ & 63, 1);
                if (layer + 1 < MK_NLAYER) convert_layer_weights(ka, lds, layer + 1, bid * 8 + wv, G * 8, wv, tl_ & 63, 0);
                __syncthreads();
            }
        }
        SEAM(p + 1);
        if (IN(p + 2)) { PHASE_BEGIN();
            z_pass((const float*)(ws + WS_YF), (const bf16*)(ws + WS_SU), ka->in[12] + layer * 512, (bf16*)(ws + WS_Z));
        }
        SEAM(p + 2);
        if (IN(p + 3)) { PHASE_BEGIN();
            const int hg = G >> 1;
            if (bid < hg) { pg8::Gemm g{(const bf16*)(ws + WS_Z), (const bf16*)(wl + OW_GLU), MT, 512, 512}; pg8::StaticOrder S; S.init(MT, 512, hg, bid);
              EpiGlu E{(const bf16*)(ws + WS_Z), ka->in[14] + layer * 512, (bf16*)ka->out + (size_t)TPR * 512};
              pg8::gemm_phase<EpiGlu, pg8::StaticOrder, MK_ALIGN, MK_SP2>(lds, g, S, E); if (META) thin_gemm<EpiGlu>(lds, g.A, g.Bt, g.K, g.N, E, bid, hg); }
            else { pg8::Gemm g{(const bf16*)(ws + WS_PD), (const bf16*)(wl + OW_POOL), MT, 512, 512}; pg8::StaticOrder S; S.init(MT, 512, G - hg, bid - hg);
              EpiScale E{(bf16*)ka->out + (size_t)2 * TPR * 512, 512, ka->in[16] + layer * 512};
              pg8::gemm_phase<EpiScale, pg8::StaticOrder, MK_ALIGN, MK_SP2>(lds, g, S, E); if (META) thin_gemm<EpiScale>(lds, g.A, g.Bt, g.K, g.N, E, bid - hg, G - hg); }
        }
        SEAM(p + 3);
        if (IN(p + 4)) { PHASE_BEGIN();
            bf16* Y3 = (bf16*)ka->out;
            bf16* BR0 = (bf16*)(ws + WS_X), *BR1 = (bf16*)(ws + WS_X + 4 * UU), *BR2 = (bf16*)(ws + WS_X + 6 * UU);
            const bf16* Wbr = (const bf16*)(wl + OW_BR); const bf16* Wg = (const bf16*)(wl + OW_IN) + (size_t)NPROJ * DM; bf16* MG = (bf16*)(ws + WS_MG);
            { pg8::Gemm g{Y3, Wbr, 3 * TPR, 3072, 512}; TripleOrder S; S.init(G, bid, TPR / 256, 4);
              EpiBr3 E{BR0, TPR / 256};
              pg8::gemm_phase<EpiBr3, TripleOrder, MK_ALIGN, MK_SP2>(lds, g, S, E); }
            if (META) {
#pragma unroll 1
                for (int c = 0; c < 3; ++c) { EpiScale E{BR0 + (size_t)(2 * c + 2 * (c > 0)) * (UU / 2), 1024, nullptr};
                    thin_gemm<EpiScale>(lds, Y3 + (size_t)c * TPR * 512, Wbr + (size_t)c * 1024 * 512, 512, 1024, E, bid, G); }
            }
            { pg8::Gemm g{HB, Wg, MT, 3072, DM}; TripleOrder S; S.init(G, bid, 0, 4);
              EpiGate3 E{rs_mix, BR0, MG};
              pg8::gemm_phase<EpiGate3, TripleOrder, MK_ALIGN, MK_SP2>(lds, g, S, E); }
            if (META) {
                { EpiGate<true> E{rs_mix, BR0, MG}; thin_gemm<EpiGate<true>>(lds, HB, Wg, DM, 1024, E, bid, G); }
                { EpiGate<false> E{rs_mix, BR1, MG}; thin_gemm<EpiGate<false>>(lds, HB, Wg + (size_t)1024 * DM, DM, 1024, E, bid, G); }
                { EpiGate<false> E{rs_mix, BR2, MG}; thin_gemm<EpiGate<false>>(lds, HB, Wg + (size_t)2048 * DM, DM, 1024, E, bid, G); }
            }
        }
        SEAM(p + 4);
        if (IN(p + 5)) { PHASE_BEGIN();
            pg8::Gemm g{(const bf16*)(ws + WS_MG), (const bf16*)(wl + OW_OUT), MT, DM, DM}; pg8::StaticOrder S; S.init(MT, DM, G, bid);
            EpiRes E{(const float*)nullptr, HB, rs_mlp};
            pg8::gemm_phase<EpiRes, pg8::StaticOrder, MK_ALIGN, MK_SP2>(lds, g, S, E); if (META) thin_gemm<EpiRes>(lds, g.A, g.Bt, g.K, g.N, E, bid, G);
        }
        SEAM(p + 5);
        if (IN(p + 6)) { PHASE_BEGIN();
            pg8::Gemm g{HB, (const bf16*)(wl + OW_UP), MT, FF, DM}; pg8::StaticOrder S; S.init(MT, FF, G, bid);
            EpiUp E{rs_mlp, (bf16*)(ws + WS_ACT)};
            pg8::gemm_phase<EpiUp, pg8::StaticOrder, MK_ALIGN, MK_SP2>(lds, g, S, E); if (META) thin_gemm<EpiUp>(lds, g.A, g.Bt, g.K, g.N, E, bid, G);
        }
        SEAM(p + 6);
        if (IN(p + 7)) { PHASE_BEGIN();
            pg8::Gemm g{(const bf16*)(ws + WS_ACT), (const bf16*)(wl + OW_DN), MT, DM, FF}; pg8::StaticOrder S; S.init(MT, DM, G, bid);
            EpiRes E{(const float*)nullptr, HB, rs_next};
            pg8::gemm_phase<EpiRes, pg8::StaticOrder, MK_ALIGN, MK_SP2>(lds, g, S, E); if (META) thin_gemm<EpiRes>(lds, g.A, g.Bt, g.K, g.N, E, bid, G);
        }
        SEAM(p + 7);
    }
#ifdef MK_DUMP_OFF
    if (IN(PH_FINAL)) { KArgsP ka = KARGS();
        const bf16* src = (const bf16*)(ka->ws + (MK_DUMP_OFF)); const bf16* src2 = (const bf16*)(ka->ws + (MK_DUMP_OFF2));
        for (int i = bid * 512 + threadIdx.x; i < NREAL * 1024; i += G * 512) { const int R = MK_DUMP_ROW(i >> 10), c = i & 1023; ka->out[i] = c < 512 ? bf2f(src[(size_t)R * (MK_DUMP_LD) + (c % (MK_DUMP_LD))]) : bf2f(src2[(size_t)R * (MK_DUMP_LD2) + (c % (MK_DUMP_LD2))]); }
    }
#else
    if (IN(PH_FINAL)) { KArgsP ka = KARGS();
        const float* rs = (const float*)(ka->ws + WS_RS) + (size_t)MK_RSIDX * TPR * 16; const float* gain = ka->in[22];
        int tl_ = threadIdx.x; asm volatile("" : "+v"(tl_));
        for (int i = bid * 512 + tl_; i < NREAL * 256; i += G * 512) {
            const int R = i >> 8, c4 = (i & 255) * 4;
            const float r = row_rstd(rs, R);
            const u32x2 hb = *(const u32x2*)((const bf16*)(ka->ws + WS_HB) + (size_t)R * DM + c4); const f32x4 gn = *(const f32x4*)(gain + c4);
            f32x4 v = {bf2f(hb.x & 0xffffu), bf2f(hb.x >> 16), bf2f(hb.y & 0xffffu), bf2f(hb.y >> 16)};
            v = v * r * gn;
            *(f32x4*)(ka->out + (size_t)R * DM + c4) = v;
        }
    }
#endif
#undef IN
#undef SEAM
}

extern "C" void kernel_launch(void* const* d_in, const int* in_sizes, int n_in, void* d_out, int out_size, void* d_ws, size_t ws_size, hipStream_t stream) {
    static int grid = 0;
    if (grid == 0) {
        if (n_in != 23 || out_size != NREAL * DM || ws_size < WS_END) { fprintf(stderr, "kernel_launch: unexpected shapes (n_in %d out %d ws %zu)\n", n_in, out_size, ws_size); grid = -1; return; }
        int dev = 0, cus = 0, per_cu = 0;
        hipGetDevice(&dev); hipDeviceGetAttribute(&cus, hipDeviceAttributeMultiprocessorCount, dev);
        if (hipFuncSetAttribute((const void*)fwd_kernel, hipFuncAttributeMaxDynamicSharedMemorySize, LDS_BYTES) != hipSuccess) { fprintf(stderr, "kernel_launch: hipFuncSetAttribute failed\n"); grid = -1; return; }
        if (hipOccupancyMaxActiveBlocksPerMultiprocessor(&per_cu, (const void*)fwd_kernel, 512, LDS_BYTES) != hipSuccess || per_cu < 1) { fprintf(stderr, "kernel_launch: occupancy query gave %d\n", per_cu); per_cu = 1; }
        (void)hipGetLastError();
        grid = cus * (per_cu > 1 ? 1 : per_cu);
        if (grid <= 0) grid = 256;
    }
    if (grid < 0) return;
    Args a{};
    for (int i = 0; i < 23; ++i) a.in[i] = (const float*)d_in[i];
    a.out = (float*)d_out; a.ws = (unsigned char*)d_ws;
#if MK_SPLIT
    for (int ph = 0; ph < NPHASE; ++ph) hipLaunchKernelGGL(fwd_kernel, dim3(grid), dim3(512), LDS_BYTES, stream, a, ph, ph + 1);
#else
    int lo = 0, hi = NPHASE;
    void* kargs[] = {(void*)&a, (void*)&lo, (void*)&hi};
    hipError_t e = hipLaunchCooperativeKernel((const void*)fwd_kernel, dim3(grid), dim3(512), kargs, LDS_BYTES, stream);
    if (e != hipSuccess) fprintf(stderr, "kernel_launch: cooperative launch failed: %s (grid %d)\n", hipGetErrorString(e), grid);
#endif
}
```

```cpp
#include <hip/hip_runtime.h>
#include <hip/hip_cooperative_groups.h>
#include <cstdio>
#include <cstdint>
namespace cg = cooperative_groups;
namespace pg8 {
#define PG8_LAS __attribute__((address_space(3)))
typedef unsigned short bf16_t;
typedef short bf16x8 __attribute__((ext_vector_type(8)));
typedef float f32x4 __attribute__((ext_vector_type(4)));
typedef unsigned u32x4 __attribute__((ext_vector_type(4)));
constexpr int BM = 256, BK = 64, HALF = 128, HTB = HALF * BK * 2  , STAGE_BYTES = 8 * HTB, NXCD = 8, WGM = 8;

__host__ __device__ __forceinline__ int lds_byte(int r, int c) { const int st = (r >> 4) * 2 + (c >> 5), rr = r & 15, cc = c & 31, ob = rr * 64 + cc * 2; return st * 1024 + (ob ^ (((ob >> 9) & 1) << 5)); }
__host__ __device__ __forceinline__ void stage_rc(int b, int& R, int& C) { const int st = b / 1024, sb = b % 1024, swz = sb ^ (((sb >> 9) & 1) << 5); R = (st >> 1) * 16 + swz / 64; C = (st & 1) * 32 + (swz % 64) / 2; }
__host__ __device__ __forceinline__ int perm32(int rho) { const int n = rho >> 4, i = rho & 15; return 8 * (i >> 2) + 4 * n + (i & 3); }

struct Unit { int pm, pn; };
struct Gemm { const bf16_t* A; const bf16_t* Bt; int M, N, K; };

struct StaticOrder {
    int nM, nN, nwg, G, c;
    __host__ __device__ void init(int M, int N, int G_, int c_) { nM = M / BM; nN = N / BM; nwg = nM * nN; G = G_; c = c_; }
    __host__ __device__ __forceinline__ bool next(int i, Unit& u) const {
        const long L = (long)i * G + c; if (L >= nwg) return false;
        int wgid = (int)L; { const int q = nwg / NXCD, r = nwg % NXCD, xcd = wgid % NXCD, off = wgid / NXCD; wgid = (xcd < r ? xcd * (q + 1) : r * (q + 1) + (xcd - r) * q) + off; }
        const int nig = WGM * nN, gid = wgid / nig, fm = gid * WGM, gsz = (nM - fm) < WGM ? (nM - fm) : WGM;
        u.pm = fm + ((wgid % nig) % gsz); u.pn = (wgid % nig) / gsz; return true;
    }
    __device__ __forceinline__ void a_ready(const Unit&) const {}
    __device__ __forceinline__ void done(const Unit&) const {}
};

__device__ __forceinline__ unsigned cvt_pk_bf16(float lo, float hi) { unsigned r; asm volatile("v_cvt_pk_bf16_f32 %0, %1, %2" : "=v"(r) : "v"(lo), "v"(hi)); return r; }
template <class Epi, class Sched, bool ALIGN_EPI = false, bool SP2 = false>
__device__ __forceinline__ void gemm_phase(PG8_LAS unsigned char* lds, const Gemm g, const Sched& S, const Epi& E) {
    int tid_l = threadIdx.x; asm volatile("" : "+v"(tid_l));
    const int tid = tid_l, wid = __builtin_amdgcn_readfirstlane(tid >> 6), lane = tid & 63, wr = wid >> 2, wc = wid & 3, fr = lane & 15, fq = lane >> 4;
    const int K = g.K, nt = K / BK;
    unsigned voffA[2], voffB[2];
#pragma unroll
    for (int i = 0; i < 2; ++i) { int R, C; stage_rc(tid * 16 + i * 8192, R, C); const int Rb = Epi::PERM ? ((R & ~31) + perm32(R & 31)) : R;
        voffA[i] = (unsigned)(R * K + C) * 2u; voffB[i] = (unsigned)(Rb * K + C) * 2u; }
    const size_t kstep = (size_t)(BK * 2);
    const size_t hstep = (size_t)HALF * K * 2;
    const size_t tstep = 2 * hstep;
    const unsigned ldsw = (unsigned)wid * 1024u;
    const int aoff = lds_byte(wr * 64 + fr, fq * 8), boff = lds_byte(wc * 32 + fr, fq * 8);
#define PG8_SA(b, h) (((b) * 2 + (h)) * HTB)
#define PG8_SB(b, h) ((4 + (b) * 2 + (h)) * HTB)
#define PG8_STAGE(bufoff, gbase, voff) do { _Pragma("unroll") for (int _i = 0; _i < 2; ++_i) \
        __builtin_amdgcn_global_load_lds((const unsigned*)((const char*)(gbase) + (voff)[_i]), (PG8_LAS unsigned*)(lds + (bufoff) + ldsw + _i * 8192), 16, 0, 0); } while (0)
#define PG8_LDA(dst, b, h) do { _Pragma("unroll") for (int m = 0; m < 4; ++m) _Pragma("unroll") for (int k = 0; k < 2; ++k) dst[m][k] = *(const PG8_LAS bf16x8*)(lds + PG8_SA(b, h) + aoff + m * 2048 + k * 1024); } while (0)
#define PG8_LDB(dst, b, h) do { _Pragma("unroll") for (int n = 0; n < 2; ++n) _Pragma("unroll") for (int k = 0; k < 2; ++k) dst[n][k] = *(const PG8_LAS bf16x8*)(lds + PG8_SB(b, h) + boff + n * 2048 + k * 1024); } while (0)
#define PG8_MMA(ai, bj, At, Bt) do { __builtin_amdgcn_s_setprio(1); _Pragma("unroll") for (int m = 0; m < 4; ++m) _Pragma("unroll") for (int n = 0; n < 2; ++n) _Pragma("unroll") for (int k = 0; k < 2; ++k) \
        acc[ai][bj][m][n] = __builtin_amdgcn_mfma_f32_16x16x32_bf16(Bt[n][k], At[m][k], acc[ai][bj][m][n], 0, 0, 0); __builtin_amdgcn_s_setprio(0); } while (0)
#define PG8_WAIT_V(n) asm volatile("s_waitcnt vmcnt(" #n ")" ::: "memory")
#define PG8_WAIT_L(n) asm volatile("s_waitcnt lgkmcnt(" #n ")" ::: "memory")
#define PG8_BAR __builtin_amdgcn_s_barrier()
#define PG8_SCHED __builtin_amdgcn_sched_barrier(0)
    Unit cur, nxt; int ui = 0;
    if (!S.next(0, cur)) return;
    f32x4 acc[2][2][4][2];
#pragma unroll
    for (int a = 0; a < 2; ++a)
#pragma unroll
        for (int b = 0; b < 2; ++b)
#pragma unroll
            for (int m = 0; m < 4; ++m)
#pragma unroll
                for (int n = 0; n < 2; ++n) acc[a][b][m][n] = (f32x4){0.f, 0.f, 0.f, 0.f};
    bf16x8 At[4][2], B0[2][2], B1[2][2];
    const char* cA = (const char*)g.A + (size_t)cur.pm * tstep; const char* cB = (const char*)g.Bt + (size_t)cur.pn * tstep;
    S.a_ready(cur);
    if constexpr (SP2) {
        PG8_STAGE(PG8_SB(0, 0), cB, voffB); PG8_STAGE(PG8_SB(0, 1), cB + hstep, voffB); PG8_STAGE(PG8_SA(0, 0), cA, voffA); PG8_STAGE(PG8_SA(0, 1), cA + hstep, voffA);
        if (wr == 1) PG8_BAR;
        PG8_WAIT_V(2); PG8_BAR;
        PG8_STAGE(PG8_SB(1, 0), cB + kstep, voffB); PG8_STAGE(PG8_SA(1, 0), cA + kstep, voffA); PG8_STAGE(PG8_SB(1, 1), cB + hstep + kstep, voffB);
        PG8_WAIT_V(6); PG8_BAR;
    } else {
        PG8_STAGE(PG8_SB(0, 0), cB, voffB); PG8_STAGE(PG8_SA(0, 0), cA, voffA); PG8_STAGE(PG8_SB(0, 1), cB + hstep, voffB); PG8_STAGE(PG8_SA(0, 1), cA + hstep, voffA);
        if (wr == 1) PG8_BAR;
        PG8_WAIT_V(4); PG8_BAR;
        PG8_STAGE(PG8_SB(1, 0), cB + kstep, voffB); PG8_STAGE(PG8_SA(1, 0), cA + kstep, voffA); PG8_STAGE(PG8_SB(1, 1), cB + hstep + kstep, voffB);
        PG8_WAIT_V(6); PG8_BAR;
    }
    for (;;) {
        const bool has_next = S.next(ui + 1, nxt);
        const char* nA = has_next ? (const char*)g.A + (size_t)nxt.pm * tstep : cA; const char* nB = has_next ? (const char*)g.Bt + (size_t)nxt.pn * tstep : cB;
        for (int t = 0; t < nt; t += 2) {
            const bool last = (t == nt - 2);
            const char* a1 = cA + (size_t)(t + 1) * kstep;
            const char* a2 = last ? nA : cA + (size_t)(t + 2) * kstep; const char* b2 = last ? nB : cB + (size_t)(t + 2) * kstep;
            const char* a3 = a2 + kstep; const char* b3 = b2 + kstep;
            if (last && has_next) S.a_ready(nxt);
            if constexpr (SP2) {
            PG8_LDB(B0, 0, 0); PG8_LDB(B1, 0, 1); PG8_SCHED; PG8_LDA(At, 0, 0); PG8_STAGE(PG8_SA(1, 1), a1 + hstep, voffA);
            PG8_WAIT_V(8); PG8_WAIT_L(0); PG8_BAR; PG8_MMA(0, 0, At, B0); PG8_MMA(0, 1, At, B1); PG8_BAR; PG8_SCHED;
            PG8_LDA(At, 0, 1); PG8_STAGE(PG8_SB(0, 0), b2, voffB); PG8_STAGE(PG8_SB(0, 1), b2 + hstep, voffB); PG8_STAGE(PG8_SA(0, 0), a2, voffA);
            PG8_WAIT_V(8); PG8_WAIT_L(0); PG8_BAR; PG8_MMA(1, 0, At, B0); PG8_MMA(1, 1, At, B1); PG8_BAR; PG8_SCHED;
            PG8_LDB(B0, 1, 0); PG8_LDB(B1, 1, 1); PG8_SCHED; PG8_LDA(At, 1, 0); PG8_STAGE(PG8_SA(0, 1), a2 + hstep, voffA);
            PG8_WAIT_V(8); PG8_WAIT_L(0); PG8_BAR; PG8_MMA(0, 0, At, B0); PG8_MMA(0, 1, At, B1); PG8_BAR; PG8_SCHED;
            PG8_LDA(At, 1, 1); PG8_STAGE(PG8_SB(1, 0), b3, voffB); PG8_STAGE(PG8_SB(1, 1), b3 + hstep, voffB); PG8_STAGE(PG8_SA(1, 0), a3, voffA);
            PG8_WAIT_V(8); PG8_WAIT_L(0); PG8_BAR; PG8_MMA(1, 0, At, B0); PG8_MMA(1, 1, At, B1); PG8_BAR; PG8_SCHED;
            } else {
            PG8_LDB(B0, 0, 0); PG8_SCHED; PG8_LDA(At, 0, 0); PG8_STAGE(PG8_SA(1, 1), a1 + hstep, voffA);
            PG8_WAIT_L(8); PG8_BAR; PG8_WAIT_L(0); PG8_MMA(0, 0, At, B0); PG8_BAR; PG8_SCHED;
            PG8_LDB(B1, 0, 1); PG8_STAGE(PG8_SB(0, 0), b2, voffB);
            PG8_BAR; PG8_WAIT_L(0); PG8_MMA(0, 1, At, B1); PG8_BAR;
            PG8_LDA(At, 0, 1); PG8_STAGE(PG8_SA(0, 0), a2, voffA);
            PG8_BAR; PG8_WAIT_L(0); PG8_MMA(1, 0, At, B0); PG8_BAR; PG8_SCHED;
            PG8_STAGE(PG8_SB(0, 1), b2 + hstep, voffB);
            PG8_WAIT_V(6); PG8_BAR; PG8_MMA(1, 1, At, B1); PG8_BAR;
            PG8_LDB(B0, 1, 0); PG8_SCHED; PG8_LDA(At, 1, 0); PG8_STAGE(PG8_SA(0, 1), a2 + hstep, voffA);
            PG8_WAIT_L(8); PG8_BAR; PG8_WAIT_L(0); PG8_MMA(0, 0, At, B0); PG8_BAR; PG8_SCHED;
            PG8_LDB(B1, 1, 1); PG8_STAGE(PG8_SB(1, 0), b3, voffB);
            PG8_BAR; PG8_WAIT_L(0); PG8_MMA(0, 1, At, B1); PG8_BAR;
            PG8_LDA(At, 1, 1); PG8_STAGE(PG8_SA(1, 0), a3, voffA);
            PG8_BAR; PG8_WAIT_L(0); PG8_MMA(1, 0, At, B0); PG8_BAR; PG8_SCHED;
            PG8_STAGE(PG8_SB(1, 1), b3 + hstep, voffB);
            PG8_WAIT_V(6); PG8_BAR; PG8_MMA(1, 1, At, B1); PG8_BAR;
            }
        }
        if constexpr (ALIGN_EPI) { if (wr == 0) PG8_BAR; }
        asm volatile("s_nop 15\n\ts_nop 15" ::: "memory");
        if constexpr (!Epi::AFTER_DRAIN) { E(acc, cur, wr, wc, fr, fq); S.done(cur); }
        if (!has_next) break;
#pragma unroll
        for (int a = 0; a < 2; ++a)
#pragma unroll
            for (int b = 0; b < 2; ++b)
#pragma unroll
                for (int m = 0; m < 4; ++m)
#pragma unroll
                    for (int n = 0; n < 2; ++n) acc[a][b][m][n] = (f32x4){0.f, 0.f, 0.f, 0.f};
        cur = nxt; cA = nA; cB = nB; ++ui;
        if constexpr (ALIGN_EPI) { if (wr == 1) PG8_BAR; }
    }
    PG8_WAIT_V(0);
    if constexpr (!ALIGN_EPI) { if (wr == 0) PG8_BAR; }
    PG8_BAR;
    if constexpr (Epi::AFTER_DRAIN) { E.fused(acc, cur, wr, wc, fr, fq, lds, wid, lane); S.done(cur); }
#undef PG8_SA
#undef PG8_SB
#undef PG8_STAGE
#undef PG8_LDA
#undef PG8_LDB
#undef PG8_MMA
#undef PG8_WAIT_V
#undef PG8_WAIT_L
#undef PG8_BAR
#undef PG8_SCHED
}
}

#define LAS __attribute__((address_space(3)))
typedef unsigned short bf16;
typedef short bf16x8 __attribute__((ext_vector_type(8)));
typedef float f32x4 __attribute__((ext_vector_type(4)));
typedef float f32x16 __attribute__((ext_vector_type(16)));
typedef unsigned u32x2 __attribute__((ext_vector_type(2)));
typedef unsigned u32x4 __attribute__((ext_vector_type(4)));

constexpr int NB = 8, SEQ = 2048, NMETA = 16, LL = 2064, DM = 1024, FF = 4096, DIN = 4864, NPROJ = 1792;
constexpr int NREAL = NB * SEQ;
constexpr int TPR = NREAL + 256;
constexpr int LDS_BYTES = 147456;

constexpr size_t MiB = 1u << 20;
constexpr size_t WS_CTL = 0;
constexpr size_t WS_ROPE = 1 * MiB;
constexpr size_t WS_ABAR = 2 * MiB;
constexpr size_t WS_BMAT = 2 * MiB + 65536;
constexpr size_t WS_CMAT = WS_BMAT + 524288;
constexpr size_t WS_HM = 4 * MiB;
constexpr size_t WS_W = 5 * MiB;
constexpr size_t OW_IN = 0, OW_GLU = (size_t)DIN * DM * 2, OW_POOL = OW_GLU + 512 * 512 * 2, OW_BR = OW_POOL + 512 * 512 * 2,
                 OW_OUT = OW_BR + 3 * 1024 * 512 * 2, OW_UP = OW_OUT + 1024 * 1024 * 2, OW_DN = OW_UP + (size_t)FF * DM * 2, LW_BYTES = OW_DN + (size_t)FF * DM * 2;
constexpr size_t WS_HB = 68 * MiB;
constexpr size_t WS_X = 101 * MiB;
constexpr size_t UU = (size_t)TPR * 512 * 2;
constexpr size_t WS_YF = WS_X, WS_YP = WS_X, WS_Q = WS_X + 2 * UU, WS_K = WS_Q + UU, WS_V = WS_K + UU / 4, WS_MG = WS_X + 2 * UU,
                 WS_SU = WS_X + 4 * UU, WS_YA = WS_X + 8 * UU  , WS_PU = WS_X + 5 * UU, WS_YS = WS_PU, WS_Z = WS_X + 6 * UU, WS_PD = WS_X + 7 * UU, WS_BR = WS_Z, WS_ACT = WS_X;
constexpr size_t WS_RS = WS_X + 9 * UU;
constexpr size_t WS_END = WS_RS + (size_t)5 * TPR * 16 * 4;
static_assert(WS_W + 2 * LW_BYTES <= WS_HB && WS_HB + (size_t)TPR * 1024 * 2 <= WS_X && WS_END <= 256 * MiB, "ws map");
static_assert((size_t)256 * 2064 * 16 * 4 <= 2 * UU, "YF fits");

__device__ __forceinline__ unsigned pk2(float lo, float hi) { unsigned r; asm("v_cvt_pk_bf16_f32 %0, %1, %2" : "=v"(r) : "v"(lo), "v"(hi)); return r; }
__device__ __forceinline__ unsigned f2bf(float f) { return pk2(f, 0.f) & 0xffffu; }
__device__ __forceinline__ float bf2f(unsigned b) { return __uint_as_float(b << 16); }
__device__ __forceinline__ int tok_row(int b, int l) { return l >= NMETA ? b * SEQ + l - NMETA : NREAL + b * NMETA + l; }
#define LDS_FENCE() asm volatile("s_waitcnt lgkmcnt(0)" ::: "memory")
#define SSM_SYNC() do { asm volatile("s_waitcnt vmcnt(0) lgkmcnt(0)" ::: "memory"); __syncthreads(); } while (0)
__device__ __forceinline__ float row_rstd(const float* rs, int R) {
    const f32x4 a = *(const f32x4*)(rs + (size_t)R * 4), b = *(const f32x4*)(rs + ((size_t)TPR + R) * 4), c = *(const f32x4*)(rs + ((size_t)2 * TPR + R) * 4), d = *(const f32x4*)(rs + ((size_t)3 * TPR + R) * 4);
    const float s = (((a[0] + a[1]) + (a[2] + a[3])) + ((b[0] + b[1]) + (b[2] + b[3]))) + (((c[0] + c[1]) + (c[2] + c[3])) + ((d[0] + d[1]) + (d[2] + d[3])));
    return rsqrtf(s * (1.0f / 1024.0f) + 1e-6f);
}

__device__ __forceinline__ void dsincos(double a, double& s, double& c) {
    const double q = rint(a * 0.63661977236758134308);
    double r = fma(-q, 1.57079632679489655800e+00, a); r = fma(-q, 6.12323399573676603587e-17, r);
    const double r2 = r * r;
    double sp = -7.6471637318198164759e-13; sp = fma(sp, r2, 1.6059043836821614599e-10); sp = fma(sp, r2, -2.5052108385441718775e-08); sp = fma(sp, r2, 2.7557319223985890653e-06);
    sp = fma(sp, r2, -1.9841269841269841270e-04); sp = fma(sp, r2, 8.3333333333333333333e-03); sp = fma(sp, r2, -1.6666666666666666667e-01); sp = fma(sp * r2, r, r);
    double cp = 4.7794773323873852974e-14; cp = fma(cp, r2, -1.1470745597729724714e-11); cp = fma(cp, r2, 2.0876756987868098979e-09); cp = fma(cp, r2, -2.7557319223985890653e-07);
    cp = fma(cp, r2, 2.4801587301587301587e-05); cp = fma(cp, r2, -1.3888888888888888889e-03); cp = fma(cp, r2, 4.1666666666666666667e-02); cp = fma(cp, r2, -0.5); cp = fma(cp, r2, 1.0);
    const int qi = ((int)q) & 3;
    s = (qi == 0) ? sp : (qi == 1) ? cp : (qi == 2) ? -sp : -cp;
    c = (qi == 0) ? cp : (qi == 1) ? -sp : (qi == 2) ? -cp : sp;
}
__device__ __forceinline__ double dexp(double x) {
    const double k = rint(x * 1.44269504088896340736);
    double r = fma(-k, 6.93147180369123816490e-01, x); r = fma(-k, 1.90821492927058770002e-10, r);
    double p = 1.0 / 6227020800.0; p = fma(p, r, 1.0 / 479001600.0); p = fma(p, r, 1.0 / 39916800.0); p = fma(p, r, 1.0 / 3628800.0); p = fma(p, r, 1.0 / 362880.0); p = fma(p, r, 1.0 / 40320.0);
    p = fma(p, r, 1.0 / 5040.0); p = fma(p, r, 1.0 / 720.0); p = fma(p, r, 1.0 / 120.0); p = fma(p, r, 1.0 / 24.0); p = fma(p, r, 1.0 / 6.0); p = fma(p, r, 0.5); p = fma(p, r, 1.0); p = fma(p, r, 1.0);
    const long long bits = ((long long)(1023 + (int)k)) << 52;
    return p * __longlong_as_double(bits);
}

struct EpiInProj {
    static constexpr bool PERM = true, AFTER_DRAIN = false;
    const float* rowss; const float* rope; bf16 *Q, *K, *V, *SU, *PU;
    __device__ __forceinline__ u32x2 quad(int l, int c, const f32x4& v) const {
        u32x2 w;
        if (c < 640) {
            const int i0 = (c & 63) >> 1;
            const f32x4 cs = *(const f32x4*)(rope + ((size_t)l * 32 + i0) * 2);
            float o0 = v[0] * cs[0] - v[1] * cs[1], o1 = v[1] * cs[0] + v[0] * cs[1], o2 = v[2] * cs[2] - v[3] * cs[3], o3 = v[3] * cs[2] + v[2] * cs[3];
            if (c < 512) { o0 *= 0.125f; o1 *= 0.125f; o2 *= 0.125f; o3 *= 0.125f; }
            w.x = pk2(o0, o1); w.y = pk2(o2, o3);
        } else { w.x = pk2(v[0], v[1]); w.y = pk2(v[2], v[3]); }
        return w;
    }
    __device__ __forceinline__ void operator()(const f32x4 (&acc)[2][2][4][2], const pg8::Unit& u, int wr, int wc, int fr, int fq) const {
#pragma unroll
        for (int ai = 0; ai < 2; ++ai)
#pragma unroll
            for (int m = 0; m < 4; ++m) {
                const int R = u.pm * 256 + ai * 128 + wr * 64 + m * 16 + fr;
                const float rs = row_rstd(rowss, R);
                const int l = R < NREAL ? (R & 2047) + NMETA : (R & 15);
#pragma unroll
                for (int bj = 0; bj < 2; ++bj) {
                    const int c = u.pn * 256 + bj * 128 + wc * 32 + 8 * fq;
                    const u32x2 w0 = quad(l, c, acc[ai][bj][m][0] * rs), w1 = quad(l, c + 4, acc[ai][bj][m][1] * rs);
                    u32x4 w; w.x = w0.x; w.y = w0.y; w.z = w1.x; w.w = w1.y;
                    bf16* dst = c < 512 ? Q + (size_t)R * 512 + c : c < 640 ? K + (size_t)R * 128 + (c - 512) : c < 768 ? V + (size_t)R * 128 + (c - 640)
                              : c < 1280 ? SU + (size_t)R * 512 + (c - 768) : PU + (size_t)R * 512 + (c - 1280);
                    *(u32x4*)dst = w;
                }
            }
    }
};
#define EPI_BODY() \
    __device__ __forceinline__ void rg(int R, int pn, int wc, int fq, const f32x4 (&a4)[2][2]) const { \
        _Pragma("unroll") for (int bj = 0; bj < 2; ++bj) q2(R, pn * 256 + bj * 128 + wc * 32 + 8 * fq, a4[bj][0], a4[bj][1]); } \
    __device__ __forceinline__ void tq(int R, int c, const f32x4& v) const { q(R, c, v); } \
    EPI_OP()
#define EPI_OP() \
    __device__ __forceinline__ void operator()(const f32x4 (&acc)[2][2][4][2], const pg8::Unit& u, int wr, int wc, int fr, int fq) const { \
        _Pragma("unroll") for (int ai = 0; ai < 2; ++ai) _Pragma("unroll") for (int m = 0; m < 4; ++m) { \
            const f32x4 a4[2][2] = {{acc[ai][0][m][0], acc[ai][0][m][1]}, {acc[ai][1][m][0], acc[ai][1][m][1]}}; \
            rg(u.pm * 256 + ai * 128 + wr * 64 + m * 16 + fr, u.pn, wc, fq, a4); } }
#define EPI_BODY_RS() \
    __device__ __forceinline__ void rg(int R, int pn, int wc, int fq, const f32x4 (&a4)[2][2]) const { const float rs = row_rstd(rowss, R); \
        _Pragma("unroll") for (int bj = 0; bj < 2; ++bj) q2(R, pn * 256 + bj * 128 + wc * 32 + 8 * fq, a4[bj][0], a4[bj][1], rs); } \
    __device__ __forceinline__ void tq(int R, int c, const f32x4& v) const { q(R, c, v, row_rstd(rowss, R)); } \
    EPI_OP()
struct EpiGlu {
    static constexpr bool PERM = true, AFTER_DRAIN = false;
    const bf16* Z; const float* bias; bf16* YS;
    __device__ __forceinline__ void q(int R, int c, const f32x4& a) const {
        const f32x4 v = a + *(const f32x4*)(bias + c);
        const u32x2 zz = *(const u32x2*)(Z + (size_t)R * 512 + c);
        const float z0 = bf2f(zz.x & 0xffffu), z1 = bf2f(zz.x >> 16), z2 = bf2f(zz.y & 0xffffu), z3 = bf2f(zz.y >> 16);
        u32x2 w; w.x = pk2(z0 * __builtin_amdgcn_rcpf(1.0f + __expf(-v[0])), z1 * __builtin_amdgcn_rcpf(1.0f + __expf(-v[1]))); w.y = pk2(z2 * __builtin_amdgcn_rcpf(1.0f + __expf(-v[2])), z3 * __builtin_amdgcn_rcpf(1.0f + __expf(-v[3])));
        *(u32x2*)(YS + (size_t)R * 512 + c) = w;
    }
    __device__ __forceinline__ void q2(int R, int c, const f32x4& a0, const f32x4& a1) const {
        const f32x4 v0 = a0 + *(const f32x4*)(bias + c), v1 = a1 + *(const f32x4*)(bias + c + 4);
        const u32x4 zz = *(const u32x4*)(Z + (size_t)R * 512 + c);
        u32x4 w;
        w.x = pk2(bf2f(zz.x & 0xffffu) * __builtin_amdgcn_rcpf(1.0f + __expf(-v0[0])), bf2f(zz.x >> 16) * __builtin_amdgcn_rcpf(1.0f + __expf(-v0[1])));
        w.y = pk2(bf2f(zz.y & 0xffffu) * __builtin_amdgcn_rcpf(1.0f + __expf(-v0[2])), bf2f(zz.y >> 16) * __builtin_amdgcn_rcpf(1.0f + __expf(-v0[3])));
        w.z = pk2(bf2f(zz.z & 0xffffu) * __builtin_amdgcn_rcpf(1.0f + __expf(-v1[0])), bf2f(zz.z >> 16) * __builtin_amdgcn_rcpf(1.0f + __expf(-v1[1])));
        w.w = pk2(bf2f(zz.w & 0xffffu) * __builtin_amdgcn_rcpf(1.0f + __expf(-v1[2])), bf2f(zz.w >> 16) * __builtin_amdgcn_rcpf(1.0f + __expf(-v1[3])));
        *(u32x4*)(YS + (size_t)R * 512 + c) = w;
    }
    EPI_BODY()
};
struct EpiScale {
    static constexpr bool PERM = true, AFTER_DRAIN = false;
    bf16* O; int ldc; const float* scale;
    __device__ __forceinline__ void q(int R, int c, const f32x4& a) const {
        f32x4 v = a;
        if (scale) v = v * *(const f32x4*)(scale + c);
        u32x2 w; w.x = pk2(v[0], v[1]); w.y = pk2(v[2], v[3]);
        *(u32x2*)(O + (size_t)R * ldc + c) = w;
    }
    __device__ __forceinline__ void q2(int R, int c, const f32x4& a0, const f32x4& a1) const {
        f32x4 v0 = a0, v1 = a1;
        if (scale) { v0 = v0 * *(const f32x4*)(scale + c); v1 = v1 * *(const f32x4*)(scale + c + 4); }
        u32x4 w; w.x = pk2(v0[0], v0[1]); w.y = pk2(v0[2], v0[3]); w.z = pk2(v1[0], v1[1]); w.w = pk2(v1[2], v1[3]);
        *(u32x4*)(O + (size_t)R * ldc + c) = w;
    }
    EPI_BODY()
};
template <bool FIRST> struct EpiGate {
    static constexpr bool PERM = true, AFTER_DRAIN = false;
    const float* rowss; const bf16* BR; bf16* MG;
    __device__ __forceinline__ void q(int R, int c, const f32x4& a, float rs) const {
        const f32x4 v = a * rs;
        const u32x2 bb = *(const u32x2*)(BR + (size_t)R * 1024 + c);
        float o0 = bf2f(bb.x & 0xffffu) * __builtin_amdgcn_rcpf(1.0f + __expf(-v[0])), o1 = bf2f(bb.x >> 16) * __builtin_amdgcn_rcpf(1.0f + __expf(-v[1]));
        float o2 = bf2f(bb.y & 0xffffu) * __builtin_amdgcn_rcpf(1.0f + __expf(-v[2])), o3 = bf2f(bb.y >> 16) * __builtin_amdgcn_rcpf(1.0f + __expf(-v[3]));
        if (!FIRST) { const u32x2 mm = *(const u32x2*)(MG + (size_t)R * 1024 + c);
            o0 += bf2f(mm.x & 0xffffu); o1 += bf2f(mm.x >> 16); o2 += bf2f(mm.y & 0xffffu); o3 += bf2f(mm.y >> 16); }
        u32x2 w; w.x = pk2(o0, o1); w.y = pk2(o2, o3);
        *(u32x2*)(MG + (size_t)R * 1024 + c) = w;
    }
    __device__ __forceinline__ void q2(int R, int c, const f32x4& a0, const f32x4& a1, float rs) const {
        const f32x4 v0 = a0 * rs, v1 = a1 * rs;
        const u32x4 bb = *(const u32x4*)(BR + (size_t)R * 1024 + c);
        float o[8];
        o[0] = bf2f(bb.x & 0xffffu) * __builtin_amdgcn_rcpf(1.0f + __expf(-v0[0])); o[1] = bf2f(bb.x >> 16) * __builtin_amdgcn_rcpf(1.0f + __expf(-v0[1]));
        o[2] = bf2f(bb.y & 0xffffu) * __builtin_amdgcn_rcpf(1.0f + __expf(-v0[2])); o[3] = bf2f(bb.y >> 16) * __builtin_amdgcn_rcpf(1.0f + __expf(-v0[3]));
        o[4] = bf2f(bb.z & 0xffffu) * __builtin_amdgcn_rcpf(1.0f + __expf(-v1[0])); o[5] = bf2f(bb.z >> 16) * __builtin_amdgcn_rcpf(1.0f + __expf(-v1[1]));
        o[6] = bf2f(bb.w & 0xffffu) * __builtin_amdgcn_rcpf(1.0f + __expf(-v1[2])); o[7] = bf2f(bb.w >> 16) * __builtin_amdgcn_rcpf(1.0f + __expf(-v1[3]));
        if (!FIRST) { const u32x4 mm = *(const u32x4*)(MG + (size_t)R * 1024 + c);
            o[0] += bf2f(mm.x & 0xffffu); o[1] += bf2f(mm.x >> 16); o[2] += bf2f(mm.y & 0xffffu); o[3] += bf2f(mm.y >> 16);
            o[4] += bf2f(mm.z & 0xffffu); o[5] += bf2f(mm.z >> 16); o[6] += bf2f(mm.w & 0xffffu); o[7] += bf2f(mm.w >> 16); }
        u32x4 w; w.x = pk2(o[0], o[1]); w.y = pk2(o[2], o[3]); w.z = pk2(o[4], o[5]); w.w = pk2(o[6], o[7]);
        *(u32x4*)(MG + (size_t)R * 1024 + c) = w;
    }
    EPI_BODY_RS()
};
struct EpiRes {
    static constexpr bool PERM = true, AFTER_DRAIN = false;
    const float* Xin; bf16* HB; float* rowss_out;
    __device__ __forceinline__ float q(int R, int c, const f32x4& a) const {
        f32x4 h;
        if (Xin && R < NREAL) h = *(const f32x4*)(Xin + (size_t)R * 1024 + c);
        else { const u32x2 hb = *(const u32x2*)(HB + (size_t)R * 1024 + c); h = (f32x4){bf2f(hb.x & 0xffffu), bf2f(hb.x >> 16), bf2f(hb.y & 0xffffu), bf2f(hb.y >> 16)}; }
        h = h + a;
        u32x2 w; w.x = pk2(h[0], h[1]); w.y = pk2(h[2], h[3]);
        *(u32x2*)(HB + (size_t)R * 1024 + c) = w;
        const float r0 = bf2f(w.x & 0xffffu), r1 = bf2f(w.x >> 16), r2 = bf2f(w.y & 0xffffu), r3 = bf2f(w.y >> 16);
        return (r0 * r0 + r1 * r1) + (r2 * r2 + r3 * r3);
    }
    __device__ __forceinline__ float q2(int R, int c, const f32x4& a0, const f32x4& a1) const {
        f32x4 h0, h1;
        if (Xin && R < NREAL) { h0 = *(const f32x4*)(Xin + (size_t)R * 1024 + c); h1 = *(const f32x4*)(Xin + (size_t)R * 1024 + c + 4); }
        else { const u32x4 hb = *(const u32x4*)(HB + (size_t)R * 1024 + c);
            h0 = (f32x4){bf2f(hb.x & 0xffffu), bf2f(hb.x >> 16), bf2f(hb.y & 0xffffu), bf2f(hb.y >> 16)}; h1 = (f32x4){bf2f(hb.z & 0xffffu), bf2f(hb.z >> 16), bf2f(hb.w & 0xffffu), bf2f(hb.w >> 16)}; }
        h0 = h0 + a0; h1 = h1 + a1;
        u32x4 w; w.x = pk2(h0[0], h0[1]); w.y = pk2(h0[2], h0[3]); w.z = pk2(h1[0], h1[1]); w.w = pk2(h1[2], h1[3]);
        *(u32x4*)(HB + (size_t)R * 1024 + c) = w;
        const float r0 = bf2f(w.x & 0xffffu), r1 = bf2f(w.x >> 16), r2 = bf2f(w.y & 0xffffu), r3 = bf2f(w.y >> 16), r4 = bf2f(w.z & 0xffffu), r5 = bf2f(w.z >> 16), r6 = bf2f(w.w & 0xffffu), r7 = bf2f(w.w >> 16);
        return ((r0 * r0 + r1 * r1) + (r2 * r2 + r3 * r3)) + ((r4 * r4 + r5 * r5) + (r6 * r6 + r7 * r7));
    }
    __device__ __forceinline__ void rg(int R, int pn, int wc, int fq, const f32x4 (&a4)[2][2]) const {
        float ss = 0.f;
#pragma unroll
        for (int bj = 0; bj < 2; ++bj) ss += q2(R, pn * 256 + bj * 128 + wc * 32 + 8 * fq, a4[bj][0], a4[bj][1]);
        ss += __shfl_xor(ss, 16); ss += __shfl_xor(ss, 32);
        if (fq == 0) rowss_out[((size_t)pn * TPR + R) * 4 + wc] = ss;
    }
    __device__ __forceinline__ void tq(int R, int c, const f32x4& v) const {
        float ss = q(R, c, v);
        ss += __shfl_xor(ss, 16); ss += __shfl_xor(ss, 32);
        if ((threadIdx.x & 48) == 0) atomicAdd(rowss_out + (size_t)R * 4, ss);
    }
    EPI_OP()
};
struct EpiUp {
    static constexpr bool PERM = true, AFTER_DRAIN = false;
    const float* rowss; bf16* ACT;
    __device__ __forceinline__ void q(int R, int c, const f32x4& a, float rs) const {
        f32x4 v = a * rs;
#pragma unroll
        for (int j = 0; j < 4; ++j) { const float r = fmaxf(v[j], 0.f); v[j] = r * r; }
        u32x2 w; w.x = pk2(v[0], v[1]); w.y = pk2(v[2], v[3]);
        *(u32x2*)(ACT + (size_t)R * FF + c) = w;
    }
    __device__ __forceinline__ void q2(int R, int c, const f32x4& a0, const f32x4& a1, float rs) const {
        f32x4 v0 = a0 * rs, v1 = a1 * rs;
#pragma unroll
        for (int j = 0; j < 4; ++j) { const float r0 = fmaxf(v0[j], 0.f), r1 = fmaxf(v1[j], 0.f); v0[j] = r0 * r0; v1[j] = r1 * r1; }
        u32x4 w; w.x = pk2(v0[0], v0[1]); w.y = pk2(v0[2], v0[3]); w.z = pk2(v1[0], v1[1]); w.w = pk2(v1[2], v1[3]);
        *(u32x4*)(ACT + (size_t)R * FF + c) = w;
    }
    EPI_BODY_RS()
};
struct TripleOrder {
    pg8::StaticOrder S0; int arow, bcol;
    __device__ __forceinline__ void init(int G, int c, int arow_, int bcol_) { S0.init(NREAL, 1024, G, c); arow = arow_; bcol = bcol_; }
    __device__ __forceinline__ bool next(int i, pg8::Unit& u) const { pg8::Unit t; t.pm = 0; t.pn = 0; if (!S0.next(i / 3, t)) return false; const int br = i % 3; u.pm = t.pm + br * arow; u.pn = t.pn + br * bcol; return true; }
    __device__ __forceinline__ void a_ready(const pg8::Unit&) const {}
    __device__ __forceinline__ void done(const pg8::Unit&) const {}
};
struct EpiBr3 {
    static constexpr bool PERM = true, AFTER_DRAIN = false;
    bf16* Bbase; int arow;
    __device__ __forceinline__ void operator()(const f32x4 (&acc)[2][2][4][2], const pg8::Unit& u, int wr, int wc, int fr, int fq) const {
        const int c = u.pn >> 2, pn = u.pn & 3, pm = u.pm - arow * c; bf16* O = Bbase + (size_t)(2 * c + 2 * (c > 0)) * (UU / 2);
#pragma unroll
        for (int ai = 0; ai < 2; ++ai)
#pragma unroll
            for (int m = 0; m < 4; ++m) { const int R = pm * 256 + ai * 128 + wr * 64 + m * 16 + fr;
#pragma unroll
                for (int bj = 0; bj < 2; ++bj) { const f32x4 v0 = acc[ai][bj][m][0], v1 = acc[ai][bj][m][1];
                    u32x4 w; w.x = pk2(v0[0], v0[1]); w.y = pk2(v0[2], v0[3]); w.z = pk2(v1[0], v1[1]); w.w = pk2(v1[2], v1[3]);
                    *(u32x4*)(O + (size_t)R * 1024 + pn * 256 + bj * 128 + wc * 32 + 8 * fq) = w; } }
    }
};
struct EpiGate3 {
    static constexpr bool PERM = true, AFTER_DRAIN = false;
    const float* rowss; const bf16* Bbase; bf16* MG;
    __device__ __forceinline__ void operator()(const f32x4 (&acc)[2][2][4][2], const pg8::Unit& u, int wr, int wc, int fr, int fq) const {
        const int c = u.pn >> 2, pn = u.pn & 3; const bf16* BR = Bbase + (size_t)(2 * c + 2 * (c > 0)) * (UU / 2);
#pragma unroll
        for (int ai = 0; ai < 2; ++ai)
#pragma unroll
            for (int m = 0; m < 4; ++m) { const int R = u.pm * 256 + ai * 128 + wr * 64 + m * 16 + fr; const float rs = row_rstd(rowss, R);
#pragma unroll
                for (int bj = 0; bj < 2; ++bj) { const int cc = pn * 256 + bj * 128 + wc * 32 + 8 * fq;
                    const f32x4 v0 = acc[ai][bj][m][0] * rs, v1 = acc[ai][bj][m][1] * rs;
                    const u32x4 bb = *(const u32x4*)(BR + (size_t)R * 1024 + cc);
                    float o[8];
                    o[0] = bf2f(bb.x & 0xffffu) * __builtin_amdgcn_rcpf(1.0f + __expf(-v0[0])); o[1] = bf2f(bb.x >> 16) * __builtin_amdgcn_rcpf(1.0f + __expf(-v0[1]));
                    o[2] = bf2f(bb.y & 0xffffu) * __builtin_amdgcn_rcpf(1.0f + __expf(-v0[2])); o[3] = bf2f(bb.y >> 16) * __builtin_amdgcn_rcpf(1.0f + __expf(-v0[3]));
                    o[4] = bf2f(bb.z & 0xffffu) * __builtin_amdgcn_rcpf(1.0f + __expf(-v1[0])); o[5] = bf2f(bb.z >> 16) * __builtin_amdgcn_rcpf(1.0f + __expf(-v1[1]));
                    o[6] = bf2f(bb.w & 0xffffu) * __builtin_amdgcn_rcpf(1.0f + __expf(-v1[2])); o[7] = bf2f(bb.w >> 16) * __builtin_amdgcn_rcpf(1.0f + __expf(-v1[3]));
                    if (c != 0) { const u32x4 mm = *(const u32x4*)(MG + (size_t)R * 1024 + cc);
                        o[0] += bf2f(mm.x & 0xffffu); o[1] += bf2f(mm.x >> 16); o[2] += bf2f(mm.y & 0xffffu); o[3] += bf2f(mm.y >> 16);
                        o[4] += bf2f(mm.z & 0xffffu); o[5] += bf2f(mm.z >> 16); o[6] += bf2f(mm.w & 0xffffu); o[7] += bf2f(mm.w >> 16); }
                    u32x4 w; w.x = pk2(o[0], o[1]); w.y = pk2(o[2], o[3]); w.z = pk2(o[4], o[5]); w.w = pk2(o[6], o[7]);
                    *(u32x4*)(MG + (size_t)R * 1024 + cc) = w; } }
    }
};
template <class Epi>
__device__ __forceinline__ void thin_gemm(LAS unsigned char* lds, const bf16* A, const bf16* Bt, int K, int N, const Epi& E, int vb, int vg) {
    int tid_l = threadIdx.x; asm volatile("" : "+v"(tid_l));
    const int lane = tid_l & 63, w = __builtin_amdgcn_readfirstlane(tid_l >> 6), fr = lane & 15, fq = lane >> 4;
    LAS f32x4* red = (LAS f32x4*)lds;
    const int kw = K >> 3;
    for (int pc = vb; pc < N / 16; pc += vg) {
        const bf16* ap = A + (size_t)(NREAL + fr) * K + w * kw + 8 * fq;
        const bf16* bp = Bt + (size_t)(16 * pc + fr) * K + w * kw + 8 * fq;
        f32x4 acc[8];
#pragma unroll
        for (int rb = 0; rb < 8; ++rb) acc[rb] = (f32x4){0.f, 0.f, 0.f, 0.f};
#pragma unroll 4
        for (int k0 = 0; k0 < kw; k0 += 32) {
            const bf16x8 bf = *(const bf16x8*)(bp + k0);
            bf16x8 af[8];
#pragma unroll
            for (int rb = 0; rb < 8; ++rb) af[rb] = *(const bf16x8*)(ap + (size_t)(16 * rb) * K + k0);
#pragma unroll
            for (int rb = 0; rb < 8; ++rb) acc[rb] = __builtin_amdgcn_mfma_f32_16x16x32_bf16(bf, af[rb], acc[rb], 0, 0, 0);
        }
        asm volatile("s_nop 15\n\ts_nop 15" : "+v"(acc[0]), "+v"(acc[1]), "+v"(acc[2]), "+v"(acc[3]), "+v"(acc[4]), "+v"(acc[5]), "+v"(acc[6]), "+v"(acc[7]));
#pragma unroll
        for (int rb = 0; rb < 8; ++rb) red[(w * 8 + rb) * 64 + lane] = acc[rb];
        LDS_FENCE(); __syncthreads();
        f32x4 v = red[(0 * 8 + w) * 64 + lane];
#pragma unroll
        for (int ww = 1; ww < 8; ++ww) v = v + red[(ww * 8 + w) * 64 + lane];
        LDS_FENCE(); __syncthreads();
        E.tq(NREAL + 16 * w + fr, 16 * pc + 4 * fq, v);
    }
}

struct Args { const float* in[23]; float* out; unsigned char* ws; };

__device__ __forceinline__ void p0_item(const float* W, int ldw, int K, const float* scale, bf16* WT, int permrows, LAS float* scr, int item, int nblk, int lane) {
    const int kb = item / nblk, nb = item % nblk, k0 = 64 * kb, n0 = 64 * nb;
#pragma unroll 4
    for (int i = 0; i < 16; ++i) {
        const int kk = 4 * i + (lane >> 4), c4 = (lane & 15) * 4;
        f32x4 w = *(const f32x4*)(W + (size_t)(k0 + kk) * ldw + n0 + c4);
        if (scale) w = w * scale[k0 + kk];
        scr[kk * 65 + c4] = w[0]; scr[kk * 65 + c4 + 1] = w[1]; scr[kk * 65 + c4 + 2] = w[2]; scr[kk * 65 + c4 + 3] = w[3];
    }
    LDS_FENCE();
    const int c = lane & 7;
#pragma unroll
    for (int j = 0; j < 8; ++j) {
        const int n = (lane >> 3) + 8 * j;
        const int sc = (n0 + n) < permrows ? ((n & 1) ? 32 + (n >> 1) : (n >> 1)) : n;
        const LAS float* s = scr + (8 * c) * 65 + sc;
        u32x4 o; o.x = pk2(s[0 * 65], s[1 * 65]); o.y = pk2(s[2 * 65], s[3 * 65]); o.z = pk2(s[4 * 65], s[5 * 65]); o.w = pk2(s[6 * 65], s[7 * 65]);
        *(u32x4*)(WT + (size_t)(n0 + n) * K + k0 + 8 * c) = o;
    }
    LDS_FENCE();
}

typedef const __attribute__((address_space(4))) Args* KArgsP;
__device__ __forceinline__ void convert_layer_weights(KArgsP ka, LAS unsigned char* lds, int layer, int vw, int nvw, int wave, int lane, int part  ) {
    unsigned char* ws = ka->ws;
    LAS float* scr = (LAS float*)(lds + wave * 17408);
    constexpr int I_IN = 16 * 76, I_GLU = 8 * 8, I_BR = 8 * 16, I_OUT = 16 * 16, I_UP = 16 * 64, I_DN = 64 * 16, I_L = I_IN + I_GLU + 3 * I_BR + I_OUT + I_UP + I_DN;
    unsigned char* wl = ws + WS_W + (size_t)layer * LW_BYTES;
    for (int it = (part == 0 ? 0 : I_IN) + vw; it < (part == 0 ? I_IN : I_L); it += nvw) {
        int r = it;
        if (r < I_IN) { p0_item(ka->in[3] + (size_t)layer * DM * DIN, DIN, DM, ka->in[2] + layer * DM, (bf16*)(wl + OW_IN), 640, scr, r, 76, lane); continue; } r -= I_IN;
        if (r < I_GLU) { p0_item(ka->in[13] + (size_t)layer * 512 * 512, 512, 512, nullptr, (bf16*)(wl + OW_GLU), 0, scr, r, 8, lane); continue; } r -= I_GLU;
        if (r < 3 * I_BR) { const int c = r / I_BR; p0_item(ka->in[17] + ((size_t)layer * 3 + c) * 512 * 1024, 1024, 512, nullptr, (bf16*)(wl + OW_BR) + (size_t)c * 1024 * 512, 0, scr, r % I_BR, 16, lane); continue; } r -= 3 * I_BR;
        if (r < I_OUT) { p0_item(ka->in[18] + (size_t)layer * DM * DM, DM, DM, nullptr, (bf16*)(wl + OW_OUT), 0, scr, r, 16, lane); continue; } r -= I_OUT;
        if (r < I_UP) { p0_item(ka->in[20] + (size_t)layer * DM * FF, FF, DM, ka->in[19] + layer * DM, (bf16*)(wl + OW_UP), 0, scr, r, 64, lane); continue; } r -= I_UP;
        p0_item(ka->in[21] + (size_t)layer * FF * DM, DM, FF, nullptr, (bf16*)(wl + OW_DN), 0, scr, r, 16, lane);
    }
    if (part == 1) for (int i = vw * 64 + lane; i < 512 * 64; i += nvw * 64) {
        const int n = i >> 6, k0 = (i & 63) * 8;
        u32x4 o = {0u, 0u, 0u, 0u};
        if ((n >> 7) == (k0 >> 7)) { const float* src = ka->in[15] + (((size_t)layer * 4 + (n >> 7)) * 128 + (k0 & 127)) * 128 + (n & 127);
            o.x = pk2(src[0], src[128]); o.y = pk2(src[256], src[384]); o.z = pk2(src[512], src[640]); o.w = pk2(src[768], src[896]); }
        *(u32x4*)((bf16*)(wl + OW_POOL) + (size_t)n * 512 + k0) = o;
    }
}

__device__ __forceinline__ void p0_prologue(const Args& a, LAS unsigned char* lds) {
    int tl_ = threadIdx.x; asm volatile("" : "+v"(tl_));
    const int tid = tl_, lane = tid & 63, wave = __builtin_amdgcn_readfirstlane(tid >> 6);
    const int gw = blockIdx.x * 8 + wave, NGW = gridDim.x * 8;
    const int gt = blockIdx.x * 512 + tid, NGT = gridDim.x * 512;
    unsigned char* ws = a.ws;
    for (int i = gt; i < 4 * 4 * 128 * 4; i += NGT) { const int idx = 1 + (i >> 11), pn = (i >> 9) & 3, r = (i >> 2) & 127, sl = i & 3;
        ((float*)(ws + WS_RS))[((size_t)idx * 4 * TPR + (size_t)pn * TPR + NREAL + r) * 4 + sl] = 0.f; }
    for (int i = gt; i < LL * 32; i += NGT) {
        const int l = i >> 5, f = i & 31;
        const float invf = (float)dexp(-(double)f * (9.21034037197618273607 / 32.0));
        const float ang = (float)l * invf;
        double s, c; dsincos((double)ang, s, c);
        float* rp = (float*)(ws + WS_ROPE) + (size_t)i * 2; rp[0] = (float)c; rp[1] = (float)s;
    }
    for (int j = gt; j < 2 * 2 * 32 * 64 * 16; j += NGT) {
        const int q = j & 15, i = j >> 4, n = i & 63, pidx = i >> 6;
        const double lr = (double)a.in[5][i], li = (double)a.in[6][i];
        const double dt = (double)(float)dexp((double)a.in[7][pidx]);
        const double mag = dexp(lr * dt); double sn, cn; dsincos(li * dt, sn, cn);
        const double are = mag * cn, aim = mag * sn, den = lr * lr + li * li, nre = are - 1.0;
        const double fre = (nre * lr + aim * li) / den, fim = (aim * lr - nre * li) / den;
        if (q == 0) { float* ab = (float*)(ws + WS_ABAR) + (size_t)i * 2; ab[0] = (float)are; ab[1] = (float)aim; }
        bf16* bm = (bf16*)(ws + WS_BMAT) + (size_t)pidx * 128 * 16;
        bf16* cm = (bf16*)(ws + WS_CMAT) + (size_t)pidx * 16 * 128;
        const double br = (double)a.in[8][(size_t)i * 16 + q], bi = (double)a.in[9][(size_t)i * 16 + q];
        bm[n * 16 + q] = (bf16)f2bf((float)(fre * br - fim * bi));
        bm[(64 + n) * 16 + q] = (bf16)f2bf((float)(fre * bi + fim * br));
        *(unsigned*)(cm + q * 128 + 2 * n) = pk2(a.in[10][((size_t)pidx * 16 + q) * 64 + n], -a.in[11][((size_t)pidx * 16 + q) * 64 + n]);
    }
    for (int R = gw; R < TPR; R += NGW) {
        const int mrow = R - NREAL;
        const float* src = R < NREAL ? a.in[0] + (size_t)R * DM : a.in[1] + (size_t)(mrow & 15) * DM;
        float* dst = R < NREAL ? a.out + (size_t)R * DM : (float*)(ws + WS_HM) + (size_t)mrow * DM;
        bf16* hb = (bf16*)(ws + WS_HB) + (size_t)R * DM;
        const bool pad = mrow >= NB * NMETA;
        float ss = 0.f;
#pragma unroll
        for (int j = 0; j < 4; ++j) {
            f32x4 v = *(const f32x4*)(src + 4 * lane + 256 * j);
            if (pad) v = (f32x4){0.f, 0.f, 0.f, 0.f};
            ss += (v[0] * v[0] + v[1] * v[1]) + (v[2] * v[2] + v[3] * v[3]);
            u32x2 w; w.x = pk2(v[0], v[1]); w.y = pk2(v[2], v[3]);
            *(u32x2*)(hb + 4 * lane + 256 * j) = w;
        }
#pragma unroll
        for (int o = 1; o < 64; o <<= 1) ss += __shfl_xor(ss, o);
        if (lane < 16) ((float*)(ws + WS_RS))[((size_t)(lane >> 2) * TPR + R) * 4 + (lane & 3)] = lane == 0 ? ss : 0.f;
    }
}

__device__ __forceinline__ void ssm_task(LAS unsigned char* lds, int task, int layer, const bf16* SU, float* YF,
                                         const float* abar_all, const bf16* bmat_all, const bf16* cmat_all) {
    int tid_l = threadIdx.x; asm volatile("" : "+v"(tid_l));
    const int tid = tid_l, lane = tid & 63, wave = __builtin_amdgcn_readfirstlane(tid >> 6);
    const int b = task >> 5, g = task & 31;
    __syncthreads();
    LAS float* BU = (LAS float*)(lds + wave * 12800);
    LAS unsigned short* X = (LAS unsigned short*)(lds + wave * 12800 + 8448);
    LAS float* SX = (LAS float*)(lds + 8 * 12800);
    const int blk0 = wave == 0 ? 0 : 16 * wave + 1, nblk = wave == 0 ? 17 : 16;
    bf16* yfb = (bf16*)YF + (size_t)task * LL * 16;
    const int fr = lane & 15, fq = lane >> 4;
    const bf16x8 zero8 = {0, 0, 0, 0, 0, 0, 0, 0};
    for (int dir = 0; dir < 2; ++dir) {
        const int pidx = (layer * 2 + dir) * 32 + g;
        const float are = abar_all[((size_t)pidx * 64 + lane) * 2], aim = abar_all[((size_t)pidx * 64 + lane) * 2 + 1];
        bf16x8 bfr[8], cfr[4];
        const bf16* bm = bmat_all + (size_t)pidx * 128 * 16;
#pragma unroll
        for (int nt = 0; nt < 8; ++nt) bfr[nt] = fq < 2 ? *(const bf16x8*)(bm + (nt * 16 + fr) * 16 + 8 * fq) : zero8;
        const bf16* cm = cmat_all + (size_t)pidx * 16 * 128;
#pragma unroll
        for (int ks = 0; ks < 4; ++ks) cfr[ks] = *(const bf16x8*)(cm + fr * 128 + ks * 32 + 8 * fq);
        float p16r = are, p16i = aim;
#pragma unroll
        for (int i = 0; i < 4; ++i) { const float tr = p16r * p16r - p16i * p16i, ti = 2.f * p16r * p16i; p16r = tr; p16i = ti; }
        float p256r = p16r, p256i = p16i;
#pragma unroll
        for (int i = 0; i < 4; ++i) { const float tr = p256r * p256r - p256i * p256i, ti = 2.f * p256r * p256i; p256r = tr; p256i = ti; }
        const float p272r = p256r * p16r - p256i * p16i, p272i = p256r * p16i + p256i * p16r;

        float xre = 0.f, xim = 0.f;
        for (int pass = 0; pass < 2; ++pass) {
            bf16x8 unext;
            { const int blkf = dir == 0 ? blk0 : blk0 + nblk - 1; const int Rf = blkf == 0 ? NREAL + b * NMETA : b * SEQ + blkf * 16 - NMETA;
              unext = fq < 2 ? *(const bf16x8*)(SU + (size_t)(Rf + fr) * 512 + g * 16 + 8 * fq) : zero8; }
            for (int ib = 0; ib < nblk; ++ib) {
                const int blk = dir == 0 ? blk0 + ib : blk0 + nblk - 1 - ib;
                const bf16x8 ufr = unext;
                if (ib + 1 < nblk) { const int blkn = dir == 0 ? blk + 1 : blk - 1; const int Rn = blkn == 0 ? NREAL + b * NMETA : b * SEQ + blkn * 16 - NMETA;
                    unext = fq < 2 ? *(const bf16x8*)(SU + (size_t)(Rn + fr) * 512 + g * 16 + 8 * fq) : zero8; }
                f32x4 dd[8];
#pragma unroll
                for (int nt = 0; nt < 8; ++nt) { dd[nt] = (f32x4){0.f, 0.f, 0.f, 0.f}; dd[nt] = __builtin_amdgcn_mfma_f32_16x16x32_bf16(ufr, bfr[nt], dd[nt], 0, 0, 0); }
                asm volatile("s_nop 15\n\ts_nop 15" : "+v"(dd[0]), "+v"(dd[1]), "+v"(dd[2]), "+v"(dd[3]), "+v"(dd[4]), "+v"(dd[5]), "+v"(dd[6]), "+v"(dd[7]));
#pragma unroll
                for (int nt = 0; nt < 8; ++nt)
#pragma unroll
                    for (int r = 0; r < 4; ++r) BU[(4 * fq + r) * 132 + nt * 16 + fr] = dd[nt][r];
                LDS_FENCE();
                float bur[16], bui[16];
#pragma unroll
                for (int i = 0; i < 16; ++i) { const int tt = dir == 0 ? i : 15 - i; bur[i] = BU[tt * 132 + lane]; bui[i] = BU[tt * 132 + 64 + lane]; }
                if (pass == 0) {
#pragma unroll
                    for (int i = 0; i < 16; ++i) {
                        const float bre = bur[i], bim = bui[i];
                        const float nr = are * xre - aim * xim + bre, ni = are * xim + aim * xre + bim; xre = nr; xim = ni;
                    }
                    LDS_FENCE();
                } else {
#pragma unroll
                    for (int i = 0; i < 16; ++i) {
                        const int tt = dir == 0 ? i : 15 - i;
                        const float bre = bur[i], bim = bui[i];
                        const float nr = are * xre - aim * xim + bre, ni = are * xim + aim * xre + bim; xre = nr; xim = ni;
                        *(LAS unsigned*)(X + tt * 136 + 2 * lane) = pk2(xre, xim);
                    }
                    LDS_FENCE();
                    f32x4 y = {0.f, 0.f, 0.f, 0.f};
#pragma unroll
                    for (int ks = 0; ks < 4; ++ks) {
                        const bf16x8 afr = *(const LAS bf16x8*)(X + fr * 136 + ks * 32 + 8 * fq);
                        y = __builtin_amdgcn_mfma_f32_16x16x32_bf16(afr, cfr[ks], y, 0, 0, 0);
                    }
                    asm volatile("s_nop 15\n\ts_nop 15" : "+v"(y));
                    LDS_FENCE();
                    {
                        bf16* yd = yfb + (size_t)dir * 256 * LL * 16;
#pragma unroll
                        for (int r = 0; r < 4; ++r) yd[(size_t)(blk * 16 + 4 * fq + r) * 16 + fr] = (bf16)f2bf(y[r]);
                    }
                }
            }
            if (pass == 0) {
                SX[(wave * 64 + lane) * 2] = xre; SX[(wave * 64 + lane) * 2 + 1] = xim;
                LDS_FENCE(); __syncthreads();
                float cre = 0.f, cim = 0.f;
                if (dir == 0) {
                    for (int w = 0; w < wave; ++w) { const float pr = w == 0 ? p272r : p256r, pi = w == 0 ? p272i : p256i;
                        const float sr = SX[(w * 64 + lane) * 2], si = SX[(w * 64 + lane) * 2 + 1];
                        const float nr = pr * cre - pi * cim + sr, ni = pr * cim + pi * cre + si; cre = nr; cim = ni; }
                } else {
                    for (int w = 7; w > wave; --w) {
                        const float sr = SX[(w * 64 + lane) * 2], si = SX[(w * 64 + lane) * 2 + 1];
                        const float nr = p256r * cre - p256i * cim + sr, ni = p256r * cim + p256i * cre + si; cre = nr; cim = ni; }
                }
                xre = cre; xim = cim;
            }
        }
        LDS_FENCE(); __syncthreads();
    }
}

constexpr int ATT_KROW = 72, ATT_VROW = 40, ATT_KT = 32 * ATT_KROW * 2  , ATT_VT = 64 * ATT_VROW * 2  , ATT_MAXT = 11, ATT_VOFF = ATT_MAXT * ATT_KT;
static_assert(ATT_VOFF + ATT_MAXT * ATT_VT <= 131072, "attention LDS");
__device__ __forceinline__ void attn_task(LAS unsigned char* lds, int task, const bf16* Q, const bf16* K, const bf16* V, bf16* YA, const float* sink) {
    int tid_l = threadIdx.x; asm volatile("" : "+v"(tid_l));
    const int tid = tid_l, lane = tid & 63, wave = __builtin_amdgcn_readfirstlane(tid >> 6);
    const int qb = task < 512 ? (task & 31) : 32, bh = task < 512 ? (task >> 5) : task - 512, h = bh & 1, b = bh >> 1;
    const int l0 = qb * 64;
    __syncthreads();
    int jlo = (l0 - 128) >> 5; if (jlo < 1) jlo = 1;
    int jhi = (l0 + 191) >> 5; if (jhi > 64) jhi = 64;
    const int ntiles = 1 + (jhi - jlo + 1);
    LAS unsigned short* Ks = (LAS unsigned short*)lds;
    LAS unsigned short* Vs = (LAS unsigned short*)(lds + ATT_VOFF);
    for (int idx = tid; idx < ntiles * 32 * 8; idx += 512) {
        const int ch = idx & 7, key = idx >> 3, slot = key >> 5, kk = key & 31;
        const int lk = (slot == 0 ? 0 : (jlo + slot - 1) * 32) + kk;
        u32x4 kv = {0u, 0u, 0u, 0u}, vv = {0u, 0u, 0u, 0u};
        if (lk < LL) { const size_t R = (size_t)tok_row(b, lk);
            kv = *(const u32x4*)(K + R * 128 + h * 64 + ch * 8); vv = *(const u32x4*)(V + R * 128 + h * 64 + ch * 8); }
        *(LAS u32x4*)(Ks + slot * (ATT_KT / 2) + kk * ATT_KROW + ch * 8) = kv;
        LAS unsigned short* vd = Vs + slot * (ATT_VT / 2) + (ch * 8) * ATT_VROW + kk;
        vd[0 * ATT_VROW] = (unsigned short)(vv.x & 0xffffu); vd[1 * ATT_VROW] = (unsigned short)(vv.x >> 16);
        vd[2 * ATT_VROW] = (unsigned short)(vv.y & 0xffffu); vd[3 * ATT_VROW] = (unsigned short)(vv.y >> 16);
        vd[4 * ATT_VROW] = (unsigned short)(vv.z & 0xffffu); vd[5 * ATT_VROW] = (unsigned short)(vv.z >> 16);
        vd[6 * ATT_VROW] = (unsigned short)(vv.w & 0xffffu); vd[7 * ATT_VROW] = (unsigned short)(vv.w >> 16);
    }
    LDS_FENCE(); __syncthreads();
    const int head = h * 4 + (wave >> 1), r32 = lane & 31, hi = lane >> 5;
    const int lq = l0 + 32 * (wave & 1) + r32;
    const bool qvalid = lq < LL;
    const size_t Rq = (size_t)tok_row(b, qvalid ? lq : LL - 1);
    bf16x8 qf[4];
#pragma unroll
    for (int ks = 0; ks < 4; ++ks) qf[ks] = *(const bf16x8*)(Q + Rq * 512 + head * 64 + ks * 16 + 8 * hi);
    float mrun = sink[head], lsum = hi == 0 ? 1.0f : 0.0f;
    f32x16 o0, o1;
#pragma unroll
    for (int i = 0; i < 16; ++i) { o0[i] = 0.f; o1[i] = 0.f; }
    const int lqw = l0 + 32 * (wave & 1);
    for (int slot = 0; slot < ntiles; ++slot) {
        const int kbase = slot == 0 ? 0 : (jlo + slot - 1) * 32;
        if (lqw >= LL || (slot != 0 && (kbase + 31 < lqw - 128 || kbase > lqw + 31 + 128))) continue;
        const LAS unsigned short* kt = Ks + slot * (ATT_KT / 2);
        f32x16 s;
#pragma unroll
        for (int i = 0; i < 16; ++i) s[i] = 0.f;
#pragma unroll
        for (int ks = 0; ks < 4; ++ks) {
            const bf16x8 kf = *(const LAS bf16x8*)(kt + r32 * ATT_KROW + ks * 16 + 8 * hi);
            s = __builtin_amdgcn_mfma_f32_32x32x16_bf16(kf, qf[ks], s, 0, 0, 0);
        }
        asm volatile("s_nop 15\n\ts_nop 15" : "+v"(s));
        float mt = -1e30f;
#pragma unroll
        for (int i = 0; i < 16; ++i) {
            const int lk = kbase + (i & 3) + 8 * (i >> 2) + 4 * hi;
            int d = lq - lk; d = d < 0 ? -d : d;
            const bool valid = (lk < NMETA) || (d <= 128 && lk < LL);
            s[i] = valid ? s[i] : -1e30f;
            mt = fmaxf(mt, s[i]);
        }
        mt = fmaxf(mt, __shfl_xor(mt, 32));
        const float mnew = fmaxf(mrun, mt);
        const float alpha = __expf(mrun - mnew);
        mrun = mnew;
        float ps = 0.f;
#pragma unroll
        for (int i = 0; i < 16; ++i) { s[i] = __expf(s[i] - mnew); ps += s[i]; }
        lsum = lsum * alpha + ps;
#pragma unroll
        for (int i = 0; i < 16; ++i) { o0[i] *= alpha; o1[i] *= alpha; }
        const LAS unsigned short* vt = Vs + slot * (ATT_VT / 2);
#pragma unroll
        for (int s2 = 0; s2 < 2; ++s2) {
            union { bf16x8 v; unsigned u[4]; } pf;
            pf.u[0] = pk2(s[8 * s2 + 0], s[8 * s2 + 1]); pf.u[1] = pk2(s[8 * s2 + 2], s[8 * s2 + 3]);
            pf.u[2] = pk2(s[8 * s2 + 4], s[8 * s2 + 5]); pf.u[3] = pk2(s[8 * s2 + 6], s[8 * s2 + 7]);
#pragma unroll
            for (int dt = 0; dt < 2; ++dt) {
                union { bf16x8 v; u32x2 u[2]; } vf;
                const LAS unsigned short* vp = vt + (dt * 32 + r32) * ATT_VROW + 16 * s2 + 4 * hi;
                vf.u[0] = *(const LAS u32x2*)(vp); vf.u[1] = *(const LAS u32x2*)(vp + 8);
                if (dt == 0) o0 = __builtin_amdgcn_mfma_f32_32x32x16_bf16(vf.v, pf.v, o0, 0, 0, 0);
                else o1 = __builtin_amdgcn_mfma_f32_32x32x16_bf16(vf.v, pf.v, o1, 0, 0, 0);
            }
        }
    }
    asm volatile("s_nop 15\n\ts_nop 15" : "+v"(o0), "+v"(o1));
    lsum += __shfl_xor(lsum, 32);
    const float inv = 1.0f / lsum;
    if (qvalid) {
#pragma unroll
        for (int g4 = 0; g4 < 4; ++g4) {
            u32x2 w0, w1;
            w0.x = pk2(o0[4 * g4] * inv, o0[4 * g4 + 1] * inv); w0.y = pk2(o0[4 * g4 + 2] * inv, o0[4 * g4 + 3] * inv);
            w1.x = pk2(o1[4 * g4] * inv, o1[4 * g4 + 1] * inv); w1.y = pk2(o1[4 * g4 + 2] * inv, o1[4 * g4 + 3] * inv);
            *(u32x2*)(YA + Rq * 512 + head * 64 + 8 * g4 + 4 * hi) = w0;
            *(u32x2*)(YA + Rq * 512 + head * 64 + 32 + 8 * g4 + 4 * hi) = w1;
        }
    }
    __syncthreads();
}

__device__ __forceinline__ void pool_diff(LAS unsigned char* lds, const bf16* PU, bf16* PD) {
    int tl_ = threadIdx.x; asm volatile("" : "+v"(tl_));
    constexpr int TOK = 65, HALO = 8, ROWS = TOK + 2 * HALO, NTOK = NB * LL;
    for (int blk = blockIdx.x; blk * TOK < NTOK; blk += gridDim.x) {
        const int f0 = blk * TOK;
        __syncthreads();
        for (int i = tl_; i < ROWS * 64; i += 512) {
            const int r = i >> 6, ch = i & 63, f = f0 - HALO + r;
            u32x4 v = {0u, 0u, 0u, 0u};
            if (f >= 0 && f < NTOK) { const int b = f / LL, l = f % LL; v = *(const u32x4*)(PU + (size_t)tok_row(b, l) * 512 + ch * 8); }
            *(LAS u32x4*)(lds + (size_t)i * 16) = v;
        }
        LDS_FENCE(); __syncthreads();
        for (int i = tl_; i < TOK * 64; i += 512) {
            const int t = i >> 6, ch = i & 63, f = f0 + t;
            if (f >= NTOK) continue;
            const int b = f / LL, l = f % LL, half = 1 << (ch >> 4);
            const int lo = l - half < 0 ? 0 : l - half, hh = l + half > LL ? LL : l + half;
            float s[8];
#pragma unroll
            for (int j = 0; j < 8; ++j) s[j] = 0.f;
            for (int lp = lo; lp < hh; ++lp) {
                const u32x4 v = *(const LAS u32x4*)(lds + (size_t)((t + HALO + lp - l) * 64 + ch) * 16);
                s[0] += bf2f(v.x & 0xffffu); s[1] += bf2f(v.x >> 16); s[2] += bf2f(v.y & 0xffffu); s[3] += bf2f(v.y >> 16);
                s[4] += bf2f(v.z & 0xffffu); s[5] += bf2f(v.z >> 16); s[6] += bf2f(v.w & 0xffffu); s[7] += bf2f(v.w >> 16);
            }
            const float ic = 1.0f / (float)(hh - lo);
            const u32x4 v = *(const LAS u32x4*)(lds + (size_t)((t + HALO) * 64 + ch) * 16);
            u32x4 o;
            o.x = pk2(s[0] * ic - bf2f(v.x & 0xffffu), s[1] * ic - bf2f(v.x >> 16)); o.y = pk2(s[2] * ic - bf2f(v.y & 0xffffu), s[3] * ic - bf2f(v.y >> 16));
            o.z = pk2(s[4] * ic - bf2f(v.z & 0xffffu), s[5] * ic - bf2f(v.z >> 16)); o.w = pk2(s[6] * ic - bf2f(v.w & 0xffffu), s[7] * ic - bf2f(v.w >> 16));
            *(u32x4*)(PD + (size_t)tok_row(b, l) * 512 + ch * 8) = o;
        }
    }
    __syncthreads();
}

__device__ __forceinline__ void z_pass(const float* YF, const bf16* SU, const float* dskip, bf16* Z) {
    int tl_ = threadIdx.x; asm volatile("" : "+v"(tl_)); const int gt = blockIdx.x * 512 + tl_, NGT = gridDim.x * 512;
    for (int i = gt; i < NB * LL * 64; i += NGT) {
        const int ch = i & 63, tk = i >> 6, b = tk / LL, l = tk % LL, g = ch >> 1;
        const size_t R = (size_t)tok_row(b, l);
        const bf16* yp = (const bf16*)YF + ((size_t)(b * 32 + g) * LL + l) * 16 + (ch & 1) * 8;
        const u32x4 ya = *(const u32x4*)yp, yb = *(const u32x4*)(yp + (size_t)256 * LL * 16);
        f32x4 y0, y1;
        y0[0] = bf2f(ya.x & 0xffffu) + bf2f(yb.x & 0xffffu); y0[1] = bf2f(ya.x >> 16) + bf2f(yb.x >> 16); y0[2] = bf2f(ya.y & 0xffffu) + bf2f(yb.y & 0xffffu); y0[3] = bf2f(ya.y >> 16) + bf2f(yb.y >> 16);
        y1[0] = bf2f(ya.z & 0xffffu) + bf2f(yb.z & 0xffffu); y1[1] = bf2f(ya.z >> 16) + bf2f(yb.z >> 16); y1[2] = bf2f(ya.w & 0xffffu) + bf2f(yb.w & 0xffffu); y1[3] = bf2f(ya.w >> 16) + bf2f(yb.w >> 16);
        const f32x4 d0 = *(const f32x4*)(dskip + ch * 8), d1 = *(const f32x4*)(dskip + ch * 8 + 4);
        const u32x4 uu = *(const u32x4*)(SU + R * 512 + ch * 8);
        float t[8];
        t[0] = y0[0] + d0[0] * bf2f(uu.x & 0xffffu); t[1] = y0[1] + d0[1] * bf2f(uu.x >> 16); t[2] = y0[2] + d0[2] * bf2f(uu.y & 0xffffu); t[3] = y0[3] + d0[3] * bf2f(uu.y >> 16);
        t[4] = y1[0] + d1[0] * bf2f(uu.z & 0xffffu); t[5] = y1[1] + d1[1] * bf2f(uu.z >> 16); t[6] = y1[2] + d1[2] * bf2f(uu.w & 0xffffu); t[7] = y1[3] + d1[3] * bf2f(uu.w >> 16);
#pragma unroll
        for (int j = 0; j < 8; ++j) {
            const float v = t[j], tt = __builtin_amdgcn_rcpf(fabsf(v) * 0.2316418882f + 1.0f);
            float q = tt * 0.5307027145f + (-0.7265760135f); q = q * tt + 0.7107068705f; q = q * tt + (-0.142248368f); q = q * tt + 0.127414796f; q = q * tt;
            const float m = v * (q * __builtin_amdgcn_exp2f(v * v * (-0.72134752044f)));
            t[j] = v < 0.f ? m : v - m;
        }
        u32x4 o; o.x = pk2(t[0], t[1]); o.y = pk2(t[2], t[3]); o.z = pk2(t[4], t[5]); o.w = pk2(t[6], t[7]);
        *(u32x4*)(Z + R * 512 + ch * 8) = o;
    }
}

#define XB_TMO      128
#define XB_XCNT(j)  (256  + 64 * (j))
#define XB_XSUB(j)  (1280 + 64 * (j))
#define XB_XGEN(j)  (2304 + 64 * (j))
#define XB_TOP      3328
#define XB_TOPGEN   3392
#define XCD_BAR_WORDS 3456
#define XB_SPIN_CAP (1u << 18)

__device__ __forceinline__ unsigned xb_ld(unsigned* p)              { return __hip_atomic_load(p, __ATOMIC_RELAXED, __HIP_MEMORY_SCOPE_AGENT); }
__device__ __forceinline__ unsigned xb_add(unsigned* p, unsigned v) { return __hip_atomic_fetch_add(p, v, __ATOMIC_RELAXED, __HIP_MEMORY_SCOPE_AGENT); }
__device__ __forceinline__ unsigned xb_xcc_id() { return (unsigned)__builtin_amdgcn_s_getreg((3 << 11) | 20) & 0xFu; }
#define XB_SPIN(cond, bar) do { unsigned _sp = 0; while (cond) { __builtin_amdgcn_s_sleep(1); \
    if ((++_sp & 255u) == 0u) { if (xb_ld(&(bar)[XB_TMO])) break; if (_sp > XB_SPIN_CAP) { atomicAdd(&(bar)[XB_TMO], 1u); break; } } } } while (0)

struct XcdBarrier {
    unsigned* bar; unsigned x;
    volatile LAS unsigned* st;
};

__device__ __forceinline__ XcdBarrier xcd_barrier_post(unsigned* bar, volatile LAS unsigned* st) {
    XcdBarrier b; b.bar = bar; b.x = xb_xcc_id(); b.st = st;
    if (threadIdx.x == 0) (void)xb_add(&bar[XB_XCNT(b.x)], 1u);
    return b;
}
__device__ __forceinline__ void xcd_barrier_complete(unsigned* bar, unsigned x, unsigned& nloc, unsigned& nx) {
    const unsigned G = gridDim.x * gridDim.y * gridDim.z;
    unsigned sum, cnt, mine, sp = 0u;
    for (;;) {
        sum = 0u; cnt = 0u; mine = 0u;
#pragma unroll
        for (unsigned j = 0; j < 16; ++j) { const unsigned c = xb_ld(&bar[XB_XCNT(j)]); sum += c; cnt += (c > 0u) ? 1u : 0u; mine = (j == x) ? c : mine; }
        if (sum == G) break;
        __builtin_amdgcn_s_sleep(1);
        if ((++sp & 255u) == 0u) { if (xb_ld(&bar[XB_TMO])) break; if (sp > XB_SPIN_CAP) { atomicAdd(&bar[XB_TMO], 1u); break; } }
    }
    nloc = mine > 0u ? mine : 1u; nx = cnt > 0u ? cnt : 1u;
}

__device__ __forceinline__ void xcd_barrier(const XcdBarrier& b) {
    asm volatile("s_waitcnt vmcnt(0)" ::: "memory");
    __syncthreads();
    if (threadIdx.x == 0) {
        unsigned* bar = b.bar;
        __builtin_amdgcn_s_waitcnt(0);
        unsigned nloc = b.st[0], nx = b.st[1];
        if (nloc == 0u) { xcd_barrier_complete(bar, b.x, nloc, nx); b.st[0] = nloc; b.st[1] = nx; }
        const unsigned old = xb_add(&bar[XB_XSUB(b.x)], 1u);
        const unsigned gen = old / nloc;
        if (old + 1u == (gen + 1u) * nloc) {
            __builtin_amdgcn_fence(__ATOMIC_RELEASE, "agent");
            asm volatile("s_waitcnt vmcnt(0)" ::: "memory");
            const unsigned og = xb_add(&bar[XB_TOP], 1u);
            const unsigned tg = og / nx;
            if (og + 1u == (tg + 1u) * nx) xb_add(&bar[XB_TOPGEN], 1u);
            else XB_SPIN(xb_ld(&bar[XB_TOPGEN]) == tg, bar);
            __builtin_amdgcn_fence(__ATOMIC_ACQUIRE, "agent");
            xb_add(&bar[XB_XGEN(b.x)], 1u);
            asm volatile("s_waitcnt vmcnt(0)" ::: "memory");
        } else {
            XB_SPIN(xb_ld(&bar[XB_XGEN(b.x)]) == gen, bar);
            __builtin_amdgcn_fence(__ATOMIC_ACQUIRE, "agent");
            asm volatile("s_waitcnt vmcnt(0)" ::: "memory");
        }
    }
    __syncthreads();
}

#ifndef MK_ALIGN
#define MK_ALIGN true
#endif
#ifndef MK_SP2
#define MK_SP2 true
#endif
#ifndef MK_SPLIT
#define MK_SPLIT 0
#endif
#ifndef MK_NLAYER
#define MK_NLAYER 2
#endif
constexpr int NPL = 8, NPHASE = 1 + 2 * NPL + 1, PH_FINAL = NPHASE - 1;

#define KARGS() ({ auto kp_ = __builtin_amdgcn_kernarg_segment_ptr(); asm volatile("" : "+s"(kp_)); (KArgsP)kp_; })
__global__ void __launch_bounds__(512, 2) fwd_kernel(Args a_unused, int ph_lo, int ph_hi) {
    (void)a_unused;
    extern __shared__ __attribute__((aligned(16))) unsigned char lds_raw[];
    LAS unsigned char* lds = (LAS unsigned char*)lds_raw;
    const int G = gridDim.x, bid = blockIdx.x;
#if MK_SPLIT
#define GRID_SYNC() do {} while (0)
    (void)lds;
#else
#define CG_SYNC() do { asm volatile("s_waitcnt vmcnt(0)" ::: "memory"); __syncthreads(); \
    if (threadIdx.x == 0) { __builtin_amdgcn_fence(__ATOMIC_RELEASE, "agent"); asm volatile("s_waitcnt vmcnt(0)" ::: "memory"); } \
    __syncthreads(); grid.sync(); \
    if (threadIdx.x == 0) { __builtin_amdgcn_fence(__ATOMIC_ACQUIRE, "agent"); asm volatile("s_waitcnt vmcnt(0)" ::: "memory"); } \
    __syncthreads(); } while (0)
    cg::grid_group grid = cg::this_grid();
    unsigned* barw = (unsigned*)(KARGS()->ws + WS_CTL);
    if (bid == 0) for (int i = threadIdx.x; i < XCD_BAR_WORDS; i += 512) __hip_atomic_store(barw + i, 0u, __ATOMIC_RELAXED, __HIP_MEMORY_SCOPE_AGENT);
    volatile LAS unsigned* xst = (volatile LAS unsigned*)(lds + LDS_BYTES - 64);
    if (threadIdx.x < 2) xst[threadIdx.x] = 0u;
    CG_SYNC();
    const XcdBarrier xbar = xcd_barrier_post(barw, xst);
#define GRID_SYNC() xcd_barrier(xbar)

#endif
#ifndef PHMASK
#define PHMASK 0xFFFFu
#endif
#define IN(k) (((PHMASK >> ((k) == 0 ? 0 : (k) == PH_FINAL ? 9 : 1 + ((k) - 1) % NPL)) & 1u) && ph_lo <= (k) && (k) < ph_hi)
#define SEAM(k) do { if (IN(k) && (k) + 1 < ph_hi) GRID_SYNC(); } while (0)
#define PHASE_BEGIN() KArgsP ka = KARGS(); unsigned char* ws = ka->ws; asm volatile("" : "+s"(ws)); float* rowss = (float*)(ws + WS_RS); float* Hm = (float*)(ws + WS_HM); bf16* HB = (bf16*)(ws + WS_HB); unsigned char* wl = ws + WS_W + (size_t)layer * LW_BYTES; \
    const int MT = NREAL; const bool META = layer != MK_NLAYER - 1;     \
    const float* rs_mix = rowss + (size_t)(2 * layer) * TPR * 16; float* rs_mlp = rowss + (size_t)(2 * layer + 1) * TPR * 16; float* rs_next = rowss + (size_t)(2 * layer + 2) * TPR * 16; (void)MT; (void)META; (void)Hm; (void)HB; (void)wl; (void)rs_mix; (void)rs_mlp; (void)rs_next;

    if (IN(0)) {
        { int tl_ = threadIdx.x; asm volatile("" : "+v"(tl_)); const int wv = __builtin_amdgcn_readfirstlane(tl_ >> 6);
          convert_layer_weights(KARGS(), lds, 0, bid * 8 + wv, G * 8, wv, tl_ & 63, 0); }
        Args al; { KArgsP kp = KARGS(); for (int i = 0; i < 23; ++i) al.in[i] = kp->in[i]; al.out = kp->out; al.ws = kp->ws; } p0_prologue(al, lds); }
    SEAM(0);
#ifndef MK_NLAYER
#define MK_NLAYER 2
#endif
#ifndef MK_RSIDX
#define MK_RSIDX 4
#endif
#pragma unroll 1
    for (int layer = 0; layer < MK_NLAYER; ++layer) {
        const int p = 1 + NPL * layer;
        if (IN(p)) { PHASE_BEGIN();
            pg8::Gemm g{HB, (const bf16*)(wl + OW_IN), TPR, NPROJ, DM}; pg8::StaticOrder S; S.init(TPR, NPROJ, G, bid);
            EpiInProj E{rs_mix, (const float*)(ws + WS_ROPE), (bf16*)(ws + WS_Q), (bf16*)(ws + WS_K), (bf16*)(ws + WS_V), (bf16*)(ws + WS_SU), (bf16*)(ws + WS_PU)};
            pg8::gemm_phase<EpiInProj, pg8::StaticOrder, MK_ALIGN, MK_SP2>(lds, g, S, E);
        }
        SEAM(p);
        if (IN(p + 1)) { PHASE_BEGIN();
            for (int t = bid; t < 256; t += G)
                ssm_task(lds, t, layer, (const bf16*)(ws + WS_SU), (float*)(ws + WS_YF), (const float*)(ws + WS_ABAR), (const bf16*)(ws + WS_BMAT), (const bf16*)(ws + WS_CMAT));
            for (int t = bid; t < NB * 2 * 33; t += G)
                attn_task(lds, t, (const bf16*)(ws + WS_Q), (const bf16*)(ws + WS_K), (const bf16*)(ws + WS_V), (bf16*)ka->out, ka->in[4] + layer * 8);
            pool_diff(lds, (const bf16*)(ws + WS_PU), (bf16*)(ws + WS_PD));
            {
                int tl_ = threadIdx.x; asm volatile("" : "+v"(tl_)); const int wv = __builtin_amdgcn_readfirstlane(tl_ >> 6);
                convert_layer_weights(ka, lds, layer, bid * 8 + wv, G * 8, wv, tl_ & 63, 1);
                if (layer + 1 < MK_NLAYER) convert_layer_weights(ka, lds, layer + 1, bid * 8 + wv, G * 8, wv, tl_ & 63, 0);
                __syncthreads();
            }
        }
        SEAM(p + 1);
        if (IN(p + 2)) { PHASE_BEGIN();
            z_pass((const float*)(ws + WS_YF), (const bf16*)(ws + WS_SU), ka->in[12] + layer * 512, (bf16*)(ws + WS_Z));
        }
        SEAM(p + 2);
        if (IN(p + 3)) { PHASE_BEGIN();
            const int hg = G >> 1;
            if (bid < hg) { pg8::Gemm g{(const bf16*)(ws + WS_Z), (const bf16*)(wl + OW_GLU), MT, 512, 512}; pg8::StaticOrder S; S.init(MT, 512, hg, bid);
              EpiGlu E{(const bf16*)(ws + WS_Z), ka->in[14] + layer * 512, (bf16*)ka->out + (size_t)TPR * 512};
              pg8::gemm_phase<EpiGlu, pg8::StaticOrder, MK_ALIGN, MK_SP2>(lds, g, S, E); if (META) thin_gemm<EpiGlu>(lds, g.A, g.Bt, g.K, g.N, E, bid, hg); }
            else { pg8::Gemm g{(const bf16*)(ws + WS_PD), (const bf16*)(wl + OW_POOL), MT, 512, 512}; pg8::StaticOrder S; S.init(MT, 512, G - hg, bid - hg);
              EpiScale E{(bf16*)ka->out + (size_t)2 * TPR * 512, 512, ka->in[16] + layer * 512};
              pg8::gemm_phase<EpiScale, pg8::StaticOrder, MK_ALIGN, MK_SP2>(lds, g, S, E); if (META) thin_gemm<EpiScale>(lds, g.A, g.Bt, g.K, g.N, E, bid - hg, G - hg); }
        }
        SEAM(p + 3);
        if (IN(p + 4)) { PHASE_BEGIN();
            bf16* Y3 = (bf16*)ka->out;
            bf16* BR0 = (bf16*)(ws + WS_X), *BR1 = (bf16*)(ws + WS_X + 4 * UU), *BR2 = (bf16*)(ws + WS_X + 6 * UU);
            const bf16* Wbr = (const bf16*)(wl + OW_BR); const bf16* Wg = (const bf16*)(wl + OW_IN) + (size_t)NPROJ * DM; bf16* MG = (bf16*)(ws + WS_MG);
            { pg8::Gemm g{Y3, Wbr, 3 * TPR, 3072, 512}; TripleOrder S; S.init(G, bid, TPR / 256, 4);
              EpiBr3 E{BR0, TPR / 256};
              pg8::gemm_phase<EpiBr3, TripleOrder, MK_ALIGN, MK_SP2>(lds, g, S, E); }
            if (META) {
#pragma unroll 1
                for (int c = 0; c < 3; ++c) { EpiScale E{BR0 + (size_t)(2 * c + 2 * (c > 0)) * (UU / 2), 1024, nullptr};
                    thin_gemm<EpiScale>(lds, Y3 + (size_t)c * TPR * 512, Wbr + (size_t)c * 1024 * 512, 512, 1024, E, bid, G); }
            }
            { pg8::Gemm g{HB, Wg, MT, 3072, DM}; TripleOrder S; S.init(G, bid, 0, 4);
              EpiGate3 E{rs_mix, BR0, MG};
              pg8::gemm_phase<EpiGate3, TripleOrder, MK_ALIGN, MK_SP2>(lds, g, S, E); }
            if (META) {
                { EpiGate<true> E{rs_mix, BR0, MG}; thin_gemm<EpiGate<true>>(lds, HB, Wg, DM, 1024, E, bid, G); }
                { EpiGate<false> E{rs_mix, BR1, MG}; thin_gemm<EpiGate<false>>(lds, HB, Wg + (size_t)1024 * DM, DM, 1024, E, bid, G); }
                { EpiGate<false> E{rs_mix, BR2, MG}; thin_gemm<EpiGate<false>>(lds, HB, Wg + (size_t)2048 * DM, DM, 1024, E, bid, G); }
            }
        }
        SEAM(p + 4);
        if (IN(p + 5)) { PHASE_BEGIN();
            pg8::Gemm g{(const bf16*)(ws + WS_MG), (const bf16*)(wl + OW_OUT), MT, DM, DM}; pg8::StaticOrder S; S.init(MT, DM, G, bid);
            EpiRes E{(const float*)nullptr, HB, rs_mlp};
            pg8::gemm_phase<EpiRes, pg8::StaticOrder, MK_ALIGN, MK_SP2>(lds, g, S, E); if (META) thin_gemm<EpiRes>(lds, g.A, g.Bt, g.K, g.N, E, bid, G);
        }
        SEAM(p + 5);
        if (IN(p + 6)) { PHASE_BEGIN();
            pg8::Gemm g{HB, (const bf16*)(wl + OW_UP), MT, FF, DM}; pg8::StaticOrder S; S.init(MT, FF, G, bid);
            EpiUp E{rs_mlp, (bf16*)(ws + WS_ACT)};
            pg8::gemm_phase<EpiUp, pg8::StaticOrder, MK_ALIGN, MK_SP2>(lds, g, S, E); if (META) thin_gemm<EpiUp>(lds, g.A, g.Bt, g.K, g.N, E, bid, G);
        }
        SEAM(p + 6);
        if (IN(p + 7)) { PHASE_BEGIN();
            pg8::Gemm g{(const bf16*)(ws + WS_ACT), (const bf16*)(wl + OW_DN), MT, DM, FF}; pg8::StaticOrder S; S.init(MT, DM, G, bid);
            EpiRes E{(const float*)nullptr, HB, rs_next};
            pg8::gemm_phase<EpiRes, pg8::StaticOrder, MK_ALIGN, MK_SP2>(lds, g, S, E); if (META) thin_gemm<EpiRes>(lds, g.A, g.Bt, g.K, g.N, E, bid, G);
        }
        SEAM(p + 7);
    }
#ifdef MK_DUMP_OFF
    if (IN(PH_FINAL)) { KArgsP ka = KARGS();
        const bf16* src = (const bf16*)(ka->ws + (MK_DUMP_OFF)); const bf16* src2 = (const bf16*)(ka->ws + (MK_DUMP_OFF2));
        for (int i = bid * 512 + threadIdx.x; i < NREAL * 1024; i += G * 512) { const int R = MK_DUMP_ROW(i >> 10), c = i & 1023; ka->out[i] = c < 512 ? bf2f(src[(size_t)R * (MK_DUMP_LD) + (c % (MK_DUMP_LD))]) : bf2f(src2[(size_t)R * (MK_DUMP_LD2) + (c % (MK_DUMP_LD2))]); }
    }
#else
    if (IN(PH_FINAL)) { KArgsP ka = KARGS();
        const float* rs = (const float*)(ka->ws + WS_RS) + (size_t)MK_RSIDX * TPR * 16; const float* gain = ka->in[22];
        int tl_ = threadIdx.x; asm volatile("" : "+v"(tl_));
        for (int i = bid * 512 + tl_; i < NREAL * 256; i += G * 512) {
            const int R = i >> 8, c4 = (i & 255) * 4;
            const float r = row_rstd(rs, R);
            const u32x2 hb = *(const u32x2*)((const bf16*)(ka->ws + WS_HB) + (size_t)R * DM + c4); const f32x4 gn = *(const f32x4*)(gain + c4);
            f32x4 v = {bf2f(hb.x & 0xffffu), bf2f(hb.x >> 16), bf2f(hb.y & 0xffffu), bf2f(hb.y >> 16)};
            v = v * r * gn;
            *(f32x4*)(ka->out + (size_t)R * DM + c4) = v;
        }
    }
#endif
#undef IN
#undef SEAM
}

extern "C" void kernel_launch(void* const* d_in, const int* in_sizes, int n_in, void* d_out, int out_size, void* d_ws, size_t ws_size, hipStream_t stream) {
    static int grid = 0;
    if (grid == 0) {
        if (n_in != 23 || out_size != NREAL * DM || ws_size < WS_END) { fprintf(stderr, "kernel_launch: unexpected shapes (n_in %d out %d ws %zu)\n", n_in, out_size, ws_size); grid = -1; return; }
        int dev = 0, cus = 0, per_cu = 0;
        hipGetDevice(&dev); hipDeviceGetAttribute(&cus, hipDeviceAttributeMultiprocessorCount, dev);
        if (hipFuncSetAttribute((const void*)fwd_kernel, hipFuncAttributeMaxDynamicSharedMemorySize, LDS_BYTES) != hipSuccess) { fprintf(stderr, "kernel_launch: hipFuncSetAttribute failed\n"); grid = -1; return; }
        if (hipOccupancyMaxActiveBlocksPerMultiprocessor(&per_cu, (const void*)fwd_kernel, 512, LDS_BYTES) != hipSuccess || per_cu < 1) { fprintf(stderr, "kernel_launch: occupancy query gave %d\n", per_cu); per_cu = 1; }
        (void)hipGetLastError();
        grid = cus * (per_cu > 1 ? 1 : per_cu);
        if (grid <= 0) grid = 256;
    }
    if (grid < 0) return;
    Args a{};
    for (int i = 0; i < 23; ++i) a.in[i] = (const float*)d_in[i];
    a.out = (float*)d_out; a.ws = (unsigned char*)d_ws;
#if MK_SPLIT
    for (int ph = 0; ph < NPHASE; ++ph) hipLaunchKernelGGL(fwd_kernel, dim3(grid), dim3(512), LDS_BYTES, stream, a, ph, ph + 1);
#else
    int lo = 0, hi = NPHASE;
    void* kargs[] = {(void*)&a, (void*)&lo, (void*)&hi};
    hipError_t e = hipLaunchCooperativeKernel((const void*)fwd_kernel, dim3(grid), dim3(512), kargs, LDS_BYTES, stream);
    if (e != hipSuccess) fprintf(stderr, "kernel_launch: cooperative launch failed: %s (grid %d)\n", hipGetErrorString(e), grid);
#endif
}
```

```cpp
#include <hip/hip_runtime.h>
#include <hip/hip_cooperative_groups.h>
#include <cstdio>
#include <cstdint>
namespace cg = cooperative_groups;
namespace pg8 {
#define PG8_LAS __attribute__((address_space(3)))
typedef unsigned short bf16_t;
typedef short bf16x8 __attribute__((ext_vector_type(8)));
typedef float f32x4 __attribute__((ext_vector_type(4)));
typedef unsigned u32x4 __attribute__((ext_vector_type(4)));
constexpr int BM = 256, BK = 64, HALF = 128, HTB = HALF * BK * 2  , STAGE_BYTES = 8 * HTB, NXCD = 8, WGM = 8;

__host__ __device__ __forceinline__ int lds_byte(int r, int c) { const int st = (r >> 4) * 2 + (c >> 5), rr = r & 15, cc = c & 31, ob = rr * 64 + cc * 2; return st * 1024 + (ob ^ (((ob >> 9) & 1) << 5)); }
__host__ __device__ __forceinline__ void stage_rc(int b, int& R, int& C) { const int st = b / 1024, sb = b % 1024, swz = sb ^ (((sb >> 9) & 1) << 5); R = (st >> 1) * 16 + swz / 64; C = (st & 1) * 32 + (swz % 64) / 2; }
__host__ __device__ __forceinline__ int perm32(int rho) { const int n = rho >> 4, i = rho & 15; return 8 * (i >> 2) + 4 * n + (i & 3); }

struct Unit { int pm, pn; };
struct Gemm { const bf16_t* A; const bf16_t* Bt; int M, N, K; };

struct StaticOrder {
    int nM, nN, nwg, G, c;
    __host__ __device__ void init(int M, int N, int G_, int c_) { nM = M / BM; nN = N / BM; nwg = nM * nN; G = G_; c = c_; }
    __host__ __device__ __forceinline__ bool next(int i, Unit& u) const {
        const long L = (long)i * G + c; if (L >= nwg) return false;
        int wgid = (int)L; { const int q = nwg / NXCD, r = nwg % NXCD, xcd = wgid % NXCD, off = wgid / NXCD; wgid = (xcd < r ? xcd * (q + 1) : r * (q + 1) + (xcd - r) * q) + off; }
        const int nig = WGM * nN, gid = wgid / nig, fm = gid * WGM, gsz = (nM - fm) < WGM ? (nM - fm) : WGM;
        u.pm = fm + ((wgid % nig) % gsz); u.pn = (wgid % nig) / gsz; return true;
    }
    __device__ __forceinline__ void a_ready(const Unit&) const {}
    __device__ __forceinline__ void done(const Unit&) const {}
};

__device__ __forceinline__ unsigned cvt_pk_bf16(float lo, float hi) { unsigned r; asm volatile("v_cvt_pk_bf16_f32 %0, %1, %2" : "=v"(r) : "v"(lo), "v"(hi)); return r; }
template <class Epi, class Sched, bool ALIGN_EPI = false, bool SP2 = false>
__device__ __forceinline__ void gemm_phase(PG8_LAS unsigned char* lds, const Gemm g, const Sched& S, const Epi& E) {
    int tid_l = threadIdx.x; asm volatile("" : "+v"(tid_l));
    const int tid = tid_l, wid = __builtin_amdgcn_readfirstlane(tid >> 6), lane = tid & 63, wr = wid >> 2, wc = wid & 3, fr = lane & 15, fq = lane >> 4;
    const int K = g.K, nt = K / BK;
    unsigned voffA[2], voffB[2];
#pragma unroll
    for (int i = 0; i < 2; ++i) { int R, C; stage_rc(tid * 16 + i * 8192, R, C); const int Rb = Epi::PERM ? ((R & ~31) + perm32(R & 31)) : R;
        voffA[i] = (unsigned)(R * K + C) * 2u; voffB[i] = (unsigned)(Rb * K + C) * 2u; }
    const size_t kstep = (size_t)(BK * 2);
    const size_t hstep = (size_t)HALF * K * 2;
    const size_t tstep = 2 * hstep;
    const unsigned ldsw = (unsigned)wid * 1024u;
    const int aoff = lds_byte(wr * 64 + fr, fq * 8), boff = lds_byte(wc * 32 + fr, fq * 8);
#define PG8_SA(b, h) (((b) * 2 + (h)) * HTB)
#define PG8_SB(b, h) ((4 + (b) * 2 + (h)) * HTB)
#define PG8_STAGE(bufoff, gbase, voff) do { _Pragma("unroll") for (int _i = 0; _i < 2; ++_i) \
        __builtin_amdgcn_global_load_lds((const unsigned*)((const char*)(gbase) + (voff)[_i]), (PG8_LAS unsigned*)(lds + (bufoff) + ldsw + _i * 8192), 16, 0, 0); } while (0)
#define PG8_LDA(dst, b, h) do { _Pragma("unroll") for (int m = 0; m < 4; ++m) _Pragma("unroll") for (int k = 0; k < 2; ++k) dst[m][k] = *(const PG8_LAS bf16x8*)(lds + PG8_SA(b, h) + aoff + m * 2048 + k * 1024); } while (0)
#define PG8_LDB(dst, b, h) do { _Pragma("unroll") for (int n = 0; n < 2; ++n) _Pragma("unroll") for (int k = 0; k < 2; ++k) dst[n][k] = *(const PG8_LAS bf16x8*)(lds + PG8_SB(b, h) + boff + n * 2048 + k * 1024); } while (0)
#define PG8_MMA(ai, bj, At, Bt) do { __builtin_amdgcn_s_setprio(1); _Pragma("unroll") for (int m = 0; m < 4; ++m) _Pragma("unroll") for (int n = 0; n < 2; ++n) _Pragma("unroll") for (int k = 0; k < 2; ++k) \
        acc[ai][bj][m][n] = __builtin_amdgcn_mfma_f32_16x16x32_bf16(Bt[n][k], At[m][k], acc[ai][bj][m][n], 0, 0, 0); __builtin_amdgcn_s_setprio(0); } while (0)
#define PG8_WAIT_V(n) asm volatile("s_waitcnt vmcnt(" #n ")" ::: "memory")
#define PG8_WAIT_L(n) asm volatile("s_waitcnt lgkmcnt(" #n ")" ::: "memory")
#define PG8_BAR __builtin_amdgcn_s_barrier()
#define PG8_SCHED __builtin_amdgcn_sched_barrier(0)
    Unit cur, nxt; int ui = 0;
    if (!S.next(0, cur)) return;
    f32x4 acc[2][2][4][2];
#pragma unroll
    for (int a = 0; a < 2; ++a)
#pragma unroll
        for (int b = 0; b < 2; ++b)
#pragma unroll
            for (int m = 0; m < 4; ++m)
#pragma unroll
                for (int n = 0; n < 2; ++n) acc[a][b][m][n] = (f32x4){0.f, 0.f, 0.f, 0.f};
    bf16x8 At[4][2], B0[2][2], B1[2][2];
    const char* cA = (const char*)g.A + (size_t)cur.pm * tstep; const char* cB = (const char*)g.Bt + (size_t)cur.pn * tstep;
    S.a_ready(cur);
    if constexpr (SP2) {
        PG8_STAGE(PG8_SB(0, 0), cB, voffB); PG8_STAGE(PG8_SB(0, 1), cB + hstep, voffB); PG8_STAGE(PG8_SA(0, 0), cA, voffA); PG8_STAGE(PG8_SA(0, 1), cA + hstep, voffA);
        if (wr == 1) PG8_BAR;
        PG8_WAIT_V(2); PG8_BAR;
        PG8_STAGE(PG8_SB(1, 0), cB + kstep, voffB); PG8_STAGE(PG8_SA(1, 0), cA + kstep, voffA); PG8_STAGE(PG8_SB(1, 1), cB + hstep + kstep, voffB);
        PG8_WAIT_V(6); PG8_BAR;
    } else {
        PG8_STAGE(PG8_SB(0, 0), cB, voffB); PG8_STAGE(PG8_SA(0, 0), cA, voffA); PG8_STAGE(PG8_SB(0, 1), cB + hstep, voffB); PG8_STAGE(PG8_SA(0, 1), cA + hstep, voffA);
        if (wr == 1) PG8_BAR;
        PG8_WAIT_V(4); PG8_BAR;
        PG8_STAGE(PG8_SB(1, 0), cB + kstep, voffB); PG8_STAGE(PG8_SA(1, 0), cA + kstep, voffA); PG8_STAGE(PG8_SB(1, 1), cB + hstep + kstep, voffB);
        PG8_WAIT_V(6); PG8_BAR;
    }
    for (;;) {
        const bool has_next = S.next(ui + 1, nxt);
        const char* nA = has_next ? (const char*)g.A + (size_t)nxt.pm * tstep : cA; const char* nB = has_next ? (const char*)g.Bt + (size_t)nxt.pn * tstep : cB;
        for (int t = 0; t < nt; t += 2) {
            const bool last = (t == nt - 2);
            const char* a1 = cA + (size_t)(t + 1) * kstep;
            const char* a2 = last ? nA : cA + (size_t)(t + 2) * kstep; const char* b2 = last ? nB : cB + (size_t)(t + 2) * kstep;
            const char* a3 = a2 + kstep; const char* b3 = b2 + kstep;
            if (last && has_next) S.a_ready(nxt);
            if constexpr (SP2) {
            PG8_LDB(B0, 0, 0); PG8_LDB(B1, 0, 1); PG8_SCHED; PG8_LDA(At, 0, 0); PG8_STAGE(PG8_SA(1, 1), a1 + hstep, voffA);
            PG8_WAIT_V(8); PG8_WAIT_L(0); PG8_BAR; PG8_MMA(0, 0, At, B0); PG8_MMA(0, 1, At, B1); PG8_BAR; PG8_SCHED;
            PG8_LDA(At, 0, 1); PG8_STAGE(PG8_SB(0, 0), b2, voffB); PG8_STAGE(PG8_SB(0, 1), b2 + hstep, voffB); PG8_STAGE(PG8_SA(0, 0), a2, voffA);
            PG8_WAIT_V(8); PG8_WAIT_L(0); PG8_BAR; PG8_MMA(1, 0, At, B0); PG8_MMA(1, 1, At, B1); PG8_BAR; PG8_SCHED;
            PG8_LDB(B0, 1, 0); PG8_LDB(B1, 1, 1); PG8_SCHED; PG8_LDA(At, 1, 0); PG8_STAGE(PG8_SA(0, 1), a2 + hstep, voffA);
            PG8_WAIT_V(8); PG8_WAIT_L(0); PG8_BAR; PG8_MMA(0, 0, At, B0); PG8_MMA(0, 1, At, B1); PG8_BAR; PG8_SCHED;
            PG8_LDA(At, 1, 1); PG8_STAGE(PG8_SB(1, 0), b3, voffB); PG8_STAGE(PG8_SB(1, 1), b3 + hstep, voffB); PG8_STAGE(PG8_SA(1, 0), a3, voffA);
            PG8_WAIT_V(8); PG8_WAIT_L(0); PG8_BAR; PG8_MMA(1, 0, At, B0); PG8_MMA(1, 1, At, B1); PG8_BAR; PG8_SCHED;
            } else {
            PG8_LDB(B0, 0, 0); PG8_SCHED; PG8_LDA(At, 0, 0); PG8_STAGE(PG8_SA(1, 1), a1 + hstep, voffA);
            PG8_WAIT_L(8); PG8_BAR; PG8_WAIT_L(0); PG8_MMA(0, 0, At, B0); PG8_BAR; PG8_SCHED;
            PG8_LDB(B1, 0, 1); PG8_STAGE(PG8_SB(0, 0), b2, voffB);
            PG8_BAR; PG8_WAIT_L(0); PG8_MMA(0, 1, At, B1); PG8_BAR;
            PG8_LDA(At, 0, 1); PG8_STAGE(PG8_SA(0, 0), a2, voffA);
            PG8_BAR; PG8_WAIT_L(0); PG8_MMA(1, 0, At, B0); PG8_BAR; PG8_SCHED;
            PG8_STAGE(PG8_SB(0, 1), b2 + hstep, voffB);
            PG8_WAIT_V(6); PG8_BAR; PG8_MMA(1, 1, At, B1); PG8_BAR;
            PG8_LDB(B0, 1, 0); PG8_SCHED; PG8_LDA(At, 1, 0); PG8_STAGE(PG8_SA(0, 1), a2 + hstep, voffA);
            PG8_WAIT_L(8); PG8_BAR; PG8_WAIT_L(0); PG8_MMA(0, 0, At, B0); PG8_BAR; PG8_SCHED;
            PG8_LDB(B1, 1, 1); PG8_STAGE(PG8_SB(1, 0), b3, voffB);
            PG8_BAR; PG8_WAIT_L(0); PG8_MMA(0, 1, At, B1); PG8_BAR;
            PG8_LDA(At, 1, 1); PG8_STAGE(PG8_SA(1, 0), a3, voffA);
            PG8_BAR; PG8_WAIT_L(0); PG8_MMA(1, 0, At, B0); PG8_BAR; PG8_SCHED;
            PG8_STAGE(PG8_SB(1, 1), b3 + hstep, voffB);
            PG8_WAIT_V(6); PG8_BAR; PG8_MMA(1, 1, At, B1); PG8_BAR;
            }
        }
        if constexpr (ALIGN_EPI) { if (wr == 0) PG8_BAR; }
        asm volatile("s_nop 15\n\ts_nop 15" ::: "memory");
        if constexpr (!Epi::AFTER_DRAIN) { E(acc, cur, wr, wc, fr, fq); S.done(cur); }
        if (!has_next) break;
#pragma unroll
        for (int a = 0; a < 2; ++a)
#pragma unroll
            for (int b = 0; b < 2; ++b)
#pragma unroll
                for (int m = 0; m < 4; ++m)
#pragma unroll
                    for (int n = 0; n < 2; ++n) acc[a][b][m][n] = (f32x4){0.f, 0.f, 0.f, 0.f};
        cur = nxt; cA = nA; cB = nB; ++ui;
        if constexpr (ALIGN_EPI) { if (wr == 1) PG8_BAR; }
    }
    PG8_WAIT_V(0);
    if constexpr (!ALIGN_EPI) { if (wr == 0) PG8_BAR; }
    PG8_BAR;
    if constexpr (Epi::AFTER_DRAIN) { E.fused(acc, cur, wr, wc, fr, fq, lds, wid, lane); S.done(cur); }
#undef PG8_SA
#undef PG8_SB
#undef PG8_STAGE
#undef PG8_LDA
#undef PG8_LDB
#undef PG8_MMA
#undef PG8_WAIT_V
#undef PG8_WAIT_L
#undef PG8_BAR
#undef PG8_SCHED
}
}

#define LAS __attribute__((address_space(3)))
typedef unsigned short bf16;
typedef short bf16x8 __attribute__((ext_vector_type(8)));
typedef float f32x4 __attribute__((ext_vector_type(4)));
typedef float f32x16 __attribute__((ext_vector_type(16)));
typedef unsigned u32x2 __attribute__((ext_vector_type(2)));
typedef unsigned u32x4 __attribute__((ext_vector_type(4)));

constexpr int NB = 8, SEQ = 2048, NMETA = 16, LL = 2064, DM = 1024, FF = 4096, DIN = 4864, NPROJ = 1792;
constexpr int NREAL = NB * SEQ;
constexpr int TPR = NREAL + 256;
constexpr int LDS_BYTES = 147456;

constexpr size_t MiB = 1u << 20;
constexpr size_t WS_CTL = 0;
constexpr size_t WS_ROPE = 1 * MiB;
constexpr size_t WS_ABAR = 2 * MiB;
constexpr size_t WS_BMAT = 2 * MiB + 65536;
constexpr size_t WS_CMAT = WS_BMAT + 524288;
constexpr size_t WS_HM = 4 * MiB;
constexpr size_t WS_W = 5 * MiB;
constexpr size_t OW_IN = 0, OW_GLU = (size_t)DIN * DM * 2, OW_POOL = OW_GLU + 512 * 512 * 2, OW_BR = OW_POOL + 512 * 512 * 2,
                 OW_OUT = OW_BR + 3 * 1024 * 512 * 2, OW_UP = OW_OUT + 1024 * 1024 * 2, OW_DN = OW_UP + (size_t)FF * DM * 2, LW_BYTES = OW_DN + (size_t)FF * DM * 2;
constexpr size_t WS_HB = 68 * MiB;
constexpr size_t WS_X = 101 * MiB;
constexpr size_t UU = (size_t)TPR * 512 * 2;
constexpr size_t WS_YF = WS_X, WS_YP = WS_X, WS_Q = WS_X + 2 * UU, WS_K = WS_Q + UU, WS_V = WS_K + UU / 4, WS_MG = WS_X + 2 * UU,
                 WS_SU = WS_X + 4 * UU, WS_YA = WS_X + 8 * UU  , WS_PU = WS_X + 5 * UU, WS_YS = WS_PU, WS_Z = WS_X + 6 * UU, WS_PD = WS_X + 7 * UU, WS_BR = WS_Z, WS_ACT = WS_X;
constexpr size_t WS_RS = WS_X + 9 * UU;
constexpr size_t WS_END = WS_RS + (size_t)5 * TPR * 16 * 4;
static_assert(WS_W + 2 * LW_BYTES <= WS_HB && WS_HB + (size_t)TPR * 1024 * 2 <= WS_X && WS_END <= 256 * MiB, "ws map");
static_assert((size_t)256 * 2064 * 16 * 4 <= 2 * UU, "YF fits");

__device__ __forceinline__ unsigned pk2(float lo, float hi) { unsigned r; asm("v_cvt_pk_bf16_f32 %0, %1, %2" : "=v"(r) : "v"(lo), "v"(hi)); return r; }
__device__ __forceinline__ unsigned f2bf(float f) { return pk2(f, 0.f) & 0xffffu; }
__device__ __forceinline__ float bf2f(unsigned b) { return __uint_as_float(b << 16); }
__device__ __forceinline__ int tok_row(int b, int l) { return l >= NMETA ? b * SEQ + l - NMETA : NREAL + b * NMETA + l; }
#define LDS_FENCE() asm volatile("s_waitcnt lgkmcnt(0)" ::: "memory")
#define SSM_SYNC() do { asm volatile("s_waitcnt vmcnt(0) lgkmcnt(0)" ::: "memory"); __syncthreads(); } while (0)
__device__ __forceinline__ float row_rstd(const float* rs, int R) {
    const f32x4 a = *(const f32x4*)(rs + (size_t)R * 4), b = *(const f32x4*)(rs + ((size_t)TPR + R) * 4), c = *(const f32x4*)(rs + ((size_t)2 * TPR + R) * 4), d = *(const f32x4*)(rs + ((size_t)3 * TPR + R) * 4);
    const float s = (((a[0] + a[1]) + (a[2] + a[3])) + ((b[0] + b[1]) + (b[2] + b[3]))) + (((c[0] + c[1]) + (c[2] + c[3])) + ((d[0] + d[1]) + (d[2] + d[3])));
    return rsqrtf(s * (1.0f / 1024.0f) + 1e-6f);
}

__device__ __forceinline__ void dsincos(double a, double& s, double& c) {
    const double q = rint(a * 0.63661977236758134308);
    double r = fma(-q, 1.57079632679489655800e+00, a); r = fma(-q, 6.12323399573676603587e-17, r);
    const double r2 = r * r;
    double sp = -7.6471637318198164759e-13; sp = fma(sp, r2, 1.6059043836821614599e-10); sp = fma(sp, r2, -2.5052108385441718775e-08); sp = fma(sp, r2, 2.7557319223985890653e-06);
    sp = fma(sp, r2, -1.9841269841269841270e-04); sp = fma(sp, r2, 8.3333333333333333333e-03); sp = fma(sp, r2, -1.6666666666666666667e-01); sp = fma(sp * r2, r, r);
    double cp = 4.7794773323873852974e-14; cp = fma(cp, r2, -1.1470745597729724714e-11); cp = fma(cp, r2, 2.0876756987868098979e-09); cp = fma(cp, r2, -2.7557319223985890653e-07);
    cp = fma(cp, r2, 2.4801587301587301587e-05); cp = fma(cp, r2, -1.3888888888888888889e-03); cp = fma(cp, r2, 4.1666666666666666667e-02); cp = fma(cp, r2, -0.5); cp = fma(cp, r2, 1.0);
    const int qi = ((int)q) & 3;
    s = (qi == 0) ? sp : (qi == 1) ? cp : (qi == 2) ? -sp : -cp;
    c = (qi == 0) ? cp : (qi == 1) ? -sp : (qi == 2) ? -cp : sp;
}
__device__ __forceinline__ double dexp(double x) {
    const double k = rint(x * 1.44269504088896340736);
    double r = fma(-k, 6.93147180369123816490e-01, x); r = fma(-k, 1.90821492927058770002e-10, r);
    double p = 1.0 / 6227020800.0; p = fma(p, r, 1.0 / 479001600.0); p = fma(p, r, 1.0 / 39916800.0); p = fma(p, r, 1.0 / 3628800.0); p = fma(p, r, 1.0 / 362880.0); p = fma(p, r, 1.0 / 40320.0);
    p = fma(p, r, 1.0 / 5040.0); p = fma(p, r, 1.0 / 720.0); p = fma(p, r, 1.0 / 120.0); p = fma(p, r, 1.0 / 24.0); p = fma(p, r, 1.0 / 6.0); p = fma(p, r, 0.5); p = fma(p, r, 1.0); p = fma(p, r, 1.0);
    const long long bits = ((long long)(1023 + (int)k)) << 52;
    return p * __longlong_as_double(bits);
}

struct EpiInProj {
    static constexpr bool PERM = true, AFTER_DRAIN = false;
    const float* rowss; const float* rope; bf16 *Q, *K, *V, *SU, *PU;
    __device__ __forceinline__ u32x2 quad(int l, int c, const f32x4& v) const {
        u32x2 w;
        if (c < 640) {
            const int i0 = (c & 63) >> 1;
            const f32x4 cs = *(const f32x4*)(rope + ((size_t)l * 32 + i0) * 2);
            float o0 = v[0] * cs[0] - v[1] * cs[1], o1 = v[1] * cs[0] + v[0] * cs[1], o2 = v[2] * cs[2] - v[3] * cs[3], o3 = v[3] * cs[2] + v[2] * cs[3];
            if (c < 512) { o0 *= 0.125f; o1 *= 0.125f; o2 *= 0.125f; o3 *= 0.125f; }
            w.x = pk2(o0, o1); w.y = pk2(o2, o3);
        } else { w.x = pk2(v[0], v[1]); w.y = pk2(v[2], v[3]); }
        return w;
    }
    __device__ __forceinline__ void operator()(const f32x4 (&acc)[2][2][4][2], const pg8::Unit& u, int wr, int wc, int fr, int fq) const {
#pragma unroll
        for (int ai = 0; ai < 2; ++ai)
#pragma unroll
            for (int m = 0; m < 4; ++m) {
                const int R = u.pm * 256 + ai * 128 + wr * 64 + m * 16 + fr;
                const float rs = row_rstd(rowss, R);
                const int l = R < NREAL ? (R & 2047) + NMETA : (R & 15);
#pragma unroll
                for (int bj = 0; bj < 2; ++bj) {
                    const int c = u.pn * 256 + bj * 128 + wc * 32 + 8 * fq;
                    const u32x2 w0 = quad(l, c, acc[ai][bj][m][0] * rs), w1 = quad(l, c + 4, acc[ai][bj][m][1] * rs);
                    u32x4 w; w.x = w0.x; w.y = w0.y; w.z = w1.x; w.w = w1.y;
                    bf16* dst = c < 512 ? Q + (size_t)R * 512 + c : c < 640 ? K + (size_t)R * 128 + (c - 512) : c < 768 ? V + (size_t)R * 128 + (c - 640)
                              : c < 1280 ? SU + (size_t)R * 512 + (c - 768) : PU + (size_t)R * 512 + (c - 1280);
                    *(u32x4*)dst = w;
                }
            }
    }
};
#define EPI_BODY() \
    __device__ __forceinline__ void rg(int R, int pn, int wc, int fq, const f32x4 (&a4)[2][2]) const { \
        _Pragma("unroll") for (int bj = 0; bj < 2; ++bj) q2(R, pn * 256 + bj * 128 + wc * 32 + 8 * fq, a4[bj][0], a4[bj][1]); } \
    __device__ __forceinline__ void tq(int R, int c, const f32x4& v) const { q(R, c, v); } \
    EPI_OP()
#define EPI_OP() \
    __device__ __forceinline__ void operator()(const f32x4 (&acc)[2][2][4][2], const pg8::Unit& u, int wr, int wc, int fr, int fq) const { \
        _Pragma("unroll") for (int ai = 0; ai < 2; ++ai) _Pragma("unroll") for (int m = 0; m < 4; ++m) { \
            const f32x4 a4[2][2] = {{acc[ai][0][m][0], acc[ai][0][m][1]}, {acc[ai][1][m][0], acc[ai][1][m][1]}}; \
            rg(u.pm * 256 + ai * 128 + wr * 64 + m * 16 + fr, u.pn, wc, fq, a4); } }
#define EPI_BODY_RS() \
    __device__ __forceinline__ void rg(int R, int pn, int wc, int fq, const f32x4 (&a4)[2][2]) const { const float rs = row_rstd(rowss, R); \
        _Pragma("unroll") for (int bj = 0; bj < 2; ++bj) q2(R, pn * 256 + bj * 128 + wc * 32 + 8 * fq, a4[bj][0], a4[bj][1], rs); } \
    __device__ __forceinline__ void tq(int R, int c, const f32x4& v) const { q(R, c, v, row_rstd(rowss, R)); } \
    EPI_OP()
struct EpiGlu {
    static constexpr bool PERM = true, AFTER_DRAIN = false;
    const bf16* Z; const float* bias; bf16* YS;
    __device__ __forceinline__ void q(int R, int c, const f32x4& a) const {
        const f32x4 v = a + *(const f32x4*)(bias + c);
        const u32x2 zz = *(const u32x2*)(Z + (size_t)R * 512 + c);
        const float z0 = bf2f(zz.x & 0xffffu), z1 = bf2f(zz.x >> 16), z2 = bf2f(zz.y & 0xffffu), z3 = bf2f(zz.y >> 16);
        u32x2 w; w.x = pk2(z0 * __builtin_amdgcn_rcpf(1.0f + __expf(-v[0])), z1 * __builtin_amdgcn_rcpf(1.0f + __expf(-v[1]))); w.y = pk2(z2 * __builtin_amdgcn_rcpf(1.0f + __expf(-v[2])), z3 * __builtin_amdgcn_rcpf(1.0f + __expf(-v[3])));
        *(u32x2*)(YS + (size_t)R * 512 + c) = w;
    }
    __device__ __forceinline__ void q2(int R, int c, const f32x4& a0, const f32x4& a1) const {
        const f32x4 v0 = a0 + *(const f32x4*)(bias + c), v1 = a1 + *(const f32x4*)(bias + c + 4);
        const u32x4 zz = *(const u32x4*)(Z + (size_t)R * 512 + c);
        u32x4 w;
        w.x = pk2(bf2f(zz.x & 0xffffu) * __builtin_amdgcn_rcpf(1.0f + __expf(-v0[0])), bf2f(zz.x >> 16) * __builtin_amdgcn_rcpf(1.0f + __expf(-v0[1])));
        w.y = pk2(bf2f(zz.y & 0xffffu) * __builtin_amdgcn_rcpf(1.0f + __expf(-v0[2])), bf2f(zz.y >> 16) * __builtin_amdgcn_rcpf(1.0f + __expf(-v0[3])));
        w.z = pk2(bf2f(zz.z & 0xffffu) * __builtin_amdgcn_rcpf(1.0f + __expf(-v1[0])), bf2f(zz.z >> 16) * __builtin_amdgcn_rcpf(1.0f + __expf(-v1[1])));
        w.w = pk2(bf2f(zz.w & 0xffffu) * __builtin_amdgcn_rcpf(1.0f + __expf(-v1[2])), bf2f(zz.w >> 16) * __builtin_amdgcn_rcpf(1.0f + __expf(-v1[3])));
        *(u32x4*)(YS + (size_t)R * 512 + c) = w;
    }
    EPI_BODY()
};
struct EpiScale {
    static constexpr bool PERM = true, AFTER_DRAIN = false;
    bf16* O; int ldc; const float* scale;
    __device__ __forceinline__ void q(int R, int c, const f32x4& a) const {
        f32x4 v = a;
        if (scale) v = v * *(const f32x4*)(scale + c);
        u32x2 w; w.x = pk2(v[0], v[1]); w.y = pk2(v[2], v[3]);
        *(u32x2*)(O + (size_t)R * ldc + c) = w;
    }
    __device__ __forceinline__ void q2(int R, int c, const f32x4& a0, const f32x4& a1) const {
        f32x4 v0 = a0, v1 = a1;
        if (scale) { v0 = v0 * *(const f32x4*)(scale + c); v1 = v1 * *(const f32x4*)(scale + c + 4); }
        u32x4 w; w.x = pk2(v0[0], v0[1]); w.y = pk2(v0[2], v0[3]); w.z = pk2(v1[0], v1[1]); w.w = pk2(v1[2], v1[3]);
        *(u32x4*)(O + (size_t)R * ldc + c) = w;
    }
    EPI_BODY()
};
template <bool FIRST> struct EpiGate {
    static constexpr bool PERM = true, AFTER_DRAIN = false;
    const float* rowss; const bf16* BR; bf16* MG;
    __device__ __forceinline__ void q(int R, int c, const f32x4& a, float rs) const {
        const f32x4 v = a * rs;
        const u32x2 bb = *(const u32x2*)(BR + (size_t)R * 1024 + c);
        float o0 = bf2f(bb.x & 0xffffu) * __builtin_amdgcn_rcpf(1.0f + __expf(-v[0])), o1 = bf2f(bb.x >> 16) * __builtin_amdgcn_rcpf(1.0f + __expf(-v[1]));
        float o2 = bf2f(bb.y & 0xffffu) * __builtin_amdgcn_rcpf(1.0f + __expf(-v[2])), o3 = bf2f(bb.y >> 16) * __builtin_amdgcn_rcpf(1.0f + __expf(-v[3]));
        if (!FIRST) { const u32x2 mm = *(const u32x2*)(MG + (size_t)R * 1024 + c);
            o0 += bf2f(mm.x & 0xffffu); o1 += bf2f(mm.x >> 16); o2 += bf2f(mm.y & 0xffffu); o3 += bf2f(mm.y >> 16); }
        u32x2 w; w.x = pk2(o0, o1); w.y = pk2(o2, o3);
        *(u32x2*)(MG + (size_t)R * 1024 + c) = w;
    }
    __device__ __forceinline__ void q2(int R, int c, const f32x4& a0, const f32x4& a1, float rs) const {
        const f32x4 v0 = a0 * rs, v1 = a1 * rs;
        const u32x4 bb = *(const u32x4*)(BR + (size_t)R * 1024 + c);
        float o[8];
        o[0] = bf2f(bb.x & 0xffffu) * __builtin_amdgcn_rcpf(1.0f + __expf(-v0[0])); o[1] = bf2f(bb.x >> 16) * __builtin_amdgcn_rcpf(1.0f + __expf(-v0[1]));
        o[2] = bf2f(bb.y & 0xffffu) * __builtin_amdgcn_rcpf(1.0f + __expf(-v0[2])); o[3] = bf2f(bb.y >> 16) * __builtin_amdgcn_rcpf(1.0f + __expf(-v0[3]));
        o[4] = bf2f(bb.z & 0xffffu) * __builtin_amdgcn_rcpf(1.0f + __expf(-v1[0])); o[5] = bf2f(bb.z >> 16) * __builtin_amdgcn_rcpf(1.0f + __expf(-v1[1]));
        o[6] = bf2f(bb.w & 0xffffu) * __builtin_amdgcn_rcpf(1.0f + __expf(-v1[2])); o[7] = bf2f(bb.w >> 16) * __builtin_amdgcn_rcpf(1.0f + __expf(-v1[3]));
        if (!FIRST) { const u32x4 mm = *(const u32x4*)(MG + (size_t)R * 1024 + c);
            o[0] += bf2f(mm.x & 0xffffu); o[1] += bf2f(mm.x >> 16); o[2] += bf2f(mm.y & 0xffffu); o[3] += bf2f(mm.y >> 16);
            o[4] += bf2f(mm.z & 0xffffu); o[5] += bf2f(mm.z >> 16); o[6] += bf2f(mm.w & 0xffffu); o[7] += bf2f(mm.w >> 16); }
        u32x4 w; w.x = pk2(o[0], o[1]); w.y = pk2(o[2], o[3]); w.z = pk2(o[4], o[5]); w.w = pk2(o[6], o[7]);
        *(u32x4*)(MG + (size_t)R * 1024 + c) = w;
    }
    EPI_BODY_RS()
};
struct EpiRes {
    static constexpr bool PERM = true, AFTER_DRAIN = false;
    const float* Xin; bf16* HB; float* rowss_out;
    __device__ __forceinline__ float q(int R, int c, const f32x4& a) const {
        f32x4 h;
        if (Xin && R < NREAL) h = *(const f32x4*)(Xin + (size_t)R * 1024 + c);
        else { const u32x2 hb = *(const u32x2*)(HB + (size_t)R * 1024 + c); h = (f32x4){bf2f(hb.x & 0xffffu), bf2f(hb.x >> 16), bf2f(hb.y & 0xffffu), bf2f(hb.y >> 16)}; }
        h = h + a;
        u32x2 w; w.x = pk2(h[0], h[1]); w.y = pk2(h[2], h[3]);
        *(u32x2*)(HB + (size_t)R * 1024 + c) = w;
        const float r0 = bf2f(w.x & 0xffffu), r1 = bf2f(w.x >> 16), r2 = bf2f(w.y & 0xffffu), r3 = bf2f(w.y >> 16);
        return (r0 * r0 + r1 * r1) + (r2 * r2 + r3 * r3);
    }
    __device__ __forceinline__ float q2(int R, int c, const f32x4& a0, const f32x4& a1) const {
        f32x4 h0, h1;
        if (Xin && R < NREAL) { h0 = *(const f32x4*)(Xin + (size_t)R * 1024 + c); h1 = *(const f32x4*)(Xin + (size_t)R * 1024 + c + 4); }
        else { const u32x4 hb = *(const u32x4*)(HB + (size_t)R * 1024 + c);
            h0 = (f32x4){bf2f(hb.x & 0xffffu), bf2f(hb.x >> 16), bf2f(hb.y & 0xffffu), bf2f(hb.y >> 16)}; h1 = (f32x4){bf2f(hb.z & 0xffffu), bf2f(hb.z >> 16), bf2f(hb.w & 0xffffu), bf2f(hb.w >> 16)}; }
        h0 = h0 + a0; h1 = h1 + a1;
        u32x4 w; w.x = pk2(h0[0], h0[1]); w.y = pk2(h0[2], h0[3]); w.z = pk2(h1[0], h1[1]); w.w = pk2(h1[2], h1[3]);
        *(u32x4*)(HB + (size_t)R * 1024 + c) = w;
        const float r0 = bf2f(w.x & 0xffffu), r1 = bf2f(w.x >> 16), r2 = bf2f(w.y & 0xffffu), r3 = bf2f(w.y >> 16), r4 = bf2f(w.z & 0xffffu), r5 = bf2f(w.z >> 16), r6 = bf2f(w.w & 0xffffu), r7 = bf2f(w.w >> 16);
        return ((r0 * r0 + r1 * r1) + (r2 * r2 + r3 * r3)) + ((r4 * r4 + r5 * r5) + (r6 * r6 + r7 * r7));
    }
    __device__ __forceinline__ void rg(int R, int pn, int wc, int fq, const f32x4 (&a4)[2][2]) const {
        float ss = 0.f;
#pragma unroll
        for (int bj = 0; bj < 2; ++bj) ss += q2(R, pn * 256 + bj * 128 + wc * 32 + 8 * fq, a4[bj][0], a4[bj][1]);
        ss += __shfl_xor(ss, 16); ss += __shfl_xor(ss, 32);
        if (fq == 0) rowss_out[((size_t)pn * TPR + R) * 4 + wc] = ss;
    }
    __device__ __forceinline__ void tq(int R, int c, const f32x4& v) const {
        float ss = q(R, c, v);
        ss += __shfl_xor(ss, 16); ss += __shfl_xor(ss, 32);
        if ((threadIdx.x & 48) == 0) atomicAdd(rowss_out + (size_t)R * 4, ss);
    }
    EPI_OP()
};
struct EpiUp {
    static constexpr bool PERM = true, AFTER_DRAIN = false;
    const float* rowss; bf16* ACT;
    __device__ __forceinline__ void q(int R, int c, const f32x4& a, float rs) const {
        f32x4 v = a * rs;
#pragma unroll
        for (int j = 0; j < 4; ++j) { const float r = fmaxf(v[j], 0.f); v[j] = r * r; }
        u32x2 w; w.x = pk2(v[0], v[1]); w.y = pk2(v[2], v[3]);
        *(u32x2*)(ACT + (size_t)R * FF + c) = w;
    }
    __device__ __forceinline__ void q2(int R, int c, const f32x4& a0, const f32x4& a1, float rs) const {
        f32x4 v0 = a0 * rs, v1 = a1 * rs;
#pragma unroll
        for (int j = 0; j < 4; ++j) { const float r0 = fmaxf(v0[j], 0.f), r1 = fmaxf(v1[j], 0.f); v0[j] = r0 * r0; v1[j] = r1 * r1; }
        u32x4 w; w.x = pk2(v0[0], v0[1]); w.y = pk2(v0[2], v0[3]); w.z = pk2(v1[0], v1[1]); w.w = pk2(v1[2], v1[3]);
        *(u32x4*)(ACT + (size_t)R * FF + c) = w;
    }
    EPI_BODY_RS()
};
struct TripleOrder {
    pg8::StaticOrder S0; int arow, bcol;
    __device__ __forceinline__ void init(int G, int c, int arow_, int bcol_) { S0.init(NREAL, 1024, G, c); arow = arow_; bcol = bcol_; }
    __device__ __forceinline__ bool next(int i, pg8::Unit& u) const { pg8::Unit t; t.pm = 0; t.pn = 0; if (!S0.next(i / 3, t)) return false; const int br = i % 3; u.pm = t.pm + br * arow; u.pn = t.pn + br * bcol; return true; }
    __device__ __forceinline__ void a_ready(const pg8::Unit&) const {}
    __device__ __forceinline__ void done(const pg8::Unit&) const {}
};
struct EpiBr3 {
    static constexpr bool PERM = true, AFTER_DRAIN = false;
    bf16* Bbase; int arow;
    __device__ __forceinline__ void operator()(const f32x4 (&acc)[2][2][4][2], const pg8::Unit& u, int wr, int wc, int fr, int fq) const {
        const int c = u.pn >> 2, pn = u.pn & 3, pm = u.pm - arow * c; bf16* O = Bbase + (size_t)(2 * c + 2 * (c > 0)) * (UU / 2);
#pragma unroll
        for (int ai = 0; ai < 2; ++ai)
#pragma unroll
            for (int m = 0; m < 4; ++m) { const int R = pm * 256 + ai * 128 + wr * 64 + m * 16 + fr;
#pragma unroll
                for (int bj = 0; bj < 2; ++bj) { const f32x4 v0 = acc[ai][bj][m][0], v1 = acc[ai][bj][m][1];
                    u32x4 w; w.x = pk2(v0[0], v0[1]); w.y = pk2(v0[2], v0[3]); w.z = pk2(v1[0], v1[1]); w.w = pk2(v1[2], v1[3]);
                    *(u32x4*)(O + (size_t)R * 1024 + pn * 256 + bj * 128 + wc * 32 + 8 * fq) = w; } }
    }
};
struct EpiGate3 {
    static constexpr bool PERM = true, AFTER_DRAIN = false;
    const float* rowss; const bf16* Bbase; bf16* MG;
    __device__ __forceinline__ void operator()(const f32x4 (&acc)[2][2][4][2], const pg8::Unit& u, int wr, int wc, int fr, int fq) const {
        const int c = u.pn >> 2, pn = u.pn & 3; const bf16* BR = Bbase + (size_t)(2 * c + 2 * (c > 0)) * (UU / 2);
#pragma unroll
        for (int ai = 0; ai < 2; ++ai)
#pragma unroll
            for (int m = 0; m < 4; ++m) { const int R = u.pm * 256 + ai * 128 + wr * 64 + m * 16 + fr; const float rs = row_rstd(rowss, R);
#pragma unroll
                for (int bj = 0; bj < 2; ++bj) { const int cc = pn * 256 + bj * 128 + wc * 32 + 8 * fq;
                    const f32x4 v0 = acc[ai][bj][m][0] * rs, v1 = acc[ai][bj][m][1] * rs;
                    const u32x4 bb = *(const u32x4*)(BR + (size_t)R * 1024 + cc);
                    float o[8];
                    o[0] = bf2f(bb.x & 0xffffu) * __builtin_amdgcn_rcpf(1.0f + __expf(-v0[0])); o[1] = bf2f(bb.x >> 16) * __builtin_amdgcn_rcpf(1.0f + __expf(-v0[1]));
                    o[2] = bf2f(bb.y & 0xffffu) * __builtin_amdgcn_rcpf(1.0f + __expf(-v0[2])); o[3] = bf2f(bb.y >> 16) * __builtin_amdgcn_rcpf(1.0f + __expf(-v0[3]));
                    o[4] = bf2f(bb.z & 0xffffu) * __builtin_amdgcn_rcpf(1.0f + __expf(-v1[0])); o[5] = bf2f(bb.z >> 16) * __builtin_amdgcn_rcpf(1.0f + __expf(-v1[1]));
                    o[6] = bf2f(bb.w & 0xffffu) * __builtin_amdgcn_rcpf(1.0f + __expf(-v1[2])); o[7] = bf2f(bb.w >> 16) * __builtin_amdgcn_rcpf(1.0f + __expf(-v1[3]));
                    if (c != 0) { const u32x4 mm = *(const u32x4*)(MG + (size_t)R * 1024 + cc);
                        o[0] += bf2f(mm.x & 0xffffu); o[1] += bf2f(mm.x >> 16); o[2] += bf2f(mm.y & 0xffffu); o[3] += bf2f(mm.y >> 16);
                        o[4] += bf2f(mm.z & 0xffffu); o[5] += bf2f(mm.z >> 16); o[6] += bf2f(mm.w & 0xffffu); o[7] += bf2f(mm.w >> 16); }
                    u32x4 w; w.x = pk2(o[0], o[1]); w.y = pk2(o[2], o[3]); w.z = pk2(o[4], o[5]); w.w = pk2(o[6], o[7]);
                    *(u32x4*)(MG + (size_t)R * 1024 + cc) = w; } }
    }
};
template <class Epi, bool SUM3 = false>
__device__ __forceinline__ void thin_gemm(LAS unsigned char* lds, const bf16* A, const bf16* Bt, int K, int N, const Epi& E, int vb, int vg, size_t asum_stride = 0) {
    int tid_l = threadIdx.x; asm volatile("" : "+v"(tid_l));
    const int lane = tid_l & 63, w = __builtin_amdgcn_readfirstlane(tid_l >> 6), fr = lane & 15, fq = lane >> 4;
    LAS f32x4* red = (LAS f32x4*)lds;
    const int kw = K >> 3;
    for (int pc = vb; pc < N / 16; pc += vg) {
        const bf16* ap = A + (size_t)(NREAL + fr) * K + w * kw + 8 * fq;
        const bf16* bp = Bt + (size_t)(16 * pc + fr) * K + w * kw + 8 * fq;
        f32x4 acc[8];
#pragma unroll
        for (int rb = 0; rb < 8; ++rb) acc[rb] = (f32x4){0.f, 0.f, 0.f, 0.f};
#pragma unroll (SUM3 ? 1 : 4)
        for (int k0 = 0; k0 < kw; k0 += 32) {
            const bf16x8 bf = *(const bf16x8*)(bp + k0);
            bf16x8 af[8];
#pragma unroll
            for (int rb = 0; rb < 8; ++rb) {
                if constexpr (!SUM3) af[rb] = *(const bf16x8*)(ap + (size_t)(16 * rb) * K + k0);
                else {
                    const bf16* a0 = ap + (size_t)(16 * rb) * K + k0;
                    const u32x4 x0 = *(const u32x4*)a0, x1 = *(const u32x4*)(a0 + asum_stride), x2 = *(const u32x4*)(a0 + 2 * asum_stride);
                    union { bf16x8 v; unsigned u[4]; } s;
                    const unsigned w0[4] = {x0.x, x0.y, x0.z, x0.w}, w1[4] = {x1.x, x1.y, x1.z, x1.w}, w2[4] = {x2.x, x2.y, x2.z, x2.w};
#pragma unroll
                    for (int j = 0; j < 4; ++j) s.u[j] = pk2((bf2f(w0[j] & 0xffffu) + bf2f(w1[j] & 0xffffu)) + bf2f(w2[j] & 0xffffu), (bf2f(w0[j] >> 16) + bf2f(w1[j] >> 16)) + bf2f(w2[j] >> 16));
                    af[rb] = s.v;
                }
            }
#pragma unroll
            for (int rb = 0; rb < 8; ++rb) acc[rb] = __builtin_amdgcn_mfma_f32_16x16x32_bf16(bf, af[rb], acc[rb], 0, 0, 0);
        }
        asm volatile("s_nop 15\n\ts_nop 15" : "+v"(acc[0]), "+v"(acc[1]), "+v"(acc[2]), "+v"(acc[3]), "+v"(acc[4]), "+v"(acc[5]), "+v"(acc[6]), "+v"(acc[7]));
#pragma unroll
        for (int rb = 0; rb < 8; ++rb) red[(w * 8 + rb) * 64 + lane] = acc[rb];
        LDS_FENCE(); __syncthreads();
        f32x4 v = red[(0 * 8 + w) * 64 + lane];
#pragma unroll
        for (int ww = 1; ww < 8; ++ww) v = v + red[(ww * 8 + w) * 64 + lane];
        LDS_FENCE(); __syncthreads();
        E.tq(NREAL + 16 * w + fr, 16 * pc + 4 * fq, v);
    }
}

struct Args { const float* in[23]; float* out; unsigned char* ws; };

__device__ __forceinline__ void p0_item(const float* W, int ldw, int K, const float* scale, bf16* WT, int permrows, LAS float* scr, int item, int nblk, int lane) {
    const int kb = item / nblk, nb = item % nblk, k0 = 64 * kb, n0 = 64 * nb;
#pragma unroll 4
    for (int i = 0; i < 16; ++i) {
        const int kk = 4 * i + (lane >> 4), c4 = (lane & 15) * 4;
        f32x4 w = *(const f32x4*)(W + (size_t)(k0 + kk) * ldw + n0 + c4);
        if (scale) w = w * scale[k0 + kk];
        scr[kk * 65 + c4] = w[0]; scr[kk * 65 + c4 + 1] = w[1]; scr[kk * 65 + c4 + 2] = w[2]; scr[kk * 65 + c4 + 3] = w[3];
    }
    LDS_FENCE();
    const int c = lane & 7;
#pragma unroll
    for (int j = 0; j < 8; ++j) {
        const int n = (lane >> 3) + 8 * j;
        const int sc = (n0 + n) < permrows ? ((n & 1) ? 32 + (n >> 1) : (n >> 1)) : n;
        const LAS float* s = scr + (8 * c) * 65 + sc;
        u32x4 o; o.x = pk2(s[0 * 65], s[1 * 65]); o.y = pk2(s[2 * 65], s[3 * 65]); o.z = pk2(s[4 * 65], s[5 * 65]); o.w = pk2(s[6 * 65], s[7 * 65]);
        *(u32x4*)(WT + (size_t)(n0 + n) * K + k0 + 8 * c) = o;
    }
    LDS_FENCE();
}

typedef const __attribute__((address_space(4))) Args* KArgsP;
__device__ __forceinline__ void convert_layer_weights(KArgsP ka, LAS unsigned char* lds, int layer, int vw, int nvw, int wave, int lane, int part  ) {
    unsigned char* ws = ka->ws;
    LAS float* scr = (LAS float*)(lds + wave * 17408);
    constexpr int I_IN = 16 * 76, I_GLU = 8 * 8, I_BR = 8 * 16, I_OUT = 16 * 16, I_UP = 16 * 64, I_DN = 64 * 16, I_L = I_IN + I_GLU + 3 * I_BR + I_OUT + I_UP + I_DN;
    unsigned char* wl = ws + WS_W + (size_t)layer * LW_BYTES;
    for (int it = (part == 0 ? 0 : I_IN) + vw; it < (part == 0 ? I_IN : I_L); it += nvw) {
        int r = it;
        if (r < I_IN) { p0_item(ka->in[3] + (size_t)layer * DM * DIN, DIN, DM, ka->in[2] + layer * DM, (bf16*)(wl + OW_IN), 640, scr, r, 76, lane); continue; } r -= I_IN;
        if (r < I_GLU) { p0_item(ka->in[13] + (size_t)layer * 512 * 512, 512, 512, nullptr, (bf16*)(wl + OW_GLU), 0, scr, r, 8, lane); continue; } r -= I_GLU;
        if (r < 3 * I_BR) { const int c = r / I_BR; p0_item(ka->in[17] + ((size_t)layer * 3 + c) * 512 * 1024, 1024, 512, nullptr, (bf16*)(wl + OW_BR) + (size_t)c * 1024 * 512, 0, scr, r % I_BR, 16, lane); continue; } r -= 3 * I_BR;
        if (r < I_OUT) { p0_item(ka->in[18] + (size_t)layer * DM * DM, DM, DM, nullptr, (bf16*)(wl + OW_OUT), 0, scr, r, 16, lane); continue; } r -= I_OUT;
        if (r < I_UP) { p0_item(ka->in[20] + (size_t)layer * DM * FF, FF, DM, ka->in[19] + layer * DM, (bf16*)(wl + OW_UP), 0, scr, r, 64, lane); continue; } r -= I_UP;
        p0_item(ka->in[21] + (size_t)layer * FF * DM, DM, FF, nullptr, (bf16*)(wl + OW_DN), 0, scr, r, 16, lane);
    }
    if (part == 1) for (int i = vw * 64 + lane; i < 512 * 64; i += nvw * 64) {
        const int n = i >> 6, k0 = (i & 63) * 8;
        u32x4 o = {0u, 0u, 0u, 0u};
        if ((n >> 7) == (k0 >> 7)) { const float* src = ka->in[15] + (((size_t)layer * 4 + (n >> 7)) * 128 + (k0 & 127)) * 128 + (n & 127);
            o.x = pk2(src[0], src[128]); o.y = pk2(src[256], src[384]); o.z = pk2(src[512], src[640]); o.w = pk2(src[768], src[896]); }
        *(u32x4*)((bf16*)(wl + OW_POOL) + (size_t)n * 512 + k0) = o;
    }
}

__device__ __forceinline__ void p0_prologue(const Args& a, LAS unsigned char* lds) {
    int tl_ = threadIdx.x; asm volatile("" : "+v"(tl_));
    const int tid = tl_, lane = tid & 63, wave = __builtin_amdgcn_readfirstlane(tid >> 6);
    const int gw = blockIdx.x * 8 + wave, NGW = gridDim.x * 8;
    const int gt = blockIdx.x * 512 + tid, NGT = gridDim.x * 512;
    unsigned char* ws = a.ws;
    for (int i = gt; i < 4 * 4 * 128 * 4; i += NGT) { const int idx = 1 + (i >> 11), pn = (i >> 9) & 3, r = (i >> 2) & 127, sl = i & 3;
        ((float*)(ws + WS_RS))[((size_t)idx * 4 * TPR + (size_t)pn * TPR + NREAL + r) * 4 + sl] = 0.f; }
    for (int i = gt; i < LL * 32; i += NGT) {
        const int l = i >> 5, f = i & 31;
        const float invf = (float)dexp(-(double)f * (9.21034037197618273607 / 32.0));
        const float ang = (float)l * invf;
        double s, c; dsincos((double)ang, s, c);
        float* rp = (float*)(ws + WS_ROPE) + (size_t)i * 2; rp[0] = (float)c; rp[1] = (float)s;
    }
    for (int j = gt; j < 2 * 2 * 32 * 64 * 16; j += NGT) {
        const int q = j & 15, i = j >> 4, n = i & 63, pidx = i >> 6;
        const double lr = (double)a.in[5][i], li = (double)a.in[6][i];
        const double dt = (double)(float)dexp((double)a.in[7][pidx]);
        const double mag = dexp(lr * dt); double sn, cn; dsincos(li * dt, sn, cn);
        const double are = mag * cn, aim = mag * sn, den = lr * lr + li * li, nre = are - 1.0;
        const double fre = (nre * lr + aim * li) / den, fim = (aim * lr - nre * li) / den;
        if (q == 0) { float* ab = (float*)(ws + WS_ABAR) + (size_t)i * 2; ab[0] = (float)are; ab[1] = (float)aim; }
        bf16* bm = (bf16*)(ws + WS_BMAT) + (size_t)pidx * 128 * 16;
        bf16* cm = (bf16*)(ws + WS_CMAT) + (size_t)pidx * 16 * 128;
        const double br = (double)a.in[8][(size_t)i * 16 + q], bi = (double)a.in[9][(size_t)i * 16 + q];
        bm[n * 16 + q] = (bf16)f2bf((float)(fre * br - fim * bi));
        bm[(64 + n) * 16 + q] = (bf16)f2bf((float)(fre * bi + fim * br));
        *(unsigned*)(cm + q * 128 + 2 * n) = pk2(a.in[10][((size_t)pidx * 16 + q) * 64 + n], -a.in[11][((size_t)pidx * 16 + q) * 64 + n]);
    }
    for (int R = gw; R < TPR; R += NGW) {
        const int mrow = R - NREAL;
        const float* src = R < NREAL ? a.in[0] + (size_t)R * DM : a.in[1] + (size_t)(mrow & 15) * DM;
        float* dst = R < NREAL ? a.out + (size_t)R * DM : (float*)(ws + WS_HM) + (size_t)mrow * DM;
        bf16* hb = (bf16*)(ws + WS_HB) + (size_t)R * DM;
        const bool pad = mrow >= NB * NMETA;
        float ss = 0.f;
#pragma unroll
        for (int j = 0; j < 4; ++j) {
            f32x4 v = *(const f32x4*)(src + 4 * lane + 256 * j);
            if (pad) v = (f32x4){0.f, 0.f, 0.f, 0.f};
            ss += (v[0] * v[0] + v[1] * v[1]) + (v[2] * v[2] + v[3] * v[3]);
            u32x2 w; w.x = pk2(v[0], v[1]); w.y = pk2(v[2], v[3]);
            *(u32x2*)(hb + 4 * lane + 256 * j) = w;
        }
#pragma unroll
        for (int o = 1; o < 64; o <<= 1) ss += __shfl_xor(ss, o);
        if (lane < 16) ((float*)(ws + WS_RS))[((size_t)(lane >> 2) * TPR + R) * 4 + (lane & 3)] = lane == 0 ? ss : 0.f;
    }
}

__device__ __forceinline__ void ssm_task(LAS unsigned char* lds, int task, int layer, const bf16* SU, float* YF,
                                         const float* abar_all, const bf16* bmat_all, const bf16* cmat_all) {
    int tid_l = threadIdx.x; asm volatile("" : "+v"(tid_l));
    const int tid = tid_l, lane = tid & 63, wave = __builtin_amdgcn_readfirstlane(tid >> 6);
    const int b = task >> 5, g = task & 31;
    __syncthreads();
    LAS float* BU = (LAS float*)(lds + wave * 12800);
    LAS unsigned short* X = (LAS unsigned short*)(lds + wave * 12800 + 8448);
    LAS float* SX = (LAS float*)(lds + 8 * 12800);
    const int blk0 = wave == 0 ? 0 : 16 * wave + 1, nblk = wave == 0 ? 17 : 16;
    bf16* yfb = (bf16*)YF + (size_t)task * LL * 16;
    const int fr = lane & 15, fq = lane >> 4;
    const bf16x8 zero8 = {0, 0, 0, 0, 0, 0, 0, 0};
    for (int dir = 0; dir < 2; ++dir) {
        const int pidx = (layer * 2 + dir) * 32 + g;
        const float are = abar_all[((size_t)pidx * 64 + lane) * 2], aim = abar_all[((size_t)pidx * 64 + lane) * 2 + 1];
        bf16x8 bfr[8], cfr[4];
        const bf16* bm = bmat_all + (size_t)pidx * 128 * 16;
#pragma unroll
        for (int nt = 0; nt < 8; ++nt) bfr[nt] = fq < 2 ? *(const bf16x8*)(bm + (nt * 16 + fr) * 16 + 8 * fq) : zero8;
        const bf16* cm = cmat_all + (size_t)pidx * 16 * 128;
#pragma unroll
        for (int ks = 0; ks < 4; ++ks) cfr[ks] = *(const bf16x8*)(cm + fr * 128 + ks * 32 + 8 * fq);
        float p16r = are, p16i = aim;
#pragma unroll
        for (int i = 0; i < 4; ++i) { const float tr = p16r * p16r - p16i * p16i, ti = 2.f * p16r * p16i; p16r = tr; p16i = ti; }
        float p256r = p16r, p256i = p16i;
#pragma unroll
        for (int i = 0; i < 4; ++i) { const float tr = p256r * p256r - p256i * p256i, ti = 2.f * p256r * p256i; p256r = tr; p256i = ti; }
        const float p272r = p256r * p16r - p256i * p16i, p272i = p256r * p16i + p256i * p16r;

        float xre = 0.f, xim = 0.f;
        for (int pass = 0; pass < 2; ++pass) {
            bf16x8 unext;
            { const int blkf = dir == 0 ? blk0 : blk0 + nblk - 1; const int Rf = blkf == 0 ? NREAL + b * NMETA : b * SEQ + blkf * 16 - NMETA;
              unext = fq < 2 ? *(const bf16x8*)(SU + (size_t)(Rf + fr) * 512 + g * 16 + 8 * fq) : zero8; }
            for (int ib = 0; ib < nblk; ++ib) {
                const int blk = dir == 0 ? blk0 + ib : blk0 + nblk - 1 - ib;
                const bf16x8 ufr = unext;
                if (ib + 1 < nblk) { const int blkn = dir == 0 ? blk + 1 : blk - 1; const int Rn = blkn == 0 ? NREAL + b * NMETA : b * SEQ + blkn * 16 - NMETA;
                    unext = fq < 2 ? *(const bf16x8*)(SU + (size_t)(Rn + fr) * 512 + g * 16 + 8 * fq) : zero8; }
                f32x4 dd[8];
#pragma unroll
                for (int nt = 0; nt < 8; ++nt) { dd[nt] = (f32x4){0.f, 0.f, 0.f, 0.f}; dd[nt] = __builtin_amdgcn_mfma_f32_16x16x32_bf16(ufr, bfr[nt], dd[nt], 0, 0, 0); }
                asm volatile("s_nop 15\n\ts_nop 15" : "+v"(dd[0]), "+v"(dd[1]), "+v"(dd[2]), "+v"(dd[3]), "+v"(dd[4]), "+v"(dd[5]), "+v"(dd[6]), "+v"(dd[7]));
#pragma unroll
                for (int nt = 0; nt < 8; ++nt)
#pragma unroll
                    for (int r = 0; r < 4; ++r) BU[(4 * fq + r) * 132 + nt * 16 + fr] = dd[nt][r];
                LDS_FENCE();
                float bur[16], bui[16];
#pragma unroll
                for (int i = 0; i < 16; ++i) { const int tt = dir == 0 ? i : 15 - i; bur[i] = BU[tt * 132 + lane]; bui[i] = BU[tt * 132 + 64 + lane]; }
                if (pass == 0) {
#pragma unroll
                    for (int i = 0; i < 16; ++i) {
                        const float bre = bur[i], bim = bui[i];
                        const float nr = are * xre - aim * xim + bre, ni = are * xim + aim * xre + bim; xre = nr; xim = ni;
                    }
                    LDS_FENCE();
                } else {
#pragma unroll
                    for (int i = 0; i < 16; ++i) {
                        const int tt = dir == 0 ? i : 15 - i;
                        const float bre = bur[i], bim = bui[i];
                        const float nr = are * xre - aim * xim + bre, ni = are * xim + aim * xre + bim; xre = nr; xim = ni;
                        *(LAS unsigned*)(X + tt * 136 + 2 * lane) = pk2(xre, xim);
                    }
                    LDS_FENCE();
                    f32x4 y = {0.f, 0.f, 0.f, 0.f};
#pragma unroll
                    for (int ks = 0; ks < 4; ++ks) {
                        const bf16x8 afr = *(const LAS bf16x8*)(X + fr * 136 + ks * 32 + 8 * fq);
                        y = __builtin_amdgcn_mfma_f32_16x16x32_bf16(afr, cfr[ks], y, 0, 0, 0);
                    }
                    asm volatile("s_nop 15\n\ts_nop 15" : "+v"(y));
                    LDS_FENCE();
                    {
                        bf16* yd = yfb + (size_t)dir * 256 * LL * 16;
#pragma unroll
                        for (int r = 0; r < 4; ++r) yd[(size_t)(blk * 16 + 4 * fq + r) * 16 + fr] = (bf16)f2bf(y[r]);
                    }
                }
            }
            if (pass == 0) {
                SX[(wave * 64 + lane) * 2] = xre; SX[(wave * 64 + lane) * 2 + 1] = xim;
                LDS_FENCE(); __syncthreads();
                float cre = 0.f, cim = 0.f;
                if (dir == 0) {
                    for (int w = 0; w < wave; ++w) { const float pr = w == 0 ? p272r : p256r, pi = w == 0 ? p272i : p256i;
                        const float sr = SX[(w * 64 + lane) * 2], si = SX[(w * 64 + lane) * 2 + 1];
                        const float nr = pr * cre - pi * cim + sr, ni = pr * cim + pi * cre + si; cre = nr; cim = ni; }
                } else {
                    for (int w = 7; w > wave; --w) {
                        const float sr = SX[(w * 64 + lane) * 2], si = SX[(w * 64 + lane) * 2 + 1];
                        const float nr = p256r * cre - p256i * cim + sr, ni = p256r * cim + p256i * cre + si; cre = nr; cim = ni; }
                }
                xre = cre; xim = cim;
            }
        }
        LDS_FENCE(); __syncthreads();
    }
}

constexpr int ATT_KROW = 72, ATT_VROW = 40, ATT_KT = 32 * ATT_KROW * 2  , ATT_VT = 64 * ATT_VROW * 2  , ATT_MAXT = 11, ATT_VOFF = ATT_MAXT * ATT_KT;
static_assert(ATT_VOFF + ATT_MAXT * ATT_VT <= 131072, "attention LDS");
__device__ __forceinline__ void attn_task(LAS unsigned char* lds, int task, const bf16* Q, const bf16* K, const bf16* V, bf16* YA, const float* sink) {
    int tid_l = threadIdx.x; asm volatile("" : "+v"(tid_l));
    const int tid = tid_l, lane = tid & 63, wave = __builtin_amdgcn_readfirstlane(tid >> 6);
    const int qb = task < 512 ? (task & 31) : 32, bh = task < 512 ? (task >> 5) : task - 512, h = bh & 1, b = bh >> 1;
    const int l0 = qb * 64;
    __syncthreads();
    int jlo = (l0 - 128) >> 5; if (jlo < 1) jlo = 1;
    int jhi = (l0 + 191) >> 5; if (jhi > 64) jhi = 64;
    const int ntiles = 1 + (jhi - jlo + 1);
    LAS unsigned short* Ks = (LAS unsigned short*)lds;
    LAS unsigned short* Vs = (LAS unsigned short*)(lds + ATT_VOFF);
    for (int idx = tid; idx < ntiles * 32 * 8; idx += 512) {
        const int ch = idx & 7, key = idx >> 3, slot = key >> 5, kk = key & 31;
        const int lk = (slot == 0 ? 0 : (jlo + slot - 1) * 32) + kk;
        u32x4 kv = {0u, 0u, 0u, 0u}, vv = {0u, 0u, 0u, 0u};
        if (lk < LL) { const size_t R = (size_t)tok_row(b, lk);
            kv = *(const u32x4*)(K + R * 128 + h * 64 + ch * 8); vv = *(const u32x4*)(V + R * 128 + h * 64 + ch * 8); }
        *(LAS u32x4*)(Ks + slot * (ATT_KT / 2) + kk * ATT_KROW + ch * 8) = kv;
        LAS unsigned short* vd = Vs + slot * (ATT_VT / 2) + (ch * 8) * ATT_VROW + kk;
        vd[0 * ATT_VROW] = (unsigned short)(vv.x & 0xffffu); vd[1 * ATT_VROW] = (unsigned short)(vv.x >> 16);
        vd[2 * ATT_VROW] = (unsigned short)(vv.y & 0xffffu); vd[3 * ATT_VROW] = (unsigned short)(vv.y >> 16);
        vd[4 * ATT_VROW] = (unsigned short)(vv.z & 0xffffu); vd[5 * ATT_VROW] = (unsigned short)(vv.z >> 16);
        vd[6 * ATT_VROW] = (unsigned short)(vv.w & 0xffffu); vd[7 * ATT_VROW] = (unsigned short)(vv.w >> 16);
    }
    LDS_FENCE(); __syncthreads();
    const int head = h * 4 + (wave >> 1), r32 = lane & 31, hi = lane >> 5;
    const int lq = l0 + 32 * (wave & 1) + r32;
    const bool qvalid = lq < LL;
    const size_t Rq = (size_t)tok_row(b, qvalid ? lq : LL - 1);
    bf16x8 qf[4];
#pragma unroll
    for (int ks = 0; ks < 4; ++ks) qf[ks] = *(const bf16x8*)(Q + Rq * 512 + head * 64 + ks * 16 + 8 * hi);
    float mrun = sink[head], lsum = hi == 0 ? 1.0f : 0.0f;
    f32x16 o0, o1;
#pragma unroll
    for (int i = 0; i < 16; ++i) { o0[i] = 0.f; o1[i] = 0.f; }
    const int lqw = l0 + 32 * (wave & 1);
    for (int slot = 0; slot < ntiles; ++slot) {
        const int kbase = slot == 0 ? 0 : (jlo + slot - 1) * 32;
        if (lqw >= LL || (slot != 0 && (kbase + 31 < lqw - 128 || kbase > lqw + 31 + 128))) continue;
        const LAS unsigned short* kt = Ks + slot * (ATT_KT / 2);
        f32x16 s;
#pragma unroll
        for (int i = 0; i < 16; ++i) s[i] = 0.f;
#pragma unroll
        for (int ks = 0; ks < 4; ++ks) {
            const bf16x8 kf = *(const LAS bf16x8*)(kt + r32 * ATT_KROW + ks * 16 + 8 * hi);
            s = __builtin_amdgcn_mfma_f32_32x32x16_bf16(kf, qf[ks], s, 0, 0, 0);
        }
        asm volatile("s_nop 15\n\ts_nop 15" : "+v"(s));
        float mt = -1e30f;
#pragma unroll
        for (int i = 0; i < 16; ++i) {
            const int lk = kbase + (i & 3) + 8 * (i >> 2) + 4 * hi;
            int d = lq - lk; d = d < 0 ? -d : d;
            const bool valid = (lk < NMETA) || (d <= 128 && lk < LL);
            s[i] = valid ? s[i] : -1e30f;
            mt = fmaxf(mt, s[i]);
        }
        mt = fmaxf(mt, __shfl_xor(mt, 32));
        const float mnew = fmaxf(mrun, mt);
        const float alpha = __expf(mrun - mnew);
        mrun = mnew;
        float ps = 0.f;
#pragma unroll
        for (int i = 0; i < 16; ++i) { s[i] = __expf(s[i] - mnew); ps += s[i]; }
        lsum = lsum * alpha + ps;
#pragma unroll
        for (int i = 0; i < 16; ++i) { o0[i] *= alpha; o1[i] *= alpha; }
        const LAS unsigned short* vt = Vs + slot * (ATT_VT / 2);
#pragma unroll
        for (int s2 = 0; s2 < 2; ++s2) {
            union { bf16x8 v; unsigned u[4]; } pf;
            pf.u[0] = pk2(s[8 * s2 + 0], s[8 * s2 + 1]); pf.u[1] = pk2(s[8 * s2 + 2], s[8 * s2 + 3]);
            pf.u[2] = pk2(s[8 * s2 + 4], s[8 * s2 + 5]); pf.u[3] = pk2(s[8 * s2 + 6], s[8 * s2 + 7]);
#pragma unroll
            for (int dt = 0; dt < 2; ++dt) {
                union { bf16x8 v; u32x2 u[2]; } vf;
                const LAS unsigned short* vp = vt + (dt * 32 + r32) * ATT_VROW + 16 * s2 + 4 * hi;
                vf.u[0] = *(const LAS u32x2*)(vp); vf.u[1] = *(const LAS u32x2*)(vp + 8);
                if (dt == 0) o0 = __builtin_amdgcn_mfma_f32_32x32x16_bf16(vf.v, pf.v, o0, 0, 0, 0);
                else o1 = __builtin_amdgcn_mfma_f32_32x32x16_bf16(vf.v, pf.v, o1, 0, 0, 0);
            }
        }
    }
    asm volatile("s_nop 15\n\ts_nop 15" : "+v"(o0), "+v"(o1));
    lsum += __shfl_xor(lsum, 32);
    const float inv = 1.0f / lsum;
    if (qvalid) {
#pragma unroll
        for (int g4 = 0; g4 < 4; ++g4) {
            u32x2 w0, w1;
            w0.x = pk2(o0[4 * g4] * inv, o0[4 * g4 + 1] * inv); w0.y = pk2(o0[4 * g4 + 2] * inv, o0[4 * g4 + 3] * inv);
            w1.x = pk2(o1[4 * g4] * inv, o1[4 * g4 + 1] * inv); w1.y = pk2(o1[4 * g4 + 2] * inv, o1[4 * g4 + 3] * inv);
            *(u32x2*)(YA + Rq * 512 + head * 64 + 8 * g4 + 4 * hi) = w0;
            *(u32x2*)(YA + Rq * 512 + head * 64 + 32 + 8 * g4 + 4 * hi) = w1;
        }
    }
    __syncthreads();
}

__device__ __forceinline__ void pool_diff(LAS unsigned char* lds, const bf16* PU, bf16* PD) {
    int tl_ = threadIdx.x; asm volatile("" : "+v"(tl_));
    constexpr int TOK = 65, HALO = 8, ROWS = TOK + 2 * HALO, NTOK = NB * LL;
    for (int blk = blockIdx.x; blk * TOK < NTOK; blk += gridDim.x) {
        const int f0 = blk * TOK;
        __syncthreads();
        for (int i = tl_; i < ROWS * 64; i += 512) {
            const int r = i >> 6, ch = i & 63, f = f0 - HALO + r;
            u32x4 v = {0u, 0u, 0u, 0u};
            if (f >= 0 && f < NTOK) { const int b = f / LL, l = f % LL; v = *(const u32x4*)(PU + (size_t)tok_row(b, l) * 512 + ch * 8); }
            *(LAS u32x4*)(lds + (size_t)i * 16) = v;
        }
        LDS_FENCE(); __syncthreads();
        for (int i = tl_; i < TOK * 64; i += 512) {
            const int t = i >> 6, ch = i & 63, f = f0 + t;
            if (f >= NTOK) continue;
            const int b = f / LL, l = f % LL, half = 1 << (ch >> 4);
            const int lo = l - half < 0 ? 0 : l - half, hh = l + half > LL ? LL : l + half;
            float s[8];
#pragma unroll
            for (int j = 0; j < 8; ++j) s[j] = 0.f;
            for (int lp = lo; lp < hh; ++lp) {
                const u32x4 v = *(const LAS u32x4*)(lds + (size_t)((t + HALO + lp - l) * 64 + ch) * 16);
                s[0] += bf2f(v.x & 0xffffu); s[1] += bf2f(v.x >> 16); s[2] += bf2f(v.y & 0xffffu); s[3] += bf2f(v.y >> 16);
                s[4] += bf2f(v.z & 0xffffu); s[5] += bf2f(v.z >> 16); s[6] += bf2f(v.w & 0xffffu); s[7] += bf2f(v.w >> 16);
            }
            const float ic = 1.0f / (float)(hh - lo);
            const u32x4 v = *(const LAS u32x4*)(lds + (size_t)((t + HALO) * 64 + ch) * 16);
            u32x4 o;
            o.x = pk2(s[0] * ic - bf2f(v.x & 0xffffu), s[1] * ic - bf2f(v.x >> 16)); o.y = pk2(s[2] * ic - bf2f(v.y & 0xffffu), s[3] * ic - bf2f(v.y >> 16));
            o.z = pk2(s[4] * ic - bf2f(v.z & 0xffffu), s[5] * ic - bf2f(v.z >> 16)); o.w = pk2(s[6] * ic - bf2f(v.w & 0xffffu), s[7] * ic - bf2f(v.w >> 16));
            *(u32x4*)(PD + (size_t)tok_row(b, l) * 512 + ch * 8) = o;
        }
    }
    __syncthreads();
}

__device__ __forceinline__ void z_pass(const float* YF, const bf16* SU, const float* dskip, bf16* Z) {
    int tl_ = threadIdx.x; asm volatile("" : "+v"(tl_)); const int gt = blockIdx.x * 512 + tl_, NGT = gridDim.x * 512;
    for (int i = gt; i < NB * LL * 64; i += NGT) {
        const int ch = i & 63, tk = i >> 6, b = tk / LL, l = tk % LL, g = ch >> 1;
        const size_t R = (size_t)tok_row(b, l);
        const bf16* yp = (const bf16*)YF + ((size_t)(b * 32 + g) * LL + l) * 16 + (ch & 1) * 8;
        const u32x4 ya = *(const u32x4*)yp, yb = *(const u32x4*)(yp + (size_t)256 * LL * 16);
        f32x4 y0, y1;
        y0[0] = bf2f(ya.x & 0xffffu) + bf2f(yb.x & 0xffffu); y0[1] = bf2f(ya.x >> 16) + bf2f(yb.x >> 16); y0[2] = bf2f(ya.y & 0xffffu) + bf2f(yb.y & 0xffffu); y0[3] = bf2f(ya.y >> 16) + bf2f(yb.y >> 16);
        y1[0] = bf2f(ya.z & 0xffffu) + bf2f(yb.z & 0xffffu); y1[1] = bf2f(ya.z >> 16) + bf2f(yb.z >> 16); y1[2] = bf2f(ya.w & 0xffffu) + bf2f(yb.w & 0xffffu); y1[3] = bf2f(ya.w >> 16) + bf2f(yb.w >> 16);
        const f32x4 d0 = *(const f32x4*)(dskip + ch * 8), d1 = *(const f32x4*)(dskip + ch * 8 + 4);
        const u32x4 uu = *(const u32x4*)(SU + R * 512 + ch * 8);
        float t[8];
        t[0] = y0[0] + d0[0] * bf2f(uu.x & 0xffffu); t[1] = y0[1] + d0[1] * bf2f(uu.x >> 16); t[2] = y0[2] + d0[2] * bf2f(uu.y & 0xffffu); t[3] = y0[3] + d0[3] * bf2f(uu.y >> 16);
        t[4] = y1[0] + d1[0] * bf2f(uu.z & 0xffffu); t[5] = y1[1] + d1[1] * bf2f(uu.z >> 16); t[6] = y1[2] + d1[2] * bf2f(uu.w & 0xffffu); t[7] = y1[3] + d1[3] * bf2f(uu.w >> 16);
#pragma unroll
        for (int j = 0; j < 8; ++j) {
            const float v = t[j], tt = __builtin_amdgcn_rcpf(fabsf(v) * 0.2316418882f + 1.0f);
            float q = tt * 0.5307027145f + (-0.7265760135f); q = q * tt + 0.7107068705f; q = q * tt + (-0.142248368f); q = q * tt + 0.127414796f; q = q * tt;
            const float m = v * (q * __builtin_amdgcn_exp2f(v * v * (-0.72134752044f)));
            t[j] = v < 0.f ? m : v - m;
        }
        u32x4 o; o.x = pk2(t[0], t[1]); o.y = pk2(t[2], t[3]); o.z = pk2(t[4], t[5]); o.w = pk2(t[6], t[7]);
        *(u32x4*)(Z + R * 512 + ch * 8) = o;
    }
}

#define XB_TMO      128
#define XB_XCNT(j)  (256  + 64 * (j))
#define XB_XSUB(j)  (1280 + 64 * (j))
#define XB_XGEN(j)  (2304 + 64 * (j))
#define XB_TOP      3328
#define XB_TOPGEN   3392
#define XCD_BAR_WORDS 3456
#define XB_SPIN_CAP (1u << 18)

__device__ __forceinline__ unsigned xb_ld(unsigned* p)              { return __hip_atomic_load(p, __ATOMIC_RELAXED, __HIP_MEMORY_SCOPE_AGENT); }
__device__ __forceinline__ unsigned xb_add(unsigned* p, unsigned v) { return __hip_atomic_fetch_add(p, v, __ATOMIC_RELAXED, __HIP_MEMORY_SCOPE_AGENT); }
__device__ __forceinline__ unsigned xb_xcc_id() { return (unsigned)__builtin_amdgcn_s_getreg((3 << 11) | 20) & 0xFu; }
#define XB_SPIN(cond, bar) do { unsigned _sp = 0; while (cond) { __builtin_amdgcn_s_sleep(1); \
    if ((++_sp & 255u) == 0u) { if (xb_ld(&(bar)[XB_TMO])) break; if (_sp > XB_SPIN_CAP) { atomicAdd(&(bar)[XB_TMO], 1u); break; } } } } while (0)

struct XcdBarrier {
    unsigned* bar; unsigned x;
    volatile LAS unsigned* st;
};

__device__ __forceinline__ XcdBarrier xcd_barrier_post(unsigned* bar, volatile LAS unsigned* st) {
    XcdBarrier b; b.bar = bar; b.x = xb_xcc_id(); b.st = st;
    if (threadIdx.x == 0) (void)xb_add(&bar[XB_XCNT(b.x)], 1u);
    return b;
}
__device__ __forceinline__ void xcd_barrier_complete(unsigned* bar, unsigned x, unsigned& nloc, unsigned& nx) {
    const unsigned G = gridDim.x * gridDim.y * gridDim.z;
    unsigned sum, cnt, mine, sp = 0u;
    for (;;) {
        sum = 0u; cnt = 0u; mine = 0u;
#pragma unroll
        for (unsigned j = 0; j < 16; ++j) { const unsigned c = xb_ld(&bar[XB_XCNT(j)]); sum += c; cnt += (c > 0u) ? 1u : 0u; mine = (j == x) ? c : mine; }
        if (sum == G) break;
        __builtin_amdgcn_s_sleep(1);
        if ((++sp & 255u) == 0u) { if (xb_ld(&bar[XB_TMO])) break; if (sp > XB_SPIN_CAP) { atomicAdd(&bar[XB_TMO], 1u); break; } }
    }
    nloc = mine > 0u ? mine : 1u; nx = cnt > 0u ? cnt : 1u;
}

__device__ __forceinline__ void xcd_barrier(const XcdBarrier& b) {
    asm volatile("s_waitcnt vmcnt(0)" ::: "memory");
    __syncthreads();
    if (threadIdx.x == 0) {
        unsigned* bar = b.bar;
        __builtin_amdgcn_s_waitcnt(0);
        unsigned nloc = b.st[0], nx = b.st[1];
        if (nloc == 0u) { xcd_barrier_complete(bar, b.x, nloc, nx); b.st[0] = nloc; b.st[1] = nx; }
        const unsigned old = xb_add(&bar[XB_XSUB(b.x)], 1u);
        const unsigned gen = old / nloc;
        if (old + 1u == (gen + 1u) * nloc) {
            __builtin_amdgcn_fence(__ATOMIC_RELEASE, "agent");
            asm volatile("s_waitcnt vmcnt(0)" ::: "memory");
            const unsigned og = xb_add(&bar[XB_TOP], 1u);
            const unsigned tg = og / nx;
            if (og + 1u == (tg + 1u) * nx) xb_add(&bar[XB_TOPGEN], 1u);
            else XB_SPIN(xb_ld(&bar[XB_TOPGEN]) == tg, bar);
            __builtin_amdgcn_fence(__ATOMIC_ACQUIRE, "agent");
            xb_add(&bar[XB_XGEN(b.x)], 1u);
            asm volatile("s_waitcnt vmcnt(0)" ::: "memory");
        } else {
            XB_SPIN(xb_ld(&bar[XB_XGEN(b.x)]) == gen, bar);
            __builtin_amdgcn_fence(__ATOMIC_ACQUIRE, "agent");
            asm volatile("s_waitcnt vmcnt(0)" ::: "memory");
        }
    }
    __syncthreads();
}

#ifndef MK_ALIGN
#define MK_ALIGN true
#endif
#ifndef MK_SP2
#define MK_SP2 true
#endif
#ifndef MK_SPLIT
#define MK_SPLIT 0
#endif
#ifndef MK_NLAYER
#define MK_NLAYER 2
#endif
constexpr int NPL = 8, NPHASE = 1 + 2 * NPL + 1, PH_FINAL = NPHASE - 1;

#define KARGS() ({ auto kp_ = __builtin_amdgcn_kernarg_segment_ptr(); asm volatile("" : "+s"(kp_)); (KArgsP)kp_; })
__global__ void __launch_bounds__(512, 2) fwd_kernel(Args a_unused, int ph_lo, int ph_hi) {
    (void)a_unused;
    extern __shared__ __attribute__((aligned(16))) unsigned char lds_raw[];
    LAS unsigned char* lds = (LAS unsigned char*)lds_raw;
    const int G = gridDim.x, bid = blockIdx.x;
#if MK_SPLIT
#define GRID_SYNC() do {} while (0)
    (void)lds;
#else
#define CG_SYNC() do { asm volatile("s_waitcnt vmcnt(0)" ::: "memory"); __syncthreads(); \
    if (threadIdx.x == 0) { __builtin_amdgcn_fence(__ATOMIC_RELEASE, "agent"); asm volatile("s_waitcnt vmcnt(0)" ::: "memory"); } \
    __syncthreads(); grid.sync(); \
    if (threadIdx.x == 0) { __builtin_amdgcn_fence(__ATOMIC_ACQUIRE, "agent"); asm volatile("s_waitcnt vmcnt(0)" ::: "memory"); } \
    __syncthreads(); } while (0)
    cg::grid_group grid = cg::this_grid();
    unsigned* barw = (unsigned*)(KARGS()->ws + WS_CTL);
    if (bid == 0) for (int i = threadIdx.x; i < XCD_BAR_WORDS; i += 512) __hip_atomic_store(barw + i, 0u, __ATOMIC_RELAXED, __HIP_MEMORY_SCOPE_AGENT);
    volatile LAS unsigned* xst = (volatile LAS unsigned*)(lds + LDS_BYTES - 64);
    if (threadIdx.x < 2) xst[threadIdx.x] = 0u;
    CG_SYNC();
    const XcdBarrier xbar = xcd_barrier_post(barw, xst);
#define GRID_SYNC() xcd_barrier(xbar)

#endif
#ifndef PHMASK
#define PHMASK 0xFFFFu
#endif
#define IN(k) (((PHMASK >> ((k) == 0 ? 0 : (k) == PH_FINAL ? 9 : 1 + ((k) - 1) % NPL)) & 1u) && ph_lo <= (k) && (k) < ph_hi)
#define SEAM(k) do { if (IN(k) && (k) + 1 < ph_hi) GRID_SYNC(); } while (0)
#define PHASE_BEGIN() KArgsP ka = KARGS(); unsigned char* ws = ka->ws; asm volatile("" : "+s"(ws)); float* rowss = (float*)(ws + WS_RS); float* Hm = (float*)(ws + WS_HM); bf16* HB = (bf16*)(ws + WS_HB); unsigned char* wl = ws + WS_W + (size_t)layer * LW_BYTES; \
    const int MT = NREAL; const bool META = layer != MK_NLAYER - 1;     \
    const float* rs_mix = rowss + (size_t)(2 * layer) * TPR * 16; float* rs_mlp = rowss + (size_t)(2 * layer + 1) * TPR * 16; float* rs_next = rowss + (size_t)(2 * layer + 2) * TPR * 16; (void)MT; (void)META; (void)Hm; (void)HB; (void)wl; (void)rs_mix; (void)rs_mlp; (void)rs_next;

    if (IN(0)) {
        { int tl_ = threadIdx.x; asm volatile("" : "+v"(tl_)); const int wv = __builtin_amdgcn_readfirstlane(tl_ >> 6);
          convert_layer_weights(KARGS(), lds, 0, bid * 8 + wv, G * 8, wv, tl_ & 63, 0); }
        Args al; { KArgsP kp = KARGS(); for (int i = 0; i < 23; ++i) al.in[i] = kp->in[i]; al.out = kp->out; al.ws = kp->ws; } p0_prologue(al, lds); }
    SEAM(0);
#ifndef MK_NLAYER
#define MK_NLAYER 2
#endif
#ifndef MK_RSIDX
#define MK_RSIDX 4
#endif
#pragma unroll 1
    for (int layer = 0; layer < MK_NLAYER; ++layer) {
        const int p = 1 + NPL * layer;
        if (IN(p)) { PHASE_BEGIN();
            pg8::Gemm g{HB, (const bf16*)(wl + OW_IN), TPR, NPROJ, DM}; pg8::StaticOrder S; S.init(TPR, NPROJ, G, bid);
            EpiInProj E{rs_mix, (const float*)(ws + WS_ROPE), (bf16*)(ws + WS_Q), (bf16*)(ws + WS_K), (bf16*)(ws + WS_V), (bf16*)(ws + WS_SU), (bf16*)(ws + WS_PU)};
            pg8::gemm_phase<EpiInProj, pg8::StaticOrder, MK_ALIGN, MK_SP2>(lds, g, S, E);
        }
        SEAM(p);
        if (IN(p + 1)) { PHASE_BEGIN();
            for (int t = bid; t < 256; t += G)
                ssm_task(lds, t, layer, (const bf16*)(ws + WS_SU), (float*)(ws + WS_YF), (const float*)(ws + WS_ABAR), (const bf16*)(ws + WS_BMAT), (const bf16*)(ws + WS_CMAT));
            for (int t = bid; t < NB * 2 * 33; t += G)
                attn_task(lds, t, (const bf16*)(ws + WS_Q), (const bf16*)(ws + WS_K), (const bf16*)(ws + WS_V), (bf16*)ka->out, ka->in[4] + layer * 8);
            pool_diff(lds, (const bf16*)(ws + WS_PU), (bf16*)(ws + WS_PD));
            {
                int tl_ = threadIdx.x; asm volatile("" : "+v"(tl_)); const int wv = __builtin_amdgcn_readfirstlane(tl_ >> 6);
                convert_layer_weights(ka, lds, layer, bid * 8 + wv, G * 8, wv, tl_ & 63, 1);
                if (layer + 1 < MK_NLAYER) convert_layer_weights(ka, lds, layer + 1, bid * 8 + wv, G * 8, wv, tl_ & 63, 0);
                __syncthreads();
            }
        }
        SEAM(p + 1);
        if (IN(p + 2)) { PHASE_BEGIN();
            z_pass((const float*)(ws + WS_YF), (const bf16*)(ws + WS_SU), ka->in[12] + layer * 512, (bf16*)(ws + WS_Z));
        }
        SEAM(p + 2);
        if (IN(p + 3)) { PHASE_BEGIN();
            const int hg = G >> 1;
            if (bid < hg) { pg8::Gemm g{(const bf16*)(ws + WS_Z), (const bf16*)(wl + OW_GLU), MT, 512, 512}; pg8::StaticOrder S; S.init(MT, 512, hg, bid);
              EpiGlu E{(const bf16*)(ws + WS_Z), ka->in[14] + layer * 512, (bf16*)ka->out + (size_t)TPR * 512};
              pg8::gemm_phase<EpiGlu, pg8::StaticOrder, MK_ALIGN, MK_SP2>(lds, g, S, E); if (META) thin_gemm<EpiGlu>(lds, g.A, g.Bt, g.K, g.N, E, bid, hg); }
            else { pg8::Gemm g{(const bf16*)(ws + WS_PD), (const bf16*)(wl + OW_POOL), MT, 512, 512}; pg8::StaticOrder S; S.init(MT, 512, G - hg, bid - hg);
              EpiScale E{(bf16*)ka->out + (size_t)2 * TPR * 512, 512, ka->in[16] + layer * 512};
              pg8::gemm_phase<EpiScale, pg8::StaticOrder, MK_ALIGN, MK_SP2>(lds, g, S, E); if (META) thin_gemm<EpiScale>(lds, g.A, g.Bt, g.K, g.N, E, bid - hg, G - hg); }
        }
        SEAM(p + 3);
        if (IN(p + 4)) { PHASE_BEGIN();
            bf16* Y3 = (bf16*)ka->out;
            bf16* BR0 = (bf16*)(ws + WS_X), *BR1 = (bf16*)(ws + WS_X + 4 * UU), *BR2 = (bf16*)(ws + WS_X + 6 * UU);
            const bf16* Wbr = (const bf16*)(wl + OW_BR); const bf16* Wg = (const bf16*)(wl + OW_IN) + (size_t)NPROJ * DM; bf16* MG = (bf16*)(ws + WS_MG);
            { pg8::Gemm g{Y3, Wbr, 3 * TPR, 3072, 512}; TripleOrder S; S.init(G, bid, TPR / 256, 4);
              EpiBr3 E{BR0, TPR / 256};
              pg8::gemm_phase<EpiBr3, TripleOrder, MK_ALIGN, MK_SP2>(lds, g, S, E); }
            { pg8::Gemm g{HB, Wg, MT, 3072, DM}; TripleOrder S; S.init(G, bid, 0, 4);
              EpiGate3 E{rs_mix, BR0, MG};
              pg8::gemm_phase<EpiGate3, TripleOrder, MK_ALIGN, MK_SP2>(lds, g, S, E); }
            if (META) {
                bf16* GBm = (bf16*)(ws + WS_HM) - (size_t)NREAL * 1024;
#pragma unroll 1
                for (int c = 0; c < 3; ++c) {
                    const int vb = (bid - 64 * c) & 255;
                    bf16* BRc = BR0 + (size_t)(2 * c + 2 * (c > 0)) * (UU / 2);
                    { EpiScale E{BRc, 1024, nullptr}; thin_gemm<EpiScale>(lds, Y3 + (size_t)c * TPR * 512, Wbr + (size_t)c * 1024 * 512, 512, 1024, E, vb, 256); }
                    { EpiGate<true> E{rs_mix, BRc, GBm + (size_t)c * 128 * 1024}; thin_gemm<EpiGate<true>>(lds, HB, Wg + (size_t)c * 1024 * DM, DM, 1024, E, vb, 256); }
                }
            }
        }
        SEAM(p + 4);
        if (IN(p + 5)) { PHASE_BEGIN();
            pg8::Gemm g{(const bf16*)(ws + WS_MG), (const bf16*)(wl + OW_OUT), MT, DM, DM}; pg8::StaticOrder S; S.init(MT, DM, G, bid);
            EpiRes E{(const float*)nullptr, HB, rs_mlp};
            pg8::gemm_phase<EpiRes, pg8::StaticOrder, MK_ALIGN, MK_SP2>(lds, g, S, E); if (META) thin_gemm<EpiRes, true>(lds, (const bf16*)(ws + WS_HM) - (size_t)NREAL * 1024, g.Bt, g.K, g.N, E, bid, G, (size_t)128 * 1024);
        }
        SEAM(p + 5);
        if (IN(p + 6)) { PHASE_BEGIN();
            pg8::Gemm g{HB, (const bf16*)(wl + OW_UP), MT, FF, DM}; pg8::StaticOrder S; S.init(MT, FF, G, bid);
            EpiUp E{rs_mlp, (bf16*)(ws + WS_ACT)};
            pg8::gemm_phase<EpiUp, pg8::StaticOrder, MK_ALIGN, MK_SP2>(lds, g, S, E); if (META) thin_gemm<EpiUp>(lds, g.A, g.Bt, g.K, g.N, E, bid, G);
        }
        SEAM(p + 6);
        if (IN(p + 7)) { PHASE_BEGIN();
            pg8::Gemm g{(const bf16*)(ws + WS_ACT), (const bf16*)(wl + OW_DN), MT, DM, FF}; pg8::StaticOrder S; S.init(MT, DM, G, bid);
            EpiRes E{(const float*)nullptr, HB, rs_next};
            pg8::gemm_phase<EpiRes, pg8::StaticOrder, MK_ALIGN, MK_SP2>(lds, g, S, E); if (META) thin_gemm<EpiRes>(lds, g.A, g.Bt, g.K, g.N, E, bid, G);
        }
        SEAM(p + 7);
    }
#ifdef MK_DUMP_OFF
    if (IN(PH_FINAL)) { KArgsP ka = KARGS();
        const bf16* src = (const bf16*)(ka->ws + (MK_DUMP_OFF)); const bf16* src2 = (const bf16*)(ka->ws + (MK_DUMP_OFF2));
        for (int i = bid * 512 + threadIdx.x; i < NREAL * 1024; i += G * 512) { const int R = MK_DUMP_ROW(i >> 10), c = i & 1023; ka->out[i] = c < 512 ? bf2f(src[(size_t)R * (MK_DUMP_LD) + (c % (MK_DUMP_LD))]) : bf2f(src2[(size_t)R * (MK_DUMP_LD2) + (c % (MK_DUMP_LD2))]); }
    }
#else
    if (IN(PH_FINAL)) { KArgsP ka = KARGS();
        const float* rs = (const float*)(ka->ws + WS_RS) + (size_t)MK_RSIDX * TPR * 16; const float* gain = ka->in[22];
        int tl_ = threadIdx.x; asm volatile("" : "+v"(tl_));
        for (int i = bid * 512 + tl_; i < NREAL * 256; i += G * 512) {
            const int R = i >> 8, c4 = (i & 255) * 4;
            const float r = row_rstd(rs, R);
            const u32x2 hb = *(const u32x2*)((const bf16*)(ka->ws + WS_HB) + (size_t)R * DM + c4); const f32x4 gn = *(const f32x4*)(gain + c4);
            f32x4 v = {bf2f(hb.x & 0xffffu), bf2f(hb.x >> 16), bf2f(hb.y & 0xffffu), bf2f(hb.y >> 16)};
            v = v * r * gn;
            *(f32x4*)(ka->out + (size_t)R * DM + c4) = v;
        }
    }
#endif
#undef IN
#undef SEAM
}

extern "C" void kernel_launch(void* const* d_in, const int* in_sizes, int n_in, void* d_out, int out_size, void* d_ws, size_t ws_size, hipStream_t stream) {
    static int grid = 0;
    if (grid == 0) {
        if (n_in != 23 || out_size != NREAL * DM || ws_size < WS_END) { fprintf(stderr, "kernel_launch: unexpected shapes (n_in %d out %d ws %zu)\n", n_in, out_size, ws_size); grid = -1; return; }
        int dev = 0, cus = 0, per_cu = 0;
        hipGetDevice(&dev); hipDeviceGetAttribute(&cus, hipDeviceAttributeMultiprocessorCount, dev);
        if (hipFuncSetAttribute((const void*)fwd_kernel, hipFuncAttributeMaxDynamicSharedMemorySize, LDS_BYTES) != hipSuccess) { fprintf(stderr, "kernel_launch: hipFuncSetAttribute failed\n"); grid = -1; return; }
        if (hipOccupancyMaxActiveBlocksPerMultiprocessor(&per_cu, (const void*)fwd_kernel, 512, LDS_BYTES) != hipSuccess || per_cu < 1) { fprintf(stderr, "kernel_launch: occupancy query gave %d\n", per_cu); per_cu = 1; }
        (void)hipGetLastError();
        grid = cus * (per_cu > 1 ? 1 : per_cu);
        if (grid <= 0) grid = 256;
    }
    if (grid < 0) return;
    Args a{};
    for (int i = 0; i < 23; ++i) a.in[i] = (const float*)d_in[i];
    a.out = (float*)d_out; a.ws = (unsigned char*)d_ws;
#if MK_SPLIT
    for (int ph = 0; ph < NPHASE; ++ph) hipLaunchKernelGGL(fwd_kernel, dim3(grid), dim3(512), LDS_BYTES, stream, a, ph, ph + 1);
#else
    int lo = 0, hi = NPHASE;
    void* kargs[] = {(void*)&a, (void*)&lo, (void*)&hi};
    hipError_t e = hipLaunchCooperativeKernel((const void*)fwd_kernel, dim3(grid), dim3(512), kargs, LDS_BYTES, stream);
    if (e != hipSuccess) fprintf(stderr, "kernel_launch: cooperative launch failed: %s (grid %d)\n", hipGetErrorString(e), grid);
#endif
}
```

```cpp
#include <hip/hip_runtime.h>
#include <hip/hip_cooperative_groups.h>
#include <cstdio>
#include <cstdint>
namespace cg = cooperative_groups;
namespace pg8 {
#define PG8_LAS __attribute__((address_space(3)))
typedef unsigned short bf16_t;
typedef short bf16x8 __attribute__((ext_vector_type(8)));
typedef float f32x4 __attribute__((ext_vector_type(4)));
typedef unsigned u32x4 __attribute__((ext_vector_type(4)));
constexpr int BM = 256, BK = 64, HALF = 128, HTB = HALF * BK * 2  , STAGE_BYTES = 8 * HTB, NXCD = 8, WGM = 8;

__host__ __device__ __forceinline__ int lds_byte(int r, int c) { const int st = (r >> 4) * 2 + (c >> 5), rr = r & 15, cc = c & 31, ob = rr * 64 + cc * 2; return st * 1024 + (ob ^ (((ob >> 9) & 1) << 5)); }
__host__ __device__ __forceinline__ void stage_rc(int b, int& R, int& C) { const int st = b / 1024, sb = b % 1024, swz = sb ^ (((sb >> 9) & 1) << 5); R = (st >> 1) * 16 + swz / 64; C = (st & 1) * 32 + (swz % 64) / 2; }
__host__ __device__ __forceinline__ int perm32(int rho) { const int n = rho >> 4, i = rho & 15; return 8 * (i >> 2) + 4 * n + (i & 3); }

struct Unit { int pm, pn; };
struct Gemm { const bf16_t* A; const bf16_t* Bt; int M, N, K; };

struct StaticOrder {
    int nM, nN, nwg, G, c;
    __host__ __device__ void init(int M, int N, int G_, int c_) { nM = M / BM; nN = N / BM; nwg = nM * nN; G = G_; c = c_; }
    __host__ __device__ __forceinline__ bool next(int i, Unit& u) const {
        const long L = (long)i * G + c; if (L >= nwg) return false;
        int wgid = (int)L; { const int q = nwg / NXCD, r = nwg % NXCD, xcd = wgid % NXCD, off = wgid / NXCD; wgid = (xcd < r ? xcd * (q + 1) : r * (q + 1) + (xcd - r) * q) + off; }
        const int nig = WGM * nN, gid = wgid / nig, fm = gid * WGM, gsz = (nM - fm) < WGM ? (nM - fm) : WGM;
        u.pm = fm + ((wgid % nig) % gsz); u.pn = (wgid % nig) / gsz; return true;
    }
    __device__ __forceinline__ void a_ready(const Unit&) const {}
    __device__ __forceinline__ void done(const Unit&) const {}
};

__device__ __forceinline__ unsigned cvt_pk_bf16(float lo, float hi) { unsigned r; asm volatile("v_cvt_pk_bf16_f32 %0, %1, %2" : "=v"(r) : "v"(lo), "v"(hi)); return r; }
template <class Epi, class Sched, bool ALIGN_EPI = false, bool SP2 = false>
__device__ __forceinline__ void gemm_phase(PG8_LAS unsigned char* lds, const Gemm g, const Sched& S, const Epi& E) {
    int tid_l = threadIdx.x; asm volatile("" : "+v"(tid_l));
    const int tid = tid_l, wid = __builtin_amdgcn_readfirstlane(tid >> 6), lane = tid & 63, wr = wid >> 2, wc = wid & 3, fr = lane & 15, fq = lane >> 4;
    const int K = g.K, nt = K / BK;
    unsigned voffA[2], voffB[2];
#pragma unroll
    for (int i = 0; i < 2; ++i) { int R, C; stage_rc(tid * 16 + i * 8192, R, C); const int Rb = Epi::PERM ? ((R & ~31) + perm32(R & 31)) : R;
        voffA[i] = (unsigned)(R * K + C) * 2u; voffB[i] = (unsigned)(Rb * K + C) * 2u; }
    const size_t kstep = (size_t)(BK * 2);
    const size_t hstep = (size_t)HALF * K * 2;
    const size_t tstep = 2 * hstep;
    const unsigned ldsw = (unsigned)wid * 1024u;
    const int aoff = lds_byte(wr * 64 + fr, fq * 8), boff = lds_byte(wc * 32 + fr, fq * 8);
#define PG8_SA(b, h) (((b) * 2 + (h)) * HTB)
#define PG8_SB(b, h) ((4 + (b) * 2 + (h)) * HTB)
#define PG8_STAGE(bufoff, gbase, voff) do { _Pragma("unroll") for (int _i = 0; _i < 2; ++_i) \
        __builtin_amdgcn_global_load_lds((const unsigned*)((const char*)(gbase) + (voff)[_i]), (PG8_LAS unsigned*)(lds + (bufoff) + ldsw + _i * 8192), 16, 0, 0); } while (0)
#define PG8_LDA(dst, b, h) do { _Pragma("unroll") for (int m = 0; m < 4; ++m) _Pragma("unroll") for (int k = 0; k < 2; ++k) dst[m][k] = *(const PG8_LAS bf16x8*)(lds + PG8_SA(b, h) + aoff + m * 2048 + k * 1024); } while (0)
#define PG8_LDB(dst, b, h) do { _Pragma("unroll") for (int n = 0; n < 2; ++n) _Pragma("unroll") for (int k = 0; k < 2; ++k) dst[n][k] = *(const PG8_LAS bf16x8*)(lds + PG8_SB(b, h) + boff + n * 2048 + k * 1024); } while (0)
#define PG8_MMA(ai, bj, At, Bt) do { __builtin_amdgcn_s_setprio(1); _Pragma("unroll") for (int m = 0; m < 4; ++m) _Pragma("unroll") for (int n = 0; n < 2; ++n) _Pragma("unroll") for (int k = 0; k < 2; ++k) \
        acc[ai][bj][m][n] = __builtin_amdgcn_mfma_f32_16x16x32_bf16(Bt[n][k], At[m][k], acc[ai][bj][m][n], 0, 0, 0); __builtin_amdgcn_s_setprio(0); } while (0)
#define PG8_WAIT_V(n) asm volatile("s_waitcnt vmcnt(" #n ")" ::: "memory")
#define PG8_WAIT_L(n) asm volatile("s_waitcnt lgkmcnt(" #n ")" ::: "memory")
#define PG8_BAR __builtin_amdgcn_s_barrier()
#define PG8_SCHED __builtin_amdgcn_sched_barrier(0)
    Unit cur, nxt; int ui = 0;
    if (!S.next(0, cur)) return;
    f32x4 acc[2][2][4][2];
#pragma unroll
    for (int a = 0; a < 2; ++a)
#pragma unroll
        for (int b = 0; b < 2; ++b)
#pragma unroll
            for (int m = 0; m < 4; ++m)
#pragma unroll
                for (int n = 0; n < 2; ++n) acc[a][b][m][n] = (f32x4){0.f, 0.f, 0.f, 0.f};
    bf16x8 At[4][2], B0[2][2], B1[2][2];
    const char* cA = (const char*)g.A + (size_t)cur.pm * tstep; const char* cB = (const char*)g.Bt + (size_t)cur.pn * tstep;
    S.a_ready(cur);
    if constexpr (SP2) {
        PG8_STAGE(PG8_SB(0, 0), cB, voffB); PG8_STAGE(PG8_SB(0, 1), cB + hstep, voffB); PG8_STAGE(PG8_SA(0, 0), cA, voffA); PG8_STAGE(PG8_SA(0, 1), cA + hstep, voffA);
        if (wr == 1) PG8_BAR;
        PG8_WAIT_V(2); PG8_BAR;
        PG8_STAGE(PG8_SB(1, 0), cB + kstep, voffB); PG8_STAGE(PG8_SA(1, 0), cA + kstep, voffA); PG8_STAGE(PG8_SB(1, 1), cB + hstep + kstep, voffB);
        PG8_WAIT_V(6); PG8_BAR;
    } else {
        PG8_STAGE(PG8_SB(0, 0), cB, voffB); PG8_STAGE(PG8_SA(0, 0), cA, voffA); PG8_STAGE(PG8_SB(0, 1), cB + hstep, voffB); PG8_STAGE(PG8_SA(0, 1), cA + hstep, voffA);
        if (wr == 1) PG8_BAR;
        PG8_WAIT_V(4); PG8_BAR;
        PG8_STAGE(PG8_SB(1, 0), cB + kstep, voffB); PG8_STAGE(PG8_SA(1, 0), cA + kstep, voffA); PG8_STAGE(PG8_SB(1, 1), cB + hstep + kstep, voffB);
        PG8_WAIT_V(6); PG8_BAR;
    }
    for (;;) {
        const bool has_next = S.next(ui + 1, nxt);
        const char* nA = has_next ? (const char*)g.A + (size_t)nxt.pm * tstep : cA; const char* nB = has_next ? (const char*)g.Bt + (size_t)nxt.pn * tstep : cB;
        for (int t = 0; t < nt; t += 2) {
            const bool last = (t == nt - 2);
            const char* a1 = cA + (size_t)(t + 1) * kstep;
            const char* a2 = last ? nA : cA + (size_t)(t + 2) * kstep; const char* b2 = last ? nB : cB + (size_t)(t + 2) * kstep;
            const char* a3 = a2 + kstep; const char* b3 = b2 + kstep;
            if (last && has_next) S.a_ready(nxt);
            if constexpr (SP2) {
            PG8_LDB(B0, 0, 0); PG8_LDB(B1, 0, 1); PG8_SCHED; PG8_LDA(At, 0, 0); PG8_STAGE(PG8_SA(1, 1), a1 + hstep, voffA);
            PG8_WAIT_V(8); PG8_WAIT_L(0); PG8_BAR; PG8_MMA(0, 0, At, B0); PG8_MMA(0, 1, At, B1); PG8_BAR; PG8_SCHED;
            PG8_LDA(At, 0, 1); PG8_STAGE(PG8_SB(0, 0), b2, voffB); PG8_STAGE(PG8_SB(0, 1), b2 + hstep, voffB); PG8_STAGE(PG8_SA(0, 0), a2, voffA);
            PG8_WAIT_V(8); PG8_WAIT_L(0); PG8_BAR; PG8_MMA(1, 0, At, B0); PG8_MMA(1, 1, At, B1); PG8_BAR; PG8_SCHED;
            PG8_LDB(B0, 1, 0); PG8_LDB(B1, 1, 1); PG8_SCHED; PG8_LDA(At, 1, 0); PG8_STAGE(PG8_SA(0, 1), a2 + hstep, voffA);
            PG8_WAIT_V(8); PG8_WAIT_L(0); PG8_BAR; PG8_MMA(0, 0, At, B0); PG8_MMA(0, 1, At, B1); PG8_BAR; PG8_SCHED;
            PG8_LDA(At, 1, 1); PG8_STAGE(PG8_SB(1, 0), b3, voffB); PG8_STAGE(PG8_SB(1, 1), b3 + hstep, voffB); PG8_STAGE(PG8_SA(1, 0), a3, voffA);
            PG8_WAIT_V(8); PG8_WAIT_L(0); PG8_BAR; PG8_MMA(1, 0, At, B0); PG8_MMA(1, 1, At, B1); PG8_BAR; PG8_SCHED;
            } else {
            PG8_LDB(B0, 0, 0); PG8_SCHED; PG8_LDA(At, 0, 0); PG8_STAGE(PG8_SA(1, 1), a1 + hstep, voffA);
            PG8_WAIT_L(8); PG8_BAR; PG8_WAIT_L(0); PG8_MMA(0, 0, At, B0); PG8_BAR; PG8_SCHED;
            PG8_LDB(B1, 0, 1); PG8_STAGE(PG8_SB(0, 0), b2, voffB);
            PG8_BAR; PG8_WAIT_L(0); PG8_MMA(0, 1, At, B1); PG8_BAR;
            PG8_LDA(At, 0, 1); PG8_STAGE(PG8_SA(0, 0), a2, voffA);
            PG8_BAR; PG8_WAIT_L(0); PG8_MMA(1, 0, At, B0); PG8_BAR; PG8_SCHED;
            PG8_STAGE(PG8_SB(0, 1), b2 + hstep, voffB);
            PG8_WAIT_V(6); PG8_BAR; PG8_MMA(1, 1, At, B1); PG8_BAR;
            PG8_LDB(B0, 1, 0); PG8_SCHED; PG8_LDA(At, 1, 0); PG8_STAGE(PG8_SA(0, 1), a2 + hstep, voffA);
            PG8_WAIT_L(8); PG8_BAR; PG8_WAIT_L(0); PG8_MMA(0, 0, At, B0); PG8_BAR; PG8_SCHED;
            PG8_LDB(B1, 1, 1); PG8_STAGE(PG8_SB(1, 0), b3, voffB);
            PG8_BAR; PG8_WAIT_L(0); PG8_MMA(0, 1, At, B1); PG8_BAR;
            PG8_LDA(At, 1, 1); PG8_STAGE(PG8_SA(1, 0), a3, voffA);
            PG8_BAR; PG8_WAIT_L(0); PG8_MMA(1, 0, At, B0); PG8_BAR; PG8_SCHED;
            PG8_STAGE(PG8_SB(1, 1), b3 + hstep, voffB);
            PG8_WAIT_V(6); PG8_BAR; PG8_MMA(1, 1, At, B1); PG8_BAR;
            }
        }
        if constexpr (ALIGN_EPI) { if (wr == 0) PG8_BAR; }
        asm volatile("s_nop 15\n\ts_nop 15" ::: "memory");
        if constexpr (!Epi::AFTER_DRAIN) { E(acc, cur, wr, wc, fr, fq); S.done(cur); }
        if (!has_next) break;
#pragma unroll
        for (int a = 0; a < 2; ++a)
#pragma unroll
            for (int b = 0; b < 2; ++b)
#pragma unroll
                for (int m = 0; m < 4; ++m)
#pragma unroll
                    for (int n = 0; n < 2; ++n) acc[a][b][m][n] = (f32x4){0.f, 0.f, 0.f, 0.f};
        cur = nxt; cA = nA; cB = nB; ++ui;
        if constexpr (ALIGN_EPI) { if (wr == 1) PG8_BAR; }
    }
    PG8_WAIT_V(0);
    if constexpr (!ALIGN_EPI) { if (wr == 0) PG8_BAR; }
    PG8_BAR;
    if constexpr (Epi::AFTER_DRAIN) { E.fused(acc, cur, wr, wc, fr, fq, lds, wid, lane); S.done(cur); }
#undef PG8_SA
#undef PG8_SB
#undef PG8_STAGE
#undef PG8_LDA
#undef PG8_LDB
#undef PG8_MMA
#undef PG8_WAIT_V
#undef PG8_WAIT_L
#undef PG8_BAR
#undef PG8_SCHED
}
}

#define LAS __attribute__((address_space(3)))
typedef unsigned short bf16;
typedef short bf16x8 __attribute__((ext_vector_type(8)));
typedef float f32x4 __attribute__((ext_vector_type(4)));
typedef float f32x16 __attribute__((ext_vector_type(16)));
typedef unsigned u32x2 __attribute__((ext_vector_type(2)));
typedef unsigned u32x4 __attribute__((ext_vector_type(4)));

constexpr int NB = 8, SEQ = 2048, NMETA = 16, LL = 2064, DM = 1024, FF = 4096, DIN = 4864, NPROJ = 1792;
constexpr int NREAL = NB * SEQ;
constexpr int TPR = NREAL + 256;
constexpr int LDS_BYTES = 147456;

constexpr size_t MiB = 1u << 20;
constexpr size_t WS_CTL = 0;
constexpr size_t WS_ROPE = 1 * MiB;
constexpr size_t WS_ABAR = 2 * MiB;
constexpr size_t WS_BMAT = 2 * MiB + 65536;
constexpr size_t WS_CMAT = WS_BMAT + 524288;
constexpr size_t WS_HM = 4 * MiB;
constexpr size_t WS_W = 5 * MiB;
constexpr size_t OW_IN = 0, OW_GLU = (size_t)DIN * DM * 2, OW_POOL = OW_GLU + 512 * 512 * 2, OW_BR = OW_POOL + 512 * 512 * 2,
                 OW_OUT = OW_BR + 3 * 1024 * 512 * 2, OW_UP = OW_OUT + 1024 * 1024 * 2, OW_DN = OW_UP + (size_t)FF * DM * 2, LW_BYTES = OW_DN + (size_t)FF * DM * 2;
constexpr size_t WS_HB = 68 * MiB;
constexpr size_t WS_X = 101 * MiB;
constexpr size_t UU = (size_t)TPR * 512 * 2;
constexpr size_t WS_YF = WS_X, WS_YP = WS_X, WS_Q = WS_X + 2 * UU, WS_K = WS_Q + UU, WS_V = WS_K + UU / 4, WS_MG = WS_X + 2 * UU,
                 WS_SU = WS_X + 4 * UU, WS_YA = WS_X + 8 * UU  , WS_PU = WS_X + 5 * UU, WS_YS = WS_PU, WS_Z = WS_X + 6 * UU, WS_PD = WS_X + 7 * UU, WS_BR = WS_Z, WS_ACT = WS_X;
constexpr size_t WS_RS = WS_X + 9 * UU;
constexpr size_t WS_END = WS_RS + (size_t)5 * TPR * 16 * 4;
static_assert(WS_W + 2 * LW_BYTES <= WS_HB && WS_HB + (size_t)TPR * 1024 * 2 <= WS_X && WS_END <= 256 * MiB, "ws map");
static_assert((size_t)256 * 2064 * 16 * 4 <= 2 * UU, "YF fits");

__device__ __forceinline__ unsigned pk2(float lo, float hi) { unsigned r; asm("v_cvt_pk_bf16_f32 %0, %1, %2" : "=v"(r) : "v"(lo), "v"(hi)); return r; }
__device__ __forceinline__ unsigned f2bf(float f) { return pk2(f, 0.f) & 0xffffu; }
__device__ __forceinline__ float bf2f(unsigned b) { return __uint_as_float(b << 16); }
__device__ __forceinline__ int tok_row(int b, int l) { return l >= NMETA ? b * SEQ + l - NMETA : NREAL + b * NMETA + l; }
#define LDS_FENCE() asm volatile("s_waitcnt lgkmcnt(0)" ::: "memory")
#define SSM_SYNC() do { asm volatile("s_waitcnt vmcnt(0) lgkmcnt(0)" ::: "memory"); __syncthreads(); } while (0)
__device__ __forceinline__ float row_rstd(const float* rs, int R) {
    const f32x4 a = *(const f32x4*)(rs + (size_t)R * 4), b = *(const f32x4*)(rs + ((size_t)TPR + R) * 4), c = *(const f32x4*)(rs + ((size_t)2 * TPR + R) * 4), d = *(const f32x4*)(rs + ((size_t)3 * TPR + R) * 4);
    const float s = (((a[0] + a[1]) + (a[2] + a[3])) + ((b[0] + b[1]) + (b[2] + b[3]))) + (((c[0] + c[1]) + (c[2] + c[3])) + ((d[0] + d[1]) + (d[2] + d[3])));
    return rsqrtf(s * (1.0f / 1024.0f) + 1e-6f);
}

__device__ __forceinline__ void dsincos(double a, double& s, double& c) {
    const double q = rint(a * 0.63661977236758134308);
    double r = fma(-q, 1.57079632679489655800e+00, a); r = fma(-q, 6.12323399573676603587e-17, r);
    const double r2 = r * r;
    double sp = -7.6471637318198164759e-13; sp = fma(sp, r2, 1.6059043836821614599e-10); sp = fma(sp, r2, -2.5052108385441718775e-08); sp = fma(sp, r2, 2.7557319223985890653e-06);
    sp = fma(sp, r2, -1.9841269841269841270e-04); sp = fma(sp, r2, 8.3333333333333333333e-03); sp = fma(sp, r2, -1.6666666666666666667e-01); sp = fma(sp * r2, r, r);
    double cp = 4.7794773323873852974e-14; cp = fma(cp, r2, -1.1470745597729724714e-11); cp = fma(cp, r2, 2.0876756987868098979e-09); cp = fma(cp, r2, -2.7557319223985890653e-07);
    cp = fma(cp, r2, 2.4801587301587301587e-05); cp = fma(cp, r2, -1.3888888888888888889e-03); cp = fma(cp, r2, 4.1666666666666666667e-02); cp = fma(cp, r2, -0.5); cp = fma(cp, r2, 1.0);
    const int qi = ((int)q) & 3;
    s = (qi == 0) ? sp : (qi == 1) ? cp : (qi == 2) ? -sp : -cp;
    c = (qi == 0) ? cp : (qi == 1) ? -sp : (qi == 2) ? -cp : sp;
}
__device__ __forceinline__ double dexp(double x) {
    const double k = rint(x * 1.44269504088896340736);
    double r = fma(-k, 6.93147180369123816490e-01, x); r = fma(-k, 1.90821492927058770002e-10, r);
    double p = 1.0 / 6227020800.0; p = fma(p, r, 1.0 / 479001600.0); p = fma(p, r, 1.0 / 39916800.0); p = fma(p, r, 1.0 / 3628800.0); p = fma(p, r, 1.0 / 362880.0); p = fma(p, r, 1.0 / 40320.0);
    p = fma(p, r, 1.0 / 5040.0); p = fma(p, r, 1.0 / 720.0); p = fma(p, r, 1.0 / 120.0); p = fma(p, r, 1.0 / 24.0); p = fma(p, r, 1.0 / 6.0); p = fma(p, r, 0.5); p = fma(p, r, 1.0); p = fma(p, r, 1.0);
    const long long bits = ((long long)(1023 + (int)k)) << 52;
    return p * __longlong_as_double(bits);
}

struct EpiInProj {
    static constexpr bool PERM = true, AFTER_DRAIN = false;
    const float* rowss; const float* rope; bf16 *Q, *K, *V, *SU, *PU;
    __device__ __forceinline__ u32x2 quad(int l, int c, const f32x4& v) const {
        u32x2 w;
        if (c < 640) {
            const int i0 = (c & 63) >> 1;
            const f32x4 cs = *(const f32x4*)(rope + ((size_t)l * 32 + i0) * 2);
            float o0 = v[0] * cs[0] - v[1] * cs[1], o1 = v[1] * cs[0] + v[0] * cs[1], o2 = v[2] * cs[2] - v[3] * cs[3], o3 = v[3] * cs[2] + v[2] * cs[3];
            if (c < 512) { o0 *= 0.125f; o1 *= 0.125f; o2 *= 0.125f; o3 *= 0.125f; }
            w.x = pk2(o0, o1); w.y = pk2(o2, o3);
        } else { w.x = pk2(v[0], v[1]); w.y = pk2(v[2], v[3]); }
        return w;
    }
    __device__ __forceinline__ void operator()(const f32x4 (&acc)[2][2][4][2], const pg8::Unit& u, int wr, int wc, int fr, int fq) const {
#pragma unroll
        for (int ai = 0; ai < 2; ++ai)
#pragma unroll
            for (int m = 0; m < 4; ++m) {
                const int R = u.pm * 256 + ai * 128 + wr * 64 + m * 16 + fr;
                const float rs = row_rstd(rowss, R);
                const int l = R < NREAL ? (R & 2047) + NMETA : (R & 15);
#pragma unroll
                for (int bj = 0; bj < 2; ++bj) {
                    const int c = u.pn * 256 + bj * 128 + wc * 32 + 8 * fq;
                    const u32x2 w0 = quad(l, c, acc[ai][bj][m][0] * rs), w1 = quad(l, c + 4, acc[ai][bj][m][1] * rs);
                    u32x4 w; w.x = w0.x; w.y = w0.y; w.z = w1.x; w.w = w1.y;
                    bf16* dst = c < 512 ? Q + (size_t)R * 512 + c : c < 640 ? K + (size_t)R * 128 + (c - 512) : c < 768 ? V + (size_t)R * 128 + (c - 640)
                              : c < 1280 ? SU + (size_t)R * 512 + (c - 768) : PU + (size_t)R * 512 + (c - 1280);
                    *(u32x4*)dst = w;
                }
            }
    }
};
#define EPI_BODY() \
    __device__ __forceinline__ void rg(int R, int pn, int wc, int fq, const f32x4 (&a4)[2][2]) const { \
        _Pragma("unroll") for (int bj = 0; bj < 2; ++bj) q2(R, pn * 256 + bj * 128 + wc * 32 + 8 * fq, a4[bj][0], a4[bj][1]); } \
    __device__ __forceinline__ void tq(int R, int c, const f32x4& v) const { q(R, c, v); } \
    EPI_OP()
#define EPI_OP() \
    __device__ __forceinline__ void operator()(const f32x4 (&acc)[2][2][4][2], const pg8::Unit& u, int wr, int wc, int fr, int fq) const { \
        _Pragma("unroll") for (int ai = 0; ai < 2; ++ai) _Pragma("unroll") for (int m = 0; m < 4; ++m) { \
            const f32x4 a4[2][2] = {{acc[ai][0][m][0], acc[ai][0][m][1]}, {acc[ai][1][m][0], acc[ai][1][m][1]}}; \
            rg(u.pm * 256 + ai * 128 + wr * 64 + m * 16 + fr, u.pn, wc, fq, a4); } }
#define EPI_BODY_RS() \
    __device__ __forceinline__ void rg(int R, int pn, int wc, int fq, const f32x4 (&a4)[2][2]) const { const float rs = row_rstd(rowss, R); \
        _Pragma("unroll") for (int bj = 0; bj < 2; ++bj) q2(R, pn * 256 + bj * 128 + wc * 32 + 8 * fq, a4[bj][0], a4[bj][1], rs); } \
    __device__ __forceinline__ void tq(int R, int c, const f32x4& v) const { q(R, c, v, row_rstd(rowss, R)); } \
    EPI_OP()
struct EpiGlu {
    static constexpr bool PERM = true, AFTER_DRAIN = false;
    const bf16* Z; const float* bias; bf16* YS;
    __device__ __forceinline__ void q(int R, int c, const f32x4& a) const {
        const f32x4 v = a + *(const f32x4*)(bias + c);
        const u32x2 zz = *(const u32x2*)(Z + (size_t)R * 512 + c);
        const float z0 = bf2f(zz.x & 0xffffu), z1 = bf2f(zz.x >> 16), z2 = bf2f(zz.y & 0xffffu), z3 = bf2f(zz.y >> 16);
        u32x2 w; w.x = pk2(z0 * __builtin_amdgcn_rcpf(1.0f + __expf(-v[0])), z1 * __builtin_amdgcn_rcpf(1.0f + __expf(-v[1]))); w.y = pk2(z2 * __builtin_amdgcn_rcpf(1.0f + __expf(-v[2])), z3 * __builtin_amdgcn_rcpf(1.0f + __expf(-v[3])));
        *(u32x2*)(YS + (size_t)R * 512 + c) = w;
    }
    __device__ __forceinline__ void q2(int R, int c, const f32x4& a0, const f32x4& a1) const {
        const f32x4 v0 = a0 + *(const f32x4*)(bias + c), v1 = a1 + *(const f32x4*)(bias + c + 4);
        const u32x4 zz = *(const u32x4*)(Z + (size_t)R * 512 + c);
        u32x4 w;
        w.x = pk2(bf2f(zz.x & 0xffffu) * __builtin_amdgcn_rcpf(1.0f + __expf(-v0[0])), bf2f(zz.x >> 16) * __builtin_amdgcn_rcpf(1.0f + __expf(-v0[1])));
        w.y = pk2(bf2f(zz.y & 0xffffu) * __builtin_amdgcn_rcpf(1.0f + __expf(-v0[2])), bf2f(zz.y >> 16) * __builtin_amdgcn_rcpf(1.0f + __expf(-v0[3])));
        w.z = pk2(bf2f(zz.z & 0xffffu) * __builtin_amdgcn_rcpf(1.0f + __expf(-v1[0])), bf2f(zz.z >> 16) * __builtin_amdgcn_rcpf(1.0f + __expf(-v1[1])));
        w.w = pk2(bf2f(zz.w & 0xffffu) * __builtin_amdgcn_rcpf(1.0f + __expf(-v1[2])), bf2f(zz.w >> 16) * __builtin_amdgcn_rcpf(1.0f + __expf(-v1[3])));
        *(u32x4*)(YS + (size_t)R * 512 + c) = w;
    }
    EPI_BODY()
};
struct EpiScale {
    static constexpr bool PERM = true, AFTER_DRAIN = false;
    bf16* O; int ldc; const float* scale;
    __device__ __forceinline__ void q(int R, int c, const f32x4& a) const {
        f32x4 v = a;
        if (scale) v = v * *(const f32x4*)(scale + c);
        u32x2 w; w.x = pk2(v[0], v[1]); w.y = pk2(v[2], v[3]);
        *(u32x2*)(O + (size_t)R * ldc + c) = w;
    }
    __device__ __forceinline__ void q2(int R, int c, const f32x4& a0, const f32x4& a1) const {
        f32x4 v0 = a0, v1 = a1;
        if (scale) { v0 = v0 * *(const f32x4*)(scale + c); v1 = v1 * *(const f32x4*)(scale + c + 4); }
        u32x4 w; w.x = pk2(v0[0], v0[1]); w.y = pk2(v0[2], v0[3]); w.z = pk2(v1[0], v1[1]); w.w = pk2(v1[2], v1[3]);
        *(u32x4*)(O + (size_t)R * ldc + c) = w;
    }
    EPI_BODY()
};
template <bool FIRST> struct EpiGate {
    static constexpr bool PERM = true, AFTER_DRAIN = false;
    const float* rowss; const bf16* BR; bf16* MG;
    __device__ __forceinline__ void q(int R, int c, const f32x4& a, float rs) const {
        const f32x4 v = a * rs;
        const u32x2 bb = *(const u32x2*)(BR + (size_t)R * 1024 + c);
        float o0 = bf2f(bb.x & 0xffffu) * __builtin_amdgcn_rcpf(1.0f + __expf(-v[0])), o1 = bf2f(bb.x >> 16) * __builtin_amdgcn_rcpf(1.0f + __expf(-v[1]));
        float o2 = bf2f(bb.y & 0xffffu) * __builtin_amdgcn_rcpf(1.0f + __expf(-v[2])), o3 = bf2f(bb.y >> 16) * __builtin_amdgcn_rcpf(1.0f + __expf(-v[3]));
        if (!FIRST) { const u32x2 mm = *(const u32x2*)(MG + (size_t)R * 1024 + c);
            o0 += bf2f(mm.x & 0xffffu); o1 += bf2f(mm.x >> 16); o2 += bf2f(mm.y & 0xffffu); o3 += bf2f(mm.y >> 16); }
        u32x2 w; w.x = pk2(o0, o1); w.y = pk2(o2, o3);
        *(u32x2*)(MG + (size_t)R * 1024 + c) = w;
    }
    __device__ __forceinline__ void q2(int R, int c, const f32x4& a0, const f32x4& a1, float rs) const {
        const f32x4 v0 = a0 * rs, v1 = a1 * rs;
        const u32x4 bb = *(const u32x4*)(BR + (size_t)R * 1024 + c);
        float o[8];
        o[0] = bf2f(bb.x & 0xffffu) * __builtin_amdgcn_rcpf(1.0f + __expf(-v0[0])); o[1] = bf2f(bb.x >> 16) * __builtin_amdgcn_rcpf(1.0f + __expf(-v0[1]));
        o[2] = bf2f(bb.y & 0xffffu) * __builtin_amdgcn_rcpf(1.0f + __expf(-v0[2])); o[3] = bf2f(bb.y >> 16) * __builtin_amdgcn_rcpf(1.0f + __expf(-v0[3]));
        o[4] = bf2f(bb.z & 0xffffu) * __builtin_amdgcn_rcpf(1.0f + __expf(-v1[0])); o[5] = bf2f(bb.z >> 16) * __builtin_amdgcn_rcpf(1.0f + __expf(-v1[1]));
        o[6] = bf2f(bb.w & 0xffffu) * __builtin_amdgcn_rcpf(1.0f + __expf(-v1[2])); o[7] = bf2f(bb.w >> 16) * __builtin_amdgcn_rcpf(1.0f + __expf(-v1[3]));
        if (!FIRST) { const u32x4 mm = *(const u32x4*)(MG + (size_t)R * 1024 + c);
            o[0] += bf2f(mm.x & 0xffffu); o[1] += bf2f(mm.x >> 16); o[2] += bf2f(mm.y & 0xffffu); o[3] += bf2f(mm.y >> 16);
            o[4] += bf2f(mm.z & 0xffffu); o[5] += bf2f(mm.z >> 16); o[6] += bf2f(mm.w & 0xffffu); o[7] += bf2f(mm.w >> 16); }
        u32x4 w; w.x = pk2(o[0], o[1]); w.y = pk2(o[2], o[3]); w.z = pk2(o[4], o[5]); w.w = pk2(o[6], o[7]);
        *(u32x4*)(MG + (size_t)R * 1024 + c) = w;
    }
    EPI_BODY_RS()
};
struct EpiRes {
    static constexpr bool PERM = true, AFTER_DRAIN = false;
    const float* Xin; bf16* HB; float* rowss_out;
    __device__ __forceinline__ float q(int R, int c, const f32x4& a) const {
        f32x4 h;
        if (Xin && R < NREAL) h = *(const f32x4*)(Xin + (size_t)R * 1024 + c);
        else { const u32x2 hb = *(const u32x2*)(HB + (size_t)R * 1024 + c); h = (f32x4){bf2f(hb.x & 0xffffu), bf2f(hb.x >> 16), bf2f(hb.y & 0xffffu), bf2f(hb.y >> 16)}; }
        h = h + a;
        u32x2 w; w.x = pk2(h[0], h[1]); w.y = pk2(h[2], h[3]);
        *(u32x2*)(HB + (size_t)R * 1024 + c) = w;
        const float r0 = bf2f(w.x & 0xffffu), r1 = bf2f(w.x >> 16), r2 = bf2f(w.y & 0xffffu), r3 = bf2f(w.y >> 16);
        return (r0 * r0 + r1 * r1) + (r2 * r2 + r3 * r3);
    }
    __device__ __forceinline__ float q2(int R, int c, const f32x4& a0, const f32x4& a1) const {
        f32x4 h0, h1;
        if (Xin && R < NREAL) { h0 = *(const f32x4*)(Xin + (size_t)R * 1024 + c); h1 = *(const f32x4*)(Xin + (size_t)R * 1024 + c + 4); }
        else { const u32x4 hb = *(const u32x4*)(HB + (size_t)R * 1024 + c);
            h0 = (f32x4){bf2f(hb.x & 0xffffu), bf2f(hb.x >> 16), bf2f(hb.y & 0xffffu), bf2f(hb.y >> 16)}; h1 = (f32x4){bf2f(hb.z & 0xffffu), bf2f(hb.z >> 16), bf2f(hb.w & 0xffffu), bf2f(hb.w >> 16)}; }
        h0 = h0 + a0; h1 = h1 + a1;
        u32x4 w; w.x = pk2(h0[0], h0[1]); w.y = pk2(h0[2], h0[3]); w.z = pk2(h1[0], h1[1]); w.w = pk2(h1[2], h1[3]);
        *(u32x4*)(HB + (size_t)R * 1024 + c) = w;
        const float r0 = bf2f(w.x & 0xffffu), r1 = bf2f(w.x >> 16), r2 = bf2f(w.y & 0xffffu), r3 = bf2f(w.y >> 16), r4 = bf2f(w.z & 0xffffu), r5 = bf2f(w.z >> 16), r6 = bf2f(w.w & 0xffffu), r7 = bf2f(w.w >> 16);
        return ((r0 * r0 + r1 * r1) + (r2 * r2 + r3 * r3)) + ((r4 * r4 + r5 * r5) + (r6 * r6 + r7 * r7));
    }
    __device__ __forceinline__ void rg(int R, int pn, int wc, int fq, const f32x4 (&a4)[2][2]) const {
        float ss = 0.f;
#pragma unroll
        for (int bj = 0; bj < 2; ++bj) ss += q2(R, pn * 256 + bj * 128 + wc * 32 + 8 * fq, a4[bj][0], a4[bj][1]);
        ss += __shfl_xor(ss, 16); ss += __shfl_xor(ss, 32);
        if (fq == 0) rowss_out[((size_t)pn * TPR + R) * 4 + wc] = ss;
    }
    __device__ __forceinline__ void tq(int R, int c, const f32x4& v) const {
        float ss = q(R, c, v);
        ss += __shfl_xor(ss, 16); ss += __shfl_xor(ss, 32);
        if ((threadIdx.x & 48) == 0) atomicAdd(rowss_out + (size_t)R * 4, ss);
    }
    EPI_OP()
};
struct EpiUp {
    static constexpr bool PERM = true, AFTER_DRAIN = false;
    const float* rowss; bf16* ACT;
    __device__ __forceinline__ void q(int R, int c, const f32x4& a, float rs) const {
        f32x4 v = a * rs;
#pragma unroll
        for (int j = 0; j < 4; ++j) { const float r = fmaxf(v[j], 0.f); v[j] = r * r; }
        u32x2 w; w.x = pk2(v[0], v[1]); w.y = pk2(v[2], v[3]);
        *(u32x2*)(ACT + (size_t)R * FF + c) = w;
    }
    __device__ __forceinline__ void q2(int R, int c, const f32x4& a0, const f32x4& a1, float rs) const {
        f32x4 v0 = a0 * rs, v1 = a1 * rs;
#pragma unroll
        for (int j = 0; j < 4; ++j) { const float r0 = fmaxf(v0[j], 0.f), r1 = fmaxf(v1[j], 0.f); v0[j] = r0 * r0; v1[j] = r1 * r1; }
        u32x4 w; w.x = pk2(v0[0], v0[1]); w.y = pk2(v0[2], v0[3]); w.z = pk2(v1[0], v1[1]); w.w = pk2(v1[2], v1[3]);
        *(u32x4*)(ACT + (size_t)R * FF + c) = w;
    }
    EPI_BODY_RS()
};
struct TripleOrder {
    pg8::StaticOrder S0; int arow, bcol;
    __device__ __forceinline__ void init(int G, int c, int arow_, int bcol_) { S0.init(NREAL, 1024, G, c); arow = arow_; bcol = bcol_; }
    __device__ __forceinline__ bool next(int i, pg8::Unit& u) const { pg8::Unit t; t.pm = 0; t.pn = 0; if (!S0.next(i / 3, t)) return false; const int br = i % 3; u.pm = t.pm + br * arow; u.pn = t.pn + br * bcol; return true; }
    __device__ __forceinline__ void a_ready(const pg8::Unit&) const {}
    __device__ __forceinline__ void done(const pg8::Unit&) const {}
};
struct EpiBr3 {
    static constexpr bool PERM = true, AFTER_DRAIN = false;
    bf16* Bbase; int arow;
    __device__ __forceinline__ void operator()(const f32x4 (&acc)[2][2][4][2], const pg8::Unit& u, int wr, int wc, int fr, int fq) const {
        const int c = u.pn >> 2, pn = u.pn & 3, pm = u.pm - arow * c; bf16* O = Bbase + (size_t)(2 * c + 2 * (c > 0)) * (UU / 2);
#pragma unroll
        for (int ai = 0; ai < 2; ++ai)
#pragma unroll
            for (int m = 0; m < 4; ++m) { const int R = pm * 256 + ai * 128 + wr * 64 + m * 16 + fr;
#pragma unroll
                for (int bj = 0; bj < 2; ++bj) { const f32x4 v0 = acc[ai][bj][m][0], v1 = acc[ai][bj][m][1];
                    u32x4 w; w.x = pk2(v0[0], v0[1]); w.y = pk2(v0[2], v0[3]); w.z = pk2(v1[0], v1[1]); w.w = pk2(v1[2], v1[3]);
                    *(u32x4*)(O + (size_t)R * 1024 + pn * 256 + bj * 128 + wc * 32 + 8 * fq) = w; } }
    }
};
struct EpiGate3 {
    static constexpr bool PERM = true, AFTER_DRAIN = false;
    const float* rowss; const bf16* Bbase; bf16* MG;
    __device__ __forceinline__ void operator()(const f32x4 (&acc)[2][2][4][2], const pg8::Unit& u, int wr, int wc, int fr, int fq) const {
        const int c = u.pn >> 2, pn = u.pn & 3; const bf16* BR = Bbase + (size_t)(2 * c + 2 * (c > 0)) * (UU / 2);
#pragma unroll
        for (int ai = 0; ai < 2; ++ai)
#pragma unroll
            for (int m = 0; m < 4; ++m) { const int R = u.pm * 256 + ai * 128 + wr * 64 + m * 16 + fr; const float rs = row_rstd(rowss, R);
#pragma unroll
                for (int bj = 0; bj < 2; ++bj) { const int cc = pn * 256 + bj * 128 + wc * 32 + 8 * fq;
                    const f32x4 v0 = acc[ai][bj][m][0] * rs, v1 = acc[ai][bj][m][1] * rs;
                    const u32x4 bb = *(const u32x4*)(BR + (size_t)R * 1024 + cc);
                    float o[8];
                    o[0] = bf2f(bb.x & 0xffffu) * __builtin_amdgcn_rcpf(1.0f + __expf(-v0[0])); o[1] = bf2f(bb.x >> 16) * __builtin_amdgcn_rcpf(1.0f + __expf(-v0[1]));
                    o[2] = bf2f(bb.y & 0xffffu) * __builtin_amdgcn_rcpf(1.0f + __expf(-v0[2])); o[3] = bf2f(bb.y >> 16) * __builtin_amdgcn_rcpf(1.0f + __expf(-v0[3]));
                    o[4] = bf2f(bb.z & 0xffffu) * __builtin_amdgcn_rcpf(1.0f + __expf(-v1[0])); o[5] = bf2f(bb.z >> 16) * __builtin_amdgcn_rcpf(1.0f + __expf(-v1[1]));
                    o[6] = bf2f(bb.w & 0xffffu) * __builtin_amdgcn_rcpf(1.0f + __expf(-v1[2])); o[7] = bf2f(bb.w >> 16) * __builtin_amdgcn_rcpf(1.0f + __expf(-v1[3]));
                    if (c != 0) { const u32x4 mm = *(const u32x4*)(MG + (size_t)R * 1024 + cc);
                        o[0] += bf2f(mm.x & 0xffffu); o[1] += bf2f(mm.x >> 16); o[2] += bf2f(mm.y & 0xffffu); o[3] += bf2f(mm.y >> 16);
                        o[4] += bf2f(mm.z & 0xffffu); o[5] += bf2f(mm.z >> 16); o[6] += bf2f(mm.w & 0xffffu); o[7] += bf2f(mm.w >> 16); }
                    u32x4 w; w.x = pk2(o[0], o[1]); w.y = pk2(o[2], o[3]); w.z = pk2(o[4], o[5]); w.w = pk2(o[6], o[7]);
                    *(u32x4*)(MG + (size_t)R * 1024 + cc) = w; } }
    }
};
template <class Epi, bool SUM3 = false>
__device__ __forceinline__ void thin_gemm(LAS unsigned char* lds, const bf16* A, const bf16* Bt, int K, int N, const Epi& E, int vb, int vg, size_t asum_stride = 0) {
    int tid_l = threadIdx.x; asm volatile("" : "+v"(tid_l));
    const int lane = tid_l & 63, w = __builtin_amdgcn_readfirstlane(tid_l >> 6), fr = lane & 15, fq = lane >> 4;
    LAS f32x4* red = (LAS f32x4*)lds;
    const int kw = K >> 3;
    for (int pc = vb; pc < N / 16; pc += vg) {
        const bf16* ap = A + (size_t)(NREAL + fr) * K + w * kw + 8 * fq;
        const bf16* bp = Bt + (size_t)(16 * pc + fr) * K + w * kw + 8 * fq;
        f32x4 acc[8];
#pragma unroll
        for (int rb = 0; rb < 8; ++rb) acc[rb] = (f32x4){0.f, 0.f, 0.f, 0.f};
#pragma unroll (SUM3 ? 1 : 4)
        for (int k0 = 0; k0 < kw; k0 += 32) {
            const bf16x8 bf = *(const bf16x8*)(bp + k0);
            bf16x8 af[8];
#pragma unroll
            for (int rb = 0; rb < 8; ++rb) {
                if constexpr (!SUM3) af[rb] = *(const bf16x8*)(ap + (size_t)(16 * rb) * K + k0);
                else {
                    const bf16* a0 = ap + (size_t)(16 * rb) * K + k0;
                    const u32x4 x0 = *(const u32x4*)a0, x1 = *(const u32x4*)(a0 + asum_stride), x2 = *(const u32x4*)(a0 + 2 * asum_stride);
                    union { bf16x8 v; unsigned u[4]; } s;
                    const unsigned w0[4] = {x0.x, x0.y, x0.z, x0.w}, w1[4] = {x1.x, x1.y, x1.z, x1.w}, w2[4] = {x2.x, x2.y, x2.z, x2.w};
#pragma unroll
                    for (int j = 0; j < 4; ++j) s.u[j] = pk2((bf2f(w0[j] & 0xffffu) + bf2f(w1[j] & 0xffffu)) + bf2f(w2[j] & 0xffffu), (bf2f(w0[j] >> 16) + bf2f(w1[j] >> 16)) + bf2f(w2[j] >> 16));
                    af[rb] = s.v;
                }
            }
#pragma unroll
            for (int rb = 0; rb < 8; ++rb) acc[rb] = __builtin_amdgcn_mfma_f32_16x16x32_bf16(bf, af[rb], acc[rb], 0, 0, 0);
        }
        asm volatile("s_nop 15\n\ts_nop 15" : "+v"(acc[0]), "+v"(acc[1]), "+v"(acc[2]), "+v"(acc[3]), "+v"(acc[4]), "+v"(acc[5]), "+v"(acc[6]), "+v"(acc[7]));
#pragma unroll
        for (int rb = 0; rb < 8; ++rb) red[(w * 8 + rb) * 64 + lane] = acc[rb];
        LDS_FENCE(); __syncthreads();
        f32x4 v = red[(0 * 8 + w) * 64 + lane];
#pragma unroll
        for (int ww = 1; ww < 8; ++ww) v = v + red[(ww * 8 + w) * 64 + lane];
        LDS_FENCE(); __syncthreads();
        E.tq(NREAL + 16 * w + fr, 16 * pc + 4 * fq, v);
    }
}

struct Args { const float* in[23]; float* out; unsigned char* ws; };

__device__ __forceinline__ void p0_item(const float* W, int ldw, int K, const float* scale, bf16* WT, int permrows, LAS float* scr, int item, int nblk, int lane) {
    const int kb = item / nblk, nb = item % nblk, k0 = 64 * kb, n0 = 64 * nb;
#pragma unroll 4
    for (int i = 0; i < 16; ++i) {
        const int kk = 4 * i + (lane >> 4), c4 = (lane & 15) * 4;
        f32x4 w = *(const f32x4*)(W + (size_t)(k0 + kk) * ldw + n0 + c4);
        if (scale) w = w * scale[k0 + kk];
        scr[kk * 65 + c4] = w[0]; scr[kk * 65 + c4 + 1] = w[1]; scr[kk * 65 + c4 + 2] = w[2]; scr[kk * 65 + c4 + 3] = w[3];
    }
    LDS_FENCE();
    const int c = lane & 7;
#pragma unroll
    for (int j = 0; j < 8; ++j) {
        const int n = (lane >> 3) + 8 * j;
        const int sc = (n0 + n) < permrows ? ((n & 1) ? 32 + (n >> 1) : (n >> 1)) : n;
        const LAS float* s = scr + (8 * c) * 65 + sc;
        u32x4 o; o.x = pk2(s[0 * 65], s[1 * 65]); o.y = pk2(s[2 * 65], s[3 * 65]); o.z = pk2(s[4 * 65], s[5 * 65]); o.w = pk2(s[6 * 65], s[7 * 65]);
        *(u32x4*)(WT + (size_t)(n0 + n) * K + k0 + 8 * c) = o;
    }
    LDS_FENCE();
}

typedef const __attribute__((address_space(4))) Args* KArgsP;
__device__ __forceinline__ void convert_layer_weights(KArgsP ka, LAS unsigned char* lds, int layer, int vw, int nvw, int wave, int lane, int part  ) {
    unsigned char* ws = ka->ws;
    LAS float* scr = (LAS float*)(lds + wave * 17408);
    constexpr int I_IN = 16 * 76, I_GLU = 8 * 8, I_BR = 8 * 16, I_OUT = 16 * 16, I_UP = 16 * 64, I_DN = 64 * 16, I_L = I_IN + I_GLU + 3 * I_BR + I_OUT + I_UP + I_DN;
    unsigned char* wl = ws + WS_W + (size_t)layer * LW_BYTES;
    for (int it = (part == 0 ? 0 : I_IN) + vw; it < (part == 0 ? I_IN : I_L); it += nvw) {
        int r = it;
        if (r < I_IN) { p0_item(ka->in[3] + (size_t)layer * DM * DIN, DIN, DM, ka->in[2] + layer * DM, (bf16*)(wl + OW_IN), 640, scr, r, 76, lane); continue; } r -= I_IN;
        if (r < I_GLU) { p0_item(ka->in[13] + (size_t)layer * 512 * 512, 512, 512, nullptr, (bf16*)(wl + OW_GLU), 0, scr, r, 8, lane); continue; } r -= I_GLU;
        if (r < 3 * I_BR) { const int c = r / I_BR; p0_item(ka->in[17] + ((size_t)layer * 3 + c) * 512 * 1024, 1024, 512, nullptr, (bf16*)(wl + OW_BR) + (size_t)c * 1024 * 512, 0, scr, r % I_BR, 16, lane); continue; } r -= 3 * I_BR;
        if (r < I_OUT) { p0_item(ka->in[18] + (size_t)layer * DM * DM, DM, DM, nullptr, (bf16*)(wl + OW_OUT), 0, scr, r, 16, lane); continue; } r -= I_OUT;
        if (r < I_UP) { p0_item(ka->in[20] + (size_t)layer * DM * FF, FF, DM, ka->in[19] + layer * DM, (bf16*)(wl + OW_UP), 0, scr, r, 64, lane); continue; } r -= I_UP;
        p0_item(ka->in[21] + (size_t)layer * FF * DM, DM, FF, nullptr, (bf16*)(wl + OW_DN), 0, scr, r, 16, lane);
    }
    if (part == 1) for (int i = vw * 64 + lane; i < 512 * 64; i += nvw * 64) {
        const int n = i >> 6, k0 = (i & 63) * 8;
        u32x4 o = {0u, 0u, 0u, 0u};
        if ((n >> 7) == (k0 >> 7)) { const float* src = ka->in[15] + (((size_t)layer * 4 + (n >> 7)) * 128 + (k0 & 127)) * 128 + (n & 127);
            o.x = pk2(src[0], src[128]); o.y = pk2(src[256], src[384]); o.z = pk2(src[512], src[640]); o.w = pk2(src[768], src[896]); }
        *(u32x4*)((bf16*)(wl + OW_POOL) + (size_t)n * 512 + k0) = o;
    }
}

__device__ __forceinline__ void p0_prologue(const Args& a, LAS unsigned char* lds) {
    int tl_ = threadIdx.x; asm volatile("" : "+v"(tl_));
    const int tid = tl_, lane = tid & 63, wave = __builtin_amdgcn_readfirstlane(tid >> 6);
    const int gw = blockIdx.x * 8 + wave, NGW = gridDim.x * 8;
    const int gt = blockIdx.x * 512 + tid, NGT = gridDim.x * 512;
    unsigned char* ws = a.ws;
    for (int i = gt; i < 4 * 4 * 128 * 4; i += NGT) { const int idx = 1 + (i >> 11), pn = (i >> 9) & 3, r = (i >> 2) & 127, sl = i & 3;
        ((float*)(ws + WS_RS))[((size_t)idx * 4 * TPR + (size_t)pn * TPR + NREAL + r) * 4 + sl] = 0.f; }
    for (int i = gt; i < LL * 32; i += NGT) {
        const int l = i >> 5, f = i & 31;
        const float invf = (float)dexp(-(double)f * (9.21034037197618273607 / 32.0));
        const float ang = (float)l * invf;
        double s, c; dsincos((double)ang, s, c);
        float* rp = (float*)(ws + WS_ROPE) + (size_t)i * 2; rp[0] = (float)c; rp[1] = (float)s;
    }
    for (int j = gt; j < 2 * 2 * 32 * 64 * 16; j += NGT) {
        const int q = j & 15, i = j >> 4, n = i & 63, pidx = i >> 6;
        const double lr = (double)a.in[5][i], li = (double)a.in[6][i];
        const double dt = (double)(float)dexp((double)a.in[7][pidx]);
        const double mag = dexp(lr * dt); double sn, cn; dsincos(li * dt, sn, cn);
        const double are = mag * cn, aim = mag * sn, den = lr * lr + li * li, nre = are - 1.0;
        const double fre = (nre * lr + aim * li) / den, fim = (aim * lr - nre * li) / den;
        if (q == 0) { float* ab = (float*)(ws + WS_ABAR) + (size_t)i * 2; ab[0] = (float)are; ab[1] = (float)aim; }
        bf16* bm = (bf16*)(ws + WS_BMAT) + (size_t)pidx * 128 * 16;
        bf16* cm = (bf16*)(ws + WS_CMAT) + (size_t)pidx * 16 * 128;
        const double br = (double)a.in[8][(size_t)i * 16 + q], bi = (double)a.in[9][(size_t)i * 16 + q];
        bm[n * 16 + q] = (bf16)f2bf((float)(fre * br - fim * bi));
        bm[(64 + n) * 16 + q] = (bf16)f2bf((float)(fre * bi + fim * br));
        *(unsigned*)(cm + q * 128 + 2 * n) = pk2(a.in[10][((size_t)pidx * 16 + q) * 64 + n], -a.in[11][((size_t)pidx * 16 + q) * 64 + n]);
    }
    for (int R = gw; R < TPR; R += NGW) {
        const int mrow = R - NREAL;
        const float* src = R < NREAL ? a.in[0] + (size_t)R * DM : a.in[1] + (size_t)(mrow & 15) * DM;
        float* dst = R < NREAL ? a.out + (size_t)R * DM : (float*)(ws + WS_HM) + (size_t)mrow * DM;
        bf16* hb = (bf16*)(ws + WS_HB) + (size_t)R * DM;
        const bool pad = mrow >= NB * NMETA;
        float ss = 0.f;
#pragma unroll
        for (int j = 0; j < 4; ++j) {
            f32x4 v = *(const f32x4*)(src + 4 * lane + 256 * j);
            if (pad) v = (f32x4){0.f, 0.f, 0.f, 0.f};
            ss += (v[0] * v[0] + v[1] * v[1]) + (v[2] * v[2] + v[3] * v[3]);
            u32x2 w; w.x = pk2(v[0], v[1]); w.y = pk2(v[2], v[3]);
            *(u32x2*)(hb + 4 * lane + 256 * j) = w;
        }
#pragma unroll
        for (int o = 1; o < 64; o <<= 1) ss += __shfl_xor(ss, o);
        if (lane < 16) ((float*)(ws + WS_RS))[((size_t)(lane >> 2) * TPR + R) * 4 + (lane & 3)] = lane == 0 ? ss : 0.f;
    }
}

__device__ __forceinline__ void ssm_task(LAS unsigned char* lds, int task, int layer, const bf16* SU, float* YF,
                                         const float* abar_all, const bf16* bmat_all, const bf16* cmat_all) {
    int tid_l = threadIdx.x; asm volatile("" : "+v"(tid_l));
    const int tid = tid_l, lane = tid & 63, wave = __builtin_amdgcn_readfirstlane(tid >> 6);
    const int b = task >> 5, g = task & 31;
    __syncthreads();
    LAS float* BU = (LAS float*)(lds + wave * 12800);
    LAS unsigned short* X = (LAS unsigned short*)(lds + wave * 12800 + 8448);
    LAS float* SX = (LAS float*)(lds + 8 * 12800);
    const int blk0 = wave == 0 ? 0 : 16 * wave + 1, nblk = wave == 0 ? 17 : 16;
    bf16* yfb = (bf16*)YF + (size_t)task * LL * 16;
    const int fr = lane & 15, fq = lane >> 4;
    const bf16x8 zero8 = {0, 0, 0, 0, 0, 0, 0, 0};
    for (int dir = 0; dir < 2; ++dir) {
        const int pidx = (layer * 2 + dir) * 32 + g;
        const float are = abar_all[((size_t)pidx * 64 + lane) * 2], aim = abar_all[((size_t)pidx * 64 + lane) * 2 + 1];
        bf16x8 bfr[8], cfr[4];
        const bf16* bm = bmat_all + (size_t)pidx * 128 * 16;
#pragma unroll
        for (int nt = 0; nt < 8; ++nt) bfr[nt] = fq < 2 ? *(const bf16x8*)(bm + (nt * 16 + fr) * 16 + 8 * fq) : zero8;
        const bf16* cm = cmat_all + (size_t)pidx * 16 * 128;
#pragma unroll
        for (int ks = 0; ks < 4; ++ks) cfr[ks] = *(const bf16x8*)(cm + fr * 128 + ks * 32 + 8 * fq);
        float p16r = are, p16i = aim;
#pragma unroll
        for (int i = 0; i < 4; ++i) { const float tr = p16r * p16r - p16i * p16i, ti = 2.f * p16r * p16i; p16r = tr; p16i = ti; }
        float p256r = p16r, p256i = p16i;
#pragma unroll
        for (int i = 0; i < 4; ++i) { const float tr = p256r * p256r - p256i * p256i, ti = 2.f * p256r * p256i; p256r = tr; p256i = ti; }
        const float p272r = p256r * p16r - p256i * p16i, p272i = p256r * p16i + p256i * p16r;

        float xre = 0.f, xim = 0.f;
        for (int pass = 0; pass < 2; ++pass) {
            bf16x8 unext;
            { const int blkf = dir == 0 ? blk0 : blk0 + nblk - 1; const int Rf = blkf == 0 ? NREAL + b * NMETA : b * SEQ + blkf * 16 - NMETA;
              unext = fq < 2 ? *(const bf16x8*)(SU + (size_t)(Rf + fr) * 512 + g * 16 + 8 * fq) : zero8; }
            for (int ib = 0; ib < nblk; ++ib) {
                const int blk = dir == 0 ? blk0 + ib : blk0 + nblk - 1 - ib;
                const bf16x8 ufr = unext;
                if (ib + 1 < nblk) { const int blkn = dir == 0 ? blk + 1 : blk - 1; const int Rn = blkn == 0 ? NREAL + b * NMETA : b * SEQ + blkn * 16 - NMETA;
                    unext = fq < 2 ? *(const bf16x8*)(SU + (size_t)(Rn + fr) * 512 + g * 16 + 8 * fq) : zero8; }
                f32x4 dd[8];
#pragma unroll
                for (int nt = 0; nt < 8; ++nt) { dd[nt] = (f32x4){0.f, 0.f, 0.f, 0.f}; dd[nt] = __builtin_amdgcn_mfma_f32_16x16x32_bf16(ufr, bfr[nt], dd[nt], 0, 0, 0); }
                asm volatile("s_nop 15\n\ts_nop 15" : "+v"(dd[0]), "+v"(dd[1]), "+v"(dd[2]), "+v"(dd[3]), "+v"(dd[4]), "+v"(dd[5]), "+v"(dd[6]), "+v"(dd[7]));
#pragma unroll
                for (int nt = 0; nt < 8; ++nt)
#pragma unroll
                    for (int r = 0; r < 4; ++r) BU[(4 * fq + r) * 132 + nt * 16 + fr] = dd[nt][r];
                LDS_FENCE();
                float bur[16], bui[16];
#pragma unroll
                for (int i = 0; i < 16; ++i) { const int tt = dir == 0 ? i : 15 - i; bur[i] = BU[tt * 132 + lane]; bui[i] = BU[tt * 132 + 64 + lane]; }
                if (pass == 0) {
#pragma unroll
                    for (int i = 0; i < 16; ++i) {
                        const float bre = bur[i], bim = bui[i];
                        const float nr = are * xre - aim * xim + bre, ni = are * xim + aim * xre + bim; xre = nr; xim = ni;
                    }
                    LDS_FENCE();
                } else {
#pragma unroll
                    for (int i = 0; i < 16; ++i) {
                        const int tt = dir == 0 ? i : 15 - i;
                        const float bre = bur[i], bim = bui[i];
                        const float nr = are * xre - aim * xim + bre, ni = are * xim + aim * xre + bim; xre = nr; xim = ni;
                        *(LAS unsigned*)(X + tt * 136 + 2 * lane) = pk2(xre, xim);
                    }
                    LDS_FENCE();
                    f32x4 y = {0.f, 0.f, 0.f, 0.f};
#pragma unroll
                    for (int ks = 0; ks < 4; ++ks) {
                        const bf16x8 afr = *(const LAS bf16x8*)(X + fr * 136 + ks * 32 + 8 * fq);
                        y = __builtin_amdgcn_mfma_f32_16x16x32_bf16(afr, cfr[ks], y, 0, 0, 0);
                    }
                    asm volatile("s_nop 15\n\ts_nop 15" : "+v"(y));
                    LDS_FENCE();
                    {
                        bf16* yd = yfb + (size_t)dir * 256 * LL * 16;
#pragma unroll
                        for (int r = 0; r < 4; ++r) yd[(size_t)(blk * 16 + 4 * fq + r) * 16 + fr] = (bf16)f2bf(y[r]);
                    }
                }
            }
            if (pass == 0) {
                SX[(wave * 64 + lane) * 2] = xre; SX[(wave * 64 + lane) * 2 + 1] = xim;
                LDS_FENCE(); __syncthreads();
                float cre = 0.f, cim = 0.f;
                if (dir == 0) {
                    for (int w = 0; w < wave; ++w) { const float pr = w == 0 ? p272r : p256r, pi = w == 0 ? p272i : p256i;
                        const float sr = SX[(w * 64 + lane) * 2], si = SX[(w * 64 + lane) * 2 + 1];
                        const float nr = pr * cre - pi * cim + sr, ni = pr * cim + pi * cre + si; cre = nr; cim = ni; }
                } else {
                    for (int w = 7; w > wave; --w) {
                        const float sr = SX[(w * 64 + lane) * 2], si = SX[(w * 64 + lane) * 2 + 1];
                        const float nr = p256r * cre - p256i * cim + sr, ni = p256r * cim + p256i * cre + si; cre = nr; cim = ni; }
                }
                xre = cre; xim = cim;
            }
        }
        LDS_FENCE(); __syncthreads();
    }
}

constexpr int ATT_KROW = 72, ATT_VROW = 40, ATT_KT = 32 * ATT_KROW * 2  , ATT_VT = 64 * ATT_VROW * 2  , ATT_MAXT = 11, ATT_VOFF = ATT_MAXT * ATT_KT;
static_assert(ATT_VOFF + ATT_MAXT * ATT_VT <= 131072, "attention LDS");
__device__ __forceinline__ void attn_task(LAS unsigned char* lds, int task, const bf16* Q, const bf16* K, const bf16* V, bf16* YA, const float* sink) {
    int tid_l = threadIdx.x; asm volatile("" : "+v"(tid_l));
    const int tid = tid_l, lane = tid & 63, wave = __builtin_amdgcn_readfirstlane(tid >> 6);
    const int qb = task < 512 ? (task & 31) : 32, bh = task < 512 ? (task >> 5) : task - 512, h = bh & 1, b = bh >> 1;
    const int l0 = qb * 64;
    __syncthreads();
    int jlo = (l0 - 128) >> 5; if (jlo < 1) jlo = 1;
    int jhi = (l0 + 191) >> 5; if (jhi > 64) jhi = 64;
    const int ntiles = 1 + (jhi - jlo + 1);
    LAS unsigned short* Ks = (LAS unsigned short*)lds;
    LAS unsigned short* Vs = (LAS unsigned short*)(lds + ATT_VOFF);
    for (int idx = tid; idx < ntiles * 32 * 8; idx += 512) {
        const int ch = idx & 7, key = idx >> 3, slot = key >> 5, kk = key & 31;
        const int lk = (slot == 0 ? 0 : (jlo + slot - 1) * 32) + kk;
        u32x4 kv = {0u, 0u, 0u, 0u}, vv = {0u, 0u, 0u, 0u};
        if (lk < LL) { const size_t R = (size_t)tok_row(b, lk);
            kv = *(const u32x4*)(K + R * 128 + h * 64 + ch * 8); vv = *(const u32x4*)(V + R * 128 + h * 64 + ch * 8); }
        *(LAS u32x4*)(Ks + slot * (ATT_KT / 2) + kk * ATT_KROW + ch * 8) = kv;
        LAS unsigned short* vd = Vs + slot * (ATT_VT / 2) + (ch * 8) * ATT_VROW + kk;
        vd[0 * ATT_VROW] = (unsigned short)(vv.x & 0xffffu); vd[1 * ATT_VROW] = (unsigned short)(vv.x >> 16);
        vd[2 * ATT_VROW] = (unsigned short)(vv.y & 0xffffu); vd[3 * ATT_VROW] = (unsigned short)(vv.y >> 16);
        vd[4 * ATT_VROW] = (unsigned short)(vv.z & 0xffffu); vd[5 * ATT_VROW] = (unsigned short)(vv.z >> 16);
        vd[6 * ATT_VROW] = (unsigned short)(vv.w & 0xffffu); vd[7 * ATT_VROW] = (unsigned short)(vv.w >> 16);
    }
    LDS_FENCE(); __syncthreads();
    const int head = h * 4 + (wave >> 1), r32 = lane & 31, hi = lane >> 5;
    const int lq = l0 + 32 * (wave & 1) + r32;
    const bool qvalid = lq < LL;
    const size_t Rq = (size_t)tok_row(b, qvalid ? lq : LL - 1);
    bf16x8 qf[4];
#pragma unroll
    for (int ks = 0; ks < 4; ++ks) qf[ks] = *(const bf16x8*)(Q + Rq * 512 + head * 64 + ks * 16 + 8 * hi);
    float mrun = sink[head], lsum = hi == 0 ? 1.0f : 0.0f;
    f32x16 o0, o1;
#pragma unroll
    for (int i = 0; i < 16; ++i) { o0[i] = 0.f; o1[i] = 0.f; }
    const int lqw = l0 + 32 * (wave & 1);
    for (int slot = 0; slot < ntiles; ++slot) {
        const int kbase = slot == 0 ? 0 : (jlo + slot - 1) * 32;
        if (lqw >= LL || (slot != 0 && (kbase + 31 < lqw - 128 || kbase > lqw + 31 + 128))) continue;
        const LAS unsigned short* kt = Ks + slot * (ATT_KT / 2);
        f32x16 s;
#pragma unroll
        for (int i = 0; i < 16; ++i) s[i] = 0.f;
#pragma unroll
        for (int ks = 0; ks < 4; ++ks) {
            const bf16x8 kf = *(const LAS bf16x8*)(kt + r32 * ATT_KROW + ks * 16 + 8 * hi);
            s = __builtin_amdgcn_mfma_f32_32x32x16_bf16(kf, qf[ks], s, 0, 0, 0);
        }
        asm volatile("s_nop 15\n\ts_nop 15" : "+v"(s));
        float mt = -1e30f;
#pragma unroll
        for (int i = 0; i < 16; ++i) {
            const int lk = kbase + (i & 3) + 8 * (i >> 2) + 4 * hi;
            int d = lq - lk; d = d < 0 ? -d : d;
            const bool valid = (lk < NMETA) || (d <= 128 && lk < LL);
            s[i] = valid ? s[i] : -1e30f;
            mt = fmaxf(mt, s[i]);
        }
        mt = fmaxf(mt, __shfl_xor(mt, 32));
        const float mnew = fmaxf(mrun, mt);
        const float alpha = __expf(mrun - mnew);
        mrun = mnew;
        float ps = 0.f;
#pragma unroll
        for (int i = 0; i < 16; ++i) { s[i] = __expf(s[i] - mnew); ps += s[i]; }
        lsum = lsum * alpha + ps;
#pragma unroll
        for (int i = 0; i < 16; ++i) { o0[i] *= alpha; o1[i] *= alpha; }
        const LAS unsigned short* vt = Vs + slot * (ATT_VT / 2);
#pragma unroll
        for (int s2 = 0; s2 < 2; ++s2) {
            union { bf16x8 v; unsigned u[4]; } pf;
            pf.u[0] = pk2(s[8 * s2 + 0], s[8 * s2 + 1]); pf.u[1] = pk2(s[8 * s2 + 2], s[8 * s2 + 3]);
            pf.u[2] = pk2(s[8 * s2 + 4], s[8 * s2 + 5]); pf.u[3] = pk2(s[8 * s2 + 6], s[8 * s2 + 7]);
#pragma unroll
            for (int dt = 0; dt < 2; ++dt) {
                union { bf16x8 v; u32x2 u[2]; } vf;
                const LAS unsigned short* vp = vt + (dt * 32 + r32) * ATT_VROW + 16 * s2 + 4 * hi;
                vf.u[0] = *(const LAS u32x2*)(vp); vf.u[1] = *(const LAS u32x2*)(vp + 8);
                if (dt == 0) o0 = __builtin_amdgcn_mfma_f32_32x32x16_bf16(vf.v, pf.v, o0, 0, 0, 0);
                else o1 = __builtin_amdgcn_mfma_f32_32x32x16_bf16(vf.v, pf.v, o1, 0, 0, 0);
            }
        }
    }
    asm volatile("s_nop 15\n\ts_nop 15" : "+v"(o0), "+v"(o1));
    lsum += __shfl_xor(lsum, 32);
    const float inv = 1.0f / lsum;
    if (qvalid) {
#pragma unroll
        for (int g4 = 0; g4 < 4; ++g4) {
            u32x2 w0, w1;
            w0.x = pk2(o0[4 * g4] * inv, o0[4 * g4 + 1] * inv); w0.y = pk2(o0[4 * g4 + 2] * inv, o0[4 * g4 + 3] * inv);
            w1.x = pk2(o1[4 * g4] * inv, o1[4 * g4 + 1] * inv); w1.y = pk2(o1[4 * g4 + 2] * inv, o1[4 * g4 + 3] * inv);
            *(u32x2*)(YA + Rq * 512 + head * 64 + 8 * g4 + 4 * hi) = w0;
            *(u32x2*)(YA + Rq * 512 + head * 64 + 32 + 8 * g4 + 4 * hi) = w1;
        }
    }
    __syncthreads();
}

__device__ __forceinline__ void pool_diff(LAS unsigned char* lds, const bf16* PU, bf16* PD) {
    int tl_ = threadIdx.x; asm volatile("" : "+v"(tl_));
    constexpr int TOK = 65, HALO = 8, ROWS = TOK + 2 * HALO, NTOK = NB * LL;
    for (int blk = blockIdx.x; blk * TOK < NTOK; blk += gridDim.x) {
        const int f0 = blk * TOK;
        __syncthreads();
        for (int i = tl_; i < ROWS * 64; i += 512) {
            const int r = i >> 6, ch = i & 63, f = f0 - HALO + r;
            u32x4 v = {0u, 0u, 0u, 0u};
            if (f >= 0 && f < NTOK) { const int b = f / LL, l = f % LL; v = *(const u32x4*)(PU + (size_t)tok_row(b, l) * 512 + ch * 8); }
            *(LAS u32x4*)(lds + (size_t)i * 16) = v;
        }
        LDS_FENCE(); __syncthreads();
        for (int i = tl_; i < TOK * 64; i += 512) {
            const int t = i >> 6, ch = i & 63, f = f0 + t;
            if (f >= NTOK) continue;
            const int b = f / LL, l = f % LL, half = 1 << (ch >> 4);
            const int lo = l - half < 0 ? 0 : l - half, hh = l + half > LL ? LL : l + half;
            float s[8];
#pragma unroll
            for (int j = 0; j < 8; ++j) s[j] = 0.f;
            for (int lp = lo; lp < hh; ++lp) {
                const u32x4 v = *(const LAS u32x4*)(lds + (size_t)((t + HALO + lp - l) * 64 + ch) * 16);
                s[0] += bf2f(v.x & 0xffffu); s[1] += bf2f(v.x >> 16); s[2] += bf2f(v.y & 0xffffu); s[3] += bf2f(v.y >> 16);
                s[4] += bf2f(v.z & 0xffffu); s[5] += bf2f(v.z >> 16); s[6] += bf2f(v.w & 0xffffu); s[7] += bf2f(v.w >> 16);
            }
            const float ic = 1.0f / (float)(hh - lo);
            const u32x4 v = *(const LAS u32x4*)(lds + (size_t)((t + HALO) * 64 + ch) * 16);
            u32x4 o;
            o.x = pk2(s[0] * ic - bf2f(v.x & 0xffffu), s[1] * ic - bf2f(v.x >> 16)); o.y = pk2(s[2] * ic - bf2f(v.y & 0xffffu), s[3] * ic - bf2f(v.y >> 16));
            o.z = pk2(s[4] * ic - bf2f(v.z & 0xffffu), s[5] * ic - bf2f(v.z >> 16)); o.w = pk2(s[6] * ic - bf2f(v.w & 0xffffu), s[7] * ic - bf2f(v.w >> 16));
            *(u32x4*)(PD + (size_t)tok_row(b, l) * 512 + ch * 8) = o;
        }
    }
    __syncthreads();
}

__device__ __forceinline__ void z_pass(const float* YF, const bf16* SU, const float* dskip, bf16* Z) {
    int tl_ = threadIdx.x; asm volatile("" : "+v"(tl_)); const int gt = blockIdx.x * 512 + tl_, NGT = gridDim.x * 512;
    for (int i = gt; i < NB * LL * 64; i += NGT) {
        const int ch = i & 63, tk = i >> 6, b = tk / LL, l = tk % LL, g = ch >> 1;
        const size_t R = (size_t)tok_row(b, l);
        const bf16* yp = (const bf16*)YF + ((size_t)(b * 32 + g) * LL + l) * 16 + (ch & 1) * 8;
        const u32x4 ya = *(const u32x4*)yp, yb = *(const u32x4*)(yp + (size_t)256 * LL * 16);
        f32x4 y0, y1;
        y0[0] = bf2f(ya.x & 0xffffu) + bf2f(yb.x & 0xffffu); y0[1] = bf2f(ya.x >> 16) + bf2f(yb.x >> 16); y0[2] = bf2f(ya.y & 0xffffu) + bf2f(yb.y & 0xffffu); y0[3] = bf2f(ya.y >> 16) + bf2f(yb.y >> 16);
        y1[0] = bf2f(ya.z & 0xffffu) + bf2f(yb.z & 0xffffu); y1[1] = bf2f(ya.z >> 16) + bf2f(yb.z >> 16); y1[2] = bf2f(ya.w & 0xffffu) + bf2f(yb.w & 0xffffu); y1[3] = bf2f(ya.w >> 16) + bf2f(yb.w >> 16);
        const f32x4 d0 = *(const f32x4*)(dskip + ch * 8), d1 = *(const f32x4*)(dskip + ch * 8 + 4);
        const u32x4 uu = *(const u32x4*)(SU + R * 512 + ch * 8);
        float t[8];
        t[0] = y0[0] + d0[0] * bf2f(uu.x & 0xffffu); t[1] = y0[1] + d0[1] * bf2f(uu.x >> 16); t[2] = y0[2] + d0[2] * bf2f(uu.y & 0xffffu); t[3] = y0[3] + d0[3] * bf2f(uu.y >> 16);
        t[4] = y1[0] + d1[0] * bf2f(uu.z & 0xffffu); t[5] = y1[1] + d1[1] * bf2f(uu.z >> 16); t[6] = y1[2] + d1[2] * bf2f(uu.w & 0xffffu); t[7] = y1[3] + d1[3] * bf2f(uu.w >> 16);
#pragma unroll
        for (int j = 0; j < 8; ++j) {
            const float v = t[j], tt = __builtin_amdgcn_rcpf(fabsf(v) * 0.2316418882f + 1.0f);
            float q = tt * 0.5307027145f + (-0.7265760135f); q = q * tt + 0.7107068705f; q = q * tt + (-0.142248368f); q = q * tt + 0.127414796f; q = q * tt;
            const float m = v * (q * __builtin_amdgcn_exp2f(v * v * (-0.72134752044f)));
            t[j] = v < 0.f ? m : v - m;
        }
        u32x4 o; o.x = pk2(t[0], t[1]); o.y = pk2(t[2], t[3]); o.z = pk2(t[4], t[5]); o.w = pk2(t[6], t[7]);
        *(u32x4*)(Z + R * 512 + ch * 8) = o;
    }
}

#define XB_TMO      128
#define XB_XCNT(j)  (256  + 64 * (j))
#define XB_XSUB(j)  (1280 + 64 * (j))
#define XB_XGEN(j)  (2304 + 64 * (j))
#define XB_TOP      3328
#define XB_TOPGEN   3392
#define XCD_BAR_WORDS 3456
#define XB_SPIN_CAP (1u << 18)

__device__ __forceinline__ unsigned xb_ld(unsigned* p)              { return __hip_atomic_load(p, __ATOMIC_RELAXED, __HIP_MEMORY_SCOPE_AGENT); }
__device__ __forceinline__ unsigned xb_add(unsigned* p, unsigned v) { return __hip_atomic_fetch_add(p, v, __ATOMIC_RELAXED, __HIP_MEMORY_SCOPE_AGENT); }
__device__ __forceinline__ unsigned xb_xcc_id() { return (unsigned)__builtin_amdgcn_s_getreg((3 << 11) | 20) & 0xFu; }
#define XB_SPIN(cond, bar) do { unsigned _sp = 0; while (cond) { __builtin_amdgcn_s_sleep(1); \
    if ((++_sp & 255u) == 0u) { if (xb_ld(&(bar)[XB_TMO])) break; if (_sp > XB_SPIN_CAP) { atomicAdd(&(bar)[XB_TMO], 1u); break; } } } } while (0)

struct XcdBarrier {
    unsigned* bar; unsigned x;
    volatile LAS unsigned* st;
};

__device__ __forceinline__ XcdBarrier xcd_barrier_post(unsigned* bar, volatile LAS unsigned* st) {
    XcdBarrier b; b.bar = bar; b.x = xb_xcc_id(); b.st = st;
    if (threadIdx.x == 0) (void)xb_add(&bar[XB_XCNT(b.x)], 1u);
    return b;
}
__device__ __forceinline__ void xcd_barrier_complete(unsigned* bar, unsigned x, unsigned& nloc, unsigned& nx) {
    const unsigned G = gridDim.x * gridDim.y * gridDim.z;
    unsigned sum, cnt, mine, sp = 0u;
    for (;;) {
        sum = 0u; cnt = 0u; mine = 0u;
#pragma unroll
        for (unsigned j = 0; j < 16; ++j) { const unsigned c = xb_ld(&bar[XB_XCNT(j)]); sum += c; cnt += (c > 0u) ? 1u : 0u; mine = (j == x) ? c : mine; }
        if (sum == G) break;
        __builtin_amdgcn_s_sleep(1);
        if ((++sp & 255u) == 0u) { if (xb_ld(&bar[XB_TMO])) break; if (sp > XB_SPIN_CAP) { atomicAdd(&bar[XB_TMO], 1u); break; } }
    }
    nloc = mine > 0u ? mine : 1u; nx = cnt > 0u ? cnt : 1u;
}

__device__ __forceinline__ void xcd_barrier(const XcdBarrier& b) {
    asm volatile("s_waitcnt vmcnt(0)" ::: "memory");
    __syncthreads();
    if (threadIdx.x == 0) {
        unsigned* bar = b.bar;
        __builtin_amdgcn_s_waitcnt(0);
        unsigned nloc = b.st[0], nx = b.st[1];
        if (nloc == 0u) { xcd_barrier_complete(bar, b.x, nloc, nx); b.st[0] = nloc; b.st[1] = nx; }
        const unsigned old = xb_add(&bar[XB_XSUB(b.x)], 1u);
        const unsigned gen = old / nloc;
        if (old + 1u == (gen + 1u) * nloc) {
            __builtin_amdgcn_fence(__ATOMIC_RELEASE, "agent");
            asm volatile("s_waitcnt vmcnt(0)" ::: "memory");
            const unsigned og = xb_add(&bar[XB_TOP], 1u);
            const unsigned tg = og / nx;
            if (og + 1u == (tg + 1u) * nx) xb_add(&bar[XB_TOPGEN], 1u);
            else XB_SPIN(xb_ld(&bar[XB_TOPGEN]) == tg, bar);
            __builtin_amdgcn_fence(__ATOMIC_ACQUIRE, "agent");
            xb_add(&bar[XB_XGEN(b.x)], 1u);
            asm volatile("s_waitcnt vmcnt(0)" ::: "memory");
        } else {
            XB_SPIN(xb_ld(&bar[XB_XGEN(b.x)]) == gen, bar);
            __builtin_amdgcn_fence(__ATOMIC_ACQUIRE, "agent");
            asm volatile("s_waitcnt vmcnt(0)" ::: "memory");
        }
    }
    __syncthreads();
}

#ifndef MK_ALIGN
#define MK_ALIGN true
#endif
#ifndef MK_SP2
#define MK_SP2 true
#endif
#ifndef MK_SPLIT
#define MK_SPLIT 0
#endif
#ifndef MK_NLAYER
#define MK_NLAYER 2
#endif
constexpr int NPL = 8, NPHASE = 1 + 2 * NPL + 1, PH_FINAL = NPHASE - 1;

#define KARGS() ({ auto kp_ = __builtin_amdgcn_kernarg_segment_ptr(); asm volatile("" : "+s"(kp_)); (KArgsP)kp_; })
__global__ void __launch_bounds__(512, 2) fwd_kernel(Args a_unused, int ph_lo, int ph_hi) {
    (void)a_unused;
    extern __shared__ __attribute__((aligned(16))) unsigned char lds_raw[];
    LAS unsigned char* lds = (LAS unsigned char*)lds_raw;
    const int G = gridDim.x, bid = blockIdx.x;
#if MK_SPLIT
#define GRID_SYNC() do {} while (0)
    (void)lds;
#else
#define CG_SYNC() do { asm volatile("s_waitcnt vmcnt(0)" ::: "memory"); __syncthreads(); \
    if (threadIdx.x == 0) { __builtin_amdgcn_fence(__ATOMIC_RELEASE, "agent"); asm volatile("s_waitcnt vmcnt(0)" ::: "memory"); } \
    __syncthreads(); grid.sync(); \
    if (threadIdx.x == 0) { __builtin_amdgcn_fence(__ATOMIC_ACQUIRE, "agent"); asm volatile("s_waitcnt vmcnt(0)" ::: "memory"); } \
    __syncthreads(); } while (0)
    cg::grid_group grid = cg::this_grid();
    unsigned* barw = (unsigned*)(KARGS()->ws + WS_CTL);
    if (bid == 0) for (int i = threadIdx.x; i < XCD_BAR_WORDS; i += 512) __hip_atomic_store(barw + i, 0u, __ATOMIC_RELAXED, __HIP_MEMORY_SCOPE_AGENT);
    volatile LAS unsigned* xst = (volatile LAS unsigned*)(lds + LDS_BYTES - 64);
    if (threadIdx.x < 2) xst[threadIdx.x] = 0u;
    CG_SYNC();
    const XcdBarrier xbar = xcd_barrier_post(barw, xst);
#define GRID_SYNC() xcd_barrier(xbar)

#endif
#ifndef PHMASK
#define PHMASK 0xFFFFu
#endif
#define IN(k) (((PHMASK >> ((k) == 0 ? 0 : (k) == PH_FINAL ? 9 : 1 + ((k) - 1) % NPL)) & 1u) && ph_lo <= (k) && (k) < ph_hi)
#define SEAM(k) do { if (IN(k) && (k) + 1 < ph_hi) GRID_SYNC(); } while (0)
#define PHASE_BEGIN() KArgsP ka = KARGS(); unsigned char* ws = ka->ws; asm volatile("" : "+s"(ws)); float* rowss = (float*)(ws + WS_RS); float* Hm = (float*)(ws + WS_HM); bf16* HB = (bf16*)(ws + WS_HB); unsigned char* wl = ws + WS_W + (size_t)layer * LW_BYTES; \
    const int MT = NREAL; const bool META = layer != MK_NLAYER - 1;     \
    const float* rs_mix = rowss + (size_t)(2 * layer) * TPR * 16; float* rs_mlp = rowss + (size_t)(2 * layer + 1) * TPR * 16; float* rs_next = rowss + (size_t)(2 * layer + 2) * TPR * 16; (void)MT; (void)META; (void)Hm; (void)HB; (void)wl; (void)rs_mix; (void)rs_mlp; (void)rs_next;

    if (IN(0)) {
        { int tl_ = threadIdx.x; asm volatile("" : "+v"(tl_)); const int wv = __builtin_amdgcn_readfirstlane(tl_ >> 6);
          convert_layer_weights(KARGS(), lds, 0, bid * 8 + wv, G * 8, wv, tl_ & 63, 0); }
        Args al; { KArgsP kp = KARGS(); for (int i = 0; i < 23; ++i) al.in[i] = kp->in[i]; al.out = kp->out; al.ws = kp->ws; } p0_prologue(al, lds); }
    SEAM(0);
#ifndef MK_NLAYER
#define MK_NLAYER 2
#endif
#ifndef MK_RSIDX
#define MK_RSIDX 4
#endif
#pragma unroll 1
    for (int layer = 0; layer < MK_NLAYER; ++layer) {
        const int p = 1 + NPL * layer;
        if (IN(p)) { PHASE_BEGIN();
            pg8::Gemm g{HB, (const bf16*)(wl + OW_IN), TPR, NPROJ, DM}; pg8::StaticOrder S; S.init(TPR, NPROJ, G, bid);
            EpiInProj E{rs_mix, (const float*)(ws + WS_ROPE), (bf16*)(ws + WS_Q), (bf16*)(ws + WS_K), (bf16*)(ws + WS_V), (bf16*)(ws + WS_SU), (bf16*)(ws + WS_PU)};
            pg8::gemm_phase<EpiInProj, pg8::StaticOrder, MK_ALIGN, MK_SP2>(lds, g, S, E);
        }
        SEAM(p);
        if (IN(p + 1)) { PHASE_BEGIN();
            for (int t = bid; t < 256; t += G)
                ssm_task(lds, t, layer, (const bf16*)(ws + WS_SU), (float*)(ws + WS_YF), (const float*)(ws + WS_ABAR), (const bf16*)(ws + WS_BMAT), (const bf16*)(ws + WS_CMAT));
            for (int t = bid; t < NB * 2 * 33; t += G)
                attn_task(lds, t, (const bf16*)(ws + WS_Q), (const bf16*)(ws + WS_K), (const bf16*)(ws + WS_V), (bf16*)ka->out, ka->in[4] + layer * 8);
            pool_diff(lds, (const bf16*)(ws + WS_PU), (bf16*)(ws + WS_PD));
            {
                int tl_ = threadIdx.x; asm volatile("" : "+v"(tl_)); const int wv = __builtin_amdgcn_readfirstlane(tl_ >> 6);
                convert_layer_weights(ka, lds, layer, bid * 8 + wv, G * 8, wv, tl_ & 63, 1);
                if (layer + 1 < MK_NLAYER) convert_layer_weights(ka, lds, layer + 1, bid * 8 + wv, G * 8, wv, tl_ & 63, 0);
                __syncthreads();
            }
        }
        SEAM(p + 1);
        if (IN(p + 2)) { PHASE_BEGIN();
            z_pass((const float*)(ws + WS_YF), (const bf16*)(ws + WS_SU), ka->in[12] + layer * 512, (bf16*)(ws + WS_Z));
        }
        SEAM(p + 2);
        if (IN(p + 3)) { PHASE_BEGIN();
            const int hg = G >> 1;
            if (bid < hg) { pg8::Gemm g{(const bf16*)(ws + WS_Z), (const bf16*)(wl + OW_GLU), MT, 512, 512}; pg8::StaticOrder S; S.init(MT, 512, hg, bid);
              EpiGlu E{(const bf16*)(ws + WS_Z), ka->in[14] + layer * 512, (bf16*)ka->out + (size_t)TPR * 512};
              pg8::gemm_phase<EpiGlu, pg8::StaticOrder, MK_ALIGN, MK_SP2>(lds, g, S, E); if (META) thin_gemm<EpiGlu>(lds, g.A, g.Bt, g.K, g.N, E, bid, hg); }
            else { pg8::Gemm g{(const bf16*)(ws + WS_PD), (const bf16*)(wl + OW_POOL), MT, 512, 512}; pg8::StaticOrder S; S.init(MT, 512, G - hg, bid - hg);
              EpiScale E{(bf16*)ka->out + (size_t)2 * TPR * 512, 512, ka->in[16] + layer * 512};
              pg8::gemm_phase<EpiScale, pg8::StaticOrder, MK_ALIGN, MK_SP2>(lds, g, S, E); if (META) thin_gemm<EpiScale>(lds, g.A, g.Bt, g.K, g.N, E, bid - hg, G - hg); }
        }
        SEAM(p + 3);
        if (IN(p + 4)) { PHASE_BEGIN();
            bf16* Y3 = (bf16*)ka->out;
            bf16* BR0 = (bf16*)(ws + WS_X), *BR1 = (bf16*)(ws + WS_X + 4 * UU), *BR2 = (bf16*)(ws + WS_X + 6 * UU);
            const bf16* Wbr = (const bf16*)(wl + OW_BR); const bf16* Wg = (const bf16*)(wl + OW_IN) + (size_t)NPROJ * DM; bf16* MG = (bf16*)(ws + WS_MG);
            { pg8::Gemm g{Y3, Wbr, 3 * TPR, 3072, 512}; TripleOrder S; S.init(G, bid, TPR / 256, 4);
              EpiBr3 E{BR0, TPR / 256};
              pg8::gemm_phase<EpiBr3, TripleOrder, MK_ALIGN, MK_SP2>(lds, g, S, E); }
            { pg8::Gemm g{HB, Wg, MT, 3072, DM}; TripleOrder S; S.init(G, bid, 0, 4);
              EpiGate3 E{rs_mix, BR0, MG};
              pg8::gemm_phase<EpiGate3, TripleOrder, MK_ALIGN, MK_SP2>(lds, g, S, E); }
            if (META) {
                bf16* GBm = (bf16*)(ws + WS_HM) - (size_t)NREAL * 1024;
#pragma unroll 1
                for (int c = 0; c < 3; ++c) {
                    const int vb = (bid - 64 * c) & 255;
                    bf16* BRc = BR0 + (size_t)(2 * c + 2 * (c > 0)) * (UU / 2);
                    { EpiScale E{BRc, 1024, nullptr}; thin_gemm<EpiScale>(lds, Y3 + (size_t)c * TPR * 512, Wbr + (size_t)c * 1024 * 512, 512, 1024, E, vb, 256); }
                    { EpiGate<true> E{rs_mix, BRc, GBm + (size_t)c * 128 * 1024}; thin_gemm<EpiGate<true>>(lds, HB, Wg + (size_t)c * 1024 * DM, DM, 1024, E, vb, 256); }
                }
            }
        }
        SEAM(p + 4);
        if (IN(p + 5)) { PHASE_BEGIN();
            pg8::Gemm g{(const bf16*)(ws + WS_MG), (const bf16*)(wl + OW_OUT), MT, DM, DM}; pg8::StaticOrder S; S.init(MT, DM, G, bid);
            EpiRes E{(const float*)nullptr, HB, rs_mlp};
            pg8::gemm_phase<EpiRes, pg8::StaticOrder, MK_ALIGN, MK_SP2>(lds, g, S, E); if (META) thin_gemm<EpiRes, true>(lds, (const bf16*)(ws + WS_HM) - (size_t)NREAL * 1024, g.Bt, g.K, g.N, E, bid, G, (size_t)128 * 1024);
        }
        SEAM(p + 5);
        if (IN(p + 6)) { PHASE_BEGIN();
            pg8::Gemm g{HB, (const bf16*)(wl + OW_UP), MT, FF, DM}; pg8::StaticOrder S; S.init(MT, FF, G, bid);
            EpiUp E{rs_mlp, (bf16*)(ws + WS_ACT)};
            pg8::gemm_phase<EpiUp, pg8::StaticOrder, MK_ALIGN, MK_SP2>(lds, g, S, E); if (META) thin_gemm<EpiUp>(lds, g.A, g.Bt, g.K, g.N, E, bid, G);
        }
        SEAM(p + 6);
        if (IN(p + 7)) { PHASE_BEGIN();
            pg8::Gemm g{(const bf16*)(ws + WS_ACT), (const bf16*)(wl + OW_DN), MT, DM, FF}; pg8::StaticOrder S; S.init(MT, DM, G, bid);
            EpiRes E{(const float*)nullptr, HB, rs_next};
            pg8::gemm_phase<EpiRes, pg8::StaticOrder, MK_ALIGN, MK_SP2>(lds, g, S, E); if (META) thin_gemm<EpiRes>(lds, g.A, g.Bt, g.K, g.N, E, bid, G);
        }
        SEAM(p + 7);
    }
#ifdef MK_DUMP_OFF
    if (IN(PH_FINAL)) { KArgsP ka = KARGS();
        const bf16* src = (const bf16*)(ka->ws + (MK_DUMP_OFF)); const bf16* src2 = (const bf16*)(ka->ws + (MK_DUMP_OFF2));
        for (int i = bid * 512 + threadIdx.x; i < NREAL * 1024; i += G * 512) { const int R = MK_DUMP_ROW(i >> 10), c = i & 1023; ka->out[i] = c < 512 ? bf2f(src[(size_t)R * (MK_DUMP_LD) + (c % (MK_DUMP_LD))]) : bf2f(src2[(size_t)R * (MK_DUMP_LD2) + (c % (MK_DUMP_LD2))]); }
    }
#else
    if (IN(PH_FINAL)) { KArgsP ka = KARGS();
        const float* rs = (const float*)(ka->ws + WS_RS) + (size_t)MK_RSIDX * TPR * 16; const float* gain = ka->in[22];
        int tl_ = threadIdx.x; asm volatile("" : "+v"(tl_));
        const int lane = tl_ & 63, wv = __builtin_amdgcn_readfirstlane(tl_ >> 6);
        for (int R = bid * 8 + wv; R < NREAL; R += G * 8) {
            const float r = row_rstd(rs, R);
            const bf16* hrow = (const bf16*)(ka->ws + WS_HB) + (size_t)R * DM; float* orow = ka->out + (size_t)R * DM;
#pragma unroll
            for (int j = 0; j < 4; ++j) {
                const int c4 = (lane + 64 * j) * 4;
                const u32x2 hb = *(const u32x2*)(hrow + c4); const f32x4 gn = *(const f32x4*)(gain + c4);
                f32x4 v = {bf2f(hb.x & 0xffffu), bf2f(hb.x >> 16), bf2f(hb.y & 0xffffu), bf2f(hb.y >> 16)};
                v = v * r * gn;
                *(f32x4*)(orow + c4) = v;
            }
        }
    }
#endif
#undef IN
#undef SEAM
}

extern "C" void kernel_launch(void* const* d_in, const int* in_sizes, int n_in, void* d_out, int out_size, void* d_ws, size_t ws_size, hipStream_t stream) {
    static int grid = 0;
    if (grid == 0) {
        if (n_in != 23 || out_size != NREAL * DM || ws_size < WS_END) { fprintf(stderr, "kernel_launch: unexpected shapes (n_in %d out %d ws %zu)\n", n_in, out_size, ws_size); grid = -1; return; }
        int dev = 0, cus = 0, per_cu = 0;
        hipGetDevice(&dev); hipDeviceGetAttribute(&cus, hipDeviceAttributeMultiprocessorCount, dev);
        if (hipFuncSetAttribute((const void*)fwd_kernel, hipFuncAttributeMaxDynamicSharedMemorySize, LDS_BYTES) != hipSuccess) { fprintf(stderr, "kernel_launch: hipFuncSetAttribute failed\n"); grid = -1; return; }
        if (hipOccupancyMaxActiveBlocksPerMultiprocessor(&per_cu, (const void*)fwd_kernel, 512, LDS_BYTES) != hipSuccess || per_cu < 1) { fprintf(stderr, "kernel_launch: occupancy query gave %d\n", per_cu); per_cu = 1; }
        (void)hipGetLastError();
        grid = cus * (per_cu > 1 ? 1 : per_cu);
        if (grid <= 0) grid = 256;
    }
    if (grid < 0) return;
    Args a{};
    for (int i = 0; i < 23; ++i) a.in[i] = (const float*)d_in[i];
    a.out = (float*)d_out; a.ws = (unsigned char*)d_ws;
#if MK_SPLIT
    for (int ph = 0; ph < NPHASE; ++ph) hipLaunchKernelGGL(fwd_kernel, dim3(grid), dim3(512), LDS_BYTES, stream, a, ph, ph + 1);
#else
    int lo = 0, hi = NPHASE;
    void* kargs[] = {(void*)&a, (void*)&lo, (void*)&hi};
    hipError_t e = hipLaunchCooperativeKernel((const void*)fwd_kernel, dim3(grid), dim3(512), kargs, LDS_BYTES, stream);
    if (e != hipSuccess) fprintf(stderr, "kernel_launch: cooperative launch failed: %s (grid %d)\n", hipGetErrorString(e), grid);
#endif
}
```

```cpp
#include <hip/hip_runtime.h>
#include <hip/hip_cooperative_groups.h>
#include <cstdio>
#include <cstdint>
namespace cg = cooperative_groups;
namespace pg8 {
#define PG8_LAS __attribute__((address_space(3)))
typedef unsigned short bf16_t;
typedef short bf16x8 __attribute__((ext_vector_type(8)));
typedef float f32x4 __attribute__((ext_vector_type(4)));
typedef unsigned u32x4 __attribute__((ext_vector_type(4)));
constexpr int BM = 256, BK = 64, HALF = 128, HTB = HALF * BK * 2  , STAGE_BYTES = 8 * HTB, NXCD = 8, WGM = 8;

__host__ __device__ __forceinline__ int lds_byte(int r, int c) { const int st = (r >> 4) * 2 + (c >> 5), rr = r & 15, cc = c & 31, ob = rr * 64 + cc * 2; return st * 1024 + (ob ^ (((ob >> 9) & 1) << 5)); }
__host__ __device__ __forceinline__ void stage_rc(int b, int& R, int& C) { const int st = b / 1024, sb = b % 1024, swz = sb ^ (((sb >> 9) & 1) << 5); R = (st >> 1) * 16 + swz / 64; C = (st & 1) * 32 + (swz % 64) / 2; }
__host__ __device__ __forceinline__ int perm32(int rho) { const int n = rho >> 4, i = rho & 15; return 8 * (i >> 2) + 4 * n + (i & 3); }

struct Unit { int pm, pn; };
struct Gemm { const bf16_t* A; const bf16_t* Bt; int M, N, K; };

struct StaticOrder {
    int nM, nN, nwg, G, c;
    __host__ __device__ void init(int M, int N, int G_, int c_) { nM = M / BM; nN = N / BM; nwg = nM * nN; G = G_; c = c_; }
    __host__ __device__ __forceinline__ bool next(int i, Unit& u) const {
        const long L = (long)i * G + c; if (L >= nwg) return false;
        int wgid = (int)L; { const int q = nwg / NXCD, r = nwg % NXCD, xcd = wgid % NXCD, off = wgid / NXCD; wgid = (xcd < r ? xcd * (q + 1) : r * (q + 1) + (xcd - r) * q) + off; }
        const int nig = WGM * nN, gid = wgid / nig, fm = gid * WGM, gsz = (nM - fm) < WGM ? (nM - fm) : WGM;
        u.pm = fm + ((wgid % nig) % gsz); u.pn = (wgid % nig) / gsz; return true;
    }
    __device__ __forceinline__ void a_ready(const Unit&) const {}
    __device__ __forceinline__ void done(const Unit&) const {}
};

__device__ __forceinline__ unsigned cvt_pk_bf16(float lo, float hi) { unsigned r; asm volatile("v_cvt_pk_bf16_f32 %0, %1, %2" : "=v"(r) : "v"(lo), "v"(hi)); return r; }
template <class Epi, class Sched, bool ALIGN_EPI = false, bool SP2 = false>
__device__ __forceinline__ void gemm_phase(PG8_LAS unsigned char* lds, const Gemm g, const Sched& S, const Epi& E) {
    int tid_l = threadIdx.x; asm volatile("" : "+v"(tid_l));
    const int tid = tid_l, wid = __builtin_amdgcn_readfirstlane(tid >> 6), lane = tid & 63, wr = wid >> 2, wc = wid & 3, fr = lane & 15, fq = lane >> 4;
    const int K = g.K, nt = K / BK;
    unsigned voffA[2], voffB[2];
#pragma unroll
    for (int i = 0; i < 2; ++i) { int R, C; stage_rc(tid * 16 + i * 8192, R, C); const int Rb = Epi::PERM ? ((R & ~31) + perm32(R & 31)) : R;
        voffA[i] = (unsigned)(R * K + C) * 2u; voffB[i] = (unsigned)(Rb * K + C) * 2u; }
    const size_t kstep = (size_t)(BK * 2);
    const size_t hstep = (size_t)HALF * K * 2;
    const size_t tstep = 2 * hstep;
    const unsigned ldsw = (unsigned)wid * 1024u;
    const int aoff = lds_byte(wr * 64 + fr, fq * 8), boff = lds_byte(wc * 32 + fr, fq * 8);
#define PG8_SA(b, h) (((b) * 2 + (h)) * HTB)
#define PG8_SB(b, h) ((4 + (b) * 2 + (h)) * HTB)
#define PG8_STAGE(bufoff, gbase, voff) do { _Pragma("unroll") for (int _i = 0; _i < 2; ++_i) \
        __builtin_amdgcn_global_load_lds((const unsigned*)((const char*)(gbase) + (voff)[_i]), (PG8_LAS unsigned*)(lds + (bufoff) + ldsw + _i * 8192), 16, 0, 0); } while (0)
#define PG8_LDA(dst, b, h) do { _Pragma("unroll") for (int m = 0; m < 4; ++m) _Pragma("unroll") for (int k = 0; k < 2; ++k) dst[m][k] = *(const PG8_LAS bf16x8*)(lds + PG8_SA(b, h) + aoff + m * 2048 + k * 1024); } while (0)
#define PG8_LDB(dst, b, h) do { _Pragma("unroll") for (int n = 0; n < 2; ++n) _Pragma("unroll") for (int k = 0; k < 2; ++k) dst[n][k] = *(const PG8_LAS bf16x8*)(lds + PG8_SB(b, h) + boff + n * 2048 + k * 1024); } while (0)
#define PG8_MMA(ai, bj, At, Bt) do { __builtin_amdgcn_s_setprio(1); _Pragma("unroll") for (int m = 0; m < 4; ++m) _Pragma("unroll") for (int n = 0; n < 2; ++n) _Pragma("unroll") for (int k = 0; k < 2; ++k) \
        acc[ai][bj][m][n] = __builtin_amdgcn_mfma_f32_16x16x32_bf16(Bt[n][k], At[m][k], acc[ai][bj][m][n], 0, 0, 0); __builtin_amdgcn_s_setprio(0); } while (0)
#define PG8_WAIT_V(n) asm volatile("s_waitcnt vmcnt(" #n ")" ::: "memory")
#define PG8_WAIT_L(n) asm volatile("s_waitcnt lgkmcnt(" #n ")" ::: "memory")
#define PG8_BAR __builtin_amdgcn_s_barrier()
#define PG8_SCHED __builtin_amdgcn_sched_barrier(0)
    Unit cur, nxt; int ui = 0;
    if (!S.next(0, cur)) return;
    f32x4 acc[2][2][4][2];
#pragma unroll
    for (int a = 0; a < 2; ++a)
#pragma unroll
        for (int b = 0; b < 2; ++b)
#pragma unroll
            for (int m = 0; m < 4; ++m)
#pragma unroll
                for (int n = 0; n < 2; ++n) acc[a][b][m][n] = (f32x4){0.f, 0.f, 0.f, 0.f};
    bf16x8 At[4][2], B0[2][2], B1[2][2];
    const char* cA = (const char*)g.A + (size_t)cur.pm * tstep; const char* cB = (const char*)g.Bt + (size_t)cur.pn * tstep;
    S.a_ready(cur);
    if constexpr (SP2) {
        PG8_STAGE(PG8_SB(0, 0), cB, voffB); PG8_STAGE(PG8_SB(0, 1), cB + hstep, voffB); PG8_STAGE(PG8_SA(0, 0), cA, voffA); PG8_STAGE(PG8_SA(0, 1), cA + hstep, voffA);
        if (wr == 1) PG8_BAR;
        PG8_WAIT_V(2); PG8_BAR;
        PG8_STAGE(PG8_SB(1, 0), cB + kstep, voffB); PG8_STAGE(PG8_SA(1, 0), cA + kstep, voffA); PG8_STAGE(PG8_SB(1, 1), cB + hstep + kstep, voffB);
        PG8_WAIT_V(6); PG8_BAR;
    } else {
        PG8_STAGE(PG8_SB(0, 0), cB, voffB); PG8_STAGE(PG8_SA(0, 0), cA, voffA); PG8_STAGE(PG8_SB(0, 1), cB + hstep, voffB); PG8_STAGE(PG8_SA(0, 1), cA + hstep, voffA);
        if (wr == 1) PG8_BAR;
        PG8_WAIT_V(4); PG8_BAR;
        PG8_STAGE(PG8_SB(1, 0), cB + kstep, voffB); PG8_STAGE(PG8_SA(1, 0), cA + kstep, voffA); PG8_STAGE(PG8_SB(1, 1), cB + hstep + kstep, voffB);
        PG8_WAIT_V(6); PG8_BAR;
    }
    for (;;) {
        const bool has_next = S.next(ui + 1, nxt);
        const char* nA = has_next ? (const char*)g.A + (size_t)nxt.pm * tstep : cA; const char* nB = has_next ? (const char*)g.Bt + (size_t)nxt.pn * tstep : cB;
        for (int t = 0; t < nt; t += 2) {
            const bool last = (t == nt - 2);
            const char* a1 = cA + (size_t)(t + 1) * kstep;
            const char* a2 = last ? nA : cA + (size_t)(t + 2) * kstep; const char* b2 = last ? nB : cB + (size_t)(t + 2) * kstep;
            const char* a3 = a2 + kstep; const char* b3 = b2 + kstep;
            if (last && has_next) S.a_ready(nxt);
            if constexpr (SP2) {
            PG8_LDB(B0, 0, 0); PG8_LDB(B1, 0, 1); PG8_SCHED; PG8_LDA(At, 0, 0); PG8_STAGE(PG8_SA(1, 1), a1 + hstep, voffA);
            PG8_WAIT_V(8); PG8_WAIT_L(0); PG8_BAR; PG8_MMA(0, 0, At, B0); PG8_MMA(0, 1, At, B1); PG8_BAR; PG8_SCHED;
            PG8_LDA(At, 0, 1); PG8_STAGE(PG8_SB(0, 0), b2, voffB); PG8_STAGE(PG8_SB(0, 1), b2 + hstep, voffB); PG8_STAGE(PG8_SA(0, 0), a2, voffA);
            PG8_WAIT_V(8); PG8_WAIT_L(0); PG8_BAR; PG8_MMA(1, 0, At, B0); PG8_MMA(1, 1, At, B1); PG8_BAR; PG8_SCHED;
            PG8_LDB(B0, 1, 0); PG8_LDB(B1, 1, 1); PG8_SCHED; PG8_LDA(At, 1, 0); PG8_STAGE(PG8_SA(0, 1), a2 + hstep, voffA);
            PG8_WAIT_V(8); PG8_WAIT_L(0); PG8_BAR; PG8_MMA(0, 0, At, B0); PG8_MMA(0, 1, At, B1); PG8_BAR; PG8_SCHED;
            PG8_LDA(At, 1, 1); PG8_STAGE(PG8_SB(1, 0), b3, voffB); PG8_STAGE(PG8_SB(1, 1), b3 + hstep, voffB); PG8_STAGE(PG8_SA(1, 0), a3, voffA);
            PG8_WAIT_V(8); PG8_WAIT_L(0); PG8_BAR; PG8_MMA(1, 0, At, B0); PG8_MMA(1, 1, At, B1); PG8_BAR; PG8_SCHED;
            } else {
            PG8_LDB(B0, 0, 0); PG8_SCHED; PG8_LDA(At, 0, 0); PG8_STAGE(PG8_SA(1, 1), a1 + hstep, voffA);
            PG8_WAIT_L(8); PG8_BAR; PG8_WAIT_L(0); PG8_MMA(0, 0, At, B0); PG8_BAR; PG8_SCHED;
            PG8_LDB(B1, 0, 1); PG8_STAGE(PG8_SB(0, 0), b2, voffB);
            PG8_BAR; PG8_WAIT_L(0); PG8_MMA(0, 1, At, B1); PG8_BAR;
            PG8_LDA(At, 0, 1); PG8_STAGE(PG8_SA(0, 0), a2, voffA);
            PG8_BAR; PG8_WAIT_L(0); PG8_MMA(1, 0, At, B0); PG8_BAR; PG8_SCHED;
            PG8_STAGE(PG8_SB(0, 1), b2 + hstep, voffB);
            PG8_WAIT_V(6); PG8_BAR; PG8_MMA(1, 1, At, B1); PG8_BAR;
            PG8_LDB(B0, 1, 0); PG8_SCHED; PG8_LDA(At, 1, 0); PG8_STAGE(PG8_SA(0, 1), a2 + hstep, voffA);
            PG8_WAIT_L(8); PG8_BAR; PG8_WAIT_L(0); PG8_MMA(0, 0, At, B0); PG8_BAR; PG8_SCHED;
            PG8_LDB(B1, 1, 1); PG8_STAGE(PG8_SB(1, 0), b3, voffB);
            PG8_BAR; PG8_WAIT_L(0); PG8_MMA(0, 1, At, B1); PG8_BAR;
            PG8_LDA(At, 1, 1); PG8_STAGE(PG8_SA(1, 0), a3, voffA);
            PG8_BAR; PG8_WAIT_L(0); PG8_MMA(1, 0, At, B0); PG8_BAR; PG8_SCHED;
            PG8_STAGE(PG8_SB(1, 1), b3 + hstep, voffB);
            PG8_WAIT_V(6); PG8_BAR; PG8_MMA(1, 1, At, B1); PG8_BAR;
            }
        }
        if constexpr (ALIGN_EPI) { if (wr == 0) PG8_BAR; }
        asm volatile("s_nop 15\n\ts_nop 15" ::: "memory");
        if constexpr (!Epi::AFTER_DRAIN) { E(acc, cur, wr, wc, fr, fq); S.done(cur); }
        if (!has_next) break;
#pragma unroll
        for (int a = 0; a < 2; ++a)
#pragma unroll
            for (int b = 0; b < 2; ++b)
#pragma unroll
                for (int m = 0; m < 4; ++m)
#pragma unroll
                    for (int n = 0; n < 2; ++n) acc[a][b][m][n] = (f32x4){0.f, 0.f, 0.f, 0.f};
        cur = nxt; cA = nA; cB = nB; ++ui;
        if constexpr (ALIGN_EPI) { if (wr == 1) PG8_BAR; }
    }
    PG8_WAIT_V(0);
    if constexpr (!ALIGN_EPI) { if (wr == 0) PG8_BAR; }
    PG8_BAR;
    if constexpr (Epi::AFTER_DRAIN) { E.fused(acc, cur, wr, wc, fr, fq, lds, wid, lane); S.done(cur); }
#undef PG8_SA
#undef PG8_SB
#undef PG8_STAGE
#undef PG8_LDA
#undef PG8_LDB
#undef PG8_MMA
#undef PG8_WAIT_V
#undef PG8_WAIT_L
#undef PG8_BAR
#undef PG8_SCHED
}
}

#define LAS __attribute__((address_space(3)))
typedef unsigned short bf16;
typedef short bf16x8 __attribute__((ext_vector_type(8)));
typedef float f32x4 __attribute__((ext_vector_type(4)));
typedef float f32x16 __attribute__((ext_vector_type(16)));
typedef unsigned u32x2 __attribute__((ext_vector_type(2)));
typedef unsigned u32x4 __attribute__((ext_vector_type(4)));

constexpr int NB = 8, SEQ = 2048, NMETA = 16, LL = 2064, DM = 1024, FF = 4096, DIN = 4864, NPROJ = 1792;
constexpr int NREAL = NB * SEQ;
constexpr int TPR = NREAL + 256;
constexpr int LDS_BYTES = 147456;

constexpr size_t MiB = 1u << 20;
constexpr size_t WS_CTL = 0;
constexpr size_t WS_ROPE = 1 * MiB;
constexpr size_t WS_ABAR = 2 * MiB;
constexpr size_t WS_BMAT = 2 * MiB + 65536;
constexpr size_t WS_CMAT = WS_BMAT + 524288;
constexpr size_t WS_HM = 4 * MiB;
constexpr size_t WS_W = 5 * MiB;
constexpr size_t OW_IN = 0, OW_GLU = (size_t)DIN * DM * 2, OW_POOL = OW_GLU + 512 * 512 * 2, OW_BR = OW_POOL + 512 * 512 * 2,
                 OW_OUT = OW_BR + 3 * 1024 * 512 * 2, OW_UP = OW_OUT + 1024 * 1024 * 2, OW_DN = OW_UP + (size_t)FF * DM * 2, LW_BYTES = OW_DN + (size_t)FF * DM * 2;
constexpr size_t WS_HB = 68 * MiB;
constexpr size_t WS_X = 101 * MiB;
constexpr size_t UU = (size_t)TPR * 512 * 2;
constexpr size_t WS_YF = WS_X, WS_YP = WS_X, WS_Q = WS_X + 2 * UU, WS_K = WS_Q + UU, WS_V = WS_K + UU / 4, WS_MG = WS_X + 2 * UU,
                 WS_SU = WS_X + 4 * UU, WS_YA = WS_X + 8 * UU  , WS_PU = WS_X + 5 * UU, WS_YS = WS_PU, WS_Z = WS_X + 6 * UU, WS_PD = WS_X + 7 * UU, WS_BR = WS_Z, WS_ACT = WS_X;
constexpr size_t WS_RS = WS_X + 9 * UU;
constexpr size_t WS_END = WS_RS + (size_t)5 * TPR * 16 * 4;
static_assert(WS_W + 2 * LW_BYTES <= WS_HB && WS_HB + (size_t)TPR * 1024 * 2 <= WS_X && WS_END <= 256 * MiB, "ws map");
static_assert((size_t)256 * 2064 * 16 * 4 <= 2 * UU, "YF fits");

__device__ __forceinline__ unsigned pk2(float lo, float hi) { unsigned r; asm("v_cvt_pk_bf16_f32 %0, %1, %2" : "=v"(r) : "v"(lo), "v"(hi)); return r; }
__device__ __forceinline__ unsigned f2bf(float f) { return pk2(f, 0.f) & 0xffffu; }
__device__ __forceinline__ float bf2f(unsigned b) { return __uint_as_float(b << 16); }
__device__ __forceinline__ int tok_row(int b, int l) { return l >= NMETA ? b * SEQ + l - NMETA : NREAL + b * NMETA + l; }
#define LDS_FENCE() asm volatile("s_waitcnt lgkmcnt(0)" ::: "memory")
#define SSM_SYNC() do { asm volatile("s_waitcnt vmcnt(0) lgkmcnt(0)" ::: "memory"); __syncthreads(); } while (0)
__device__ __forceinline__ float row_rstd(const float* rs, int R) {
    const f32x4 a = *(const f32x4*)(rs + (size_t)R * 4), b = *(const f32x4*)(rs + ((size_t)TPR + R) * 4), c = *(const f32x4*)(rs + ((size_t)2 * TPR + R) * 4), d = *(const f32x4*)(rs + ((size_t)3 * TPR + R) * 4);
    const float s = (((a[0] + a[1]) + (a[2] + a[3])) + ((b[0] + b[1]) + (b[2] + b[3]))) + (((c[0] + c[1]) + (c[2] + c[3])) + ((d[0] + d[1]) + (d[2] + d[3])));
    return rsqrtf(s * (1.0f / 1024.0f) + 1e-6f);
}

__device__ __forceinline__ void dsincos(double a, double& s, double& c) {
    const double q = rint(a * 0.63661977236758134308);
    double r = fma(-q, 1.57079632679489655800e+00, a); r = fma(-q, 6.12323399573676603587e-17, r);
    const double r2 = r * r;
    double sp = -7.6471637318198164759e-13; sp = fma(sp, r2, 1.6059043836821614599e-10); sp = fma(sp, r2, -2.5052108385441718775e-08); sp = fma(sp, r2, 2.7557319223985890653e-06);
    sp = fma(sp, r2, -1.9841269841269841270e-04); sp = fma(sp, r2, 8.3333333333333333333e-03); sp = fma(sp, r2, -1.6666666666666666667e-01); sp = fma(sp * r2, r, r);
    double cp = 4.7794773323873852974e-14; cp = fma(cp, r2, -1.1470745597729724714e-11); cp = fma(cp, r2, 2.0876756987868098979e-09); cp = fma(cp, r2, -2.7557319223985890653e-07);
    cp = fma(cp, r2, 2.4801587301587301587e-05); cp = fma(cp, r2, -1.3888888888888888889e-03); cp = fma(cp, r2, 4.1666666666666666667e-02); cp = fma(cp, r2, -0.5); cp = fma(cp, r2, 1.0);
    const int qi = ((int)q) & 3;
    s = (qi == 0) ? sp : (qi == 1) ? cp : (qi == 2) ? -sp : -cp;
    c = (qi == 0) ? cp : (qi == 1) ? -sp : (qi == 2) ? -cp : sp;
}
__device__ __forceinline__ double dexp(double x) {
    const double k = rint(x * 1.44269504088896340736);
    double r = fma(-k, 6.93147180369123816490e-01, x); r = fma(-k, 1.90821492927058770002e-10, r);
    double p = 1.0 / 6227020800.0; p = fma(p, r, 1.0 / 479001600.0); p = fma(p, r, 1.0 / 39916800.0); p = fma(p, r, 1.0 / 3628800.0); p = fma(p, r, 1.0 / 362880.0); p = fma(p, r, 1.0 / 40320.0);
    p = fma(p, r, 1.0 / 5040.0); p = fma(p, r, 1.0 / 720.0); p = fma(p, r, 1.0 / 120.0); p = fma(p, r, 1.0 / 24.0); p = fma(p, r, 1.0 / 6.0); p = fma(p, r, 0.5); p = fma(p, r, 1.0); p = fma(p, r, 1.0);
    const long long bits = ((long long)(1023 + (int)k)) << 52;
    return p * __longlong_as_double(bits);
}

struct EpiInProj {
    static constexpr bool PERM = true, AFTER_DRAIN = false;
    const float* rowss; const float* rope; bf16 *Q, *K, *V, *SU, *PU;
    __device__ __forceinline__ u32x2 quad(int l, int c, const f32x4& v) const {
        u32x2 w;
        if (c < 640) {
            const int i0 = (c & 63) >> 1;
            const f32x4 cs = *(const f32x4*)(rope + ((size_t)l * 32 + i0) * 2);
            float o0 = v[0] * cs[0] - v[1] * cs[1], o1 = v[1] * cs[0] + v[0] * cs[1], o2 = v[2] * cs[2] - v[3] * cs[3], o3 = v[3] * cs[2] + v[2] * cs[3];
            if (c < 512) { o0 *= 0.125f; o1 *= 0.125f; o2 *= 0.125f; o3 *= 0.125f; }
            w.x = pk2(o0, o1); w.y = pk2(o2, o3);
        } else { w.x = pk2(v[0], v[1]); w.y = pk2(v[2], v[3]); }
        return w;
    }
    __device__ __forceinline__ void operator()(const f32x4 (&acc)[2][2][4][2], const pg8::Unit& u, int wr, int wc, int fr, int fq) const {
#pragma unroll
        for (int ai = 0; ai < 2; ++ai)
#pragma unroll
            for (int m = 0; m < 4; ++m) {
                const int R = u.pm * 256 + ai * 128 + wr * 64 + m * 16 + fr;
                const float rs = row_rstd(rowss, R);
                const int l = R < NREAL ? (R & 2047) + NMETA : (R & 15);
#pragma unroll
                for (int bj = 0; bj < 2; ++bj) {
                    const int c = u.pn * 256 + bj * 128 + wc * 32 + 8 * fq;
                    const u32x2 w0 = quad(l, c, acc[ai][bj][m][0] * rs), w1 = quad(l, c + 4, acc[ai][bj][m][1] * rs);
                    u32x4 w; w.x = w0.x; w.y = w0.y; w.z = w1.x; w.w = w1.y;
                    bf16* dst = c < 512 ? Q + (size_t)R * 512 + c : c < 640 ? K + (size_t)R * 128 + (c - 512) : c < 768 ? V + (size_t)R * 128 + (c - 640)
                              : c < 1280 ? SU + (size_t)R * 512 + (c - 768) : PU + (size_t)R * 512 + (c - 1280);
                    *(u32x4*)dst = w;
                }
            }
    }
};
#define EPI_BODY() \
    __device__ __forceinline__ void rg(int R, int pn, int wc, int fq, const f32x4 (&a4)[2][2]) const { \
        _Pragma("unroll") for (int bj = 0; bj < 2; ++bj) q2(R, pn * 256 + bj * 128 + wc * 32 + 8 * fq, a4[bj][0], a4[bj][1]); } \
    __device__ __forceinline__ void tq(int R, int c, const f32x4& v) const { q(R, c, v); } \
    EPI_OP()
#define EPI_OP() \
    __device__ __forceinline__ void operator()(const f32x4 (&acc)[2][2][4][2], const pg8::Unit& u, int wr, int wc, int fr, int fq) const { \
        _Pragma("unroll") for (int ai = 0; ai < 2; ++ai) _Pragma("unroll") for (int m = 0; m < 4; ++m) { \
            const f32x4 a4[2][2] = {{acc[ai][0][m][0], acc[ai][0][m][1]}, {acc[ai][1][m][0], acc[ai][1][m][1]}}; \
            rg(u.pm * 256 + ai * 128 + wr * 64 + m * 16 + fr, u.pn, wc, fq, a4); } }
#define EPI_BODY_RS() \
    __device__ __forceinline__ void rg(int R, int pn, int wc, int fq, const f32x4 (&a4)[2][2]) const { const float rs = row_rstd(rowss, R); \
        _Pragma("unroll") for (int bj = 0; bj < 2; ++bj) q2(R, pn * 256 + bj * 128 + wc * 32 + 8 * fq, a4[bj][0], a4[bj][1], rs); } \
    __device__ __forceinline__ void tq(int R, int c, const f32x4& v) const { q(R, c, v, row_rstd(rowss, R)); } \
    EPI_OP()
struct EpiGlu {
    static constexpr bool PERM = true, AFTER_DRAIN = false;
    const bf16* Z; const float* bias; bf16* YS;
    __device__ __forceinline__ void q(int R, int c, const f32x4& a) const {
        const f32x4 v = a + *(const f32x4*)(bias + c);
        const u32x2 zz = *(const u32x2*)(Z + (size_t)R * 512 + c);
        const float z0 = bf2f(zz.x & 0xffffu), z1 = bf2f(zz.x >> 16), z2 = bf2f(zz.y & 0xffffu), z3 = bf2f(zz.y >> 16);
        u32x2 w; w.x = pk2(z0 * __builtin_amdgcn_rcpf(1.0f + __expf(-v[0])), z1 * __builtin_amdgcn_rcpf(1.0f + __expf(-v[1]))); w.y = pk2(z2 * __builtin_amdgcn_rcpf(1.0f + __expf(-v[2])), z3 * __builtin_amdgcn_rcpf(1.0f + __expf(-v[3])));
        *(u32x2*)(YS + (size_t)R * 512 + c) = w;
    }
    __device__ __forceinline__ void q2(int R, int c, const f32x4& a0, const f32x4& a1) const {
        const f32x4 v0 = a0 + *(const f32x4*)(bias + c), v1 = a1 + *(const f32x4*)(bias + c + 4);
        const u32x4 zz = *(const u32x4*)(Z + (size_t)R * 512 + c);
        u32x4 w;
        w.x = pk2(bf2f(zz.x & 0xffffu) * __builtin_amdgcn_rcpf(1.0f + __expf(-v0[0])), bf2f(zz.x >> 16) * __builtin_amdgcn_rcpf(1.0f + __expf(-v0[1])));
        w.y = pk2(bf2f(zz.y & 0xffffu) * __builtin_amdgcn_rcpf(1.0f + __expf(-v0[2])), bf2f(zz.y >> 16) * __builtin_amdgcn_rcpf(1.0f + __expf(-v0[3])));
        w.z = pk2(bf2f(zz.z & 0xffffu) * __builtin_amdgcn_rcpf(1.0f + __expf(-v1[0])), bf2f(zz.z >> 16) * __builtin_amdgcn_rcpf(1.0f + __expf(-v1[1])));
        w.w = pk2(bf2f(zz.w & 0xffffu) * __builtin_amdgcn_rcpf(1.0f + __expf(-v1[2])), bf2f(zz.w >> 16) * __builtin_amdgcn_rcpf(1.0f + __expf(-v1[3])));
        *(u32x4*)(YS + (size_t)R * 512 + c) = w;
    }
    EPI_BODY()
};
struct EpiScale {
    static constexpr bool PERM = true, AFTER_DRAIN = false;
    bf16* O; int ldc; const float* scale;
    __device__ __forceinline__ void q(int R, int c, const f32x4& a) const {
        f32x4 v = a;
        if (scale) v = v * *(const f32x4*)(scale + c);
        u32x2 w; w.x = pk2(v[0], v[1]); w.y = pk2(v[2], v[3]);
        *(u32x2*)(O + (size_t)R * ldc + c) = w;
    }
    __device__ __forceinline__ void q2(int R, int c, const f32x4& a0, const f32x4& a1) const {
        f32x4 v0 = a0, v1 = a1;
        if (scale) { v0 = v0 * *(const f32x4*)(scale + c); v1 = v1 * *(const f32x4*)(scale + c + 4); }
        u32x4 w; w.x = pk2(v0[0], v0[1]); w.y = pk2(v0[2], v0[3]); w.z = pk2(v1[0], v1[1]); w.w = pk2(v1[2], v1[3]);
        *(u32x4*)(O + (size_t)R * ldc + c) = w;
    }
    EPI_BODY()
};
template <bool FIRST> struct EpiGate {
    static constexpr bool PERM = true, AFTER_DRAIN = false;
    const float* rowss; const bf16* BR; bf16* MG;
    __device__ __forceinline__ void q(int R, int c, const f32x4& a, float rs) const {
        const f32x4 v = a * rs;
        const u32x2 bb = *(const u32x2*)(BR + (size_t)R * 1024 + c);
        float o0 = bf2f(bb.x & 0xffffu) * __builtin_amdgcn_rcpf(1.0f + __expf(-v[0])), o1 = bf2f(bb.x >> 16) * __builtin_amdgcn_rcpf(1.0f + __expf(-v[1]));
        float o2 = bf2f(bb.y & 0xffffu) * __builtin_amdgcn_rcpf(1.0f + __expf(-v[2])), o3 = bf2f(bb.y >> 16) * __builtin_amdgcn_rcpf(1.0f + __expf(-v[3]));
        if (!FIRST) { const u32x2 mm = *(const u32x2*)(MG + (size_t)R * 1024 + c);
            o0 += bf2f(mm.x & 0xffffu); o1 += bf2f(mm.x >> 16); o2 += bf2f(mm.y & 0xffffu); o3 += bf2f(mm.y >> 16); }
        u32x2 w; w.x = pk2(o0, o1); w.y = pk2(o2, o3);
        *(u32x2*)(MG + (size_t)R * 1024 + c) = w;
    }
    __device__ __forceinline__ void q2(int R, int c, const f32x4& a0, const f32x4& a1, float rs) const {
        const f32x4 v0 = a0 * rs, v1 = a1 * rs;
        const u32x4 bb = *(const u32x4*)(BR + (size_t)R * 1024 + c);
        float o[8];
        o[0] = bf2f(bb.x & 0xffffu) * __builtin_amdgcn_rcpf(1.0f + __expf(-v0[0])); o[1] = bf2f(bb.x >> 16) * __builtin_amdgcn_rcpf(1.0f + __expf(-v0[1]));
        o[2] = bf2f(bb.y & 0xffffu) * __builtin_amdgcn_rcpf(1.0f + __expf(-v0[2])); o[3] = bf2f(bb.y >> 16) * __builtin_amdgcn_rcpf(1.0f + __expf(-v0[3]));
        o[4] = bf2f(bb.z & 0xffffu) * __builtin_amdgcn_rcpf(1.0f + __expf(-v1[0])); o[5] = bf2f(bb.z >> 16) * __builtin_amdgcn_rcpf(1.0f + __expf(-v1[1]));
        o[6] = bf2f(bb.w & 0xffffu) * __builtin_amdgcn_rcpf(1.0f + __expf(-v1[2])); o[7] = bf2f(bb.w >> 16) * __builtin_amdgcn_rcpf(1.0f + __expf(-v1[3]));
        if (!FIRST) { const u32x4 mm = *(const u32x4*)(MG + (size_t)R * 1024 + c);
            o[0] += bf2f(mm.x & 0xffffu); o[1] += bf2f(mm.x >> 16); o[2] += bf2f(mm.y & 0xffffu); o[3] += bf2f(mm.y >> 16);
            o[4] += bf2f(mm.z & 0xffffu); o[5] += bf2f(mm.z >> 16); o[6] += bf2f(mm.w & 0xffffu); o[7] += bf2f(mm.w >> 16); }
        u32x4 w; w.x = pk2(o[0], o[1]); w.y = pk2(o[2], o[3]); w.z = pk2(o[4], o[5]); w.w = pk2(o[6], o[7]);
        *(u32x4*)(MG + (size_t)R * 1024 + c) = w;
    }
    EPI_BODY_RS()
};
struct EpiRes {
    static constexpr bool PERM = true, AFTER_DRAIN = false;
    const float* Xin; bf16* HB; float* rowss_out;
    __device__ __forceinline__ float q(int R, int c, const f32x4& a) const {
        f32x4 h;
        if (Xin && R < NREAL) h = *(const f32x4*)(Xin + (size_t)R * 1024 + c);
        else { const u32x2 hb = *(const u32x2*)(HB + (size_t)R * 1024 + c); h = (f32x4){bf2f(hb.x & 0xffffu), bf2f(hb.x >> 16), bf2f(hb.y & 0xffffu), bf2f(hb.y >> 16)}; }
        h = h + a;
        u32x2 w; w.x = pk2(h[0], h[1]); w.y = pk2(h[2], h[3]);
        *(u32x2*)(HB + (size_t)R * 1024 + c) = w;
        const float r0 = bf2f(w.x & 0xffffu), r1 = bf2f(w.x >> 16), r2 = bf2f(w.y & 0xffffu), r3 = bf2f(w.y >> 16);
        return (r0 * r0 + r1 * r1) + (r2 * r2 + r3 * r3);
    }
    __device__ __forceinline__ float q2(int R, int c, const f32x4& a0, const f32x4& a1) const {
        f32x4 h0, h1;
        if (Xin && R < NREAL) { h0 = *(const f32x4*)(Xin + (size_t)R * 1024 + c); h1 = *(const f32x4*)(Xin + (size_t)R * 1024 + c + 4); }
        else { const u32x4 hb = *(const u32x4*)(HB + (size_t)R * 1024 + c);
            h0 = (f32x4){bf2f(hb.x & 0xffffu), bf2f(hb.x >> 16), bf2f(hb.y & 0xffffu), bf2f(hb.y >> 16)}; h1 = (f32x4){bf2f(hb.z & 0xffffu), bf2f(hb.z >> 16), bf2f(hb.w & 0xffffu), bf2f(hb.w >> 16)}; }
        h0 = h0 + a0; h1 = h1 + a1;
        u32x4 w; w.x = pk2(h0[0], h0[1]); w.y = pk2(h0[2], h0[3]); w.z = pk2(h1[0], h1[1]); w.w = pk2(h1[2], h1[3]);
        *(u32x4*)(HB + (size_t)R * 1024 + c) = w;
        const float r0 = bf2f(w.x & 0xffffu), r1 = bf2f(w.x >> 16), r2 = bf2f(w.y & 0xffffu), r3 = bf2f(w.y >> 16), r4 = bf2f(w.z & 0xffffu), r5 = bf2f(w.z >> 16), r6 = bf2f(w.w & 0xffffu), r7 = bf2f(w.w >> 16);
        return ((r0 * r0 + r1 * r1) + (r2 * r2 + r3 * r3)) + ((r4 * r4 + r5 * r5) + (r6 * r6 + r7 * r7));
    }
    __device__ __forceinline__ void rg(int R, int pn, int wc, int fq, const f32x4 (&a4)[2][2]) const {
        float ss = 0.f;
#pragma unroll
        for (int bj = 0; bj < 2; ++bj) ss += q2(R, pn * 256 + bj * 128 + wc * 32 + 8 * fq, a4[bj][0], a4[bj][1]);
        ss += __shfl_xor(ss, 16); ss += __shfl_xor(ss, 32);
        if (fq == 0) rowss_out[((size_t)pn * TPR + R) * 4 + wc] = ss;
    }
    __device__ __forceinline__ void tq(int R, int c, const f32x4& v) const {
        float ss = q(R, c, v);
        ss += __shfl_xor(ss, 16); ss += __shfl_xor(ss, 32);
        if ((threadIdx.x & 48) == 0) atomicAdd(rowss_out + (size_t)R * 4, ss);
    }
    EPI_OP()
};
struct EpiUp {
    static constexpr bool PERM = true, AFTER_DRAIN = false;
    const float* rowss; bf16* ACT;
    __device__ __forceinline__ void q(int R, int c, const f32x4& a, float rs) const {
        f32x4 v = a * rs;
#pragma unroll
        for (int j = 0; j < 4; ++j) { const float r = fmaxf(v[j], 0.f); v[j] = r * r; }
        u32x2 w; w.x = pk2(v[0], v[1]); w.y = pk2(v[2], v[3]);
        *(u32x2*)(ACT + (size_t)R * FF + c) = w;
    }
    __device__ __forceinline__ void q2(int R, int c, const f32x4& a0, const f32x4& a1, float rs) const {
        f32x4 v0 = a0 * rs, v1 = a1 * rs;
#pragma unroll
        for (int j = 0; j < 4; ++j) { const float r0 = fmaxf(v0[j], 0.f), r1 = fmaxf(v1[j], 0.f); v0[j] = r0 * r0; v1[j] = r1 * r1; }
        u32x4 w; w.x = pk2(v0[0], v0[1]); w.y = pk2(v0[2], v0[3]); w.z = pk2(v1[0], v1[1]); w.w = pk2(v1[2], v1[3]);
        *(u32x4*)(ACT + (size_t)R * FF + c) = w;
    }
    EPI_BODY_RS()
};
struct TripleOrder {
    pg8::StaticOrder S0; int arow, bcol;
    __device__ __forceinline__ void init(int G, int c, int arow_, int bcol_) { S0.init(NREAL, 1024, G, c); arow = arow_; bcol = bcol_; }
    __device__ __forceinline__ bool next(int i, pg8::Unit& u) const { pg8::Unit t; t.pm = 0; t.pn = 0; if (!S0.next(i / 3, t)) return false; const int br = i % 3; u.pm = t.pm + br * arow; u.pn = t.pn + br * bcol; return true; }
    __device__ __forceinline__ void a_ready(const pg8::Unit&) const {}
    __device__ __forceinline__ void done(const pg8::Unit&) const {}
};
struct EpiBr3 {
    static constexpr bool PERM = true, AFTER_DRAIN = false;
    bf16* Bbase; int arow;
    __device__ __forceinline__ void operator()(const f32x4 (&acc)[2][2][4][2], const pg8::Unit& u, int wr, int wc, int fr, int fq) const {
        const int c = u.pn >> 2, pn = u.pn & 3, pm = u.pm - arow * c; bf16* O = Bbase + (size_t)(2 * c + 2 * (c > 0)) * (UU / 2);
#pragma unroll
        for (int ai = 0; ai < 2; ++ai)
#pragma unroll
            for (int m = 0; m < 4; ++m) { const int R = pm * 256 + ai * 128 + wr * 64 + m * 16 + fr;
#pragma unroll
                for (int bj = 0; bj < 2; ++bj) { const f32x4 v0 = acc[ai][bj][m][0], v1 = acc[ai][bj][m][1];
                    u32x4 w; w.x = pk2(v0[0], v0[1]); w.y = pk2(v0[2], v0[3]); w.z = pk2(v1[0], v1[1]); w.w = pk2(v1[2], v1[3]);
                    *(u32x4*)(O + (size_t)R * 1024 + pn * 256 + bj * 128 + wc * 32 + 8 * fq) = w; } }
    }
};
struct EpiGate3 {
    static constexpr bool PERM = true, AFTER_DRAIN = false;
    const float* rowss; const bf16* Bbase; bf16* MG;
    __device__ __forceinline__ void operator()(const f32x4 (&acc)[2][2][4][2], const pg8::Unit& u, int wr, int wc, int fr, int fq) const {
        const int c = u.pn >> 2, pn = u.pn & 3; const bf16* BR = Bbase + (size_t)(2 * c + 2 * (c > 0)) * (UU / 2);
#pragma unroll
        for (int ai = 0; ai < 2; ++ai)
#pragma unroll
            for (int m = 0; m < 4; ++m) { const int R = u.pm * 256 + ai * 128 + wr * 64 + m * 16 + fr; const float rs = row_rstd(rowss, R);
#pragma unroll
                for (int bj = 0; bj < 2; ++bj) { const int cc = pn * 256 + bj * 128 + wc * 32 + 8 * fq;
                    const f32x4 v0 = acc[ai][bj][m][0] * rs, v1 = acc[ai][bj][m][1] * rs;
                    const u32x4 bb = *(const u32x4*)(BR + (size_t)R * 1024 + cc);
                    float o[8];
                    o[0] = bf2f(bb.x & 0xffffu) * __builtin_amdgcn_rcpf(1.0f + __expf(-v0[0])); o[1] = bf2f(bb.x >> 16) * __builtin_amdgcn_rcpf(1.0f + __expf(-v0[1]));
                    o[2] = bf2f(bb.y & 0xffffu) * __builtin_amdgcn_rcpf(1.0f + __expf(-v0[2])); o[3] = bf2f(bb.y >> 16) * __builtin_amdgcn_rcpf(1.0f + __expf(-v0[3]));
                    o[4] = bf2f(bb.z & 0xffffu) * __builtin_amdgcn_rcpf(1.0f + __expf(-v1[0])); o[5] = bf2f(bb.z >> 16) * __builtin_amdgcn_rcpf(1.0f + __expf(-v1[1]));
                    o[6] = bf2f(bb.w & 0xffffu) * __builtin_amdgcn_rcpf(1.0f + __expf(-v1[2])); o[7] = bf2f(bb.w >> 16) * __builtin_amdgcn_rcpf(1.0f + __expf(-v1[3]));
                    if (c != 0) { const u32x4 mm = *(const u32x4*)(MG + (size_t)R * 1024 + cc);
                        o[0] += bf2f(mm.x & 0xffffu); o[1] += bf2f(mm.x >> 16); o[2] += bf2f(mm.y & 0xffffu); o[3] += bf2f(mm.y >> 16);
                        o[4] += bf2f(mm.z & 0xffffu); o[5] += bf2f(mm.z >> 16); o[6] += bf2f(mm.w & 0xffffu); o[7] += bf2f(mm.w >> 16); }
                    u32x4 w; w.x = pk2(o[0], o[1]); w.y = pk2(o[2], o[3]); w.z = pk2(o[4], o[5]); w.w = pk2(o[6], o[7]);
                    *(u32x4*)(MG + (size_t)R * 1024 + cc) = w; } }
    }
};
template <class Epi, bool SUM3 = false>
__device__ __forceinline__ void thin_gemm(LAS unsigned char* lds, const bf16* A, const bf16* Bt, int K, int N, const Epi& E, int vb, int vg, size_t asum_stride = 0) {
    int tid_l = threadIdx.x; asm volatile("" : "+v"(tid_l));
    const int lane = tid_l & 63, w = __builtin_amdgcn_readfirstlane(tid_l >> 6), fr = lane & 15, fq = lane >> 4;
    LAS f32x4* red = (LAS f32x4*)lds;
    const int kw = K >> 3;
    for (int pc = vb; pc < N / 16; pc += vg) {
        const bf16* ap = A + (size_t)(NREAL + fr) * K + w * kw + 8 * fq;
        const bf16* bp = Bt + (size_t)(16 * pc + fr) * K + w * kw + 8 * fq;
        f32x4 acc[8];
#pragma unroll
        for (int rb = 0; rb < 8; ++rb) acc[rb] = (f32x4){0.f, 0.f, 0.f, 0.f};
#pragma unroll (SUM3 ? 1 : 4)
        for (int k0 = 0; k0 < kw; k0 += 32) {
            const bf16x8 bf = *(const bf16x8*)(bp + k0);
            bf16x8 af[8];
#pragma unroll
            for (int rb = 0; rb < 8; ++rb) {
                if constexpr (!SUM3) af[rb] = *(const bf16x8*)(ap + (size_t)(16 * rb) * K + k0);
                else {
                    const bf16* a0 = ap + (size_t)(16 * rb) * K + k0;
                    const u32x4 x0 = *(const u32x4*)a0, x1 = *(const u32x4*)(a0 + asum_stride), x2 = *(const u32x4*)(a0 + 2 * asum_stride);
                    union { bf16x8 v; unsigned u[4]; } s;
                    const unsigned w0[4] = {x0.x, x0.y, x0.z, x0.w}, w1[4] = {x1.x, x1.y, x1.z, x1.w}, w2[4] = {x2.x, x2.y, x2.z, x2.w};
#pragma unroll
                    for (int j = 0; j < 4; ++j) s.u[j] = pk2((bf2f(w0[j] & 0xffffu) + bf2f(w1[j] & 0xffffu)) + bf2f(w2[j] & 0xffffu), (bf2f(w0[j] >> 16) + bf2f(w1[j] >> 16)) + bf2f(w2[j] >> 16));
                    af[rb] = s.v;
                }
            }
#pragma unroll
            for (int rb = 0; rb < 8; ++rb) acc[rb] = __builtin_amdgcn_mfma_f32_16x16x32_bf16(bf, af[rb], acc[rb], 0, 0, 0);
        }
        asm volatile("s_nop 15\n\ts_nop 15" : "+v"(acc[0]), "+v"(acc[1]), "+v"(acc[2]), "+v"(acc[3]), "+v"(acc[4]), "+v"(acc[5]), "+v"(acc[6]), "+v"(acc[7]));
#pragma unroll
        for (int rb = 0; rb < 8; ++rb) red[(w * 8 + rb) * 64 + lane] = acc[rb];
        LDS_FENCE(); __syncthreads();
        f32x4 v = red[(0 * 8 + w) * 64 + lane];
#pragma unroll
        for (int ww = 1; ww < 8; ++ww) v = v + red[(ww * 8 + w) * 64 + lane];
        LDS_FENCE(); __syncthreads();
        E.tq(NREAL + 16 * w + fr, 16 * pc + 4 * fq, v);
    }
}

struct Args { const float* in[23]; float* out; unsigned char* ws; };

__device__ __forceinline__ void p0_item(const float* W, int ldw, int K, const float* scale, bf16* WT, int permrows, LAS float* scr, int item, int nblk, int lane) {
    const int kb = item / nblk, nb = item % nblk, k0 = 64 * kb, n0 = 64 * nb;
#pragma unroll 4
    for (int i = 0; i < 16; ++i) {
        const int kk = 4 * i + (lane >> 4), c4 = (lane & 15) * 4;
        f32x4 w = __builtin_nontemporal_load((const f32x4*)(W + (size_t)(k0 + kk) * ldw + n0 + c4));
        if (scale) w = w * scale[k0 + kk];
        scr[kk * 65 + c4] = w[0]; scr[kk * 65 + c4 + 1] = w[1]; scr[kk * 65 + c4 + 2] = w[2]; scr[kk * 65 + c4 + 3] = w[3];
    }
    LDS_FENCE();
    const int c = lane & 7;
#pragma unroll
    for (int j = 0; j < 8; ++j) {
        const int n = (lane >> 3) + 8 * j;
        const int sc = (n0 + n) < permrows ? ((n & 1) ? 32 + (n >> 1) : (n >> 1)) : n;
        const LAS float* s = scr + (8 * c) * 65 + sc;
        u32x4 o; o.x = pk2(s[0 * 65], s[1 * 65]); o.y = pk2(s[2 * 65], s[3 * 65]); o.z = pk2(s[4 * 65], s[5 * 65]); o.w = pk2(s[6 * 65], s[7 * 65]);
        *(u32x4*)(WT + (size_t)(n0 + n) * K + k0 + 8 * c) = o;
    }
    LDS_FENCE();
}

typedef const __attribute__((address_space(4))) Args* KArgsP;
__device__ __forceinline__ void convert_layer_weights(KArgsP ka, LAS unsigned char* lds, int layer, int vw, int nvw, int wave, int lane, int part  ) {
    unsigned char* ws = ka->ws;
    LAS float* scr = (LAS float*)(lds + wave * 17408);
    constexpr int I_IN = 16 * 76, I_GLU = 8 * 8, I_BR = 8 * 16, I_OUT = 16 * 16, I_UP = 16 * 64, I_DN = 64 * 16, I_L = I_IN + I_GLU + 3 * I_BR + I_OUT + I_UP + I_DN;
    unsigned char* wl = ws + WS_W + (size_t)layer * LW_BYTES;
    for (int it = (part == 0 ? 0 : I_IN) + vw; it < (part == 0 ? I_IN : I_L); it += nvw) {
        int r = it;
        if (r < I_IN) { p0_item(ka->in[3] + (size_t)layer * DM * DIN, DIN, DM, ka->in[2] + layer * DM, (bf16*)(wl + OW_IN), 640, scr, r, 76, lane); continue; } r -= I_IN;
        if (r < I_GLU) { p0_item(ka->in[13] + (size_t)layer * 512 * 512, 512, 512, nullptr, (bf16*)(wl + OW_GLU), 0, scr, r, 8, lane); continue; } r -= I_GLU;
        if (r < 3 * I_BR) { const int c = r / I_BR; p0_item(ka->in[17] + ((size_t)layer * 3 + c) * 512 * 1024, 1024, 512, nullptr, (bf16*)(wl + OW_BR) + (size_t)c * 1024 * 512, 0, scr, r % I_BR, 16, lane); continue; } r -= 3 * I_BR;
        if (r < I_OUT) { p0_item(ka->in[18] + (size_t)layer * DM * DM, DM, DM, nullptr, (bf16*)(wl + OW_OUT), 0, scr, r, 16, lane); continue; } r -= I_OUT;
        if (r < I_UP) { p0_item(ka->in[20] + (size_t)layer * DM * FF, FF, DM, ka->in[19] + layer * DM, (bf16*)(wl + OW_UP), 0, scr, r, 64, lane); continue; } r -= I_UP;
        p0_item(ka->in[21] + (size_t)layer * FF * DM, DM, FF, nullptr, (bf16*)(wl + OW_DN), 0, scr, r, 16, lane);
    }
    if (part == 1) for (int i = vw * 64 + lane; i < 512 * 64; i += nvw * 64) {
        const int n = i >> 6, k0 = (i & 63) * 8;
        u32x4 o = {0u, 0u, 0u, 0u};
        if ((n >> 7) == (k0 >> 7)) { const float* src = ka->in[15] + (((size_t)layer * 4 + (n >> 7)) * 128 + (k0 & 127)) * 128 + (n & 127);
            o.x = pk2(src[0], src[128]); o.y = pk2(src[256], src[384]); o.z = pk2(src[512], src[640]); o.w = pk2(src[768], src[896]); }
        *(u32x4*)((bf16*)(wl + OW_POOL) + (size_t)n * 512 + k0) = o;
    }
}

__device__ __forceinline__ void p0_prologue(const Args& a, LAS unsigned char* lds) {
    int tl_ = threadIdx.x; asm volatile("" : "+v"(tl_));
    const int tid = tl_, lane = tid & 63, wave = __builtin_amdgcn_readfirstlane(tid >> 6);
    const int gw = blockIdx.x * 8 + wave, NGW = gridDim.x * 8;
    const int gt = blockIdx.x * 512 + tid, NGT = gridDim.x * 512;
    unsigned char* ws = a.ws;
    for (int i = gt; i < 4 * 4 * 128 * 4; i += NGT) { const int idx = 1 + (i >> 11), pn = (i >> 9) & 3, r = (i >> 2) & 127, sl = i & 3;
        ((float*)(ws + WS_RS))[((size_t)idx * 4 * TPR + (size_t)pn * TPR + NREAL + r) * 4 + sl] = 0.f; }
    for (int i = gt; i < LL * 32; i += NGT) {
        const int l = i >> 5, f = i & 31;
        const float invf = (float)dexp(-(double)f * (9.21034037197618273607 / 32.0));
        const float ang = (float)l * invf;
        double s, c; dsincos((double)ang, s, c);
        float* rp = (float*)(ws + WS_ROPE) + (size_t)i * 2; rp[0] = (float)c; rp[1] = (float)s;
    }
    for (int j = gt; j < 2 * 2 * 32 * 64 * 16; j += NGT) {
        const int q = j & 15, i = j >> 4, n = i & 63, pidx = i >> 6;
        const double lr = (double)a.in[5][i], li = (double)a.in[6][i];
        const double dt = (double)(float)dexp((double)a.in[7][pidx]);
        const double mag = dexp(lr * dt); double sn, cn; dsincos(li * dt, sn, cn);
        const double are = mag * cn, aim = mag * sn, den = lr * lr + li * li, nre = are - 1.0;
        const double fre = (nre * lr + aim * li) / den, fim = (aim * lr - nre * li) / den;
        if (q == 0) { float* ab = (float*)(ws + WS_ABAR) + (size_t)i * 2; ab[0] = (float)are; ab[1] = (float)aim; }
        bf16* bm = (bf16*)(ws + WS_BMAT) + (size_t)pidx * 128 * 16;
        bf16* cm = (bf16*)(ws + WS_CMAT) + (size_t)pidx * 16 * 128;
        const double br = (double)a.in[8][(size_t)i * 16 + q], bi = (double)a.in[9][(size_t)i * 16 + q];
        bm[n * 16 + q] = (bf16)f2bf((float)(fre * br - fim * bi));
        bm[(64 + n) * 16 + q] = (bf16)f2bf((float)(fre * bi + fim * br));
        *(unsigned*)(cm + q * 128 + 2 * n) = pk2(a.in[10][((size_t)pidx * 16 + q) * 64 + n], -a.in[11][((size_t)pidx * 16 + q) * 64 + n]);
    }
    for (int R = gw; R < TPR; R += NGW) {
        const int mrow = R - NREAL;
        const float* src = R < NREAL ? a.in[0] + (size_t)R * DM : a.in[1] + (size_t)(mrow & 15) * DM;
        float* dst = R < NREAL ? a.out + (size_t)R * DM : (float*)(ws + WS_HM) + (size_t)mrow * DM;
        bf16* hb = (bf16*)(ws + WS_HB) + (size_t)R * DM;
        const bool pad = mrow >= NB * NMETA;
        float ss = 0.f;
#pragma unroll
        for (int j = 0; j < 4; ++j) {
            f32x4 v = __builtin_nontemporal_load((const f32x4*)(src + 4 * lane + 256 * j));
            if (pad) v = (f32x4){0.f, 0.f, 0.f, 0.f};
            ss += (v[0] * v[0] + v[1] * v[1]) + (v[2] * v[2] + v[3] * v[3]);
            u32x2 w; w.x = pk2(v[0], v[1]); w.y = pk2(v[2], v[3]);
            *(u32x2*)(hb + 4 * lane + 256 * j) = w;
        }
#pragma unroll
        for (int o = 1; o < 64; o <<= 1) ss += __shfl_xor(ss, o);
        if (lane < 16) ((float*)(ws + WS_RS))[((size_t)(lane >> 2) * TPR + R) * 4 + (lane & 3)] = lane == 0 ? ss : 0.f;
    }
}

__device__ __forceinline__ void ssm_task(LAS unsigned char* lds, int task, int layer, const bf16* SU, float* YF,
                                         const float* abar_all, const bf16* bmat_all, const bf16* cmat_all) {
    int tid_l = threadIdx.x; asm volatile("" : "+v"(tid_l));
    const int tid = tid_l, lane = tid & 63, wave = __builtin_amdgcn_readfirstlane(tid >> 6);
    const int b = task >> 5, g = task & 31;
    __syncthreads();
    LAS float* BU = (LAS float*)(lds + wave * 12800);
    LAS unsigned short* X = (LAS unsigned short*)(lds + wave * 12800 + 8448);
    LAS float* SX = (LAS float*)(lds + 8 * 12800);
    const int blk0 = wave == 0 ? 0 : 16 * wave + 1, nblk = wave == 0 ? 17 : 16;
    bf16* yfb = (bf16*)YF + (size_t)task * LL * 16;
    const int fr = lane & 15, fq = lane >> 4;
    const bf16x8 zero8 = {0, 0, 0, 0, 0, 0, 0, 0};
    for (int dir = 0; dir < 2; ++dir) {
        const int pidx = (layer * 2 + dir) * 32 + g;
        const float are = abar_all[((size_t)pidx * 64 + lane) * 2], aim = abar_all[((size_t)pidx * 64 + lane) * 2 + 1];
        bf16x8 bfr[8], cfr[4];
        const bf16* bm = bmat_all + (size_t)pidx * 128 * 16;
#pragma unroll
        for (int nt = 0; nt < 8; ++nt) bfr[nt] = fq < 2 ? *(const bf16x8*)(bm + (nt * 16 + fr) * 16 + 8 * fq) : zero8;
        const bf16* cm = cmat_all + (size_t)pidx * 16 * 128;
#pragma unroll
        for (int ks = 0; ks < 4; ++ks) cfr[ks] = *(const bf16x8*)(cm + fr * 128 + ks * 32 + 8 * fq);
        float p16r = are, p16i = aim;
#pragma unroll
        for (int i = 0; i < 4; ++i) { const float tr = p16r * p16r - p16i * p16i, ti = 2.f * p16r * p16i; p16r = tr; p16i = ti; }
        float p256r = p16r, p256i = p16i;
#pragma unroll
        for (int i = 0; i < 4; ++i) { const float tr = p256r * p256r - p256i * p256i, ti = 2.f * p256r * p256i; p256r = tr; p256i = ti; }
        const float p272r = p256r * p16r - p256i * p16i, p272i = p256r * p16i + p256i * p16r;

        float xre = 0.f, xim = 0.f;
        for (int pass = 0; pass < 2; ++pass) {
            bf16x8 unext;
            { const int blkf = dir == 0 ? blk0 : blk0 + nblk - 1; const int Rf = blkf == 0 ? NREAL + b * NMETA : b * SEQ + blkf * 16 - NMETA;
              unext = fq < 2 ? *(const bf16x8*)(SU + (size_t)(Rf + fr) * 512 + g * 16 + 8 * fq) : zero8; }
            for (int ib = 0; ib < nblk; ++ib) {
                const int blk = dir == 0 ? blk0 + ib : blk0 + nblk - 1 - ib;
                const bf16x8 ufr = unext;
                if (ib + 1 < nblk) { const int blkn = dir == 0 ? blk + 1 : blk - 1; const int Rn = blkn == 0 ? NREAL + b * NMETA : b * SEQ + blkn * 16 - NMETA;
                    unext = fq < 2 ? *(const bf16x8*)(SU + (size_t)(Rn + fr) * 512 + g * 16 + 8 * fq) : zero8; }
                f32x4 dd[8];
#pragma unroll
                for (int nt = 0; nt < 8; ++nt) { dd[nt] = (f32x4){0.f, 0.f, 0.f, 0.f}; dd[nt] = __builtin_amdgcn_mfma_f32_16x16x32_bf16(ufr, bfr[nt], dd[nt], 0, 0, 0); }
                asm volatile("s_nop 15\n\ts_nop 15" : "+v"(dd[0]), "+v"(dd[1]), "+v"(dd[2]), "+v"(dd[3]), "+v"(dd[4]), "+v"(dd[5]), "+v"(dd[6]), "+v"(dd[7]));
#pragma unroll
                for (int nt = 0; nt < 8; ++nt)
#pragma unroll
                    for (int r = 0; r < 4; ++r) BU[(4 * fq + r) * 132 + nt * 16 + fr] = dd[nt][r];
                LDS_FENCE();
                float bur[16], bui[16];
#pragma unroll
                for (int i = 0; i < 16; ++i) { const int tt = dir == 0 ? i : 15 - i; bur[i] = BU[tt * 132 + lane]; bui[i] = BU[tt * 132 + 64 + lane]; }
                if (pass == 0) {
#pragma unroll
                    for (int i = 0; i < 16; ++i) {
                        const float bre = bur[i], bim = bui[i];
                        const float nr = are * xre - aim * xim + bre, ni = are * xim + aim * xre + bim; xre = nr; xim = ni;
                    }
                    LDS_FENCE();
                } else {
#pragma unroll
                    for (int i = 0; i < 16; ++i) {
                        const int tt = dir == 0 ? i : 15 - i;
                        const float bre = bur[i], bim = bui[i];
                        const float nr = are * xre - aim * xim + bre, ni = are * xim + aim * xre + bim; xre = nr; xim = ni;
                        *(LAS unsigned*)(X + tt * 136 + 2 * lane) = pk2(xre, xim);
                    }
                    LDS_FENCE();
                    f32x4 y = {0.f, 0.f, 0.f, 0.f};
#pragma unroll
                    for (int ks = 0; ks < 4; ++ks) {
                        const bf16x8 afr = *(const LAS bf16x8*)(X + fr * 136 + ks * 32 + 8 * fq);
                        y = __builtin_amdgcn_mfma_f32_16x16x32_bf16(afr, cfr[ks], y, 0, 0, 0);
                    }
                    asm volatile("s_nop 15\n\ts_nop 15" : "+v"(y));
                    LDS_FENCE();
                    {
                        bf16* yd = yfb + (size_t)dir * 256 * LL * 16;
#pragma unroll
                        for (int r = 0; r < 4; ++r) yd[(size_t)(blk * 16 + 4 * fq + r) * 16 + fr] = (bf16)f2bf(y[r]);
                    }
                }
            }
            if (pass == 0) {
                SX[(wave * 64 + lane) * 2] = xre; SX[(wave * 64 + lane) * 2 + 1] = xim;
                LDS_FENCE(); __syncthreads();
                float cre = 0.f, cim = 0.f;
                if (dir == 0) {
                    for (int w = 0; w < wave; ++w) { const float pr = w == 0 ? p272r : p256r, pi = w == 0 ? p272i : p256i;
                        const float sr = SX[(w * 64 + lane) * 2], si = SX[(w * 64 + lane) * 2 + 1];
                        const float nr = pr * cre - pi * cim + sr, ni = pr * cim + pi * cre + si; cre = nr; cim = ni; }
                } else {
                    for (int w = 7; w > wave; --w) {
                        const float sr = SX[(w * 64 + lane) * 2], si = SX[(w * 64 + lane) * 2 + 1];
                        const float nr = p256r * cre - p256i * cim + sr, ni = p256r * cim + p256i * cre + si; cre = nr; cim = ni; }
                }
                xre = cre; xim = cim;
            }
        }
        LDS_FENCE(); __syncthreads();
    }
}

constexpr int ATT_KROW = 72, ATT_VROW = 40, ATT_KT = 32 * ATT_KROW * 2  , ATT_VT = 64 * ATT_VROW * 2  , ATT_MAXT = 11, ATT_VOFF = ATT_MAXT * ATT_KT;
static_assert(ATT_VOFF + ATT_MAXT * ATT_VT <= 131072, "attention LDS");
__device__ __forceinline__ void attn_task(LAS unsigned char* lds, int task, const bf16* Q, const bf16* K, const bf16* V, bf16* YA, const float* sink) {
    int tid_l = threadIdx.x; asm volatile("" : "+v"(tid_l));
    const int tid = tid_l, lane = tid & 63, wave = __builtin_amdgcn_readfirstlane(tid >> 6);
    const int qb = task < 512 ? (task & 31) : 32, bh = task < 512 ? (task >> 5) : task - 512, h = bh & 1, b = bh >> 1;
    const int l0 = qb * 64;
    __syncthreads();
    int jlo = (l0 - 128) >> 5; if (jlo < 1) jlo = 1;
    int jhi = (l0 + 191) >> 5; if (jhi > 64) jhi = 64;
    const int ntiles = 1 + (jhi - jlo + 1);
    LAS unsigned short* Ks = (LAS unsigned short*)lds;
    LAS unsigned short* Vs = (LAS unsigned short*)(lds + ATT_VOFF);
    for (int idx = tid; idx < ntiles * 32 * 8; idx += 512) {
        const int ch = idx & 7, key = idx >> 3, slot = key >> 5, kk = key & 31;
        const int lk = (slot == 0 ? 0 : (jlo + slot - 1) * 32) + kk;
        u32x4 kv = {0u, 0u, 0u, 0u}, vv = {0u, 0u, 0u, 0u};
        if (lk < LL) { const size_t R = (size_t)tok_row(b, lk);
            kv = *(const u32x4*)(K + R * 128 + h * 64 + ch * 8); vv = *(const u32x4*)(V + R * 128 + h * 64 + ch * 8); }
        *(LAS u32x4*)(Ks + slot * (ATT_KT / 2) + kk * ATT_KROW + ch * 8) = kv;
        LAS unsigned short* vd = Vs + slot * (ATT_VT / 2) + (ch * 8) * ATT_VROW + kk;
        vd[0 * ATT_VROW] = (unsigned short)(vv.x & 0xffffu); vd[1 * ATT_VROW] = (unsigned short)(vv.x >> 16);
        vd[2 * ATT_VROW] = (unsigned short)(vv.y & 0xffffu); vd[3 * ATT_VROW] = (unsigned short)(vv.y >> 16);
        vd[4 * ATT_VROW] = (unsigned short)(vv.z & 0xffffu); vd[5 * ATT_VROW] = (unsigned short)(vv.z >> 16);
        vd[6 * ATT_VROW] = (unsigned short)(vv.w & 0xffffu); vd[7 * ATT_VROW] = (unsigned short)(vv.w >> 16);
    }
    LDS_FENCE(); __syncthreads();
    const int head = h * 4 + (wave >> 1), r32 = lane & 31, hi = lane >> 5;
    const int lq = l0 + 32 * (wave & 1) + r32;
    const bool qvalid = lq < LL;
    const size_t Rq = (size_t)tok_row(b, qvalid ? lq : LL - 1);
    bf16x8 qf[4];
#pragma unroll
    for (int ks = 0; ks < 4; ++ks) qf[ks] = *(const bf16x8*)(Q + Rq * 512 + head * 64 + ks * 16 + 8 * hi);
    float mrun = sink[head], lsum = hi == 0 ? 1.0f : 0.0f;
    f32x16 o0, o1;
#pragma unroll
    for (int i = 0; i < 16; ++i) { o0[i] = 0.f; o1[i] = 0.f; }
    const int lqw = l0 + 32 * (wave & 1);
    for (int slot = 0; slot < ntiles; ++slot) {
        const int kbase = slot == 0 ? 0 : (jlo + slot - 1) * 32;
        if (lqw >= LL || (slot != 0 && (kbase + 31 < lqw - 128 || kbase > lqw + 31 + 128))) continue;
        const LAS unsigned short* kt = Ks + slot * (ATT_KT / 2);
        f32x16 s;
#pragma unroll
        for (int i = 0; i < 16; ++i) s[i] = 0.f;
#pragma unroll
        for (int ks = 0; ks < 4; ++ks) {
            const bf16x8 kf = *(const LAS bf16x8*)(kt + r32 * ATT_KROW + ks * 16 + 8 * hi);
            s = __builtin_amdgcn_mfma_f32_32x32x16_bf16(kf, qf[ks], s, 0, 0, 0);
        }
        asm volatile("s_nop 15\n\ts_nop 15" : "+v"(s));
        float mt = -1e30f;
#pragma unroll
        for (int i = 0; i < 16; ++i) {
            const int lk = kbase + (i & 3) + 8 * (i >> 2) + 4 * hi;
            int d = lq - lk; d = d < 0 ? -d : d;
            const bool valid = (lk < NMETA) || (d <= 128 && lk < LL);
            s[i] = valid ? s[i] : -1e30f;
            mt = fmaxf(mt, s[i]);
        }
        mt = fmaxf(mt, __shfl_xor(mt, 32));
        const float mnew = fmaxf(mrun, mt);
        const float alpha = __expf(mrun - mnew);
        mrun = mnew;
        float ps = 0.f;
#pragma unroll
        for (int i = 0; i < 16; ++i) { s[i] = __expf(s[i] - mnew); ps += s[i]; }
        lsum = lsum * alpha + ps;
#pragma unroll
        for (int i = 0; i < 16; ++i) { o0[i] *= alpha; o1[i] *= alpha; }
        const LAS unsigned short* vt = Vs + slot * (ATT_VT / 2);
#pragma unroll
        for (int s2 = 0; s2 < 2; ++s2) {
            union { bf16x8 v; unsigned u[4]; } pf;
            pf.u[0] = pk2(s[8 * s2 + 0], s[8 * s2 + 1]); pf.u[1] = pk2(s[8 * s2 + 2], s[8 * s2 + 3]);
            pf.u[2] = pk2(s[8 * s2 + 4], s[8 * s2 + 5]); pf.u[3] = pk2(s[8 * s2 + 6], s[8 * s2 + 7]);
#pragma unroll
            for (int dt = 0; dt < 2; ++dt) {
                union { bf16x8 v; u32x2 u[2]; } vf;
                const LAS unsigned short* vp = vt + (dt * 32 + r32) * ATT_VROW + 16 * s2 + 4 * hi;
                vf.u[0] = *(const LAS u32x2*)(vp); vf.u[1] = *(const LAS u32x2*)(vp + 8);
                if (dt == 0) o0 = __builtin_amdgcn_mfma_f32_32x32x16_bf16(vf.v, pf.v, o0, 0, 0, 0);
                else o1 = __builtin_amdgcn_mfma_f32_32x32x16_bf16(vf.v, pf.v, o1, 0, 0, 0);
            }
        }
    }
    asm volatile("s_nop 15\n\ts_nop 15" : "+v"(o0), "+v"(o1));
    lsum += __shfl_xor(lsum, 32);
    const float inv = 1.0f / lsum;
    if (qvalid) {
#pragma unroll
        for (int g4 = 0; g4 < 4; ++g4) {
            u32x2 w0, w1;
            w0.x = pk2(o0[4 * g4] * inv, o0[4 * g4 + 1] * inv); w0.y = pk2(o0[4 * g4 + 2] * inv, o0[4 * g4 + 3] * inv);
            w1.x = pk2(o1[4 * g4] * inv, o1[4 * g4 + 1] * inv); w1.y = pk2(o1[4 * g4 + 2] * inv, o1[4 * g4 + 3] * inv);
            *(u32x2*)(YA + Rq * 512 + head * 64 + 8 * g4 + 4 * hi) = w0;
            *(u32x2*)(YA + Rq * 512 + head * 64 + 32 + 8 * g4 + 4 * hi) = w1;
        }
    }
    __syncthreads();
}

__device__ __forceinline__ void pool_diff(LAS unsigned char* lds, const bf16* PU, bf16* PD) {
    int tl_ = threadIdx.x; asm volatile("" : "+v"(tl_));
    constexpr int TOK = 65, HALO = 8, ROWS = TOK + 2 * HALO, NTOK = NB * LL;
    for (int blk = blockIdx.x; blk * TOK < NTOK; blk += gridDim.x) {
        const int f0 = blk * TOK;
        __syncthreads();
        for (int i = tl_; i < ROWS * 64; i += 512) {
            const int r = i >> 6, ch = i & 63, f = f0 - HALO + r;
            u32x4 v = {0u, 0u, 0u, 0u};
            if (f >= 0 && f < NTOK) { const int b = f / LL, l = f % LL; v = *(const u32x4*)(PU + (size_t)tok_row(b, l) * 512 + ch * 8); }
            *(LAS u32x4*)(lds + (size_t)i * 16) = v;
        }
        LDS_FENCE(); __syncthreads();
        for (int i = tl_; i < TOK * 64; i += 512) {
            const int t = i >> 6, ch = i & 63, f = f0 + t;
            if (f >= NTOK) continue;
            const int b = f / LL, l = f % LL, half = 1 << (ch >> 4);
            const int lo = l - half < 0 ? 0 : l - half, hh = l + half > LL ? LL : l + half;
            float s[8];
#pragma unroll
            for (int j = 0; j < 8; ++j) s[j] = 0.f;
            for (int lp = lo; lp < hh; ++lp) {
                const u32x4 v = *(const LAS u32x4*)(lds + (size_t)((t + HALO + lp - l) * 64 + ch) * 16);
                s[0] += bf2f(v.x & 0xffffu); s[1] += bf2f(v.x >> 16); s[2] += bf2f(v.y & 0xffffu); s[3] += bf2f(v.y >> 16);
                s[4] += bf2f(v.z & 0xffffu); s[5] += bf2f(v.z >> 16); s[6] += bf2f(v.w & 0xffffu); s[7] += bf2f(v.w >> 16);
            }
            const float ic = 1.0f / (float)(hh - lo);
            const u32x4 v = *(const LAS u32x4*)(lds + (size_t)((t + HALO) * 64 + ch) * 16);
            u32x4 o;
            o.x = pk2(s[0] * ic - bf2f(v.x & 0xffffu), s[1] * ic - bf2f(v.x >> 16)); o.y = pk2(s[2] * ic - bf2f(v.y & 0xffffu), s[3] * ic - bf2f(v.y >> 16));
            o.z = pk2(s[4] * ic - bf2f(v.z & 0xffffu), s[5] * ic - bf2f(v.z >> 16)); o.w = pk2(s[6] * ic - bf2f(v.w & 0xffffu), s[7] * ic - bf2f(v.w >> 16));
            *(u32x4*)(PD + (size_t)tok_row(b, l) * 512 + ch * 8) = o;
        }
    }
    __syncthreads();
}

__device__ __forceinline__ void z_pass(const float* YF, const bf16* SU, const float* dskip, bf16* Z) {
    int tl_ = threadIdx.x; asm volatile("" : "+v"(tl_)); const int gt = blockIdx.x * 512 + tl_, NGT = gridDim.x * 512;
    for (int i = gt; i < NB * LL * 64; i += NGT) {
        const int ch = i & 63, tk = i >> 6, b = tk / LL, l = tk % LL, g = ch >> 1;
        const size_t R = (size_t)tok_row(b, l);
        const bf16* yp = (const bf16*)YF + ((size_t)(b * 32 + g) * LL + l) * 16 + (ch & 1) * 8;
        const u32x4 ya = *(const u32x4*)yp, yb = *(const u32x4*)(yp + (size_t)256 * LL * 16);
        f32x4 y0, y1;
        y0[0] = bf2f(ya.x & 0xffffu) + bf2f(yb.x & 0xffffu); y0[1] = bf2f(ya.x >> 16) + bf2f(yb.x >> 16); y0[2] = bf2f(ya.y & 0xffffu) + bf2f(yb.y & 0xffffu); y0[3] = bf2f(ya.y >> 16) + bf2f(yb.y >> 16);
        y1[0] = bf2f(ya.z & 0xffffu) + bf2f(yb.z & 0xffffu); y1[1] = bf2f(ya.z >> 16) + bf2f(yb.z >> 16); y1[2] = bf2f(ya.w & 0xffffu) + bf2f(yb.w & 0xffffu); y1[3] = bf2f(ya.w >> 16) + bf2f(yb.w >> 16);
        const f32x4 d0 = *(const f32x4*)(dskip + ch * 8), d1 = *(const f32x4*)(dskip + ch * 8 + 4);
        const u32x4 uu = *(const u32x4*)(SU + R * 512 + ch * 8);
        float t[8];
        t[0] = y0[0] + d0[0] * bf2f(uu.x & 0xffffu); t[1] = y0[1] + d0[1] * bf2f(uu.x >> 16); t[2] = y0[2] + d0[2] * bf2f(uu.y & 0xffffu); t[3] = y0[3] + d0[3] * bf2f(uu.y >> 16);
        t[4] = y1[0] + d1[0] * bf2f(uu.z & 0xffffu); t[5] = y1[1] + d1[1] * bf2f(uu.z >> 16); t[6] = y1[2] + d1[2] * bf2f(uu.w & 0xffffu); t[7] = y1[3] + d1[3] * bf2f(uu.w >> 16);
#pragma unroll
        for (int j = 0; j < 8; ++j) {
            const float v = t[j], tt = __builtin_amdgcn_rcpf(fabsf(v) * 0.2316418882f + 1.0f);
            float q = tt * 0.5307027145f + (-0.7265760135f); q = q * tt + 0.7107068705f; q = q * tt + (-0.142248368f); q = q * tt + 0.127414796f; q = q * tt;
            const float m = v * (q * __builtin_amdgcn_exp2f(v * v * (-0.72134752044f)));
            t[j] = v < 0.f ? m : v - m;
        }
        u32x4 o; o.x = pk2(t[0], t[1]); o.y = pk2(t[2], t[3]); o.z = pk2(t[4], t[5]); o.w = pk2(t[6], t[7]);
        *(u32x4*)(Z + R * 512 + ch * 8) = o;
    }
}

#define XB_TMO      128
#define XB_XCNT(j)  (256  + 64 * (j))
#define XB_XSUB(j)  (1280 + 64 * (j))
#define XB_XGEN(j)  (2304 + 64 * (j))
#define XB_TOP      3328
#define XB_TOPGEN   3392
#define XCD_BAR_WORDS 3456
#define XB_SPIN_CAP (1u << 18)

__device__ __forceinline__ unsigned xb_ld(unsigned* p)              { return __hip_atomic_load(p, __ATOMIC_RELAXED, __HIP_MEMORY_SCOPE_AGENT); }
__device__ __forceinline__ unsigned xb_add(unsigned* p, unsigned v) { return __hip_atomic_fetch_add(p, v, __ATOMIC_RELAXED, __HIP_MEMORY_SCOPE_AGENT); }
__device__ __forceinline__ unsigned xb_xcc_id() { return (unsigned)__builtin_amdgcn_s_getreg((3 << 11) | 20) & 0xFu; }
#define XB_SPIN(cond, bar) do { unsigned _sp = 0; while (cond) { __builtin_amdgcn_s_sleep(1); \
    if ((++_sp & 255u) == 0u) { if (xb_ld(&(bar)[XB_TMO])) break; if (_sp > XB_SPIN_CAP) { atomicAdd(&(bar)[XB_TMO], 1u); break; } } } } while (0)

struct XcdBarrier {
    unsigned* bar; unsigned x;
    volatile LAS unsigned* st;
};

__device__ __forceinline__ XcdBarrier xcd_barrier_post(unsigned* bar, volatile LAS unsigned* st) {
    XcdBarrier b; b.bar = bar; b.x = xb_xcc_id(); b.st = st;
    if (threadIdx.x == 0) (void)xb_add(&bar[XB_XCNT(b.x)], 1u);
    return b;
}
__device__ __forceinline__ void xcd_barrier_complete(unsigned* bar, unsigned x, unsigned& nloc, unsigned& nx) {
    const unsigned G = gridDim.x * gridDim.y * gridDim.z;
    unsigned sum, cnt, mine, sp = 0u;
    for (;;) {
        sum = 0u; cnt = 0u; mine = 0u;
#pragma unroll
        for (unsigned j = 0; j < 16; ++j) { const unsigned c = xb_ld(&bar[XB_XCNT(j)]); sum += c; cnt += (c > 0u) ? 1u : 0u; mine = (j == x) ? c : mine; }
        if (sum == G) break;
        __builtin_amdgcn_s_sleep(1);
        if ((++sp & 255u) == 0u) { if (xb_ld(&bar[XB_TMO])) break; if (sp > XB_SPIN_CAP) { atomicAdd(&bar[XB_TMO], 1u); break; } }
    }
    nloc = mine > 0u ? mine : 1u; nx = cnt > 0u ? cnt : 1u;
}

__device__ __forceinline__ void xcd_barrier(const XcdBarrier& b) {
    asm volatile("s_waitcnt vmcnt(0)" ::: "memory");
    __syncthreads();
    if (threadIdx.x == 0) {
        unsigned* bar = b.bar;
        __builtin_amdgcn_s_waitcnt(0);
        unsigned nloc = b.st[0], nx = b.st[1];
        if (nloc == 0u) { xcd_barrier_complete(bar, b.x, nloc, nx); b.st[0] = nloc; b.st[1] = nx; }
        const unsigned old = xb_add(&bar[XB_XSUB(b.x)], 1u);
        const unsigned gen = old / nloc;
        if (old + 1u == (gen + 1u) * nloc) {
            __builtin_amdgcn_fence(__ATOMIC_RELEASE, "agent");
            asm volatile("s_waitcnt vmcnt(0)" ::: "memory");
            const unsigned og = xb_add(&bar[XB_TOP], 1u);
            const unsigned tg = og / nx;
            if (og + 1u == (tg + 1u) * nx) xb_add(&bar[XB_TOPGEN], 1u);
            else XB_SPIN(xb_ld(&bar[XB_TOPGEN]) == tg, bar);
            __builtin_amdgcn_fence(__ATOMIC_ACQUIRE, "agent");
            xb_add(&bar[XB_XGEN(b.x)], 1u);
            asm volatile("s_waitcnt vmcnt(0)" ::: "memory");
        } else {
            XB_SPIN(xb_ld(&bar[XB_XGEN(b.x)]) == gen, bar);
            __builtin_amdgcn_fence(__ATOMIC_ACQUIRE, "agent");
            asm volatile("s_waitcnt vmcnt(0)" ::: "memory");
        }
    }
    __syncthreads();
}

#ifndef MK_ALIGN
#define MK_ALIGN true
#endif
#ifndef MK_SP2
#define MK_SP2 true
#endif
#ifndef MK_SPLIT
#define MK_SPLIT 0
#endif
#ifndef MK_NLAYER
#define MK_NLAYER 2
#endif
constexpr int NPL = 8, NPHASE = 1 + 2 * NPL + 1, PH_FINAL = NPHASE - 1;

#define KARGS() ({ auto kp_ = __builtin_amdgcn_kernarg_segment_ptr(); asm volatile("" : "+s"(kp_)); (KArgsP)kp_; })
__global__ void __launch_bounds__(512, 2) fwd_kernel(Args a_unused, int ph_lo, int ph_hi) {
    (void)a_unused;
    extern __shared__ __attribute__((aligned(16))) unsigned char lds_raw[];
    LAS unsigned char* lds = (LAS unsigned char*)lds_raw;
    const int G = gridDim.x, bid = blockIdx.x;
#if MK_SPLIT
#define GRID_SYNC() do {} while (0)
    (void)lds;
#else
#define CG_SYNC() do { asm volatile("s_waitcnt vmcnt(0)" ::: "memory"); __syncthreads(); \
    if (threadIdx.x == 0) { __builtin_amdgcn_fence(__ATOMIC_RELEASE, "agent"); asm volatile("s_waitcnt vmcnt(0)" ::: "memory"); } \
    __syncthreads(); grid.sync(); \
    if (threadIdx.x == 0) { __builtin_amdgcn_fence(__ATOMIC_ACQUIRE, "agent"); asm volatile("s_waitcnt vmcnt(0)" ::: "memory"); } \
    __syncthreads(); } while (0)
    cg::grid_group grid = cg::this_grid();
    unsigned* barw = (unsigned*)(KARGS()->ws + WS_CTL);
    if (bid == 0) for (int i = threadIdx.x; i < XCD_BAR_WORDS; i += 512) __hip_atomic_store(barw + i, 0u, __ATOMIC_RELAXED, __HIP_MEMORY_SCOPE_AGENT);
    volatile LAS unsigned* xst = (volatile LAS unsigned*)(lds + LDS_BYTES - 64);
    if (threadIdx.x < 2) xst[threadIdx.x] = 0u;
    CG_SYNC();
    const XcdBarrier xbar = xcd_barrier_post(barw, xst);
#define GRID_SYNC() xcd_barrier(xbar)

#endif
#ifndef PHMASK
#define PHMASK 0xFFFFu
#endif
#define IN(k) (((PHMASK >> ((k) == 0 ? 0 : (k) == PH_FINAL ? 9 : 1 + ((k) - 1) % NPL)) & 1u) && ph_lo <= (k) && (k) < ph_hi)
#define SEAM(k) do { if (IN(k) && (k) + 1 < ph_hi) GRID_SYNC(); } while (0)
#define PHASE_BEGIN() KArgsP ka = KARGS(); unsigned char* ws = ka->ws; asm volatile("" : "+s"(ws)); float* rowss = (float*)(ws + WS_RS); float* Hm = (float*)(ws + WS_HM); bf16* HB = (bf16*)(ws + WS_HB); unsigned char* wl = ws + WS_W + (size_t)layer * LW_BYTES; \
    const int MT = NREAL; const bool META = layer != MK_NLAYER - 1;     \
    const float* rs_mix = rowss + (size_t)(2 * layer) * TPR * 16; float* rs_mlp = rowss + (size_t)(2 * layer + 1) * TPR * 16; float* rs_next = rowss + (size_t)(2 * layer + 2) * TPR * 16; (void)MT; (void)META; (void)Hm; (void)HB; (void)wl; (void)rs_mix; (void)rs_mlp; (void)rs_next;

    if (IN(0)) {
        { int tl_ = threadIdx.x; asm volatile("" : "+v"(tl_)); const int wv = __builtin_amdgcn_readfirstlane(tl_ >> 6);
          convert_layer_weights(KARGS(), lds, 0, bid * 8 + wv, G * 8, wv, tl_ & 63, 0); }
        Args al; { KArgsP kp = KARGS(); for (int i = 0; i < 23; ++i) al.in[i] = kp->in[i]; al.out = kp->out; al.ws = kp->ws; } p0_prologue(al, lds); }
    SEAM(0);
#ifndef MK_NLAYER
#define MK_NLAYER 2
#endif
#ifndef MK_RSIDX
#define MK_RSIDX 4
#endif
#pragma unroll 1
    for (int layer = 0; layer < MK_NLAYER; ++layer) {
        const int p = 1 + NPL * layer;
        if (IN(p)) { PHASE_BEGIN();
            pg8::Gemm g{HB, (const bf16*)(wl + OW_IN), TPR, NPROJ, DM}; pg8::StaticOrder S; S.init(TPR, NPROJ, G, bid);
            EpiInProj E{rs_mix, (const float*)(ws + WS_ROPE), (bf16*)(ws + WS_Q), (bf16*)(ws + WS_K), (bf16*)(ws + WS_V), (bf16*)(ws + WS_SU), (bf16*)(ws + WS_PU)};
            pg8::gemm_phase<EpiInProj, pg8::StaticOrder, MK_ALIGN, MK_SP2>(lds, g, S, E);
        }
        SEAM(p);
        if (IN(p + 1)) { PHASE_BEGIN();
            for (int t = bid; t < 256; t += G)
                ssm_task(lds, t, layer, (const bf16*)(ws + WS_SU), (float*)(ws + WS_YF), (const float*)(ws + WS_ABAR), (const bf16*)(ws + WS_BMAT), (const bf16*)(ws + WS_CMAT));
            for (int t = bid; t < NB * 2 * 33; t += G)
                attn_task(lds, t, (const bf16*)(ws + WS_Q), (const bf16*)(ws + WS_K), (const bf16*)(ws + WS_V), (bf16*)ka->out, ka->in[4] + layer * 8);
            pool_diff(lds, (const bf16*)(ws + WS_PU), (bf16*)(ws + WS_PD));
            {
                int tl_ = threadIdx.x; asm volatile("" : "+v"(tl_)); const int wv = __builtin_amdgcn_readfirstlane(tl_ >> 6);
                convert_layer_weights(ka, lds, layer, bid * 8 + wv, G * 8, wv, tl_ & 63, 1);
                if (layer + 1 < MK_NLAYER) convert_layer_weights(ka, lds, layer + 1, bid * 8 + wv, G * 8, wv, tl_ & 63, 0);
                __syncthreads();
            }
        }
        SEAM(p + 1);
        if (IN(p + 2)) { PHASE_BEGIN();
            z_pass((const float*)(ws + WS_YF), (const bf16*)(ws + WS_SU), ka->in[12] + layer * 512, (bf16*)(ws + WS_Z));
        }
        SEAM(p + 2);
        if (IN(p + 3)) { PHASE_BEGIN();
            const int hg = G >> 1;
            if (bid < hg) { pg8::Gemm g{(const bf16*)(ws + WS_Z), (const bf16*)(wl + OW_GLU), MT, 512, 512}; pg8::StaticOrder S; S.init(MT, 512, hg, bid);
              EpiGlu E{(const bf16*)(ws + WS_Z), ka->in[14] + layer * 512, (bf16*)ka->out + (size_t)TPR * 512};
              pg8::gemm_phase<EpiGlu, pg8::StaticOrder, MK_ALIGN, MK_SP2>(lds, g, S, E); if (META) thin_gemm<EpiGlu>(lds, g.A, g.Bt, g.K, g.N, E, bid, hg); }
            else { pg8::Gemm g{(const bf16*)(ws + WS_PD), (const bf16*)(wl + OW_POOL), MT, 512, 512}; pg8::StaticOrder S; S.init(MT, 512, G - hg, bid - hg);
              EpiScale E{(bf16*)ka->out + (size_t)2 * TPR * 512, 512, ka->in[16] + layer * 512};
              pg8::gemm_phase<EpiScale, pg8::StaticOrder, MK_ALIGN, MK_SP2>(lds, g, S, E); if (META) thin_gemm<EpiScale>(lds, g.A, g.Bt, g.K, g.N, E, bid - hg, G - hg); }
        }
        SEAM(p + 3);
        if (IN(p + 4)) { PHASE_BEGIN();
            bf16* Y3 = (bf16*)ka->out;
            bf16* BR0 = (bf16*)(ws + WS_X), *BR1 = (bf16*)(ws + WS_X + 4 * UU), *BR2 = (bf16*)(ws + WS_X + 6 * UU);
            const bf16* Wbr = (const bf16*)(wl + OW_BR); const bf16* Wg = (const bf16*)(wl + OW_IN) + (size_t)NPROJ * DM; bf16* MG = (bf16*)(ws + WS_MG);
            { pg8::Gemm g{Y3, Wbr, 3 * TPR, 3072, 512}; TripleOrder S; S.init(G, bid, TPR / 256, 4);
              EpiBr3 E{BR0, TPR / 256};
              pg8::gemm_phase<EpiBr3, TripleOrder, MK_ALIGN, MK_SP2>(lds, g, S, E); }
            { pg8::Gemm g{HB, Wg, MT, 3072, DM}; TripleOrder S; S.init(G, bid, 0, 4);
              EpiGate3 E{rs_mix, BR0, MG};
              pg8::gemm_phase<EpiGate3, TripleOrder, MK_ALIGN, MK_SP2>(lds, g, S, E); }
            if (META) {
                bf16* GBm = (bf16*)(ws + WS_HM) - (size_t)NREAL * 1024;
#pragma unroll 1
                for (int c = 0; c < 3; ++c) {
                    const int vb = (bid - 64 * c) & 255;
                    bf16* BRc = BR0 + (size_t)(2 * c + 2 * (c > 0)) * (UU / 2);
                    { EpiScale E{BRc, 1024, nullptr}; thin_gemm<EpiScale>(lds, Y3 + (size_t)c * TPR * 512, Wbr + (size_t)c * 1024 * 512, 512, 1024, E, vb, 256); }
                    { EpiGate<true> E{rs_mix, BRc, GBm + (size_t)c * 128 * 1024}; thin_gemm<EpiGate<true>>(lds, HB, Wg + (size_t)c * 1024 * DM, DM, 1024, E, vb, 256); }
                }
            }
        }
        SEAM(p + 4);
        if (IN(p + 5)) { PHASE_BEGIN();
            pg8::Gemm g{(const bf16*)(ws + WS_MG), (const bf16*)(wl + OW_OUT), MT, DM, DM}; pg8::StaticOrder S; S.init(MT, DM, G, bid);
            EpiRes E{(const float*)nullptr, HB, rs_mlp};
            pg8::gemm_phase<EpiRes, pg8::StaticOrder, MK_ALIGN, MK_SP2>(lds, g, S, E); if (META) thin_gemm<EpiRes, true>(lds, (const bf16*)(ws + WS_HM) - (size_t)NREAL * 1024, g.Bt, g.K, g.N, E, bid, G, (size_t)128 * 1024);
        }
        SEAM(p + 5);
        if (IN(p + 6)) { PHASE_BEGIN();
            pg8::Gemm g{HB, (const bf16*)(wl + OW_UP), MT, FF, DM}; pg8::StaticOrder S; S.init(MT, FF, G, bid);
            EpiUp E{rs_mlp, (bf16*)(ws + WS_ACT)};
            pg8::gemm_phase<EpiUp, pg8::StaticOrder, MK_ALIGN, MK_SP2>(lds, g, S, E); if (META) thin_gemm<EpiUp>(lds, g.A, g.Bt, g.K, g.N, E, bid, G);
        }
        SEAM(p + 6);
        if (IN(p + 7)) { PHASE_BEGIN();
            pg8::Gemm g{(const bf16*)(ws + WS_ACT), (const bf16*)(wl + OW_DN), MT, DM, FF}; pg8::StaticOrder S; S.init(MT, DM, G, bid);
            EpiRes E{(const float*)nullptr, HB, rs_next};
            pg8::gemm_phase<EpiRes, pg8::StaticOrder, MK_ALIGN, MK_SP2>(lds, g, S, E); if (META) thin_gemm<EpiRes>(lds, g.A, g.Bt, g.K, g.N, E, bid, G);
        }
        SEAM(p + 7);
    }
#ifdef MK_DUMP_OFF
    if (IN(PH_FINAL)) { KArgsP ka = KARGS();
        const bf16* src = (const bf16*)(ka->ws + (MK_DUMP_OFF)); const bf16* src2 = (const bf16*)(ka->ws + (MK_DUMP_OFF2));
        for (int i = bid * 512 + threadIdx.x; i < NREAL * 1024; i += G * 512) { const int R = MK_DUMP_ROW(i >> 10), c = i & 1023; ka->out[i] = c < 512 ? bf2f(src[(size_t)R * (MK_DUMP_LD) + (c % (MK_DUMP_LD))]) : bf2f(src2[(size_t)R * (MK_DUMP_LD2) + (c % (MK_DUMP_LD2))]); }
    }
#else
    if (IN(PH_FINAL)) { KArgsP ka = KARGS();
        const float* rs = (const float*)(ka->ws + WS_RS) + (size_t)MK_RSIDX * TPR * 16; const float* gain = ka->in[22];
        int tl_ = threadIdx.x; asm volatile("" : "+v"(tl_));
        const int lane = tl_ & 63, wv = __builtin_amdgcn_readfirstlane(tl_ >> 6);
        for (int R = bid * 8 + wv; R < NREAL; R += G * 8) {
            const float r = row_rstd(rs, R);
            const bf16* hrow = (const bf16*)(ka->ws + WS_HB) + (size_t)R * DM; float* orow = ka->out + (size_t)R * DM;
#pragma unroll
            for (int j = 0; j < 4; ++j) {
                const int c4 = (lane + 64 * j) * 4;
                const u32x2 hb = *(const u32x2*)(hrow + c4); const f32x4 gn = *(const f32x4*)(gain + c4);
                f32x4 v = {bf2f(hb.x & 0xffffu), bf2f(hb.x >> 16), bf2f(hb.y & 0xffffu), bf2f(hb.y >> 16)};
                v = v * r * gn;
                __builtin_nontemporal_store(v, (f32x4*)(orow + c4));
            }
        }
    }
#endif
#undef IN
#undef SEAM
}

extern "C" void kernel_launch(void* const* d_in, const int* in_sizes, int n_in, void* d_out, int out_size, void* d_ws, size_t ws_size, hipStream_t stream) {
    static int grid = 0;
    if (grid == 0) {
        if (n_in != 23 || out_size != NREAL * DM || ws_size < WS_END) { fprintf(stderr, "kernel_launch: unexpected shapes (n_in %d out %d ws %zu)\n", n_in, out_size, ws_size); grid = -1; return; }
        int dev = 0, cus = 0, per_cu = 0;
        hipGetDevice(&dev); hipDeviceGetAttribute(&cus, hipDeviceAttributeMultiprocessorCount, dev);
        if (hipFuncSetAttribute((const void*)fwd_kernel, hipFuncAttributeMaxDynamicSharedMemorySize, LDS_BYTES) != hipSuccess) { fprintf(stderr, "kernel_launch: hipFuncSetAttribute failed\n"); grid = -1; return; }
        if (hipOccupancyMaxActiveBlocksPerMultiprocessor(&per_cu, (const void*)fwd_kernel, 512, LDS_BYTES) != hipSuccess || per_cu < 1) { fprintf(stderr, "kernel_launch: occupancy query gave %d\n", per_cu); per_cu = 1; }
        (void)hipGetLastError();
        grid = cus * (per_cu > 1 ? 1 : per_cu);
        if (grid <= 0) grid = 256;
    }
    if (grid < 0) return;
    Args a{};
    for (int i = 0; i < 23; ++i) a.in[i] = (const float*)d_in[i];
    a.out = (float*)d_out; a.ws = (unsigned char*)d_ws;
#if MK_SPLIT
    for (int ph = 0; ph < NPHASE; ++ph) hipLaunchKernelGGL(fwd_kernel, dim3(grid), dim3(512), LDS_BYTES, stream, a, ph, ph + 1);
#else
    int lo = 0, hi = NPHASE;
    void* kargs[] = {(void*)&a, (void*)&lo, (void*)&hi};
    hipError_t e = hipLaunchCooperativeKernel((const void*)fwd_kernel, dim3(grid), dim3(512), kargs, LDS_BYTES, stream);
    if (e != hipSuccess) fprintf(stderr, "kernel_launch: cooperative launch failed: %s (grid %d)\n", hipGetErrorString(e), grid);
#endif
}
```

```cpp
#include <hip/hip_runtime.h>
#include <hip/hip_cooperative_groups.h>
#include <cstdio>
#include <cstdint>
namespace cg = cooperative_groups;
namespace pg8 {
#define PG8_LAS __attribute__((address_space(3)))
typedef unsigned short bf16_t;
typedef short bf16x8 __attribute__((ext_vector_type(8)));
typedef float f32x4 __attribute__((ext_vector_type(4)));
typedef unsigned u32x4 __attribute__((ext_vector_type(4)));
constexpr int BM = 256, BK = 64, HALF = 128, HTB = HALF * BK * 2  , STAGE_BYTES = 8 * HTB, NXCD = 8, WGM = 8;

__host__ __device__ __forceinline__ int lds_byte(int r, int c) { const int st = (r >> 4) * 2 + (c >> 5), rr = r & 15, cc = c & 31, ob = rr * 64 + cc * 2; return st * 1024 + (ob ^ (((ob >> 9) & 1) << 5)); }
__host__ __device__ __forceinline__ void stage_rc(int b, int& R, int& C) { const int st = b / 1024, sb = b % 1024, swz = sb ^ (((sb >> 9) & 1) << 5); R = (st >> 1) * 16 + swz / 64; C = (st & 1) * 32 + (swz % 64) / 2; }
__host__ __device__ __forceinline__ int perm32(int rho) { const int n = rho >> 4, i = rho & 15; return 8 * (i >> 2) + 4 * n + (i & 3); }

struct Unit { int pm, pn; };
struct Gemm { const bf16_t* A; const bf16_t* Bt; int M, N, K; };

struct StaticOrder {
    int nM, nN, nwg, G, c;
    __host__ __device__ void init(int M, int N, int G_, int c_) { nM = M / BM; nN = N / BM; nwg = nM * nN; G = G_; c = c_; }
    __host__ __device__ __forceinline__ bool next(int i, Unit& u) const {
        const long L = (long)i * G + c; if (L >= nwg) return false;
        int wgid = (int)L; { const int q = nwg / NXCD, r = nwg % NXCD, xcd = wgid % NXCD, off = wgid / NXCD; wgid = (xcd < r ? xcd * (q + 1) : r * (q + 1) + (xcd - r) * q) + off; }
        const int nig = WGM * nN, gid = wgid / nig, fm = gid * WGM, gsz = (nM - fm) < WGM ? (nM - fm) : WGM;
        u.pm = fm + ((wgid % nig) % gsz); u.pn = (wgid % nig) / gsz; return true;
    }
    __device__ __forceinline__ void a_ready(const Unit&) const {}
    __device__ __forceinline__ void done(const Unit&) const {}
};

__device__ __forceinline__ unsigned cvt_pk_bf16(float lo, float hi) { unsigned r; asm volatile("v_cvt_pk_bf16_f32 %0, %1, %2" : "=v"(r) : "v"(lo), "v"(hi)); return r; }
template <class Epi, class Sched, bool ALIGN_EPI = false, bool SP2 = false>
__device__ __forceinline__ void gemm_phase(PG8_LAS unsigned char* lds, const Gemm g, const Sched& S, const Epi& E) {
    int tid_l = threadIdx.x; asm volatile("" : "+v"(tid_l));
    const int tid = tid_l, wid = __builtin_amdgcn_readfirstlane(tid >> 6), lane = tid & 63, wr = wid >> 2, wc = wid & 3, fr = lane & 15, fq = lane >> 4;
    const int K = g.K, nt = K / BK;
    unsigned voffA[2], voffB[2];
#pragma unroll
    for (int i = 0; i < 2; ++i) { int R, C; stage_rc(tid * 16 + i * 8192, R, C); const int Rb = Epi::PERM ? ((R & ~31) + perm32(R & 31)) : R;
        voffA[i] = (unsigned)(R * K + C) * 2u; voffB[i] = (unsigned)(Rb * K + C) * 2u; }
    const size_t kstep = (size_t)(BK * 2);
    const size_t hstep = (size_t)HALF * K * 2;
    const size_t tstep = 2 * hstep;
    const unsigned ldsw = (unsigned)wid * 1024u;
    const int aoff = lds_byte(wr * 64 + fr, fq * 8), boff = lds_byte(wc * 32 + fr, fq * 8);
#define PG8_SA(b, h) (((b) * 2 + (h)) * HTB)
#define PG8_SB(b, h) ((4 + (b) * 2 + (h)) * HTB)
#define PG8_STAGE(bufoff, gbase, voff) do { _Pragma("unroll") for (int _i = 0; _i < 2; ++_i) \
        __builtin_amdgcn_global_load_lds((const unsigned*)((const char*)(gbase) + (voff)[_i]), (PG8_LAS unsigned*)(lds + (bufoff) + ldsw + _i * 8192), 16, 0, 0); } while (0)
#define PG8_LDA(dst, b, h) do { _Pragma("unroll") for (int m = 0; m < 4; ++m) _Pragma("unroll") for (int k = 0; k < 2; ++k) dst[m][k] = *(const PG8_LAS bf16x8*)(lds + PG8_SA(b, h) + aoff + m * 2048 + k * 1024); } while (0)
#define PG8_LDB(dst, b, h) do { _Pragma("unroll") for (int n = 0; n < 2; ++n) _Pragma("unroll") for (int k = 0; k < 2; ++k) dst[n][k] = *(const PG8_LAS bf16x8*)(lds + PG8_SB(b, h) + boff + n * 2048 + k * 1024); } while (0)
#define PG8_MMA(ai, bj, At, Bt) do { __builtin_amdgcn_s_setprio(1); _Pragma("unroll") for (int m = 0; m < 4; ++m) _Pragma("unroll") for (int n = 0; n < 2; ++n) _Pragma("unroll") for (int k = 0; k < 2; ++k) \
        acc[ai][bj][m][n] = __builtin_amdgcn_mfma_f32_16x16x32_bf16(Bt[n][k], At[m][k], acc[ai][bj][m][n], 0, 0, 0); __builtin_amdgcn_s_setprio(0); } while (0)
#define PG8_WAIT_V(n) asm volatile("s_waitcnt vmcnt(" #n ")" ::: "memory")
#define PG8_WAIT_L(n) asm volatile("s_waitcnt lgkmcnt(" #n ")" ::: "memory")
#define PG8_BAR __builtin_amdgcn_s_barrier()
#define PG8_SCHED __builtin_amdgcn_sched_barrier(0)
    Unit cur, nxt; int ui = 0;
    if (!S.next(0, cur)) return;
    f32x4 acc[2][2][4][2];
#pragma unroll
    for (int a = 0; a < 2; ++a)
#pragma unroll
        for (int b = 0; b < 2; ++b)
#pragma unroll
            for (int m = 0; m < 4; ++m)
#pragma unroll
                for (int n = 0; n < 2; ++n) acc[a][b][m][n] = (f32x4){0.f, 0.f, 0.f, 0.f};
    bf16x8 At[4][2], B0[2][2], B1[2][2];
    const char* cA = (const char*)g.A + (size_t)cur.pm * tstep; const char* cB = (const char*)g.Bt + (size_t)cur.pn * tstep;
    S.a_ready(cur);
    if constexpr (SP2) {
        PG8_STAGE(PG8_SB(0, 0), cB, voffB); PG8_STAGE(PG8_SB(0, 1), cB + hstep, voffB); PG8_STAGE(PG8_SA(0, 0), cA, voffA); PG8_STAGE(PG8_SA(0, 1), cA + hstep, voffA);
        if (wr == 1) PG8_BAR;
        PG8_WAIT_V(2); PG8_BAR;
        PG8_STAGE(PG8_SB(1, 0), cB + kstep, voffB); PG8_STAGE(PG8_SA(1, 0), cA + kstep, voffA); PG8_STAGE(PG8_SB(1, 1), cB + hstep + kstep, voffB);
        PG8_WAIT_V(6); PG8_BAR;
    } else {
        PG8_STAGE(PG8_SB(0, 0), cB, voffB); PG8_STAGE(PG8_SA(0, 0), cA, voffA); PG8_STAGE(PG8_SB(0, 1), cB + hstep, voffB); PG8_STAGE(PG8_SA(0, 1), cA + hstep, voffA);
        if (wr == 1) PG8_BAR;
        PG8_WAIT_V(4); PG8_BAR;
        PG8_STAGE(PG8_SB(1, 0), cB + kstep, voffB); PG8_STAGE(PG8_SA(1, 0), cA + kstep, voffA); PG8_STAGE(PG8_SB(1, 1), cB + hstep + kstep, voffB);
        PG8_WAIT_V(6); PG8_BAR;
    }
    for (;;) {
        const bool has_next = S.next(ui + 1, nxt);
        const char* nA = has_next ? (const char*)g.A + (size_t)nxt.pm * tstep : cA; const char* nB = has_next ? (const char*)g.Bt + (size_t)nxt.pn * tstep : cB;
        for (int t = 0; t < nt; t += 2) {
            const bool last = (t == nt - 2);
            const char* a1 = cA + (size_t)(t + 1) * kstep;
            const char* a2 = last ? nA : cA + (size_t)(t + 2) * kstep; const char* b2 = last ? nB : cB + (size_t)(t + 2) * kstep;
            const char* a3 = a2 + kstep; const char* b3 = b2 + kstep;
            if (last && has_next) S.a_ready(nxt);
            if constexpr (SP2) {
            PG8_LDB(B0, 0, 0); PG8_LDB(B1, 0, 1); PG8_SCHED; PG8_LDA(At, 0, 0); PG8_STAGE(PG8_SA(1, 1), a1 + hstep, voffA);
            PG8_WAIT_V(8); PG8_WAIT_L(0); PG8_BAR; PG8_MMA(0, 0, At, B0); PG8_MMA(0, 1, At, B1); PG8_BAR; PG8_SCHED;
            PG8_LDA(At, 0, 1); PG8_STAGE(PG8_SB(0, 0), b2, voffB); PG8_STAGE(PG8_SB(0, 1), b2 + hstep, voffB); PG8_STAGE(PG8_SA(0, 0), a2, voffA);
            PG8_WAIT_V(8); PG8_WAIT_L(0); PG8_BAR; PG8_MMA(1, 0, At, B0); PG8_MMA(1, 1, At, B1); PG8_BAR; PG8_SCHED;
            PG8_LDB(B0, 1, 0); PG8_LDB(B1, 1, 1); PG8_SCHED; PG8_LDA(At, 1, 0); PG8_STAGE(PG8_SA(0, 1), a2 + hstep, voffA);
            PG8_WAIT_V(8); PG8_WAIT_L(0); PG8_BAR; PG8_MMA(0, 0, At, B0); PG8_MMA(0, 1, At, B1); PG8_BAR; PG8_SCHED;
            PG8_LDA(At, 1, 1); PG8_STAGE(PG8_SB(1, 0), b3, voffB); PG8_STAGE(PG8_SB(1, 1), b3 + hstep, voffB); PG8_STAGE(PG8_SA(1, 0), a3, voffA);
            PG8_WAIT_V(8); PG8_WAIT_L(0); PG8_BAR; PG8_MMA(1, 0, At, B0); PG8_MMA(1, 1, At, B1); PG8_BAR; PG8_SCHED;
            } else {
            PG8_LDB(B0, 0, 0); PG8_SCHED; PG8_LDA(At, 0, 0); PG8_STAGE(PG8_SA(1, 1), a1 + hstep, voffA);
            PG8_WAIT_L(8); PG8_BAR; PG8_WAIT_L(0); PG8_MMA(0, 0, At, B0); PG8_BAR; PG8_SCHED;
            PG8_LDB(B1, 0, 1); PG8_STAGE(PG8_SB(0, 0), b2, voffB);
            PG8_BAR; PG8_WAIT_L(0); PG8_MMA(0, 1, At, B1); PG8_BAR;
            PG8_LDA(At, 0, 1); PG8_STAGE(PG8_SA(0, 0), a2, voffA);
            PG8_BAR; PG8_WAIT_L(0); PG8_MMA(1, 0, At, B0); PG8_BAR; PG8_SCHED;
            PG8_STAGE(PG8_SB(0, 1), b2 + hstep, voffB);
            PG8_WAIT_V(6); PG8_BAR; PG8_MMA(1, 1, At, B1); PG8_BAR;
            PG8_LDB(B0, 1, 0); PG8_SCHED; PG8_LDA(At, 1, 0); PG8_STAGE(PG8_SA(0, 1), a2 + hstep, voffA);
            PG8_WAIT_L(8); PG8_BAR; PG8_WAIT_L(0); PG8_MMA(0, 0, At, B0); PG8_BAR; PG8_SCHED;
            PG8_LDB(B1, 1, 1); PG8_STAGE(PG8_SB(1, 0), b3, voffB);
            PG8_BAR; PG8_WAIT_L(0); PG8_MMA(0, 1, At, B1); PG8_BAR;
            PG8_LDA(At, 1, 1); PG8_STAGE(PG8_SA(1, 0), a3, voffA);
            PG8_BAR; PG8_WAIT_L(0); PG8_MMA(1, 0, At, B0); PG8_BAR; PG8_SCHED;
            PG8_STAGE(PG8_SB(1, 1), b3 + hstep, voffB);
            PG8_WAIT_V(6); PG8_BAR; PG8_MMA(1, 1, At, B1); PG8_BAR;
            }
        }
        if constexpr (ALIGN_EPI) { if (wr == 0) PG8_BAR; }
        asm volatile("s_nop 15\n\ts_nop 15" ::: "memory");
        if constexpr (!Epi::AFTER_DRAIN) { E(acc, cur, wr, wc, fr, fq); S.done(cur); }
        if (!has_next) break;
#pragma unroll
        for (int a = 0; a < 2; ++a)
#pragma unroll
            for (int b = 0; b < 2; ++b)
#pragma unroll
                for (int m = 0; m < 4; ++m)
#pragma unroll
                    for (int n = 0; n < 2; ++n) acc[a][b][m][n] = (f32x4){0.f, 0.f, 0.f, 0.f};
        cur = nxt; cA = nA; cB = nB; ++ui;
        if constexpr (ALIGN_EPI) { if (wr == 1) PG8_BAR; }
    }
    PG8_WAIT_V(0);
    if constexpr (!ALIGN_EPI) { if (wr == 0) PG8_BAR; }
    PG8_BAR;
    if constexpr (Epi::AFTER_DRAIN) { E.fused(acc, cur, wr, wc, fr, fq, lds, wid, lane); S.done(cur); }
#undef PG8_SA
#undef PG8_SB
#undef PG8_STAGE
#undef PG8_LDA
#undef PG8_LDB
#undef PG8_MMA
#undef PG8_WAIT_V
#undef PG8_WAIT_L
#undef PG8_BAR
#undef PG8_SCHED
}
}

#define LAS __attribute__((address_space(3)))
typedef unsigned short bf16;
typedef short bf16x8 __attribute__((ext_vector_type(8)));
typedef float f32x4 __attribute__((ext_vector_type(4)));
typedef float f32x16 __attribute__((ext_vector_type(16)));
typedef unsigned u32x2 __attribute__((ext_vector_type(2)));
typedef unsigned u32x4 __attribute__((ext_vector_type(4)));

constexpr int NB = 8, SEQ = 2048, NMETA = 16, LL = 2064, DM = 1024, FF = 4096, DIN = 4864, NPROJ = 1792;
constexpr int NREAL = NB * SEQ;
constexpr int TPR = NREAL + 256;
constexpr int LDS_BYTES = 147456;

constexpr size_t MiB = 1u << 20;
constexpr size_t WS_CTL = 0;
constexpr size_t WS_ROPE = 1 * MiB;
constexpr size_t WS_ABAR = 2 * MiB;
constexpr size_t WS_BMAT = 2 * MiB + 65536;
constexpr size_t WS_CMAT = WS_BMAT + 524288;
constexpr size_t WS_HM = 4 * MiB;
constexpr size_t WS_W = 5 * MiB;
constexpr size_t OW_IN = 0, OW_GLU = (size_t)DIN * DM * 2, OW_POOL = OW_GLU + 512 * 512 * 2, OW_BR = OW_POOL + 512 * 512 * 2,
                 OW_OUT = OW_BR + 3 * 1024 * 512 * 2, OW_UP = OW_OUT + 1024 * 1024 * 2, OW_DN = OW_UP + (size_t)FF * DM * 2, LW_BYTES = OW_DN + (size_t)FF * DM * 2;
constexpr size_t WS_HB = 68 * MiB;
constexpr size_t WS_X = 101 * MiB;
constexpr size_t UU = (size_t)TPR * 512 * 2;
constexpr size_t WS_YF = WS_X, WS_YP = WS_X, WS_Q = WS_X + 2 * UU, WS_K = WS_Q + UU, WS_V = WS_K + UU / 4, WS_MG = WS_X + 2 * UU,
                 WS_SU = WS_X + 4 * UU, WS_YA = WS_X + 8 * UU  , WS_PU = WS_X + 5 * UU, WS_YS = WS_PU, WS_Z = WS_X + 6 * UU, WS_PD = WS_X + 7 * UU, WS_BR = WS_Z, WS_ACT = WS_X;
constexpr size_t WS_RS = WS_X + 9 * UU;
constexpr size_t WS_END = WS_RS + (size_t)5 * TPR * 16 * 4;
static_assert(WS_W + 2 * LW_BYTES <= WS_HB && WS_HB + (size_t)TPR * 1024 * 2 <= WS_X && WS_END <= 256 * MiB, "ws map");
static_assert((size_t)256 * 2064 * 16 * 4 <= 2 * UU, "YF fits");

__device__ __forceinline__ unsigned pk2(float lo, float hi) { unsigned r; asm("v_cvt_pk_bf16_f32 %0, %1, %2" : "=v"(r) : "v"(lo), "v"(hi)); return r; }
__device__ __forceinline__ unsigned f2bf(float f) { return pk2(f, 0.f) & 0xffffu; }
__device__ __forceinline__ float bf2f(unsigned b) { return __uint_as_float(b << 16); }
__device__ __forceinline__ int tok_row(int b, int l) { return l >= NMETA ? b * SEQ + l - NMETA : NREAL + b * NMETA + l; }
#define LDS_FENCE() asm volatile("s_waitcnt lgkmcnt(0)" ::: "memory")
#define SSM_SYNC() do { asm volatile("s_waitcnt vmcnt(0) lgkmcnt(0)" ::: "memory"); __syncthreads(); } while (0)
__device__ __forceinline__ float row_rstd(const float* rs, int R) {
    const f32x4 a = *(const f32x4*)(rs + (size_t)R * 4), b = *(const f32x4*)(rs + ((size_t)TPR + R) * 4), c = *(const f32x4*)(rs + ((size_t)2 * TPR + R) * 4), d = *(const f32x4*)(rs + ((size_t)3 * TPR + R) * 4);
    const float s = (((a[0] + a[1]) + (a[2] + a[3])) + ((b[0] + b[1]) + (b[2] + b[3]))) + (((c[0] + c[1]) + (c[2] + c[3])) + ((d[0] + d[1]) + (d[2] + d[3])));
    return rsqrtf(s * (1.0f / 1024.0f) + 1e-6f);
}

__device__ __forceinline__ void dsincos(double a, double& s, double& c) {
    const double q = rint(a * 0.63661977236758134308);
    double r = fma(-q, 1.57079632679489655800e+00, a); r = fma(-q, 6.12323399573676603587e-17, r);
    const double r2 = r * r;
    double sp = -7.6471637318198164759e-13; sp = fma(sp, r2, 1.6059043836821614599e-10); sp = fma(sp, r2, -2.5052108385441718775e-08); sp = fma(sp, r2, 2.7557319223985890653e-06);
    sp = fma(sp, r2, -1.9841269841269841270e-04); sp = fma(sp, r2, 8.3333333333333333333e-03); sp = fma(sp, r2, -1.6666666666666666667e-01); sp = fma(sp * r2, r, r);
    double cp = 4.7794773323873852974e-14; cp = fma(cp, r2, -1.1470745597729724714e-11); cp = fma(cp, r2, 2.0876756987868098979e-09); cp = fma(cp, r2, -2.7557319223985890653e-07);
    cp = fma(cp, r2, 2.4801587301587301587e-05); cp = fma(cp, r2, -1.3888888888888888889e-03); cp = fma(cp, r2, 4.1666666666666666667e-02); cp = fma(cp, r2, -0.5); cp = fma(cp, r2, 1.0);
    const int qi = ((int)q) & 3;
    s = (qi == 0) ? sp : (qi == 1) ? cp : (qi == 2) ? -sp : -cp;
    c = (qi == 0) ? cp : (qi == 1) ? -sp : (qi == 2) ? -cp : sp;
}
__device__ __forceinline__ double dexp(double x) {
    const double k = rint(x * 1.44269504088896340736);
    double r = fma(-k, 6.93147180369123816490e-01, x); r = fma(-k, 1.90821492927058770002e-10, r);
    double p = 1.0 / 6227020800.0; p = fma(p, r, 1.0 / 479001600.0); p = fma(p, r, 1.0 / 39916800.0); p = fma(p, r, 1.0 / 3628800.0); p = fma(p, r, 1.0 / 362880.0); p = fma(p, r, 1.0 / 40320.0);
    p = fma(p, r, 1.0 / 5040.0); p = fma(p, r, 1.0 / 720.0); p = fma(p, r, 1.0 / 120.0); p = fma(p, r, 1.0 / 24.0); p = fma(p, r, 1.0 / 6.0); p = fma(p, r, 0.5); p = fma(p, r, 1.0); p = fma(p, r, 1.0);
    const long long bits = ((long long)(1023 + (int)k)) << 52;
    return p * __longlong_as_double(bits);
}

struct EpiInProj {
    static constexpr bool PERM = true, AFTER_DRAIN = false;
    const float* rowss; const float* rope; bf16 *Q, *K, *V, *SU, *PU;
    __device__ __forceinline__ u32x2 quad(int l, int c, const f32x4& v) const {
        u32x2 w;
        if (c < 640) {
            const int i0 = (c & 63) >> 1;
            const f32x4 cs = *(const f32x4*)(rope + ((size_t)l * 32 + i0) * 2);
            float o0 = v[0] * cs[0] - v[1] * cs[1], o1 = v[1] * cs[0] + v[0] * cs[1], o2 = v[2] * cs[2] - v[3] * cs[3], o3 = v[3] * cs[2] + v[2] * cs[3];
            if (c < 512) { o0 *= 0.125f; o1 *= 0.125f; o2 *= 0.125f; o3 *= 0.125f; }
            w.x = pk2(o0, o1); w.y = pk2(o2, o3);
        } else { w.x = pk2(v[0], v[1]); w.y = pk2(v[2], v[3]); }
        return w;
    }
    __device__ __forceinline__ void operator()(const f32x4 (&acc)[2][2][4][2], const pg8::Unit& u, int wr, int wc, int fr, int fq) const {
#pragma unroll
        for (int ai = 0; ai < 2; ++ai)
#pragma unroll
            for (int m = 0; m < 4; ++m) {
                const int R = u.pm * 256 + ai * 128 + wr * 64 + m * 16 + fr;
                const float rs = row_rstd(rowss, R);
                const int l = R < NREAL ? (R & 2047) + NMETA : (R & 15);
#pragma unroll
                for (int bj = 0; bj < 2; ++bj) {
                    const int c = u.pn * 256 + bj * 128 + wc * 32 + 8 * fq;
                    const u32x2 w0 = quad(l, c, acc[ai][bj][m][0] * rs), w1 = quad(l, c + 4, acc[ai][bj][m][1] * rs);
                    u32x4 w; w.x = w0.x; w.y = w0.y; w.z = w1.x; w.w = w1.y;
                    bf16* dst = c < 512 ? Q + (size_t)R * 512 + c : c < 640 ? K + (size_t)R * 128 + (c - 512) : c < 768 ? V + (size_t)R * 128 + (c - 640)
                              : c < 1280 ? SU + (size_t)R * 512 + (c - 768) : PU + (size_t)R * 512 + (c - 1280);
                    *(u32x4*)dst = w;
                }
            }
    }
};
#define EPI_BODY() \
    __device__ __forceinline__ void rg(int R, int pn, int wc, int fq, const f32x4 (&a4)[2][2]) const { \
        _Pragma("unroll") for (int bj = 0; bj < 2; ++bj) q2(R, pn * 256 + bj * 128 + wc * 32 + 8 * fq, a4[bj][0], a4[bj][1]); } \
    __device__ __forceinline__ void tq(int R, int c, const f32x4& v) const { q(R, c, v); } \
    EPI_OP()
#define EPI_OP() \
    __device__ __forceinline__ void operator()(const f32x4 (&acc)[2][2][4][2], const pg8::Unit& u, int wr, int wc, int fr, int fq) const { \
        _Pragma("unroll") for (int ai = 0; ai < 2; ++ai) _Pragma("unroll") for (int m = 0; m < 4; ++m) { \
            const f32x4 a4[2][2] = {{acc[ai][0][m][0], acc[ai][0][m][1]}, {acc[ai][1][m][0], acc[ai][1][m][1]}}; \
            rg(u.pm * 256 + ai * 128 + wr * 64 + m * 16 + fr, u.pn, wc, fq, a4); } }
#define EPI_BODY_RS() \
    __device__ __forceinline__ void rg(int R, int pn, int wc, int fq, const f32x4 (&a4)[2][2]) const { const float rs = row_rstd(rowss, R); \
        _Pragma("unroll") for (int bj = 0; bj < 2; ++bj) q2(R, pn * 256 + bj * 128 + wc * 32 + 8 * fq, a4[bj][0], a4[bj][1], rs); } \
    __device__ __forceinline__ void tq(int R, int c, const f32x4& v) const { q(R, c, v, row_rstd(rowss, R)); } \
    EPI_OP()
struct EpiGlu {
    static constexpr bool PERM = true, AFTER_DRAIN = false;
    const bf16* Z; const float* bias; bf16* YS;
    __device__ __forceinline__ void q(int R, int c, const f32x4& a) const {
        const f32x4 v = a + *(const f32x4*)(bias + c);
        const u32x2 zz = *(const u32x2*)(Z + (size_t)R * 512 + c);
        const float z0 = bf2f(zz.x & 0xffffu), z1 = bf2f(zz.x >> 16), z2 = bf2f(zz.y & 0xffffu), z3 = bf2f(zz.y >> 16);
        u32x2 w; w.x = pk2(z0 * __builtin_amdgcn_rcpf(1.0f + __expf(-v[0])), z1 * __builtin_amdgcn_rcpf(1.0f + __expf(-v[1]))); w.y = pk2(z2 * __builtin_amdgcn_rcpf(1.0f + __expf(-v[2])), z3 * __builtin_amdgcn_rcpf(1.0f + __expf(-v[3])));
        *(u32x2*)(YS + (size_t)R * 512 + c) = w;
    }
    __device__ __forceinline__ void q2(int R, int c, const f32x4& a0, const f32x4& a1) const {
        const f32x4 v0 = a0 + *(const f32x4*)(bias + c), v1 = a1 + *(const f32x4*)(bias + c + 4);
        const u32x4 zz = *(const u32x4*)(Z + (size_t)R * 512 + c);
        u32x4 w;
        w.x = pk2(bf2f(zz.x & 0xffffu) * __builtin_amdgcn_rcpf(1.0f + __expf(-v0[0])), bf2f(zz.x >> 16) * __builtin_amdgcn_rcpf(1.0f + __expf(-v0[1])));
        w.y = pk2(bf2f(zz.y & 0xffffu) * __builtin_amdgcn_rcpf(1.0f + __expf(-v0[2])), bf2f(zz.y >> 16) * __builtin_amdgcn_rcpf(1.0f + __expf(-v0[3])));
        w.z = pk2(bf2f(zz.z & 0xffffu) * __builtin_amdgcn_rcpf(1.0f + __expf(-v1[0])), bf2f(zz.z >> 16) * __builtin_amdgcn_rcpf(1.0f + __expf(-v1[1])));
        w.w = pk2(bf2f(zz.w & 0xffffu) * __builtin_amdgcn_rcpf(1.0f + __expf(-v1[2])), bf2f(zz.w >> 16) * __builtin_amdgcn_rcpf(1.0f + __expf(-v1[3])));
        *(u32x4*)(YS + (size_t)R * 512 + c) = w;
    }
    EPI_BODY()
};
struct EpiScale {
    static constexpr bool PERM = true, AFTER_DRAIN = false;
    bf16* O; int ldc; const float* scale;
    __device__ __forceinline__ void q(int R, int c, const f32x4& a) const {
        f32x4 v = a;
        if (scale) v = v * *(const f32x4*)(scale + c);
        u32x2 w; w.x = pk2(v[0], v[1]); w.y = pk2(v[2], v[3]);
        *(u32x2*)(O + (size_t)R * ldc + c) = w;
    }
    __device__ __forceinline__ void q2(int R, int c, const f32x4& a0, const f32x4& a1) const {
        f32x4 v0 = a0, v1 = a1;
        if (scale) { v0 = v0 * *(const f32x4*)(scale + c); v1 = v1 * *(const f32x4*)(scale + c + 4); }
        u32x4 w; w.x = pk2(v0[0], v0[1]); w.y = pk2(v0[2], v0[3]); w.z = pk2(v1[0], v1[1]); w.w = pk2(v1[2], v1[3]);
        *(u32x4*)(O + (size_t)R * ldc + c) = w;
    }
    EPI_BODY()
};
template <bool FIRST> struct EpiGate {
    static constexpr bool PERM = true, AFTER_DRAIN = false;
    const float* rowss; const bf16* BR; bf16* MG;
    __device__ __forceinline__ void q(int R, int c, const f32x4& a, float rs) const {
        const f32x4 v = a * rs;
        const u32x2 bb = *(const u32x2*)(BR + (size_t)R * 1024 + c);
        float o0 = bf2f(bb.x & 0xffffu) * __builtin_amdgcn_rcpf(1.0f + __expf(-v[0])), o1 = bf2f(bb.x >> 16) * __builtin_amdgcn_rcpf(1.0f + __expf(-v[1]));
        float o2 = bf2f(bb.y & 0xffffu) * __builtin_amdgcn_rcpf(1.0f + __expf(-v[2])), o3 = bf2f(bb.y >> 16) * __builtin_amdgcn_rcpf(1.0f + __expf(-v[3]));
        if (!FIRST) { const u32x2 mm = *(const u32x2*)(MG + (size_t)R * 1024 + c);
            o0 += bf2f(mm.x & 0xffffu); o1 += bf2f(mm.x >> 16); o2 += bf2f(mm.y & 0xffffu); o3 += bf2f(mm.y >> 16); }
        u32x2 w; w.x = pk2(o0, o1); w.y = pk2(o2, o3);
        *(u32x2*)(MG + (size_t)R * 1024 + c) = w;
    }
    __device__ __forceinline__ void q2(int R, int c, const f32x4& a0, const f32x4& a1, float rs) const {
        const f32x4 v0 = a0 * rs, v1 = a1 * rs;
        const u32x4 bb = *(const u32x4*)(BR + (size_t)R * 1024 + c);
        float o[8];
        o[0] = bf2f(bb.x & 0xffffu) * __builtin_amdgcn_rcpf(1.0f + __expf(-v0[0])); o[1] = bf2f(bb.x >> 16) * __builtin_amdgcn_rcpf(1.0f + __expf(-v0[1]));
        o[2] = bf2f(bb.y & 0xffffu) * __builtin_amdgcn_rcpf(1.0f + __expf(-v0[2])); o[3] = bf2f(bb.y >> 16) * __builtin_amdgcn_rcpf(1.0f + __expf(-v0[3]));
        o[4] = bf2f(bb.z & 0xffffu) * __builtin_amdgcn_rcpf(1.0f + __expf(-v1[0])); o[5] = bf2f(bb.z >> 16) * __builtin_amdgcn_rcpf(1.0f + __expf(-v1[1]));
        o[6] = bf2f(bb.w & 0xffffu) * __builtin_amdgcn_rcpf(1.0f + __expf(-v1[2])); o[7] = bf2f(bb.w >> 16) * __builtin_amdgcn_rcpf(1.0f + __expf(-v1[3]));
        if (!FIRST) { const u32x4 mm = *(const u32x4*)(MG + (size_t)R * 1024 + c);
            o[0] += bf2f(mm.x & 0xffffu); o[1] += bf2f(mm.x >> 16); o[2] += bf2f(mm.y & 0xffffu); o[3] += bf2f(mm.y >> 16);
            o[4] += bf2f(mm.z & 0xffffu); o[5] += bf2f(mm.z >> 16); o[6] += bf2f(mm.w & 0xffffu); o[7] += bf2f(mm.w >> 16); }
        u32x4 w; w.x = pk2(o[0], o[1]); w.y = pk2(o[2], o[3]); w.z = pk2(o[4], o[5]); w.w = pk2(o[6], o[7]);
        *(u32x4*)(MG + (size_t)R * 1024 + c) = w;
    }
    EPI_BODY_RS()
};
struct EpiRes {
    static constexpr bool PERM = true, AFTER_DRAIN = false;
    const float* Xin; bf16* HB; float* rowss_out;
    __device__ __forceinline__ float q(int R, int c, const f32x4& a) const {
        f32x4 h;
        if (Xin && R < NREAL) h = *(const f32x4*)(Xin + (size_t)R * 1024 + c);
        else { const u32x2 hb = *(const u32x2*)(HB + (size_t)R * 1024 + c); h = (f32x4){bf2f(hb.x & 0xffffu), bf2f(hb.x >> 16), bf2f(hb.y & 0xffffu), bf2f(hb.y >> 16)}; }
        h = h + a;
        u32x2 w; w.x = pk2(h[0], h[1]); w.y = pk2(h[2], h[3]);
        *(u32x2*)(HB + (size_t)R * 1024 + c) = w;
        const float r0 = bf2f(w.x & 0xffffu), r1 = bf2f(w.x >> 16), r2 = bf2f(w.y & 0xffffu), r3 = bf2f(w.y >> 16);
        return (r0 * r0 + r1 * r1) + (r2 * r2 + r3 * r3);
    }
    __device__ __forceinline__ float q2(int R, int c, const f32x4& a0, const f32x4& a1) const {
        f32x4 h0, h1;
        if (Xin && R < NREAL) { h0 = *(const f32x4*)(Xin + (size_t)R * 1024 + c); h1 = *(const f32x4*)(Xin + (size_t)R * 1024 + c + 4); }
        else { const u32x4 hb = *(const u32x4*)(HB + (size_t)R * 1024 + c);
            h0 = (f32x4){bf2f(hb.x & 0xffffu), bf2f(hb.x >> 16), bf2f(hb.y & 0xffffu), bf2f(hb.y >> 16)}; h1 = (f32x4){bf2f(hb.z & 0xffffu), bf2f(hb.z >> 16), bf2f(hb.w & 0xffffu), bf2f(hb.w >> 16)}; }
        h0 = h0 + a0; h1 = h1 + a1;
        u32x4 w; w.x = pk2(h0[0], h0[1]); w.y = pk2(h0[2], h0[3]); w.z = pk2(h1[0], h1[1]); w.w = pk2(h1[2], h1[3]);
        *(u32x4*)(HB + (size_t)R * 1024 + c) = w;
        const float r0 = bf2f(w.x & 0xffffu), r1 = bf2f(w.x >> 16), r2 = bf2f(w.y & 0xffffu), r3 = bf2f(w.y >> 16), r4 = bf2f(w.z & 0xffffu), r5 = bf2f(w.z >> 16), r6 = bf2f(w.w & 0xffffu), r7 = bf2f(w.w >> 16);
        return ((r0 * r0 + r1 * r1) + (r2 * r2 + r3 * r3)) + ((r4 * r4 + r5 * r5) + (r6 * r6 + r7 * r7));
    }
    __device__ __forceinline__ void rg(int R, int pn, int wc, int fq, const f32x4 (&a4)[2][2]) const {
        float ss = 0.f;
#pragma unroll
        for (int bj = 0; bj < 2; ++bj) ss += q2(R, pn * 256 + bj * 128 + wc * 32 + 8 * fq, a4[bj][0], a4[bj][1]);
        ss += __shfl_xor(ss, 16); ss += __shfl_xor(ss, 32);
        if (fq == 0) rowss_out[((size_t)pn * TPR + R) * 4 + wc] = ss;
    }
    __device__ __forceinline__ void tq(int R, int c, const f32x4& v) const {
        float ss = q(R, c, v);
        ss += __shfl_xor(ss, 16); ss += __shfl_xor(ss, 32);
        if ((threadIdx.x & 48) == 0) atomicAdd(rowss_out + (size_t)R * 4, ss);
    }
    EPI_OP()
};
struct EpiUp {
    static constexpr bool PERM = true, AFTER_DRAIN = false;
    const float* rowss; bf16* ACT;
    __device__ __forceinline__ void q(int R, int c, const f32x4& a, float rs) const {
        f32x4 v = a * rs;
#pragma unroll
        for (int j = 0; j < 4; ++j) { const float r = fmaxf(v[j], 0.f); v[j] = r * r; }
        u32x2 w; w.x = pk2(v[0], v[1]); w.y = pk2(v[2], v[3]);
        *(u32x2*)(ACT + (size_t)R * FF + c) = w;
    }
    __device__ __forceinline__ void q2(int R, int c, const f32x4& a0, const f32x4& a1, float rs) const {
        f32x4 v0 = a0 * rs, v1 = a1 * rs;
#pragma unroll
        for (int j = 0; j < 4; ++j) { const float r0 = fmaxf(v0[j], 0.f), r1 = fmaxf(v1[j], 0.f); v0[j] = r0 * r0; v1[j] = r1 * r1; }
        u32x4 w; w.x = pk2(v0[0], v0[1]); w.y = pk2(v0[2], v0[3]); w.z = pk2(v1[0], v1[1]); w.w = pk2(v1[2], v1[3]);
        *(u32x4*)(ACT + (size_t)R * FF + c) = w;
    }
    EPI_BODY_RS()
};
struct TripleOrder {
    pg8::StaticOrder S0; int arow, bcol;
    __device__ __forceinline__ void init(int G, int c, int arow_, int bcol_) { S0.init(NREAL, 1024, G, c); arow = arow_; bcol = bcol_; }
    __device__ __forceinline__ bool next(int i, pg8::Unit& u) const { pg8::Unit t; t.pm = 0; t.pn = 0; if (!S0.next(i / 3, t)) return false; const int br = i % 3; u.pm = t.pm + br * arow; u.pn = t.pn + br * bcol; return true; }
    __device__ __forceinline__ void a_ready(const pg8::Unit&) const {}
    __device__ __forceinline__ void done(const pg8::Unit&) const {}
};
struct EpiBr3 {
    static constexpr bool PERM = true, AFTER_DRAIN = false;
    bf16* Bbase; int arow;
    __device__ __forceinline__ void operator()(const f32x4 (&acc)[2][2][4][2], const pg8::Unit& u, int wr, int wc, int fr, int fq) const {
        const int c = u.pn >> 2, pn = u.pn & 3, pm = u.pm - arow * c; bf16* O = Bbase + (size_t)(2 * c + 2 * (c > 0)) * (UU / 2);
#pragma unroll
        for (int ai = 0; ai < 2; ++ai)
#pragma unroll
            for (int m = 0; m < 4; ++m) { const int R = pm * 256 + ai * 128 + wr * 64 + m * 16 + fr;
#pragma unroll
                for (int bj = 0; bj < 2; ++bj) { const f32x4 v0 = acc[ai][bj][m][0], v1 = acc[ai][bj][m][1];
                    u32x4 w; w.x = pk2(v0[0], v0[1]); w.y = pk2(v0[2], v0[3]); w.z = pk2(v1[0], v1[1]); w.w = pk2(v1[2], v1[3]);
                    *(u32x4*)(O + (size_t)R * 1024 + pn * 256 + bj * 128 + wc * 32 + 8 * fq) = w; } }
    }
};
struct EpiGate3 {
    static constexpr bool PERM = true, AFTER_DRAIN = false;
    const float* rowss; const bf16* Bbase; bf16* MG;
    __device__ __forceinline__ void operator()(const f32x4 (&acc)[2][2][4][2], const pg8::Unit& u, int wr, int wc, int fr, int fq) const {
        const int c = u.pn >> 2, pn = u.pn & 3; const bf16* BR = Bbase + (size_t)(2 * c + 2 * (c > 0)) * (UU / 2);
#pragma unroll
        for (int ai = 0; ai < 2; ++ai)
#pragma unroll
            for (int m = 0; m < 4; ++m) { const int R = u.pm * 256 + ai * 128 + wr * 64 + m * 16 + fr; const float rs = row_rstd(rowss, R);
#pragma unroll
                for (int bj = 0; bj < 2; ++bj) { const int cc = pn * 256 + bj * 128 + wc * 32 + 8 * fq;
                    const f32x4 v0 = acc[ai][bj][m][0] * rs, v1 = acc[ai][bj][m][1] * rs;
                    const u32x4 bb = *(const u32x4*)(BR + (size_t)R * 1024 + cc);
                    float o[8];
                    o[0] = bf2f(bb.x & 0xffffu) * __builtin_amdgcn_rcpf(1.0f + __expf(-v0[0])); o[1] = bf2f(bb.x >> 16) * __builtin_amdgcn_rcpf(1.0f + __expf(-v0[1]));
                    o[2] = bf2f(bb.y & 0xffffu) * __builtin_amdgcn_rcpf(1.0f + __expf(-v0[2])); o[3] = bf2f(bb.y >> 16) * __builtin_amdgcn_rcpf(1.0f + __expf(-v0[3]));
                    o[4] = bf2f(bb.z & 0xffffu) * __builtin_amdgcn_rcpf(1.0f + __expf(-v1[0])); o[5] = bf2f(bb.z >> 16) * __builtin_amdgcn_rcpf(1.0f + __expf(-v1[1]));
                    o[6] = bf2f(bb.w & 0xffffu) * __builtin_amdgcn_rcpf(1.0f + __expf(-v1[2])); o[7] = bf2f(bb.w >> 16) * __builtin_amdgcn_rcpf(1.0f + __expf(-v1[3]));
                    if (c != 0) { const u32x4 mm = *(const u32x4*)(MG + (size_t)R * 1024 + cc);
                        o[0] += bf2f(mm.x & 0xffffu); o[1] += bf2f(mm.x >> 16); o[2] += bf2f(mm.y & 0xffffu); o[3] += bf2f(mm.y >> 16);
                        o[4] += bf2f(mm.z & 0xffffu); o[5] += bf2f(mm.z >> 16); o[6] += bf2f(mm.w & 0xffffu); o[7] += bf2f(mm.w >> 16); }
                    u32x4 w; w.x = pk2(o[0], o[1]); w.y = pk2(o[2], o[3]); w.z = pk2(o[4], o[5]); w.w = pk2(o[6], o[7]);
                    *(u32x4*)(MG + (size_t)R * 1024 + cc) = w; } }
    }
};
template <class Epi, bool SUM3 = false>
__device__ __forceinline__ void thin_gemm(LAS unsigned char* lds, const bf16* A, const bf16* Bt, int K, int N, const Epi& E, int vb, int vg, size_t asum_stride = 0) {
    int tid_l = threadIdx.x; asm volatile("" : "+v"(tid_l));
    const int lane = tid_l & 63, w = __builtin_amdgcn_readfirstlane(tid_l >> 6), fr = lane & 15, fq = lane >> 4;
    LAS f32x4* red = (LAS f32x4*)lds;
    const int kw = K >> 3;
    for (int pc = vb; pc < N / 16; pc += vg) {
        const bf16* ap = A + (size_t)(NREAL + fr) * K + w * kw + 8 * fq;
        const bf16* bp = Bt + (size_t)(16 * pc + fr) * K + w * kw + 8 * fq;
        f32x4 acc[8];
#pragma unroll
        for (int rb = 0; rb < 8; ++rb) acc[rb] = (f32x4){0.f, 0.f, 0.f, 0.f};
#pragma unroll (SUM3 ? 1 : 4)
        for (int k0 = 0; k0 < kw; k0 += 32) {
            const bf16x8 bf = *(const bf16x8*)(bp + k0);
            bf16x8 af[8];
#pragma unroll
            for (int rb = 0; rb < 8; ++rb) {
                if constexpr (!SUM3) af[rb] = *(const bf16x8*)(ap + (size_t)(16 * rb) * K + k0);
                else {
                    const bf16* a0 = ap + (size_t)(16 * rb) * K + k0;
                    const u32x4 x0 = *(const u32x4*)a0, x1 = *(const u32x4*)(a0 + asum_stride), x2 = *(const u32x4*)(a0 + 2 * asum_stride);
                    union { bf16x8 v; unsigned u[4]; } s;
                    const unsigned w0[4] = {x0.x, x0.y, x0.z, x0.w}, w1[4] = {x1.x, x1.y, x1.z, x1.w}, w2[4] = {x2.x, x2.y, x2.z, x2.w};
#pragma unroll
                    for (int j = 0; j < 4; ++j) s.u[j] = pk2((bf2f(w0[j] & 0xffffu) + bf2f(w1[j] & 0xffffu)) + bf2f(w2[j] & 0xffffu), (bf2f(w0[j] >> 16) + bf2f(w1[j] >> 16)) + bf2f(w2[j] >> 16));
                    af[rb] = s.v;
                }
            }
#pragma unroll
            for (int rb = 0; rb < 8; ++rb) acc[rb] = __builtin_amdgcn_mfma_f32_16x16x32_bf16(bf, af[rb], acc[rb], 0, 0, 0);
        }
        asm volatile("s_nop 15\n\ts_nop 15" : "+v"(acc[0]), "+v"(acc[1]), "+v"(acc[2]), "+v"(acc[3]), "+v"(acc[4]), "+v"(acc[5]), "+v"(acc[6]), "+v"(acc[7]));
#pragma unroll
        for (int rb = 0; rb < 8; ++rb) red[(w * 8 + rb) * 64 + lane] = acc[rb];
        LDS_FENCE(); __syncthreads();
        f32x4 v = red[(0 * 8 + w) * 64 + lane];
#pragma unroll
        for (int ww = 1; ww < 8; ++ww) v = v + red[(ww * 8 + w) * 64 + lane];
        LDS_FENCE(); __syncthreads();
        E.tq(NREAL + 16 * w + fr, 16 * pc + 4 * fq, v);
    }
}

struct Args { const float* in[23]; float* out; unsigned char* ws; };

__device__ __forceinline__ void p0_item(const float* W, int ldw, int K, const float* scale, bf16* WT, int permrows, LAS float* scr, int item, int nblk, int lane) {
    const int kb = item / nblk, nb = item % nblk, k0 = 64 * kb, n0 = 64 * nb;
#pragma unroll 4
    for (int i = 0; i < 16; ++i) {
        const int kk = 4 * i + (lane >> 4), c4 = (lane & 15) * 4;
        f32x4 w = __builtin_nontemporal_load((const f32x4*)(W + (size_t)(k0 + kk) * ldw + n0 + c4));
        if (scale) w = w * scale[k0 + kk];
        scr[kk * 65 + c4] = w[0]; scr[kk * 65 + c4 + 1] = w[1]; scr[kk * 65 + c4 + 2] = w[2]; scr[kk * 65 + c4 + 3] = w[3];
    }
    LDS_FENCE();
    const int c = lane & 7;
#pragma unroll
    for (int j = 0; j < 8; ++j) {
        const int n = (lane >> 3) + 8 * j;
        const int sc = (n0 + n) < permrows ? ((n & 1) ? 32 + (n >> 1) : (n >> 1)) : n;
        const LAS float* s = scr + (8 * c) * 65 + sc;
        u32x4 o; o.x = pk2(s[0 * 65], s[1 * 65]); o.y = pk2(s[2 * 65], s[3 * 65]); o.z = pk2(s[4 * 65], s[5 * 65]); o.w = pk2(s[6 * 65], s[7 * 65]);
        *(u32x4*)(WT + (size_t)(n0 + n) * K + k0 + 8 * c) = o;
    }
    LDS_FENCE();
}

typedef const __attribute__((address_space(4))) Args* KArgsP;
__device__ __forceinline__ void convert_layer_weights(KArgsP ka, LAS unsigned char* lds, int layer, int vw, int nvw, int wave, int lane, int part  ) {
    unsigned char* ws = ka->ws;
    LAS float* scr = (LAS float*)(lds + wave * 17408);
    constexpr int I_IN = 16 * 76, I_GLU = 8 * 8, I_BR = 8 * 16, I_OUT = 16 * 16, I_UP = 16 * 64, I_DN = 64 * 16, I_L = I_IN + I_GLU + 3 * I_BR + I_OUT + I_UP + I_DN;
    unsigned char* wl = ws + WS_W + (size_t)layer * LW_BYTES;
    for (int it = (part == 0 ? 0 : I_IN) + vw; it < (part == 0 ? I_IN : I_L); it += nvw) {
        int r = it;
        if (r < I_IN) { p0_item(ka->in[3] + (size_t)layer * DM * DIN, DIN, DM, ka->in[2] + layer * DM, (bf16*)(wl + OW_IN), 640, scr, r, 76, lane); continue; } r -= I_IN;
        if (r < I_GLU) { p0_item(ka->in[13] + (size_t)layer * 512 * 512, 512, 512, nullptr, (bf16*)(wl + OW_GLU), 0, scr, r, 8, lane); continue; } r -= I_GLU;
        if (r < 3 * I_BR) { const int c = r / I_BR; p0_item(ka->in[17] + ((size_t)layer * 3 + c) * 512 * 1024, 1024, 512, nullptr, (bf16*)(wl + OW_BR) + (size_t)c * 1024 * 512, 0, scr, r % I_BR, 16, lane); continue; } r -= 3 * I_BR;
        if (r < I_OUT) { p0_item(ka->in[18] + (size_t)layer * DM * DM, DM, DM, nullptr, (bf16*)(wl + OW_OUT), 0, scr, r, 16, lane); continue; } r -= I_OUT;
        if (r < I_UP) { p0_item(ka->in[20] + (size_t)layer * DM * FF, FF, DM, ka->in[19] + layer * DM, (bf16*)(wl + OW_UP), 0, scr, r, 64, lane); continue; } r -= I_UP;
        p0_item(ka->in[21] + (size_t)layer * FF * DM, DM, FF, nullptr, (bf16*)(wl + OW_DN), 0, scr, r, 16, lane);
    }
    if (part == 1) for (int i = vw * 64 + lane; i < 512 * 64; i += nvw * 64) {
        const int n = i >> 6, k0 = (i & 63) * 8;
        u32x4 o = {0u, 0u, 0u, 0u};
        if ((n >> 7) == (k0 >> 7)) { const float* src = ka->in[15] + (((size_t)layer * 4 + (n >> 7)) * 128 + (k0 & 127)) * 128 + (n & 127);
            o.x = pk2(src[0], src[128]); o.y = pk2(src[256], src[384]); o.z = pk2(src[512], src[640]); o.w = pk2(src[768], src[896]); }
        *(u32x4*)((bf16*)(wl + OW_POOL) + (size_t)n * 512 + k0) = o;
    }
}

__device__ __forceinline__ void p0_prologue(const Args& a, LAS unsigned char* lds) {
    int tl_ = threadIdx.x; asm volatile("" : "+v"(tl_));
    const int tid = tl_, lane = tid & 63, wave = __builtin_amdgcn_readfirstlane(tid >> 6);
    const int gw = blockIdx.x * 8 + wave, NGW = gridDim.x * 8;
    const int gt = blockIdx.x * 512 + tid, NGT = gridDim.x * 512;
    unsigned char* ws = a.ws;
    for (int i = gt; i < 4 * 4 * 128 * 4; i += NGT) { const int idx = 1 + (i >> 11), pn = (i >> 9) & 3, r = (i >> 2) & 127, sl = i & 3;
        ((float*)(ws + WS_RS))[((size_t)idx * 4 * TPR + (size_t)pn * TPR + NREAL + r) * 4 + sl] = 0.f; }
    for (int i = gt; i < LL * 32; i += NGT) {
        const int l = i >> 5, f = i & 31;
        const float invf = (float)dexp(-(double)f * (9.21034037197618273607 / 32.0));
        const float ang = (float)l * invf;
        double s, c; dsincos((double)ang, s, c);
        float* rp = (float*)(ws + WS_ROPE) + (size_t)i * 2; rp[0] = (float)c; rp[1] = (float)s;
    }
    for (int j = gt; j < 2 * 2 * 32 * 64 * 16; j += NGT) {
        const int q = j & 15, i = j >> 4, n = i & 63, pidx = i >> 6;
        const double lr = (double)a.in[5][i], li = (double)a.in[6][i];
        const double dt = (double)(float)dexp((double)a.in[7][pidx]);
        const double mag = dexp(lr * dt); double sn, cn; dsincos(li * dt, sn, cn);
        const double are = mag * cn, aim = mag * sn, den = lr * lr + li * li, nre = are - 1.0;
        const double fre = (nre * lr + aim * li) / den, fim = (aim * lr - nre * li) / den;
        if (q == 0) { float* ab = (float*)(ws + WS_ABAR) + (size_t)i * 2; ab[0] = (float)are; ab[1] = (float)aim; }
        bf16* bm = (bf16*)(ws + WS_BMAT) + (size_t)pidx * 128 * 16;
        bf16* cm = (bf16*)(ws + WS_CMAT) + (size_t)pidx * 16 * 128;
        const double br = (double)a.in[8][(size_t)i * 16 + q], bi = (double)a.in[9][(size_t)i * 16 + q];
        bm[n * 16 + q] = (bf16)f2bf((float)(fre * br - fim * bi));
        bm[(64 + n) * 16 + q] = (bf16)f2bf((float)(fre * bi + fim * br));
        *(unsigned*)(cm + q * 128 + 2 * n) = pk2(a.in[10][((size_t)pidx * 16 + q) * 64 + n], -a.in[11][((size_t)pidx * 16 + q) * 64 + n]);
    }
    for (int R = gw; R < TPR; R += NGW) {
        const int mrow = R - NREAL;
        const float* src = R < NREAL ? a.in[0] + (size_t)R * DM : a.in[1] + (size_t)(mrow & 15) * DM;
        float* dst = R < NREAL ? a.out + (size_t)R * DM : (float*)(ws + WS_HM) + (size_t)mrow * DM;
        bf16* hb = (bf16*)(ws + WS_HB) + (size_t)R * DM;
        const bool pad = mrow >= NB * NMETA;
        float ss = 0.f;
#pragma unroll
        for (int j = 0; j < 4; ++j) {
            f32x4 v = __builtin_nontemporal_load((const f32x4*)(src + 4 * lane + 256 * j));
            if (pad) v = (f32x4){0.f, 0.f, 0.f, 0.f};
            ss += (v[0] * v[0] + v[1] * v[1]) + (v[2] * v[2] + v[3] * v[3]);
            u32x2 w; w.x = pk2(v[0], v[1]); w.y = pk2(v[2], v[3]);
            *(u32x2*)(hb + 4 * lane + 256 * j) = w;
        }
#pragma unroll
        for (int o = 1; o < 64; o <<= 1) ss += __shfl_xor(ss, o);
        if (lane < 16) ((float*)(ws + WS_RS))[((size_t)(lane >> 2) * TPR + R) * 4 + (lane & 3)] = lane == 0 ? ss : 0.f;
    }
}

__device__ __forceinline__ void ssm_task(LAS unsigned char* lds, int task, int layer, const bf16* SU, float* YF,
                                         const float* abar_all, const bf16* bmat_all, const bf16* cmat_all) {
    int tid_l = threadIdx.x; asm volatile("" : "+v"(tid_l));
    const int tid = tid_l, lane = tid & 63, wave = __builtin_amdgcn_readfirstlane(tid >> 6);
    const int b = task >> 5, g = task & 31;
    __syncthreads();
    LAS float* BU = (LAS float*)(lds + wave * 12800);
    LAS unsigned short* X = (LAS unsigned short*)(lds + wave * 12800 + 8448);
    LAS float* SX = (LAS float*)(lds + 8 * 12800);
    const int blk0 = wave == 0 ? 0 : 16 * wave + 1, nblk = wave == 0 ? 17 : 16;
    bf16* yfb = (bf16*)YF + (size_t)task * LL * 16;
    const int fr = lane & 15, fq = lane >> 4;
    const bf16x8 zero8 = {0, 0, 0, 0, 0, 0, 0, 0};
    for (int dir = 0; dir < 2; ++dir) {
        const int pidx = (layer * 2 + dir) * 32 + g;
        const float are = abar_all[((size_t)pidx * 64 + lane) * 2], aim = abar_all[((size_t)pidx * 64 + lane) * 2 + 1];
        bf16x8 bfr[8], cfr[4];
        const bf16* bm = bmat_all + (size_t)pidx * 128 * 16;
#pragma unroll
        for (int nt = 0; nt < 8; ++nt) bfr[nt] = fq < 2 ? *(const bf16x8*)(bm + (nt * 16 + fr) * 16 + 8 * fq) : zero8;
        const bf16* cm = cmat_all + (size_t)pidx * 16 * 128;
#pragma unroll
        for (int ks = 0; ks < 4; ++ks) cfr[ks] = *(const bf16x8*)(cm + fr * 128 + ks * 32 + 8 * fq);
        float p16r = are, p16i = aim;
#pragma unroll
        for (int i = 0; i < 4; ++i) { const float tr = p16r * p16r - p16i * p16i, ti = 2.f * p16r * p16i; p16r = tr; p16i = ti; }
        float p256r = p16r, p256i = p16i;
#pragma unroll
        for (int i = 0; i < 4; ++i) { const float tr = p256r * p256r - p256i * p256i, ti = 2.f * p256r * p256i; p256r = tr; p256i = ti; }
        const float p272r = p256r * p16r - p256i * p16i, p272i = p256r * p16i + p256i * p16r;

        float xre = 0.f, xim = 0.f;
        for (int pass = 0; pass < 2; ++pass) {
            bf16x8 unext;
            { const int blkf = dir == 0 ? blk0 : blk0 + nblk - 1; const int Rf = blkf == 0 ? NREAL + b * NMETA : b * SEQ + blkf * 16 - NMETA;
              unext = fq < 2 ? *(const bf16x8*)(SU + (size_t)(Rf + fr) * 512 + g * 16 + 8 * fq) : zero8; }
            for (int ib = 0; ib < nblk; ++ib) {
                const int blk = dir == 0 ? blk0 + ib : blk0 + nblk - 1 - ib;
                const bf16x8 ufr = unext;
                if (ib + 1 < nblk) { const int blkn = dir == 0 ? blk + 1 : blk - 1; const int Rn = blkn == 0 ? NREAL + b * NMETA : b * SEQ + blkn * 16 - NMETA;
                    unext = fq < 2 ? *(const bf16x8*)(SU + (size_t)(Rn + fr) * 512 + g * 16 + 8 * fq) : zero8; }
                f32x4 dd[8];
#pragma unroll
                for (int nt = 0; nt < 8; ++nt) { dd[nt] = (f32x4){0.f, 0.f, 0.f, 0.f}; dd[nt] = __builtin_amdgcn_mfma_f32_16x16x32_bf16(ufr, bfr[nt], dd[nt], 0, 0, 0); }
                asm volatile("s_nop 15\n\ts_nop 15" : "+v"(dd[0]), "+v"(dd[1]), "+v"(dd[2]), "+v"(dd[3]), "+v"(dd[4]), "+v"(dd[5]), "+v"(dd[6]), "+v"(dd[7]));
#pragma unroll
                for (int nt = 0; nt < 8; ++nt)
#pragma unroll
                    for (int r = 0; r < 4; ++r) BU[(4 * fq + r) * 132 + nt * 16 + fr] = dd[nt][r];
                LDS_FENCE();
                float bur[16], bui[16];
#pragma unroll
                for (int i = 0; i < 16; ++i) { const int tt = dir == 0 ? i : 15 - i; bur[i] = BU[tt * 132 + lane]; bui[i] = BU[tt * 132 + 64 + lane]; }
                if (pass == 0) {
#pragma unroll
                    for (int i = 0; i < 16; ++i) {
                        const float bre = bur[i], bim = bui[i];
                        const float nr = are * xre - aim * xim + bre, ni = are * xim + aim * xre + bim; xre = nr; xim = ni;
                    }
                    LDS_FENCE();
                } else {
#pragma unroll
                    for (int i = 0; i < 16; ++i) {
                        const int tt = dir == 0 ? i : 15 - i;
                        const float bre = bur[i], bim = bui[i];
                        const float nr = are * xre - aim * xim + bre, ni = are * xim + aim * xre + bim; xre = nr; xim = ni;
                        *(LAS unsigned*)(X + tt * 136 + 2 * lane) = pk2(xre, xim);
                    }
                    LDS_FENCE();
                    f32x4 y = {0.f, 0.f, 0.f, 0.f};
#pragma unroll
                    for (int ks = 0; ks < 4; ++ks) {
                        const bf16x8 afr = *(const LAS bf16x8*)(X + fr * 136 + ks * 32 + 8 * fq);
                        y = __builtin_amdgcn_mfma_f32_16x16x32_bf16(afr, cfr[ks], y, 0, 0, 0);
                    }
                    asm volatile("s_nop 15\n\ts_nop 15" : "+v"(y));
                    LDS_FENCE();
                    {
                        bf16* yd = yfb + (size_t)dir * 256 * LL * 16;
#pragma unroll
                        for (int r = 0; r < 4; ++r) yd[(size_t)(blk * 16 + 4 * fq + r) * 16 + fr] = (bf16)f2bf(y[r]);
                    }
                }
            }
            if (pass == 0) {
                SX[(wave * 64 + lane) * 2] = xre; SX[(wave * 64 + lane) * 2 + 1] = xim;
                LDS_FENCE(); __syncthreads();
                float cre = 0.f, cim = 0.f;
                if (dir == 0) {
                    for (int w = 0; w < wave; ++w) { const float pr = w == 0 ? p272r : p256r, pi = w == 0 ? p272i : p256i;
                        const float sr = SX[(w * 64 + lane) * 2], si = SX[(w * 64 + lane) * 2 + 1];
                        const float nr = pr * cre - pi * cim + sr, ni = pr * cim + pi * cre + si; cre = nr; cim = ni; }
                } else {
                    for (int w = 7; w > wave; --w) {
                        const float sr = SX[(w * 64 + lane) * 2], si = SX[(w * 64 + lane) * 2 + 1];
                        const float nr = p256r * cre - p256i * cim + sr, ni = p256r * cim + p256i * cre + si; cre = nr; cim = ni; }
                }
                xre = cre; xim = cim;
            }
        }
        LDS_FENCE(); __syncthreads();
    }
}

constexpr int ATT_KROW = 72, ATT_VROW = 40, ATT_KT = 32 * ATT_KROW * 2  , ATT_VT = 64 * ATT_VROW * 2  , ATT_MAXT = 11, ATT_VOFF = ATT_MAXT * ATT_KT;
static_assert(ATT_VOFF + ATT_MAXT * ATT_VT <= 131072, "attention LDS");
__device__ __forceinline__ void attn_task(LAS unsigned char* lds, int task, const bf16* Q, const bf16* K, const bf16* V, bf16* YA, const float* sink) {
    int tid_l = threadIdx.x; asm volatile("" : "+v"(tid_l));
    const int tid = tid_l, lane = tid & 63, wave = __builtin_amdgcn_readfirstlane(tid >> 6);
    const int qb = task < 512 ? (task & 31) : 32, bh = task < 512 ? (task >> 5) : task - 512, h = bh & 1, b = bh >> 1;
    const int l0 = qb * 64;
    __syncthreads();
    int jlo = (l0 - 128) >> 5; if (jlo < 1) jlo = 1;
    int jhi = (l0 + 191) >> 5; if (jhi > 64) jhi = 64;
    const int ntiles = 1 + (jhi - jlo + 1);
    LAS unsigned short* Ks = (LAS unsigned short*)lds;
    LAS unsigned short* Vs = (LAS unsigned short*)(lds + ATT_VOFF);
    for (int idx = tid; idx < ntiles * 32 * 8; idx += 512) {
        const int ch = idx & 7, key = idx >> 3, slot = key >> 5, kk = key & 31;
        const int lk = (slot == 0 ? 0 : (jlo + slot - 1) * 32) + kk;
        u32x4 kv = {0u, 0u, 0u, 0u}, vv = {0u, 0u, 0u, 0u};
        if (lk < LL) { const size_t R = (size_t)tok_row(b, lk);
            kv = *(const u32x4*)(K + R * 128 + h * 64 + ch * 8); vv = *(const u32x4*)(V + R * 128 + h * 64 + ch * 8); }
        *(LAS u32x4*)(Ks + slot * (ATT_KT / 2) + kk * ATT_KROW + ch * 8) = kv;
        LAS unsigned short* vd = Vs + slot * (ATT_VT / 2) + (ch * 8) * ATT_VROW + kk;
        vd[0 * ATT_VROW] = (unsigned short)(vv.x & 0xffffu); vd[1 * ATT_VROW] = (unsigned short)(vv.x >> 16);
        vd[2 * ATT_VROW] = (unsigned short)(vv.y & 0xffffu); vd[3 * ATT_VROW] = (unsigned short)(vv.y >> 16);
        vd[4 * ATT_VROW] = (unsigned short)(vv.z & 0xffffu); vd[5 * ATT_VROW] = (unsigned short)(vv.z >> 16);
        vd[6 * ATT_VROW] = (unsigned short)(vv.w & 0xffffu); vd[7 * ATT_VROW] = (unsigned short)(vv.w >> 16);
    }
    LDS_FENCE(); __syncthreads();
    const int head = h * 4 + (wave >> 1), r32 = lane & 31, hi = lane >> 5;
    const int lq = l0 + 32 * (wave & 1) + r32;
    const bool qvalid = lq < LL;
    const size_t Rq = (size_t)tok_row(b, qvalid ? lq : LL - 1);
    bf16x8 qf[4];
#pragma unroll
    for (int ks = 0; ks < 4; ++ks) qf[ks] = *(const bf16x8*)(Q + Rq * 512 + head * 64 + ks * 16 + 8 * hi);
    float mrun = sink[head], lsum = hi == 0 ? 1.0f : 0.0f;
    f32x16 o0, o1;
#pragma unroll
    for (int i = 0; i < 16; ++i) { o0[i] = 0.f; o1[i] = 0.f; }
    const int lqw = l0 + 32 * (wave & 1);
    for (int slot = 0; slot < ntiles; ++slot) {
        const int kbase = slot == 0 ? 0 : (jlo + slot - 1) * 32;
        if (lqw >= LL || (slot != 0 && (kbase + 31 < lqw - 128 || kbase > lqw + 31 + 128))) continue;
        const LAS unsigned short* kt = Ks + slot * (ATT_KT / 2);
        f32x16 s;
#pragma unroll
        for (int i = 0; i < 16; ++i) s[i] = 0.f;
#pragma unroll
        for (int ks = 0; ks < 4; ++ks) {
            const bf16x8 kf = *(const LAS bf16x8*)(kt + r32 * ATT_KROW + ks * 16 + 8 * hi);
            s = __builtin_amdgcn_mfma_f32_32x32x16_bf16(kf, qf[ks], s, 0, 0, 0);
        }
        asm volatile("s_nop 15\n\ts_nop 15" : "+v"(s));
        float mt = -1e30f;
#pragma unroll
        for (int i = 0; i < 16; ++i) {
            const int lk = kbase + (i & 3) + 8 * (i >> 2) + 4 * hi;
            int d = lq - lk; d = d < 0 ? -d : d;
            const bool valid = (lk < NMETA) || (d <= 128 && lk < LL);
            s[i] = valid ? s[i] : -1e30f;
            mt = fmaxf(mt, s[i]);
        }
        mt = fmaxf(mt, __shfl_xor(mt, 32));
        const float mnew = fmaxf(mrun, mt);
        const float alpha = __expf(mrun - mnew);
        mrun = mnew;
        float ps = 0.f;
#pragma unroll
        for (int i = 0; i < 16; ++i) { s[i] = __expf(s[i] - mnew); ps += s[i]; }
        lsum = lsum * alpha + ps;
#pragma unroll
        for (int i = 0; i < 16; ++i) { o0[i] *= alpha; o1[i] *= alpha; }
        const LAS unsigned short* vt = Vs + slot * (ATT_VT / 2);
#pragma unroll
        for (int s2 = 0; s2 < 2; ++s2) {
            union { bf16x8 v; unsigned u[4]; } pf;
            pf.u[0] = pk2(s[8 * s2 + 0], s[8 * s2 + 1]); pf.u[1] = pk2(s[8 * s2 + 2], s[8 * s2 + 3]);
            pf.u[2] = pk2(s[8 * s2 + 4], s[8 * s2 + 5]); pf.u[3] = pk2(s[8 * s2 + 6], s[8 * s2 + 7]);
#pragma unroll
            for (int dt = 0; dt < 2; ++dt) {
                union { bf16x8 v; u32x2 u[2]; } vf;
                const LAS unsigned short* vp = vt + (dt * 32 + r32) * ATT_VROW + 16 * s2 + 4 * hi;
                vf.u[0] = *(const LAS u32x2*)(vp); vf.u[1] = *(const LAS u32x2*)(vp + 8);
                if (dt == 0) o0 = __builtin_amdgcn_mfma_f32_32x32x16_bf16(vf.v, pf.v, o0, 0, 0, 0);
                else o1 = __builtin_amdgcn_mfma_f32_32x32x16_bf16(vf.v, pf.v, o1, 0, 0, 0);
            }
        }
        asm volatile("s_nop 15\n\ts_nop 15" : "+v"(o0), "+v"(o1));
    }
    asm volatile("s_nop 15\n\ts_nop 15" : "+v"(o0), "+v"(o1));
    lsum += __shfl_xor(lsum, 32);
    const float inv = 1.0f / lsum;
    if (qvalid) {
#pragma unroll
        for (int g4 = 0; g4 < 4; ++g4) {
            u32x2 w0, w1;
            w0.x = pk2(o0[4 * g4] * inv, o0[4 * g4 + 1] * inv); w0.y = pk2(o0[4 * g4 + 2] * inv, o0[4 * g4 + 3] * inv);
            w1.x = pk2(o1[4 * g4] * inv, o1[4 * g4 + 1] * inv); w1.y = pk2(o1[4 * g4 + 2] * inv, o1[4 * g4 + 3] * inv);
            *(u32x2*)(YA + Rq * 512 + head * 64 + 8 * g4 + 4 * hi) = w0;
            *(u32x2*)(YA + Rq * 512 + head * 64 + 32 + 8 * g4 + 4 * hi) = w1;
        }
    }
    __syncthreads();
}

__device__ __forceinline__ void pool_diff(LAS unsigned char* lds, const bf16* PU, bf16* PD) {
    int tl_ = threadIdx.x; asm volatile("" : "+v"(tl_));
    constexpr int TOK = 65, HALO = 8, ROWS = TOK + 2 * HALO, NTOK = NB * LL;
    for (int blk = blockIdx.x; blk * TOK < NTOK; blk += gridDim.x) {
        const int f0 = blk * TOK;
        __syncthreads();
        for (int i = tl_; i < ROWS * 64; i += 512) {
            const int r = i >> 6, ch = i & 63, f = f0 - HALO + r;
            u32x4 v = {0u, 0u, 0u, 0u};
            if (f >= 0 && f < NTOK) { const int b = f / LL, l = f % LL; v = *(const u32x4*)(PU + (size_t)tok_row(b, l) * 512 + ch * 8); }
            *(LAS u32x4*)(lds + (size_t)i * 16) = v;
        }
        LDS_FENCE(); __syncthreads();
        for (int i = tl_; i < TOK * 64; i += 512) {
            const int t = i >> 6, ch = i & 63, f = f0 + t;
            if (f >= NTOK) continue;
            const int b = f / LL, l = f % LL, half = 1 << (ch >> 4);
            const int lo = l - half < 0 ? 0 : l - half, hh = l + half > LL ? LL : l + half;
            float s[8];
#pragma unroll
            for (int j = 0; j < 8; ++j) s[j] = 0.f;
            for (int lp = lo; lp < hh; ++lp) {
                const u32x4 v = *(const LAS u32x4*)(lds + (size_t)((t + HALO + lp - l) * 64 + ch) * 16);
                s[0] += bf2f(v.x & 0xffffu); s[1] += bf2f(v.x >> 16); s[2] += bf2f(v.y & 0xffffu); s[3] += bf2f(v.y >> 16);
                s[4] += bf2f(v.z & 0xffffu); s[5] += bf2f(v.z >> 16); s[6] += bf2f(v.w & 0xffffu); s[7] += bf2f(v.w >> 16);
            }
            const float ic = 1.0f / (float)(hh - lo);
            const u32x4 v = *(const LAS u32x4*)(lds + (size_t)((t + HALO) * 64 + ch) * 16);
            u32x4 o;
            o.x = pk2(s[0] * ic - bf2f(v.x & 0xffffu), s[1] * ic - bf2f(v.x >> 16)); o.y = pk2(s[2] * ic - bf2f(v.y & 0xffffu), s[3] * ic - bf2f(v.y >> 16));
            o.z = pk2(s[4] * ic - bf2f(v.z & 0xffffu), s[5] * ic - bf2f(v.z >> 16)); o.w = pk2(s[6] * ic - bf2f(v.w & 0xffffu), s[7] * ic - bf2f(v.w >> 16));
            *(u32x4*)(PD + (size_t)tok_row(b, l) * 512 + ch * 8) = o;
        }
    }
    __syncthreads();
}

__device__ __forceinline__ void z_pass(const float* YF, const bf16* SU, const float* dskip, bf16* Z) {
    int tl_ = threadIdx.x; asm volatile("" : "+v"(tl_)); const int gt = blockIdx.x * 512 + tl_, NGT = gridDim.x * 512;
    for (int i = gt; i < NB * LL * 64; i += NGT) {
        const int ch = i & 63, tk = i >> 6, b = tk / LL, l = tk % LL, g = ch >> 1;
        const size_t R = (size_t)tok_row(b, l);
        const bf16* yp = (const bf16*)YF + ((size_t)(b * 32 + g) * LL + l) * 16 + (ch & 1) * 8;
        const u32x4 ya = *(const u32x4*)yp, yb = *(const u32x4*)(yp + (size_t)256 * LL * 16);
        f32x4 y0, y1;
        y0[0] = bf2f(ya.x & 0xffffu) + bf2f(yb.x & 0xffffu); y0[1] = bf2f(ya.x >> 16) + bf2f(yb.x >> 16); y0[2] = bf2f(ya.y & 0xffffu) + bf2f(yb.y & 0xffffu); y0[3] = bf2f(ya.y >> 16) + bf2f(yb.y >> 16);
        y1[0] = bf2f(ya.z & 0xffffu) + bf2f(yb.z & 0xffffu); y1[1] = bf2f(ya.z >> 16) + bf2f(yb.z >> 16); y1[2] = bf2f(ya.w & 0xffffu) + bf2f(yb.w & 0xffffu); y1[3] = bf2f(ya.w >> 16) + bf2f(yb.w >> 16);
        const f32x4 d0 = *(const f32x4*)(dskip + ch * 8), d1 = *(const f32x4*)(dskip + ch * 8 + 4);
        const u32x4 uu = *(const u32x4*)(SU + R * 512 + ch * 8);
        float t[8];
        t[0] = y0[0] + d0[0] * bf2f(uu.x & 0xffffu); t[1] = y0[1] + d0[1] * bf2f(uu.x >> 16); t[2] = y0[2] + d0[2] * bf2f(uu.y & 0xffffu); t[3] = y0[3] + d0[3] * bf2f(uu.y >> 16);
        t[4] = y1[0] + d1[0] * bf2f(uu.z & 0xffffu); t[5] = y1[1] + d1[1] * bf2f(uu.z >> 16); t[6] = y1[2] + d1[2] * bf2f(uu.w & 0xffffu); t[7] = y1[3] + d1[3] * bf2f(uu.w >> 16);
#pragma unroll
        for (int j = 0; j < 8; ++j) {
            const float v = t[j], tt = __builtin_amdgcn_rcpf(fabsf(v) * 0.2316418882f + 1.0f);
            float q = tt * 0.5307027145f + (-0.7265760135f); q = q * tt + 0.7107068705f; q = q * tt + (-0.142248368f); q = q * tt + 0.127414796f; q = q * tt;
            const float m = v * (q * __builtin_amdgcn_exp2f(v * v * (-0.72134752044f)));
            t[j] = v < 0.f ? m : v - m;
        }
        u32x4 o; o.x = pk2(t[0], t[1]); o.y = pk2(t[2], t[3]); o.z = pk2(t[4], t[5]); o.w = pk2(t[6], t[7]);
        *(u32x4*)(Z + R * 512 + ch * 8) = o;
    }
}

#define XB_TMO      128
#define XB_XCNT(j)  (256  + 64 * (j))
#define XB_XSUB(j)  (1280 + 64 * (j))
#define XB_XGEN(j)  (2304 + 64 * (j))
#define XB_TOP      3328
#define XB_TOPGEN   3392
#define XCD_BAR_WORDS 3456
#define XB_SPIN_CAP (1u << 18)

__device__ __forceinline__ unsigned xb_ld(unsigned* p)              { return __hip_atomic_load(p, __ATOMIC_RELAXED, __HIP_MEMORY_SCOPE_AGENT); }
__device__ __forceinline__ unsigned xb_add(unsigned* p, unsigned v) { return __hip_atomic_fetch_add(p, v, __ATOMIC_RELAXED, __HIP_MEMORY_SCOPE_AGENT); }
__device__ __forceinline__ unsigned xb_xcc_id() { return (unsigned)__builtin_amdgcn_s_getreg((3 << 11) | 20) & 0xFu; }
#define XB_SPIN(cond, bar) do { unsigned _sp = 0; while (cond) { __builtin_amdgcn_s_sleep(1); \
    if ((++_sp & 255u) == 0u) { if (xb_ld(&(bar)[XB_TMO])) break; if (_sp > XB_SPIN_CAP) { atomicAdd(&(bar)[XB_TMO], 1u); break; } } } } while (0)

struct XcdBarrier {
    unsigned* bar; unsigned x;
    volatile LAS unsigned* st;
};

__device__ __forceinline__ XcdBarrier xcd_barrier_post(unsigned* bar, volatile LAS unsigned* st) {
    XcdBarrier b; b.bar = bar; b.x = xb_xcc_id(); b.st = st;
    if (threadIdx.x == 0) (void)xb_add(&bar[XB_XCNT(b.x)], 1u);
    return b;
}
__device__ __forceinline__ void xcd_barrier_complete(unsigned* bar, unsigned x, unsigned& nloc, unsigned& nx) {
    const unsigned G = gridDim.x * gridDim.y * gridDim.z;
    unsigned sum, cnt, mine, sp = 0u;
    for (;;) {
        sum = 0u; cnt = 0u; mine = 0u;
#pragma unroll
        for (unsigned j = 0; j < 16; ++j) { const unsigned c = xb_ld(&bar[XB_XCNT(j)]); sum += c; cnt += (c > 0u) ? 1u : 0u; mine = (j == x) ? c : mine; }
        if (sum == G) break;
        __builtin_amdgcn_s_sleep(1);
        if ((++sp & 255u) == 0u) { if (xb_ld(&bar[XB_TMO])) break; if (sp > XB_SPIN_CAP) { atomicAdd(&bar[XB_TMO], 1u); break; } }
    }
    nloc = mine > 0u ? mine : 1u; nx = cnt > 0u ? cnt : 1u;
}

__device__ __forceinline__ void xcd_barrier(const XcdBarrier& b) {
    asm volatile("s_waitcnt vmcnt(0)" ::: "memory");
    __syncthreads();
    if (threadIdx.x == 0) {
        unsigned* bar = b.bar;
        __builtin_amdgcn_s_waitcnt(0);
        unsigned nloc = b.st[0], nx = b.st[1];
        if (nloc == 0u) { xcd_barrier_complete(bar, b.x, nloc, nx); b.st[0] = nloc; b.st[1] = nx; }
        const unsigned old = xb_add(&bar[XB_XSUB(b.x)], 1u);
        const unsigned gen = old / nloc;
        if (old + 1u == (gen + 1u) * nloc) {
            __builtin_amdgcn_fence(__ATOMIC_RELEASE, "agent");
            asm volatile("s_waitcnt vmcnt(0)" ::: "memory");
            const unsigned og = xb_add(&bar[XB_TOP], 1u);
            const unsigned tg = og / nx;
            if (og + 1u == (tg + 1u) * nx) xb_add(&bar[XB_TOPGEN], 1u);
            else XB_SPIN(xb_ld(&bar[XB_TOPGEN]) == tg, bar);
            __builtin_amdgcn_fence(__ATOMIC_ACQUIRE, "agent");
            xb_add(&bar[XB_XGEN(b.x)], 1u);
            asm volatile("s_waitcnt vmcnt(0)" ::: "memory");
        } else {
            XB_SPIN(xb_ld(&bar[XB_XGEN(b.x)]) == gen, bar);
            __builtin_amdgcn_fence(__ATOMIC_ACQUIRE, "agent");
            asm volatile("s_waitcnt vmcnt(0)" ::: "memory");
        }
    }
    __syncthreads();
}

#ifndef MK_ALIGN
#define MK_ALIGN true
#endif
#ifndef MK_SP2
#define MK_SP2 true
#endif
#ifndef MK_SPLIT
#define MK_SPLIT 0
#endif
#ifndef MK_NLAYER
#define MK_NLAYER 2
#endif
constexpr int NPL = 8, NPHASE = 1 + 2 * NPL + 1, PH_FINAL = NPHASE - 1;

#define KARGS() ({ auto kp_ = __builtin_amdgcn_kernarg_segment_ptr(); asm volatile("" : "+s"(kp_)); (KArgsP)kp_; })
__global__ void __launch_bounds__(512, 2) fwd_kernel(Args a_unused, int ph_lo, int ph_hi) {
    (void)a_unused;
    extern __shared__ __attribute__((aligned(16))) unsigned char lds_raw[];
    LAS unsigned char* lds = (LAS unsigned char*)lds_raw;
    const int G = gridDim.x, bid = blockIdx.x;
#if MK_SPLIT
#define GRID_SYNC() do {} while (0)
    (void)lds;
#else
#define CG_SYNC() do { asm volatile("s_waitcnt vmcnt(0)" ::: "memory"); __syncthreads(); \
    if (threadIdx.x == 0) { __builtin_amdgcn_fence(__ATOMIC_RELEASE, "agent"); asm volatile("s_waitcnt vmcnt(0)" ::: "memory"); } \
    __syncthreads(); grid.sync(); \
    if (threadIdx.x == 0) { __builtin_amdgcn_fence(__ATOMIC_ACQUIRE, "agent"); asm volatile("s_waitcnt vmcnt(0)" ::: "memory"); } \
    __syncthreads(); } while (0)
    cg::grid_group grid = cg::this_grid();
    unsigned* barw = (unsigned*)(KARGS()->ws + WS_CTL);
    if (bid == 0) for (int i = threadIdx.x; i < XCD_BAR_WORDS; i += 512) __hip_atomic_store(barw + i, 0u, __ATOMIC_RELAXED, __HIP_MEMORY_SCOPE_AGENT);
    volatile LAS unsigned* xst = (volatile LAS unsigned*)(lds + LDS_BYTES - 64);
    if (threadIdx.x < 2) xst[threadIdx.x] = 0u;
    CG_SYNC();
    const XcdBarrier xbar = xcd_barrier_post(barw, xst);
#define GRID_SYNC() xcd_barrier(xbar)

#endif
#ifndef PHMASK
#define PHMASK 0xFFFFu
#endif
#define IN(k) (((PHMASK >> ((k) == 0 ? 0 : (k) == PH_FINAL ? 9 : 1 + ((k) - 1) % NPL)) & 1u) && ph_lo <= (k) && (k) < ph_hi)
#define SEAM(k) do { if (IN(k) && (k) + 1 < ph_hi) GRID_SYNC(); } while (0)
#define PHASE_BEGIN() KArgsP ka = KARGS(); unsigned char* ws = ka->ws; asm volatile("" : "+s"(ws)); float* rowss = (float*)(ws + WS_RS); float* Hm = (float*)(ws + WS_HM); bf16* HB = (bf16*)(ws + WS_HB); unsigned char* wl = ws + WS_W + (size_t)layer * LW_BYTES; \
    const int MT = NREAL; const bool META = layer != MK_NLAYER - 1;     \
    const float* rs_mix = rowss + (size_t)(2 * layer) * TPR * 16; float* rs_mlp = rowss + (size_t)(2 * layer + 1) * TPR * 16; float* rs_next = rowss + (size_t)(2 * layer + 2) * TPR * 16; (void)MT; (void)META; (void)Hm; (void)HB; (void)wl; (void)rs_mix; (void)rs_mlp; (void)rs_next;

    if (IN(0)) {
        { int tl_ = threadIdx.x; asm volatile("" : "+v"(tl_)); const int wv = __builtin_amdgcn_readfirstlane(tl_ >> 6);
          convert_layer_weights(KARGS(), lds, 0, bid * 8 + wv, G * 8, wv, tl_ & 63, 0); }
        Args al; { KArgsP kp = KARGS(); for (int i = 0; i < 23; ++i) al.in[i] = kp->in[i]; al.out = kp->out; al.ws = kp->ws; } p0_prologue(al, lds); }
    SEAM(0);
#ifndef MK_NLAYER
#define MK_NLAYER 2
#endif
#ifndef MK_RSIDX
#define MK_RSIDX 4
#endif
#pragma unroll 1
    for (int layer = 0; layer < MK_NLAYER; ++layer) {
        const int p = 1 + NPL * layer;
        if (IN(p)) { PHASE_BEGIN();
            pg8::Gemm g{HB, (const bf16*)(wl + OW_IN), TPR, NPROJ, DM}; pg8::StaticOrder S; S.init(TPR, NPROJ, G, bid);
            EpiInProj E{rs_mix, (const float*)(ws + WS_ROPE), (bf16*)(ws + WS_Q), (bf16*)(ws + WS_K), (bf16*)(ws + WS_V), (bf16*)(ws + WS_SU), (bf16*)(ws + WS_PU)};
            pg8::gemm_phase<EpiInProj, pg8::StaticOrder, MK_ALIGN, MK_SP2>(lds, g, S, E);
        }
        SEAM(p);
        if (IN(p + 1)) { PHASE_BEGIN();
            for (int t = bid; t < 256; t += G)
                ssm_task(lds, t, layer, (const bf16*)(ws + WS_SU), (float*)(ws + WS_YF), (const float*)(ws + WS_ABAR), (const bf16*)(ws + WS_BMAT), (const bf16*)(ws + WS_CMAT));
            for (int t = bid; t < NB * 2 * 33; t += G)
                attn_task(lds, t, (const bf16*)(ws + WS_Q), (const bf16*)(ws + WS_K), (const bf16*)(ws + WS_V), (bf16*)ka->out, ka->in[4] + layer * 8);
            pool_diff(lds, (const bf16*)(ws + WS_PU), (bf16*)(ws + WS_PD));
            {
                int tl_ = threadIdx.x; asm volatile("" : "+v"(tl_)); const int wv = __builtin_amdgcn_readfirstlane(tl_ >> 6);
                convert_layer_weights(ka, lds, layer, bid * 8 + wv, G * 8, wv, tl_ & 63, 1);
                if (layer + 1 < MK_NLAYER) convert_layer_weights(ka, lds, layer + 1, bid * 8 + wv, G * 8, wv, tl_ & 63, 0);
                __syncthreads();
            }
        }
        SEAM(p + 1);
        if (IN(p + 2)) { PHASE_BEGIN();
            z_pass((const float*)(ws + WS_YF), (const bf16*)(ws + WS_SU), ka->in[12] + layer * 512, (bf16*)(ws + WS_Z));
        }
        SEAM(p + 2);
        if (IN(p + 3)) { PHASE_BEGIN();
            const int hg = G >> 1;
            if (bid < hg) { pg8::Gemm g{(const bf16*)(ws + WS_Z), (const bf16*)(wl + OW_GLU), MT, 512, 512}; pg8::StaticOrder S; S.init(MT, 512, hg, bid);
              EpiGlu E{(const bf16*)(ws + WS_Z), ka->in[14] + layer * 512, (bf16*)ka->out + (size_t)TPR * 512};
              pg8::gemm_phase<EpiGlu, pg8::StaticOrder, MK_ALIGN, MK_SP2>(lds, g, S, E); if (META) thin_gemm<EpiGlu>(lds, g.A, g.Bt, g.K, g.N, E, bid, hg); }
            else { pg8::Gemm g{(const bf16*)(ws + WS_PD), (const bf16*)(wl + OW_POOL), MT, 512, 512}; pg8::StaticOrder S; S.init(MT, 512, G - hg, bid - hg);
              EpiScale E{(bf16*)ka->out + (size_t)2 * TPR * 512, 512, ka->in[16] + layer * 512};
              pg8::gemm_phase<EpiScale, pg8::StaticOrder, MK_ALIGN, MK_SP2>(lds, g, S, E); if (META) thin_gemm<EpiScale>(lds, g.A, g.Bt, g.K, g.N, E, bid - hg, G - hg); }
        }
        SEAM(p + 3);
        if (IN(p + 4)) { PHASE_BEGIN();
            bf16* Y3 = (bf16*)ka->out;
            bf16* BR0 = (bf16*)(ws + WS_X), *BR1 = (bf16*)(ws + WS_X + 4 * UU), *BR2 = (bf16*)(ws + WS_X + 6 * UU);
            const bf16* Wbr = (const bf16*)(wl + OW_BR); const bf16* Wg = (const bf16*)(wl + OW_IN) + (size_t)NPROJ * DM; bf16* MG = (bf16*)(ws + WS_MG);
            { pg8::Gemm g{Y3, Wbr, 3 * TPR, 3072, 512}; TripleOrder S; S.init(G, bid, TPR / 256, 4);
              EpiBr3 E{BR0, TPR / 256};
              pg8::gemm_phase<EpiBr3, TripleOrder, MK_ALIGN, MK_SP2>(lds, g, S, E); }
            { pg8::Gemm g{HB, Wg, MT, 3072, DM}; TripleOrder S; S.init(G, bid, 0, 4);
              EpiGate3 E{rs_mix, BR0, MG};
              pg8::gemm_phase<EpiGate3, TripleOrder, MK_ALIGN, MK_SP2>(lds, g, S, E); }
            if (META) {
                bf16* GBm = (bf16*)(ws + WS_HM) - (size_t)NREAL * 1024;
#pragma unroll 1
                for (int c = 0; c < 3; ++c) {
                    const int vb = (bid - 64 * c) & 255;
                    bf16* BRc = BR0 + (size_t)(2 * c + 2 * (c > 0)) * (UU / 2);
                    { EpiScale E{BRc, 1024, nullptr}; thin_gemm<EpiScale>(lds, Y3 + (size_t)c * TPR * 512, Wbr + (size_t)c * 1024 * 512, 512, 1024, E, vb, 256); }
                    { EpiGate<true> E{rs_mix, BRc, GBm + (size_t)c * 128 * 1024}; thin_gemm<EpiGate<true>>(lds, HB, Wg + (size_t)c * 1024 * DM, DM, 1024, E, vb, 256); }
                }
            }
        }
        SEAM(p + 4);
        if (IN(p + 5)) { PHASE_BEGIN();
            pg8::Gemm g{(const bf16*)(ws + WS_MG), (const bf16*)(wl + OW_OUT), MT, DM, DM}; pg8::StaticOrder S; S.init(MT, DM, G, bid);
            EpiRes E{(const float*)nullptr, HB, rs_mlp};
            pg8::gemm_phase<EpiRes, pg8::StaticOrder, MK_ALIGN, MK_SP2>(lds, g, S, E); if (META) thin_gemm<EpiRes, true>(lds, (const bf16*)(ws + WS_HM) - (size_t)NREAL * 1024, g.Bt, g.K, g.N, E, bid, G, (size_t)128 * 1024);
        }
        SEAM(p + 5);
        if (IN(p + 6)) { PHASE_BEGIN();
            pg8::Gemm g{HB, (const bf16*)(wl + OW_UP), MT, FF, DM}; pg8::StaticOrder S; S.init(MT, FF, G, bid);
            EpiUp E{rs_mlp, (bf16*)(ws + WS_ACT)};
            pg8::gemm_phase<EpiUp, pg8::StaticOrder, MK_ALIGN, MK_SP2>(lds, g, S, E); if (META) thin_gemm<EpiUp>(lds, g.A, g.Bt, g.K, g.N, E, bid, G);
        }
        SEAM(p + 6);
        if (IN(p + 7)) { PHASE_BEGIN();
            pg8::Gemm g{(const bf16*)(ws + WS_ACT), (const bf16*)(wl + OW_DN), MT, DM, FF}; pg8::StaticOrder S; S.init(MT, DM, G, bid);
            EpiRes E{(const float*)nullptr, HB, rs_next};
            pg8::gemm_phase<EpiRes, pg8::StaticOrder, MK_ALIGN, MK_SP2>(lds, g, S, E); if (META) thin_gemm<EpiRes>(lds, g.A, g.Bt, g.K, g.N, E, bid, G);
        }
        SEAM(p + 7);
    }
#ifdef MK_DUMP_OFF
    if (IN(PH_FINAL)) { KArgsP ka = KARGS();
        const bf16* src = (const bf16*)(ka->ws + (MK_DUMP_OFF)); const bf16* src2 = (const bf16*)(ka->ws + (MK_DUMP_OFF2));
        for (int i = bid * 512 + threadIdx.x; i < NREAL * 1024; i += G * 512) { const int R = MK_DUMP_ROW(i >> 10), c = i & 1023; ka->out[i] = c < 512 ? bf2f(src[(size_t)R * (MK_DUMP_LD) + (c % (MK_DUMP_LD))]) : bf2f(src2[(size_t)R * (MK_DUMP_LD2) + (c % (MK_DUMP_LD2))]); }
    }
#else
    if (IN(PH_FINAL)) { KArgsP ka = KARGS();
        const float* rs = (const float*)(ka->ws + WS_RS) + (size_t)MK_RSIDX * TPR * 16; const float* gain = ka->in[22];
        int tl_ = threadIdx.x; asm volatile("" : "+v"(tl_));
        const int lane = tl_ & 63, wv = __builtin_amdgcn_readfirstlane(tl_ >> 6);
        for (int R = bid * 8 + wv; R < NREAL; R += G * 8) {
            const float r = row_rstd(rs, R);
            const bf16* hrow = (const bf16*)(ka->ws + WS_HB) + (size_t)R * DM; float* orow = ka->out + (size_t)R * DM;
#pragma unroll
            for (int j = 0; j < 4; ++j) {
                const int c4 = (lane + 64 * j) * 4;
                const u32x2 hb = *(const u32x2*)(hrow + c4); const f32x4 gn = *(const f32x4*)(gain + c4);
                f32x4 v = {bf2f(hb.x & 0xffffu), bf2f(hb.x >> 16), bf2f(hb.y & 0xffffu), bf2f(hb.y >> 16)};
                v = v * r * gn;
                __builtin_nontemporal_store(v, (f32x4*)(orow + c4));
            }
        }
    }
#endif
#undef IN
#undef SEAM
}

extern "C" void kernel_launch(void* const* d_in, const int* in_sizes, int n_in, void* d_out, int out_size, void* d_ws, size_t ws_size, hipStream_t stream) {
    static int grid = 0;
    if (grid == 0) {
        if (n_in != 23 || out_size != NREAL * DM || ws_size < WS_END) { fprintf(stderr, "kernel_launch: unexpected shapes (n_in %d out %d ws %zu)\n", n_in, out_size, ws_size); grid = -1; return; }
        int dev = 0, cus = 0, per_cu = 0;
        hipGetDevice(&dev); hipDeviceGetAttribute(&cus, hipDeviceAttributeMultiprocessorCount, dev);
        if (hipFuncSetAttribute((const void*)fwd_kernel, hipFuncAttributeMaxDynamicSharedMemorySize, LDS_BYTES) != hipSuccess) { fprintf(stderr, "kernel_launch: hipFuncSetAttribute failed\n"); grid = -1; return; }
        if (hipOccupancyMaxActiveBlocksPerMultiprocessor(&per_cu, (const void*)fwd_kernel, 512, LDS_BYTES) != hipSuccess || per_cu < 1) { fprintf(stderr, "kernel_launch: occupancy query gave %d\n", per_cu); per_cu = 1; }
        (void)hipGetLastError();
        grid = cus * (per_cu > 1 ? 1 : per_cu);
        if (grid <= 0) grid = 256;
    }
    if (grid < 0) return;
    Args a{};
    for (int i = 0; i < 23; ++i) a.in[i] = (const float*)d_in[i];
    a.out = (float*)d_out; a.ws = (unsigned char*)d_ws;
#if MK_SPLIT
    for (int ph = 0; ph < NPHASE; ++ph) hipLaunchKernelGGL(fwd_kernel, dim3(grid), dim3(512), LDS_BYTES, stream, a, ph, ph + 1);
#else
    int lo = 0, hi = NPHASE;
    void* kargs[] = {(void*)&a, (void*)&lo, (void*)&hi};
    hipError_t e = hipLaunchCooperativeKernel((const void*)fwd_kernel, dim3(grid), dim3(512), kargs, LDS_BYTES, stream);
    if (e != hipSuccess) fprintf(stderr, "kernel_launch: cooperative launch failed: %s (grid %d)\n", hipGetErrorString(e), grid);
#endif
}
```
